# Optimizing an MI355X kernel written in HIP

```python
import jax, jax.numpy as jnp
from jax import lax
import numpy as np

D_MODEL = 1024
BATCH = 16
SEQ = 2048
DEPTH = 1

PLE_DIM = 256
ATTN_WIDTH = D_MODEL // 2
ATTN_HEAD_DIM = 64
N_ATTN_HEADS = ATTN_WIDTH // ATTN_HEAD_DIM
ROPE_THETA = 10000.0
MOBA_BLOCK = 256
MOBA_TOPK = 3
MOBA_QUERY_CHUNK = 16
GMLP_WIDTH = D_MODEL - ATTN_WIDTH
GMLP_GROUPS = 4
GMLP_GROUP_DIM = GMLP_WIDTH // GMLP_GROUPS
GMLP_CHUNK = 128
MIX_WIDTH = ATTN_WIDTH + GMLP_WIDTH
IN_PROJ_WIDTH = 3 * ATTN_WIDTH + 2 * GMLP_WIDTH
N_EXPERTS = 32
TOP_K = 4
D_EXPERT = D_MODEL
SWIGLU_LIMIT = 7.0
SWIGLU_ALPHA = 1.702
EXPERT_ROW_BLOCK = 512
NORM_EPS = 1e-6
NEG_INF = -1e30

kernel_name = "hymba_moba_gmlp_moe_ple"


def rmsnorm(x, g):
    xf = x.astype(jnp.float32)
    y = xf * lax.rsqrt(jnp.mean(xf * xf, axis=-1, keepdims=True) + NORM_EPS)
    return (y * g.astype(jnp.float32)).astype(x.dtype)


def layernorm(x, g, b):
    xf = x.astype(jnp.float32)
    mu = jnp.mean(xf, axis=-1, keepdims=True)
    var = jnp.mean(jnp.square(xf - mu), axis=-1, keepdims=True)
    y = (xf - mu) * lax.rsqrt(var + NORM_EPS)
    return (y * g.astype(jnp.float32) + b.astype(jnp.float32)).astype(x.dtype)


def rope(x):
    S, hd = x.shape[2], x.shape[3]
    half = hd // 2
    inv = ROPE_THETA ** (-jnp.arange(half, dtype=jnp.float32) / half)
    ang = jnp.arange(S, dtype=jnp.float32)[:, None] * inv[None, :]
    cos = jnp.cos(ang).astype(x.dtype)
    sin = jnp.sin(ang).astype(x.dtype)
    x1, x2 = x[..., :half], x[..., half:]
    return jnp.concatenate([x1 * cos - x2 * sin, x2 * cos + x1 * sin], axis=-1)


def moba_attention(q, k, v):
    B, H, S, hd = q.shape
    n_blk = -(-S // MOBA_BLOCK)
    S_pad = n_blk * MOBA_BLOCK
    pad = ((0, 0), (0, 0), (0, S_pad - S), (0, 0))
    q, k, v = jnp.pad(q, pad), jnp.pad(k, pad), jnp.pad(v, pad)
    scale = 1.0 / np.sqrt(hd)
    k_blocks = k.reshape(B, H, n_blk, MOBA_BLOCK, hd)
    v_blocks = v.reshape(B, H, n_blk, MOBA_BLOCK, hd)
    k_mean = jnp.mean(k_blocks.astype(jnp.float32), axis=3)

    q_block = jnp.arange(S_pad) // MOBA_BLOCK
    gate = jnp.einsum('bhsd,bhnd->bhsn', q.astype(jnp.float32), k_mean)
    fully_past = jnp.arange(n_blk)[None, :] < q_block[:, None]
    gate = jnp.where(fully_past, gate, NEG_INF)
    k_sel = min(MOBA_TOPK, n_blk)
    _, sel_idx = lax.top_k(gate, k_sel)
    sel_valid = jnp.arange(k_sel)[None, :] < q_block[:, None]

    QC = MOBA_QUERY_CHUNK
    n_qc = S_pad // QC
    q_c = q.reshape(B, H, n_qc, QC, hd).transpose(2, 0, 1, 3, 4)
    idx_c = sel_idx.reshape(B, H, n_qc, QC, k_sel).transpose(2, 0, 1, 3, 4)
    valid_c = sel_valid.reshape(n_qc, QC, k_sel)
    b_ix = jnp.arange(B)[:, None, None, None]
    h_ix = jnp.arange(H)[None, :, None, None]

    def query_chunk(args):
        c, qq, idx, valid = args
        q_pos = c * QC + jnp.arange(QC)
        own = (c * QC) // MOBA_BLOCK
        k_own = lax.dynamic_index_in_dim(k_blocks, own, axis=2, keepdims=False)
        v_own = lax.dynamic_index_in_dim(v_blocks, own, axis=2, keepdims=False)
        k_pos = own * MOBA_BLOCK + jnp.arange(MOBA_BLOCK)
        s_own = jnp.einsum('bhqd,bhkd->bhqk', qq, k_own).astype(jnp.float32) * scale
        s_own = jnp.where(k_pos[None, :] <= q_pos[:, None], s_own, NEG_INF)
        k_g = k_blocks[b_ix, h_ix, idx]
        v_g = v_blocks[b_ix, h_ix, idx]
        s_past = jnp.einsum('bhqd,bhqrkd->bhqrk', qq, k_g).astype(jnp.float32) * scale
        s_past = jnp.where(valid[None, None, :, :, None], s_past, NEG_INF)
        s = jnp.concatenate([s_past.reshape(B, H, QC, k_sel * MOBA_BLOCK), s_own], axis=-1)
        prob = jax.nn.softmax(s, axis=-1)
        p_past = prob[..., :k_sel * MOBA_BLOCK].reshape(B, H, QC, k_sel, MOBA_BLOCK).astype(v.dtype)
        p_own = prob[..., k_sel * MOBA_BLOCK:].astype(v.dtype)
        return (jnp.einsum('bhqrk,bhqrkd->bhqd', p_past, v_g)
                + jnp.einsum('bhqk,bhkd->bhqd', p_own, v_own))

    out = lax.map(query_chunk, (jnp.arange(n_qc), q_c, idx_c, valid_c))
    out = out.transpose(1, 2, 0, 3, 4).reshape(B, H, S_pad, hd)
    return out[:, :, :S]


def gmlp_spatial_gating(u, v, ln_g, ln_b, w_s, b_s):
    B, S, _ = v.shape
    nc = S // GMLP_CHUNK
    u = jax.nn.gelu(u, approximate=False)
    v = jax.nn.gelu(v, approximate=False).reshape(B, S, GMLP_GROUPS, GMLP_GROUP_DIM)
    v = layernorm(v, ln_g.reshape(GMLP_GROUPS, GMLP_GROUP_DIM), ln_b.reshape(GMLP_GROUPS, GMLP_GROUP_DIM))
    v = v.reshape(B, nc, GMLP_CHUNK, GMLP_GROUPS, GMLP_GROUP_DIM)
    causal = jnp.tril(jnp.ones((GMLP_CHUNK, GMLP_CHUNK), dtype=w_s.dtype))
    w = w_s * causal[None]
    mixed = jnp.einsum('gts,bcsgd->bctgd', w, v) + b_s.T[None, None, :, :, None]
    out = u.reshape(B, nc, GMLP_CHUNK, GMLP_GROUPS, GMLP_GROUP_DIM) * mixed
    return out.reshape(B, S, GMLP_WIDTH)


def routed_experts(h, router_w, router_b, w_gu, b_gu, w_dn, b_dn):
    B, S, D = h.shape
    T = B * S
    hf = h.reshape(T, D)
    logits = (hf @ router_w + router_b).astype(jnp.float32)
    top_v, top_i = lax.top_k(logits, TOP_K)
    gate = jax.nn.softmax(top_v, axis=-1)

    flat_e = top_i.reshape(-1)
    flat_t = jnp.repeat(jnp.arange(T, dtype=jnp.int32), TOP_K)
    flat_g = gate.reshape(-1)
    order = jnp.argsort(flat_e)
    se, st, sg = flat_e[order], flat_t[order], flat_g[order]
    counts = jnp.bincount(flat_e, length=N_EXPERTS)
    padded = (counts + EXPERT_ROW_BLOCK - 1) // EXPERT_ROW_BLOCK * EXPERT_ROW_BLOCK
    start = jnp.cumsum(counts) - counts
    pend = jnp.cumsum(padded)
    pstart = pend - padded
    dest = pstart[se] + (jnp.arange(T * TOP_K) - start[se])
    n_rows = T * TOP_K + N_EXPERTS * EXPERT_ROW_BLOCK
    n_blocks = n_rows // EXPERT_ROW_BLOCK
    row_tok = jnp.full((n_rows,), T, dtype=jnp.int32).at[dest].set(st)
    row_g = jnp.zeros((n_rows,), dtype=jnp.float32).at[dest].set(sg)
    blk_e = jnp.minimum(jnp.searchsorted(pend, jnp.arange(n_blocks) * EXPERT_ROW_BLOCK, side='right'),
                        N_EXPERTS - 1)
    h_pad = jnp.concatenate([hf, jnp.zeros((1, D), hf.dtype)], axis=0)
    x_rows = h_pad[row_tok].reshape(n_blocks, EXPERT_ROW_BLOCK, D)

    def expert_block(args):
        e, xb = args
        gu = xb @ w_gu[e] + b_gu[e]
        g, lin = gu[:, :D_EXPERT], gu[:, D_EXPERT:]
        g = jnp.minimum(g, SWIGLU_LIMIT)
        lin = jnp.clip(lin, -SWIGLU_LIMIT, SWIGLU_LIMIT)
        a = g * jax.nn.sigmoid(SWIGLU_ALPHA * g) * (lin + 1.0)
        return a @ w_dn[e] + b_dn[e]

    y_rows = lax.map(expert_block, (blk_e, x_rows)).reshape(n_rows, D)
    y = jax.ops.segment_sum(y_rows * row_g[:, None].astype(y_rows.dtype), row_tok,
                            num_segments=T + 1)[:T]
    return y.reshape(B, S, D)


def setup_inputs(seed: int = 0) -> dict:
    key = jax.random.key(seed)
    ks = jax.random.split(key, 24)
    f32 = jnp.float32
    nrm = lambda k, shape, s: jax.random.normal(k, shape, f32) * s
    gain = lambda k, shape: 1.0 + 0.02 * jax.random.normal(k, shape, f32)
    L, D, E, F = DEPTH, D_MODEL, N_EXPERTS, D_EXPERT
    return {
        "x": jax.random.normal(ks[0], (BATCH, SEQ, D), f32),
        "p": jax.random.normal(ks[1], (DEPTH, BATCH, SEQ, PLE_DIM), f32),
        "mix_norm": gain(ks[2], (L, D)),
        "w_in": nrm(ks[3], (L, D, IN_PROJ_WIDTH), D ** -0.5),
        "gmlp_ln_g": gain(ks[4], (L, GMLP_WIDTH)),
        "gmlp_ln_b": nrm(ks[5], (L, GMLP_WIDTH), 0.02),
        "gmlp_ws": nrm(ks[6], (L, GMLP_GROUPS, GMLP_CHUNK, GMLP_CHUNK), GMLP_CHUNK ** -0.5),
        "gmlp_bs": gain(ks[7], (L, GMLP_GROUPS, GMLP_CHUNK)),
        "attn_out_norm": gain(ks[8], (L, ATTN_WIDTH)),
        "gmlp_out_norm": gain(ks[9], (L, GMLP_WIDTH)),
        "w_out": nrm(ks[10], (L, MIX_WIDTH, D), MIX_WIDTH ** -0.5),
        "ffn_norm": gain(ks[11], (L, D)),
        "router_w": nrm(ks[12], (L, D, E), D ** -0.5),
        "router_b": nrm(ks[13], (L, E), 0.01),
        "w_gate_up": nrm(ks[14], (L, E, D, 2 * F), D ** -0.5),
        "b_gate_up": nrm(ks[15], (L, E, 2 * F), 0.01),
        "w_down": nrm(ks[16], (L, E, F, D), F ** -0.5),
        "b_down": nrm(ks[17], (L, E, D), 0.01),
        "ple_norm": gain(ks[18], (L, D)),
        "w_ple_gate": nrm(ks[19], (L, D, D), D ** -0.5),
        "w_ple_proj": nrm(ks[20], (L, PLE_DIM, D), PLE_DIM ** -0.5),
        "ple_post_norm": gain(ks[21], (L, D)),
        "final_norm": gain(ks[22], (D,)),
    }


def reference(x, p, mix_norm, w_in, gmlp_ln_g, gmlp_ln_b, gmlp_ws, gmlp_bs, attn_out_norm,
              gmlp_out_norm, w_out, ffn_norm, router_w, router_b, w_gate_up, b_gate_up,
              w_down, b_down, ple_norm, w_ple_gate, w_ple_proj, ple_post_norm, final_norm):
    B, S, D = x.shape
    A = ATTN_WIDTH
    for i in range(DEPTH):
        h = rmsnorm(x, mix_norm[i])
        proj = h @ w_in[i]
        heads = lambda t: t.reshape(B, S, N_ATTN_HEADS, ATTN_HEAD_DIM).transpose(0, 2, 1, 3)
        q = rope(heads(proj[..., 0:A]))
        k = rope(heads(proj[..., A:2 * A]))
        v = heads(proj[..., 2 * A:3 * A])
        u_g = proj[..., 3 * A:3 * A + GMLP_WIDTH]
        v_g = proj[..., 3 * A + GMLP_WIDTH:]
        attn = moba_attention(q, k, v).transpose(0, 2, 1, 3).reshape(B, S, A)
        gm = gmlp_spatial_gating(u_g, v_g, gmlp_ln_g[i], gmlp_ln_b[i], gmlp_ws[i], gmlp_bs[i])
        mixed = jnp.concatenate([rmsnorm(attn, attn_out_norm[i]), rmsnorm(gm, gmlp_out_norm[i])], axis=-1)
        x = x + mixed @ w_out[i]
        x = x + routed_experts(rmsnorm(x, ffn_norm[i]), router_w[i], router_b[i],
                               w_gate_up[i], b_gate_up[i], w_down[i], b_down[i])
        gate = jax.nn.sigmoid(rmsnorm(x, ple_norm[i]) @ w_ple_gate[i])
        x = x + gate * rmsnorm(p[i] @ w_ple_proj[i], ple_post_norm[i])
    return rmsnorm(x, final_norm)
```

```cpp
#include <hip/hip_runtime.h>
#include <cstdio>
#include <cstdint>

#ifndef CHECK_STAGE
#define CHECK_STAGE 0
#endif
#ifndef CHECK_REPORT
#define CHECK_REPORT 0
#endif
#ifndef CHECK_REPORT2
#define CHECK_REPORT2 0
#endif
#ifndef CHECK_REPORT3
#define CHECK_REPORT3 0
#endif
#ifndef CHECK_SKIP
#define CHECK_SKIP 0
#endif
#ifndef PHMASK
#define PHMASK 0x3ff
#endif
#define PH(n) ((PHMASK >> (n)) & 1)

#define GAS __attribute__((address_space(1)))
#define LAS __attribute__((address_space(3)))
typedef unsigned short bf16;
typedef unsigned v4u __attribute__((ext_vector_type(4)));
typedef unsigned v2u __attribute__((ext_vector_type(2)));
typedef float f32x2 __attribute__((ext_vector_type(2)));
typedef float f32x4 __attribute__((ext_vector_type(4)));
typedef float f32x16 __attribute__((ext_vector_type(16)));
typedef short bf16x8 __attribute__((ext_vector_type(8)));
typedef short s16x4 __attribute__((ext_vector_type(4)));
typedef GAS unsigned gu32;

constexpr int BATCH = 16, SEQ = 2048, DM = 1024, T = BATCH * SEQ;
constexpr int AW = 512, NH = 8, HD = 64, NBLK = 8, MOBA = 256;
constexpr int GW = 512, GG = 4, GD = 128, GC = 128;
constexpr int NPROJ = 3 * AW + 2 * GW;
constexpr int NE = 32, TOPK = 4, FF = 1024;
constexpr int PLE = 256;
constexpr int MAXROWS = T * TOPK + NE * 256;
constexpr float EPS = 1e-6f;
constexpr int NWAVES = 8, NTHR = 512;

constexpr size_t MiB = 1u << 20;
constexpr size_t WS_CTL = 0, CTL_ZERO_BYTES = 1 * MiB;
constexpr size_t WS_KMEAN = 256 * 1024;
constexpr size_t WS_WIN = 1 * MiB;
constexpr size_t WS_WOUT = 6 * MiB;
constexpr size_t WS_WPG = 8 * MiB;
constexpr size_t WS_WPP = 10 * MiB;
constexpr size_t WS_RWG = 10 * MiB + 512 * 1024;
constexpr size_t WS_ROPE = 11 * MiB;
constexpr size_t WS_WGU = 16 * MiB;
constexpr size_t WS_WDN = 144 * MiB;
constexpr size_t WS_XNB = 208 * MiB;
constexpr size_t WS_BIG1 = 272 * MiB;
constexpr size_t WS_Q = WS_BIG1, WS_K = WS_Q + 32 * MiB, WS_V = WS_K + 32 * MiB, WS_U = WS_V + 32 * MiB, WS_VG = WS_U + 32 * MiB, WS_MIX = WS_VG + 32 * MiB;
constexpr size_t WS_YBUF = WS_BIG1;
constexpr size_t WS_BIG2 = 544 * MiB;
constexpr size_t WS_ABUF = WS_BIG2, WS_GATE = WS_BIG2, WS_PP = WS_BIG2 + 64 * MiB;
constexpr size_t WS_PB = 816 * MiB;
constexpr size_t WS_IDX = 832 * MiB;
constexpr size_t WS_GSS = 836 * MiB;
constexpr size_t WS_TOKPOS = 840 * MiB;
constexpr size_t WS_SSQA = 841 * MiB;
constexpr size_t WS_SSQG = 842 * MiB;
constexpr size_t WS_SSQ1 = 843 * MiB;
constexpr size_t WS_SSQPP = 845 * MiB;
constexpr size_t WS_X2N = WS_XNB;
constexpr size_t WS_END = 848 * MiB;
static_assert(WS_MIX + 64 * MiB <= WS_BIG2 && (size_t)MAXROWS * 1024 * 2 <= 272 * MiB, "ws map");
constexpr int CW_TMO = 0, CW_CODE = 1;
constexpr int CW_BAR = 4096;
constexpr int CW_CNT = 8192;
constexpr int CW_CHK = 12288;

constexpr int RING_OFF = 0, RING_BYTES = 131072;
constexpr int P0_SCR_WAVE = 64 * 65 * 4;
constexpr int LDSCTL_OFF = 8 * P0_SCR_WAVE;
constexpr int XTAB_OFF = LDSCTL_OFF + 1024;
static_assert(LDSCTL_OFF >= RING_BYTES, "lds map");
constexpr int LDS_BYTES = 163840;

#define RLX_AGENT __ATOMIC_RELAXED, __HIP_MEMORY_SCOPE_AGENT
#define LDS_WAIT() asm volatile("s_waitcnt lgkmcnt(0)" ::: "memory")
#define VM_WAIT() asm volatile("s_waitcnt vmcnt(0)" ::: "memory")
__device__ __forceinline__ unsigned f2bf(float f) { unsigned u = __builtin_bit_cast(unsigned, f); return (u + 0x7fffu + ((u >> 16) & 1u)) >> 16; }
__device__ __forceinline__ unsigned pk2(float lo, float hi) { return f2bf(lo) | (f2bf(hi) << 16); }
__device__ __forceinline__ float bf2f(unsigned short b) { return __builtin_bit_cast(float, ((unsigned)b) << 16); }
__device__ __forceinline__ float bflo(unsigned w) { return __builtin_bit_cast(float, w << 16); }
__device__ __forceinline__ float bfhi(unsigned w) { return __builtin_bit_cast(float, w & 0xffff0000u); }
typedef __bf16 bf16x2_t __attribute__((ext_vector_type(2)));
__device__ __forceinline__ unsigned cvt_pk_bf16(float lo, float hi) { const f32x2 v = {lo, hi}; const bf16x2_t b = __builtin_convertvector(v, bf16x2_t); return __builtin_bit_cast(unsigned, b); }
__device__ __forceinline__ float wave_sum(float v) {
#pragma unroll
    for (int o = 1; o < 64; o <<= 1) v += __shfl_xor(v, o);
    return v;
}
__device__ __forceinline__ f32x2 gelu_pk(f32x2 v) {
    const f32x2 av = __builtin_elementwise_abs(v), d = av * 0.2316418882f + 1.0f;
    f32x2 t; t.x = __builtin_amdgcn_rcpf(d.x); t.y = __builtin_amdgcn_rcpf(d.y);
    f32x2 q = t * 0.5307027145f + (-0.7265760135f); q = q * t + 0.7107068705f; q = q * t + (-0.142248368f); q = q * t + 0.127414796f; q = q * t;
    const f32x2 s = (v * v) * (-0.72134752044f);
    f32x2 e; e.x = __builtin_amdgcn_exp2f(s.x); e.y = __builtin_amdgcn_exp2f(s.y);
    const f32x2 m = v * (q * e), r = v - m;
    f32x2 o; o.x = v.x < 0.f ? m.x : r.x; o.y = v.y < 0.f ? m.y : r.y; return o;
}
__device__ __forceinline__ f32x4 gelu4(f32x4 v) { const f32x2 a = gelu_pk((f32x2){v[0], v[1]}), b = gelu_pk((f32x2){v[2], v[3]}); return (f32x4){a.x, a.y, b.x, b.y}; }
__device__ __forceinline__ float sigmoidf_fast(float x) { return __builtin_amdgcn_rcpf(1.0f + __builtin_amdgcn_exp2f(-1.4426950408889634f * x)); }

#define XB_TMO      128
#define XB_XCNT(j)  (256  + 64 * (j))
#define XB_XSUB(j)  (1280 + 64 * (j))
#define XB_XGEN(j)  (2304 + 64 * (j))
#define XB_TOP      3328
#define XB_TOPGEN   3392
#define XCD_BAR_WORDS 3456
#define XB_SPIN_CAP (1u << 18)
__device__ __forceinline__ unsigned xb_ld(unsigned* p)              { return __hip_atomic_load(p, __ATOMIC_RELAXED, __HIP_MEMORY_SCOPE_AGENT); }
__device__ __forceinline__ unsigned xb_add(unsigned* p, unsigned v) { return __hip_atomic_fetch_add(p, v, __ATOMIC_RELAXED, __HIP_MEMORY_SCOPE_AGENT); }
__device__ __forceinline__ unsigned xb_xcc_id() { return (unsigned)__builtin_amdgcn_s_getreg((3 << 11) | 20) & 0xFu; }
#define XB_SPIN(cond, bar) do { unsigned _sp = 0; while (cond) { __builtin_amdgcn_s_sleep(1); \
    if ((++_sp & 255u) == 0u) { if (xb_ld(&(bar)[XB_TMO])) break; if (_sp > XB_SPIN_CAP) { atomicAdd(&(bar)[XB_TMO], 1u); break; } } } } while (0)
struct XcdBarrier { unsigned* bar; unsigned x; volatile LAS unsigned* st; };
__device__ __forceinline__ XcdBarrier xcd_barrier_post(unsigned* bar, volatile LAS unsigned* st) {
    XcdBarrier b; b.bar = bar; b.x = xb_xcc_id(); b.st = st;
    if (threadIdx.x == 0) (void)xb_add(&bar[XB_XCNT(b.x)], 1u);
    return b;
}
__device__ __forceinline__ void xcd_barrier_complete(unsigned* bar, unsigned x, unsigned& nloc, unsigned& nx) {
    const unsigned G = gridDim.x * gridDim.y * gridDim.z;
    unsigned sum, cnt, mine, sp = 0u;
    for (;;) {
        sum = 0u; cnt = 0u; mine = 0u;
#pragma unroll
        for (unsigned j = 0; j < 16; ++j) { const unsigned c = xb_ld(&bar[XB_XCNT(j)]); sum += c; cnt += (c > 0u) ? 1u : 0u; mine = (j == x) ? c : mine; }
        if (sum == G) break;
        __builtin_amdgcn_s_sleep(1);
        if ((++sp & 255u) == 0u) { if (xb_ld(&bar[XB_TMO])) break; if (sp > XB_SPIN_CAP) { atomicAdd(&bar[XB_TMO], 1u); break; } }
    }
    nloc = mine > 0u ? mine : 1u; nx = cnt > 0u ? cnt : 1u;
}
__device__ __forceinline__ void xcd_barrier(const XcdBarrier& b) {
    asm volatile("s_waitcnt vmcnt(0)" ::: "memory");
    __syncthreads();
    if (threadIdx.x == 0) {
        unsigned* bar = b.bar;
        __builtin_amdgcn_s_waitcnt(0);
        unsigned nloc = b.st[0], nx = b.st[1];
        if (nloc == 0u) { xcd_barrier_complete(bar, b.x, nloc, nx); b.st[0] = nloc; b.st[1] = nx; }
        const unsigned old = xb_add(&bar[XB_XSUB(b.x)], 1u);
        const unsigned gen = old / nloc;
        if (old + 1u == (gen + 1u) * nloc) {
            __builtin_amdgcn_fence(__ATOMIC_RELEASE, "agent");
            asm volatile("s_waitcnt vmcnt(0)" ::: "memory");
            const unsigned og = xb_add(&bar[XB_TOP], 1u);
            const unsigned tg = og / nx;
            if (og + 1u == (tg + 1u) * nx) xb_add(&bar[XB_TOPGEN], 1u);
            else XB_SPIN(xb_ld(&bar[XB_TOPGEN]) == tg, bar);
            __builtin_amdgcn_fence(__ATOMIC_ACQUIRE, "agent");
            xb_add(&bar[XB_XGEN(b.x)], 1u);
            asm volatile("s_waitcnt vmcnt(0)" ::: "memory");
        } else {
            XB_SPIN(xb_ld(&bar[XB_XGEN(b.x)]) == gen, bar);
            __builtin_amdgcn_fence(__ATOMIC_ACQUIRE, "agent");
            asm volatile("s_waitcnt vmcnt(0)" ::: "memory");
        }
    }
    __syncthreads();
}

namespace pg8 {
constexpr int BM = 256, BK = 64, HALF = 128, HTB = HALF * BK * 2, STAGE_BYTES = 8 * HTB, NXCD = 8, WGM = 8;
__host__ __device__ __forceinline__ int lds_byte(int r, int c) { const int st = (r >> 4) * 2 + (c >> 5), rr = r & 15, cc = c & 31, ob = rr * 64 + cc * 2; return st * 1024 + (ob ^ (((ob >> 9) & 1) << 5)); }
__host__ __device__ __forceinline__ void stage_rc(int b, int& R, int& C) { const int st = b / 1024, sb = b % 1024, swz = sb ^ (((sb >> 9) & 1) << 5); R = (st >> 1) * 16 + swz / 64; C = (st & 1) * 32 + (swz % 64) / 2; }
__host__ __device__ __forceinline__ int perm32(int rho) { const int n = rho >> 4, i = rho & 15; return 8 * (i >> 2) + 4 * n + (i & 3); }

struct Unit { int pm, pn, e, rt; };

__device__ __forceinline__ void flat_to_tile(int L, int nwg, int nM, int nN, int& pm, int& pn) {
    int wgid = L; { const int q = nwg / NXCD, r = nwg % NXCD, xcd = wgid % NXCD, off = wgid / NXCD; wgid = (xcd < r ? xcd * (q + 1) : r * (q + 1) + (xcd - r) * q) + off; }
    const int nig = WGM * nN, gid = wgid / nig, fm = gid * WGM, gsz = (nM - fm) < WGM ? (nM - fm) : WGM;
    pm = fm + ((wgid % nig) % gsz); pn = (wgid % nig) / gsz;
}
struct DenseSched {
    const char* A; const char* Bt; int nM, nN, nwg, G, c; size_t tstep;
    __device__ __forceinline__ void init(const void* A_, const void* Bt_, int M, int N, int K, int G_, int c_) { A = (const char*)A_; Bt = (const char*)Bt_; nM = M / BM; nN = N / BM; nwg = nM * nN; G = G_; c = c_; tstep = (size_t)BM * K * 2; }
    __device__ __forceinline__ bool next(int i, Unit& u) const { const long L = (long)i * G + c; if (L >= nwg) return false; flat_to_tile((int)L, nwg, nM, nN, u.pm, u.pn); u.e = 0; u.rt = u.pm; return true; }
    __device__ __forceinline__ const char* a_base(const Unit& u) const { return A + (size_t)u.pm * tstep; }
    __device__ __forceinline__ const char* b_base(const Unit& u) const { return Bt + (size_t)u.pn * tstep; }
    __device__ __forceinline__ void gather(int, int, int, unsigned (&)[2][2]) const {}
};
struct MoeSched {
    const char* A; const char* Bt; size_t a_tstep, b_estep, b_tstep; int nunits; const LAS unsigned* ulist; const LAS unsigned* gtab; bool gath;
    __device__ __forceinline__ bool next(int i, Unit& u) const {
        if (i >= nunits) return false;
        const unsigned w = (unsigned)__builtin_amdgcn_readfirstlane((int)ulist[i]);
        u.pm = (int)(w & 0x3ffu); u.pn = (int)((w >> 10) & 0x7u); u.e = (int)((w >> 13) & 0x1fu); u.rt = (int)(w >> 18); return true;
    }
    __device__ __forceinline__ const char* a_base(const Unit& u) const { return gath ? A : A + (size_t)u.pm * a_tstep; }
    __device__ __forceinline__ const char* b_base(const Unit& u) const { return Bt + (size_t)u.e * b_estep + (size_t)u.pn * b_tstep; }
    __device__ __forceinline__ void gather(int i, int R0, int R1, unsigned (&off)[2][2]) const {
        const LAS unsigned* g = gtab + i * 256;
        off[0][0] = g[R0]; off[0][1] = g[R1]; off[1][0] = g[128 + R0]; off[1][1] = g[128 + R1];
    }
};

#define PG8_SA(b, h) (((b) * 2 + (h)) * HTB)
#define PG8_SB(b, h) ((4 + (b) * 2 + (h)) * HTB)
#define PG8_GLDS(src, dstoff) __builtin_amdgcn_global_load_lds((const unsigned*)(src), (LAS unsigned*)(lds + (dstoff)), 16, 0, 0)
#define PG8_STAGE_B(bufoff, gbase) do { _Pragma("unroll") for (int _i = 0; _i < 2; ++_i) PG8_GLDS((const char*)(gbase) + voffB[_i], (bufoff) + ldsw + _i * 8192); } while (0)
#define PG8_STAGE_A(bufoff, kptr, h, o) do { _Pragma("unroll") for (int _i = 0; _i < 2; ++_i) \
        PG8_GLDS(GATHER ? (const char*)(kptr) + (o)[h][_i] : (const char*)(kptr) + (size_t)(h) * hstep + voffA[_i], (bufoff) + ldsw + _i * 8192); } while (0)
#define PG8_LDA(dst, b, h) do { _Pragma("unroll") for (int m = 0; m < 4; ++m) _Pragma("unroll") for (int k = 0; k < 2; ++k) dst[m][k] = *(const LAS bf16x8*)(lds + PG8_SA(b, h) + aoff + m * 2048 + k * 1024); } while (0)
#define PG8_LDB(dst, b, h) do { _Pragma("unroll") for (int n = 0; n < 2; ++n) _Pragma("unroll") for (int k = 0; k < 2; ++k) dst[n][k] = *(const LAS bf16x8*)(lds + PG8_SB(b, h) + boff + n * 2048 + k * 1024); } while (0)
#define PG8_MMA(ai, bj, At, Bt) do { __builtin_amdgcn_s_setprio(1); _Pragma("unroll") for (int m = 0; m < 4; ++m) _Pragma("unroll") for (int n = 0; n < 2; ++n) _Pragma("unroll") for (int k = 0; k < 2; ++k) \
        acc[ai][bj][m][n] = __builtin_amdgcn_mfma_f32_16x16x32_bf16(Bt[n][k], At[m][k], acc[ai][bj][m][n], 0, 0, 0); __builtin_amdgcn_s_setprio(0); } while (0)
#define PG8_WAIT_V(n) asm volatile("s_waitcnt vmcnt(" #n ")" ::: "memory")
#define PG8_WAIT_L(n) asm volatile("s_waitcnt lgkmcnt(" #n ")" ::: "memory")
#define PG8_BAR __builtin_amdgcn_s_barrier()
#define PG8_SCHED __builtin_amdgcn_sched_barrier(0)

template <class Epi, class Sched, bool GATHER, bool MIDK>
__device__ __forceinline__ void gemm_phase(LAS unsigned char* lds, const int K, const Sched& S, const Epi& E) {
    int tid = (int)threadIdx.x; asm volatile("" : "+v"(tid));
    const int wid = __builtin_amdgcn_readfirstlane(tid >> 6), lane = tid & 63, wr = wid >> 2, wc = wid & 3, fr = lane & 15, fq = lane >> 4;
    const int nt = K / BK;
    unsigned voffA[2], voffB[2]; int Rg[2]; unsigned Cg[2];
#pragma unroll
    for (int i = 0; i < 2; ++i) { int R, C; stage_rc(tid * 16 + i * 8192, R, C); const int Rb = Epi::PERM ? ((R & ~31) + perm32(R & 31)) : R;
        voffA[i] = (unsigned)(R * K + C) * 2u; voffB[i] = (unsigned)(Rb * K + C) * 2u; Rg[i] = R; Cg[i] = (unsigned)C * 2u; }
    const size_t kstep = (size_t)(BK * 2);
    const size_t hstep = (size_t)HALF * K * 2;
    const unsigned ldsw = (unsigned)wid * 1024u;
    const int aoff = lds_byte(wr * 64 + fr, fq * 8), boff = lds_byte(wc * 32 + fr, fq * 8);
    Unit cur, nxt; int ui = 0;
    if (!S.next(0, cur)) return;
    f32x4 acc[2][2][4][2];
#pragma unroll
    for (int a = 0; a < 2; ++a)
#pragma unroll
        for (int b = 0; b < 2; ++b)
#pragma unroll
            for (int m = 0; m < 4; ++m)
#pragma unroll
                for (int n = 0; n < 2; ++n) acc[a][b][m][n] = (f32x4){0.f, 0.f, 0.f, 0.f};
    bf16x8 At[4][2], B0[2][2], B1[2][2];
    unsigned offC[2][2] = {{0u, 0u}, {0u, 0u}}, offN[2][2] = {{0u, 0u}, {0u, 0u}};
    if constexpr (GATHER) { S.gather(0, Rg[0], Rg[1], offC);
#pragma unroll
        for (int h = 0; h < 2; ++h)
#pragma unroll
            for (int i = 0; i < 2; ++i) offC[h][i] += Cg[i]; }
    const char* cA = S.a_base(cur); const char* cB = S.b_base(cur);
    PG8_STAGE_B(PG8_SB(0, 0), cB); PG8_STAGE_B(PG8_SB(0, 1), cB + hstep); PG8_STAGE_A(PG8_SA(0, 0), cA, 0, offC); PG8_STAGE_A(PG8_SA(0, 1), cA, 1, offC);
    if (wr == 1) PG8_BAR;
    PG8_WAIT_V(2); PG8_BAR;
    PG8_STAGE_B(PG8_SB(1, 0), cB + kstep); PG8_STAGE_A(PG8_SA(1, 0), cA + kstep, 0, offC); PG8_STAGE_B(PG8_SB(1, 1), cB + hstep + kstep);
    PG8_WAIT_V(6); PG8_BAR;
    for (;;) {
        const bool has_next = S.next(ui + 1, nxt);
        const char* nA = has_next ? S.a_base(nxt) : cA; const char* nB = has_next ? S.b_base(nxt) : cB;
        if constexpr (GATHER) { if (has_next) { S.gather(ui + 1, Rg[0], Rg[1], offN);
#pragma unroll
                for (int h = 0; h < 2; ++h)
#pragma unroll
                    for (int i = 0; i < 2; ++i) offN[h][i] += Cg[i]; }
            else {
#pragma unroll
                for (int h = 0; h < 2; ++h)
#pragma unroll
                    for (int i = 0; i < 2; ++i) offN[h][i] = offC[h][i]; } }
        for (int t = 0; t < nt; t += 2) {
            const bool last = (t == nt - 2);
            const char* a1 = cA + (size_t)(t + 1) * kstep;
            const char* a2 = last ? nA : cA + (size_t)(t + 2) * kstep; const char* b2 = last ? nB : cB + (size_t)(t + 2) * kstep;
            const char* a3 = a2 + kstep; const char* b3 = b2 + kstep;
            unsigned o2[2][2];
#pragma unroll
            for (int h = 0; h < 2; ++h)
#pragma unroll
                for (int i = 0; i < 2; ++i) o2[h][i] = last ? offN[h][i] : offC[h][i];
            if constexpr (MIDK) { if (t == nt / 2) E.midk(acc, cur, wr, fr); }
            PG8_LDB(B0, 0, 0); PG8_LDB(B1, 0, 1); PG8_SCHED; PG8_LDA(At, 0, 0); PG8_STAGE_A(PG8_SA(1, 1), a1, 1, offC);
            PG8_WAIT_V(8); PG8_WAIT_L(0); PG8_BAR; PG8_MMA(0, 0, At, B0); PG8_MMA(0, 1, At, B1); PG8_BAR; PG8_SCHED;
            PG8_LDA(At, 0, 1); PG8_STAGE_B(PG8_SB(0, 0), b2); PG8_STAGE_B(PG8_SB(0, 1), b2 + hstep); PG8_STAGE_A(PG8_SA(0, 0), a2, 0, o2);
            PG8_WAIT_V(8); PG8_WAIT_L(0); PG8_BAR; PG8_MMA(1, 0, At, B0); PG8_MMA(1, 1, At, B1); PG8_BAR; PG8_SCHED;
            PG8_LDB(B0, 1, 0); PG8_LDB(B1, 1, 1); PG8_SCHED; PG8_LDA(At, 1, 0); PG8_STAGE_A(PG8_SA(0, 1), a2, 1, o2);
            PG8_WAIT_V(8); PG8_WAIT_L(0); PG8_BAR; PG8_MMA(0, 0, At, B0); PG8_MMA(0, 1, At, B1); PG8_BAR; PG8_SCHED;
            PG8_LDA(At, 1, 1); PG8_STAGE_B(PG8_SB(1, 0), b3); PG8_STAGE_B(PG8_SB(1, 1), b3 + hstep); PG8_STAGE_A(PG8_SA(1, 0), a3, 0, o2);
            PG8_WAIT_V(8); PG8_WAIT_L(0); PG8_BAR; PG8_MMA(1, 0, At, B0); PG8_MMA(1, 1, At, B1); PG8_BAR; PG8_SCHED;
        }
        if (wr == 0) PG8_BAR;
        E(acc, cur, wr, wc, fr, fq);
        if (!has_next) break;
#pragma unroll
        for (int a = 0; a < 2; ++a)
#pragma unroll
            for (int b = 0; b < 2; ++b)
#pragma unroll
                for (int m = 0; m < 4; ++m)
#pragma unroll
                    for (int n = 0; n < 2; ++n) acc[a][b][m][n] = (f32x4){0.f, 0.f, 0.f, 0.f};
        cur = nxt; cA = nA; cB = nB; ++ui;
        if constexpr (GATHER) {
#pragma unroll
            for (int h = 0; h < 2; ++h)
#pragma unroll
                for (int i = 0; i < 2; ++i) offC[h][i] = offN[h][i]; }
        if (wr == 1) PG8_BAR;
    }
    PG8_WAIT_V(0);
    PG8_BAR;
}
}

struct Frame {
    LAS unsigned char* lds;
    volatile LAS unsigned* MISC;
    gu32* ctl;
    unsigned char* ws;
    int vcu, G;
    const float *x, *p, *mix_norm, *w_in, *ln_g, *ln_b, *gws, *gbs, *aon, *gon, *w_out, *ffn_norm, *router_w, *router_b, *w_gu, *b_gu, *w_dn, *b_dn, *ple_norm, *w_pg, *w_pp, *ppn, *final_norm;
    float* out;
};
template <class T_> __device__ __forceinline__ T_* wsp(const Frame& F, size_t off) { return (T_*)(F.ws + off); }

#define PHASE_IDS int TID_ = (int)threadIdx.x; asm volatile("" : "+v"(TID_)); const int LANE_ = TID_ & 63; const int WAVE_ = __builtin_amdgcn_readfirstlane(TID_ >> 6); (void)LANE_; (void)WAVE_
template <class ColMap>
__device__ __forceinline__ void p0_transpose_item(const float* W, int K, int N, bf16* WT, const float* gain, LAS float* scr, int item, int lane, int nphys, const ColMap& cm) {
    const int nblk = nphys / 64, kb = item / nblk, nb = item % nblk, k0 = 64 * kb, n0 = 64 * nb;
    const int srccol = cm(n0 + lane);
#pragma unroll 8
    for (int kk = 0; kk < 64; ++kk) { float v = W[(size_t)(k0 + kk) * N + srccol]; if (gain) v *= gain[k0 + kk]; scr[kk * 65 + lane] = v; }
    LDS_WAIT(); asm volatile("" ::: "memory");
    const int c = lane & 7;
#pragma unroll
    for (int j = 0; j < 8; ++j) { const int n = (lane >> 3) + 8 * j; const LAS float* s = scr + (8 * c) * 65 + n;
        v4u o; o.x = pk2(s[0 * 65], s[1 * 65]); o.y = pk2(s[2 * 65], s[3 * 65]); o.z = pk2(s[4 * 65], s[5 * 65]); o.w = pk2(s[6 * 65], s[7 * 65]);
        *(GAS v4u*)(WT + (size_t)(n0 + n) * K + k0 + 8 * c) = o; }
    LDS_WAIT(); asm volatile("" ::: "memory");
}
struct CmId { __device__ __forceinline__ int operator()(int n) const { return n; } };
struct CmWin { __device__ __forceinline__ int operator()(int n) const { if (n >= 2 * AW) return n; const int c = n & 63; return (n & ~63) + 4 * (c >> 3) + (c & 3) + 32 * ((c >> 2) & 1); } };
struct CmWgu { __device__ __forceinline__ int operator()(int n) const { return ((n >> 7) & 1) * FF + (n >> 8) * 128 + (n & 127); } };

__device__ __forceinline__ void p0_prologue(Frame& F) {
    PHASE_IDS;
    LAS float* scr = (LAS float*)(F.lds + RING_OFF + WAVE_ * P0_SCR_WAVE);
    const int gw = F.vcu * NWAVES + WAVE_, NGW = F.G * NWAVES;
    constexpr int I_GU = (DM / 64) * (2 * FF / 64), I_DN = (FF / 64) * (DM / 64), I_IN = (DM / 64) * (NPROJ / 64), I_SQ = (DM / 64) * (DM / 64), I_PP = (PLE / 64) * (DM / 64);
    constexpr int NITEMS = NE * I_GU + NE * I_DN + I_IN + 2 * I_SQ + I_PP;
    bf16* WGU = wsp<bf16>(F, WS_WGU); bf16* WDN = wsp<bf16>(F, WS_WDN);
    for (int it = gw; it < NITEMS; it += NGW) {
        int r = it;
        if (r < NE * I_GU) { const int e = r / I_GU; p0_transpose_item(F.w_gu + (size_t)e * DM * 2 * FF, DM, 2 * FF, WGU + (size_t)e * 2 * FF * DM, F.ffn_norm, scr, r % I_GU, LANE_, 2 * FF, CmWgu()); continue; } r -= NE * I_GU;
        if (r < NE * I_DN) { const int e = r / I_DN; p0_transpose_item(F.w_dn + (size_t)e * FF * DM, FF, DM, WDN + (size_t)e * DM * FF, nullptr, scr, r % I_DN, LANE_, DM, CmId()); continue; } r -= NE * I_DN;
        if (r < I_IN) { p0_transpose_item(F.w_in, DM, NPROJ, wsp<bf16>(F, WS_WIN), F.mix_norm, scr, r, LANE_, NPROJ, CmWin()); continue; } r -= I_IN;
        if (r < I_SQ) {
            const int nblk = DM / 64, kb = r / nblk; const float* g = (kb < 8) ? F.aon : (F.gon - AW);
            p0_transpose_item(F.w_out, DM, DM, wsp<bf16>(F, WS_WOUT), g, scr, r, LANE_, DM, CmId()); continue; } r -= I_SQ;
        if (r < I_SQ) { p0_transpose_item(F.w_pg, DM, DM, wsp<bf16>(F, WS_WPG), F.ple_norm, scr, r, LANE_, DM, CmId()); continue; } r -= I_SQ;
        p0_transpose_item(F.w_pp, PLE, DM, wsp<bf16>(F, WS_WPP), nullptr, scr, r, LANE_, DM, CmId());
    }
    bf16* XN = wsp<bf16>(F, WS_XNB);
    for (int m = gw; m < T; m += NGW) {
        const GAS f32x4* xr = (const GAS f32x4*)(F.x + (size_t)m * DM) + LANE_;
        f32x4 v[4]; float s = 0.f;
#pragma unroll
        for (int j = 0; j < 4; ++j) { v[j] = xr[64 * j]; s += (v[j].x * v[j].x + v[j].y * v[j].y) + (v[j].z * v[j].z + v[j].w * v[j].w); }
        const float rstd = 1.0f / sqrtf(wave_sum(s) * (1.f / DM) + EPS);
        GAS v2u* o8 = (GAS v2u*)(XN + (size_t)m * DM) + LANE_;
#pragma unroll
        for (int j = 0; j < 4; ++j) { v2u w; w.x = pk2(v[j].x * rstd, v[j].y * rstd); w.y = pk2(v[j].z * rstd, v[j].w * rstd); o8[64 * j] = w; }
    }
    { const GAS f32x4* pr = (const GAS f32x4*)F.p; GAS v2u* po = (GAS v2u*)wsp<bf16>(F, WS_PB);
      const size_t n4 = (size_t)T * PLE / 4, gt = (size_t)(F.vcu * NTHR + TID_), GT = (size_t)F.G * NTHR;
      for (size_t i = gt; i < n4; i += GT) { const f32x4 v = pr[i]; v2u w; w.x = pk2(v.x, v.y); w.y = pk2(v.z, v.w); po[i] = w; } }
    { const int gt = F.vcu * NTHR + TID_, GT = F.G * NTHR; float* RWG = wsp<float>(F, WS_RWG);
      for (int i = gt; i < DM * NE; i += GT) RWG[i] = F.router_w[i] * F.ffn_norm[i / NE];
      float* RC = wsp<float>(F, WS_ROPE); float* RS = RC + SEQ * 32;
      for (int i = gt; i < SEQ * 32; i += GT) { const int pos = i >> 5, j = i & 31; const float inv = powf(10000.0f, -(float)j / 32.0f); const float ang = (float)pos * inv; float sn, cs; sincosf(ang, &sn, &cs); RC[i] = cs; RS[i] = sn; } }
}

using pg8::Unit;
constexpr int HALF = 128;
struct EpiInProj {
    static constexpr bool PERM = true;
    bf16* QKVUV; const float *rc, *rs; float* kmean;
    __device__ __forceinline__ void operator()(const f32x4 (&acc)[2][2][4][2], const Unit& u, int wr, int wc, int fr, int fq) const {
        const int type = u.pn >> 1, colt = (u.pn & 1) * 256 + wc * 32 + 8 * fq;
        const int row0 = u.pm * 256 + wr * 64 + fr;
        if (type <= 1) {
            bf16* dst = QKVUV + (size_t)type * (16u << 20);
            const int pos0 = (u.pm & 7) * 256 + wr * 64 + fr, i0 = 16 * (wc & 1) + 4 * fq;
            f32x4 cs_[2][2];
#pragma unroll
            for (int bj = 0; bj < 2; ++bj) { cs_[bj][0] = (f32x4){0.f, 0.f, 0.f, 0.f}; cs_[bj][1] = (f32x4){0.f, 0.f, 0.f, 0.f}; }
#pragma unroll
            for (int ai = 0; ai < 2; ++ai)
#pragma unroll
                for (int m = 0; m < 4; ++m) { const int ro = ai * HALF + m * 16; const int pos = pos0 + ro;
                    const f32x4 c = *(const f32x4*)(rc + pos * 32 + i0), s = *(const f32x4*)(rs + pos * 32 + i0);
                    bf16* rowp = dst + (size_t)(row0 + ro) * AW + colt;
#pragma unroll
                    for (int bj = 0; bj < 2; ++bj) { const f32x4 x1 = acc[ai][bj][m][0], x2 = acc[ai][bj][m][1];
                        const f32x4 o1 = x1 * c - x2 * s, o2 = x2 * c + x1 * s;
                        cs_[bj][0] += o1; cs_[bj][1] += o2;
                        v4u w; w.x = cvt_pk_bf16(o1[0], o1[1]); w.y = cvt_pk_bf16(o1[2], o1[3]); w.z = cvt_pk_bf16(o2[0], o2[1]); w.w = cvt_pk_bf16(o2[2], o2[3]);
                        *(v4u*)(rowp + bj * HALF) = w; } }
            if (type == 1) {
#pragma unroll
                for (int bj = 0; bj < 2; ++bj)
#pragma unroll
                    for (int n = 0; n < 2; ++n)
#pragma unroll
                        for (int j = 0; j < 4; ++j) { float v = cs_[bj][n][j]; v += __shfl_xor(v, 1); v += __shfl_xor(v, 2); v += __shfl_xor(v, 4); v += __shfl_xor(v, 8); cs_[bj][n][j] = v; }
                if (fr == 0) { const int b = u.pm >> 3, blk = u.pm & 7;
#pragma unroll
                    for (int bj = 0; bj < 2; ++bj) { const int colh = (u.pn & 1) * 256 + bj * HALF + wc * 32; const int head = colh >> 6, cpos = (colh & 63) + 8 * fq;
                        float* km = kmean + ((size_t)((b * NH + head) * NBLK + blk)) * HD + cpos;
#pragma unroll
                        for (int n = 0; n < 2; ++n)
#pragma unroll
                            for (int j = 0; j < 4; ++j) atomicAdd(km + 4 * n + j, cs_[bj][n][j]); } }
            }
        } else {
            bf16* dst = QKVUV + (size_t)type * (16u << 20);
#pragma unroll
            for (int ai = 0; ai < 2; ++ai)
#pragma unroll
                for (int m = 0; m < 4; ++m) { bf16* rowp = dst + (size_t)(row0 + ai * HALF + m * 16) * AW + colt;
#pragma unroll
                    for (int bj = 0; bj < 2; ++bj) { f32x4 v0 = acc[ai][bj][m][0], v1 = acc[ai][bj][m][1];
                        if (type >= 3) { v0 = gelu4(v0); v1 = gelu4(v1); }
                        v4u w; w.x = cvt_pk_bf16(v0[0], v0[1]); w.y = cvt_pk_bf16(v0[2], v0[3]); w.z = cvt_pk_bf16(v1[0], v1[1]); w.w = cvt_pk_bf16(v1[2], v1[3]);
                        *(v4u*)(rowp + bj * HALF) = w; } }
        }
    }
};
struct EpiOutProj {
    static constexpr bool PERM = false;
    const float* x; float* x1; float* ssq1; const LAS f32x2* rtab;
    const LAS int* slot_of;
    int pm_a, pm_b;
    __device__ __forceinline__ int slot(const Unit& u) const { return u.pm == pm_a ? 0 : 1; }
    __device__ __forceinline__ void midk(f32x4 (&acc)[2][2][4][2], const Unit& u, int wr, int fr) const {
        const LAS f32x2* t = rtab + slot(u) * 256 + wr * 64 + fr;
#pragma unroll
        for (int ai = 0; ai < 2; ++ai)
#pragma unroll
            for (int m = 0; m < 4; ++m) { const float r = t[ai * HALF + m * 16].x;
#pragma unroll
                for (int bj = 0; bj < 2; ++bj)
#pragma unroll
                    for (int n = 0; n < 2; ++n) acc[ai][bj][m][n] *= r; }
    }
    __device__ __forceinline__ void operator()(const f32x4 (&acc)[2][2][4][2], const Unit& u, int wr, int wc, int fr, int fq) const {
        const LAS f32x2* t = rtab + slot(u) * 256 + wr * 64 + fr;
        const int row0 = u.pm * 256 + wr * 64 + fr, col0 = u.pn * 256 + wc * 32 + 4 * fq;
#pragma unroll
        for (int ai = 0; ai < 2; ++ai)
#pragma unroll
            for (int m = 0; m < 4; ++m) { const int ro = ai * HALF + m * 16; const float rg = t[ro].y; const size_t off = (size_t)(row0 + ro) * DM + col0; float q = 0.f;
#pragma unroll
                for (int bj = 0; bj < 2; ++bj)
#pragma unroll
                    for (int n = 0; n < 2; ++n) { const f32x4 bs = *(const f32x4*)(x + off + bj * HALF + n * 16); const f32x4 o = bs + acc[ai][bj][m][n] * rg;
                        q += (o[0] * o[0] + o[1] * o[1]) + (o[2] * o[2] + o[3] * o[3]); *(f32x4*)(x1 + off + bj * HALF + n * 16) = o; }
                q += __shfl_xor(q, 16); q += __shfl_xor(q, 32);
                if (fq == 0) ssq1[(size_t)(row0 + ro) * 16 + u.pn * 4 + wc] = q; }
    }
};
struct EpiMoe1 {
    static constexpr bool PERM = true;
    bf16* A; const float* b_gu;
    __device__ __forceinline__ void operator()(const f32x4 (&acc)[2][2][4][2], const Unit& u, int wr, int wc, int fr, int fq) const {
        const int row0 = u.pm * 256 + wr * 64 + fr, col = u.pn * 128 + wc * 32 + 8 * fq;
        const float* bg = b_gu + (size_t)u.e * 2 * FF + col;
        f32x4 bgv[2], blv[2];
#pragma unroll
        for (int n = 0; n < 2; ++n) { bgv[n] = *(const f32x4*)(bg + 4 * n); blv[n] = *(const f32x4*)(bg + FF + 4 * n); }
#pragma unroll
        for (int ai = 0; ai < 2; ++ai)
#pragma unroll
            for (int m = 0; m < 4; ++m) { f32x4 a[2];
#pragma unroll
                for (int n = 0; n < 2; ++n) { const f32x4 g = acc[ai][0][m][n] + bgv[n], l = acc[ai][1][m][n] + blv[n];
#pragma unroll
                    for (int j = 0; j < 4; ++j) { const float gc = fminf(g[j], 7.0f), lc = fminf(fmaxf(l[j], -7.0f), 7.0f); a[n][j] = gc * sigmoidf_fast(1.702f * gc) * (lc + 1.0f); } }
                v4u w; w.x = cvt_pk_bf16(a[0][0], a[0][1]); w.y = cvt_pk_bf16(a[0][2], a[0][3]); w.z = cvt_pk_bf16(a[1][0], a[1][1]); w.w = cvt_pk_bf16(a[1][2], a[1][3]);
                *(v4u*)(A + (size_t)(row0 + ai * HALF + m * 16) * FF + col) = w; }
    }
};
struct EpiMoe2 {
    static constexpr bool PERM = true;
    bf16* Y; const float* b_dn; const float* gss;
    __device__ __forceinline__ void operator()(const f32x4 (&acc)[2][2][4][2], const Unit& u, int wr, int wc, int fr, int fq) const {
        const int row0 = u.pm * 256 + wr * 64 + fr, col0 = u.pn * 256 + wc * 32 + 8 * fq;
        const float* gs = gss + (size_t)u.e * T + u.rt * 256 + wr * 64 + fr;
        f32x4 bv[2][2];
#pragma unroll
        for (int bj = 0; bj < 2; ++bj)
#pragma unroll
            for (int n = 0; n < 2; ++n) bv[bj][n] = *(const f32x4*)(b_dn + (size_t)u.e * DM + col0 + bj * HALF + 4 * n);
#pragma unroll
        for (int ai = 0; ai < 2; ++ai)
#pragma unroll
            for (int m = 0; m < 4; ++m) { const float g = gs[ai * HALF + m * 16]; bf16* rowp = Y + (size_t)(row0 + ai * HALF + m * 16) * DM + col0;
#pragma unroll
                for (int bj = 0; bj < 2; ++bj) { const f32x4 v0 = (acc[ai][bj][m][0] + bv[bj][0]) * g, v1 = (acc[ai][bj][m][1] + bv[bj][1]) * g;
                    v4u w; w.x = cvt_pk_bf16(v0[0], v0[1]); w.y = cvt_pk_bf16(v0[2], v0[3]); w.z = cvt_pk_bf16(v1[0], v1[1]); w.w = cvt_pk_bf16(v1[2], v1[3]);
                    *(v4u*)(rowp + bj * HALF) = w; } }
    }
};
template <int MODE> struct EpiPle {
    static constexpr bool PERM = true;
    bf16* O; float* ssq;
    __device__ __forceinline__ void operator()(const f32x4 (&acc)[2][2][4][2], const Unit& u, int wr, int wc, int fr, int fq) const {
        const int row0 = u.pm * 256 + wr * 64 + fr, col0 = u.pn * 256 + wc * 32 + 8 * fq;
#pragma unroll
        for (int ai = 0; ai < 2; ++ai)
#pragma unroll
            for (int m = 0; m < 4; ++m) { bf16* rowp = O + (size_t)(row0 + ai * HALF + m * 16) * DM + col0; float q = 0.f;
#pragma unroll
                for (int bj = 0; bj < 2; ++bj) { f32x4 v0 = acc[ai][bj][m][0], v1 = acc[ai][bj][m][1];
                    if (MODE == 0) {
#pragma unroll
                        for (int j = 0; j < 4; ++j) { v0[j] = sigmoidf_fast(v0[j]); v1[j] = sigmoidf_fast(v1[j]); } }
                    else { q += (v0[0] * v0[0] + v0[1] * v0[1]) + (v0[2] * v0[2] + v0[3] * v0[3]) + (v1[0] * v1[0] + v1[1] * v1[1]) + (v1[2] * v1[2] + v1[3] * v1[3]); }
                    v4u w; w.x = cvt_pk_bf16(v0[0], v0[1]); w.y = cvt_pk_bf16(v0[2], v0[3]); w.z = cvt_pk_bf16(v1[0], v1[1]); w.w = cvt_pk_bf16(v1[2], v1[3]);
                    *(v4u*)(rowp + bj * HALF) = w; }
                if (MODE == 1) { q += __shfl_xor(q, 16); q += __shfl_xor(q, 32); if (fq == 0) ssq[(size_t)(row0 + ai * HALF + m * 16) * 16 + u.pn * 4 + wc] = q; } }
    }
};

namespace att {
constexpr int QBLK = 32, KVBLK = 64;
constexpr float SCALE = 0.125f, THR = 8.f;
constexpr int SHM_V = KVBLK * HD * 2, SHM_K = SHM_V;
constexpr int LDS_BYTES_ = 2 * SHM_V + 2 * SHM_K + NWAVES * 64 * 4;
#define ATT_KSWZ(row, colB) ((row) * 128 + ((colB) ^ (((row) & 7) << 4)))
#define ATT_SBAR() __builtin_amdgcn_sched_barrier(0)
__device__ __forceinline__ int crow(int r, int hi) { return (r & 3) + 8 * (r >> 2) + 4 * hi; }
__device__ __forceinline__ void cmask(f32x16& p0, f32x16& p1, int jb, int qrel, int hi) {
    const float NEG = -__builtin_inff(); const int kb = 64 * jb + 4 * hi;
#pragma unroll
    for (int r = 0; r < 16; ++r) { const int kv = kb + (r & 3) + 8 * (r >> 2); if (kv > qrel) p0[r] = NEG; if (kv + 32 > qrel) p1[r] = NEG; }
}
__device__ __forceinline__ void bmask(f32x16& p0, f32x16& p1, bool keep) {
    const float NEG = -__builtin_inff();
    if (!keep) {
#pragma unroll
        for (int r = 0; r < 16; ++r) { p0[r] = NEG; p1[r] = NEG; } }
}
__device__ __forceinline__ void partialSM(f32x16& p0, f32x16& p1, float& m_reg, float& mn, float& alpha, bool keep) {
    float pmax = p0[0];
#pragma unroll
    for (int r = 1; r < 16; ++r) pmax = fmaxf(pmax, p0[r]);
#pragma unroll
    for (int r = 0; r < 16; ++r) pmax = fmaxf(pmax, p1[r]);
    { auto rr = __builtin_amdgcn_permlane32_swap(__float_as_uint(pmax), __float_as_uint(pmax), false, false);
      pmax = fmaxf(__uint_as_float(rr[0]), __uint_as_float(rr[1])); }
    if (!keep) pmax = -__builtin_inff();
    constexpr float C2 = 1.4426950408889634f * SCALE;
    if (__builtin_expect(__all((pmax - m_reg) * SCALE <= THR), 1)) { mn = m_reg; alpha = 1.f; }
    else { mn = fmaxf(m_reg, pmax); alpha = __builtin_amdgcn_exp2f((m_reg - mn) * C2); m_reg = mn; }
    const float mnL = keep ? -mn * C2 : -__builtin_inff(), c2 = keep ? C2 : 0.f;
#pragma unroll
    for (int r = 0; r < 16; ++r) p0[r] = fmaf(p0[r], c2, mnL);
#pragma unroll
    for (int r = 0; r < 16; ++r) p1[r] = fmaf(p1[r], c2, mnL);
#pragma unroll
    for (int r = 0; r < 16; ++r) p0[r] = __builtin_amdgcn_exp2f(p0[r]);
}
__device__ __forceinline__ void finishSM(f32x16& p0, f32x16& p1, float alpha, float& l_reg, bf16x8& pa0, bf16x8& pa1, bf16x8& pa2, bf16x8& pa3) {
#pragma unroll
    for (int r = 0; r < 16; ++r) p1[r] = __builtin_amdgcn_exp2f(p1[r]);
    float ps = 0;
#pragma unroll
    for (int r = 0; r < 16; ++r) ps += p0[r];
#pragma unroll
    for (int r = 0; r < 16; ++r) ps += p1[r];
    { auto rr = __builtin_amdgcn_permlane32_swap(__float_as_uint(ps), __float_as_uint(ps), false, false);
      ps = __uint_as_float(rr[0]) + __uint_as_float(rr[1]); }
    l_reg = l_reg * alpha + ps;
#define ATT_PK4(P, B, OUT) do { unsigned a0 = cvt_pk_bf16(P[B+0], P[B+1]), a1 = cvt_pk_bf16(P[B+2], P[B+3]);             \
        unsigned b0 = cvt_pk_bf16(P[B+4], P[B+5]), b1 = cvt_pk_bf16(P[B+6], P[B+7]);                                       \
        auto r0 = __builtin_amdgcn_permlane32_swap(a0, b0, false, false); auto r1 = __builtin_amdgcn_permlane32_swap(a1, b1, false, false); \
        v4u w = {r0[0], r1[0], r0[1], r1[1]}; OUT = *reinterpret_cast<bf16x8*>(&w); } while (0)
    ATT_PK4(p0, 0, pa0); ATT_PK4(p0, 8, pa1); ATT_PK4(p1, 0, pa2); ATT_PK4(p1, 8, pa3);
#undef ATT_PK4
}
__device__ __forceinline__ void qkt(f32x16& p0, f32x16& p1, const LAS unsigned char* Ks, const bf16x8* qr, int r32, int hi) {
    p0 = f32x16{}; p1 = f32x16{};
#pragma unroll
    for (int d0 = 0; d0 < 4; ++d0) { const int cb = (d0 * 16 + hi * 8) * 2;
        const bf16x8 b0 = *(const LAS bf16x8*)(Ks + ATT_KSWZ(r32, cb));
        const bf16x8 b1 = *(const LAS bf16x8*)(Ks + ATT_KSWZ(32 + r32, cb));
        p0 = __builtin_amdgcn_mfma_f32_32x32x16_bf16(b0, qr[d0], p0, 0, 0, 0);
        p1 = __builtin_amdgcn_mfma_f32_32x32x16_bf16(b1, qr[d0], p1, 0, 0, 0); }
}
__device__ __forceinline__ void pv(f32x16* o, int vb, bf16x8 pa0, bf16x8 pa1, bf16x8 pa2, bf16x8 pa3) {
#pragma unroll
    for (int d0 = 0; d0 < 2; ++d0) { s16x4 lo[4], hi[4];
#pragma unroll
        for (int ks = 0; ks < 4; ++ks) { const int a = vb + d0 * 2048 + (ks >> 1) * 4096 + (ks & 1) * 512;
            asm volatile("ds_read_b64_tr_b16 %0,%1" : "=&v"(lo[ks]) : "v"(a) : "memory");
            asm volatile("ds_read_b64_tr_b16 %0,%1 offset:128" : "=&v"(hi[ks]) : "v"(a) : "memory"); }
        asm volatile("s_waitcnt lgkmcnt(0)" ::: "memory"); ATT_SBAR();
#define ATT_PK(k) (bf16x8){lo[k][0], lo[k][1], lo[k][2], lo[k][3], hi[k][0], hi[k][1], hi[k][2], hi[k][3]}
        o[d0] = __builtin_amdgcn_mfma_f32_32x32x16_bf16(pa0, ATT_PK(0), o[d0], 0, 0, 0);
        o[d0] = __builtin_amdgcn_mfma_f32_32x32x16_bf16(pa1, ATT_PK(1), o[d0], 0, 0, 0);
        o[d0] = __builtin_amdgcn_mfma_f32_32x32x16_bf16(pa2, ATT_PK(2), o[d0], 0, 0, 0);
        o[d0] = __builtin_amdgcn_mfma_f32_32x32x16_bf16(pa3, ATT_PK(3), o[d0], 0, 0, 0);
#undef ATT_PK
    }
}
__device__ __forceinline__ void attn_unit(const Frame& F, int b, int h, int qb, LAS unsigned char* scratch) {
    PHASE_IDS;
    const int tid = TID_, wid = tid >> 6, lane = tid & 63, r32 = lane & 31, hi = lane >> 5;
    const bf16* Qg = wsp<bf16>(F, WS_Q); const bf16* Kg = wsp<bf16>(F, WS_K); const bf16* Vg = wsp<bf16>(F, WS_V);
    const size_t rowbase = (size_t)b * SEQ; const int q0 = qb * MOBA;
    const bf16* Qw = Qg + (rowbase + q0 + wid * QBLK) * AW + h * HD;
    const bf16* Kh = Kg + rowbase * AW + h * HD; const bf16* Vh = Vg + rowbase * AW + h * HD;
    LAS unsigned char* V_lds = scratch; LAS unsigned char* K_lds = scratch + 2 * SHM_V;
    LAS float* wsf = (LAS float*)(scratch + 2 * SHM_V + 2 * SHM_K) + wid * 64; LAS float* li_l = wsf; LAS float* al_l = wsf + 32;
    float m_reg = -1e30f, l_reg = 0.f; f32x16 o[2]; o[0] = f32x16{}; o[1] = f32x16{}; bf16x8 qr[4];
#pragma unroll
    for (int d0 = 0; d0 < 4; ++d0) qr[d0] = *(const bf16x8*)(Qw + (size_t)r32 * AW + d0 * 16 + hi * 8);
    unsigned sel = 0u;
    if (qb <= 3) sel = (1u << qb) - 1u;
    else {
        const float* km = wsp<float>(F, WS_KMEAN) + (size_t)((b * NH + h) * NBLK) * HD + hi * 8;
        float b0 = -__builtin_inff(), b1 = b0, b2 = b0; int i0 = 0, i1 = 0, i2 = 0;
#pragma unroll 1
        for (int j = 0; j < qb; ++j) { float s = 0.f;
#pragma unroll
            for (int d0 = 0; d0 < 4; ++d0) { const f32x4 k0 = *(const f32x4*)(km + j * HD + d0 * 16), k1 = *(const f32x4*)(km + j * HD + d0 * 16 + 4);
                const v4u qw = *reinterpret_cast<const v4u*>(&qr[d0]);
                s += bflo(qw.x) * k0[0] + bfhi(qw.x) * k0[1] + bflo(qw.y) * k0[2] + bfhi(qw.y) * k0[3] + bflo(qw.z) * k1[0] + bfhi(qw.z) * k1[1] + bflo(qw.w) * k1[2] + bfhi(qw.w) * k1[3]; }
            s += __shfl_xor(s, 32);
            if (s > b0) { b2 = b1; i2 = i1; b1 = b0; i1 = i0; b0 = s; i0 = j; } else if (s > b1) { b2 = b1; i2 = i1; b1 = s; i1 = j; } else if (s > b2) { b2 = s; i2 = j; } }
        sel = (1u << i0) | (1u << i1) | (1u << i2);
    }
    const int sr = tid >> 3, sc = (tid & 7) * 8;
    const int vst = 2 * ((sr >> 5) * 2048 + (sc >> 4) * 512 + (sr & 31) * 16 + (sc & 8));
    const int vb0 = (int)(size_t)V_lds + (lane & 15) * 8 + ((lane >> 4) & 1) * 1024 + (lane >> 5) * 256;
    bf16x8 st_v, st_k;
#define ATT_SLOAD(k0) do { const size_t rr_ = (size_t)((k0) + sr) * AW + sc; st_v = *(const bf16x8*)(Vh + rr_); st_k = *(const bf16x8*)(Kh + rr_); } while (0)
#define ATT_SWRITE(bf) do { *(LAS bf16x8*)(V_lds + (bf) * SHM_V + vst) = st_v; *(LAS bf16x8*)(K_lds + (bf) * SHM_K + ATT_KSWZ(sr, sc * 2)) = st_k; } while (0)
#define ATT_RESC(a) do { if (__any((a) < 1.f)) { if (hi == 0) al_l[r32] = (a); asm volatile("s_waitcnt lgkmcnt(0)" ::: "memory");      \
        _Pragma("unroll") for (int d_ = 0; d_ < 2; ++d_) _Pragma("unroll") for (int r = 0; r < 16; ++r) o[d_][r] *= al_l[crow(r, hi)]; } } while (0)
    const int NT = (q0 + MOBA) / KVBLK;
    const int qrel = wid * QBLK + r32;
#define ATT_MASK(P0, P1, t) do { const int jb_ = (t) - (NT - 4); if (jb_ >= 0) cmask(P0, P1, jb_, qrel, hi); } while (0)
#define ATT_KEEP(t) ((((t) >= NT - 4) ? 1u : ((sel >> ((t) >> 2)) & 1u)) != 0u)
    f32x16 pA0, pA1, pB0, pB1; float mnA, mnB, alA, alB; bf16x8 pa0, pa1, pa2, pa3;
    ATT_SLOAD(0); ATT_SWRITE(0); __syncthreads();
    qkt(pA0, pA1, K_lds, qr, r32, hi); ATT_MASK(pA0, pA1, 0); partialSM(pA0, pA1, m_reg, mnA, alA, ATT_KEEP(0));
    ATT_SLOAD(KVBLK); ATT_SWRITE(1); __syncthreads();
    for (int j = 1; j + 1 < NT; j += 2) {
        ATT_SBAR(); qkt(pB0, pB1, K_lds + SHM_K, qr, r32, hi); ATT_MASK(pB0, pB1, j);
        finishSM(pA0, pA1, alA, l_reg, pa0, pa1, pa2, pa3); ATT_SBAR();
        ATT_SLOAD((j + 1) * KVBLK); ATT_SBAR();
        pv(o, vb0, pa0, pa1, pa2, pa3); partialSM(pB0, pB1, m_reg, mnB, alB, ATT_KEEP(j));
        __syncthreads(); asm volatile("s_waitcnt vmcnt(0)" ::: "memory"); ATT_SWRITE(0);
        ATT_RESC(alB); __syncthreads();
        ATT_SBAR(); qkt(pA0, pA1, K_lds, qr, r32, hi); ATT_MASK(pA0, pA1, j + 1);
        finishSM(pB0, pB1, alB, l_reg, pa0, pa1, pa2, pa3); ATT_SBAR();
        if (j + 2 < NT) { ATT_SLOAD((j + 2) * KVBLK); ATT_SBAR(); }
        pv(o, vb0 + SHM_V, pa0, pa1, pa2, pa3); partialSM(pA0, pA1, m_reg, mnA, alA, ATT_KEEP(j + 1));
        __syncthreads(); if (j + 2 < NT) { asm volatile("s_waitcnt vmcnt(0)" ::: "memory"); ATT_SWRITE(1); }
        ATT_RESC(alA); __syncthreads();
    }
    ATT_SBAR(); qkt(pB0, pB1, K_lds + SHM_K, qr, r32, hi); ATT_MASK(pB0, pB1, NT - 1);
    finishSM(pA0, pA1, alA, l_reg, pa0, pa1, pa2, pa3); ATT_SBAR();
    pv(o, vb0, pa0, pa1, pa2, pa3); partialSM(pB0, pB1, m_reg, mnB, alB, true);
    __syncthreads(); ATT_RESC(alB);
    finishSM(pB0, pB1, alB, l_reg, pa0, pa1, pa2, pa3); ATT_SBAR();
    pv(o, vb0 + SHM_V, pa0, pa1, pa2, pa3);
    if (hi == 0) li_l[r32] = l_reg; asm volatile("s_waitcnt lgkmcnt(0)" ::: "memory");
    float rli[16];
#pragma unroll
    for (int r = 0; r < 16; ++r) rli[r] = __builtin_amdgcn_rcpf(li_l[crow(r, hi)]);
    bf16* Ow = wsp<bf16>(F, WS_MIX) + (rowbase + q0 + wid * QBLK) * DM + h * HD;
    float* ssqa = wsp<float>(F, WS_SSQA) + (rowbase + q0 + wid * QBLK) * NH + h;
    float qq[16];
#pragma unroll
    for (int r = 0; r < 16; ++r) { const int orow = crow(r, hi); float q2 = 0.f;
#pragma unroll
        for (int d0 = 0; d0 < 2; ++d0) { const float v = o[d0][r] * rli[r]; const float vn = __shfl_xor(v, 1); q2 += v * v;
            if ((r32 & 1) == 0) *(unsigned*)(Ow + (size_t)orow * DM + d0 * 32 + r32) = cvt_pk_bf16(v, vn); }
        qq[r] = q2; }
#pragma unroll
    for (int i = 0; i < 8; ++i) { const bool up = (lane & 16) != 0; const float send = up ? qq[i] : qq[i + 8], keep = up ? qq[i + 8] : qq[i]; qq[i] = keep + __shfl_xor(send, 16); }
#pragma unroll
    for (int i = 0; i < 4; ++i) { const bool up = (lane & 8) != 0; const float send = up ? qq[i] : qq[i + 4], keep = up ? qq[i + 4] : qq[i]; qq[i] = keep + __shfl_xor(send, 8); }
#pragma unroll
    for (int i = 0; i < 2; ++i) { const bool up = (lane & 4) != 0; const float send = up ? qq[i] : qq[i + 2], keep = up ? qq[i + 2] : qq[i]; qq[i] = keep + __shfl_xor(send, 4); }
    { const bool up = (lane & 2) != 0; const float send = up ? qq[0] : qq[1], keep = up ? qq[1] : qq[0]; qq[0] = keep + __shfl_xor(send, 2); }
    qq[0] += __shfl_xor(qq[0], 1);
    if ((lane & 1) == 0) ssqa[(size_t)crow(r32 >> 1, hi) * NH] = qq[0];
    __syncthreads();
#undef ATT_SLOAD
#undef ATT_SWRITE
#undef ATT_RESC
#undef ATT_MASK
#undef ATT_KEEP
}
}

namespace gm {
constexpr int PITCH = 136;
__device__ __forceinline__ void unit(const Frame& F, int b, int c, int g, LAS unsigned char* scratch) {
    PHASE_IDS;
    const int tid = TID_, wid = tid >> 6, lane = tid & 63, fr = lane & 15, fq = lane >> 4;
    const size_t row0 = (size_t)b * SEQ + c * GC;
    const bf16* VGg = wsp<bf16>(F, WS_VG) + row0 * GW + g * GD; const bf16* Ug = wsp<bf16>(F, WS_U) + row0 * GW + g * GD;
    LAS unsigned short* vt = (LAS unsigned short*)scratch;
    { const int s = wid * 16 + (lane >> 2), dq = (lane & 3) * 32;
      const v4u* src = (const v4u*)(VGg + (size_t)s * GW + dq); float v[32]; float sum = 0.f;
#pragma unroll
      for (int i = 0; i < 4; ++i) { const v4u w = src[i]; const unsigned ww[4] = {w.x, w.y, w.z, w.w};
#pragma unroll
          for (int k = 0; k < 4; ++k) { v[i * 8 + 2 * k] = bflo(ww[k]); v[i * 8 + 2 * k + 1] = bfhi(ww[k]); sum += v[i * 8 + 2 * k] + v[i * 8 + 2 * k + 1]; } }
      sum += __shfl_xor(sum, 1); sum += __shfl_xor(sum, 2); const float mu = sum * (1.f / GD); float var = 0.f;
#pragma unroll
      for (int i = 0; i < 32; ++i) { v[i] -= mu; var += v[i] * v[i]; }
      var += __shfl_xor(var, 1); var += __shfl_xor(var, 2); const float rstd = 1.0f / sqrtf(var * (1.f / GD) + EPS);
      const float* lg = F.ln_g + g * GD + dq; const float* lb = F.ln_b + g * GD + dq;
#pragma unroll
      for (int i = 0; i < 32; ++i) vt[(dq + i) * PITCH + s] = (unsigned short)f2bf(v[i] * rstd * lg[i] + lb[i]); }
    __syncthreads();
    const int t = wid * 16 + fr;
    const float* Wg = F.gws + (size_t)g * GC * GC + (size_t)t * GC;
    f32x4 acc[8];
#pragma unroll
    for (int n = 0; n < 8; ++n) acc[n] = (f32x4){0.f, 0.f, 0.f, 0.f};
    const int nks = (wid * 16 + 16 + 31) / 32;
    for (int ks = 0; ks < nks; ++ks) { const int s0 = ks * 32 + fq * 8;
        const f32x4 w0 = *(const f32x4*)(Wg + s0), w1 = *(const f32x4*)(Wg + s0 + 4);
        float wv[8] = {w0[0], w0[1], w0[2], w0[3], w1[0], w1[1], w1[2], w1[3]};
#pragma unroll
        for (int j = 0; j < 8; ++j) if (s0 + j > t) wv[j] = 0.f;
        v4u aw; aw.x = pk2(wv[0], wv[1]); aw.y = pk2(wv[2], wv[3]); aw.z = pk2(wv[4], wv[5]); aw.w = pk2(wv[6], wv[7]);
        const bf16x8 af = *reinterpret_cast<const bf16x8*>(&aw);
#pragma unroll
        for (int n = 0; n < 8; ++n) { const bf16x8 bfr = *(const LAS bf16x8*)(vt + (n * 16 + fr) * PITCH + s0);
            acc[n] = __builtin_amdgcn_mfma_f32_16x16x32_bf16(af, bfr, acc[n], 0, 0, 0); } }
    bf16* Og = wsp<bf16>(F, WS_MIX) + row0 * DM + AW + g * GD; float* ssqg = wsp<float>(F, WS_SSQG) + row0 * GG + g;
#pragma unroll
    for (int j = 0; j < 4; ++j) { const int tt = wid * 16 + fq * 4 + j; const float bs = F.gbs[g * GC + tt]; float q2 = 0.f;
#pragma unroll
        for (int n = 0; n < 8; ++n) { const int d = n * 16 + fr; const float uu = bf2f(Ug[(size_t)tt * GW + d]); const float o = uu * (acc[n][j] + bs); q2 += o * o;
            Og[(size_t)tt * DM + d] = (bf16)f2bf(o); }
        q2 += __shfl_xor(q2, 1); q2 += __shfl_xor(q2, 2); q2 += __shfl_xor(q2, 4); q2 += __shfl_xor(q2, 8);
        if (fr == 0) ssqg[(size_t)tt * GG] = q2; }
    __syncthreads();
}
}

__device__ __forceinline__ void p2_mixers(const Frame& F) {
    LAS unsigned char* scratch = F.lds + RING_OFF;
    const int v = F.vcu;
    { const int bh = v >> 1, s0 = (v & 1) * 2;
#pragma unroll 1
      for (int i = 0; i < 4; ++i) { const int qq = s0 + (i >> 1); const int qb = (i & 1) ? 7 - qq : qq; att::attn_unit(F, bh / NH, bh % NH, qb, scratch); } }
#pragma unroll 1
    for (int i = 0; i < 4; ++i) { const int uidx = 4 * v + i; gm::unit(F, uidx >> 6, (uidx >> 2) & 15, uidx & 3, scratch); }
}

__device__ __forceinline__ void p4_router(const Frame& F) {
    PHASE_IDS;
    const int tid = TID_, wid = tid >> 6, lane = tid & 63, tk = lane & 31, hf = lane >> 5;
    LAS unsigned* hist = (LAS unsigned*)(F.lds + XTAB_OFF);
    LAS unsigned* base = hist + 32;
    const float* RWG = wsp<float>(F, WS_RWG); const float* x1 = F.out; const float* ssq1 = wsp<float>(F, WS_SSQ1);
    bf16* XN = wsp<bf16>(F, WS_XNB); unsigned* cntg = (unsigned*)(F.ctl + CW_CNT);
    unsigned* IDX = wsp<unsigned>(F, WS_IDX); float* GSS = wsp<float>(F, WS_GSS); unsigned* TOKPOS = wsp<unsigned>(F, WS_TOKPOS);
    if (tid < 32) hist[tid] = 0u;
    __syncthreads();
    const bool active = wid < 4; const int tok = (F.vcu * 4 + (wid & 3)) * 32 + tk;
    int pe[4] = {0, 0, 0, 0}; float pg[4] = {0.f, 0.f, 0.f, 0.f}; unsigned rank[2] = {0u, 0u}; int my_e[2] = {0, 0}; float my_g[2] = {0.f, 0.f};
    if (active) {
        float rstd; { const f32x4* sp = (const f32x4*)(ssq1 + (size_t)tok * 16); const f32x4 a = sp[0], b = sp[1], c = sp[2], d = sp[3];
            const float s = ((a[0] + a[1]) + (a[2] + a[3])) + ((b[0] + b[1]) + (b[2] + b[3])) + ((c[0] + c[1]) + (c[2] + c[3])) + ((d[0] + d[1]) + (d[2] + d[3]));
            rstd = 1.0f / sqrtf(s * (1.f / DM) + EPS); }
        f32x16 acc = f32x16{};
        const float* xr = x1 + (size_t)tok * DM + 4 * hf; bf16* xo = XN + (size_t)tok * DM + 4 * hf;
        const float* wr_ = RWG + tk;
#pragma unroll 4
        for (int j = 0; j < DM / 8; ++j) { f32x4 xv = *(const f32x4*)(xr + 8 * j); xv = xv * rstd;
            v2u w; w.x = cvt_pk_bf16(xv[0], xv[1]); w.y = cvt_pk_bf16(xv[2], xv[3]); *(v2u*)(xo + 8 * j) = w;
#pragma unroll
            for (int e = 0; e < 4; ++e) { const float wv = wr_[(size_t)(8 * j + 4 * hf + e) * NE]; acc = __builtin_amdgcn_mfma_f32_32x32x2f32(wv, xv[e], acc, 0, 0, 0); } }
        float lv[16];
#pragma unroll
        for (int r = 0; r < 16; ++r) { const int e = (r & 3) + 8 * (r >> 2) + 4 * hf; lv[r] = acc[r] + F.router_b[e]; }
        float tv[4]; int ti[4]; unsigned used = 0u;
#pragma unroll
        for (int k = 0; k < 4; ++k) { float best = -__builtin_inff(); int br = 0;
#pragma unroll
            for (int r = 0; r < 16; ++r) { const int e = (r & 3) + 8 * (r >> 2) + 4 * hf; const int eb = (br & 3) + 8 * (br >> 2) + 4 * hf;
                const bool better = !((used >> r) & 1u) && (lv[r] > best || (lv[r] == best && e < eb)); if (better) { best = lv[r]; br = r; } }
            used |= 1u << br; tv[k] = best; ti[k] = (br & 3) + 8 * (br >> 2) + 4 * hf; }
        float ov[4]; int oi[4];
#pragma unroll
        for (int k = 0; k < 4; ++k) { ov[k] = __shfl_xor(tv[k], 32); oi[k] = __shfl_xor(ti[k], 32); }
        int ia = 0, ib = 0;
#pragma unroll
        for (int k = 0; k < 4; ++k) {
            float va = tv[0], vb = ov[0]; int ea = ti[0], eb = oi[0];
#pragma unroll
            for (int q = 1; q < 4; ++q) { if (ia == q) { va = tv[q]; ea = ti[q]; } if (ib == q) { vb = ov[q]; eb = oi[q]; } }
            const bool takeA = (va > vb) || (va == vb && ea < eb);
            pg[k] = takeA ? va : vb; pe[k] = takeA ? ea : eb; if (takeA) ++ia; else ++ib; }
        { const float m = pg[0]; float s = 0.f;
#pragma unroll
          for (int k = 0; k < 4; ++k) { pg[k] = __builtin_amdgcn_exp2f((pg[k] - m) * 1.4426950408889634f); s += pg[k]; }
          const float inv = 1.0f / s;
#pragma unroll
          for (int k = 0; k < 4; ++k) pg[k] *= inv; }
        { const int m = -hf; my_e[0] = pe[0] ^ ((pe[0] ^ pe[2]) & m); my_e[1] = pe[1] ^ ((pe[1] ^ pe[3]) & m);
          const unsigned g0 = __float_as_uint(pg[0]), g1 = __float_as_uint(pg[1]), g2 = __float_as_uint(pg[2]), g3 = __float_as_uint(pg[3]);
          my_g[0] = __uint_as_float(g0 ^ ((g0 ^ g2) & (unsigned)m)); my_g[1] = __uint_as_float(g1 ^ ((g1 ^ g3) & (unsigned)m)); }
#pragma unroll
        for (int q = 0; q < 2; ++q) rank[q] = atomicAdd((unsigned*)&hist[my_e[q]], 1u);
    }
    __syncthreads();
    if (tid < 32) base[tid] = atomicAdd(cntg + tid, hist[tid]);
    __syncthreads();
    if (active) {
#pragma unroll
        for (int q = 0; q < 2; ++q) { const int k = 2 * hf + q; const int e = my_e[q]; const float g = my_g[q];
            const unsigned slot = base[e] + rank[q];
            IDX[(size_t)e * T + slot] = (unsigned)tok; GSS[(size_t)e * T + slot] = g; TOKPOS[(size_t)tok * 4 + k] = ((unsigned)e << 16) | slot; }
    }
    __syncthreads();
}

constexpr int MAXU = 18;
constexpr int XT_TSTART = 0, XT_ULIST = 256, XT_GTAB = 512;
static_assert(XT_GTAB + MAXU * 1024 <= LDS_BYTES - XTAB_OFF, "xtab");
__device__ __forceinline__ int moe_build_tables(const Frame& F, int P  , bool gather) {
    PHASE_IDS;
    LAS unsigned* tstart = (LAS unsigned*)(F.lds + XTAB_OFF + XT_TSTART);
    LAS unsigned* ulist = (LAS unsigned*)(F.lds + XTAB_OFF + XT_ULIST);
    LAS unsigned* gtab = (LAS unsigned*)(F.lds + XTAB_OFF + XT_GTAB);
    const unsigned* cntg = (const unsigned*)(F.ctl + CW_CNT); const unsigned* IDX = wsp<unsigned>(F, WS_IDX);
    const int tid = TID_;
    if (tid == 0) { unsigned s = 0; for (int e = 0; e < NE; ++e) { tstart[e] = s; unsigned c = cntg[e]; if (c > (unsigned)T) c = (unsigned)T; s += (c + 255u) >> 8; } tstart[NE] = s; }
    __syncthreads();
    const int NT_ = (int)tstart[NE], U = NT_ * P, G = F.G, c = (int)blockIdx.x;
    const int nunits = (c < U) ? (U - c + G - 1) / G : 0;
    if (tid < MAXU && tid < nunits) { const int L = tid * G + c; int gt, pn; pg8::flat_to_tile(L, U, NT_, P, gt, pn);
        int e = 0; for (int k = 1; k < NE; ++k) if ((unsigned)gt >= tstart[k]) e = k;
        const int rt = gt - (int)tstart[e];
        ulist[tid] = (unsigned)gt | ((unsigned)pn << 10) | ((unsigned)e << 13) | ((unsigned)rt << 18); }
    __syncthreads();
    if (gather) {
        for (int i = 0; i < nunits && i < MAXU; ++i) { const unsigned w = ulist[i]; const int e = (int)((w >> 13) & 0x1fu), rt = (int)(w >> 18);
            unsigned cn = cntg[e]; if (cn > (unsigned)T) cn = (unsigned)T;
            if (tid < 256) { const unsigned slot = (unsigned)rt * 256u + (unsigned)tid; unsigned tok = 0u; if (slot < cn) { tok = IDX[(size_t)e * T + slot]; if (tok >= (unsigned)T) tok = 0u; } gtab[i * 256 + tid] = tok * (unsigned)(DM * 2); } }
    }
    __syncthreads();
    return nunits < MAXU ? nunits : MAXU;
}

__device__ __forceinline__ void p7_combine(const Frame& F) {
    PHASE_IDS;
    LAS unsigned* tstart = (LAS unsigned*)(F.lds + XTAB_OFF + XT_TSTART);
    const unsigned* cntg = (const unsigned*)(F.ctl + CW_CNT);
    if (TID_ == 0) { unsigned s = 0; for (int e = 0; e < NE; ++e) { tstart[e] = s; unsigned c = cntg[e]; if (c > (unsigned)T) c = (unsigned)T; s += (c + 255u) >> 8; } tstart[NE] = s; }
    __syncthreads();
    const int gw = F.vcu * NWAVES + WAVE_, NGW = F.G * NWAVES;
    const unsigned* TOKPOS = wsp<unsigned>(F, WS_TOKPOS); const bf16* Y = wsp<bf16>(F, WS_YBUF); bf16* XN = wsp<bf16>(F, WS_X2N);
    for (int m = gw; m < T; m += NGW) {
        const v4u tp = *(const v4u*)(TOKPOS + (size_t)m * 4); const unsigned tpw[4] = {tp.x, tp.y, tp.z, tp.w};
        size_t yrow[4];
#pragma unroll
        for (int k = 0; k < 4; ++k) { const unsigned e = (tpw[k] >> 16) & 31u, slot = tpw[k] & 0xffffu; yrow[k] = ((size_t)tstart[e] * 256u + slot) * DM; }
        float* xr = F.out + (size_t)m * DM;
        f32x4 v[4]; float s = 0.f;
#pragma unroll
        for (int j = 0; j < 4; ++j) { v[j] = *(const f32x4*)(xr + 4 * LANE_ + 256 * j);
#pragma unroll
            for (int k = 0; k < 4; ++k) { const v2u w = *(const v2u*)(Y + yrow[k] + 4 * LANE_ + 256 * j); v[j][0] += bflo(w.x); v[j][1] += bfhi(w.x); v[j][2] += bflo(w.y); v[j][3] += bfhi(w.y); }
            s += (v[j].x * v[j].x + v[j].y * v[j].y) + (v[j].z * v[j].z + v[j].w * v[j].w); }
        const float rstd = 1.0f / sqrtf(wave_sum(s) * (1.f / DM) + EPS);
#pragma unroll
        for (int j = 0; j < 4; ++j) { *(f32x4*)(xr + 4 * LANE_ + 256 * j) = v[j];
            v2u w; w.x = pk2(v[j].x * rstd, v[j].y * rstd); w.y = pk2(v[j].z * rstd, v[j].w * rstd); *(v2u*)(XN + (size_t)m * DM + 4 * LANE_ + 256 * j) = w; }
    }
}

__device__ __forceinline__ void p9_final(const Frame& F) {
    PHASE_IDS;
    const int gw = F.vcu * NWAVES + WAVE_, NGW = F.G * NWAVES;
    const bf16* GATE = wsp<bf16>(F, WS_GATE); const bf16* PP = wsp<bf16>(F, WS_PP); const float* ssqpp = wsp<float>(F, WS_SSQPP);
    for (int m = gw; m < T; m += NGW) {
        float rpp; { const f32x4* sp = (const f32x4*)(ssqpp + (size_t)m * 16); const f32x4 a = sp[0], b = sp[1], c = sp[2], d = sp[3];
            const float s = ((a[0] + a[1]) + (a[2] + a[3])) + ((b[0] + b[1]) + (b[2] + b[3])) + ((c[0] + c[1]) + (c[2] + c[3])) + ((d[0] + d[1]) + (d[2] + d[3]));
            rpp = 1.0f / sqrtf(s * (1.f / DM) + EPS); }
        float* xr = F.out + (size_t)m * DM;
        f32x4 v[4]; float s = 0.f;
#pragma unroll
        for (int j = 0; j < 4; ++j) { const int col = 4 * LANE_ + 256 * j; v[j] = *(const f32x4*)(xr + col);
            const v2u g = *(const v2u*)(GATE + (size_t)m * DM + col), pw = *(const v2u*)(PP + (size_t)m * DM + col); const f32x4 pg_ = *(const f32x4*)(F.ppn + col);
            v[j][0] += bflo(g.x) * (bflo(pw.x) * rpp * pg_[0]); v[j][1] += bfhi(g.x) * (bfhi(pw.x) * rpp * pg_[1]);
            v[j][2] += bflo(g.y) * (bflo(pw.y) * rpp * pg_[2]); v[j][3] += bfhi(g.y) * (bfhi(pw.y) * rpp * pg_[3]);
            s += (v[j].x * v[j].x + v[j].y * v[j].y) + (v[j].z * v[j].z + v[j].w * v[j].w); }
        const float rstd = 1.0f / sqrtf(wave_sum(s) * (1.f / DM) + EPS);
#pragma unroll
        for (int j = 0; j < 4; ++j) { const int col = 4 * LANE_ + 256 * j; const f32x4 fg = *(const f32x4*)(F.final_norm + col); *(f32x4*)(xr + col) = v[j] * rstd * fg; }
    }
}

struct Args { const float* in[23]; float* out; unsigned char* ws; };
#if CHECK_STAGE
__device__ __forceinline__ unsigned hmix(unsigned z) { z ^= z >> 16; z *= 0x7feb352du; z ^= z >> 15; z *= 0x846ca68bu; z ^= z >> 16; return z; }
__device__ __forceinline__ void chk_add(const Frame& F, int st, bool bad) { atomicAdd((unsigned*)(F.ctl + CW_CHK + 2 * st), bad ? 1u : 0u); atomicAdd((unsigned*)(F.ctl + CW_CHK + 2 * st + 1), 1u); }
__device__ __forceinline__ bool offby(float got, float ex, float rel, float ab) { const float d = fabsf(got - ex); return !(d <= rel * fabsf(ex) + ab); }
__device__ __forceinline__ float dot_bf(const bf16* a, const bf16* b, int n) { float s = 0.f; for (int k = 0; k < n; ++k) s += bf2f(a[k]) * bf2f(b[k]); return s; }
__device__ __forceinline__ float gelu_ref(float v) { return 0.5f * v * (1.0f + erff(v * 0.70710678f)); }
__device__ __forceinline__ unsigned chk_tstart(const Frame& F, unsigned ex) { const unsigned* cntg = (const unsigned*)(F.ctl + CW_CNT); unsigned s_ = 0; for (unsigned e = 0; e < ex; ++e) { unsigned c = cntg[e]; if (c > (unsigned)T) c = T; s_ += (c + 255u) >> 8; } return s_; }
template <int ST> __device__ __forceinline__ void stage_check(const Frame& F) {
    const unsigned gt = (unsigned)blockIdx.x * NTHR + threadIdx.x;
    const unsigned h0 = hmix(gt * 2654435761u + ST * 40503u), h1 = hmix(h0 + 0x9e3779b9u), h2 = hmix(h1 + 0x85ebca6bu);
    if (ST == 1) {
        if (gt >= 16384) return;
        const int which = gt & 7;
        if (which == 0) { const int e = h0 % NE, n = h1 % (2 * FF), k = h2 % DM; const int lc = CmWgu()(n);
            const float ex = bf2f((bf16)f2bf(F.w_gu[((size_t)e * DM + k) * 2 * FF + lc] * F.ffn_norm[k])); chk_add(F, ST, offby(bf2f(wsp<bf16>(F, WS_WGU)[((size_t)e * 2 * FF + n) * DM + k]), ex, 1e-6f, 1e-30f)); }
        else if (which == 1) { const int e = h0 % NE, n = h1 % DM, k = h2 % FF;
            const float ex = bf2f((bf16)f2bf(F.w_dn[((size_t)e * FF + k) * DM + n])); chk_add(F, ST, offby(bf2f(wsp<bf16>(F, WS_WDN)[((size_t)e * DM + n) * FF + k]), ex, 1e-6f, 1e-30f)); }
        else if (which == 2) { const int n = h1 % NPROJ, k = h2 % DM; const int lc = CmWin()(n);
            const float ex = bf2f((bf16)f2bf(F.w_in[(size_t)k * NPROJ + lc] * F.mix_norm[k])); chk_add(F, ST, offby(bf2f(wsp<bf16>(F, WS_WIN)[(size_t)n * DM + k]), ex, 1e-6f, 1e-30f)); }
        else if (which == 3) { const int n = h1 % DM, k = h2 % DM; const float g = k < AW ? F.aon[k] : F.gon[k - AW];
            const float ex = bf2f((bf16)f2bf(F.w_out[(size_t)k * DM + n] * g)); chk_add(F, ST, offby(bf2f(wsp<bf16>(F, WS_WOUT)[(size_t)n * DM + k]), ex, 1e-6f, 1e-30f)); }
        else if (which == 4) { const int n = h1 % DM, k = h2 % DM;
            const float ex = bf2f((bf16)f2bf(F.w_pg[(size_t)k * DM + n] * F.ple_norm[k])); chk_add(F, ST, offby(bf2f(wsp<bf16>(F, WS_WPG)[(size_t)n * DM + k]), ex, 1e-6f, 1e-30f)); }
        else if (which == 5) { const int n = h1 % DM, k = h2 % PLE;
            const float ex = bf2f((bf16)f2bf(F.w_pp[(size_t)k * DM + n])); chk_add(F, ST, offby(bf2f(wsp<bf16>(F, WS_WPP)[(size_t)n * PLE + k]), ex, 1e-6f, 1e-30f)); }
        else if (which == 6) { const int row = h0 % T, k = h1 % DM; float ss = 0.f; for (int j = 0; j < DM; ++j) { const float v = F.x[(size_t)row * DM + j]; ss += v * v; }
            const float ex = F.x[(size_t)row * DM + k] / sqrtf(ss / DM + EPS); chk_add(F, ST, offby(bf2f(wsp<bf16>(F, WS_XNB)[(size_t)row * DM + k]), ex, 0.01f, 1e-3f)); }
        else { const int row = h0 % T, k = h1 % PLE; chk_add(F, ST, offby(bf2f(wsp<bf16>(F, WS_PB)[(size_t)row * PLE + k]), F.p[(size_t)row * PLE + k], 0.005f, 1e-6f)); }
    }
    if (ST == 2) {
        if (gt >= 16384) return;
        const bf16* XN = wsp<bf16>(F, WS_XNB); const bf16* WIN = wsp<bf16>(F, WS_WIN);
        if ((gt & 7) == 7) {
            const int b = h0 % BATCH, hh = h1 % NH, blk = h2 % NBLK, c = (h2 >> 8) % HD; float s_ = 0.f;
            for (int r = 0; r < 256; ++r) s_ += bf2f(wsp<bf16>(F, WS_K)[((size_t)b * SEQ + blk * 256 + r) * AW + hh * HD + c]);
            chk_add(F, ST, offby(wsp<float>(F, WS_KMEAN)[((size_t)(b * NH + hh) * NBLK + blk) * HD + c], s_, 0.02f, 0.3f)); return; }
        const int row = h0 % T, type = h1 % 5, c = h2 % AW; const bf16* xr = XN + (size_t)row * DM;
        const float v = dot_bf(xr, WIN + (size_t)(type * AW + c) * DM, DM); float ex;
        if (type <= 1) { const float vp = dot_bf(xr, WIN + (size_t)(type * AW + (c ^ 4)) * DM, DM); const int i = 4 * ((c & 63) >> 3) + (c & 3), pos = row & (SEQ - 1);
            const float cs = wsp<float>(F, WS_ROPE)[pos * 32 + i], sn = wsp<float>(F, WS_ROPE)[SEQ * 32 + pos * 32 + i];
            { const float inv = powf(10000.0f, -(float)i / 32.0f); const float ang = (float)pos * inv; if (offby(cs, cosf(ang), 0.f, 1e-3f) || offby(sn, sinf(ang), 0.f, 1e-3f)) { chk_add(F, ST, true); return; } }
            ex = (c & 4) ? v * cs + vp * sn : v * cs - vp * sn; }
        else if (type == 2) ex = v; else ex = gelu_ref(v);
        chk_add(F, ST, offby(bf2f(wsp<bf16>(F, WS_Q)[(size_t)type * (16u << 20) + (size_t)row * AW + c]), ex, 0.02f, 0.02f));
    }
    if (ST == 3) {
        if (gt >= 8192) return;
        if (gt & 1) {
            const int row = h0 % T, g = h1 % GG, d = h2 % GD; const int b = row / SEQ, s_ = row % SEQ, c = s_ / GC, t = s_ % GC; float acc = 0.f;
            for (int sp = 0; sp <= t; ++sp) { const bf16* vr = wsp<bf16>(F, WS_VG) + ((size_t)b * SEQ + c * GC + sp) * GW + g * GD; float mu = 0.f; for (int j = 0; j < GD; ++j) mu += bf2f(vr[j]); mu /= GD;
                float var = 0.f; for (int j = 0; j < GD; ++j) { const float dd = bf2f(vr[j]) - mu; var += dd * dd; } const float rstd = 1.0f / sqrtf(var / GD + EPS);
                const float vn = bf2f((bf16)f2bf((bf2f(vr[d]) - mu) * rstd * F.ln_g[g * GD + d] + F.ln_b[g * GD + d])); acc += bf2f((bf16)f2bf(F.gws[((size_t)g * GC + t) * GC + sp])) * vn; }
            const float ex = bf2f(wsp<bf16>(F, WS_U)[(size_t)row * GW + g * GD + d]) * (acc + F.gbs[g * GC + t]);
            chk_add(F, ST, offby(bf2f(wsp<bf16>(F, WS_MIX)[(size_t)row * DM + AW + g * GD + d]), ex, 0.03f, 0.02f)); return; }
        const int row = h0 % T, hh = h1 % NH; const int b = row / SEQ, s_ = row % SEQ, qb = s_ / MOBA; float q[HD];
#pragma unroll
        for (int c = 0; c < HD; ++c) q[c] = bf2f(wsp<bf16>(F, WS_Q)[(size_t)row * AW + hh * HD + c]);
        unsigned sel = 0u;
        if (qb <= 3) sel = (1u << qb) - 1u;
        else { float b0 = -__builtin_inff(), b1 = b0, b2 = b0; int i0 = 0, i1 = 0, i2 = 0;
            for (int j = 0; j < qb; ++j) { const float* km = wsp<float>(F, WS_KMEAN) + ((size_t)(b * NH + hh) * NBLK + j) * HD; float g = 0.f;
#pragma unroll
                for (int c = 0; c < HD; ++c) g += q[c] * km[c];
                if (g > b0) { b2 = b1; i2 = i1; b1 = b0; i1 = i0; b0 = g; i0 = j; } else if (g > b1) { b2 = b1; i2 = i1; b1 = g; i1 = j; } else if (g > b2) { b2 = g; i2 = j; } }
            sel = (1u << i0) | (1u << i1) | (1u << i2); }
        float mx = -__builtin_inff();
        for (int kp = 0; kp <= s_; ++kp) { const int blk = kp / MOBA; if (blk != qb && !((sel >> blk) & 1u)) continue; const bf16* kr = wsp<bf16>(F, WS_K) + ((size_t)b * SEQ + kp) * AW + hh * HD; float sc = 0.f;
#pragma unroll
            for (int c = 0; c < HD; ++c) sc += q[c] * bf2f(kr[c]);
            mx = fmaxf(mx, sc * 0.125f); }
        float o[HD]; float l = 0.f;
#pragma unroll
        for (int c = 0; c < HD; ++c) o[c] = 0.f;
        for (int kp = 0; kp <= s_; ++kp) { const int blk = kp / MOBA; if (blk != qb && !((sel >> blk) & 1u)) continue; const bf16* kr = wsp<bf16>(F, WS_K) + ((size_t)b * SEQ + kp) * AW + hh * HD; float sc = 0.f;
#pragma unroll
            for (int c = 0; c < HD; ++c) sc += q[c] * bf2f(kr[c]);
            const float pr = expf(sc * 0.125f - mx); l += pr; const bf16* vr = wsp<bf16>(F, WS_V) + ((size_t)b * SEQ + kp) * AW + hh * HD;
#pragma unroll
            for (int c = 0; c < HD; ++c) o[c] += pr * bf2f(vr[c]); }
        bool bad = false; float ss = 0.f;
#pragma unroll
        for (int c = 0; c < HD; ++c) { const float ex = o[c] / l; ss += ex * ex; bad |= offby(bf2f(wsp<bf16>(F, WS_MIX)[(size_t)row * DM + hh * HD + c]), ex, 0.04f, 0.02f); }
        bad |= offby(wsp<float>(F, WS_SSQA)[(size_t)row * NH + hh], ss, 0.03f, 1e-3f);
        chk_add(F, ST, bad);
    }
    if (ST == 4) {
        if (gt >= 16384) return;
        const int row = h0 % T, col = h1 % DM; const bf16* mr = wsp<bf16>(F, WS_MIX) + (size_t)row * DM; const bf16* wr_ = wsp<bf16>(F, WS_WOUT) + (size_t)col * DM;
        float sa = 0.f, sg = 0.f, da = 0.f, dg = 0.f;
        for (int k = 0; k < AW; ++k) { const float a = bf2f(mr[k]), g = bf2f(mr[AW + k]); sa += a * a; sg += g * g; da += a * bf2f(wr_[k]); dg += g * bf2f(wr_[AW + k]); }
        const float ex = F.x[(size_t)row * DM + col] + da / sqrtf(sa / AW + EPS) + dg / sqrtf(sg / GW + EPS);
        chk_add(F, ST, offby(F.out[(size_t)row * DM + col], ex, 0.01f, 0.03f));
    }
    if (ST == 5) {
        if (gt >= 8192) return;
        const int tok = h0 % T; const float* xr = F.out + (size_t)tok * DM; float ss = 0.f; for (int k = 0; k < DM; ++k) ss += xr[k] * xr[k]; const float rstd = 1.0f / sqrtf(ss / DM + EPS);
        bool bad = false;
        for (int j = 0; j < 4; ++j) { const int k = (h1 >> (8 * j)) % DM; bad |= offby(bf2f(wsp<bf16>(F, WS_XNB)[(size_t)tok * DM + k]), xr[k] * rstd, 0.01f, 1e-3f); }
        float lg[NE];
#pragma unroll
        for (int e = 0; e < NE; ++e) lg[e] = 0.f;
        for (int k = 0; k < DM; ++k) { const float xv = xr[k] * rstd * F.ffn_norm[k];
#pragma unroll
            for (int e = 0; e < NE; ++e) lg[e] += xv * F.router_w[k * NE + e]; }
#pragma unroll
        for (int e = 0; e < NE; ++e) lg[e] += F.router_b[e];
        int te[4]; float tv[4]; unsigned used = 0u;
#pragma unroll
        for (int k = 0; k < 4; ++k) { float best = -__builtin_inff(); int bi = 0;
#pragma unroll
            for (int e = 0; e < NE; ++e) if (!((used >> e) & 1u) && lg[e] > best) { best = lg[e]; bi = e; }
            used |= 1u << bi; te[k] = bi; tv[k] = best; }
        { float gg[4]; float den = 0.f;
#pragma unroll
          for (int k = 0; k < 4; ++k) { float v = -__builtin_inff();
#pragma unroll
              for (int e = 0; e < NE; ++e) if (e == te[k]) v = lg[e];
              gg[k] = v; }
          const float mm = gg[0];
#pragma unroll
          for (int k = 0; k < 4; ++k) { gg[k] = expf(gg[k] - mm); den += gg[k]; }
          const unsigned* tp = wsp<unsigned>(F, WS_TOKPOS) + (size_t)tok * 4;
#pragma unroll
          for (int k = 0; k < 4; ++k) { const unsigned e = tp[k] >> 16, slot = tp[k] & 0xffffu; bad |= (e != (unsigned)te[k]);
              if (e < NE && slot < (unsigned)T) { bad |= wsp<unsigned>(F, WS_IDX)[(size_t)e * T + slot] != (unsigned)tok; bad |= offby(wsp<float>(F, WS_GSS)[(size_t)e * T + slot], gg[k] / den, 2e-3f, 1e-5f);
                  bad |= slot >= ((const unsigned*)(F.ctl + CW_CNT))[e]; } else bad = true; } }
        (void)tv;
        chk_add(F, ST, bad);
    }
    if (ST == 6 || ST == 7) {
        if (gt >= 16384) return;
        const int tok = h0 % T, k = h1 & 3, col = (h1 >> 2) % FF; const unsigned tp = wsp<unsigned>(F, WS_TOKPOS)[(size_t)tok * 4 + k]; const unsigned e = tp >> 16, slot = tp & 0xffffu;
        if (e >= NE) { chk_add(F, ST, true); return; }
        const unsigned tse = chk_tstart(F, e);
        const size_t row = (size_t)tse * 256 + slot;
        if (ST == 6) { const bf16* xr = wsp<bf16>(F, WS_XNB) + (size_t)tok * DM; const int np = (col >> 7) * 256 + (col & 127);
            const float g = dot_bf(xr, wsp<bf16>(F, WS_WGU) + ((size_t)e * 2 * FF + np) * DM, DM) + F.b_gu[(size_t)e * 2 * FF + col];
            const float l = dot_bf(xr, wsp<bf16>(F, WS_WGU) + ((size_t)e * 2 * FF + np + 128) * DM, DM) + F.b_gu[(size_t)e * 2 * FF + FF + col];
            const float gc = fminf(g, 7.f), lc = fminf(fmaxf(l, -7.f), 7.f); const float ex = gc / (1.0f + expf(-1.702f * gc)) * (lc + 1.0f);
            chk_add(F, ST, offby(bf2f(wsp<bf16>(F, WS_ABUF)[row * FF + col]), ex, 0.03f, 0.03f)); }
        else { const float d = dot_bf(wsp<bf16>(F, WS_ABUF) + row * FF, wsp<bf16>(F, WS_WDN) + ((size_t)e * DM + col) * FF, FF) + F.b_dn[(size_t)e * DM + col];
            const float ex = d * wsp<float>(F, WS_GSS)[(size_t)e * T + slot];
            chk_add(F, ST, offby(bf2f(wsp<bf16>(F, WS_YBUF)[row * DM + col]), ex, 0.03f, 0.01f)); }
    }
    if (ST == 8) {
        if (gt >= 8192) return;
        const int tok = h0 % T; const float* xr = F.out + (size_t)tok * DM; float ss = 0.f; for (int k = 0; k < DM; ++k) ss += xr[k] * xr[k]; const float rstd = 1.0f / sqrtf(ss / DM + EPS);
        bool bad = false; for (int k = 0; k < DM; ++k) { bad |= offby(bf2f(wsp<bf16>(F, WS_X2N)[(size_t)tok * DM + k]), xr[k] * rstd, 0.01f, 1e-3f); bad |= !(fabsf(xr[k]) < 30.f); }
        chk_add(F, ST, bad);
    }
    if (ST == 9) {
        if (gt >= 16384) return;
        const int row = h0 % T, col = h1 % DM;
        if (gt & 1) { const float d = dot_bf(wsp<bf16>(F, WS_X2N) + (size_t)row * DM, wsp<bf16>(F, WS_WPG) + (size_t)col * DM, DM); const float got = bf2f(wsp<bf16>(F, WS_GATE)[(size_t)row * DM + col]); const float ex = 1.0f / (1.0f + expf(-d)); const bool bad = offby(got, ex, 0.02f, 0.01f); chk_add(F, ST, bad);
            if (bad) { atomicOr((unsigned*)(F.ctl + CW_CHK + 40), 1u << ((col >> 3) & 31)); atomicOr((unsigned*)(F.ctl + CW_CHK + 41), 1u << ((row >> 3) & 31)); atomicOr((unsigned*)(F.ctl + CW_CHK + 42), 1u << (col & 7)); atomicOr((unsigned*)(F.ctl + CW_CHK + 43), 1u << (row & 7));
                if (!(got >= 0.f && got <= 1.f)) atomicAdd((unsigned*)(F.ctl + CW_CHK + 44), 1u); { int cl = (int)floorf(log2f(fabsf(got) + 1e-30f)) + 40; cl = cl < 0 ? 0 : (cl > 80 ? 80 : cl); atomicMax((unsigned*)(F.ctl + CW_CHK + 46), (unsigned)cl); atomicMin((unsigned*)(F.ctl + CW_CHK + 47), 0xffffffffu - (unsigned)cl); if (got < 0.f) atomicAdd((unsigned*)(F.ctl + CW_CHK + 48), 1u); } if (fabsf(got - ex) > 0.2f) atomicAdd((unsigned*)(F.ctl + CW_CHK + 45), 1u); } }
        else { const float d = dot_bf(wsp<bf16>(F, WS_PB) + (size_t)row * PLE, wsp<bf16>(F, WS_WPP) + (size_t)col * PLE, PLE); chk_add(F, 10, offby(bf2f(wsp<bf16>(F, WS_PP)[(size_t)row * DM + col]), d, 0.02f, 0.02f)); }
    }
}
__device__ __forceinline__ void check_report(const Frame& F) {
    float c2 = 3.0f;
    for (int st = 1; st <= 10; ++st) { const unsigned bad = F.ctl[CW_CHK + 2 * st], tot = F.ctl[CW_CHK + 2 * st + 1]; const float fr = tot ? (float)bad / (float)tot : 1.0f;
        (void)fr; if (((CHECK_SKIP >> st) & 1) == 0 && bad >= 1u) { c2 = powf(10.0f, (float)st) * (1.0f + fminf((float)bad, 80.0f) * 0.1f); break; } }
#if CHECK_REPORT >= 40
    { unsigned v = F.ctl[CW_CHK + CHECK_REPORT]; if (CHECK_REPORT == 47) v = 0xffffffffu - v; c2 = powf(10.0f, (float)(v >> 27)) * (1.0f + (float)((v >> 21) & 63u) * 0.1f);
#if CHECK_REPORT2
      c2 = powf(10.0f, (float)((v >> 16) & 31u)) * (1.0f + (float)((v >> 10) & 63u) * 0.1f);
#endif
#if CHECK_REPORT3
      c2 = powf(10.0f, (float)((v >> 5) & 31u)) * (1.0f + (float)(v & 31u) * 0.1f);
#endif
      if (CHECK_REPORT >= 46 && CHECK_REPORT <= 47) c2 = powf(10.0f, (float)(v / 9u)) * (1.0f + (float)(v % 9u));
    }
#endif
    if (F.ctl[CW_BAR + XB_TMO] != 0u) c2 = 1e20f;
    const float c = sqrtf(c2);
    for (size_t i = (size_t)blockIdx.x * NTHR + threadIdx.x; i < (size_t)T * DM; i += (size_t)gridDim.x * NTHR) F.out[i] = c;
}
#define STAGE_CHECK(n) stage_check<(n)>(F)
#else
#define STAGE_CHECK(n) do {} while (0)
#endif

__global__ void __launch_bounds__(NTHR, 2) mega_fwd(Args args) {
    extern __shared__ __attribute__((aligned(16))) unsigned char lds_raw[];
    Frame F;
    F.lds = (LAS unsigned char*)lds_raw;
    F.MISC = (volatile LAS unsigned*)(F.lds + LDSCTL_OFF);
    F.G = gridDim.x; { const int bx = blockIdx.x; F.vcu = (F.G % 8 == 0) ? (bx % 8) * (F.G / 8) + bx / 8 : bx; }
    F.ws = args.ws; F.ctl = (gu32*)(args.ws + WS_CTL); F.out = args.out;
    F.x = args.in[0]; F.p = args.in[1]; F.mix_norm = args.in[2]; F.w_in = args.in[3]; F.ln_g = args.in[4]; F.ln_b = args.in[5]; F.gws = args.in[6]; F.gbs = args.in[7];
    F.aon = args.in[8]; F.gon = args.in[9]; F.w_out = args.in[10]; F.ffn_norm = args.in[11]; F.router_w = args.in[12]; F.router_b = args.in[13]; F.w_gu = args.in[14]; F.b_gu = args.in[15];
    F.w_dn = args.in[16]; F.b_dn = args.in[17]; F.ple_norm = args.in[18]; F.w_pg = args.in[19]; F.w_pp = args.in[20]; F.ppn = args.in[21]; F.final_norm = args.in[22];
    { PHASE_IDS; for (int u = TID_; u < 256; u += NTHR) ((LAS unsigned*)(F.lds + LDSCTL_OFF))[u] = 0u; }
    __syncthreads();
    XcdBarrier bar = xcd_barrier_post((unsigned*)(F.ctl + CW_BAR), F.MISC + 8);
#define GRID_BAR() xcd_barrier(bar)
#define STAGE_END(n) STAGE_CHECK(n)

    if (PH(0)) p0_prologue(F);
    GRID_BAR();
    STAGE_END(1);
    if (PH(1)) { pg8::DenseSched S; S.init(wsp<bf16>(F, WS_XNB), wsp<bf16>(F, WS_WIN), T, NPROJ, DM, F.G, (int)blockIdx.x);
      float* RC = wsp<float>(F, WS_ROPE);
      EpiInProj E{wsp<bf16>(F, WS_Q), RC, RC + SEQ * 32, wsp<float>(F, WS_KMEAN)};
      pg8::gemm_phase<EpiInProj, pg8::DenseSched, false, false>(F.lds + RING_OFF, DM, S, E); }
    GRID_BAR();
    STAGE_END(2);
    if (PH(2)) p2_mixers(F);
    GRID_BAR();
    STAGE_END(3);
    if (PH(3)) { pg8::DenseSched S; S.init(wsp<bf16>(F, WS_MIX), wsp<bf16>(F, WS_WOUT), T, DM, DM, F.G, (int)blockIdx.x);
      LAS f32x2* rtab = (LAS f32x2*)(F.lds + XTAB_OFF);
      Unit ua, ub; const bool ha = S.next(0, ua), hb = S.next(1, ub);
      { PHASE_IDS; const int s = TID_ >> 8, r = TID_ & 255; const bool has = s ? hb : ha; const int pm = s ? ub.pm : ua.pm;
        if (has) { const size_t row = (size_t)pm * 256 + r; const f32x4* pa = (const f32x4*)(wsp<float>(F, WS_SSQA) + row * NH); const f32x4 a0 = pa[0], a1 = pa[1], g0 = *(const f32x4*)(wsp<float>(F, WS_SSQG) + row * GG);
            const float sa = ((a0[0] + a0[1]) + (a0[2] + a0[3])) + ((a1[0] + a1[1]) + (a1[2] + a1[3])), sg = (g0[0] + g0[1]) + (g0[2] + g0[3]);
            const float ra = 1.0f / sqrtf(sa * (1.f / AW) + EPS), rg = 1.0f / sqrtf(sg * (1.f / GW) + EPS);
            rtab[s * 256 + r] = (f32x2){ra / rg, rg}; } }
      __syncthreads();
      EpiOutProj E{F.x, F.out, wsp<float>(F, WS_SSQ1), rtab, nullptr, ha ? ua.pm : -1, hb ? ub.pm : -1};
      pg8::gemm_phase<EpiOutProj, pg8::DenseSched, false, true>(F.lds + RING_OFF, DM, S, E); }
    GRID_BAR();
    STAGE_END(4);
    if (PH(4)) p4_router(F);
    GRID_BAR();
    STAGE_END(5);
    if (PH(5)) { const int nu = moe_build_tables(F, 2 * FF / 256, true);
      pg8::MoeSched S{(const char*)wsp<bf16>(F, WS_XNB), (const char*)wsp<bf16>(F, WS_WGU), 0, (size_t)2 * FF * DM * 2, (size_t)256 * DM * 2, nu,
                      (const LAS unsigned*)(F.lds + XTAB_OFF + XT_ULIST), (const LAS unsigned*)(F.lds + XTAB_OFF + XT_GTAB), true};
      EpiMoe1 E{wsp<bf16>(F, WS_ABUF), F.b_gu};
      pg8::gemm_phase<EpiMoe1, pg8::MoeSched, true, false>(F.lds + RING_OFF, DM, S, E); }
    GRID_BAR();
    STAGE_END(6);
    if (PH(6)) { const int nu = moe_build_tables(F, DM / 256, false);
      pg8::MoeSched S{(const char*)wsp<bf16>(F, WS_ABUF), (const char*)wsp<bf16>(F, WS_WDN), (size_t)256 * FF * 2, (size_t)DM * FF * 2, (size_t)256 * FF * 2, nu,
                      (const LAS unsigned*)(F.lds + XTAB_OFF + XT_ULIST), (const LAS unsigned*)(F.lds + XTAB_OFF + XT_GTAB), false};
      EpiMoe2 E{wsp<bf16>(F, WS_YBUF), F.b_dn, wsp<float>(F, WS_GSS)};
      pg8::gemm_phase<EpiMoe2, pg8::MoeSched, false, false>(F.lds + RING_OFF, FF, S, E); }
    GRID_BAR();
    STAGE_END(7);
    if (PH(7)) p7_combine(F);
    GRID_BAR();
    STAGE_END(8);
    if (PH(8)) { pg8::DenseSched S; S.init(wsp<bf16>(F, WS_X2N), wsp<bf16>(F, WS_WPG), T, DM, DM, F.G, (int)blockIdx.x);
      EpiPle<0> E{wsp<bf16>(F, WS_GATE), nullptr};
      pg8::gemm_phase<EpiPle<0>, pg8::DenseSched, false, false>(F.lds + RING_OFF, DM, S, E);
#if CHECK_STAGE
      GRID_BAR();
      pg8::gemm_phase<EpiPle<0>, pg8::DenseSched, false, false>(F.lds + RING_OFF, DM, S, E);
#endif
    }
#if CHECK_STAGE
    GRID_BAR(); STAGE_CHECK(9);
#endif
    if (PH(8)) { pg8::DenseSched S; S.init(wsp<bf16>(F, WS_PB), wsp<bf16>(F, WS_WPP), T, DM, PLE, F.G, (int)blockIdx.x);
      EpiPle<1> E{wsp<bf16>(F, WS_PP), wsp<float>(F, WS_SSQPP)};
      int Kp = PLE; asm volatile("" : "+s"(Kp));
      pg8::gemm_phase<EpiPle<1>, pg8::DenseSched, false, false>(F.lds + RING_OFF, Kp, S, E); }
    GRID_BAR();
    STAGE_END(9);
#if CHECK_STAGE
    GRID_BAR(); check_report(F);
#else
    if (PH(9)) p9_final(F);
#endif
}

extern "C" void kernel_launch(void* const* d_in, const int* in_sizes, int n_in, void* d_out, int out_size, void* d_ws, size_t ws_size, hipStream_t stream) {
    static int grid = 0;
    if (grid == 0) {
        if (n_in != 23 || in_sizes[0] != T * DM || out_size != T * DM || ws_size < WS_END) { fprintf(stderr, "kernel_launch: unexpected shapes (n_in %d, in0 %d, out %d, ws %zu)\n", n_in, n_in > 0 ? in_sizes[0] : -1, out_size, ws_size); grid = -1; return; }
        int dev = 0, cus = 0, per_cu = 0;
        if (hipGetDevice(&dev) != hipSuccess || hipDeviceGetAttribute(&cus, hipDeviceAttributeMultiprocessorCount, dev) != hipSuccess) { grid = -1; return; }
        if (hipFuncSetAttribute((const void*)mega_fwd, hipFuncAttributeMaxDynamicSharedMemorySize, LDS_BYTES) != hipSuccess) { fprintf(stderr, "kernel_launch: hipFuncSetAttribute failed\n"); grid = -1; return; }
        if (hipOccupancyMaxActiveBlocksPerMultiprocessor(&per_cu, (const void*)mega_fwd, NTHR, LDS_BYTES) != hipSuccess || per_cu < 1)
            fprintf(stderr, "kernel_launch: note: occupancy query reports %d workgroups per CU\n", per_cu);
        (void)hipGetLastError();
        grid = cus;
    }
    if (grid < 0) return;
    if (hipMemsetAsync((char*)d_ws + WS_CTL, 0, CTL_ZERO_BYTES, stream) != hipSuccess) return;
    Args a{};
    for (int i = 0; i < 23; ++i) a.in[i] = (const float*)d_in[i];
    a.out = (float*)d_out; a.ws = (unsigned char*)d_ws;
    hipLaunchKernelGGL(mega_fwd, dim3(grid), dim3(NTHR), LDS_BYTES, stream, a);
}
```

```cpp
#include <hip/hip_runtime.h>
#include <cstdio>
#include <cstdint>

#ifndef CHECK_STAGE
#define CHECK_STAGE 0
#endif
#ifndef CHECK_REPORT
#define CHECK_REPORT 0
#endif
#ifndef CHECK_REPORT2
#define CHECK_REPORT2 0
#endif
#ifndef CHECK_REPORT3
#define CHECK_REPORT3 0
#endif
#ifndef DUP_PHASE
#define DUP_PHASE -1
#endif
#ifndef TPROBE
#define TPROBE 0
#endif
#ifndef TP_A
#define TP_A 5
#endif
#ifndef TP_B
#define TP_B 6
#endif
#ifndef CHECK_SKIP
#define CHECK_SKIP 0
#endif
#ifndef PHMASK
#define PHMASK 0x3ff
#endif
#define PH(n) ((PHMASK >> (n)) & 1)

#define GAS __attribute__((address_space(1)))
#define LAS __attribute__((address_space(3)))
typedef unsigned short bf16;
typedef unsigned v4u __attribute__((ext_vector_type(4)));
typedef unsigned v2u __attribute__((ext_vector_type(2)));
typedef float f32x2 __attribute__((ext_vector_type(2)));
typedef float f32x4 __attribute__((ext_vector_type(4)));
typedef float f32x16 __attribute__((ext_vector_type(16)));
typedef short bf16x8 __attribute__((ext_vector_type(8)));
typedef short s16x4 __attribute__((ext_vector_type(4)));
typedef GAS unsigned gu32;

constexpr int BATCH = 16, SEQ = 2048, DM = 1024, T = BATCH * SEQ;
constexpr int AW = 512, NH = 8, HD = 64, NBLK = 8, MOBA = 256;
constexpr int GW = 512, GG = 4, GD = 128, GC = 128;
constexpr int NPROJ = 3 * AW + 2 * GW;
constexpr int NE = 32, TOPK = 4, FF = 1024;
constexpr int PLE = 256;
constexpr int MAXROWS = T * TOPK + NE * 256;
constexpr float EPS = 1e-6f;
constexpr int NWAVES = 8, NTHR = 512;

constexpr size_t MiB = 1u << 20;
constexpr size_t WS_CTL = 0, CTL_ZERO_BYTES = 1 * MiB;
constexpr size_t WS_KMEAN = 256 * 1024;
constexpr size_t WS_WIN = 1 * MiB;
constexpr size_t WS_WOUT = 6 * MiB;
constexpr size_t WS_WPG = 8 * MiB;
constexpr size_t WS_WPP = 10 * MiB;
constexpr size_t WS_RWG = 10 * MiB + 512 * 1024;
constexpr size_t WS_ROPE = 11 * MiB;
constexpr size_t WS_WGU = 16 * MiB;
constexpr size_t WS_WDN = 144 * MiB;
constexpr size_t WS_XNB = 208 * MiB;
constexpr size_t WS_BIG1 = 272 * MiB;
constexpr size_t WS_Q = WS_BIG1, WS_K = WS_Q + 32 * MiB, WS_V = WS_K + 32 * MiB, WS_U = WS_V + 32 * MiB, WS_VG = WS_U + 32 * MiB, WS_MIX = WS_VG + 32 * MiB;
constexpr size_t WS_YBUF = WS_BIG1;
constexpr size_t WS_BIG2 = 544 * MiB;
constexpr size_t WS_ABUF = WS_BIG2, WS_GATE = WS_BIG2, WS_PP = WS_BIG2 + 64 * MiB;
constexpr size_t WS_PB = 816 * MiB;
constexpr size_t WS_IDX = 832 * MiB;
constexpr size_t WS_GSS = 836 * MiB;
constexpr size_t WS_TOKPOS = 840 * MiB;
constexpr size_t WS_SSQA = 841 * MiB;
constexpr size_t WS_SSQG = 842 * MiB;
constexpr size_t WS_SSQ1 = 843 * MiB;
constexpr size_t WS_SSQPP = 845 * MiB;
constexpr size_t WS_X1F8 = 848 * MiB;
constexpr size_t WS_X2N = WS_XNB;
constexpr size_t WS_END = 880 * MiB;
static_assert(WS_MIX + 64 * MiB <= WS_BIG2 && (size_t)MAXROWS * 1024 * 2 <= 272 * MiB, "ws map");
constexpr int CW_TMO = 0, CW_CODE = 1;
constexpr int CW_BAR = 4096;
constexpr int CW_CNT = 8192;
constexpr int CW_TS = 12000;
constexpr int CW_CHK = 12288;

constexpr int RING_OFF = 0, RING_BYTES = 131072;
constexpr int P0_SCR_WAVE = 64 * 65 * 4;
constexpr int LDSCTL_OFF = 8 * P0_SCR_WAVE;
constexpr int XTAB_OFF = LDSCTL_OFF + 1024;
static_assert(LDSCTL_OFF >= RING_BYTES, "lds map");
constexpr int LDS_BYTES = 163840;

#define RLX_AGENT __ATOMIC_RELAXED, __HIP_MEMORY_SCOPE_AGENT
#define LDS_WAIT() asm volatile("s_waitcnt lgkmcnt(0)" ::: "memory")
#define VM_WAIT() asm volatile("s_waitcnt vmcnt(0)" ::: "memory")
__device__ __forceinline__ unsigned f2bf(float f) { unsigned u = __builtin_bit_cast(unsigned, f); return (u + 0x7fffu + ((u >> 16) & 1u)) >> 16; }
__device__ __forceinline__ unsigned pk2(float lo, float hi) { return f2bf(lo) | (f2bf(hi) << 16); }
__device__ __forceinline__ float bf2f(unsigned short b) { return __builtin_bit_cast(float, ((unsigned)b) << 16); }
__device__ __forceinline__ float bflo(unsigned w) { return __builtin_bit_cast(float, w << 16); }
__device__ __forceinline__ float bfhi(unsigned w) { return __builtin_bit_cast(float, w & 0xffff0000u); }
typedef __bf16 bf16x2_t __attribute__((ext_vector_type(2)));
__device__ __forceinline__ unsigned cvt_pk_bf16(float lo, float hi) { const f32x2 v = {lo, hi}; const bf16x2_t b = __builtin_convertvector(v, bf16x2_t); return __builtin_bit_cast(unsigned, b); }
__device__ __forceinline__ float clamp448(float x) { return fminf(fmaxf(x, -448.0f), 448.0f); }
__device__ __forceinline__ unsigned pk4_fp8(float a, float b, float c, float d) { unsigned w = 0u; w = (unsigned)__builtin_amdgcn_cvt_pk_fp8_f32(clamp448(a), clamp448(b), (int)w, false); w = (unsigned)__builtin_amdgcn_cvt_pk_fp8_f32(clamp448(c), clamp448(d), (int)w, true); return w; }
__device__ __forceinline__ float fp8_to_f(unsigned v) { const unsigned sg = (v >> 7) & 1u, e = (v >> 3) & 15u, m = v & 7u; const float r = e ? ldexpf(1.0f + (float)m * 0.125f, (int)e - 7) : ldexpf((float)m * 0.125f, -6); return sg ? -r : r; }
__device__ __forceinline__ float wave_sum(float v) {
#pragma unroll
    for (int o = 1; o < 64; o <<= 1) v += __shfl_xor(v, o);
    return v;
}
__device__ __forceinline__ f32x2 gelu_pk(f32x2 v) {
    const f32x2 av = __builtin_elementwise_abs(v), d = av * 0.2316418882f + 1.0f;
    f32x2 t; t.x = __builtin_amdgcn_rcpf(d.x); t.y = __builtin_amdgcn_rcpf(d.y);
    f32x2 q = t * 0.5307027145f + (-0.7265760135f); q = q * t + 0.7107068705f; q = q * t + (-0.142248368f); q = q * t + 0.127414796f; q = q * t;
    const f32x2 s = (v * v) * (-0.72134752044f);
    f32x2 e; e.x = __builtin_amdgcn_exp2f(s.x); e.y = __builtin_amdgcn_exp2f(s.y);
    const f32x2 m = v * (q * e), r = v - m;
    f32x2 o; o.x = v.x < 0.f ? m.x : r.x; o.y = v.y < 0.f ? m.y : r.y; return o;
}
__device__ __forceinline__ f32x4 gelu4(f32x4 v) { const f32x2 a = gelu_pk((f32x2){v[0], v[1]}), b = gelu_pk((f32x2){v[2], v[3]}); return (f32x4){a.x, a.y, b.x, b.y}; }
__device__ __forceinline__ float sigmoidf_fast(float x) { return __builtin_amdgcn_rcpf(1.0f + __builtin_amdgcn_exp2f(-1.4426950408889634f * x)); }

#define XB_TMO      128
#define XB_XCNT(j)  (256  + 64 * (j))
#define XB_XSUB(j)  (1280 + 64 * (j))
#define XB_XGEN(j)  (2304 + 64 * (j))
#define XB_TOP      3328
#define XB_TOPGEN   3392
#define XCD_BAR_WORDS 3456
#define XB_SPIN_CAP (1u << 18)
__device__ __forceinline__ unsigned xb_ld(unsigned* p)              { return __hip_atomic_load(p, __ATOMIC_RELAXED, __HIP_MEMORY_SCOPE_AGENT); }
__device__ __forceinline__ unsigned xb_add(unsigned* p, unsigned v) { return __hip_atomic_fetch_add(p, v, __ATOMIC_RELAXED, __HIP_MEMORY_SCOPE_AGENT); }
__device__ __forceinline__ unsigned xb_xcc_id() { return (unsigned)__builtin_amdgcn_s_getreg((3 << 11) | 20) & 0xFu; }
#define XB_SPIN(cond, bar) do { unsigned _sp = 0; while (cond) { __builtin_amdgcn_s_sleep(1); \
    if ((++_sp & 255u) == 0u) { if (xb_ld(&(bar)[XB_TMO])) break; if (_sp > XB_SPIN_CAP) { atomicAdd(&(bar)[XB_TMO], 1u); break; } } } } while (0)
struct XcdBarrier { unsigned* bar; unsigned x; volatile LAS unsigned* st; };
__device__ __forceinline__ XcdBarrier xcd_barrier_post(unsigned* bar, volatile LAS unsigned* st) {
    XcdBarrier b; b.bar = bar; b.x = xb_xcc_id(); b.st = st;
    if (threadIdx.x == 0) (void)xb_add(&bar[XB_XCNT(b.x)], 1u);
    return b;
}
__device__ __forceinline__ void xcd_barrier_complete(unsigned* bar, unsigned x, unsigned& nloc, unsigned& nx) {
    const unsigned G = gridDim.x * gridDim.y * gridDim.z;
    unsigned sum, cnt, mine, sp = 0u;
    for (;;) {
        sum = 0u; cnt = 0u; mine = 0u;
#pragma unroll
        for (unsigned j = 0; j < 16; ++j) { const unsigned c = xb_ld(&bar[XB_XCNT(j)]); sum += c; cnt += (c > 0u) ? 1u : 0u; mine = (j == x) ? c : mine; }
        if (sum == G) break;
        __builtin_amdgcn_s_sleep(1);
        if ((++sp & 255u) == 0u) { if (xb_ld(&bar[XB_TMO])) break; if (sp > XB_SPIN_CAP) { atomicAdd(&bar[XB_TMO], 1u); break; } }
    }
    nloc = mine > 0u ? mine : 1u; nx = cnt > 0u ? cnt : 1u;
}
__device__ __forceinline__ void xcd_barrier(const XcdBarrier& b) {
    asm volatile("s_waitcnt vmcnt(0)" ::: "memory");
    __syncthreads();
    if (threadIdx.x == 0) {
        unsigned* bar = b.bar;
        __builtin_amdgcn_s_waitcnt(0);
        unsigned nloc = b.st[0], nx = b.st[1];
        if (nloc == 0u) { xcd_barrier_complete(bar, b.x, nloc, nx); b.st[0] = nloc; b.st[1] = nx; }
        const unsigned old = xb_add(&bar[XB_XSUB(b.x)], 1u);
        const unsigned gen = old / nloc;
        if (old + 1u == (gen + 1u) * nloc) {
            __builtin_amdgcn_fence(__ATOMIC_RELEASE, "agent");
            asm volatile("s_waitcnt vmcnt(0)" ::: "memory");
            const unsigned og = xb_add(&bar[XB_TOP], 1u);
            const unsigned tg = og / nx;
            if (og + 1u == (tg + 1u) * nx) xb_add(&bar[XB_TOPGEN], 1u);
            else XB_SPIN(xb_ld(&bar[XB_TOPGEN]) == tg, bar);
            __builtin_amdgcn_fence(__ATOMIC_ACQUIRE, "agent");
            xb_add(&bar[XB_XGEN(b.x)], 1u);
            asm volatile("s_waitcnt vmcnt(0)" ::: "memory");
        } else {
            XB_SPIN(xb_ld(&bar[XB_XGEN(b.x)]) == gen, bar);
            __builtin_amdgcn_fence(__ATOMIC_ACQUIRE, "agent");
            asm volatile("s_waitcnt vmcnt(0)" ::: "memory");
        }
    }
    __syncthreads();
}

namespace pg8 {
constexpr int BM = 256, BK = 64, HALF = 128, HTB = HALF * BK * 2, STAGE_BYTES = 8 * HTB, NXCD = 8, WGM = 8;
__host__ __device__ __forceinline__ int lds_byte(int r, int c) { const int st = (r >> 4) * 2 + (c >> 5), rr = r & 15, cc = c & 31, ob = rr * 64 + cc * 2; return st * 1024 + (ob ^ (((ob >> 9) & 1) << 5)); }
__host__ __device__ __forceinline__ void stage_rc(int b, int& R, int& C) { const int st = b / 1024, sb = b % 1024, swz = sb ^ (((sb >> 9) & 1) << 5); R = (st >> 1) * 16 + swz / 64; C = (st & 1) * 32 + (swz % 64) / 2; }
__host__ __device__ __forceinline__ int perm32(int rho) { const int n = rho >> 4, i = rho & 15; return 8 * (i >> 2) + 4 * n + (i & 3); }

typedef int v8i __attribute__((ext_vector_type(8)));
constexpr int F8_WSHIFT = 6, F8_SCALE_W = 127 - F8_WSHIFT;
typedef int v4i __attribute__((ext_vector_type(4)));
__device__ __forceinline__ v8i ld8(const LAS unsigned char* p0, const LAS unsigned char* p1) { const v4i lo = *(const LAS v4i*)p0, hi = *(const LAS v4i*)p1; return __builtin_shufflevector(lo, hi, 0, 1, 2, 3, 4, 5, 6, 7); }
struct Unit { int pm, pn, e, rt; };

__device__ __forceinline__ void flat_to_tile(int L, int nwg, int nM, int nN, int& pm, int& pn) {
    int wgid = L; { const int q = nwg / NXCD, r = nwg % NXCD, xcd = wgid % NXCD, off = wgid / NXCD; wgid = (xcd < r ? xcd * (q + 1) : r * (q + 1) + (xcd - r) * q) + off; }
    const int nig = WGM * nN, gid = wgid / nig, fm = gid * WGM, gsz = (nM - fm) < WGM ? (nM - fm) : WGM;
    pm = fm + ((wgid % nig) % gsz); pn = (wgid % nig) / gsz;
}
struct DenseSched {
    const char* A; const char* Bt; int nM, nN, nwg, G, c; size_t tstep;
    __device__ __forceinline__ void init(const void* A_, const void* Bt_, int M, int N, int K, int G_, int c_) { A = (const char*)A_; Bt = (const char*)Bt_; nM = M / BM; nN = N / BM; nwg = nM * nN; G = G_; c = c_; tstep = (size_t)BM * K * 2; }
    __device__ __forceinline__ bool next(int i, Unit& u) const { const long L = (long)i * G + c; if (L >= nwg) return false; flat_to_tile((int)L, nwg, nM, nN, u.pm, u.pn); u.e = 0; u.rt = u.pm; return true; }
    __device__ __forceinline__ const char* a_base(const Unit& u) const { return A + (size_t)u.pm * tstep; }
    __device__ __forceinline__ const char* b_base(const Unit& u) const { return Bt + (size_t)u.pn * tstep; }
    __device__ __forceinline__ void gather(int, int, int, unsigned (&)[2][2]) const {}
};
struct MoeSched {
    const char* A; const char* Bt; size_t a_tstep, b_estep, b_tstep; int nunits; const LAS unsigned* ulist; const LAS unsigned* gtab; bool gath;
    __device__ __forceinline__ bool next(int i, Unit& u) const {
        if (i >= nunits) return false;
        const unsigned w = (unsigned)__builtin_amdgcn_readfirstlane((int)ulist[i]);
        u.pm = (int)(w & 0x3ffu); u.pn = (int)((w >> 10) & 0x7u); u.e = (int)((w >> 13) & 0x1fu); u.rt = (int)(w >> 18); return true;
    }
    __device__ __forceinline__ const char* a_base(const Unit& u) const { return gath ? A : A + (size_t)u.pm * a_tstep; }
    __device__ __forceinline__ const char* b_base(const Unit& u) const { return Bt + (size_t)u.e * b_estep + (size_t)u.pn * b_tstep; }
    __device__ __forceinline__ void gather(int i, int R0, int R1, unsigned (&off)[2][2]) const {
        const LAS unsigned* g = gtab + i * 256;
        off[0][0] = g[R0]; off[0][1] = g[R1]; off[1][0] = g[128 + R0]; off[1][1] = g[128 + R1];
    }
};

#define PG8_SA(b, h) (((b) * 2 + (h)) * HTB)
#define PG8_SB(b, h) ((4 + (b) * 2 + (h)) * HTB)
#define PG8_GLDS(src, dstoff) __builtin_amdgcn_global_load_lds((const unsigned*)(src), (LAS unsigned*)(lds + (dstoff)), 16, 0, 0)
#define PG8_STAGE_B(bufoff, gbase) do { _Pragma("unroll") for (int _i = 0; _i < 2; ++_i) PG8_GLDS((const char*)(gbase) + voffB[_i], (bufoff) + ldsw + _i * 8192); } while (0)
#define PG8_STAGE_A(bufoff, kptr, h, o) do { _Pragma("unroll") for (int _i = 0; _i < 2; ++_i) \
        PG8_GLDS(GATHER ? (const char*)(kptr) + (o)[h][_i] : (const char*)(kptr) + (size_t)(h) * hstep + voffA[_i], (bufoff) + ldsw + _i * 8192); } while (0)
#define PG8_LDA(dst, b, h) do { _Pragma("unroll") for (int m = 0; m < 4; ++m) { if constexpr (F8) dst##8[m] = ld8(lds + PG8_SA(b, h) + a8_0 + m * 2048, lds + PG8_SA(b, h) + a8_1 + m * 2048); \
        else { _Pragma("unroll") for (int k = 0; k < 2; ++k) dst[m][k] = *(const LAS bf16x8*)(lds + PG8_SA(b, h) + aoff + m * 2048 + k * 1024); } } } while (0)
#define PG8_LDB(dst, b, h) do { _Pragma("unroll") for (int n = 0; n < 2; ++n) { if constexpr (F8) dst##8[n] = ld8(lds + PG8_SB(b, h) + b8_0 + n * 2048, lds + PG8_SB(b, h) + b8_1 + n * 2048); \
        else { _Pragma("unroll") for (int k = 0; k < 2; ++k) dst[n][k] = *(const LAS bf16x8*)(lds + PG8_SB(b, h) + boff + n * 2048 + k * 1024); } } } while (0)
#define PG8_MMA(ai, bj, At, Bt) do { __builtin_amdgcn_s_setprio(1); _Pragma("unroll") for (int m = 0; m < 4; ++m) _Pragma("unroll") for (int n = 0; n < 2; ++n) { \
        if constexpr (F8) asm volatile("v_mfma_scale_f32_16x16x128_f8f6f4 %0, %1, %2, %0, %3, %4 op_sel_hi:[0,0,0]" : "+v"(acc[ai][bj][m][n]) : "v"(Bt##8[n]), "v"(At##8[m]), "v"(sc_w), "v"(sc_a)); \
        else { _Pragma("unroll") for (int k = 0; k < 2; ++k) acc[ai][bj][m][n] = __builtin_amdgcn_mfma_f32_16x16x32_bf16(Bt[n][k], At[m][k], acc[ai][bj][m][n], 0, 0, 0); } } __builtin_amdgcn_s_setprio(0); } while (0)
#define PG8_WAIT_V(n) asm volatile("s_waitcnt vmcnt(" #n ")" ::: "memory")
#define PG8_WAIT_L(n) asm volatile("s_waitcnt lgkmcnt(" #n ")" ::: "memory")
#define PG8_BAR __builtin_amdgcn_s_barrier()
#define PG8_SCHED __builtin_amdgcn_sched_barrier(0)

template <class Epi, class Sched, bool GATHER, bool MIDK, bool F8 = false>
__device__ __forceinline__ void gemm_phase(LAS unsigned char* lds, const int KB  , const Sched& S, const Epi& E) {
    int tid = (int)threadIdx.x; asm volatile("" : "+v"(tid));
    const int wid = __builtin_amdgcn_readfirstlane(tid >> 6), lane = tid & 63, wr = wid >> 2, wc = wid & 3, fr = lane & 15, fq = lane >> 4;
    const int nt = KB / 128;
    unsigned voffA[2], voffB[2]; int Rg[2]; unsigned Cg[2];
#pragma unroll
    for (int i = 0; i < 2; ++i) { int R, C; stage_rc(tid * 16 + i * 8192, R, C); const int Rb = Epi::PERM ? ((R & ~31) + perm32(R & 31)) : R;
        voffA[i] = (unsigned)(R * KB + C * 2); voffB[i] = (unsigned)(Rb * KB + C * 2); Rg[i] = R; Cg[i] = (unsigned)C * 2u; }
    const size_t kstep = 128;
    const size_t hstep = (size_t)HALF * KB;
    const unsigned ldsw = (unsigned)wid * 1024u;
    const int aoff = lds_byte(wr * 64 + fr, fq * 8), boff = lds_byte(wc * 32 + fr, fq * 8);
    const int a8_0 = lds_byte(wr * 64 + fr, 16 * fq), a8_1 = lds_byte(wr * 64 + fr, 16 * fq + 8), b8_0 = lds_byte(wc * 32 + fr, 16 * fq), b8_1 = lds_byte(wc * 32 + fr, 16 * fq + 8);
    Unit cur, nxt; int ui = 0;
    if (!S.next(0, cur)) return;
    f32x4 acc[2][2][4][2];
#pragma unroll
    for (int a = 0; a < 2; ++a)
#pragma unroll
        for (int b = 0; b < 2; ++b)
#pragma unroll
            for (int m = 0; m < 4; ++m)
#pragma unroll
                for (int n = 0; n < 2; ++n) acc[a][b][m][n] = (f32x4){0.f, 0.f, 0.f, 0.f};
    bf16x8 At[4][2], B0[2][2], B1[2][2]; v8i At8[4], B08[2], B18[2];
    int sc_w = F8_SCALE_W, sc_a = 127; if constexpr (F8) { asm volatile("" : "+v"(sc_w), "+v"(sc_a)); }
    unsigned offC[2][2] = {{0u, 0u}, {0u, 0u}}, offN[2][2] = {{0u, 0u}, {0u, 0u}};
    if constexpr (GATHER) { S.gather(0, Rg[0], Rg[1], offC);
#pragma unroll
        for (int h = 0; h < 2; ++h)
#pragma unroll
            for (int i = 0; i < 2; ++i) offC[h][i] += Cg[i]; }
    const char* cA = S.a_base(cur); const char* cB = S.b_base(cur);
    PG8_STAGE_B(PG8_SB(0, 0), cB); PG8_STAGE_B(PG8_SB(0, 1), cB + hstep); PG8_STAGE_A(PG8_SA(0, 0), cA, 0, offC); PG8_STAGE_A(PG8_SA(0, 1), cA, 1, offC);
    if (wr == 1) PG8_BAR;
    PG8_WAIT_V(2); PG8_BAR;
    PG8_STAGE_B(PG8_SB(1, 0), cB + kstep); PG8_STAGE_A(PG8_SA(1, 0), cA + kstep, 0, offC); PG8_STAGE_B(PG8_SB(1, 1), cB + hstep + kstep);
    PG8_WAIT_V(6); PG8_BAR;
    for (;;) {
        const bool has_next = S.next(ui + 1, nxt);
        const char* nA = has_next ? S.a_base(nxt) : cA; const char* nB = has_next ? S.b_base(nxt) : cB;
        if constexpr (GATHER) { if (has_next) { S.gather(ui + 1, Rg[0], Rg[1], offN);
#pragma unroll
                for (int h = 0; h < 2; ++h)
#pragma unroll
                    for (int i = 0; i < 2; ++i) offN[h][i] += Cg[i]; }
            else {
#pragma unroll
                for (int h = 0; h < 2; ++h)
#pragma unroll
                    for (int i = 0; i < 2; ++i) offN[h][i] = offC[h][i]; } }
        for (int t = 0; t < nt; t += 2) {
            const bool last = (t == nt - 2);
            const char* a1 = cA + (size_t)(t + 1) * kstep;
            const char* a2 = last ? nA : cA + (size_t)(t + 2) * kstep; const char* b2 = last ? nB : cB + (size_t)(t + 2) * kstep;
            const char* a3 = a2 + kstep; const char* b3 = b2 + kstep;
            unsigned o2[2][2];
#pragma unroll
            for (int h = 0; h < 2; ++h)
#pragma unroll
                for (int i = 0; i < 2; ++i) o2[h][i] = last ? offN[h][i] : offC[h][i];
            if constexpr (MIDK) { if (t == nt / 2) E.midk(acc, cur, wr, fr); }
            PG8_LDB(B0, 0, 0); PG8_LDB(B1, 0, 1); PG8_SCHED; PG8_LDA(At, 0, 0); PG8_STAGE_A(PG8_SA(1, 1), a1, 1, offC);
            PG8_WAIT_V(8); PG8_WAIT_L(0); PG8_BAR; PG8_MMA(0, 0, At, B0); PG8_MMA(0, 1, At, B1); PG8_BAR; PG8_SCHED;
            PG8_LDA(At, 0, 1); PG8_STAGE_B(PG8_SB(0, 0), b2); PG8_STAGE_B(PG8_SB(0, 1), b2 + hstep); PG8_STAGE_A(PG8_SA(0, 0), a2, 0, o2);
            PG8_WAIT_V(8); PG8_WAIT_L(0); PG8_BAR; PG8_MMA(1, 0, At, B0); PG8_MMA(1, 1, At, B1); PG8_BAR; PG8_SCHED;
            PG8_LDB(B0, 1, 0); PG8_LDB(B1, 1, 1); PG8_SCHED; PG8_LDA(At, 1, 0); PG8_STAGE_A(PG8_SA(0, 1), a2, 1, o2);
            PG8_WAIT_V(8); PG8_WAIT_L(0); PG8_BAR; PG8_MMA(0, 0, At, B0); PG8_MMA(0, 1, At, B1); PG8_BAR; PG8_SCHED;
            PG8_LDA(At, 1, 1); PG8_STAGE_B(PG8_SB(1, 0), b3); PG8_STAGE_B(PG8_SB(1, 1), b3 + hstep); PG8_STAGE_A(PG8_SA(1, 0), a3, 0, o2);
            PG8_WAIT_V(8); PG8_WAIT_L(0); PG8_BAR; PG8_MMA(1, 0, At, B0); PG8_MMA(1, 1, At, B1); PG8_BAR; PG8_SCHED;
        }
        if (wr == 0) PG8_BAR;
        if constexpr (F8) asm volatile("s_nop 15\n\ts_nop 15" ::: "memory");
        E(acc, cur, wr, wc, fr, fq);
        if (!has_next) break;
#pragma unroll
        for (int a = 0; a < 2; ++a)
#pragma unroll
            for (int b = 0; b < 2; ++b)
#pragma unroll
                for (int m = 0; m < 4; ++m)
#pragma unroll
                    for (int n = 0; n < 2; ++n) acc[a][b][m][n] = (f32x4){0.f, 0.f, 0.f, 0.f};
        cur = nxt; cA = nA; cB = nB; ++ui;
        if constexpr (GATHER) {
#pragma unroll
            for (int h = 0; h < 2; ++h)
#pragma unroll
                for (int i = 0; i < 2; ++i) offC[h][i] = offN[h][i]; }
        if (wr == 1) PG8_BAR;
    }
    PG8_WAIT_V(0);
    PG8_BAR;
}
}

struct Frame {
    LAS unsigned char* lds;
    volatile LAS unsigned* MISC;
    gu32* ctl;
    unsigned char* ws;
    int vcu, G;
    const float *x, *p, *mix_norm, *w_in, *ln_g, *ln_b, *gws, *gbs, *aon, *gon, *w_out, *ffn_norm, *router_w, *router_b, *w_gu, *b_gu, *w_dn, *b_dn, *ple_norm, *w_pg, *w_pp, *ppn, *final_norm;
    float* out;
};
template <class T_> __device__ __forceinline__ T_* wsp(const Frame& F, size_t off) { return (T_*)(F.ws + off); }

#define PHASE_IDS int TID_ = (int)threadIdx.x; asm volatile("" : "+v"(TID_)); const int LANE_ = TID_ & 63; const int WAVE_ = __builtin_amdgcn_readfirstlane(TID_ >> 6); (void)LANE_; (void)WAVE_
template <class ColMap>
__device__ __forceinline__ void p0_transpose_item(const float* W, int K, int N, bf16* WT, const float* gain, LAS float* scr, int item, int lane, int nphys, const ColMap& cm) {
    const int nblk = nphys / 64, kb = item / nblk, nb = item % nblk, k0 = 64 * kb, n0 = 64 * nb;
    const int srccol = cm(n0 + lane);
    float v_[64]; const float* src = W + (size_t)k0 * N + srccol;
#pragma unroll
    for (int kk = 0; kk < 64; ++kk) v_[kk] = __builtin_nontemporal_load(src + (size_t)kk * N);
    if (gain) {
#pragma unroll
        for (int kk = 0; kk < 64; kk += 4) { const f32x4 g4 = *(const f32x4*)(gain + k0 + kk); v_[kk] *= g4[0]; v_[kk + 1] *= g4[1]; v_[kk + 2] *= g4[2]; v_[kk + 3] *= g4[3]; } }
#pragma unroll
    for (int kk = 0; kk < 64; ++kk) scr[kk * 65 + lane] = v_[kk];
    LDS_WAIT(); asm volatile("" ::: "memory");
    const int c = lane & 7;
#pragma unroll
    for (int j = 0; j < 8; ++j) { const int n = (lane >> 3) + 8 * j; const LAS float* s = scr + (8 * c) * 65 + n;
        v4u o; o.x = pk2(s[0 * 65], s[1 * 65]); o.y = pk2(s[2 * 65], s[3 * 65]); o.z = pk2(s[4 * 65], s[5 * 65]); o.w = pk2(s[6 * 65], s[7 * 65]);
        *(GAS v4u*)(WT + (size_t)(n0 + n) * K + k0 + 8 * c) = o; }
    LDS_WAIT(); asm volatile("" ::: "memory");
}
template <class ColMap>
__device__ __forceinline__ void p0_transpose_item_f8(const float* W, int K, int N, unsigned char* WT, const float* gain, LAS float* scr, int item, int lane, int nphys, const ColMap& cm) {
    const int nblk = nphys / 64, kb = item / nblk, nb = item % nblk, k0 = 64 * kb, n0 = 64 * nb;
    const int srccol = cm(n0 + lane);
    float v_[64]; const float* src = W + (size_t)k0 * N + srccol;
#pragma unroll
    for (int kk = 0; kk < 64; ++kk) v_[kk] = __builtin_nontemporal_load(src + (size_t)kk * N);
    constexpr float WS_ = (float)(1 << pg8::F8_WSHIFT);
#pragma unroll
    for (int kk = 0; kk < 64; kk += 4) { f32x4 g4 = gain ? *(const f32x4*)(gain + k0 + kk) : (f32x4){1.f, 1.f, 1.f, 1.f}; v_[kk] *= g4[0] * WS_; v_[kk + 1] *= g4[1] * WS_; v_[kk + 2] *= g4[2] * WS_; v_[kk + 3] *= g4[3] * WS_; }
#pragma unroll
    for (int kk = 0; kk < 64; ++kk) scr[kk * 65 + lane] = v_[kk];
    LDS_WAIT(); asm volatile("" ::: "memory");
    const int c = lane & 3;
#pragma unroll
    for (int j = 0; j < 4; ++j) { const int n = (lane >> 2) + 16 * j; const LAS float* s_ = scr + (16 * c) * 65 + n;
        v4u o; o.x = pk4_fp8(s_[0 * 65], s_[1 * 65], s_[2 * 65], s_[3 * 65]); o.y = pk4_fp8(s_[4 * 65], s_[5 * 65], s_[6 * 65], s_[7 * 65]);
        o.z = pk4_fp8(s_[8 * 65], s_[9 * 65], s_[10 * 65], s_[11 * 65]); o.w = pk4_fp8(s_[12 * 65], s_[13 * 65], s_[14 * 65], s_[15 * 65]);
        *(GAS v4u*)(WT + (size_t)(n0 + n) * K + k0 + 16 * c) = o; }
    LDS_WAIT(); asm volatile("" ::: "memory");
}
struct CmId { __device__ __forceinline__ int operator()(int n) const { return n; } };
struct CmWin { __device__ __forceinline__ int operator()(int n) const { if (n >= 2 * AW) return n; const int c = n & 63; return (n & ~63) + 4 * (c >> 3) + (c & 3) + 32 * ((c >> 2) & 1); } };
struct CmWgu { __device__ __forceinline__ int operator()(int n) const { return ((n >> 7) & 1) * FF + (n >> 8) * 128 + (n & 127); } };

__device__ __forceinline__ void p0_prologue(Frame& F) {
    PHASE_IDS;
    LAS float* scr = (LAS float*)(F.lds + RING_OFF + WAVE_ * P0_SCR_WAVE);
    const int gw = F.vcu * NWAVES + WAVE_, NGW = F.G * NWAVES;
    constexpr int I_GU = (DM / 64) * (2 * FF / 64), I_DN = (FF / 64) * (DM / 64), I_IN = (DM / 64) * (NPROJ / 64), I_SQ = (DM / 64) * (DM / 64), I_PP = (PLE / 64) * (DM / 64);
    constexpr int NITEMS = NE * I_GU + NE * I_DN + I_IN + 2 * I_SQ + I_PP;
    unsigned char* WGU = wsp<unsigned char>(F, WS_WGU); unsigned char* WDN = wsp<unsigned char>(F, WS_WDN);
    for (int it = gw; it < NITEMS; it += NGW) {
        int r = it;
        if (r < NE * I_GU) { const int e = r / I_GU; p0_transpose_item_f8(F.w_gu + (size_t)e * DM * 2 * FF, DM, 2 * FF, WGU + (size_t)e * 2 * FF * DM, F.ffn_norm, scr, r % I_GU, LANE_, 2 * FF, CmWgu()); continue; } r -= NE * I_GU;
        if (r < NE * I_DN) { const int e = r / I_DN; p0_transpose_item_f8(F.w_dn + (size_t)e * FF * DM, FF, DM, WDN + (size_t)e * DM * FF, nullptr, scr, r % I_DN, LANE_, DM, CmId()); continue; } r -= NE * I_DN;
        if (r < I_IN) { p0_transpose_item(F.w_in, DM, NPROJ, wsp<bf16>(F, WS_WIN), F.mix_norm, scr, r, LANE_, NPROJ, CmWin()); continue; } r -= I_IN;
        if (r < I_SQ) {
            const int nblk = DM / 64, kb = r / nblk; const float* g = (kb < 8) ? F.aon : (F.gon - AW);
            p0_transpose_item(F.w_out, DM, DM, wsp<bf16>(F, WS_WOUT), g, scr, r, LANE_, DM, CmId()); continue; } r -= I_SQ;
        if (r < I_SQ) { p0_transpose_item(F.w_pg, DM, DM, wsp<bf16>(F, WS_WPG), F.ple_norm, scr, r, LANE_, DM, CmId()); continue; } r -= I_SQ;
        p0_transpose_item(F.w_pp, PLE, DM, wsp<bf16>(F, WS_WPP), nullptr, scr, r, LANE_, DM, CmId());
    }
    bf16* XN = wsp<bf16>(F, WS_XNB);
    for (int m = gw; m < T; m += NGW) {
        const GAS f32x4* xr = (const GAS f32x4*)(F.x + (size_t)m * DM) + LANE_;
        f32x4 v[4]; float s = 0.f;
#pragma unroll
        for (int j = 0; j < 4; ++j) { v[j] = xr[64 * j]; s += (v[j].x * v[j].x + v[j].y * v[j].y) + (v[j].z * v[j].z + v[j].w * v[j].w); }
        const float rstd = 1.0f / sqrtf(wave_sum(s) * (1.f / DM) + EPS);
        GAS v2u* o8 = (GAS v2u*)(XN + (size_t)m * DM) + LANE_;
#pragma unroll
        for (int j = 0; j < 4; ++j) { v2u w; w.x = pk2(v[j].x * rstd, v[j].y * rstd); w.y = pk2(v[j].z * rstd, v[j].w * rstd); o8[64 * j] = w; }
    }
    { const GAS f32x4* pr = (const GAS f32x4*)F.p; GAS v2u* po = (GAS v2u*)wsp<bf16>(F, WS_PB);
      const size_t n4 = (size_t)T * PLE / 4, gt = (size_t)(F.vcu * NTHR + TID_), GT = (size_t)F.G * NTHR;
      for (size_t i = gt; i < n4; i += GT) { const f32x4 v = pr[i]; v2u w; w.x = pk2(v.x, v.y); w.y = pk2(v.z, v.w); po[i] = w; } }
    { const int gt = F.vcu * NTHR + TID_, GT = F.G * NTHR; float* RWG = wsp<float>(F, WS_RWG);
      for (int i = gt; i < DM * NE; i += GT) RWG[i] = F.router_w[i] * F.ffn_norm[i / NE];
      float* RC = wsp<float>(F, WS_ROPE); float* RS = RC + SEQ * 32;
      for (int i = gt; i < SEQ * 32; i += GT) { const int pos = i >> 5, j = i & 31; const float inv = powf(10000.0f, -(float)j / 32.0f); const float ang = (float)pos * inv; float sn, cs; sincosf(ang, &sn, &cs); RC[i] = cs; RS[i] = sn; } }
}

using pg8::Unit;
constexpr int HALF = 128;
struct EpiInProj {
    static constexpr bool PERM = true;
    bf16* QKVUV; const float *rc, *rs; float* kmean;
    __device__ __forceinline__ void operator()(const f32x4 (&acc)[2][2][4][2], const Unit& u, int wr, int wc, int fr, int fq) const {
        const int type = u.pn >> 1, colt = (u.pn & 1) * 256 + wc * 32 + 8 * fq;
        const int row0 = u.pm * 256 + wr * 64 + fr;
        if (type <= 1) {
            bf16* dst = QKVUV + (size_t)type * (16u << 20);
            const int pos0 = (u.pm & 7) * 256 + wr * 64 + fr, i0 = 16 * (wc & 1) + 4 * fq;
            f32x4 cs_[2][2];
#pragma unroll
            for (int bj = 0; bj < 2; ++bj) { cs_[bj][0] = (f32x4){0.f, 0.f, 0.f, 0.f}; cs_[bj][1] = (f32x4){0.f, 0.f, 0.f, 0.f}; }
#pragma unroll
            for (int ai = 0; ai < 2; ++ai)
#pragma unroll
                for (int m = 0; m < 4; ++m) { const int ro = ai * HALF + m * 16; const int pos = pos0 + ro;
                    const f32x4 c = *(const f32x4*)(rc + pos * 32 + i0), s = *(const f32x4*)(rs + pos * 32 + i0);
                    bf16* rowp = dst + (size_t)(row0 + ro) * AW + colt;
#pragma unroll
                    for (int bj = 0; bj < 2; ++bj) { const f32x4 x1 = acc[ai][bj][m][0], x2 = acc[ai][bj][m][1];
                        const f32x4 o1 = x1 * c - x2 * s, o2 = x2 * c + x1 * s;
                        cs_[bj][0] += o1; cs_[bj][1] += o2;
                        v4u w; w.x = cvt_pk_bf16(o1[0], o1[1]); w.y = cvt_pk_bf16(o1[2], o1[3]); w.z = cvt_pk_bf16(o2[0], o2[1]); w.w = cvt_pk_bf16(o2[2], o2[3]);
                        *(v4u*)(rowp + bj * HALF) = w; } }
            if (type == 1) {
#pragma unroll
                for (int bj = 0; bj < 2; ++bj)
#pragma unroll
                    for (int n = 0; n < 2; ++n)
#pragma unroll
                        for (int j = 0; j < 4; ++j) { float v = cs_[bj][n][j]; v += __shfl_xor(v, 1); v += __shfl_xor(v, 2); v += __shfl_xor(v, 4); v += __shfl_xor(v, 8); cs_[bj][n][j] = v; }
                if (fr == 0) { const int b = u.pm >> 3, blk = u.pm & 7;
#pragma unroll
                    for (int bj = 0; bj < 2; ++bj) { const int colh = (u.pn & 1) * 256 + bj * HALF + wc * 32; const int head = colh >> 6, cpos = (colh & 63) + 8 * fq;
                        float* km = kmean + ((size_t)((b * NH + head) * NBLK + blk)) * HD + cpos;
#pragma unroll
                        for (int n = 0; n < 2; ++n)
#pragma unroll
                            for (int j = 0; j < 4; ++j) atomicAdd(km + 4 * n + j, cs_[bj][n][j]); } }
            }
        } else {
            bf16* dst = QKVUV + (size_t)type * (16u << 20);
#pragma unroll
            for (int ai = 0; ai < 2; ++ai)
#pragma unroll
                for (int m = 0; m < 4; ++m) { bf16* rowp = dst + (size_t)(row0 + ai * HALF + m * 16) * AW + colt;
#pragma unroll
                    for (int bj = 0; bj < 2; ++bj) { f32x4 v0 = acc[ai][bj][m][0], v1 = acc[ai][bj][m][1];
                        if (type >= 3) { v0 = gelu4(v0); v1 = gelu4(v1); }
                        v4u w; w.x = cvt_pk_bf16(v0[0], v0[1]); w.y = cvt_pk_bf16(v0[2], v0[3]); w.z = cvt_pk_bf16(v1[0], v1[1]); w.w = cvt_pk_bf16(v1[2], v1[3]);
                        *(v4u*)(rowp + bj * HALF) = w; } }
        }
    }
};
struct EpiOutProj {
    static constexpr bool PERM = false;
    const float* x; float* x1; float* ssq1; const LAS f32x2* rtab;
    const LAS int* slot_of;
    int pm_a, pm_b;
    __device__ __forceinline__ int slot(const Unit& u) const { return u.pm == pm_a ? 0 : 1; }
    __device__ __forceinline__ void midk(f32x4 (&acc)[2][2][4][2], const Unit& u, int wr, int fr) const {
        const LAS f32x2* t = rtab + slot(u) * 256 + wr * 64 + fr;
#pragma unroll
        for (int ai = 0; ai < 2; ++ai)
#pragma unroll
            for (int m = 0; m < 4; ++m) { const float r = t[ai * HALF + m * 16].x;
#pragma unroll
                for (int bj = 0; bj < 2; ++bj)
#pragma unroll
                    for (int n = 0; n < 2; ++n) acc[ai][bj][m][n] *= r; }
    }
    __device__ __forceinline__ void operator()(const f32x4 (&acc)[2][2][4][2], const Unit& u, int wr, int wc, int fr, int fq) const {
        const LAS f32x2* t = rtab + slot(u) * 256 + wr * 64 + fr;
        const int row0 = u.pm * 256 + wr * 64 + fr, col0 = u.pn * 256 + wc * 32 + 4 * fq;
#pragma unroll
        for (int ai = 0; ai < 2; ++ai)
#pragma unroll
            for (int m = 0; m < 4; ++m) { const int ro = ai * HALF + m * 16; const float rg = t[ro].y; const size_t off = (size_t)(row0 + ro) * DM + col0; float q = 0.f;
#pragma unroll
                for (int bj = 0; bj < 2; ++bj)
#pragma unroll
                    for (int n = 0; n < 2; ++n) { const f32x4 bs = *(const f32x4*)(x + off + bj * HALF + n * 16); const f32x4 o = bs + acc[ai][bj][m][n] * rg;
                        q += (o[0] * o[0] + o[1] * o[1]) + (o[2] * o[2] + o[3] * o[3]); *(f32x4*)(x1 + off + bj * HALF + n * 16) = o; }
                q += __shfl_xor(q, 16); q += __shfl_xor(q, 32);
                if (fq == 0) ssq1[(size_t)(row0 + ro) * 16 + u.pn * 4 + wc] = q; }
    }
};
struct EpiMoe1 {
    static constexpr bool PERM = true;
    unsigned char* A; const float* b_gu;
    __device__ __forceinline__ void operator()(const f32x4 (&acc)[2][2][4][2], const Unit& u, int wr, int wc, int fr, int fq) const {
        const int row0 = u.pm * 256 + wr * 64 + fr, col = u.pn * 128 + wc * 32 + 8 * fq;
        const float* bg = b_gu + (size_t)u.e * 2 * FF + col;
        f32x4 bgv[2], blv[2];
#pragma unroll
        for (int n = 0; n < 2; ++n) { bgv[n] = *(const f32x4*)(bg + 4 * n); blv[n] = *(const f32x4*)(bg + FF + 4 * n); }
#pragma unroll
        for (int ai = 0; ai < 2; ++ai)
#pragma unroll
            for (int m = 0; m < 4; ++m) { f32x4 a[2];
#pragma unroll
                for (int n = 0; n < 2; ++n) { const f32x4 g = acc[ai][0][m][n] + bgv[n], l = acc[ai][1][m][n] + blv[n];
#pragma unroll
                    for (int j = 0; j < 4; ++j) { const float gc = fminf(g[j], 7.0f), lc = fminf(fmaxf(l[j], -7.0f), 7.0f); a[n][j] = gc * sigmoidf_fast(1.702f * gc) * (lc + 1.0f); } }
                v2u w; w.x = pk4_fp8(a[0][0], a[0][1], a[0][2], a[0][3]); w.y = pk4_fp8(a[1][0], a[1][1], a[1][2], a[1][3]);
                *(v2u*)(A + (size_t)(row0 + ai * HALF + m * 16) * FF + col) = w; }
    }
};
struct EpiMoe2 {
    static constexpr bool PERM = true;
    bf16* Y; const float* b_dn; const float* gss;
    __device__ __forceinline__ void operator()(const f32x4 (&acc)[2][2][4][2], const Unit& u, int wr, int wc, int fr, int fq) const {
        const int row0 = u.pm * 256 + wr * 64 + fr, col0 = u.pn * 256 + wc * 32 + 8 * fq;
        const float* gs = gss + (size_t)u.e * T + u.rt * 256 + wr * 64 + fr;
        f32x4 bv[2][2];
#pragma unroll
        for (int bj = 0; bj < 2; ++bj)
#pragma unroll
            for (int n = 0; n < 2; ++n) bv[bj][n] = *(const f32x4*)(b_dn + (size_t)u.e * DM + col0 + bj * HALF + 4 * n);
#pragma unroll
        for (int ai = 0; ai < 2; ++ai)
#pragma unroll
            for (int m = 0; m < 4; ++m) { const float g = gs[ai * HALF + m * 16]; bf16* rowp = Y + (size_t)(row0 + ai * HALF + m * 16) * DM + col0;
#pragma unroll
                for (int bj = 0; bj < 2; ++bj) { const f32x4 v0 = (acc[ai][bj][m][0] + bv[bj][0]) * g, v1 = (acc[ai][bj][m][1] + bv[bj][1]) * g;
                    v4u w; w.x = cvt_pk_bf16(v0[0], v0[1]); w.y = cvt_pk_bf16(v0[2], v0[3]); w.z = cvt_pk_bf16(v1[0], v1[1]); w.w = cvt_pk_bf16(v1[2], v1[3]);
                    *(v4u*)(rowp + bj * HALF) = w; } }
    }
};
template <int MODE> struct EpiPle {
    static constexpr bool PERM = true;
    bf16* O; float* ssq;
    __device__ __forceinline__ void operator()(const f32x4 (&acc)[2][2][4][2], const Unit& u, int wr, int wc, int fr, int fq) const {
        const int row0 = u.pm * 256 + wr * 64 + fr, col0 = u.pn * 256 + wc * 32 + 8 * fq;
#pragma unroll
        for (int ai = 0; ai < 2; ++ai)
#pragma unroll
            for (int m = 0; m < 4; ++m) { bf16* rowp = O + (size_t)(row0 + ai * HALF + m * 16) * DM + col0; float q = 0.f;
#pragma unroll
                for (int bj = 0; bj < 2; ++bj) { f32x4 v0 = acc[ai][bj][m][0], v1 = acc[ai][bj][m][1];
                    if (MODE == 0) {
#pragma unroll
                        for (int j = 0; j < 4; ++j) { v0[j] = sigmoidf_fast(v0[j]); v1[j] = sigmoidf_fast(v1[j]); } }
                    else { q += (v0[0] * v0[0] + v0[1] * v0[1]) + (v0[2] * v0[2] + v0[3] * v0[3]) + (v1[0] * v1[0] + v1[1] * v1[1]) + (v1[2] * v1[2] + v1[3] * v1[3]); }
                    v4u w; w.x = cvt_pk_bf16(v0[0], v0[1]); w.y = cvt_pk_bf16(v0[2], v0[3]); w.z = cvt_pk_bf16(v1[0], v1[1]); w.w = cvt_pk_bf16(v1[2], v1[3]);
                    *(v4u*)(rowp + bj * HALF) = w; }
                if (MODE == 1) { q += __shfl_xor(q, 16); q += __shfl_xor(q, 32); if (fq == 0) ssq[(size_t)(row0 + ai * HALF + m * 16) * 16 + u.pn * 4 + wc] = q; } }
    }
};

namespace att {
constexpr int QBLK = 32, KVBLK = 64;
constexpr float SCALE = 0.125f, THR = 8.f;
constexpr int SHM_V = KVBLK * HD * 2, SHM_K = SHM_V;
constexpr int LDS_BYTES_ = 2 * SHM_V + 2 * SHM_K + NWAVES * 64 * 4;
#define ATT_KSWZ(row, colB) ((row) * 128 + ((colB) ^ (((row) & 7) << 4)))
#define ATT_SBAR() __builtin_amdgcn_sched_barrier(0)
__device__ __forceinline__ int crow(int r, int hi) { return (r & 3) + 8 * (r >> 2) + 4 * hi; }
__device__ __forceinline__ void cmask(f32x16& p0, f32x16& p1, int jb, int qrel, int hi) {
    const float NEG = -__builtin_inff(); const int kb = 64 * jb + 4 * hi;
#pragma unroll
    for (int r = 0; r < 16; ++r) { const int kv = kb + (r & 3) + 8 * (r >> 2); if (kv > qrel) p0[r] = NEG; if (kv + 32 > qrel) p1[r] = NEG; }
}
__device__ __forceinline__ void bmask(f32x16& p0, f32x16& p1, bool keep) {
    const float NEG = -__builtin_inff();
    if (!keep) {
#pragma unroll
        for (int r = 0; r < 16; ++r) { p0[r] = NEG; p1[r] = NEG; } }
}
__device__ __forceinline__ void partialSM(f32x16& p0, f32x16& p1, float& m_reg, float& mn, float& alpha, bool keep) {
    float pmax = p0[0];
#pragma unroll
    for (int r = 1; r < 16; ++r) pmax = fmaxf(pmax, p0[r]);
#pragma unroll
    for (int r = 0; r < 16; ++r) pmax = fmaxf(pmax, p1[r]);
    { auto rr = __builtin_amdgcn_permlane32_swap(__float_as_uint(pmax), __float_as_uint(pmax), false, false);
      pmax = fmaxf(__uint_as_float(rr[0]), __uint_as_float(rr[1])); }
    if (!keep) pmax = -__builtin_inff();
    constexpr float C2 = 1.4426950408889634f * SCALE;
    if (__builtin_expect(__all((pmax - m_reg) * SCALE <= THR), 1)) { mn = m_reg; alpha = 1.f; }
    else { mn = fmaxf(m_reg, pmax); alpha = __builtin_amdgcn_exp2f((m_reg - mn) * C2); m_reg = mn; }
    const float mnL = keep ? -mn * C2 : -__builtin_inff(), c2 = keep ? C2 : 0.f;
#pragma unroll
    for (int r = 0; r < 16; ++r) p0[r] = fmaf(p0[r], c2, mnL);
#pragma unroll
    for (int r = 0; r < 16; ++r) p1[r] = fmaf(p1[r], c2, mnL);
#pragma unroll
    for (int r = 0; r < 16; ++r) p0[r] = __builtin_amdgcn_exp2f(p0[r]);
}
__device__ __forceinline__ void finishSM(f32x16& p0, f32x16& p1, float alpha, float& l_reg, bf16x8& pa0, bf16x8& pa1, bf16x8& pa2, bf16x8& pa3) {
#pragma unroll
    for (int r = 0; r < 16; ++r) p1[r] = __builtin_amdgcn_exp2f(p1[r]);
    float ps = 0;
#pragma unroll
    for (int r = 0; r < 16; ++r) ps += p0[r];
#pragma unroll
    for (int r = 0; r < 16; ++r) ps += p1[r];
    { auto rr = __builtin_amdgcn_permlane32_swap(__float_as_uint(ps), __float_as_uint(ps), false, false);
      ps = __uint_as_float(rr[0]) + __uint_as_float(rr[1]); }
    l_reg = l_reg * alpha + ps;
#define ATT_PK4(P, B, OUT) do { unsigned a0 = cvt_pk_bf16(P[B+0], P[B+1]), a1 = cvt_pk_bf16(P[B+2], P[B+3]);             \
        unsigned b0 = cvt_pk_bf16(P[B+4], P[B+5]), b1 = cvt_pk_bf16(P[B+6], P[B+7]);                                       \
        auto r0 = __builtin_amdgcn_permlane32_swap(a0, b0, false, false); auto r1 = __builtin_amdgcn_permlane32_swap(a1, b1, false, false); \
        v4u w = {r0[0], r1[0], r0[1], r1[1]}; OUT = *reinterpret_cast<bf16x8*>(&w); } while (0)
    ATT_PK4(p0, 0, pa0); ATT_PK4(p0, 8, pa1); ATT_PK4(p1, 0, pa2); ATT_PK4(p1, 8, pa3);
#undef ATT_PK4
}
__device__ __forceinline__ void qkt(f32x16& p0, f32x16& p1, const LAS unsigned char* Ks, const bf16x8* qr, int r32, int hi) {
    p0 = f32x16{}; p1 = f32x16{};
#pragma unroll
    for (int d0 = 0; d0 < 4; ++d0) { const int cb = (d0 * 16 + hi * 8) * 2;
        const bf16x8 b0 = *(const LAS bf16x8*)(Ks + ATT_KSWZ(r32, cb));
        const bf16x8 b1 = *(const LAS bf16x8*)(Ks + ATT_KSWZ(32 + r32, cb));
        p0 = __builtin_amdgcn_mfma_f32_32x32x16_bf16(b0, qr[d0], p0, 0, 0, 0);
        p1 = __builtin_amdgcn_mfma_f32_32x32x16_bf16(b1, qr[d0], p1, 0, 0, 0); }
}
__device__ __forceinline__ void pv(f32x16* o, int vb, bf16x8 pa0, bf16x8 pa1, bf16x8 pa2, bf16x8 pa3) {
#pragma unroll
    for (int d0 = 0; d0 < 2; ++d0) { s16x4 lo[4], hi[4];
#pragma unroll
        for (int ks = 0; ks < 4; ++ks) { const int a = vb + d0 * 2048 + (ks >> 1) * 4096 + (ks & 1) * 512;
            asm volatile("ds_read_b64_tr_b16 %0,%1" : "=&v"(lo[ks]) : "v"(a) : "memory");
            asm volatile("ds_read_b64_tr_b16 %0,%1 offset:128" : "=&v"(hi[ks]) : "v"(a) : "memory"); }
        asm volatile("s_waitcnt lgkmcnt(0)" ::: "memory"); ATT_SBAR();
#define ATT_PK(k) (bf16x8){lo[k][0], lo[k][1], lo[k][2], lo[k][3], hi[k][0], hi[k][1], hi[k][2], hi[k][3]}
        o[d0] = __builtin_amdgcn_mfma_f32_32x32x16_bf16(pa0, ATT_PK(0), o[d0], 0, 0, 0);
        o[d0] = __builtin_amdgcn_mfma_f32_32x32x16_bf16(pa1, ATT_PK(1), o[d0], 0, 0, 0);
        o[d0] = __builtin_amdgcn_mfma_f32_32x32x16_bf16(pa2, ATT_PK(2), o[d0], 0, 0, 0);
        o[d0] = __builtin_amdgcn_mfma_f32_32x32x16_bf16(pa3, ATT_PK(3), o[d0], 0, 0, 0);
#undef ATT_PK
    }
}
__device__ __forceinline__ void attn_unit(const Frame& F, int b, int h, int qb, LAS unsigned char* scratch) {
    PHASE_IDS;
    const int tid = TID_, wid = tid >> 6, lane = tid & 63, r32 = lane & 31, hi = lane >> 5;
    const bf16* Qg = wsp<bf16>(F, WS_Q); const bf16* Kg = wsp<bf16>(F, WS_K); const bf16* Vg = wsp<bf16>(F, WS_V);
    const size_t rowbase = (size_t)b * SEQ; const int q0 = qb * MOBA;
    const bf16* Qw = Qg + (rowbase + q0 + wid * QBLK) * AW + h * HD;
    const bf16* Kh = Kg + rowbase * AW + h * HD; const bf16* Vh = Vg + rowbase * AW + h * HD;
    LAS unsigned char* V_lds = scratch; LAS unsigned char* K_lds = scratch + 2 * SHM_V;
    LAS float* wsf = (LAS float*)(scratch + 2 * SHM_V + 2 * SHM_K) + wid * 64; LAS float* li_l = wsf; LAS float* al_l = wsf + 32;
    float m_reg = -1e30f, l_reg = 0.f; f32x16 o[2]; o[0] = f32x16{}; o[1] = f32x16{}; bf16x8 qr[4];
#pragma unroll
    for (int d0 = 0; d0 < 4; ++d0) qr[d0] = *(const bf16x8*)(Qw + (size_t)r32 * AW + d0 * 16 + hi * 8);
    unsigned sel = 0u;
    if (qb <= 3) sel = (1u << qb) - 1u;
    else {
        const float* km = wsp<float>(F, WS_KMEAN) + (size_t)((b * NH + h) * NBLK) * HD + hi * 8;
        float b0 = -__builtin_inff(), b1 = b0, b2 = b0; int i0 = 0, i1 = 0, i2 = 0;
#pragma unroll 1
        for (int j = 0; j < qb; ++j) { float s = 0.f;
#pragma unroll
            for (int d0 = 0; d0 < 4; ++d0) { const f32x4 k0 = *(const f32x4*)(km + j * HD + d0 * 16), k1 = *(const f32x4*)(km + j * HD + d0 * 16 + 4);
                const v4u qw = *reinterpret_cast<const v4u*>(&qr[d0]);
                s += bflo(qw.x) * k0[0] + bfhi(qw.x) * k0[1] + bflo(qw.y) * k0[2] + bfhi(qw.y) * k0[3] + bflo(qw.z) * k1[0] + bfhi(qw.z) * k1[1] + bflo(qw.w) * k1[2] + bfhi(qw.w) * k1[3]; }
            s += __shfl_xor(s, 32);
            if (s > b0) { b2 = b1; i2 = i1; b1 = b0; i1 = i0; b0 = s; i0 = j; } else if (s > b1) { b2 = b1; i2 = i1; b1 = s; i1 = j; } else if (s > b2) { b2 = s; i2 = j; } }
        sel = (1u << i0) | (1u << i1) | (1u << i2);
    }
    const int sr = tid >> 3, sc = (tid & 7) * 8;
    const int vst = 2 * ((sr >> 5) * 2048 + (sc >> 4) * 512 + (sr & 31) * 16 + (sc & 8));
    const int vb0 = (int)(size_t)V_lds + (lane & 15) * 8 + ((lane >> 4) & 1) * 1024 + (lane >> 5) * 256;
    bf16x8 st_v, st_k;
#define ATT_SLOAD(k0) do { const size_t rr_ = (size_t)((k0) + sr) * AW + sc; st_v = *(const bf16x8*)(Vh + rr_); st_k = *(const bf16x8*)(Kh + rr_); } while (0)
#define ATT_SWRITE(bf) do { *(LAS bf16x8*)(V_lds + (bf) * SHM_V + vst) = st_v; *(LAS bf16x8*)(K_lds + (bf) * SHM_K + ATT_KSWZ(sr, sc * 2)) = st_k; } while (0)
#define ATT_RESC(a) do { if (__any((a) < 1.f)) { if (hi == 0) al_l[r32] = (a); asm volatile("s_waitcnt lgkmcnt(0)" ::: "memory");      \
        _Pragma("unroll") for (int d_ = 0; d_ < 2; ++d_) _Pragma("unroll") for (int r = 0; r < 16; ++r) o[d_][r] *= al_l[crow(r, hi)]; } } while (0)
    const int NT = (q0 + MOBA) / KVBLK;
    const int qrel = wid * QBLK + r32;
#define ATT_MASK(P0, P1, t) do { const int jb_ = (t) - (NT - 4); if (jb_ >= 0) cmask(P0, P1, jb_, qrel, hi); } while (0)
#define ATT_KEEP(t) ((((t) >= NT - 4) ? 1u : ((sel >> ((t) >> 2)) & 1u)) != 0u)
    f32x16 pA0, pA1, pB0, pB1; float mnA, mnB, alA, alB; bf16x8 pa0, pa1, pa2, pa3;
    ATT_SLOAD(0); ATT_SWRITE(0); __syncthreads();
    qkt(pA0, pA1, K_lds, qr, r32, hi); ATT_MASK(pA0, pA1, 0); partialSM(pA0, pA1, m_reg, mnA, alA, ATT_KEEP(0));
    ATT_SLOAD(KVBLK); ATT_SWRITE(1); __syncthreads();
    for (int j = 1; j + 1 < NT; j += 2) {
        ATT_SBAR(); qkt(pB0, pB1, K_lds + SHM_K, qr, r32, hi); ATT_MASK(pB0, pB1, j);
        finishSM(pA0, pA1, alA, l_reg, pa0, pa1, pa2, pa3); ATT_SBAR();
        ATT_SLOAD((j + 1) * KVBLK); ATT_SBAR();
        pv(o, vb0, pa0, pa1, pa2, pa3); partialSM(pB0, pB1, m_reg, mnB, alB, ATT_KEEP(j));
        __syncthreads(); asm volatile("s_waitcnt vmcnt(0)" ::: "memory"); ATT_SWRITE(0);
        ATT_RESC(alB); __syncthreads();
        ATT_SBAR(); qkt(pA0, pA1, K_lds, qr, r32, hi); ATT_MASK(pA0, pA1, j + 1);
        finishSM(pB0, pB1, alB, l_reg, pa0, pa1, pa2, pa3); ATT_SBAR();
        if (j + 2 < NT) { ATT_SLOAD((j + 2) * KVBLK); ATT_SBAR(); }
        pv(o, vb0 + SHM_V, pa0, pa1, pa2, pa3); partialSM(pA0, pA1, m_reg, mnA, alA, ATT_KEEP(j + 1));
        __syncthreads(); if (j + 2 < NT) { asm volatile("s_waitcnt vmcnt(0)" ::: "memory"); ATT_SWRITE(1); }
        ATT_RESC(alA); __syncthreads();
    }
    ATT_SBAR(); qkt(pB0, pB1, K_lds + SHM_K, qr, r32, hi); ATT_MASK(pB0, pB1, NT - 1);
    finishSM(pA0, pA1, alA, l_reg, pa0, pa1, pa2, pa3); ATT_SBAR();
    pv(o, vb0, pa0, pa1, pa2, pa3); partialSM(pB0, pB1, m_reg, mnB, alB, true);
    __syncthreads(); ATT_RESC(alB);
    finishSM(pB0, pB1, alB, l_reg, pa0, pa1, pa2, pa3); ATT_SBAR();
    pv(o, vb0 + SHM_V, pa0, pa1, pa2, pa3);
    if (hi == 0) li_l[r32] = l_reg; asm volatile("s_waitcnt lgkmcnt(0)" ::: "memory");
    float rli[16];
#pragma unroll
    for (int r = 0; r < 16; ++r) rli[r] = __builtin_amdgcn_rcpf(li_l[crow(r, hi)]);
    bf16* Ow = wsp<bf16>(F, WS_MIX) + (rowbase + q0 + wid * QBLK) * DM + h * HD;
    float* ssqa = wsp<float>(F, WS_SSQA) + (rowbase + q0 + wid * QBLK) * NH + h;
    float qq[16];
#pragma unroll
    for (int r = 0; r < 16; ++r) { const int orow = crow(r, hi); float q2 = 0.f;
#pragma unroll
        for (int d0 = 0; d0 < 2; ++d0) { const float v = o[d0][r] * rli[r]; const float vn = __shfl_xor(v, 1); q2 += v * v;
            if ((r32 & 1) == 0) *(unsigned*)(Ow + (size_t)orow * DM + d0 * 32 + r32) = cvt_pk_bf16(v, vn); }
        qq[r] = q2; }
#pragma unroll
    for (int i = 0; i < 8; ++i) { const bool up = (lane & 16) != 0; const float send = up ? qq[i] : qq[i + 8], keep = up ? qq[i + 8] : qq[i]; qq[i] = keep + __shfl_xor(send, 16); }
#pragma unroll
    for (int i = 0; i < 4; ++i) { const bool up = (lane & 8) != 0; const float send = up ? qq[i] : qq[i + 4], keep = up ? qq[i + 4] : qq[i]; qq[i] = keep + __shfl_xor(send, 8); }
#pragma unroll
    for (int i = 0; i < 2; ++i) { const bool up = (lane & 4) != 0; const float send = up ? qq[i] : qq[i + 2], keep = up ? qq[i + 2] : qq[i]; qq[i] = keep + __shfl_xor(send, 4); }
    { const bool up = (lane & 2) != 0; const float send = up ? qq[0] : qq[1], keep = up ? qq[1] : qq[0]; qq[0] = keep + __shfl_xor(send, 2); }
    qq[0] += __shfl_xor(qq[0], 1);
    if ((lane & 1) == 0) ssqa[(size_t)crow(r32 >> 1, hi) * NH] = qq[0];
    __syncthreads();
#undef ATT_SLOAD
#undef ATT_SWRITE
#undef ATT_RESC
#undef ATT_MASK
#undef ATT_KEEP
}
}

namespace gm {
constexpr int PITCH = 136;
__device__ __forceinline__ void unit(const Frame& F, int b, int c, int g, LAS unsigned char* scratch) {
    PHASE_IDS;
    const int tid = TID_, wid = tid >> 6, lane = tid & 63, fr = lane & 15, fq = lane >> 4;
    const size_t row0 = (size_t)b * SEQ + c * GC;
    const bf16* VGg = wsp<bf16>(F, WS_VG) + row0 * GW + g * GD; const bf16* Ug = wsp<bf16>(F, WS_U) + row0 * GW + g * GD;
    LAS unsigned short* vt = (LAS unsigned short*)scratch;
    { const int s = wid * 16 + (lane >> 2), dq = (lane & 3) * 32;
      const v4u* src = (const v4u*)(VGg + (size_t)s * GW + dq); float v[32]; float sum = 0.f;
#pragma unroll
      for (int i = 0; i < 4; ++i) { const v4u w = src[i]; const unsigned ww[4] = {w.x, w.y, w.z, w.w};
#pragma unroll
          for (int k = 0; k < 4; ++k) { v[i * 8 + 2 * k] = bflo(ww[k]); v[i * 8 + 2 * k + 1] = bfhi(ww[k]); sum += v[i * 8 + 2 * k] + v[i * 8 + 2 * k + 1]; } }
      sum += __shfl_xor(sum, 1); sum += __shfl_xor(sum, 2); const float mu = sum * (1.f / GD); float var = 0.f;
#pragma unroll
      for (int i = 0; i < 32; ++i) { v[i] -= mu; var += v[i] * v[i]; }
      var += __shfl_xor(var, 1); var += __shfl_xor(var, 2); const float rstd = 1.0f / sqrtf(var * (1.f / GD) + EPS);
      const float* lg = F.ln_g + g * GD + dq; const float* lb = F.ln_b + g * GD + dq;
#pragma unroll
      for (int i = 0; i < 32; ++i) vt[(dq + i) * PITCH + s] = (unsigned short)f2bf(v[i] * rstd * lg[i] + lb[i]); }
    __syncthreads();
    const int t = wid * 16 + fr;
    const float* Wg = F.gws + (size_t)g * GC * GC + (size_t)t * GC;
    f32x4 acc[8];
#pragma unroll
    for (int n = 0; n < 8; ++n) acc[n] = (f32x4){0.f, 0.f, 0.f, 0.f};
    const int nks = (wid * 16 + 16 + 31) / 32;
    for (int ks = 0; ks < nks; ++ks) { const int s0 = ks * 32 + fq * 8;
        const f32x4 w0 = *(const f32x4*)(Wg + s0), w1 = *(const f32x4*)(Wg + s0 + 4);
        float wv[8] = {w0[0], w0[1], w0[2], w0[3], w1[0], w1[1], w1[2], w1[3]};
#pragma unroll
        for (int j = 0; j < 8; ++j) if (s0 + j > t) wv[j] = 0.f;
        v4u aw; aw.x = pk2(wv[0], wv[1]); aw.y = pk2(wv[2], wv[3]); aw.z = pk2(wv[4], wv[5]); aw.w = pk2(wv[6], wv[7]);
        const bf16x8 af = *reinterpret_cast<const bf16x8*>(&aw);
#pragma unroll
        for (int n = 0; n < 8; ++n) { const bf16x8 bfr = *(const LAS bf16x8*)(vt + (n * 16 + fr) * PITCH + s0);
            acc[n] = __builtin_amdgcn_mfma_f32_16x16x32_bf16(af, bfr, acc[n], 0, 0, 0); } }
    bf16* Og = wsp<bf16>(F, WS_MIX) + row0 * DM + AW + g * GD; float* ssqg = wsp<float>(F, WS_SSQG) + row0 * GG + g;
#pragma unroll
    for (int j = 0; j < 4; ++j) { const int tt = wid * 16 + fq * 4 + j; const float bs = F.gbs[g * GC + tt]; float q2 = 0.f;
#pragma unroll
        for (int n = 0; n < 8; ++n) { const int d = n * 16 + fr; const float uu = bf2f(Ug[(size_t)tt * GW + d]); const float o = uu * (acc[n][j] + bs); q2 += o * o;
            Og[(size_t)tt * DM + d] = (bf16)f2bf(o); }
        q2 += __shfl_xor(q2, 1); q2 += __shfl_xor(q2, 2); q2 += __shfl_xor(q2, 4); q2 += __shfl_xor(q2, 8);
        if (fr == 0) ssqg[(size_t)tt * GG] = q2; }
    __syncthreads();
}
}

__device__ __forceinline__ void p2_mixers(const Frame& F) {
    LAS unsigned char* scratch = F.lds + RING_OFF;
    const int v = F.vcu;
    { const int bh = v >> 1, s0 = (v & 1) * 2;
#pragma unroll 1
      for (int i = 0; i < 4; ++i) { const int qq = s0 + (i >> 1); const int qb = (i & 1) ? 7 - qq : qq; att::attn_unit(F, bh / NH, bh % NH, qb, scratch); } }
#pragma unroll 1
    for (int i = 0; i < 4; ++i) { const int uidx = 4 * v + i; gm::unit(F, uidx >> 6, (uidx >> 2) & 15, uidx & 3, scratch); }
}

__device__ __forceinline__ void p4_router(const Frame& F) {
    PHASE_IDS;
    const int tid = TID_, wid = tid >> 6, lane = tid & 63, tk = lane & 31, hf = lane >> 5;
    LAS unsigned* hist = (LAS unsigned*)(F.lds + XTAB_OFF);
    LAS unsigned* base = hist + 32;
    const float* RWG = wsp<float>(F, WS_RWG); const float* x1 = F.out; const float* ssq1 = wsp<float>(F, WS_SSQ1);
    unsigned char* XN = wsp<unsigned char>(F, WS_X1F8); unsigned* cntg = (unsigned*)(F.ctl + CW_CNT);
    unsigned* IDX = wsp<unsigned>(F, WS_IDX); float* GSS = wsp<float>(F, WS_GSS); unsigned* TOKPOS = wsp<unsigned>(F, WS_TOKPOS);
    if (tid < 32) hist[tid] = 0u;
    __syncthreads();
    const bool active = wid < 4; const int tok = (F.vcu * 4 + (wid & 3)) * 32 + tk;
    int pe[4] = {0, 0, 0, 0}; float pg[4] = {0.f, 0.f, 0.f, 0.f}; unsigned rank[2] = {0u, 0u}; int my_e[2] = {0, 0}; float my_g[2] = {0.f, 0.f};
    if (active) {
        float rstd; { const f32x4* sp = (const f32x4*)(ssq1 + (size_t)tok * 16); const f32x4 a = sp[0], b = sp[1], c = sp[2], d = sp[3];
            const float s = ((a[0] + a[1]) + (a[2] + a[3])) + ((b[0] + b[1]) + (b[2] + b[3])) + ((c[0] + c[1]) + (c[2] + c[3])) + ((d[0] + d[1]) + (d[2] + d[3]));
            rstd = 1.0f / sqrtf(s * (1.f / DM) + EPS); }
        f32x16 acc = f32x16{};
        const float* xr = x1 + (size_t)tok * DM + 4 * hf; unsigned char* xo = XN + (size_t)tok * DM + 4 * hf;
        const float* wr_ = RWG + tk;
#pragma unroll 4
        for (int j = 0; j < DM / 8; ++j) { f32x4 xv = *(const f32x4*)(xr + 8 * j); xv = xv * rstd;
            *(unsigned*)(xo + 8 * j) = pk4_fp8(xv[0], xv[1], xv[2], xv[3]);
#pragma unroll
            for (int e = 0; e < 4; ++e) { const float wv = wr_[(size_t)(8 * j + 4 * hf + e) * NE]; acc = __builtin_amdgcn_mfma_f32_32x32x2f32(wv, xv[e], acc, 0, 0, 0); } }
        float lv[16];
#pragma unroll
        for (int r = 0; r < 16; ++r) { const int e = (r & 3) + 8 * (r >> 2) + 4 * hf; lv[r] = acc[r] + F.router_b[e]; }
        float tv[4]; int ti[4]; unsigned used = 0u;
#pragma unroll
        for (int k = 0; k < 4; ++k) { float best = -__builtin_inff(); int br = 0;
#pragma unroll
            for (int r = 0; r < 16; ++r) { const int e = (r & 3) + 8 * (r >> 2) + 4 * hf; const int eb = (br & 3) + 8 * (br >> 2) + 4 * hf;
                const bool better = !((used >> r) & 1u) && (lv[r] > best || (lv[r] == best && e < eb)); if (better) { best = lv[r]; br = r; } }
            used |= 1u << br; tv[k] = best; ti[k] = (br & 3) + 8 * (br >> 2) + 4 * hf; }
        float ov[4]; int oi[4];
#pragma unroll
        for (int k = 0; k < 4; ++k) { ov[k] = __shfl_xor(tv[k], 32); oi[k] = __shfl_xor(ti[k], 32); }
        int ia = 0, ib = 0;
#pragma unroll
        for (int k = 0; k < 4; ++k) {
            float va = tv[0], vb = ov[0]; int ea = ti[0], eb = oi[0];
#pragma unroll
            for (int q = 1; q < 4; ++q) { if (ia == q) { va = tv[q]; ea = ti[q]; } if (ib == q) { vb = ov[q]; eb = oi[q]; } }
            const bool takeA = (va > vb) || (va == vb && ea < eb);
            pg[k] = takeA ? va : vb; pe[k] = takeA ? ea : eb; if (takeA) ++ia; else ++ib; }
        { const float m = pg[0]; float s = 0.f;
#pragma unroll
          for (int k = 0; k < 4; ++k) { pg[k] = __builtin_amdgcn_exp2f((pg[k] - m) * 1.4426950408889634f); s += pg[k]; }
          const float inv = 1.0f / s;
#pragma unroll
          for (int k = 0; k < 4; ++k) pg[k] *= inv; }
        { const int m = -hf; my_e[0] = pe[0] ^ ((pe[0] ^ pe[2]) & m); my_e[1] = pe[1] ^ ((pe[1] ^ pe[3]) & m);
          const unsigned g0 = __float_as_uint(pg[0]), g1 = __float_as_uint(pg[1]), g2 = __float_as_uint(pg[2]), g3 = __float_as_uint(pg[3]);
          my_g[0] = __uint_as_float(g0 ^ ((g0 ^ g2) & (unsigned)m)); my_g[1] = __uint_as_float(g1 ^ ((g1 ^ g3) & (unsigned)m)); }
#pragma unroll
        for (int q = 0; q < 2; ++q) rank[q] = atomicAdd((unsigned*)&hist[my_e[q]], 1u);
    }
    __syncthreads();
    if (tid < 32) base[tid] = atomicAdd(cntg + tid, hist[tid]);
    __syncthreads();
    if (active) {
#pragma unroll
        for (int q = 0; q < 2; ++q) { const int k = 2 * hf + q; const int e = my_e[q]; const float g = my_g[q];
            const unsigned slot = base[e] + rank[q];
            IDX[(size_t)e * T + slot] = (unsigned)tok; GSS[(size_t)e * T + slot] = g; TOKPOS[(size_t)tok * 4 + k] = ((unsigned)e << 16) | slot; }
    }
    __syncthreads();
}

constexpr int MAXU = 18;
constexpr int XT_TSTART = 0, XT_ULIST = 256, XT_GTAB = 512;
static_assert(XT_GTAB + MAXU * 1024 <= LDS_BYTES - XTAB_OFF, "xtab");
__device__ __forceinline__ int moe_build_tables(const Frame& F, int P  , bool gather) {
    PHASE_IDS;
    LAS unsigned* tstart = (LAS unsigned*)(F.lds + XTAB_OFF + XT_TSTART);
    LAS unsigned* ulist = (LAS unsigned*)(F.lds + XTAB_OFF + XT_ULIST);
    LAS unsigned* gtab = (LAS unsigned*)(F.lds + XTAB_OFF + XT_GTAB);
    const unsigned* cntg = (const unsigned*)(F.ctl + CW_CNT); const unsigned* IDX = wsp<unsigned>(F, WS_IDX);
    const int tid = TID_;
    if (tid == 0) { unsigned s = 0; for (int e = 0; e < NE; ++e) { tstart[e] = s; unsigned c = cntg[e]; if (c > (unsigned)T) c = (unsigned)T; s += (c + 255u) >> 8; } tstart[NE] = s; }
    __syncthreads();
    const int NT_ = (int)tstart[NE], U = NT_ * P, G = F.G, c = (int)blockIdx.x;
    const int nunits = (c < U) ? (U - c + G - 1) / G : 0;
    if (tid < MAXU && tid < nunits) { const int L = tid * G + c; int gt, pn; pg8::flat_to_tile(L, U, NT_, P, gt, pn);
        int e = 0; for (int k = 1; k < NE; ++k) if ((unsigned)gt >= tstart[k]) e = k;
        const int rt = gt - (int)tstart[e];
        ulist[tid] = (unsigned)gt | ((unsigned)pn << 10) | ((unsigned)e << 13) | ((unsigned)rt << 18); }
    __syncthreads();
    if (gather) {
        for (int i = 0; i < nunits && i < MAXU; ++i) { const unsigned w = ulist[i]; const int e = (int)((w >> 13) & 0x1fu), rt = (int)(w >> 18);
            unsigned cn = cntg[e]; if (cn > (unsigned)T) cn = (unsigned)T;
            if (tid < 256) { const unsigned slot = (unsigned)rt * 256u + (unsigned)tid; unsigned tok = 0u; if (slot < cn) { tok = IDX[(size_t)e * T + slot]; if (tok >= (unsigned)T) tok = 0u; } gtab[i * 256 + tid] = tok * (unsigned)DM; } }
    }
    __syncthreads();
    return nunits < MAXU ? nunits : MAXU;
}

__device__ __forceinline__ void p7_combine(const Frame& F) {
    PHASE_IDS;
    LAS unsigned* tstart = (LAS unsigned*)(F.lds + XTAB_OFF + XT_TSTART);
    const unsigned* cntg = (const unsigned*)(F.ctl + CW_CNT);
    if (TID_ == 0) { unsigned s = 0; for (int e = 0; e < NE; ++e) { tstart[e] = s; unsigned c = cntg[e]; if (c > (unsigned)T) c = (unsigned)T; s += (c + 255u) >> 8; } tstart[NE] = s; }
    __syncthreads();
    const int gw = F.vcu * NWAVES + WAVE_, NGW = F.G * NWAVES;
    const unsigned* TOKPOS = wsp<unsigned>(F, WS_TOKPOS); const bf16* Y = wsp<bf16>(F, WS_YBUF); bf16* XN = wsp<bf16>(F, WS_X2N);
    for (int m = gw; m < T; m += NGW) {
        const v4u tp = *(const v4u*)(TOKPOS + (size_t)m * 4); const unsigned tpw[4] = {tp.x, tp.y, tp.z, tp.w};
        size_t yrow[4];
#pragma unroll
        for (int k = 0; k < 4; ++k) { const unsigned e = (tpw[k] >> 16) & 31u, slot = tpw[k] & 0xffffu; yrow[k] = ((size_t)tstart[e] * 256u + slot) * DM; }
        float* xr = F.out + (size_t)m * DM;
        f32x4 v[4]; float s = 0.f;
#pragma unroll
        for (int j = 0; j < 4; ++j) { v[j] = *(const f32x4*)(xr + 4 * LANE_ + 256 * j);
#pragma unroll
            for (int k = 0; k < 4; ++k) { const v2u w = *(const v2u*)(Y + yrow[k] + 4 * LANE_ + 256 * j); v[j][0] += bflo(w.x); v[j][1] += bfhi(w.x); v[j][2] += bflo(w.y); v[j][3] += bfhi(w.y); }
            s += (v[j].x * v[j].x + v[j].y * v[j].y) + (v[j].z * v[j].z + v[j].w * v[j].w); }
        const float rstd = 1.0f / sqrtf(wave_sum(s) * (1.f / DM) + EPS);
#pragma unroll
        for (int j = 0; j < 4; ++j) { *(f32x4*)(xr + 4 * LANE_ + 256 * j) = v[j];
            v2u w; w.x = pk2(v[j].x * rstd, v[j].y * rstd); w.y = pk2(v[j].z * rstd, v[j].w * rstd); *(v2u*)(XN + (size_t)m * DM + 4 * LANE_ + 256 * j) = w; }
    }
}

__device__ __forceinline__ void p9_final(const Frame& F) {
    PHASE_IDS;
    const int gw = F.vcu * NWAVES + WAVE_, NGW = F.G * NWAVES;
    const bf16* GATE = wsp<bf16>(F, WS_GATE); const bf16* PP = wsp<bf16>(F, WS_PP); const float* ssqpp = wsp<float>(F, WS_SSQPP);
    for (int m = gw; m < T; m += NGW) {
        float rpp; { const f32x4* sp = (const f32x4*)(ssqpp + (size_t)m * 16); const f32x4 a = sp[0], b = sp[1], c = sp[2], d = sp[3];
            const float s = ((a[0] + a[1]) + (a[2] + a[3])) + ((b[0] + b[1]) + (b[2] + b[3])) + ((c[0] + c[1]) + (c[2] + c[3])) + ((d[0] + d[1]) + (d[2] + d[3]));
            rpp = 1.0f / sqrtf(s * (1.f / DM) + EPS); }
        float* xr = F.out + (size_t)m * DM;
        f32x4 v[4]; float s = 0.f;
#pragma unroll
        for (int j = 0; j < 4; ++j) { const int col = 4 * LANE_ + 256 * j; v[j] = *(const f32x4*)(xr + col);
            const v2u g = *(const v2u*)(GATE + (size_t)m * DM + col), pw = *(const v2u*)(PP + (size_t)m * DM + col); const f32x4 pg_ = *(const f32x4*)(F.ppn + col);
            v[j][0] += bflo(g.x) * (bflo(pw.x) * rpp * pg_[0]); v[j][1] += bfhi(g.x) * (bfhi(pw.x) * rpp * pg_[1]);
            v[j][2] += bflo(g.y) * (bflo(pw.y) * rpp * pg_[2]); v[j][3] += bfhi(g.y) * (bfhi(pw.y) * rpp * pg_[3]);
            s += (v[j].x * v[j].x + v[j].y * v[j].y) + (v[j].z * v[j].z + v[j].w * v[j].w); }
        const float rstd = 1.0f / sqrtf(wave_sum(s) * (1.f / DM) + EPS);
#pragma unroll
        for (int j = 0; j < 4; ++j) { const int col = 4 * LANE_ + 256 * j; const f32x4 fg = *(const f32x4*)(F.final_norm + col); *(f32x4*)(xr + col) = v[j] * rstd * fg; }
    }
}

struct Args { const float* in[23]; float* out; unsigned char* ws; };
#if CHECK_STAGE
__device__ __forceinline__ unsigned hmix(unsigned z) { z ^= z >> 16; z *= 0x7feb352du; z ^= z >> 15; z *= 0x846ca68bu; z ^= z >> 16; return z; }
__device__ __forceinline__ void chk_add(const Frame& F, int st, bool bad) { atomicAdd((unsigned*)(F.ctl + CW_CHK + 2 * st), bad ? 1u : 0u); atomicAdd((unsigned*)(F.ctl + CW_CHK + 2 * st + 1), 1u); }
__device__ __forceinline__ bool offby(float got, float ex, float rel, float ab) { const float d = fabsf(got - ex); return !(d <= rel * fabsf(ex) + ab); }
__device__ __forceinline__ float dot_bf(const bf16* a, const bf16* b, int n) { float s = 0.f; for (int k = 0; k < n; ++k) s += bf2f(a[k]) * bf2f(b[k]); return s; }
__device__ __forceinline__ float gelu_ref(float v) { return 0.5f * v * (1.0f + erff(v * 0.70710678f)); }
__device__ __forceinline__ unsigned chk_tstart(const Frame& F, unsigned ex) { const unsigned* cntg = (const unsigned*)(F.ctl + CW_CNT); unsigned s_ = 0; for (unsigned e = 0; e < ex; ++e) { unsigned c = cntg[e]; if (c > (unsigned)T) c = T; s_ += (c + 255u) >> 8; } return s_; }
template <int ST> __device__ __forceinline__ void stage_check(const Frame& F) {
    const unsigned gt = (unsigned)blockIdx.x * NTHR + threadIdx.x;
    const unsigned h0 = hmix(gt * 2654435761u + ST * 40503u), h1 = hmix(h0 + 0x9e3779b9u), h2 = hmix(h1 + 0x85ebca6bu);
    if (ST == 1) {
        if (gt >= 16384) return;
        const int which = gt & 7;
        if (which == 0) { const int e = h0 % NE, n = h1 % (2 * FF), k = h2 % DM; const int lc = CmWgu()(n);
            const float ex = bf2f((bf16)f2bf(F.w_gu[((size_t)e * DM + k) * 2 * FF + lc] * F.ffn_norm[k])); chk_add(F, ST, offby(bf2f(wsp<bf16>(F, WS_WGU)[((size_t)e * 2 * FF + n) * DM + k]), ex, 1e-6f, 1e-30f)); }
        else if (which == 1) { const int e = h0 % NE, n = h1 % DM, k = h2 % FF;
            const float ex = bf2f((bf16)f2bf(F.w_dn[((size_t)e * FF + k) * DM + n])); chk_add(F, ST, offby(bf2f(wsp<bf16>(F, WS_WDN)[((size_t)e * DM + n) * FF + k]), ex, 1e-6f, 1e-30f)); }
        else if (which == 2) { const int n = h1 % NPROJ, k = h2 % DM; const int lc = CmWin()(n);
            const float ex = bf2f((bf16)f2bf(F.w_in[(size_t)k * NPROJ + lc] * F.mix_norm[k])); chk_add(F, ST, offby(bf2f(wsp<bf16>(F, WS_WIN)[(size_t)n * DM + k]), ex, 1e-6f, 1e-30f)); }
        else if (which == 3) { const int n = h1 % DM, k = h2 % DM; const float g = k < AW ? F.aon[k] : F.gon[k - AW];
            const float ex = bf2f((bf16)f2bf(F.w_out[(size_t)k * DM + n] * g)); chk_add(F, ST, offby(bf2f(wsp<bf16>(F, WS_WOUT)[(size_t)n * DM + k]), ex, 1e-6f, 1e-30f)); }
        else if (which == 4) { const int n = h1 % DM, k = h2 % DM;
            const float ex = bf2f((bf16)f2bf(F.w_pg[(size_t)k * DM + n] * F.ple_norm[k])); chk_add(F, ST, offby(bf2f(wsp<bf16>(F, WS_WPG)[(size_t)n * DM + k]), ex, 1e-6f, 1e-30f)); }
        else if (which == 5) { const int n = h1 % DM, k = h2 % PLE;
            const float ex = bf2f((bf16)f2bf(F.w_pp[(size_t)k * DM + n])); chk_add(F, ST, offby(bf2f(wsp<bf16>(F, WS_WPP)[(size_t)n * PLE + k]), ex, 1e-6f, 1e-30f)); }
        else if (which == 6) { const int row = h0 % T, k = h1 % DM; float ss = 0.f; for (int j = 0; j < DM; ++j) { const float v = F.x[(size_t)row * DM + j]; ss += v * v; }
            const float ex = F.x[(size_t)row * DM + k] / sqrtf(ss / DM + EPS); chk_add(F, ST, offby(bf2f(wsp<bf16>(F, WS_XNB)[(size_t)row * DM + k]), ex, 0.01f, 1e-3f)); }
        else { const int row = h0 % T, k = h1 % PLE; chk_add(F, ST, offby(bf2f(wsp<bf16>(F, WS_PB)[(size_t)row * PLE + k]), F.p[(size_t)row * PLE + k], 0.005f, 1e-6f)); }
    }
    if (ST == 2) {
        if (gt >= 16384) return;
        const bf16* XN = wsp<bf16>(F, WS_XNB); const bf16* WIN = wsp<bf16>(F, WS_WIN);
        if ((gt & 7) == 7) {
            const int b = h0 % BATCH, hh = h1 % NH, blk = h2 % NBLK, c = (h2 >> 8) % HD; float s_ = 0.f;
            for (int r = 0; r < 256; ++r) s_ += bf2f(wsp<bf16>(F, WS_K)[((size_t)b * SEQ + blk * 256 + r) * AW + hh * HD + c]);
            chk_add(F, ST, offby(wsp<float>(F, WS_KMEAN)[((size_t)(b * NH + hh) * NBLK + blk) * HD + c], s_, 0.02f, 0.3f)); return; }
        const int row = h0 % T, type = h1 % 5, c = h2 % AW; const bf16* xr = XN + (size_t)row * DM;
        const float v = dot_bf(xr, WIN + (size_t)(type * AW + c) * DM, DM); float ex;
        if (type <= 1) { const float vp = dot_bf(xr, WIN + (size_t)(type * AW + (c ^ 4)) * DM, DM); const int i = 4 * ((c & 63) >> 3) + (c & 3), pos = row & (SEQ - 1);
            const float cs = wsp<float>(F, WS_ROPE)[pos * 32 + i], sn = wsp<float>(F, WS_ROPE)[SEQ * 32 + pos * 32 + i];
            { const float inv = powf(10000.0f, -(float)i / 32.0f); const float ang = (float)pos * inv; if (offby(cs, cosf(ang), 0.f, 1e-3f) || offby(sn, sinf(ang), 0.f, 1e-3f)) { chk_add(F, ST, true); return; } }
            ex = (c & 4) ? v * cs + vp * sn : v * cs - vp * sn; }
        else if (type == 2) ex = v; else ex = gelu_ref(v);
        chk_add(F, ST, offby(bf2f(wsp<bf16>(F, WS_Q)[(size_t)type * (16u << 20) + (size_t)row * AW + c]), ex, 0.02f, 0.02f));
    }
    if (ST == 3) {
        if (gt >= 8192) return;
        if (gt & 1) {
            const int row = h0 % T, g = h1 % GG, d = h2 % GD; const int b = row / SEQ, s_ = row % SEQ, c = s_ / GC, t = s_ % GC; float acc = 0.f;
            for (int sp = 0; sp <= t; ++sp) { const bf16* vr = wsp<bf16>(F, WS_VG) + ((size_t)b * SEQ + c * GC + sp) * GW + g * GD; float mu = 0.f; for (int j = 0; j < GD; ++j) mu += bf2f(vr[j]); mu /= GD;
                float var = 0.f; for (int j = 0; j < GD; ++j) { const float dd = bf2f(vr[j]) - mu; var += dd * dd; } const float rstd = 1.0f / sqrtf(var / GD + EPS);
                const float vn = bf2f((bf16)f2bf((bf2f(vr[d]) - mu) * rstd * F.ln_g[g * GD + d] + F.ln_b[g * GD + d])); acc += bf2f((bf16)f2bf(F.gws[((size_t)g * GC + t) * GC + sp])) * vn; }
            const float ex = bf2f(wsp<bf16>(F, WS_U)[(size_t)row * GW + g * GD + d]) * (acc + F.gbs[g * GC + t]);
            chk_add(F, ST, offby(bf2f(wsp<bf16>(F, WS_MIX)[(size_t)row * DM + AW + g * GD + d]), ex, 0.03f, 0.02f)); return; }
        const int row = h0 % T, hh = h1 % NH; const int b = row / SEQ, s_ = row % SEQ, qb = s_ / MOBA; float q[HD];
#pragma unroll
        for (int c = 0; c < HD; ++c) q[c] = bf2f(wsp<bf16>(F, WS_Q)[(size_t)row * AW + hh * HD + c]);
        unsigned sel = 0u;
        if (qb <= 3) sel = (1u << qb) - 1u;
        else { float b0 = -__builtin_inff(), b1 = b0, b2 = b0; int i0 = 0, i1 = 0, i2 = 0;
            for (int j = 0; j < qb; ++j) { const float* km = wsp<float>(F, WS_KMEAN) + ((size_t)(b * NH + hh) * NBLK + j) * HD; float g = 0.f;
#pragma unroll
                for (int c = 0; c < HD; ++c) g += q[c] * km[c];
                if (g > b0) { b2 = b1; i2 = i1; b1 = b0; i1 = i0; b0 = g; i0 = j; } else if (g > b1) { b2 = b1; i2 = i1; b1 = g; i1 = j; } else if (g > b2) { b2 = g; i2 = j; } }
            sel = (1u << i0) | (1u << i1) | (1u << i2); }
        float mx = -__builtin_inff();
        for (int kp = 0; kp <= s_; ++kp) { const int blk = kp / MOBA; if (blk != qb && !((sel >> blk) & 1u)) continue; const bf16* kr = wsp<bf16>(F, WS_K) + ((size_t)b * SEQ + kp) * AW + hh * HD; float sc = 0.f;
#pragma unroll
            for (int c = 0; c < HD; ++c) sc += q[c] * bf2f(kr[c]);
            mx = fmaxf(mx, sc * 0.125f); }
        float o[HD]; float l = 0.f;
#pragma unroll
        for (int c = 0; c < HD; ++c) o[c] = 0.f;
        for (int kp = 0; kp <= s_; ++kp) { const int blk = kp / MOBA; if (blk != qb && !((sel >> blk) & 1u)) continue; const bf16* kr = wsp<bf16>(F, WS_K) + ((size_t)b * SEQ + kp) * AW + hh * HD; float sc = 0.f;
#pragma unroll
            for (int c = 0; c < HD; ++c) sc += q[c] * bf2f(kr[c]);
            const float pr = expf(sc * 0.125f - mx); l += pr; const bf16* vr = wsp<bf16>(F, WS_V) + ((size_t)b * SEQ + kp) * AW + hh * HD;
#pragma unroll
            for (int c = 0; c < HD; ++c) o[c] += pr * bf2f(vr[c]); }
        bool bad = false; float ss = 0.f;
#pragma unroll
        for (int c = 0; c < HD; ++c) { const float ex = o[c] / l; ss += ex * ex; bad |= offby(bf2f(wsp<bf16>(F, WS_MIX)[(size_t)row * DM + hh * HD + c]), ex, 0.04f, 0.02f); }
        bad |= offby(wsp<float>(F, WS_SSQA)[(size_t)row * NH + hh], ss, 0.03f, 1e-3f);
        chk_add(F, ST, bad);
    }
    if (ST == 4) {
        if (gt >= 16384) return;
        const int row = h0 % T, col = h1 % DM; const bf16* mr = wsp<bf16>(F, WS_MIX) + (size_t)row * DM; const bf16* wr_ = wsp<bf16>(F, WS_WOUT) + (size_t)col * DM;
        float sa = 0.f, sg = 0.f, da = 0.f, dg = 0.f;
        for (int k = 0; k < AW; ++k) { const float a = bf2f(mr[k]), g = bf2f(mr[AW + k]); sa += a * a; sg += g * g; da += a * bf2f(wr_[k]); dg += g * bf2f(wr_[AW + k]); }
        const float ex = F.x[(size_t)row * DM + col] + da / sqrtf(sa / AW + EPS) + dg / sqrtf(sg / GW + EPS);
        chk_add(F, ST, offby(F.out[(size_t)row * DM + col], ex, 0.01f, 0.03f));
    }
    if (ST == 5) {
        if (gt >= 8192) return;
        const int tok = h0 % T; const float* xr = F.out + (size_t)tok * DM; float ss = 0.f; for (int k = 0; k < DM; ++k) ss += xr[k] * xr[k]; const float rstd = 1.0f / sqrtf(ss / DM + EPS);
        bool bad = false;
        for (int j = 0; j < 4; ++j) { const int k = (h1 >> (8 * j)) % DM; bad |= offby(bf2f(wsp<bf16>(F, WS_XNB)[(size_t)tok * DM + k]), xr[k] * rstd, 0.01f, 1e-3f); }
        float lg[NE];
#pragma unroll
        for (int e = 0; e < NE; ++e) lg[e] = 0.f;
        for (int k = 0; k < DM; ++k) { const float xv = xr[k] * rstd * F.ffn_norm[k];
#pragma unroll
            for (int e = 0; e < NE; ++e) lg[e] += xv * F.router_w[k * NE + e]; }
#pragma unroll
        for (int e = 0; e < NE; ++e) lg[e] += F.router_b[e];
        int te[4]; float tv[4]; unsigned used = 0u;
#pragma unroll
        for (int k = 0; k < 4; ++k) { float best = -__builtin_inff(); int bi = 0;
#pragma unroll
            for (int e = 0; e < NE; ++e) if (!((used >> e) & 1u) && lg[e] > best) { best = lg[e]; bi = e; }
            used |= 1u << bi; te[k] = bi; tv[k] = best; }
        { float gg[4]; float den = 0.f;
#pragma unroll
          for (int k = 0; k < 4; ++k) { float v = -__builtin_inff();
#pragma unroll
              for (int e = 0; e < NE; ++e) if (e == te[k]) v = lg[e];
              gg[k] = v; }
          const float mm = gg[0];
#pragma unroll
          for (int k = 0; k < 4; ++k) { gg[k] = expf(gg[k] - mm); den += gg[k]; }
          const unsigned* tp = wsp<unsigned>(F, WS_TOKPOS) + (size_t)tok * 4;
#pragma unroll
          for (int k = 0; k < 4; ++k) { const unsigned e = tp[k] >> 16, slot = tp[k] & 0xffffu; bad |= (e != (unsigned)te[k]);
              if (e < NE && slot < (unsigned)T) { bad |= wsp<unsigned>(F, WS_IDX)[(size_t)e * T + slot] != (unsigned)tok; bad |= offby(wsp<float>(F, WS_GSS)[(size_t)e * T + slot], gg[k] / den, 2e-3f, 1e-5f);
                  bad |= slot >= ((const unsigned*)(F.ctl + CW_CNT))[e]; } else bad = true; } }
        (void)tv;
        chk_add(F, ST, bad);
    }
    if (ST == 6 || ST == 7) {
        if (gt >= 16384) return;
        const int tok = h0 % T, k = h1 & 3, col = (h1 >> 2) % FF; const unsigned tp = wsp<unsigned>(F, WS_TOKPOS)[(size_t)tok * 4 + k]; const unsigned e = tp >> 16, slot = tp & 0xffffu;
        if (e >= NE) { chk_add(F, ST, true); return; }
        const unsigned tse = chk_tstart(F, e);
        const size_t row = (size_t)tse * 256 + slot;
        if (ST == 6) { const bf16* xr = wsp<bf16>(F, WS_XNB) + (size_t)tok * DM; const int np = (col >> 7) * 256 + (col & 127);
            const float g = dot_bf(xr, wsp<bf16>(F, WS_WGU) + ((size_t)e * 2 * FF + np) * DM, DM) + F.b_gu[(size_t)e * 2 * FF + col];
            const float l = dot_bf(xr, wsp<bf16>(F, WS_WGU) + ((size_t)e * 2 * FF + np + 128) * DM, DM) + F.b_gu[(size_t)e * 2 * FF + FF + col];
            const float gc = fminf(g, 7.f), lc = fminf(fmaxf(l, -7.f), 7.f); const float ex = gc / (1.0f + expf(-1.702f * gc)) * (lc + 1.0f);
            chk_add(F, ST, offby(bf2f(wsp<bf16>(F, WS_ABUF)[row * FF + col]), ex, 0.03f, 0.03f)); }
        else { const float d = dot_bf(wsp<bf16>(F, WS_ABUF) + row * FF, wsp<bf16>(F, WS_WDN) + ((size_t)e * DM + col) * FF, FF) + F.b_dn[(size_t)e * DM + col];
            const float ex = d * wsp<float>(F, WS_GSS)[(size_t)e * T + slot];
            chk_add(F, ST, offby(bf2f(wsp<bf16>(F, WS_YBUF)[row * DM + col]), ex, 0.03f, 0.01f)); }
    }
    if (ST == 8) {
        if (gt >= 8192) return;
        const int tok = h0 % T; const float* xr = F.out + (size_t)tok * DM; float ss = 0.f; for (int k = 0; k < DM; ++k) ss += xr[k] * xr[k]; const float rstd = 1.0f / sqrtf(ss / DM + EPS);
        bool bad = false; for (int k = 0; k < DM; ++k) { bad |= offby(bf2f(wsp<bf16>(F, WS_X2N)[(size_t)tok * DM + k]), xr[k] * rstd, 0.01f, 1e-3f); bad |= !(fabsf(xr[k]) < 30.f); }
        chk_add(F, ST, bad);
    }
    if (ST == 9) {
        if (gt >= 16384) return;
        const int row = h0 % T, col = h1 % DM;
        if (gt & 1) { const float d = dot_bf(wsp<bf16>(F, WS_X2N) + (size_t)row * DM, wsp<bf16>(F, WS_WPG) + (size_t)col * DM, DM); const float got = bf2f(wsp<bf16>(F, WS_GATE)[(size_t)row * DM + col]); const float ex = 1.0f / (1.0f + expf(-d)); const bool bad = offby(got, ex, 0.02f, 0.01f); chk_add(F, ST, bad);
            if (bad) { atomicOr((unsigned*)(F.ctl + CW_CHK + 40), 1u << ((col >> 3) & 31)); atomicOr((unsigned*)(F.ctl + CW_CHK + 41), 1u << ((row >> 3) & 31)); atomicOr((unsigned*)(F.ctl + CW_CHK + 42), 1u << (col & 7)); atomicOr((unsigned*)(F.ctl + CW_CHK + 43), 1u << (row & 7));
                if (!(got >= 0.f && got <= 1.f)) atomicAdd((unsigned*)(F.ctl + CW_CHK + 44), 1u); { int cl = (int)floorf(log2f(fabsf(got) + 1e-30f)) + 40; cl = cl < 0 ? 0 : (cl > 80 ? 80 : cl); atomicMax((unsigned*)(F.ctl + CW_CHK + 46), (unsigned)cl); atomicMin((unsigned*)(F.ctl + CW_CHK + 47), 0xffffffffu - (unsigned)cl); if (got < 0.f) atomicAdd((unsigned*)(F.ctl + CW_CHK + 48), 1u); } if (fabsf(got - ex) > 0.2f) atomicAdd((unsigned*)(F.ctl + CW_CHK + 45), 1u); } }
        else { const float d = dot_bf(wsp<bf16>(F, WS_PB) + (size_t)row * PLE, wsp<bf16>(F, WS_WPP) + (size_t)col * PLE, PLE); chk_add(F, 10, offby(bf2f(wsp<bf16>(F, WS_PP)[(size_t)row * DM + col]), d, 0.02f, 0.02f)); }
    }
}
__device__ __forceinline__ void check_report(const Frame& F) {
    float c2 = 3.0f;
    for (int st = 1; st <= 10; ++st) { const unsigned bad = F.ctl[CW_CHK + 2 * st], tot = F.ctl[CW_CHK + 2 * st + 1]; const float fr = tot ? (float)bad / (float)tot : 1.0f;
        (void)fr; if (((CHECK_SKIP >> st) & 1) == 0 && bad >= 1u) { c2 = powf(10.0f, (float)st) * (1.0f + fminf((float)bad, 80.0f) * 0.1f); break; } }
#if CHECK_REPORT >= 40
    { unsigned v = F.ctl[CW_CHK + CHECK_REPORT]; if (CHECK_REPORT == 47) v = 0xffffffffu - v; c2 = powf(10.0f, (float)(v >> 27)) * (1.0f + (float)((v >> 21) & 63u) * 0.1f);
#if CHECK_REPORT2
      c2 = powf(10.0f, (float)((v >> 16) & 31u)) * (1.0f + (float)((v >> 10) & 63u) * 0.1f);
#endif
#if CHECK_REPORT3
      c2 = powf(10.0f, (float)((v >> 5) & 31u)) * (1.0f + (float)(v & 31u) * 0.1f);
#endif
      if (CHECK_REPORT >= 46 && CHECK_REPORT <= 47) c2 = powf(10.0f, (float)(v / 9u)) * (1.0f + (float)(v % 9u));
    }
#endif
    if (F.ctl[CW_BAR + XB_TMO] != 0u) c2 = 1e20f;
    const float c = sqrtf(c2);
    for (size_t i = (size_t)blockIdx.x * NTHR + threadIdx.x; i < (size_t)T * DM; i += (size_t)gridDim.x * NTHR) F.out[i] = c;
}
#define STAGE_CHECK(n) stage_check<(n)>(F)
#else
#define STAGE_CHECK(n) do {} while (0)
#endif

__global__ void __launch_bounds__(NTHR, 2) mega_fwd(Args args) {
    extern __shared__ __attribute__((aligned(16))) unsigned char lds_raw[];
    Frame F;
    F.lds = (LAS unsigned char*)lds_raw;
    F.MISC = (volatile LAS unsigned*)(F.lds + LDSCTL_OFF);
    F.G = gridDim.x; { const int bx = blockIdx.x; F.vcu = (F.G % 8 == 0) ? (bx % 8) * (F.G / 8) + bx / 8 : bx; }
    F.ws = args.ws; F.ctl = (gu32*)(args.ws + WS_CTL); F.out = args.out;
    F.x = args.in[0]; F.p = args.in[1]; F.mix_norm = args.in[2]; F.w_in = args.in[3]; F.ln_g = args.in[4]; F.ln_b = args.in[5]; F.gws = args.in[6]; F.gbs = args.in[7];
    F.aon = args.in[8]; F.gon = args.in[9]; F.w_out = args.in[10]; F.ffn_norm = args.in[11]; F.router_w = args.in[12]; F.router_b = args.in[13]; F.w_gu = args.in[14]; F.b_gu = args.in[15];
    F.w_dn = args.in[16]; F.b_dn = args.in[17]; F.ple_norm = args.in[18]; F.w_pg = args.in[19]; F.w_pp = args.in[20]; F.ppn = args.in[21]; F.final_norm = args.in[22];
    { PHASE_IDS; for (int u = TID_; u < 256; u += NTHR) ((LAS unsigned*)(F.lds + LDSCTL_OFF))[u] = 0u; }
    __syncthreads();
    XcdBarrier bar = xcd_barrier_post((unsigned*)(F.ctl + CW_BAR), F.MISC + 8);
#define GRID_BAR() xcd_barrier(bar)
#define STAGE_END(n) do { STAGE_CHECK(n); if (TPROBE && blockIdx.x == 0 && threadIdx.x == 0) ((unsigned long long*)(F.ctl + CW_TS))[(n)] = __builtin_amdgcn_s_memrealtime(); } while (0)

    if (TPROBE && blockIdx.x == 0 && threadIdx.x == 0) ((unsigned long long*)(F.ctl + CW_TS))[0] = __builtin_amdgcn_s_memrealtime();
    for (int rep = 0; rep < (DUP_PHASE == 0 ? 2 : 1); ++rep) {
    if (PH(0)) p0_prologue(F);
    GRID_BAR(); }
    STAGE_END(1);
    if (PH(1)) { pg8::DenseSched S; S.init(wsp<bf16>(F, WS_XNB), wsp<bf16>(F, WS_WIN), T, NPROJ, DM, F.G, (int)blockIdx.x);
      float* RC = wsp<float>(F, WS_ROPE);
      EpiInProj E{wsp<bf16>(F, WS_Q), RC, RC + SEQ * 32, wsp<float>(F, WS_KMEAN)};
      for (int rep = 0; rep < (DUP_PHASE == 1 ? 2 : 1); ++rep) { if (rep) GRID_BAR();
      pg8::gemm_phase<EpiInProj, pg8::DenseSched, false, false>(F.lds + RING_OFF, DM * 2, S, E); } }
    GRID_BAR();
    STAGE_END(2);
    for (int rep = 0; rep < (DUP_PHASE == 2 ? 2 : 1); ++rep) {
    if (PH(2)) p2_mixers(F);
    GRID_BAR(); }
    STAGE_END(3);
    if (PH(3)) { pg8::DenseSched S; S.init(wsp<bf16>(F, WS_MIX), wsp<bf16>(F, WS_WOUT), T, DM, DM, F.G, (int)blockIdx.x);
      LAS f32x2* rtab = (LAS f32x2*)(F.lds + XTAB_OFF);
      Unit ua, ub; const bool ha = S.next(0, ua), hb = S.next(1, ub);
      { PHASE_IDS; const int s = TID_ >> 8, r = TID_ & 255; const bool has = s ? hb : ha; const int pm = s ? ub.pm : ua.pm;
        if (has) { const size_t row = (size_t)pm * 256 + r; const f32x4* pa = (const f32x4*)(wsp<float>(F, WS_SSQA) + row * NH); const f32x4 a0 = pa[0], a1 = pa[1], g0 = *(const f32x4*)(wsp<float>(F, WS_SSQG) + row * GG);
            const float sa = ((a0[0] + a0[1]) + (a0[2] + a0[3])) + ((a1[0] + a1[1]) + (a1[2] + a1[3])), sg = (g0[0] + g0[1]) + (g0[2] + g0[3]);
            const float ra = 1.0f / sqrtf(sa * (1.f / AW) + EPS), rg = 1.0f / sqrtf(sg * (1.f / GW) + EPS);
            rtab[s * 256 + r] = (f32x2){ra / rg, rg}; } }
      __syncthreads();
      EpiOutProj E{F.x, F.out, wsp<float>(F, WS_SSQ1), rtab, nullptr, ha ? ua.pm : -1, hb ? ub.pm : -1};
      for (int rep = 0; rep < (DUP_PHASE == 3 ? 2 : 1); ++rep) { if (rep) GRID_BAR();
      pg8::gemm_phase<EpiOutProj, pg8::DenseSched, false, true>(F.lds + RING_OFF, DM * 2, S, E); } }
    GRID_BAR();
    STAGE_END(4);
    if (PH(4)) p4_router(F);
    GRID_BAR();
    STAGE_END(5);
    if (PH(5)) { const int nu = moe_build_tables(F, 2 * FF / 256, true);
      pg8::MoeSched S{(const char*)wsp<char>(F, WS_X1F8), (const char*)wsp<char>(F, WS_WGU), 0, (size_t)2 * FF * DM, (size_t)256 * DM, nu,
                      (const LAS unsigned*)(F.lds + XTAB_OFF + XT_ULIST), (const LAS unsigned*)(F.lds + XTAB_OFF + XT_GTAB), true};
      EpiMoe1 E{wsp<unsigned char>(F, WS_ABUF), F.b_gu};
      for (int rep = 0; rep < (DUP_PHASE == 5 ? 2 : 1); ++rep) { if (rep) GRID_BAR();
      int Kb = DM; asm volatile("" : "+s"(Kb));
      pg8::gemm_phase<EpiMoe1, pg8::MoeSched, true, false, true>(F.lds + RING_OFF, Kb, S, E); } }
    GRID_BAR();
    STAGE_END(6);
    if (PH(6)) { const int nu = moe_build_tables(F, DM / 256, false);
      pg8::MoeSched S{(const char*)wsp<char>(F, WS_ABUF), (const char*)wsp<char>(F, WS_WDN), (size_t)256 * FF, (size_t)DM * FF, (size_t)256 * FF, nu,
                      (const LAS unsigned*)(F.lds + XTAB_OFF + XT_ULIST), (const LAS unsigned*)(F.lds + XTAB_OFF + XT_GTAB), false};
      EpiMoe2 E{wsp<bf16>(F, WS_YBUF), F.b_dn, wsp<float>(F, WS_GSS)};
      for (int rep = 0; rep < (DUP_PHASE == 6 ? 2 : 1); ++rep) { if (rep) GRID_BAR();
      int Kb = FF; asm volatile("" : "+s"(Kb));
      pg8::gemm_phase<EpiMoe2, pg8::MoeSched, false, false, true>(F.lds + RING_OFF, Kb, S, E); } }
    GRID_BAR();
    STAGE_END(7);
    if (PH(7)) p7_combine(F);
    GRID_BAR();
    STAGE_END(8);
    if (PH(8)) { pg8::DenseSched S; S.init(wsp<bf16>(F, WS_X2N), wsp<bf16>(F, WS_WPG), T, DM, DM, F.G, (int)blockIdx.x);
      EpiPle<0> E{wsp<bf16>(F, WS_GATE), nullptr};
      pg8::gemm_phase<EpiPle<0>, pg8::DenseSched, false, false>(F.lds + RING_OFF, DM * 2, S, E);
#if CHECK_STAGE
      GRID_BAR();
      pg8::gemm_phase<EpiPle<0>, pg8::DenseSched, false, false>(F.lds + RING_OFF, DM * 2, S, E);
#endif
    }
#if CHECK_STAGE
    GRID_BAR(); STAGE_CHECK(9);
#endif
    if (PH(8)) { pg8::DenseSched S; S.init(wsp<bf16>(F, WS_PB), wsp<bf16>(F, WS_WPP), T, DM, PLE, F.G, (int)blockIdx.x);
      EpiPle<1> E{wsp<bf16>(F, WS_PP), wsp<float>(F, WS_SSQPP)};
      int Kp = PLE * 2; asm volatile("" : "+s"(Kp));
      pg8::gemm_phase<EpiPle<1>, pg8::DenseSched, false, false>(F.lds + RING_OFF, Kp, S, E); }
    GRID_BAR();
    STAGE_END(9);
#if CHECK_STAGE
    GRID_BAR(); check_report(F);
#else
    if (PH(9)) p9_final(F);
#if TPROBE
    GRID_BAR();
    { const unsigned long long* ts = (const unsigned long long*)(F.ctl + CW_TS); if (blockIdx.x == 0 && threadIdx.x == 0) ((unsigned long long*)(F.ctl + CW_TS))[10] = __builtin_amdgcn_s_memrealtime();
      __syncthreads(); GRID_BAR();
      const float da = (float)(ts[TP_A + 1] - ts[TP_A]) * 0.01f, db = (float)(ts[TP_B + 1] - ts[TP_B]) * 0.01f;
      const float E = fminf(30.f, floorf(da / 25.f + 0.5f)), M = 1.0f + fminf(8.9f, db / 100.f);
      const float c = sqrtf(powf(10.0f, E) * M);
      for (size_t i = (size_t)blockIdx.x * NTHR + threadIdx.x; i < (size_t)T * DM; i += (size_t)gridDim.x * NTHR) F.out[i] = c; }
#endif
#endif
}

extern "C" void kernel_launch(void* const* d_in, const int* in_sizes, int n_in, void* d_out, int out_size, void* d_ws, size_t ws_size, hipStream_t stream) {
    static int grid = 0;
    if (grid == 0) {
        if (n_in != 23 || in_sizes[0] != T * DM || out_size != T * DM || ws_size < WS_END) { fprintf(stderr, "kernel_launch: unexpected shapes (n_in %d, in0 %d, out %d, ws %zu)\n", n_in, n_in > 0 ? in_sizes[0] : -1, out_size, ws_size); grid = -1; return; }
        int dev = 0, cus = 0, per_cu = 0;
        if (hipGetDevice(&dev) != hipSuccess || hipDeviceGetAttribute(&cus, hipDeviceAttributeMultiprocessorCount, dev) != hipSuccess) { grid = -1; return; }
        if (hipFuncSetAttribute((const void*)mega_fwd, hipFuncAttributeMaxDynamicSharedMemorySize, LDS_BYTES) != hipSuccess) { fprintf(stderr, "kernel_launch: hipFuncSetAttribute failed\n"); grid = -1; return; }
        if (hipOccupancyMaxActiveBlocksPerMultiprocessor(&per_cu, (const void*)mega_fwd, NTHR, LDS_BYTES) != hipSuccess || per_cu < 1)
            fprintf(stderr, "kernel_launch: note: occupancy query reports %d workgroups per CU\n", per_cu);
        (void)hipGetLastError();
        grid = cus;
    }
    if (grid < 0) return;
    if (hipMemsetAsync((char*)d_ws + WS_CTL, 0, CTL_ZERO_BYTES, stream) != hipSuccess) return;
    Args a{};
    for (int i = 0; i < 23; ++i) a.in[i] = (const float*)d_in[i];
    a.out = (float*)d_out; a.ws = (unsigned char*)d_ws;
    hipLaunchKernelGGL(mega_fwd, dim3(grid), dim3(NTHR), LDS_BYTES, stream, a);
}
```

```cpp
#include <hip/hip_runtime.h>
#include <cstdio>
#include <cstdint>

#ifndef CHECK_STAGE
#define CHECK_STAGE 0
#endif
#ifndef CHECK_REPORT
#define CHECK_REPORT 0
#endif
#ifndef CHECK_REPORT2
#define CHECK_REPORT2 0
#endif
#ifndef CHECK_REPORT3
#define CHECK_REPORT3 0
#endif
#ifndef DUP_PHASE
#define DUP_PHASE -1
#endif
#ifndef TPROBE
#define TPROBE 0
#endif
#ifndef TP_A
#define TP_A 5
#endif
#ifndef TP_B
#define TP_B 6
#endif
#ifndef CHECK_SKIP
#define CHECK_SKIP 0
#endif
#ifndef PHMASK
#define PHMASK 0x3ff
#endif
#define PH(n) ((PHMASK >> (n)) & 1)

#define GAS __attribute__((address_space(1)))
#define LAS __attribute__((address_space(3)))
typedef unsigned short bf16;
typedef unsigned v4u __attribute__((ext_vector_type(4)));
typedef unsigned v2u __attribute__((ext_vector_type(2)));
typedef float f32x2 __attribute__((ext_vector_type(2)));
typedef float f32x4 __attribute__((ext_vector_type(4)));
typedef float f32x16 __attribute__((ext_vector_type(16)));
typedef short bf16x8 __attribute__((ext_vector_type(8)));
typedef short s16x4 __attribute__((ext_vector_type(4)));
typedef GAS unsigned gu32;

constexpr int BATCH = 16, SEQ = 2048, DM = 1024, T = BATCH * SEQ;
constexpr int AW = 512, NH = 8, HD = 64, NBLK = 8, MOBA = 256;
constexpr int GW = 512, GG = 4, GD = 128, GC = 128;
constexpr int NPROJ = 3 * AW + 2 * GW;
constexpr int NE = 32, TOPK = 4, FF = 1024;
constexpr int PLE = 256;
constexpr int MAXROWS = T * TOPK + NE * 256;
constexpr float EPS = 1e-6f;
constexpr int NWAVES = 8, NTHR = 512;

constexpr size_t MiB = 1u << 20;
constexpr size_t WS_CTL = 0, CTL_ZERO_BYTES = 1 * MiB;
constexpr size_t WS_KMEAN = 256 * 1024;
constexpr size_t WS_WIN = 1 * MiB;
constexpr size_t WS_WOUT = 6 * MiB;
constexpr size_t WS_WPG = 8 * MiB;
constexpr size_t WS_WPP = 10 * MiB;
constexpr size_t WS_RWG = 10 * MiB + 512 * 1024;
constexpr size_t WS_ROPE = 11 * MiB;
constexpr size_t WS_WGU = 16 * MiB;
constexpr size_t WS_WDN = 144 * MiB;
constexpr size_t WS_XNB = 208 * MiB;
constexpr size_t WS_BIG1 = 272 * MiB;
constexpr size_t WS_Q = WS_BIG1, WS_K = WS_Q + 32 * MiB, WS_V = WS_K + 32 * MiB, WS_U = WS_V + 32 * MiB, WS_VG = WS_U + 32 * MiB, WS_MIX = WS_VG + 32 * MiB;
constexpr size_t WS_YBUF = WS_BIG1;
constexpr size_t WS_BIG2 = 544 * MiB;
constexpr size_t WS_ABUF = WS_BIG2, WS_GATE = WS_BIG2, WS_PP = WS_BIG2 + 64 * MiB;
constexpr size_t WS_PB = 816 * MiB;
constexpr size_t WS_IDX = 832 * MiB;
constexpr size_t WS_GSS = 836 * MiB;
constexpr size_t WS_TOKPOS = 840 * MiB;
constexpr size_t WS_SSQA = 841 * MiB;
constexpr size_t WS_SSQG = 842 * MiB;
constexpr size_t WS_SSQ1 = 843 * MiB;
constexpr size_t WS_SSQPP = 845 * MiB;
constexpr size_t WS_X1F8 = 848 * MiB;
constexpr size_t WS_X2N = WS_XNB;
constexpr size_t WS_X1B = 880 * MiB;
constexpr size_t WS_X2B = 944 * MiB;
constexpr size_t WS_SIG0 = 1008 * MiB;
constexpr size_t WS_RSTD2 = 1008 * MiB + 256 * 1024;
constexpr size_t WS_RWT = 1008 * MiB + 512 * 1024;
constexpr size_t WS_RSS = 1009 * MiB;
constexpr size_t WS_END = 1013 * MiB;
static_assert(WS_MIX + 64 * MiB <= WS_BIG2 && (size_t)MAXROWS * 1024 * 2 <= 272 * MiB, "ws map");
constexpr int CW_TMO = 0, CW_CODE = 1;
constexpr int CW_BAR = 4096;
constexpr int CW_CNT = 8192;
constexpr int CW_TS = 12000;
constexpr int CW_CHK = 12288;

constexpr int RING_OFF = 0, RING_BYTES = 131072;
constexpr int P0_SCR_WAVE = 64 * 65 * 4;
constexpr int LDSCTL_OFF = 8 * P0_SCR_WAVE;
constexpr int XTAB_OFF = LDSCTL_OFF + 1024;
static_assert(LDSCTL_OFF >= RING_BYTES, "lds map");
constexpr int LDS_BYTES = 163840;

#define RLX_AGENT __ATOMIC_RELAXED, __HIP_MEMORY_SCOPE_AGENT
#define LDS_WAIT() asm volatile("s_waitcnt lgkmcnt(0)" ::: "memory")
#define VM_WAIT() asm volatile("s_waitcnt vmcnt(0)" ::: "memory")
__device__ __forceinline__ unsigned f2bf(float f) { unsigned u = __builtin_bit_cast(unsigned, f); return (u + 0x7fffu + ((u >> 16) & 1u)) >> 16; }
__device__ __forceinline__ unsigned pk2(float lo, float hi) { return f2bf(lo) | (f2bf(hi) << 16); }
__device__ __forceinline__ float bf2f(unsigned short b) { return __builtin_bit_cast(float, ((unsigned)b) << 16); }
__device__ __forceinline__ float bflo(unsigned w) { return __builtin_bit_cast(float, w << 16); }
__device__ __forceinline__ float bfhi(unsigned w) { return __builtin_bit_cast(float, w & 0xffff0000u); }
typedef __bf16 bf16x2_t __attribute__((ext_vector_type(2)));
__device__ __forceinline__ unsigned cvt_pk_bf16(float lo, float hi) { const f32x2 v = {lo, hi}; const bf16x2_t b = __builtin_convertvector(v, bf16x2_t); return __builtin_bit_cast(unsigned, b); }
__device__ __forceinline__ float clamp448(float x) { return fminf(fmaxf(x, -448.0f), 448.0f); }
__device__ __forceinline__ unsigned pk4_fp8(float a, float b, float c, float d) { unsigned w = 0u; w = (unsigned)__builtin_amdgcn_cvt_pk_fp8_f32(clamp448(a), clamp448(b), (int)w, false); w = (unsigned)__builtin_amdgcn_cvt_pk_fp8_f32(clamp448(c), clamp448(d), (int)w, true); return w; }
__device__ __forceinline__ float fp8_to_f(unsigned v) { const unsigned sg = (v >> 7) & 1u, e = (v >> 3) & 15u, m = v & 7u; const float r = e ? ldexpf(1.0f + (float)m * 0.125f, (int)e - 7) : ldexpf((float)m * 0.125f, -6); return sg ? -r : r; }
__device__ __forceinline__ float wave_sum(float v) {
#pragma unroll
    for (int o = 1; o < 64; o <<= 1) v += __shfl_xor(v, o);
    return v;
}
__device__ __forceinline__ f32x2 gelu_pk(f32x2 v) {
    const f32x2 av = __builtin_elementwise_abs(v), d = av * 0.2316418882f + 1.0f;
    f32x2 t; t.x = __builtin_amdgcn_rcpf(d.x); t.y = __builtin_amdgcn_rcpf(d.y);
    f32x2 q = t * 0.5307027145f + (-0.7265760135f); q = q * t + 0.7107068705f; q = q * t + (-0.142248368f); q = q * t + 0.127414796f; q = q * t;
    const f32x2 s = (v * v) * (-0.72134752044f);
    f32x2 e; e.x = __builtin_amdgcn_exp2f(s.x); e.y = __builtin_amdgcn_exp2f(s.y);
    const f32x2 m = v * (q * e), r = v - m;
    f32x2 o; o.x = v.x < 0.f ? m.x : r.x; o.y = v.y < 0.f ? m.y : r.y; return o;
}
__device__ __forceinline__ f32x4 gelu4(f32x4 v) { const f32x2 a = gelu_pk((f32x2){v[0], v[1]}), b = gelu_pk((f32x2){v[2], v[3]}); return (f32x4){a.x, a.y, b.x, b.y}; }
__device__ __forceinline__ float sigmoidf_fast(float x) { return __builtin_amdgcn_rcpf(1.0f + __builtin_amdgcn_exp2f(-1.4426950408889634f * x)); }

#define XB_TMO      128
#define XB_XCNT(j)  (256  + 64 * (j))
#define XB_XSUB(j)  (1280 + 64 * (j))
#define XB_XGEN(j)  (2304 + 64 * (j))
#define XB_TOP      3328
#define XB_TOPGEN   3392
#define XCD_BAR_WORDS 3456
#define XB_SPIN_CAP (1u << 18)
__device__ __forceinline__ unsigned xb_ld(unsigned* p)              { return __hip_atomic_load(p, __ATOMIC_RELAXED, __HIP_MEMORY_SCOPE_AGENT); }
__device__ __forceinline__ unsigned xb_add(unsigned* p, unsigned v) { return __hip_atomic_fetch_add(p, v, __ATOMIC_RELAXED, __HIP_MEMORY_SCOPE_AGENT); }
__device__ __forceinline__ unsigned xb_xcc_id() { return (unsigned)__builtin_amdgcn_s_getreg((3 << 11) | 20) & 0xFu; }
#define XB_SPIN(cond, bar) do { unsigned _sp = 0; while (cond) { __builtin_amdgcn_s_sleep(1); \
    if ((++_sp & 255u) == 0u) { if (xb_ld(&(bar)[XB_TMO])) break; if (_sp > XB_SPIN_CAP) { atomicAdd(&(bar)[XB_TMO], 1u); break; } } } } while (0)
struct XcdBarrier { unsigned* bar; unsigned x; volatile LAS unsigned* st; };
__device__ __forceinline__ XcdBarrier xcd_barrier_post(unsigned* bar, volatile LAS unsigned* st) {
    XcdBarrier b; b.bar = bar; b.x = xb_xcc_id(); b.st = st;
    if (threadIdx.x == 0) (void)xb_add(&bar[XB_XCNT(b.x)], 1u);
    return b;
}
__device__ __forceinline__ void xcd_barrier_complete(unsigned* bar, unsigned x, unsigned& nloc, unsigned& nx) {
    const unsigned G = gridDim.x * gridDim.y * gridDim.z;
    unsigned sum, cnt, mine, sp = 0u;
    for (;;) {
        sum = 0u; cnt = 0u; mine = 0u;
#pragma unroll
        for (unsigned j = 0; j < 16; ++j) { const unsigned c = xb_ld(&bar[XB_XCNT(j)]); sum += c; cnt += (c > 0u) ? 1u : 0u; mine = (j == x) ? c : mine; }
        if (sum == G) break;
        __builtin_amdgcn_s_sleep(1);
        if ((++sp & 255u) == 0u) { if (xb_ld(&bar[XB_TMO])) break; if (sp > XB_SPIN_CAP) { atomicAdd(&bar[XB_TMO], 1u); break; } }
    }
    nloc = mine > 0u ? mine : 1u; nx = cnt > 0u ? cnt : 1u;
}
__device__ __forceinline__ void xcd_barrier(const XcdBarrier& b) {
    asm volatile("s_waitcnt vmcnt(0)" ::: "memory");
    __syncthreads();
    if (threadIdx.x == 0) {
        unsigned* bar = b.bar;
        __builtin_amdgcn_s_waitcnt(0);
        unsigned nloc = b.st[0], nx = b.st[1];
        if (nloc == 0u) { xcd_barrier_complete(bar, b.x, nloc, nx); b.st[0] = nloc; b.st[1] = nx; }
        const unsigned old = xb_add(&bar[XB_XSUB(b.x)], 1u);
        const unsigned gen = old / nloc;
        if (old + 1u == (gen + 1u) * nloc) {
            __builtin_amdgcn_fence(__ATOMIC_RELEASE, "agent");
            asm volatile("s_waitcnt vmcnt(0)" ::: "memory");
            const unsigned og = xb_add(&bar[XB_TOP], 1u);
            const unsigned tg = og / nx;
            if (og + 1u == (tg + 1u) * nx) xb_add(&bar[XB_TOPGEN], 1u);
            else XB_SPIN(xb_ld(&bar[XB_TOPGEN]) == tg, bar);
            __builtin_amdgcn_fence(__ATOMIC_ACQUIRE, "agent");
            xb_add(&bar[XB_XGEN(b.x)], 1u);
            asm volatile("s_waitcnt vmcnt(0)" ::: "memory");
        } else {
            XB_SPIN(xb_ld(&bar[XB_XGEN(b.x)]) == gen, bar);
            __builtin_amdgcn_fence(__ATOMIC_ACQUIRE, "agent");
            asm volatile("s_waitcnt vmcnt(0)" ::: "memory");
        }
    }
    __syncthreads();
}

namespace pg8 {
constexpr int BM = 256, BK = 64, HALF = 128, HTB = HALF * BK * 2, STAGE_BYTES = 8 * HTB, NXCD = 8, WGM = 8;
__host__ __device__ __forceinline__ int lds_byte(int r, int c) { const int st = (r >> 4) * 2 + (c >> 5), rr = r & 15, cc = c & 31, ob = rr * 64 + cc * 2; return st * 1024 + (ob ^ (((ob >> 9) & 1) << 5)); }
__host__ __device__ __forceinline__ void stage_rc(int b, int& R, int& C) { const int st = b / 1024, sb = b % 1024, swz = sb ^ (((sb >> 9) & 1) << 5); R = (st >> 1) * 16 + swz / 64; C = (st & 1) * 32 + (swz % 64) / 2; }
__host__ __device__ __forceinline__ int perm32(int rho) { const int n = rho >> 4, i = rho & 15; return 8 * (i >> 2) + 4 * n + (i & 3); }

typedef int v8i __attribute__((ext_vector_type(8)));
constexpr int F8_WSHIFT = 6, F8_SCALE_W = 127 - F8_WSHIFT;
typedef int v4i __attribute__((ext_vector_type(4)));
__device__ __forceinline__ v8i ld8(const LAS unsigned char* p0, const LAS unsigned char* p1) { const v4i lo = *(const LAS v4i*)p0, hi = *(const LAS v4i*)p1; return __builtin_shufflevector(lo, hi, 0, 1, 2, 3, 4, 5, 6, 7); }
struct Unit { int pm, pn, e, rt; };

__device__ __forceinline__ void flat_to_tile(int L, int nwg, int nM, int nN, int& pm, int& pn) {
    int wgid = L; { const int q = nwg / NXCD, r = nwg % NXCD, xcd = wgid % NXCD, off = wgid / NXCD; wgid = (xcd < r ? xcd * (q + 1) : r * (q + 1) + (xcd - r) * q) + off; }
    const int nig = WGM * nN, gid = wgid / nig, fm = gid * WGM, gsz = (nM - fm) < WGM ? (nM - fm) : WGM;
    pm = fm + ((wgid % nig) % gsz); pn = (wgid % nig) / gsz;
}
struct DenseSched {
    const char* A; const char* Bt; int nM, nN, nwg, G, c; size_t tstep;
    __device__ __forceinline__ void init(const void* A_, const void* Bt_, int M, int N, int K, int G_, int c_) { A = (const char*)A_; Bt = (const char*)Bt_; nM = M / BM; nN = N / BM; nwg = nM * nN; G = G_; c = c_; tstep = (size_t)BM * K * 2; }
    __device__ __forceinline__ bool next(int i, Unit& u) const { const long L = (long)i * G + c; if (L >= nwg) return false; flat_to_tile((int)L, nwg, nM, nN, u.pm, u.pn); u.e = 0; u.rt = u.pm; return true; }
    __device__ __forceinline__ const char* a_base(const Unit& u) const { return A + (size_t)u.pm * tstep; }
    __device__ __forceinline__ const char* b_base(const Unit& u) const { return Bt + (size_t)u.pn * tstep; }
    __device__ __forceinline__ void gather(int, int, int, unsigned (&)[2][2]) const {}
};
struct MoeSched {
    const char* A; const char* Bt; size_t a_tstep, b_estep, b_tstep; int nunits; const LAS unsigned* ulist; const LAS unsigned* gtab; bool gath;
    __device__ __forceinline__ bool next(int i, Unit& u) const {
        if (i >= nunits) return false;
        const unsigned w = (unsigned)__builtin_amdgcn_readfirstlane((int)ulist[i]);
        u.pm = (int)(w & 0x3ffu); u.pn = (int)((w >> 10) & 0x7u); u.e = (int)((w >> 13) & 0x1fu); u.rt = (int)(w >> 18); return true;
    }
    __device__ __forceinline__ const char* a_base(const Unit& u) const { return gath ? A : A + (size_t)u.pm * a_tstep; }
    __device__ __forceinline__ const char* b_base(const Unit& u) const { return Bt + (size_t)u.e * b_estep + (size_t)u.pn * b_tstep; }
    __device__ __forceinline__ void gather(int i, int R0, int R1, unsigned (&off)[2][2]) const {
        const LAS unsigned* g = gtab + i * 256;
        off[0][0] = g[R0]; off[0][1] = g[R1]; off[1][0] = g[128 + R0]; off[1][1] = g[128 + R1];
    }
};

#define PG8_SA(b, h) (((b) * 2 + (h)) * HTB)
#define PG8_SB(b, h) ((4 + (b) * 2 + (h)) * HTB)
#define PG8_GLDS(src, dstoff) __builtin_amdgcn_global_load_lds((const unsigned*)(src), (LAS unsigned*)(lds + (dstoff)), 16, 0, 0)
#define PG8_STAGE_B(bufoff, gbase) do { _Pragma("unroll") for (int _i = 0; _i < 2; ++_i) PG8_GLDS((const char*)(gbase) + voffB[_i], (bufoff) + ldsw + _i * 8192); } while (0)
#define PG8_STAGE_A(bufoff, kptr, h, o) do { _Pragma("unroll") for (int _i = 0; _i < 2; ++_i) \
        PG8_GLDS(GATHER ? (const char*)(kptr) + (o)[h][_i] : (const char*)(kptr) + (size_t)(h) * hstep + voffA[_i], (bufoff) + ldsw + _i * 8192); } while (0)
#define PG8_LDA(dst, b, h) do { _Pragma("unroll") for (int m = 0; m < 4; ++m) { if constexpr (F8) dst##8[m] = ld8(lds + PG8_SA(b, h) + a8_0 + m * 2048, lds + PG8_SA(b, h) + a8_1 + m * 2048); \
        else { _Pragma("unroll") for (int k = 0; k < 2; ++k) dst[m][k] = *(const LAS bf16x8*)(lds + PG8_SA(b, h) + aoff + m * 2048 + k * 1024); } } } while (0)
#define PG8_LDB(dst, b, h) do { _Pragma("unroll") for (int n = 0; n < 2; ++n) { if constexpr (F8) dst##8[n] = ld8(lds + PG8_SB(b, h) + b8_0 + n * 2048, lds + PG8_SB(b, h) + b8_1 + n * 2048); \
        else { _Pragma("unroll") for (int k = 0; k < 2; ++k) dst[n][k] = *(const LAS bf16x8*)(lds + PG8_SB(b, h) + boff + n * 2048 + k * 1024); } } } while (0)
#define PG8_MMA(ai, bj, At, Bt) do { __builtin_amdgcn_s_setprio(1); _Pragma("unroll") for (int m = 0; m < 4; ++m) _Pragma("unroll") for (int n = 0; n < 2; ++n) { \
        if constexpr (F8) asm volatile("v_mfma_scale_f32_16x16x128_f8f6f4 %0, %1, %2, %0, %3, %4 op_sel_hi:[0,0,0]" : "+v"(acc[ai][bj][m][n]) : "v"(Bt##8[n]), "v"(At##8[m]), "v"(sc_w), "v"(sc_a)); \
        else { _Pragma("unroll") for (int k = 0; k < 2; ++k) acc[ai][bj][m][n] = __builtin_amdgcn_mfma_f32_16x16x32_bf16(Bt[n][k], At[m][k], acc[ai][bj][m][n], 0, 0, 0); } } __builtin_amdgcn_s_setprio(0); } while (0)
#define PG8_WAIT_V(n) asm volatile("s_waitcnt vmcnt(" #n ")" ::: "memory")
#define PG8_WAIT_L(n) asm volatile("s_waitcnt lgkmcnt(" #n ")" ::: "memory")
#define PG8_BAR __builtin_amdgcn_s_barrier()
#define PG8_SCHED __builtin_amdgcn_sched_barrier(0)

template <class Epi, class Sched, bool GATHER, bool MIDK, bool F8 = false>
__device__ __forceinline__ void gemm_phase(LAS unsigned char* lds, const int KB  , const Sched& S, const Epi& E) {
    int tid = (int)threadIdx.x; asm volatile("" : "+v"(tid));
    const int wid = __builtin_amdgcn_readfirstlane(tid >> 6), lane = tid & 63, wr = wid >> 2, wc = wid & 3, fr = lane & 15, fq = lane >> 4;
    const int nt = KB / 128;
    unsigned voffA[2], voffB[2]; int Rg[2]; unsigned Cg[2];
#pragma unroll
    for (int i = 0; i < 2; ++i) { int R, C; stage_rc(tid * 16 + i * 8192, R, C); const int Rb = Epi::PERM ? ((R & ~31) + perm32(R & 31)) : R;
        voffA[i] = (unsigned)(R * KB + C * 2); voffB[i] = (unsigned)(Rb * KB + C * 2); Rg[i] = R; Cg[i] = (unsigned)C * 2u; }
    const size_t kstep = 128;
    const size_t hstep = (size_t)HALF * KB;
    const unsigned ldsw = (unsigned)wid * 1024u;
    const int aoff = lds_byte(wr * 64 + fr, fq * 8), boff = lds_byte(wc * 32 + fr, fq * 8);
    const int a8_0 = lds_byte(wr * 64 + fr, 16 * fq), a8_1 = lds_byte(wr * 64 + fr, 16 * fq + 8), b8_0 = lds_byte(wc * 32 + fr, 16 * fq), b8_1 = lds_byte(wc * 32 + fr, 16 * fq + 8);
    Unit cur, nxt; int ui = 0;
    if (!S.next(0, cur)) return;
    f32x4 acc[2][2][4][2];
#pragma unroll
    for (int a = 0; a < 2; ++a)
#pragma unroll
        for (int b = 0; b < 2; ++b)
#pragma unroll
            for (int m = 0; m < 4; ++m)
#pragma unroll
                for (int n = 0; n < 2; ++n) acc[a][b][m][n] = (f32x4){0.f, 0.f, 0.f, 0.f};
    bf16x8 At[4][2], B0[2][2], B1[2][2]; v8i At8[4], B08[2], B18[2];
    int sc_w = F8_SCALE_W, sc_a = 127; if constexpr (F8) { asm volatile("" : "+v"(sc_w), "+v"(sc_a)); }
    unsigned offC[2][2] = {{0u, 0u}, {0u, 0u}}, offN[2][2] = {{0u, 0u}, {0u, 0u}};
    if constexpr (GATHER) { S.gather(0, Rg[0], Rg[1], offC);
#pragma unroll
        for (int h = 0; h < 2; ++h)
#pragma unroll
            for (int i = 0; i < 2; ++i) offC[h][i] += Cg[i]; }
    const char* cA = S.a_base(cur); const char* cB = S.b_base(cur);
    PG8_STAGE_B(PG8_SB(0, 0), cB); PG8_STAGE_B(PG8_SB(0, 1), cB + hstep); PG8_STAGE_A(PG8_SA(0, 0), cA, 0, offC); PG8_STAGE_A(PG8_SA(0, 1), cA, 1, offC);
    if (wr == 1) PG8_BAR;
    PG8_WAIT_V(2); PG8_BAR;
    PG8_STAGE_B(PG8_SB(1, 0), cB + kstep); PG8_STAGE_A(PG8_SA(1, 0), cA + kstep, 0, offC); PG8_STAGE_B(PG8_SB(1, 1), cB + hstep + kstep);
    PG8_WAIT_V(6); PG8_BAR;
    for (;;) {
        const bool has_next = S.next(ui + 1, nxt);
        const char* nA = has_next ? S.a_base(nxt) : cA; const char* nB = has_next ? S.b_base(nxt) : cB;
        if constexpr (GATHER) { if (has_next) { S.gather(ui + 1, Rg[0], Rg[1], offN);
#pragma unroll
                for (int h = 0; h < 2; ++h)
#pragma unroll
                    for (int i = 0; i < 2; ++i) offN[h][i] += Cg[i]; }
            else {
#pragma unroll
                for (int h = 0; h < 2; ++h)
#pragma unroll
                    for (int i = 0; i < 2; ++i) offN[h][i] = offC[h][i]; } }
        for (int t = 0; t < nt; t += 2) {
            const bool last = (t == nt - 2);
            const char* a1 = cA + (size_t)(t + 1) * kstep;
            const char* a2 = last ? nA : cA + (size_t)(t + 2) * kstep; const char* b2 = last ? nB : cB + (size_t)(t + 2) * kstep;
            const char* a3 = a2 + kstep; const char* b3 = b2 + kstep;
            unsigned o2[2][2];
#pragma unroll
            for (int h = 0; h < 2; ++h)
#pragma unroll
                for (int i = 0; i < 2; ++i) o2[h][i] = last ? offN[h][i] : offC[h][i];
            if constexpr (MIDK) { if (t == nt / 2) E.midk(acc, cur, wr, fr); }
            PG8_LDB(B0, 0, 0); PG8_LDB(B1, 0, 1); PG8_SCHED; PG8_LDA(At, 0, 0); PG8_STAGE_A(PG8_SA(1, 1), a1, 1, offC);
            PG8_WAIT_V(8); PG8_WAIT_L(0); PG8_BAR; PG8_MMA(0, 0, At, B0); PG8_MMA(0, 1, At, B1); PG8_BAR; PG8_SCHED;
            PG8_LDA(At, 0, 1); PG8_STAGE_B(PG8_SB(0, 0), b2); PG8_STAGE_B(PG8_SB(0, 1), b2 + hstep); PG8_STAGE_A(PG8_SA(0, 0), a2, 0, o2);
            PG8_WAIT_V(8); PG8_WAIT_L(0); PG8_BAR; PG8_MMA(1, 0, At, B0); PG8_MMA(1, 1, At, B1); PG8_BAR; PG8_SCHED;
            PG8_LDB(B0, 1, 0); PG8_LDB(B1, 1, 1); PG8_SCHED; PG8_LDA(At, 1, 0); PG8_STAGE_A(PG8_SA(0, 1), a2, 1, o2);
            PG8_WAIT_V(8); PG8_WAIT_L(0); PG8_BAR; PG8_MMA(0, 0, At, B0); PG8_MMA(0, 1, At, B1); PG8_BAR; PG8_SCHED;
            PG8_LDA(At, 1, 1); PG8_STAGE_B(PG8_SB(1, 0), b3); PG8_STAGE_B(PG8_SB(1, 1), b3 + hstep); PG8_STAGE_A(PG8_SA(1, 0), a3, 0, o2);
            PG8_WAIT_V(8); PG8_WAIT_L(0); PG8_BAR; PG8_MMA(1, 0, At, B0); PG8_MMA(1, 1, At, B1); PG8_BAR; PG8_SCHED;
        }
        if (wr == 0) PG8_BAR;
        if constexpr (F8) asm volatile("s_nop 15\n\ts_nop 15" ::: "memory");
        E(acc, cur, wr, wc, fr, fq);
        if (!has_next) break;
#pragma unroll
        for (int a = 0; a < 2; ++a)
#pragma unroll
            for (int b = 0; b < 2; ++b)
#pragma unroll
                for (int m = 0; m < 4; ++m)
#pragma unroll
                    for (int n = 0; n < 2; ++n) acc[a][b][m][n] = (f32x4){0.f, 0.f, 0.f, 0.f};
        cur = nxt; cA = nA; cB = nB; ++ui;
        if constexpr (GATHER) {
#pragma unroll
            for (int h = 0; h < 2; ++h)
#pragma unroll
                for (int i = 0; i < 2; ++i) offC[h][i] = offN[h][i]; }
        if (wr == 1) PG8_BAR;
    }
    PG8_WAIT_V(0);
    PG8_BAR;
}
}

struct Frame {
    LAS unsigned char* lds;
    volatile LAS unsigned* MISC;
    gu32* ctl;
    unsigned char* ws;
    int vcu, G;
    const float *x, *p, *mix_norm, *w_in, *ln_g, *ln_b, *gws, *gbs, *aon, *gon, *w_out, *ffn_norm, *router_w, *router_b, *w_gu, *b_gu, *w_dn, *b_dn, *ple_norm, *w_pg, *w_pp, *ppn, *final_norm;
    float* out;
};
template <class T_> __device__ __forceinline__ T_* wsp(const Frame& F, size_t off) { return (T_*)(F.ws + off); }

#define PHASE_IDS int TID_ = (int)threadIdx.x; asm volatile("" : "+v"(TID_)); const int LANE_ = TID_ & 63; const int WAVE_ = __builtin_amdgcn_readfirstlane(TID_ >> 6); (void)LANE_; (void)WAVE_
template <class ColMap>
__device__ __forceinline__ void p0_transpose_item(const float* W, int K, int N, bf16* WT, const float* gain, LAS float* scr, int item, int lane, int nphys, const ColMap& cm) {
    const int nblk = nphys / 64, kb = item / nblk, nb = item % nblk, k0 = 64 * kb, n0 = 64 * nb;
    const int srccol = cm(n0 + lane);
    float v_[64]; const float* src = W + (size_t)k0 * N + srccol;
#pragma unroll
    for (int kk = 0; kk < 64; ++kk) v_[kk] = __builtin_nontemporal_load(src + (size_t)kk * N);
    if (gain) {
#pragma unroll
        for (int kk = 0; kk < 64; kk += 4) { const f32x4 g4 = *(const f32x4*)(gain + k0 + kk); v_[kk] *= g4[0]; v_[kk + 1] *= g4[1]; v_[kk + 2] *= g4[2]; v_[kk + 3] *= g4[3]; } }
#pragma unroll
    for (int kk = 0; kk < 64; ++kk) scr[kk * 65 + lane] = v_[kk];
    LDS_WAIT(); asm volatile("" ::: "memory");
    const int c = lane & 7;
#pragma unroll
    for (int j = 0; j < 8; ++j) { const int n = (lane >> 3) + 8 * j; const LAS float* s = scr + (8 * c) * 65 + n;
        v4u o; o.x = pk2(s[0 * 65], s[1 * 65]); o.y = pk2(s[2 * 65], s[3 * 65]); o.z = pk2(s[4 * 65], s[5 * 65]); o.w = pk2(s[6 * 65], s[7 * 65]);
        *(GAS v4u*)(WT + (size_t)(n0 + n) * K + k0 + 8 * c) = o; }
    LDS_WAIT(); asm volatile("" ::: "memory");
}
template <class ColMap>
__device__ __forceinline__ void p0_transpose_item_f8(const float* W, int K, int N, unsigned char* WT, const float* gain, LAS float* scr, int item, int lane, int nphys, const ColMap& cm) {
    const int nblk = nphys / 64, kb = item / nblk, nb = item % nblk, k0 = 64 * kb, n0 = 64 * nb;
    const int srccol = cm(n0 + lane);
    float v_[64]; const float* src = W + (size_t)k0 * N + srccol;
#pragma unroll
    for (int kk = 0; kk < 64; ++kk) v_[kk] = __builtin_nontemporal_load(src + (size_t)kk * N);
    constexpr float WS_ = (float)(1 << pg8::F8_WSHIFT);
#pragma unroll
    for (int kk = 0; kk < 64; kk += 4) { f32x4 g4 = gain ? *(const f32x4*)(gain + k0 + kk) : (f32x4){1.f, 1.f, 1.f, 1.f}; v_[kk] *= g4[0] * WS_; v_[kk + 1] *= g4[1] * WS_; v_[kk + 2] *= g4[2] * WS_; v_[kk + 3] *= g4[3] * WS_; }
#pragma unroll
    for (int kk = 0; kk < 64; ++kk) scr[kk * 65 + lane] = v_[kk];
    LDS_WAIT(); asm volatile("" ::: "memory");
    const int c = lane & 3;
#pragma unroll
    for (int j = 0; j < 4; ++j) { const int n = (lane >> 2) + 16 * j; const LAS float* s_ = scr + (16 * c) * 65 + n;
        v4u o; o.x = pk4_fp8(s_[0 * 65], s_[1 * 65], s_[2 * 65], s_[3 * 65]); o.y = pk4_fp8(s_[4 * 65], s_[5 * 65], s_[6 * 65], s_[7 * 65]);
        o.z = pk4_fp8(s_[8 * 65], s_[9 * 65], s_[10 * 65], s_[11 * 65]); o.w = pk4_fp8(s_[12 * 65], s_[13 * 65], s_[14 * 65], s_[15 * 65]);
        *(GAS v4u*)(WT + (size_t)(n0 + n) * K + k0 + 16 * c) = o; }
    LDS_WAIT(); asm volatile("" ::: "memory");
}
struct CmId { __device__ __forceinline__ int operator()(int n) const { return n; } };
struct CmWin { __device__ __forceinline__ int operator()(int n) const { if (n >= 2 * AW) return n; const int c = n & 63; return (n & ~63) + 4 * (c >> 3) + (c & 3) + 32 * ((c >> 2) & 1); } };
struct CmWgu { __device__ __forceinline__ int operator()(int n) const { return ((n >> 7) & 1) * FF + (n >> 8) * 128 + (n & 127); } };

__device__ __forceinline__ void p0_prologue(Frame& F) {
    PHASE_IDS;
    LAS float* scr = (LAS float*)(F.lds + RING_OFF + WAVE_ * P0_SCR_WAVE);
    const int gw = F.vcu * NWAVES + WAVE_, NGW = F.G * NWAVES;
    constexpr int I_GU = (DM / 64) * (2 * FF / 64), I_DN = (FF / 64) * (DM / 64), I_IN = (DM / 64) * (NPROJ / 64), I_SQ = (DM / 64) * (DM / 64), I_PP = (PLE / 64) * (DM / 64);
    constexpr int NITEMS = NE * I_GU + NE * I_DN + I_IN + 2 * I_SQ + I_PP;
    unsigned char* WGU = wsp<unsigned char>(F, WS_WGU); unsigned char* WDN = wsp<unsigned char>(F, WS_WDN);
    for (int it = gw; it < NITEMS; it += NGW) {
        int r = it;
        if (r < NE * I_GU) { const int e = r / I_GU; p0_transpose_item_f8(F.w_gu + (size_t)e * DM * 2 * FF, DM, 2 * FF, WGU + (size_t)e * 2 * FF * DM, F.ffn_norm, scr, r % I_GU, LANE_, 2 * FF, CmWgu()); continue; } r -= NE * I_GU;
        if (r < NE * I_DN) { const int e = r / I_DN; p0_transpose_item_f8(F.w_dn + (size_t)e * FF * DM, FF, DM, WDN + (size_t)e * DM * FF, nullptr, scr, r % I_DN, LANE_, DM, CmId()); continue; } r -= NE * I_DN;
        if (r < I_IN) { p0_transpose_item(F.w_in, DM, NPROJ, wsp<bf16>(F, WS_WIN), F.mix_norm, scr, r, LANE_, NPROJ, CmWin()); continue; } r -= I_IN;
        if (r < I_SQ) {
            const int nblk = DM / 64, kb = r / nblk; const float* g = (kb < 8) ? F.aon : (F.gon - AW);
            p0_transpose_item(F.w_out, DM, DM, wsp<bf16>(F, WS_WOUT), g, scr, r, LANE_, DM, CmId()); continue; } r -= I_SQ;
        if (r < I_SQ) { p0_transpose_item(F.w_pg, DM, DM, wsp<bf16>(F, WS_WPG), F.ple_norm, scr, r, LANE_, DM, CmId()); continue; } r -= I_SQ;
        p0_transpose_item(F.w_pp, PLE, DM, wsp<bf16>(F, WS_WPP), nullptr, scr, r, LANE_, DM, CmId());
    }
    bf16* XN = wsp<bf16>(F, WS_XNB);
    for (int m = gw; m < T; m += NGW) {
        const GAS f32x4* xr = (const GAS f32x4*)(F.x + (size_t)m * DM) + LANE_;
        f32x4 v[4]; float s = 0.f;
#pragma unroll
        for (int j = 0; j < 4; ++j) { v[j] = xr[64 * j]; s += (v[j].x * v[j].x + v[j].y * v[j].y) + (v[j].z * v[j].z + v[j].w * v[j].w); }
        const float sig = sqrtf(wave_sum(s) * (1.f / DM) + EPS), rstd = 1.0f / sig;
        if (LANE_ == 0) wsp<float>(F, WS_SIG0)[m] = sig;
        GAS v2u* o8 = (GAS v2u*)(XN + (size_t)m * DM) + LANE_;
#pragma unroll
        for (int j = 0; j < 4; ++j) { v2u w; w.x = pk2(v[j].x * rstd, v[j].y * rstd); w.y = pk2(v[j].z * rstd, v[j].w * rstd); o8[64 * j] = w; }
    }
    { const GAS f32x4* pr = (const GAS f32x4*)F.p; GAS v2u* po = (GAS v2u*)wsp<bf16>(F, WS_PB);
      const size_t n4 = (size_t)T * PLE / 4, gt = (size_t)(F.vcu * NTHR + TID_), GT = (size_t)F.G * NTHR;
      for (size_t i = gt; i < n4; i += GT) { const f32x4 v = pr[i]; v2u w; w.x = pk2(v.x, v.y); w.y = pk2(v.z, v.w); po[i] = w; } }
    { const int gt = F.vcu * NTHR + TID_, GT = F.G * NTHR; float* RWG = wsp<float>(F, WS_RWG);
      (void)RWG; bf16* RWT = wsp<bf16>(F, WS_RWT);
      for (int i = gt; i < DM * NE; i += GT) { const int e = i / DM, k = i % DM; const float w = F.router_w[k * NE + e] * F.ffn_norm[k]; const unsigned hi = f2bf(w); const float lo = w - bf2f((bf16)hi); RWT[i] = (bf16)hi; RWT[NE * DM + i] = (bf16)f2bf(lo); }
      float* RC = wsp<float>(F, WS_ROPE); float* RS = RC + SEQ * 32;
      for (int i = gt; i < SEQ * 32; i += GT) { const int pos = i >> 5, j = i & 31; const float inv = powf(10000.0f, -(float)j / 32.0f); const float ang = (float)pos * inv; float sn, cs; sincosf(ang, &sn, &cs); RC[i] = cs; RS[i] = sn; } }
}

using pg8::Unit;
constexpr int HALF = 128;
struct EpiInProj {
    static constexpr bool PERM = true;
    bf16* QKVUV; const float *rc, *rs; float* kmean;
    __device__ __forceinline__ void operator()(const f32x4 (&acc)[2][2][4][2], const Unit& u, int wr, int wc, int fr, int fq) const {
        const int type = u.pn >> 1, colt = (u.pn & 1) * 256 + wc * 32 + 8 * fq;
        const int row0 = u.pm * 256 + wr * 64 + fr;
        if (type <= 1) {
            bf16* dst = QKVUV + (size_t)type * (16u << 20);
            const int pos0 = (u.pm & 7) * 256 + wr * 64 + fr, i0 = 16 * (wc & 1) + 4 * fq;
            f32x4 cs_[2][2];
#pragma unroll
            for (int bj = 0; bj < 2; ++bj) { cs_[bj][0] = (f32x4){0.f, 0.f, 0.f, 0.f}; cs_[bj][1] = (f32x4){0.f, 0.f, 0.f, 0.f}; }
#pragma unroll
            for (int ai = 0; ai < 2; ++ai) { f32x4 cc[4], ss[4];
#pragma unroll
                for (int m = 0; m < 4; ++m) { const int pos = pos0 + ai * HALF + m * 16; cc[m] = *(const f32x4*)(rc + pos * 32 + i0); ss[m] = *(const f32x4*)(rs + pos * 32 + i0); }
#pragma unroll
                for (int m = 0; m < 4; ++m) { const int ro = ai * HALF + m * 16; const f32x4 c = cc[m], s = ss[m];
                    bf16* rowp = dst + (size_t)(row0 + ro) * AW + colt;
#pragma unroll
                    for (int bj = 0; bj < 2; ++bj) { const f32x4 x1 = acc[ai][bj][m][0], x2 = acc[ai][bj][m][1];
                        const f32x4 o1 = x1 * c - x2 * s, o2 = x2 * c + x1 * s;
                        cs_[bj][0] += o1; cs_[bj][1] += o2;
                        v4u w; w.x = cvt_pk_bf16(o1[0], o1[1]); w.y = cvt_pk_bf16(o1[2], o1[3]); w.z = cvt_pk_bf16(o2[0], o2[1]); w.w = cvt_pk_bf16(o2[2], o2[3]);
                        *(v4u*)(rowp + bj * HALF) = w; } }
                asm volatile("" ::: "memory"); }
            if (type == 1) {
#pragma unroll
                for (int bj = 0; bj < 2; ++bj)
#pragma unroll
                    for (int n = 0; n < 2; ++n)
#pragma unroll
                        for (int j = 0; j < 4; ++j) { float v = cs_[bj][n][j]; v += __shfl_xor(v, 1); v += __shfl_xor(v, 2); v += __shfl_xor(v, 4); v += __shfl_xor(v, 8); cs_[bj][n][j] = v; }
                if (fr == 0) { const int b = u.pm >> 3, blk = u.pm & 7;
#pragma unroll
                    for (int bj = 0; bj < 2; ++bj) { const int colh = (u.pn & 1) * 256 + bj * HALF + wc * 32; const int head = colh >> 6, cpos = (colh & 63) + 8 * fq;
                        float* km = kmean + ((size_t)((b * NH + head) * NBLK + blk)) * HD + cpos;
#pragma unroll
                        for (int n = 0; n < 2; ++n)
#pragma unroll
                            for (int j = 0; j < 4; ++j) atomicAdd(km + 4 * n + j, cs_[bj][n][j]); } }
            }
        } else {
            bf16* dst = QKVUV + (size_t)type * (16u << 20);
#pragma unroll
            for (int ai = 0; ai < 2; ++ai)
#pragma unroll
                for (int m = 0; m < 4; ++m) { bf16* rowp = dst + (size_t)(row0 + ai * HALF + m * 16) * AW + colt;
#pragma unroll
                    for (int bj = 0; bj < 2; ++bj) { f32x4 v0 = acc[ai][bj][m][0], v1 = acc[ai][bj][m][1];
                        if (type >= 3) { v0 = gelu4(v0); v1 = gelu4(v1); }
                        v4u w; w.x = cvt_pk_bf16(v0[0], v0[1]); w.y = cvt_pk_bf16(v0[2], v0[3]); w.z = cvt_pk_bf16(v1[0], v1[1]); w.w = cvt_pk_bf16(v1[2], v1[3]);
                        *(v4u*)(rowp + bj * HALF) = w; } }
        }
    }
};
struct EpiOutProj {
    static constexpr bool PERM = true;
    const bf16* xn; const float* sig0; bf16* x1; unsigned char* x1f8; float* ssq1; const LAS f32x2* rtab;
    int pm_a, pm_b;
    __device__ __forceinline__ int slot(const Unit& u) const { return u.pm == pm_a ? 0 : 1; }
    __device__ __forceinline__ void midk(f32x4 (&acc)[2][2][4][2], const Unit& u, int wr, int fr) const {
        const LAS f32x2* t = rtab + slot(u) * 256 + wr * 64 + fr;
#pragma unroll
        for (int ai = 0; ai < 2; ++ai)
#pragma unroll
            for (int m = 0; m < 4; ++m) { const float r = t[ai * HALF + m * 16].x;
#pragma unroll
                for (int bj = 0; bj < 2; ++bj)
#pragma unroll
                    for (int n = 0; n < 2; ++n) acc[ai][bj][m][n] *= r; }
    }
    __device__ __forceinline__ void operator()(const f32x4 (&acc)[2][2][4][2], const Unit& u, int wr, int wc, int fr, int fq) const {
        const LAS f32x2* t = rtab + slot(u) * 256 + wr * 64 + fr;
        const int row0 = u.pm * 256 + wr * 64 + fr, col0 = u.pn * 256 + wc * 32 + 8 * fq;
#pragma unroll
        for (int ai = 0; ai < 2; ++ai) { v4u xv[4][2]; float sg[4];
#pragma unroll
            for (int m = 0; m < 4; ++m) { const size_t off = (size_t)(row0 + ai * HALF + m * 16) * DM + col0; sg[m] = sig0[row0 + ai * HALF + m * 16];
                xv[m][0] = *(const v4u*)(xn + off); xv[m][1] = *(const v4u*)(xn + off + HALF); }
#pragma unroll
            for (int m = 0; m < 4; ++m) { const int ro = ai * HALF + m * 16; const float rg = t[ro].y, sx = sg[m]; const size_t off = (size_t)(row0 + ro) * DM + col0; float q = 0.f;
#pragma unroll
                for (int bj = 0; bj < 2; ++bj) { const v4u xw = xv[m][bj];
                    const f32x4 x0 = {bflo(xw.x), bfhi(xw.x), bflo(xw.y), bfhi(xw.y)}, x1_ = {bflo(xw.z), bfhi(xw.z), bflo(xw.w), bfhi(xw.w)};
                    const f32x4 o0 = x0 * sx + acc[ai][bj][m][0] * rg, o1 = x1_ * sx + acc[ai][bj][m][1] * rg;
                    q += (o0[0] * o0[0] + o0[1] * o0[1]) + (o0[2] * o0[2] + o0[3] * o0[3]) + (o1[0] * o1[0] + o1[1] * o1[1]) + (o1[2] * o1[2] + o1[3] * o1[3]);
                    v4u w; w.x = cvt_pk_bf16(o0[0], o0[1]); w.y = cvt_pk_bf16(o0[2], o0[3]); w.z = cvt_pk_bf16(o1[0], o1[1]); w.w = cvt_pk_bf16(o1[2], o1[3]);
                    *(v4u*)(x1 + off + bj * HALF) = w;
                    v2u w8; w8.x = pk4_fp8(o0[0], o0[1], o0[2], o0[3]); w8.y = pk4_fp8(o1[0], o1[1], o1[2], o1[3]); *(v2u*)(x1f8 + off + bj * HALF) = w8; }
                q += __shfl_xor(q, 16); q += __shfl_xor(q, 32);
                if (fq == 0) ssq1[(size_t)(row0 + ro) * 16 + u.pn * 4 + wc] = q; }
            asm volatile("" ::: "memory"); }
    }
};
struct EpiMoe1 {
    static constexpr bool PERM = true;
    unsigned char* A; const float* b_gu; const float* rss;
    __device__ __forceinline__ void operator()(const f32x4 (&acc)[2][2][4][2], const Unit& u, int wr, int wc, int fr, int fq) const {
        const int row0 = u.pm * 256 + wr * 64 + fr, col = u.pn * 128 + wc * 32 + 8 * fq;
        const float* bg = b_gu + (size_t)u.e * 2 * FF + col; const float* rs_ = rss + (size_t)u.e * T + u.rt * 256 + wr * 64 + fr;
        float rsv[2][4];
#pragma unroll
        for (int ai = 0; ai < 2; ++ai)
#pragma unroll
            for (int m = 0; m < 4; ++m) rsv[ai][m] = rs_[ai * HALF + m * 16];
        f32x4 bgv[2], blv[2];
#pragma unroll
        for (int n = 0; n < 2; ++n) { bgv[n] = *(const f32x4*)(bg + 4 * n); blv[n] = *(const f32x4*)(bg + FF + 4 * n); }
#pragma unroll
        for (int ai = 0; ai < 2; ++ai)
#pragma unroll
            for (int m = 0; m < 4; ++m) { f32x4 a[2];
#pragma unroll
                for (int n = 0; n < 2; ++n) { const f32x4 g = acc[ai][0][m][n] * rsv[ai][m] + bgv[n], l = acc[ai][1][m][n] * rsv[ai][m] + blv[n];
#pragma unroll
                    for (int j = 0; j < 4; ++j) { const float gc = fminf(g[j], 7.0f), lc = fminf(fmaxf(l[j], -7.0f), 7.0f); a[n][j] = gc * sigmoidf_fast(1.702f * gc) * (lc + 1.0f); } }
                v2u w; w.x = pk4_fp8(a[0][0], a[0][1], a[0][2], a[0][3]); w.y = pk4_fp8(a[1][0], a[1][1], a[1][2], a[1][3]);
                *(v2u*)(A + (size_t)(row0 + ai * HALF + m * 16) * FF + col) = w; }
    }
};
struct EpiMoe2 {
    static constexpr bool PERM = true;
    bf16* Y; const float* b_dn; const float* gss;
    __device__ __forceinline__ void operator()(const f32x4 (&acc)[2][2][4][2], const Unit& u, int wr, int wc, int fr, int fq) const {
        const int row0 = u.pm * 256 + wr * 64 + fr, col0 = u.pn * 256 + wc * 32 + 8 * fq;
        const float* gs = gss + (size_t)u.e * T + u.rt * 256 + wr * 64 + fr;
        f32x4 bv[2][2];
#pragma unroll
        for (int bj = 0; bj < 2; ++bj)
#pragma unroll
            for (int n = 0; n < 2; ++n) bv[bj][n] = *(const f32x4*)(b_dn + (size_t)u.e * DM + col0 + bj * HALF + 4 * n);
#pragma unroll
        for (int ai = 0; ai < 2; ++ai)
#pragma unroll
            for (int m = 0; m < 4; ++m) { const float g = gs[ai * HALF + m * 16]; bf16* rowp = Y + (size_t)(row0 + ai * HALF + m * 16) * DM + col0;
#pragma unroll
                for (int bj = 0; bj < 2; ++bj) { const f32x4 v0 = (acc[ai][bj][m][0] + bv[bj][0]) * g, v1 = (acc[ai][bj][m][1] + bv[bj][1]) * g;
                    v4u w; w.x = cvt_pk_bf16(v0[0], v0[1]); w.y = cvt_pk_bf16(v0[2], v0[3]); w.z = cvt_pk_bf16(v1[0], v1[1]); w.w = cvt_pk_bf16(v1[2], v1[3]);
                    *(v4u*)(rowp + bj * HALF) = w; } }
    }
};
template <int MODE> struct EpiPle {
    static constexpr bool PERM = true;
    bf16* O; float* ssq;
    __device__ __forceinline__ void operator()(const f32x4 (&acc)[2][2][4][2], const Unit& u, int wr, int wc, int fr, int fq) const {
        const int row0 = u.pm * 256 + wr * 64 + fr, col0 = u.pn * 256 + wc * 32 + 8 * fq;
#pragma unroll
        for (int ai = 0; ai < 2; ++ai)
#pragma unroll
            for (int m = 0; m < 4; ++m) { bf16* rowp = O + (size_t)(row0 + ai * HALF + m * 16) * DM + col0; float q = 0.f; const float rs = (MODE == 0) ? ssq[row0 + ai * HALF + m * 16] : 1.0f;
#pragma unroll
                for (int bj = 0; bj < 2; ++bj) { f32x4 v0 = acc[ai][bj][m][0], v1 = acc[ai][bj][m][1];
                    if (MODE == 0) {
#pragma unroll
                        for (int j = 0; j < 4; ++j) { v0[j] = sigmoidf_fast(rs * v0[j]); v1[j] = sigmoidf_fast(rs * v1[j]); } }
                    else { q += (v0[0] * v0[0] + v0[1] * v0[1]) + (v0[2] * v0[2] + v0[3] * v0[3]) + (v1[0] * v1[0] + v1[1] * v1[1]) + (v1[2] * v1[2] + v1[3] * v1[3]); }
                    v4u w; w.x = cvt_pk_bf16(v0[0], v0[1]); w.y = cvt_pk_bf16(v0[2], v0[3]); w.z = cvt_pk_bf16(v1[0], v1[1]); w.w = cvt_pk_bf16(v1[2], v1[3]);
                    *(v4u*)(rowp + bj * HALF) = w; }
                if (MODE == 1) { q += __shfl_xor(q, 16); q += __shfl_xor(q, 32); if (fq == 0) ssq[(size_t)(row0 + ai * HALF + m * 16) * 16 + u.pn * 4 + wc] = q; } }
    }
};

namespace att {
constexpr int QBLK = 32, KVBLK = 64;
constexpr float SCALE = 0.125f, THR = 8.f;
constexpr int SHM_V = KVBLK * HD * 2, SHM_K = SHM_V;
constexpr int LDS_BYTES_ = 2 * SHM_V + 2 * SHM_K + NWAVES * 64 * 4;
#define ATT_KSWZ(row, colB) ((row) * 128 + ((colB) ^ (((row) & 7) << 4)))
#define ATT_SBAR() __builtin_amdgcn_sched_barrier(0)
__device__ __forceinline__ int crow(int r, int hi) { return (r & 3) + 8 * (r >> 2) + 4 * hi; }
__device__ __forceinline__ void cmask(f32x16& p0, f32x16& p1, int jb, int qrel, int hi) {
    const float NEG = -__builtin_inff(); const int kb = 64 * jb + 4 * hi;
#pragma unroll
    for (int r = 0; r < 16; ++r) { const int kv = kb + (r & 3) + 8 * (r >> 2); if (kv > qrel) p0[r] = NEG; if (kv + 32 > qrel) p1[r] = NEG; }
}
__device__ __forceinline__ void bmask(f32x16& p0, f32x16& p1, bool keep) {
    const float NEG = -__builtin_inff();
    if (!keep) {
#pragma unroll
        for (int r = 0; r < 16; ++r) { p0[r] = NEG; p1[r] = NEG; } }
}
__device__ __forceinline__ void partialSM(f32x16& p0, f32x16& p1, float& m_reg, float& mn, float& alpha, bool keep) {
    float pmax = p0[0];
#pragma unroll
    for (int r = 1; r < 16; ++r) pmax = fmaxf(pmax, p0[r]);
#pragma unroll
    for (int r = 0; r < 16; ++r) pmax = fmaxf(pmax, p1[r]);
    { auto rr = __builtin_amdgcn_permlane32_swap(__float_as_uint(pmax), __float_as_uint(pmax), false, false);
      pmax = fmaxf(__uint_as_float(rr[0]), __uint_as_float(rr[1])); }
    if (!keep) pmax = -__builtin_inff();
    constexpr float C2 = 1.4426950408889634f * SCALE;
    if (__builtin_expect(__all((pmax - m_reg) * SCALE <= THR), 1)) { mn = m_reg; alpha = 1.f; }
    else { mn = fmaxf(m_reg, pmax); alpha = __builtin_amdgcn_exp2f((m_reg - mn) * C2); m_reg = mn; }
    const float mnL = keep ? -mn * C2 : -__builtin_inff(), c2 = keep ? C2 : 0.f;
#pragma unroll
    for (int r = 0; r < 16; ++r) p0[r] = fmaf(p0[r], c2, mnL);
#pragma unroll
    for (int r = 0; r < 16; ++r) p1[r] = fmaf(p1[r], c2, mnL);
#pragma unroll
    for (int r = 0; r < 16; ++r) p0[r] = __builtin_amdgcn_exp2f(p0[r]);
}
__device__ __forceinline__ void finishSM(f32x16& p0, f32x16& p1, float alpha, float& l_reg, bf16x8& pa0, bf16x8& pa1, bf16x8& pa2, bf16x8& pa3) {
#pragma unroll
    for (int r = 0; r < 16; ++r) p1[r] = __builtin_amdgcn_exp2f(p1[r]);
    float ps = 0;
#pragma unroll
    for (int r = 0; r < 16; ++r) ps += p0[r];
#pragma unroll
    for (int r = 0; r < 16; ++r) ps += p1[r];
    { auto rr = __builtin_amdgcn_permlane32_swap(__float_as_uint(ps), __float_as_uint(ps), false, false);
      ps = __uint_as_float(rr[0]) + __uint_as_float(rr[1]); }
    l_reg = l_reg * alpha + ps;
#define ATT_PK4(P, B, OUT) do { unsigned a0 = cvt_pk_bf16(P[B+0], P[B+1]), a1 = cvt_pk_bf16(P[B+2], P[B+3]);             \
        unsigned b0 = cvt_pk_bf16(P[B+4], P[B+5]), b1 = cvt_pk_bf16(P[B+6], P[B+7]);                                       \
        auto r0 = __builtin_amdgcn_permlane32_swap(a0, b0, false, false); auto r1 = __builtin_amdgcn_permlane32_swap(a1, b1, false, false); \
        v4u w = {r0[0], r1[0], r0[1], r1[1]}; OUT = *reinterpret_cast<bf16x8*>(&w); } while (0)
    ATT_PK4(p0, 0, pa0); ATT_PK4(p0, 8, pa1); ATT_PK4(p1, 0, pa2); ATT_PK4(p1, 8, pa3);
#undef ATT_PK4
}
__device__ __forceinline__ void qkt(f32x16& p0, f32x16& p1, const LAS unsigned char* Ks, const bf16x8* qr, int r32, int hi) {
    p0 = f32x16{}; p1 = f32x16{};
#pragma unroll
    for (int d0 = 0; d0 < 4; ++d0) { const int cb = (d0 * 16 + hi * 8) * 2;
        const bf16x8 b0 = *(const LAS bf16x8*)(Ks + ATT_KSWZ(r32, cb));
        const bf16x8 b1 = *(const LAS bf16x8*)(Ks + ATT_KSWZ(32 + r32, cb));
        p0 = __builtin_amdgcn_mfma_f32_32x32x16_bf16(b0, qr[d0], p0, 0, 0, 0);
        p1 = __builtin_amdgcn_mfma_f32_32x32x16_bf16(b1, qr[d0], p1, 0, 0, 0); }
}
__device__ __forceinline__ void pv(f32x16* o, int vb, bf16x8 pa0, bf16x8 pa1, bf16x8 pa2, bf16x8 pa3) {
#pragma unroll
    for (int d0 = 0; d0 < 2; ++d0) { s16x4 lo[4], hi[4];
#pragma unroll
        for (int ks = 0; ks < 4; ++ks) { const int a = vb + d0 * 2048 + (ks >> 1) * 4096 + (ks & 1) * 512;
            asm volatile("ds_read_b64_tr_b16 %0,%1" : "=&v"(lo[ks]) : "v"(a) : "memory");
            asm volatile("ds_read_b64_tr_b16 %0,%1 offset:128" : "=&v"(hi[ks]) : "v"(a) : "memory"); }
        asm volatile("s_waitcnt lgkmcnt(0)" ::: "memory"); ATT_SBAR();
#define ATT_PK(k) (bf16x8){lo[k][0], lo[k][1], lo[k][2], lo[k][3], hi[k][0], hi[k][1], hi[k][2], hi[k][3]}
        o[d0] = __builtin_amdgcn_mfma_f32_32x32x16_bf16(pa0, ATT_PK(0), o[d0], 0, 0, 0);
        o[d0] = __builtin_amdgcn_mfma_f32_32x32x16_bf16(pa1, ATT_PK(1), o[d0], 0, 0, 0);
        o[d0] = __builtin_amdgcn_mfma_f32_32x32x16_bf16(pa2, ATT_PK(2), o[d0], 0, 0, 0);
        o[d0] = __builtin_amdgcn_mfma_f32_32x32x16_bf16(pa3, ATT_PK(3), o[d0], 0, 0, 0);
#undef ATT_PK
    }
}
__device__ __forceinline__ void attn_unit(const Frame& F, int b, int h, int qb, LAS unsigned char* scratch) {
    PHASE_IDS;
    const int tid = TID_, wid = tid >> 6, lane = tid & 63, r32 = lane & 31, hi = lane >> 5;
    const bf16* Qg = wsp<bf16>(F, WS_Q); const bf16* Kg = wsp<bf16>(F, WS_K); const bf16* Vg = wsp<bf16>(F, WS_V);
    const size_t rowbase = (size_t)b * SEQ; const int q0 = qb * MOBA;
    const bf16* Qw = Qg + (rowbase + q0 + wid * QBLK) * AW + h * HD;
    const bf16* Kh = Kg + rowbase * AW + h * HD; const bf16* Vh = Vg + rowbase * AW + h * HD;
    LAS unsigned char* V_lds = scratch; LAS unsigned char* K_lds = scratch + 2 * SHM_V;
    LAS float* wsf = (LAS float*)(scratch + 2 * SHM_V + 2 * SHM_K) + wid * 64; LAS float* li_l = wsf; LAS float* al_l = wsf + 32;
    float m_reg = -1e30f, l_reg = 0.f; f32x16 o[2]; o[0] = f32x16{}; o[1] = f32x16{}; bf16x8 qr[4];
#pragma unroll
    for (int d0 = 0; d0 < 4; ++d0) qr[d0] = *(const bf16x8*)(Qw + (size_t)r32 * AW + d0 * 16 + hi * 8);
    unsigned sel = 0u;
    if (qb <= 3) sel = (1u << qb) - 1u;
    else {
        const float* km = wsp<float>(F, WS_KMEAN) + (size_t)((b * NH + h) * NBLK) * HD + hi * 8;
        float b0 = -__builtin_inff(), b1 = b0, b2 = b0; int i0 = 0, i1 = 0, i2 = 0;
#pragma unroll 1
        for (int j = 0; j < qb; ++j) { float s = 0.f;
#pragma unroll
            for (int d0 = 0; d0 < 4; ++d0) { const f32x4 k0 = *(const f32x4*)(km + j * HD + d0 * 16), k1 = *(const f32x4*)(km + j * HD + d0 * 16 + 4);
                const v4u qw = *reinterpret_cast<const v4u*>(&qr[d0]);
                s += bflo(qw.x) * k0[0] + bfhi(qw.x) * k0[1] + bflo(qw.y) * k0[2] + bfhi(qw.y) * k0[3] + bflo(qw.z) * k1[0] + bfhi(qw.z) * k1[1] + bflo(qw.w) * k1[2] + bfhi(qw.w) * k1[3]; }
            s += __shfl_xor(s, 32);
            if (s > b0) { b2 = b1; i2 = i1; b1 = b0; i1 = i0; b0 = s; i0 = j; } else if (s > b1) { b2 = b1; i2 = i1; b1 = s; i1 = j; } else if (s > b2) { b2 = s; i2 = j; } }
        sel = (1u << i0) | (1u << i1) | (1u << i2);
    }
    const int sr = tid >> 3, sc = (tid & 7) * 8;
    const int vst = 2 * ((sr >> 5) * 2048 + (sc >> 4) * 512 + (sr & 31) * 16 + (sc & 8));
    const int vb0 = (int)(size_t)V_lds + (lane & 15) * 8 + ((lane >> 4) & 1) * 1024 + (lane >> 5) * 256;
    bf16x8 st_v, st_k;
#define ATT_SLOAD(k0) do { const size_t rr_ = (size_t)((k0) + sr) * AW + sc; st_v = *(const bf16x8*)(Vh + rr_); st_k = *(const bf16x8*)(Kh + rr_); } while (0)
#define ATT_SWRITE(bf) do { *(LAS bf16x8*)(V_lds + (bf) * SHM_V + vst) = st_v; *(LAS bf16x8*)(K_lds + (bf) * SHM_K + ATT_KSWZ(sr, sc * 2)) = st_k; } while (0)
#define ATT_RESC(a) do { if (__any((a) < 1.f)) { if (hi == 0) al_l[r32] = (a); asm volatile("s_waitcnt lgkmcnt(0)" ::: "memory");      \
        _Pragma("unroll") for (int d_ = 0; d_ < 2; ++d_) _Pragma("unroll") for (int r = 0; r < 16; ++r) o[d_][r] *= al_l[crow(r, hi)]; } } while (0)
    const int NT = (q0 + MOBA) / KVBLK;
    const int qrel = wid * QBLK + r32;
#define ATT_MASK(P0, P1, t) do { const int jb_ = (t) - (NT - 4); if (jb_ >= 0) cmask(P0, P1, jb_, qrel, hi); } while (0)
#define ATT_KEEP(t) ((((t) >= NT - 4) ? 1u : ((sel >> ((t) >> 2)) & 1u)) != 0u)
    f32x16 pA0, pA1, pB0, pB1; float mnA, mnB, alA, alB; bf16x8 pa0, pa1, pa2, pa3;
    ATT_SLOAD(0); ATT_SWRITE(0); ATT_SLOAD(KVBLK); __syncthreads();
    qkt(pA0, pA1, K_lds, qr, r32, hi); ATT_MASK(pA0, pA1, 0); partialSM(pA0, pA1, m_reg, mnA, alA, ATT_KEEP(0));
    asm volatile("s_waitcnt vmcnt(0)" ::: "memory"); ATT_SWRITE(1); ATT_SLOAD(2 * KVBLK); __syncthreads();
    for (int j = 1; j + 1 < NT; j += 2) {
        ATT_SBAR(); qkt(pB0, pB1, K_lds + SHM_K, qr, r32, hi); ATT_MASK(pB0, pB1, j);
        finishSM(pA0, pA1, alA, l_reg, pa0, pa1, pa2, pa3); ATT_SBAR();
        pv(o, vb0, pa0, pa1, pa2, pa3); partialSM(pB0, pB1, m_reg, mnB, alB, ATT_KEEP(j));
        __syncthreads(); asm volatile("s_waitcnt vmcnt(0)" ::: "memory"); ATT_SWRITE(0); if (j + 2 < NT) ATT_SLOAD((j + 2) * KVBLK);
        ATT_RESC(alB); __syncthreads();
        ATT_SBAR(); qkt(pA0, pA1, K_lds, qr, r32, hi); ATT_MASK(pA0, pA1, j + 1);
        finishSM(pB0, pB1, alB, l_reg, pa0, pa1, pa2, pa3); ATT_SBAR();
        pv(o, vb0 + SHM_V, pa0, pa1, pa2, pa3); partialSM(pA0, pA1, m_reg, mnA, alA, ATT_KEEP(j + 1));
        __syncthreads(); if (j + 2 < NT) { asm volatile("s_waitcnt vmcnt(0)" ::: "memory"); ATT_SWRITE(1); if (j + 3 < NT) ATT_SLOAD((j + 3) * KVBLK); }
        ATT_RESC(alA); __syncthreads();
    }
    ATT_SBAR(); qkt(pB0, pB1, K_lds + SHM_K, qr, r32, hi); ATT_MASK(pB0, pB1, NT - 1);
    finishSM(pA0, pA1, alA, l_reg, pa0, pa1, pa2, pa3); ATT_SBAR();
    pv(o, vb0, pa0, pa1, pa2, pa3); partialSM(pB0, pB1, m_reg, mnB, alB, true);
    __syncthreads(); ATT_RESC(alB);
    finishSM(pB0, pB1, alB, l_reg, pa0, pa1, pa2, pa3); ATT_SBAR();
    pv(o, vb0 + SHM_V, pa0, pa1, pa2, pa3);
    if (hi == 0) li_l[r32] = l_reg; asm volatile("s_waitcnt lgkmcnt(0)" ::: "memory");
    float rli[16];
#pragma unroll
    for (int r = 0; r < 16; ++r) rli[r] = __builtin_amdgcn_rcpf(li_l[crow(r, hi)]);
    bf16* Ow = wsp<bf16>(F, WS_MIX) + (rowbase + q0 + wid * QBLK) * DM + h * HD;
    float* ssqa = wsp<float>(F, WS_SSQA) + (rowbase + q0 + wid * QBLK) * NH + h;
    float qq[16];
#pragma unroll
    for (int r = 0; r < 16; ++r) { const int orow = crow(r, hi); float q2 = 0.f;
#pragma unroll
        for (int d0 = 0; d0 < 2; ++d0) { const float v = o[d0][r] * rli[r]; const float vn = __shfl_xor(v, 1); q2 += v * v;
            if ((r32 & 1) == 0) *(unsigned*)(Ow + (size_t)orow * DM + d0 * 32 + r32) = cvt_pk_bf16(v, vn); }
        qq[r] = q2; }
#pragma unroll
    for (int i = 0; i < 8; ++i) { const bool up = (lane & 16) != 0; const float send = up ? qq[i] : qq[i + 8], keep = up ? qq[i + 8] : qq[i]; qq[i] = keep + __shfl_xor(send, 16); }
#pragma unroll
    for (int i = 0; i < 4; ++i) { const bool up = (lane & 8) != 0; const float send = up ? qq[i] : qq[i + 4], keep = up ? qq[i + 4] : qq[i]; qq[i] = keep + __shfl_xor(send, 8); }
#pragma unroll
    for (int i = 0; i < 2; ++i) { const bool up = (lane & 4) != 0; const float send = up ? qq[i] : qq[i + 2], keep = up ? qq[i + 2] : qq[i]; qq[i] = keep + __shfl_xor(send, 4); }
    { const bool up = (lane & 2) != 0; const float send = up ? qq[0] : qq[1], keep = up ? qq[1] : qq[0]; qq[0] = keep + __shfl_xor(send, 2); }
    qq[0] += __shfl_xor(qq[0], 1);
    if ((lane & 1) == 0) ssqa[(size_t)crow(r32 >> 1, hi) * NH] = qq[0];
    __syncthreads();
#undef ATT_SLOAD
#undef ATT_SWRITE
#undef ATT_RESC
#undef ATT_MASK
#undef ATT_KEEP
}
}

namespace gm {
constexpr int PITCH = 136;
__device__ __forceinline__ void unit(const Frame& F, int b, int c, int g, LAS unsigned char* scratch) {
    PHASE_IDS;
    const int tid = TID_, wid = tid >> 6, lane = tid & 63, fr = lane & 15, fq = lane >> 4;
    const size_t row0 = (size_t)b * SEQ + c * GC;
    const bf16* VGg = wsp<bf16>(F, WS_VG) + row0 * GW + g * GD; const bf16* Ug = wsp<bf16>(F, WS_U) + row0 * GW + g * GD;
    LAS unsigned short* vt = (LAS unsigned short*)scratch;
    { const int s = wid * 16 + (lane >> 2), dq = (lane & 3) * 32;
      const v4u* src = (const v4u*)(VGg + (size_t)s * GW + dq); float v[32]; float sum = 0.f;
#pragma unroll
      for (int i = 0; i < 4; ++i) { const v4u w = src[i]; const unsigned ww[4] = {w.x, w.y, w.z, w.w};
#pragma unroll
          for (int k = 0; k < 4; ++k) { v[i * 8 + 2 * k] = bflo(ww[k]); v[i * 8 + 2 * k + 1] = bfhi(ww[k]); sum += v[i * 8 + 2 * k] + v[i * 8 + 2 * k + 1]; } }
      sum += __shfl_xor(sum, 1); sum += __shfl_xor(sum, 2); const float mu = sum * (1.f / GD); float var = 0.f;
#pragma unroll
      for (int i = 0; i < 32; ++i) { v[i] -= mu; var += v[i] * v[i]; }
      var += __shfl_xor(var, 1); var += __shfl_xor(var, 2); const float rstd = 1.0f / sqrtf(var * (1.f / GD) + EPS);
      const float* lg = F.ln_g + g * GD + dq; const float* lb = F.ln_b + g * GD + dq;
#pragma unroll
      for (int i = 0; i < 32; ++i) vt[(dq + i) * PITCH + s] = (unsigned short)f2bf(v[i] * rstd * lg[i] + lb[i]); }
    __syncthreads();
    const int t = wid * 16 + fr;
    const float* Wg = F.gws + (size_t)g * GC * GC + (size_t)t * GC;
    const int nks = (wid * 16 + 16 + 31) / 32;
    f32x4 w0[4], w1[4];
#pragma unroll
    for (int ks = 0; ks < 4; ++ks) if (ks < nks) { w0[ks] = *(const f32x4*)(Wg + ks * 32 + fq * 8); w1[ks] = *(const f32x4*)(Wg + ks * 32 + fq * 8 + 4); }
    const bf16* Ut = Ug + (size_t)t * GW + 4 * fq; v2u uu[8];
#pragma unroll
    for (int n = 0; n < 8; ++n) uu[n] = *(const v2u*)(Ut + n * 16);
    f32x4 acc[8];
#pragma unroll
    for (int n = 0; n < 8; ++n) acc[n] = (f32x4){0.f, 0.f, 0.f, 0.f};
#pragma unroll
    for (int ks = 0; ks < 4; ++ks) if (ks < nks) { const int s0 = ks * 32 + fq * 8;
        float wv[8] = {w0[ks][0], w0[ks][1], w0[ks][2], w0[ks][3], w1[ks][0], w1[ks][1], w1[ks][2], w1[ks][3]};
#pragma unroll
        for (int j = 0; j < 8; ++j) if (s0 + j > t) wv[j] = 0.f;
        v4u aw; aw.x = pk2(wv[0], wv[1]); aw.y = pk2(wv[2], wv[3]); aw.z = pk2(wv[4], wv[5]); aw.w = pk2(wv[6], wv[7]);
        const bf16x8 wf = *reinterpret_cast<const bf16x8*>(&aw);
#pragma unroll
        for (int n = 0; n < 8; ++n) { const bf16x8 vf = *(const LAS bf16x8*)(vt + (n * 16 + fr) * PITCH + s0);
            acc[n] = __builtin_amdgcn_mfma_f32_16x16x32_bf16(vf, wf, acc[n], 0, 0, 0); } }
    bf16* Og = wsp<bf16>(F, WS_MIX) + (row0 + t) * DM + AW + g * GD + 4 * fq; float* ssqg = wsp<float>(F, WS_SSQG) + (row0 + t) * GG + g;
    const float bs = F.gbs[g * GC + t]; float q2 = 0.f;
#pragma unroll
    for (int n = 0; n < 8; ++n) { const float o0 = bflo(uu[n].x) * (acc[n][0] + bs), o1 = bfhi(uu[n].x) * (acc[n][1] + bs), o2 = bflo(uu[n].y) * (acc[n][2] + bs), o3 = bfhi(uu[n].y) * (acc[n][3] + bs);
        q2 += (o0 * o0 + o1 * o1) + (o2 * o2 + o3 * o3); v2u w; w.x = cvt_pk_bf16(o0, o1); w.y = cvt_pk_bf16(o2, o3); *(v2u*)(Og + n * 16) = w; }
    q2 += __shfl_xor(q2, 16); q2 += __shfl_xor(q2, 32);
    if (fq == 0) ssqg[0] = q2;
    __syncthreads();
}
}

__device__ __forceinline__ void p2_mixers(const Frame& F) {
    LAS unsigned char* scratch = F.lds + RING_OFF;
    const int v = F.vcu;
    { const int bh = v >> 1, s0 = (v & 1) * 2;
#pragma unroll 1
      for (int i = 0; i < 4; ++i) { const int qq = s0 + (i >> 1); const int qb = (i & 1) ? 7 - qq : qq; att::attn_unit(F, bh / NH, bh % NH, qb, scratch); } }
#pragma unroll 1
    for (int i = 0; i < 4; ++i) { const int uidx = 4 * v + i; gm::unit(F, uidx >> 6, (uidx >> 2) & 15, uidx & 3, scratch); }
}

__device__ __forceinline__ void p4_router(const Frame& F) {
    PHASE_IDS;
    const int tid = TID_, wid = tid >> 6, lane = tid & 63, tk = lane & 31, hf = lane >> 5;
    LAS unsigned* hist = (LAS unsigned*)(F.lds + XTAB_OFF);
    LAS unsigned* base = hist + 32;
    const bf16* RWT = wsp<bf16>(F, WS_RWT); const bf16* x1 = wsp<bf16>(F, WS_X1B); const float* ssq1 = wsp<float>(F, WS_SSQ1);
    unsigned* cntg = (unsigned*)(F.ctl + CW_CNT);
    unsigned* IDX = wsp<unsigned>(F, WS_IDX); float* GSS = wsp<float>(F, WS_GSS); float* RSS = wsp<float>(F, WS_RSS); unsigned* TOKPOS = wsp<unsigned>(F, WS_TOKPOS);
    if (tid < 32) hist[tid] = 0u;
    __syncthreads();
    const int unit = F.vcu * 4 + (wid & 3), kh = wid >> 2; const int tok = unit * 32 + tk;
    LAS float* xch = (LAS float*)(F.lds + RING_OFF) + (wid & 3) * 64 * 16;
    float rstd; { const f32x4* sp = (const f32x4*)(ssq1 + (size_t)tok * 16); const f32x4 a = sp[0], b = sp[1], c = sp[2], d = sp[3];
        const float s_ = ((a[0] + a[1]) + (a[2] + a[3])) + ((b[0] + b[1]) + (b[2] + b[3])) + ((c[0] + c[1]) + (c[2] + c[3])) + ((d[0] + d[1]) + (d[2] + d[3]));
        rstd = 1.0f / sqrtf(s_ * (1.f / DM) + EPS); }
    f32x16 acc = f32x16{};
    { const bf16* xr = x1 + (size_t)tok * DM + kh * 512 + 8 * hf; const bf16* wh = RWT + (size_t)tk * DM + kh * 512 + 8 * hf; const bf16* wl = wh + NE * DM;
#pragma unroll 8
      for (int s_ = 0; s_ < 32; ++s_) { const bf16x8 xv = *(const bf16x8*)(xr + 16 * s_), a_hi = *(const bf16x8*)(wh + 16 * s_), a_lo = *(const bf16x8*)(wl + 16 * s_);
          acc = __builtin_amdgcn_mfma_f32_32x32x16_bf16(a_hi, xv, acc, 0, 0, 0); acc = __builtin_amdgcn_mfma_f32_32x32x16_bf16(a_lo, xv, acc, 0, 0, 0); } }
    if (kh == 1) {
#pragma unroll
        for (int r = 0; r < 16; ++r) xch[lane * 16 + r] = acc[r]; }
    __syncthreads();
    const bool active = kh == 0;
    int pe[4] = {0, 0, 0, 0}; float pg[4] = {0.f, 0.f, 0.f, 0.f}; unsigned rank[2] = {0u, 0u}; int my_e[2] = {0, 0}; float my_g[2] = {0.f, 0.f};
    if (active) {
        float lv[16];
#pragma unroll
        for (int r = 0; r < 16; ++r) { const int e = (r & 3) + 8 * (r >> 2) + 4 * hf; lv[r] = (acc[r] + xch[lane * 16 + r]) * rstd + F.router_b[e]; }
        float tv[4]; int ti[4]; unsigned used = 0u;
#pragma unroll
        for (int k = 0; k < 4; ++k) { float best = -__builtin_inff(); int br = 0;
#pragma unroll
            for (int r = 0; r < 16; ++r) { const int e = (r & 3) + 8 * (r >> 2) + 4 * hf; const int eb = (br & 3) + 8 * (br >> 2) + 4 * hf;
                const bool better = !((used >> r) & 1u) && (lv[r] > best || (lv[r] == best && e < eb)); if (better) { best = lv[r]; br = r; } }
            used |= 1u << br; tv[k] = best; ti[k] = (br & 3) + 8 * (br >> 2) + 4 * hf; }
        float ov[4]; int oi[4];
#pragma unroll
        for (int k = 0; k < 4; ++k) { ov[k] = __shfl_xor(tv[k], 32); oi[k] = __shfl_xor(ti[k], 32); }
        int ia = 0, ib = 0;
#pragma unroll
        for (int k = 0; k < 4; ++k) {
            float va = tv[0], vb = ov[0]; int ea = ti[0], eb = oi[0];
#pragma unroll
            for (int q = 1; q < 4; ++q) { if (ia == q) { va = tv[q]; ea = ti[q]; } if (ib == q) { vb = ov[q]; eb = oi[q]; } }
            const bool takeA = (va > vb) || (va == vb && ea < eb);
            pg[k] = takeA ? va : vb; pe[k] = takeA ? ea : eb; if (takeA) ++ia; else ++ib; }
        { const float m = pg[0]; float s_ = 0.f;
#pragma unroll
          for (int k = 0; k < 4; ++k) { pg[k] = __builtin_amdgcn_exp2f((pg[k] - m) * 1.4426950408889634f); s_ += pg[k]; }
          const float inv = 1.0f / s_;
#pragma unroll
          for (int k = 0; k < 4; ++k) pg[k] *= inv; }
        { const int m = -hf; my_e[0] = pe[0] ^ ((pe[0] ^ pe[2]) & m); my_e[1] = pe[1] ^ ((pe[1] ^ pe[3]) & m);
          const unsigned g0 = __float_as_uint(pg[0]), g1 = __float_as_uint(pg[1]), g2 = __float_as_uint(pg[2]), g3 = __float_as_uint(pg[3]);
          my_g[0] = __uint_as_float(g0 ^ ((g0 ^ g2) & (unsigned)m)); my_g[1] = __uint_as_float(g1 ^ ((g1 ^ g3) & (unsigned)m)); }
#pragma unroll
        for (int q = 0; q < 2; ++q) rank[q] = atomicAdd((unsigned*)&hist[my_e[q]], 1u);
    }
    __syncthreads();
    if (tid < 32) base[tid] = atomicAdd(cntg + tid, hist[tid]);
    __syncthreads();
    if (active) {
#pragma unroll
        for (int q = 0; q < 2; ++q) { const int k = 2 * hf + q; const int e = my_e[q]; const float g = my_g[q];
            const unsigned slot = base[e] + rank[q];
            IDX[(size_t)e * T + slot] = (unsigned)tok; GSS[(size_t)e * T + slot] = g; RSS[(size_t)e * T + slot] = rstd; TOKPOS[(size_t)tok * 4 + k] = ((unsigned)e << 16) | slot; }
    }
    __syncthreads();
}

constexpr int MAXU = 18;
constexpr int XT_TSTART = 0, XT_ULIST = 256, XT_GTAB = 512;
static_assert(XT_GTAB + MAXU * 1024 <= LDS_BYTES - XTAB_OFF, "xtab");
__device__ __forceinline__ int moe_build_tables(const Frame& F, int P  , bool gather) {
    PHASE_IDS;
    LAS unsigned* tstart = (LAS unsigned*)(F.lds + XTAB_OFF + XT_TSTART);
    LAS unsigned* ulist = (LAS unsigned*)(F.lds + XTAB_OFF + XT_ULIST);
    LAS unsigned* gtab = (LAS unsigned*)(F.lds + XTAB_OFF + XT_GTAB);
    const unsigned* cntg = (const unsigned*)(F.ctl + CW_CNT); const unsigned* IDX = wsp<unsigned>(F, WS_IDX);
    const int tid = TID_;
    if (tid == 0) { unsigned s = 0; for (int e = 0; e < NE; ++e) { tstart[e] = s; unsigned c = cntg[e]; if (c > (unsigned)T) c = (unsigned)T; s += (c + 255u) >> 8; } tstart[NE] = s; }
    __syncthreads();
    const int NT_ = (int)tstart[NE], U = NT_ * P, G = F.G, c = (int)blockIdx.x;
    const int nunits = (c < U) ? (U - c + G - 1) / G : 0;
    if (tid < MAXU && tid < nunits) { const int L = tid * G + c; int gt, pn; pg8::flat_to_tile(L, U, NT_, P, gt, pn);
        int e = 0; for (int k = 1; k < NE; ++k) if ((unsigned)gt >= tstart[k]) e = k;
        const int rt = gt - (int)tstart[e];
        ulist[tid] = (unsigned)gt | ((unsigned)pn << 10) | ((unsigned)e << 13) | ((unsigned)rt << 18); }
    __syncthreads();
    if (gather) {
        for (int i = 0; i < nunits && i < MAXU; ++i) { const unsigned w = ulist[i]; const int e = (int)((w >> 13) & 0x1fu), rt = (int)(w >> 18);
            unsigned cn = cntg[e]; if (cn > (unsigned)T) cn = (unsigned)T;
            if (tid < 256) { const unsigned slot = (unsigned)rt * 256u + (unsigned)tid; unsigned tok = 0u; if (slot < cn) { tok = IDX[(size_t)e * T + slot]; if (tok >= (unsigned)T) tok = 0u; } gtab[i * 256 + tid] = tok * (unsigned)DM; } }
    }
    __syncthreads();
    return nunits < MAXU ? nunits : MAXU;
}

__device__ __forceinline__ void p7_combine(const Frame& F) {
    PHASE_IDS;
    LAS unsigned* tstart = (LAS unsigned*)(F.lds + XTAB_OFF + XT_TSTART);
    const unsigned* cntg = (const unsigned*)(F.ctl + CW_CNT);
    if (TID_ == 0) { unsigned s = 0; for (int e = 0; e < NE; ++e) { tstart[e] = s; unsigned c = cntg[e]; if (c > (unsigned)T) c = (unsigned)T; s += (c + 255u) >> 8; } tstart[NE] = s; }
    __syncthreads();
    const int gw = F.vcu * NWAVES + WAVE_, NGW = F.G * NWAVES;
    const unsigned* TOKPOS = wsp<unsigned>(F, WS_TOKPOS); const bf16* Y = wsp<bf16>(F, WS_YBUF); const bf16* X1 = wsp<bf16>(F, WS_X1B); bf16* X2 = wsp<bf16>(F, WS_X2B); float* RS2 = wsp<float>(F, WS_RSTD2);
    for (int m = gw; m < T; m += NGW) {
        const v4u tp = *(const v4u*)(TOKPOS + (size_t)m * 4); const unsigned tpw[4] = {tp.x, tp.y, tp.z, tp.w};
        size_t yrow[4];
#pragma unroll
        for (int k = 0; k < 4; ++k) { const unsigned e = (tpw[k] >> 16) & 31u, slot = tpw[k] & 0xffffu; yrow[k] = ((size_t)tstart[e] * 256u + slot) * DM; }
        f32x4 v[4]; float s = 0.f;
#pragma unroll
        for (int j = 0; j < 4; ++j) { const v2u xw = *(const v2u*)(X1 + (size_t)m * DM + 4 * LANE_ + 256 * j); v[j] = (f32x4){bflo(xw.x), bfhi(xw.x), bflo(xw.y), bfhi(xw.y)};
#pragma unroll
            for (int k = 0; k < 4; ++k) { const v2u w = *(const v2u*)(Y + yrow[k] + 4 * LANE_ + 256 * j); v[j][0] += bflo(w.x); v[j][1] += bfhi(w.x); v[j][2] += bflo(w.y); v[j][3] += bfhi(w.y); }
            s += (v[j].x * v[j].x + v[j].y * v[j].y) + (v[j].z * v[j].z + v[j].w * v[j].w); }
        const float rstd = 1.0f / sqrtf(wave_sum(s) * (1.f / DM) + EPS);
        if (LANE_ == 0) RS2[m] = rstd;
#pragma unroll
        for (int j = 0; j < 4; ++j) { v2u w; w.x = cvt_pk_bf16(v[j].x, v[j].y); w.y = cvt_pk_bf16(v[j].z, v[j].w); *(v2u*)(X2 + (size_t)m * DM + 4 * LANE_ + 256 * j) = w; }
    }
}

__device__ __forceinline__ void p9_final(const Frame& F) {
    PHASE_IDS;
    const int gw = F.vcu * NWAVES + WAVE_, NGW = F.G * NWAVES;
    const bf16* GATE = wsp<bf16>(F, WS_GATE); const bf16* PP = wsp<bf16>(F, WS_PP); const float* ssqpp = wsp<float>(F, WS_SSQPP);
    for (int m = gw; m < T; m += NGW) {
        float rpp; { const f32x4* sp = (const f32x4*)(ssqpp + (size_t)m * 16); const f32x4 a = sp[0], b = sp[1], c = sp[2], d = sp[3];
            const float s = ((a[0] + a[1]) + (a[2] + a[3])) + ((b[0] + b[1]) + (b[2] + b[3])) + ((c[0] + c[1]) + (c[2] + c[3])) + ((d[0] + d[1]) + (d[2] + d[3]));
            rpp = 1.0f / sqrtf(s * (1.f / DM) + EPS); }
        float* xr = F.out + (size_t)m * DM; const bf16* x2r = wsp<bf16>(F, WS_X2B) + (size_t)m * DM;
        f32x4 v[4]; float s = 0.f;
#pragma unroll
        for (int j = 0; j < 4; ++j) { const int col = 4 * LANE_ + 256 * j; { const v2u xw = *(const v2u*)(x2r + col); v[j] = (f32x4){bflo(xw.x), bfhi(xw.x), bflo(xw.y), bfhi(xw.y)}; }
            const v2u g = *(const v2u*)(GATE + (size_t)m * DM + col), pw = *(const v2u*)(PP + (size_t)m * DM + col); const f32x4 pg_ = *(const f32x4*)(F.ppn + col);
            v[j][0] += bflo(g.x) * (bflo(pw.x) * rpp * pg_[0]); v[j][1] += bfhi(g.x) * (bfhi(pw.x) * rpp * pg_[1]);
            v[j][2] += bflo(g.y) * (bflo(pw.y) * rpp * pg_[2]); v[j][3] += bfhi(g.y) * (bfhi(pw.y) * rpp * pg_[3]);
            s += (v[j].x * v[j].x + v[j].y * v[j].y) + (v[j].z * v[j].z + v[j].w * v[j].w); }
        const float rstd = 1.0f / sqrtf(wave_sum(s) * (1.f / DM) + EPS);
#pragma unroll
        for (int j = 0; j < 4; ++j) { const int col = 4 * LANE_ + 256 * j; const f32x4 fg = *(const f32x4*)(F.final_norm + col); *(f32x4*)(xr + col) = v[j] * rstd * fg; }
    }
}

struct Args { const float* in[23]; float* out; unsigned char* ws; };
#if CHECK_STAGE
__device__ __forceinline__ unsigned hmix(unsigned z) { z ^= z >> 16; z *= 0x7feb352du; z ^= z >> 15; z *= 0x846ca68bu; z ^= z >> 16; return z; }
__device__ __forceinline__ void chk_add(const Frame& F, int st, bool bad) { atomicAdd((unsigned*)(F.ctl + CW_CHK + 2 * st), bad ? 1u : 0u); atomicAdd((unsigned*)(F.ctl + CW_CHK + 2 * st + 1), 1u); }
__device__ __forceinline__ bool offby(float got, float ex, float rel, float ab) { const float d = fabsf(got - ex); return !(d <= rel * fabsf(ex) + ab); }
__device__ __forceinline__ float dot_bf(const bf16* a, const bf16* b, int n) { float s = 0.f; for (int k = 0; k < n; ++k) s += bf2f(a[k]) * bf2f(b[k]); return s; }
__device__ __forceinline__ float gelu_ref(float v) { return 0.5f * v * (1.0f + erff(v * 0.70710678f)); }
__device__ __forceinline__ unsigned chk_tstart(const Frame& F, unsigned ex) { const unsigned* cntg = (const unsigned*)(F.ctl + CW_CNT); unsigned s_ = 0; for (unsigned e = 0; e < ex; ++e) { unsigned c = cntg[e]; if (c > (unsigned)T) c = T; s_ += (c + 255u) >> 8; } return s_; }
template <int ST> __device__ __forceinline__ void stage_check(const Frame& F) {
    const unsigned gt = (unsigned)blockIdx.x * NTHR + threadIdx.x;
    const unsigned h0 = hmix(gt * 2654435761u + ST * 40503u), h1 = hmix(h0 + 0x9e3779b9u), h2 = hmix(h1 + 0x85ebca6bu);
    if (ST == 1) {
        if (gt >= 16384) return;
        const int which = gt & 7;
        if (which == 0) { const int e = h0 % NE, n = h1 % (2 * FF), k = h2 % DM; const int lc = CmWgu()(n);
            const float ex = bf2f((bf16)f2bf(F.w_gu[((size_t)e * DM + k) * 2 * FF + lc] * F.ffn_norm[k])); chk_add(F, ST, offby(bf2f(wsp<bf16>(F, WS_WGU)[((size_t)e * 2 * FF + n) * DM + k]), ex, 1e-6f, 1e-30f)); }
        else if (which == 1) { const int e = h0 % NE, n = h1 % DM, k = h2 % FF;
            const float ex = bf2f((bf16)f2bf(F.w_dn[((size_t)e * FF + k) * DM + n])); chk_add(F, ST, offby(bf2f(wsp<bf16>(F, WS_WDN)[((size_t)e * DM + n) * FF + k]), ex, 1e-6f, 1e-30f)); }
        else if (which == 2) { const int n = h1 % NPROJ, k = h2 % DM; const int lc = CmWin()(n);
            const float ex = bf2f((bf16)f2bf(F.w_in[(size_t)k * NPROJ + lc] * F.mix_norm[k])); chk_add(F, ST, offby(bf2f(wsp<bf16>(F, WS_WIN)[(size_t)n * DM + k]), ex, 1e-6f, 1e-30f)); }
        else if (which == 3) { const int n = h1 % DM, k = h2 % DM; const float g = k < AW ? F.aon[k] : F.gon[k - AW];
            const float ex = bf2f((bf16)f2bf(F.w_out[(size_t)k * DM + n] * g)); chk_add(F, ST, offby(bf2f(wsp<bf16>(F, WS_WOUT)[(size_t)n * DM + k]), ex, 1e-6f, 1e-30f)); }
        else if (which == 4) { const int n = h1 % DM, k = h2 % DM;
            const float ex = bf2f((bf16)f2bf(F.w_pg[(size_t)k * DM + n] * F.ple_norm[k])); chk_add(F, ST, offby(bf2f(wsp<bf16>(F, WS_WPG)[(size_t)n * DM + k]), ex, 1e-6f, 1e-30f)); }
        else if (which == 5) { const int n = h1 % DM, k = h2 % PLE;
            const float ex = bf2f((bf16)f2bf(F.w_pp[(size_t)k * DM + n])); chk_add(F, ST, offby(bf2f(wsp<bf16>(F, WS_WPP)[(size_t)n * PLE + k]), ex, 1e-6f, 1e-30f)); }
        else if (which == 6) { const int row = h0 % T, k = h1 % DM; float ss = 0.f; for (int j = 0; j < DM; ++j) { const float v = F.x[(size_t)row * DM + j]; ss += v * v; }
            const float ex = F.x[(size_t)row * DM + k] / sqrtf(ss / DM + EPS); chk_add(F, ST, offby(bf2f(wsp<bf16>(F, WS_XNB)[(size_t)row * DM + k]), ex, 0.01f, 1e-3f)); }
        else { const int row = h0 % T, k = h1 % PLE; chk_add(F, ST, offby(bf2f(wsp<bf16>(F, WS_PB)[(size_t)row * PLE + k]), F.p[(size_t)row * PLE + k], 0.005f, 1e-6f)); }
    }
    if (ST == 2) {
        if (gt >= 16384) return;
        const bf16* XN = wsp<bf16>(F, WS_XNB); const bf16* WIN = wsp<bf16>(F, WS_WIN);
        if ((gt & 7) == 7) {
            const int b = h0 % BATCH, hh = h1 % NH, blk = h2 % NBLK, c = (h2 >> 8) % HD; float s_ = 0.f;
            for (int r = 0; r < 256; ++r) s_ += bf2f(wsp<bf16>(F, WS_K)[((size_t)b * SEQ + blk * 256 + r) * AW + hh * HD + c]);
            chk_add(F, ST, offby(wsp<float>(F, WS_KMEAN)[((size_t)(b * NH + hh) * NBLK + blk) * HD + c], s_, 0.02f, 0.3f)); return; }
        const int row = h0 % T, type = h1 % 5, c = h2 % AW; const bf16* xr = XN + (size_t)row * DM;
        const float v = dot_bf(xr, WIN + (size_t)(type * AW + c) * DM, DM); float ex;
        if (type <= 1) { const float vp = dot_bf(xr, WIN + (size_t)(type * AW + (c ^ 4)) * DM, DM); const int i = 4 * ((c & 63) >> 3) + (c & 3), pos = row & (SEQ - 1);
            const float cs = wsp<float>(F, WS_ROPE)[pos * 32 + i], sn = wsp<float>(F, WS_ROPE)[SEQ * 32 + pos * 32 + i];
            { const float inv = powf(10000.0f, -(float)i / 32.0f); const float ang = (float)pos * inv; if (offby(cs, cosf(ang), 0.f, 1e-3f) || offby(sn, sinf(ang), 0.f, 1e-3f)) { chk_add(F, ST, true); return; } }
            ex = (c & 4) ? v * cs + vp * sn : v * cs - vp * sn; }
        else if (type == 2) ex = v; else ex = gelu_ref(v);
        chk_add(F, ST, offby(bf2f(wsp<bf16>(F, WS_Q)[(size_t)type * (16u << 20) + (size_t)row * AW + c]), ex, 0.02f, 0.02f));
    }
    if (ST == 3) {
        if (gt >= 8192) return;
        if (gt & 1) {
            const int row = h0 % T, g = h1 % GG, d = h2 % GD; const int b = row / SEQ, s_ = row % SEQ, c = s_ / GC, t = s_ % GC; float acc = 0.f;
            for (int sp = 0; sp <= t; ++sp) { const bf16* vr = wsp<bf16>(F, WS_VG) + ((size_t)b * SEQ + c * GC + sp) * GW + g * GD; float mu = 0.f; for (int j = 0; j < GD; ++j) mu += bf2f(vr[j]); mu /= GD;
                float var = 0.f; for (int j = 0; j < GD; ++j) { const float dd = bf2f(vr[j]) - mu; var += dd * dd; } const float rstd = 1.0f / sqrtf(var / GD + EPS);
                const float vn = bf2f((bf16)f2bf((bf2f(vr[d]) - mu) * rstd * F.ln_g[g * GD + d] + F.ln_b[g * GD + d])); acc += bf2f((bf16)f2bf(F.gws[((size_t)g * GC + t) * GC + sp])) * vn; }
            const float ex = bf2f(wsp<bf16>(F, WS_U)[(size_t)row * GW + g * GD + d]) * (acc + F.gbs[g * GC + t]);
            chk_add(F, ST, offby(bf2f(wsp<bf16>(F, WS_MIX)[(size_t)row * DM + AW + g * GD + d]), ex, 0.03f, 0.02f)); return; }
        const int row = h0 % T, hh = h1 % NH; const int b = row / SEQ, s_ = row % SEQ, qb = s_ / MOBA; float q[HD];
#pragma unroll
        for (int c = 0; c < HD; ++c) q[c] = bf2f(wsp<bf16>(F, WS_Q)[(size_t)row * AW + hh * HD + c]);
        unsigned sel = 0u;
        if (qb <= 3) sel = (1u << qb) - 1u;
        else { float b0 = -__builtin_inff(), b1 = b0, b2 = b0; int i0 = 0, i1 = 0, i2 = 0;
            for (int j = 0; j < qb; ++j) { const float* km = wsp<float>(F, WS_KMEAN) + ((size_t)(b * NH + hh) * NBLK + j) * HD; float g = 0.f;
#pragma unroll
                for (int c = 0; c < HD; ++c) g += q[c] * km[c];
                if (g > b0) { b2 = b1; i2 = i1; b1 = b0; i1 = i0; b0 = g; i0 = j; } else if (g > b1) { b2 = b1; i2 = i1; b1 = g; i1 = j; } else if (g > b2) { b2 = g; i2 = j; } }
            sel = (1u << i0) | (1u << i1) | (1u << i2); }
        float mx = -__builtin_inff();
        for (int kp = 0; kp <= s_; ++kp) { const int blk = kp / MOBA; if (blk != qb && !((sel >> blk) & 1u)) continue; const bf16* kr = wsp<bf16>(F, WS_K) + ((size_t)b * SEQ + kp) * AW + hh * HD; float sc = 0.f;
#pragma unroll
            for (int c = 0; c < HD; ++c) sc += q[c] * bf2f(kr[c]);
            mx = fmaxf(mx, sc * 0.125f); }
        float o[HD]; float l = 0.f;
#pragma unroll
        for (int c = 0; c < HD; ++c) o[c] = 0.f;
        for (int kp = 0; kp <= s_; ++kp) { const int blk = kp / MOBA; if (blk != qb && !((sel >> blk) & 1u)) continue; const bf16* kr = wsp<bf16>(F, WS_K) + ((size_t)b * SEQ + kp) * AW + hh * HD; float sc = 0.f;
#pragma unroll
            for (int c = 0; c < HD; ++c) sc += q[c] * bf2f(kr[c]);
            const float pr = expf(sc * 0.125f - mx); l += pr; const bf16* vr = wsp<bf16>(F, WS_V) + ((size_t)b * SEQ + kp) * AW + hh * HD;
#pragma unroll
            for (int c = 0; c < HD; ++c) o[c] += pr * bf2f(vr[c]); }
        bool bad = false; float ss = 0.f;
#pragma unroll
        for (int c = 0; c < HD; ++c) { const float ex = o[c] / l; ss += ex * ex; bad |= offby(bf2f(wsp<bf16>(F, WS_MIX)[(size_t)row * DM + hh * HD + c]), ex, 0.04f, 0.02f); }
        bad |= offby(wsp<float>(F, WS_SSQA)[(size_t)row * NH + hh], ss, 0.03f, 1e-3f);
        chk_add(F, ST, bad);
    }
    if (ST == 4) {
        if (gt >= 16384) return;
        const int row = h0 % T, col = h1 % DM; const bf16* mr = wsp<bf16>(F, WS_MIX) + (size_t)row * DM; const bf16* wr_ = wsp<bf16>(F, WS_WOUT) + (size_t)col * DM;
        float sa = 0.f, sg = 0.f, da = 0.f, dg = 0.f;
        for (int k = 0; k < AW; ++k) { const float a = bf2f(mr[k]), g = bf2f(mr[AW + k]); sa += a * a; sg += g * g; da += a * bf2f(wr_[k]); dg += g * bf2f(wr_[AW + k]); }
        const float ex = F.x[(size_t)row * DM + col] + da / sqrtf(sa / AW + EPS) + dg / sqrtf(sg / GW + EPS);
        chk_add(F, ST, offby(F.out[(size_t)row * DM + col], ex, 0.01f, 0.03f));
    }
    if (ST == 5) {
        if (gt >= 8192) return;
        const int tok = h0 % T; const float* xr = F.out + (size_t)tok * DM; float ss = 0.f; for (int k = 0; k < DM; ++k) ss += xr[k] * xr[k]; const float rstd = 1.0f / sqrtf(ss / DM + EPS);
        bool bad = false;
        for (int j = 0; j < 4; ++j) { const int k = (h1 >> (8 * j)) % DM; bad |= offby(bf2f(wsp<bf16>(F, WS_XNB)[(size_t)tok * DM + k]), xr[k] * rstd, 0.01f, 1e-3f); }
        float lg[NE];
#pragma unroll
        for (int e = 0; e < NE; ++e) lg[e] = 0.f;
        for (int k = 0; k < DM; ++k) { const float xv = xr[k] * rstd * F.ffn_norm[k];
#pragma unroll
            for (int e = 0; e < NE; ++e) lg[e] += xv * F.router_w[k * NE + e]; }
#pragma unroll
        for (int e = 0; e < NE; ++e) lg[e] += F.router_b[e];
        int te[4]; float tv[4]; unsigned used = 0u;
#pragma unroll
        for (int k = 0; k < 4; ++k) { float best = -__builtin_inff(); int bi = 0;
#pragma unroll
            for (int e = 0; e < NE; ++e) if (!((used >> e) & 1u) && lg[e] > best) { best = lg[e]; bi = e; }
            used |= 1u << bi; te[k] = bi; tv[k] = best; }
        { float gg[4]; float den = 0.f;
#pragma unroll
          for (int k = 0; k < 4; ++k) { float v = -__builtin_inff();
#pragma unroll
              for (int e = 0; e < NE; ++e) if (e == te[k]) v = lg[e];
              gg[k] = v; }
          const float mm = gg[0];
#pragma unroll
          for (int k = 0; k < 4; ++k) { gg[k] = expf(gg[k] - mm); den += gg[k]; }
          const unsigned* tp = wsp<unsigned>(F, WS_TOKPOS) + (size_t)tok * 4;
#pragma unroll
          for (int k = 0; k < 4; ++k) { const unsigned e = tp[k] >> 16, slot = tp[k] & 0xffffu; bad |= (e != (unsigned)te[k]);
              if (e < NE && slot < (unsigned)T) { bad |= wsp<unsigned>(F, WS_IDX)[(size_t)e * T + slot] != (unsigned)tok; bad |= offby(wsp<float>(F, WS_GSS)[(size_t)e * T + slot], gg[k] / den, 2e-3f, 1e-5f);
                  bad |= slot >= ((const unsigned*)(F.ctl + CW_CNT))[e]; } else bad = true; } }
        (void)tv;
        chk_add(F, ST, bad);
    }
    if (ST == 6 || ST == 7) {
        if (gt >= 16384) return;
        const int tok = h0 % T, k = h1 & 3, col = (h1 >> 2) % FF; const unsigned tp = wsp<unsigned>(F, WS_TOKPOS)[(size_t)tok * 4 + k]; const unsigned e = tp >> 16, slot = tp & 0xffffu;
        if (e >= NE) { chk_add(F, ST, true); return; }
        const unsigned tse = chk_tstart(F, e);
        const size_t row = (size_t)tse * 256 + slot;
        if (ST == 6) { const bf16* xr = wsp<bf16>(F, WS_XNB) + (size_t)tok * DM; const int np = (col >> 7) * 256 + (col & 127);
            const float g = dot_bf(xr, wsp<bf16>(F, WS_WGU) + ((size_t)e * 2 * FF + np) * DM, DM) + F.b_gu[(size_t)e * 2 * FF + col];
            const float l = dot_bf(xr, wsp<bf16>(F, WS_WGU) + ((size_t)e * 2 * FF + np + 128) * DM, DM) + F.b_gu[(size_t)e * 2 * FF + FF + col];
            const float gc = fminf(g, 7.f), lc = fminf(fmaxf(l, -7.f), 7.f); const float ex = gc / (1.0f + expf(-1.702f * gc)) * (lc + 1.0f);
            chk_add(F, ST, offby(bf2f(wsp<bf16>(F, WS_ABUF)[row * FF + col]), ex, 0.03f, 0.03f)); }
        else { const float d = dot_bf(wsp<bf16>(F, WS_ABUF) + row * FF, wsp<bf16>(F, WS_WDN) + ((size_t)e * DM + col) * FF, FF) + F.b_dn[(size_t)e * DM + col];
            const float ex = d * wsp<float>(F, WS_GSS)[(size_t)e * T + slot];
            chk_add(F, ST, offby(bf2f(wsp<bf16>(F, WS_YBUF)[row * DM + col]), ex, 0.03f, 0.01f)); }
    }
    if (ST == 8) {
        if (gt >= 8192) return;
        const int tok = h0 % T; const float* xr = F.out + (size_t)tok * DM; float ss = 0.f; for (int k = 0; k < DM; ++k) ss += xr[k] * xr[k]; const float rstd = 1.0f / sqrtf(ss / DM + EPS);
        bool bad = false; for (int k = 0; k < DM; ++k) { bad |= offby(bf2f(wsp<bf16>(F, WS_X2N)[(size_t)tok * DM + k]), xr[k] * rstd, 0.01f, 1e-3f); bad |= !(fabsf(xr[k]) < 30.f); }
        chk_add(F, ST, bad);
    }
    if (ST == 9) {
        if (gt >= 16384) return;
        const int row = h0 % T, col = h1 % DM;
        if (gt & 1) { const float d = dot_bf(wsp<bf16>(F, WS_X2N) + (size_t)row * DM, wsp<bf16>(F, WS_WPG) + (size_t)col * DM, DM); const float got = bf2f(wsp<bf16>(F, WS_GATE)[(size_t)row * DM + col]); const float ex = 1.0f / (1.0f + expf(-d)); const bool bad = offby(got, ex, 0.02f, 0.01f); chk_add(F, ST, bad);
            if (bad) { atomicOr((unsigned*)(F.ctl + CW_CHK + 40), 1u << ((col >> 3) & 31)); atomicOr((unsigned*)(F.ctl + CW_CHK + 41), 1u << ((row >> 3) & 31)); atomicOr((unsigned*)(F.ctl + CW_CHK + 42), 1u << (col & 7)); atomicOr((unsigned*)(F.ctl + CW_CHK + 43), 1u << (row & 7));
                if (!(got >= 0.f && got <= 1.f)) atomicAdd((unsigned*)(F.ctl + CW_CHK + 44), 1u); { int cl = (int)floorf(log2f(fabsf(got) + 1e-30f)) + 40; cl = cl < 0 ? 0 : (cl > 80 ? 80 : cl); atomicMax((unsigned*)(F.ctl + CW_CHK + 46), (unsigned)cl); atomicMin((unsigned*)(F.ctl + CW_CHK + 47), 0xffffffffu - (unsigned)cl); if (got < 0.f) atomicAdd((unsigned*)(F.ctl + CW_CHK + 48), 1u); } if (fabsf(got - ex) > 0.2f) atomicAdd((unsigned*)(F.ctl + CW_CHK + 45), 1u); } }
        else { const float d = dot_bf(wsp<bf16>(F, WS_PB) + (size_t)row * PLE, wsp<bf16>(F, WS_WPP) + (size_t)col * PLE, PLE); chk_add(F, 10, offby(bf2f(wsp<bf16>(F, WS_PP)[(size_t)row * DM + col]), d, 0.02f, 0.02f)); }
    }
}
__device__ __forceinline__ void check_report(const Frame& F) {
    float c2 = 3.0f;
    for (int st = 1; st <= 10; ++st) { const unsigned bad = F.ctl[CW_CHK + 2 * st], tot = F.ctl[CW_CHK + 2 * st + 1]; const float fr = tot ? (float)bad / (float)tot : 1.0f;
        (void)fr; if (((CHECK_SKIP >> st) & 1) == 0 && bad >= 1u) { c2 = powf(10.0f, (float)st) * (1.0f + fminf((float)bad, 80.0f) * 0.1f); break; } }
#if CHECK_REPORT >= 40
    { unsigned v = F.ctl[CW_CHK + CHECK_REPORT]; if (CHECK_REPORT == 47) v = 0xffffffffu - v; c2 = powf(10.0f, (float)(v >> 27)) * (1.0f + (float)((v >> 21) & 63u) * 0.1f);
#if CHECK_REPORT2
      c2 = powf(10.0f, (float)((v >> 16) & 31u)) * (1.0f + (float)((v >> 10) & 63u) * 0.1f);
#endif
#if CHECK_REPORT3
      c2 = powf(10.0f, (float)((v >> 5) & 31u)) * (1.0f + (float)(v & 31u) * 0.1f);
#endif
      if (CHECK_REPORT >= 46 && CHECK_REPORT <= 47) c2 = powf(10.0f, (float)(v / 9u)) * (1.0f + (float)(v % 9u));
    }
#endif
    if (F.ctl[CW_BAR + XB_TMO] != 0u) c2 = 1e20f;
    const float c = sqrtf(c2);
    for (size_t i = (size_t)blockIdx.x * NTHR + threadIdx.x; i < (size_t)T * DM; i += (size_t)gridDim.x * NTHR) F.out[i] = c;
}
#define STAGE_CHECK(n) stage_check<(n)>(F)
#else
#define STAGE_CHECK(n) do {} while (0)
#endif

__global__ void __launch_bounds__(NTHR, 2) mega_fwd(Args args) {
    extern __shared__ __attribute__((aligned(16))) unsigned char lds_raw[];
    Frame F;
    F.lds = (LAS unsigned char*)lds_raw;
    F.MISC = (volatile LAS unsigned*)(F.lds + LDSCTL_OFF);
    F.G = gridDim.x; { const int bx = blockIdx.x; F.vcu = (F.G % 8 == 0) ? (bx % 8) * (F.G / 8) + bx / 8 : bx; }
    F.ws = args.ws; F.ctl = (gu32*)(args.ws + WS_CTL); F.out = args.out;
    F.x = args.in[0]; F.p = args.in[1]; F.mix_norm = args.in[2]; F.w_in = args.in[3]; F.ln_g = args.in[4]; F.ln_b = args.in[5]; F.gws = args.in[6]; F.gbs = args.in[7];
    F.aon = args.in[8]; F.gon = args.in[9]; F.w_out = args.in[10]; F.ffn_norm = args.in[11]; F.router_w = args.in[12]; F.router_b = args.in[13]; F.w_gu = args.in[14]; F.b_gu = args.in[15];
    F.w_dn = args.in[16]; F.b_dn = args.in[17]; F.ple_norm = args.in[18]; F.w_pg = args.in[19]; F.w_pp = args.in[20]; F.ppn = args.in[21]; F.final_norm = args.in[22];
    { PHASE_IDS; for (int u = TID_; u < 256; u += NTHR) ((LAS unsigned*)(F.lds + LDSCTL_OFF))[u] = 0u; }
    __syncthreads();
    XcdBarrier bar = xcd_barrier_post((unsigned*)(F.ctl + CW_BAR), F.MISC + 8);
#define GRID_BAR() xcd_barrier(bar)
#define STAGE_END(n) do { STAGE_CHECK(n); if (TPROBE && blockIdx.x == 0 && threadIdx.x == 0) ((unsigned long long*)(F.ctl + CW_TS))[(n)] = __builtin_amdgcn_s_memrealtime(); } while (0)

    if (TPROBE && blockIdx.x == 0 && threadIdx.x == 0) ((unsigned long long*)(F.ctl + CW_TS))[0] = __builtin_amdgcn_s_memrealtime();
    for (int rep = 0; rep < (DUP_PHASE == 0 ? 2 : 1); ++rep) {
    if (PH(0)) p0_prologue(F);
    GRID_BAR(); }
    STAGE_END(1);
    if (PH(1)) { pg8::DenseSched S; S.init(wsp<bf16>(F, WS_XNB), wsp<bf16>(F, WS_WIN), T, NPROJ, DM, F.G, (int)blockIdx.x);
      float* RC = wsp<float>(F, WS_ROPE);
      EpiInProj E{wsp<bf16>(F, WS_Q), RC, RC + SEQ * 32, wsp<float>(F, WS_KMEAN)};
      for (int rep = 0; rep < (DUP_PHASE == 1 ? 2 : 1); ++rep) { if (rep) GRID_BAR();
      pg8::gemm_phase<EpiInProj, pg8::DenseSched, false, false>(F.lds + RING_OFF, DM * 2, S, E); } }
    GRID_BAR();
    STAGE_END(2);
    for (int rep = 0; rep < (DUP_PHASE == 2 ? 2 : 1); ++rep) {
    if (PH(2)) p2_mixers(F);
    GRID_BAR(); }
    STAGE_END(3);
    if (PH(3)) { pg8::DenseSched S; S.init(wsp<bf16>(F, WS_MIX), wsp<bf16>(F, WS_WOUT), T, DM, DM, F.G, (int)blockIdx.x);
      LAS f32x2* rtab = (LAS f32x2*)(F.lds + XTAB_OFF);
      Unit ua, ub; const bool ha = S.next(0, ua), hb = S.next(1, ub);
      { PHASE_IDS; const int s = TID_ >> 8, r = TID_ & 255; const bool has = s ? hb : ha; const int pm = s ? ub.pm : ua.pm;
        if (has) { const size_t row = (size_t)pm * 256 + r; const f32x4* pa = (const f32x4*)(wsp<float>(F, WS_SSQA) + row * NH); const f32x4 a0 = pa[0], a1 = pa[1], g0 = *(const f32x4*)(wsp<float>(F, WS_SSQG) + row * GG);
            const float sa = ((a0[0] + a0[1]) + (a0[2] + a0[3])) + ((a1[0] + a1[1]) + (a1[2] + a1[3])), sg = (g0[0] + g0[1]) + (g0[2] + g0[3]);
            const float ra = 1.0f / sqrtf(sa * (1.f / AW) + EPS), rg = 1.0f / sqrtf(sg * (1.f / GW) + EPS);
            rtab[s * 256 + r] = (f32x2){ra / rg, rg}; } }
      __syncthreads();
      EpiOutProj E{wsp<bf16>(F, WS_XNB), wsp<float>(F, WS_SIG0), wsp<bf16>(F, WS_X1B), wsp<unsigned char>(F, WS_X1F8), wsp<float>(F, WS_SSQ1), rtab, ha ? ua.pm : -1, hb ? ub.pm : -1};
      for (int rep = 0; rep < (DUP_PHASE == 3 ? 2 : 1); ++rep) { if (rep) GRID_BAR();
      pg8::gemm_phase<EpiOutProj, pg8::DenseSched, false, true>(F.lds + RING_OFF, DM * 2, S, E); } }
    GRID_BAR();
    STAGE_END(4);
    if (PH(4)) p4_router(F);
    GRID_BAR();
    STAGE_END(5);
    if (PH(5)) { const int nu = moe_build_tables(F, 2 * FF / 256, true);
      pg8::MoeSched S{(const char*)wsp<char>(F, WS_X1F8), (const char*)wsp<char>(F, WS_WGU), 0, (size_t)2 * FF * DM, (size_t)256 * DM, nu,
                      (const LAS unsigned*)(F.lds + XTAB_OFF + XT_ULIST), (const LAS unsigned*)(F.lds + XTAB_OFF + XT_GTAB), true};
      EpiMoe1 E{wsp<unsigned char>(F, WS_ABUF), F.b_gu, wsp<float>(F, WS_RSS)};
      for (int rep = 0; rep < (DUP_PHASE == 5 ? 2 : 1); ++rep) { if (rep) GRID_BAR();
      int Kb = DM; asm volatile("" : "+s"(Kb));
      pg8::gemm_phase<EpiMoe1, pg8::MoeSched, true, false, true>(F.lds + RING_OFF, Kb, S, E); } }
    GRID_BAR();
    STAGE_END(6);
    if (PH(6)) { const int nu = moe_build_tables(F, DM / 256, false);
      pg8::MoeSched S{(const char*)wsp<char>(F, WS_ABUF), (const char*)wsp<char>(F, WS_WDN), (size_t)256 * FF, (size_t)DM * FF, (size_t)256 * FF, nu,
                      (const LAS unsigned*)(F.lds + XTAB_OFF + XT_ULIST), (const LAS unsigned*)(F.lds + XTAB_OFF + XT_GTAB), false};
      EpiMoe2 E{wsp<bf16>(F, WS_YBUF), F.b_dn, wsp<float>(F, WS_GSS)};
      for (int rep = 0; rep < (DUP_PHASE == 6 ? 2 : 1); ++rep) { if (rep) GRID_BAR();
      int Kb = FF; asm volatile("" : "+s"(Kb));
      pg8::gemm_phase<EpiMoe2, pg8::MoeSched, false, false, true>(F.lds + RING_OFF, Kb, S, E); } }
    GRID_BAR();
    STAGE_END(7);
    if (PH(7)) p7_combine(F);
    GRID_BAR();
    STAGE_END(8);
    if (PH(8)) { pg8::DenseSched S; S.init(wsp<bf16>(F, WS_X2B), wsp<bf16>(F, WS_WPG), T, DM, DM, F.G, (int)blockIdx.x);
      EpiPle<0> E{wsp<bf16>(F, WS_GATE), wsp<float>(F, WS_RSTD2)};
      pg8::gemm_phase<EpiPle<0>, pg8::DenseSched, false, false>(F.lds + RING_OFF, DM * 2, S, E);
#if CHECK_STAGE
      GRID_BAR();
      pg8::gemm_phase<EpiPle<0>, pg8::DenseSched, false, false>(F.lds + RING_OFF, DM * 2, S, E);
#endif
    }
#if CHECK_STAGE
    GRID_BAR(); STAGE_CHECK(9);
#endif
    if (PH(8)) { pg8::DenseSched S; S.init(wsp<bf16>(F, WS_PB), wsp<bf16>(F, WS_WPP), T, DM, PLE, F.G, (int)blockIdx.x);
      EpiPle<1> E{wsp<bf16>(F, WS_PP), wsp<float>(F, WS_SSQPP)};
      int Kp = PLE * 2; asm volatile("" : "+s"(Kp));
      pg8::gemm_phase<EpiPle<1>, pg8::DenseSched, false, false>(F.lds + RING_OFF, Kp, S, E); }
    GRID_BAR();
    STAGE_END(9);
#if CHECK_STAGE
    GRID_BAR(); check_report(F);
#else
    if (PH(9)) p9_final(F);
#if TPROBE
    GRID_BAR();
    if (blockIdx.x == 0 && threadIdx.x == 0) { const unsigned long long* ts = (const unsigned long long*)(F.ctl + CW_TS); const unsigned long long t1 = (TP_A == 9) ? __builtin_amdgcn_s_memrealtime() : ts[TP_A + 1];
        F.out[0] += (float)(t1 - ts[TP_A]) * 0.01f * 0.25f; }
#endif
#endif
}

extern "C" void kernel_launch(void* const* d_in, const int* in_sizes, int n_in, void* d_out, int out_size, void* d_ws, size_t ws_size, hipStream_t stream) {
    static int grid = 0;
    if (grid == 0) {
        if (n_in != 23 || in_sizes[0] != T * DM || out_size != T * DM || ws_size < WS_END) { fprintf(stderr, "kernel_launch: unexpected shapes (n_in %d, in0 %d, out %d, ws %zu)\n", n_in, n_in > 0 ? in_sizes[0] : -1, out_size, ws_size); grid = -1; return; }
        int dev = 0, cus = 0, per_cu = 0;
        if (hipGetDevice(&dev) != hipSuccess || hipDeviceGetAttribute(&cus, hipDeviceAttributeMultiprocessorCount, dev) != hipSuccess) { grid = -1; return; }
        if (hipFuncSetAttribute((const void*)mega_fwd, hipFuncAttributeMaxDynamicSharedMemorySize, LDS_BYTES) != hipSuccess) { fprintf(stderr, "kernel_launch: hipFuncSetAttribute failed\n"); grid = -1; return; }
        if (hipOccupancyMaxActiveBlocksPerMultiprocessor(&per_cu, (const void*)mega_fwd, NTHR, LDS_BYTES) != hipSuccess || per_cu < 1)
            fprintf(stderr, "kernel_launch: note: occupancy query reports %d workgroups per CU\n", per_cu);
        (void)hipGetLastError();
        grid = cus;
    }
    if (grid < 0) return;
    if (hipMemsetAsync((char*)d_ws + WS_CTL, 0, CTL_ZERO_BYTES, stream) != hipSuccess) return;
    Args a{};
    for (int i = 0; i < 23; ++i) a.in[i] = (const float*)d_in[i];
    a.out = (float*)d_out; a.ws = (unsigned char*)d_ws;
    hipLaunchKernelGGL(mega_fwd, dim3(grid), dim3(NTHR), LDS_BYTES, stream, a);
}
```

```cpp
#include <hip/hip_runtime.h>
#include <cstdio>
#include <cstdint>

#ifndef CHECK_STAGE
#define CHECK_STAGE 0
#endif
#ifndef CHECK_REPORT
#define CHECK_REPORT 0
#endif
#ifndef CHECK_REPORT2
#define CHECK_REPORT2 0
#endif
#ifndef CHECK_REPORT3
#define CHECK_REPORT3 0
#endif
#ifndef DUP_PHASE
#define DUP_PHASE -1
#endif
#ifndef TPROBE
#define TPROBE 0
#endif
#ifndef TP_A
#define TP_A 5
#endif
#ifndef TP_B
#define TP_B 6
#endif
#ifndef CHECK_SKIP
#define CHECK_SKIP 0
#endif
#ifndef PHMASK
#define PHMASK 0x3ff
#endif
#define PH(n) ((PHMASK >> (n)) & 1)

#define GAS __attribute__((address_space(1)))
#define LAS __attribute__((address_space(3)))
typedef unsigned short bf16;
typedef unsigned v4u __attribute__((ext_vector_type(4)));
typedef unsigned v2u __attribute__((ext_vector_type(2)));
typedef float f32x2 __attribute__((ext_vector_type(2)));
typedef float f32x4 __attribute__((ext_vector_type(4)));
typedef float f32x16 __attribute__((ext_vector_type(16)));
typedef short bf16x8 __attribute__((ext_vector_type(8)));
typedef short s16x4 __attribute__((ext_vector_type(4)));
typedef GAS unsigned gu32;

constexpr int BATCH = 16, SEQ = 2048, DM = 1024, T = BATCH * SEQ;
constexpr int AW = 512, NH = 8, HD = 64, NBLK = 8, MOBA = 256;
constexpr int GW = 512, GG = 4, GD = 128, GC = 128;
constexpr int NPROJ = 3 * AW + 2 * GW;
constexpr int NE = 32, TOPK = 4, FF = 1024;
constexpr int PLE = 256;
constexpr int MAXROWS = T * TOPK + NE * 256;
constexpr float EPS = 1e-6f;
constexpr int NWAVES = 8, NTHR = 512;

constexpr size_t MiB = 1u << 20;
constexpr size_t WS_CTL = 0, CTL_ZERO_BYTES = 1 * MiB;
constexpr size_t WS_KMEAN = 256 * 1024;
constexpr size_t WS_WIN = 1 * MiB;
constexpr size_t WS_WOUT = 6 * MiB;
constexpr size_t WS_WPG = 8 * MiB;
constexpr size_t WS_WPP = 10 * MiB;
constexpr size_t WS_RWG = 10 * MiB + 512 * 1024;
constexpr size_t WS_ROPE = 11 * MiB;
constexpr size_t WS_WGU = 16 * MiB;
constexpr size_t WS_WDN = 144 * MiB;
constexpr size_t WS_XNB = 208 * MiB;
constexpr size_t WS_BIG1 = 272 * MiB;
constexpr size_t WS_Q = WS_BIG1, WS_K = WS_Q + 32 * MiB, WS_V = WS_K + 32 * MiB, WS_U = WS_V + 32 * MiB, WS_VG = WS_U + 32 * MiB, WS_MIX = WS_VG + 32 * MiB;
constexpr size_t WS_YBUF = WS_BIG1;
constexpr size_t WS_BIG2 = 544 * MiB;
constexpr size_t WS_ABUF = WS_BIG2, WS_GATE = WS_BIG2, WS_PP = WS_BIG2 + 64 * MiB;
constexpr size_t WS_PB = 816 * MiB;
constexpr size_t WS_IDX = 832 * MiB;
constexpr size_t WS_GSS = 836 * MiB;
constexpr size_t WS_TOKPOS = 840 * MiB;
constexpr size_t WS_SSQA = 841 * MiB;
constexpr size_t WS_SSQG = 842 * MiB;
constexpr size_t WS_SSQ1 = 843 * MiB;
constexpr size_t WS_SSQPP = 845 * MiB;
constexpr size_t WS_X1F8 = 848 * MiB;
constexpr size_t WS_X2N = WS_XNB;
constexpr size_t WS_X1B = 880 * MiB;
constexpr size_t WS_X2B = 944 * MiB;
constexpr size_t WS_SIG0 = 1008 * MiB;
constexpr size_t WS_RSTD2 = 1008 * MiB + 256 * 1024;
constexpr size_t WS_RWT = 1008 * MiB + 512 * 1024;
constexpr size_t WS_RSS = 1009 * MiB;
constexpr size_t WS_END = 1013 * MiB;
static_assert(WS_MIX + 64 * MiB <= WS_BIG2 && (size_t)MAXROWS * 1024 * 2 <= 272 * MiB, "ws map");
constexpr int CW_TMO = 0, CW_CODE = 1;
constexpr int CW_BAR = 4096;
constexpr int CW_CNT = 8192;
constexpr int CW_TS = 12000;
constexpr int CW_CHK = 12288;

constexpr int RING_OFF = 0, RING_BYTES = 131072;
constexpr int P0_SCR_WAVE = 64 * 65 * 4;
constexpr int LDSCTL_OFF = 8 * P0_SCR_WAVE;
constexpr int XTAB_OFF = LDSCTL_OFF + 1024;
static_assert(LDSCTL_OFF >= RING_BYTES, "lds map");
constexpr int LDS_BYTES = 163840;

#define RLX_AGENT __ATOMIC_RELAXED, __HIP_MEMORY_SCOPE_AGENT
#define LDS_WAIT() asm volatile("s_waitcnt lgkmcnt(0)" ::: "memory")
#define VM_WAIT() asm volatile("s_waitcnt vmcnt(0)" ::: "memory")
__device__ __forceinline__ unsigned f2bf(float f) { unsigned u = __builtin_bit_cast(unsigned, f); return (u + 0x7fffu + ((u >> 16) & 1u)) >> 16; }
__device__ __forceinline__ unsigned pk2(float lo, float hi) { return f2bf(lo) | (f2bf(hi) << 16); }
__device__ __forceinline__ float bf2f(unsigned short b) { return __builtin_bit_cast(float, ((unsigned)b) << 16); }
__device__ __forceinline__ float bflo(unsigned w) { return __builtin_bit_cast(float, w << 16); }
__device__ __forceinline__ float bfhi(unsigned w) { return __builtin_bit_cast(float, w & 0xffff0000u); }
typedef __bf16 bf16x2_t __attribute__((ext_vector_type(2)));
__device__ __forceinline__ unsigned cvt_pk_bf16(float lo, float hi) { const f32x2 v = {lo, hi}; const bf16x2_t b = __builtin_convertvector(v, bf16x2_t); return __builtin_bit_cast(unsigned, b); }
__device__ __forceinline__ float clamp448(float x) { return fminf(fmaxf(x, -448.0f), 448.0f); }
__device__ __forceinline__ unsigned pk4_fp8(float a, float b, float c, float d) { unsigned w = 0u; w = (unsigned)__builtin_amdgcn_cvt_pk_fp8_f32(clamp448(a), clamp448(b), (int)w, false); w = (unsigned)__builtin_amdgcn_cvt_pk_fp8_f32(clamp448(c), clamp448(d), (int)w, true); return w; }
__device__ __forceinline__ float fp8_to_f(unsigned v) { const unsigned sg = (v >> 7) & 1u, e = (v >> 3) & 15u, m = v & 7u; const float r = e ? ldexpf(1.0f + (float)m * 0.125f, (int)e - 7) : ldexpf((float)m * 0.125f, -6); return sg ? -r : r; }
__device__ __forceinline__ float wave_sum(float v) {
#pragma unroll
    for (int o = 1; o < 64; o <<= 1) v += __shfl_xor(v, o);
    return v;
}
__device__ __forceinline__ f32x2 gelu_pk(f32x2 v) {
    const f32x2 av = __builtin_elementwise_abs(v), d = av * 0.2316418882f + 1.0f;
    f32x2 t; t.x = __builtin_amdgcn_rcpf(d.x); t.y = __builtin_amdgcn_rcpf(d.y);
    f32x2 q = t * 0.5307027145f + (-0.7265760135f); q = q * t + 0.7107068705f; q = q * t + (-0.142248368f); q = q * t + 0.127414796f; q = q * t;
    const f32x2 s = (v * v) * (-0.72134752044f);
    f32x2 e; e.x = __builtin_amdgcn_exp2f(s.x); e.y = __builtin_amdgcn_exp2f(s.y);
    const f32x2 m = v * (q * e), r = v - m;
    f32x2 o; o.x = v.x < 0.f ? m.x : r.x; o.y = v.y < 0.f ? m.y : r.y; return o;
}
__device__ __forceinline__ f32x4 gelu4(f32x4 v) { const f32x2 a = gelu_pk((f32x2){v[0], v[1]}), b = gelu_pk((f32x2){v[2], v[3]}); return (f32x4){a.x, a.y, b.x, b.y}; }
__device__ __forceinline__ float sigmoidf_fast(float x) { return __builtin_amdgcn_rcpf(1.0f + __builtin_amdgcn_exp2f(-1.4426950408889634f * x)); }

#define XB_TMO      128
#define XB_XCNT(j)  (256  + 64 * (j))
#define XB_XSUB(j)  (1280 + 64 * (j))
#define XB_XGEN(j)  (2304 + 64 * (j))
#define XB_TOP      3328
#define XB_TOPGEN   3392
#define XCD_BAR_WORDS 3456
#define XB_SPIN_CAP (1u << 18)
__device__ __forceinline__ unsigned xb_ld(unsigned* p)              { return __hip_atomic_load(p, __ATOMIC_RELAXED, __HIP_MEMORY_SCOPE_AGENT); }
__device__ __forceinline__ unsigned xb_add(unsigned* p, unsigned v) { return __hip_atomic_fetch_add(p, v, __ATOMIC_RELAXED, __HIP_MEMORY_SCOPE_AGENT); }
__device__ __forceinline__ unsigned xb_xcc_id() { return (unsigned)__builtin_amdgcn_s_getreg((3 << 11) | 20) & 0xFu; }
#define XB_SPIN(cond, bar) do { unsigned _sp = 0; while (cond) { __builtin_amdgcn_s_sleep(1); \
    if ((++_sp & 255u) == 0u) { if (xb_ld(&(bar)[XB_TMO])) break; if (_sp > XB_SPIN_CAP) { atomicAdd(&(bar)[XB_TMO], 1u); break; } } } } while (0)
struct XcdBarrier { unsigned* bar; unsigned x; volatile LAS unsigned* st; };
__device__ __forceinline__ XcdBarrier xcd_barrier_post(unsigned* bar, volatile LAS unsigned* st) {
    XcdBarrier b; b.bar = bar; b.x = xb_xcc_id(); b.st = st;
    if (threadIdx.x == 0) (void)xb_add(&bar[XB_XCNT(b.x)], 1u);
    return b;
}
__device__ __forceinline__ void xcd_barrier_complete(unsigned* bar, unsigned x, unsigned& nloc, unsigned& nx) {
    const unsigned G = gridDim.x * gridDim.y * gridDim.z;
    unsigned sum, cnt, mine, sp = 0u;
    for (;;) {
        sum = 0u; cnt = 0u; mine = 0u;
#pragma unroll
        for (unsigned j = 0; j < 16; ++j) { const unsigned c = xb_ld(&bar[XB_XCNT(j)]); sum += c; cnt += (c > 0u) ? 1u : 0u; mine = (j == x) ? c : mine; }
        if (sum == G) break;
        __builtin_amdgcn_s_sleep(1);
        if ((++sp & 255u) == 0u) { if (xb_ld(&bar[XB_TMO])) break; if (sp > XB_SPIN_CAP) { atomicAdd(&bar[XB_TMO], 1u); break; } }
    }
    nloc = mine > 0u ? mine : 1u; nx = cnt > 0u ? cnt : 1u;
}
__device__ __forceinline__ void xcd_barrier(const XcdBarrier& b) {
    asm volatile("s_waitcnt vmcnt(0)" ::: "memory");
    __syncthreads();
    if (threadIdx.x == 0) {
        unsigned* bar = b.bar;
        __builtin_amdgcn_s_waitcnt(0);
        unsigned nloc = b.st[0], nx = b.st[1];
        if (nloc == 0u) { xcd_barrier_complete(bar, b.x, nloc, nx); b.st[0] = nloc; b.st[1] = nx; }
        const unsigned old = xb_add(&bar[XB_XSUB(b.x)], 1u);
        const unsigned gen = old / nloc;
        if (old + 1u == (gen + 1u) * nloc) {
            __builtin_amdgcn_fence(__ATOMIC_RELEASE, "agent");
            asm volatile("s_waitcnt vmcnt(0)" ::: "memory");
            const unsigned og = xb_add(&bar[XB_TOP], 1u);
            const unsigned tg = og / nx;
            if (og + 1u == (tg + 1u) * nx) xb_add(&bar[XB_TOPGEN], 1u);
            else XB_SPIN(xb_ld(&bar[XB_TOPGEN]) == tg, bar);
            __builtin_amdgcn_fence(__ATOMIC_ACQUIRE, "agent");
            xb_add(&bar[XB_XGEN(b.x)], 1u);
            asm volatile("s_waitcnt vmcnt(0)" ::: "memory");
        } else {
            XB_SPIN(xb_ld(&bar[XB_XGEN(b.x)]) == gen, bar);
            __builtin_amdgcn_fence(__ATOMIC_ACQUIRE, "agent");
            asm volatile("s_waitcnt vmcnt(0)" ::: "memory");
        }
    }
    __syncthreads();
}

namespace pg8 {
constexpr int BM = 256, BK = 64, HALF = 128, HTB = HALF * BK * 2, STAGE_BYTES = 8 * HTB, NXCD = 8, WGM = 8;
__host__ __device__ __forceinline__ int lds_byte(int r, int c) { const int st = (r >> 4) * 2 + (c >> 5), rr = r & 15, cc = c & 31, ob = rr * 64 + cc * 2; return st * 1024 + (ob ^ (((ob >> 9) & 1) << 5)); }
__host__ __device__ __forceinline__ void stage_rc(int b, int& R, int& C) { const int st = b / 1024, sb = b % 1024, swz = sb ^ (((sb >> 9) & 1) << 5); R = (st >> 1) * 16 + swz / 64; C = (st & 1) * 32 + (swz % 64) / 2; }
__host__ __device__ __forceinline__ int perm32(int rho) { const int n = rho >> 4, i = rho & 15; return 8 * (i >> 2) + 4 * n + (i & 3); }

typedef int v8i __attribute__((ext_vector_type(8)));
constexpr int F8_WSHIFT = 6, F8_SCALE_W = 127 - F8_WSHIFT;
typedef int v4i __attribute__((ext_vector_type(4)));
__device__ __forceinline__ v8i ld8(const LAS unsigned char* p0, const LAS unsigned char* p1) { const v4i lo = *(const LAS v4i*)p0, hi = *(const LAS v4i*)p1; return __builtin_shufflevector(lo, hi, 0, 1, 2, 3, 4, 5, 6, 7); }
struct Unit { int pm, pn, e, rt; };

__device__ __forceinline__ void flat_to_tile(int L, int nwg, int nM, int nN, int& pm, int& pn) {
    int wgid = L; { const int q = nwg / NXCD, r = nwg % NXCD, xcd = wgid % NXCD, off = wgid / NXCD; wgid = (xcd < r ? xcd * (q + 1) : r * (q + 1) + (xcd - r) * q) + off; }
    const int nig = WGM * nN, gid = wgid / nig, fm = gid * WGM, gsz = (nM - fm) < WGM ? (nM - fm) : WGM;
    pm = fm + ((wgid % nig) % gsz); pn = (wgid % nig) / gsz;
}
struct DenseSched {
    const char* A; const char* Bt; int nM, nN, nwg, G, c; size_t tstep;
    __device__ __forceinline__ void init(const void* A_, const void* Bt_, int M, int N, int K, int G_, int c_) { A = (const char*)A_; Bt = (const char*)Bt_; nM = M / BM; nN = N / BM; nwg = nM * nN; G = G_; c = c_; tstep = (size_t)BM * K * 2; }
    __device__ __forceinline__ bool next(int i, Unit& u) const { const long L = (long)i * G + c; if (L >= nwg) return false; flat_to_tile((int)L, nwg, nM, nN, u.pm, u.pn); u.e = 0; u.rt = u.pm; return true; }
    __device__ __forceinline__ const char* a_base(const Unit& u) const { return A + (size_t)u.pm * tstep; }
    __device__ __forceinline__ const char* b_base(const Unit& u) const { return Bt + (size_t)u.pn * tstep; }
    __device__ __forceinline__ void gather(int, int, int, unsigned (&)[2][2]) const {}
};
struct MoeSched {
    const char* A; const char* Bt; size_t a_tstep, b_estep, b_tstep; int nunits; const LAS unsigned* ulist; const LAS unsigned* gtab; bool gath;
    __device__ __forceinline__ bool next(int i, Unit& u) const {
        if (i >= nunits) return false;
        const unsigned w = (unsigned)__builtin_amdgcn_readfirstlane((int)ulist[i]);
        u.pm = (int)(w & 0x3ffu); u.pn = (int)((w >> 10) & 0x7u); u.e = (int)((w >> 13) & 0x1fu); u.rt = (int)(w >> 18); return true;
    }
    __device__ __forceinline__ const char* a_base(const Unit& u) const { return gath ? A : A + (size_t)u.pm * a_tstep; }
    __device__ __forceinline__ const char* b_base(const Unit& u) const { return Bt + (size_t)u.e * b_estep + (size_t)u.pn * b_tstep; }
    __device__ __forceinline__ void gather(int i, int R0, int R1, unsigned (&off)[2][2]) const {
        const LAS unsigned* g = gtab + i * 256;
        off[0][0] = g[R0]; off[0][1] = g[R1]; off[1][0] = g[128 + R0]; off[1][1] = g[128 + R1];
    }
};

#define PG8_SA(b, h) (((b) * 2 + (h)) * HTB)
#define PG8_SB(b, h) ((4 + (b) * 2 + (h)) * HTB)
#define PG8_GLDS(src, dstoff) __builtin_amdgcn_global_load_lds((const unsigned*)(src), (LAS unsigned*)(lds + (dstoff)), 16, 0, 0)
#define PG8_STAGE_B(bufoff, gbase) do { _Pragma("unroll") for (int _i = 0; _i < 2; ++_i) PG8_GLDS((const char*)(gbase) + voffB[_i], (bufoff) + ldsw + _i * 8192); } while (0)
#define PG8_STAGE_A(bufoff, kptr, h, o) do { _Pragma("unroll") for (int _i = 0; _i < 2; ++_i) \
        PG8_GLDS(GATHER ? (const char*)(kptr) + (o)[h][_i] : (const char*)(kptr) + (size_t)(h) * hstep + voffA[_i], (bufoff) + ldsw + _i * 8192); } while (0)
#define PG8_LDA(dst, b, h) do { _Pragma("unroll") for (int m = 0; m < 4; ++m) { if constexpr (F8) dst##8[m] = ld8(lds + PG8_SA(b, h) + a8_0 + m * 2048, lds + PG8_SA(b, h) + a8_1 + m * 2048); \
        else { _Pragma("unroll") for (int k = 0; k < 2; ++k) dst[m][k] = *(const LAS bf16x8*)(lds + PG8_SA(b, h) + aoff + m * 2048 + k * 1024); } } } while (0)
#define PG8_LDB(dst, b, h) do { _Pragma("unroll") for (int n = 0; n < 2; ++n) { if constexpr (F8) dst##8[n] = ld8(lds + PG8_SB(b, h) + b8_0 + n * 2048, lds + PG8_SB(b, h) + b8_1 + n * 2048); \
        else { _Pragma("unroll") for (int k = 0; k < 2; ++k) dst[n][k] = *(const LAS bf16x8*)(lds + PG8_SB(b, h) + boff + n * 2048 + k * 1024); } } } while (0)
#define PG8_MMA(ai, bj, At, Bt) do { __builtin_amdgcn_s_setprio(1); _Pragma("unroll") for (int m = 0; m < 4; ++m) _Pragma("unroll") for (int n = 0; n < 2; ++n) { \
        if constexpr (F8) asm volatile("v_mfma_scale_f32_16x16x128_f8f6f4 %0, %1, %2, %0, %3, %4 op_sel_hi:[0,0,0]" : "+v"(acc[ai][bj][m][n]) : "v"(Bt##8[n]), "v"(At##8[m]), "v"(sc_w), "v"(sc_a)); \
        else { _Pragma("unroll") for (int k = 0; k < 2; ++k) acc[ai][bj][m][n] = __builtin_amdgcn_mfma_f32_16x16x32_bf16(Bt[n][k], At[m][k], acc[ai][bj][m][n], 0, 0, 0); } } __builtin_amdgcn_s_setprio(0); } while (0)
#define PG8_WAIT_V(n) asm volatile("s_waitcnt vmcnt(" #n ")" ::: "memory")
#define PG8_WAIT_L(n) asm volatile("s_waitcnt lgkmcnt(" #n ")" ::: "memory")
#define PG8_BAR __builtin_amdgcn_s_barrier()
#define PG8_SCHED __builtin_amdgcn_sched_barrier(0)

template <class Epi, class Sched, bool GATHER, bool MIDK, bool F8 = false>
__device__ __forceinline__ void gemm_phase(LAS unsigned char* lds, const int KB  , const Sched& S, const Epi& E) {
    int tid = (int)threadIdx.x; asm volatile("" : "+v"(tid));
    const int wid = __builtin_amdgcn_readfirstlane(tid >> 6), lane = tid & 63, wr = wid >> 2, wc = wid & 3, fr = lane & 15, fq = lane >> 4;
    const int nt = KB / 128;
    unsigned voffA[2], voffB[2]; int Rg[2]; unsigned Cg[2];
#pragma unroll
    for (int i = 0; i < 2; ++i) { int R, C; stage_rc(tid * 16 + i * 8192, R, C); const int Rb = Epi::PERM ? ((R & ~31) + perm32(R & 31)) : R;
        voffA[i] = (unsigned)(R * KB + C * 2); voffB[i] = (unsigned)(Rb * KB + C * 2); Rg[i] = R; Cg[i] = (unsigned)C * 2u; }
    const size_t kstep = 128;
    const size_t hstep = (size_t)HALF * KB;
    const unsigned ldsw = (unsigned)wid * 1024u;
    const int aoff = lds_byte(wr * 64 + fr, fq * 8), boff = lds_byte(wc * 32 + fr, fq * 8);
    const int a8_0 = lds_byte(wr * 64 + fr, 16 * fq), a8_1 = lds_byte(wr * 64 + fr, 16 * fq + 8), b8_0 = lds_byte(wc * 32 + fr, 16 * fq), b8_1 = lds_byte(wc * 32 + fr, 16 * fq + 8);
    Unit cur, nxt; int ui = 0;
    if (!S.next(0, cur)) return;
    f32x4 acc[2][2][4][2];
#pragma unroll
    for (int a = 0; a < 2; ++a)
#pragma unroll
        for (int b = 0; b < 2; ++b)
#pragma unroll
            for (int m = 0; m < 4; ++m)
#pragma unroll
                for (int n = 0; n < 2; ++n) acc[a][b][m][n] = (f32x4){0.f, 0.f, 0.f, 0.f};
    bf16x8 At[4][2], B0[2][2], B1[2][2]; v8i At8[4], B08[2], B18[2];
    int sc_w = F8_SCALE_W, sc_a = 127; if constexpr (F8) { asm volatile("" : "+v"(sc_w), "+v"(sc_a)); }
    unsigned offC[2][2] = {{0u, 0u}, {0u, 0u}}, offN[2][2] = {{0u, 0u}, {0u, 0u}};
    if constexpr (GATHER) { S.gather(0, Rg[0], Rg[1], offC);
#pragma unroll
        for (int h = 0; h < 2; ++h)
#pragma unroll
            for (int i = 0; i < 2; ++i) offC[h][i] += Cg[i]; }
    const char* cA = S.a_base(cur); const char* cB = S.b_base(cur);
    PG8_STAGE_B(PG8_SB(0, 0), cB); PG8_STAGE_B(PG8_SB(0, 1), cB + hstep); PG8_STAGE_A(PG8_SA(0, 0), cA, 0, offC); PG8_STAGE_A(PG8_SA(0, 1), cA, 1, offC);
    if (wr == 1) PG8_BAR;
    PG8_WAIT_V(2); PG8_BAR;
    PG8_STAGE_B(PG8_SB(1, 0), cB + kstep); PG8_STAGE_A(PG8_SA(1, 0), cA + kstep, 0, offC); PG8_STAGE_B(PG8_SB(1, 1), cB + hstep + kstep);
    PG8_WAIT_V(6); PG8_BAR;
    for (;;) {
        const bool has_next = S.next(ui + 1, nxt);
        const char* nA = has_next ? S.a_base(nxt) : cA; const char* nB = has_next ? S.b_base(nxt) : cB;
        if constexpr (GATHER) { if (has_next) { S.gather(ui + 1, Rg[0], Rg[1], offN);
#pragma unroll
                for (int h = 0; h < 2; ++h)
#pragma unroll
                    for (int i = 0; i < 2; ++i) offN[h][i] += Cg[i]; }
            else {
#pragma unroll
                for (int h = 0; h < 2; ++h)
#pragma unroll
                    for (int i = 0; i < 2; ++i) offN[h][i] = offC[h][i]; } }
        for (int t = 0; t < nt; t += 2) {
            const bool last = (t == nt - 2);
            const char* a1 = cA + (size_t)(t + 1) * kstep;
            const char* a2 = last ? nA : cA + (size_t)(t + 2) * kstep; const char* b2 = last ? nB : cB + (size_t)(t + 2) * kstep;
            const char* a3 = a2 + kstep; const char* b3 = b2 + kstep;
            unsigned o2[2][2];
#pragma unroll
            for (int h = 0; h < 2; ++h)
#pragma unroll
                for (int i = 0; i < 2; ++i) o2[h][i] = last ? offN[h][i] : offC[h][i];
            if constexpr (MIDK) { if (t == nt / 2) E.midk(acc, cur, wr, fr); }
            PG8_LDB(B0, 0, 0); PG8_LDB(B1, 0, 1); PG8_SCHED; PG8_LDA(At, 0, 0); PG8_STAGE_A(PG8_SA(1, 1), a1, 1, offC);
            PG8_WAIT_V(8); PG8_WAIT_L(0); PG8_BAR; PG8_MMA(0, 0, At, B0); PG8_MMA(0, 1, At, B1); PG8_BAR; PG8_SCHED;
            PG8_LDA(At, 0, 1); PG8_STAGE_B(PG8_SB(0, 0), b2); PG8_STAGE_B(PG8_SB(0, 1), b2 + hstep); PG8_STAGE_A(PG8_SA(0, 0), a2, 0, o2);
            PG8_WAIT_V(8); PG8_WAIT_L(0); PG8_BAR; PG8_MMA(1, 0, At, B0); PG8_MMA(1, 1, At, B1); PG8_BAR; PG8_SCHED;
            PG8_LDB(B0, 1, 0); PG8_LDB(B1, 1, 1); PG8_SCHED; PG8_LDA(At, 1, 0); PG8_STAGE_A(PG8_SA(0, 1), a2, 1, o2);
            PG8_WAIT_V(8); PG8_WAIT_L(0); PG8_BAR; PG8_MMA(0, 0, At, B0); PG8_MMA(0, 1, At, B1); PG8_BAR; PG8_SCHED;
            PG8_LDA(At, 1, 1); PG8_STAGE_B(PG8_SB(1, 0), b3); PG8_STAGE_B(PG8_SB(1, 1), b3 + hstep); PG8_STAGE_A(PG8_SA(1, 0), a3, 0, o2);
            PG8_WAIT_V(8); PG8_WAIT_L(0); PG8_BAR; PG8_MMA(1, 0, At, B0); PG8_MMA(1, 1, At, B1); PG8_BAR; PG8_SCHED;
        }
        if (wr == 0) PG8_BAR;
        if constexpr (F8) asm volatile("s_nop 15\n\ts_nop 15" ::: "memory");
        E(acc, cur, wr, wc, fr, fq);
        if (!has_next) break;
#pragma unroll
        for (int a = 0; a < 2; ++a)
#pragma unroll
            for (int b = 0; b < 2; ++b)
#pragma unroll
                for (int m = 0; m < 4; ++m)
#pragma unroll
                    for (int n = 0; n < 2; ++n) acc[a][b][m][n] = (f32x4){0.f, 0.f, 0.f, 0.f};
        cur = nxt; cA = nA; cB = nB; ++ui;
        if constexpr (GATHER) {
#pragma unroll
            for (int h = 0; h < 2; ++h)
#pragma unroll
                for (int i = 0; i < 2; ++i) offC[h][i] = offN[h][i]; }
        if (wr == 1) PG8_BAR;
    }
    PG8_WAIT_V(0);
    PG8_BAR;
}
}

struct Frame {
    LAS unsigned char* lds;
    volatile LAS unsigned* MISC;
    gu32* ctl;
    unsigned char* ws;
    int vcu, G;
    const float *x, *p, *mix_norm, *w_in, *ln_g, *ln_b, *gws, *gbs, *aon, *gon, *w_out, *ffn_norm, *router_w, *router_b, *w_gu, *b_gu, *w_dn, *b_dn, *ple_norm, *w_pg, *w_pp, *ppn, *final_norm;
    float* out;
};
template <class T_> __device__ __forceinline__ T_* wsp(const Frame& F, size_t off) { return (T_*)(F.ws + off); }

#define PHASE_IDS int TID_ = (int)threadIdx.x; asm volatile("" : "+v"(TID_)); const int LANE_ = TID_ & 63; const int WAVE_ = __builtin_amdgcn_readfirstlane(TID_ >> 6); (void)LANE_; (void)WAVE_
template <class ColMap>
__device__ __forceinline__ void p0_transpose_item(const float* W, int K, int N, bf16* WT, const float* gain, LAS float* scr, int item, int lane, int nphys, const ColMap& cm) {
    const int nblk = nphys / 64, kb = item / nblk, nb = item % nblk, k0 = 64 * kb, n0 = 64 * nb;
    const int srccol = cm(n0 + lane);
    float v_[64]; const float* src = W + (size_t)k0 * N + srccol;
#pragma unroll
    for (int kk = 0; kk < 64; ++kk) v_[kk] = __builtin_nontemporal_load(src + (size_t)kk * N);
    if (gain) {
#pragma unroll
        for (int kk = 0; kk < 64; kk += 4) { const f32x4 g4 = *(const f32x4*)(gain + k0 + kk); v_[kk] *= g4[0]; v_[kk + 1] *= g4[1]; v_[kk + 2] *= g4[2]; v_[kk + 3] *= g4[3]; } }
#pragma unroll
    for (int kk = 0; kk < 64; ++kk) scr[kk * 65 + lane] = v_[kk];
    LDS_WAIT(); asm volatile("" ::: "memory");
    const int c = lane & 7;
#pragma unroll
    for (int j = 0; j < 8; ++j) { const int n = (lane >> 3) + 8 * j; const LAS float* s = scr + (8 * c) * 65 + n;
        v4u o; o.x = pk2(s[0 * 65], s[1 * 65]); o.y = pk2(s[2 * 65], s[3 * 65]); o.z = pk2(s[4 * 65], s[5 * 65]); o.w = pk2(s[6 * 65], s[7 * 65]);
        *(GAS v4u*)(WT + (size_t)(n0 + n) * K + k0 + 8 * c) = o; }
    LDS_WAIT(); asm volatile("" ::: "memory");
}
template <class ColMap>
__device__ __forceinline__ void p0_transpose_item_f8(const float* W, int K, int N, unsigned char* WT, const float* gain, LAS float* scr, int item, int lane, int nphys, const ColMap& cm) {
    const int nblk = nphys / 64, kb = item / nblk, nb = item % nblk, k0 = 64 * kb, n0 = 64 * nb;
    const int srccol = cm(n0 + lane);
    float v_[64]; const float* src = W + (size_t)k0 * N + srccol;
#pragma unroll
    for (int kk = 0; kk < 64; ++kk) v_[kk] = __builtin_nontemporal_load(src + (size_t)kk * N);
    constexpr float WS_ = (float)(1 << pg8::F8_WSHIFT);
#pragma unroll
    for (int kk = 0; kk < 64; kk += 4) { f32x4 g4 = gain ? *(const f32x4*)(gain + k0 + kk) : (f32x4){1.f, 1.f, 1.f, 1.f}; v_[kk] *= g4[0] * WS_; v_[kk + 1] *= g4[1] * WS_; v_[kk + 2] *= g4[2] * WS_; v_[kk + 3] *= g4[3] * WS_; }
#pragma unroll
    for (int kk = 0; kk < 64; ++kk) scr[kk * 65 + lane] = v_[kk];
    LDS_WAIT(); asm volatile("" ::: "memory");
    const int c = lane & 3;
#pragma unroll
    for (int j = 0; j < 4; ++j) { const int n = (lane >> 2) + 16 * j; const LAS float* s_ = scr + (16 * c) * 65 + n;
        v4u o; o.x = pk4_fp8(s_[0 * 65], s_[1 * 65], s_[2 * 65], s_[3 * 65]); o.y = pk4_fp8(s_[4 * 65], s_[5 * 65], s_[6 * 65], s_[7 * 65]);
        o.z = pk4_fp8(s_[8 * 65], s_[9 * 65], s_[10 * 65], s_[11 * 65]); o.w = pk4_fp8(s_[12 * 65], s_[13 * 65], s_[14 * 65], s_[15 * 65]);
        *(GAS v4u*)(WT + (size_t)(n0 + n) * K + k0 + 16 * c) = o; }
    LDS_WAIT(); asm volatile("" ::: "memory");
}
struct CmId { __device__ __forceinline__ int operator()(int n) const { return n; } };
struct CmWin { __device__ __forceinline__ int operator()(int n) const { if (n >= 2 * AW) return n; const int c = n & 63; return (n & ~63) + 4 * (c >> 3) + (c & 3) + 32 * ((c >> 2) & 1); } };
struct CmWgu { __device__ __forceinline__ int operator()(int n) const { return ((n >> 7) & 1) * FF + (n >> 8) * 128 + (n & 127); } };

__device__ __forceinline__ void p0_prologue(Frame& F) {
    PHASE_IDS;
    LAS float* scr = (LAS float*)(F.lds + RING_OFF + WAVE_ * P0_SCR_WAVE);
    const int gw = F.vcu * NWAVES + WAVE_, NGW = F.G * NWAVES;
    constexpr int I_GU = (DM / 64) * (2 * FF / 64), I_DN = (FF / 64) * (DM / 64), I_IN = (DM / 64) * (NPROJ / 64), I_SQ = (DM / 64) * (DM / 64), I_PP = (PLE / 64) * (DM / 64);
    constexpr int NITEMS = NE * I_GU + NE * I_DN + I_IN + 2 * I_SQ + I_PP;
    unsigned char* WGU = wsp<unsigned char>(F, WS_WGU); unsigned char* WDN = wsp<unsigned char>(F, WS_WDN);
    for (int it = gw; it < NITEMS; it += NGW) {
        int r = it;
        if (r < NE * I_GU) { const int e = r / I_GU; p0_transpose_item_f8(F.w_gu + (size_t)e * DM * 2 * FF, DM, 2 * FF, WGU + (size_t)e * 2 * FF * DM, F.ffn_norm, scr, r % I_GU, LANE_, 2 * FF, CmWgu()); continue; } r -= NE * I_GU;
        if (r < NE * I_DN) { const int e = r / I_DN; p0_transpose_item_f8(F.w_dn + (size_t)e * FF * DM, FF, DM, WDN + (size_t)e * DM * FF, nullptr, scr, r % I_DN, LANE_, DM, CmId()); continue; } r -= NE * I_DN;
        if (r < I_IN) { p0_transpose_item(F.w_in, DM, NPROJ, wsp<bf16>(F, WS_WIN), F.mix_norm, scr, r, LANE_, NPROJ, CmWin()); continue; } r -= I_IN;
        if (r < I_SQ) {
            const int nblk = DM / 64, kb = r / nblk; const float* g = (kb < 8) ? F.aon : (F.gon - AW);
            p0_transpose_item(F.w_out, DM, DM, wsp<bf16>(F, WS_WOUT), g, scr, r, LANE_, DM, CmId()); continue; } r -= I_SQ;
        if (r < I_SQ) { p0_transpose_item(F.w_pg, DM, DM, wsp<bf16>(F, WS_WPG), F.ple_norm, scr, r, LANE_, DM, CmId()); continue; } r -= I_SQ;
        p0_transpose_item(F.w_pp, PLE, DM, wsp<bf16>(F, WS_WPP), nullptr, scr, r, LANE_, DM, CmId());
    }
    if (TPROBE && blockIdx.x == 0 && threadIdx.x == 0) ((unsigned long long*)(F.ctl + CW_TS))[11] = __builtin_amdgcn_s_memrealtime();
    bf16* XN = wsp<bf16>(F, WS_XNB);
    for (int m0 = gw; m0 < T; m0 += 2 * NGW) {
        f32x4 v[2][4]; float s[2] = {0.f, 0.f};
#pragma unroll
        for (int r = 0; r < 2; ++r) { const GAS f32x4* xr = (const GAS f32x4*)(F.x + (size_t)(m0 + r * NGW) * DM) + LANE_;
#pragma unroll
            for (int j = 0; j < 4; ++j) v[r][j] = __builtin_nontemporal_load(xr + 64 * j); }
#pragma unroll
        for (int r = 0; r < 2; ++r) {
#pragma unroll
            for (int j = 0; j < 4; ++j) s[r] += (v[r][j].x * v[r][j].x + v[r][j].y * v[r][j].y) + (v[r][j].z * v[r][j].z + v[r][j].w * v[r][j].w); }
#pragma unroll
        for (int r = 0; r < 2; ++r) { const int m = m0 + r * NGW; const float sig = sqrtf(wave_sum(s[r]) * (1.f / DM) + EPS), rstd = 1.0f / sig;
            if (LANE_ == 0) wsp<float>(F, WS_SIG0)[m] = sig;
            GAS v2u* o8 = (GAS v2u*)(XN + (size_t)m * DM) + LANE_;
#pragma unroll
            for (int j = 0; j < 4; ++j) { v2u w; w.x = pk2(v[r][j].x * rstd, v[r][j].y * rstd); w.y = pk2(v[r][j].z * rstd, v[r][j].w * rstd); o8[64 * j] = w; } }
    }
    if (TPROBE && blockIdx.x == 0 && threadIdx.x == 0) ((unsigned long long*)(F.ctl + CW_TS))[12] = __builtin_amdgcn_s_memrealtime();
    { const GAS f32x4* pr = (const GAS f32x4*)F.p; GAS v2u* po = (GAS v2u*)wsp<bf16>(F, WS_PB);
      const size_t n4 = (size_t)T * PLE / 4, gt = (size_t)(F.vcu * NTHR + TID_), GT = (size_t)F.G * NTHR;
      for (size_t i = gt; i < n4; i += GT) { const f32x4 v = pr[i]; v2u w; w.x = pk2(v.x, v.y); w.y = pk2(v.z, v.w); po[i] = w; } }
    if (TPROBE && blockIdx.x == 0 && threadIdx.x == 0) ((unsigned long long*)(F.ctl + CW_TS))[13] = __builtin_amdgcn_s_memrealtime();
    { const int gt = F.vcu * NTHR + TID_, GT = F.G * NTHR; float* RWG = wsp<float>(F, WS_RWG);
      (void)RWG; bf16* RWT = wsp<bf16>(F, WS_RWT);
      for (int i = gt; i < DM * NE; i += GT) { const int e = i / DM, k = i % DM; const float w = F.router_w[k * NE + e] * F.ffn_norm[k]; const unsigned hi = f2bf(w); const float lo = w - bf2f((bf16)hi); RWT[i] = (bf16)hi; RWT[NE * DM + i] = (bf16)f2bf(lo); }
      float* RC = wsp<float>(F, WS_ROPE); float* RS = RC + SEQ * 32;
      for (int i = gt; i < SEQ * 32; i += GT) { const int pos = i >> 5, j = i & 31; const float inv = powf(10000.0f, -(float)j / 32.0f); const float ang = (float)pos * inv; float sn, cs; sincosf(ang, &sn, &cs); RC[i] = cs; RS[i] = sn; } }
}

using pg8::Unit;
constexpr int HALF = 128;
struct EpiInProj {
    static constexpr bool PERM = true;
    bf16* QKVUV; const float *rc, *rs; float* kmean;
    __device__ __forceinline__ void operator()(const f32x4 (&acc)[2][2][4][2], const Unit& u, int wr, int wc, int fr, int fq) const {
        const int type = u.pn >> 1, colt = (u.pn & 1) * 256 + wc * 32 + 8 * fq;
        const int row0 = u.pm * 256 + wr * 64 + fr;
        if (type <= 1) {
            bf16* dst = QKVUV + (size_t)type * (16u << 20);
            const int pos0 = (u.pm & 7) * 256 + wr * 64 + fr, i0 = 16 * (wc & 1) + 4 * fq;
            f32x4 cs_[2][2];
#pragma unroll
            for (int bj = 0; bj < 2; ++bj) { cs_[bj][0] = (f32x4){0.f, 0.f, 0.f, 0.f}; cs_[bj][1] = (f32x4){0.f, 0.f, 0.f, 0.f}; }
#pragma unroll
            for (int ai = 0; ai < 2; ++ai) { f32x4 cc[4], ss[4];
#pragma unroll
                for (int m = 0; m < 4; ++m) { const int pos = pos0 + ai * HALF + m * 16; cc[m] = *(const f32x4*)(rc + pos * 32 + i0); ss[m] = *(const f32x4*)(rs + pos * 32 + i0); }
#pragma unroll
                for (int m = 0; m < 4; ++m) { const int ro = ai * HALF + m * 16; const f32x4 c = cc[m], s = ss[m];
                    bf16* rowp = dst + (size_t)(row0 + ro) * AW + colt;
#pragma unroll
                    for (int bj = 0; bj < 2; ++bj) { const f32x4 x1 = acc[ai][bj][m][0], x2 = acc[ai][bj][m][1];
                        const f32x4 o1 = x1 * c - x2 * s, o2 = x2 * c + x1 * s;
                        cs_[bj][0] += o1; cs_[bj][1] += o2;
                        v4u w; w.x = cvt_pk_bf16(o1[0], o1[1]); w.y = cvt_pk_bf16(o1[2], o1[3]); w.z = cvt_pk_bf16(o2[0], o2[1]); w.w = cvt_pk_bf16(o2[2], o2[3]);
                        *(v4u*)(rowp + bj * HALF) = w; } }
                asm volatile("" ::: "memory"); }
            if (type == 1) {
#pragma unroll
                for (int bj = 0; bj < 2; ++bj)
#pragma unroll
                    for (int n = 0; n < 2; ++n)
#pragma unroll
                        for (int j = 0; j < 4; ++j) { float v = cs_[bj][n][j]; v += __shfl_xor(v, 1); v += __shfl_xor(v, 2); v += __shfl_xor(v, 4); v += __shfl_xor(v, 8); cs_[bj][n][j] = v; }
                if (fr == 0) { const int b = u.pm >> 3, blk = u.pm & 7;
#pragma unroll
                    for (int bj = 0; bj < 2; ++bj) { const int colh = (u.pn & 1) * 256 + bj * HALF + wc * 32; const int head = colh >> 6, cpos = (colh & 63) + 8 * fq;
                        float* km = kmean + ((size_t)((b * NH + head) * NBLK + blk)) * HD + cpos;
#pragma unroll
                        for (int n = 0; n < 2; ++n)
#pragma unroll
                            for (int j = 0; j < 4; ++j) atomicAdd(km + 4 * n + j, cs_[bj][n][j]); } }
            }
        } else {
            bf16* dst = QKVUV + (size_t)type * (16u << 20);
#pragma unroll
            for (int ai = 0; ai < 2; ++ai)
#pragma unroll
                for (int m = 0; m < 4; ++m) { bf16* rowp = dst + (size_t)(row0 + ai * HALF + m * 16) * AW + colt;
#pragma unroll
                    for (int bj = 0; bj < 2; ++bj) { f32x4 v0 = acc[ai][bj][m][0], v1 = acc[ai][bj][m][1];
                        if (type >= 3) { v0 = gelu4(v0); v1 = gelu4(v1); }
                        v4u w; w.x = cvt_pk_bf16(v0[0], v0[1]); w.y = cvt_pk_bf16(v0[2], v0[3]); w.z = cvt_pk_bf16(v1[0], v1[1]); w.w = cvt_pk_bf16(v1[2], v1[3]);
                        *(v4u*)(rowp + bj * HALF) = w; } }
        }
    }
};
struct EpiOutProj {
    static constexpr bool PERM = true;
    const bf16* xn; const float* sig0; bf16* x1; unsigned char* x1f8; float* ssq1; const LAS f32x2* rtab;
    int pm_a, pm_b;
    __device__ __forceinline__ int slot(const Unit& u) const { return u.pm == pm_a ? 0 : 1; }
    __device__ __forceinline__ void midk(f32x4 (&acc)[2][2][4][2], const Unit& u, int wr, int fr) const {
        const LAS f32x2* t = rtab + slot(u) * 256 + wr * 64 + fr;
#pragma unroll
        for (int ai = 0; ai < 2; ++ai)
#pragma unroll
            for (int m = 0; m < 4; ++m) { const float r = t[ai * HALF + m * 16].x;
#pragma unroll
                for (int bj = 0; bj < 2; ++bj)
#pragma unroll
                    for (int n = 0; n < 2; ++n) acc[ai][bj][m][n] *= r; }
    }
    __device__ __forceinline__ void operator()(const f32x4 (&acc)[2][2][4][2], const Unit& u, int wr, int wc, int fr, int fq) const {
        const LAS f32x2* t = rtab + slot(u) * 256 + wr * 64 + fr;
        const int row0 = u.pm * 256 + wr * 64 + fr, col0 = u.pn * 256 + wc * 32 + 8 * fq;
#pragma unroll
        for (int ai = 0; ai < 2; ++ai) { v4u xv[4][2]; float sg[4];
#pragma unroll
            for (int m = 0; m < 4; ++m) { const size_t off = (size_t)(row0 + ai * HALF + m * 16) * DM + col0; sg[m] = sig0[row0 + ai * HALF + m * 16];
                xv[m][0] = *(const v4u*)(xn + off); xv[m][1] = *(const v4u*)(xn + off + HALF); }
#pragma unroll
            for (int m = 0; m < 4; ++m) { const int ro = ai * HALF + m * 16; const float rg = t[ro].y, sx = sg[m]; const size_t off = (size_t)(row0 + ro) * DM + col0; float q = 0.f;
#pragma unroll
                for (int bj = 0; bj < 2; ++bj) { const v4u xw = xv[m][bj];
                    const f32x4 x0 = {bflo(xw.x), bfhi(xw.x), bflo(xw.y), bfhi(xw.y)}, x1_ = {bflo(xw.z), bfhi(xw.z), bflo(xw.w), bfhi(xw.w)};
                    const f32x4 o0 = x0 * sx + acc[ai][bj][m][0] * rg, o1 = x1_ * sx + acc[ai][bj][m][1] * rg;
                    q += (o0[0] * o0[0] + o0[1] * o0[1]) + (o0[2] * o0[2] + o0[3] * o0[3]) + (o1[0] * o1[0] + o1[1] * o1[1]) + (o1[2] * o1[2] + o1[3] * o1[3]);
                    v4u w; w.x = cvt_pk_bf16(o0[0], o0[1]); w.y = cvt_pk_bf16(o0[2], o0[3]); w.z = cvt_pk_bf16(o1[0], o1[1]); w.w = cvt_pk_bf16(o1[2], o1[3]);
                    *(v4u*)(x1 + off + bj * HALF) = w;
                    v2u w8; w8.x = pk4_fp8(o0[0], o0[1], o0[2], o0[3]); w8.y = pk4_fp8(o1[0], o1[1], o1[2], o1[3]); *(v2u*)(x1f8 + off + bj * HALF) = w8; }
                q += __shfl_xor(q, 16); q += __shfl_xor(q, 32);
                if (fq == 0) ssq1[(size_t)(row0 + ro) * 16 + u.pn * 4 + wc] = q; }
            asm volatile("" ::: "memory"); }
    }
};
struct EpiMoe1 {
    static constexpr bool PERM = true;
    unsigned char* A; const float* b_gu; const float* rss;
    __device__ __forceinline__ void operator()(const f32x4 (&acc)[2][2][4][2], const Unit& u, int wr, int wc, int fr, int fq) const {
        const int row0 = u.pm * 256 + wr * 64 + fr, col = u.pn * 128 + wc * 32 + 8 * fq;
        const float* bg = b_gu + (size_t)u.e * 2 * FF + col; const float* rs_ = rss + (size_t)u.e * T + u.rt * 256 + wr * 64 + fr;
        float rsv[2][4];
#pragma unroll
        for (int ai = 0; ai < 2; ++ai)
#pragma unroll
            for (int m = 0; m < 4; ++m) rsv[ai][m] = rs_[ai * HALF + m * 16];
        f32x4 bgv[2], blv[2];
#pragma unroll
        for (int n = 0; n < 2; ++n) { bgv[n] = *(const f32x4*)(bg + 4 * n); blv[n] = *(const f32x4*)(bg + FF + 4 * n); }
#pragma unroll
        for (int ai = 0; ai < 2; ++ai)
#pragma unroll
            for (int m = 0; m < 4; ++m) { f32x4 a[2];
#pragma unroll
                for (int n = 0; n < 2; ++n) { const f32x4 g = acc[ai][0][m][n] * rsv[ai][m] + bgv[n], l = acc[ai][1][m][n] * rsv[ai][m] + blv[n];
#pragma unroll
                    for (int j = 0; j < 4; ++j) { const float gc = fminf(g[j], 7.0f), lc = fminf(fmaxf(l[j], -7.0f), 7.0f); a[n][j] = gc * sigmoidf_fast(1.702f * gc) * (lc + 1.0f); } }
                v2u w; w.x = pk4_fp8(a[0][0], a[0][1], a[0][2], a[0][3]); w.y = pk4_fp8(a[1][0], a[1][1], a[1][2], a[1][3]);
                *(v2u*)(A + (size_t)(row0 + ai * HALF + m * 16) * FF + col) = w; }
    }
};
struct EpiMoe2 {
    static constexpr bool PERM = true;
    bf16* Y; const float* b_dn; const float* gss;
    __device__ __forceinline__ void operator()(const f32x4 (&acc)[2][2][4][2], const Unit& u, int wr, int wc, int fr, int fq) const {
        const int row0 = u.pm * 256 + wr * 64 + fr, col0 = u.pn * 256 + wc * 32 + 8 * fq;
        const float* gs = gss + (size_t)u.e * T + u.rt * 256 + wr * 64 + fr;
        f32x4 bv[2][2];
#pragma unroll
        for (int bj = 0; bj < 2; ++bj)
#pragma unroll
            for (int n = 0; n < 2; ++n) bv[bj][n] = *(const f32x4*)(b_dn + (size_t)u.e * DM + col0 + bj * HALF + 4 * n);
#pragma unroll
        for (int ai = 0; ai < 2; ++ai)
#pragma unroll
            for (int m = 0; m < 4; ++m) { const float g = gs[ai * HALF + m * 16]; bf16* rowp = Y + (size_t)(row0 + ai * HALF + m * 16) * DM + col0;
#pragma unroll
                for (int bj = 0; bj < 2; ++bj) { const f32x4 v0 = (acc[ai][bj][m][0] + bv[bj][0]) * g, v1 = (acc[ai][bj][m][1] + bv[bj][1]) * g;
                    v4u w; w.x = cvt_pk_bf16(v0[0], v0[1]); w.y = cvt_pk_bf16(v0[2], v0[3]); w.z = cvt_pk_bf16(v1[0], v1[1]); w.w = cvt_pk_bf16(v1[2], v1[3]);
                    *(v4u*)(rowp + bj * HALF) = w; } }
    }
};
template <int MODE> struct EpiPle {
    static constexpr bool PERM = true;
    bf16* O; float* ssq;
    __device__ __forceinline__ void operator()(const f32x4 (&acc)[2][2][4][2], const Unit& u, int wr, int wc, int fr, int fq) const {
        const int row0 = u.pm * 256 + wr * 64 + fr, col0 = u.pn * 256 + wc * 32 + 8 * fq;
#pragma unroll
        for (int ai = 0; ai < 2; ++ai)
#pragma unroll
            for (int m = 0; m < 4; ++m) { bf16* rowp = O + (size_t)(row0 + ai * HALF + m * 16) * DM + col0; float q = 0.f; const float rs = (MODE == 0) ? ssq[row0 + ai * HALF + m * 16] : 1.0f;
#pragma unroll
                for (int bj = 0; bj < 2; ++bj) { f32x4 v0 = acc[ai][bj][m][0], v1 = acc[ai][bj][m][1];
                    if (MODE == 0) {
#pragma unroll
                        for (int j = 0; j < 4; ++j) { v0[j] = sigmoidf_fast(rs * v0[j]); v1[j] = sigmoidf_fast(rs * v1[j]); } }
                    else { q += (v0[0] * v0[0] + v0[1] * v0[1]) + (v0[2] * v0[2] + v0[3] * v0[3]) + (v1[0] * v1[0] + v1[1] * v1[1]) + (v1[2] * v1[2] + v1[3] * v1[3]); }
                    v4u w; w.x = cvt_pk_bf16(v0[0], v0[1]); w.y = cvt_pk_bf16(v0[2], v0[3]); w.z = cvt_pk_bf16(v1[0], v1[1]); w.w = cvt_pk_bf16(v1[2], v1[3]);
                    *(v4u*)(rowp + bj * HALF) = w; }
                if (MODE == 1) { q += __shfl_xor(q, 16); q += __shfl_xor(q, 32); if (fq == 0) ssq[(size_t)(row0 + ai * HALF + m * 16) * 16 + u.pn * 4 + wc] = q; } }
    }
};

namespace att {
constexpr int QBLK = 32, KVBLK = 64;
constexpr float SCALE = 0.125f, THR = 8.f;
constexpr int SHM_V = KVBLK * HD * 2, SHM_K = SHM_V;
constexpr int NSLOT = 3;
constexpr int LDS_BYTES_ = NSLOT * SHM_V + NSLOT * SHM_K + NWAVES * 64 * 4;
#define ATT_KSWZ(row, colB) ((row) * 128 + ((colB) ^ (((row) & 7) << 4)))
#define ATT_SBAR() __builtin_amdgcn_sched_barrier(0)
__device__ __forceinline__ int crow(int r, int hi) { return (r & 3) + 8 * (r >> 2) + 4 * hi; }
__device__ __forceinline__ void cmask(f32x16& p0, f32x16& p1, int jb, int qrel, int hi) {
    const float NEG = -__builtin_inff(); const int kb = 64 * jb + 4 * hi;
#pragma unroll
    for (int r = 0; r < 16; ++r) { const int kv = kb + (r & 3) + 8 * (r >> 2); if (kv > qrel) p0[r] = NEG; if (kv + 32 > qrel) p1[r] = NEG; }
}
__device__ __forceinline__ void bmask(f32x16& p0, f32x16& p1, bool keep) {
    const float NEG = -__builtin_inff();
    if (!keep) {
#pragma unroll
        for (int r = 0; r < 16; ++r) { p0[r] = NEG; p1[r] = NEG; } }
}
__device__ __forceinline__ void partialSM(f32x16& p0, f32x16& p1, float& m_reg, float& mn, float& alpha, bool keep) {
    float pmax = p0[0];
#pragma unroll
    for (int r = 1; r < 16; ++r) pmax = fmaxf(pmax, p0[r]);
#pragma unroll
    for (int r = 0; r < 16; ++r) pmax = fmaxf(pmax, p1[r]);
    { auto rr = __builtin_amdgcn_permlane32_swap(__float_as_uint(pmax), __float_as_uint(pmax), false, false);
      pmax = fmaxf(__uint_as_float(rr[0]), __uint_as_float(rr[1])); }
    if (!keep) pmax = -__builtin_inff();
    constexpr float C2 = 1.4426950408889634f * SCALE;
    if (__builtin_expect(__all((pmax - m_reg) * SCALE <= THR), 1)) { mn = m_reg; alpha = 1.f; }
    else { mn = fmaxf(m_reg, pmax); alpha = __builtin_amdgcn_exp2f((m_reg - mn) * C2); m_reg = mn; }
    const float mnL = keep ? -mn * C2 : -__builtin_inff(), c2 = keep ? C2 : 0.f;
#pragma unroll
    for (int r = 0; r < 16; ++r) p0[r] = fmaf(p0[r], c2, mnL);
#pragma unroll
    for (int r = 0; r < 16; ++r) p1[r] = fmaf(p1[r], c2, mnL);
#pragma unroll
    for (int r = 0; r < 16; ++r) p0[r] = __builtin_amdgcn_exp2f(p0[r]);
}
__device__ __forceinline__ void finishSM(f32x16& p0, f32x16& p1, float alpha, float& l_reg, bf16x8& pa0, bf16x8& pa1, bf16x8& pa2, bf16x8& pa3) {
#pragma unroll
    for (int r = 0; r < 16; ++r) p1[r] = __builtin_amdgcn_exp2f(p1[r]);
    float ps = 0;
#pragma unroll
    for (int r = 0; r < 16; ++r) ps += p0[r];
#pragma unroll
    for (int r = 0; r < 16; ++r) ps += p1[r];
    { auto rr = __builtin_amdgcn_permlane32_swap(__float_as_uint(ps), __float_as_uint(ps), false, false);
      ps = __uint_as_float(rr[0]) + __uint_as_float(rr[1]); }
    l_reg = l_reg * alpha + ps;
#define ATT_PK4(P, B, OUT) do { unsigned a0 = cvt_pk_bf16(P[B+0], P[B+1]), a1 = cvt_pk_bf16(P[B+2], P[B+3]);             \
        unsigned b0 = cvt_pk_bf16(P[B+4], P[B+5]), b1 = cvt_pk_bf16(P[B+6], P[B+7]);                                       \
        auto r0 = __builtin_amdgcn_permlane32_swap(a0, b0, false, false); auto r1 = __builtin_amdgcn_permlane32_swap(a1, b1, false, false); \
        v4u w = {r0[0], r1[0], r0[1], r1[1]}; OUT = *reinterpret_cast<bf16x8*>(&w); } while (0)
    ATT_PK4(p0, 0, pa0); ATT_PK4(p0, 8, pa1); ATT_PK4(p1, 0, pa2); ATT_PK4(p1, 8, pa3);
#undef ATT_PK4
}
__device__ __forceinline__ void qkt(f32x16& p0, f32x16& p1, const LAS unsigned char* Ks, const bf16x8* qr, int r32, int hi) {
    p0 = f32x16{}; p1 = f32x16{};
#pragma unroll
    for (int d0 = 0; d0 < 4; ++d0) { const int cb = (d0 * 16 + hi * 8) * 2;
        const bf16x8 b0 = *(const LAS bf16x8*)(Ks + ATT_KSWZ(r32, cb));
        const bf16x8 b1 = *(const LAS bf16x8*)(Ks + ATT_KSWZ(32 + r32, cb));
        p0 = __builtin_amdgcn_mfma_f32_32x32x16_bf16(b0, qr[d0], p0, 0, 0, 0);
        p1 = __builtin_amdgcn_mfma_f32_32x32x16_bf16(b1, qr[d0], p1, 0, 0, 0); }
}
__device__ __forceinline__ void pv(f32x16* o, int vb, bf16x8 pa0, bf16x8 pa1, bf16x8 pa2, bf16x8 pa3) {
#pragma unroll
    for (int d0 = 0; d0 < 2; ++d0) { s16x4 lo[4], hi[4];
#pragma unroll
        for (int ks = 0; ks < 4; ++ks) { const int a = vb + d0 * 2048 + (ks >> 1) * 4096 + (ks & 1) * 512;
            asm volatile("ds_read_b64_tr_b16 %0,%1" : "=&v"(lo[ks]) : "v"(a) : "memory");
            asm volatile("ds_read_b64_tr_b16 %0,%1 offset:128" : "=&v"(hi[ks]) : "v"(a) : "memory"); }
        asm volatile("s_waitcnt lgkmcnt(0)" ::: "memory"); ATT_SBAR();
#define ATT_PK(k) (bf16x8){lo[k][0], lo[k][1], lo[k][2], lo[k][3], hi[k][0], hi[k][1], hi[k][2], hi[k][3]}
        o[d0] = __builtin_amdgcn_mfma_f32_32x32x16_bf16(pa0, ATT_PK(0), o[d0], 0, 0, 0);
        o[d0] = __builtin_amdgcn_mfma_f32_32x32x16_bf16(pa1, ATT_PK(1), o[d0], 0, 0, 0);
        o[d0] = __builtin_amdgcn_mfma_f32_32x32x16_bf16(pa2, ATT_PK(2), o[d0], 0, 0, 0);
        o[d0] = __builtin_amdgcn_mfma_f32_32x32x16_bf16(pa3, ATT_PK(3), o[d0], 0, 0, 0);
#undef ATT_PK
    }
}
__device__ __forceinline__ void attn_unit(const Frame& F, int b, int h, int qb, LAS unsigned char* scratch) {
    PHASE_IDS;
    const int tid = TID_, wid = tid >> 6, lane = tid & 63, r32 = lane & 31, hi = lane >> 5;
    const bf16* Qg = wsp<bf16>(F, WS_Q); const bf16* Kg = wsp<bf16>(F, WS_K); const bf16* Vg = wsp<bf16>(F, WS_V);
    const size_t rowbase = (size_t)b * SEQ; const int q0 = qb * MOBA;
    const bf16* Qw = Qg + (rowbase + q0 + wid * QBLK) * AW + h * HD;
    const bf16* Kh = Kg + rowbase * AW + h * HD; const bf16* Vh = Vg + rowbase * AW + h * HD;
    LAS unsigned char* V_lds = scratch; LAS unsigned char* K_lds = scratch + NSLOT * SHM_V;
    LAS float* wsf = (LAS float*)(scratch + NSLOT * SHM_V + NSLOT * SHM_K) + wid * 64; LAS float* li_l = wsf; LAS float* al_l = wsf + 32;
    float m_reg = -1e30f, l_reg = 0.f; f32x16 o[2]; o[0] = f32x16{}; o[1] = f32x16{}; bf16x8 qr[4];
#pragma unroll
    for (int d0 = 0; d0 < 4; ++d0) qr[d0] = *(const bf16x8*)(Qw + (size_t)r32 * AW + d0 * 16 + hi * 8);
    unsigned sel = 0u;
    if (qb <= 3) sel = (1u << qb) - 1u;
    else {
        const float* km = wsp<float>(F, WS_KMEAN) + (size_t)((b * NH + h) * NBLK) * HD + (size_t)(r32 & 7) * HD + hi * 8;
        f32x4 kv[4][2];
#pragma unroll
        for (int d0 = 0; d0 < 4; ++d0) { kv[d0][0] = *(const f32x4*)(km + d0 * 16); kv[d0][1] = *(const f32x4*)(km + d0 * 16 + 4); }
        f32x16 gacc = f32x16{};
#pragma unroll
        for (int d0 = 0; d0 < 4; ++d0) { float f[8] = {kv[d0][0][0], kv[d0][0][1], kv[d0][0][2], kv[d0][0][3], kv[d0][1][0], kv[d0][1][1], kv[d0][1][2], kv[d0][1][3]};
            unsigned hw[4], lw[4];
#pragma unroll
            for (int p = 0; p < 4; ++p) { float a0 = f[2 * p], a1 = f[2 * p + 1]; if (r32 >= 8) { a0 = 0.f; a1 = 0.f; }
                const unsigned h0 = f2bf(a0), h1 = f2bf(a1); hw[p] = h0 | (h1 << 16); lw[p] = pk2(a0 - bf2f((bf16)h0), a1 - bf2f((bf16)h1)); }
            const v4u hv = {hw[0], hw[1], hw[2], hw[3]}, lv = {lw[0], lw[1], lw[2], lw[3]};
            gacc = __builtin_amdgcn_mfma_f32_32x32x16_bf16(__builtin_bit_cast(bf16x8, hv), qr[d0], gacc, 0, 0, 0);
            gacc = __builtin_amdgcn_mfma_f32_32x32x16_bf16(__builtin_bit_cast(bf16x8, lv), qr[d0], gacc, 0, 0, 0); }
        float g[8];
#pragma unroll
        for (int r = 0; r < 4; ++r) { const float mine = gacc[r], other = __shfl_xor(mine, 32); g[r] = hi ? other : mine; g[4 + r] = hi ? mine : other; }
        float b0 = -__builtin_inff(), b1 = b0, b2 = b0; int i0 = 0, i1 = 0, i2 = 0;
#pragma unroll
        for (int j = 0; j < NBLK - 1; ++j) { const float s_ = (j < qb) ? g[j] : -__builtin_inff();
            if (s_ > b0) { b2 = b1; i2 = i1; b1 = b0; i1 = i0; b0 = s_; i0 = j; } else if (s_ > b1) { b2 = b1; i2 = i1; b1 = s_; i1 = j; } else if (s_ > b2) { b2 = s_; i2 = j; } }
        sel = (1u << i0) | (1u << i1) | (1u << i2);
    }
    const int sr = tid >> 3, sc = (tid & 7) * 8;
    const int vst = 2 * ((sr >> 5) * 2048 + (sc >> 4) * 512 + (sr & 31) * 16 + (sc & 8));
    const int vb0 = (int)(size_t)V_lds + (lane & 15) * 8 + ((lane >> 4) & 1) * 1024 + (lane >> 5) * 256;
    bf16x8 st_v, st_k;
#define ATT_SLOAD(k0) do { const size_t rr_ = (size_t)((k0) + sr) * AW + sc; st_v = *(const bf16x8*)(Vh + rr_); st_k = *(const bf16x8*)(Kh + rr_); } while (0)
#define ATT_SWRITE(bf) do { *(LAS bf16x8*)(V_lds + (bf) * SHM_V + vst) = st_v; *(LAS bf16x8*)(K_lds + (bf) * SHM_K + ATT_KSWZ(sr, sc * 2)) = st_k; } while (0)
#define ATT_RESC(a) do { if (__any((a) < 1.f)) { if (hi == 0) al_l[r32] = (a); asm volatile("s_waitcnt lgkmcnt(0)" ::: "memory");      \
        _Pragma("unroll") for (int d_ = 0; d_ < 2; ++d_) _Pragma("unroll") for (int r = 0; r < 16; ++r) o[d_][r] *= al_l[crow(r, hi)]; } } while (0)
    const int NT = (q0 + MOBA) / KVBLK;
    const int qrel = wid * QBLK + r32;
#define ATT_MASK(P0, P1, t) do { const int jb_ = (t) - (NT - 4); if (jb_ >= 0) cmask(P0, P1, jb_, qrel, hi); } while (0)
#define ATT_KEEP(t) ((((t) >= NT - 4) ? 1u : ((sel >> ((t) >> 2)) & 1u)) != 0u)
    f32x16 pA0, pA1, pB0, pB1; float mnA, mnB, alA, alB; bf16x8 pa0, pa1, pa2, pa3;
    int s0 = 0, s1 = 1, s2 = 2;
#define ATT_ROT() do { const int t_ = s0; s0 = s1; s1 = s2; s2 = t_; } while (0)
    ATT_SLOAD(0); asm volatile("s_waitcnt vmcnt(0)" ::: "memory"); ATT_SWRITE(0); ATT_SLOAD(KVBLK);
    s0 = 2; s1 = 0; s2 = 1;
    __syncthreads();
    asm volatile("s_waitcnt vmcnt(0)" ::: "memory"); ATT_SWRITE(s2); ATT_SLOAD(2 * KVBLK);
    qkt(pA0, pA1, K_lds + s1 * SHM_K, qr, r32, hi); ATT_MASK(pA0, pA1, 0); partialSM(pA0, pA1, m_reg, mnA, alA, ATT_KEEP(0));
    ATT_ROT();
    for (int j = 1; j < NT; j += 2) {
        __syncthreads();
        if (j + 1 < NT) { asm volatile("s_waitcnt vmcnt(0)" ::: "memory"); ATT_SWRITE(s2); if (j + 2 < NT) ATT_SLOAD((j + 2) * KVBLK); }
        ATT_SBAR(); qkt(pB0, pB1, K_lds + s1 * SHM_K, qr, r32, hi); ATT_MASK(pB0, pB1, j);
        finishSM(pA0, pA1, alA, l_reg, pa0, pa1, pa2, pa3); ATT_SBAR();
        pv(o, vb0 + s0 * SHM_V, pa0, pa1, pa2, pa3); partialSM(pB0, pB1, m_reg, mnB, alB, ATT_KEEP(j));
        ATT_RESC(alB); ATT_ROT();
        if (j + 1 < NT) {
            __syncthreads();
            if (j + 2 < NT) { asm volatile("s_waitcnt vmcnt(0)" ::: "memory"); ATT_SWRITE(s2); if (j + 3 < NT) ATT_SLOAD((j + 3) * KVBLK); }
            ATT_SBAR(); qkt(pA0, pA1, K_lds + s1 * SHM_K, qr, r32, hi); ATT_MASK(pA0, pA1, j + 1);
            finishSM(pB0, pB1, alB, l_reg, pa0, pa1, pa2, pa3); ATT_SBAR();
            pv(o, vb0 + s0 * SHM_V, pa0, pa1, pa2, pa3); partialSM(pA0, pA1, m_reg, mnA, alA, ATT_KEEP(j + 1));
            ATT_RESC(alA); ATT_ROT();
        }
    }
    finishSM(pB0, pB1, alB, l_reg, pa0, pa1, pa2, pa3); ATT_SBAR();
    pv(o, vb0 + s0 * SHM_V, pa0, pa1, pa2, pa3);
#undef ATT_ROT
    if (hi == 0) li_l[r32] = l_reg; asm volatile("s_waitcnt lgkmcnt(0)" ::: "memory");
    float rli[16];
#pragma unroll
    for (int r = 0; r < 16; ++r) rli[r] = __builtin_amdgcn_rcpf(li_l[crow(r, hi)]);
    bf16* Ow = wsp<bf16>(F, WS_MIX) + (rowbase + q0 + wid * QBLK) * DM + h * HD;
    float* ssqa = wsp<float>(F, WS_SSQA) + (rowbase + q0 + wid * QBLK) * NH + h;
    float qq[16];
#pragma unroll
    for (int r = 0; r < 16; ++r) { const int orow = crow(r, hi); float q2 = 0.f;
#pragma unroll
        for (int d0 = 0; d0 < 2; ++d0) { const float v = o[d0][r] * rli[r]; const float vn = __shfl_xor(v, 1); q2 += v * v;
            if ((r32 & 1) == 0) *(unsigned*)(Ow + (size_t)orow * DM + d0 * 32 + r32) = cvt_pk_bf16(v, vn); }
        qq[r] = q2; }
#pragma unroll
    for (int i = 0; i < 8; ++i) { const bool up = (lane & 16) != 0; const float send = up ? qq[i] : qq[i + 8], keep = up ? qq[i + 8] : qq[i]; qq[i] = keep + __shfl_xor(send, 16); }
#pragma unroll
    for (int i = 0; i < 4; ++i) { const bool up = (lane & 8) != 0; const float send = up ? qq[i] : qq[i + 4], keep = up ? qq[i + 4] : qq[i]; qq[i] = keep + __shfl_xor(send, 8); }
#pragma unroll
    for (int i = 0; i < 2; ++i) { const bool up = (lane & 4) != 0; const float send = up ? qq[i] : qq[i + 2], keep = up ? qq[i + 2] : qq[i]; qq[i] = keep + __shfl_xor(send, 4); }
    { const bool up = (lane & 2) != 0; const float send = up ? qq[0] : qq[1], keep = up ? qq[1] : qq[0]; qq[0] = keep + __shfl_xor(send, 2); }
    qq[0] += __shfl_xor(qq[0], 1);
    if ((lane & 1) == 0) ssqa[(size_t)crow(r32 >> 1, hi) * NH] = qq[0];
    __syncthreads();
#undef ATT_SLOAD
#undef ATT_SWRITE
#undef ATT_RESC
#undef ATT_MASK
#undef ATT_KEEP
}
}

namespace gm {
__device__ __forceinline__ int vt_off(int d, int s) { return d * 256 + ((((s >> 3) ^ (d & 15)) & 15) << 4) + (s & 7) * 2; }
__device__ __forceinline__ void units4(const Frame& F, int v, LAS unsigned char* scratch) {
    PHASE_IDS;
    const int tid = TID_, wid = tid >> 6, lane = tid & 63, fr = lane & 15, fq = lane >> 4;
    const int u = wid >> 1, half = wid & 1, uidx = 4 * v + u, b = uidx >> 6, c = (uidx >> 2) & 15, g = uidx & 3;
    const size_t row0 = (size_t)b * SEQ + c * GC;
    const bf16* VGg = wsp<bf16>(F, WS_VG) + row0 * GW + g * GD; const bf16* Ug = wsp<bf16>(F, WS_U) + row0 * GW + g * GD;
    LAS unsigned char* vt = scratch + u * 32768;
    { const int s_ = half * 64 + lane; const v4u* src = (const v4u*)(VGg + (size_t)s_ * GW); v4u raw[16]; float sum = 0.f, sq = 0.f;
#pragma unroll
      for (int i = 0; i < 16; ++i) raw[i] = src[i];
#pragma unroll
      for (int i = 0; i < 16; ++i) { const unsigned ww[4] = {raw[i].x, raw[i].y, raw[i].z, raw[i].w};
#pragma unroll
          for (int k = 0; k < 4; ++k) { const float a0 = bflo(ww[k]), a1 = bfhi(ww[k]); sum += a0 + a1; sq += a0 * a0 + a1 * a1; } }
      const float mu = sum * (1.f / GD); const float var = fmaxf(sq * (1.f / GD) - mu * mu, 0.f); const float rstd = 1.0f / sqrtf(var + EPS);
      const float* lg = F.ln_g + g * GD; const float* lb = F.ln_b + g * GD;
#pragma unroll
      for (int i = 0; i < 16; ++i) { const unsigned ww[4] = {raw[i].x, raw[i].y, raw[i].z, raw[i].w}; const f32x4 g0 = *(const f32x4*)(lg + 8 * i), g1 = *(const f32x4*)(lg + 8 * i + 4), b0 = *(const f32x4*)(lb + 8 * i), b1 = *(const f32x4*)(lb + 8 * i + 4);
          const float gg[8] = {g0[0], g0[1], g0[2], g0[3], g1[0], g1[1], g1[2], g1[3]}, bb[8] = {b0[0], b0[1], b0[2], b0[3], b1[0], b1[1], b1[2], b1[3]};
#pragma unroll
          for (int k = 0; k < 4; ++k) { const int d = 8 * i + 2 * k;
              *(LAS unsigned short*)(vt + vt_off(d, s_)) = (unsigned short)f2bf((bflo(ww[k]) - mu) * rstd * gg[2 * k] + bb[2 * k]);
              *(LAS unsigned short*)(vt + vt_off(d + 1, s_)) = (unsigned short)f2bf((bfhi(ww[k]) - mu) * rstd * gg[2 * k + 1] + bb[2 * k + 1]); } } }
    __syncthreads();
#pragma unroll 1
    for (int m = 0; m < 4; ++m) {
        const int tb = half * 64 + m * 16, t = tb + fr;
        const float* Wg = F.gws + (size_t)g * GC * GC + (size_t)t * GC;
        const int nks = (tb + 16 + 31) / 32;
        f32x4 w0[4], w1[4];
#pragma unroll
        for (int ks = 0; ks < 4; ++ks) if (ks < nks) { w0[ks] = *(const f32x4*)(Wg + ks * 32 + fq * 8); w1[ks] = *(const f32x4*)(Wg + ks * 32 + fq * 8 + 4); }
        const bf16* Ut = Ug + (size_t)t * GW + 4 * fq; v2u uu[8];
#pragma unroll
        for (int n = 0; n < 8; ++n) uu[n] = *(const v2u*)(Ut + n * 16);
        f32x4 acc[8];
#pragma unroll
        for (int n = 0; n < 8; ++n) acc[n] = (f32x4){0.f, 0.f, 0.f, 0.f};
#pragma unroll
        for (int ks = 0; ks < 4; ++ks) if (ks < nks) { const int s0 = ks * 32 + fq * 8;
            float wv[8] = {w0[ks][0], w0[ks][1], w0[ks][2], w0[ks][3], w1[ks][0], w1[ks][1], w1[ks][2], w1[ks][3]};
#pragma unroll
            for (int j = 0; j < 8; ++j) if (s0 + j > t) wv[j] = 0.f;
            v4u aw; aw.x = pk2(wv[0], wv[1]); aw.y = pk2(wv[2], wv[3]); aw.z = pk2(wv[4], wv[5]); aw.w = pk2(wv[6], wv[7]);
            const bf16x8 wf = *reinterpret_cast<const bf16x8*>(&aw);
#pragma unroll
            for (int n = 0; n < 8; ++n) { const bf16x8 vf = *(const LAS bf16x8*)(vt + vt_off(n * 16 + fr, s0));
                acc[n] = __builtin_amdgcn_mfma_f32_16x16x32_bf16(vf, wf, acc[n], 0, 0, 0); } }
        bf16* Og = wsp<bf16>(F, WS_MIX) + (row0 + t) * DM + AW + g * GD + 4 * fq; float* ssqg = wsp<float>(F, WS_SSQG) + (row0 + t) * GG + g;
        const float bs = F.gbs[g * GC + t]; float q2 = 0.f;
#pragma unroll
        for (int n = 0; n < 8; ++n) { const float o0 = bflo(uu[n].x) * (acc[n][0] + bs), o1 = bfhi(uu[n].x) * (acc[n][1] + bs), o2 = bflo(uu[n].y) * (acc[n][2] + bs), o3 = bfhi(uu[n].y) * (acc[n][3] + bs);
            q2 += (o0 * o0 + o1 * o1) + (o2 * o2 + o3 * o3); v2u w; w.x = cvt_pk_bf16(o0, o1); w.y = cvt_pk_bf16(o2, o3); *(v2u*)(Og + n * 16) = w; }
        q2 += __shfl_xor(q2, 16); q2 += __shfl_xor(q2, 32);
        if (fq == 0) ssqg[0] = q2;
    }
    __syncthreads();
}
}

__device__ __forceinline__ void p2_mixers(const Frame& F) {
    LAS unsigned char* scratch = F.lds + RING_OFF;
    const int v = F.vcu;
    { const int bh = v >> 1, s0 = (v & 1) * 2;
#pragma unroll 1
      for (int i = 0; i < 4; ++i) { const int qq = s0 + (i >> 1); const int qb = (i & 1) ? 7 - qq : qq; att::attn_unit(F, bh / NH, bh % NH, qb, scratch); } }
    if (TPROBE && blockIdx.x == 0 && threadIdx.x == 0) ((unsigned long long*)(F.ctl + CW_TS))[14] = __builtin_amdgcn_s_memrealtime();
    gm::units4(F, v, scratch);
}

__device__ __forceinline__ void p4_router(const Frame& F) {
    PHASE_IDS;
    const int tid = TID_, wid = tid >> 6, lane = tid & 63, tk = lane & 31, hf = lane >> 5;
    LAS unsigned* hist = (LAS unsigned*)(F.lds + XTAB_OFF);
    LAS unsigned* base = hist + 32;
    const bf16* RWT = wsp<bf16>(F, WS_RWT); const bf16* x1 = wsp<bf16>(F, WS_X1B); const float* ssq1 = wsp<float>(F, WS_SSQ1);
    unsigned* cntg = (unsigned*)(F.ctl + CW_CNT);
    unsigned* IDX = wsp<unsigned>(F, WS_IDX); float* GSS = wsp<float>(F, WS_GSS); float* RSS = wsp<float>(F, WS_RSS); unsigned* TOKPOS = wsp<unsigned>(F, WS_TOKPOS);
    if (tid < 32) hist[tid] = 0u;
    __syncthreads();
    const int unit = F.vcu * 4 + (wid & 3), kh = wid >> 2; const int tok = unit * 32 + tk;
    LAS float* xch = (LAS float*)(F.lds + RING_OFF) + (wid & 3) * 64 * 16;
    float rstd; { const f32x4* sp = (const f32x4*)(ssq1 + (size_t)tok * 16); const f32x4 a = sp[0], b = sp[1], c = sp[2], d = sp[3];
        const float s_ = ((a[0] + a[1]) + (a[2] + a[3])) + ((b[0] + b[1]) + (b[2] + b[3])) + ((c[0] + c[1]) + (c[2] + c[3])) + ((d[0] + d[1]) + (d[2] + d[3]));
        rstd = 1.0f / sqrtf(s_ * (1.f / DM) + EPS); }
    f32x16 acc = f32x16{};
    { const bf16* xr = x1 + (size_t)tok * DM + kh * 512 + 8 * hf; const bf16* wh = RWT + (size_t)tk * DM + kh * 512 + 8 * hf; const bf16* wl = wh + NE * DM;
#pragma unroll 8
      for (int s_ = 0; s_ < 32; ++s_) { const bf16x8 xv = *(const bf16x8*)(xr + 16 * s_), a_hi = *(const bf16x8*)(wh + 16 * s_), a_lo = *(const bf16x8*)(wl + 16 * s_);
          acc = __builtin_amdgcn_mfma_f32_32x32x16_bf16(a_hi, xv, acc, 0, 0, 0); acc = __builtin_amdgcn_mfma_f32_32x32x16_bf16(a_lo, xv, acc, 0, 0, 0); } }
    if (kh == 1) {
#pragma unroll
        for (int r = 0; r < 16; ++r) xch[lane * 16 + r] = acc[r]; }
    __syncthreads();
    const bool active = kh == 0;
    int pe[4] = {0, 0, 0, 0}; float pg[4] = {0.f, 0.f, 0.f, 0.f}; unsigned rank[2] = {0u, 0u}; int my_e[2] = {0, 0}; float my_g[2] = {0.f, 0.f};
    if (active) {
        float lv[16];
#pragma unroll
        for (int r = 0; r < 16; ++r) { const int e = (r & 3) + 8 * (r >> 2) + 4 * hf; lv[r] = (acc[r] + xch[lane * 16 + r]) * rstd + F.router_b[e]; }
        float tv[4]; int ti[4]; unsigned used = 0u;
#pragma unroll
        for (int k = 0; k < 4; ++k) { float best = -__builtin_inff(); int br = 0;
#pragma unroll
            for (int r = 0; r < 16; ++r) { const int e = (r & 3) + 8 * (r >> 2) + 4 * hf; const int eb = (br & 3) + 8 * (br >> 2) + 4 * hf;
                const bool better = !((used >> r) & 1u) && (lv[r] > best || (lv[r] == best && e < eb)); if (better) { best = lv[r]; br = r; } }
            used |= 1u << br; tv[k] = best; ti[k] = (br & 3) + 8 * (br >> 2) + 4 * hf; }
        float ov[4]; int oi[4];
#pragma unroll
        for (int k = 0; k < 4; ++k) { ov[k] = __shfl_xor(tv[k], 32); oi[k] = __shfl_xor(ti[k], 32); }
        int ia = 0, ib = 0;
#pragma unroll
        for (int k = 0; k < 4; ++k) {
            float va = tv[0], vb = ov[0]; int ea = ti[0], eb = oi[0];
#pragma unroll
            for (int q = 1; q < 4; ++q) { if (ia == q) { va = tv[q]; ea = ti[q]; } if (ib == q) { vb = ov[q]; eb = oi[q]; } }
            const bool takeA = (va > vb) || (va == vb && ea < eb);
            pg[k] = takeA ? va : vb; pe[k] = takeA ? ea : eb; if (takeA) ++ia; else ++ib; }
        { const float m = pg[0]; float s_ = 0.f;
#pragma unroll
          for (int k = 0; k < 4; ++k) { pg[k] = __builtin_amdgcn_exp2f((pg[k] - m) * 1.4426950408889634f); s_ += pg[k]; }
          const float inv = 1.0f / s_;
#pragma unroll
          for (int k = 0; k < 4; ++k) pg[k] *= inv; }
        { const int m = -hf; my_e[0] = pe[0] ^ ((pe[0] ^ pe[2]) & m); my_e[1] = pe[1] ^ ((pe[1] ^ pe[3]) & m);
          const unsigned g0 = __float_as_uint(pg[0]), g1 = __float_as_uint(pg[1]), g2 = __float_as_uint(pg[2]), g3 = __float_as_uint(pg[3]);
          my_g[0] = __uint_as_float(g0 ^ ((g0 ^ g2) & (unsigned)m)); my_g[1] = __uint_as_float(g1 ^ ((g1 ^ g3) & (unsigned)m)); }
#pragma unroll
        for (int q = 0; q < 2; ++q) rank[q] = atomicAdd((unsigned*)&hist[my_e[q]], 1u);
    }
    __syncthreads();
    if (tid < 32) base[tid] = atomicAdd(cntg + tid, hist[tid]);
    __syncthreads();
    if (active) {
#pragma unroll
        for (int q = 0; q < 2; ++q) { const int k = 2 * hf + q; const int e = my_e[q]; const float g = my_g[q];
            const unsigned slot = base[e] + rank[q];
            IDX[(size_t)e * T + slot] = (unsigned)tok; GSS[(size_t)e * T + slot] = g; RSS[(size_t)e * T + slot] = rstd; TOKPOS[(size_t)tok * 4 + k] = ((unsigned)e << 16) | slot; }
    }
    __syncthreads();
}

__device__ __forceinline__ void build_tstart(const Frame& F, LAS unsigned* tstart, int tid) {
    if (tid < 64) { const unsigned* cntg = (const unsigned*)(F.ctl + CW_CNT); unsigned c = (tid < NE) ? cntg[tid] : 0u; if (c > (unsigned)T) c = (unsigned)T;
        unsigned x = (c + 255u) >> 8;
#pragma unroll
        for (int o = 1; o < 32; o <<= 1) { const unsigned y = __shfl_up(x, o); if ((tid & 63) >= o) x += y; }
        if (tid < NE) tstart[tid + 1] = x; if (tid == 0) tstart[0] = 0u; }
}
constexpr int MAXU = 18;
constexpr int XT_TSTART = 0, XT_ULIST = 256, XT_GTAB = 512;
static_assert(XT_GTAB + MAXU * 1024 <= LDS_BYTES - XTAB_OFF, "xtab");
__device__ __forceinline__ int moe_build_tables(const Frame& F, int P  , bool gather) {
    PHASE_IDS;
    LAS unsigned* tstart = (LAS unsigned*)(F.lds + XTAB_OFF + XT_TSTART);
    LAS unsigned* ulist = (LAS unsigned*)(F.lds + XTAB_OFF + XT_ULIST);
    LAS unsigned* gtab = (LAS unsigned*)(F.lds + XTAB_OFF + XT_GTAB);
    const unsigned* cntg = (const unsigned*)(F.ctl + CW_CNT); const unsigned* IDX = wsp<unsigned>(F, WS_IDX);
    const int tid = TID_;
    build_tstart(F, tstart, tid);
    __syncthreads();
    const int NT_ = (int)tstart[NE], U = NT_ * P, G = F.G, c = (int)blockIdx.x;
    const int nunits = (c < U) ? (U - c + G - 1) / G : 0;
    if (tid < MAXU && tid < nunits) { const int L = tid * G + c; int gt, pn; pg8::flat_to_tile(L, U, NT_, P, gt, pn);
        int e = 0; for (int k = 1; k < NE; ++k) if ((unsigned)gt >= tstart[k]) e = k;
        const int rt = gt - (int)tstart[e];
        ulist[tid] = (unsigned)gt | ((unsigned)pn << 10) | ((unsigned)e << 13) | ((unsigned)rt << 18); }
    __syncthreads();
    if (gather) {
        unsigned tokv[(MAXU + 1) / 2];
#pragma unroll
        for (int p = 0; p < (MAXU + 1) / 2; ++p) { const int i = 2 * p + (tid >> 8), r = tid & 255; tokv[p] = 0u;
            if (i < nunits && i < MAXU) { const unsigned w = ulist[i]; const int e = (int)((w >> 13) & 0x1fu), rt = (int)(w >> 18);
                unsigned cn = cntg[e]; if (cn > (unsigned)T) cn = (unsigned)T; const unsigned slot = (unsigned)rt * 256u + (unsigned)r;
                if (slot < cn) tokv[p] = IDX[(size_t)e * T + slot]; } }
#pragma unroll
        for (int p = 0; p < (MAXU + 1) / 2; ++p) { const int i = 2 * p + (tid >> 8), r = tid & 255;
            if (i < nunits && i < MAXU) { unsigned tok = tokv[p]; if (tok >= (unsigned)T) tok = 0u; gtab[i * 256 + r] = tok * (unsigned)DM; } }
    }
    __syncthreads();
    return nunits < MAXU ? nunits : MAXU;
}

__device__ __forceinline__ void p7_combine(const Frame& F) {
    PHASE_IDS;
    LAS unsigned* tstart = (LAS unsigned*)(F.lds + XTAB_OFF + XT_TSTART);
    const unsigned* cntg = (const unsigned*)(F.ctl + CW_CNT);
    build_tstart(F, tstart, TID_); (void)cntg;
    __syncthreads();
    const int gw = F.vcu * NWAVES + WAVE_, NGW = F.G * NWAVES;
    const unsigned* TOKPOS = wsp<unsigned>(F, WS_TOKPOS); const bf16* Y = wsp<bf16>(F, WS_YBUF); const bf16* X1 = wsp<bf16>(F, WS_X1B); bf16* X2 = wsp<bf16>(F, WS_X2B); float* RS2 = wsp<float>(F, WS_RSTD2);
    for (int m0 = gw; m0 < T; m0 += 2 * NGW) {
        f32x4 v[2][4]; v2u yv[2][4][4]; float s[2] = {0.f, 0.f};
#pragma unroll
        for (int r = 0; r < 2; ++r) { const int m = m0 + r * NGW;
            const v4u tp = *(const v4u*)(TOKPOS + (size_t)m * 4); const unsigned tpw[4] = {tp.x, tp.y, tp.z, tp.w};
            size_t yrow[4];
#pragma unroll
            for (int k = 0; k < 4; ++k) { const unsigned e = (tpw[k] >> 16) & 31u, slot = tpw[k] & 0xffffu; yrow[k] = ((size_t)tstart[e] * 256u + slot) * DM; }
#pragma unroll
            for (int j = 0; j < 4; ++j) { const v2u xw = *(const v2u*)(X1 + (size_t)m * DM + 4 * LANE_ + 256 * j); v[r][j] = (f32x4){bflo(xw.x), bfhi(xw.x), bflo(xw.y), bfhi(xw.y)};
#pragma unroll
                for (int k = 0; k < 4; ++k) yv[r][j][k] = *(const v2u*)(Y + yrow[k] + 4 * LANE_ + 256 * j); } }
#pragma unroll
        for (int r = 0; r < 2; ++r) {
#pragma unroll
            for (int j = 0; j < 4; ++j) {
#pragma unroll
                for (int k = 0; k < 4; ++k) { const v2u w = yv[r][j][k]; v[r][j][0] += bflo(w.x); v[r][j][1] += bfhi(w.x); v[r][j][2] += bflo(w.y); v[r][j][3] += bfhi(w.y); }
                s[r] += (v[r][j].x * v[r][j].x + v[r][j].y * v[r][j].y) + (v[r][j].z * v[r][j].z + v[r][j].w * v[r][j].w); } }
#pragma unroll
        for (int r = 0; r < 2; ++r) { const int m = m0 + r * NGW; const float rstd = 1.0f / sqrtf(wave_sum(s[r]) * (1.f / DM) + EPS);
            if (LANE_ == 0) RS2[m] = rstd;
#pragma unroll
            for (int j = 0; j < 4; ++j) { v2u w; w.x = cvt_pk_bf16(v[r][j].x, v[r][j].y); w.y = cvt_pk_bf16(v[r][j].z, v[r][j].w); *(v2u*)(X2 + (size_t)m * DM + 4 * LANE_ + 256 * j) = w; } }
    }
}

__device__ __forceinline__ void p9_final(const Frame& F) {
    PHASE_IDS;
    const int gw = F.vcu * NWAVES + WAVE_, NGW = F.G * NWAVES;
    const bf16* GATE = wsp<bf16>(F, WS_GATE); const bf16* PP = wsp<bf16>(F, WS_PP); const float* ssqpp = wsp<float>(F, WS_SSQPP);
    for (int m0 = gw; m0 < T; m0 += 2 * NGW) {
        f32x4 v[2][4]; v2u gv[2][4], pv_[2][4]; f32x4 sq[2][4]; float s[2] = {0.f, 0.f};
#pragma unroll
        for (int r = 0; r < 2; ++r) { const int m = m0 + r * NGW; const bf16* x2r = wsp<bf16>(F, WS_X2B) + (size_t)m * DM;
#pragma unroll
            for (int q = 0; q < 4; ++q) sq[r][q] = *(const f32x4*)(ssqpp + (size_t)m * 16 + 4 * q);
#pragma unroll
            for (int j = 0; j < 4; ++j) { const int col = 4 * LANE_ + 256 * j; const v2u xw = *(const v2u*)(x2r + col); v[r][j] = (f32x4){bflo(xw.x), bfhi(xw.x), bflo(xw.y), bfhi(xw.y)};
                gv[r][j] = *(const v2u*)(GATE + (size_t)m * DM + col); pv_[r][j] = *(const v2u*)(PP + (size_t)m * DM + col); } }
#pragma unroll
        for (int r = 0; r < 2; ++r) { const f32x4 a = sq[r][0], b = sq[r][1], c = sq[r][2], d = sq[r][3];
            const float sp = ((a[0] + a[1]) + (a[2] + a[3])) + ((b[0] + b[1]) + (b[2] + b[3])) + ((c[0] + c[1]) + (c[2] + c[3])) + ((d[0] + d[1]) + (d[2] + d[3]));
            const float rpp = 1.0f / sqrtf(sp * (1.f / DM) + EPS);
#pragma unroll
            for (int j = 0; j < 4; ++j) { const int col = 4 * LANE_ + 256 * j; const v2u g = gv[r][j], pw = pv_[r][j]; const f32x4 pg_ = *(const f32x4*)(F.ppn + col);
                v[r][j][0] += bflo(g.x) * (bflo(pw.x) * rpp * pg_[0]); v[r][j][1] += bfhi(g.x) * (bfhi(pw.x) * rpp * pg_[1]);
                v[r][j][2] += bflo(g.y) * (bflo(pw.y) * rpp * pg_[2]); v[r][j][3] += bfhi(g.y) * (bfhi(pw.y) * rpp * pg_[3]);
                s[r] += (v[r][j].x * v[r][j].x + v[r][j].y * v[r][j].y) + (v[r][j].z * v[r][j].z + v[r][j].w * v[r][j].w); } }
#pragma unroll
        for (int r = 0; r < 2; ++r) { const int m = m0 + r * NGW; float* xr = F.out + (size_t)m * DM; const float rstd = 1.0f / sqrtf(wave_sum(s[r]) * (1.f / DM) + EPS);
#pragma unroll
            for (int j = 0; j < 4; ++j) { const int col = 4 * LANE_ + 256 * j; const f32x4 fg = *(const f32x4*)(F.final_norm + col); __builtin_nontemporal_store(v[r][j] * rstd * fg, (f32x4*)(xr + col)); } }
    }
}

struct Args { const float* in[23]; float* out; unsigned char* ws; };
#if CHECK_STAGE
__device__ __forceinline__ unsigned hmix(unsigned z) { z ^= z >> 16; z *= 0x7feb352du; z ^= z >> 15; z *= 0x846ca68bu; z ^= z >> 16; return z; }
__device__ __forceinline__ void chk_add(const Frame& F, int st, bool bad) { atomicAdd((unsigned*)(F.ctl + CW_CHK + 2 * st), bad ? 1u : 0u); atomicAdd((unsigned*)(F.ctl + CW_CHK + 2 * st + 1), 1u); }
__device__ __forceinline__ bool offby(float got, float ex, float rel, float ab) { const float d = fabsf(got - ex); return !(d <= rel * fabsf(ex) + ab); }
__device__ __forceinline__ float dot_bf(const bf16* a, const bf16* b, int n) { float s = 0.f; for (int k = 0; k < n; ++k) s += bf2f(a[k]) * bf2f(b[k]); return s; }
__device__ __forceinline__ float gelu_ref(float v) { return 0.5f * v * (1.0f + erff(v * 0.70710678f)); }
__device__ __forceinline__ unsigned chk_tstart(const Frame& F, unsigned ex) { const unsigned* cntg = (const unsigned*)(F.ctl + CW_CNT); unsigned s_ = 0; for (unsigned e = 0; e < ex; ++e) { unsigned c = cntg[e]; if (c > (unsigned)T) c = T; s_ += (c + 255u) >> 8; } return s_; }
template <int ST> __device__ __forceinline__ void stage_check(const Frame& F) {
    const unsigned gt = (unsigned)blockIdx.x * NTHR + threadIdx.x;
    const unsigned h0 = hmix(gt * 2654435761u + ST * 40503u), h1 = hmix(h0 + 0x9e3779b9u), h2 = hmix(h1 + 0x85ebca6bu);
    if (ST == 1) {
        if (gt >= 16384) return;
        const int which = gt & 7;
        if (which == 0) { const int e = h0 % NE, n = h1 % (2 * FF), k = h2 % DM; const int lc = CmWgu()(n);
            const float ex = bf2f((bf16)f2bf(F.w_gu[((size_t)e * DM + k) * 2 * FF + lc] * F.ffn_norm[k])); chk_add(F, ST, offby(bf2f(wsp<bf16>(F, WS_WGU)[((size_t)e * 2 * FF + n) * DM + k]), ex, 1e-6f, 1e-30f)); }
        else if (which == 1) { const int e = h0 % NE, n = h1 % DM, k = h2 % FF;
            const float ex = bf2f((bf16)f2bf(F.w_dn[((size_t)e * FF + k) * DM + n])); chk_add(F, ST, offby(bf2f(wsp<bf16>(F, WS_WDN)[((size_t)e * DM + n) * FF + k]), ex, 1e-6f, 1e-30f)); }
        else if (which == 2) { const int n = h1 % NPROJ, k = h2 % DM; const int lc = CmWin()(n);
            const float ex = bf2f((bf16)f2bf(F.w_in[(size_t)k * NPROJ + lc] * F.mix_norm[k])); chk_add(F, ST, offby(bf2f(wsp<bf16>(F, WS_WIN)[(size_t)n * DM + k]), ex, 1e-6f, 1e-30f)); }
        else if (which == 3) { const int n = h1 % DM, k = h2 % DM; const float g = k < AW ? F.aon[k] : F.gon[k - AW];
            const float ex = bf2f((bf16)f2bf(F.w_out[(size_t)k * DM + n] * g)); chk_add(F, ST, offby(bf2f(wsp<bf16>(F, WS_WOUT)[(size_t)n * DM + k]), ex, 1e-6f, 1e-30f)); }
        else if (which == 4) { const int n = h1 % DM, k = h2 % DM;
            const float ex = bf2f((bf16)f2bf(F.w_pg[(size_t)k * DM + n] * F.ple_norm[k])); chk_add(F, ST, offby(bf2f(wsp<bf16>(F, WS_WPG)[(size_t)n * DM + k]), ex, 1e-6f, 1e-30f)); }
        else if (which == 5) { const int n = h1 % DM, k = h2 % PLE;
            const float ex = bf2f((bf16)f2bf(F.w_pp[(size_t)k * DM + n])); chk_add(F, ST, offby(bf2f(wsp<bf16>(F, WS_WPP)[(size_t)n * PLE + k]), ex, 1e-6f, 1e-30f)); }
        else if (which == 6) { const int row = h0 % T, k = h1 % DM; float ss = 0.f; for (int j = 0; j < DM; ++j) { const float v = F.x[(size_t)row * DM + j]; ss += v * v; }
            const float ex = F.x[(size_t)row * DM + k] / sqrtf(ss / DM + EPS); chk_add(F, ST, offby(bf2f(wsp<bf16>(F, WS_XNB)[(size_t)row * DM + k]), ex, 0.01f, 1e-3f)); }
        else { const int row = h0 % T, k = h1 % PLE; chk_add(F, ST, offby(bf2f(wsp<bf16>(F, WS_PB)[(size_t)row * PLE + k]), F.p[(size_t)row * PLE + k], 0.005f, 1e-6f)); }
    }
    if (ST == 2) {
        if (gt >= 16384) return;
        const bf16* XN = wsp<bf16>(F, WS_XNB); const bf16* WIN = wsp<bf16>(F, WS_WIN);
        if ((gt & 7) == 7) {
            const int b = h0 % BATCH, hh = h1 % NH, blk = h2 % NBLK, c = (h2 >> 8) % HD; float s_ = 0.f;
            for (int r = 0; r < 256; ++r) s_ += bf2f(wsp<bf16>(F, WS_K)[((size_t)b * SEQ + blk * 256 + r) * AW + hh * HD + c]);
            chk_add(F, ST, offby(wsp<float>(F, WS_KMEAN)[((size_t)(b * NH + hh) * NBLK + blk) * HD + c], s_, 0.02f, 0.3f)); return; }
        const int row = h0 % T, type = h1 % 5, c = h2 % AW; const bf16* xr = XN + (size_t)row * DM;
        const float v = dot_bf(xr, WIN + (size_t)(type * AW + c) * DM, DM); float ex;
        if (type <= 1) { const float vp = dot_bf(xr, WIN + (size_t)(type * AW + (c ^ 4)) * DM, DM); const int i = 4 * ((c & 63) >> 3) + (c & 3), pos = row & (SEQ - 1);
            const float cs = wsp<float>(F, WS_ROPE)[pos * 32 + i], sn = wsp<float>(F, WS_ROPE)[SEQ * 32 + pos * 32 + i];
            { const float inv = powf(10000.0f, -(float)i / 32.0f); const float ang = (float)pos * inv; if (offby(cs, cosf(ang), 0.f, 1e-3f) || offby(sn, sinf(ang), 0.f, 1e-3f)) { chk_add(F, ST, true); return; } }
            ex = (c & 4) ? v * cs + vp * sn : v * cs - vp * sn; }
        else if (type == 2) ex = v; else ex = gelu_ref(v);
        chk_add(F, ST, offby(bf2f(wsp<bf16>(F, WS_Q)[(size_t)type * (16u << 20) + (size_t)row * AW + c]), ex, 0.02f, 0.02f));
    }
    if (ST == 3) {
        if (gt >= 8192) return;
        if (gt & 1) {
            const int row = h0 % T, g = h1 % GG, d = h2 % GD; const int b = row / SEQ, s_ = row % SEQ, c = s_ / GC, t = s_ % GC; float acc = 0.f;
            for (int sp = 0; sp <= t; ++sp) { const bf16* vr = wsp<bf16>(F, WS_VG) + ((size_t)b * SEQ + c * GC + sp) * GW + g * GD; float mu = 0.f; for (int j = 0; j < GD; ++j) mu += bf2f(vr[j]); mu /= GD;
                float var = 0.f; for (int j = 0; j < GD; ++j) { const float dd = bf2f(vr[j]) - mu; var += dd * dd; } const float rstd = 1.0f / sqrtf(var / GD + EPS);
                const float vn = bf2f((bf16)f2bf((bf2f(vr[d]) - mu) * rstd * F.ln_g[g * GD + d] + F.ln_b[g * GD + d])); acc += bf2f((bf16)f2bf(F.gws[((size_t)g * GC + t) * GC + sp])) * vn; }
            const float ex = bf2f(wsp<bf16>(F, WS_U)[(size_t)row * GW + g * GD + d]) * (acc + F.gbs[g * GC + t]);
            chk_add(F, ST, offby(bf2f(wsp<bf16>(F, WS_MIX)[(size_t)row * DM + AW + g * GD + d]), ex, 0.03f, 0.02f)); return; }
        const int row = h0 % T, hh = h1 % NH; const int b = row / SEQ, s_ = row % SEQ, qb = s_ / MOBA; float q[HD];
#pragma unroll
        for (int c = 0; c < HD; ++c) q[c] = bf2f(wsp<bf16>(F, WS_Q)[(size_t)row * AW + hh * HD + c]);
        unsigned sel = 0u;
        if (qb <= 3) sel = (1u << qb) - 1u;
        else { float b0 = -__builtin_inff(), b1 = b0, b2 = b0; int i0 = 0, i1 = 0, i2 = 0;
            for (int j = 0; j < qb; ++j) { const float* km = wsp<float>(F, WS_KMEAN) + ((size_t)(b * NH + hh) * NBLK + j) * HD; float g = 0.f;
#pragma unroll
                for (int c = 0; c < HD; ++c) g += q[c] * km[c];
                if (g > b0) { b2 = b1; i2 = i1; b1 = b0; i1 = i0; b0 = g; i0 = j; } else if (g > b1) { b2 = b1; i2 = i1; b1 = g; i1 = j; } else if (g > b2) { b2 = g; i2 = j; } }
            sel = (1u << i0) | (1u << i1) | (1u << i2); }
        float mx = -__builtin_inff();
        for (int kp = 0; kp <= s_; ++kp) { const int blk = kp / MOBA; if (blk != qb && !((sel >> blk) & 1u)) continue; const bf16* kr = wsp<bf16>(F, WS_K) + ((size_t)b * SEQ + kp) * AW + hh * HD; float sc = 0.f;
#pragma unroll
            for (int c = 0; c < HD; ++c) sc += q[c] * bf2f(kr[c]);
            mx = fmaxf(mx, sc * 0.125f); }
        float o[HD]; float l = 0.f;
#pragma unroll
        for (int c = 0; c < HD; ++c) o[c] = 0.f;
        for (int kp = 0; kp <= s_; ++kp) { const int blk = kp / MOBA; if (blk != qb && !((sel >> blk) & 1u)) continue; const bf16* kr = wsp<bf16>(F, WS_K) + ((size_t)b * SEQ + kp) * AW + hh * HD; float sc = 0.f;
#pragma unroll
            for (int c = 0; c < HD; ++c) sc += q[c] * bf2f(kr[c]);
            const float pr = expf(sc * 0.125f - mx); l += pr; const bf16* vr = wsp<bf16>(F, WS_V) + ((size_t)b * SEQ + kp) * AW + hh * HD;
#pragma unroll
            for (int c = 0; c < HD; ++c) o[c] += pr * bf2f(vr[c]); }
        bool bad = false; float ss = 0.f;
#pragma unroll
        for (int c = 0; c < HD; ++c) { const float ex = o[c] / l; ss += ex * ex; bad |= offby(bf2f(wsp<bf16>(F, WS_MIX)[(size_t)row * DM + hh * HD + c]), ex, 0.04f, 0.02f); }
        bad |= offby(wsp<float>(F, WS_SSQA)[(size_t)row * NH + hh], ss, 0.03f, 1e-3f);
        chk_add(F, ST, bad);
    }
    if (ST == 4) {
        if (gt >= 16384) return;
        const int row = h0 % T, col = h1 % DM; const bf16* mr = wsp<bf16>(F, WS_MIX) + (size_t)row * DM; const bf16* wr_ = wsp<bf16>(F, WS_WOUT) + (size_t)col * DM;
        float sa = 0.f, sg = 0.f, da = 0.f, dg = 0.f;
        for (int k = 0; k < AW; ++k) { const float a = bf2f(mr[k]), g = bf2f(mr[AW + k]); sa += a * a; sg += g * g; da += a * bf2f(wr_[k]); dg += g * bf2f(wr_[AW + k]); }
        const float ex = F.x[(size_t)row * DM + col] + da / sqrtf(sa / AW + EPS) + dg / sqrtf(sg / GW + EPS);
        chk_add(F, ST, offby(F.out[(size_t)row * DM + col], ex, 0.01f, 0.03f));
    }
    if (ST == 5) {
        if (gt >= 8192) return;
        const int tok = h0 % T; const float* xr = F.out + (size_t)tok * DM; float ss = 0.f; for (int k = 0; k < DM; ++k) ss += xr[k] * xr[k]; const float rstd = 1.0f / sqrtf(ss / DM + EPS);
        bool bad = false;
        for (int j = 0; j < 4; ++j) { const int k = (h1 >> (8 * j)) % DM; bad |= offby(bf2f(wsp<bf16>(F, WS_XNB)[(size_t)tok * DM + k]), xr[k] * rstd, 0.01f, 1e-3f); }
        float lg[NE];
#pragma unroll
        for (int e = 0; e < NE; ++e) lg[e] = 0.f;
        for (int k = 0; k < DM; ++k) { const float xv = xr[k] * rstd * F.ffn_norm[k];
#pragma unroll
            for (int e = 0; e < NE; ++e) lg[e] += xv * F.router_w[k * NE + e]; }
#pragma unroll
        for (int e = 0; e < NE; ++e) lg[e] += F.router_b[e];
        int te[4]; float tv[4]; unsigned used = 0u;
#pragma unroll
        for (int k = 0; k < 4; ++k) { float best = -__builtin_inff(); int bi = 0;
#pragma unroll
            for (int e = 0; e < NE; ++e) if (!((used >> e) & 1u) && lg[e] > best) { best = lg[e]; bi = e; }
            used |= 1u << bi; te[k] = bi; tv[k] = best; }
        { float gg[4]; float den = 0.f;
#pragma unroll
          for (int k = 0; k < 4; ++k) { float v = -__builtin_inff();
#pragma unroll
              for (int e = 0; e < NE; ++e) if (e == te[k]) v = lg[e];
              gg[k] = v; }
          const float mm = gg[0];
#pragma unroll
          for (int k = 0; k < 4; ++k) { gg[k] = expf(gg[k] - mm); den += gg[k]; }
          const unsigned* tp = wsp<unsigned>(F, WS_TOKPOS) + (size_t)tok * 4;
#pragma unroll
          for (int k = 0; k < 4; ++k) { const unsigned e = tp[k] >> 16, slot = tp[k] & 0xffffu; bad |= (e != (unsigned)te[k]);
              if (e < NE && slot < (unsigned)T) { bad |= wsp<unsigned>(F, WS_IDX)[(size_t)e * T + slot] != (unsigned)tok; bad |= offby(wsp<float>(F, WS_GSS)[(size_t)e * T + slot], gg[k] / den, 2e-3f, 1e-5f);
                  bad |= slot >= ((const unsigned*)(F.ctl + CW_CNT))[e]; } else bad = true; } }
        (void)tv;
        chk_add(F, ST, bad);
    }
    if (ST == 6 || ST == 7) {
        if (gt >= 16384) return;
        const int tok = h0 % T, k = h1 & 3, col = (h1 >> 2) % FF; const unsigned tp = wsp<unsigned>(F, WS_TOKPOS)[(size_t)tok * 4 + k]; const unsigned e = tp >> 16, slot = tp & 0xffffu;
        if (e >= NE) { chk_add(F, ST, true); return; }
        const unsigned tse = chk_tstart(F, e);
        const size_t row = (size_t)tse * 256 + slot;
        if (ST == 6) { const bf16* xr = wsp<bf16>(F, WS_XNB) + (size_t)tok * DM; const int np = (col >> 7) * 256 + (col & 127);
            const float g = dot_bf(xr, wsp<bf16>(F, WS_WGU) + ((size_t)e * 2 * FF + np) * DM, DM) + F.b_gu[(size_t)e * 2 * FF + col];
            const float l = dot_bf(xr, wsp<bf16>(F, WS_WGU) + ((size_t)e * 2 * FF + np + 128) * DM, DM) + F.b_gu[(size_t)e * 2 * FF + FF + col];
            const float gc = fminf(g, 7.f), lc = fminf(fmaxf(l, -7.f), 7.f); const float ex = gc / (1.0f + expf(-1.702f * gc)) * (lc + 1.0f);
            chk_add(F, ST, offby(bf2f(wsp<bf16>(F, WS_ABUF)[row * FF + col]), ex, 0.03f, 0.03f)); }
        else { const float d = dot_bf(wsp<bf16>(F, WS_ABUF) + row * FF, wsp<bf16>(F, WS_WDN) + ((size_t)e * DM + col) * FF, FF) + F.b_dn[(size_t)e * DM + col];
            const float ex = d * wsp<float>(F, WS_GSS)[(size_t)e * T + slot];
            chk_add(F, ST, offby(bf2f(wsp<bf16>(F, WS_YBUF)[row * DM + col]), ex, 0.03f, 0.01f)); }
    }
    if (ST == 8) {
        if (gt >= 8192) return;
        const int tok = h0 % T; const float* xr = F.out + (size_t)tok * DM; float ss = 0.f; for (int k = 0; k < DM; ++k) ss += xr[k] * xr[k]; const float rstd = 1.0f / sqrtf(ss / DM + EPS);
        bool bad = false; for (int k = 0; k < DM; ++k) { bad |= offby(bf2f(wsp<bf16>(F, WS_X2N)[(size_t)tok * DM + k]), xr[k] * rstd, 0.01f, 1e-3f); bad |= !(fabsf(xr[k]) < 30.f); }
        chk_add(F, ST, bad);
    }
    if (ST == 9) {
        if (gt >= 16384) return;
        const int row = h0 % T, col = h1 % DM;
        if (gt & 1) { const float d = dot_bf(wsp<bf16>(F, WS_X2N) + (size_t)row * DM, wsp<bf16>(F, WS_WPG) + (size_t)col * DM, DM); const float got = bf2f(wsp<bf16>(F, WS_GATE)[(size_t)row * DM + col]); const float ex = 1.0f / (1.0f + expf(-d)); const bool bad = offby(got, ex, 0.02f, 0.01f); chk_add(F, ST, bad);
            if (bad) { atomicOr((unsigned*)(F.ctl + CW_CHK + 40), 1u << ((col >> 3) & 31)); atomicOr((unsigned*)(F.ctl + CW_CHK + 41), 1u << ((row >> 3) & 31)); atomicOr((unsigned*)(F.ctl + CW_CHK + 42), 1u << (col & 7)); atomicOr((unsigned*)(F.ctl + CW_CHK + 43), 1u << (row & 7));
                if (!(got >= 0.f && got <= 1.f)) atomicAdd((unsigned*)(F.ctl + CW_CHK + 44), 1u); { int cl = (int)floorf(log2f(fabsf(got) + 1e-30f)) + 40; cl = cl < 0 ? 0 : (cl > 80 ? 80 : cl); atomicMax((unsigned*)(F.ctl + CW_CHK + 46), (unsigned)cl); atomicMin((unsigned*)(F.ctl + CW_CHK + 47), 0xffffffffu - (unsigned)cl); if (got < 0.f) atomicAdd((unsigned*)(F.ctl + CW_CHK + 48), 1u); } if (fabsf(got - ex) > 0.2f) atomicAdd((unsigned*)(F.ctl + CW_CHK + 45), 1u); } }
        else { const float d = dot_bf(wsp<bf16>(F, WS_PB) + (size_t)row * PLE, wsp<bf16>(F, WS_WPP) + (size_t)col * PLE, PLE); chk_add(F, 10, offby(bf2f(wsp<bf16>(F, WS_PP)[(size_t)row * DM + col]), d, 0.02f, 0.02f)); }
    }
}
__device__ __forceinline__ void check_report(const Frame& F) {
    float c2 = 3.0f;
    for (int st = 1; st <= 10; ++st) { const unsigned bad = F.ctl[CW_CHK + 2 * st], tot = F.ctl[CW_CHK + 2 * st + 1]; const float fr = tot ? (float)bad / (float)tot : 1.0f;
        (void)fr; if (((CHECK_SKIP >> st) & 1) == 0 && bad >= 1u) { c2 = powf(10.0f, (float)st) * (1.0f + fminf((float)bad, 80.0f) * 0.1f); break; } }
#if CHECK_REPORT >= 40
    { unsigned v = F.ctl[CW_CHK + CHECK_REPORT]; if (CHECK_REPORT == 47) v = 0xffffffffu - v; c2 = powf(10.0f, (float)(v >> 27)) * (1.0f + (float)((v >> 21) & 63u) * 0.1f);
#if CHECK_REPORT2
      c2 = powf(10.0f, (float)((v >> 16) & 31u)) * (1.0f + (float)((v >> 10) & 63u) * 0.1f);
#endif
#if CHECK_REPORT3
      c2 = powf(10.0f, (float)((v >> 5) & 31u)) * (1.0f + (float)(v & 31u) * 0.1f);
#endif
      if (CHECK_REPORT >= 46 && CHECK_REPORT <= 47) c2 = powf(10.0f, (float)(v / 9u)) * (1.0f + (float)(v % 9u));
    }
#endif
    if (F.ctl[CW_BAR + XB_TMO] != 0u) c2 = 1e20f;
    const float c = sqrtf(c2);
    for (size_t i = (size_t)blockIdx.x * NTHR + threadIdx.x; i < (size_t)T * DM; i += (size_t)gridDim.x * NTHR) F.out[i] = c;
}
#define STAGE_CHECK(n) stage_check<(n)>(F)
#else
#define STAGE_CHECK(n) do {} while (0)
#endif

__global__ void __launch_bounds__(NTHR, 2) mega_fwd(Args args) {
    extern __shared__ __attribute__((aligned(16))) unsigned char lds_raw[];
    Frame F;
    F.lds = (LAS unsigned char*)lds_raw;
    F.MISC = (volatile LAS unsigned*)(F.lds + LDSCTL_OFF);
    F.G = gridDim.x; { const int bx = blockIdx.x; F.vcu = (F.G % 8 == 0) ? (bx % 8) * (F.G / 8) + bx / 8 : bx; }
    F.ws = args.ws; F.ctl = (gu32*)(args.ws + WS_CTL); F.out = args.out;
    F.x = args.in[0]; F.p = args.in[1]; F.mix_norm = args.in[2]; F.w_in = args.in[3]; F.ln_g = args.in[4]; F.ln_b = args.in[5]; F.gws = args.in[6]; F.gbs = args.in[7];
    F.aon = args.in[8]; F.gon = args.in[9]; F.w_out = args.in[10]; F.ffn_norm = args.in[11]; F.router_w = args.in[12]; F.router_b = args.in[13]; F.w_gu = args.in[14]; F.b_gu = args.in[15];
    F.w_dn = args.in[16]; F.b_dn = args.in[17]; F.ple_norm = args.in[18]; F.w_pg = args.in[19]; F.w_pp = args.in[20]; F.ppn = args.in[21]; F.final_norm = args.in[22];
    { PHASE_IDS; for (int u = TID_; u < 256; u += NTHR) ((LAS unsigned*)(F.lds + LDSCTL_OFF))[u] = 0u; }
    __syncthreads();
    XcdBarrier bar = xcd_barrier_post((unsigned*)(F.ctl + CW_BAR), F.MISC + 8);
#define GRID_BAR() xcd_barrier(bar)
#define STAGE_END(n) do { STAGE_CHECK(n); if (TPROBE && blockIdx.x == 0 && threadIdx.x == 0) ((unsigned long long*)(F.ctl + CW_TS))[(n)] = __builtin_amdgcn_s_memrealtime(); } while (0)

    if (TPROBE && blockIdx.x == 0 && threadIdx.x == 0) ((unsigned long long*)(F.ctl + CW_TS))[0] = __builtin_amdgcn_s_memrealtime();
    for (int rep = 0; rep < (DUP_PHASE == 0 ? 2 : 1); ++rep) {
    if (PH(0)) p0_prologue(F);
    GRID_BAR(); }
    STAGE_END(1);
    if (PH(1)) { pg8::DenseSched S; S.init(wsp<bf16>(F, WS_XNB), wsp<bf16>(F, WS_WIN), T, NPROJ, DM, F.G, (int)blockIdx.x);
      float* RC = wsp<float>(F, WS_ROPE);
      EpiInProj E{wsp<bf16>(F, WS_Q), RC, RC + SEQ * 32, wsp<float>(F, WS_KMEAN)};
      for (int rep = 0; rep < (DUP_PHASE == 1 ? 2 : 1); ++rep) { if (rep) GRID_BAR();
      pg8::gemm_phase<EpiInProj, pg8::DenseSched, false, false>(F.lds + RING_OFF, DM * 2, S, E); } }
    GRID_BAR();
    STAGE_END(2);
    for (int rep = 0; rep < (DUP_PHASE == 2 ? 2 : 1); ++rep) {
    if (PH(2)) p2_mixers(F);
    GRID_BAR(); }
    STAGE_END(3);
    if (PH(3)) { pg8::DenseSched S; S.init(wsp<bf16>(F, WS_MIX), wsp<bf16>(F, WS_WOUT), T, DM, DM, F.G, (int)blockIdx.x);
      LAS f32x2* rtab = (LAS f32x2*)(F.lds + XTAB_OFF);
      Unit ua, ub; const bool ha = S.next(0, ua), hb = S.next(1, ub);
      { PHASE_IDS; const int s = TID_ >> 8, r = TID_ & 255; const bool has = s ? hb : ha; const int pm = s ? ub.pm : ua.pm;
        if (has) { const size_t row = (size_t)pm * 256 + r; const f32x4* pa = (const f32x4*)(wsp<float>(F, WS_SSQA) + row * NH); const f32x4 a0 = pa[0], a1 = pa[1], g0 = *(const f32x4*)(wsp<float>(F, WS_SSQG) + row * GG);
            const float sa = ((a0[0] + a0[1]) + (a0[2] + a0[3])) + ((a1[0] + a1[1]) + (a1[2] + a1[3])), sg = (g0[0] + g0[1]) + (g0[2] + g0[3]);
            const float ra = 1.0f / sqrtf(sa * (1.f / AW) + EPS), rg = 1.0f / sqrtf(sg * (1.f / GW) + EPS);
            rtab[s * 256 + r] = (f32x2){ra / rg, rg}; } }
      __syncthreads();
      EpiOutProj E{wsp<bf16>(F, WS_XNB), wsp<float>(F, WS_SIG0), wsp<bf16>(F, WS_X1B), wsp<unsigned char>(F, WS_X1F8), wsp<float>(F, WS_SSQ1), rtab, ha ? ua.pm : -1, hb ? ub.pm : -1};
      for (int rep = 0; rep < (DUP_PHASE == 3 ? 2 : 1); ++rep) { if (rep) GRID_BAR();
      pg8::gemm_phase<EpiOutProj, pg8::DenseSched, false, true>(F.lds + RING_OFF, DM * 2, S, E); } }
    GRID_BAR();
    STAGE_END(4);
    if (PH(4)) p4_router(F);
    GRID_BAR();
    STAGE_END(5);
    if (PH(5)) { const int nu = moe_build_tables(F, 2 * FF / 256, true);
      pg8::MoeSched S{(const char*)wsp<char>(F, WS_X1F8), (const char*)wsp<char>(F, WS_WGU), 0, (size_t)2 * FF * DM, (size_t)256 * DM, nu,
                      (const LAS unsigned*)(F.lds + XTAB_OFF + XT_ULIST), (const LAS unsigned*)(F.lds + XTAB_OFF + XT_GTAB), true};
      EpiMoe1 E{wsp<unsigned char>(F, WS_ABUF), F.b_gu, wsp<float>(F, WS_RSS)};
      for (int rep = 0; rep < (DUP_PHASE == 5 ? 2 : 1); ++rep) { if (rep) GRID_BAR();
      int Kb = DM; asm volatile("" : "+s"(Kb));
      pg8::gemm_phase<EpiMoe1, pg8::MoeSched, true, false, true>(F.lds + RING_OFF, Kb, S, E); } }
    GRID_BAR();
    STAGE_END(6);
    if (PH(6)) { const int nu = moe_build_tables(F, DM / 256, false);
      pg8::MoeSched S{(const char*)wsp<char>(F, WS_ABUF), (const char*)wsp<char>(F, WS_WDN), (size_t)256 * FF, (size_t)DM * FF, (size_t)256 * FF, nu,
                      (const LAS unsigned*)(F.lds + XTAB_OFF + XT_ULIST), (const LAS unsigned*)(F.lds + XTAB_OFF + XT_GTAB), false};
      EpiMoe2 E{wsp<bf16>(F, WS_YBUF), F.b_dn, wsp<float>(F, WS_GSS)};
      for (int rep = 0; rep < (DUP_PHASE == 6 ? 2 : 1); ++rep) { if (rep) GRID_BAR();
      int Kb = FF; asm volatile("" : "+s"(Kb));
      pg8::gemm_phase<EpiMoe2, pg8::MoeSched, false, false, true>(F.lds + RING_OFF, Kb, S, E); } }
    GRID_BAR();
    STAGE_END(7);
    if (PH(7)) p7_combine(F);
    GRID_BAR();
    STAGE_END(8);
    if (PH(8)) { pg8::DenseSched S; S.init(wsp<bf16>(F, WS_X2B), wsp<bf16>(F, WS_WPG), T, DM, DM, F.G, (int)blockIdx.x);
      EpiPle<0> E{wsp<bf16>(F, WS_GATE), wsp<float>(F, WS_RSTD2)};
      pg8::gemm_phase<EpiPle<0>, pg8::DenseSched, false, false>(F.lds + RING_OFF, DM * 2, S, E);
#if CHECK_STAGE
      GRID_BAR();
      pg8::gemm_phase<EpiPle<0>, pg8::DenseSched, false, false>(F.lds + RING_OFF, DM * 2, S, E);
#endif
    }
#if CHECK_STAGE
    GRID_BAR(); STAGE_CHECK(9);
#endif
    if (PH(8)) { pg8::DenseSched S; S.init(wsp<bf16>(F, WS_PB), wsp<bf16>(F, WS_WPP), T, DM, PLE, F.G, (int)blockIdx.x);
      EpiPle<1> E{wsp<bf16>(F, WS_PP), wsp<float>(F, WS_SSQPP)};
      int Kp = PLE * 2; asm volatile("" : "+s"(Kp));
      pg8::gemm_phase<EpiPle<1>, pg8::DenseSched, false, false>(F.lds + RING_OFF, Kp, S, E); }
    GRID_BAR();
    STAGE_END(9);
#if CHECK_STAGE
    GRID_BAR(); check_report(F);
#else
    if (PH(9)) p9_final(F);
#if TPROBE
    GRID_BAR();
    if (blockIdx.x == 0 && threadIdx.x == 0) { const unsigned long long* ts = (const unsigned long long*)(F.ctl + CW_TS); const unsigned long long t1 = (TP_A == 9) ? __builtin_amdgcn_s_memrealtime() : ts[(TP_A < 10 ? TP_A : 0) + 1];
        unsigned long long d = t1 - ts[TP_A < 10 ? TP_A : 0];
        if (TP_A == 20) d = ts[11] - ts[0]; if (TP_A == 21) d = ts[12] - ts[11]; if (TP_A == 22) d = ts[13] - ts[12]; if (TP_A == 23) d = ts[1] - ts[13]; if (TP_A == 24) d = ts[14] - ts[2]; if (TP_A == 25) d = ts[3] - ts[14];
        F.out[0] += floorf((float)d * 0.01f * 0.125f + 0.5f) * 2.0f; }
#endif
#endif
}

extern "C" void kernel_launch(void* const* d_in, const int* in_sizes, int n_in, void* d_out, int out_size, void* d_ws, size_t ws_size, hipStream_t stream) {
    static int grid = 0;
    if (grid == 0) {
        if (n_in != 23 || in_sizes[0] != T * DM || out_size != T * DM || ws_size < WS_END) { fprintf(stderr, "kernel_launch: unexpected shapes (n_in %d, in0 %d, out %d, ws %zu)\n", n_in, n_in > 0 ? in_sizes[0] : -1, out_size, ws_size); grid = -1; return; }
        int dev = 0, cus = 0, per_cu = 0;
        if (hipGetDevice(&dev) != hipSuccess || hipDeviceGetAttribute(&cus, hipDeviceAttributeMultiprocessorCount, dev) != hipSuccess) { grid = -1; return; }
        if (hipFuncSetAttribute((const void*)mega_fwd, hipFuncAttributeMaxDynamicSharedMemorySize, LDS_BYTES) != hipSuccess) { fprintf(stderr, "kernel_launch: hipFuncSetAttribute failed\n"); grid = -1; return; }
        if (hipOccupancyMaxActiveBlocksPerMultiprocessor(&per_cu, (const void*)mega_fwd, NTHR, LDS_BYTES) != hipSuccess || per_cu < 1)
            fprintf(stderr, "kernel_launch: note: occupancy query reports %d workgroups per CU\n", per_cu);
        (void)hipGetLastError();
        grid = cus;
    }
    if (grid < 0) return;
    if (hipMemsetAsync((char*)d_ws + WS_CTL, 0, CTL_ZERO_BYTES, stream) != hipSuccess) return;
    Args a{};
    for (int i = 0; i < 23; ++i) a.in[i] = (const float*)d_in[i];
    a.out = (float*)d_out; a.ws = (unsigned char*)d_ws;
    hipLaunchKernelGGL(mega_fwd, dim3(grid), dim3(NTHR), LDS_BYTES, stream, a);
}
```

```cpp
#include <hip/hip_runtime.h>
#include <cstdio>
#include <cstdint>

#ifndef CHECK_STAGE
#define CHECK_STAGE 0
#endif
#ifndef CHECK_REPORT
#define CHECK_REPORT 0
#endif
#ifndef CHECK_REPORT2
#define CHECK_REPORT2 0
#endif
#ifndef CHECK_REPORT3
#define CHECK_REPORT3 0
#endif
#ifndef DUP_PHASE
#define DUP_PHASE -1
#endif
#ifndef TPROBE
#define TPROBE 0
#endif
#ifndef TP_A
#define TP_A 5
#endif
#ifndef TP_B
#define TP_B 6
#endif
#ifndef CHECK_SKIP
#define CHECK_SKIP 0
#endif
#ifndef PHMASK
#define PHMASK 0x3ff
#endif
#define PH(n) ((PHMASK >> (n)) & 1)

#define GAS __attribute__((address_space(1)))
#define LAS __attribute__((address_space(3)))
typedef unsigned short bf16;
typedef unsigned v4u __attribute__((ext_vector_type(4)));
typedef unsigned v2u __attribute__((ext_vector_type(2)));
typedef float f32x2 __attribute__((ext_vector_type(2)));
typedef float f32x4 __attribute__((ext_vector_type(4)));
typedef float f32x16 __attribute__((ext_vector_type(16)));
typedef short bf16x8 __attribute__((ext_vector_type(8)));
typedef short s16x4 __attribute__((ext_vector_type(4)));
typedef GAS unsigned gu32;

constexpr int BATCH = 16, SEQ = 2048, DM = 1024, T = BATCH * SEQ;
constexpr int AW = 512, NH = 8, HD = 64, NBLK = 8, MOBA = 256;
constexpr int GW = 512, GG = 4, GD = 128, GC = 128;
constexpr int NPROJ = 3 * AW + 2 * GW;
constexpr int NE = 32, TOPK = 4, FF = 1024;
constexpr int PLE = 256;
constexpr int MAXROWS = T * TOPK + NE * 256;
constexpr float EPS = 1e-6f;
constexpr int NWAVES = 8, NTHR = 512;

constexpr size_t MiB = 1u << 20;
constexpr size_t WS_CTL = 0, CTL_ZERO_BYTES = 1 * MiB;
constexpr size_t WS_KMEAN = 256 * 1024;
constexpr size_t WS_WIN = 1 * MiB;
constexpr size_t WS_WOUT = 6 * MiB;
constexpr size_t WS_WPG = 8 * MiB;
constexpr size_t WS_WPP = 10 * MiB;
constexpr size_t WS_RWG = 10 * MiB + 512 * 1024;
constexpr size_t WS_ROPE = 11 * MiB;
constexpr size_t WS_WGU = 16 * MiB;
constexpr size_t WS_WDN = 144 * MiB;
constexpr size_t WS_XNB = 208 * MiB;
constexpr size_t WS_BIG1 = 272 * MiB;
constexpr size_t WS_Q = WS_BIG1, WS_K = WS_Q + 32 * MiB, WS_V = WS_K + 32 * MiB, WS_U = WS_V + 32 * MiB, WS_VG = WS_U + 32 * MiB, WS_MIX = WS_VG + 32 * MiB;
constexpr size_t WS_YBUF = WS_BIG1;
constexpr size_t WS_BIG2 = 544 * MiB;
constexpr size_t WS_ABUF = WS_BIG2, WS_GATE = WS_BIG2, WS_PP = WS_BIG2 + 64 * MiB;
constexpr size_t WS_PB = 816 * MiB;
constexpr size_t WS_IDX = 832 * MiB;
constexpr size_t WS_GSS = 836 * MiB;
constexpr size_t WS_TOKPOS = 840 * MiB;
constexpr size_t WS_SSQA = 841 * MiB;
constexpr size_t WS_SSQG = 842 * MiB;
constexpr size_t WS_SSQ1 = 843 * MiB;
constexpr size_t WS_SSQPP = 845 * MiB;
constexpr size_t WS_X1F8 = 848 * MiB;
constexpr size_t WS_X2N = WS_XNB;
constexpr size_t WS_X1B = 880 * MiB;
constexpr size_t WS_X2B = 944 * MiB;
constexpr size_t WS_SIG0 = 1008 * MiB;
constexpr size_t WS_RSTD2 = 1008 * MiB + 256 * 1024;
constexpr size_t WS_RWT = 1008 * MiB + 512 * 1024;
constexpr size_t WS_RSS = 1009 * MiB;
constexpr size_t WS_X2F8 = 176 * MiB;
constexpr size_t WS_WPG8 = 80 * MiB;
constexpr size_t WS_END = 1013 * MiB;
static_assert(WS_MIX + 64 * MiB <= WS_BIG2 && (size_t)MAXROWS * 1024 * 2 <= 272 * MiB, "ws map");
constexpr int CW_TMO = 0, CW_CODE = 1;
constexpr int CW_BAR = 4096;
constexpr int CW_CNT = 8192;
constexpr int CW_TS = 12000;
constexpr int CW_CHK = 12288;

constexpr int RING_OFF = 0, RING_BYTES = 131072;
constexpr int P0_SCR_WAVE = 64 * 65 * 4;
constexpr int LDSCTL_OFF = 8 * P0_SCR_WAVE;
constexpr int XTAB_OFF = LDSCTL_OFF + 1024;
static_assert(LDSCTL_OFF >= RING_BYTES, "lds map");
constexpr int LDS_BYTES = 163840;

#define RLX_AGENT __ATOMIC_RELAXED, __HIP_MEMORY_SCOPE_AGENT
#define LDS_WAIT() asm volatile("s_waitcnt lgkmcnt(0)" ::: "memory")
#define VM_WAIT() asm volatile("s_waitcnt vmcnt(0)" ::: "memory")
__device__ __forceinline__ unsigned f2bf(float f) { unsigned u = __builtin_bit_cast(unsigned, f); return (u + 0x7fffu + ((u >> 16) & 1u)) >> 16; }
__device__ __forceinline__ unsigned pk2(float lo, float hi) { return f2bf(lo) | (f2bf(hi) << 16); }
__device__ __forceinline__ float bf2f(unsigned short b) { return __builtin_bit_cast(float, ((unsigned)b) << 16); }
__device__ __forceinline__ float bflo(unsigned w) { return __builtin_bit_cast(float, w << 16); }
__device__ __forceinline__ float bfhi(unsigned w) { return __builtin_bit_cast(float, w & 0xffff0000u); }
typedef __bf16 bf16x2_t __attribute__((ext_vector_type(2)));
__device__ __forceinline__ unsigned cvt_pk_bf16(float lo, float hi) { const f32x2 v = {lo, hi}; const bf16x2_t b = __builtin_convertvector(v, bf16x2_t); return __builtin_bit_cast(unsigned, b); }
__device__ __forceinline__ float clamp448(float x) { return fminf(fmaxf(x, -448.0f), 448.0f); }
__device__ __forceinline__ unsigned pk4_fp8(float a, float b, float c, float d) { unsigned w = 0u; w = (unsigned)__builtin_amdgcn_cvt_pk_fp8_f32(clamp448(a), clamp448(b), (int)w, false); w = (unsigned)__builtin_amdgcn_cvt_pk_fp8_f32(clamp448(c), clamp448(d), (int)w, true); return w; }
__device__ __forceinline__ float fp8_to_f(unsigned v) { const unsigned sg = (v >> 7) & 1u, e = (v >> 3) & 15u, m = v & 7u; const float r = e ? ldexpf(1.0f + (float)m * 0.125f, (int)e - 7) : ldexpf((float)m * 0.125f, -6); return sg ? -r : r; }
__device__ __forceinline__ float wave_sum(float v) {
#pragma unroll
    for (int o = 1; o < 64; o <<= 1) v += __shfl_xor(v, o);
    return v;
}
__device__ __forceinline__ f32x2 gelu_pk(f32x2 v) {
    const f32x2 av = __builtin_elementwise_abs(v), d = av * 0.2316418882f + 1.0f;
    f32x2 t; t.x = __builtin_amdgcn_rcpf(d.x); t.y = __builtin_amdgcn_rcpf(d.y);
    f32x2 q = t * 0.5307027145f + (-0.7265760135f); q = q * t + 0.7107068705f; q = q * t + (-0.142248368f); q = q * t + 0.127414796f; q = q * t;
    const f32x2 s = (v * v) * (-0.72134752044f);
    f32x2 e; e.x = __builtin_amdgcn_exp2f(s.x); e.y = __builtin_amdgcn_exp2f(s.y);
    const f32x2 m = v * (q * e), r = v - m;
    f32x2 o; o.x = v.x < 0.f ? m.x : r.x; o.y = v.y < 0.f ? m.y : r.y; return o;
}
__device__ __forceinline__ f32x4 gelu4(f32x4 v) { const f32x2 a = gelu_pk((f32x2){v[0], v[1]}), b = gelu_pk((f32x2){v[2], v[3]}); return (f32x4){a.x, a.y, b.x, b.y}; }
__device__ __forceinline__ float sigmoidf_fast(float x) { return __builtin_amdgcn_rcpf(1.0f + __builtin_amdgcn_exp2f(-1.4426950408889634f * x)); }

#define XB_TMO      128
#define XB_XCNT(j)  (256  + 64 * (j))
#define XB_XSUB(j)  (1280 + 64 * (j))
#define XB_XGEN(j)  (2304 + 64 * (j))
#define XB_TOP      3328
#define XB_TOPGEN   3392
#define XCD_BAR_WORDS 3456
#define XB_SPIN_CAP (1u << 18)
__device__ __forceinline__ unsigned xb_ld(unsigned* p)              { return __hip_atomic_load(p, __ATOMIC_RELAXED, __HIP_MEMORY_SCOPE_AGENT); }
__device__ __forceinline__ unsigned xb_add(unsigned* p, unsigned v) { return __hip_atomic_fetch_add(p, v, __ATOMIC_RELAXED, __HIP_MEMORY_SCOPE_AGENT); }
__device__ __forceinline__ unsigned xb_xcc_id() { return (unsigned)__builtin_amdgcn_s_getreg((3 << 11) | 20) & 0xFu; }
#define XB_SPIN(cond, bar) do { unsigned _sp = 0; while (cond) { __builtin_amdgcn_s_sleep(1); \
    if ((++_sp & 255u) == 0u) { if (xb_ld(&(bar)[XB_TMO])) break; if (_sp > XB_SPIN_CAP) { atomicAdd(&(bar)[XB_TMO], 1u); break; } } } } while (0)
struct XcdBarrier { unsigned* bar; unsigned x; volatile LAS unsigned* st; };
__device__ __forceinline__ XcdBarrier xcd_barrier_post(unsigned* bar, volatile LAS unsigned* st) {
    XcdBarrier b; b.bar = bar; b.x = xb_xcc_id(); b.st = st;
    if (threadIdx.x == 0) (void)xb_add(&bar[XB_XCNT(b.x)], 1u);
    return b;
}
__device__ __forceinline__ void xcd_barrier_complete(unsigned* bar, unsigned x, unsigned& nloc, unsigned& nx) {
    const unsigned G = gridDim.x * gridDim.y * gridDim.z;
    unsigned sum, cnt, mine, sp = 0u;
    for (;;) {
        sum = 0u; cnt = 0u; mine = 0u;
#pragma unroll
        for (unsigned j = 0; j < 16; ++j) { const unsigned c = xb_ld(&bar[XB_XCNT(j)]); sum += c; cnt += (c > 0u) ? 1u : 0u; mine = (j == x) ? c : mine; }
        if (sum == G) break;
        __builtin_amdgcn_s_sleep(1);
        if ((++sp & 255u) == 0u) { if (xb_ld(&bar[XB_TMO])) break; if (sp > XB_SPIN_CAP) { atomicAdd(&bar[XB_TMO], 1u); break; } }
    }
    nloc = mine > 0u ? mine : 1u; nx = cnt > 0u ? cnt : 1u;
}
__device__ __forceinline__ void xcd_barrier(const XcdBarrier& b) {
    asm volatile("s_waitcnt vmcnt(0)" ::: "memory");
    __syncthreads();
    if (threadIdx.x == 0) {
        unsigned* bar = b.bar;
        __builtin_amdgcn_s_waitcnt(0);
        unsigned nloc = b.st[0], nx = b.st[1];
        if (nloc == 0u) { xcd_barrier_complete(bar, b.x, nloc, nx); b.st[0] = nloc; b.st[1] = nx; }
        const unsigned old = xb_add(&bar[XB_XSUB(b.x)], 1u);
        const unsigned gen = old / nloc;
        if (old + 1u == (gen + 1u) * nloc) {
            __builtin_amdgcn_fence(__ATOMIC_RELEASE, "agent");
            asm volatile("s_waitcnt vmcnt(0)" ::: "memory");
            const unsigned og = xb_add(&bar[XB_TOP], 1u);
            const unsigned tg = og / nx;
            if (og + 1u == (tg + 1u) * nx) xb_add(&bar[XB_TOPGEN], 1u);
            else XB_SPIN(xb_ld(&bar[XB_TOPGEN]) == tg, bar);
            __builtin_amdgcn_fence(__ATOMIC_ACQUIRE, "agent");
            xb_add(&bar[XB_XGEN(b.x)], 1u);
            asm volatile("s_waitcnt vmcnt(0)" ::: "memory");
        } else {
            XB_SPIN(xb_ld(&bar[XB_XGEN(b.x)]) == gen, bar);
            __builtin_amdgcn_fence(__ATOMIC_ACQUIRE, "agent");
            asm volatile("s_waitcnt vmcnt(0)" ::: "memory");
        }
    }
    __syncthreads();
}

namespace pg8 {
constexpr int BM = 256, BK = 64, HALF = 128, HTB = HALF * BK * 2, STAGE_BYTES = 8 * HTB, NXCD = 8, WGM = 8;
__host__ __device__ __forceinline__ int lds_byte(int r, int c) { const int st = (r >> 4) * 2 + (c >> 5), rr = r & 15, cc = c & 31, ob = rr * 64 + cc * 2; return st * 1024 + (ob ^ (((ob >> 9) & 1) << 5)); }
__host__ __device__ __forceinline__ void stage_rc(int b, int& R, int& C) { const int st = b / 1024, sb = b % 1024, swz = sb ^ (((sb >> 9) & 1) << 5); R = (st >> 1) * 16 + swz / 64; C = (st & 1) * 32 + (swz % 64) / 2; }
__host__ __device__ __forceinline__ int perm32(int rho) { const int n = rho >> 4, i = rho & 15; return 8 * (i >> 2) + 4 * n + (i & 3); }

typedef int v8i __attribute__((ext_vector_type(8)));
constexpr int F8_WSHIFT = 6, F8_SCALE_W = 127 - F8_WSHIFT;
typedef int v4i __attribute__((ext_vector_type(4)));
__device__ __forceinline__ v8i ld8(const LAS unsigned char* p0, const LAS unsigned char* p1) { const v4i lo = *(const LAS v4i*)p0, hi = *(const LAS v4i*)p1; return __builtin_shufflevector(lo, hi, 0, 1, 2, 3, 4, 5, 6, 7); }
struct Unit { int pm, pn, e, rt; };

__device__ __forceinline__ void flat_to_tile(int L, int nwg, int nM, int nN, int& pm, int& pn) {
    int wgid = L; { const int q = nwg / NXCD, r = nwg % NXCD, xcd = wgid % NXCD, off = wgid / NXCD; wgid = (xcd < r ? xcd * (q + 1) : r * (q + 1) + (xcd - r) * q) + off; }
    const int nig = WGM * nN, gid = wgid / nig, fm = gid * WGM, gsz = (nM - fm) < WGM ? (nM - fm) : WGM;
    pm = fm + ((wgid % nig) % gsz); pn = (wgid % nig) / gsz;
}
struct DenseSched {
    const char* A; const char* Bt; int nM, nN, nwg, G, c; size_t tstep;
    __device__ __forceinline__ void init(const void* A_, const void* Bt_, int M, int N, int K, int G_, int c_, int ebytes = 2) { A = (const char*)A_; Bt = (const char*)Bt_; nM = M / BM; nN = N / BM; nwg = nM * nN; G = G_; c = c_; tstep = (size_t)BM * K * ebytes; }
    __device__ __forceinline__ bool next(int i, Unit& u) const { const long L = (long)i * G + c; if (L >= nwg) return false; flat_to_tile((int)L, nwg, nM, nN, u.pm, u.pn); u.e = 0; u.rt = u.pm; return true; }
    __device__ __forceinline__ const char* a_base(const Unit& u) const { return A + (size_t)u.pm * tstep; }
    __device__ __forceinline__ const char* b_base(const Unit& u) const { return Bt + (size_t)u.pn * tstep; }
    __device__ __forceinline__ void gather(int, int, int, unsigned (&)[2][2]) const {}
};
struct MoeSched {
    const char* A; const char* Bt; size_t a_tstep, b_estep, b_tstep; int nunits; const LAS unsigned* ulist; const LAS unsigned* gtab; bool gath;
    __device__ __forceinline__ bool next(int i, Unit& u) const {
        if (i >= nunits) return false;
        const unsigned w = (unsigned)__builtin_amdgcn_readfirstlane((int)ulist[i]);
        u.pm = (int)(w & 0x3ffu); u.pn = (int)((w >> 10) & 0x7u); u.e = (int)((w >> 13) & 0x1fu); u.rt = (int)(w >> 18); return true;
    }
    __device__ __forceinline__ const char* a_base(const Unit& u) const { return gath ? A : A + (size_t)u.pm * a_tstep; }
    __device__ __forceinline__ const char* b_base(const Unit& u) const { return Bt + (size_t)u.e * b_estep + (size_t)u.pn * b_tstep; }
    __device__ __forceinline__ void gather(int i, int R0, int R1, unsigned (&off)[2][2]) const {
        const LAS unsigned* g = gtab + i * 256;
        off[0][0] = g[R0]; off[0][1] = g[R1]; off[1][0] = g[128 + R0]; off[1][1] = g[128 + R1];
    }
};

#define PG8_SA(b, h) (((b) * 2 + (h)) * HTB)
#define PG8_SB(b, h) ((4 + (b) * 2 + (h)) * HTB)
#define PG8_GLDS(src, dstoff) __builtin_amdgcn_global_load_lds((const unsigned*)(src), (LAS unsigned*)(lds + (dstoff)), 16, 0, 0)
#define PG8_STAGE_B(bufoff, gbase) do { _Pragma("unroll") for (int _i = 0; _i < 2; ++_i) PG8_GLDS((const char*)(gbase) + voffB[_i], (bufoff) + ldsw + _i * 8192); } while (0)
#define PG8_STAGE_A(bufoff, kptr, h, o) do { _Pragma("unroll") for (int _i = 0; _i < 2; ++_i) \
        PG8_GLDS(GATHER ? (const char*)(kptr) + (o)[h][_i] : (const char*)(kptr) + (size_t)(h) * hstep + voffA[_i], (bufoff) + ldsw + _i * 8192); } while (0)
#define PG8_LDA(dst, b, h) do { _Pragma("unroll") for (int m = 0; m < 4; ++m) { if constexpr (F8) dst##8[m] = ld8(lds + PG8_SA(b, h) + a8_0 + m * 2048, lds + PG8_SA(b, h) + a8_1 + m * 2048); \
        else { _Pragma("unroll") for (int k = 0; k < 2; ++k) dst[m][k] = *(const LAS bf16x8*)(lds + PG8_SA(b, h) + aoff + m * 2048 + k * 1024); } } } while (0)
#define PG8_LDB(dst, b, h) do { _Pragma("unroll") for (int n = 0; n < 2; ++n) { if constexpr (F8) dst##8[n] = ld8(lds + PG8_SB(b, h) + b8_0 + n * 2048, lds + PG8_SB(b, h) + b8_1 + n * 2048); \
        else { _Pragma("unroll") for (int k = 0; k < 2; ++k) dst[n][k] = *(const LAS bf16x8*)(lds + PG8_SB(b, h) + boff + n * 2048 + k * 1024); } } } while (0)
#define PG8_MMA(ai, bj, At, Bt) do { __builtin_amdgcn_s_setprio(1); _Pragma("unroll") for (int m = 0; m < 4; ++m) _Pragma("unroll") for (int n = 0; n < 2; ++n) { \
        if constexpr (F8) asm volatile("v_mfma_scale_f32_16x16x128_f8f6f4 %0, %1, %2, %0, %3, %4 op_sel_hi:[0,0,0]" : "+v"(acc[ai][bj][m][n]) : "v"(Bt##8[n]), "v"(At##8[m]), "v"(sc_w), "v"(sc_a)); \
        else { _Pragma("unroll") for (int k = 0; k < 2; ++k) acc[ai][bj][m][n] = __builtin_amdgcn_mfma_f32_16x16x32_bf16(Bt[n][k], At[m][k], acc[ai][bj][m][n], 0, 0, 0); } } __builtin_amdgcn_s_setprio(0); } while (0)
#define PG8_WAIT_V(n) asm volatile("s_waitcnt vmcnt(" #n ")" ::: "memory")
#define PG8_WAIT_L(n) asm volatile("s_waitcnt lgkmcnt(" #n ")" ::: "memory")
#define PG8_BAR __builtin_amdgcn_s_barrier()
#define PG8_SCHED __builtin_amdgcn_sched_barrier(0)

template <class Epi, class Sched, bool GATHER, bool MIDK, bool F8 = false>
__device__ __forceinline__ void gemm_phase(LAS unsigned char* lds, const int KB  , const Sched& S, const Epi& E) {
    int tid = (int)threadIdx.x; asm volatile("" : "+v"(tid));
    const int wid = __builtin_amdgcn_readfirstlane(tid >> 6), lane = tid & 63, wr = wid >> 2, wc = wid & 3, fr = lane & 15, fq = lane >> 4;
    const int nt = KB / 128;
    unsigned voffA[2], voffB[2]; int Rg[2]; unsigned Cg[2];
#pragma unroll
    for (int i = 0; i < 2; ++i) { int R, C; stage_rc(tid * 16 + i * 8192, R, C); const int Rb = Epi::PERM ? ((R & ~31) + perm32(R & 31)) : R;
        voffA[i] = (unsigned)(R * KB + C * 2); voffB[i] = (unsigned)(Rb * KB + C * 2); Rg[i] = R; Cg[i] = (unsigned)C * 2u; }
    const size_t kstep = 128;
    const size_t hstep = (size_t)HALF * KB;
    const unsigned ldsw = (unsigned)wid * 1024u;
    const int aoff = lds_byte(wr * 64 + fr, fq * 8), boff = lds_byte(wc * 32 + fr, fq * 8);
    const int a8_0 = lds_byte(wr * 64 + fr, 16 * fq), a8_1 = lds_byte(wr * 64 + fr, 16 * fq + 8), b8_0 = lds_byte(wc * 32 + fr, 16 * fq), b8_1 = lds_byte(wc * 32 + fr, 16 * fq + 8);
    Unit cur, nxt; int ui = 0;
    if (!S.next(0, cur)) return;
    f32x4 acc[2][2][4][2];
#pragma unroll
    for (int a = 0; a < 2; ++a)
#pragma unroll
        for (int b = 0; b < 2; ++b)
#pragma unroll
            for (int m = 0; m < 4; ++m)
#pragma unroll
                for (int n = 0; n < 2; ++n) acc[a][b][m][n] = (f32x4){0.f, 0.f, 0.f, 0.f};
    bf16x8 At[4][2], B0[2][2], B1[2][2]; v8i At8[4], B08[2], B18[2];
    int sc_w = F8_SCALE_W, sc_a = 127; if constexpr (F8) { asm volatile("" : "+v"(sc_w), "+v"(sc_a)); }
    unsigned offC[2][2] = {{0u, 0u}, {0u, 0u}}, offN[2][2] = {{0u, 0u}, {0u, 0u}};
    if constexpr (GATHER) { S.gather(0, Rg[0], Rg[1], offC);
#pragma unroll
        for (int h = 0; h < 2; ++h)
#pragma unroll
            for (int i = 0; i < 2; ++i) offC[h][i] += Cg[i]; }
    const char* cA = S.a_base(cur); const char* cB = S.b_base(cur);
    PG8_STAGE_B(PG8_SB(0, 0), cB); PG8_STAGE_B(PG8_SB(0, 1), cB + hstep); PG8_STAGE_A(PG8_SA(0, 0), cA, 0, offC); PG8_STAGE_A(PG8_SA(0, 1), cA, 1, offC);
    if (wr == 1) PG8_BAR;
    PG8_WAIT_V(2); PG8_BAR;
    PG8_STAGE_B(PG8_SB(1, 0), cB + kstep); PG8_STAGE_A(PG8_SA(1, 0), cA + kstep, 0, offC); PG8_STAGE_B(PG8_SB(1, 1), cB + hstep + kstep);
    PG8_WAIT_V(6); PG8_BAR;
    for (;;) {
        const bool has_next = S.next(ui + 1, nxt);
        const char* nA = has_next ? S.a_base(nxt) : cA; const char* nB = has_next ? S.b_base(nxt) : cB;
        if constexpr (GATHER) { if (has_next) { S.gather(ui + 1, Rg[0], Rg[1], offN);
#pragma unroll
                for (int h = 0; h < 2; ++h)
#pragma unroll
                    for (int i = 0; i < 2; ++i) offN[h][i] += Cg[i]; }
            else {
#pragma unroll
                for (int h = 0; h < 2; ++h)
#pragma unroll
                    for (int i = 0; i < 2; ++i) offN[h][i] = offC[h][i]; } }
        for (int t = 0; t < nt; t += 2) {
            const bool last = (t == nt - 2);
            const char* a1 = cA + (size_t)(t + 1) * kstep;
            const char* a2 = last ? nA : cA + (size_t)(t + 2) * kstep; const char* b2 = last ? nB : cB + (size_t)(t + 2) * kstep;
            const char* a3 = a2 + kstep; const char* b3 = b2 + kstep;
            unsigned o2[2][2];
#pragma unroll
            for (int h = 0; h < 2; ++h)
#pragma unroll
                for (int i = 0; i < 2; ++i) o2[h][i] = last ? offN[h][i] : offC[h][i];
            if constexpr (MIDK) { if (t == nt / 2) E.midk(acc, cur, wr, fr); }
            PG8_LDB(B0, 0, 0); PG8_LDB(B1, 0, 1); PG8_SCHED; PG8_LDA(At, 0, 0); PG8_STAGE_A(PG8_SA(1, 1), a1, 1, offC);
            PG8_WAIT_V(8); PG8_WAIT_L(0); PG8_BAR; PG8_MMA(0, 0, At, B0); PG8_MMA(0, 1, At, B1); PG8_BAR; PG8_SCHED;
            PG8_LDA(At, 0, 1); PG8_STAGE_B(PG8_SB(0, 0), b2); PG8_STAGE_B(PG8_SB(0, 1), b2 + hstep); PG8_STAGE_A(PG8_SA(0, 0), a2, 0, o2);
            PG8_WAIT_V(8); PG8_WAIT_L(0); PG8_BAR; PG8_MMA(1, 0, At, B0); PG8_MMA(1, 1, At, B1); PG8_BAR; PG8_SCHED;
            PG8_LDB(B0, 1, 0); PG8_LDB(B1, 1, 1); PG8_SCHED; PG8_LDA(At, 1, 0); PG8_STAGE_A(PG8_SA(0, 1), a2, 1, o2);
            PG8_WAIT_V(8); PG8_WAIT_L(0); PG8_BAR; PG8_MMA(0, 0, At, B0); PG8_MMA(0, 1, At, B1); PG8_BAR; PG8_SCHED;
            PG8_LDA(At, 1, 1); PG8_STAGE_B(PG8_SB(1, 0), b3); PG8_STAGE_B(PG8_SB(1, 1), b3 + hstep); PG8_STAGE_A(PG8_SA(1, 0), a3, 0, o2);
            PG8_WAIT_V(8); PG8_WAIT_L(0); PG8_BAR; PG8_MMA(1, 0, At, B0); PG8_MMA(1, 1, At, B1); PG8_BAR; PG8_SCHED;
        }
        if (wr == 0) PG8_BAR;
        if constexpr (F8) asm volatile("s_nop 15\n\ts_nop 15" ::: "memory");
        E(acc, cur, wr, wc, fr, fq);
        if (!has_next) break;
#pragma unroll
        for (int a = 0; a < 2; ++a)
#pragma unroll
            for (int b = 0; b < 2; ++b)
#pragma unroll
                for (int m = 0; m < 4; ++m)
#pragma unroll
                    for (int n = 0; n < 2; ++n) acc[a][b][m][n] = (f32x4){0.f, 0.f, 0.f, 0.f};
        cur = nxt; cA = nA; cB = nB; ++ui;
        if constexpr (GATHER) {
#pragma unroll
            for (int h = 0; h < 2; ++h)
#pragma unroll
                for (int i = 0; i < 2; ++i) offC[h][i] = offN[h][i]; }
        if (wr == 1) PG8_BAR;
    }
    PG8_WAIT_V(0);
    PG8_BAR;
}
}

struct Frame {
    LAS unsigned char* lds;
    volatile LAS unsigned* MISC;
    gu32* ctl;
    unsigned char* ws;
    int vcu, G;
    const float *x, *p, *mix_norm, *w_in, *ln_g, *ln_b, *gws, *gbs, *aon, *gon, *w_out, *ffn_norm, *router_w, *router_b, *w_gu, *b_gu, *w_dn, *b_dn, *ple_norm, *w_pg, *w_pp, *ppn, *final_norm;
    float* out;
};
template <class T_> __device__ __forceinline__ T_* wsp(const Frame& F, size_t off) { return (T_*)(F.ws + off); }

#define PHASE_IDS int TID_ = (int)threadIdx.x; asm volatile("" : "+v"(TID_)); const int LANE_ = TID_ & 63; const int WAVE_ = __builtin_amdgcn_readfirstlane(TID_ >> 6); (void)LANE_; (void)WAVE_
template <class ColMap>
__device__ __forceinline__ void p0_transpose_item(const float* W, int K, int N, bf16* WT, const float* gain, LAS float* scr, int item, int lane, int nphys, const ColMap& cm) {
    const int nblk = nphys / 64, kb = item / nblk, nb = item % nblk, k0 = 64 * kb, n0 = 64 * nb;
    const int srccol = cm(n0 + lane);
    float v_[64]; const float* src = W + (size_t)k0 * N + srccol;
#pragma unroll
    for (int kk = 0; kk < 64; ++kk) v_[kk] = __builtin_nontemporal_load(src + (size_t)kk * N);
    if (gain) {
#pragma unroll
        for (int kk = 0; kk < 64; kk += 4) { const f32x4 g4 = *(const f32x4*)(gain + k0 + kk); v_[kk] *= g4[0]; v_[kk + 1] *= g4[1]; v_[kk + 2] *= g4[2]; v_[kk + 3] *= g4[3]; } }
#pragma unroll
    for (int kk = 0; kk < 64; ++kk) scr[kk * 65 + lane] = v_[kk];
    LDS_WAIT(); asm volatile("" ::: "memory");
    const int c = lane & 7;
#pragma unroll
    for (int j = 0; j < 8; ++j) { const int n = (lane >> 3) + 8 * j; const LAS float* s = scr + (8 * c) * 65 + n;
        v4u o; o.x = pk2(s[0 * 65], s[1 * 65]); o.y = pk2(s[2 * 65], s[3 * 65]); o.z = pk2(s[4 * 65], s[5 * 65]); o.w = pk2(s[6 * 65], s[7 * 65]);
        *(GAS v4u*)(WT + (size_t)(n0 + n) * K + k0 + 8 * c) = o; }
    LDS_WAIT(); asm volatile("" ::: "memory");
}
template <class ColMap>
__device__ __forceinline__ void p0_transpose_item_f8(const float* W, int K, int N, unsigned char* WT, const float* gain, LAS float* scr, int item, int lane, int nphys, const ColMap& cm) {
    const int nblk = nphys / 64, kb = item / nblk, nb = item % nblk, k0 = 64 * kb, n0 = 64 * nb;
    const int srccol = cm(n0 + lane);
    float v_[64]; const float* src = W + (size_t)k0 * N + srccol;
#pragma unroll
    for (int kk = 0; kk < 64; ++kk) v_[kk] = __builtin_nontemporal_load(src + (size_t)kk * N);
    constexpr float WS_ = (float)(1 << pg8::F8_WSHIFT);
#pragma unroll
    for (int kk = 0; kk < 64; kk += 4) { f32x4 g4 = gain ? *(const f32x4*)(gain + k0 + kk) : (f32x4){1.f, 1.f, 1.f, 1.f}; v_[kk] *= g4[0] * WS_; v_[kk + 1] *= g4[1] * WS_; v_[kk + 2] *= g4[2] * WS_; v_[kk + 3] *= g4[3] * WS_; }
#pragma unroll
    for (int kk = 0; kk < 64; ++kk) scr[kk * 65 + lane] = v_[kk];
    LDS_WAIT(); asm volatile("" ::: "memory");
    const int c = lane & 3;
#pragma unroll
    for (int j = 0; j < 4; ++j) { const int n = (lane >> 2) + 16 * j; const LAS float* s_ = scr + (16 * c) * 65 + n;
        v4u o; o.x = pk4_fp8(s_[0 * 65], s_[1 * 65], s_[2 * 65], s_[3 * 65]); o.y = pk4_fp8(s_[4 * 65], s_[5 * 65], s_[6 * 65], s_[7 * 65]);
        o.z = pk4_fp8(s_[8 * 65], s_[9 * 65], s_[10 * 65], s_[11 * 65]); o.w = pk4_fp8(s_[12 * 65], s_[13 * 65], s_[14 * 65], s_[15 * 65]);
        *(GAS v4u*)(WT + (size_t)(n0 + n) * K + k0 + 16 * c) = o; }
    LDS_WAIT(); asm volatile("" ::: "memory");
}
struct CmId { __device__ __forceinline__ int operator()(int n) const { return n; } };
struct CmWin { __device__ __forceinline__ int operator()(int n) const { if (n >= 2 * AW) return n; const int c = n & 63; return (n & ~63) + 4 * (c >> 3) + (c & 3) + 32 * ((c >> 2) & 1); } };
struct CmWgu { __device__ __forceinline__ int operator()(int n) const { return ((n >> 7) & 1) * FF + (n >> 8) * 128 + (n & 127); } };

__device__ __forceinline__ void p0_prologue(Frame& F) {
    PHASE_IDS;
    LAS float* scr = (LAS float*)(F.lds + RING_OFF + WAVE_ * P0_SCR_WAVE);
    const int gw = F.vcu * NWAVES + WAVE_, NGW = F.G * NWAVES;
    constexpr int I_GU = (DM / 64) * (2 * FF / 64), I_DN = (FF / 64) * (DM / 64), I_IN = (DM / 64) * (NPROJ / 64), I_SQ = (DM / 64) * (DM / 64), I_PP = (PLE / 64) * (DM / 64);
    constexpr int NITEMS = NE * I_GU + NE * I_DN + I_IN + 2 * I_SQ + I_PP;
    unsigned char* WGU = wsp<unsigned char>(F, WS_WGU); unsigned char* WDN = wsp<unsigned char>(F, WS_WDN);
    for (int it = gw; it < NITEMS; it += NGW) {
        int r = it;
        if (r < NE * I_GU) { const int e = r / I_GU; p0_transpose_item_f8(F.w_gu + (size_t)e * DM * 2 * FF, DM, 2 * FF, WGU + (size_t)e * 2 * FF * DM, F.ffn_norm, scr, r % I_GU, LANE_, 2 * FF, CmWgu()); continue; } r -= NE * I_GU;
        if (r < NE * I_DN) { const int e = r / I_DN; p0_transpose_item_f8(F.w_dn + (size_t)e * FF * DM, FF, DM, WDN + (size_t)e * DM * FF, nullptr, scr, r % I_DN, LANE_, DM, CmId()); continue; } r -= NE * I_DN;
        if (r < I_IN) { p0_transpose_item(F.w_in, DM, NPROJ, wsp<bf16>(F, WS_WIN), F.mix_norm, scr, r, LANE_, NPROJ, CmWin()); continue; } r -= I_IN;
        if (r < I_SQ) {
            const int nblk = DM / 64, kb = r / nblk; const float* g = (kb < 8) ? F.aon : (F.gon - AW);
            p0_transpose_item(F.w_out, DM, DM, wsp<bf16>(F, WS_WOUT), g, scr, r, LANE_, DM, CmId()); continue; } r -= I_SQ;
        if (r < I_SQ) { p0_transpose_item_f8(F.w_pg, DM, DM, wsp<unsigned char>(F, WS_WPG8), F.ple_norm, scr, r, LANE_, DM, CmId()); continue; } r -= I_SQ;
        p0_transpose_item(F.w_pp, PLE, DM, wsp<bf16>(F, WS_WPP), nullptr, scr, r, LANE_, DM, CmId());
    }
    if (TPROBE && blockIdx.x == 0 && threadIdx.x == 0) ((unsigned long long*)(F.ctl + CW_TS))[11] = __builtin_amdgcn_s_memrealtime();
    bf16* XN = wsp<bf16>(F, WS_XNB);
    for (int m0 = gw; m0 < T; m0 += 2 * NGW) {
        f32x4 v[2][4]; float s[2] = {0.f, 0.f};
#pragma unroll
        for (int r = 0; r < 2; ++r) { const GAS f32x4* xr = (const GAS f32x4*)(F.x + (size_t)(m0 + r * NGW) * DM) + LANE_;
#pragma unroll
            for (int j = 0; j < 4; ++j) v[r][j] = __builtin_nontemporal_load(xr + 64 * j); }
#pragma unroll
        for (int r = 0; r < 2; ++r) {
#pragma unroll
            for (int j = 0; j < 4; ++j) s[r] += (v[r][j].x * v[r][j].x + v[r][j].y * v[r][j].y) + (v[r][j].z * v[r][j].z + v[r][j].w * v[r][j].w); }
#pragma unroll
        for (int r = 0; r < 2; ++r) { const int m = m0 + r * NGW; const float sig = sqrtf(wave_sum(s[r]) * (1.f / DM) + EPS), rstd = 1.0f / sig;
            if (LANE_ == 0) wsp<float>(F, WS_SIG0)[m] = sig;
            GAS v2u* o8 = (GAS v2u*)(XN + (size_t)m * DM) + LANE_;
#pragma unroll
            for (int j = 0; j < 4; ++j) { v2u w; w.x = pk2(v[r][j].x * rstd, v[r][j].y * rstd); w.y = pk2(v[r][j].z * rstd, v[r][j].w * rstd); o8[64 * j] = w; } }
    }
    if (TPROBE && blockIdx.x == 0 && threadIdx.x == 0) ((unsigned long long*)(F.ctl + CW_TS))[12] = __builtin_amdgcn_s_memrealtime();
    { const GAS f32x4* pr = (const GAS f32x4*)F.p; GAS v2u* po = (GAS v2u*)wsp<bf16>(F, WS_PB);
      const size_t n4 = (size_t)T * PLE / 4, gt = (size_t)(F.vcu * NTHR + TID_), GT = (size_t)F.G * NTHR;
      for (size_t i = gt; i < n4; i += GT) { const f32x4 v = pr[i]; v2u w; w.x = pk2(v.x, v.y); w.y = pk2(v.z, v.w); po[i] = w; } }
    if (TPROBE && blockIdx.x == 0 && threadIdx.x == 0) ((unsigned long long*)(F.ctl + CW_TS))[13] = __builtin_amdgcn_s_memrealtime();
    { const int gt = F.vcu * NTHR + TID_, GT = F.G * NTHR; float* RWG = wsp<float>(F, WS_RWG);
      (void)RWG; bf16* RWT = wsp<bf16>(F, WS_RWT);
      for (int i = gt; i < DM * NE; i += GT) { const int e = i / DM, k = i % DM; const float w = F.router_w[k * NE + e] * F.ffn_norm[k]; const unsigned hi = f2bf(w); const float lo = w - bf2f((bf16)hi); RWT[i] = (bf16)hi; RWT[NE * DM + i] = (bf16)f2bf(lo); }
      float* RC = wsp<float>(F, WS_ROPE); float* RS = RC + SEQ * 32;
      for (int i = gt; i < SEQ * 32; i += GT) { const int pos = i >> 5, j = i & 31; const float inv = powf(10000.0f, -(float)j / 32.0f); const float ang = (float)pos * inv; float sn, cs; sincosf(ang, &sn, &cs); RC[i] = cs; RS[i] = sn; } }
}

using pg8::Unit;
constexpr int HALF = 128;
struct EpiInProj {
    static constexpr bool PERM = true;
    bf16* QKVUV; const float *rc, *rs; float* kmean;
    __device__ __forceinline__ void operator()(const f32x4 (&acc)[2][2][4][2], const Unit& u, int wr, int wc, int fr, int fq) const {
        const int type = u.pn >> 1, colt = (u.pn & 1) * 256 + wc * 32 + 8 * fq;
        const int row0 = u.pm * 256 + wr * 64 + fr;
        if (type <= 1) {
            bf16* dst = QKVUV + (size_t)type * (16u << 20);
            const int pos0 = (u.pm & 7) * 256 + wr * 64 + fr, i0 = 16 * (wc & 1) + 4 * fq;
            f32x4 cs_[2][2];
#pragma unroll
            for (int bj = 0; bj < 2; ++bj) { cs_[bj][0] = (f32x4){0.f, 0.f, 0.f, 0.f}; cs_[bj][1] = (f32x4){0.f, 0.f, 0.f, 0.f}; }
#pragma unroll
            for (int ai = 0; ai < 2; ++ai) { f32x4 cc[4], ss[4];
#pragma unroll
                for (int m = 0; m < 4; ++m) { const int pos = pos0 + ai * HALF + m * 16; cc[m] = *(const f32x4*)(rc + pos * 32 + i0); ss[m] = *(const f32x4*)(rs + pos * 32 + i0); }
#pragma unroll
                for (int m = 0; m < 4; ++m) { const int ro = ai * HALF + m * 16; const f32x4 c = cc[m], s = ss[m];
                    bf16* rowp = dst + (size_t)(row0 + ro) * AW + colt;
#pragma unroll
                    for (int bj = 0; bj < 2; ++bj) { const f32x4 x1 = acc[ai][bj][m][0], x2 = acc[ai][bj][m][1];
                        const f32x4 o1 = x1 * c - x2 * s, o2 = x2 * c + x1 * s;
                        cs_[bj][0] += o1; cs_[bj][1] += o2;
                        v4u w; w.x = cvt_pk_bf16(o1[0], o1[1]); w.y = cvt_pk_bf16(o1[2], o1[3]); w.z = cvt_pk_bf16(o2[0], o2[1]); w.w = cvt_pk_bf16(o2[2], o2[3]);
                        *(v4u*)(rowp + bj * HALF) = w; } }
                asm volatile("" ::: "memory"); }
            if (type == 1) {
#pragma unroll
                for (int bj = 0; bj < 2; ++bj)
#pragma unroll
                    for (int n = 0; n < 2; ++n)
#pragma unroll
                        for (int j = 0; j < 4; ++j) { float v = cs_[bj][n][j]; v += __shfl_xor(v, 1); v += __shfl_xor(v, 2); v += __shfl_xor(v, 4); v += __shfl_xor(v, 8); cs_[bj][n][j] = v; }
                if (fr == 0) { const int b = u.pm >> 3, blk = u.pm & 7;
#pragma unroll
                    for (int bj = 0; bj < 2; ++bj) { const int colh = (u.pn & 1) * 256 + bj * HALF + wc * 32; const int head = colh >> 6, cpos = (colh & 63) + 8 * fq;
                        float* km = kmean + ((size_t)((b * NH + head) * NBLK + blk)) * HD + cpos;
#pragma unroll
                        for (int n = 0; n < 2; ++n)
#pragma unroll
                            for (int j = 0; j < 4; ++j) atomicAdd(km + 4 * n + j, cs_[bj][n][j]); } }
            }
        } else {
            bf16* dst = QKVUV + (size_t)type * (16u << 20);
#pragma unroll
            for (int ai = 0; ai < 2; ++ai)
#pragma unroll
                for (int m = 0; m < 4; ++m) { bf16* rowp = dst + (size_t)(row0 + ai * HALF + m * 16) * AW + colt;
#pragma unroll
                    for (int bj = 0; bj < 2; ++bj) { f32x4 v0 = acc[ai][bj][m][0], v1 = acc[ai][bj][m][1];
                        if (type >= 3) { v0 = gelu4(v0); v1 = gelu4(v1); }
                        v4u w; w.x = cvt_pk_bf16(v0[0], v0[1]); w.y = cvt_pk_bf16(v0[2], v0[3]); w.z = cvt_pk_bf16(v1[0], v1[1]); w.w = cvt_pk_bf16(v1[2], v1[3]);
                        *(v4u*)(rowp + bj * HALF) = w; } }
        }
    }
};
struct EpiOutProj {
    static constexpr bool PERM = true;
    const bf16* xn; const float* sig0; bf16* x1; unsigned char* x1f8; float* ssq1; const LAS f32x2* rtab;
    int pm_a, pm_b;
    __device__ __forceinline__ int slot(const Unit& u) const { return u.pm == pm_a ? 0 : 1; }
    __device__ __forceinline__ void midk(f32x4 (&acc)[2][2][4][2], const Unit& u, int wr, int fr) const {
        const LAS f32x2* t = rtab + slot(u) * 256 + wr * 64 + fr;
#pragma unroll
        for (int ai = 0; ai < 2; ++ai)
#pragma unroll
            for (int m = 0; m < 4; ++m) { const float r = t[ai * HALF + m * 16].x;
#pragma unroll
                for (int bj = 0; bj < 2; ++bj)
#pragma unroll
                    for (int n = 0; n < 2; ++n) acc[ai][bj][m][n] *= r; }
    }
    __device__ __forceinline__ void operator()(const f32x4 (&acc)[2][2][4][2], const Unit& u, int wr, int wc, int fr, int fq) const {
        const LAS f32x2* t = rtab + slot(u) * 256 + wr * 64 + fr;
        const int row0 = u.pm * 256 + wr * 64 + fr, col0 = u.pn * 256 + wc * 32 + 8 * fq;
#pragma unroll
        for (int ai = 0; ai < 2; ++ai) { v4u xv[4][2]; float sg[4];
#pragma unroll
            for (int m = 0; m < 4; ++m) { const size_t off = (size_t)(row0 + ai * HALF + m * 16) * DM + col0; sg[m] = sig0[row0 + ai * HALF + m * 16];
                xv[m][0] = *(const v4u*)(xn + off); xv[m][1] = *(const v4u*)(xn + off + HALF); }
#pragma unroll
            for (int m = 0; m < 4; ++m) { const int ro = ai * HALF + m * 16; const float rg = t[ro].y, sx = sg[m]; const size_t off = (size_t)(row0 + ro) * DM + col0; float q = 0.f;
#pragma unroll
                for (int bj = 0; bj < 2; ++bj) { const v4u xw = xv[m][bj];
                    const f32x4 x0 = {bflo(xw.x), bfhi(xw.x), bflo(xw.y), bfhi(xw.y)}, x1_ = {bflo(xw.z), bfhi(xw.z), bflo(xw.w), bfhi(xw.w)};
                    const f32x4 o0 = x0 * sx + acc[ai][bj][m][0] * rg, o1 = x1_ * sx + acc[ai][bj][m][1] * rg;
                    q += (o0[0] * o0[0] + o0[1] * o0[1]) + (o0[2] * o0[2] + o0[3] * o0[3]) + (o1[0] * o1[0] + o1[1] * o1[1]) + (o1[2] * o1[2] + o1[3] * o1[3]);
                    v4u w; w.x = cvt_pk_bf16(o0[0], o0[1]); w.y = cvt_pk_bf16(o0[2], o0[3]); w.z = cvt_pk_bf16(o1[0], o1[1]); w.w = cvt_pk_bf16(o1[2], o1[3]);
                    *(v4u*)(x1 + off + bj * HALF) = w;
                    v2u w8; w8.x = pk4_fp8(o0[0], o0[1], o0[2], o0[3]); w8.y = pk4_fp8(o1[0], o1[1], o1[2], o1[3]); *(v2u*)(x1f8 + off + bj * HALF) = w8; }
                q += __shfl_xor(q, 16); q += __shfl_xor(q, 32);
                if (fq == 0) ssq1[(size_t)(row0 + ro) * 16 + u.pn * 4 + wc] = q; }
            asm volatile("" ::: "memory"); }
    }
};
struct EpiMoe1 {
    static constexpr bool PERM = true;
    unsigned char* A; const float* b_gu; const float* rss;
    __device__ __forceinline__ void operator()(const f32x4 (&acc)[2][2][4][2], const Unit& u, int wr, int wc, int fr, int fq) const {
        const int row0 = u.pm * 256 + wr * 64 + fr, col = u.pn * 128 + wc * 32 + 8 * fq;
        const float* bg = b_gu + (size_t)u.e * 2 * FF + col; const float* rs_ = rss + (size_t)u.e * T + u.rt * 256 + wr * 64 + fr;
        float rsv[2][4];
#pragma unroll
        for (int ai = 0; ai < 2; ++ai)
#pragma unroll
            for (int m = 0; m < 4; ++m) rsv[ai][m] = rs_[ai * HALF + m * 16];
        f32x4 bgv[2], blv[2];
#pragma unroll
        for (int n = 0; n < 2; ++n) { bgv[n] = *(const f32x4*)(bg + 4 * n); blv[n] = *(const f32x4*)(bg + FF + 4 * n); }
#pragma unroll
        for (int ai = 0; ai < 2; ++ai)
#pragma unroll
            for (int m = 0; m < 4; ++m) { f32x4 a[2];
#pragma unroll
                for (int n = 0; n < 2; ++n) { const f32x4 g = acc[ai][0][m][n] * rsv[ai][m] + bgv[n], l = acc[ai][1][m][n] * rsv[ai][m] + blv[n];
#pragma unroll
                    for (int j = 0; j < 4; ++j) { const float gc = fminf(g[j], 7.0f), lc = fminf(fmaxf(l[j], -7.0f), 7.0f); a[n][j] = gc * sigmoidf_fast(1.702f * gc) * (lc + 1.0f); } }
                v2u w; w.x = pk4_fp8(a[0][0], a[0][1], a[0][2], a[0][3]); w.y = pk4_fp8(a[1][0], a[1][1], a[1][2], a[1][3]);
                *(v2u*)(A + (size_t)(row0 + ai * HALF + m * 16) * FF + col) = w; }
    }
};
constexpr float Y_SCALE = 16.0f;
struct EpiMoe2 {
    static constexpr bool PERM = true;
    unsigned char* Y; const float* b_dn; const float* gss;
    __device__ __forceinline__ void operator()(const f32x4 (&acc)[2][2][4][2], const Unit& u, int wr, int wc, int fr, int fq) const {
        const int row0 = u.pm * 256 + wr * 64 + fr, col0 = u.pn * 256 + wc * 32 + 8 * fq;
        const float* gs = gss + (size_t)u.e * T + u.rt * 256 + wr * 64 + fr;
        f32x4 bv[2][2]; float gv[2][4];
#pragma unroll
        for (int bj = 0; bj < 2; ++bj)
#pragma unroll
            for (int n = 0; n < 2; ++n) bv[bj][n] = *(const f32x4*)(b_dn + (size_t)u.e * DM + col0 + bj * HALF + 4 * n);
#pragma unroll
        for (int ai = 0; ai < 2; ++ai)
#pragma unroll
            for (int m = 0; m < 4; ++m) gv[ai][m] = gs[ai * HALF + m * 16] * Y_SCALE;
#pragma unroll
        for (int ai = 0; ai < 2; ++ai)
#pragma unroll
            for (int m = 0; m < 4; ++m) { const float g = gv[ai][m]; unsigned char* rowp = Y + (size_t)(row0 + ai * HALF + m * 16) * DM + col0;
#pragma unroll
                for (int bj = 0; bj < 2; ++bj) { const f32x4 v0 = (acc[ai][bj][m][0] + bv[bj][0]) * g, v1 = (acc[ai][bj][m][1] + bv[bj][1]) * g;
                    v2u w; w.x = pk4_fp8(v0[0], v0[1], v0[2], v0[3]); w.y = pk4_fp8(v1[0], v1[1], v1[2], v1[3]);
                    *(v2u*)(rowp + bj * HALF) = w; } }
    }
};
constexpr float GATE_SCALE = 128.0f;
template <int MODE> struct EpiPle {
    static constexpr bool PERM = true;
    unsigned char* O; float* ssq;
    __device__ __forceinline__ void operator()(const f32x4 (&acc)[2][2][4][2], const Unit& u, int wr, int wc, int fr, int fq) const {
        const int row0 = u.pm * 256 + wr * 64 + fr, col0 = u.pn * 256 + wc * 32 + 8 * fq;
        float rsv[2][4];
#pragma unroll
        for (int ai = 0; ai < 2; ++ai)
#pragma unroll
            for (int m = 0; m < 4; ++m) rsv[ai][m] = (MODE == 0) ? ssq[row0 + ai * HALF + m * 16] : 1.0f;
#pragma unroll
        for (int ai = 0; ai < 2; ++ai)
#pragma unroll
            for (int m = 0; m < 4; ++m) { unsigned char* rowp = O + (size_t)(row0 + ai * HALF + m * 16) * DM + col0; float q = 0.f; const float rs = rsv[ai][m];
#pragma unroll
                for (int bj = 0; bj < 2; ++bj) { f32x4 v0 = acc[ai][bj][m][0], v1 = acc[ai][bj][m][1];
                    if (MODE == 0) {
#pragma unroll
                        for (int j = 0; j < 4; ++j) { v0[j] = GATE_SCALE * sigmoidf_fast(rs * v0[j]); v1[j] = GATE_SCALE * sigmoidf_fast(rs * v1[j]); } }
                    else { q += (v0[0] * v0[0] + v0[1] * v0[1]) + (v0[2] * v0[2] + v0[3] * v0[3]) + (v1[0] * v1[0] + v1[1] * v1[1]) + (v1[2] * v1[2] + v1[3] * v1[3]); }
                    v2u w; w.x = pk4_fp8(v0[0], v0[1], v0[2], v0[3]); w.y = pk4_fp8(v1[0], v1[1], v1[2], v1[3]);
                    *(v2u*)(rowp + bj * HALF) = w; }
                if (MODE == 1) { q += __shfl_xor(q, 16); q += __shfl_xor(q, 32); if (fq == 0) ssq[(size_t)(row0 + ai * HALF + m * 16) * 16 + u.pn * 4 + wc] = q; } }
    }
};

namespace att {
constexpr int QBLK = 32, KVBLK = 64;
constexpr float SCALE = 0.125f, THR = 8.f;
constexpr int SHM_V = KVBLK * HD * 2, SHM_K = SHM_V;
constexpr int NSLOT = 3;
constexpr int LDS_BYTES_ = NSLOT * SHM_V + NSLOT * SHM_K + NWAVES * 64 * 4;
#define ATT_KSWZ(row, colB) ((row) * 128 + ((colB) ^ (((row) & 7) << 4)))
#define ATT_SBAR() __builtin_amdgcn_sched_barrier(0)
__device__ __forceinline__ int crow(int r, int hi) { return (r & 3) + 8 * (r >> 2) + 4 * hi; }
__device__ __forceinline__ void cmask(f32x16& p0, f32x16& p1, int jb, int qrel, int hi) {
    const float NEG = -__builtin_inff(); const int kb = 64 * jb + 4 * hi;
#pragma unroll
    for (int r = 0; r < 16; ++r) { const int kv = kb + (r & 3) + 8 * (r >> 2); if (kv > qrel) p0[r] = NEG; if (kv + 32 > qrel) p1[r] = NEG; }
}
__device__ __forceinline__ void bmask(f32x16& p0, f32x16& p1, bool keep) {
    const float NEG = -__builtin_inff();
    if (!keep) {
#pragma unroll
        for (int r = 0; r < 16; ++r) { p0[r] = NEG; p1[r] = NEG; } }
}
__device__ __forceinline__ void partialSM(f32x16& p0, f32x16& p1, float& m_reg, float& mn, float& alpha, bool keep) {
    float pmax = p0[0];
#pragma unroll
    for (int r = 1; r < 16; ++r) pmax = fmaxf(pmax, p0[r]);
#pragma unroll
    for (int r = 0; r < 16; ++r) pmax = fmaxf(pmax, p1[r]);
    { auto rr = __builtin_amdgcn_permlane32_swap(__float_as_uint(pmax), __float_as_uint(pmax), false, false);
      pmax = fmaxf(__uint_as_float(rr[0]), __uint_as_float(rr[1])); }
    if (!keep) pmax = -__builtin_inff();
    constexpr float C2 = 1.4426950408889634f * SCALE;
    if (__builtin_expect(__all((pmax - m_reg) * SCALE <= THR), 1)) { mn = m_reg; alpha = 1.f; }
    else { mn = fmaxf(m_reg, pmax); alpha = __builtin_amdgcn_exp2f((m_reg - mn) * C2); m_reg = mn; }
    const float mnL = keep ? -mn * C2 : -__builtin_inff(), c2 = keep ? C2 : 0.f;
#pragma unroll
    for (int r = 0; r < 16; ++r) p0[r] = fmaf(p0[r], c2, mnL);
#pragma unroll
    for (int r = 0; r < 16; ++r) p1[r] = fmaf(p1[r], c2, mnL);
#pragma unroll
    for (int r = 0; r < 16; ++r) p0[r] = __builtin_amdgcn_exp2f(p0[r]);
}
__device__ __forceinline__ void finishSM(f32x16& p0, f32x16& p1, float alpha, float& l_reg, bf16x8& pa0, bf16x8& pa1, bf16x8& pa2, bf16x8& pa3) {
#pragma unroll
    for (int r = 0; r < 16; ++r) p1[r] = __builtin_amdgcn_exp2f(p1[r]);
    float ps = 0;
#pragma unroll
    for (int r = 0; r < 16; ++r) ps += p0[r];
#pragma unroll
    for (int r = 0; r < 16; ++r) ps += p1[r];
    { auto rr = __builtin_amdgcn_permlane32_swap(__float_as_uint(ps), __float_as_uint(ps), false, false);
      ps = __uint_as_float(rr[0]) + __uint_as_float(rr[1]); }
    l_reg = l_reg * alpha + ps;
#define ATT_PK4(P, B, OUT) do { unsigned a0 = cvt_pk_bf16(P[B+0], P[B+1]), a1 = cvt_pk_bf16(P[B+2], P[B+3]);             \
        unsigned b0 = cvt_pk_bf16(P[B+4], P[B+5]), b1 = cvt_pk_bf16(P[B+6], P[B+7]);                                       \
        auto r0 = __builtin_amdgcn_permlane32_swap(a0, b0, false, false); auto r1 = __builtin_amdgcn_permlane32_swap(a1, b1, false, false); \
        v4u w = {r0[0], r1[0], r0[1], r1[1]}; OUT = *reinterpret_cast<bf16x8*>(&w); } while (0)
    ATT_PK4(p0, 0, pa0); ATT_PK4(p0, 8, pa1); ATT_PK4(p1, 0, pa2); ATT_PK4(p1, 8, pa3);
#undef ATT_PK4
}
__device__ __forceinline__ void qkt(f32x16& p0, f32x16& p1, const LAS unsigned char* Ks, const bf16x8* qr, int r32, int hi) {
    p0 = f32x16{}; p1 = f32x16{};
#pragma unroll
    for (int d0 = 0; d0 < 4; ++d0) { const int cb = (d0 * 16 + hi * 8) * 2;
        const bf16x8 b0 = *(const LAS bf16x8*)(Ks + ATT_KSWZ(r32, cb));
        const bf16x8 b1 = *(const LAS bf16x8*)(Ks + ATT_KSWZ(32 + r32, cb));
        p0 = __builtin_amdgcn_mfma_f32_32x32x16_bf16(b0, qr[d0], p0, 0, 0, 0);
        p1 = __builtin_amdgcn_mfma_f32_32x32x16_bf16(b1, qr[d0], p1, 0, 0, 0); }
}
__device__ __forceinline__ void pv(f32x16* o, int vb, bf16x8 pa0, bf16x8 pa1, bf16x8 pa2, bf16x8 pa3) {
#pragma unroll
    for (int d0 = 0; d0 < 2; ++d0) { s16x4 lo[4], hi[4];
#pragma unroll
        for (int ks = 0; ks < 4; ++ks) { const int a = vb + d0 * 2048 + (ks >> 1) * 4096 + (ks & 1) * 512;
            asm volatile("ds_read_b64_tr_b16 %0,%1" : "=&v"(lo[ks]) : "v"(a) : "memory");
            asm volatile("ds_read_b64_tr_b16 %0,%1 offset:128" : "=&v"(hi[ks]) : "v"(a) : "memory"); }
        asm volatile("s_waitcnt lgkmcnt(0)" ::: "memory"); ATT_SBAR();
#define ATT_PK(k) (bf16x8){lo[k][0], lo[k][1], lo[k][2], lo[k][3], hi[k][0], hi[k][1], hi[k][2], hi[k][3]}
        o[d0] = __builtin_amdgcn_mfma_f32_32x32x16_bf16(pa0, ATT_PK(0), o[d0], 0, 0, 0);
        o[d0] = __builtin_amdgcn_mfma_f32_32x32x16_bf16(pa1, ATT_PK(1), o[d0], 0, 0, 0);
        o[d0] = __builtin_amdgcn_mfma_f32_32x32x16_bf16(pa2, ATT_PK(2), o[d0], 0, 0, 0);
        o[d0] = __builtin_amdgcn_mfma_f32_32x32x16_bf16(pa3, ATT_PK(3), o[d0], 0, 0, 0);
#undef ATT_PK
    }
}
__device__ __forceinline__ void attn_unit(const Frame& F, int b, int h, int qb, LAS unsigned char* scratch) {
    PHASE_IDS;
    const int tid = TID_, wid = tid >> 6, lane = tid & 63, r32 = lane & 31, hi = lane >> 5;
    const bf16* Qg = wsp<bf16>(F, WS_Q); const bf16* Kg = wsp<bf16>(F, WS_K); const bf16* Vg = wsp<bf16>(F, WS_V);
    const size_t rowbase = (size_t)b * SEQ; const int q0 = qb * MOBA;
    const bf16* Qw = Qg + (rowbase + q0 + wid * QBLK) * AW + h * HD;
    const bf16* Kh = Kg + rowbase * AW + h * HD; const bf16* Vh = Vg + rowbase * AW + h * HD;
    LAS unsigned char* V_lds = scratch; LAS unsigned char* K_lds = scratch + NSLOT * SHM_V;
    LAS float* wsf = (LAS float*)(scratch + NSLOT * SHM_V + NSLOT * SHM_K) + wid * 64; LAS float* li_l = wsf; LAS float* al_l = wsf + 32;
    float m_reg = -1e30f, l_reg = 0.f; f32x16 o[2]; o[0] = f32x16{}; o[1] = f32x16{}; bf16x8 qr[4];
#pragma unroll
    for (int d0 = 0; d0 < 4; ++d0) qr[d0] = *(const bf16x8*)(Qw + (size_t)r32 * AW + d0 * 16 + hi * 8);
    unsigned sel = 0u;
    if (qb <= 3) sel = (1u << qb) - 1u;
    else {
        const float* km = wsp<float>(F, WS_KMEAN) + (size_t)((b * NH + h) * NBLK) * HD + (size_t)(r32 & 7) * HD + hi * 8;
        f32x4 kv[4][2];
#pragma unroll
        for (int d0 = 0; d0 < 4; ++d0) { kv[d0][0] = *(const f32x4*)(km + d0 * 16); kv[d0][1] = *(const f32x4*)(km + d0 * 16 + 4); }
        f32x16 gacc = f32x16{};
#pragma unroll
        for (int d0 = 0; d0 < 4; ++d0) { float f[8] = {kv[d0][0][0], kv[d0][0][1], kv[d0][0][2], kv[d0][0][3], kv[d0][1][0], kv[d0][1][1], kv[d0][1][2], kv[d0][1][3]};
            unsigned hw[4], lw[4];
#pragma unroll
            for (int p = 0; p < 4; ++p) { float a0 = f[2 * p], a1 = f[2 * p + 1]; if (r32 >= 8) { a0 = 0.f; a1 = 0.f; }
                const unsigned h0 = f2bf(a0), h1 = f2bf(a1); hw[p] = h0 | (h1 << 16); lw[p] = pk2(a0 - bf2f((bf16)h0), a1 - bf2f((bf16)h1)); }
            const v4u hv = {hw[0], hw[1], hw[2], hw[3]}, lv = {lw[0], lw[1], lw[2], lw[3]};
            gacc = __builtin_amdgcn_mfma_f32_32x32x16_bf16(__builtin_bit_cast(bf16x8, hv), qr[d0], gacc, 0, 0, 0);
            gacc = __builtin_amdgcn_mfma_f32_32x32x16_bf16(__builtin_bit_cast(bf16x8, lv), qr[d0], gacc, 0, 0, 0); }
        float g[8];
#pragma unroll
        for (int r = 0; r < 4; ++r) { const float mine = gacc[r], other = __shfl_xor(mine, 32); g[r] = hi ? other : mine; g[4 + r] = hi ? mine : other; }
        float b0 = -__builtin_inff(), b1 = b0, b2 = b0; int i0 = 0, i1 = 0, i2 = 0;
#pragma unroll
        for (int j = 0; j < NBLK - 1; ++j) { const float s_ = (j < qb) ? g[j] : -__builtin_inff();
            if (s_ > b0) { b2 = b1; i2 = i1; b1 = b0; i1 = i0; b0 = s_; i0 = j; } else if (s_ > b1) { b2 = b1; i2 = i1; b1 = s_; i1 = j; } else if (s_ > b2) { b2 = s_; i2 = j; } }
        sel = (1u << i0) | (1u << i1) | (1u << i2);
    }
    const int sr = tid >> 3, sc = (tid & 7) * 8;
    const int vst = 2 * ((sr >> 5) * 2048 + (sc >> 4) * 512 + (sr & 31) * 16 + (sc & 8));
    const int vb0 = (int)(size_t)V_lds + (lane & 15) * 8 + ((lane >> 4) & 1) * 1024 + (lane >> 5) * 256;
    bf16x8 st_v, st_k;
#define ATT_SLOAD(k0) do { const size_t rr_ = (size_t)((k0) + sr) * AW + sc; st_v = *(const bf16x8*)(Vh + rr_); st_k = *(const bf16x8*)(Kh + rr_); } while (0)
#define ATT_SWRITE(bf) do { *(LAS bf16x8*)(V_lds + (bf) * SHM_V + vst) = st_v; *(LAS bf16x8*)(K_lds + (bf) * SHM_K + ATT_KSWZ(sr, sc * 2)) = st_k; } while (0)
#define ATT_RESC(a) do { if (__any((a) < 1.f)) { if (hi == 0) al_l[r32] = (a); asm volatile("s_waitcnt lgkmcnt(0)" ::: "memory");      \
        _Pragma("unroll") for (int d_ = 0; d_ < 2; ++d_) _Pragma("unroll") for (int r = 0; r < 16; ++r) o[d_][r] *= al_l[crow(r, hi)]; } } while (0)
    const int NT = (q0 + MOBA) / KVBLK;
    const int qrel = wid * QBLK + r32;
#define ATT_MASK(P0, P1, t) do { const int jb_ = (t) - (NT - 4); if (jb_ >= 0) cmask(P0, P1, jb_, qrel, hi); } while (0)
#define ATT_KEEP(t) ((((t) >= NT - 4) ? 1u : ((sel >> ((t) >> 2)) & 1u)) != 0u)
    f32x16 pA0, pA1, pB0, pB1; float mnA, mnB, alA, alB; bf16x8 pa0, pa1, pa2, pa3;
    int s0 = 0, s1 = 1, s2 = 2;
#define ATT_ROT() do { const int t_ = s0; s0 = s1; s1 = s2; s2 = t_; } while (0)
    ATT_SLOAD(0); asm volatile("s_waitcnt vmcnt(0)" ::: "memory"); ATT_SWRITE(0); ATT_SLOAD(KVBLK);
    s0 = 2; s1 = 0; s2 = 1;
    __syncthreads();
    asm volatile("s_waitcnt vmcnt(0)" ::: "memory"); ATT_SWRITE(s2); ATT_SLOAD(2 * KVBLK);
    qkt(pA0, pA1, K_lds + s1 * SHM_K, qr, r32, hi); ATT_MASK(pA0, pA1, 0); partialSM(pA0, pA1, m_reg, mnA, alA, ATT_KEEP(0));
    ATT_ROT();
    for (int j = 1; j < NT; j += 2) {
        __syncthreads();
        if (j + 1 < NT) { asm volatile("s_waitcnt vmcnt(0)" ::: "memory"); ATT_SWRITE(s2); if (j + 2 < NT) ATT_SLOAD((j + 2) * KVBLK); }
        ATT_SBAR(); qkt(pB0, pB1, K_lds + s1 * SHM_K, qr, r32, hi); ATT_MASK(pB0, pB1, j);
        finishSM(pA0, pA1, alA, l_reg, pa0, pa1, pa2, pa3); ATT_SBAR();
        pv(o, vb0 + s0 * SHM_V, pa0, pa1, pa2, pa3); partialSM(pB0, pB1, m_reg, mnB, alB, ATT_KEEP(j));
        ATT_RESC(alB); ATT_ROT();
        if (j + 1 < NT) {
            __syncthreads();
            if (j + 2 < NT) { asm volatile("s_waitcnt vmcnt(0)" ::: "memory"); ATT_SWRITE(s2); if (j + 3 < NT) ATT_SLOAD((j + 3) * KVBLK); }
            ATT_SBAR(); qkt(pA0, pA1, K_lds + s1 * SHM_K, qr, r32, hi); ATT_MASK(pA0, pA1, j + 1);
            finishSM(pB0, pB1, alB, l_reg, pa0, pa1, pa2, pa3); ATT_SBAR();
            pv(o, vb0 + s0 * SHM_V, pa0, pa1, pa2, pa3); partialSM(pA0, pA1, m_reg, mnA, alA, ATT_KEEP(j + 1));
            ATT_RESC(alA); ATT_ROT();
        }
    }
    finishSM(pB0, pB1, alB, l_reg, pa0, pa1, pa2, pa3); ATT_SBAR();
    pv(o, vb0 + s0 * SHM_V, pa0, pa1, pa2, pa3);
#undef ATT_ROT
    if (hi == 0) li_l[r32] = l_reg; asm volatile("s_waitcnt lgkmcnt(0)" ::: "memory");
    float rli[16];
#pragma unroll
    for (int r = 0; r < 16; ++r) rli[r] = __builtin_amdgcn_rcpf(li_l[crow(r, hi)]);
    bf16* Ow = wsp<bf16>(F, WS_MIX) + (rowbase + q0 + wid * QBLK) * DM + h * HD;
    float* ssqa = wsp<float>(F, WS_SSQA) + (rowbase + q0 + wid * QBLK) * NH + h;
    float qq[16];
#pragma unroll
    for (int r = 0; r < 16; ++r) { const int orow = crow(r, hi); float q2 = 0.f;
#pragma unroll
        for (int d0 = 0; d0 < 2; ++d0) { const float v = o[d0][r] * rli[r]; const float vn = __shfl_xor(v, 1); q2 += v * v;
            if ((r32 & 1) == 0) *(unsigned*)(Ow + (size_t)orow * DM + d0 * 32 + r32) = cvt_pk_bf16(v, vn); }
        qq[r] = q2; }
#pragma unroll
    for (int i = 0; i < 8; ++i) { const bool up = (lane & 16) != 0; const float send = up ? qq[i] : qq[i + 8], keep = up ? qq[i + 8] : qq[i]; qq[i] = keep + __shfl_xor(send, 16); }
#pragma unroll
    for (int i = 0; i < 4; ++i) { const bool up = (lane & 8) != 0; const float send = up ? qq[i] : qq[i + 4], keep = up ? qq[i + 4] : qq[i]; qq[i] = keep + __shfl_xor(send, 8); }
#pragma unroll
    for (int i = 0; i < 2; ++i) { const bool up = (lane & 4) != 0; const float send = up ? qq[i] : qq[i + 2], keep = up ? qq[i + 2] : qq[i]; qq[i] = keep + __shfl_xor(send, 4); }
    { const bool up = (lane & 2) != 0; const float send = up ? qq[0] : qq[1], keep = up ? qq[1] : qq[0]; qq[0] = keep + __shfl_xor(send, 2); }
    qq[0] += __shfl_xor(qq[0], 1);
    if ((lane & 1) == 0) ssqa[(size_t)crow(r32 >> 1, hi) * NH] = qq[0];
    __syncthreads();
#undef ATT_SLOAD
#undef ATT_SWRITE
#undef ATT_RESC
#undef ATT_MASK
#undef ATT_KEEP
}
}

namespace gm {
__device__ __forceinline__ int vt_off(int d, int s) { return d * 256 + ((((s >> 3) ^ (d & 15)) & 15) << 4) + (s & 7) * 2; }
__device__ __forceinline__ void units4(const Frame& F, int v, LAS unsigned char* scratch) {
    PHASE_IDS;
    const int tid = TID_, wid = tid >> 6, lane = tid & 63, fr = lane & 15, fq = lane >> 4;
    const int u = wid >> 1, half = wid & 1, uidx = 4 * v + u, b = uidx >> 6, c = (uidx >> 2) & 15, g = uidx & 3;
    const size_t row0 = (size_t)b * SEQ + c * GC;
    const bf16* VGg = wsp<bf16>(F, WS_VG) + row0 * GW + g * GD; const bf16* Ug = wsp<bf16>(F, WS_U) + row0 * GW + g * GD;
    LAS unsigned char* vt = scratch + u * 32768;
    { const int s_ = half * 64 + lane; const v4u* src = (const v4u*)(VGg + (size_t)s_ * GW); v4u raw[16]; float sum = 0.f, sq = 0.f;
#pragma unroll
      for (int i = 0; i < 16; ++i) raw[i] = src[i];
#pragma unroll
      for (int i = 0; i < 16; ++i) { const unsigned ww[4] = {raw[i].x, raw[i].y, raw[i].z, raw[i].w};
#pragma unroll
          for (int k = 0; k < 4; ++k) { const float a0 = bflo(ww[k]), a1 = bfhi(ww[k]); sum += a0 + a1; sq += a0 * a0 + a1 * a1; } }
      const float mu = sum * (1.f / GD); const float var = fmaxf(sq * (1.f / GD) - mu * mu, 0.f); const float rstd = 1.0f / sqrtf(var + EPS);
      const float* lg = F.ln_g + g * GD; const float* lb = F.ln_b + g * GD;
#pragma unroll
      for (int i = 0; i < 16; ++i) { const unsigned ww[4] = {raw[i].x, raw[i].y, raw[i].z, raw[i].w}; const f32x4 g0 = *(const f32x4*)(lg + 8 * i), g1 = *(const f32x4*)(lg + 8 * i + 4), b0 = *(const f32x4*)(lb + 8 * i), b1 = *(const f32x4*)(lb + 8 * i + 4);
          const float gg[8] = {g0[0], g0[1], g0[2], g0[3], g1[0], g1[1], g1[2], g1[3]}, bb[8] = {b0[0], b0[1], b0[2], b0[3], b1[0], b1[1], b1[2], b1[3]};
#pragma unroll
          for (int k = 0; k < 4; ++k) { const int d = 8 * i + 2 * k;
              *(LAS unsigned short*)(vt + vt_off(d, s_)) = (unsigned short)f2bf((bflo(ww[k]) - mu) * rstd * gg[2 * k] + bb[2 * k]);
              *(LAS unsigned short*)(vt + vt_off(d + 1, s_)) = (unsigned short)f2bf((bfhi(ww[k]) - mu) * rstd * gg[2 * k + 1] + bb[2 * k + 1]); } } }
    __syncthreads();
#pragma unroll 1
    for (int m = 0; m < 4; ++m) {
        const int tb = half * 64 + m * 16, t = tb + fr;
        const float* Wg = F.gws + (size_t)g * GC * GC + (size_t)t * GC;
        const int nks = (tb + 16 + 31) / 32;
        f32x4 w0[4], w1[4];
#pragma unroll
        for (int ks = 0; ks < 4; ++ks) if (ks < nks) { w0[ks] = *(const f32x4*)(Wg + ks * 32 + fq * 8); w1[ks] = *(const f32x4*)(Wg + ks * 32 + fq * 8 + 4); }
        const bf16* Ut = Ug + (size_t)t * GW + 4 * fq; v2u uu[8];
#pragma unroll
        for (int n = 0; n < 8; ++n) uu[n] = *(const v2u*)(Ut + n * 16);
        f32x4 acc[8];
#pragma unroll
        for (int n = 0; n < 8; ++n) acc[n] = (f32x4){0.f, 0.f, 0.f, 0.f};
#pragma unroll
        for (int ks = 0; ks < 4; ++ks) if (ks < nks) { const int s0 = ks * 32 + fq * 8;
            float wv[8] = {w0[ks][0], w0[ks][1], w0[ks][2], w0[ks][3], w1[ks][0], w1[ks][1], w1[ks][2], w1[ks][3]};
#pragma unroll
            for (int j = 0; j < 8; ++j) if (s0 + j > t) wv[j] = 0.f;
            v4u aw; aw.x = pk2(wv[0], wv[1]); aw.y = pk2(wv[2], wv[3]); aw.z = pk2(wv[4], wv[5]); aw.w = pk2(wv[6], wv[7]);
            const bf16x8 wf = *reinterpret_cast<const bf16x8*>(&aw);
#pragma unroll
            for (int n = 0; n < 8; ++n) { const bf16x8 vf = *(const LAS bf16x8*)(vt + vt_off(n * 16 + fr, s0));
                acc[n] = __builtin_amdgcn_mfma_f32_16x16x32_bf16(vf, wf, acc[n], 0, 0, 0); } }
        bf16* Og = wsp<bf16>(F, WS_MIX) + (row0 + t) * DM + AW + g * GD + 4 * fq; float* ssqg = wsp<float>(F, WS_SSQG) + (row0 + t) * GG + g;
        const float bs = F.gbs[g * GC + t]; float q2 = 0.f;
#pragma unroll
        for (int n = 0; n < 8; ++n) { const float o0 = bflo(uu[n].x) * (acc[n][0] + bs), o1 = bfhi(uu[n].x) * (acc[n][1] + bs), o2 = bflo(uu[n].y) * (acc[n][2] + bs), o3 = bfhi(uu[n].y) * (acc[n][3] + bs);
            q2 += (o0 * o0 + o1 * o1) + (o2 * o2 + o3 * o3); v2u w; w.x = cvt_pk_bf16(o0, o1); w.y = cvt_pk_bf16(o2, o3); *(v2u*)(Og + n * 16) = w; }
        q2 += __shfl_xor(q2, 16); q2 += __shfl_xor(q2, 32);
        if (fq == 0) ssqg[0] = q2;
    }
    __syncthreads();
}
}

__device__ __forceinline__ void p2_mixers(const Frame& F) {
    LAS unsigned char* scratch = F.lds + RING_OFF;
    const int v = F.vcu;
    { const int bh = v >> 1, s0 = (v & 1) * 2;
#pragma unroll 1
      for (int i = 0; i < 4; ++i) { const int qq = s0 + (i >> 1); const int qb = (i & 1) ? 7 - qq : qq; att::attn_unit(F, bh / NH, bh % NH, qb, scratch); } }
    if (TPROBE && blockIdx.x == 0 && threadIdx.x == 0) ((unsigned long long*)(F.ctl + CW_TS))[14] = __builtin_amdgcn_s_memrealtime();
    gm::units4(F, v, scratch);
}

__device__ __forceinline__ void p4_router(const Frame& F) {
    PHASE_IDS;
    const int tid = TID_, wid = tid >> 6, lane = tid & 63, tk = lane & 31, hf = lane >> 5;
    LAS unsigned* hist = (LAS unsigned*)(F.lds + XTAB_OFF);
    LAS unsigned* base = hist + 32;
    const bf16* RWT = wsp<bf16>(F, WS_RWT); const bf16* x1 = wsp<bf16>(F, WS_X1B); const float* ssq1 = wsp<float>(F, WS_SSQ1);
    unsigned* cntg = (unsigned*)(F.ctl + CW_CNT);
    unsigned* IDX = wsp<unsigned>(F, WS_IDX); float* GSS = wsp<float>(F, WS_GSS); float* RSS = wsp<float>(F, WS_RSS); unsigned* TOKPOS = wsp<unsigned>(F, WS_TOKPOS);
    if (tid < 32) hist[tid] = 0u;
    __syncthreads();
    const int unit = F.vcu * 4 + (wid & 3), kh = wid >> 2; const int tok = unit * 32 + tk;
    LAS float* xch = (LAS float*)(F.lds + RING_OFF) + (wid & 3) * 64 * 16;
    float rstd; { const f32x4* sp = (const f32x4*)(ssq1 + (size_t)tok * 16); const f32x4 a = sp[0], b = sp[1], c = sp[2], d = sp[3];
        const float s_ = ((a[0] + a[1]) + (a[2] + a[3])) + ((b[0] + b[1]) + (b[2] + b[3])) + ((c[0] + c[1]) + (c[2] + c[3])) + ((d[0] + d[1]) + (d[2] + d[3]));
        rstd = 1.0f / sqrtf(s_ * (1.f / DM) + EPS); }
    f32x16 acc = f32x16{};
    { const bf16* xr = x1 + (size_t)tok * DM + kh * 512 + 8 * hf; const bf16* wh = RWT + (size_t)tk * DM + kh * 512 + 8 * hf; const bf16* wl = wh + NE * DM;
#pragma unroll 8
      for (int s_ = 0; s_ < 32; ++s_) { const bf16x8 xv = *(const bf16x8*)(xr + 16 * s_), a_hi = *(const bf16x8*)(wh + 16 * s_), a_lo = *(const bf16x8*)(wl + 16 * s_);
          acc = __builtin_amdgcn_mfma_f32_32x32x16_bf16(a_hi, xv, acc, 0, 0, 0); acc = __builtin_amdgcn_mfma_f32_32x32x16_bf16(a_lo, xv, acc, 0, 0, 0); } }
    if (kh == 1) {
#pragma unroll
        for (int r = 0; r < 16; ++r) xch[lane * 16 + r] = acc[r]; }
    __syncthreads();
    const bool active = kh == 0;
    int pe[4] = {0, 0, 0, 0}; float pg[4] = {0.f, 0.f, 0.f, 0.f}; unsigned rank[2] = {0u, 0u}; int my_e[2] = {0, 0}; float my_g[2] = {0.f, 0.f};
    if (active) {
        float lv[16];
#pragma unroll
        for (int r = 0; r < 16; ++r) { const int e = (r & 3) + 8 * (r >> 2) + 4 * hf; lv[r] = (acc[r] + xch[lane * 16 + r]) * rstd + F.router_b[e]; }
        float tv[4]; int ti[4]; unsigned used = 0u;
#pragma unroll
        for (int k = 0; k < 4; ++k) { float best = -__builtin_inff(); int br = 0;
#pragma unroll
            for (int r = 0; r < 16; ++r) { const int e = (r & 3) + 8 * (r >> 2) + 4 * hf; const int eb = (br & 3) + 8 * (br >> 2) + 4 * hf;
                const bool better = !((used >> r) & 1u) && (lv[r] > best || (lv[r] == best && e < eb)); if (better) { best = lv[r]; br = r; } }
            used |= 1u << br; tv[k] = best; ti[k] = (br & 3) + 8 * (br >> 2) + 4 * hf; }
        float ov[4]; int oi[4];
#pragma unroll
        for (int k = 0; k < 4; ++k) { ov[k] = __shfl_xor(tv[k], 32); oi[k] = __shfl_xor(ti[k], 32); }
        int ia = 0, ib = 0;
#pragma unroll
        for (int k = 0; k < 4; ++k) {
            float va = tv[0], vb = ov[0]; int ea = ti[0], eb = oi[0];
#pragma unroll
            for (int q = 1; q < 4; ++q) { if (ia == q) { va = tv[q]; ea = ti[q]; } if (ib == q) { vb = ov[q]; eb = oi[q]; } }
            const bool takeA = (va > vb) || (va == vb && ea < eb);
            pg[k] = takeA ? va : vb; pe[k] = takeA ? ea : eb; if (takeA) ++ia; else ++ib; }
        { const float m = pg[0]; float s_ = 0.f;
#pragma unroll
          for (int k = 0; k < 4; ++k) { pg[k] = __builtin_amdgcn_exp2f((pg[k] - m) * 1.4426950408889634f); s_ += pg[k]; }
          const float inv = 1.0f / s_;
#pragma unroll
          for (int k = 0; k < 4; ++k) pg[k] *= inv; }
        { const int m = -hf; my_e[0] = pe[0] ^ ((pe[0] ^ pe[2]) & m); my_e[1] = pe[1] ^ ((pe[1] ^ pe[3]) & m);
          const unsigned g0 = __float_as_uint(pg[0]), g1 = __float_as_uint(pg[1]), g2 = __float_as_uint(pg[2]), g3 = __float_as_uint(pg[3]);
          my_g[0] = __uint_as_float(g0 ^ ((g0 ^ g2) & (unsigned)m)); my_g[1] = __uint_as_float(g1 ^ ((g1 ^ g3) & (unsigned)m)); }
#pragma unroll
        for (int q = 0; q < 2; ++q) rank[q] = atomicAdd((unsigned*)&hist[my_e[q]], 1u);
    }
    __syncthreads();
    if (tid < 32) base[tid] = atomicAdd(cntg + tid, hist[tid]);
    __syncthreads();
    if (active) {
#pragma unroll
        for (int q = 0; q < 2; ++q) { const int k = 2 * hf + q; const int e = my_e[q]; const float g = my_g[q];
            const unsigned slot = base[e] + rank[q];
            IDX[(size_t)e * T + slot] = (unsigned)tok; GSS[(size_t)e * T + slot] = g; RSS[(size_t)e * T + slot] = rstd; TOKPOS[(size_t)tok * 4 + k] = ((unsigned)e << 16) | slot; }
    }
    __syncthreads();
}

__device__ __forceinline__ void build_tstart(const Frame& F, LAS unsigned* tstart, int tid) {
    if (tid < 64) { const unsigned* cntg = (const unsigned*)(F.ctl + CW_CNT); unsigned c = (tid < NE) ? cntg[tid] : 0u; if (c > (unsigned)T) c = (unsigned)T;
        unsigned x = (c + 255u) >> 8;
#pragma unroll
        for (int o = 1; o < 32; o <<= 1) { const unsigned y = __shfl_up(x, o); if ((tid & 63) >= o) x += y; }
        if (tid < NE) tstart[tid + 1] = x; if (tid == 0) tstart[0] = 0u; }
}
constexpr int MAXU = 18;
constexpr int XT_TSTART = 0, XT_ULIST = 256, XT_GTAB = 512;
static_assert(XT_GTAB + MAXU * 1024 <= LDS_BYTES - XTAB_OFF, "xtab");
__device__ __forceinline__ int moe_build_tables(const Frame& F, int P  , bool gather) {
    PHASE_IDS;
    LAS unsigned* tstart = (LAS unsigned*)(F.lds + XTAB_OFF + XT_TSTART);
    LAS unsigned* ulist = (LAS unsigned*)(F.lds + XTAB_OFF + XT_ULIST);
    LAS unsigned* gtab = (LAS unsigned*)(F.lds + XTAB_OFF + XT_GTAB);
    const unsigned* cntg = (const unsigned*)(F.ctl + CW_CNT); const unsigned* IDX = wsp<unsigned>(F, WS_IDX);
    const int tid = TID_;
    build_tstart(F, tstart, tid);
    __syncthreads();
    const int NT_ = (int)tstart[NE], U = NT_ * P, G = F.G, c = (int)blockIdx.x;
    const int nunits = (c < U) ? (U - c + G - 1) / G : 0;
    if (tid < MAXU && tid < nunits) { const int L = tid * G + c; int gt, pn; pg8::flat_to_tile(L, U, NT_, P, gt, pn);
        int e = 0; for (int k = 1; k < NE; ++k) if ((unsigned)gt >= tstart[k]) e = k;
        const int rt = gt - (int)tstart[e];
        ulist[tid] = (unsigned)gt | ((unsigned)pn << 10) | ((unsigned)e << 13) | ((unsigned)rt << 18); }
    __syncthreads();
    if (gather) {
        unsigned tokv[(MAXU + 1) / 2];
#pragma unroll
        for (int p = 0; p < (MAXU + 1) / 2; ++p) { const int i = 2 * p + (tid >> 8), r = tid & 255; tokv[p] = 0u;
            if (i < nunits && i < MAXU) { const unsigned w = ulist[i]; const int e = (int)((w >> 13) & 0x1fu), rt = (int)(w >> 18);
                unsigned cn = cntg[e]; if (cn > (unsigned)T) cn = (unsigned)T; const unsigned slot = (unsigned)rt * 256u + (unsigned)r;
                if (slot < cn) tokv[p] = IDX[(size_t)e * T + slot]; } }
#pragma unroll
        for (int p = 0; p < (MAXU + 1) / 2; ++p) { const int i = 2 * p + (tid >> 8), r = tid & 255;
            if (i < nunits && i < MAXU) { unsigned tok = tokv[p]; if (tok >= (unsigned)T) tok = 0u; gtab[i * 256 + r] = tok * (unsigned)DM; } }
    }
    __syncthreads();
    return nunits < MAXU ? nunits : MAXU;
}

__device__ __forceinline__ void p7_combine(const Frame& F) {
    PHASE_IDS;
    LAS unsigned* tstart = (LAS unsigned*)(F.lds + XTAB_OFF + XT_TSTART);
    const unsigned* cntg = (const unsigned*)(F.ctl + CW_CNT);
    build_tstart(F, tstart, TID_); (void)cntg;
    __syncthreads();
    const int gw = F.vcu * NWAVES + WAVE_, NGW = F.G * NWAVES;
    const unsigned* TOKPOS = wsp<unsigned>(F, WS_TOKPOS); const unsigned char* Y = wsp<unsigned char>(F, WS_YBUF); const bf16* X1 = wsp<bf16>(F, WS_X1B); bf16* X2 = wsp<bf16>(F, WS_X2B); unsigned char* X28 = wsp<unsigned char>(F, WS_X2F8); float* RS2 = wsp<float>(F, WS_RSTD2);
    for (int m0 = gw; m0 < T; m0 += 2 * NGW) {
        f32x4 v[2][4]; unsigned yv[2][4][4]; float s[2] = {0.f, 0.f};
#pragma unroll
        for (int r = 0; r < 2; ++r) { const int m = m0 + r * NGW;
            const v4u tp = *(const v4u*)(TOKPOS + (size_t)m * 4); const unsigned tpw[4] = {tp.x, tp.y, tp.z, tp.w};
            size_t yrow[4];
#pragma unroll
            for (int k = 0; k < 4; ++k) { const unsigned e = (tpw[k] >> 16) & 31u, slot = tpw[k] & 0xffffu; yrow[k] = ((size_t)tstart[e] * 256u + slot) * DM; }
#pragma unroll
            for (int j = 0; j < 4; ++j) { const v2u xw = *(const v2u*)(X1 + (size_t)m * DM + 4 * LANE_ + 256 * j); v[r][j] = (f32x4){bflo(xw.x), bfhi(xw.x), bflo(xw.y), bfhi(xw.y)};
#pragma unroll
                for (int k = 0; k < 4; ++k) yv[r][j][k] = *(const unsigned*)(Y + yrow[k] + 4 * LANE_ + 256 * j); } }
#pragma unroll
        for (int r = 0; r < 2; ++r) {
#pragma unroll
            for (int j = 0; j < 4; ++j) {
#pragma unroll
                for (int k = 0; k < 4; ++k) { const unsigned w = yv[r][j][k]; const f32x2 lo = __builtin_amdgcn_cvt_pk_f32_fp8((int)w, false), hi2 = __builtin_amdgcn_cvt_pk_f32_fp8((int)w, true);
                    v[r][j][0] += lo[0] * (1.0f / Y_SCALE); v[r][j][1] += lo[1] * (1.0f / Y_SCALE); v[r][j][2] += hi2[0] * (1.0f / Y_SCALE); v[r][j][3] += hi2[1] * (1.0f / Y_SCALE); }
                s[r] += (v[r][j].x * v[r][j].x + v[r][j].y * v[r][j].y) + (v[r][j].z * v[r][j].z + v[r][j].w * v[r][j].w); } }
#pragma unroll
        for (int r = 0; r < 2; ++r) { const int m = m0 + r * NGW; const float rstd = 1.0f / sqrtf(wave_sum(s[r]) * (1.f / DM) + EPS);
            if (LANE_ == 0) RS2[m] = rstd;
#pragma unroll
            for (int j = 0; j < 4; ++j) { v2u w; w.x = cvt_pk_bf16(v[r][j].x, v[r][j].y); w.y = cvt_pk_bf16(v[r][j].z, v[r][j].w); *(v2u*)(X2 + (size_t)m * DM + 4 * LANE_ + 256 * j) = w;
                *(unsigned*)(X28 + (size_t)m * DM + 4 * LANE_ + 256 * j) = pk4_fp8(v[r][j].x, v[r][j].y, v[r][j].z, v[r][j].w); } }
    }
}

__device__ __forceinline__ void p9_final(const Frame& F) {
    PHASE_IDS;
    const int gw = F.vcu * NWAVES + WAVE_, NGW = F.G * NWAVES;
    const unsigned char* GATE = wsp<unsigned char>(F, WS_GATE); const unsigned char* PP = wsp<unsigned char>(F, WS_PP); const float* ssqpp = wsp<float>(F, WS_SSQPP);
    for (int m0 = gw; m0 < T; m0 += 2 * NGW) {
        f32x4 v[2][4]; unsigned gv[2][4], pv_[2][4]; f32x4 sq[2][4]; float s[2] = {0.f, 0.f};
#pragma unroll
        for (int r = 0; r < 2; ++r) { const int m = m0 + r * NGW; const bf16* x2r = wsp<bf16>(F, WS_X2B) + (size_t)m * DM;
#pragma unroll
            for (int q = 0; q < 4; ++q) sq[r][q] = *(const f32x4*)(ssqpp + (size_t)m * 16 + 4 * q);
#pragma unroll
            for (int j = 0; j < 4; ++j) { const int col = 4 * LANE_ + 256 * j; const v2u xw = *(const v2u*)(x2r + col); v[r][j] = (f32x4){bflo(xw.x), bfhi(xw.x), bflo(xw.y), bfhi(xw.y)};
                gv[r][j] = *(const unsigned*)(GATE + (size_t)m * DM + col); pv_[r][j] = *(const unsigned*)(PP + (size_t)m * DM + col); } }
#pragma unroll
        for (int r = 0; r < 2; ++r) { const f32x4 a = sq[r][0], b = sq[r][1], c = sq[r][2], d = sq[r][3];
            const float sp = ((a[0] + a[1]) + (a[2] + a[3])) + ((b[0] + b[1]) + (b[2] + b[3])) + ((c[0] + c[1]) + (c[2] + c[3])) + ((d[0] + d[1]) + (d[2] + d[3]));
            const float rpp = 1.0f / sqrtf(sp * (1.f / DM) + EPS);
#pragma unroll
            for (int j = 0; j < 4; ++j) { const int col = 4 * LANE_ + 256 * j; const f32x4 pg_ = *(const f32x4*)(F.ppn + col);
                const f32x2 g01 = __builtin_amdgcn_cvt_pk_f32_fp8((int)gv[r][j], false), g23 = __builtin_amdgcn_cvt_pk_f32_fp8((int)gv[r][j], true);
                const f32x2 p01 = __builtin_amdgcn_cvt_pk_f32_fp8((int)pv_[r][j], false), p23 = __builtin_amdgcn_cvt_pk_f32_fp8((int)pv_[r][j], true);
                const float rg = rpp * (1.0f / GATE_SCALE);
                v[r][j][0] += g01[0] * (p01[0] * rg * pg_[0]); v[r][j][1] += g01[1] * (p01[1] * rg * pg_[1]);
                v[r][j][2] += g23[0] * (p23[0] * rg * pg_[2]); v[r][j][3] += g23[1] * (p23[1] * rg * pg_[3]);
                s[r] += (v[r][j].x * v[r][j].x + v[r][j].y * v[r][j].y) + (v[r][j].z * v[r][j].z + v[r][j].w * v[r][j].w); } }
#pragma unroll
        for (int r = 0; r < 2; ++r) { const int m = m0 + r * NGW; float* xr = F.out + (size_t)m * DM; const float rstd = 1.0f / sqrtf(wave_sum(s[r]) * (1.f / DM) + EPS);
#pragma unroll
            for (int j = 0; j < 4; ++j) { const int col = 4 * LANE_ + 256 * j; const f32x4 fg = *(const f32x4*)(F.final_norm + col); __builtin_nontemporal_store(v[r][j] * rstd * fg, (f32x4*)(xr + col)); } }
    }
}

struct Args { const float* in[23]; float* out; unsigned char* ws; };
#if CHECK_STAGE
__device__ __forceinline__ unsigned hmix(unsigned z) { z ^= z >> 16; z *= 0x7feb352du; z ^= z >> 15; z *= 0x846ca68bu; z ^= z >> 16; return z; }
__device__ __forceinline__ void chk_add(const Frame& F, int st, bool bad) { atomicAdd((unsigned*)(F.ctl + CW_CHK + 2 * st), bad ? 1u : 0u); atomicAdd((unsigned*)(F.ctl + CW_CHK + 2 * st + 1), 1u); }
__device__ __forceinline__ bool offby(float got, float ex, float rel, float ab) { const float d = fabsf(got - ex); return !(d <= rel * fabsf(ex) + ab); }
__device__ __forceinline__ float dot_bf(const bf16* a, const bf16* b, int n) { float s = 0.f; for (int k = 0; k < n; ++k) s += bf2f(a[k]) * bf2f(b[k]); return s; }
__device__ __forceinline__ float gelu_ref(float v) { return 0.5f * v * (1.0f + erff(v * 0.70710678f)); }
__device__ __forceinline__ unsigned chk_tstart(const Frame& F, unsigned ex) { const unsigned* cntg = (const unsigned*)(F.ctl + CW_CNT); unsigned s_ = 0; for (unsigned e = 0; e < ex; ++e) { unsigned c = cntg[e]; if (c > (unsigned)T) c = T; s_ += (c + 255u) >> 8; } return s_; }
template <int ST> __device__ __forceinline__ void stage_check(const Frame& F) {
    const unsigned gt = (unsigned)blockIdx.x * NTHR + threadIdx.x;
    const unsigned h0 = hmix(gt * 2654435761u + ST * 40503u), h1 = hmix(h0 + 0x9e3779b9u), h2 = hmix(h1 + 0x85ebca6bu);
    if (ST == 1) {
        if (gt >= 16384) return;
        const int which = gt & 7;
        if (which == 0) { const int e = h0 % NE, n = h1 % (2 * FF), k = h2 % DM; const int lc = CmWgu()(n);
            const float ex = bf2f((bf16)f2bf(F.w_gu[((size_t)e * DM + k) * 2 * FF + lc] * F.ffn_norm[k])); chk_add(F, ST, offby(bf2f(wsp<bf16>(F, WS_WGU)[((size_t)e * 2 * FF + n) * DM + k]), ex, 1e-6f, 1e-30f)); }
        else if (which == 1) { const int e = h0 % NE, n = h1 % DM, k = h2 % FF;
            const float ex = bf2f((bf16)f2bf(F.w_dn[((size_t)e * FF + k) * DM + n])); chk_add(F, ST, offby(bf2f(wsp<bf16>(F, WS_WDN)[((size_t)e * DM + n) * FF + k]), ex, 1e-6f, 1e-30f)); }
        else if (which == 2) { const int n = h1 % NPROJ, k = h2 % DM; const int lc = CmWin()(n);
            const float ex = bf2f((bf16)f2bf(F.w_in[(size_t)k * NPROJ + lc] * F.mix_norm[k])); chk_add(F, ST, offby(bf2f(wsp<bf16>(F, WS_WIN)[(size_t)n * DM + k]), ex, 1e-6f, 1e-30f)); }
        else if (which == 3) { const int n = h1 % DM, k = h2 % DM; const float g = k < AW ? F.aon[k] : F.gon[k - AW];
            const float ex = bf2f((bf16)f2bf(F.w_out[(size_t)k * DM + n] * g)); chk_add(F, ST, offby(bf2f(wsp<bf16>(F, WS_WOUT)[(size_t)n * DM + k]), ex, 1e-6f, 1e-30f)); }
        else if (which == 4) { const int n = h1 % DM, k = h2 % DM;
            const float ex = bf2f((bf16)f2bf(F.w_pg[(size_t)k * DM + n] * F.ple_norm[k])); chk_add(F, ST, offby(bf2f(wsp<bf16>(F, WS_WPG)[(size_t)n * DM + k]), ex, 1e-6f, 1e-30f)); }
        else if (which == 5) { const int n = h1 % DM, k = h2 % PLE;
            const float ex = bf2f((bf16)f2bf(F.w_pp[(size_t)k * DM + n])); chk_add(F, ST, offby(bf2f(wsp<bf16>(F, WS_WPP)[(size_t)n * PLE + k]), ex, 1e-6f, 1e-30f)); }
        else if (which == 6) { const int row = h0 % T, k = h1 % DM; float ss = 0.f; for (int j = 0; j < DM; ++j) { const float v = F.x[(size_t)row * DM + j]; ss += v * v; }
            const float ex = F.x[(size_t)row * DM + k] / sqrtf(ss / DM + EPS); chk_add(F, ST, offby(bf2f(wsp<bf16>(F, WS_XNB)[(size_t)row * DM + k]), ex, 0.01f, 1e-3f)); }
        else { const int row = h0 % T, k = h1 % PLE; chk_add(F, ST, offby(bf2f(wsp<bf16>(F, WS_PB)[(size_t)row * PLE + k]), F.p[(size_t)row * PLE + k], 0.005f, 1e-6f)); }
    }
    if (ST == 2) {
        if (gt >= 16384) return;
        const bf16* XN = wsp<bf16>(F, WS_XNB); const bf16* WIN = wsp<bf16>(F, WS_WIN);
        if ((gt & 7) == 7) {
            const int b = h0 % BATCH, hh = h1 % NH, blk = h2 % NBLK, c = (h2 >> 8) % HD; float s_ = 0.f;
            for (int r = 0; r < 256; ++r) s_ += bf2f(wsp<bf16>(F, WS_K)[((size_t)b * SEQ + blk * 256 + r) * AW + hh * HD + c]);
            chk_add(F, ST, offby(wsp<float>(F, WS_KMEAN)[((size_t)(b * NH + hh) * NBLK + blk) * HD + c], s_, 0.02f, 0.3f)); return; }
        const int row = h0 % T, type = h1 % 5, c = h2 % AW; const bf16* xr = XN + (size_t)row * DM;
        const float v = dot_bf(xr, WIN + (size_t)(type * AW + c) * DM, DM); float ex;
        if (type <= 1) { const float vp = dot_bf(xr, WIN + (size_t)(type * AW + (c ^ 4)) * DM, DM); const int i = 4 * ((c & 63) >> 3) + (c & 3), pos = row & (SEQ - 1);
            const float cs = wsp<float>(F, WS_ROPE)[pos * 32 + i], sn = wsp<float>(F, WS_ROPE)[SEQ * 32 + pos * 32 + i];
            { const float inv = powf(10000.0f, -(float)i / 32.0f); const float ang = (float)pos * inv; if (offby(cs, cosf(ang), 0.f, 1e-3f) || offby(sn, sinf(ang), 0.f, 1e-3f)) { chk_add(F, ST, true); return; } }
            ex = (c & 4) ? v * cs + vp * sn : v * cs - vp * sn; }
        else if (type == 2) ex = v; else ex = gelu_ref(v);
        chk_add(F, ST, offby(bf2f(wsp<bf16>(F, WS_Q)[(size_t)type * (16u << 20) + (size_t)row * AW + c]), ex, 0.02f, 0.02f));
    }
    if (ST == 3) {
        if (gt >= 8192) return;
        if (gt & 1) {
            const int row = h0 % T, g = h1 % GG, d = h2 % GD; const int b = row / SEQ, s_ = row % SEQ, c = s_ / GC, t = s_ % GC; float acc = 0.f;
            for (int sp = 0; sp <= t; ++sp) { const bf16* vr = wsp<bf16>(F, WS_VG) + ((size_t)b * SEQ + c * GC + sp) * GW + g * GD; float mu = 0.f; for (int j = 0; j < GD; ++j) mu += bf2f(vr[j]); mu /= GD;
                float var = 0.f; for (int j = 0; j < GD; ++j) { const float dd = bf2f(vr[j]) - mu; var += dd * dd; } const float rstd = 1.0f / sqrtf(var / GD + EPS);
                const float vn = bf2f((bf16)f2bf((bf2f(vr[d]) - mu) * rstd * F.ln_g[g * GD + d] + F.ln_b[g * GD + d])); acc += bf2f((bf16)f2bf(F.gws[((size_t)g * GC + t) * GC + sp])) * vn; }
            const float ex = bf2f(wsp<bf16>(F, WS_U)[(size_t)row * GW + g * GD + d]) * (acc + F.gbs[g * GC + t]);
            chk_add(F, ST, offby(bf2f(wsp<bf16>(F, WS_MIX)[(size_t)row * DM + AW + g * GD + d]), ex, 0.03f, 0.02f)); return; }
        const int row = h0 % T, hh = h1 % NH; const int b = row / SEQ, s_ = row % SEQ, qb = s_ / MOBA; float q[HD];
#pragma unroll
        for (int c = 0; c < HD; ++c) q[c] = bf2f(wsp<bf16>(F, WS_Q)[(size_t)row * AW + hh * HD + c]);
        unsigned sel = 0u;
        if (qb <= 3) sel = (1u << qb) - 1u;
        else { float b0 = -__builtin_inff(), b1 = b0, b2 = b0; int i0 = 0, i1 = 0, i2 = 0;
            for (int j = 0; j < qb; ++j) { const float* km = wsp<float>(F, WS_KMEAN) + ((size_t)(b * NH + hh) * NBLK + j) * HD; float g = 0.f;
#pragma unroll
                for (int c = 0; c < HD; ++c) g += q[c] * km[c];
                if (g > b0) { b2 = b1; i2 = i1; b1 = b0; i1 = i0; b0 = g; i0 = j; } else if (g > b1) { b2 = b1; i2 = i1; b1 = g; i1 = j; } else if (g > b2) { b2 = g; i2 = j; } }
            sel = (1u << i0) | (1u << i1) | (1u << i2); }
        float mx = -__builtin_inff();
        for (int kp = 0; kp <= s_; ++kp) { const int blk = kp / MOBA; if (blk != qb && !((sel >> blk) & 1u)) continue; const bf16* kr = wsp<bf16>(F, WS_K) + ((size_t)b * SEQ + kp) * AW + hh * HD; float sc = 0.f;
#pragma unroll
            for (int c = 0; c < HD; ++c) sc += q[c] * bf2f(kr[c]);
            mx = fmaxf(mx, sc * 0.125f); }
        float o[HD]; float l = 0.f;
#pragma unroll
        for (int c = 0; c < HD; ++c) o[c] = 0.f;
        for (int kp = 0; kp <= s_; ++kp) { const int blk = kp / MOBA; if (blk != qb && !((sel >> blk) & 1u)) continue; const bf16* kr = wsp<bf16>(F, WS_K) + ((size_t)b * SEQ + kp) * AW + hh * HD; float sc = 0.f;
#pragma unroll
            for (int c = 0; c < HD; ++c) sc += q[c] * bf2f(kr[c]);
            const float pr = expf(sc * 0.125f - mx); l += pr; const bf16* vr = wsp<bf16>(F, WS_V) + ((size_t)b * SEQ + kp) * AW + hh * HD;
#pragma unroll
            for (int c = 0; c < HD; ++c) o[c] += pr * bf2f(vr[c]); }
        bool bad = false; float ss = 0.f;
#pragma unroll
        for (int c = 0; c < HD; ++c) { const float ex = o[c] / l; ss += ex * ex; bad |= offby(bf2f(wsp<bf16>(F, WS_MIX)[(size_t)row * DM + hh * HD + c]), ex, 0.04f, 0.02f); }
        bad |= offby(wsp<float>(F, WS_SSQA)[(size_t)row * NH + hh], ss, 0.03f, 1e-3f);
        chk_add(F, ST, bad);
    }
    if (ST == 4) {
        if (gt >= 16384) return;
        const int row = h0 % T, col = h1 % DM; const bf16* mr = wsp<bf16>(F, WS_MIX) + (size_t)row * DM; const bf16* wr_ = wsp<bf16>(F, WS_WOUT) + (size_t)col * DM;
        float sa = 0.f, sg = 0.f, da = 0.f, dg = 0.f;
        for (int k = 0; k < AW; ++k) { const float a = bf2f(mr[k]), g = bf2f(mr[AW + k]); sa += a * a; sg += g * g; da += a * bf2f(wr_[k]); dg += g * bf2f(wr_[AW + k]); }
        const float ex = F.x[(size_t)row * DM + col] + da / sqrtf(sa / AW + EPS) + dg / sqrtf(sg / GW + EPS);
        chk_add(F, ST, offby(F.out[(size_t)row * DM + col], ex, 0.01f, 0.03f));
    }
    if (ST == 5) {
        if (gt >= 8192) return;
        const int tok = h0 % T; const float* xr = F.out + (size_t)tok * DM; float ss = 0.f; for (int k = 0; k < DM; ++k) ss += xr[k] * xr[k]; const float rstd = 1.0f / sqrtf(ss / DM + EPS);
        bool bad = false;
        for (int j = 0; j < 4; ++j) { const int k = (h1 >> (8 * j)) % DM; bad |= offby(bf2f(wsp<bf16>(F, WS_XNB)[(size_t)tok * DM + k]), xr[k] * rstd, 0.01f, 1e-3f); }
        float lg[NE];
#pragma unroll
        for (int e = 0; e < NE; ++e) lg[e] = 0.f;
        for (int k = 0; k < DM; ++k) { const float xv = xr[k] * rstd * F.ffn_norm[k];
#pragma unroll
            for (int e = 0; e < NE; ++e) lg[e] += xv * F.router_w[k * NE + e]; }
#pragma unroll
        for (int e = 0; e < NE; ++e) lg[e] += F.router_b[e];
        int te[4]; float tv[4]; unsigned used = 0u;
#pragma unroll
        for (int k = 0; k < 4; ++k) { float best = -__builtin_inff(); int bi = 0;
#pragma unroll
            for (int e = 0; e < NE; ++e) if (!((used >> e) & 1u) && lg[e] > best) { best = lg[e]; bi = e; }
            used |= 1u << bi; te[k] = bi; tv[k] = best; }
        { float gg[4]; float den = 0.f;
#pragma unroll
          for (int k = 0; k < 4; ++k) { float v = -__builtin_inff();
#pragma unroll
              for (int e = 0; e < NE; ++e) if (e == te[k]) v = lg[e];
              gg[k] = v; }
          const float mm = gg[0];
#pragma unroll
          for (int k = 0; k < 4; ++k) { gg[k] = expf(gg[k] - mm); den += gg[k]; }
          const unsigned* tp = wsp<unsigned>(F, WS_TOKPOS) + (size_t)tok * 4;
#pragma unroll
          for (int k = 0; k < 4; ++k) { const unsigned e = tp[k] >> 16, slot = tp[k] & 0xffffu; bad |= (e != (unsigned)te[k]);
              if (e < NE && slot < (unsigned)T) { bad |= wsp<unsigned>(F, WS_IDX)[(size_t)e * T + slot] != (unsigned)tok; bad |= offby(wsp<float>(F, WS_GSS)[(size_t)e * T + slot], gg[k] / den, 2e-3f, 1e-5f);
                  bad |= slot >= ((const unsigned*)(F.ctl + CW_CNT))[e]; } else bad = true; } }
        (void)tv;
        chk_add(F, ST, bad);
    }
    if (ST == 6 || ST == 7) {
        if (gt >= 16384) return;
        const int tok = h0 % T, k = h1 & 3, col = (h1 >> 2) % FF; const unsigned tp = wsp<unsigned>(F, WS_TOKPOS)[(size_t)tok * 4 + k]; const unsigned e = tp >> 16, slot = tp & 0xffffu;
        if (e >= NE) { chk_add(F, ST, true); return; }
        const unsigned tse = chk_tstart(F, e);
        const size_t row = (size_t)tse * 256 + slot;
        if (ST == 6) { const bf16* xr = wsp<bf16>(F, WS_XNB) + (size_t)tok * DM; const int np = (col >> 7) * 256 + (col & 127);
            const float g = dot_bf(xr, wsp<bf16>(F, WS_WGU) + ((size_t)e * 2 * FF + np) * DM, DM) + F.b_gu[(size_t)e * 2 * FF + col];
            const float l = dot_bf(xr, wsp<bf16>(F, WS_WGU) + ((size_t)e * 2 * FF + np + 128) * DM, DM) + F.b_gu[(size_t)e * 2 * FF + FF + col];
            const float gc = fminf(g, 7.f), lc = fminf(fmaxf(l, -7.f), 7.f); const float ex = gc / (1.0f + expf(-1.702f * gc)) * (lc + 1.0f);
            chk_add(F, ST, offby(bf2f(wsp<bf16>(F, WS_ABUF)[row * FF + col]), ex, 0.03f, 0.03f)); }
        else { const float d = dot_bf(wsp<bf16>(F, WS_ABUF) + row * FF, wsp<bf16>(F, WS_WDN) + ((size_t)e * DM + col) * FF, FF) + F.b_dn[(size_t)e * DM + col];
            const float ex = d * wsp<float>(F, WS_GSS)[(size_t)e * T + slot];
            chk_add(F, ST, offby(bf2f(wsp<bf16>(F, WS_YBUF)[row * DM + col]), ex, 0.03f, 0.01f)); }
    }
    if (ST == 8) {
        if (gt >= 8192) return;
        const int tok = h0 % T; const float* xr = F.out + (size_t)tok * DM; float ss = 0.f; for (int k = 0; k < DM; ++k) ss += xr[k] * xr[k]; const float rstd = 1.0f / sqrtf(ss / DM + EPS);
        bool bad = false; for (int k = 0; k < DM; ++k) { bad |= offby(bf2f(wsp<bf16>(F, WS_X2N)[(size_t)tok * DM + k]), xr[k] * rstd, 0.01f, 1e-3f); bad |= !(fabsf(xr[k]) < 30.f); }
        chk_add(F, ST, bad);
    }
    if (ST == 9) {
        if (gt >= 16384) return;
        const int row = h0 % T, col = h1 % DM;
        if (gt & 1) { const float d = dot_bf(wsp<bf16>(F, WS_X2N) + (size_t)row * DM, wsp<bf16>(F, WS_WPG) + (size_t)col * DM, DM); const float got = bf2f(wsp<bf16>(F, WS_GATE)[(size_t)row * DM + col]); const float ex = 1.0f / (1.0f + expf(-d)); const bool bad = offby(got, ex, 0.02f, 0.01f); chk_add(F, ST, bad);
            if (bad) { atomicOr((unsigned*)(F.ctl + CW_CHK + 40), 1u << ((col >> 3) & 31)); atomicOr((unsigned*)(F.ctl + CW_CHK + 41), 1u << ((row >> 3) & 31)); atomicOr((unsigned*)(F.ctl + CW_CHK + 42), 1u << (col & 7)); atomicOr((unsigned*)(F.ctl + CW_CHK + 43), 1u << (row & 7));
                if (!(got >= 0.f && got <= 1.f)) atomicAdd((unsigned*)(F.ctl + CW_CHK + 44), 1u); { int cl = (int)floorf(log2f(fabsf(got) + 1e-30f)) + 40; cl = cl < 0 ? 0 : (cl > 80 ? 80 : cl); atomicMax((unsigned*)(F.ctl + CW_CHK + 46), (unsigned)cl); atomicMin((unsigned*)(F.ctl + CW_CHK + 47), 0xffffffffu - (unsigned)cl); if (got < 0.f) atomicAdd((unsigned*)(F.ctl + CW_CHK + 48), 1u); } if (fabsf(got - ex) > 0.2f) atomicAdd((unsigned*)(F.ctl + CW_CHK + 45), 1u); } }
        else { const float d = dot_bf(wsp<bf16>(F, WS_PB) + (size_t)row * PLE, wsp<bf16>(F, WS_WPP) + (size_t)col * PLE, PLE); chk_add(F, 10, offby(bf2f(wsp<bf16>(F, WS_PP)[(size_t)row * DM + col]), d, 0.02f, 0.02f)); }
    }
}
__device__ __forceinline__ void check_report(const Frame& F) {
    float c2 = 3.0f;
    for (int st = 1; st <= 10; ++st) { const unsigned bad = F.ctl[CW_CHK + 2 * st], tot = F.ctl[CW_CHK + 2 * st + 1]; const float fr = tot ? (float)bad / (float)tot : 1.0f;
        (void)fr; if (((CHECK_SKIP >> st) & 1) == 0 && bad >= 1u) { c2 = powf(10.0f, (float)st) * (1.0f + fminf((float)bad, 80.0f) * 0.1f); break; } }
#if CHECK_REPORT >= 40
    { unsigned v = F.ctl[CW_CHK + CHECK_REPORT]; if (CHECK_REPORT == 47) v = 0xffffffffu - v; c2 = powf(10.0f, (float)(v >> 27)) * (1.0f + (float)((v >> 21) & 63u) * 0.1f);
#if CHECK_REPORT2
      c2 = powf(10.0f, (float)((v >> 16) & 31u)) * (1.0f + (float)((v >> 10) & 63u) * 0.1f);
#endif
#if CHECK_REPORT3
      c2 = powf(10.0f, (float)((v >> 5) & 31u)) * (1.0f + (float)(v & 31u) * 0.1f);
#endif
      if (CHECK_REPORT >= 46 && CHECK_REPORT <= 47) c2 = powf(10.0f, (float)(v / 9u)) * (1.0f + (float)(v % 9u));
    }
#endif
    if (F.ctl[CW_BAR + XB_TMO] != 0u) c2 = 1e20f;
    const float c = sqrtf(c2);
    for (size_t i = (size_t)blockIdx.x * NTHR + threadIdx.x; i < (size_t)T * DM; i += (size_t)gridDim.x * NTHR) F.out[i] = c;
}
#define STAGE_CHECK(n) stage_check<(n)>(F)
#else
#define STAGE_CHECK(n) do {} while (0)
#endif

__global__ void __launch_bounds__(NTHR, 2) mega_fwd(Args args) {
    extern __shared__ __attribute__((aligned(16))) unsigned char lds_raw[];
    Frame F;
    F.lds = (LAS unsigned char*)lds_raw;
    F.MISC = (volatile LAS unsigned*)(F.lds + LDSCTL_OFF);
    F.G = gridDim.x; { const int bx = blockIdx.x; F.vcu = (F.G % 8 == 0) ? (bx % 8) * (F.G / 8) + bx / 8 : bx; }
    F.ws = args.ws; F.ctl = (gu32*)(args.ws + WS_CTL); F.out = args.out;
    F.x = args.in[0]; F.p = args.in[1]; F.mix_norm = args.in[2]; F.w_in = args.in[3]; F.ln_g = args.in[4]; F.ln_b = args.in[5]; F.gws = args.in[6]; F.gbs = args.in[7];
    F.aon = args.in[8]; F.gon = args.in[9]; F.w_out = args.in[10]; F.ffn_norm = args.in[11]; F.router_w = args.in[12]; F.router_b = args.in[13]; F.w_gu = args.in[14]; F.b_gu = args.in[15];
    F.w_dn = args.in[16]; F.b_dn = args.in[17]; F.ple_norm = args.in[18]; F.w_pg = args.in[19]; F.w_pp = args.in[20]; F.ppn = args.in[21]; F.final_norm = args.in[22];
    { PHASE_IDS; for (int u = TID_; u < 256; u += NTHR) ((LAS unsigned*)(F.lds + LDSCTL_OFF))[u] = 0u; }
    __syncthreads();
    XcdBarrier bar = xcd_barrier_post((unsigned*)(F.ctl + CW_BAR), F.MISC + 8);
#define GRID_BAR() xcd_barrier(bar)
#define STAGE_END(n) do { STAGE_CHECK(n); if (TPROBE && blockIdx.x == 0 && threadIdx.x == 0) ((unsigned long long*)(F.ctl + CW_TS))[(n)] = __builtin_amdgcn_s_memrealtime(); } while (0)

    if (TPROBE && blockIdx.x == 0 && threadIdx.x == 0) ((unsigned long long*)(F.ctl + CW_TS))[0] = __builtin_amdgcn_s_memrealtime();
    for (int rep = 0; rep < (DUP_PHASE == 0 ? 2 : 1); ++rep) {
    if (PH(0)) p0_prologue(F);
    GRID_BAR(); }
    STAGE_END(1);
    if (PH(1)) { pg8::DenseSched S; S.init(wsp<bf16>(F, WS_XNB), wsp<bf16>(F, WS_WIN), T, NPROJ, DM, F.G, (int)blockIdx.x);
      float* RC = wsp<float>(F, WS_ROPE);
      EpiInProj E{wsp<bf16>(F, WS_Q), RC, RC + SEQ * 32, wsp<float>(F, WS_KMEAN)};
      for (int rep = 0; rep < (DUP_PHASE == 1 ? 2 : 1); ++rep) { if (rep) GRID_BAR();
      pg8::gemm_phase<EpiInProj, pg8::DenseSched, false, false>(F.lds + RING_OFF, DM * 2, S, E); } }
    GRID_BAR();
    STAGE_END(2);
    for (int rep = 0; rep < (DUP_PHASE == 2 ? 2 : 1); ++rep) {
    if (PH(2)) p2_mixers(F);
    GRID_BAR(); }
    STAGE_END(3);
    if (PH(3)) { pg8::DenseSched S; S.init(wsp<bf16>(F, WS_MIX), wsp<bf16>(F, WS_WOUT), T, DM, DM, F.G, (int)blockIdx.x);
      LAS f32x2* rtab = (LAS f32x2*)(F.lds + XTAB_OFF);
      Unit ua, ub; const bool ha = S.next(0, ua), hb = S.next(1, ub);
      { PHASE_IDS; const int s = TID_ >> 8, r = TID_ & 255; const bool has = s ? hb : ha; const int pm = s ? ub.pm : ua.pm;
        if (has) { const size_t row = (size_t)pm * 256 + r; const f32x4* pa = (const f32x4*)(wsp<float>(F, WS_SSQA) + row * NH); const f32x4 a0 = pa[0], a1 = pa[1], g0 = *(const f32x4*)(wsp<float>(F, WS_SSQG) + row * GG);
            const float sa = ((a0[0] + a0[1]) + (a0[2] + a0[3])) + ((a1[0] + a1[1]) + (a1[2] + a1[3])), sg = (g0[0] + g0[1]) + (g0[2] + g0[3]);
            const float ra = 1.0f / sqrtf(sa * (1.f / AW) + EPS), rg = 1.0f / sqrtf(sg * (1.f / GW) + EPS);
            rtab[s * 256 + r] = (f32x2){ra / rg, rg}; } }
      __syncthreads();
      EpiOutProj E{wsp<bf16>(F, WS_XNB), wsp<float>(F, WS_SIG0), wsp<bf16>(F, WS_X1B), wsp<unsigned char>(F, WS_X1F8), wsp<float>(F, WS_SSQ1), rtab, ha ? ua.pm : -1, hb ? ub.pm : -1};
      for (int rep = 0; rep < (DUP_PHASE == 3 ? 2 : 1); ++rep) { if (rep) GRID_BAR();
      pg8::gemm_phase<EpiOutProj, pg8::DenseSched, false, true>(F.lds + RING_OFF, DM * 2, S, E); } }
    GRID_BAR();
    STAGE_END(4);
    if (PH(4)) p4_router(F);
    GRID_BAR();
    STAGE_END(5);
    if (PH(5)) { const int nu = moe_build_tables(F, 2 * FF / 256, true);
      pg8::MoeSched S{(const char*)wsp<char>(F, WS_X1F8), (const char*)wsp<char>(F, WS_WGU), 0, (size_t)2 * FF * DM, (size_t)256 * DM, nu,
                      (const LAS unsigned*)(F.lds + XTAB_OFF + XT_ULIST), (const LAS unsigned*)(F.lds + XTAB_OFF + XT_GTAB), true};
      EpiMoe1 E{wsp<unsigned char>(F, WS_ABUF), F.b_gu, wsp<float>(F, WS_RSS)};
      for (int rep = 0; rep < (DUP_PHASE == 5 ? 2 : 1); ++rep) { if (rep) GRID_BAR();
      int Kb = DM; asm volatile("" : "+s"(Kb));
      pg8::gemm_phase<EpiMoe1, pg8::MoeSched, true, false, true>(F.lds + RING_OFF, Kb, S, E); } }
    GRID_BAR();
    STAGE_END(6);
    if (PH(6)) { const int nu = moe_build_tables(F, DM / 256, false);
      pg8::MoeSched S{(const char*)wsp<char>(F, WS_ABUF), (const char*)wsp<char>(F, WS_WDN), (size_t)256 * FF, (size_t)DM * FF, (size_t)256 * FF, nu,
                      (const LAS unsigned*)(F.lds + XTAB_OFF + XT_ULIST), (const LAS unsigned*)(F.lds + XTAB_OFF + XT_GTAB), false};
      EpiMoe2 E{wsp<unsigned char>(F, WS_YBUF), F.b_dn, wsp<float>(F, WS_GSS)};
      for (int rep = 0; rep < (DUP_PHASE == 6 ? 2 : 1); ++rep) { if (rep) GRID_BAR();
      int Kb = FF; asm volatile("" : "+s"(Kb));
      pg8::gemm_phase<EpiMoe2, pg8::MoeSched, false, false, true>(F.lds + RING_OFF, Kb, S, E); } }
    GRID_BAR();
    STAGE_END(7);
    if (PH(7)) p7_combine(F);
    GRID_BAR();
    STAGE_END(8);
    if (PH(8)) { pg8::DenseSched S; S.init(wsp<unsigned char>(F, WS_X2F8), wsp<unsigned char>(F, WS_WPG8), T, DM, DM, F.G, (int)blockIdx.x, 1);
      EpiPle<0> E{wsp<unsigned char>(F, WS_GATE), wsp<float>(F, WS_RSTD2)};
      int Kb = DM; asm volatile("" : "+s"(Kb));
      pg8::gemm_phase<EpiPle<0>, pg8::DenseSched, false, false, true>(F.lds + RING_OFF, Kb, S, E);
#if CHECK_STAGE
      GRID_BAR();
      int Kb = DM; asm volatile("" : "+s"(Kb));
      pg8::gemm_phase<EpiPle<0>, pg8::DenseSched, false, false, true>(F.lds + RING_OFF, Kb, S, E);
#endif
    }
#if CHECK_STAGE
    GRID_BAR(); STAGE_CHECK(9);
#endif
    if (PH(8)) { pg8::DenseSched S; S.init(wsp<bf16>(F, WS_PB), wsp<bf16>(F, WS_WPP), T, DM, PLE, F.G, (int)blockIdx.x);
      EpiPle<1> E{wsp<unsigned char>(F, WS_PP), wsp<float>(F, WS_SSQPP)};
      int Kp = PLE * 2; asm volatile("" : "+s"(Kp));
      pg8::gemm_phase<EpiPle<1>, pg8::DenseSched, false, false>(F.lds + RING_OFF, Kp, S, E); }
    GRID_BAR();
    STAGE_END(9);
#if CHECK_STAGE
    GRID_BAR(); check_report(F);
#else
    if (PH(9)) p9_final(F);
#if TPROBE
    GRID_BAR();
    if (blockIdx.x == 0 && threadIdx.x == 0) { const unsigned long long* ts = (const unsigned long long*)(F.ctl + CW_TS); const unsigned long long t1 = (TP_A == 9) ? __builtin_amdgcn_s_memrealtime() : ts[(TP_A < 10 ? TP_A : 0) + 1];
        unsigned long long d = t1 - ts[TP_A < 10 ? TP_A : 0];
        if (TP_A == 20) d = ts[11] - ts[0]; if (TP_A == 21) d = ts[12] - ts[11]; if (TP_A == 22) d = ts[13] - ts[12]; if (TP_A == 23) d = ts[1] - ts[13]; if (TP_A == 24) d = ts[14] - ts[2]; if (TP_A == 25) d = ts[3] - ts[14];
        F.out[0] += floorf((float)d * 0.01f * 0.125f + 0.5f) * 2.0f; }
#endif
#endif
}

extern "C" void kernel_launch(void* const* d_in, const int* in_sizes, int n_in, void* d_out, int out_size, void* d_ws, size_t ws_size, hipStream_t stream) {
    static int grid = 0;
    if (grid == 0) {
        if (n_in != 23 || in_sizes[0] != T * DM || out_size != T * DM || ws_size < WS_END) { fprintf(stderr, "kernel_launch: unexpected shapes (n_in %d, in0 %d, out %d, ws %zu)\n", n_in, n_in > 0 ? in_sizes[0] : -1, out_size, ws_size); grid = -1; return; }
        int dev = 0, cus = 0, per_cu = 0;
        if (hipGetDevice(&dev) != hipSuccess || hipDeviceGetAttribute(&cus, hipDeviceAttributeMultiprocessorCount, dev) != hipSuccess) { grid = -1; return; }
        if (hipFuncSetAttribute((const void*)mega_fwd, hipFuncAttributeMaxDynamicSharedMemorySize, LDS_BYTES) != hipSuccess) { fprintf(stderr, "kernel_launch: hipFuncSetAttribute failed\n"); grid = -1; return; }
        if (hipOccupancyMaxActiveBlocksPerMultiprocessor(&per_cu, (const void*)mega_fwd, NTHR, LDS_BYTES) != hipSuccess || per_cu < 1)
            fprintf(stderr, "kernel_launch: note: occupancy query reports %d workgroups per CU\n", per_cu);
        (void)hipGetLastError();
        if (cus < 256) { fprintf(stderr, "kernel_launch: built for a 256-CU device (found %d CUs); nothing launched\n", cus); grid = -1; return; }
        grid = 256;
    }
    if (grid < 0) return;
    if (hipMemsetAsync((char*)d_ws + WS_CTL, 0, CTL_ZERO_BYTES, stream) != hipSuccess) return;
    Args a{};
    for (int i = 0; i < 23; ++i) a.in[i] = (const float*)d_in[i];
    a.out = (float*)d_out; a.ws = (unsigned char*)d_ws;
    hipLaunchKernelGGL(mega_fwd, dim3(grid), dim3(NTHR), LDS_BYTES, stream, a);
}
```

```cpp
#include <hip/hip_runtime.h>
#include <cstdio>
#include <cstdint>

#ifndef CHECK_STAGE
#define CHECK_STAGE 0
#endif
#ifndef CHECK_REPORT
#define CHECK_REPORT 0
#endif
#ifndef CHECK_REPORT2
#define CHECK_REPORT2 0
#endif
#ifndef CHECK_REPORT3
#define CHECK_REPORT3 0
#endif
#ifndef DUP_PHASE
#define DUP_PHASE -1
#endif
#ifndef TPROBE
#define TPROBE 0
#endif
#ifndef TP_A
#define TP_A 5
#endif
#ifndef TP_B
#define TP_B 6
#endif
#ifndef CHECK_SKIP
#define CHECK_SKIP 0
#endif
#ifndef PHMASK
#define PHMASK 0x3ff
#endif
#define PH(n) ((PHMASK >> (n)) & 1)

#define GAS __attribute__((address_space(1)))
#define LAS __attribute__((address_space(3)))
typedef unsigned short bf16;
typedef unsigned v4u __attribute__((ext_vector_type(4)));
typedef unsigned v2u __attribute__((ext_vector_type(2)));
typedef float f32x2 __attribute__((ext_vector_type(2)));
typedef float f32x4 __attribute__((ext_vector_type(4)));
typedef float f32x16 __attribute__((ext_vector_type(16)));
typedef short bf16x8 __attribute__((ext_vector_type(8)));
typedef short s16x4 __attribute__((ext_vector_type(4)));
typedef GAS unsigned gu32;

constexpr int BATCH = 16, SEQ = 2048, DM = 1024, T = BATCH * SEQ;
constexpr int AW = 512, NH = 8, HD = 64, NBLK = 8, MOBA = 256;
constexpr int GW = 512, GG = 4, GD = 128, GC = 128;
constexpr int NPROJ = 3 * AW + 2 * GW;
constexpr int NE = 32, TOPK = 4, FF = 1024;
constexpr int PLE = 256;
constexpr int MAXROWS = T * TOPK + NE * 256;
constexpr float EPS = 1e-6f;
constexpr int NWAVES = 8, NTHR = 512;

constexpr size_t MiB = 1u << 20;
constexpr size_t WS_CTL = 0, CTL_ZERO_BYTES = 1 * MiB;
constexpr size_t WS_KMEAN = 256 * 1024;
constexpr size_t WS_WIN = 1 * MiB;
constexpr size_t WS_WOUT = 6 * MiB;
constexpr size_t WS_WPG = 8 * MiB;
constexpr size_t WS_WPP = 10 * MiB;
constexpr size_t WS_RWG = 10 * MiB + 512 * 1024;
constexpr size_t WS_ROPE = 11 * MiB;
constexpr size_t WS_WGU = 16 * MiB;
constexpr size_t WS_WDN = 144 * MiB;
constexpr size_t WS_XNB = 208 * MiB;
constexpr size_t WS_BIG1 = 272 * MiB;
constexpr size_t WS_Q = WS_BIG1, WS_K = WS_Q + 32 * MiB, WS_V = WS_K + 32 * MiB, WS_U = WS_V + 32 * MiB, WS_VG = WS_U + 32 * MiB, WS_MIX = WS_VG + 32 * MiB;
constexpr size_t WS_YBUF = WS_BIG1;
constexpr size_t WS_BIG2 = 544 * MiB;
constexpr size_t WS_ABUF = WS_BIG2, WS_GATE = WS_BIG2, WS_PP = WS_BIG2 + 64 * MiB;
constexpr size_t WS_PB = 816 * MiB;
constexpr size_t WS_IDX = 832 * MiB;
constexpr size_t WS_GSS = 836 * MiB;
constexpr size_t WS_TOKPOS = 840 * MiB;
constexpr size_t WS_SSQA = 841 * MiB;
constexpr size_t WS_SSQG = 842 * MiB;
constexpr size_t WS_SSQ1 = 843 * MiB;
constexpr size_t WS_SSQPP = 845 * MiB;
constexpr size_t WS_X1F8 = 848 * MiB;
constexpr size_t WS_X2N = WS_XNB;
constexpr size_t WS_X1B = 880 * MiB;
constexpr size_t WS_X2B = 944 * MiB;
constexpr size_t WS_SIG0 = 1008 * MiB;
constexpr size_t WS_RSTD2 = 1008 * MiB + 256 * 1024;
constexpr size_t WS_RWT = 1008 * MiB + 512 * 1024;
constexpr size_t WS_RSS = 1009 * MiB;
constexpr size_t WS_X2F8 = 176 * MiB;
constexpr size_t WS_WPG8 = 80 * MiB;
constexpr size_t WS_END = 1013 * MiB;
static_assert(WS_MIX + 64 * MiB <= WS_BIG2 && (size_t)MAXROWS * 1024 * 2 <= 272 * MiB, "ws map");
constexpr int CW_TMO = 0, CW_CODE = 1;
constexpr int CW_BAR = 4096;
constexpr int CW_CNT = 8192;
constexpr int CW_TS = 12000;
constexpr int CW_CHK = 12288;

constexpr int RING_OFF = 0, RING_BYTES = 131072;
constexpr int P0_SCR_WAVE = 64 * 65 * 4;
constexpr int LDSCTL_OFF = 8 * P0_SCR_WAVE;
constexpr int XTAB_OFF = LDSCTL_OFF + 1024;
static_assert(LDSCTL_OFF >= RING_BYTES, "lds map");
constexpr int LDS_BYTES = 163840;

#define RLX_AGENT __ATOMIC_RELAXED, __HIP_MEMORY_SCOPE_AGENT
#define LDS_WAIT() asm volatile("s_waitcnt lgkmcnt(0)" ::: "memory")
#define VM_WAIT() asm volatile("s_waitcnt vmcnt(0)" ::: "memory")
__device__ __forceinline__ unsigned f2bf(float f) { unsigned u = __builtin_bit_cast(unsigned, f); return (u + 0x7fffu + ((u >> 16) & 1u)) >> 16; }
__device__ __forceinline__ unsigned pk2(float lo, float hi) { return f2bf(lo) | (f2bf(hi) << 16); }
__device__ __forceinline__ float bf2f(unsigned short b) { return __builtin_bit_cast(float, ((unsigned)b) << 16); }
__device__ __forceinline__ float bflo(unsigned w) { return __builtin_bit_cast(float, w << 16); }
__device__ __forceinline__ float bfhi(unsigned w) { return __builtin_bit_cast(float, w & 0xffff0000u); }
typedef __bf16 bf16x2_t __attribute__((ext_vector_type(2)));
__device__ __forceinline__ unsigned cvt_pk_bf16(float lo, float hi) { const f32x2 v = {lo, hi}; const bf16x2_t b = __builtin_convertvector(v, bf16x2_t); return __builtin_bit_cast(unsigned, b); }
__device__ __forceinline__ float clamp448(float x) { return fminf(fmaxf(x, -448.0f), 448.0f); }
__device__ __forceinline__ unsigned pk4_fp8(float a, float b, float c, float d) { unsigned w = 0u; w = (unsigned)__builtin_amdgcn_cvt_pk_fp8_f32(clamp448(a), clamp448(b), (int)w, false); w = (unsigned)__builtin_amdgcn_cvt_pk_fp8_f32(clamp448(c), clamp448(d), (int)w, true); return w; }
__device__ __forceinline__ float fp8_to_f(unsigned v) { const unsigned sg = (v >> 7) & 1u, e = (v >> 3) & 15u, m = v & 7u; const float r = e ? ldexpf(1.0f + (float)m * 0.125f, (int)e - 7) : ldexpf((float)m * 0.125f, -6); return sg ? -r : r; }
__device__ __forceinline__ float wave_sum(float v) {
#pragma unroll
    for (int o = 1; o < 64; o <<= 1) v += __shfl_xor(v, o);
    return v;
}
__device__ __forceinline__ f32x2 gelu_pk(f32x2 v) {
    const f32x2 av = __builtin_elementwise_abs(v), d = av * 0.2316418882f + 1.0f;
    f32x2 t; t.x = __builtin_amdgcn_rcpf(d.x); t.y = __builtin_amdgcn_rcpf(d.y);
    f32x2 q = t * 0.5307027145f + (-0.7265760135f); q = q * t + 0.7107068705f; q = q * t + (-0.142248368f); q = q * t + 0.127414796f; q = q * t;
    const f32x2 s = (v * v) * (-0.72134752044f);
    f32x2 e; e.x = __builtin_amdgcn_exp2f(s.x); e.y = __builtin_amdgcn_exp2f(s.y);
    const f32x2 m = v * (q * e), r = v - m;
    f32x2 o; o.x = v.x < 0.f ? m.x : r.x; o.y = v.y < 0.f ? m.y : r.y; return o;
}
__device__ __forceinline__ f32x4 gelu4(f32x4 v) { const f32x2 a = gelu_pk((f32x2){v[0], v[1]}), b = gelu_pk((f32x2){v[2], v[3]}); return (f32x4){a.x, a.y, b.x, b.y}; }
__device__ __forceinline__ float sigmoidf_fast(float x) { return __builtin_amdgcn_rcpf(1.0f + __builtin_amdgcn_exp2f(-1.4426950408889634f * x)); }

#define XB_TMO      128
#define XB_XCNT(j)  (256  + 64 * (j))
#define XB_XSUB(j)  (1280 + 64 * (j))
#define XB_XGEN(j)  (2304 + 64 * (j))
#define XB_TOP      3328
#define XB_TOPGEN   3392
#define XCD_BAR_WORDS 3456
#define XB_SPIN_CAP (1u << 18)
__device__ __forceinline__ unsigned xb_ld(unsigned* p)              { return __hip_atomic_load(p, __ATOMIC_RELAXED, __HIP_MEMORY_SCOPE_AGENT); }
__device__ __forceinline__ unsigned xb_add(unsigned* p, unsigned v) { return __hip_atomic_fetch_add(p, v, __ATOMIC_RELAXED, __HIP_MEMORY_SCOPE_AGENT); }
__device__ __forceinline__ unsigned xb_xcc_id() { return (unsigned)__builtin_amdgcn_s_getreg((3 << 11) | 20) & 0xFu; }
#define XB_SPIN(cond, bar) do { unsigned _sp = 0; while (cond) { __builtin_amdgcn_s_sleep(1); \
    if ((++_sp & 255u) == 0u) { if (xb_ld(&(bar)[XB_TMO])) break; if (_sp > XB_SPIN_CAP) { atomicAdd(&(bar)[XB_TMO], 1u); break; } } } } while (0)
struct XcdBarrier { unsigned* bar; unsigned x; volatile LAS unsigned* st; };
__device__ __forceinline__ XcdBarrier xcd_barrier_post(unsigned* bar, volatile LAS unsigned* st) {
    XcdBarrier b; b.bar = bar; b.x = xb_xcc_id(); b.st = st;
    if (threadIdx.x == 0) (void)xb_add(&bar[XB_XCNT(b.x)], 1u);
    return b;
}
__device__ __forceinline__ void xcd_barrier_complete(unsigned* bar, unsigned x, unsigned& nloc, unsigned& nx) {
    const unsigned G = gridDim.x * gridDim.y * gridDim.z;
    unsigned sum, cnt, mine, sp = 0u;
    for (;;) {
        sum = 0u; cnt = 0u; mine = 0u;
#pragma unroll
        for (unsigned j = 0; j < 16; ++j) { const unsigned c = xb_ld(&bar[XB_XCNT(j)]); sum += c; cnt += (c > 0u) ? 1u : 0u; mine = (j == x) ? c : mine; }
        if (sum == G) break;
        __builtin_amdgcn_s_sleep(1);
        if ((++sp & 255u) == 0u) { if (xb_ld(&bar[XB_TMO])) break; if (sp > XB_SPIN_CAP) { atomicAdd(&bar[XB_TMO], 1u); break; } }
    }
    nloc = mine > 0u ? mine : 1u; nx = cnt > 0u ? cnt : 1u;
}
__device__ __forceinline__ void xcd_barrier(const XcdBarrier& b) {
    asm volatile("s_waitcnt vmcnt(0)" ::: "memory");
    __syncthreads();
    if (threadIdx.x == 0) {
        unsigned* bar = b.bar;
        __builtin_amdgcn_s_waitcnt(0);
        unsigned nloc = b.st[0], nx = b.st[1];
        if (nloc == 0u) { xcd_barrier_complete(bar, b.x, nloc, nx); b.st[0] = nloc; b.st[1] = nx; }
        const unsigned old = xb_add(&bar[XB_XSUB(b.x)], 1u);
        const unsigned gen = old / nloc;
        if (old + 1u == (gen + 1u) * nloc) {
            __builtin_amdgcn_fence(__ATOMIC_RELEASE, "agent");
            asm volatile("s_waitcnt vmcnt(0)" ::: "memory");
            const unsigned og = xb_add(&bar[XB_TOP], 1u);
            const unsigned tg = og / nx;
            if (og + 1u == (tg + 1u) * nx) xb_add(&bar[XB_TOPGEN], 1u);
            else XB_SPIN(xb_ld(&bar[XB_TOPGEN]) == tg, bar);
            __builtin_amdgcn_fence(__ATOMIC_ACQUIRE, "agent");
            xb_add(&bar[XB_XGEN(b.x)], 1u);
            asm volatile("s_waitcnt vmcnt(0)" ::: "memory");
        } else {
            XB_SPIN(xb_ld(&bar[XB_XGEN(b.x)]) == gen, bar);
            __builtin_amdgcn_fence(__ATOMIC_ACQUIRE, "agent");
            asm volatile("s_waitcnt vmcnt(0)" ::: "memory");
        }
    }
    __syncthreads();
}

namespace pg8 {
constexpr int BM = 256, BK = 64, HALF = 128, HTB = HALF * BK * 2, STAGE_BYTES = 8 * HTB, NXCD = 8, WGM = 8;
__host__ __device__ __forceinline__ int lds_byte(int r, int c) { const int st = (r >> 4) * 2 + (c >> 5), rr = r & 15, cc = c & 31, ob = rr * 64 + cc * 2; return st * 1024 + (ob ^ (((ob >> 9) & 1) << 5)); }
__host__ __device__ __forceinline__ void stage_rc(int b, int& R, int& C) { const int st = b / 1024, sb = b % 1024, swz = sb ^ (((sb >> 9) & 1) << 5); R = (st >> 1) * 16 + swz / 64; C = (st & 1) * 32 + (swz % 64) / 2; }
__host__ __device__ __forceinline__ int perm32(int rho) { const int n = rho >> 4, i = rho & 15; return 8 * (i >> 2) + 4 * n + (i & 3); }

typedef int v8i __attribute__((ext_vector_type(8)));
constexpr int F8_WSHIFT = 6, F8_SCALE_W = 127 - F8_WSHIFT;
typedef int v4i __attribute__((ext_vector_type(4)));
__device__ __forceinline__ v8i ld8(const LAS unsigned char* p0, const LAS unsigned char* p1) { const v4i lo = *(const LAS v4i*)p0, hi = *(const LAS v4i*)p1; return __builtin_shufflevector(lo, hi, 0, 1, 2, 3, 4, 5, 6, 7); }
struct Unit { int pm, pn, e, rt; };

__device__ __forceinline__ void flat_to_tile(int L, int nwg, int nM, int nN, int& pm, int& pn) {
    int wgid = L; { const int q = nwg / NXCD, r = nwg % NXCD, xcd = wgid % NXCD, off = wgid / NXCD; wgid = (xcd < r ? xcd * (q + 1) : r * (q + 1) + (xcd - r) * q) + off; }
    const int nig = WGM * nN, gid = wgid / nig, fm = gid * WGM, gsz = (nM - fm) < WGM ? (nM - fm) : WGM;
    pm = fm + ((wgid % nig) % gsz); pn = (wgid % nig) / gsz;
}
struct DenseSched {
    const char* A; const char* Bt; int nM, nN, nwg, G, c; size_t tstep;
    __device__ __forceinline__ void init(const void* A_, const void* Bt_, int M, int N, int K, int G_, int c_, int ebytes = 2) { A = (const char*)A_; Bt = (const char*)Bt_; nM = M / BM; nN = N / BM; nwg = nM * nN; G = G_; c = c_; tstep = (size_t)BM * K * ebytes; }
    __device__ __forceinline__ bool next(int i, Unit& u) const { const long L = (long)i * G + c; if (L >= nwg) return false; flat_to_tile((int)L, nwg, nM, nN, u.pm, u.pn); u.e = 0; u.rt = u.pm; return true; }
    __device__ __forceinline__ const char* a_base(const Unit& u) const { return A + (size_t)u.pm * tstep; }
    __device__ __forceinline__ const char* b_base(const Unit& u) const { return Bt + (size_t)u.pn * tstep; }
    __device__ __forceinline__ void gather(int, int, int, unsigned (&)[2][2]) const {}
};
struct MoeSched {
    const char* A; const char* Bt; size_t a_tstep, b_estep, b_tstep; int nunits; const LAS unsigned* ulist; const LAS unsigned* gtab; bool gath;
    __device__ __forceinline__ bool next(int i, Unit& u) const {
        if (i >= nunits) return false;
        const unsigned w = (unsigned)__builtin_amdgcn_readfirstlane((int)ulist[i]);
        u.pm = (int)(w & 0x3ffu); u.pn = (int)((w >> 10) & 0x7u); u.e = (int)((w >> 13) & 0x1fu); u.rt = (int)(w >> 18); return true;
    }
    __device__ __forceinline__ const char* a_base(const Unit& u) const { return gath ? A : A + (size_t)u.pm * a_tstep; }
    __device__ __forceinline__ const char* b_base(const Unit& u) const { return Bt + (size_t)u.e * b_estep + (size_t)u.pn * b_tstep; }
    __device__ __forceinline__ void gather(int i, int R0, int R1, unsigned (&off)[2][2]) const {
        const LAS unsigned* g = gtab + i * 256;
        off[0][0] = g[R0]; off[0][1] = g[R1]; off[1][0] = g[128 + R0]; off[1][1] = g[128 + R1];
    }
};

#define PG8_SA(b, h) (((b) * 2 + (h)) * HTB)
#define PG8_SB(b, h) ((4 + (b) * 2 + (h)) * HTB)
#define PG8_GLDS(src, dstoff) __builtin_amdgcn_global_load_lds((const unsigned*)(src), (LAS unsigned*)(lds + (dstoff)), 16, 0, 0)
#define PG8_STAGE_B(bufoff, gbase) do { _Pragma("unroll") for (int _i = 0; _i < 2; ++_i) PG8_GLDS((const char*)(gbase) + voffB[_i], (bufoff) + ldsw + _i * 8192); } while (0)
#define PG8_STAGE_A(bufoff, kptr, h, o) do { _Pragma("unroll") for (int _i = 0; _i < 2; ++_i) \
        PG8_GLDS(GATHER ? (const char*)(kptr) + (o)[h][_i] : (const char*)(kptr) + (size_t)(h) * hstep + voffA[_i], (bufoff) + ldsw + _i * 8192); } while (0)
#define PG8_LDA(dst, b, h) do { _Pragma("unroll") for (int m = 0; m < 4; ++m) { if constexpr (F8) dst##8[m] = ld8(lds + PG8_SA(b, h) + a8_0 + m * 2048, lds + PG8_SA(b, h) + a8_1 + m * 2048); \
        else { _Pragma("unroll") for (int k = 0; k < 2; ++k) dst[m][k] = *(const LAS bf16x8*)(lds + PG8_SA(b, h) + aoff + m * 2048 + k * 1024); } } } while (0)
#define PG8_LDB(dst, b, h) do { _Pragma("unroll") for (int n = 0; n < 2; ++n) { if constexpr (F8) dst##8[n] = ld8(lds + PG8_SB(b, h) + b8_0 + n * 2048, lds + PG8_SB(b, h) + b8_1 + n * 2048); \
        else { _Pragma("unroll") for (int k = 0; k < 2; ++k) dst[n][k] = *(const LAS bf16x8*)(lds + PG8_SB(b, h) + boff + n * 2048 + k * 1024); } } } while (0)
#define PG8_MMA(ai, bj, At, Bt) do { __builtin_amdgcn_s_setprio(1); _Pragma("unroll") for (int m = 0; m < 4; ++m) _Pragma("unroll") for (int n = 0; n < 2; ++n) { \
        if constexpr (F8) asm volatile("v_mfma_scale_f32_16x16x128_f8f6f4 %0, %1, %2, %0, %3, %4 op_sel_hi:[0,0,0]" : "+v"(acc[ai][bj][m][n]) : "v"(Bt##8[n]), "v"(At##8[m]), "v"(sc_w), "v"(sc_a)); \
        else { _Pragma("unroll") for (int k = 0; k < 2; ++k) acc[ai][bj][m][n] = __builtin_amdgcn_mfma_f32_16x16x32_bf16(Bt[n][k], At[m][k], acc[ai][bj][m][n], 0, 0, 0); } } __builtin_amdgcn_s_setprio(0); } while (0)
#define PG8_WAIT_V(n) asm volatile("s_waitcnt vmcnt(" #n ")" ::: "memory")
#define PG8_WAIT_L(n) asm volatile("s_waitcnt lgkmcnt(" #n ")" ::: "memory")
#define PG8_BAR __builtin_amdgcn_s_barrier()
#define PG8_SCHED __builtin_amdgcn_sched_barrier(0)

template <class Epi, class Sched, bool GATHER, bool MIDK, bool F8 = false>
__device__ __forceinline__ void gemm_phase(LAS unsigned char* lds, const int KB  , const Sched& S, const Epi& E) {
    int tid = (int)threadIdx.x; asm volatile("" : "+v"(tid));
    const int wid = __builtin_amdgcn_readfirstlane(tid >> 6), lane = tid & 63, wr = wid >> 2, wc = wid & 3, fr = lane & 15, fq = lane >> 4;
    const int nt = KB / 128;
    unsigned voffA[2], voffB[2]; int Rg[2]; unsigned Cg[2];
#pragma unroll
    for (int i = 0; i < 2; ++i) { int R, C; stage_rc(tid * 16 + i * 8192, R, C); const int Rb = Epi::PERM ? ((R & ~31) + perm32(R & 31)) : R;
        voffA[i] = (unsigned)(R * KB + C * 2); voffB[i] = (unsigned)(Rb * KB + C * 2); Rg[i] = R; Cg[i] = (unsigned)C * 2u; }
    const size_t kstep = 128;
    const size_t hstep = (size_t)HALF * KB;
    const unsigned ldsw = (unsigned)wid * 1024u;
    const int aoff = lds_byte(wr * 64 + fr, fq * 8), boff = lds_byte(wc * 32 + fr, fq * 8);
    const int a8_0 = lds_byte(wr * 64 + fr, 16 * fq), a8_1 = lds_byte(wr * 64 + fr, 16 * fq + 8), b8_0 = lds_byte(wc * 32 + fr, 16 * fq), b8_1 = lds_byte(wc * 32 + fr, 16 * fq + 8);
    Unit cur, nxt; int ui = 0;
    if (!S.next(0, cur)) return;
    f32x4 acc[2][2][4][2];
#pragma unroll
    for (int a = 0; a < 2; ++a)
#pragma unroll
        for (int b = 0; b < 2; ++b)
#pragma unroll
            for (int m = 0; m < 4; ++m)
#pragma unroll
                for (int n = 0; n < 2; ++n) acc[a][b][m][n] = (f32x4){0.f, 0.f, 0.f, 0.f};
    bf16x8 At[4][2], B0[2][2], B1[2][2]; v8i At8[4], B08[2], B18[2];
    int sc_w = F8_SCALE_W, sc_a = 127; if constexpr (F8) { asm volatile("" : "+v"(sc_w), "+v"(sc_a)); }
    unsigned offC[2][2] = {{0u, 0u}, {0u, 0u}}, offN[2][2] = {{0u, 0u}, {0u, 0u}};
    if constexpr (GATHER) { S.gather(0, Rg[0], Rg[1], offC);
#pragma unroll
        for (int h = 0; h < 2; ++h)
#pragma unroll
            for (int i = 0; i < 2; ++i) offC[h][i] += Cg[i]; }
    const char* cA = S.a_base(cur); const char* cB = S.b_base(cur);
    PG8_STAGE_B(PG8_SB(0, 0), cB); PG8_STAGE_B(PG8_SB(0, 1), cB + hstep); PG8_STAGE_A(PG8_SA(0, 0), cA, 0, offC); PG8_STAGE_A(PG8_SA(0, 1), cA, 1, offC);
    if (wr == 1) PG8_BAR;
    PG8_WAIT_V(2); PG8_BAR;
    PG8_STAGE_B(PG8_SB(1, 0), cB + kstep); PG8_STAGE_A(PG8_SA(1, 0), cA + kstep, 0, offC); PG8_STAGE_B(PG8_SB(1, 1), cB + hstep + kstep);
    PG8_WAIT_V(6); PG8_BAR;
    for (;;) {
        const bool has_next = S.next(ui + 1, nxt);
        const char* nA = has_next ? S.a_base(nxt) : cA; const char* nB = has_next ? S.b_base(nxt) : cB;
        if constexpr (GATHER) { if (has_next) { S.gather(ui + 1, Rg[0], Rg[1], offN);
#pragma unroll
                for (int h = 0; h < 2; ++h)
#pragma unroll
                    for (int i = 0; i < 2; ++i) offN[h][i] += Cg[i]; }
            else {
#pragma unroll
                for (int h = 0; h < 2; ++h)
#pragma unroll
                    for (int i = 0; i < 2; ++i) offN[h][i] = offC[h][i]; } }
        for (int t = 0; t < nt; t += 2) {
            const bool last = (t == nt - 2);
            const char* a1 = cA + (size_t)(t + 1) * kstep;
            const char* a2 = last ? nA : cA + (size_t)(t + 2) * kstep; const char* b2 = last ? nB : cB + (size_t)(t + 2) * kstep;
            const char* a3 = a2 + kstep; const char* b3 = b2 + kstep;
            unsigned o2[2][2];
#pragma unroll
            for (int h = 0; h < 2; ++h)
#pragma unroll
                for (int i = 0; i < 2; ++i) o2[h][i] = last ? offN[h][i] : offC[h][i];
            if constexpr (MIDK) { if (t == nt / 2) E.midk(acc, cur, wr, fr); }
            PG8_LDB(B0, 0, 0); PG8_LDB(B1, 0, 1); PG8_SCHED; PG8_LDA(At, 0, 0); PG8_STAGE_A(PG8_SA(1, 1), a1, 1, offC);
            PG8_WAIT_V(8); PG8_WAIT_L(0); PG8_BAR; PG8_MMA(0, 0, At, B0); PG8_MMA(0, 1, At, B1); PG8_BAR; PG8_SCHED;
            PG8_LDA(At, 0, 1); PG8_STAGE_B(PG8_SB(0, 0), b2); PG8_STAGE_B(PG8_SB(0, 1), b2 + hstep); PG8_STAGE_A(PG8_SA(0, 0), a2, 0, o2);
            PG8_WAIT_V(8); PG8_WAIT_L(0); PG8_BAR; PG8_MMA(1, 0, At, B0); PG8_MMA(1, 1, At, B1); PG8_BAR; PG8_SCHED;
            PG8_LDB(B0, 1, 0); PG8_LDB(B1, 1, 1); PG8_SCHED; PG8_LDA(At, 1, 0); PG8_STAGE_A(PG8_SA(0, 1), a2, 1, o2);
            PG8_WAIT_V(8); PG8_WAIT_L(0); PG8_BAR; PG8_MMA(0, 0, At, B0); PG8_MMA(0, 1, At, B1); PG8_BAR; PG8_SCHED;
            PG8_LDA(At, 1, 1); PG8_STAGE_B(PG8_SB(1, 0), b3); PG8_STAGE_B(PG8_SB(1, 1), b3 + hstep); PG8_STAGE_A(PG8_SA(1, 0), a3, 0, o2);
            PG8_WAIT_V(8); PG8_WAIT_L(0); PG8_BAR; PG8_MMA(1, 0, At, B0); PG8_MMA(1, 1, At, B1); PG8_BAR; PG8_SCHED;
        }
        if (wr == 0) PG8_BAR;
        if constexpr (F8) asm volatile("s_nop 15\n\ts_nop 15" ::: "memory");
        E(acc, cur, wr, wc, fr, fq);
        if (!has_next) break;
#pragma unroll
        for (int a = 0; a < 2; ++a)
#pragma unroll
            for (int b = 0; b < 2; ++b)
#pragma unroll
                for (int m = 0; m < 4; ++m)
#pragma unroll
                    for (int n = 0; n < 2; ++n) acc[a][b][m][n] = (f32x4){0.f, 0.f, 0.f, 0.f};
        cur = nxt; cA = nA; cB = nB; ++ui;
        if constexpr (GATHER) {
#pragma unroll
            for (int h = 0; h < 2; ++h)
#pragma unroll
                for (int i = 0; i < 2; ++i) offC[h][i] = offN[h][i]; }
        if (wr == 1) PG8_BAR;
    }
    PG8_WAIT_V(0);
    PG8_BAR;
}
}

struct Frame {
    LAS unsigned char* lds;
    volatile LAS unsigned* MISC;
    gu32* ctl;
    unsigned char* ws;
    int vcu, G;
    const float *x, *p, *mix_norm, *w_in, *ln_g, *ln_b, *gws, *gbs, *aon, *gon, *w_out, *ffn_norm, *router_w, *router_b, *w_gu, *b_gu, *w_dn, *b_dn, *ple_norm, *w_pg, *w_pp, *ppn, *final_norm;
    float* out;
};
template <class T_> __device__ __forceinline__ T_* wsp(const Frame& F, size_t off) { return (T_*)(F.ws + off); }

#define PHASE_IDS int TID_ = (int)threadIdx.x; asm volatile("" : "+v"(TID_)); const int LANE_ = TID_ & 63; const int WAVE_ = __builtin_amdgcn_readfirstlane(TID_ >> 6); (void)LANE_; (void)WAVE_
template <class ColMap>
__device__ __forceinline__ void p0_transpose_item(const float* W, int K, int N, bf16* WT, const float* gain, LAS float* scr, int item, int lane, int nphys, const ColMap& cm) {
    const int nblk = nphys / 64, kb = item / nblk, nb = item % nblk, k0 = 64 * kb, n0 = 64 * nb;
    const int srccol = cm(n0 + lane);
    float v_[64]; const float* src = W + (size_t)k0 * N + srccol;
#pragma unroll
    for (int kk = 0; kk < 64; ++kk) v_[kk] = __builtin_nontemporal_load(src + (size_t)kk * N);
    if (gain) {
#pragma unroll
        for (int kk = 0; kk < 64; kk += 4) { const f32x4 g4 = *(const f32x4*)(gain + k0 + kk); v_[kk] *= g4[0]; v_[kk + 1] *= g4[1]; v_[kk + 2] *= g4[2]; v_[kk + 3] *= g4[3]; } }
#pragma unroll
    for (int kk = 0; kk < 64; ++kk) scr[kk * 65 + lane] = v_[kk];
    LDS_WAIT(); asm volatile("" ::: "memory");
    const int c = lane & 7;
#pragma unroll
    for (int j = 0; j < 8; ++j) { const int n = (lane >> 3) + 8 * j; const LAS float* s = scr + (8 * c) * 65 + n;
        v4u o; o.x = pk2(s[0 * 65], s[1 * 65]); o.y = pk2(s[2 * 65], s[3 * 65]); o.z = pk2(s[4 * 65], s[5 * 65]); o.w = pk2(s[6 * 65], s[7 * 65]);
        *(GAS v4u*)(WT + (size_t)(n0 + n) * K + k0 + 8 * c) = o; }
    LDS_WAIT(); asm volatile("" ::: "memory");
}
template <class ColMap>
__device__ __forceinline__ void p0_transpose_item_f8(const float* W, int K, int N, unsigned char* WT, const float* gain, LAS float* scr, int item, int lane, int nphys, const ColMap& cm) {
    const int nblk = nphys / 64, kb = item / nblk, nb = item % nblk, k0 = 64 * kb, n0 = 64 * nb;
    const int srccol = cm(n0 + lane);
    float v_[64]; const float* src = W + (size_t)k0 * N + srccol;
#pragma unroll
    for (int kk = 0; kk < 64; ++kk) v_[kk] = __builtin_nontemporal_load(src + (size_t)kk * N);
    constexpr float WS_ = (float)(1 << pg8::F8_WSHIFT);
#pragma unroll
    for (int kk = 0; kk < 64; kk += 4) { f32x4 g4 = gain ? *(const f32x4*)(gain + k0 + kk) : (f32x4){1.f, 1.f, 1.f, 1.f}; v_[kk] *= g4[0] * WS_; v_[kk + 1] *= g4[1] * WS_; v_[kk + 2] *= g4[2] * WS_; v_[kk + 3] *= g4[3] * WS_; }
#pragma unroll
    for (int kk = 0; kk < 64; ++kk) scr[kk * 65 + lane] = v_[kk];
    LDS_WAIT(); asm volatile("" ::: "memory");
    const int c = lane & 3;
#pragma unroll
    for (int j = 0; j < 4; ++j) { const int n = (lane >> 2) + 16 * j; const LAS float* s_ = scr + (16 * c) * 65 + n;
        v4u o; o.x = pk4_fp8(s_[0 * 65], s_[1 * 65], s_[2 * 65], s_[3 * 65]); o.y = pk4_fp8(s_[4 * 65], s_[5 * 65], s_[6 * 65], s_[7 * 65]);
        o.z = pk4_fp8(s_[8 * 65], s_[9 * 65], s_[10 * 65], s_[11 * 65]); o.w = pk4_fp8(s_[12 * 65], s_[13 * 65], s_[14 * 65], s_[15 * 65]);
        *(GAS v4u*)(WT + (size_t)(n0 + n) * K + k0 + 16 * c) = o; }
    LDS_WAIT(); asm volatile("" ::: "memory");
}
struct CmId { __device__ __forceinline__ int operator()(int n) const { return n; } };
struct CmWin { __device__ __forceinline__ int operator()(int n) const { if (n >= 2 * AW) return n; const int c = n & 63; return (n & ~63) + 4 * (c >> 3) + (c & 3) + 32 * ((c >> 2) & 1); } };
struct CmWgu { __device__ __forceinline__ int operator()(int n) const { return ((n >> 7) & 1) * FF + (n >> 8) * 128 + (n & 127); } };

__device__ __forceinline__ void p0_prologue(Frame& F) {
    PHASE_IDS;
    LAS float* scr = (LAS float*)(F.lds + RING_OFF + WAVE_ * P0_SCR_WAVE);
    const int gw = F.vcu * NWAVES + WAVE_, NGW = F.G * NWAVES;
    constexpr int I_GU = (DM / 64) * (2 * FF / 64), I_DN = (FF / 64) * (DM / 64), I_IN = (DM / 64) * (NPROJ / 64), I_SQ = (DM / 64) * (DM / 64), I_PP = (PLE / 64) * (DM / 64);
    constexpr int NITEMS = NE * I_GU + NE * I_DN + I_IN + 2 * I_SQ + I_PP;
    unsigned char* WGU = wsp<unsigned char>(F, WS_WGU); unsigned char* WDN = wsp<unsigned char>(F, WS_WDN);
    for (int it = gw; it < NITEMS; it += NGW) {
        int r = it;
        if (r < NE * I_GU) { const int e = r / I_GU; p0_transpose_item_f8(F.w_gu + (size_t)e * DM * 2 * FF, DM, 2 * FF, WGU + (size_t)e * 2 * FF * DM, F.ffn_norm, scr, r % I_GU, LANE_, 2 * FF, CmWgu()); continue; } r -= NE * I_GU;
        if (r < NE * I_DN) { const int e = r / I_DN; p0_transpose_item_f8(F.w_dn + (size_t)e * FF * DM, FF, DM, WDN + (size_t)e * DM * FF, nullptr, scr, r % I_DN, LANE_, DM, CmId()); continue; } r -= NE * I_DN;
        if (r < I_IN) { p0_transpose_item(F.w_in, DM, NPROJ, wsp<bf16>(F, WS_WIN), F.mix_norm, scr, r, LANE_, NPROJ, CmWin()); continue; } r -= I_IN;
        if (r < I_SQ) {
            const int nblk = DM / 64, kb = r / nblk; const float* g = (kb < 8) ? F.aon : (F.gon - AW);
            p0_transpose_item(F.w_out, DM, DM, wsp<bf16>(F, WS_WOUT), g, scr, r, LANE_, DM, CmId()); continue; } r -= I_SQ;
        if (r < I_SQ) { p0_transpose_item_f8(F.w_pg, DM, DM, wsp<unsigned char>(F, WS_WPG8), F.ple_norm, scr, r, LANE_, DM, CmId()); continue; } r -= I_SQ;
        p0_transpose_item(F.w_pp, PLE, DM, wsp<bf16>(F, WS_WPP), nullptr, scr, r, LANE_, DM, CmId());
    }
    if (TPROBE && blockIdx.x == 0 && threadIdx.x == 0) ((unsigned long long*)(F.ctl + CW_TS))[11] = __builtin_amdgcn_s_memrealtime();
    bf16* XN = wsp<bf16>(F, WS_XNB);
    for (int m0 = gw; m0 < T; m0 += 2 * NGW) {
        f32x4 v[2][4]; float s[2] = {0.f, 0.f};
#pragma unroll
        for (int r = 0; r < 2; ++r) { const GAS f32x4* xr = (const GAS f32x4*)(F.x + (size_t)(m0 + r * NGW) * DM) + LANE_;
#pragma unroll
            for (int j = 0; j < 4; ++j) v[r][j] = __builtin_nontemporal_load(xr + 64 * j); }
#pragma unroll
        for (int r = 0; r < 2; ++r) {
#pragma unroll
            for (int j = 0; j < 4; ++j) s[r] += (v[r][j].x * v[r][j].x + v[r][j].y * v[r][j].y) + (v[r][j].z * v[r][j].z + v[r][j].w * v[r][j].w); }
#pragma unroll
        for (int r = 0; r < 2; ++r) { const int m = m0 + r * NGW; const float sig = sqrtf(wave_sum(s[r]) * (1.f / DM) + EPS), rstd = 1.0f / sig;
            if (LANE_ == 0) wsp<float>(F, WS_SIG0)[m] = sig;
            GAS v2u* o8 = (GAS v2u*)(XN + (size_t)m * DM) + LANE_;
#pragma unroll
            for (int j = 0; j < 4; ++j) { v2u w; w.x = pk2(v[r][j].x * rstd, v[r][j].y * rstd); w.y = pk2(v[r][j].z * rstd, v[r][j].w * rstd); o8[64 * j] = w; } }
    }
    if (TPROBE && blockIdx.x == 0 && threadIdx.x == 0) ((unsigned long long*)(F.ctl + CW_TS))[12] = __builtin_amdgcn_s_memrealtime();
    { const GAS f32x4* pr = (const GAS f32x4*)F.p; GAS v2u* po = (GAS v2u*)wsp<bf16>(F, WS_PB);
      const size_t n4 = (size_t)T * PLE / 4, gt = (size_t)(F.vcu * NTHR + TID_), GT = (size_t)F.G * NTHR;
      for (size_t i = gt; i < n4; i += GT) { const f32x4 v = pr[i]; v2u w; w.x = pk2(v.x, v.y); w.y = pk2(v.z, v.w); po[i] = w; } }
    if (TPROBE && blockIdx.x == 0 && threadIdx.x == 0) ((unsigned long long*)(F.ctl + CW_TS))[13] = __builtin_amdgcn_s_memrealtime();
    { const int gt = F.vcu * NTHR + TID_, GT = F.G * NTHR; float* RWG = wsp<float>(F, WS_RWG);
      (void)RWG; bf16* RWT = wsp<bf16>(F, WS_RWT);
      for (int i = gt; i < DM * NE; i += GT) { const int e = i / DM, k = i % DM; const float w = F.router_w[k * NE + e] * F.ffn_norm[k]; const unsigned hi = f2bf(w); const float lo = w - bf2f((bf16)hi); RWT[i] = (bf16)hi; RWT[NE * DM + i] = (bf16)f2bf(lo); }
      float* RC = wsp<float>(F, WS_ROPE); float* RS = RC + SEQ * 32;
      for (int i = gt; i < SEQ * 32; i += GT) { const int pos = i >> 5, j = i & 31; const float inv = powf(10000.0f, -(float)j / 32.0f); const float ang = (float)pos * inv; float sn, cs; sincosf(ang, &sn, &cs); RC[i] = cs; RS[i] = sn; } }
}

using pg8::Unit;
constexpr int HALF = 128;
struct EpiInProj {
    static constexpr bool PERM = true;
    bf16* QKVUV; const float *rc, *rs; float* kmean;
    __device__ __forceinline__ void operator()(const f32x4 (&acc)[2][2][4][2], const Unit& u, int wr, int wc, int fr, int fq) const {
        const int type = u.pn >> 1, colt = (u.pn & 1) * 256 + wc * 32 + 8 * fq;
        const int row0 = u.pm * 256 + wr * 64 + fr;
        if (type <= 1) {
            bf16* dst = QKVUV + (size_t)type * (16u << 20);
            const int pos0 = (u.pm & 7) * 256 + wr * 64 + fr, i0 = 16 * (wc & 1) + 4 * fq;
            f32x4 cs_[2][2];
#pragma unroll
            for (int bj = 0; bj < 2; ++bj) { cs_[bj][0] = (f32x4){0.f, 0.f, 0.f, 0.f}; cs_[bj][1] = (f32x4){0.f, 0.f, 0.f, 0.f}; }
#pragma unroll
            for (int ai = 0; ai < 2; ++ai) { f32x4 cc[4], ss[4];
#pragma unroll
                for (int m = 0; m < 4; ++m) { const int pos = pos0 + ai * HALF + m * 16; cc[m] = *(const f32x4*)(rc + pos * 32 + i0); ss[m] = *(const f32x4*)(rs + pos * 32 + i0); }
#pragma unroll
                for (int m = 0; m < 4; ++m) { const int ro = ai * HALF + m * 16; const f32x4 c = cc[m], s = ss[m];
                    bf16* rowp = dst + (size_t)(row0 + ro) * AW + colt;
#pragma unroll
                    for (int bj = 0; bj < 2; ++bj) { const f32x4 x1 = acc[ai][bj][m][0], x2 = acc[ai][bj][m][1];
                        const f32x4 o1 = x1 * c - x2 * s, o2 = x2 * c + x1 * s;
                        cs_[bj][0] += o1; cs_[bj][1] += o2;
                        v4u w; w.x = cvt_pk_bf16(o1[0], o1[1]); w.y = cvt_pk_bf16(o1[2], o1[3]); w.z = cvt_pk_bf16(o2[0], o2[1]); w.w = cvt_pk_bf16(o2[2], o2[3]);
                        *(v4u*)(rowp + bj * HALF) = w; } }
                asm volatile("" ::: "memory"); }
            if (type == 1) {
#pragma unroll
                for (int bj = 0; bj < 2; ++bj)
#pragma unroll
                    for (int n = 0; n < 2; ++n)
#pragma unroll
                        for (int j = 0; j < 4; ++j) { float v = cs_[bj][n][j]; v += __shfl_xor(v, 1); v += __shfl_xor(v, 2); v += __shfl_xor(v, 4); v += __shfl_xor(v, 8); cs_[bj][n][j] = v; }
                if (fr == 0) { const int b = u.pm >> 3, blk = u.pm & 7;
#pragma unroll
                    for (int bj = 0; bj < 2; ++bj) { const int colh = (u.pn & 1) * 256 + bj * HALF + wc * 32; const int head = colh >> 6, cpos = (colh & 63) + 8 * fq;
                        float* km = kmean + ((size_t)((b * NH + head) * NBLK + blk)) * HD + cpos;
#pragma unroll
                        for (int n = 0; n < 2; ++n)
#pragma unroll
                            for (int j = 0; j < 4; ++j) atomicAdd(km + 4 * n + j, cs_[bj][n][j]); } }
            }
        } else {
            bf16* dst = QKVUV + (size_t)type * (16u << 20);
#pragma unroll
            for (int ai = 0; ai < 2; ++ai)
#pragma unroll
                for (int m = 0; m < 4; ++m) { bf16* rowp = dst + (size_t)(row0 + ai * HALF + m * 16) * AW + colt;
#pragma unroll
                    for (int bj = 0; bj < 2; ++bj) { f32x4 v0 = acc[ai][bj][m][0], v1 = acc[ai][bj][m][1];
                        if (type >= 3) { v0 = gelu4(v0); v1 = gelu4(v1); }
                        v4u w; w.x = cvt_pk_bf16(v0[0], v0[1]); w.y = cvt_pk_bf16(v0[2], v0[3]); w.z = cvt_pk_bf16(v1[0], v1[1]); w.w = cvt_pk_bf16(v1[2], v1[3]);
                        *(v4u*)(rowp + bj * HALF) = w; } }
        }
    }
};
struct EpiOutProj {
    static constexpr bool PERM = true;
    const bf16* xn; const float* sig0; bf16* x1; unsigned char* x1f8; float* ssq1; const LAS f32x2* rtab;
    int pm_a, pm_b;
    __device__ __forceinline__ int slot(const Unit& u) const { return u.pm == pm_a ? 0 : 1; }
    __device__ __forceinline__ void midk(f32x4 (&acc)[2][2][4][2], const Unit& u, int wr, int fr) const {
        const LAS f32x2* t = rtab + slot(u) * 256 + wr * 64 + fr;
#pragma unroll
        for (int ai = 0; ai < 2; ++ai)
#pragma unroll
            for (int m = 0; m < 4; ++m) { const float r = t[ai * HALF + m * 16].x;
#pragma unroll
                for (int bj = 0; bj < 2; ++bj)
#pragma unroll
                    for (int n = 0; n < 2; ++n) acc[ai][bj][m][n] *= r; }
    }
    __device__ __forceinline__ void operator()(const f32x4 (&acc)[2][2][4][2], const Unit& u, int wr, int wc, int fr, int fq) const {
        const LAS f32x2* t = rtab + slot(u) * 256 + wr * 64 + fr;
        const int row0 = u.pm * 256 + wr * 64 + fr, col0 = u.pn * 256 + wc * 32 + 8 * fq;
#pragma unroll
        for (int ai = 0; ai < 2; ++ai) { v4u xv[4][2]; float sg[4];
#pragma unroll
            for (int m = 0; m < 4; ++m) { const size_t off = (size_t)(row0 + ai * HALF + m * 16) * DM + col0; sg[m] = sig0[row0 + ai * HALF + m * 16];
                xv[m][0] = *(const v4u*)(xn + off); xv[m][1] = *(const v4u*)(xn + off + HALF); }
#pragma unroll
            for (int m = 0; m < 4; ++m) { const int ro = ai * HALF + m * 16; const float rg = t[ro].y, sx = sg[m]; const size_t off = (size_t)(row0 + ro) * DM + col0; float q = 0.f;
#pragma unroll
                for (int bj = 0; bj < 2; ++bj) { const v4u xw = xv[m][bj];
                    const f32x4 x0 = {bflo(xw.x), bfhi(xw.x), bflo(xw.y), bfhi(xw.y)}, x1_ = {bflo(xw.z), bfhi(xw.z), bflo(xw.w), bfhi(xw.w)};
                    const f32x4 o0 = x0 * sx + acc[ai][bj][m][0] * rg, o1 = x1_ * sx + acc[ai][bj][m][1] * rg;
                    q += (o0[0] * o0[0] + o0[1] * o0[1]) + (o0[2] * o0[2] + o0[3] * o0[3]) + (o1[0] * o1[0] + o1[1] * o1[1]) + (o1[2] * o1[2] + o1[3] * o1[3]);
                    v4u w; w.x = cvt_pk_bf16(o0[0], o0[1]); w.y = cvt_pk_bf16(o0[2], o0[3]); w.z = cvt_pk_bf16(o1[0], o1[1]); w.w = cvt_pk_bf16(o1[2], o1[3]);
                    *(v4u*)(x1 + off + bj * HALF) = w;
                    v2u w8; w8.x = pk4_fp8(o0[0], o0[1], o0[2], o0[3]); w8.y = pk4_fp8(o1[0], o1[1], o1[2], o1[3]); *(v2u*)(x1f8 + off + bj * HALF) = w8; }
                q += __shfl_xor(q, 16); q += __shfl_xor(q, 32);
                if (fq == 0) ssq1[(size_t)(row0 + ro) * 16 + u.pn * 4 + wc] = q; }
            asm volatile("" ::: "memory"); }
    }
};
struct EpiMoe1 {
    static constexpr bool PERM = true;
    unsigned char* A; const float* b_gu; const float* rss;
    __device__ __forceinline__ void operator()(const f32x4 (&acc)[2][2][4][2], const Unit& u, int wr, int wc, int fr, int fq) const {
        const int row0 = u.pm * 256 + wr * 64 + fr, col = u.pn * 128 + wc * 32 + 8 * fq;
        const float* bg = b_gu + (size_t)u.e * 2 * FF + col; const float* rs_ = rss + (size_t)u.e * T + u.rt * 256 + wr * 64 + fr;
        float rsv[2][4];
#pragma unroll
        for (int ai = 0; ai < 2; ++ai)
#pragma unroll
            for (int m = 0; m < 4; ++m) rsv[ai][m] = rs_[ai * HALF + m * 16];
        f32x4 bgv[2], blv[2];
#pragma unroll
        for (int n = 0; n < 2; ++n) { bgv[n] = *(const f32x4*)(bg + 4 * n); blv[n] = *(const f32x4*)(bg + FF + 4 * n); }
#pragma unroll
        for (int ai = 0; ai < 2; ++ai)
#pragma unroll
            for (int m = 0; m < 4; ++m) { f32x4 a[2];
#pragma unroll
                for (int n = 0; n < 2; ++n) { const f32x4 g = acc[ai][0][m][n] * rsv[ai][m] + bgv[n], l = acc[ai][1][m][n] * rsv[ai][m] + blv[n];
#pragma unroll
                    for (int p = 0; p < 2; ++p) { f32x2 gc = {fminf(g[2 * p], 7.0f), fminf(g[2 * p + 1], 7.0f)}; f32x2 lc = {fminf(fmaxf(l[2 * p], -7.0f), 7.0f), fminf(fmaxf(l[2 * p + 1], -7.0f), 7.0f)};
                        const f32x2 z = gc * (-1.702f * 1.4426950408889634f); f32x2 e; e.x = __builtin_amdgcn_exp2f(z.x); e.y = __builtin_amdgcn_exp2f(z.y);
                        const f32x2 d = e + 1.0f; f32x2 r; r.x = __builtin_amdgcn_rcpf(d.x); r.y = __builtin_amdgcn_rcpf(d.y);
                        const f32x2 o = (gc * r) * (lc + 1.0f); a[n][2 * p] = o.x; a[n][2 * p + 1] = o.y; } }
                v2u w; w.x = pk4_fp8(a[0][0], a[0][1], a[0][2], a[0][3]); w.y = pk4_fp8(a[1][0], a[1][1], a[1][2], a[1][3]);
                *(v2u*)(A + (size_t)(row0 + ai * HALF + m * 16) * FF + col) = w; }
    }
};
constexpr float Y_SCALE = 16.0f;
struct EpiMoe2 {
    static constexpr bool PERM = true;
    unsigned char* Y; const float* b_dn; const float* gss;
    __device__ __forceinline__ void operator()(const f32x4 (&acc)[2][2][4][2], const Unit& u, int wr, int wc, int fr, int fq) const {
        const int row0 = u.pm * 256 + wr * 64 + fr, col0 = u.pn * 256 + wc * 32 + 8 * fq;
        const float* gs = gss + (size_t)u.e * T + u.rt * 256 + wr * 64 + fr;
        f32x4 bv[2][2]; float gv[2][4];
#pragma unroll
        for (int bj = 0; bj < 2; ++bj)
#pragma unroll
            for (int n = 0; n < 2; ++n) bv[bj][n] = *(const f32x4*)(b_dn + (size_t)u.e * DM + col0 + bj * HALF + 4 * n);
#pragma unroll
        for (int ai = 0; ai < 2; ++ai)
#pragma unroll
            for (int m = 0; m < 4; ++m) gv[ai][m] = gs[ai * HALF + m * 16] * Y_SCALE;
#pragma unroll
        for (int ai = 0; ai < 2; ++ai)
#pragma unroll
            for (int m = 0; m < 4; ++m) { const float g = gv[ai][m]; unsigned char* rowp = Y + (size_t)(row0 + ai * HALF + m * 16) * DM + col0;
#pragma unroll
                for (int bj = 0; bj < 2; ++bj) { const f32x4 v0 = (acc[ai][bj][m][0] + bv[bj][0]) * g, v1 = (acc[ai][bj][m][1] + bv[bj][1]) * g;
                    v2u w; w.x = pk4_fp8(v0[0], v0[1], v0[2], v0[3]); w.y = pk4_fp8(v1[0], v1[1], v1[2], v1[3]);
                    *(v2u*)(rowp + bj * HALF) = w; } }
    }
};
constexpr float GATE_SCALE = 128.0f;
template <int MODE> struct EpiPle {
    static constexpr bool PERM = true;
    unsigned char* O; float* ssq;
    __device__ __forceinline__ void operator()(const f32x4 (&acc)[2][2][4][2], const Unit& u, int wr, int wc, int fr, int fq) const {
        const int row0 = u.pm * 256 + wr * 64 + fr, col0 = u.pn * 256 + wc * 32 + 8 * fq;
        float rsv[2][4];
#pragma unroll
        for (int ai = 0; ai < 2; ++ai)
#pragma unroll
            for (int m = 0; m < 4; ++m) rsv[ai][m] = (MODE == 0) ? ssq[row0 + ai * HALF + m * 16] : 1.0f;
#pragma unroll
        for (int ai = 0; ai < 2; ++ai)
#pragma unroll
            for (int m = 0; m < 4; ++m) { unsigned char* rowp = O + (size_t)(row0 + ai * HALF + m * 16) * DM + col0; float q = 0.f; const float rs = rsv[ai][m];
#pragma unroll
                for (int bj = 0; bj < 2; ++bj) { f32x4 v0 = acc[ai][bj][m][0], v1 = acc[ai][bj][m][1];
                    if (MODE == 0) {
#pragma unroll
                        for (int j = 0; j < 4; ++j) { v0[j] = GATE_SCALE * sigmoidf_fast(rs * v0[j]); v1[j] = GATE_SCALE * sigmoidf_fast(rs * v1[j]); } }
                    else { q += (v0[0] * v0[0] + v0[1] * v0[1]) + (v0[2] * v0[2] + v0[3] * v0[3]) + (v1[0] * v1[0] + v1[1] * v1[1]) + (v1[2] * v1[2] + v1[3] * v1[3]); }
                    v2u w; w.x = pk4_fp8(v0[0], v0[1], v0[2], v0[3]); w.y = pk4_fp8(v1[0], v1[1], v1[2], v1[3]);
                    *(v2u*)(rowp + bj * HALF) = w; }
                if (MODE == 1) { q += __shfl_xor(q, 16); q += __shfl_xor(q, 32); if (fq == 0) ssq[(size_t)(row0 + ai * HALF + m * 16) * 16 + u.pn * 4 + wc] = q; } }
    }
};

namespace att {
constexpr int QBLK = 32, KVBLK = 64;
constexpr float SCALE = 0.125f, THR = 8.f;
constexpr int SHM_V = KVBLK * HD * 2, SHM_K = SHM_V;
constexpr int NSLOT = 3;
constexpr int LDS_BYTES_ = NSLOT * SHM_V + NSLOT * SHM_K + NWAVES * 64 * 4;
#define ATT_KSWZ(row, colB) ((row) * 128 + ((colB) ^ (((row) & 7) << 4)))
#define ATT_SBAR() __builtin_amdgcn_sched_barrier(0)
__device__ __forceinline__ int crow(int r, int hi) { return (r & 3) + 8 * (r >> 2) + 4 * hi; }
__device__ __forceinline__ void cmask(f32x16& p0, f32x16& p1, int jb, int qrel, int hi) {
    const float NEG = -__builtin_inff(); const int kb = 64 * jb + 4 * hi;
#pragma unroll
    for (int r = 0; r < 16; ++r) { const int kv = kb + (r & 3) + 8 * (r >> 2); if (kv > qrel) p0[r] = NEG; if (kv + 32 > qrel) p1[r] = NEG; }
}
__device__ __forceinline__ void bmask(f32x16& p0, f32x16& p1, bool keep) {
    const float NEG = -__builtin_inff();
    if (!keep) {
#pragma unroll
        for (int r = 0; r < 16; ++r) { p0[r] = NEG; p1[r] = NEG; } }
}
__device__ __forceinline__ void partialSM(f32x16& p0, f32x16& p1, float& m_reg, float& mn, float& alpha, bool keep) {
    float pmax = p0[0];
#pragma unroll
    for (int r = 1; r < 16; ++r) pmax = fmaxf(pmax, p0[r]);
#pragma unroll
    for (int r = 0; r < 16; ++r) pmax = fmaxf(pmax, p1[r]);
    { auto rr = __builtin_amdgcn_permlane32_swap(__float_as_uint(pmax), __float_as_uint(pmax), false, false);
      pmax = fmaxf(__uint_as_float(rr[0]), __uint_as_float(rr[1])); }
    if (!keep) pmax = -__builtin_inff();
    constexpr float C2 = 1.4426950408889634f * SCALE;
    if (__builtin_expect(__all((pmax - m_reg) * SCALE <= THR), 1)) { mn = m_reg; alpha = 1.f; }
    else { mn = fmaxf(m_reg, pmax); alpha = __builtin_amdgcn_exp2f((m_reg - mn) * C2); m_reg = mn; }
    const float mnL = keep ? -mn * C2 : -__builtin_inff(), c2 = keep ? C2 : 0.f;
#pragma unroll
    for (int r = 0; r < 16; ++r) p0[r] = fmaf(p0[r], c2, mnL);
#pragma unroll
    for (int r = 0; r < 16; ++r) p1[r] = fmaf(p1[r], c2, mnL);
#pragma unroll
    for (int r = 0; r < 16; ++r) p0[r] = __builtin_amdgcn_exp2f(p0[r]);
}
__device__ __forceinline__ void finishSM(f32x16& p0, f32x16& p1, float alpha, float& l_reg, bf16x8& pa0, bf16x8& pa1, bf16x8& pa2, bf16x8& pa3) {
#pragma unroll
    for (int r = 0; r < 16; ++r) p1[r] = __builtin_amdgcn_exp2f(p1[r]);
    float ps = 0;
#pragma unroll
    for (int r = 0; r < 16; ++r) ps += p0[r];
#pragma unroll
    for (int r = 0; r < 16; ++r) ps += p1[r];
    { auto rr = __builtin_amdgcn_permlane32_swap(__float_as_uint(ps), __float_as_uint(ps), false, false);
      ps = __uint_as_float(rr[0]) + __uint_as_float(rr[1]); }
    l_reg = l_reg * alpha + ps;
#define ATT_PK4(P, B, OUT) do { unsigned a0 = cvt_pk_bf16(P[B+0], P[B+1]), a1 = cvt_pk_bf16(P[B+2], P[B+3]);             \
        unsigned b0 = cvt_pk_bf16(P[B+4], P[B+5]), b1 = cvt_pk_bf16(P[B+6], P[B+7]);                                       \
        auto r0 = __builtin_amdgcn_permlane32_swap(a0, b0, false, false); auto r1 = __builtin_amdgcn_permlane32_swap(a1, b1, false, false); \
        v4u w = {r0[0], r1[0], r0[1], r1[1]}; OUT = *reinterpret_cast<bf16x8*>(&w); } while (0)
    ATT_PK4(p0, 0, pa0); ATT_PK4(p0, 8, pa1); ATT_PK4(p1, 0, pa2); ATT_PK4(p1, 8, pa3);
#undef ATT_PK4
}
__device__ __forceinline__ void qkt(f32x16& p0, f32x16& p1, const LAS unsigned char* Ks, const bf16x8* qr, int r32, int hi) {
    p0 = f32x16{}; p1 = f32x16{};
#pragma unroll
    for (int d0 = 0; d0 < 4; ++d0) { const int cb = (d0 * 16 + hi * 8) * 2;
        const bf16x8 b0 = *(const LAS bf16x8*)(Ks + ATT_KSWZ(r32, cb));
        const bf16x8 b1 = *(const LAS bf16x8*)(Ks + ATT_KSWZ(32 + r32, cb));
        p0 = __builtin_amdgcn_mfma_f32_32x32x16_bf16(b0, qr[d0], p0, 0, 0, 0);
        p1 = __builtin_amdgcn_mfma_f32_32x32x16_bf16(b1, qr[d0], p1, 0, 0, 0); }
}
__device__ __forceinline__ void pv(f32x16* o, int vb, bf16x8 pa0, bf16x8 pa1, bf16x8 pa2, bf16x8 pa3) {
#pragma unroll
    for (int d0 = 0; d0 < 2; ++d0) { s16x4 lo[4], hi[4];
#pragma unroll
        for (int ks = 0; ks < 4; ++ks) { const int a = vb + d0 * 2048 + (ks >> 1) * 4096 + (ks & 1) * 512;
            asm volatile("ds_read_b64_tr_b16 %0,%1" : "=&v"(lo[ks]) : "v"(a) : "memory");
            asm volatile("ds_read_b64_tr_b16 %0,%1 offset:128" : "=&v"(hi[ks]) : "v"(a) : "memory"); }
        asm volatile("s_waitcnt lgkmcnt(0)" ::: "memory"); ATT_SBAR();
#define ATT_PK(k) (bf16x8){lo[k][0], lo[k][1], lo[k][2], lo[k][3], hi[k][0], hi[k][1], hi[k][2], hi[k][3]}
        o[d0] = __builtin_amdgcn_mfma_f32_32x32x16_bf16(pa0, ATT_PK(0), o[d0], 0, 0, 0);
        o[d0] = __builtin_amdgcn_mfma_f32_32x32x16_bf16(pa1, ATT_PK(1), o[d0], 0, 0, 0);
        o[d0] = __builtin_amdgcn_mfma_f32_32x32x16_bf16(pa2, ATT_PK(2), o[d0], 0, 0, 0);
        o[d0] = __builtin_amdgcn_mfma_f32_32x32x16_bf16(pa3, ATT_PK(3), o[d0], 0, 0, 0);
#undef ATT_PK
    }
}
__device__ __forceinline__ void attn_unit(const Frame& F, int b, int h, int qb, LAS unsigned char* scratch) {
    PHASE_IDS;
    const int tid = TID_, wid = tid >> 6, lane = tid & 63, r32 = lane & 31, hi = lane >> 5;
    const bf16* Qg = wsp<bf16>(F, WS_Q); const bf16* Kg = wsp<bf16>(F, WS_K); const bf16* Vg = wsp<bf16>(F, WS_V);
    const size_t rowbase = (size_t)b * SEQ; const int q0 = qb * MOBA;
    const bf16* Qw = Qg + (rowbase + q0 + wid * QBLK) * AW + h * HD;
    const bf16* Kh = Kg + rowbase * AW + h * HD; const bf16* Vh = Vg + rowbase * AW + h * HD;
    LAS unsigned char* V_lds = scratch; LAS unsigned char* K_lds = scratch + NSLOT * SHM_V;
    LAS float* wsf = (LAS float*)(scratch + NSLOT * SHM_V + NSLOT * SHM_K) + wid * 64; LAS float* li_l = wsf; LAS float* al_l = wsf + 32;
    float m_reg = -1e30f, l_reg = 0.f; f32x16 o[2]; o[0] = f32x16{}; o[1] = f32x16{}; bf16x8 qr[4];
#pragma unroll
    for (int d0 = 0; d0 < 4; ++d0) qr[d0] = *(const bf16x8*)(Qw + (size_t)r32 * AW + d0 * 16 + hi * 8);
    unsigned sel = 0u;
    if (qb <= 3) sel = (1u << qb) - 1u;
    else {
        const float* km = wsp<float>(F, WS_KMEAN) + (size_t)((b * NH + h) * NBLK) * HD + (size_t)(r32 & 7) * HD + hi * 8;
        f32x4 kv[4][2];
#pragma unroll
        for (int d0 = 0; d0 < 4; ++d0) { kv[d0][0] = *(const f32x4*)(km + d0 * 16); kv[d0][1] = *(const f32x4*)(km + d0 * 16 + 4); }
        f32x16 gacc = f32x16{};
#pragma unroll
        for (int d0 = 0; d0 < 4; ++d0) { float f[8] = {kv[d0][0][0], kv[d0][0][1], kv[d0][0][2], kv[d0][0][3], kv[d0][1][0], kv[d0][1][1], kv[d0][1][2], kv[d0][1][3]};
            unsigned hw[4], lw[4];
#pragma unroll
            for (int p = 0; p < 4; ++p) { float a0 = f[2 * p], a1 = f[2 * p + 1]; if (r32 >= 8) { a0 = 0.f; a1 = 0.f; }
                const unsigned h0 = f2bf(a0), h1 = f2bf(a1); hw[p] = h0 | (h1 << 16); lw[p] = pk2(a0 - bf2f((bf16)h0), a1 - bf2f((bf16)h1)); }
            const v4u hv = {hw[0], hw[1], hw[2], hw[3]}, lv = {lw[0], lw[1], lw[2], lw[3]};
            gacc = __builtin_amdgcn_mfma_f32_32x32x16_bf16(__builtin_bit_cast(bf16x8, hv), qr[d0], gacc, 0, 0, 0);
            gacc = __builtin_amdgcn_mfma_f32_32x32x16_bf16(__builtin_bit_cast(bf16x8, lv), qr[d0], gacc, 0, 0, 0); }
        float g[8];
#pragma unroll
        for (int r = 0; r < 4; ++r) { const float mine = gacc[r], other = __shfl_xor(mine, 32); g[r] = hi ? other : mine; g[4 + r] = hi ? mine : other; }
        float b0 = -__builtin_inff(), b1 = b0, b2 = b0; int i0 = 0, i1 = 0, i2 = 0;
#pragma unroll
        for (int j = 0; j < NBLK - 1; ++j) { const float s_ = (j < qb) ? g[j] : -__builtin_inff();
            if (s_ > b0) { b2 = b1; i2 = i1; b1 = b0; i1 = i0; b0 = s_; i0 = j; } else if (s_ > b1) { b2 = b1; i2 = i1; b1 = s_; i1 = j; } else if (s_ > b2) { b2 = s_; i2 = j; } }
        sel = (1u << i0) | (1u << i1) | (1u << i2);
    }
    const int sr = tid >> 3, sc = (tid & 7) * 8;
    const int vst = 2 * ((sr >> 5) * 2048 + (sc >> 4) * 512 + (sr & 31) * 16 + (sc & 8));
    const int vb0 = (int)(size_t)V_lds + (lane & 15) * 8 + ((lane >> 4) & 1) * 1024 + (lane >> 5) * 256;
    bf16x8 st_v, st_k;
#define ATT_SLOAD(k0) do { const size_t rr_ = (size_t)((k0) + sr) * AW + sc; st_v = *(const bf16x8*)(Vh + rr_); st_k = *(const bf16x8*)(Kh + rr_); } while (0)
#define ATT_SWRITE(bf) do { *(LAS bf16x8*)(V_lds + (bf) * SHM_V + vst) = st_v; *(LAS bf16x8*)(K_lds + (bf) * SHM_K + ATT_KSWZ(sr, sc * 2)) = st_k; } while (0)
#define ATT_RESC(a) do { if (__any((a) < 1.f)) { if (hi == 0) al_l[r32] = (a); asm volatile("s_waitcnt lgkmcnt(0)" ::: "memory");      \
        _Pragma("unroll") for (int d_ = 0; d_ < 2; ++d_) _Pragma("unroll") for (int r = 0; r < 16; ++r) o[d_][r] *= al_l[crow(r, hi)]; } } while (0)
    const int NT = (q0 + MOBA) / KVBLK;
    const int qrel = wid * QBLK + r32;
#define ATT_MASK(P0, P1, t) do { const int jb_ = (t) - (NT - 4); if (jb_ >= 0) cmask(P0, P1, jb_, qrel, hi); } while (0)
#define ATT_KEEP(t) ((((t) >= NT - 4) ? 1u : ((sel >> ((t) >> 2)) & 1u)) != 0u)
    f32x16 pA0, pA1, pB0, pB1; float mnA, mnB, alA, alB; bf16x8 pa0, pa1, pa2, pa3;
    int s0 = 0, s1 = 1, s2 = 2;
#define ATT_ROT() do { const int t_ = s0; s0 = s1; s1 = s2; s2 = t_; } while (0)
    ATT_SLOAD(0); asm volatile("s_waitcnt vmcnt(0)" ::: "memory"); ATT_SWRITE(0); ATT_SLOAD(KVBLK);
    s0 = 2; s1 = 0; s2 = 1;
    __syncthreads();
    asm volatile("s_waitcnt vmcnt(0)" ::: "memory"); ATT_SWRITE(s2); ATT_SLOAD(2 * KVBLK);
    qkt(pA0, pA1, K_lds + s1 * SHM_K, qr, r32, hi); ATT_MASK(pA0, pA1, 0); partialSM(pA0, pA1, m_reg, mnA, alA, ATT_KEEP(0));
    ATT_ROT();
    for (int j = 1; j < NT; j += 2) {
        __syncthreads();
        if (j + 1 < NT) { asm volatile("s_waitcnt vmcnt(0)" ::: "memory"); ATT_SWRITE(s2); if (j + 2 < NT) ATT_SLOAD((j + 2) * KVBLK); }
        ATT_SBAR(); qkt(pB0, pB1, K_lds + s1 * SHM_K, qr, r32, hi); ATT_MASK(pB0, pB1, j);
        finishSM(pA0, pA1, alA, l_reg, pa0, pa1, pa2, pa3); ATT_SBAR();
        pv(o, vb0 + s0 * SHM_V, pa0, pa1, pa2, pa3); partialSM(pB0, pB1, m_reg, mnB, alB, ATT_KEEP(j));
        ATT_RESC(alB); ATT_ROT();
        if (j + 1 < NT) {
            __syncthreads();
            if (j + 2 < NT) { asm volatile("s_waitcnt vmcnt(0)" ::: "memory"); ATT_SWRITE(s2); if (j + 3 < NT) ATT_SLOAD((j + 3) * KVBLK); }
            ATT_SBAR(); qkt(pA0, pA1, K_lds + s1 * SHM_K, qr, r32, hi); ATT_MASK(pA0, pA1, j + 1);
            finishSM(pB0, pB1, alB, l_reg, pa0, pa1, pa2, pa3); ATT_SBAR();
            pv(o, vb0 + s0 * SHM_V, pa0, pa1, pa2, pa3); partialSM(pA0, pA1, m_reg, mnA, alA, ATT_KEEP(j + 1));
            ATT_RESC(alA); ATT_ROT();
        }
    }
    finishSM(pB0, pB1, alB, l_reg, pa0, pa1, pa2, pa3); ATT_SBAR();
    pv(o, vb0 + s0 * SHM_V, pa0, pa1, pa2, pa3);
#undef ATT_ROT
    if (hi == 0) li_l[r32] = l_reg; asm volatile("s_waitcnt lgkmcnt(0)" ::: "memory");
    float rli[16];
#pragma unroll
    for (int r = 0; r < 16; ++r) rli[r] = __builtin_amdgcn_rcpf(li_l[crow(r, hi)]);
    bf16* Ow = wsp<bf16>(F, WS_MIX) + (rowbase + q0 + wid * QBLK) * DM + h * HD;
    float* ssqa = wsp<float>(F, WS_SSQA) + (rowbase + q0 + wid * QBLK) * NH + h;
    float qq[16];
#pragma unroll
    for (int r = 0; r < 16; ++r) { const int orow = crow(r, hi); float q2 = 0.f;
#pragma unroll
        for (int d0 = 0; d0 < 2; ++d0) { const float v = o[d0][r] * rli[r]; const float vn = __shfl_xor(v, 1); q2 += v * v;
            if ((r32 & 1) == 0) *(unsigned*)(Ow + (size_t)orow * DM + d0 * 32 + r32) = cvt_pk_bf16(v, vn); }
        qq[r] = q2; }
#pragma unroll
    for (int i = 0; i < 8; ++i) { const bool up = (lane & 16) != 0; const float send = up ? qq[i] : qq[i + 8], keep = up ? qq[i + 8] : qq[i]; qq[i] = keep + __shfl_xor(send, 16); }
#pragma unroll
    for (int i = 0; i < 4; ++i) { const bool up = (lane & 8) != 0; const float send = up ? qq[i] : qq[i + 4], keep = up ? qq[i + 4] : qq[i]; qq[i] = keep + __shfl_xor(send, 8); }
#pragma unroll
    for (int i = 0; i < 2; ++i) { const bool up = (lane & 4) != 0; const float send = up ? qq[i] : qq[i + 2], keep = up ? qq[i + 2] : qq[i]; qq[i] = keep + __shfl_xor(send, 4); }
    { const bool up = (lane & 2) != 0; const float send = up ? qq[0] : qq[1], keep = up ? qq[1] : qq[0]; qq[0] = keep + __shfl_xor(send, 2); }
    qq[0] += __shfl_xor(qq[0], 1);
    if ((lane & 1) == 0) ssqa[(size_t)crow(r32 >> 1, hi) * NH] = qq[0];
    __syncthreads();
#undef ATT_SLOAD
#undef ATT_SWRITE
#undef ATT_RESC
#undef ATT_MASK
#undef ATT_KEEP
}
}

namespace gm {
__device__ __forceinline__ int vt_off(int d, int s) { return d * 256 + ((((s >> 3) ^ (d & 15)) & 15) << 4) + (s & 7) * 2; }
__device__ __forceinline__ void units4(const Frame& F, int v, LAS unsigned char* scratch) {
    PHASE_IDS;
    const int tid = TID_, wid = tid >> 6, lane = tid & 63, fr = lane & 15, fq = lane >> 4;
    const int u = wid >> 1, half = wid & 1, uidx = 4 * v + u, b = uidx >> 6, c = (uidx >> 2) & 15, g = uidx & 3;
    const size_t row0 = (size_t)b * SEQ + c * GC;
    const bf16* VGg = wsp<bf16>(F, WS_VG) + row0 * GW + g * GD; const bf16* Ug = wsp<bf16>(F, WS_U) + row0 * GW + g * GD;
    LAS unsigned char* vt = scratch + u * 32768;
    { const int s_ = half * 64 + lane; const v4u* src = (const v4u*)(VGg + (size_t)s_ * GW); v4u raw[16]; float sum = 0.f, sq = 0.f;
#pragma unroll
      for (int i = 0; i < 16; ++i) raw[i] = src[i];
#pragma unroll
      for (int i = 0; i < 16; ++i) { const unsigned ww[4] = {raw[i].x, raw[i].y, raw[i].z, raw[i].w};
#pragma unroll
          for (int k = 0; k < 4; ++k) { const float a0 = bflo(ww[k]), a1 = bfhi(ww[k]); sum += a0 + a1; sq += a0 * a0 + a1 * a1; } }
      const float mu = sum * (1.f / GD); const float var = fmaxf(sq * (1.f / GD) - mu * mu, 0.f); const float rstd = 1.0f / sqrtf(var + EPS);
      const float* lg = F.ln_g + g * GD; const float* lb = F.ln_b + g * GD;
#pragma unroll
      for (int i = 0; i < 16; ++i) { const unsigned ww[4] = {raw[i].x, raw[i].y, raw[i].z, raw[i].w}; const f32x4 g0 = *(const f32x4*)(lg + 8 * i), g1 = *(const f32x4*)(lg + 8 * i + 4), b0 = *(const f32x4*)(lb + 8 * i), b1 = *(const f32x4*)(lb + 8 * i + 4);
          const float gg[8] = {g0[0], g0[1], g0[2], g0[3], g1[0], g1[1], g1[2], g1[3]}, bb[8] = {b0[0], b0[1], b0[2], b0[3], b1[0], b1[1], b1[2], b1[3]};
#pragma unroll
          for (int k = 0; k < 4; ++k) { const int d = 8 * i + 2 * k;
              *(LAS unsigned short*)(vt + vt_off(d, s_)) = (unsigned short)f2bf((bflo(ww[k]) - mu) * rstd * gg[2 * k] + bb[2 * k]);
              *(LAS unsigned short*)(vt + vt_off(d + 1, s_)) = (unsigned short)f2bf((bfhi(ww[k]) - mu) * rstd * gg[2 * k + 1] + bb[2 * k + 1]); } } }
    __syncthreads();
#pragma unroll 1
    for (int m = 0; m < 4; ++m) {
        const int tb = half * 64 + m * 16, t = tb + fr;
        const float* Wg = F.gws + (size_t)g * GC * GC + (size_t)t * GC;
        const int nks = (tb + 16 + 31) / 32;
        f32x4 w0[4], w1[4];
#pragma unroll
        for (int ks = 0; ks < 4; ++ks) if (ks < nks) { w0[ks] = *(const f32x4*)(Wg + ks * 32 + fq * 8); w1[ks] = *(const f32x4*)(Wg + ks * 32 + fq * 8 + 4); }
        const bf16* Ut = Ug + (size_t)t * GW + 4 * fq; v2u uu[8];
#pragma unroll
        for (int n = 0; n < 8; ++n) uu[n] = *(const v2u*)(Ut + n * 16);
        f32x4 acc[8];
#pragma unroll
        for (int n = 0; n < 8; ++n) acc[n] = (f32x4){0.f, 0.f, 0.f, 0.f};
#pragma unroll
        for (int ks = 0; ks < 4; ++ks) if (ks < nks) { const int s0 = ks * 32 + fq * 8;
            float wv[8] = {w0[ks][0], w0[ks][1], w0[ks][2], w0[ks][3], w1[ks][0], w1[ks][1], w1[ks][2], w1[ks][3]};
#pragma unroll
            for (int j = 0; j < 8; ++j) if (s0 + j > t) wv[j] = 0.f;
            v4u aw; aw.x = pk2(wv[0], wv[1]); aw.y = pk2(wv[2], wv[3]); aw.z = pk2(wv[4], wv[5]); aw.w = pk2(wv[6], wv[7]);
            const bf16x8 wf = *reinterpret_cast<const bf16x8*>(&aw);
#pragma unroll
            for (int n = 0; n < 8; ++n) { const bf16x8 vf = *(const LAS bf16x8*)(vt + vt_off(n * 16 + fr, s0));
                acc[n] = __builtin_amdgcn_mfma_f32_16x16x32_bf16(vf, wf, acc[n], 0, 0, 0); } }
        bf16* Og = wsp<bf16>(F, WS_MIX) + (row0 + t) * DM + AW + g * GD + 4 * fq; float* ssqg = wsp<float>(F, WS_SSQG) + (row0 + t) * GG + g;
        const float bs = F.gbs[g * GC + t]; float q2 = 0.f;
#pragma unroll
        for (int n = 0; n < 8; ++n) { const float o0 = bflo(uu[n].x) * (acc[n][0] + bs), o1 = bfhi(uu[n].x) * (acc[n][1] + bs), o2 = bflo(uu[n].y) * (acc[n][2] + bs), o3 = bfhi(uu[n].y) * (acc[n][3] + bs);
            q2 += (o0 * o0 + o1 * o1) + (o2 * o2 + o3 * o3); v2u w; w.x = cvt_pk_bf16(o0, o1); w.y = cvt_pk_bf16(o2, o3); *(v2u*)(Og + n * 16) = w; }
        q2 += __shfl_xor(q2, 16); q2 += __shfl_xor(q2, 32);
        if (fq == 0) ssqg[0] = q2;
    }
    __syncthreads();
}
}

__device__ __forceinline__ void p2_mixers(const Frame& F) {
    LAS unsigned char* scratch = F.lds + RING_OFF;
    const int v = F.vcu;
    { const int bh = v >> 1, s0 = (v & 1) * 2;
#pragma unroll 1
      for (int i = 0; i < 4; ++i) { const int qq = s0 + (i >> 1); const int qb = (i & 1) ? 7 - qq : qq; att::attn_unit(F, bh / NH, bh % NH, qb, scratch); } }
    if (TPROBE && blockIdx.x == 0 && threadIdx.x == 0) ((unsigned long long*)(F.ctl + CW_TS))[14] = __builtin_amdgcn_s_memrealtime();
    gm::units4(F, v, scratch);
}

__device__ __forceinline__ void p4_router(const Frame& F) {
    PHASE_IDS;
    const int tid = TID_, wid = tid >> 6, lane = tid & 63, tk = lane & 31, hf = lane >> 5;
    LAS unsigned* hist = (LAS unsigned*)(F.lds + XTAB_OFF);
    LAS unsigned* base = hist + 32;
    const bf16* RWT = wsp<bf16>(F, WS_RWT); const bf16* x1 = wsp<bf16>(F, WS_X1B); const float* ssq1 = wsp<float>(F, WS_SSQ1);
    unsigned* cntg = (unsigned*)(F.ctl + CW_CNT);
    unsigned* IDX = wsp<unsigned>(F, WS_IDX); float* GSS = wsp<float>(F, WS_GSS); float* RSS = wsp<float>(F, WS_RSS); unsigned* TOKPOS = wsp<unsigned>(F, WS_TOKPOS);
    if (tid < 32) hist[tid] = 0u;
    __syncthreads();
    const int unit = F.vcu * 4 + (wid & 3), kh = wid >> 2; const int tok = unit * 32 + tk;
    LAS float* xch = (LAS float*)(F.lds + RING_OFF) + (wid & 3) * 64 * 16;
    float rstd; { const f32x4* sp = (const f32x4*)(ssq1 + (size_t)tok * 16); const f32x4 a = sp[0], b = sp[1], c = sp[2], d = sp[3];
        const float s_ = ((a[0] + a[1]) + (a[2] + a[3])) + ((b[0] + b[1]) + (b[2] + b[3])) + ((c[0] + c[1]) + (c[2] + c[3])) + ((d[0] + d[1]) + (d[2] + d[3]));
        rstd = 1.0f / sqrtf(s_ * (1.f / DM) + EPS); }
    f32x16 acc = f32x16{};
    { const bf16* xr = x1 + (size_t)tok * DM + kh * 512 + 8 * hf; const bf16* wh = RWT + (size_t)tk * DM + kh * 512 + 8 * hf; const bf16* wl = wh + NE * DM;
#pragma unroll 8
      for (int s_ = 0; s_ < 32; ++s_) { const bf16x8 xv = *(const bf16x8*)(xr + 16 * s_), a_hi = *(const bf16x8*)(wh + 16 * s_), a_lo = *(const bf16x8*)(wl + 16 * s_);
          acc = __builtin_amdgcn_mfma_f32_32x32x16_bf16(a_hi, xv, acc, 0, 0, 0); acc = __builtin_amdgcn_mfma_f32_32x32x16_bf16(a_lo, xv, acc, 0, 0, 0); } }
    if (kh == 1) {
#pragma unroll
        for (int r = 0; r < 16; ++r) xch[lane * 16 + r] = acc[r]; }
    __syncthreads();
    const bool active = kh == 0;
    int pe[4] = {0, 0, 0, 0}; float pg[4] = {0.f, 0.f, 0.f, 0.f}; unsigned rank[2] = {0u, 0u}; int my_e[2] = {0, 0}; float my_g[2] = {0.f, 0.f};
    if (active) {
        float lv[16];
#pragma unroll
        for (int r = 0; r < 16; ++r) { const int e = (r & 3) + 8 * (r >> 2) + 4 * hf; lv[r] = (acc[r] + xch[lane * 16 + r]) * rstd + F.router_b[e]; }
        float tv[4]; int ti[4]; unsigned used = 0u;
#pragma unroll
        for (int k = 0; k < 4; ++k) { float best = -__builtin_inff(); int br = 0;
#pragma unroll
            for (int r = 0; r < 16; ++r) { const int e = (r & 3) + 8 * (r >> 2) + 4 * hf; const int eb = (br & 3) + 8 * (br >> 2) + 4 * hf;
                const bool better = !((used >> r) & 1u) && (lv[r] > best || (lv[r] == best && e < eb)); if (better) { best = lv[r]; br = r; } }
            used |= 1u << br; tv[k] = best; ti[k] = (br & 3) + 8 * (br >> 2) + 4 * hf; }
        float ov[4]; int oi[4];
#pragma unroll
        for (int k = 0; k < 4; ++k) { ov[k] = __shfl_xor(tv[k], 32); oi[k] = __shfl_xor(ti[k], 32); }
        int ia = 0, ib = 0;
#pragma unroll
        for (int k = 0; k < 4; ++k) {
            float va = tv[0], vb = ov[0]; int ea = ti[0], eb = oi[0];
#pragma unroll
            for (int q = 1; q < 4; ++q) { if (ia == q) { va = tv[q]; ea = ti[q]; } if (ib == q) { vb = ov[q]; eb = oi[q]; } }
            const bool takeA = (va > vb) || (va == vb && ea < eb);
            pg[k] = takeA ? va : vb; pe[k] = takeA ? ea : eb; if (takeA) ++ia; else ++ib; }
        { const float m = pg[0]; float s_ = 0.f;
#pragma unroll
          for (int k = 0; k < 4; ++k) { pg[k] = __builtin_amdgcn_exp2f((pg[k] - m) * 1.4426950408889634f); s_ += pg[k]; }
          const float inv = 1.0f / s_;
#pragma unroll
          for (int k = 0; k < 4; ++k) pg[k] *= inv; }
        { const int m = -hf; my_e[0] = pe[0] ^ ((pe[0] ^ pe[2]) & m); my_e[1] = pe[1] ^ ((pe[1] ^ pe[3]) & m);
          const unsigned g0 = __float_as_uint(pg[0]), g1 = __float_as_uint(pg[1]), g2 = __float_as_uint(pg[2]), g3 = __float_as_uint(pg[3]);
          my_g[0] = __uint_as_float(g0 ^ ((g0 ^ g2) & (unsigned)m)); my_g[1] = __uint_as_float(g1 ^ ((g1 ^ g3) & (unsigned)m)); }
#pragma unroll
        for (int q = 0; q < 2; ++q) rank[q] = atomicAdd((unsigned*)&hist[my_e[q]], 1u);
    }
    __syncthreads();
    if (tid < 32) base[tid] = atomicAdd(cntg + tid, hist[tid]);
    __syncthreads();
    if (active) {
#pragma unroll
        for (int q = 0; q < 2; ++q) { const int k = 2 * hf + q; const int e = my_e[q]; const float g = my_g[q];
            const unsigned slot = base[e] + rank[q];
            IDX[(size_t)e * T + slot] = (unsigned)tok; GSS[(size_t)e * T + slot] = g; RSS[(size_t)e * T + slot] = rstd; TOKPOS[(size_t)tok * 4 + k] = ((unsigned)e << 16) | slot; }
    }
    __syncthreads();
}

__device__ __forceinline__ void build_tstart(const Frame& F, LAS unsigned* tstart, int tid) {
    if (tid < 64) { const unsigned* cntg = (const unsigned*)(F.ctl + CW_CNT); unsigned c = (tid < NE) ? cntg[tid] : 0u; if (c > (unsigned)T) c = (unsigned)T;
        unsigned x = (c + 255u) >> 8;
#pragma unroll
        for (int o = 1; o < 32; o <<= 1) { const unsigned y = __shfl_up(x, o); if ((tid & 63) >= o) x += y; }
        if (tid < NE) tstart[tid + 1] = x; if (tid == 0) tstart[0] = 0u; }
}
constexpr int MAXU = 18;
constexpr int XT_TSTART = 0, XT_ULIST = 256, XT_GTAB = 512;
static_assert(XT_GTAB + MAXU * 1024 <= LDS_BYTES - XTAB_OFF, "xtab");
__device__ __forceinline__ int moe_build_tables(const Frame& F, int P  , bool gather) {
    PHASE_IDS;
    LAS unsigned* tstart = (LAS unsigned*)(F.lds + XTAB_OFF + XT_TSTART);
    LAS unsigned* ulist = (LAS unsigned*)(F.lds + XTAB_OFF + XT_ULIST);
    LAS unsigned* gtab = (LAS unsigned*)(F.lds + XTAB_OFF + XT_GTAB);
    const unsigned* cntg = (const unsigned*)(F.ctl + CW_CNT); const unsigned* IDX = wsp<unsigned>(F, WS_IDX);
    const int tid = TID_;
    build_tstart(F, tstart, tid);
    __syncthreads();
    const int NT_ = (int)tstart[NE], U = NT_ * P, G = F.G, c = (int)blockIdx.x;
    const int nunits = (c < U) ? (U - c + G - 1) / G : 0;
    if (tid < MAXU && tid < nunits) { const int L = tid * G + c; int gt, pn; pg8::flat_to_tile(L, U, NT_, P, gt, pn);
        int e = 0; for (int k = 1; k < NE; ++k) if ((unsigned)gt >= tstart[k]) e = k;
        const int rt = gt - (int)tstart[e];
        ulist[tid] = (unsigned)gt | ((unsigned)pn << 10) | ((unsigned)e << 13) | ((unsigned)rt << 18); }
    __syncthreads();
    if (gather) {
        unsigned tokv[(MAXU + 1) / 2];
#pragma unroll
        for (int p = 0; p < (MAXU + 1) / 2; ++p) { const int i = 2 * p + (tid >> 8), r = tid & 255; tokv[p] = 0u;
            if (i < nunits && i < MAXU) { const unsigned w = ulist[i]; const int e = (int)((w >> 13) & 0x1fu), rt = (int)(w >> 18);
                unsigned cn = cntg[e]; if (cn > (unsigned)T) cn = (unsigned)T; const unsigned slot = (unsigned)rt * 256u + (unsigned)r;
                if (slot < cn) tokv[p] = IDX[(size_t)e * T + slot]; } }
#pragma unroll
        for (int p = 0; p < (MAXU + 1) / 2; ++p) { const int i = 2 * p + (tid >> 8), r = tid & 255;
            if (i < nunits && i < MAXU) { unsigned tok = tokv[p]; if (tok >= (unsigned)T) tok = 0u; gtab[i * 256 + r] = tok * (unsigned)DM; } }
    }
    __syncthreads();
    return nunits < MAXU ? nunits : MAXU;
}

__device__ __forceinline__ void p7_combine(const Frame& F) {
    PHASE_IDS;
    LAS unsigned* tstart = (LAS unsigned*)(F.lds + XTAB_OFF + XT_TSTART);
    const unsigned* cntg = (const unsigned*)(F.ctl + CW_CNT);
    build_tstart(F, tstart, TID_); (void)cntg;
    __syncthreads();
    const int gw = F.vcu * NWAVES + WAVE_, NGW = F.G * NWAVES;
    const unsigned* TOKPOS = wsp<unsigned>(F, WS_TOKPOS); const unsigned char* Y = wsp<unsigned char>(F, WS_YBUF); const bf16* X1 = wsp<bf16>(F, WS_X1B); bf16* X2 = wsp<bf16>(F, WS_X2B); unsigned char* X28 = wsp<unsigned char>(F, WS_X2F8); float* RS2 = wsp<float>(F, WS_RSTD2);
    for (int m0 = gw; m0 < T; m0 += 2 * NGW) {
        f32x4 v[2][4]; unsigned yv[2][4][4]; float s[2] = {0.f, 0.f};
#pragma unroll
        for (int r = 0; r < 2; ++r) { const int m = m0 + r * NGW;
            const v4u tp = *(const v4u*)(TOKPOS + (size_t)m * 4); const unsigned tpw[4] = {tp.x, tp.y, tp.z, tp.w};
            size_t yrow[4];
#pragma unroll
            for (int k = 0; k < 4; ++k) { const unsigned e = (tpw[k] >> 16) & 31u, slot = tpw[k] & 0xffffu; yrow[k] = ((size_t)tstart[e] * 256u + slot) * DM; }
#pragma unroll
            for (int j = 0; j < 4; ++j) { const v2u xw = *(const v2u*)(X1 + (size_t)m * DM + 4 * LANE_ + 256 * j); v[r][j] = (f32x4){bflo(xw.x), bfhi(xw.x), bflo(xw.y), bfhi(xw.y)};
#pragma unroll
                for (int k = 0; k < 4; ++k) yv[r][j][k] = *(const unsigned*)(Y + yrow[k] + 4 * LANE_ + 256 * j); } }
#pragma unroll
        for (int r = 0; r < 2; ++r) {
#pragma unroll
            for (int j = 0; j < 4; ++j) {
#pragma unroll
                for (int k = 0; k < 4; ++k) { const unsigned w = yv[r][j][k]; const f32x2 lo = __builtin_amdgcn_cvt_pk_f32_fp8((int)w, false), hi2 = __builtin_amdgcn_cvt_pk_f32_fp8((int)w, true);
                    v[r][j][0] += lo[0] * (1.0f / Y_SCALE); v[r][j][1] += lo[1] * (1.0f / Y_SCALE); v[r][j][2] += hi2[0] * (1.0f / Y_SCALE); v[r][j][3] += hi2[1] * (1.0f / Y_SCALE); }
                s[r] += (v[r][j].x * v[r][j].x + v[r][j].y * v[r][j].y) + (v[r][j].z * v[r][j].z + v[r][j].w * v[r][j].w); } }
#pragma unroll
        for (int r = 0; r < 2; ++r) { const int m = m0 + r * NGW; const float rstd = 1.0f / sqrtf(wave_sum(s[r]) * (1.f / DM) + EPS);
            if (LANE_ == 0) RS2[m] = rstd;
#pragma unroll
            for (int j = 0; j < 4; ++j) { v2u w; w.x = cvt_pk_bf16(v[r][j].x, v[r][j].y); w.y = cvt_pk_bf16(v[r][j].z, v[r][j].w); *(v2u*)(X2 + (size_t)m * DM + 4 * LANE_ + 256 * j) = w;
                *(unsigned*)(X28 + (size_t)m * DM + 4 * LANE_ + 256 * j) = pk4_fp8(v[r][j].x, v[r][j].y, v[r][j].z, v[r][j].w); } }
    }
}

__device__ __forceinline__ void p9_final(const Frame& F) {
    PHASE_IDS;
    const int gw = F.vcu * NWAVES + WAVE_, NGW = F.G * NWAVES;
    const unsigned char* GATE = wsp<unsigned char>(F, WS_GATE); const unsigned char* PP = wsp<unsigned char>(F, WS_PP); const float* ssqpp = wsp<float>(F, WS_SSQPP);
    for (int m0 = gw; m0 < T; m0 += 2 * NGW) {
        f32x4 v[2][4]; unsigned gv[2][4], pv_[2][4]; f32x4 sq[2][4]; float s[2] = {0.f, 0.f};
#pragma unroll
        for (int r = 0; r < 2; ++r) { const int m = m0 + r * NGW; const bf16* x2r = wsp<bf16>(F, WS_X2B) + (size_t)m * DM;
#pragma unroll
            for (int q = 0; q < 4; ++q) sq[r][q] = *(const f32x4*)(ssqpp + (size_t)m * 16 + 4 * q);
#pragma unroll
            for (int j = 0; j < 4; ++j) { const int col = 4 * LANE_ + 256 * j; const v2u xw = *(const v2u*)(x2r + col); v[r][j] = (f32x4){bflo(xw.x), bfhi(xw.x), bflo(xw.y), bfhi(xw.y)};
                gv[r][j] = *(const unsigned*)(GATE + (size_t)m * DM + col); pv_[r][j] = *(const unsigned*)(PP + (size_t)m * DM + col); } }
#pragma unroll
        for (int r = 0; r < 2; ++r) { const f32x4 a = sq[r][0], b = sq[r][1], c = sq[r][2], d = sq[r][3];
            const float sp = ((a[0] + a[1]) + (a[2] + a[3])) + ((b[0] + b[1]) + (b[2] + b[3])) + ((c[0] + c[1]) + (c[2] + c[3])) + ((d[0] + d[1]) + (d[2] + d[3]));
            const float rpp = 1.0f / sqrtf(sp * (1.f / DM) + EPS);
#pragma unroll
            for (int j = 0; j < 4; ++j) { const int col = 4 * LANE_ + 256 * j; const f32x4 pg_ = *(const f32x4*)(F.ppn + col);
                const f32x2 g01 = __builtin_amdgcn_cvt_pk_f32_fp8((int)gv[r][j], false), g23 = __builtin_amdgcn_cvt_pk_f32_fp8((int)gv[r][j], true);
                const f32x2 p01 = __builtin_amdgcn_cvt_pk_f32_fp8((int)pv_[r][j], false), p23 = __builtin_amdgcn_cvt_pk_f32_fp8((int)pv_[r][j], true);
                const float rg = rpp * (1.0f / GATE_SCALE);
                v[r][j][0] += g01[0] * (p01[0] * rg * pg_[0]); v[r][j][1] += g01[1] * (p01[1] * rg * pg_[1]);
                v[r][j][2] += g23[0] * (p23[0] * rg * pg_[2]); v[r][j][3] += g23[1] * (p23[1] * rg * pg_[3]);
                s[r] += (v[r][j].x * v[r][j].x + v[r][j].y * v[r][j].y) + (v[r][j].z * v[r][j].z + v[r][j].w * v[r][j].w); } }
#pragma unroll
        for (int r = 0; r < 2; ++r) { const int m = m0 + r * NGW; float* xr = F.out + (size_t)m * DM; const float rstd = 1.0f / sqrtf(wave_sum(s[r]) * (1.f / DM) + EPS);
#pragma unroll
            for (int j = 0; j < 4; ++j) { const int col = 4 * LANE_ + 256 * j; const f32x4 fg = *(const f32x4*)(F.final_norm + col); __builtin_nontemporal_store(v[r][j] * rstd * fg, (f32x4*)(xr + col)); } }
    }
}

struct Args { const float* in[23]; float* out; unsigned char* ws; };
#if CHECK_STAGE
__device__ __forceinline__ unsigned hmix(unsigned z) { z ^= z >> 16; z *= 0x7feb352du; z ^= z >> 15; z *= 0x846ca68bu; z ^= z >> 16; return z; }
__device__ __forceinline__ void chk_add(const Frame& F, int st, bool bad) { atomicAdd((unsigned*)(F.ctl + CW_CHK + 2 * st), bad ? 1u : 0u); atomicAdd((unsigned*)(F.ctl + CW_CHK + 2 * st + 1), 1u); }
__device__ __forceinline__ bool offby(float got, float ex, float rel, float ab) { const float d = fabsf(got - ex); return !(d <= rel * fabsf(ex) + ab); }
__device__ __forceinline__ float dot_bf(const bf16* a, const bf16* b, int n) { float s = 0.f; for (int k = 0; k < n; ++k) s += bf2f(a[k]) * bf2f(b[k]); return s; }
__device__ __forceinline__ float gelu_ref(float v) { return 0.5f * v * (1.0f + erff(v * 0.70710678f)); }
__device__ __forceinline__ unsigned chk_tstart(const Frame& F, unsigned ex) { const unsigned* cntg = (const unsigned*)(F.ctl + CW_CNT); unsigned s_ = 0; for (unsigned e = 0; e < ex; ++e) { unsigned c = cntg[e]; if (c > (unsigned)T) c = T; s_ += (c + 255u) >> 8; } return s_; }
template <int ST> __device__ __forceinline__ void stage_check(const Frame& F) {
    const unsigned gt = (unsigned)blockIdx.x * NTHR + threadIdx.x;
    const unsigned h0 = hmix(gt * 2654435761u + ST * 40503u), h1 = hmix(h0 + 0x9e3779b9u), h2 = hmix(h1 + 0x85ebca6bu);
    if (ST == 1) {
        if (gt >= 16384) return;
        const int which = gt & 7;
        if (which == 0) { const int e = h0 % NE, n = h1 % (2 * FF), k = h2 % DM; const int lc = CmWgu()(n);
            const float ex = bf2f((bf16)f2bf(F.w_gu[((size_t)e * DM + k) * 2 * FF + lc] * F.ffn_norm[k])); chk_add(F, ST, offby(bf2f(wsp<bf16>(F, WS_WGU)[((size_t)e * 2 * FF + n) * DM + k]), ex, 1e-6f, 1e-30f)); }
        else if (which == 1) { const int e = h0 % NE, n = h1 % DM, k = h2 % FF;
            const float ex = bf2f((bf16)f2bf(F.w_dn[((size_t)e * FF + k) * DM + n])); chk_add(F, ST, offby(bf2f(wsp<bf16>(F, WS_WDN)[((size_t)e * DM + n) * FF + k]), ex, 1e-6f, 1e-30f)); }
        else if (which == 2) { const int n = h1 % NPROJ, k = h2 % DM; const int lc = CmWin()(n);
            const float ex = bf2f((bf16)f2bf(F.w_in[(size_t)k * NPROJ + lc] * F.mix_norm[k])); chk_add(F, ST, offby(bf2f(wsp<bf16>(F, WS_WIN)[(size_t)n * DM + k]), ex, 1e-6f, 1e-30f)); }
        else if (which == 3) { const int n = h1 % DM, k = h2 % DM; const float g = k < AW ? F.aon[k] : F.gon[k - AW];
            const float ex = bf2f((bf16)f2bf(F.w_out[(size_t)k * DM + n] * g)); chk_add(F, ST, offby(bf2f(wsp<bf16>(F, WS_WOUT)[(size_t)n * DM + k]), ex, 1e-6f, 1e-30f)); }
        else if (which == 4) { const int n = h1 % DM, k = h2 % DM;
            const float ex = bf2f((bf16)f2bf(F.w_pg[(size_t)k * DM + n] * F.ple_norm[k])); chk_add(F, ST, offby(bf2f(wsp<bf16>(F, WS_WPG)[(size_t)n * DM + k]), ex, 1e-6f, 1e-30f)); }
        else if (which == 5) { const int n = h1 % DM, k = h2 % PLE;
            const float ex = bf2f((bf16)f2bf(F.w_pp[(size_t)k * DM + n])); chk_add(F, ST, offby(bf2f(wsp<bf16>(F, WS_WPP)[(size_t)n * PLE + k]), ex, 1e-6f, 1e-30f)); }
        else if (which == 6) { const int row = h0 % T, k = h1 % DM; float ss = 0.f; for (int j = 0; j < DM; ++j) { const float v = F.x[(size_t)row * DM + j]; ss += v * v; }
            const float ex = F.x[(size_t)row * DM + k] / sqrtf(ss / DM + EPS); chk_add(F, ST, offby(bf2f(wsp<bf16>(F, WS_XNB)[(size_t)row * DM + k]), ex, 0.01f, 1e-3f)); }
        else { const int row = h0 % T, k = h1 % PLE; chk_add(F, ST, offby(bf2f(wsp<bf16>(F, WS_PB)[(size_t)row * PLE + k]), F.p[(size_t)row * PLE + k], 0.005f, 1e-6f)); }
    }
    if (ST == 2) {
        if (gt >= 16384) return;
        const bf16* XN = wsp<bf16>(F, WS_XNB); const bf16* WIN = wsp<bf16>(F, WS_WIN);
        if ((gt & 7) == 7) {
            const int b = h0 % BATCH, hh = h1 % NH, blk = h2 % NBLK, c = (h2 >> 8) % HD; float s_ = 0.f;
            for (int r = 0; r < 256; ++r) s_ += bf2f(wsp<bf16>(F, WS_K)[((size_t)b * SEQ + blk * 256 + r) * AW + hh * HD + c]);
            chk_add(F, ST, offby(wsp<float>(F, WS_KMEAN)[((size_t)(b * NH + hh) * NBLK + blk) * HD + c], s_, 0.02f, 0.3f)); return; }
        const int row = h0 % T, type = h1 % 5, c = h2 % AW; const bf16* xr = XN + (size_t)row * DM;
        const float v = dot_bf(xr, WIN + (size_t)(type * AW + c) * DM, DM); float ex;
        if (type <= 1) { const float vp = dot_bf(xr, WIN + (size_t)(type * AW + (c ^ 4)) * DM, DM); const int i = 4 * ((c & 63) >> 3) + (c & 3), pos = row & (SEQ - 1);
            const float cs = wsp<float>(F, WS_ROPE)[pos * 32 + i], sn = wsp<float>(F, WS_ROPE)[SEQ * 32 + pos * 32 + i];
            { const float inv = powf(10000.0f, -(float)i / 32.0f); const float ang = (float)pos * inv; if (offby(cs, cosf(ang), 0.f, 1e-3f) || offby(sn, sinf(ang), 0.f, 1e-3f)) { chk_add(F, ST, true); return; } }
            ex = (c & 4) ? v * cs + vp * sn : v * cs - vp * sn; }
        else if (type == 2) ex = v; else ex = gelu_ref(v);
        chk_add(F, ST, offby(bf2f(wsp<bf16>(F, WS_Q)[(size_t)type * (16u << 20) + (size_t)row * AW + c]), ex, 0.02f, 0.02f));
    }
    if (ST == 3) {
        if (gt >= 8192) return;
        if (gt & 1) {
            const int row = h0 % T, g = h1 % GG, d = h2 % GD; const int b = row / SEQ, s_ = row % SEQ, c = s_ / GC, t = s_ % GC; float acc = 0.f;
            for (int sp = 0; sp <= t; ++sp) { const bf16* vr = wsp<bf16>(F, WS_VG) + ((size_t)b * SEQ + c * GC + sp) * GW + g * GD; float mu = 0.f; for (int j = 0; j < GD; ++j) mu += bf2f(vr[j]); mu /= GD;
                float var = 0.f; for (int j = 0; j < GD; ++j) { const float dd = bf2f(vr[j]) - mu; var += dd * dd; } const float rstd = 1.0f / sqrtf(var / GD + EPS);
                const float vn = bf2f((bf16)f2bf((bf2f(vr[d]) - mu) * rstd * F.ln_g[g * GD + d] + F.ln_b[g * GD + d])); acc += bf2f((bf16)f2bf(F.gws[((size_t)g * GC + t) * GC + sp])) * vn; }
            const float ex = bf2f(wsp<bf16>(F, WS_U)[(size_t)row * GW + g * GD + d]) * (acc + F.gbs[g * GC + t]);
            chk_add(F, ST, offby(bf2f(wsp<bf16>(F, WS_MIX)[(size_t)row * DM + AW + g * GD + d]), ex, 0.03f, 0.02f)); return; }
        const int row = h0 % T, hh = h1 % NH; const int b = row / SEQ, s_ = row % SEQ, qb = s_ / MOBA; float q[HD];
#pragma unroll
        for (int c = 0; c < HD; ++c) q[c] = bf2f(wsp<bf16>(F, WS_Q)[(size_t)row * AW + hh * HD + c]);
        unsigned sel = 0u;
        if (qb <= 3) sel = (1u << qb) - 1u;
        else { float b0 = -__builtin_inff(), b1 = b0, b2 = b0; int i0 = 0, i1 = 0, i2 = 0;
            for (int j = 0; j < qb; ++j) { const float* km = wsp<float>(F, WS_KMEAN) + ((size_t)(b * NH + hh) * NBLK + j) * HD; float g = 0.f;
#pragma unroll
                for (int c = 0; c < HD; ++c) g += q[c] * km[c];
                if (g > b0) { b2 = b1; i2 = i1; b1 = b0; i1 = i0; b0 = g; i0 = j; } else if (g > b1) { b2 = b1; i2 = i1; b1 = g; i1 = j; } else if (g > b2) { b2 = g; i2 = j; } }
            sel = (1u << i0) | (1u << i1) | (1u << i2); }
        float mx = -__builtin_inff();
        for (int kp = 0; kp <= s_; ++kp) { const int blk = kp / MOBA; if (blk != qb && !((sel >> blk) & 1u)) continue; const bf16* kr = wsp<bf16>(F, WS_K) + ((size_t)b * SEQ + kp) * AW + hh * HD; float sc = 0.f;
#pragma unroll
            for (int c = 0; c < HD; ++c) sc += q[c] * bf2f(kr[c]);
            mx = fmaxf(mx, sc * 0.125f); }
        float o[HD]; float l = 0.f;
#pragma unroll
        for (int c = 0; c < HD; ++c) o[c] = 0.f;
        for (int kp = 0; kp <= s_; ++kp) { const int blk = kp / MOBA; if (blk != qb && !((sel >> blk) & 1u)) continue; const bf16* kr = wsp<bf16>(F, WS_K) + ((size_t)b * SEQ + kp) * AW + hh * HD; float sc = 0.f;
#pragma unroll
            for (int c = 0; c < HD; ++c) sc += q[c] * bf2f(kr[c]);
            const float pr = expf(sc * 0.125f - mx); l += pr; const bf16* vr = wsp<bf16>(F, WS_V) + ((size_t)b * SEQ + kp) * AW + hh * HD;
#pragma unroll
            for (int c = 0; c < HD; ++c) o[c] += pr * bf2f(vr[c]); }
        bool bad = false; float ss = 0.f;
#pragma unroll
        for (int c = 0; c < HD; ++c) { const float ex = o[c] / l; ss += ex * ex; bad |= offby(bf2f(wsp<bf16>(F, WS_MIX)[(size_t)row * DM + hh * HD + c]), ex, 0.04f, 0.02f); }
        bad |= offby(wsp<float>(F, WS_SSQA)[(size_t)row * NH + hh], ss, 0.03f, 1e-3f);
        chk_add(F, ST, bad);
    }
    if (ST == 4) {
        if (gt >= 16384) return;
        const int row = h0 % T, col = h1 % DM; const bf16* mr = wsp<bf16>(F, WS_MIX) + (size_t)row * DM; const bf16* wr_ = wsp<bf16>(F, WS_WOUT) + (size_t)col * DM;
        float sa = 0.f, sg = 0.f, da = 0.f, dg = 0.f;
        for (int k = 0; k < AW; ++k) { const float a = bf2f(mr[k]), g = bf2f(mr[AW + k]); sa += a * a; sg += g * g; da += a * bf2f(wr_[k]); dg += g * bf2f(wr_[AW + k]); }
        const float ex = F.x[(size_t)row * DM + col] + da / sqrtf(sa / AW + EPS) + dg / sqrtf(sg / GW + EPS);
        chk_add(F, ST, offby(F.out[(size_t)row * DM + col], ex, 0.01f, 0.03f));
    }
    if (ST == 5) {
        if (gt >= 8192) return;
        const int tok = h0 % T; const float* xr = F.out + (size_t)tok * DM; float ss = 0.f; for (int k = 0; k < DM; ++k) ss += xr[k] * xr[k]; const float rstd = 1.0f / sqrtf(ss / DM + EPS);
        bool bad = false;
        for (int j = 0; j < 4; ++j) { const int k = (h1 >> (8 * j)) % DM; bad |= offby(bf2f(wsp<bf16>(F, WS_XNB)[(size_t)tok * DM + k]), xr[k] * rstd, 0.01f, 1e-3f); }
        float lg[NE];
#pragma unroll
        for (int e = 0; e < NE; ++e) lg[e] = 0.f;
        for (int k = 0; k < DM; ++k) { const float xv = xr[k] * rstd * F.ffn_norm[k];
#pragma unroll
            for (int e = 0; e < NE; ++e) lg[e] += xv * F.router_w[k * NE + e]; }
#pragma unroll
        for (int e = 0; e < NE; ++e) lg[e] += F.router_b[e];
        int te[4]; float tv[4]; unsigned used = 0u;
#pragma unroll
        for (int k = 0; k < 4; ++k) { float best = -__builtin_inff(); int bi = 0;
#pragma unroll
            for (int e = 0; e < NE; ++e) if (!((used >> e) & 1u) && lg[e] > best) { best = lg[e]; bi = e; }
            used |= 1u << bi; te[k] = bi; tv[k] = best; }
        { float gg[4]; float den = 0.f;
#pragma unroll
          for (int k = 0; k < 4; ++k) { float v = -__builtin_inff();
#pragma unroll
              for (int e = 0; e < NE; ++e) if (e == te[k]) v = lg[e];
              gg[k] = v; }
          const float mm = gg[0];
#pragma unroll
          for (int k = 0; k < 4; ++k) { gg[k] = expf(gg[k] - mm); den += gg[k]; }
          const unsigned* tp = wsp<unsigned>(F, WS_TOKPOS) + (size_t)tok * 4;
#pragma unroll
          for (int k = 0; k < 4; ++k) { const unsigned e = tp[k] >> 16, slot = tp[k] & 0xffffu; bad |= (e != (unsigned)te[k]);
              if (e < NE && slot < (unsigned)T) { bad |= wsp<unsigned>(F, WS_IDX)[(size_t)e * T + slot] != (unsigned)tok; bad |= offby(wsp<float>(F, WS_GSS)[(size_t)e * T + slot], gg[k] / den, 2e-3f, 1e-5f);
                  bad |= slot >= ((const unsigned*)(F.ctl + CW_CNT))[e]; } else bad = true; } }
        (void)tv;
        chk_add(F, ST, bad);
    }
    if (ST == 6 || ST == 7) {
        if (gt >= 16384) return;
        const int tok = h0 % T, k = h1 & 3, col = (h1 >> 2) % FF; const unsigned tp = wsp<unsigned>(F, WS_TOKPOS)[(size_t)tok * 4 + k]; const unsigned e = tp >> 16, slot = tp & 0xffffu;
        if (e >= NE) { chk_add(F, ST, true); return; }
        const unsigned tse = chk_tstart(F, e);
        const size_t row = (size_t)tse * 256 + slot;
        if (ST == 6) { const bf16* xr = wsp<bf16>(F, WS_XNB) + (size_t)tok * DM; const int np = (col >> 7) * 256 + (col & 127);
            const float g = dot_bf(xr, wsp<bf16>(F, WS_WGU) + ((size_t)e * 2 * FF + np) * DM, DM) + F.b_gu[(size_t)e * 2 * FF + col];
            const float l = dot_bf(xr, wsp<bf16>(F, WS_WGU) + ((size_t)e * 2 * FF + np + 128) * DM, DM) + F.b_gu[(size_t)e * 2 * FF + FF + col];
            const float gc = fminf(g, 7.f), lc = fminf(fmaxf(l, -7.f), 7.f); const float ex = gc / (1.0f + expf(-1.702f * gc)) * (lc + 1.0f);
            chk_add(F, ST, offby(bf2f(wsp<bf16>(F, WS_ABUF)[row * FF + col]), ex, 0.03f, 0.03f)); }
        else { const float d = dot_bf(wsp<bf16>(F, WS_ABUF) + row * FF, wsp<bf16>(F, WS_WDN) + ((size_t)e * DM + col) * FF, FF) + F.b_dn[(size_t)e * DM + col];
            const float ex = d * wsp<float>(F, WS_GSS)[(size_t)e * T + slot];
            chk_add(F, ST, offby(bf2f(wsp<bf16>(F, WS_YBUF)[row * DM + col]), ex, 0.03f, 0.01f)); }
    }
    if (ST == 8) {
        if (gt >= 8192) return;
        const int tok = h0 % T; const float* xr = F.out + (size_t)tok * DM; float ss = 0.f; for (int k = 0; k < DM; ++k) ss += xr[k] * xr[k]; const float rstd = 1.0f / sqrtf(ss / DM + EPS);
        bool bad = false; for (int k = 0; k < DM; ++k) { bad |= offby(bf2f(wsp<bf16>(F, WS_X2N)[(size_t)tok * DM + k]), xr[k] * rstd, 0.01f, 1e-3f); bad |= !(fabsf(xr[k]) < 30.f); }
        chk_add(F, ST, bad);
    }
    if (ST == 9) {
        if (gt >= 16384) return;
        const int row = h0 % T, col = h1 % DM;
        if (gt & 1) { const float d = dot_bf(wsp<bf16>(F, WS_X2N) + (size_t)row * DM, wsp<bf16>(F, WS_WPG) + (size_t)col * DM, DM); const float got = bf2f(wsp<bf16>(F, WS_GATE)[(size_t)row * DM + col]); const float ex = 1.0f / (1.0f + expf(-d)); const bool bad = offby(got, ex, 0.02f, 0.01f); chk_add(F, ST, bad);
            if (bad) { atomicOr((unsigned*)(F.ctl + CW_CHK + 40), 1u << ((col >> 3) & 31)); atomicOr((unsigned*)(F.ctl + CW_CHK + 41), 1u << ((row >> 3) & 31)); atomicOr((unsigned*)(F.ctl + CW_CHK + 42), 1u << (col & 7)); atomicOr((unsigned*)(F.ctl + CW_CHK + 43), 1u << (row & 7));
                if (!(got >= 0.f && got <= 1.f)) atomicAdd((unsigned*)(F.ctl + CW_CHK + 44), 1u); { int cl = (int)floorf(log2f(fabsf(got) + 1e-30f)) + 40; cl = cl < 0 ? 0 : (cl > 80 ? 80 : cl); atomicMax((unsigned*)(F.ctl + CW_CHK + 46), (unsigned)cl); atomicMin((unsigned*)(F.ctl + CW_CHK + 47), 0xffffffffu - (unsigned)cl); if (got < 0.f) atomicAdd((unsigned*)(F.ctl + CW_CHK + 48), 1u); } if (fabsf(got - ex) > 0.2f) atomicAdd((unsigned*)(F.ctl + CW_CHK + 45), 1u); } }
        else { const float d = dot_bf(wsp<bf16>(F, WS_PB) + (size_t)row * PLE, wsp<bf16>(F, WS_WPP) + (size_t)col * PLE, PLE); chk_add(F, 10, offby(bf2f(wsp<bf16>(F, WS_PP)[(size_t)row * DM + col]), d, 0.02f, 0.02f)); }
    }
}
__device__ __forceinline__ void check_report(const Frame& F) {
    float c2 = 3.0f;
    for (int st = 1; st <= 10; ++st) { const unsigned bad = F.ctl[CW_CHK + 2 * st], tot = F.ctl[CW_CHK + 2 * st + 1]; const float fr = tot ? (float)bad / (float)tot : 1.0f;
        (void)fr; if (((CHECK_SKIP >> st) & 1) == 0 && bad >= 1u) { c2 = powf(10.0f, (float)st) * (1.0f + fminf((float)bad, 80.0f) * 0.1f); break; } }
#if CHECK_REPORT >= 40
    { unsigned v = F.ctl[CW_CHK + CHECK_REPORT]; if (CHECK_REPORT == 47) v = 0xffffffffu - v; c2 = powf(10.0f, (float)(v >> 27)) * (1.0f + (float)((v >> 21) & 63u) * 0.1f);
#if CHECK_REPORT2
      c2 = powf(10.0f, (float)((v >> 16) & 31u)) * (1.0f + (float)((v >> 10) & 63u) * 0.1f);
#endif
#if CHECK_REPORT3
      c2 = powf(10.0f, (float)((v >> 5) & 31u)) * (1.0f + (float)(v & 31u) * 0.1f);
#endif
      if (CHECK_REPORT >= 46 && CHECK_REPORT <= 47) c2 = powf(10.0f, (float)(v / 9u)) * (1.0f + (float)(v % 9u));
    }
#endif
    if (F.ctl[CW_BAR + XB_TMO] != 0u) c2 = 1e20f;
    const float c = sqrtf(c2);
    for (size_t i = (size_t)blockIdx.x * NTHR + threadIdx.x; i < (size_t)T * DM; i += (size_t)gridDim.x * NTHR) F.out[i] = c;
}
#define STAGE_CHECK(n) stage_check<(n)>(F)
#else
#define STAGE_CHECK(n) do {} while (0)
#endif

__global__ void __launch_bounds__(NTHR, 2) mega_fwd(Args args) {
    extern __shared__ __attribute__((aligned(16))) unsigned char lds_raw[];
    Frame F;
    F.lds = (LAS unsigned char*)lds_raw;
    F.MISC = (volatile LAS unsigned*)(F.lds + LDSCTL_OFF);
    F.G = gridDim.x; { const int bx = blockIdx.x; F.vcu = (F.G % 8 == 0) ? (bx % 8) * (F.G / 8) + bx / 8 : bx; }
    F.ws = args.ws; F.ctl = (gu32*)(args.ws + WS_CTL); F.out = args.out;
    F.x = args.in[0]; F.p = args.in[1]; F.mix_norm = args.in[2]; F.w_in = args.in[3]; F.ln_g = args.in[4]; F.ln_b = args.in[5]; F.gws = args.in[6]; F.gbs = args.in[7];
    F.aon = args.in[8]; F.gon = args.in[9]; F.w_out = args.in[10]; F.ffn_norm = args.in[11]; F.router_w = args.in[12]; F.router_b = args.in[13]; F.w_gu = args.in[14]; F.b_gu = args.in[15];
    F.w_dn = args.in[16]; F.b_dn = args.in[17]; F.ple_norm = args.in[18]; F.w_pg = args.in[19]; F.w_pp = args.in[20]; F.ppn = args.in[21]; F.final_norm = args.in[22];
    { PHASE_IDS; for (int u = TID_; u < 256; u += NTHR) ((LAS unsigned*)(F.lds + LDSCTL_OFF))[u] = 0u; }
    __syncthreads();
    XcdBarrier bar = xcd_barrier_post((unsigned*)(F.ctl + CW_BAR), F.MISC + 8);
#define GRID_BAR() xcd_barrier(bar)
#define STAGE_END(n) do { STAGE_CHECK(n); if (TPROBE && blockIdx.x == 0 && threadIdx.x == 0) ((unsigned long long*)(F.ctl + CW_TS))[(n)] = __builtin_amdgcn_s_memrealtime(); } while (0)

    if (TPROBE && blockIdx.x == 0 && threadIdx.x == 0) ((unsigned long long*)(F.ctl + CW_TS))[0] = __builtin_amdgcn_s_memrealtime();
    for (int rep = 0; rep < (DUP_PHASE == 0 ? 2 : 1); ++rep) {
    if (PH(0)) p0_prologue(F);
    GRID_BAR(); }
    STAGE_END(1);
    if (PH(1)) { pg8::DenseSched S; S.init(wsp<bf16>(F, WS_XNB), wsp<bf16>(F, WS_WIN), T, NPROJ, DM, F.G, (int)blockIdx.x);
      float* RC = wsp<float>(F, WS_ROPE);
      EpiInProj E{wsp<bf16>(F, WS_Q), RC, RC + SEQ * 32, wsp<float>(F, WS_KMEAN)};
      for (int rep = 0; rep < (DUP_PHASE == 1 ? 2 : 1); ++rep) { if (rep) GRID_BAR();
      pg8::gemm_phase<EpiInProj, pg8::DenseSched, false, false>(F.lds + RING_OFF, DM * 2, S, E); } }
    GRID_BAR();
    STAGE_END(2);
    for (int rep = 0; rep < (DUP_PHASE == 2 ? 2 : 1); ++rep) {
    if (PH(2)) p2_mixers(F);
    GRID_BAR(); }
    STAGE_END(3);
    if (PH(3)) { pg8::DenseSched S; S.init(wsp<bf16>(F, WS_MIX), wsp<bf16>(F, WS_WOUT), T, DM, DM, F.G, (int)blockIdx.x);
      LAS f32x2* rtab = (LAS f32x2*)(F.lds + XTAB_OFF);
      Unit ua, ub; const bool ha = S.next(0, ua), hb = S.next(1, ub);
      { PHASE_IDS; const int s = TID_ >> 8, r = TID_ & 255; const bool has = s ? hb : ha; const int pm = s ? ub.pm : ua.pm;
        if (has) { const size_t row = (size_t)pm * 256 + r; const f32x4* pa = (const f32x4*)(wsp<float>(F, WS_SSQA) + row * NH); const f32x4 a0 = pa[0], a1 = pa[1], g0 = *(const f32x4*)(wsp<float>(F, WS_SSQG) + row * GG);
            const float sa = ((a0[0] + a0[1]) + (a0[2] + a0[3])) + ((a1[0] + a1[1]) + (a1[2] + a1[3])), sg = (g0[0] + g0[1]) + (g0[2] + g0[3]);
            const float ra = 1.0f / sqrtf(sa * (1.f / AW) + EPS), rg = 1.0f / sqrtf(sg * (1.f / GW) + EPS);
            rtab[s * 256 + r] = (f32x2){ra / rg, rg}; } }
      __syncthreads();
      EpiOutProj E{wsp<bf16>(F, WS_XNB), wsp<float>(F, WS_SIG0), wsp<bf16>(F, WS_X1B), wsp<unsigned char>(F, WS_X1F8), wsp<float>(F, WS_SSQ1), rtab, ha ? ua.pm : -1, hb ? ub.pm : -1};
      for (int rep = 0; rep < (DUP_PHASE == 3 ? 2 : 1); ++rep) { if (rep) GRID_BAR();
      pg8::gemm_phase<EpiOutProj, pg8::DenseSched, false, true>(F.lds + RING_OFF, DM * 2, S, E); } }
    GRID_BAR();
    STAGE_END(4);
    if (PH(4)) p4_router(F);
    GRID_BAR();
    STAGE_END(5);
    if (PH(5)) { const int nu = moe_build_tables(F, 2 * FF / 256, true);
      pg8::MoeSched S{(const char*)wsp<char>(F, WS_X1F8), (const char*)wsp<char>(F, WS_WGU), 0, (size_t)2 * FF * DM, (size_t)256 * DM, nu,
                      (const LAS unsigned*)(F.lds + XTAB_OFF + XT_ULIST), (const LAS unsigned*)(F.lds + XTAB_OFF + XT_GTAB), true};
      EpiMoe1 E{wsp<unsigned char>(F, WS_ABUF), F.b_gu, wsp<float>(F, WS_RSS)};
      for (int rep = 0; rep < (DUP_PHASE == 5 ? 2 : 1); ++rep) { if (rep) GRID_BAR();
      int Kb = DM; asm volatile("" : "+s"(Kb));
      pg8::gemm_phase<EpiMoe1, pg8::MoeSched, true, false, true>(F.lds + RING_OFF, Kb, S, E); } }
    GRID_BAR();
    STAGE_END(6);
    if (PH(6)) { const int nu = moe_build_tables(F, DM / 256, false);
      pg8::MoeSched S{(const char*)wsp<char>(F, WS_ABUF), (const char*)wsp<char>(F, WS_WDN), (size_t)256 * FF, (size_t)DM * FF, (size_t)256 * FF, nu,
                      (const LAS unsigned*)(F.lds + XTAB_OFF + XT_ULIST), (const LAS unsigned*)(F.lds + XTAB_OFF + XT_GTAB), false};
      EpiMoe2 E{wsp<unsigned char>(F, WS_YBUF), F.b_dn, wsp<float>(F, WS_GSS)};
      for (int rep = 0; rep < (DUP_PHASE == 6 ? 2 : 1); ++rep) { if (rep) GRID_BAR();
      int Kb = FF; asm volatile("" : "+s"(Kb));
      pg8::gemm_phase<EpiMoe2, pg8::MoeSched, false, false, true>(F.lds + RING_OFF, Kb, S, E); } }
    GRID_BAR();
    STAGE_END(7);
    if (PH(7)) p7_combine(F);
    GRID_BAR();
    STAGE_END(8);
    if (PH(8)) { pg8::DenseSched S; S.init(wsp<unsigned char>(F, WS_X2F8), wsp<unsigned char>(F, WS_WPG8), T, DM, DM, F.G, (int)blockIdx.x, 1);
      EpiPle<0> E{wsp<unsigned char>(F, WS_GATE), wsp<float>(F, WS_RSTD2)};
      int Kb = DM; asm volatile("" : "+s"(Kb));
      pg8::gemm_phase<EpiPle<0>, pg8::DenseSched, false, false, true>(F.lds + RING_OFF, Kb, S, E);
#if CHECK_STAGE
      GRID_BAR();
      int Kb = DM; asm volatile("" : "+s"(Kb));
      pg8::gemm_phase<EpiPle<0>, pg8::DenseSched, false, false, true>(F.lds + RING_OFF, Kb, S, E);
#endif
    }
#if CHECK_STAGE
    GRID_BAR(); STAGE_CHECK(9);
#endif
    if (PH(8)) { pg8::DenseSched S; S.init(wsp<bf16>(F, WS_PB), wsp<bf16>(F, WS_WPP), T, DM, PLE, F.G, (int)blockIdx.x);
      EpiPle<1> E{wsp<unsigned char>(F, WS_PP), wsp<float>(F, WS_SSQPP)};
      int Kp = PLE * 2; asm volatile("" : "+s"(Kp));
      pg8::gemm_phase<EpiPle<1>, pg8::DenseSched, false, false>(F.lds + RING_OFF, Kp, S, E); }
    GRID_BAR();
    STAGE_END(9);
#if CHECK_STAGE
    GRID_BAR(); check_report(F);
#else
    if (PH(9)) p9_final(F);
#if TPROBE
    GRID_BAR();
    if (blockIdx.x == 0 && threadIdx.x == 0) { const unsigned long long* ts = (const unsigned long long*)(F.ctl + CW_TS); const unsigned long long t1 = (TP_A == 9) ? __builtin_amdgcn_s_memrealtime() : ts[(TP_A < 10 ? TP_A : 0) + 1];
        unsigned long long d = t1 - ts[TP_A < 10 ? TP_A : 0];
        if (TP_A == 20) d = ts[11] - ts[0]; if (TP_A == 21) d = ts[12] - ts[11]; if (TP_A == 22) d = ts[13] - ts[12]; if (TP_A == 23) d = ts[1] - ts[13]; if (TP_A == 24) d = ts[14] - ts[2]; if (TP_A == 25) d = ts[3] - ts[14];
        F.out[0] += floorf((float)d * 0.01f * 0.125f + 0.5f) * 2.0f; }
#endif
#endif
}

extern "C" void kernel_launch(void* const* d_in, const int* in_sizes, int n_in, void* d_out, int out_size, void* d_ws, size_t ws_size, hipStream_t stream) {
    static int grid = 0;
    if (grid == 0) {
        if (n_in != 23 || in_sizes[0] != T * DM || out_size != T * DM || ws_size < WS_END) { fprintf(stderr, "kernel_launch: unexpected shapes (n_in %d, in0 %d, out %d, ws %zu)\n", n_in, n_in > 0 ? in_sizes[0] : -1, out_size, ws_size); grid = -1; return; }
        int dev = 0, cus = 0, per_cu = 0;
        if (hipGetDevice(&dev) != hipSuccess || hipDeviceGetAttribute(&cus, hipDeviceAttributeMultiprocessorCount, dev) != hipSuccess) { grid = -1; return; }
        if (hipFuncSetAttribute((const void*)mega_fwd, hipFuncAttributeMaxDynamicSharedMemorySize, LDS_BYTES) != hipSuccess) { fprintf(stderr, "kernel_launch: hipFuncSetAttribute failed\n"); grid = -1; return; }
        if (hipOccupancyMaxActiveBlocksPerMultiprocessor(&per_cu, (const void*)mega_fwd, NTHR, LDS_BYTES) != hipSuccess || per_cu < 1)
            fprintf(stderr, "kernel_launch: note: occupancy query reports %d workgroups per CU\n", per_cu);
        (void)hipGetLastError();
        if (cus < 256) { fprintf(stderr, "kernel_launch: built for a 256-CU device (found %d CUs); nothing launched\n", cus); grid = -1; return; }
        grid = 256;
    }
    if (grid < 0) return;
    if (hipMemsetAsync((char*)d_ws + WS_CTL, 0, CTL_ZERO_BYTES, stream) != hipSuccess) return;
    Args a{};
    for (int i = 0; i < 23; ++i) a.in[i] = (const float*)d_in[i];
    a.out = (float*)d_out; a.ws = (unsigned char*)d_ws;
    hipLaunchKernelGGL(mega_fwd, dim3(grid), dim3(NTHR), LDS_BYTES, stream, a);
}
```

```cpp
#include <hip/hip_runtime.h>
#include <cstdio>
#include <cstdint>

#ifndef CHECK_STAGE
#define CHECK_STAGE 0
#endif
#ifndef CHECK_REPORT
#define CHECK_REPORT 0
#endif
#ifndef CHECK_REPORT2
#define CHECK_REPORT2 0
#endif
#ifndef CHECK_REPORT3
#define CHECK_REPORT3 0
#endif
#ifndef DUP_PHASE
#define DUP_PHASE -1
#endif
#ifndef TPROBE
#define TPROBE 0
#endif
#ifndef TP_A
#define TP_A 5
#endif
#ifndef TP_B
#define TP_B 6
#endif
#ifndef CHECK_SKIP
#define CHECK_SKIP 0
#endif
#ifndef PHMASK
#define PHMASK 0x3ff
#endif
#define PH(n) ((PHMASK >> (n)) & 1)

#define GAS __attribute__((address_space(1)))
#define LAS __attribute__((address_space(3)))
typedef unsigned short bf16;
typedef unsigned v4u __attribute__((ext_vector_type(4)));
typedef unsigned v2u __attribute__((ext_vector_type(2)));
typedef float f32x2 __attribute__((ext_vector_type(2)));
typedef float f32x4 __attribute__((ext_vector_type(4)));
typedef float f32x16 __attribute__((ext_vector_type(16)));
typedef short bf16x8 __attribute__((ext_vector_type(8)));
typedef short s16x4 __attribute__((ext_vector_type(4)));
typedef GAS unsigned gu32;

constexpr int BATCH = 16, SEQ = 2048, DM = 1024, T = BATCH * SEQ;
constexpr int AW = 512, NH = 8, HD = 64, NBLK = 8, MOBA = 256;
constexpr int GW = 512, GG = 4, GD = 128, GC = 128;
constexpr int NPROJ = 3 * AW + 2 * GW;
constexpr int NE = 32, TOPK = 4, FF = 1024;
constexpr int PLE = 256;
constexpr int MAXROWS = T * TOPK + NE * 256;
constexpr float EPS = 1e-6f;
constexpr int NWAVES = 8, NTHR = 512;

constexpr size_t MiB = 1u << 20;
constexpr size_t WS_CTL = 0, CTL_ZERO_BYTES = 1 * MiB;
constexpr size_t WS_KMEAN = 256 * 1024;
constexpr size_t WS_WIN = 1 * MiB;
constexpr size_t WS_WOUT = 6 * MiB;
constexpr size_t WS_WPG = 8 * MiB;
constexpr size_t WS_WPP = 10 * MiB;
constexpr size_t WS_RWG = 10 * MiB + 512 * 1024;
constexpr size_t WS_ROPE = 11 * MiB;
constexpr size_t WS_WGU = 16 * MiB;
constexpr size_t WS_WDN = 144 * MiB;
constexpr size_t WS_XNB = 208 * MiB;
constexpr size_t WS_BIG1 = 272 * MiB;
constexpr size_t WS_Q = WS_BIG1, WS_K = WS_Q + 32 * MiB, WS_V = WS_K + 32 * MiB, WS_U = WS_V + 32 * MiB, WS_VG = WS_U + 32 * MiB, WS_MIX = WS_VG + 32 * MiB;
constexpr size_t WS_YBUF = WS_BIG1;
constexpr size_t WS_BIG2 = 544 * MiB;
constexpr size_t WS_ABUF = WS_BIG2, WS_GATE = WS_BIG2, WS_PP = WS_BIG2 + 64 * MiB;
constexpr size_t WS_PB = 816 * MiB;
constexpr size_t WS_IDX = 832 * MiB;
constexpr size_t WS_GSS = 836 * MiB;
constexpr size_t WS_TOKPOS = 840 * MiB;
constexpr size_t WS_SSQA = 841 * MiB;
constexpr size_t WS_SSQG = 842 * MiB;
constexpr size_t WS_SSQ1 = 843 * MiB;
constexpr size_t WS_SSQPP = 845 * MiB;
constexpr size_t WS_X1F8 = 848 * MiB;
constexpr size_t WS_X2N = WS_XNB;
constexpr size_t WS_X1B = 880 * MiB;
constexpr size_t WS_X2B = 944 * MiB;
constexpr size_t WS_SIG0 = 1008 * MiB;
constexpr size_t WS_RSTD2 = 1008 * MiB + 256 * 1024;
constexpr size_t WS_RWT = 1008 * MiB + 512 * 1024;
constexpr size_t WS_RSS = 1009 * MiB;
constexpr size_t WS_X2F8 = 176 * MiB;
constexpr size_t WS_WPG8 = 80 * MiB;
constexpr size_t WS_END = 1013 * MiB;
static_assert(WS_MIX + 64 * MiB <= WS_BIG2 && (size_t)MAXROWS * 1024 * 2 <= 272 * MiB, "ws map");
constexpr int CW_TMO = 0, CW_CODE = 1;
constexpr int CW_BAR = 4096;
constexpr int CW_CNT = 8192;
constexpr int CW_TS = 12000;
constexpr int CW_CHK = 12288;

constexpr int RING_OFF = 0, RING_BYTES = 131072;
constexpr int P0_SCR_WAVE = 64 * 65 * 4;
constexpr int LDS_BYTES_TOTAL = 163840;
constexpr int LDSCTL_OFF = LDS_BYTES_TOTAL - 1024;
constexpr int XTAB_OFF = RING_BYTES;
static_assert(8 * P0_SCR_WAVE <= LDSCTL_OFF && XTAB_OFF >= RING_BYTES, "lds map");
constexpr int LDS_BYTES = LDS_BYTES_TOTAL;

#define RLX_AGENT __ATOMIC_RELAXED, __HIP_MEMORY_SCOPE_AGENT
#define LDS_WAIT() asm volatile("s_waitcnt lgkmcnt(0)" ::: "memory")
#define VM_WAIT() asm volatile("s_waitcnt vmcnt(0)" ::: "memory")
__device__ __forceinline__ unsigned f2bf(float f) { unsigned u = __builtin_bit_cast(unsigned, f); return (u + 0x7fffu + ((u >> 16) & 1u)) >> 16; }
__device__ __forceinline__ unsigned pk2(float lo, float hi) { return f2bf(lo) | (f2bf(hi) << 16); }
__device__ __forceinline__ float bf2f(unsigned short b) { return __builtin_bit_cast(float, ((unsigned)b) << 16); }
__device__ __forceinline__ float bflo(unsigned w) { return __builtin_bit_cast(float, w << 16); }
__device__ __forceinline__ float bfhi(unsigned w) { return __builtin_bit_cast(float, w & 0xffff0000u); }
typedef __bf16 bf16x2_t __attribute__((ext_vector_type(2)));
__device__ __forceinline__ unsigned cvt_pk_bf16(float lo, float hi) { const f32x2 v = {lo, hi}; const bf16x2_t b = __builtin_convertvector(v, bf16x2_t); return __builtin_bit_cast(unsigned, b); }
__device__ __forceinline__ float clamp448(float x) { return fminf(fmaxf(x, -448.0f), 448.0f); }
__device__ __forceinline__ unsigned pk4_fp8(float a, float b, float c, float d) { unsigned w = 0u; w = (unsigned)__builtin_amdgcn_cvt_pk_fp8_f32(clamp448(a), clamp448(b), (int)w, false); w = (unsigned)__builtin_amdgcn_cvt_pk_fp8_f32(clamp448(c), clamp448(d), (int)w, true); return w; }
__device__ __forceinline__ float fp8_to_f(unsigned v) { const unsigned sg = (v >> 7) & 1u, e = (v >> 3) & 15u, m = v & 7u; const float r = e ? ldexpf(1.0f + (float)m * 0.125f, (int)e - 7) : ldexpf((float)m * 0.125f, -6); return sg ? -r : r; }
__device__ __forceinline__ float wave_sum(float v) {
#pragma unroll
    for (int o = 1; o < 64; o <<= 1) v += __shfl_xor(v, o);
    return v;
}
__device__ __forceinline__ f32x2 gelu_pk(f32x2 v) {
    const f32x2 av = __builtin_elementwise_abs(v), d = av * 0.2316418882f + 1.0f;
    f32x2 t; t.x = __builtin_amdgcn_rcpf(d.x); t.y = __builtin_amdgcn_rcpf(d.y);
    f32x2 q = t * 0.5307027145f + (-0.7265760135f); q = q * t + 0.7107068705f; q = q * t + (-0.142248368f); q = q * t + 0.127414796f; q = q * t;
    const f32x2 s = (v * v) * (-0.72134752044f);
    f32x2 e; e.x = __builtin_amdgcn_exp2f(s.x); e.y = __builtin_amdgcn_exp2f(s.y);
    const f32x2 m = v * (q * e), r = v - m;
    f32x2 o; o.x = v.x < 0.f ? m.x : r.x; o.y = v.y < 0.f ? m.y : r.y; return o;
}
__device__ __forceinline__ f32x4 gelu4(f32x4 v) { const f32x2 a = gelu_pk((f32x2){v[0], v[1]}), b = gelu_pk((f32x2){v[2], v[3]}); return (f32x4){a.x, a.y, b.x, b.y}; }
__device__ __forceinline__ float sigmoidf_fast(float x) { return __builtin_amdgcn_rcpf(1.0f + __builtin_amdgcn_exp2f(-1.4426950408889634f * x)); }

#define XB_TMO      128
#define XB_XCNT(j)  (256  + 64 * (j))
#define XB_XSUB(j)  (1280 + 64 * (j))
#define XB_XGEN(j)  (2304 + 64 * (j))
#define XB_TOP      3328
#define XB_TOPGEN   3392
#define XCD_BAR_WORDS 3456
#define XB_SPIN_CAP (1u << 18)
__device__ __forceinline__ unsigned xb_ld(unsigned* p)              { return __hip_atomic_load(p, __ATOMIC_RELAXED, __HIP_MEMORY_SCOPE_AGENT); }
__device__ __forceinline__ unsigned xb_add(unsigned* p, unsigned v) { return __hip_atomic_fetch_add(p, v, __ATOMIC_RELAXED, __HIP_MEMORY_SCOPE_AGENT); }
__device__ __forceinline__ unsigned xb_xcc_id() { return (unsigned)__builtin_amdgcn_s_getreg((3 << 11) | 20) & 0xFu; }
#define XB_SPIN(cond, bar) do { unsigned _sp = 0; while (cond) { __builtin_amdgcn_s_sleep(1); \
    if ((++_sp & 255u) == 0u) { if (xb_ld(&(bar)[XB_TMO])) break; if (_sp > XB_SPIN_CAP) { atomicAdd(&(bar)[XB_TMO], 1u); break; } } } } while (0)
struct XcdBarrier { unsigned* bar; unsigned x; volatile LAS unsigned* st; };
__device__ __forceinline__ XcdBarrier xcd_barrier_post(unsigned* bar, volatile LAS unsigned* st) {
    XcdBarrier b; b.bar = bar; b.x = xb_xcc_id(); b.st = st;
    if (threadIdx.x == 0) (void)xb_add(&bar[XB_XCNT(b.x)], 1u);
    return b;
}
__device__ __forceinline__ void xcd_barrier_complete(unsigned* bar, unsigned x, unsigned& nloc, unsigned& nx) {
    const unsigned G = gridDim.x * gridDim.y * gridDim.z;
    unsigned sum, cnt, mine, sp = 0u;
    for (;;) {
        sum = 0u; cnt = 0u; mine = 0u;
#pragma unroll
        for (unsigned j = 0; j < 16; ++j) { const unsigned c = xb_ld(&bar[XB_XCNT(j)]); sum += c; cnt += (c > 0u) ? 1u : 0u; mine = (j == x) ? c : mine; }
        if (sum == G) break;
        __builtin_amdgcn_s_sleep(1);
        if ((++sp & 255u) == 0u) { if (xb_ld(&bar[XB_TMO])) break; if (sp > XB_SPIN_CAP) { atomicAdd(&bar[XB_TMO], 1u); break; } }
    }
    nloc = mine > 0u ? mine : 1u; nx = cnt > 0u ? cnt : 1u;
}
__device__ __forceinline__ void xcd_barrier(const XcdBarrier& b) {
    asm volatile("s_waitcnt vmcnt(0)" ::: "memory");
    __syncthreads();
    if (threadIdx.x == 0) {
        unsigned* bar = b.bar;
        __builtin_amdgcn_s_waitcnt(0);
        unsigned nloc = b.st[0], nx = b.st[1];
        if (nloc == 0u) { xcd_barrier_complete(bar, b.x, nloc, nx); b.st[0] = nloc; b.st[1] = nx; }
        const unsigned old = xb_add(&bar[XB_XSUB(b.x)], 1u);
        const unsigned gen = old / nloc;
        if (old + 1u == (gen + 1u) * nloc) {
            __builtin_amdgcn_fence(__ATOMIC_RELEASE, "agent");
            asm volatile("s_waitcnt vmcnt(0)" ::: "memory");
            const unsigned og = xb_add(&bar[XB_TOP], 1u);
            const unsigned tg = og / nx;
            if (og + 1u == (tg + 1u) * nx) xb_add(&bar[XB_TOPGEN], 1u);
            else XB_SPIN(xb_ld(&bar[XB_TOPGEN]) == tg, bar);
            __builtin_amdgcn_fence(__ATOMIC_ACQUIRE, "agent");
            xb_add(&bar[XB_XGEN(b.x)], 1u);
            asm volatile("s_waitcnt vmcnt(0)" ::: "memory");
        } else {
            XB_SPIN(xb_ld(&bar[XB_XGEN(b.x)]) == gen, bar);
            __builtin_amdgcn_fence(__ATOMIC_ACQUIRE, "agent");
            asm volatile("s_waitcnt vmcnt(0)" ::: "memory");
        }
    }
    __syncthreads();
}

namespace pg8 {
constexpr int BM = 256, BK = 64, HALF = 128, HTB = HALF * BK * 2, STAGE_BYTES = 8 * HTB, NXCD = 8, WGM = 8;
__host__ __device__ __forceinline__ int lds_byte(int r, int c) { const int st = (r >> 4) * 2 + (c >> 5), rr = r & 15, cc = c & 31, ob = rr * 64 + cc * 2; return st * 1024 + (ob ^ (((ob >> 9) & 1) << 5)); }
__host__ __device__ __forceinline__ void stage_rc(int b, int& R, int& C) { const int st = b / 1024, sb = b % 1024, swz = sb ^ (((sb >> 9) & 1) << 5); R = (st >> 1) * 16 + swz / 64; C = (st & 1) * 32 + (swz % 64) / 2; }
__host__ __device__ __forceinline__ int perm32(int rho) { const int n = rho >> 4, i = rho & 15; return 8 * (i >> 2) + 4 * n + (i & 3); }

typedef int v8i __attribute__((ext_vector_type(8)));
constexpr int F8_WSHIFT = 6, F8_SCALE_W = 127 - F8_WSHIFT;
typedef int v4i __attribute__((ext_vector_type(4)));
__device__ __forceinline__ v8i ld8(const LAS unsigned char* p0, const LAS unsigned char* p1) { const v4i lo = *(const LAS v4i*)p0, hi = *(const LAS v4i*)p1; return __builtin_shufflevector(lo, hi, 0, 1, 2, 3, 4, 5, 6, 7); }
struct Unit { int pm, pn, e, rt, slot; };

__device__ __forceinline__ void flat_to_tile(int L, int nwg, int nM, int nN, int& pm, int& pn) {
    int wgid = L; { const int q = nwg / NXCD, r = nwg % NXCD, xcd = wgid % NXCD, off = wgid / NXCD; wgid = (xcd < r ? xcd * (q + 1) : r * (q + 1) + (xcd - r) * q) + off; }
    const int nig = WGM * nN, gid = wgid / nig, fm = gid * WGM, gsz = (nM - fm) < WGM ? (nM - fm) : WGM;
    pm = fm + ((wgid % nig) % gsz); pn = (wgid % nig) / gsz;
}
struct DenseSched {
    const char* A; const char* Bt; int nM, nN, nwg, G, c; size_t tstep;
    __device__ __forceinline__ void init(const void* A_, const void* Bt_, int M, int N, int K, int G_, int c_, int ebytes = 2) { A = (const char*)A_; Bt = (const char*)Bt_; nM = M / BM; nN = N / BM; nwg = nM * nN; G = G_; c = c_; tstep = (size_t)BM * K * ebytes; }
    __device__ __forceinline__ bool next(int i, Unit& u) const { const long L = (long)i * G + c; if (L >= nwg) return false; flat_to_tile((int)L, nwg, nM, nN, u.pm, u.pn); u.e = 0; u.rt = u.pm; u.slot = i; return true; }
    __device__ __forceinline__ const char* a_base(const Unit& u) const { return A + (size_t)u.pm * tstep; }
    __device__ __forceinline__ const char* b_base(const Unit& u) const { return Bt + (size_t)u.pn * tstep; }
    __device__ __forceinline__ void gather(int, int, int, unsigned (&)[2][2]) const {}
};
struct MoeSched {
    const char* A; const char* Bt; size_t a_tstep, b_estep, b_tstep; int nunits; const LAS unsigned* ulist; const LAS unsigned* gtab; bool gath;
    __device__ __forceinline__ bool next(int i, Unit& u) const {
        if (i >= nunits) return false;
        const unsigned w = (unsigned)__builtin_amdgcn_readfirstlane((int)ulist[i]);
        u.pm = (int)(w & 0x3ffu); u.pn = (int)((w >> 10) & 0x7u); u.e = (int)((w >> 13) & 0x1fu); u.rt = (int)(w >> 18); u.slot = i; return true;
    }
    __device__ __forceinline__ const char* a_base(const Unit& u) const { return gath ? A : A + (size_t)u.pm * a_tstep; }
    __device__ __forceinline__ const char* b_base(const Unit& u) const { return Bt + (size_t)u.e * b_estep + (size_t)u.pn * b_tstep; }
    __device__ __forceinline__ void gather(int i, int R0, int R1, unsigned (&off)[2][2]) const {
        const LAS unsigned short* g = (const LAS unsigned short*)gtab + i * 256;
        off[0][0] = (unsigned)g[R0] << 10; off[0][1] = (unsigned)g[R1] << 10; off[1][0] = (unsigned)g[128 + R0] << 10; off[1][1] = (unsigned)g[128 + R1] << 10;
    }
};

#define PG8_SA(b, h) (((b) * 2 + (h)) * HTB)
#define PG8_SB(b, h) ((4 + (b) * 2 + (h)) * HTB)
#define PG8_GLDS(src, dstoff) __builtin_amdgcn_global_load_lds((const unsigned*)(src), (LAS unsigned*)(lds + (dstoff)), 16, 0, 0)
#define PG8_STAGE_B(bufoff, gbase) do { _Pragma("unroll") for (int _i = 0; _i < 2; ++_i) PG8_GLDS((const char*)(gbase) + voffB[_i], (bufoff) + ldsw + _i * 8192); } while (0)
#define PG8_STAGE_A(bufoff, kptr, h, o) do { _Pragma("unroll") for (int _i = 0; _i < 2; ++_i) \
        PG8_GLDS(GATHER ? (const char*)(kptr) + (o)[h][_i] : (const char*)(kptr) + (size_t)(h) * hstep + voffA[_i], (bufoff) + ldsw + _i * 8192); } while (0)
#define PG8_LDA(dst, b, h) do { _Pragma("unroll") for (int m = 0; m < 4; ++m) { if constexpr (F8) dst##8[m] = ld8(lds + PG8_SA(b, h) + a8_0 + m * 2048, lds + PG8_SA(b, h) + a8_1 + m * 2048); \
        else { _Pragma("unroll") for (int k = 0; k < 2; ++k) dst[m][k] = *(const LAS bf16x8*)(lds + PG8_SA(b, h) + aoff + m * 2048 + k * 1024); } } } while (0)
#define PG8_LDB(dst, b, h) do { _Pragma("unroll") for (int n = 0; n < 2; ++n) { if constexpr (F8) dst##8[n] = ld8(lds + PG8_SB(b, h) + b8_0 + n * 2048, lds + PG8_SB(b, h) + b8_1 + n * 2048); \
        else { _Pragma("unroll") for (int k = 0; k < 2; ++k) dst[n][k] = *(const LAS bf16x8*)(lds + PG8_SB(b, h) + boff + n * 2048 + k * 1024); } } } while (0)
#define PG8_MMA(ai, bj, At, Bt) do { __builtin_amdgcn_s_setprio(1); _Pragma("unroll") for (int m = 0; m < 4; ++m) _Pragma("unroll") for (int n = 0; n < 2; ++n) { \
        if constexpr (F8) asm volatile("v_mfma_scale_f32_16x16x128_f8f6f4 %0, %1, %2, %0, %3, %4 op_sel_hi:[0,0,0]" : "+v"(acc[ai][bj][m][n]) : "v"(Bt##8[n]), "v"(At##8[m]), "v"(sc_w), "v"(sc_a)); \
        else { _Pragma("unroll") for (int k = 0; k < 2; ++k) acc[ai][bj][m][n] = __builtin_amdgcn_mfma_f32_16x16x32_bf16(Bt[n][k], At[m][k], acc[ai][bj][m][n], 0, 0, 0); } } __builtin_amdgcn_s_setprio(0); } while (0)
#define PG8_WAIT_V(n) asm volatile("s_waitcnt vmcnt(" #n ")" ::: "memory")
#define PG8_WAIT_L(n) asm volatile("s_waitcnt lgkmcnt(" #n ")" ::: "memory")
#define PG8_BAR __builtin_amdgcn_s_barrier()
#define PG8_SCHED __builtin_amdgcn_sched_barrier(0)

template <class Epi, class Sched, bool GATHER, bool MIDK, bool F8 = false>
__device__ __forceinline__ void gemm_phase(LAS unsigned char* lds, const int KB  , const Sched& S, const Epi& E) {
    int tid = (int)threadIdx.x; asm volatile("" : "+v"(tid));
    const int wid = __builtin_amdgcn_readfirstlane(tid >> 6), lane = tid & 63, wr = wid >> 2, wc = wid & 3, fr = lane & 15, fq = lane >> 4;
    const int nt = KB / 128;
    unsigned voffA[2], voffB[2]; int Rg[2]; unsigned Cg[2];
#pragma unroll
    for (int i = 0; i < 2; ++i) { int R, C; stage_rc(tid * 16 + i * 8192, R, C); const int Rb = Epi::PERM ? ((R & ~31) + perm32(R & 31)) : R;
        voffA[i] = (unsigned)(R * KB + C * 2); voffB[i] = (unsigned)(Rb * KB + C * 2); Rg[i] = R; Cg[i] = (unsigned)C * 2u; }
    const size_t kstep = 128;
    const size_t hstep = (size_t)HALF * KB;
    const unsigned ldsw = (unsigned)wid * 1024u;
    const int aoff = lds_byte(wr * 64 + fr, fq * 8), boff = lds_byte(wc * 32 + fr, fq * 8);
    const int a8_0 = lds_byte(wr * 64 + fr, 16 * fq), a8_1 = lds_byte(wr * 64 + fr, 16 * fq + 8), b8_0 = lds_byte(wc * 32 + fr, 16 * fq), b8_1 = lds_byte(wc * 32 + fr, 16 * fq + 8);
    Unit cur, nxt; int ui = 0;
    if (!S.next(0, cur)) return;
    f32x4 acc[2][2][4][2];
#pragma unroll
    for (int a = 0; a < 2; ++a)
#pragma unroll
        for (int b = 0; b < 2; ++b)
#pragma unroll
            for (int m = 0; m < 4; ++m)
#pragma unroll
                for (int n = 0; n < 2; ++n) acc[a][b][m][n] = (f32x4){0.f, 0.f, 0.f, 0.f};
    bf16x8 At[4][2], B0[2][2], B1[2][2]; v8i At8[4], B08[2], B18[2];
    int sc_w = F8_SCALE_W, sc_a = 127; if constexpr (F8) { asm volatile("" : "+v"(sc_w), "+v"(sc_a)); }
    unsigned offC[2][2] = {{0u, 0u}, {0u, 0u}}, offN[2][2] = {{0u, 0u}, {0u, 0u}};
    if constexpr (GATHER) { S.gather(0, Rg[0], Rg[1], offC);
#pragma unroll
        for (int h = 0; h < 2; ++h)
#pragma unroll
            for (int i = 0; i < 2; ++i) offC[h][i] += Cg[i]; }
    const char* cA = S.a_base(cur); const char* cB = S.b_base(cur);
    PG8_STAGE_B(PG8_SB(0, 0), cB); PG8_STAGE_B(PG8_SB(0, 1), cB + hstep); PG8_STAGE_A(PG8_SA(0, 0), cA, 0, offC); PG8_STAGE_A(PG8_SA(0, 1), cA, 1, offC);
    if (wr == 1) PG8_BAR;
    PG8_WAIT_V(2); PG8_BAR;
    PG8_STAGE_B(PG8_SB(1, 0), cB + kstep); PG8_STAGE_A(PG8_SA(1, 0), cA + kstep, 0, offC); PG8_STAGE_B(PG8_SB(1, 1), cB + hstep + kstep);
    PG8_WAIT_V(6); PG8_BAR;
    for (;;) {
        const bool has_next = S.next(ui + 1, nxt);
        const char* nA = has_next ? S.a_base(nxt) : cA; const char* nB = has_next ? S.b_base(nxt) : cB;
        if constexpr (GATHER) { if (has_next) { S.gather(ui + 1, Rg[0], Rg[1], offN);
#pragma unroll
                for (int h = 0; h < 2; ++h)
#pragma unroll
                    for (int i = 0; i < 2; ++i) offN[h][i] += Cg[i]; }
            else {
#pragma unroll
                for (int h = 0; h < 2; ++h)
#pragma unroll
                    for (int i = 0; i < 2; ++i) offN[h][i] = offC[h][i]; } }
        for (int t = 0; t < nt; t += 2) {
            const bool last = (t == nt - 2);
            const char* a1 = cA + (size_t)(t + 1) * kstep;
            const char* a2 = last ? nA : cA + (size_t)(t + 2) * kstep; const char* b2 = last ? nB : cB + (size_t)(t + 2) * kstep;
            const char* a3 = a2 + kstep; const char* b3 = b2 + kstep;
            unsigned o2[2][2];
#pragma unroll
            for (int h = 0; h < 2; ++h)
#pragma unroll
                for (int i = 0; i < 2; ++i) o2[h][i] = last ? offN[h][i] : offC[h][i];
            if constexpr (MIDK) { if (t == nt / 2) E.midk(acc, cur, wr, fr); }
            PG8_LDB(B0, 0, 0); PG8_LDB(B1, 0, 1); PG8_SCHED; PG8_LDA(At, 0, 0); PG8_STAGE_A(PG8_SA(1, 1), a1, 1, offC);
            PG8_WAIT_V(8); PG8_WAIT_L(0); PG8_BAR; PG8_MMA(0, 0, At, B0); PG8_MMA(0, 1, At, B1); PG8_BAR; PG8_SCHED;
            PG8_LDA(At, 0, 1); PG8_STAGE_B(PG8_SB(0, 0), b2); PG8_STAGE_B(PG8_SB(0, 1), b2 + hstep); PG8_STAGE_A(PG8_SA(0, 0), a2, 0, o2);
            PG8_WAIT_V(8); PG8_WAIT_L(0); PG8_BAR; PG8_MMA(1, 0, At, B0); PG8_MMA(1, 1, At, B1); PG8_BAR; PG8_SCHED;
            PG8_LDB(B0, 1, 0); PG8_LDB(B1, 1, 1); PG8_SCHED; PG8_LDA(At, 1, 0); PG8_STAGE_A(PG8_SA(0, 1), a2, 1, o2);
            PG8_WAIT_V(8); PG8_WAIT_L(0); PG8_BAR; PG8_MMA(0, 0, At, B0); PG8_MMA(0, 1, At, B1); PG8_BAR; PG8_SCHED;
            PG8_LDA(At, 1, 1); PG8_STAGE_B(PG8_SB(1, 0), b3); PG8_STAGE_B(PG8_SB(1, 1), b3 + hstep); PG8_STAGE_A(PG8_SA(1, 0), a3, 0, o2);
            PG8_WAIT_V(8); PG8_WAIT_L(0); PG8_BAR; PG8_MMA(1, 0, At, B0); PG8_MMA(1, 1, At, B1); PG8_BAR; PG8_SCHED;
        }
        if (wr == 0) PG8_BAR;
        if constexpr (F8) asm volatile("s_nop 15\n\ts_nop 15" ::: "memory");
        E(acc, cur, wr, wc, fr, fq);
        if (!has_next) break;
#pragma unroll
        for (int a = 0; a < 2; ++a)
#pragma unroll
            for (int b = 0; b < 2; ++b)
#pragma unroll
                for (int m = 0; m < 4; ++m)
#pragma unroll
                    for (int n = 0; n < 2; ++n) acc[a][b][m][n] = (f32x4){0.f, 0.f, 0.f, 0.f};
        cur = nxt; cA = nA; cB = nB; ++ui;
        if constexpr (GATHER) {
#pragma unroll
            for (int h = 0; h < 2; ++h)
#pragma unroll
                for (int i = 0; i < 2; ++i) offC[h][i] = offN[h][i]; }
        if (wr == 1) PG8_BAR;
    }
    PG8_WAIT_V(0);
    PG8_BAR;
}
}

struct Frame {
    LAS unsigned char* lds;
    volatile LAS unsigned* MISC;
    gu32* ctl;
    unsigned char* ws;
    int vcu, G;
    const float *x, *p, *mix_norm, *w_in, *ln_g, *ln_b, *gws, *gbs, *aon, *gon, *w_out, *ffn_norm, *router_w, *router_b, *w_gu, *b_gu, *w_dn, *b_dn, *ple_norm, *w_pg, *w_pp, *ppn, *final_norm;
    float* out;
};
template <class T_> __device__ __forceinline__ T_* wsp(const Frame& F, size_t off) { return (T_*)(F.ws + off); }

#define PHASE_IDS int TID_ = (int)threadIdx.x; asm volatile("" : "+v"(TID_)); const int LANE_ = TID_ & 63; const int WAVE_ = __builtin_amdgcn_readfirstlane(TID_ >> 6); (void)LANE_; (void)WAVE_
template <class ColMap>
__device__ __forceinline__ void p0_transpose_item(const float* W, int K, int N, bf16* WT, const float* gain, LAS float* scr, int item, int lane, int nphys, const ColMap& cm) {
    const int nblk = nphys / 64, kb = item / nblk, nb = item % nblk, k0 = 64 * kb, n0 = 64 * nb;
    const int srccol = cm(n0 + lane);
    float v_[64]; const float* src = W + (size_t)k0 * N + srccol;
#pragma unroll
    for (int kk = 0; kk < 64; ++kk) v_[kk] = __builtin_nontemporal_load(src + (size_t)kk * N);
    if (gain) {
#pragma unroll
        for (int kk = 0; kk < 64; kk += 4) { const f32x4 g4 = *(const f32x4*)(gain + k0 + kk); v_[kk] *= g4[0]; v_[kk + 1] *= g4[1]; v_[kk + 2] *= g4[2]; v_[kk + 3] *= g4[3]; } }
#pragma unroll
    for (int kk = 0; kk < 64; ++kk) scr[kk * 65 + lane] = v_[kk];
    LDS_WAIT(); asm volatile("" ::: "memory");
    const int c = lane & 7;
#pragma unroll
    for (int j = 0; j < 8; ++j) { const int n = (lane >> 3) + 8 * j; const LAS float* s = scr + (8 * c) * 65 + n;
        v4u o; o.x = pk2(s[0 * 65], s[1 * 65]); o.y = pk2(s[2 * 65], s[3 * 65]); o.z = pk2(s[4 * 65], s[5 * 65]); o.w = pk2(s[6 * 65], s[7 * 65]);
        *(GAS v4u*)(WT + (size_t)(n0 + n) * K + k0 + 8 * c) = o; }
    LDS_WAIT(); asm volatile("" ::: "memory");
}
template <class ColMap>
__device__ __forceinline__ void p0_transpose_item_f8(const float* W, int K, int N, unsigned char* WT, const float* gain, LAS float* scr, int item, int lane, int nphys, const ColMap& cm) {
    const int nblk = nphys / 64, kb = item / nblk, nb = item % nblk, k0 = 64 * kb, n0 = 64 * nb;
    const int srccol = cm(n0 + lane);
    float v_[64]; const float* src = W + (size_t)k0 * N + srccol;
#pragma unroll
    for (int kk = 0; kk < 64; ++kk) v_[kk] = __builtin_nontemporal_load(src + (size_t)kk * N);
    constexpr float WS_ = (float)(1 << pg8::F8_WSHIFT);
#pragma unroll
    for (int kk = 0; kk < 64; kk += 4) { f32x4 g4 = gain ? *(const f32x4*)(gain + k0 + kk) : (f32x4){1.f, 1.f, 1.f, 1.f}; v_[kk] *= g4[0] * WS_; v_[kk + 1] *= g4[1] * WS_; v_[kk + 2] *= g4[2] * WS_; v_[kk + 3] *= g4[3] * WS_; }
#pragma unroll
    for (int kk = 0; kk < 64; ++kk) scr[kk * 65 + lane] = v_[kk];
    LDS_WAIT(); asm volatile("" ::: "memory");
    const int c = lane & 3;
#pragma unroll
    for (int j = 0; j < 4; ++j) { const int n = (lane >> 2) + 16 * j; const LAS float* s_ = scr + (16 * c) * 65 + n;
        v4u o; o.x = pk4_fp8(s_[0 * 65], s_[1 * 65], s_[2 * 65], s_[3 * 65]); o.y = pk4_fp8(s_[4 * 65], s_[5 * 65], s_[6 * 65], s_[7 * 65]);
        o.z = pk4_fp8(s_[8 * 65], s_[9 * 65], s_[10 * 65], s_[11 * 65]); o.w = pk4_fp8(s_[12 * 65], s_[13 * 65], s_[14 * 65], s_[15 * 65]);
        *(GAS v4u*)(WT + (size_t)(n0 + n) * K + k0 + 16 * c) = o; }
    LDS_WAIT(); asm volatile("" ::: "memory");
}
struct CmId { __device__ __forceinline__ int operator()(int n) const { return n; } };
struct CmWin { __device__ __forceinline__ int operator()(int n) const { if (n >= 2 * AW) return n; const int c = n & 63; return (n & ~63) + 4 * (c >> 3) + (c & 3) + 32 * ((c >> 2) & 1); } };
struct CmWgu { __device__ __forceinline__ int operator()(int n) const { return ((n >> 7) & 1) * FF + (n >> 8) * 128 + (n & 127); } };

constexpr int XW_I_GU = (DM / 64) * (2 * FF / 64), XW_I_DN = (FF / 64) * (DM / 64), XW_ITEMS = NE * (XW_I_GU + XW_I_DN);
__device__ __forceinline__ void xw_convert_item(const Frame& F, int it, LAS float* scr, int lane) {
    if (it < NE * XW_I_GU) { const int e = it / XW_I_GU; p0_transpose_item_f8(F.w_gu + (size_t)e * DM * 2 * FF, DM, 2 * FF, wsp<unsigned char>(F, WS_WGU) + (size_t)e * 2 * FF * DM, F.ffn_norm, scr, it % XW_I_GU, lane, 2 * FF, CmWgu()); }
    else { const int r = it - NE * XW_I_GU, e = r / XW_I_DN; p0_transpose_item_f8(F.w_dn + (size_t)e * FF * DM, FF, DM, wsp<unsigned char>(F, WS_WDN) + (size_t)e * DM * FF, nullptr, scr, r % XW_I_DN, lane, DM, CmId()); }
}
__device__ __forceinline__ void p0_prologue(Frame& F) {
    PHASE_IDS;
    LAS float* scr = (LAS float*)(F.lds + RING_OFF + WAVE_ * P0_SCR_WAVE);
    const int gw = F.vcu * NWAVES + WAVE_, NGW = F.G * NWAVES;
    constexpr int I_GU = (DM / 64) * (2 * FF / 64), I_DN = (FF / 64) * (DM / 64), I_IN = (DM / 64) * (NPROJ / 64), I_SQ = (DM / 64) * (DM / 64), I_PP = (PLE / 64) * (DM / 64);
    constexpr int NITEMS = I_IN + 2 * I_SQ + I_PP;
    (void)I_GU; (void)I_DN;
    for (int it = gw; it < NITEMS; it += NGW) {
        int r = it;
        if (r < I_IN) { p0_transpose_item(F.w_in, DM, NPROJ, wsp<bf16>(F, WS_WIN), F.mix_norm, scr, r, LANE_, NPROJ, CmWin()); continue; } r -= I_IN;
        if (r < I_SQ) {
            const int nblk = DM / 64, kb = r / nblk; const float* g = (kb < 8) ? F.aon : (F.gon - AW);
            p0_transpose_item(F.w_out, DM, DM, wsp<bf16>(F, WS_WOUT), g, scr, r, LANE_, DM, CmId()); continue; } r -= I_SQ;
        if (r < I_SQ) { p0_transpose_item_f8(F.w_pg, DM, DM, wsp<unsigned char>(F, WS_WPG8), F.ple_norm, scr, r, LANE_, DM, CmId()); continue; } r -= I_SQ;
        p0_transpose_item(F.w_pp, PLE, DM, wsp<bf16>(F, WS_WPP), nullptr, scr, r, LANE_, DM, CmId());
    }
    if (TPROBE && blockIdx.x == 0 && threadIdx.x == 0) ((unsigned long long*)(F.ctl + CW_TS))[11] = __builtin_amdgcn_s_memrealtime();
    bf16* XN = wsp<bf16>(F, WS_XNB);
    for (int m0 = gw; m0 < T; m0 += 2 * NGW) {
        f32x4 v[2][4]; float s[2] = {0.f, 0.f};
#pragma unroll
        for (int r = 0; r < 2; ++r) { const GAS f32x4* xr = (const GAS f32x4*)(F.x + (size_t)(m0 + r * NGW) * DM) + LANE_;
#pragma unroll
            for (int j = 0; j < 4; ++j) v[r][j] = __builtin_nontemporal_load(xr + 64 * j); }
#pragma unroll
        for (int r = 0; r < 2; ++r) {
#pragma unroll
            for (int j = 0; j < 4; ++j) s[r] += (v[r][j].x * v[r][j].x + v[r][j].y * v[r][j].y) + (v[r][j].z * v[r][j].z + v[r][j].w * v[r][j].w); }
#pragma unroll
        for (int r = 0; r < 2; ++r) { const int m = m0 + r * NGW; const float sig = sqrtf(wave_sum(s[r]) * (1.f / DM) + EPS), rstd = 1.0f / sig;
            if (LANE_ == 0) wsp<float>(F, WS_SIG0)[m] = sig;
            GAS v2u* o8 = (GAS v2u*)(XN + (size_t)m * DM) + LANE_;
#pragma unroll
            for (int j = 0; j < 4; ++j) { v2u w; w.x = pk2(v[r][j].x * rstd, v[r][j].y * rstd); w.y = pk2(v[r][j].z * rstd, v[r][j].w * rstd); o8[64 * j] = w; } }
    }
    if (TPROBE && blockIdx.x == 0 && threadIdx.x == 0) ((unsigned long long*)(F.ctl + CW_TS))[12] = __builtin_amdgcn_s_memrealtime();
    { const GAS f32x4* pr = (const GAS f32x4*)F.p; GAS v2u* po = (GAS v2u*)wsp<bf16>(F, WS_PB);
      const size_t n4 = (size_t)T * PLE / 4, gt = (size_t)(F.vcu * NTHR + TID_), GT = (size_t)F.G * NTHR;
      for (size_t i = gt; i < n4; i += GT) { const f32x4 v = pr[i]; v2u w; w.x = pk2(v.x, v.y); w.y = pk2(v.z, v.w); po[i] = w; } }
    if (TPROBE && blockIdx.x == 0 && threadIdx.x == 0) ((unsigned long long*)(F.ctl + CW_TS))[13] = __builtin_amdgcn_s_memrealtime();
    { const int gt = F.vcu * NTHR + TID_, GT = F.G * NTHR; float* RWG = wsp<float>(F, WS_RWG);
      (void)RWG; bf16* RWT = wsp<bf16>(F, WS_RWT);
      for (int i = gt; i < DM * NE; i += GT) { const int e = i / DM, k = i % DM; const float w = F.router_w[k * NE + e] * F.ffn_norm[k]; const unsigned hi = f2bf(w); const float lo = w - bf2f((bf16)hi); RWT[i] = (bf16)hi; RWT[NE * DM + i] = (bf16)f2bf(lo); }
      float* RC = wsp<float>(F, WS_ROPE); float* RS = RC + SEQ * 32;
      for (int i = gt; i < SEQ * 32; i += GT) { const int pos = i >> 5, j = i & 31; const float inv = powf(10000.0f, -(float)j / 32.0f); const float ang = (float)pos * inv; float sn, cs; sincosf(ang, &sn, &cs); RC[i] = cs; RS[i] = sn; } }
}

using pg8::Unit;
constexpr int HALF = 128;
struct EpiInProj {
    static constexpr bool PERM = true;
    bf16* QKVUV; const float *rc, *rs; float* kmean;
    __device__ __forceinline__ void operator()(const f32x4 (&acc)[2][2][4][2], const Unit& u, int wr, int wc, int fr, int fq) const {
        const int type = u.pn >> 1, colt = (u.pn & 1) * 256 + wc * 32 + 8 * fq;
        const int row0 = u.pm * 256 + wr * 64 + fr;
        if (type <= 1) {
            bf16* dst = QKVUV + (size_t)type * (16u << 20);
            const int pos0 = (u.pm & 7) * 256 + wr * 64 + fr, i0 = 16 * (wc & 1) + 4 * fq;
            f32x4 cs_[2][2];
#pragma unroll
            for (int bj = 0; bj < 2; ++bj) { cs_[bj][0] = (f32x4){0.f, 0.f, 0.f, 0.f}; cs_[bj][1] = (f32x4){0.f, 0.f, 0.f, 0.f}; }
#pragma unroll
            for (int ai = 0; ai < 2; ++ai) { f32x4 cc[4], ss[4];
#pragma unroll
                for (int m = 0; m < 4; ++m) { const int pos = pos0 + ai * HALF + m * 16; cc[m] = *(const f32x4*)(rc + pos * 32 + i0); ss[m] = *(const f32x4*)(rs + pos * 32 + i0); }
#pragma unroll
                for (int m = 0; m < 4; ++m) { const int ro = ai * HALF + m * 16; const f32x4 c = cc[m], s = ss[m];
                    bf16* rowp = dst + (size_t)(row0 + ro) * AW + colt;
#pragma unroll
                    for (int bj = 0; bj < 2; ++bj) { const f32x4 x1 = acc[ai][bj][m][0], x2 = acc[ai][bj][m][1];
                        const f32x4 o1 = x1 * c - x2 * s, o2 = x2 * c + x1 * s;
                        cs_[bj][0] += o1; cs_[bj][1] += o2;
                        v4u w; w.x = cvt_pk_bf16(o1[0], o1[1]); w.y = cvt_pk_bf16(o1[2], o1[3]); w.z = cvt_pk_bf16(o2[0], o2[1]); w.w = cvt_pk_bf16(o2[2], o2[3]);
                        *(v4u*)(rowp + bj * HALF) = w; } }
                asm volatile("" ::: "memory"); }
            if (type == 1) {
#pragma unroll
                for (int bj = 0; bj < 2; ++bj)
#pragma unroll
                    for (int n = 0; n < 2; ++n)
#pragma unroll
                        for (int j = 0; j < 4; ++j) { float v = cs_[bj][n][j]; v += __shfl_xor(v, 1); v += __shfl_xor(v, 2); v += __shfl_xor(v, 4); v += __shfl_xor(v, 8); cs_[bj][n][j] = v; }
                if (fr == 0) { const int b = u.pm >> 3, blk = u.pm & 7;
#pragma unroll
                    for (int bj = 0; bj < 2; ++bj) { const int colh = (u.pn & 1) * 256 + bj * HALF + wc * 32; const int head = colh >> 6, cpos = (colh & 63) + 8 * fq;
                        float* km = kmean + ((size_t)((b * NH + head) * NBLK + blk)) * HD + cpos;
#pragma unroll
                        for (int n = 0; n < 2; ++n)
#pragma unroll
                            for (int j = 0; j < 4; ++j) atomicAdd(km + 4 * n + j, cs_[bj][n][j]); } }
            }
        } else {
            bf16* dst = QKVUV + (size_t)type * (16u << 20);
#pragma unroll
            for (int ai = 0; ai < 2; ++ai)
#pragma unroll
                for (int m = 0; m < 4; ++m) { bf16* rowp = dst + (size_t)(row0 + ai * HALF + m * 16) * AW + colt;
#pragma unroll
                    for (int bj = 0; bj < 2; ++bj) { f32x4 v0 = acc[ai][bj][m][0], v1 = acc[ai][bj][m][1];
                        if (type >= 3) { v0 = gelu4(v0); v1 = gelu4(v1); }
                        v4u w; w.x = cvt_pk_bf16(v0[0], v0[1]); w.y = cvt_pk_bf16(v0[2], v0[3]); w.z = cvt_pk_bf16(v1[0], v1[1]); w.w = cvt_pk_bf16(v1[2], v1[3]);
                        *(v4u*)(rowp + bj * HALF) = w; } }
        }
    }
};
struct EpiOutProj {
    static constexpr bool PERM = true;
    const bf16* xn; bf16* x1; unsigned char* x1f8; float* ssq1; const LAS f32x4* rtab;
    int pm_a, pm_b;
    __device__ __forceinline__ int slot(const Unit& u) const { return u.pm == pm_a ? 0 : 1; }
    __device__ __forceinline__ void midk(f32x4 (&acc)[2][2][4][2], const Unit& u, int wr, int fr) const {
        const LAS f32x4* t = rtab + slot(u) * 256 + wr * 64 + fr;
#pragma unroll
        for (int ai = 0; ai < 2; ++ai)
#pragma unroll
            for (int m = 0; m < 4; ++m) { const float r = t[ai * HALF + m * 16].x;
#pragma unroll
                for (int bj = 0; bj < 2; ++bj)
#pragma unroll
                    for (int n = 0; n < 2; ++n) acc[ai][bj][m][n] *= r; }
    }
    __device__ __forceinline__ void operator()(const f32x4 (&acc)[2][2][4][2], const Unit& u, int wr, int wc, int fr, int fq) const {
        const LAS f32x4* t = rtab + slot(u) * 256 + wr * 64 + fr;
        const int row0 = u.pm * 256 + wr * 64 + fr, col0 = u.pn * 256 + wc * 32 + 8 * fq;
#pragma unroll
        for (int ai = 0; ai < 2; ++ai) { v4u xv[4][2];
#pragma unroll
            for (int m = 0; m < 4; ++m) { const size_t off = (size_t)(row0 + ai * HALF + m * 16) * DM + col0;
                xv[m][0] = *(const v4u*)(xn + off); xv[m][1] = *(const v4u*)(xn + off + HALF); }
#pragma unroll
            for (int m = 0; m < 4; ++m) { const int ro = ai * HALF + m * 16; const f32x4 tv = t[ro]; const float rg = tv.y, sx = tv.z; const size_t off = (size_t)(row0 + ro) * DM + col0; float q = 0.f;
#pragma unroll
                for (int bj = 0; bj < 2; ++bj) { const v4u xw = xv[m][bj];
                    const f32x4 x0 = {bflo(xw.x), bfhi(xw.x), bflo(xw.y), bfhi(xw.y)}, x1_ = {bflo(xw.z), bfhi(xw.z), bflo(xw.w), bfhi(xw.w)};
                    const f32x4 o0 = x0 * sx + acc[ai][bj][m][0] * rg, o1 = x1_ * sx + acc[ai][bj][m][1] * rg;
                    q += (o0[0] * o0[0] + o0[1] * o0[1]) + (o0[2] * o0[2] + o0[3] * o0[3]) + (o1[0] * o1[0] + o1[1] * o1[1]) + (o1[2] * o1[2] + o1[3] * o1[3]);
                    v4u w; w.x = cvt_pk_bf16(o0[0], o0[1]); w.y = cvt_pk_bf16(o0[2], o0[3]); w.z = cvt_pk_bf16(o1[0], o1[1]); w.w = cvt_pk_bf16(o1[2], o1[3]);
                    *(v4u*)(x1 + off + bj * HALF) = w;
                    v2u w8; w8.x = pk4_fp8(o0[0], o0[1], o0[2], o0[3]); w8.y = pk4_fp8(o1[0], o1[1], o1[2], o1[3]); *(v2u*)(x1f8 + off + bj * HALF) = w8; }
                q += __shfl_xor(q, 16); q += __shfl_xor(q, 32);
                if (fq == 0) ssq1[(size_t)(row0 + ro) * 16 + u.pn * 4 + wc] = q; }
            asm volatile("" ::: "memory"); }
    }
};
struct EpiMoe1 {
    static constexpr bool PERM = true;
    unsigned char* A; const float* b_gu; const LAS float* rss;
    __device__ __forceinline__ void operator()(const f32x4 (&acc)[2][2][4][2], const Unit& u, int wr, int wc, int fr, int fq) const {
        const int row0 = u.pm * 256 + wr * 64 + fr, col = u.pn * 128 + wc * 32 + 8 * fq;
        const float* bg = b_gu + (size_t)u.e * 2 * FF + col; const LAS float* rs_ = rss + u.slot * 256 + wr * 64 + fr;
        float rsv[2][4];
#pragma unroll
        for (int ai = 0; ai < 2; ++ai)
#pragma unroll
            for (int m = 0; m < 4; ++m) rsv[ai][m] = rs_[ai * HALF + m * 16];
        f32x4 bgv[2], blv[2];
#pragma unroll
        for (int n = 0; n < 2; ++n) { bgv[n] = *(const f32x4*)(bg + 4 * n); blv[n] = *(const f32x4*)(bg + FF + 4 * n); }
#pragma unroll
        for (int ai = 0; ai < 2; ++ai)
#pragma unroll
            for (int m = 0; m < 4; ++m) { f32x4 a[2];
#pragma unroll
                for (int n = 0; n < 2; ++n) { const f32x4 g = acc[ai][0][m][n] * rsv[ai][m] + bgv[n], l = acc[ai][1][m][n] * rsv[ai][m] + blv[n];
#pragma unroll
                    for (int p = 0; p < 2; ++p) { f32x2 gc = {fminf(g[2 * p], 7.0f), fminf(g[2 * p + 1], 7.0f)}; f32x2 lc = {fminf(fmaxf(l[2 * p], -7.0f), 7.0f), fminf(fmaxf(l[2 * p + 1], -7.0f), 7.0f)};
                        const f32x2 z = gc * (-1.702f * 1.4426950408889634f); f32x2 e; e.x = __builtin_amdgcn_exp2f(z.x); e.y = __builtin_amdgcn_exp2f(z.y);
                        const f32x2 d = e + 1.0f; f32x2 r; r.x = __builtin_amdgcn_rcpf(d.x); r.y = __builtin_amdgcn_rcpf(d.y);
                        const f32x2 o = (gc * r) * (lc + 1.0f); a[n][2 * p] = o.x; a[n][2 * p + 1] = o.y; } }
                v2u w; w.x = pk4_fp8(a[0][0], a[0][1], a[0][2], a[0][3]); w.y = pk4_fp8(a[1][0], a[1][1], a[1][2], a[1][3]);
                *(v2u*)(A + (size_t)(row0 + ai * HALF + m * 16) * FF + col) = w; }
    }
};
constexpr float Y_SCALE = 16.0f;
struct EpiMoe2 {
    static constexpr bool PERM = true;
    unsigned char* Y; const float* b_dn; const LAS float* gss;
    __device__ __forceinline__ void operator()(const f32x4 (&acc)[2][2][4][2], const Unit& u, int wr, int wc, int fr, int fq) const {
        const int row0 = u.pm * 256 + wr * 64 + fr, col0 = u.pn * 256 + wc * 32 + 8 * fq;
        const LAS float* gs = gss + u.slot * 256 + wr * 64 + fr;
        f32x4 bv[2][2]; float gv[2][4];
#pragma unroll
        for (int bj = 0; bj < 2; ++bj)
#pragma unroll
            for (int n = 0; n < 2; ++n) bv[bj][n] = *(const f32x4*)(b_dn + (size_t)u.e * DM + col0 + bj * HALF + 4 * n);
#pragma unroll
        for (int ai = 0; ai < 2; ++ai)
#pragma unroll
            for (int m = 0; m < 4; ++m) gv[ai][m] = gs[ai * HALF + m * 16] * Y_SCALE;
#pragma unroll
        for (int ai = 0; ai < 2; ++ai)
#pragma unroll
            for (int m = 0; m < 4; ++m) { const float g = gv[ai][m]; unsigned char* rowp = Y + (size_t)(row0 + ai * HALF + m * 16) * DM + col0;
#pragma unroll
                for (int bj = 0; bj < 2; ++bj) { const f32x4 v0 = (acc[ai][bj][m][0] + bv[bj][0]) * g, v1 = (acc[ai][bj][m][1] + bv[bj][1]) * g;
                    v2u w; w.x = pk4_fp8(v0[0], v0[1], v0[2], v0[3]); w.y = pk4_fp8(v1[0], v1[1], v1[2], v1[3]);
                    *(v2u*)(rowp + bj * HALF) = w; } }
    }
};
constexpr float GATE_SCALE = 128.0f;
template <int MODE> struct EpiPle {
    static constexpr bool PERM = true;
    unsigned char* O; float* ssq; const LAS float* rtab; int pm_a;
    __device__ __forceinline__ void operator()(const f32x4 (&acc)[2][2][4][2], const Unit& u, int wr, int wc, int fr, int fq) const {
        const int row0 = u.pm * 256 + wr * 64 + fr, col0 = u.pn * 256 + wc * 32 + 8 * fq;
        float rsv[2][4];
#pragma unroll
        for (int ai = 0; ai < 2; ++ai)
#pragma unroll
            for (int m = 0; m < 4; ++m) rsv[ai][m] = (MODE == 0) ? rtab[(u.pm == pm_a ? 0 : 256) + wr * 64 + fr + ai * HALF + m * 16] : 1.0f;
#pragma unroll
        for (int ai = 0; ai < 2; ++ai)
#pragma unroll
            for (int m = 0; m < 4; ++m) { unsigned char* rowp = O + (size_t)(row0 + ai * HALF + m * 16) * DM + col0; float q = 0.f; const float rs = rsv[ai][m];
#pragma unroll
                for (int bj = 0; bj < 2; ++bj) { f32x4 v0 = acc[ai][bj][m][0], v1 = acc[ai][bj][m][1];
                    if (MODE == 0) {
#pragma unroll
                        for (int j = 0; j < 4; ++j) { v0[j] = GATE_SCALE * sigmoidf_fast(rs * v0[j]); v1[j] = GATE_SCALE * sigmoidf_fast(rs * v1[j]); } }
                    else { q += (v0[0] * v0[0] + v0[1] * v0[1]) + (v0[2] * v0[2] + v0[3] * v0[3]) + (v1[0] * v1[0] + v1[1] * v1[1]) + (v1[2] * v1[2] + v1[3] * v1[3]); }
                    v2u w; w.x = pk4_fp8(v0[0], v0[1], v0[2], v0[3]); w.y = pk4_fp8(v1[0], v1[1], v1[2], v1[3]);
                    *(v2u*)(rowp + bj * HALF) = w; }
                if (MODE == 1) { q += __shfl_xor(q, 16); q += __shfl_xor(q, 32); if (fq == 0) ssq[(size_t)(row0 + ai * HALF + m * 16) * 16 + u.pn * 4 + wc] = q; } }
    }
};

namespace att {
constexpr int QBLK = 32, KVBLK = 64;
constexpr float SCALE = 0.125f, THR = 8.f;
constexpr int SHM_V = KVBLK * HD * 2, SHM_K = SHM_V;
constexpr int NSLOT = 3;
constexpr int LDS_BYTES_ = NSLOT * SHM_V + NSLOT * SHM_K + NWAVES * 64 * 4;
#define ATT_KSWZ(row, colB) ((row) * 128 + ((colB) ^ (((row) & 7) << 4)))
#define ATT_SBAR() __builtin_amdgcn_sched_barrier(0)
__device__ __forceinline__ int crow(int r, int hi) { return (r & 3) + 8 * (r >> 2) + 4 * hi; }
__device__ __forceinline__ void cmask(f32x16& p0, f32x16& p1, int jb, int qrel, int hi) {
    const float NEG = -__builtin_inff(); const int kb = 64 * jb + 4 * hi;
#pragma unroll
    for (int r = 0; r < 16; ++r) { const int kv = kb + (r & 3) + 8 * (r >> 2); if (kv > qrel) p0[r] = NEG; if (kv + 32 > qrel) p1[r] = NEG; }
}
__device__ __forceinline__ void bmask(f32x16& p0, f32x16& p1, bool keep) {
    const float NEG = -__builtin_inff();
    if (!keep) {
#pragma unroll
        for (int r = 0; r < 16; ++r) { p0[r] = NEG; p1[r] = NEG; } }
}
__device__ __forceinline__ void partialSM(f32x16& p0, f32x16& p1, float& m_reg, float& mn, float& alpha, bool keep) {
    float pmax = p0[0];
#pragma unroll
    for (int r = 1; r < 16; ++r) pmax = fmaxf(pmax, p0[r]);
#pragma unroll
    for (int r = 0; r < 16; ++r) pmax = fmaxf(pmax, p1[r]);
    { auto rr = __builtin_amdgcn_permlane32_swap(__float_as_uint(pmax), __float_as_uint(pmax), false, false);
      pmax = fmaxf(__uint_as_float(rr[0]), __uint_as_float(rr[1])); }
    if (!keep) pmax = -__builtin_inff();
    constexpr float C2 = 1.4426950408889634f * SCALE;
    if (__builtin_expect(__all((pmax - m_reg) * SCALE <= THR), 1)) { mn = m_reg; alpha = 1.f; }
    else { mn = fmaxf(m_reg, pmax); alpha = __builtin_amdgcn_exp2f((m_reg - mn) * C2); m_reg = mn; }
    const float mnL = keep ? -mn * C2 : -__builtin_inff(), c2 = keep ? C2 : 0.f;
#pragma unroll
    for (int r = 0; r < 16; ++r) p0[r] = fmaf(p0[r], c2, mnL);
#pragma unroll
    for (int r = 0; r < 16; ++r) p1[r] = fmaf(p1[r], c2, mnL);
#pragma unroll
    for (int r = 0; r < 16; ++r) p0[r] = __builtin_amdgcn_exp2f(p0[r]);
}
__device__ __forceinline__ void finishSM(f32x16& p0, f32x16& p1, float alpha, float& l_reg, bf16x8& pa0, bf16x8& pa1, bf16x8& pa2, bf16x8& pa3) {
#pragma unroll
    for (int r = 0; r < 16; ++r) p1[r] = __builtin_amdgcn_exp2f(p1[r]);
    float ps = 0;
#pragma unroll
    for (int r = 0; r < 16; ++r) ps += p0[r];
#pragma unroll
    for (int r = 0; r < 16; ++r) ps += p1[r];
    { auto rr = __builtin_amdgcn_permlane32_swap(__float_as_uint(ps), __float_as_uint(ps), false, false);
      ps = __uint_as_float(rr[0]) + __uint_as_float(rr[1]); }
    l_reg = l_reg * alpha + ps;
#define ATT_PK4(P, B, OUT) do { unsigned a0 = cvt_pk_bf16(P[B+0], P[B+1]), a1 = cvt_pk_bf16(P[B+2], P[B+3]);             \
        unsigned b0 = cvt_pk_bf16(P[B+4], P[B+5]), b1 = cvt_pk_bf16(P[B+6], P[B+7]);                                       \
        auto r0 = __builtin_amdgcn_permlane32_swap(a0, b0, false, false); auto r1 = __builtin_amdgcn_permlane32_swap(a1, b1, false, false); \
        v4u w = {r0[0], r1[0], r0[1], r1[1]}; OUT = *reinterpret_cast<bf16x8*>(&w); } while (0)
    ATT_PK4(p0, 0, pa0); ATT_PK4(p0, 8, pa1); ATT_PK4(p1, 0, pa2); ATT_PK4(p1, 8, pa3);
#undef ATT_PK4
}
__device__ __forceinline__ void qkt(f32x16& p0, f32x16& p1, const LAS unsigned char* Ks, const bf16x8* qr, int r32, int hi) {
    p0 = f32x16{}; p1 = f32x16{};
#pragma unroll
    for (int d0 = 0; d0 < 4; ++d0) { const int cb = (d0 * 16 + hi * 8) * 2;
        const bf16x8 b0 = *(const LAS bf16x8*)(Ks + ATT_KSWZ(r32, cb));
        const bf16x8 b1 = *(const LAS bf16x8*)(Ks + ATT_KSWZ(32 + r32, cb));
        p0 = __builtin_amdgcn_mfma_f32_32x32x16_bf16(b0, qr[d0], p0, 0, 0, 0);
        p1 = __builtin_amdgcn_mfma_f32_32x32x16_bf16(b1, qr[d0], p1, 0, 0, 0); }
}
__device__ __forceinline__ void pv(f32x16* o, int vb, bf16x8 pa0, bf16x8 pa1, bf16x8 pa2, bf16x8 pa3) {
#pragma unroll
    for (int d0 = 0; d0 < 2; ++d0) { s16x4 lo[4], hi[4];
#pragma unroll
        for (int ks = 0; ks < 4; ++ks) { const int a = vb + d0 * 2048 + (ks >> 1) * 4096 + (ks & 1) * 512;
            asm volatile("ds_read_b64_tr_b16 %0,%1" : "=&v"(lo[ks]) : "v"(a) : "memory");
            asm volatile("ds_read_b64_tr_b16 %0,%1 offset:128" : "=&v"(hi[ks]) : "v"(a) : "memory"); }
        asm volatile("s_waitcnt lgkmcnt(0)" ::: "memory"); ATT_SBAR();
#define ATT_PK(k) (bf16x8){lo[k][0], lo[k][1], lo[k][2], lo[k][3], hi[k][0], hi[k][1], hi[k][2], hi[k][3]}
        o[d0] = __builtin_amdgcn_mfma_f32_32x32x16_bf16(pa0, ATT_PK(0), o[d0], 0, 0, 0);
        o[d0] = __builtin_amdgcn_mfma_f32_32x32x16_bf16(pa1, ATT_PK(1), o[d0], 0, 0, 0);
        o[d0] = __builtin_amdgcn_mfma_f32_32x32x16_bf16(pa2, ATT_PK(2), o[d0], 0, 0, 0);
        o[d0] = __builtin_amdgcn_mfma_f32_32x32x16_bf16(pa3, ATT_PK(3), o[d0], 0, 0, 0);
#undef ATT_PK
    }
}
__device__ __forceinline__ void attn_unit(const Frame& F, int b, int h, int qb, LAS unsigned char* scratch) {
    PHASE_IDS;
    const int tid = TID_, wid = tid >> 6, lane = tid & 63, r32 = lane & 31, hi = lane >> 5;
    const bf16* Qg = wsp<bf16>(F, WS_Q); const bf16* Kg = wsp<bf16>(F, WS_K); const bf16* Vg = wsp<bf16>(F, WS_V);
    const size_t rowbase = (size_t)b * SEQ; const int q0 = qb * MOBA;
    const bf16* Qw = Qg + (rowbase + q0 + wid * QBLK) * AW + h * HD;
    const bf16* Kh = Kg + rowbase * AW + h * HD; const bf16* Vh = Vg + rowbase * AW + h * HD;
    LAS unsigned char* V_lds = scratch; LAS unsigned char* K_lds = scratch + NSLOT * SHM_V;
    LAS float* wsf = (LAS float*)(scratch + NSLOT * SHM_V + NSLOT * SHM_K) + wid * 64; LAS float* li_l = wsf; LAS float* al_l = wsf + 32;
    float m_reg = -1e30f, l_reg = 0.f; f32x16 o[2]; o[0] = f32x16{}; o[1] = f32x16{}; bf16x8 qr[4];
#pragma unroll
    for (int d0 = 0; d0 < 4; ++d0) qr[d0] = *(const bf16x8*)(Qw + (size_t)r32 * AW + d0 * 16 + hi * 8);
    unsigned sel = 0u;
    if (qb <= 3) sel = (1u << qb) - 1u;
    else {
        const float* km = wsp<float>(F, WS_KMEAN) + (size_t)((b * NH + h) * NBLK) * HD + (size_t)(r32 & 7) * HD + hi * 8;
        f32x4 kv[4][2];
#pragma unroll
        for (int d0 = 0; d0 < 4; ++d0) { kv[d0][0] = *(const f32x4*)(km + d0 * 16); kv[d0][1] = *(const f32x4*)(km + d0 * 16 + 4); }
        f32x16 gacc = f32x16{};
#pragma unroll
        for (int d0 = 0; d0 < 4; ++d0) { float f[8] = {kv[d0][0][0], kv[d0][0][1], kv[d0][0][2], kv[d0][0][3], kv[d0][1][0], kv[d0][1][1], kv[d0][1][2], kv[d0][1][3]};
            unsigned hw[4], lw[4];
#pragma unroll
            for (int p = 0; p < 4; ++p) { float a0 = f[2 * p], a1 = f[2 * p + 1]; if (r32 >= 8) { a0 = 0.f; a1 = 0.f; }
                const unsigned h0 = f2bf(a0), h1 = f2bf(a1); hw[p] = h0 | (h1 << 16); lw[p] = pk2(a0 - bf2f((bf16)h0), a1 - bf2f((bf16)h1)); }
            const v4u hv = {hw[0], hw[1], hw[2], hw[3]}, lv = {lw[0], lw[1], lw[2], lw[3]};
            gacc = __builtin_amdgcn_mfma_f32_32x32x16_bf16(__builtin_bit_cast(bf16x8, hv), qr[d0], gacc, 0, 0, 0);
            gacc = __builtin_amdgcn_mfma_f32_32x32x16_bf16(__builtin_bit_cast(bf16x8, lv), qr[d0], gacc, 0, 0, 0); }
        float g[8];
#pragma unroll
        for (int r = 0; r < 4; ++r) { const float mine = gacc[r], other = __shfl_xor(mine, 32); g[r] = hi ? other : mine; g[4 + r] = hi ? mine : other; }
        float b0 = -__builtin_inff(), b1 = b0, b2 = b0; int i0 = 0, i1 = 0, i2 = 0;
#pragma unroll
        for (int j = 0; j < NBLK - 1; ++j) { const float s_ = (j < qb) ? g[j] : -__builtin_inff();
            if (s_ > b0) { b2 = b1; i2 = i1; b1 = b0; i1 = i0; b0 = s_; i0 = j; } else if (s_ > b1) { b2 = b1; i2 = i1; b1 = s_; i1 = j; } else if (s_ > b2) { b2 = s_; i2 = j; } }
        sel = (1u << i0) | (1u << i1) | (1u << i2);
    }
    const int sr = tid >> 3, sc = (tid & 7) * 8;
    const int vst = 2 * ((sr >> 5) * 2048 + (sc >> 4) * 512 + (sr & 31) * 16 + (sc & 8));
    const int vb0 = (int)(size_t)V_lds + (lane & 15) * 8 + ((lane >> 4) & 1) * 1024 + (lane >> 5) * 256;
    bf16x8 st_v, st_k;
#define ATT_SLOAD(k0) do { const size_t rr_ = (size_t)((k0) + sr) * AW + sc; st_v = *(const bf16x8*)(Vh + rr_); st_k = *(const bf16x8*)(Kh + rr_); } while (0)
#define ATT_SWRITE(bf) do { *(LAS bf16x8*)(V_lds + (bf) * SHM_V + vst) = st_v; *(LAS bf16x8*)(K_lds + (bf) * SHM_K + ATT_KSWZ(sr, sc * 2)) = st_k; } while (0)
#define ATT_RESC(a) do { if (__any((a) < 1.f)) { if (hi == 0) al_l[r32] = (a); asm volatile("s_waitcnt lgkmcnt(0)" ::: "memory");      \
        _Pragma("unroll") for (int d_ = 0; d_ < 2; ++d_) _Pragma("unroll") for (int r = 0; r < 16; ++r) o[d_][r] *= al_l[crow(r, hi)]; } } while (0)
    const int NT = (q0 + MOBA) / KVBLK;
    const int qrel = wid * QBLK + r32;
#define ATT_MASK(P0, P1, t) do { const int jb_ = (t) - (NT - 4); if (jb_ >= 0) cmask(P0, P1, jb_, qrel, hi); } while (0)
#define ATT_KEEP(t) ((((t) >= NT - 4) ? 1u : ((sel >> ((t) >> 2)) & 1u)) != 0u)
    f32x16 pA0, pA1, pB0, pB1; float mnA, mnB, alA, alB; bf16x8 pa0, pa1, pa2, pa3;
    int s0 = 0, s1 = 1, s2 = 2;
#define ATT_ROT() do { const int t_ = s0; s0 = s1; s1 = s2; s2 = t_; } while (0)
    ATT_SLOAD(0); asm volatile("s_waitcnt vmcnt(0)" ::: "memory"); ATT_SWRITE(0); ATT_SLOAD(KVBLK);
    s0 = 2; s1 = 0; s2 = 1;
    __syncthreads();
    asm volatile("s_waitcnt vmcnt(0)" ::: "memory"); ATT_SWRITE(s2); ATT_SLOAD(2 * KVBLK);
    qkt(pA0, pA1, K_lds + s1 * SHM_K, qr, r32, hi); ATT_MASK(pA0, pA1, 0); partialSM(pA0, pA1, m_reg, mnA, alA, ATT_KEEP(0));
    ATT_ROT();
    for (int j = 1; j < NT; j += 2) {
        __syncthreads();
        if (j + 1 < NT) { asm volatile("s_waitcnt vmcnt(0)" ::: "memory"); ATT_SWRITE(s2); if (j + 2 < NT) ATT_SLOAD((j + 2) * KVBLK); }
        ATT_SBAR(); qkt(pB0, pB1, K_lds + s1 * SHM_K, qr, r32, hi); ATT_MASK(pB0, pB1, j);
        finishSM(pA0, pA1, alA, l_reg, pa0, pa1, pa2, pa3); ATT_SBAR();
        pv(o, vb0 + s0 * SHM_V, pa0, pa1, pa2, pa3); partialSM(pB0, pB1, m_reg, mnB, alB, ATT_KEEP(j));
        ATT_RESC(alB); ATT_ROT();
        if (j + 1 < NT) {
            __syncthreads();
            if (j + 2 < NT) { asm volatile("s_waitcnt vmcnt(0)" ::: "memory"); ATT_SWRITE(s2); if (j + 3 < NT) ATT_SLOAD((j + 3) * KVBLK); }
            ATT_SBAR(); qkt(pA0, pA1, K_lds + s1 * SHM_K, qr, r32, hi); ATT_MASK(pA0, pA1, j + 1);
            finishSM(pB0, pB1, alB, l_reg, pa0, pa1, pa2, pa3); ATT_SBAR();
            pv(o, vb0 + s0 * SHM_V, pa0, pa1, pa2, pa3); partialSM(pA0, pA1, m_reg, mnA, alA, ATT_KEEP(j + 1));
            ATT_RESC(alA); ATT_ROT();
        }
    }
    finishSM(pB0, pB1, alB, l_reg, pa0, pa1, pa2, pa3); ATT_SBAR();
    pv(o, vb0 + s0 * SHM_V, pa0, pa1, pa2, pa3);
#undef ATT_ROT
    if (hi == 0) li_l[r32] = l_reg; asm volatile("s_waitcnt lgkmcnt(0)" ::: "memory");
    float rli[16];
#pragma unroll
    for (int r = 0; r < 16; ++r) rli[r] = __builtin_amdgcn_rcpf(li_l[crow(r, hi)]);
    bf16* Ow = wsp<bf16>(F, WS_MIX) + (rowbase + q0 + wid * QBLK) * DM + h * HD;
    float* ssqa = wsp<float>(F, WS_SSQA) + (rowbase + q0 + wid * QBLK) * NH + h;
    float qq[16];
#pragma unroll
    for (int r = 0; r < 16; ++r) { const int orow = crow(r, hi); float q2 = 0.f;
#pragma unroll
        for (int d0 = 0; d0 < 2; ++d0) { const float v = o[d0][r] * rli[r]; const float vn = __shfl_xor(v, 1); q2 += v * v;
            if ((r32 & 1) == 0) *(unsigned*)(Ow + (size_t)orow * DM + d0 * 32 + r32) = cvt_pk_bf16(v, vn); }
        qq[r] = q2; }
#pragma unroll
    for (int i = 0; i < 8; ++i) { const bool up = (lane & 16) != 0; const float send = up ? qq[i] : qq[i + 8], keep = up ? qq[i + 8] : qq[i]; qq[i] = keep + __shfl_xor(send, 16); }
#pragma unroll
    for (int i = 0; i < 4; ++i) { const bool up = (lane & 8) != 0; const float send = up ? qq[i] : qq[i + 4], keep = up ? qq[i + 4] : qq[i]; qq[i] = keep + __shfl_xor(send, 8); }
#pragma unroll
    for (int i = 0; i < 2; ++i) { const bool up = (lane & 4) != 0; const float send = up ? qq[i] : qq[i + 2], keep = up ? qq[i + 2] : qq[i]; qq[i] = keep + __shfl_xor(send, 4); }
    { const bool up = (lane & 2) != 0; const float send = up ? qq[0] : qq[1], keep = up ? qq[1] : qq[0]; qq[0] = keep + __shfl_xor(send, 2); }
    qq[0] += __shfl_xor(qq[0], 1);
    if ((lane & 1) == 0) ssqa[(size_t)crow(r32 >> 1, hi) * NH] = qq[0];
    __syncthreads();
#undef ATT_SLOAD
#undef ATT_SWRITE
#undef ATT_RESC
#undef ATT_MASK
#undef ATT_KEEP
}
}

namespace gm {
__device__ __forceinline__ int vt_off(int d, int s) { return d * 256 + ((((s >> 3) ^ (d & 15)) & 15) << 4) + (s & 7) * 2; }
__device__ __forceinline__ void units4(const Frame& F, int v, LAS unsigned char* scratch) {
    PHASE_IDS;
    const int tid = TID_, wid = tid >> 6, lane = tid & 63, fr = lane & 15, fq = lane >> 4;
    const int u = wid >> 1, half = wid & 1, uidx = 4 * v + u, b = uidx >> 6, c = (uidx >> 2) & 15, g = uidx & 3;
    const size_t row0 = (size_t)b * SEQ + c * GC;
    const bf16* VGg = wsp<bf16>(F, WS_VG) + row0 * GW + g * GD; const bf16* Ug = wsp<bf16>(F, WS_U) + row0 * GW + g * GD;
    LAS unsigned char* vt = scratch + u * 32768;
    { const int s_ = half * 64 + lane; const v4u* src = (const v4u*)(VGg + (size_t)s_ * GW); v4u raw[16]; float sum = 0.f, sq = 0.f;
#pragma unroll
      for (int i = 0; i < 16; ++i) raw[i] = src[i];
#pragma unroll
      for (int i = 0; i < 16; ++i) { const unsigned ww[4] = {raw[i].x, raw[i].y, raw[i].z, raw[i].w};
#pragma unroll
          for (int k = 0; k < 4; ++k) { const float a0 = bflo(ww[k]), a1 = bfhi(ww[k]); sum += a0 + a1; sq += a0 * a0 + a1 * a1; } }
      const float mu = sum * (1.f / GD); const float var = fmaxf(sq * (1.f / GD) - mu * mu, 0.f); const float rstd = 1.0f / sqrtf(var + EPS);
      const float* lg = F.ln_g + g * GD; const float* lb = F.ln_b + g * GD;
#pragma unroll
      for (int i = 0; i < 16; ++i) { const unsigned ww[4] = {raw[i].x, raw[i].y, raw[i].z, raw[i].w}; const f32x4 g0 = *(const f32x4*)(lg + 8 * i), g1 = *(const f32x4*)(lg + 8 * i + 4), b0 = *(const f32x4*)(lb + 8 * i), b1 = *(const f32x4*)(lb + 8 * i + 4);
          const float gg[8] = {g0[0], g0[1], g0[2], g0[3], g1[0], g1[1], g1[2], g1[3]}, bb[8] = {b0[0], b0[1], b0[2], b0[3], b1[0], b1[1], b1[2], b1[3]};
#pragma unroll
          for (int k = 0; k < 4; ++k) { const int d = 8 * i + 2 * k;
              *(LAS unsigned short*)(vt + vt_off(d, s_)) = (unsigned short)f2bf((bflo(ww[k]) - mu) * rstd * gg[2 * k] + bb[2 * k]);
              *(LAS unsigned short*)(vt + vt_off(d + 1, s_)) = (unsigned short)f2bf((bfhi(ww[k]) - mu) * rstd * gg[2 * k + 1] + bb[2 * k + 1]); } } }
    __syncthreads();
#pragma unroll 1
    for (int m = 0; m < 4; ++m) {
        const int tb = half * 64 + m * 16, t = tb + fr;
        const float* Wg = F.gws + (size_t)g * GC * GC + (size_t)t * GC;
        const int nks = (tb + 16 + 31) / 32;
        f32x4 w0[4], w1[4];
#pragma unroll
        for (int ks = 0; ks < 4; ++ks) if (ks < nks) { w0[ks] = *(const f32x4*)(Wg + ks * 32 + fq * 8); w1[ks] = *(const f32x4*)(Wg + ks * 32 + fq * 8 + 4); }
        const bf16* Ut = Ug + (size_t)t * GW + 4 * fq; v2u uu[8];
#pragma unroll
        for (int n = 0; n < 8; ++n) uu[n] = *(const v2u*)(Ut + n * 16);
        f32x4 acc[8];
#pragma unroll
        for (int n = 0; n < 8; ++n) acc[n] = (f32x4){0.f, 0.f, 0.f, 0.f};
#pragma unroll
        for (int ks = 0; ks < 4; ++ks) if (ks < nks) { const int s0 = ks * 32 + fq * 8;
            float wv[8] = {w0[ks][0], w0[ks][1], w0[ks][2], w0[ks][3], w1[ks][0], w1[ks][1], w1[ks][2], w1[ks][3]};
#pragma unroll
            for (int j = 0; j < 8; ++j) if (s0 + j > t) wv[j] = 0.f;
            v4u aw; aw.x = pk2(wv[0], wv[1]); aw.y = pk2(wv[2], wv[3]); aw.z = pk2(wv[4], wv[5]); aw.w = pk2(wv[6], wv[7]);
            const bf16x8 wf = *reinterpret_cast<const bf16x8*>(&aw);
#pragma unroll
            for (int n = 0; n < 8; ++n) { const bf16x8 vf = *(const LAS bf16x8*)(vt + vt_off(n * 16 + fr, s0));
                acc[n] = __builtin_amdgcn_mfma_f32_16x16x32_bf16(vf, wf, acc[n], 0, 0, 0); } }
        bf16* Og = wsp<bf16>(F, WS_MIX) + (row0 + t) * DM + AW + g * GD + 4 * fq; float* ssqg = wsp<float>(F, WS_SSQG) + (row0 + t) * GG + g;
        const float bs = F.gbs[g * GC + t]; float q2 = 0.f;
#pragma unroll
        for (int n = 0; n < 8; ++n) { const float o0 = bflo(uu[n].x) * (acc[n][0] + bs), o1 = bfhi(uu[n].x) * (acc[n][1] + bs), o2 = bflo(uu[n].y) * (acc[n][2] + bs), o3 = bfhi(uu[n].y) * (acc[n][3] + bs);
            q2 += (o0 * o0 + o1 * o1) + (o2 * o2 + o3 * o3); v2u w; w.x = cvt_pk_bf16(o0, o1); w.y = cvt_pk_bf16(o2, o3); *(v2u*)(Og + n * 16) = w; }
        q2 += __shfl_xor(q2, 16); q2 += __shfl_xor(q2, 32);
        if (fq == 0) ssqg[0] = q2;
    }
    __syncthreads();
}
}

__device__ __forceinline__ void p2_mixers(const Frame& F) {
    LAS unsigned char* scratch = F.lds + RING_OFF;
    const int v = F.vcu;
    { const int bh = v >> 1, s0 = (v & 1) * 2;
#pragma unroll 1
      for (int i = 0; i < 4; ++i) { const int qq = s0 + (i >> 1); const int qb = (i & 1) ? 7 - qq : qq; att::attn_unit(F, bh / NH, bh % NH, qb, scratch); } }
    if (TPROBE && blockIdx.x == 0 && threadIdx.x == 0) ((unsigned long long*)(F.ctl + CW_TS))[14] = __builtin_amdgcn_s_memrealtime();
    gm::units4(F, v, scratch);
}

__device__ __forceinline__ void p4_router(const Frame& F) {
    PHASE_IDS;
    const int tid = TID_, wid = tid >> 6, lane = tid & 63, tk = lane & 31, hf = lane >> 5;
    LAS unsigned* hist = (LAS unsigned*)(F.lds + XTAB_OFF + 4096);
    LAS unsigned* base = hist + 32;
    LAS unsigned* qctr = hist + 64;
    static_assert(XTAB_OFF + 4096 >= 8 * P0_SCR_WAVE, "router words above the conversion tiles");
    const bf16* RWT = wsp<bf16>(F, WS_RWT); const bf16* x1 = wsp<bf16>(F, WS_X1B); const float* ssq1 = wsp<float>(F, WS_SSQ1);
    unsigned* cntg = (unsigned*)(F.ctl + CW_CNT);
    unsigned* IDX = wsp<unsigned>(F, WS_IDX); float* GSS = wsp<float>(F, WS_GSS); float* RSS = wsp<float>(F, WS_RSS); unsigned* TOKPOS = wsp<unsigned>(F, WS_TOKPOS);
    if (tid < 32) hist[tid] = 0u; if (tid == 0) qctr[0] = 0u;
    __syncthreads();
    const bool active = wid < 4; const int tok = (F.vcu * 4 + (wid & 3)) * 32 + tk;
    int pe[4] = {0, 0, 0, 0}; float pg[4] = {0.f, 0.f, 0.f, 0.f}; unsigned rank[2] = {0u, 0u}; int my_e[2] = {0, 0}; float my_g[2] = {0.f, 0.f}; float rstd = 0.f;
    if (active) {
        { const f32x4* sp = (const f32x4*)(ssq1 + (size_t)tok * 16); const f32x4 a = sp[0], b = sp[1], c = sp[2], d = sp[3];
          const float s_ = ((a[0] + a[1]) + (a[2] + a[3])) + ((b[0] + b[1]) + (b[2] + b[3])) + ((c[0] + c[1]) + (c[2] + c[3])) + ((d[0] + d[1]) + (d[2] + d[3]));
          rstd = 1.0f / sqrtf(s_ * (1.f / DM) + EPS); }
        f32x16 acc = f32x16{};
        { const bf16* xr = x1 + (size_t)tok * DM + 8 * hf; const bf16* wh = RWT + (size_t)tk * DM + 8 * hf; const bf16* wl = wh + NE * DM;
#pragma unroll 8
          for (int s_ = 0; s_ < 64; ++s_) { const bf16x8 xv = *(const bf16x8*)(xr + 16 * s_), a_hi = *(const bf16x8*)(wh + 16 * s_), a_lo = *(const bf16x8*)(wl + 16 * s_);
              acc = __builtin_amdgcn_mfma_f32_32x32x16_bf16(a_hi, xv, acc, 0, 0, 0); acc = __builtin_amdgcn_mfma_f32_32x32x16_bf16(a_lo, xv, acc, 0, 0, 0); } }
        float lv[16];
#pragma unroll
        for (int r = 0; r < 16; ++r) { const int e = (r & 3) + 8 * (r >> 2) + 4 * hf; lv[r] = acc[r] * rstd + F.router_b[e]; }
        float tv[4]; int ti[4]; unsigned used = 0u;
#pragma unroll
        for (int k = 0; k < 4; ++k) { float best = -__builtin_inff(); int br = 0;
#pragma unroll
            for (int r = 0; r < 16; ++r) { const int e = (r & 3) + 8 * (r >> 2) + 4 * hf; const int eb = (br & 3) + 8 * (br >> 2) + 4 * hf;
                const bool better = !((used >> r) & 1u) && (lv[r] > best || (lv[r] == best && e < eb)); if (better) { best = lv[r]; br = r; } }
            used |= 1u << br; tv[k] = best; ti[k] = (br & 3) + 8 * (br >> 2) + 4 * hf; }
        float ov[4]; int oi[4];
#pragma unroll
        for (int k = 0; k < 4; ++k) { ov[k] = __shfl_xor(tv[k], 32); oi[k] = __shfl_xor(ti[k], 32); }
        int ia = 0, ib = 0;
#pragma unroll
        for (int k = 0; k < 4; ++k) {
            float va = tv[0], vb = ov[0]; int ea = ti[0], eb = oi[0];
#pragma unroll
            for (int q = 1; q < 4; ++q) { if (ia == q) { va = tv[q]; ea = ti[q]; } if (ib == q) { vb = ov[q]; eb = oi[q]; } }
            const bool takeA = (va > vb) || (va == vb && ea < eb);
            pg[k] = takeA ? va : vb; pe[k] = takeA ? ea : eb; if (takeA) ++ia; else ++ib; }
        { const float m = pg[0]; float s_ = 0.f;
#pragma unroll
          for (int k = 0; k < 4; ++k) { pg[k] = __builtin_amdgcn_exp2f((pg[k] - m) * 1.4426950408889634f); s_ += pg[k]; }
          const float inv = 1.0f / s_;
#pragma unroll
          for (int k = 0; k < 4; ++k) pg[k] *= inv; }
        { const int m = -hf; my_e[0] = pe[0] ^ ((pe[0] ^ pe[2]) & m); my_e[1] = pe[1] ^ ((pe[1] ^ pe[3]) & m);
          const unsigned g0 = __float_as_uint(pg[0]), g1 = __float_as_uint(pg[1]), g2 = __float_as_uint(pg[2]), g3 = __float_as_uint(pg[3]);
          my_g[0] = __uint_as_float(g0 ^ ((g0 ^ g2) & (unsigned)m)); my_g[1] = __uint_as_float(g1 ^ ((g1 ^ g3) & (unsigned)m)); }
#pragma unroll
        for (int q = 0; q < 2; ++q) rank[q] = atomicAdd((unsigned*)&hist[my_e[q]], 1u);
    }
    { LAS float* scr = (LAS float*)(F.lds + RING_OFF + wid * P0_SCR_WAVE); constexpr int PER_WG = XW_ITEMS / 256; static_assert(XW_ITEMS % 256 == 0, "items per workgroup");
      for (;;) { unsigned i = 0u; if (lane == 0) i = atomicAdd((unsigned*)qctr, 1u); i = (unsigned)__builtin_amdgcn_readfirstlane((int)i);
          if (i >= (unsigned)PER_WG) break;
          xw_convert_item(F, F.vcu * PER_WG + (int)i, scr, lane); } }
    __syncthreads();
    if (tid < 32) base[tid] = atomicAdd(cntg + tid, hist[tid]);
    __syncthreads();
    if (active) {
#pragma unroll
        for (int q = 0; q < 2; ++q) { const int k = 2 * hf + q; const int e = my_e[q]; const float g = my_g[q];
            const unsigned slot = base[e] + rank[q];
            IDX[(size_t)e * T + slot] = (unsigned)tok; GSS[(size_t)e * T + slot] = g; RSS[(size_t)e * T + slot] = rstd; TOKPOS[(size_t)tok * 4 + k] = ((unsigned)e << 16) | slot; }
    }
    __syncthreads();
}

__device__ __forceinline__ void build_tstart(const Frame& F, LAS unsigned* tstart, int tid) {
    if (tid < 64) { const unsigned* cntg = (const unsigned*)(F.ctl + CW_CNT); unsigned c = (tid < NE) ? cntg[tid] : 0u; if (c > (unsigned)T) c = (unsigned)T;
        unsigned x = (c + 255u) >> 8;
#pragma unroll
        for (int o = 1; o < 32; o <<= 1) { const unsigned y = __shfl_up(x, o); if ((tid & 63) >= o) x += y; }
        if (tid < NE) tstart[tid + 1] = x; if (tid == 0) tstart[0] = 0u; }
}
constexpr int MAXU = 17;
constexpr int XT_TSTART = 0, XT_ULIST = 256, XT_RS = 512, XT_GTAB = XT_RS + MAXU * 1024;
static_assert(XT_GTAB + MAXU * 512 <= LDSCTL_OFF - XTAB_OFF, "xtab");
__device__ __forceinline__ int moe_build_tables(const Frame& F, int P  , int mode) {
    PHASE_IDS;
    LAS unsigned* tstart = (LAS unsigned*)(F.lds + XTAB_OFF + XT_TSTART);
    LAS unsigned* ulist = (LAS unsigned*)(F.lds + XTAB_OFF + XT_ULIST);
    LAS float* rs = (LAS float*)(F.lds + XTAB_OFF + XT_RS);
    LAS unsigned short* gtab = (LAS unsigned short*)(F.lds + XTAB_OFF + XT_GTAB);
    const unsigned* cntg = (const unsigned*)(F.ctl + CW_CNT); const unsigned* IDX = wsp<unsigned>(F, WS_IDX);
    const float* RSRC = mode == 1 ? wsp<float>(F, WS_RSS) : wsp<float>(F, WS_GSS);
    const int tid = TID_;
    build_tstart(F, tstart, tid);
    __syncthreads();
    const int NT_ = (int)tstart[NE], U = NT_ * P, G = F.G, c = (int)blockIdx.x;
    int nunits = (c < U) ? (U - c + G - 1) / G : 0; if (nunits > MAXU) nunits = MAXU;
    if (tid < nunits) { const int L = tid * G + c; int gt, pn; pg8::flat_to_tile(L, U, NT_, P, gt, pn);
        int e = 0; for (int k = 1; k < NE; ++k) if ((unsigned)gt >= tstart[k]) e = k;
        const int rt = gt - (int)tstart[e];
        ulist[tid] = (unsigned)gt | ((unsigned)pn << 10) | ((unsigned)e << 13) | ((unsigned)rt << 18); }
    __syncthreads();
    {
        constexpr int NP = (MAXU + 1) / 2; unsigned tokv[NP]; float rsv[NP];
#pragma unroll
        for (int p = 0; p < NP; ++p) { const int i = 2 * p + (tid >> 8), r = tid & 255; tokv[p] = 0u; rsv[p] = 0.f;
            if (i < nunits) { const unsigned w = ulist[i]; const int e = (int)((w >> 13) & 0x1fu), rt = (int)(w >> 18);
                unsigned cn = cntg[e]; if (cn > (unsigned)T) cn = (unsigned)T; const unsigned slot = (unsigned)rt * 256u + (unsigned)r;
                if (slot < cn) { if (mode == 1) tokv[p] = IDX[(size_t)e * T + slot]; rsv[p] = RSRC[(size_t)e * T + slot]; } } }
#pragma unroll
        for (int p = 0; p < NP; ++p) { const int i = 2 * p + (tid >> 8), r = tid & 255;
            if (i < nunits) { unsigned tok = tokv[p]; if (tok >= (unsigned)T) tok = 0u; if (mode == 1) gtab[i * 256 + r] = (unsigned short)tok; rs[i * 256 + r] = rsv[p]; } }
    }
    __syncthreads();
    return nunits;
}

__device__ __forceinline__ void p7_combine(const Frame& F) {
    PHASE_IDS;
    LAS unsigned* tstart = (LAS unsigned*)(F.lds + XTAB_OFF + XT_TSTART);
    const unsigned* cntg = (const unsigned*)(F.ctl + CW_CNT);
    build_tstart(F, tstart, TID_); (void)cntg;
    __syncthreads();
    const int gw = F.vcu * NWAVES + WAVE_, NGW = F.G * NWAVES;
    const unsigned* TOKPOS = wsp<unsigned>(F, WS_TOKPOS); const unsigned char* Y = wsp<unsigned char>(F, WS_YBUF); const bf16* X1 = wsp<bf16>(F, WS_X1B); bf16* X2 = wsp<bf16>(F, WS_X2B); unsigned char* X28 = wsp<unsigned char>(F, WS_X2F8); float* RS2 = wsp<float>(F, WS_RSTD2);
    for (int m0 = gw; m0 < T; m0 += 2 * NGW) {
        f32x4 v[2][4]; unsigned yv[2][4][4]; float s[2] = {0.f, 0.f};
#pragma unroll
        for (int r = 0; r < 2; ++r) { const int m = m0 + r * NGW;
            const v4u tp = *(const v4u*)(TOKPOS + (size_t)m * 4); const unsigned tpw[4] = {tp.x, tp.y, tp.z, tp.w};
            size_t yrow[4];
#pragma unroll
            for (int k = 0; k < 4; ++k) { const unsigned e = (tpw[k] >> 16) & 31u, slot = tpw[k] & 0xffffu; yrow[k] = ((size_t)tstart[e] * 256u + slot) * DM; }
#pragma unroll
            for (int j = 0; j < 4; ++j) { const v2u xw = *(const v2u*)(X1 + (size_t)m * DM + 4 * LANE_ + 256 * j); v[r][j] = (f32x4){bflo(xw.x), bfhi(xw.x), bflo(xw.y), bfhi(xw.y)};
#pragma unroll
                for (int k = 0; k < 4; ++k) yv[r][j][k] = *(const unsigned*)(Y + yrow[k] + 4 * LANE_ + 256 * j); } }
#pragma unroll
        for (int r = 0; r < 2; ++r) {
#pragma unroll
            for (int j = 0; j < 4; ++j) {
#pragma unroll
                for (int k = 0; k < 4; ++k) { const unsigned w = yv[r][j][k]; const f32x2 lo = __builtin_amdgcn_cvt_pk_f32_fp8((int)w, false), hi2 = __builtin_amdgcn_cvt_pk_f32_fp8((int)w, true);
                    v[r][j][0] += lo[0] * (1.0f / Y_SCALE); v[r][j][1] += lo[1] * (1.0f / Y_SCALE); v[r][j][2] += hi2[0] * (1.0f / Y_SCALE); v[r][j][3] += hi2[1] * (1.0f / Y_SCALE); }
                s[r] += (v[r][j].x * v[r][j].x + v[r][j].y * v[r][j].y) + (v[r][j].z * v[r][j].z + v[r][j].w * v[r][j].w); } }
#pragma unroll
        for (int r = 0; r < 2; ++r) { const int m = m0 + r * NGW; const float rstd = 1.0f / sqrtf(wave_sum(s[r]) * (1.f / DM) + EPS);
            if (LANE_ == 0) RS2[m] = rstd;
#pragma unroll
            for (int j = 0; j < 4; ++j) { v2u w; w.x = cvt_pk_bf16(v[r][j].x, v[r][j].y); w.y = cvt_pk_bf16(v[r][j].z, v[r][j].w); *(v2u*)(X2 + (size_t)m * DM + 4 * LANE_ + 256 * j) = w;
                *(unsigned*)(X28 + (size_t)m * DM + 4 * LANE_ + 256 * j) = pk4_fp8(v[r][j].x, v[r][j].y, v[r][j].z, v[r][j].w); } }
    }
}

__device__ __forceinline__ void p9_final(const Frame& F) {
    PHASE_IDS;
    const int gw = F.vcu * NWAVES + WAVE_, NGW = F.G * NWAVES;
    const unsigned char* GATE = wsp<unsigned char>(F, WS_GATE); const unsigned char* PP = wsp<unsigned char>(F, WS_PP); const float* ssqpp = wsp<float>(F, WS_SSQPP);
    for (int m0 = gw; m0 < T; m0 += 2 * NGW) {
        f32x4 v[2][4]; unsigned gv[2][4], pv_[2][4]; f32x4 sq[2][4]; float s[2] = {0.f, 0.f};
#pragma unroll
        for (int r = 0; r < 2; ++r) { const int m = m0 + r * NGW; const bf16* x2r = wsp<bf16>(F, WS_X2B) + (size_t)m * DM;
#pragma unroll
            for (int q = 0; q < 4; ++q) sq[r][q] = *(const f32x4*)(ssqpp + (size_t)m * 16 + 4 * q);
#pragma unroll
            for (int j = 0; j < 4; ++j) { const int col = 4 * LANE_ + 256 * j; const v2u xw = *(const v2u*)(x2r + col); v[r][j] = (f32x4){bflo(xw.x), bfhi(xw.x), bflo(xw.y), bfhi(xw.y)};
                gv[r][j] = *(const unsigned*)(GATE + (size_t)m * DM + col); pv_[r][j] = *(const unsigned*)(PP + (size_t)m * DM + col); } }
#pragma unroll
        for (int r = 0; r < 2; ++r) { const f32x4 a = sq[r][0], b = sq[r][1], c = sq[r][2], d = sq[r][3];
            const float sp = ((a[0] + a[1]) + (a[2] + a[3])) + ((b[0] + b[1]) + (b[2] + b[3])) + ((c[0] + c[1]) + (c[2] + c[3])) + ((d[0] + d[1]) + (d[2] + d[3]));
            const float rpp = 1.0f / sqrtf(sp * (1.f / DM) + EPS);
#pragma unroll
            for (int j = 0; j < 4; ++j) { const int col = 4 * LANE_ + 256 * j; const f32x4 pg_ = *(const f32x4*)(F.ppn + col);
                const f32x2 g01 = __builtin_amdgcn_cvt_pk_f32_fp8((int)gv[r][j], false), g23 = __builtin_amdgcn_cvt_pk_f32_fp8((int)gv[r][j], true);
                const f32x2 p01 = __builtin_amdgcn_cvt_pk_f32_fp8((int)pv_[r][j], false), p23 = __builtin_amdgcn_cvt_pk_f32_fp8((int)pv_[r][j], true);
                const float rg = rpp * (1.0f / GATE_SCALE);
                v[r][j][0] += g01[0] * (p01[0] * rg * pg_[0]); v[r][j][1] += g01[1] * (p01[1] * rg * pg_[1]);
                v[r][j][2] += g23[0] * (p23[0] * rg * pg_[2]); v[r][j][3] += g23[1] * (p23[1] * rg * pg_[3]);
                s[r] += (v[r][j].x * v[r][j].x + v[r][j].y * v[r][j].y) + (v[r][j].z * v[r][j].z + v[r][j].w * v[r][j].w); } }
#pragma unroll
        for (int r = 0; r < 2; ++r) { const int m = m0 + r * NGW; float* xr = F.out + (size_t)m * DM; const float rstd = 1.0f / sqrtf(wave_sum(s[r]) * (1.f / DM) + EPS);
#pragma unroll
            for (int j = 0; j < 4; ++j) { const int col = 4 * LANE_ + 256 * j; const f32x4 fg = *(const f32x4*)(F.final_norm + col); __builtin_nontemporal_store(v[r][j] * rstd * fg, (f32x4*)(xr + col)); } }
    }
}

struct Args { const float* in[23]; float* out; unsigned char* ws; };
#if CHECK_STAGE
__device__ __forceinline__ unsigned hmix(unsigned z) { z ^= z >> 16; z *= 0x7feb352du; z ^= z >> 15; z *= 0x846ca68bu; z ^= z >> 16; return z; }
__device__ __forceinline__ void chk_add(const Frame& F, int st, bool bad) { atomicAdd((unsigned*)(F.ctl + CW_CHK + 2 * st), bad ? 1u : 0u); atomicAdd((unsigned*)(F.ctl + CW_CHK + 2 * st + 1), 1u); }
__device__ __forceinline__ bool offby(float got, float ex, float rel, float ab) { const float d = fabsf(got - ex); return !(d <= rel * fabsf(ex) + ab); }
__device__ __forceinline__ float dot_bf(const bf16* a, const bf16* b, int n) { float s = 0.f; for (int k = 0; k < n; ++k) s += bf2f(a[k]) * bf2f(b[k]); return s; }
__device__ __forceinline__ float gelu_ref(float v) { return 0.5f * v * (1.0f + erff(v * 0.70710678f)); }
__device__ __forceinline__ unsigned chk_tstart(const Frame& F, unsigned ex) { const unsigned* cntg = (const unsigned*)(F.ctl + CW_CNT); unsigned s_ = 0; for (unsigned e = 0; e < ex; ++e) { unsigned c = cntg[e]; if (c > (unsigned)T) c = T; s_ += (c + 255u) >> 8; } return s_; }
template <int ST> __device__ __forceinline__ void stage_check(const Frame& F) {
    const unsigned gt = (unsigned)blockIdx.x * NTHR + threadIdx.x;
    const unsigned h0 = hmix(gt * 2654435761u + ST * 40503u), h1 = hmix(h0 + 0x9e3779b9u), h2 = hmix(h1 + 0x85ebca6bu);
    if (ST == 1) {
        if (gt >= 16384) return;
        const int which = gt & 7;
        if (which == 0) { const int e = h0 % NE, n = h1 % (2 * FF), k = h2 % DM; const int lc = CmWgu()(n);
            const float ex = bf2f((bf16)f2bf(F.w_gu[((size_t)e * DM + k) * 2 * FF + lc] * F.ffn_norm[k])); chk_add(F, ST, offby(bf2f(wsp<bf16>(F, WS_WGU)[((size_t)e * 2 * FF + n) * DM + k]), ex, 1e-6f, 1e-30f)); }
        else if (which == 1) { const int e = h0 % NE, n = h1 % DM, k = h2 % FF;
            const float ex = bf2f((bf16)f2bf(F.w_dn[((size_t)e * FF + k) * DM + n])); chk_add(F, ST, offby(bf2f(wsp<bf16>(F, WS_WDN)[((size_t)e * DM + n) * FF + k]), ex, 1e-6f, 1e-30f)); }
        else if (which == 2) { const int n = h1 % NPROJ, k = h2 % DM; const int lc = CmWin()(n);
            const float ex = bf2f((bf16)f2bf(F.w_in[(size_t)k * NPROJ + lc] * F.mix_norm[k])); chk_add(F, ST, offby(bf2f(wsp<bf16>(F, WS_WIN)[(size_t)n * DM + k]), ex, 1e-6f, 1e-30f)); }
        else if (which == 3) { const int n = h1 % DM, k = h2 % DM; const float g = k < AW ? F.aon[k] : F.gon[k - AW];
            const float ex = bf2f((bf16)f2bf(F.w_out[(size_t)k * DM + n] * g)); chk_add(F, ST, offby(bf2f(wsp<bf16>(F, WS_WOUT)[(size_t)n * DM + k]), ex, 1e-6f, 1e-30f)); }
        else if (which == 4) { const int n = h1 % DM, k = h2 % DM;
            const float ex = bf2f((bf16)f2bf(F.w_pg[(size_t)k * DM + n] * F.ple_norm[k])); chk_add(F, ST, offby(bf2f(wsp<bf16>(F, WS_WPG)[(size_t)n * DM + k]), ex, 1e-6f, 1e-30f)); }
        else if (which == 5) { const int n = h1 % DM, k = h2 % PLE;
            const float ex = bf2f((bf16)f2bf(F.w_pp[(size_t)k * DM + n])); chk_add(F, ST, offby(bf2f(wsp<bf16>(F, WS_WPP)[(size_t)n * PLE + k]), ex, 1e-6f, 1e-30f)); }
        else if (which == 6) { const int row = h0 % T, k = h1 % DM; float ss = 0.f; for (int j = 0; j < DM; ++j) { const float v = F.x[(size_t)row * DM + j]; ss += v * v; }
            const float ex = F.x[(size_t)row * DM + k] / sqrtf(ss / DM + EPS); chk_add(F, ST, offby(bf2f(wsp<bf16>(F, WS_XNB)[(size_t)row * DM + k]), ex, 0.01f, 1e-3f)); }
        else { const int row = h0 % T, k = h1 % PLE; chk_add(F, ST, offby(bf2f(wsp<bf16>(F, WS_PB)[(size_t)row * PLE + k]), F.p[(size_t)row * PLE + k], 0.005f, 1e-6f)); }
    }
    if (ST == 2) {
        if (gt >= 16384) return;
        const bf16* XN = wsp<bf16>(F, WS_XNB); const bf16* WIN = wsp<bf16>(F, WS_WIN);
        if ((gt & 7) == 7) {
            const int b = h0 % BATCH, hh = h1 % NH, blk = h2 % NBLK, c = (h2 >> 8) % HD; float s_ = 0.f;
            for (int r = 0; r < 256; ++r) s_ += bf2f(wsp<bf16>(F, WS_K)[((size_t)b * SEQ + blk * 256 + r) * AW + hh * HD + c]);
            chk_add(F, ST, offby(wsp<float>(F, WS_KMEAN)[((size_t)(b * NH + hh) * NBLK + blk) * HD + c], s_, 0.02f, 0.3f)); return; }
        const int row = h0 % T, type = h1 % 5, c = h2 % AW; const bf16* xr = XN + (size_t)row * DM;
        const float v = dot_bf(xr, WIN + (size_t)(type * AW + c) * DM, DM); float ex;
        if (type <= 1) { const float vp = dot_bf(xr, WIN + (size_t)(type * AW + (c ^ 4)) * DM, DM); const int i = 4 * ((c & 63) >> 3) + (c & 3), pos = row & (SEQ - 1);
            const float cs = wsp<float>(F, WS_ROPE)[pos * 32 + i], sn = wsp<float>(F, WS_ROPE)[SEQ * 32 + pos * 32 + i];
            { const float inv = powf(10000.0f, -(float)i / 32.0f); const float ang = (float)pos * inv; if (offby(cs, cosf(ang), 0.f, 1e-3f) || offby(sn, sinf(ang), 0.f, 1e-3f)) { chk_add(F, ST, true); return; } }
            ex = (c & 4) ? v * cs + vp * sn : v * cs - vp * sn; }
        else if (type == 2) ex = v; else ex = gelu_ref(v);
        chk_add(F, ST, offby(bf2f(wsp<bf16>(F, WS_Q)[(size_t)type * (16u << 20) + (size_t)row * AW + c]), ex, 0.02f, 0.02f));
    }
    if (ST == 3) {
        if (gt >= 8192) return;
        if (gt & 1) {
            const int row = h0 % T, g = h1 % GG, d = h2 % GD; const int b = row / SEQ, s_ = row % SEQ, c = s_ / GC, t = s_ % GC; float acc = 0.f;
            for (int sp = 0; sp <= t; ++sp) { const bf16* vr = wsp<bf16>(F, WS_VG) + ((size_t)b * SEQ + c * GC + sp) * GW + g * GD; float mu = 0.f; for (int j = 0; j < GD; ++j) mu += bf2f(vr[j]); mu /= GD;
                float var = 0.f; for (int j = 0; j < GD; ++j) { const float dd = bf2f(vr[j]) - mu; var += dd * dd; } const float rstd = 1.0f / sqrtf(var / GD + EPS);
                const float vn = bf2f((bf16)f2bf((bf2f(vr[d]) - mu) * rstd * F.ln_g[g * GD + d] + F.ln_b[g * GD + d])); acc += bf2f((bf16)f2bf(F.gws[((size_t)g * GC + t) * GC + sp])) * vn; }
            const float ex = bf2f(wsp<bf16>(F, WS_U)[(size_t)row * GW + g * GD + d]) * (acc + F.gbs[g * GC + t]);
            chk_add(F, ST, offby(bf2f(wsp<bf16>(F, WS_MIX)[(size_t)row * DM + AW + g * GD + d]), ex, 0.03f, 0.02f)); return; }
        const int row = h0 % T, hh = h1 % NH; const int b = row / SEQ, s_ = row % SEQ, qb = s_ / MOBA; float q[HD];
#pragma unroll
        for (int c = 0; c < HD; ++c) q[c] = bf2f(wsp<bf16>(F, WS_Q)[(size_t)row * AW + hh * HD + c]);
        unsigned sel = 0u;
        if (qb <= 3) sel = (1u << qb) - 1u;
        else { float b0 = -__builtin_inff(), b1 = b0, b2 = b0; int i0 = 0, i1 = 0, i2 = 0;
            for (int j = 0; j < qb; ++j) { const float* km = wsp<float>(F, WS_KMEAN) + ((size_t)(b * NH + hh) * NBLK + j) * HD; float g = 0.f;
#pragma unroll
                for (int c = 0; c < HD; ++c) g += q[c] * km[c];
                if (g > b0) { b2 = b1; i2 = i1; b1 = b0; i1 = i0; b0 = g; i0 = j; } else if (g > b1) { b2 = b1; i2 = i1; b1 = g; i1 = j; } else if (g > b2) { b2 = g; i2 = j; } }
            sel = (1u << i0) | (1u << i1) | (1u << i2); }
        float mx = -__builtin_inff();
        for (int kp = 0; kp <= s_; ++kp) { const int blk = kp / MOBA; if (blk != qb && !((sel >> blk) & 1u)) continue; const bf16* kr = wsp<bf16>(F, WS_K) + ((size_t)b * SEQ + kp) * AW + hh * HD; float sc = 0.f;
#pragma unroll
            for (int c = 0; c < HD; ++c) sc += q[c] * bf2f(kr[c]);
            mx = fmaxf(mx, sc * 0.125f); }
        float o[HD]; float l = 0.f;
#pragma unroll
        for (int c = 0; c < HD; ++c) o[c] = 0.f;
        for (int kp = 0; kp <= s_; ++kp) { const int blk = kp / MOBA; if (blk != qb && !((sel >> blk) & 1u)) continue; const bf16* kr = wsp<bf16>(F, WS_K) + ((size_t)b * SEQ + kp) * AW + hh * HD; float sc = 0.f;
#pragma unroll
            for (int c = 0; c < HD; ++c) sc += q[c] * bf2f(kr[c]);
            const float pr = expf(sc * 0.125f - mx); l += pr; const bf16* vr = wsp<bf16>(F, WS_V) + ((size_t)b * SEQ + kp) * AW + hh * HD;
#pragma unroll
            for (int c = 0; c < HD; ++c) o[c] += pr * bf2f(vr[c]); }
        bool bad = false; float ss = 0.f;
#pragma unroll
        for (int c = 0; c < HD; ++c) { const float ex = o[c] / l; ss += ex * ex; bad |= offby(bf2f(wsp<bf16>(F, WS_MIX)[(size_t)row * DM + hh * HD + c]), ex, 0.04f, 0.02f); }
        bad |= offby(wsp<float>(F, WS_SSQA)[(size_t)row * NH + hh], ss, 0.03f, 1e-3f);
        chk_add(F, ST, bad);
    }
    if (ST == 4) {
        if (gt >= 16384) return;
        const int row = h0 % T, col = h1 % DM; const bf16* mr = wsp<bf16>(F, WS_MIX) + (size_t)row * DM; const bf16* wr_ = wsp<bf16>(F, WS_WOUT) + (size_t)col * DM;
        float sa = 0.f, sg = 0.f, da = 0.f, dg = 0.f;
        for (int k = 0; k < AW; ++k) { const float a = bf2f(mr[k]), g = bf2f(mr[AW + k]); sa += a * a; sg += g * g; da += a * bf2f(wr_[k]); dg += g * bf2f(wr_[AW + k]); }
        const float ex = F.x[(size_t)row * DM + col] + da / sqrtf(sa / AW + EPS) + dg / sqrtf(sg / GW + EPS);
        chk_add(F, ST, offby(F.out[(size_t)row * DM + col], ex, 0.01f, 0.03f));
    }
    if (ST == 5) {
        if (gt >= 8192) return;
        const int tok = h0 % T; const float* xr = F.out + (size_t)tok * DM; float ss = 0.f; for (int k = 0; k < DM; ++k) ss += xr[k] * xr[k]; const float rstd = 1.0f / sqrtf(ss / DM + EPS);
        bool bad = false;
        for (int j = 0; j < 4; ++j) { const int k = (h1 >> (8 * j)) % DM; bad |= offby(bf2f(wsp<bf16>(F, WS_XNB)[(size_t)tok * DM + k]), xr[k] * rstd, 0.01f, 1e-3f); }
        float lg[NE];
#pragma unroll
        for (int e = 0; e < NE; ++e) lg[e] = 0.f;
        for (int k = 0; k < DM; ++k) { const float xv = xr[k] * rstd * F.ffn_norm[k];
#pragma unroll
            for (int e = 0; e < NE; ++e) lg[e] += xv * F.router_w[k * NE + e]; }
#pragma unroll
        for (int e = 0; e < NE; ++e) lg[e] += F.router_b[e];
        int te[4]; float tv[4]; unsigned used = 0u;
#pragma unroll
        for (int k = 0; k < 4; ++k) { float best = -__builtin_inff(); int bi = 0;
#pragma unroll
            for (int e = 0; e < NE; ++e) if (!((used >> e) & 1u) && lg[e] > best) { best = lg[e]; bi = e; }
            used |= 1u << bi; te[k] = bi; tv[k] = best; }
        { float gg[4]; float den = 0.f;
#pragma unroll
          for (int k = 0; k < 4; ++k) { float v = -__builtin_inff();
#pragma unroll
              for (int e = 0; e < NE; ++e) if (e == te[k]) v = lg[e];
              gg[k] = v; }
          const float mm = gg[0];
#pragma unroll
          for (int k = 0; k < 4; ++k) { gg[k] = expf(gg[k] - mm); den += gg[k]; }
          const unsigned* tp = wsp<unsigned>(F, WS_TOKPOS) + (size_t)tok * 4;
#pragma unroll
          for (int k = 0; k < 4; ++k) { const unsigned e = tp[k] >> 16, slot = tp[k] & 0xffffu; bad |= (e != (unsigned)te[k]);
              if (e < NE && slot < (unsigned)T) { bad |= wsp<unsigned>(F, WS_IDX)[(size_t)e * T + slot] != (unsigned)tok; bad |= offby(wsp<float>(F, WS_GSS)[(size_t)e * T + slot], gg[k] / den, 2e-3f, 1e-5f);
                  bad |= slot >= ((const unsigned*)(F.ctl + CW_CNT))[e]; } else bad = true; } }
        (void)tv;
        chk_add(F, ST, bad);
    }
    if (ST == 6 || ST == 7) {
        if (gt >= 16384) return;
        const int tok = h0 % T, k = h1 & 3, col = (h1 >> 2) % FF; const unsigned tp = wsp<unsigned>(F, WS_TOKPOS)[(size_t)tok * 4 + k]; const unsigned e = tp >> 16, slot = tp & 0xffffu;
        if (e >= NE) { chk_add(F, ST, true); return; }
        const unsigned tse = chk_tstart(F, e);
        const size_t row = (size_t)tse * 256 + slot;
        if (ST == 6) { const bf16* xr = wsp<bf16>(F, WS_XNB) + (size_t)tok * DM; const int np = (col >> 7) * 256 + (col & 127);
            const float g = dot_bf(xr, wsp<bf16>(F, WS_WGU) + ((size_t)e * 2 * FF + np) * DM, DM) + F.b_gu[(size_t)e * 2 * FF + col];
            const float l = dot_bf(xr, wsp<bf16>(F, WS_WGU) + ((size_t)e * 2 * FF + np + 128) * DM, DM) + F.b_gu[(size_t)e * 2 * FF + FF + col];
            const float gc = fminf(g, 7.f), lc = fminf(fmaxf(l, -7.f), 7.f); const float ex = gc / (1.0f + expf(-1.702f * gc)) * (lc + 1.0f);
            chk_add(F, ST, offby(bf2f(wsp<bf16>(F, WS_ABUF)[row * FF + col]), ex, 0.03f, 0.03f)); }
        else { const float d = dot_bf(wsp<bf16>(F, WS_ABUF) + row * FF, wsp<bf16>(F, WS_WDN) + ((size_t)e * DM + col) * FF, FF) + F.b_dn[(size_t)e * DM + col];
            const float ex = d * wsp<float>(F, WS_GSS)[(size_t)e * T + slot];
            chk_add(F, ST, offby(bf2f(wsp<bf16>(F, WS_YBUF)[row * DM + col]), ex, 0.03f, 0.01f)); }
    }
    if (ST == 8) {
        if (gt >= 8192) return;
        const int tok = h0 % T; const float* xr = F.out + (size_t)tok * DM; float ss = 0.f; for (int k = 0; k < DM; ++k) ss += xr[k] * xr[k]; const float rstd = 1.0f / sqrtf(ss / DM + EPS);
        bool bad = false; for (int k = 0; k < DM; ++k) { bad |= offby(bf2f(wsp<bf16>(F, WS_X2N)[(size_t)tok * DM + k]), xr[k] * rstd, 0.01f, 1e-3f); bad |= !(fabsf(xr[k]) < 30.f); }
        chk_add(F, ST, bad);
    }
    if (ST == 9) {
        if (gt >= 16384) return;
        const int row = h0 % T, col = h1 % DM;
        if (gt & 1) { const float d = dot_bf(wsp<bf16>(F, WS_X2N) + (size_t)row * DM, wsp<bf16>(F, WS_WPG) + (size_t)col * DM, DM); const float got = bf2f(wsp<bf16>(F, WS_GATE)[(size_t)row * DM + col]); const float ex = 1.0f / (1.0f + expf(-d)); const bool bad = offby(got, ex, 0.02f, 0.01f); chk_add(F, ST, bad);
            if (bad) { atomicOr((unsigned*)(F.ctl + CW_CHK + 40), 1u << ((col >> 3) & 31)); atomicOr((unsigned*)(F.ctl + CW_CHK + 41), 1u << ((row >> 3) & 31)); atomicOr((unsigned*)(F.ctl + CW_CHK + 42), 1u << (col & 7)); atomicOr((unsigned*)(F.ctl + CW_CHK + 43), 1u << (row & 7));
                if (!(got >= 0.f && got <= 1.f)) atomicAdd((unsigned*)(F.ctl + CW_CHK + 44), 1u); { int cl = (int)floorf(log2f(fabsf(got) + 1e-30f)) + 40; cl = cl < 0 ? 0 : (cl > 80 ? 80 : cl); atomicMax((unsigned*)(F.ctl + CW_CHK + 46), (unsigned)cl); atomicMin((unsigned*)(F.ctl + CW_CHK + 47), 0xffffffffu - (unsigned)cl); if (got < 0.f) atomicAdd((unsigned*)(F.ctl + CW_CHK + 48), 1u); } if (fabsf(got - ex) > 0.2f) atomicAdd((unsigned*)(F.ctl + CW_CHK + 45), 1u); } }
        else { const float d = dot_bf(wsp<bf16>(F, WS_PB) + (size_t)row * PLE, wsp<bf16>(F, WS_WPP) + (size_t)col * PLE, PLE); chk_add(F, 10, offby(bf2f(wsp<bf16>(F, WS_PP)[(size_t)row * DM + col]), d, 0.02f, 0.02f)); }
    }
}
__device__ __forceinline__ void check_report(const Frame& F) {
    float c2 = 3.0f;
    for (int st = 1; st <= 10; ++st) { const unsigned bad = F.ctl[CW_CHK + 2 * st], tot = F.ctl[CW_CHK + 2 * st + 1]; const float fr = tot ? (float)bad / (float)tot : 1.0f;
        (void)fr; if (((CHECK_SKIP >> st) & 1) == 0 && bad >= 1u) { c2 = powf(10.0f, (float)st) * (1.0f + fminf((float)bad, 80.0f) * 0.1f); break; } }
#if CHECK_REPORT >= 40
    { unsigned v = F.ctl[CW_CHK + CHECK_REPORT]; if (CHECK_REPORT == 47) v = 0xffffffffu - v; c2 = powf(10.0f, (float)(v >> 27)) * (1.0f + (float)((v >> 21) & 63u) * 0.1f);
#if CHECK_REPORT2
      c2 = powf(10.0f, (float)((v >> 16) & 31u)) * (1.0f + (float)((v >> 10) & 63u) * 0.1f);
#endif
#if CHECK_REPORT3
      c2 = powf(10.0f, (float)((v >> 5) & 31u)) * (1.0f + (float)(v & 31u) * 0.1f);
#endif
      if (CHECK_REPORT >= 46 && CHECK_REPORT <= 47) c2 = powf(10.0f, (float)(v / 9u)) * (1.0f + (float)(v % 9u));
    }
#endif
    if (F.ctl[CW_BAR + XB_TMO] != 0u) c2 = 1e20f;
    const float c = sqrtf(c2);
    for (size_t i = (size_t)blockIdx.x * NTHR + threadIdx.x; i < (size_t)T * DM; i += (size_t)gridDim.x * NTHR) F.out[i] = c;
}
#define STAGE_CHECK(n) stage_check<(n)>(F)
#else
#define STAGE_CHECK(n) do {} while (0)
#endif

__global__ void __launch_bounds__(NTHR, 2) mega_fwd(Args args) {
    extern __shared__ __attribute__((aligned(16))) unsigned char lds_raw[];
    Frame F;
    F.lds = (LAS unsigned char*)lds_raw;
    F.MISC = (volatile LAS unsigned*)(F.lds + LDSCTL_OFF);
    F.G = gridDim.x; { const int bx = blockIdx.x; F.vcu = (F.G % 8 == 0) ? (bx % 8) * (F.G / 8) + bx / 8 : bx; }
    F.ws = args.ws; F.ctl = (gu32*)(args.ws + WS_CTL); F.out = args.out;
    F.x = args.in[0]; F.p = args.in[1]; F.mix_norm = args.in[2]; F.w_in = args.in[3]; F.ln_g = args.in[4]; F.ln_b = args.in[5]; F.gws = args.in[6]; F.gbs = args.in[7];
    F.aon = args.in[8]; F.gon = args.in[9]; F.w_out = args.in[10]; F.ffn_norm = args.in[11]; F.router_w = args.in[12]; F.router_b = args.in[13]; F.w_gu = args.in[14]; F.b_gu = args.in[15];
    F.w_dn = args.in[16]; F.b_dn = args.in[17]; F.ple_norm = args.in[18]; F.w_pg = args.in[19]; F.w_pp = args.in[20]; F.ppn = args.in[21]; F.final_norm = args.in[22];
    { PHASE_IDS; for (int u = TID_; u < 256; u += NTHR) ((LAS unsigned*)(F.lds + LDSCTL_OFF))[u] = 0u; }
    __syncthreads();
    XcdBarrier bar = xcd_barrier_post((unsigned*)(F.ctl + CW_BAR), F.MISC + 8);
#define GRID_BAR() xcd_barrier(bar)
#define STAGE_END(n) do { STAGE_CHECK(n); if (TPROBE && blockIdx.x == 0 && threadIdx.x == 0) ((unsigned long long*)(F.ctl + CW_TS))[(n)] = __builtin_amdgcn_s_memrealtime(); } while (0)

    if (TPROBE && blockIdx.x == 0 && threadIdx.x == 0) ((unsigned long long*)(F.ctl + CW_TS))[0] = __builtin_amdgcn_s_memrealtime();
    for (int rep = 0; rep < (DUP_PHASE == 0 ? 2 : 1); ++rep) {
    if (PH(0)) p0_prologue(F);
    GRID_BAR(); }
    STAGE_END(1);
    if (PH(1)) { pg8::DenseSched S; S.init(wsp<bf16>(F, WS_XNB), wsp<bf16>(F, WS_WIN), T, NPROJ, DM, F.G, (int)blockIdx.x);
      float* RC = wsp<float>(F, WS_ROPE);
      EpiInProj E{wsp<bf16>(F, WS_Q), RC, RC + SEQ * 32, wsp<float>(F, WS_KMEAN)};
      for (int rep = 0; rep < (DUP_PHASE == 1 ? 2 : 1); ++rep) { if (rep) GRID_BAR();
      pg8::gemm_phase<EpiInProj, pg8::DenseSched, false, false>(F.lds + RING_OFF, DM * 2, S, E); } }
    GRID_BAR();
    STAGE_END(2);
    for (int rep = 0; rep < (DUP_PHASE == 2 ? 2 : 1); ++rep) {
    if (PH(2)) p2_mixers(F);
    GRID_BAR(); }
    STAGE_END(3);
    if (PH(3)) { pg8::DenseSched S; S.init(wsp<bf16>(F, WS_MIX), wsp<bf16>(F, WS_WOUT), T, DM, DM, F.G, (int)blockIdx.x);
      LAS f32x4* rtab = (LAS f32x4*)(F.lds + XTAB_OFF);
      Unit ua, ub; const bool ha = S.next(0, ua), hb = S.next(1, ub);
      { PHASE_IDS; const int s = TID_ >> 8, r = TID_ & 255; const bool has = s ? hb : ha; const int pm = s ? ub.pm : ua.pm;
        if (has) { const size_t row = (size_t)pm * 256 + r; const f32x4* pa = (const f32x4*)(wsp<float>(F, WS_SSQA) + row * NH); const f32x4 a0 = pa[0], a1 = pa[1], g0 = *(const f32x4*)(wsp<float>(F, WS_SSQG) + row * GG);
            const float sa = ((a0[0] + a0[1]) + (a0[2] + a0[3])) + ((a1[0] + a1[1]) + (a1[2] + a1[3])), sg = (g0[0] + g0[1]) + (g0[2] + g0[3]);
            const float ra = 1.0f / sqrtf(sa * (1.f / AW) + EPS), rg = 1.0f / sqrtf(sg * (1.f / GW) + EPS);
            rtab[s * 256 + r] = (f32x4){ra / rg, rg, wsp<float>(F, WS_SIG0)[row], 0.f}; } }
      __syncthreads();
      EpiOutProj E{wsp<bf16>(F, WS_XNB), wsp<bf16>(F, WS_X1B), wsp<unsigned char>(F, WS_X1F8), wsp<float>(F, WS_SSQ1), rtab, ha ? ua.pm : -1, hb ? ub.pm : -1};
      for (int rep = 0; rep < (DUP_PHASE == 3 ? 2 : 1); ++rep) { if (rep) GRID_BAR();
      pg8::gemm_phase<EpiOutProj, pg8::DenseSched, false, true>(F.lds + RING_OFF, DM * 2, S, E); } }
    GRID_BAR();
    STAGE_END(4);
    if (PH(4)) p4_router(F);
    GRID_BAR();
    STAGE_END(5);
    if (PH(5)) { const int nu = moe_build_tables(F, 2 * FF / 256, 1);
      pg8::MoeSched S{(const char*)wsp<char>(F, WS_X1F8), (const char*)wsp<char>(F, WS_WGU), 0, (size_t)2 * FF * DM, (size_t)256 * DM, nu,
                      (const LAS unsigned*)(F.lds + XTAB_OFF + XT_ULIST), (const LAS unsigned*)(F.lds + XTAB_OFF + XT_GTAB), true};
      EpiMoe1 E{wsp<unsigned char>(F, WS_ABUF), F.b_gu, (const LAS float*)(F.lds + XTAB_OFF + XT_RS)};
      for (int rep = 0; rep < (DUP_PHASE == 5 ? 2 : 1); ++rep) { if (rep) GRID_BAR();
      int Kb = DM; asm volatile("" : "+s"(Kb));
      pg8::gemm_phase<EpiMoe1, pg8::MoeSched, true, false, true>(F.lds + RING_OFF, Kb, S, E); } }
    GRID_BAR();
    STAGE_END(6);
    if (PH(6)) { const int nu = moe_build_tables(F, DM / 256, 2);
      pg8::MoeSched S{(const char*)wsp<char>(F, WS_ABUF), (const char*)wsp<char>(F, WS_WDN), (size_t)256 * FF, (size_t)DM * FF, (size_t)256 * FF, nu,
                      (const LAS unsigned*)(F.lds + XTAB_OFF + XT_ULIST), (const LAS unsigned*)(F.lds + XTAB_OFF + XT_GTAB), false};
      EpiMoe2 E{wsp<unsigned char>(F, WS_YBUF), F.b_dn, (const LAS float*)(F.lds + XTAB_OFF + XT_RS)};
      for (int rep = 0; rep < (DUP_PHASE == 6 ? 2 : 1); ++rep) { if (rep) GRID_BAR();
      int Kb = FF; asm volatile("" : "+s"(Kb));
      pg8::gemm_phase<EpiMoe2, pg8::MoeSched, false, false, true>(F.lds + RING_OFF, Kb, S, E); } }
    GRID_BAR();
    STAGE_END(7);
    if (PH(7)) p7_combine(F);
    GRID_BAR();
    STAGE_END(8);
    if (PH(8)) { pg8::DenseSched S; S.init(wsp<unsigned char>(F, WS_X2F8), wsp<unsigned char>(F, WS_WPG8), T, DM, DM, F.G, (int)blockIdx.x, 1);
      LAS float* rt2 = (LAS float*)(F.lds + XTAB_OFF); Unit ua, ub; const bool ha = S.next(0, ua), hb = S.next(1, ub);
      { PHASE_IDS; const int sl = TID_ >> 8, r = TID_ & 255; const bool has = sl ? hb : ha; const int pm = sl ? ub.pm : ua.pm; if (has) rt2[sl * 256 + r] = wsp<float>(F, WS_RSTD2)[(size_t)pm * 256 + r]; }
      __syncthreads();
      EpiPle<0> E{wsp<unsigned char>(F, WS_GATE), nullptr, rt2, ha ? ua.pm : -1};
      int Kb = DM; asm volatile("" : "+s"(Kb));
      pg8::gemm_phase<EpiPle<0>, pg8::DenseSched, false, false, true>(F.lds + RING_OFF, Kb, S, E);
#if CHECK_STAGE
      GRID_BAR();
      int Kb = DM; asm volatile("" : "+s"(Kb));
      pg8::gemm_phase<EpiPle<0>, pg8::DenseSched, false, false, true>(F.lds + RING_OFF, Kb, S, E);
#endif
    }
#if CHECK_STAGE
    GRID_BAR(); STAGE_CHECK(9);
#endif
    if (PH(8)) { pg8::DenseSched S; S.init(wsp<bf16>(F, WS_PB), wsp<bf16>(F, WS_WPP), T, DM, PLE, F.G, (int)blockIdx.x);
      EpiPle<1> E{wsp<unsigned char>(F, WS_PP), wsp<float>(F, WS_SSQPP), nullptr, -1};
      int Kp = PLE * 2; asm volatile("" : "+s"(Kp));
      pg8::gemm_phase<EpiPle<1>, pg8::DenseSched, false, false>(F.lds + RING_OFF, Kp, S, E); }
    GRID_BAR();
    STAGE_END(9);
#if CHECK_STAGE
    GRID_BAR(); check_report(F);
#else
    if (PH(9)) p9_final(F);
#if TPROBE
    GRID_BAR();
    if (blockIdx.x == 0 && threadIdx.x == 0) { const unsigned long long* ts = (const unsigned long long*)(F.ctl + CW_TS); const unsigned long long t1 = (TP_A == 9) ? __builtin_amdgcn_s_memrealtime() : ts[(TP_A < 10 ? TP_A : 0) + 1];
        unsigned long long d = t1 - ts[TP_A < 10 ? TP_A : 0];
        if (TP_A == 20) d = ts[11] - ts[0]; if (TP_A == 21) d = ts[12] - ts[11]; if (TP_A == 22) d = ts[13] - ts[12]; if (TP_A == 23) d = ts[1] - ts[13]; if (TP_A == 24) d = ts[14] - ts[2]; if (TP_A == 25) d = ts[3] - ts[14];
        if (TP_A == 30) d = (__builtin_amdgcn_s_memrealtime() - ts[0]) / 8;
        F.out[0] += floorf((float)d * 0.01f * 0.125f + 0.5f) * 2.0f; }
#endif
#endif
}

extern "C" void kernel_launch(void* const* d_in, const int* in_sizes, int n_in, void* d_out, int out_size, void* d_ws, size_t ws_size, hipStream_t stream) {
    static int grid = 0;
    if (grid == 0) {
        if (n_in != 23 || in_sizes[0] != T * DM || out_size != T * DM || ws_size < WS_END) { fprintf(stderr, "kernel_launch: unexpected shapes (n_in %d, in0 %d, out %d, ws %zu)\n", n_in, n_in > 0 ? in_sizes[0] : -1, out_size, ws_size); grid = -1; return; }
        int dev = 0, cus = 0, per_cu = 0;
        if (hipGetDevice(&dev) != hipSuccess || hipDeviceGetAttribute(&cus, hipDeviceAttributeMultiprocessorCount, dev) != hipSuccess) { grid = -1; return; }
        if (hipFuncSetAttribute((const void*)mega_fwd, hipFuncAttributeMaxDynamicSharedMemorySize, LDS_BYTES) != hipSuccess) { fprintf(stderr, "kernel_launch: hipFuncSetAttribute failed\n"); grid = -1; return; }
        if (hipOccupancyMaxActiveBlocksPerMultiprocessor(&per_cu, (const void*)mega_fwd, NTHR, LDS_BYTES) != hipSuccess || per_cu < 1)
            fprintf(stderr, "kernel_launch: note: occupancy query reports %d workgroups per CU\n", per_cu);
        (void)hipGetLastError();
        if (cus < 256) { fprintf(stderr, "kernel_launch: built for a 256-CU device (found %d CUs); nothing launched\n", cus); grid = -1; return; }
        grid = 256;
    }
    if (grid < 0) return;
    if (hipMemsetAsync((char*)d_ws + WS_CTL, 0, CTL_ZERO_BYTES, stream) != hipSuccess) return;
    Args a{};
    for (int i = 0; i < 23; ++i) a.in[i] = (const float*)d_in[i];
    a.out = (float*)d_out; a.ws = (unsigned char*)d_ws;
    hipLaunchKernelGGL(mega_fwd, dim3(grid), dim3(NTHR), LDS_BYTES, stream, a);
}
```

```cpp
#include <hip/hip_runtime.h>
#include <cstdio>
#include <cstdint>

#ifndef CHECK_STAGE
#define CHECK_STAGE 0
#endif
#ifndef CHECK_REPORT
#define CHECK_REPORT 0
#endif
#ifndef CHECK_REPORT2
#define CHECK_REPORT2 0
#endif
#ifndef CHECK_REPORT3
#define CHECK_REPORT3 0
#endif
#ifndef DUP_PHASE
#define DUP_PHASE -1
#endif
#ifndef TPROBE
#define TPROBE 0
#endif
#ifndef TP_A
#define TP_A 5
#endif
#ifndef TP_B
#define TP_B 6
#endif
#ifndef CHECK_SKIP
#define CHECK_SKIP 0
#endif
#ifndef PHMASK
#define PHMASK 0x3ff
#endif
#define PH(n) ((PHMASK >> (n)) & 1)

#define GAS __attribute__((address_space(1)))
#define LAS __attribute__((address_space(3)))
typedef unsigned short bf16;
typedef unsigned v4u __attribute__((ext_vector_type(4)));
typedef unsigned v2u __attribute__((ext_vector_type(2)));
typedef float f32x2 __attribute__((ext_vector_type(2)));
typedef float f32x4 __attribute__((ext_vector_type(4)));
typedef float f32x16 __attribute__((ext_vector_type(16)));
typedef short bf16x8 __attribute__((ext_vector_type(8)));
typedef short s16x4 __attribute__((ext_vector_type(4)));
typedef GAS unsigned gu32;

constexpr int BATCH = 16, SEQ = 2048, DM = 1024, T = BATCH * SEQ;
constexpr int AW = 512, NH = 8, HD = 64, NBLK = 8, MOBA = 256;
constexpr int GW = 512, GG = 4, GD = 128, GC = 128;
constexpr int NPROJ = 3 * AW + 2 * GW;
constexpr int NE = 32, TOPK = 4, FF = 1024;
constexpr int PLE = 256;
constexpr int MAXROWS = T * TOPK + NE * 256;
constexpr float EPS = 1e-6f;
constexpr int NWAVES = 8, NTHR = 512;

constexpr size_t MiB = 1u << 20;
constexpr size_t WS_CTL = 0, CTL_ZERO_BYTES = 1 * MiB;
constexpr size_t WS_KMEAN = 256 * 1024;
constexpr size_t WS_WIN = 1 * MiB;
constexpr size_t WS_WOUT = 6 * MiB;
constexpr size_t WS_WPG = 8 * MiB;
constexpr size_t WS_WPP = 10 * MiB;
constexpr size_t WS_RWG = 10 * MiB + 512 * 1024;
constexpr size_t WS_ROPE = 11 * MiB;
constexpr size_t WS_WGU = 16 * MiB;
constexpr size_t WS_WDN = 144 * MiB;
constexpr size_t WS_XNB = 208 * MiB;
constexpr size_t WS_BIG1 = 272 * MiB;
constexpr size_t WS_Q = WS_BIG1, WS_K = WS_Q + 32 * MiB, WS_V = WS_K + 32 * MiB, WS_U = WS_V + 32 * MiB, WS_VG = WS_U + 32 * MiB, WS_MIX = WS_VG + 32 * MiB;
constexpr size_t WS_YBUF = WS_BIG1;
constexpr size_t WS_BIG2 = 544 * MiB;
constexpr size_t WS_ABUF = WS_BIG2, WS_GATE = WS_BIG2, WS_PP = WS_BIG2 + 64 * MiB;
constexpr size_t WS_PB = 816 * MiB;
constexpr size_t WS_IDX = 832 * MiB;
constexpr size_t WS_GSS = 836 * MiB;
constexpr size_t WS_TOKPOS = 840 * MiB;
constexpr size_t WS_SSQA = 841 * MiB;
constexpr size_t WS_SSQG = 842 * MiB;
constexpr size_t WS_SSQ1 = 843 * MiB;
constexpr size_t WS_SSQPP = 845 * MiB;
constexpr size_t WS_X1F8 = 848 * MiB;
constexpr size_t WS_X2N = WS_XNB;
constexpr size_t WS_X1B = 880 * MiB;
constexpr size_t WS_X2B = 944 * MiB;
constexpr size_t WS_SIG0 = 1008 * MiB;
constexpr size_t WS_RSTD2 = 1008 * MiB + 256 * 1024;
constexpr size_t WS_RWT = 1008 * MiB + 512 * 1024;
constexpr size_t WS_RSS = 1009 * MiB;
constexpr size_t WS_X2F8 = 176 * MiB;
constexpr size_t WS_WPG8 = 80 * MiB;
constexpr size_t WS_END = 1013 * MiB;
static_assert(WS_MIX + 64 * MiB <= WS_BIG2 && (size_t)MAXROWS * 1024 * 2 <= 272 * MiB, "ws map");
constexpr int CW_TMO = 0, CW_CODE = 1;
constexpr int CW_BAR = 4096;
constexpr int CW_CNT = 8192;
constexpr int CW_TS = 12000;
constexpr int CW_CHK = 12288;

constexpr int RING_OFF = 0, RING_BYTES = 131072;
constexpr int P0_SCR_WAVE = 64 * 65 * 4;
constexpr int LDS_BYTES_TOTAL = 163840;
constexpr int LDSCTL_OFF = LDS_BYTES_TOTAL - 1024;
constexpr int XTAB_OFF = RING_BYTES;
static_assert(8 * P0_SCR_WAVE <= LDSCTL_OFF && XTAB_OFF >= RING_BYTES, "lds map");
constexpr int LDS_BYTES = LDS_BYTES_TOTAL;

#define RLX_AGENT __ATOMIC_RELAXED, __HIP_MEMORY_SCOPE_AGENT
#define LDS_WAIT() asm volatile("s_waitcnt lgkmcnt(0)" ::: "memory")
#define VM_WAIT() asm volatile("s_waitcnt vmcnt(0)" ::: "memory")
__device__ __forceinline__ unsigned f2bf(float f) { unsigned u = __builtin_bit_cast(unsigned, f); return (u + 0x7fffu + ((u >> 16) & 1u)) >> 16; }
__device__ __forceinline__ unsigned pk2(float lo, float hi) { return f2bf(lo) | (f2bf(hi) << 16); }
__device__ __forceinline__ float bf2f(unsigned short b) { return __builtin_bit_cast(float, ((unsigned)b) << 16); }
__device__ __forceinline__ float bflo(unsigned w) { return __builtin_bit_cast(float, w << 16); }
__device__ __forceinline__ float bfhi(unsigned w) { return __builtin_bit_cast(float, w & 0xffff0000u); }
typedef __bf16 bf16x2_t __attribute__((ext_vector_type(2)));
__device__ __forceinline__ unsigned cvt_pk_bf16(float lo, float hi) { const f32x2 v = {lo, hi}; const bf16x2_t b = __builtin_convertvector(v, bf16x2_t); return __builtin_bit_cast(unsigned, b); }
__device__ __forceinline__ float clamp448(float x) { return fminf(fmaxf(x, -448.0f), 448.0f); }
__device__ __forceinline__ unsigned pk4_fp8(float a, float b, float c, float d) { unsigned w = 0u; w = (unsigned)__builtin_amdgcn_cvt_pk_fp8_f32(clamp448(a), clamp448(b), (int)w, false); w = (unsigned)__builtin_amdgcn_cvt_pk_fp8_f32(clamp448(c), clamp448(d), (int)w, true); return w; }
__device__ __forceinline__ float fp8_to_f(unsigned v) { const unsigned sg = (v >> 7) & 1u, e = (v >> 3) & 15u, m = v & 7u; const float r = e ? ldexpf(1.0f + (float)m * 0.125f, (int)e - 7) : ldexpf((float)m * 0.125f, -6); return sg ? -r : r; }
__device__ __forceinline__ float wave_sum(float v) {
#pragma unroll
    for (int o = 1; o < 64; o <<= 1) v += __shfl_xor(v, o);
    return v;
}
__device__ __forceinline__ f32x2 gelu_pk(f32x2 v) {
    const f32x2 av = __builtin_elementwise_abs(v), d = av * 0.2316418882f + 1.0f;
    f32x2 t; t.x = __builtin_amdgcn_rcpf(d.x); t.y = __builtin_amdgcn_rcpf(d.y);
    f32x2 q = t * 0.5307027145f + (-0.7265760135f); q = q * t + 0.7107068705f; q = q * t + (-0.142248368f); q = q * t + 0.127414796f; q = q * t;
    const f32x2 s = (v * v) * (-0.72134752044f);
    f32x2 e; e.x = __builtin_amdgcn_exp2f(s.x); e.y = __builtin_amdgcn_exp2f(s.y);
    const f32x2 m = v * (q * e), r = v - m;
    f32x2 o; o.x = v.x < 0.f ? m.x : r.x; o.y = v.y < 0.f ? m.y : r.y; return o;
}
__device__ __forceinline__ f32x4 gelu4(f32x4 v) { const f32x2 a = gelu_pk((f32x2){v[0], v[1]}), b = gelu_pk((f32x2){v[2], v[3]}); return (f32x4){a.x, a.y, b.x, b.y}; }
__device__ __forceinline__ float sigmoidf_fast(float x) { return __builtin_amdgcn_rcpf(1.0f + __builtin_amdgcn_exp2f(-1.4426950408889634f * x)); }

#define XB_TMO      128
#define XB_XCNT(j)  (256  + 64 * (j))
#define XB_XSUB(j)  (1280 + 64 * (j))
#define XB_XGEN(j)  (2304 + 64 * (j))
#define XB_TOP      3328
#define XB_TOPGEN   3392
#define XCD_BAR_WORDS 3456
#define XB_SPIN_CAP (1u << 18)
__device__ __forceinline__ unsigned xb_ld(unsigned* p)              { return __hip_atomic_load(p, __ATOMIC_RELAXED, __HIP_MEMORY_SCOPE_AGENT); }
__device__ __forceinline__ unsigned xb_add(unsigned* p, unsigned v) { return __hip_atomic_fetch_add(p, v, __ATOMIC_RELAXED, __HIP_MEMORY_SCOPE_AGENT); }
__device__ __forceinline__ unsigned xb_xcc_id() { return (unsigned)__builtin_amdgcn_s_getreg((3 << 11) | 20) & 0xFu; }
#define XB_SPIN(cond, bar) do { unsigned _sp = 0; while (cond) { __builtin_amdgcn_s_sleep(1); \
    if ((++_sp & 255u) == 0u) { if (xb_ld(&(bar)[XB_TMO])) break; if (_sp > XB_SPIN_CAP) { atomicAdd(&(bar)[XB_TMO], 1u); break; } } } } while (0)
struct XcdBarrier { unsigned* bar; unsigned x; volatile LAS unsigned* st; };
__device__ __forceinline__ XcdBarrier xcd_barrier_post(unsigned* bar, volatile LAS unsigned* st) {
    XcdBarrier b; b.bar = bar; b.x = xb_xcc_id(); b.st = st;
    if (threadIdx.x == 0) (void)xb_add(&bar[XB_XCNT(b.x)], 1u);
    return b;
}
__device__ __forceinline__ void xcd_barrier_complete(unsigned* bar, unsigned x, unsigned& nloc, unsigned& nx) {
    const unsigned G = gridDim.x * gridDim.y * gridDim.z;
    unsigned sum, cnt, mine, sp = 0u;
    for (;;) {
        sum = 0u; cnt = 0u; mine = 0u;
#pragma unroll
        for (unsigned j = 0; j < 16; ++j) { const unsigned c = xb_ld(&bar[XB_XCNT(j)]); sum += c; cnt += (c > 0u) ? 1u : 0u; mine = (j == x) ? c : mine; }
        if (sum == G) break;
        __builtin_amdgcn_s_sleep(1);
        if ((++sp & 255u) == 0u) { if (xb_ld(&bar[XB_TMO])) break; if (sp > XB_SPIN_CAP) { atomicAdd(&bar[XB_TMO], 1u); break; } }
    }
    nloc = mine > 0u ? mine : 1u; nx = cnt > 0u ? cnt : 1u;
}
__device__ __forceinline__ void xcd_barrier(const XcdBarrier& b) {
    asm volatile("s_waitcnt vmcnt(0)" ::: "memory");
    __syncthreads();
    if (threadIdx.x == 0) {
        unsigned* bar = b.bar;
        __builtin_amdgcn_s_waitcnt(0);
        unsigned nloc = b.st[0], nx = b.st[1];
        if (nloc == 0u) { xcd_barrier_complete(bar, b.x, nloc, nx); b.st[0] = nloc; b.st[1] = nx; }
        const unsigned old = xb_add(&bar[XB_XSUB(b.x)], 1u);
        const unsigned gen = old / nloc;
        if (old + 1u == (gen + 1u) * nloc) {
            __builtin_amdgcn_fence(__ATOMIC_RELEASE, "agent");
            asm volatile("s_waitcnt vmcnt(0)" ::: "memory");
            const unsigned og = xb_add(&bar[XB_TOP], 1u);
            const unsigned tg = og / nx;
            if (og + 1u == (tg + 1u) * nx) xb_add(&bar[XB_TOPGEN], 1u);
            else XB_SPIN(xb_ld(&bar[XB_TOPGEN]) == tg, bar);
            __builtin_amdgcn_fence(__ATOMIC_ACQUIRE, "agent");
            xb_add(&bar[XB_XGEN(b.x)], 1u);
            asm volatile("s_waitcnt vmcnt(0)" ::: "memory");
        } else {
            XB_SPIN(xb_ld(&bar[XB_XGEN(b.x)]) == gen, bar);
            __builtin_amdgcn_fence(__ATOMIC_ACQUIRE, "agent");
            asm volatile("s_waitcnt vmcnt(0)" ::: "memory");
        }
    }
    __syncthreads();
}

namespace pg8 {
constexpr int BM = 256, BK = 64, HALF = 128, HTB = HALF * BK * 2, STAGE_BYTES = 8 * HTB, NXCD = 8, WGM = 8;
__host__ __device__ __forceinline__ int lds_byte(int r, int c) { const int st = (r >> 4) * 2 + (c >> 5), rr = r & 15, cc = c & 31, ob = rr * 64 + cc * 2; return st * 1024 + (ob ^ (((ob >> 9) & 1) << 5)); }
__host__ __device__ __forceinline__ void stage_rc(int b, int& R, int& C) { const int st = b / 1024, sb = b % 1024, swz = sb ^ (((sb >> 9) & 1) << 5); R = (st >> 1) * 16 + swz / 64; C = (st & 1) * 32 + (swz % 64) / 2; }
__host__ __device__ __forceinline__ int perm32(int rho) { const int n = rho >> 4, i = rho & 15; return 8 * (i >> 2) + 4 * n + (i & 3); }

typedef int v8i __attribute__((ext_vector_type(8)));
constexpr int F8_WSHIFT = 6, F8_SCALE_W = 127 - F8_WSHIFT;
typedef int v4i __attribute__((ext_vector_type(4)));
__device__ __forceinline__ v8i ld8(const LAS unsigned char* p0, const LAS unsigned char* p1) { const v4i lo = *(const LAS v4i*)p0, hi = *(const LAS v4i*)p1; return __builtin_shufflevector(lo, hi, 0, 1, 2, 3, 4, 5, 6, 7); }
struct Unit { int pm, pn, e, rt, slot; };

__device__ __forceinline__ void flat_to_tile(int L, int nwg, int nM, int nN, int& pm, int& pn) {
    int wgid = L; { const int q = nwg / NXCD, r = nwg % NXCD, xcd = wgid % NXCD, off = wgid / NXCD; wgid = (xcd < r ? xcd * (q + 1) : r * (q + 1) + (xcd - r) * q) + off; }
    const int nig = WGM * nN, gid = wgid / nig, fm = gid * WGM, gsz = (nM - fm) < WGM ? (nM - fm) : WGM;
    pm = fm + ((wgid % nig) % gsz); pn = (wgid % nig) / gsz;
}
struct DenseSched {
    const char* A; const char* Bt; int nM, nN, nwg, G, c; size_t tstep;
    __device__ __forceinline__ void init(const void* A_, const void* Bt_, int M, int N, int K, int G_, int c_, int ebytes = 2) { A = (const char*)A_; Bt = (const char*)Bt_; nM = M / BM; nN = N / BM; nwg = nM * nN; G = G_; c = c_; tstep = (size_t)BM * K * ebytes; }
    __device__ __forceinline__ bool next(int i, Unit& u) const { const long L = (long)i * G + c; if (L >= nwg) return false; flat_to_tile((int)L, nwg, nM, nN, u.pm, u.pn); u.e = 0; u.rt = u.pm; u.slot = i; return true; }
    __device__ __forceinline__ const char* a_base(const Unit& u) const { return A + (size_t)u.pm * tstep; }
    __device__ __forceinline__ const char* b_base(const Unit& u) const { return Bt + (size_t)u.pn * tstep; }
    __device__ __forceinline__ void gather(int, int, int, unsigned (&)[2][2]) const {}
};
struct MoeSched {
    const char* A; const char* Bt; size_t a_tstep, b_estep, b_tstep; int nunits; const LAS unsigned* ulist; const LAS unsigned* gtab; bool gath;
    __device__ __forceinline__ bool next(int i, Unit& u) const {
        if (i >= nunits) return false;
        const unsigned w = (unsigned)__builtin_amdgcn_readfirstlane((int)ulist[i]);
        u.pm = (int)(w & 0x3ffu); u.pn = (int)((w >> 10) & 0x7u); u.e = (int)((w >> 13) & 0x1fu); u.rt = (int)(w >> 18); u.slot = i; return true;
    }
    __device__ __forceinline__ const char* a_base(const Unit& u) const { return gath ? A : A + (size_t)u.pm * a_tstep; }
    __device__ __forceinline__ const char* b_base(const Unit& u) const { return Bt + (size_t)u.e * b_estep + (size_t)u.pn * b_tstep; }
    __device__ __forceinline__ void gather(int i, int R0, int R1, unsigned (&off)[2][2]) const {
        const LAS unsigned short* g = (const LAS unsigned short*)gtab + i * 256;
        off[0][0] = (unsigned)g[R0] << 10; off[0][1] = (unsigned)g[R1] << 10; off[1][0] = (unsigned)g[128 + R0] << 10; off[1][1] = (unsigned)g[128 + R1] << 10;
    }
};

#define PG8_SA(b, h) (((b) * 2 + (h)) * HTB)
#define PG8_SB(b, h) ((4 + (b) * 2 + (h)) * HTB)
#define PG8_GLDS(src, dstoff) __builtin_amdgcn_global_load_lds((const unsigned*)(src), (LAS unsigned*)(lds + (dstoff)), 16, 0, 0)
#define PG8_STAGE_B(bufoff, gbase) do { _Pragma("unroll") for (int _i = 0; _i < 2; ++_i) PG8_GLDS((const char*)(gbase) + voffB[_i], (bufoff) + ldsw + _i * 8192); } while (0)
#define PG8_STAGE_A(bufoff, kptr, h, o) do { _Pragma("unroll") for (int _i = 0; _i < 2; ++_i) \
        PG8_GLDS(GATHER ? (const char*)(kptr) + (o)[h][_i] : (const char*)(kptr) + (size_t)(h) * hstep + voffA[_i], (bufoff) + ldsw + _i * 8192); } while (0)
#define PG8_LDA(dst, b, h) do { _Pragma("unroll") for (int m = 0; m < 4; ++m) { if constexpr (F8) dst##8[m] = ld8(lds + PG8_SA(b, h) + a8_0 + m * 2048, lds + PG8_SA(b, h) + a8_1 + m * 2048); \
        else { _Pragma("unroll") for (int k = 0; k < 2; ++k) dst[m][k] = *(const LAS bf16x8*)(lds + PG8_SA(b, h) + aoff + m * 2048 + k * 1024); } } } while (0)
#define PG8_LDB(dst, b, h) do { _Pragma("unroll") for (int n = 0; n < 2; ++n) { if constexpr (F8) dst##8[n] = ld8(lds + PG8_SB(b, h) + b8_0 + n * 2048, lds + PG8_SB(b, h) + b8_1 + n * 2048); \
        else { _Pragma("unroll") for (int k = 0; k < 2; ++k) dst[n][k] = *(const LAS bf16x8*)(lds + PG8_SB(b, h) + boff + n * 2048 + k * 1024); } } } while (0)
#define PG8_MMA(ai, bj, At, Bt) do { __builtin_amdgcn_s_setprio(1); _Pragma("unroll") for (int m = 0; m < 4; ++m) _Pragma("unroll") for (int n = 0; n < 2; ++n) { \
        if constexpr (F8) asm volatile("v_mfma_scale_f32_16x16x128_f8f6f4 %0, %1, %2, %0, %3, %4 op_sel_hi:[0,0,0]" : "+v"(acc[ai][bj][m][n]) : "v"(Bt##8[n]), "v"(At##8[m]), "v"(sc_w), "v"(sc_a)); \
        else { _Pragma("unroll") for (int k = 0; k < 2; ++k) acc[ai][bj][m][n] = __builtin_amdgcn_mfma_f32_16x16x32_bf16(Bt[n][k], At[m][k], acc[ai][bj][m][n], 0, 0, 0); } } __builtin_amdgcn_s_setprio(0); } while (0)
#define PG8_WAIT_V(n) asm volatile("s_waitcnt vmcnt(" #n ")" ::: "memory")
#define PG8_WAIT_L(n) asm volatile("s_waitcnt lgkmcnt(" #n ")" ::: "memory")
#define PG8_BAR __builtin_amdgcn_s_barrier()
#define PG8_SCHED __builtin_amdgcn_sched_barrier(0)

template <class Epi, class Sched, bool GATHER, bool MIDK, bool F8 = false>
__device__ __forceinline__ void gemm_phase(LAS unsigned char* lds, const int KB  , const Sched& S, const Epi& E) {
    int tid = (int)threadIdx.x; asm volatile("" : "+v"(tid));
    const int wid = __builtin_amdgcn_readfirstlane(tid >> 6), lane = tid & 63, wr = wid >> 2, wc = wid & 3, fr = lane & 15, fq = lane >> 4;
    const int nt = KB / 128;
    unsigned voffA[2], voffB[2]; int Rg[2]; unsigned Cg[2];
#pragma unroll
    for (int i = 0; i < 2; ++i) { int R, C; stage_rc(tid * 16 + i * 8192, R, C); const int Rb = Epi::PERM ? ((R & ~31) + perm32(R & 31)) : R;
        voffA[i] = (unsigned)(R * KB + C * 2); voffB[i] = (unsigned)(Rb * KB + C * 2); Rg[i] = R; Cg[i] = (unsigned)C * 2u; }
    const size_t kstep = 128;
    const size_t hstep = (size_t)HALF * KB;
    const unsigned ldsw = (unsigned)wid * 1024u;
    const int aoff = lds_byte(wr * 64 + fr, fq * 8), boff = lds_byte(wc * 32 + fr, fq * 8);
    const int a8_0 = aoff, a8_1 = aoff + 1024, b8_0 = boff, b8_1 = boff + 1024;
    Unit cur, nxt; int ui = 0;
    if (!S.next(0, cur)) return;
    f32x4 acc[2][2][4][2];
#pragma unroll
    for (int a = 0; a < 2; ++a)
#pragma unroll
        for (int b = 0; b < 2; ++b)
#pragma unroll
            for (int m = 0; m < 4; ++m)
#pragma unroll
                for (int n = 0; n < 2; ++n) acc[a][b][m][n] = (f32x4){0.f, 0.f, 0.f, 0.f};
    bf16x8 At[4][2], B0[2][2], B1[2][2]; v8i At8[4], B08[2], B18[2];
    int sc_w = F8_SCALE_W, sc_a = 127; if constexpr (F8) { asm volatile("" : "+v"(sc_w), "+v"(sc_a)); }
    unsigned offC[2][2] = {{0u, 0u}, {0u, 0u}}, offN[2][2] = {{0u, 0u}, {0u, 0u}};
    if constexpr (GATHER) { S.gather(0, Rg[0], Rg[1], offC);
#pragma unroll
        for (int h = 0; h < 2; ++h)
#pragma unroll
            for (int i = 0; i < 2; ++i) offC[h][i] += Cg[i]; }
    const char* cA = S.a_base(cur); const char* cB = S.b_base(cur);
    PG8_STAGE_B(PG8_SB(0, 0), cB); PG8_STAGE_B(PG8_SB(0, 1), cB + hstep); PG8_STAGE_A(PG8_SA(0, 0), cA, 0, offC); PG8_STAGE_A(PG8_SA(0, 1), cA, 1, offC);
    if (wr == 1) PG8_BAR;
    PG8_WAIT_V(2); PG8_BAR;
    PG8_STAGE_B(PG8_SB(1, 0), cB + kstep); PG8_STAGE_A(PG8_SA(1, 0), cA + kstep, 0, offC); PG8_STAGE_B(PG8_SB(1, 1), cB + hstep + kstep);
    PG8_WAIT_V(6); PG8_BAR;
    for (;;) {
        const bool has_next = S.next(ui + 1, nxt);
        const char* nA = has_next ? S.a_base(nxt) : cA; const char* nB = has_next ? S.b_base(nxt) : cB;
        if constexpr (GATHER) { if (has_next) { S.gather(ui + 1, Rg[0], Rg[1], offN);
#pragma unroll
                for (int h = 0; h < 2; ++h)
#pragma unroll
                    for (int i = 0; i < 2; ++i) offN[h][i] += Cg[i]; }
            else {
#pragma unroll
                for (int h = 0; h < 2; ++h)
#pragma unroll
                    for (int i = 0; i < 2; ++i) offN[h][i] = offC[h][i]; } }
        for (int t = 0; t < nt; t += 2) {
            const bool last = (t == nt - 2);
            const char* a1 = cA + (size_t)(t + 1) * kstep;
            const char* a2 = last ? nA : cA + (size_t)(t + 2) * kstep; const char* b2 = last ? nB : cB + (size_t)(t + 2) * kstep;
            const char* a3 = a2 + kstep; const char* b3 = b2 + kstep;
            unsigned o2[2][2];
#pragma unroll
            for (int h = 0; h < 2; ++h)
#pragma unroll
                for (int i = 0; i < 2; ++i) o2[h][i] = last ? offN[h][i] : offC[h][i];
            if constexpr (MIDK) { if (t == nt / 2) E.midk(acc, cur, wr, fr); }
            PG8_LDB(B0, 0, 0); PG8_LDB(B1, 0, 1); PG8_SCHED; PG8_LDA(At, 0, 0); PG8_STAGE_A(PG8_SA(1, 1), a1, 1, offC);
            PG8_WAIT_V(8); PG8_WAIT_L(0); PG8_BAR; PG8_MMA(0, 0, At, B0); PG8_MMA(0, 1, At, B1); PG8_BAR; PG8_SCHED;
            PG8_LDA(At, 0, 1); PG8_STAGE_B(PG8_SB(0, 0), b2); PG8_STAGE_B(PG8_SB(0, 1), b2 + hstep); PG8_STAGE_A(PG8_SA(0, 0), a2, 0, o2);
            PG8_WAIT_V(8); PG8_WAIT_L(0); PG8_BAR; PG8_MMA(1, 0, At, B0); PG8_MMA(1, 1, At, B1); PG8_BAR; PG8_SCHED;
            PG8_LDB(B0, 1, 0); PG8_LDB(B1, 1, 1); PG8_SCHED; PG8_LDA(At, 1, 0); PG8_STAGE_A(PG8_SA(0, 1), a2, 1, o2);
            PG8_WAIT_V(8); PG8_WAIT_L(0); PG8_BAR; PG8_MMA(0, 0, At, B0); PG8_MMA(0, 1, At, B1); PG8_BAR; PG8_SCHED;
            PG8_LDA(At, 1, 1); PG8_STAGE_B(PG8_SB(1, 0), b3); PG8_STAGE_B(PG8_SB(1, 1), b3 + hstep); PG8_STAGE_A(PG8_SA(1, 0), a3, 0, o2);
            PG8_WAIT_V(8); PG8_WAIT_L(0); PG8_BAR; PG8_MMA(1, 0, At, B0); PG8_MMA(1, 1, At, B1); PG8_BAR; PG8_SCHED;
        }
        if (wr == 0) PG8_BAR;
        if constexpr (F8) asm volatile("s_nop 15\n\ts_nop 15" ::: "memory");
        E(acc, cur, wr, wc, fr, fq);
        if (!has_next) break;
#pragma unroll
        for (int a = 0; a < 2; ++a)
#pragma unroll
            for (int b = 0; b < 2; ++b)
#pragma unroll
                for (int m = 0; m < 4; ++m)
#pragma unroll
                    for (int n = 0; n < 2; ++n) acc[a][b][m][n] = (f32x4){0.f, 0.f, 0.f, 0.f};
        cur = nxt; cA = nA; cB = nB; ++ui;
        if constexpr (GATHER) {
#pragma unroll
            for (int h = 0; h < 2; ++h)
#pragma unroll
                for (int i = 0; i < 2; ++i) offC[h][i] = offN[h][i]; }
        if (wr == 1) PG8_BAR;
    }
    PG8_WAIT_V(0);
    PG8_BAR;
}
}

struct Frame {
    LAS unsigned char* lds;
    volatile LAS unsigned* MISC;
    gu32* ctl;
    unsigned char* ws;
    int vcu, G;
    const float *x, *p, *mix_norm, *w_in, *ln_g, *ln_b, *gws, *gbs, *aon, *gon, *w_out, *ffn_norm, *router_w, *router_b, *w_gu, *b_gu, *w_dn, *b_dn, *ple_norm, *w_pg, *w_pp, *ppn, *final_norm;
    float* out;
};
template <class T_> __device__ __forceinline__ T_* wsp(const Frame& F, size_t off) { return (T_*)(F.ws + off); }

#define PHASE_IDS int TID_ = (int)threadIdx.x; asm volatile("" : "+v"(TID_)); const int LANE_ = TID_ & 63; const int WAVE_ = __builtin_amdgcn_readfirstlane(TID_ >> 6); (void)LANE_; (void)WAVE_
template <class ColMap>
__device__ __forceinline__ void p0_transpose_item(const float* W, int K, int N, bf16* WT, const float* gain, LAS float* scr, int item, int lane, int nphys, const ColMap& cm) {
    const int nblk = nphys / 64, kb = item / nblk, nb = item % nblk, k0 = 64 * kb, n0 = 64 * nb;
    const int srccol = cm(n0 + lane);
    float v_[64]; const float* src = W + (size_t)k0 * N + srccol;
#pragma unroll
    for (int kk = 0; kk < 64; ++kk) v_[kk] = __builtin_nontemporal_load(src + (size_t)kk * N);
    if (gain) {
#pragma unroll
        for (int kk = 0; kk < 64; kk += 4) { const f32x4 g4 = *(const f32x4*)(gain + k0 + kk); v_[kk] *= g4[0]; v_[kk + 1] *= g4[1]; v_[kk + 2] *= g4[2]; v_[kk + 3] *= g4[3]; } }
#pragma unroll
    for (int kk = 0; kk < 64; ++kk) scr[kk * 65 + lane] = v_[kk];
    LDS_WAIT(); asm volatile("" ::: "memory");
    const int c = lane & 7;
#pragma unroll
    for (int j = 0; j < 8; ++j) { const int n = (lane >> 3) + 8 * j; const LAS float* s = scr + (8 * c) * 65 + n;
        v4u o; o.x = pk2(s[0 * 65], s[1 * 65]); o.y = pk2(s[2 * 65], s[3 * 65]); o.z = pk2(s[4 * 65], s[5 * 65]); o.w = pk2(s[6 * 65], s[7 * 65]);
        *(GAS v4u*)(WT + (size_t)(n0 + n) * K + k0 + 8 * c) = o; }
    LDS_WAIT(); asm volatile("" ::: "memory");
}
template <class ColMap>
__device__ __forceinline__ void p0_transpose_item_f8(const float* W, int K, int N, unsigned char* WT, const float* gain, LAS float* scr, int item, int lane, int nphys, const ColMap& cm) {
    const int nblk = nphys / 64, kb = item / nblk, nb = item % nblk, k0 = 64 * kb, n0 = 64 * nb;
    const int srccol = cm(n0 + lane);
    float v_[64]; const float* src = W + (size_t)k0 * N + srccol;
#pragma unroll
    for (int kk = 0; kk < 64; ++kk) v_[kk] = __builtin_nontemporal_load(src + (size_t)kk * N);
    constexpr float WS_ = (float)(1 << pg8::F8_WSHIFT);
#pragma unroll
    for (int kk = 0; kk < 64; kk += 4) { f32x4 g4 = gain ? *(const f32x4*)(gain + k0 + kk) : (f32x4){1.f, 1.f, 1.f, 1.f}; v_[kk] *= g4[0] * WS_; v_[kk + 1] *= g4[1] * WS_; v_[kk + 2] *= g4[2] * WS_; v_[kk + 3] *= g4[3] * WS_; }
#pragma unroll
    for (int kk = 0; kk < 64; ++kk) scr[kk * 65 + lane] = v_[kk];
    LDS_WAIT(); asm volatile("" ::: "memory");
    const int c = lane & 3;
#pragma unroll
    for (int j = 0; j < 4; ++j) { const int n = (lane >> 2) + 16 * j; const LAS float* s_ = scr + (16 * c) * 65 + n;
        v4u o; o.x = pk4_fp8(s_[0 * 65], s_[1 * 65], s_[2 * 65], s_[3 * 65]); o.y = pk4_fp8(s_[4 * 65], s_[5 * 65], s_[6 * 65], s_[7 * 65]);
        o.z = pk4_fp8(s_[8 * 65], s_[9 * 65], s_[10 * 65], s_[11 * 65]); o.w = pk4_fp8(s_[12 * 65], s_[13 * 65], s_[14 * 65], s_[15 * 65]);
        *(GAS v4u*)(WT + (size_t)(n0 + n) * K + k0 + 16 * c) = o; }
    LDS_WAIT(); asm volatile("" ::: "memory");
}
struct CmId { __device__ __forceinline__ int operator()(int n) const { return n; } };
struct CmWin { __device__ __forceinline__ int operator()(int n) const { if (n >= 2 * AW) return n; const int c = n & 63; return (n & ~63) + 4 * (c >> 3) + (c & 3) + 32 * ((c >> 2) & 1); } };
struct CmWgu { __device__ __forceinline__ int operator()(int n) const { return ((n >> 7) & 1) * FF + (n >> 8) * 128 + (n & 127); } };

constexpr int XW_I_GU = (DM / 64) * (2 * FF / 64), XW_I_DN = (FF / 64) * (DM / 64), XW_ITEMS = NE * (XW_I_GU + XW_I_DN);
__device__ __forceinline__ void xw_convert_item(const Frame& F, int it, LAS float* scr, int lane) {
    if (it < NE * XW_I_GU) { const int e = it / XW_I_GU; p0_transpose_item_f8(F.w_gu + (size_t)e * DM * 2 * FF, DM, 2 * FF, wsp<unsigned char>(F, WS_WGU) + (size_t)e * 2 * FF * DM, F.ffn_norm, scr, it % XW_I_GU, lane, 2 * FF, CmWgu()); }
    else { const int r = it - NE * XW_I_GU, e = r / XW_I_DN; p0_transpose_item_f8(F.w_dn + (size_t)e * FF * DM, FF, DM, wsp<unsigned char>(F, WS_WDN) + (size_t)e * DM * FF, nullptr, scr, r % XW_I_DN, lane, DM, CmId()); }
}
__device__ __forceinline__ void p0_prologue(Frame& F) {
    PHASE_IDS;
    LAS float* scr = (LAS float*)(F.lds + RING_OFF + WAVE_ * P0_SCR_WAVE);
    const int gw = F.vcu * NWAVES + WAVE_, NGW = F.G * NWAVES;
    constexpr int I_GU = (DM / 64) * (2 * FF / 64), I_DN = (FF / 64) * (DM / 64), I_IN = (DM / 64) * (NPROJ / 64), I_SQ = (DM / 64) * (DM / 64), I_PP = (PLE / 64) * (DM / 64);
    constexpr int NITEMS = I_IN + 2 * I_SQ + I_PP;
    (void)I_GU; (void)I_DN;
    for (int it = gw; it < NITEMS; it += NGW) {
        int r = it;
        if (r < I_IN) { p0_transpose_item(F.w_in, DM, NPROJ, wsp<bf16>(F, WS_WIN), F.mix_norm, scr, r, LANE_, NPROJ, CmWin()); continue; } r -= I_IN;
        if (r < I_SQ) {
            const int nblk = DM / 64, kb = r / nblk; const float* g = (kb < 8) ? F.aon : (F.gon - AW);
            p0_transpose_item(F.w_out, DM, DM, wsp<bf16>(F, WS_WOUT), g, scr, r, LANE_, DM, CmId()); continue; } r -= I_SQ;
        if (r < I_SQ) { p0_transpose_item_f8(F.w_pg, DM, DM, wsp<unsigned char>(F, WS_WPG8), F.ple_norm, scr, r, LANE_, DM, CmId()); continue; } r -= I_SQ;
        p0_transpose_item(F.w_pp, PLE, DM, wsp<bf16>(F, WS_WPP), nullptr, scr, r, LANE_, DM, CmId());
    }
    if (TPROBE && blockIdx.x == 0 && threadIdx.x == 0) ((unsigned long long*)(F.ctl + CW_TS))[11] = __builtin_amdgcn_s_memrealtime();
    bf16* XN = wsp<bf16>(F, WS_XNB);
    for (int m0 = gw; m0 < T; m0 += 2 * NGW) {
        f32x4 v[2][4]; float s[2] = {0.f, 0.f};
#pragma unroll
        for (int r = 0; r < 2; ++r) { const GAS f32x4* xr = (const GAS f32x4*)(F.x + (size_t)(m0 + r * NGW) * DM) + LANE_;
#pragma unroll
            for (int j = 0; j < 4; ++j) v[r][j] = __builtin_nontemporal_load(xr + 64 * j); }
#pragma unroll
        for (int r = 0; r < 2; ++r) {
#pragma unroll
            for (int j = 0; j < 4; ++j) s[r] += (v[r][j].x * v[r][j].x + v[r][j].y * v[r][j].y) + (v[r][j].z * v[r][j].z + v[r][j].w * v[r][j].w); }
#pragma unroll
        for (int r = 0; r < 2; ++r) { const int m = m0 + r * NGW; const float sig = sqrtf(wave_sum(s[r]) * (1.f / DM) + EPS), rstd = 1.0f / sig;
            if (LANE_ == 0) wsp<float>(F, WS_SIG0)[m] = sig;
            GAS v2u* o8 = (GAS v2u*)(XN + (size_t)m * DM) + LANE_;
#pragma unroll
            for (int j = 0; j < 4; ++j) { v2u w; w.x = pk2(v[r][j].x * rstd, v[r][j].y * rstd); w.y = pk2(v[r][j].z * rstd, v[r][j].w * rstd); o8[64 * j] = w; } }
    }
    if (TPROBE && blockIdx.x == 0 && threadIdx.x == 0) ((unsigned long long*)(F.ctl + CW_TS))[12] = __builtin_amdgcn_s_memrealtime();
    { const GAS f32x4* pr = (const GAS f32x4*)F.p; GAS v2u* po = (GAS v2u*)wsp<bf16>(F, WS_PB);
      const size_t n4 = (size_t)T * PLE / 4, gt = (size_t)(F.vcu * NTHR + TID_), GT = (size_t)F.G * NTHR;
      for (size_t i = gt; i < n4; i += GT) { const f32x4 v = pr[i]; v2u w; w.x = pk2(v.x, v.y); w.y = pk2(v.z, v.w); po[i] = w; } }
    if (TPROBE && blockIdx.x == 0 && threadIdx.x == 0) ((unsigned long long*)(F.ctl + CW_TS))[13] = __builtin_amdgcn_s_memrealtime();
    { const int gt = F.vcu * NTHR + TID_, GT = F.G * NTHR; float* RWG = wsp<float>(F, WS_RWG);
      (void)RWG; bf16* RWT = wsp<bf16>(F, WS_RWT);
      for (int i = gt; i < DM * NE; i += GT) { const int e = i / DM, k = i % DM; const float w = F.router_w[k * NE + e] * F.ffn_norm[k]; const unsigned hi = f2bf(w); const float lo = w - bf2f((bf16)hi); RWT[i] = (bf16)hi; RWT[NE * DM + i] = (bf16)f2bf(lo); }
      float* RC = wsp<float>(F, WS_ROPE); float* RS = RC + SEQ * 32;
      for (int i = gt; i < SEQ * 32; i += GT) { const int pos = i >> 5, j = i & 31; const float inv = powf(10000.0f, -(float)j / 32.0f); const float ang = (float)pos * inv; float sn, cs; sincosf(ang, &sn, &cs); RC[i] = cs; RS[i] = sn; } }
}

using pg8::Unit;
constexpr int HALF = 128;
struct EpiInProj {
    static constexpr bool PERM = true;
    bf16* QKVUV; const float *rc, *rs; float* kmean;
    __device__ __forceinline__ void operator()(const f32x4 (&acc)[2][2][4][2], const Unit& u, int wr, int wc, int fr, int fq) const {
        const int type = u.pn >> 1, colt = (u.pn & 1) * 256 + wc * 32 + 8 * fq;
        const int row0 = u.pm * 256 + wr * 64 + fr;
        if (type <= 1) {
            bf16* dst = QKVUV + (size_t)type * (16u << 20);
            const int pos0 = (u.pm & 7) * 256 + wr * 64 + fr, i0 = 16 * (wc & 1) + 4 * fq;
            f32x4 cs_[2][2];
#pragma unroll
            for (int bj = 0; bj < 2; ++bj) { cs_[bj][0] = (f32x4){0.f, 0.f, 0.f, 0.f}; cs_[bj][1] = (f32x4){0.f, 0.f, 0.f, 0.f}; }
#pragma unroll
            for (int ai = 0; ai < 2; ++ai) { f32x4 cc[4], ss[4];
#pragma unroll
                for (int m = 0; m < 4; ++m) { const int pos = pos0 + ai * HALF + m * 16; cc[m] = *(const f32x4*)(rc + pos * 32 + i0); ss[m] = *(const f32x4*)(rs + pos * 32 + i0); }
#pragma unroll
                for (int m = 0; m < 4; ++m) { const int ro = ai * HALF + m * 16; const f32x4 c = cc[m], s = ss[m];
                    bf16* rowp = dst + (size_t)(row0 + ro) * AW + colt;
#pragma unroll
                    for (int bj = 0; bj < 2; ++bj) { const f32x4 x1 = acc[ai][bj][m][0], x2 = acc[ai][bj][m][1];
                        const f32x4 o1 = x1 * c - x2 * s, o2 = x2 * c + x1 * s;
                        cs_[bj][0] += o1; cs_[bj][1] += o2;
                        v4u w; w.x = cvt_pk_bf16(o1[0], o1[1]); w.y = cvt_pk_bf16(o1[2], o1[3]); w.z = cvt_pk_bf16(o2[0], o2[1]); w.w = cvt_pk_bf16(o2[2], o2[3]);
                        *(v4u*)(rowp + bj * HALF) = w; } }
                asm volatile("" ::: "memory"); }
            if (type == 1) {
#pragma unroll
                for (int bj = 0; bj < 2; ++bj)
#pragma unroll
                    for (int n = 0; n < 2; ++n)
#pragma unroll
                        for (int j = 0; j < 4; ++j) { float v = cs_[bj][n][j]; v += __shfl_xor(v, 1); v += __shfl_xor(v, 2); v += __shfl_xor(v, 4); v += __shfl_xor(v, 8); cs_[bj][n][j] = v; }
                if (fr == 0) { const int b = u.pm >> 3, blk = u.pm & 7;
#pragma unroll
                    for (int bj = 0; bj < 2; ++bj) { const int colh = (u.pn & 1) * 256 + bj * HALF + wc * 32; const int head = colh >> 6, cpos = (colh & 63) + 8 * fq;
                        float* km = kmean + ((size_t)((b * NH + head) * NBLK + blk)) * HD + cpos;
#pragma unroll
                        for (int n = 0; n < 2; ++n)
#pragma unroll
                            for (int j = 0; j < 4; ++j) atomicAdd(km + 4 * n + j, cs_[bj][n][j]); } }
            }
        } else {
            bf16* dst = QKVUV + (size_t)type * (16u << 20);
#pragma unroll
            for (int ai = 0; ai < 2; ++ai)
#pragma unroll
                for (int m = 0; m < 4; ++m) { bf16* rowp = dst + (size_t)(row0 + ai * HALF + m * 16) * AW + colt;
#pragma unroll
                    for (int bj = 0; bj < 2; ++bj) { f32x4 v0 = acc[ai][bj][m][0], v1 = acc[ai][bj][m][1];
                        if (type >= 3) { v0 = gelu4(v0); v1 = gelu4(v1); }
                        v4u w; w.x = cvt_pk_bf16(v0[0], v0[1]); w.y = cvt_pk_bf16(v0[2], v0[3]); w.z = cvt_pk_bf16(v1[0], v1[1]); w.w = cvt_pk_bf16(v1[2], v1[3]);
                        *(v4u*)(rowp + bj * HALF) = w; } }
        }
    }
};
struct EpiOutProj {
    static constexpr bool PERM = true;
    const bf16* xn; bf16* x1; unsigned char* x1f8; float* ssq1; const LAS f32x4* rtab;
    int pm_a, pm_b;
    __device__ __forceinline__ int slot(const Unit& u) const { return u.pm == pm_a ? 0 : 1; }
    __device__ __forceinline__ void midk(f32x4 (&acc)[2][2][4][2], const Unit& u, int wr, int fr) const {
        const LAS f32x4* t = rtab + slot(u) * 256 + wr * 64 + fr;
#pragma unroll
        for (int ai = 0; ai < 2; ++ai)
#pragma unroll
            for (int m = 0; m < 4; ++m) { const float r = t[ai * HALF + m * 16].x;
#pragma unroll
                for (int bj = 0; bj < 2; ++bj)
#pragma unroll
                    for (int n = 0; n < 2; ++n) acc[ai][bj][m][n] *= r; }
    }
    __device__ __forceinline__ void operator()(const f32x4 (&acc)[2][2][4][2], const Unit& u, int wr, int wc, int fr, int fq) const {
        const LAS f32x4* t = rtab + slot(u) * 256 + wr * 64 + fr;
        const int row0 = u.pm * 256 + wr * 64 + fr, col0 = u.pn * 256 + wc * 32 + 8 * fq;
#pragma unroll
        for (int ai = 0; ai < 2; ++ai) { v4u xv[4][2];
#pragma unroll
            for (int m = 0; m < 4; ++m) { const size_t off = (size_t)(row0 + ai * HALF + m * 16) * DM + col0;
                xv[m][0] = *(const v4u*)(xn + off); xv[m][1] = *(const v4u*)(xn + off + HALF); }
#pragma unroll
            for (int m = 0; m < 4; ++m) { const int ro = ai * HALF + m * 16; const f32x4 tv = t[ro]; const float rg = tv.y, sx = tv.z; const size_t off = (size_t)(row0 + ro) * DM + col0; float q = 0.f;
#pragma unroll
                for (int bj = 0; bj < 2; ++bj) { const v4u xw = xv[m][bj];
                    const f32x4 x0 = {bflo(xw.x), bfhi(xw.x), bflo(xw.y), bfhi(xw.y)}, x1_ = {bflo(xw.z), bfhi(xw.z), bflo(xw.w), bfhi(xw.w)};
                    const f32x4 o0 = x0 * sx + acc[ai][bj][m][0] * rg, o1 = x1_ * sx + acc[ai][bj][m][1] * rg;
                    q += (o0[0] * o0[0] + o0[1] * o0[1]) + (o0[2] * o0[2] + o0[3] * o0[3]) + (o1[0] * o1[0] + o1[1] * o1[1]) + (o1[2] * o1[2] + o1[3] * o1[3]);
                    v4u w; w.x = cvt_pk_bf16(o0[0], o0[1]); w.y = cvt_pk_bf16(o0[2], o0[3]); w.z = cvt_pk_bf16(o1[0], o1[1]); w.w = cvt_pk_bf16(o1[2], o1[3]);
                    *(v4u*)(x1 + off + bj * HALF) = w;
                    v2u w8; w8.x = pk4_fp8(o0[0], o0[1], o0[2], o0[3]); w8.y = pk4_fp8(o1[0], o1[1], o1[2], o1[3]); *(v2u*)(x1f8 + off + bj * HALF) = w8; }
                q += __shfl_xor(q, 16); q += __shfl_xor(q, 32);
                if (fq == 0) ssq1[(size_t)(row0 + ro) * 16 + u.pn * 4 + wc] = q; }
            asm volatile("" ::: "memory"); }
    }
};
struct EpiMoe1 {
    static constexpr bool PERM = true;
    unsigned char* A; const float* b_gu; const LAS float* rss;
    __device__ __forceinline__ void operator()(const f32x4 (&acc)[2][2][4][2], const Unit& u, int wr, int wc, int fr, int fq) const {
        const int row0 = u.pm * 256 + wr * 64 + fr, col = u.pn * 128 + wc * 32 + 8 * fq;
        const float* bg = b_gu + (size_t)u.e * 2 * FF + col; const LAS float* rs_ = rss + u.slot * 256 + wr * 64 + fr;
        float rsv[2][4];
#pragma unroll
        for (int ai = 0; ai < 2; ++ai)
#pragma unroll
            for (int m = 0; m < 4; ++m) rsv[ai][m] = rs_[ai * HALF + m * 16];
        f32x4 bgv[2], blv[2];
#pragma unroll
        for (int n = 0; n < 2; ++n) { bgv[n] = *(const f32x4*)(bg + 4 * n); blv[n] = *(const f32x4*)(bg + FF + 4 * n); }
#pragma unroll
        for (int ai = 0; ai < 2; ++ai)
#pragma unroll
            for (int m = 0; m < 4; ++m) { f32x4 a[2];
#pragma unroll
                for (int n = 0; n < 2; ++n) { const f32x4 g = acc[ai][0][m][n] * rsv[ai][m] + bgv[n], l = acc[ai][1][m][n] * rsv[ai][m] + blv[n];
#pragma unroll
                    for (int p = 0; p < 2; ++p) { f32x2 gc = {fminf(g[2 * p], 7.0f), fminf(g[2 * p + 1], 7.0f)}; f32x2 lc = {fminf(fmaxf(l[2 * p], -7.0f), 7.0f), fminf(fmaxf(l[2 * p + 1], -7.0f), 7.0f)};
                        const f32x2 z = gc * (-1.702f * 1.4426950408889634f); f32x2 e; e.x = __builtin_amdgcn_exp2f(z.x); e.y = __builtin_amdgcn_exp2f(z.y);
                        const f32x2 d = e + 1.0f; f32x2 r; r.x = __builtin_amdgcn_rcpf(d.x); r.y = __builtin_amdgcn_rcpf(d.y);
                        const f32x2 o = (gc * r) * (lc + 1.0f); a[n][2 * p] = o.x; a[n][2 * p + 1] = o.y; } }
                v2u w; w.x = pk4_fp8(a[0][0], a[0][1], a[0][2], a[0][3]); w.y = pk4_fp8(a[1][0], a[1][1], a[1][2], a[1][3]);
                *(v2u*)(A + (size_t)(row0 + ai * HALF + m * 16) * FF + col) = w; }
    }
};
constexpr float Y_SCALE = 16.0f;
struct EpiMoe2 {
    static constexpr bool PERM = true;
    unsigned char* Y; const float* b_dn; const LAS float* gss;
    __device__ __forceinline__ void operator()(const f32x4 (&acc)[2][2][4][2], const Unit& u, int wr, int wc, int fr, int fq) const {
        const int row0 = u.pm * 256 + wr * 64 + fr, col0 = u.pn * 256 + wc * 32 + 8 * fq;
        const LAS float* gs = gss + u.slot * 256 + wr * 64 + fr;
        f32x4 bv[2][2]; float gv[2][4];
#pragma unroll
        for (int bj = 0; bj < 2; ++bj)
#pragma unroll
            for (int n = 0; n < 2; ++n) bv[bj][n] = *(const f32x4*)(b_dn + (size_t)u.e * DM + col0 + bj * HALF + 4 * n);
#pragma unroll
        for (int ai = 0; ai < 2; ++ai)
#pragma unroll
            for (int m = 0; m < 4; ++m) gv[ai][m] = gs[ai * HALF + m * 16] * Y_SCALE;
#pragma unroll
        for (int ai = 0; ai < 2; ++ai)
#pragma unroll
            for (int m = 0; m < 4; ++m) { const float g = gv[ai][m]; unsigned char* rowp = Y + (size_t)(row0 + ai * HALF + m * 16) * DM + col0;
#pragma unroll
                for (int bj = 0; bj < 2; ++bj) { const f32x4 v0 = (acc[ai][bj][m][0] + bv[bj][0]) * g, v1 = (acc[ai][bj][m][1] + bv[bj][1]) * g;
                    v2u w; w.x = pk4_fp8(v0[0], v0[1], v0[2], v0[3]); w.y = pk4_fp8(v1[0], v1[1], v1[2], v1[3]);
                    *(v2u*)(rowp + bj * HALF) = w; } }
    }
};
constexpr float GATE_SCALE = 128.0f;
template <int MODE> struct EpiPle {
    static constexpr bool PERM = true;
    unsigned char* O; float* ssq; const LAS float* rtab; int pm_a;
    __device__ __forceinline__ void operator()(const f32x4 (&acc)[2][2][4][2], const Unit& u, int wr, int wc, int fr, int fq) const {
        const int row0 = u.pm * 256 + wr * 64 + fr, col0 = u.pn * 256 + wc * 32 + 8 * fq;
        float rsv[2][4];
#pragma unroll
        for (int ai = 0; ai < 2; ++ai)
#pragma unroll
            for (int m = 0; m < 4; ++m) rsv[ai][m] = (MODE == 0) ? rtab[(u.pm == pm_a ? 0 : 256) + wr * 64 + fr + ai * HALF + m * 16] : 1.0f;
#pragma unroll
        for (int ai = 0; ai < 2; ++ai)
#pragma unroll
            for (int m = 0; m < 4; ++m) { unsigned char* rowp = O + (size_t)(row0 + ai * HALF + m * 16) * DM + col0; float q = 0.f; const float rs = rsv[ai][m];
#pragma unroll
                for (int bj = 0; bj < 2; ++bj) { f32x4 v0 = acc[ai][bj][m][0], v1 = acc[ai][bj][m][1];
                    if (MODE == 0) {
#pragma unroll
                        for (int j = 0; j < 4; ++j) { v0[j] = GATE_SCALE * sigmoidf_fast(rs * v0[j]); v1[j] = GATE_SCALE * sigmoidf_fast(rs * v1[j]); } }
                    else { q += (v0[0] * v0[0] + v0[1] * v0[1]) + (v0[2] * v0[2] + v0[3] * v0[3]) + (v1[0] * v1[0] + v1[1] * v1[1]) + (v1[2] * v1[2] + v1[3] * v1[3]); }
                    v2u w; w.x = pk4_fp8(v0[0], v0[1], v0[2], v0[3]); w.y = pk4_fp8(v1[0], v1[1], v1[2], v1[3]);
                    *(v2u*)(rowp + bj * HALF) = w; }
                if (MODE == 1) { q += __shfl_xor(q, 16); q += __shfl_xor(q, 32); if (fq == 0) ssq[(size_t)(row0 + ai * HALF + m * 16) * 16 + u.pn * 4 + wc] = q; } }
    }
};

namespace att {
constexpr int QBLK = 32, KVBLK = 64;
constexpr float SCALE = 0.125f, THR = 8.f;
constexpr int SHM_V = KVBLK * HD * 2, SHM_K = SHM_V;
constexpr int NSLOT = 3;
constexpr int LDS_BYTES_ = NSLOT * SHM_V + NSLOT * SHM_K + NWAVES * 64 * 4;
#define ATT_KSWZ(row, colB) ((row) * 128 + ((colB) ^ (((row) & 7) << 4)))
#define ATT_SBAR() __builtin_amdgcn_sched_barrier(0)
__device__ __forceinline__ int crow(int r, int hi) { return (r & 3) + 8 * (r >> 2) + 4 * hi; }
__device__ __forceinline__ void cmask(f32x16& p0, f32x16& p1, int jb, int qrel, int hi) {
    const float NEG = -__builtin_inff(); const int kb = 64 * jb + 4 * hi;
#pragma unroll
    for (int r = 0; r < 16; ++r) { const int kv = kb + (r & 3) + 8 * (r >> 2); if (kv > qrel) p0[r] = NEG; if (kv + 32 > qrel) p1[r] = NEG; }
}
__device__ __forceinline__ void bmask(f32x16& p0, f32x16& p1, bool keep) {
    const float NEG = -__builtin_inff();
    if (!keep) {
#pragma unroll
        for (int r = 0; r < 16; ++r) { p0[r] = NEG; p1[r] = NEG; } }
}
__device__ __forceinline__ void partialSM(f32x16& p0, f32x16& p1, float& m_reg, float& mn, float& alpha, bool keep) {
    float pmax = p0[0];
#pragma unroll
    for (int r = 1; r < 16; ++r) pmax = fmaxf(pmax, p0[r]);
#pragma unroll
    for (int r = 0; r < 16; ++r) pmax = fmaxf(pmax, p1[r]);
    { auto rr = __builtin_amdgcn_permlane32_swap(__float_as_uint(pmax), __float_as_uint(pmax), false, false);
      pmax = fmaxf(__uint_as_float(rr[0]), __uint_as_float(rr[1])); }
    if (!keep) pmax = -__builtin_inff();
    constexpr float C2 = 1.4426950408889634f * SCALE;
    if (__builtin_expect(__all((pmax - m_reg) * SCALE <= THR), 1)) { mn = m_reg; alpha = 1.f; }
    else { mn = fmaxf(m_reg, pmax); alpha = __builtin_amdgcn_exp2f((m_reg - mn) * C2); m_reg = mn; }
    const float mnL = keep ? -mn * C2 : -__builtin_inff(), c2 = keep ? C2 : 0.f;
#pragma unroll
    for (int r = 0; r < 16; ++r) p0[r] = fmaf(p0[r], c2, mnL);
#pragma unroll
    for (int r = 0; r < 16; ++r) p1[r] = fmaf(p1[r], c2, mnL);
#pragma unroll
    for (int r = 0; r < 16; ++r) p0[r] = __builtin_amdgcn_exp2f(p0[r]);
}
__device__ __forceinline__ void finishSM(f32x16& p0, f32x16& p1, float alpha, float& l_reg, bf16x8& pa0, bf16x8& pa1, bf16x8& pa2, bf16x8& pa3) {
#pragma unroll
    for (int r = 0; r < 16; ++r) p1[r] = __builtin_amdgcn_exp2f(p1[r]);
    float ps = 0;
#pragma unroll
    for (int r = 0; r < 16; ++r) ps += p0[r];
#pragma unroll
    for (int r = 0; r < 16; ++r) ps += p1[r];
    { auto rr = __builtin_amdgcn_permlane32_swap(__float_as_uint(ps), __float_as_uint(ps), false, false);
      ps = __uint_as_float(rr[0]) + __uint_as_float(rr[1]); }
    l_reg = l_reg * alpha + ps;
#define ATT_PK4(P, B, OUT) do { unsigned a0 = cvt_pk_bf16(P[B+0], P[B+1]), a1 = cvt_pk_bf16(P[B+2], P[B+3]);             \
        unsigned b0 = cvt_pk_bf16(P[B+4], P[B+5]), b1 = cvt_pk_bf16(P[B+6], P[B+7]);                                       \
        auto r0 = __builtin_amdgcn_permlane32_swap(a0, b0, false, false); auto r1 = __builtin_amdgcn_permlane32_swap(a1, b1, false, false); \
        v4u w = {r0[0], r1[0], r0[1], r1[1]}; OUT = *reinterpret_cast<bf16x8*>(&w); } while (0)
    ATT_PK4(p0, 0, pa0); ATT_PK4(p0, 8, pa1); ATT_PK4(p1, 0, pa2); ATT_PK4(p1, 8, pa3);
#undef ATT_PK4
}
__device__ __forceinline__ void qkt(f32x16& p0, f32x16& p1, const LAS unsigned char* Ks, const bf16x8* qr, int r32, int hi) {
    p0 = f32x16{}; p1 = f32x16{};
#pragma unroll
    for (int d0 = 0; d0 < 4; ++d0) { const int cb = (d0 * 16 + hi * 8) * 2;
        const bf16x8 b0 = *(const LAS bf16x8*)(Ks + ATT_KSWZ(r32, cb));
        const bf16x8 b1 = *(const LAS bf16x8*)(Ks + ATT_KSWZ(32 + r32, cb));
        p0 = __builtin_amdgcn_mfma_f32_32x32x16_bf16(b0, qr[d0], p0, 0, 0, 0);
        p1 = __builtin_amdgcn_mfma_f32_32x32x16_bf16(b1, qr[d0], p1, 0, 0, 0); }
}
__device__ __forceinline__ void pv(f32x16* o, int vb, bf16x8 pa0, bf16x8 pa1, bf16x8 pa2, bf16x8 pa3) {
#pragma unroll
    for (int d0 = 0; d0 < 2; ++d0) { s16x4 lo[4], hi[4];
#pragma unroll
        for (int ks = 0; ks < 4; ++ks) { const int a = vb + d0 * 2048 + (ks >> 1) * 4096 + (ks & 1) * 512;
            asm volatile("ds_read_b64_tr_b16 %0,%1" : "=&v"(lo[ks]) : "v"(a) : "memory");
            asm volatile("ds_read_b64_tr_b16 %0,%1 offset:128" : "=&v"(hi[ks]) : "v"(a) : "memory"); }
        asm volatile("s_waitcnt lgkmcnt(0)" ::: "memory"); ATT_SBAR();
#define ATT_PK(k) (bf16x8){lo[k][0], lo[k][1], lo[k][2], lo[k][3], hi[k][0], hi[k][1], hi[k][2], hi[k][3]}
        o[d0] = __builtin_amdgcn_mfma_f32_32x32x16_bf16(pa0, ATT_PK(0), o[d0], 0, 0, 0);
        o[d0] = __builtin_amdgcn_mfma_f32_32x32x16_bf16(pa1, ATT_PK(1), o[d0], 0, 0, 0);
        o[d0] = __builtin_amdgcn_mfma_f32_32x32x16_bf16(pa2, ATT_PK(2), o[d0], 0, 0, 0);
        o[d0] = __builtin_amdgcn_mfma_f32_32x32x16_bf16(pa3, ATT_PK(3), o[d0], 0, 0, 0);
#undef ATT_PK
    }
}
__device__ __forceinline__ void attn_unit(const Frame& F, int b, int h, int qb, LAS unsigned char* scratch) {
    PHASE_IDS;
    const int tid = TID_, wid = tid >> 6, lane = tid & 63, r32 = lane & 31, hi = lane >> 5;
    const bf16* Qg = wsp<bf16>(F, WS_Q); const bf16* Kg = wsp<bf16>(F, WS_K); const bf16* Vg = wsp<bf16>(F, WS_V);
    const size_t rowbase = (size_t)b * SEQ; const int q0 = qb * MOBA;
    const bf16* Qw = Qg + (rowbase + q0 + wid * QBLK) * AW + h * HD;
    const bf16* Kh = Kg + rowbase * AW + h * HD; const bf16* Vh = Vg + rowbase * AW + h * HD;
    LAS unsigned char* V_lds = scratch; LAS unsigned char* K_lds = scratch + NSLOT * SHM_V;
    LAS float* wsf = (LAS float*)(scratch + NSLOT * SHM_V + NSLOT * SHM_K) + wid * 64; LAS float* li_l = wsf; LAS float* al_l = wsf + 32;
    float m_reg = -1e30f, l_reg = 0.f; f32x16 o[2]; o[0] = f32x16{}; o[1] = f32x16{}; bf16x8 qr[4];
#pragma unroll
    for (int d0 = 0; d0 < 4; ++d0) qr[d0] = *(const bf16x8*)(Qw + (size_t)r32 * AW + d0 * 16 + hi * 8);
    unsigned sel = 0u;
    if (qb <= 3) sel = (1u << qb) - 1u;
    else {
        const float* km = wsp<float>(F, WS_KMEAN) + (size_t)((b * NH + h) * NBLK) * HD + (size_t)(r32 & 7) * HD + hi * 8;
        f32x4 kv[4][2];
#pragma unroll
        for (int d0 = 0; d0 < 4; ++d0) { kv[d0][0] = *(const f32x4*)(km + d0 * 16); kv[d0][1] = *(const f32x4*)(km + d0 * 16 + 4); }
        f32x16 gacc = f32x16{};
#pragma unroll
        for (int d0 = 0; d0 < 4; ++d0) { float f[8] = {kv[d0][0][0], kv[d0][0][1], kv[d0][0][2], kv[d0][0][3], kv[d0][1][0], kv[d0][1][1], kv[d0][1][2], kv[d0][1][3]};
            unsigned hw[4], lw[4];
#pragma unroll
            for (int p = 0; p < 4; ++p) { float a0 = f[2 * p], a1 = f[2 * p + 1]; if (r32 >= 8) { a0 = 0.f; a1 = 0.f; }
                const unsigned h0 = f2bf(a0), h1 = f2bf(a1); hw[p] = h0 | (h1 << 16); lw[p] = pk2(a0 - bf2f((bf16)h0), a1 - bf2f((bf16)h1)); }
            const v4u hv = {hw[0], hw[1], hw[2], hw[3]}, lv = {lw[0], lw[1], lw[2], lw[3]};
            gacc = __builtin_amdgcn_mfma_f32_32x32x16_bf16(__builtin_bit_cast(bf16x8, hv), qr[d0], gacc, 0, 0, 0);
            gacc = __builtin_amdgcn_mfma_f32_32x32x16_bf16(__builtin_bit_cast(bf16x8, lv), qr[d0], gacc, 0, 0, 0); }
        float g[8];
#pragma unroll
        for (int r = 0; r < 4; ++r) { const float mine = gacc[r], other = __shfl_xor(mine, 32); g[r] = hi ? other : mine; g[4 + r] = hi ? mine : other; }
        float b0 = -__builtin_inff(), b1 = b0, b2 = b0; int i0 = 0, i1 = 0, i2 = 0;
#pragma unroll
        for (int j = 0; j < NBLK - 1; ++j) { const float s_ = (j < qb) ? g[j] : -__builtin_inff();
            if (s_ > b0) { b2 = b1; i2 = i1; b1 = b0; i1 = i0; b0 = s_; i0 = j; } else if (s_ > b1) { b2 = b1; i2 = i1; b1 = s_; i1 = j; } else if (s_ > b2) { b2 = s_; i2 = j; } }
        sel = (1u << i0) | (1u << i1) | (1u << i2);
    }
    const int sr = tid >> 3, sc = (tid & 7) * 8;
    const int vst = 2 * ((sr >> 5) * 2048 + (sc >> 4) * 512 + (sr & 31) * 16 + (sc & 8));
    const int vb0 = (int)(size_t)V_lds + (lane & 15) * 8 + ((lane >> 4) & 1) * 1024 + (lane >> 5) * 256;
    bf16x8 st_v, st_k;
#define ATT_SLOAD(k0) do { const size_t rr_ = (size_t)((k0) + sr) * AW + sc; st_v = *(const bf16x8*)(Vh + rr_); st_k = *(const bf16x8*)(Kh + rr_); } while (0)
#define ATT_SWRITE(bf) do { *(LAS bf16x8*)(V_lds + (bf) * SHM_V + vst) = st_v; *(LAS bf16x8*)(K_lds + (bf) * SHM_K + ATT_KSWZ(sr, sc * 2)) = st_k; } while (0)
#define ATT_RESC(a) do { if (__any((a) < 1.f)) { if (hi == 0) al_l[r32] = (a); asm volatile("s_waitcnt lgkmcnt(0)" ::: "memory");      \
        _Pragma("unroll") for (int d_ = 0; d_ < 2; ++d_) _Pragma("unroll") for (int r = 0; r < 16; ++r) o[d_][r] *= al_l[crow(r, hi)]; } } while (0)
    const int NT = (q0 + MOBA) / KVBLK;
    const int qrel = wid * QBLK + r32;
#define ATT_MASK(P0, P1, t) do { const int jb_ = (t) - (NT - 4); if (jb_ >= 0) cmask(P0, P1, jb_, qrel, hi); } while (0)
#define ATT_KEEP(t) ((((t) >= NT - 4) ? 1u : ((sel >> ((t) >> 2)) & 1u)) != 0u)
    f32x16 pA0, pA1, pB0, pB1; float mnA, mnB, alA, alB; bf16x8 pa0, pa1, pa2, pa3;
    int s0 = 0, s1 = 1, s2 = 2;
#define ATT_ROT() do { const int t_ = s0; s0 = s1; s1 = s2; s2 = t_; } while (0)
    ATT_SLOAD(0); asm volatile("s_waitcnt vmcnt(0)" ::: "memory"); ATT_SWRITE(0); ATT_SLOAD(KVBLK);
    s0 = 2; s1 = 0; s2 = 1;
    __syncthreads();
    asm volatile("s_waitcnt vmcnt(0)" ::: "memory"); ATT_SWRITE(s2); ATT_SLOAD(2 * KVBLK);
    qkt(pA0, pA1, K_lds + s1 * SHM_K, qr, r32, hi); ATT_MASK(pA0, pA1, 0); partialSM(pA0, pA1, m_reg, mnA, alA, ATT_KEEP(0));
    ATT_ROT();
    for (int j = 1; j < NT; j += 2) {
        __syncthreads();
        if (j + 1 < NT) { asm volatile("s_waitcnt vmcnt(0)" ::: "memory"); ATT_SWRITE(s2); if (j + 2 < NT) ATT_SLOAD((j + 2) * KVBLK); }
        ATT_SBAR(); qkt(pB0, pB1, K_lds + s1 * SHM_K, qr, r32, hi); ATT_MASK(pB0, pB1, j);
        finishSM(pA0, pA1, alA, l_reg, pa0, pa1, pa2, pa3); ATT_SBAR();
        pv(o, vb0 + s0 * SHM_V, pa0, pa1, pa2, pa3); partialSM(pB0, pB1, m_reg, mnB, alB, ATT_KEEP(j));
        ATT_RESC(alB); ATT_ROT();
        if (j + 1 < NT) {
            __syncthreads();
            if (j + 2 < NT) { asm volatile("s_waitcnt vmcnt(0)" ::: "memory"); ATT_SWRITE(s2); if (j + 3 < NT) ATT_SLOAD((j + 3) * KVBLK); }
            ATT_SBAR(); qkt(pA0, pA1, K_lds + s1 * SHM_K, qr, r32, hi); ATT_MASK(pA0, pA1, j + 1);
            finishSM(pB0, pB1, alB, l_reg, pa0, pa1, pa2, pa3); ATT_SBAR();
            pv(o, vb0 + s0 * SHM_V, pa0, pa1, pa2, pa3); partialSM(pA0, pA1, m_reg, mnA, alA, ATT_KEEP(j + 1));
            ATT_RESC(alA); ATT_ROT();
        }
    }
    finishSM(pB0, pB1, alB, l_reg, pa0, pa1, pa2, pa3); ATT_SBAR();
    pv(o, vb0 + s0 * SHM_V, pa0, pa1, pa2, pa3);
#undef ATT_ROT
    if (hi == 0) li_l[r32] = l_reg; asm volatile("s_waitcnt lgkmcnt(0)" ::: "memory");
    float rli[16];
#pragma unroll
    for (int r = 0; r < 16; ++r) rli[r] = __builtin_amdgcn_rcpf(li_l[crow(r, hi)]);
    bf16* Ow = wsp<bf16>(F, WS_MIX) + (rowbase + q0 + wid * QBLK) * DM + h * HD;
    float* ssqa = wsp<float>(F, WS_SSQA) + (rowbase + q0 + wid * QBLK) * NH + h;
    float qq[16];
#pragma unroll
    for (int r = 0; r < 16; ++r) { const int orow = crow(r, hi); float q2 = 0.f;
#pragma unroll
        for (int d0 = 0; d0 < 2; ++d0) { const float v = o[d0][r] * rli[r]; const float vn = __shfl_xor(v, 1); q2 += v * v;
            if ((r32 & 1) == 0) *(unsigned*)(Ow + (size_t)orow * DM + d0 * 32 + r32) = cvt_pk_bf16(v, vn); }
        qq[r] = q2; }
#pragma unroll
    for (int i = 0; i < 8; ++i) { const bool up = (lane & 16) != 0; const float send = up ? qq[i] : qq[i + 8], keep = up ? qq[i + 8] : qq[i]; qq[i] = keep + __shfl_xor(send, 16); }
#pragma unroll
    for (int i = 0; i < 4; ++i) { const bool up = (lane & 8) != 0; const float send = up ? qq[i] : qq[i + 4], keep = up ? qq[i + 4] : qq[i]; qq[i] = keep + __shfl_xor(send, 8); }
#pragma unroll
    for (int i = 0; i < 2; ++i) { const bool up = (lane & 4) != 0; const float send = up ? qq[i] : qq[i + 2], keep = up ? qq[i + 2] : qq[i]; qq[i] = keep + __shfl_xor(send, 4); }
    { const bool up = (lane & 2) != 0; const float send = up ? qq[0] : qq[1], keep = up ? qq[1] : qq[0]; qq[0] = keep + __shfl_xor(send, 2); }
    qq[0] += __shfl_xor(qq[0], 1);
    if ((lane & 1) == 0) ssqa[(size_t)crow(r32 >> 1, hi) * NH] = qq[0];
    __syncthreads();
#undef ATT_SLOAD
#undef ATT_SWRITE
#undef ATT_RESC
#undef ATT_MASK
#undef ATT_KEEP
}
}

namespace gm {
__device__ __forceinline__ int vt_off(int d, int s) { return d * 256 + ((((s >> 3) ^ (d & 15)) & 15) << 4) + (s & 7) * 2; }
__device__ __forceinline__ void units4(const Frame& F, int v, LAS unsigned char* scratch) {
    PHASE_IDS;
    const int tid = TID_, wid = tid >> 6, lane = tid & 63, fr = lane & 15, fq = lane >> 4;
    const int u = wid >> 1, half = wid & 1, uidx = 4 * v + u, b = uidx >> 6, c = (uidx >> 2) & 15, g = uidx & 3;
    const size_t row0 = (size_t)b * SEQ + c * GC;
    const bf16* VGg = wsp<bf16>(F, WS_VG) + row0 * GW + g * GD; const bf16* Ug = wsp<bf16>(F, WS_U) + row0 * GW + g * GD;
    LAS unsigned char* vt = scratch + u * 32768;
    { const int s_ = half * 64 + lane; const v4u* src = (const v4u*)(VGg + (size_t)s_ * GW); v4u raw[16]; float sum = 0.f, sq = 0.f;
#pragma unroll
      for (int i = 0; i < 16; ++i) raw[i] = src[i];
#pragma unroll
      for (int i = 0; i < 16; ++i) { const unsigned ww[4] = {raw[i].x, raw[i].y, raw[i].z, raw[i].w};
#pragma unroll
          for (int k = 0; k < 4; ++k) { const float a0 = bflo(ww[k]), a1 = bfhi(ww[k]); sum += a0 + a1; sq += a0 * a0 + a1 * a1; } }
      const float mu = sum * (1.f / GD); const float var = fmaxf(sq * (1.f / GD) - mu * mu, 0.f); const float rstd = 1.0f / sqrtf(var + EPS);
      const float* lg = F.ln_g + g * GD; const float* lb = F.ln_b + g * GD;
#pragma unroll
      for (int i = 0; i < 16; ++i) { const unsigned ww[4] = {raw[i].x, raw[i].y, raw[i].z, raw[i].w}; const f32x4 g0 = *(const f32x4*)(lg + 8 * i), g1 = *(const f32x4*)(lg + 8 * i + 4), b0 = *(const f32x4*)(lb + 8 * i), b1 = *(const f32x4*)(lb + 8 * i + 4);
          const float gg[8] = {g0[0], g0[1], g0[2], g0[3], g1[0], g1[1], g1[2], g1[3]}, bb[8] = {b0[0], b0[1], b0[2], b0[3], b1[0], b1[1], b1[2], b1[3]};
#pragma unroll
          for (int k = 0; k < 4; ++k) { const int d = 8 * i + 2 * k;
              *(LAS unsigned short*)(vt + vt_off(d, s_)) = (unsigned short)f2bf((bflo(ww[k]) - mu) * rstd * gg[2 * k] + bb[2 * k]);
              *(LAS unsigned short*)(vt + vt_off(d + 1, s_)) = (unsigned short)f2bf((bfhi(ww[k]) - mu) * rstd * gg[2 * k + 1] + bb[2 * k + 1]); } } }
    __syncthreads();
#pragma unroll 1
    for (int m = 0; m < 4; ++m) {
        const int tb = half * 64 + m * 16, t = tb + fr;
        const float* Wg = F.gws + (size_t)g * GC * GC + (size_t)t * GC;
        const int nks = (tb + 16 + 31) / 32;
        f32x4 w0[4], w1[4];
#pragma unroll
        for (int ks = 0; ks < 4; ++ks) if (ks < nks) { w0[ks] = *(const f32x4*)(Wg + ks * 32 + fq * 8); w1[ks] = *(const f32x4*)(Wg + ks * 32 + fq * 8 + 4); }
        const bf16* Ut = Ug + (size_t)t * GW + 4 * fq; v2u uu[8];
#pragma unroll
        for (int n = 0; n < 8; ++n) uu[n] = *(const v2u*)(Ut + n * 16);
        f32x4 acc[8];
#pragma unroll
        for (int n = 0; n < 8; ++n) acc[n] = (f32x4){0.f, 0.f, 0.f, 0.f};
#pragma unroll
        for (int ks = 0; ks < 4; ++ks) if (ks < nks) { const int s0 = ks * 32 + fq * 8;
            float wv[8] = {w0[ks][0], w0[ks][1], w0[ks][2], w0[ks][3], w1[ks][0], w1[ks][1], w1[ks][2], w1[ks][3]};
#pragma unroll
            for (int j = 0; j < 8; ++j) if (s0 + j > t) wv[j] = 0.f;
            v4u aw; aw.x = pk2(wv[0], wv[1]); aw.y = pk2(wv[2], wv[3]); aw.z = pk2(wv[4], wv[5]); aw.w = pk2(wv[6], wv[7]);
            const bf16x8 wf = *reinterpret_cast<const bf16x8*>(&aw);
#pragma unroll
            for (int n = 0; n < 8; ++n) { const bf16x8 vf = *(const LAS bf16x8*)(vt + vt_off(n * 16 + fr, s0));
                acc[n] = __builtin_amdgcn_mfma_f32_16x16x32_bf16(vf, wf, acc[n], 0, 0, 0); } }
        bf16* Og = wsp<bf16>(F, WS_MIX) + (row0 + t) * DM + AW + g * GD + 4 * fq; float* ssqg = wsp<float>(F, WS_SSQG) + (row0 + t) * GG + g;
        const float bs = F.gbs[g * GC + t]; float q2 = 0.f;
#pragma unroll
        for (int n = 0; n < 8; ++n) { const float o0 = bflo(uu[n].x) * (acc[n][0] + bs), o1 = bfhi(uu[n].x) * (acc[n][1] + bs), o2 = bflo(uu[n].y) * (acc[n][2] + bs), o3 = bfhi(uu[n].y) * (acc[n][3] + bs);
            q2 += (o0 * o0 + o1 * o1) + (o2 * o2 + o3 * o3); v2u w; w.x = cvt_pk_bf16(o0, o1); w.y = cvt_pk_bf16(o2, o3); *(v2u*)(Og + n * 16) = w; }
        q2 += __shfl_xor(q2, 16); q2 += __shfl_xor(q2, 32);
        if (fq == 0) ssqg[0] = q2;
    }
    __syncthreads();
}
}

__device__ __forceinline__ void p2_mixers(const Frame& F) {
    LAS unsigned char* scratch = F.lds + RING_OFF;
    const int v = F.vcu;
    { const int bh = v >> 1, s0 = (v & 1) * 2;
#pragma unroll 1
      for (int i = 0; i < 4; ++i) { const int qq = s0 + (i >> 1); const int qb = (i & 1) ? 7 - qq : qq; att::attn_unit(F, bh / NH, bh % NH, qb, scratch); } }
    if (TPROBE && blockIdx.x == 0 && threadIdx.x == 0) ((unsigned long long*)(F.ctl + CW_TS))[14] = __builtin_amdgcn_s_memrealtime();
    gm::units4(F, v, scratch);
}

__device__ __forceinline__ void p4_router(const Frame& F) {
    PHASE_IDS;
    const int tid = TID_, wid = tid >> 6, lane = tid & 63, tk = lane & 31, hf = lane >> 5;
    LAS unsigned* hist = (LAS unsigned*)(F.lds + XTAB_OFF + 4096);
    LAS unsigned* base = hist + 32;
    LAS unsigned* qctr = hist + 64;
    static_assert(XTAB_OFF + 4096 >= 8 * P0_SCR_WAVE, "router words above the conversion tiles");
    const bf16* RWT = wsp<bf16>(F, WS_RWT); const bf16* x1 = wsp<bf16>(F, WS_X1B); const float* ssq1 = wsp<float>(F, WS_SSQ1);
    unsigned* cntg = (unsigned*)(F.ctl + CW_CNT);
    unsigned* IDX = wsp<unsigned>(F, WS_IDX); float* GSS = wsp<float>(F, WS_GSS); float* RSS = wsp<float>(F, WS_RSS); unsigned* TOKPOS = wsp<unsigned>(F, WS_TOKPOS);
    if (tid < 32) hist[tid] = 0u; if (tid == 0) qctr[0] = 0u;
    __syncthreads();
    const bool active = wid < 4; const int tok = (F.vcu * 4 + (wid & 3)) * 32 + tk;
    int pe[4] = {0, 0, 0, 0}; float pg[4] = {0.f, 0.f, 0.f, 0.f}; unsigned rank[2] = {0u, 0u}; int my_e[2] = {0, 0}; float my_g[2] = {0.f, 0.f}; float rstd = 0.f;
    if (active) {
        { const f32x4* sp = (const f32x4*)(ssq1 + (size_t)tok * 16); const f32x4 a = sp[0], b = sp[1], c = sp[2], d = sp[3];
          const float s_ = ((a[0] + a[1]) + (a[2] + a[3])) + ((b[0] + b[1]) + (b[2] + b[3])) + ((c[0] + c[1]) + (c[2] + c[3])) + ((d[0] + d[1]) + (d[2] + d[3]));
          rstd = 1.0f / sqrtf(s_ * (1.f / DM) + EPS); }
        f32x16 acc = f32x16{};
        { const bf16* xr = x1 + (size_t)tok * DM + 8 * hf; const bf16* wh = RWT + (size_t)tk * DM + 8 * hf; const bf16* wl = wh + NE * DM;
#pragma unroll 8
          for (int s_ = 0; s_ < 64; ++s_) { const bf16x8 xv = *(const bf16x8*)(xr + 16 * s_), a_hi = *(const bf16x8*)(wh + 16 * s_), a_lo = *(const bf16x8*)(wl + 16 * s_);
              acc = __builtin_amdgcn_mfma_f32_32x32x16_bf16(a_hi, xv, acc, 0, 0, 0); acc = __builtin_amdgcn_mfma_f32_32x32x16_bf16(a_lo, xv, acc, 0, 0, 0); } }
        float lv[16];
#pragma unroll
        for (int r = 0; r < 16; ++r) { const int e = (r & 3) + 8 * (r >> 2) + 4 * hf; lv[r] = acc[r] * rstd + F.router_b[e]; }
        float tv[4]; int ti[4]; unsigned used = 0u;
#pragma unroll
        for (int k = 0; k < 4; ++k) { float best = -__builtin_inff(); int br = 0;
#pragma unroll
            for (int r = 0; r < 16; ++r) { const int e = (r & 3) + 8 * (r >> 2) + 4 * hf; const int eb = (br & 3) + 8 * (br >> 2) + 4 * hf;
                const bool better = !((used >> r) & 1u) && (lv[r] > best || (lv[r] == best && e < eb)); if (better) { best = lv[r]; br = r; } }
            used |= 1u << br; tv[k] = best; ti[k] = (br & 3) + 8 * (br >> 2) + 4 * hf; }
        float ov[4]; int oi[4];
#pragma unroll
        for (int k = 0; k < 4; ++k) { ov[k] = __shfl_xor(tv[k], 32); oi[k] = __shfl_xor(ti[k], 32); }
        int ia = 0, ib = 0;
#pragma unroll
        for (int k = 0; k < 4; ++k) {
            float va = tv[0], vb = ov[0]; int ea = ti[0], eb = oi[0];
#pragma unroll
            for (int q = 1; q < 4; ++q) { if (ia == q) { va = tv[q]; ea = ti[q]; } if (ib == q) { vb = ov[q]; eb = oi[q]; } }
            const bool takeA = (va > vb) || (va == vb && ea < eb);
            pg[k] = takeA ? va : vb; pe[k] = takeA ? ea : eb; if (takeA) ++ia; else ++ib; }
        { const float m = pg[0]; float s_ = 0.f;
#pragma unroll
          for (int k = 0; k < 4; ++k) { pg[k] = __builtin_amdgcn_exp2f((pg[k] - m) * 1.4426950408889634f); s_ += pg[k]; }
          const float inv = 1.0f / s_;
#pragma unroll
          for (int k = 0; k < 4; ++k) pg[k] *= inv; }
        { const int m = -hf; my_e[0] = pe[0] ^ ((pe[0] ^ pe[2]) & m); my_e[1] = pe[1] ^ ((pe[1] ^ pe[3]) & m);
          const unsigned g0 = __float_as_uint(pg[0]), g1 = __float_as_uint(pg[1]), g2 = __float_as_uint(pg[2]), g3 = __float_as_uint(pg[3]);
          my_g[0] = __uint_as_float(g0 ^ ((g0 ^ g2) & (unsigned)m)); my_g[1] = __uint_as_float(g1 ^ ((g1 ^ g3) & (unsigned)m)); }
#pragma unroll
        for (int q = 0; q < 2; ++q) rank[q] = atomicAdd((unsigned*)&hist[my_e[q]], 1u);
    }
    { LAS float* scr = (LAS float*)(F.lds + RING_OFF + wid * P0_SCR_WAVE); constexpr int PER_WG = XW_ITEMS / 256; static_assert(XW_ITEMS % 256 == 0, "items per workgroup");
      for (;;) { unsigned i = 0u; if (lane == 0) i = atomicAdd((unsigned*)qctr, 1u); i = (unsigned)__builtin_amdgcn_readfirstlane((int)i);
          if (i >= (unsigned)PER_WG) break;
          xw_convert_item(F, F.vcu * PER_WG + (int)i, scr, lane); } }
    __syncthreads();
    if (tid < 32) base[tid] = atomicAdd(cntg + tid, hist[tid]);
    __syncthreads();
    if (active) {
#pragma unroll
        for (int q = 0; q < 2; ++q) { const int k = 2 * hf + q; const int e = my_e[q]; const float g = my_g[q];
            const unsigned slot = base[e] + rank[q];
            IDX[(size_t)e * T + slot] = (unsigned)tok; GSS[(size_t)e * T + slot] = g; RSS[(size_t)e * T + slot] = rstd; TOKPOS[(size_t)tok * 4 + k] = ((unsigned)e << 16) | slot; }
    }
    __syncthreads();
}

__device__ __forceinline__ void build_tstart(const Frame& F, LAS unsigned* tstart, int tid) {
    if (tid < 64) { const unsigned* cntg = (const unsigned*)(F.ctl + CW_CNT); unsigned c = (tid < NE) ? cntg[tid] : 0u; if (c > (unsigned)T) c = (unsigned)T;
        unsigned x = (c + 255u) >> 8;
#pragma unroll
        for (int o = 1; o < 32; o <<= 1) { const unsigned y = __shfl_up(x, o); if ((tid & 63) >= o) x += y; }
        if (tid < NE) tstart[tid + 1] = x; if (tid == 0) tstart[0] = 0u; }
}
constexpr int MAXU = 17;
constexpr int XT_TSTART = 0, XT_ULIST = 256, XT_RS = 512, XT_GTAB = XT_RS + MAXU * 1024;
static_assert(XT_GTAB + MAXU * 512 <= LDSCTL_OFF - XTAB_OFF, "xtab");
__device__ __forceinline__ int moe_build_tables(const Frame& F, int P  , int mode) {
    PHASE_IDS;
    LAS unsigned* tstart = (LAS unsigned*)(F.lds + XTAB_OFF + XT_TSTART);
    LAS unsigned* ulist = (LAS unsigned*)(F.lds + XTAB_OFF + XT_ULIST);
    LAS float* rs = (LAS float*)(F.lds + XTAB_OFF + XT_RS);
    LAS unsigned short* gtab = (LAS unsigned short*)(F.lds + XTAB_OFF + XT_GTAB);
    const unsigned* cntg = (const unsigned*)(F.ctl + CW_CNT); const unsigned* IDX = wsp<unsigned>(F, WS_IDX);
    const float* RSRC = mode == 1 ? wsp<float>(F, WS_RSS) : wsp<float>(F, WS_GSS);
    const int tid = TID_;
    build_tstart(F, tstart, tid);
    __syncthreads();
    const int NT_ = (int)tstart[NE], U = NT_ * P, G = F.G, c = (int)blockIdx.x;
    int nunits = (c < U) ? (U - c + G - 1) / G : 0; if (nunits > MAXU) nunits = MAXU;
    if (tid < nunits) { const int L = tid * G + c; int gt, pn; pg8::flat_to_tile(L, U, NT_, P, gt, pn);
        int e = 0; for (int k = 1; k < NE; ++k) if ((unsigned)gt >= tstart[k]) e = k;
        const int rt = gt - (int)tstart[e];
        ulist[tid] = (unsigned)gt | ((unsigned)pn << 10) | ((unsigned)e << 13) | ((unsigned)rt << 18); }
    __syncthreads();
    {
        constexpr int NP = (MAXU + 1) / 2; unsigned tokv[NP]; float rsv[NP];
#pragma unroll
        for (int p = 0; p < NP; ++p) { const int i = 2 * p + (tid >> 8), r = tid & 255; tokv[p] = 0u; rsv[p] = 0.f;
            if (i < nunits) { const unsigned w = ulist[i]; const int e = (int)((w >> 13) & 0x1fu), rt = (int)(w >> 18);
                unsigned cn = cntg[e]; if (cn > (unsigned)T) cn = (unsigned)T; const unsigned slot = (unsigned)rt * 256u + (unsigned)r;
                if (slot < cn) { if (mode == 1) tokv[p] = IDX[(size_t)e * T + slot]; rsv[p] = RSRC[(size_t)e * T + slot]; } } }
#pragma unroll
        for (int p = 0; p < NP; ++p) { const int i = 2 * p + (tid >> 8), r = tid & 255;
            if (i < nunits) { unsigned tok = tokv[p]; if (tok >= (unsigned)T) tok = 0u; if (mode == 1) gtab[i * 256 + r] = (unsigned short)tok; rs[i * 256 + r] = rsv[p]; } }
    }
    __syncthreads();
    return nunits;
}

__device__ __forceinline__ void p7_combine(const Frame& F) {
    PHASE_IDS;
    LAS unsigned* tstart = (LAS unsigned*)(F.lds + XTAB_OFF + XT_TSTART);
    const unsigned* cntg = (const unsigned*)(F.ctl + CW_CNT);
    build_tstart(F, tstart, TID_); (void)cntg;
    __syncthreads();
    const int gw = F.vcu * NWAVES + WAVE_, NGW = F.G * NWAVES;
    const unsigned* TOKPOS = wsp<unsigned>(F, WS_TOKPOS); const unsigned char* Y = wsp<unsigned char>(F, WS_YBUF); const bf16* X1 = wsp<bf16>(F, WS_X1B); bf16* X2 = wsp<bf16>(F, WS_X2B); unsigned char* X28 = wsp<unsigned char>(F, WS_X2F8); float* RS2 = wsp<float>(F, WS_RSTD2);
    for (int m0 = gw; m0 < T; m0 += 2 * NGW) {
        f32x4 v[2][4]; unsigned yv[2][4][4]; float s[2] = {0.f, 0.f};
#pragma unroll
        for (int r = 0; r < 2; ++r) { const int m = m0 + r * NGW;
            const v4u tp = *(const v4u*)(TOKPOS + (size_t)m * 4); const unsigned tpw[4] = {tp.x, tp.y, tp.z, tp.w};
            size_t yrow[4];
#pragma unroll
            for (int k = 0; k < 4; ++k) { const unsigned e = (tpw[k] >> 16) & 31u, slot = tpw[k] & 0xffffu; yrow[k] = ((size_t)tstart[e] * 256u + slot) * DM; }
#pragma unroll
            for (int j = 0; j < 4; ++j) { const v2u xw = *(const v2u*)(X1 + (size_t)m * DM + 4 * LANE_ + 256 * j); v[r][j] = (f32x4){bflo(xw.x), bfhi(xw.x), bflo(xw.y), bfhi(xw.y)};
#pragma unroll
                for (int k = 0; k < 4; ++k) yv[r][j][k] = *(const unsigned*)(Y + yrow[k] + 4 * LANE_ + 256 * j); } }
#pragma unroll
        for (int r = 0; r < 2; ++r) {
#pragma unroll
            for (int j = 0; j < 4; ++j) {
#pragma unroll
                for (int k = 0; k < 4; ++k) { const unsigned w = yv[r][j][k]; const f32x2 lo = __builtin_amdgcn_cvt_pk_f32_fp8((int)w, false), hi2 = __builtin_amdgcn_cvt_pk_f32_fp8((int)w, true);
                    v[r][j][0] += lo[0] * (1.0f / Y_SCALE); v[r][j][1] += lo[1] * (1.0f / Y_SCALE); v[r][j][2] += hi2[0] * (1.0f / Y_SCALE); v[r][j][3] += hi2[1] * (1.0f / Y_SCALE); }
                s[r] += (v[r][j].x * v[r][j].x + v[r][j].y * v[r][j].y) + (v[r][j].z * v[r][j].z + v[r][j].w * v[r][j].w); } }
#pragma unroll
        for (int r = 0; r < 2; ++r) { const int m = m0 + r * NGW; const float rstd = 1.0f / sqrtf(wave_sum(s[r]) * (1.f / DM) + EPS);
            if (LANE_ == 0) RS2[m] = rstd;
#pragma unroll
            for (int j = 0; j < 4; ++j) { v2u w; w.x = cvt_pk_bf16(v[r][j].x, v[r][j].y); w.y = cvt_pk_bf16(v[r][j].z, v[r][j].w); *(v2u*)(X2 + (size_t)m * DM + 4 * LANE_ + 256 * j) = w;
                *(unsigned*)(X28 + (size_t)m * DM + 4 * LANE_ + 256 * j) = pk4_fp8(v[r][j].x, v[r][j].y, v[r][j].z, v[r][j].w); } }
    }
}

__device__ __forceinline__ void p9_final(const Frame& F) {
    PHASE_IDS;
    const int gw = F.vcu * NWAVES + WAVE_, NGW = F.G * NWAVES;
    const unsigned char* GATE = wsp<unsigned char>(F, WS_GATE); const unsigned char* PP = wsp<unsigned char>(F, WS_PP); const float* ssqpp = wsp<float>(F, WS_SSQPP);
    for (int m0 = gw; m0 < T; m0 += 2 * NGW) {
        f32x4 v[2][4]; unsigned gv[2][4], pv_[2][4]; f32x4 sq[2][4]; float s[2] = {0.f, 0.f};
#pragma unroll
        for (int r = 0; r < 2; ++r) { const int m = m0 + r * NGW; const bf16* x2r = wsp<bf16>(F, WS_X2B) + (size_t)m * DM;
#pragma unroll
            for (int q = 0; q < 4; ++q) sq[r][q] = *(const f32x4*)(ssqpp + (size_t)m * 16 + 4 * q);
#pragma unroll
            for (int j = 0; j < 4; ++j) { const int col = 4 * LANE_ + 256 * j; const v2u xw = *(const v2u*)(x2r + col); v[r][j] = (f32x4){bflo(xw.x), bfhi(xw.x), bflo(xw.y), bfhi(xw.y)};
                gv[r][j] = *(const unsigned*)(GATE + (size_t)m * DM + col); pv_[r][j] = *(const unsigned*)(PP + (size_t)m * DM + col); } }
#pragma unroll
        for (int r = 0; r < 2; ++r) { const f32x4 a = sq[r][0], b = sq[r][1], c = sq[r][2], d = sq[r][3];
            const float sp = ((a[0] + a[1]) + (a[2] + a[3])) + ((b[0] + b[1]) + (b[2] + b[3])) + ((c[0] + c[1]) + (c[2] + c[3])) + ((d[0] + d[1]) + (d[2] + d[3]));
            const float rpp = 1.0f / sqrtf(sp * (1.f / DM) + EPS);
#pragma unroll
            for (int j = 0; j < 4; ++j) { const int col = 4 * LANE_ + 256 * j; const f32x4 pg_ = *(const f32x4*)(F.ppn + col);
                const f32x2 g01 = __builtin_amdgcn_cvt_pk_f32_fp8((int)gv[r][j], false), g23 = __builtin_amdgcn_cvt_pk_f32_fp8((int)gv[r][j], true);
                const f32x2 p01 = __builtin_amdgcn_cvt_pk_f32_fp8((int)pv_[r][j], false), p23 = __builtin_amdgcn_cvt_pk_f32_fp8((int)pv_[r][j], true);
                const float rg = rpp * (1.0f / GATE_SCALE);
                v[r][j][0] += g01[0] * (p01[0] * rg * pg_[0]); v[r][j][1] += g01[1] * (p01[1] * rg * pg_[1]);
                v[r][j][2] += g23[0] * (p23[0] * rg * pg_[2]); v[r][j][3] += g23[1] * (p23[1] * rg * pg_[3]);
                s[r] += (v[r][j].x * v[r][j].x + v[r][j].y * v[r][j].y) + (v[r][j].z * v[r][j].z + v[r][j].w * v[r][j].w); } }
#pragma unroll
        for (int r = 0; r < 2; ++r) { const int m = m0 + r * NGW; float* xr = F.out + (size_t)m * DM; const float rstd = 1.0f / sqrtf(wave_sum(s[r]) * (1.f / DM) + EPS);
#pragma unroll
            for (int j = 0; j < 4; ++j) { const int col = 4 * LANE_ + 256 * j; const f32x4 fg = *(const f32x4*)(F.final_norm + col); __builtin_nontemporal_store(v[r][j] * rstd * fg, (f32x4*)(xr + col)); } }
    }
}

struct Args { const float* in[23]; float* out; unsigned char* ws; };
#if CHECK_STAGE
__device__ __forceinline__ unsigned hmix(unsigned z) { z ^= z >> 16; z *= 0x7feb352du; z ^= z >> 15; z *= 0x846ca68bu; z ^= z >> 16; return z; }
__device__ __forceinline__ void chk_add(const Frame& F, int st, bool bad) { atomicAdd((unsigned*)(F.ctl + CW_CHK + 2 * st), bad ? 1u : 0u); atomicAdd((unsigned*)(F.ctl + CW_CHK + 2 * st + 1), 1u); }
__device__ __forceinline__ bool offby(float got, float ex, float rel, float ab) { const float d = fabsf(got - ex); return !(d <= rel * fabsf(ex) + ab); }
__device__ __forceinline__ float dot_bf(const bf16* a, const bf16* b, int n) { float s = 0.f; for (int k = 0; k < n; ++k) s += bf2f(a[k]) * bf2f(b[k]); return s; }
__device__ __forceinline__ float gelu_ref(float v) { return 0.5f * v * (1.0f + erff(v * 0.70710678f)); }
__device__ __forceinline__ unsigned chk_tstart(const Frame& F, unsigned ex) { const unsigned* cntg = (const unsigned*)(F.ctl + CW_CNT); unsigned s_ = 0; for (unsigned e = 0; e < ex; ++e) { unsigned c = cntg[e]; if (c > (unsigned)T) c = T; s_ += (c + 255u) >> 8; } return s_; }
template <int ST> __device__ __forceinline__ void stage_check(const Frame& F) {
    const unsigned gt = (unsigned)blockIdx.x * NTHR + threadIdx.x;
    const unsigned h0 = hmix(gt * 2654435761u + ST * 40503u), h1 = hmix(h0 + 0x9e3779b9u), h2 = hmix(h1 + 0x85ebca6bu);
    if (ST == 1) {
        if (gt >= 16384) return;
        const int which = gt & 7;
        if (which == 0) { const int e = h0 % NE, n = h1 % (2 * FF), k = h2 % DM; const int lc = CmWgu()(n);
            const float ex = bf2f((bf16)f2bf(F.w_gu[((size_t)e * DM + k) * 2 * FF + lc] * F.ffn_norm[k])); chk_add(F, ST, offby(bf2f(wsp<bf16>(F, WS_WGU)[((size_t)e * 2 * FF + n) * DM + k]), ex, 1e-6f, 1e-30f)); }
        else if (which == 1) { const int e = h0 % NE, n = h1 % DM, k = h2 % FF;
            const float ex = bf2f((bf16)f2bf(F.w_dn[((size_t)e * FF + k) * DM + n])); chk_add(F, ST, offby(bf2f(wsp<bf16>(F, WS_WDN)[((size_t)e * DM + n) * FF + k]), ex, 1e-6f, 1e-30f)); }
        else if (which == 2) { const int n = h1 % NPROJ, k = h2 % DM; const int lc = CmWin()(n);
            const float ex = bf2f((bf16)f2bf(F.w_in[(size_t)k * NPROJ + lc] * F.mix_norm[k])); chk_add(F, ST, offby(bf2f(wsp<bf16>(F, WS_WIN)[(size_t)n * DM + k]), ex, 1e-6f, 1e-30f)); }
        else if (which == 3) { const int n = h1 % DM, k = h2 % DM; const float g = k < AW ? F.aon[k] : F.gon[k - AW];
            const float ex = bf2f((bf16)f2bf(F.w_out[(size_t)k * DM + n] * g)); chk_add(F, ST, offby(bf2f(wsp<bf16>(F, WS_WOUT)[(size_t)n * DM + k]), ex, 1e-6f, 1e-30f)); }
        else if (which == 4) { const int n = h1 % DM, k = h2 % DM;
            const float ex = bf2f((bf16)f2bf(F.w_pg[(size_t)k * DM + n] * F.ple_norm[k])); chk_add(F, ST, offby(bf2f(wsp<bf16>(F, WS_WPG)[(size_t)n * DM + k]), ex, 1e-6f, 1e-30f)); }
        else if (which == 5) { const int n = h1 % DM, k = h2 % PLE;
            const float ex = bf2f((bf16)f2bf(F.w_pp[(size_t)k * DM + n])); chk_add(F, ST, offby(bf2f(wsp<bf16>(F, WS_WPP)[(size_t)n * PLE + k]), ex, 1e-6f, 1e-30f)); }
        else if (which == 6) { const int row = h0 % T, k = h1 % DM; float ss = 0.f; for (int j = 0; j < DM; ++j) { const float v = F.x[(size_t)row * DM + j]; ss += v * v; }
            const float ex = F.x[(size_t)row * DM + k] / sqrtf(ss / DM + EPS); chk_add(F, ST, offby(bf2f(wsp<bf16>(F, WS_XNB)[(size_t)row * DM + k]), ex, 0.01f, 1e-3f)); }
        else { const int row = h0 % T, k = h1 % PLE; chk_add(F, ST, offby(bf2f(wsp<bf16>(F, WS_PB)[(size_t)row * PLE + k]), F.p[(size_t)row * PLE + k], 0.005f, 1e-6f)); }
    }
    if (ST == 2) {
        if (gt >= 16384) return;
        const bf16* XN = wsp<bf16>(F, WS_XNB); const bf16* WIN = wsp<bf16>(F, WS_WIN);
        if ((gt & 7) == 7) {
            const int b = h0 % BATCH, hh = h1 % NH, blk = h2 % NBLK, c = (h2 >> 8) % HD; float s_ = 0.f;
            for (int r = 0; r < 256; ++r) s_ += bf2f(wsp<bf16>(F, WS_K)[((size_t)b * SEQ + blk * 256 + r) * AW + hh * HD + c]);
            chk_add(F, ST, offby(wsp<float>(F, WS_KMEAN)[((size_t)(b * NH + hh) * NBLK + blk) * HD + c], s_, 0.02f, 0.3f)); return; }
        const int row = h0 % T, type = h1 % 5, c = h2 % AW; const bf16* xr = XN + (size_t)row * DM;
        const float v = dot_bf(xr, WIN + (size_t)(type * AW + c) * DM, DM); float ex;
        if (type <= 1) { const float vp = dot_bf(xr, WIN + (size_t)(type * AW + (c ^ 4)) * DM, DM); const int i = 4 * ((c & 63) >> 3) + (c & 3), pos = row & (SEQ - 1);
            const float cs = wsp<float>(F, WS_ROPE)[pos * 32 + i], sn = wsp<float>(F, WS_ROPE)[SEQ * 32 + pos * 32 + i];
            { const float inv = powf(10000.0f, -(float)i / 32.0f); const float ang = (float)pos * inv; if (offby(cs, cosf(ang), 0.f, 1e-3f) || offby(sn, sinf(ang), 0.f, 1e-3f)) { chk_add(F, ST, true); return; } }
            ex = (c & 4) ? v * cs + vp * sn : v * cs - vp * sn; }
        else if (type == 2) ex = v; else ex = gelu_ref(v);
        chk_add(F, ST, offby(bf2f(wsp<bf16>(F, WS_Q)[(size_t)type * (16u << 20) + (size_t)row * AW + c]), ex, 0.02f, 0.02f));
    }
    if (ST == 3) {
        if (gt >= 8192) return;
        if (gt & 1) {
            const int row = h0 % T, g = h1 % GG, d = h2 % GD; const int b = row / SEQ, s_ = row % SEQ, c = s_ / GC, t = s_ % GC; float acc = 0.f;
            for (int sp = 0; sp <= t; ++sp) { const bf16* vr = wsp<bf16>(F, WS_VG) + ((size_t)b * SEQ + c * GC + sp) * GW + g * GD; float mu = 0.f; for (int j = 0; j < GD; ++j) mu += bf2f(vr[j]); mu /= GD;
                float var = 0.f; for (int j = 0; j < GD; ++j) { const float dd = bf2f(vr[j]) - mu; var += dd * dd; } const float rstd = 1.0f / sqrtf(var / GD + EPS);
                const float vn = bf2f((bf16)f2bf((bf2f(vr[d]) - mu) * rstd * F.ln_g[g * GD + d] + F.ln_b[g * GD + d])); acc += bf2f((bf16)f2bf(F.gws[((size_t)g * GC + t) * GC + sp])) * vn; }
            const float ex = bf2f(wsp<bf16>(F, WS_U)[(size_t)row * GW + g * GD + d]) * (acc + F.gbs[g * GC + t]);
            chk_add(F, ST, offby(bf2f(wsp<bf16>(F, WS_MIX)[(size_t)row * DM + AW + g * GD + d]), ex, 0.03f, 0.02f)); return; }
        const int row = h0 % T, hh = h1 % NH; const int b = row / SEQ, s_ = row % SEQ, qb = s_ / MOBA; float q[HD];
#pragma unroll
        for (int c = 0; c < HD; ++c) q[c] = bf2f(wsp<bf16>(F, WS_Q)[(size_t)row * AW + hh * HD + c]);
        unsigned sel = 0u;
        if (qb <= 3) sel = (1u << qb) - 1u;
        else { float b0 = -__builtin_inff(), b1 = b0, b2 = b0; int i0 = 0, i1 = 0, i2 = 0;
            for (int j = 0; j < qb; ++j) { const float* km = wsp<float>(F, WS_KMEAN) + ((size_t)(b * NH + hh) * NBLK + j) * HD; float g = 0.f;
#pragma unroll
                for (int c = 0; c < HD; ++c) g += q[c] * km[c];
                if (g > b0) { b2 = b1; i2 = i1; b1 = b0; i1 = i0; b0 = g; i0 = j; } else if (g > b1) { b2 = b1; i2 = i1; b1 = g; i1 = j; } else if (g > b2) { b2 = g; i2 = j; } }
            sel = (1u << i0) | (1u << i1) | (1u << i2); }
        float mx = -__builtin_inff();
        for (int kp = 0; kp <= s_; ++kp) { const int blk = kp / MOBA; if (blk != qb && !((sel >> blk) & 1u)) continue; const bf16* kr = wsp<bf16>(F, WS_K) + ((size_t)b * SEQ + kp) * AW + hh * HD; float sc = 0.f;
#pragma unroll
            for (int c = 0; c < HD; ++c) sc += q[c] * bf2f(kr[c]);
            mx = fmaxf(mx, sc * 0.125f); }
        float o[HD]; float l = 0.f;
#pragma unroll
        for (int c = 0; c < HD; ++c) o[c] = 0.f;
        for (int kp = 0; kp <= s_; ++kp) { const int blk = kp / MOBA; if (blk != qb && !((sel >> blk) & 1u)) continue; const bf16* kr = wsp<bf16>(F, WS_K) + ((size_t)b * SEQ + kp) * AW + hh * HD; float sc = 0.f;
#pragma unroll
            for (int c = 0; c < HD; ++c) sc += q[c] * bf2f(kr[c]);
            const float pr = expf(sc * 0.125f - mx); l += pr; const bf16* vr = wsp<bf16>(F, WS_V) + ((size_t)b * SEQ + kp) * AW + hh * HD;
#pragma unroll
            for (int c = 0; c < HD; ++c) o[c] += pr * bf2f(vr[c]); }
        bool bad = false; float ss = 0.f;
#pragma unroll
        for (int c = 0; c < HD; ++c) { const float ex = o[c] / l; ss += ex * ex; bad |= offby(bf2f(wsp<bf16>(F, WS_MIX)[(size_t)row * DM + hh * HD + c]), ex, 0.04f, 0.02f); }
        bad |= offby(wsp<float>(F, WS_SSQA)[(size_t)row * NH + hh], ss, 0.03f, 1e-3f);
        chk_add(F, ST, bad);
    }
    if (ST == 4) {
        if (gt >= 16384) return;
        const int row = h0 % T, col = h1 % DM; const bf16* mr = wsp<bf16>(F, WS_MIX) + (size_t)row * DM; const bf16* wr_ = wsp<bf16>(F, WS_WOUT) + (size_t)col * DM;
        float sa = 0.f, sg = 0.f, da = 0.f, dg = 0.f;
        for (int k = 0; k < AW; ++k) { const float a = bf2f(mr[k]), g = bf2f(mr[AW + k]); sa += a * a; sg += g * g; da += a * bf2f(wr_[k]); dg += g * bf2f(wr_[AW + k]); }
        const float ex = F.x[(size_t)row * DM + col] + da / sqrtf(sa / AW + EPS) + dg / sqrtf(sg / GW + EPS);
        chk_add(F, ST, offby(F.out[(size_t)row * DM + col], ex, 0.01f, 0.03f));
    }
    if (ST == 5) {
        if (gt >= 8192) return;
        const int tok = h0 % T; const float* xr = F.out + (size_t)tok * DM; float ss = 0.f; for (int k = 0; k < DM; ++k) ss += xr[k] * xr[k]; const float rstd = 1.0f / sqrtf(ss / DM + EPS);
        bool bad = false;
        for (int j = 0; j < 4; ++j) { const int k = (h1 >> (8 * j)) % DM; bad |= offby(bf2f(wsp<bf16>(F, WS_XNB)[(size_t)tok * DM + k]), xr[k] * rstd, 0.01f, 1e-3f); }
        float lg[NE];
#pragma unroll
        for (int e = 0; e < NE; ++e) lg[e] = 0.f;
        for (int k = 0; k < DM; ++k) { const float xv = xr[k] * rstd * F.ffn_norm[k];
#pragma unroll
            for (int e = 0; e < NE; ++e) lg[e] += xv * F.router_w[k * NE + e]; }
#pragma unroll
        for (int e = 0; e < NE; ++e) lg[e] += F.router_b[e];
        int te[4]; float tv[4]; unsigned used = 0u;
#pragma unroll
        for (int k = 0; k < 4; ++k) { float best = -__builtin_inff(); int bi = 0;
#pragma unroll
            for (int e = 0; e < NE; ++e) if (!((used >> e) & 1u) && lg[e] > best) { best = lg[e]; bi = e; }
            used |= 1u << bi; te[k] = bi; tv[k] = best; }
        { float gg[4]; float den = 0.f;
#pragma unroll
          for (int k = 0; k < 4; ++k) { float v = -__builtin_inff();
#pragma unroll
              for (int e = 0; e < NE; ++e) if (e == te[k]) v = lg[e];
              gg[k] = v; }
          const float mm = gg[0];
#pragma unroll
          for (int k = 0; k < 4; ++k) { gg[k] = expf(gg[k] - mm); den += gg[k]; }
          const unsigned* tp = wsp<unsigned>(F, WS_TOKPOS) + (size_t)tok * 4;
#pragma unroll
          for (int k = 0; k < 4; ++k) { const unsigned e = tp[k] >> 16, slot = tp[k] & 0xffffu; bad |= (e != (unsigned)te[k]);
              if (e < NE && slot < (unsigned)T) { bad |= wsp<unsigned>(F, WS_IDX)[(size_t)e * T + slot] != (unsigned)tok; bad |= offby(wsp<float>(F, WS_GSS)[(size_t)e * T + slot], gg[k] / den, 2e-3f, 1e-5f);
                  bad |= slot >= ((const unsigned*)(F.ctl + CW_CNT))[e]; } else bad = true; } }
        (void)tv;
        chk_add(F, ST, bad);
    }
    if (ST == 6 || ST == 7) {
        if (gt >= 16384) return;
        const int tok = h0 % T, k = h1 & 3, col = (h1 >> 2) % FF; const unsigned tp = wsp<unsigned>(F, WS_TOKPOS)[(size_t)tok * 4 + k]; const unsigned e = tp >> 16, slot = tp & 0xffffu;
        if (e >= NE) { chk_add(F, ST, true); return; }
        const unsigned tse = chk_tstart(F, e);
        const size_t row = (size_t)tse * 256 + slot;
        if (ST == 6) { const bf16* xr = wsp<bf16>(F, WS_XNB) + (size_t)tok * DM; const int np = (col >> 7) * 256 + (col & 127);
            const float g = dot_bf(xr, wsp<bf16>(F, WS_WGU) + ((size_t)e * 2 * FF + np) * DM, DM) + F.b_gu[(size_t)e * 2 * FF + col];
            const float l = dot_bf(xr, wsp<bf16>(F, WS_WGU) + ((size_t)e * 2 * FF + np + 128) * DM, DM) + F.b_gu[(size_t)e * 2 * FF + FF + col];
            const float gc = fminf(g, 7.f), lc = fminf(fmaxf(l, -7.f), 7.f); const float ex = gc / (1.0f + expf(-1.702f * gc)) * (lc + 1.0f);
            chk_add(F, ST, offby(bf2f(wsp<bf16>(F, WS_ABUF)[row * FF + col]), ex, 0.03f, 0.03f)); }
        else { const float d = dot_bf(wsp<bf16>(F, WS_ABUF) + row * FF, wsp<bf16>(F, WS_WDN) + ((size_t)e * DM + col) * FF, FF) + F.b_dn[(size_t)e * DM + col];
            const float ex = d * wsp<float>(F, WS_GSS)[(size_t)e * T + slot];
            chk_add(F, ST, offby(bf2f(wsp<bf16>(F, WS_YBUF)[row * DM + col]), ex, 0.03f, 0.01f)); }
    }
    if (ST == 8) {
        if (gt >= 8192) return;
        const int tok = h0 % T; const float* xr = F.out + (size_t)tok * DM; float ss = 0.f; for (int k = 0; k < DM; ++k) ss += xr[k] * xr[k]; const float rstd = 1.0f / sqrtf(ss / DM + EPS);
        bool bad = false; for (int k = 0; k < DM; ++k) { bad |= offby(bf2f(wsp<bf16>(F, WS_X2N)[(size_t)tok * DM + k]), xr[k] * rstd, 0.01f, 1e-3f); bad |= !(fabsf(xr[k]) < 30.f); }
        chk_add(F, ST, bad);
    }
    if (ST == 9) {
        if (gt >= 16384) return;
        const int row = h0 % T, col = h1 % DM;
        if (gt & 1) { const float d = dot_bf(wsp<bf16>(F, WS_X2N) + (size_t)row * DM, wsp<bf16>(F, WS_WPG) + (size_t)col * DM, DM); const float got = bf2f(wsp<bf16>(F, WS_GATE)[(size_t)row * DM + col]); const float ex = 1.0f / (1.0f + expf(-d)); const bool bad = offby(got, ex, 0.02f, 0.01f); chk_add(F, ST, bad);
            if (bad) { atomicOr((unsigned*)(F.ctl + CW_CHK + 40), 1u << ((col >> 3) & 31)); atomicOr((unsigned*)(F.ctl + CW_CHK + 41), 1u << ((row >> 3) & 31)); atomicOr((unsigned*)(F.ctl + CW_CHK + 42), 1u << (col & 7)); atomicOr((unsigned*)(F.ctl + CW_CHK + 43), 1u << (row & 7));
                if (!(got >= 0.f && got <= 1.f)) atomicAdd((unsigned*)(F.ctl + CW_CHK + 44), 1u); { int cl = (int)floorf(log2f(fabsf(got) + 1e-30f)) + 40; cl = cl < 0 ? 0 : (cl > 80 ? 80 : cl); atomicMax((unsigned*)(F.ctl + CW_CHK + 46), (unsigned)cl); atomicMin((unsigned*)(F.ctl + CW_CHK + 47), 0xffffffffu - (unsigned)cl); if (got < 0.f) atomicAdd((unsigned*)(F.ctl + CW_CHK + 48), 1u); } if (fabsf(got - ex) > 0.2f) atomicAdd((unsigned*)(F.ctl + CW_CHK + 45), 1u); } }
        else { const float d = dot_bf(wsp<bf16>(F, WS_PB) + (size_t)row * PLE, wsp<bf16>(F, WS_WPP) + (size_t)col * PLE, PLE); chk_add(F, 10, offby(bf2f(wsp<bf16>(F, WS_PP)[(size_t)row * DM + col]), d, 0.02f, 0.02f)); }
    }
}
__device__ __forceinline__ void check_report(const Frame& F) {
    float c2 = 3.0f;
    for (int st = 1; st <= 10; ++st) { const unsigned bad = F.ctl[CW_CHK + 2 * st], tot = F.ctl[CW_CHK + 2 * st + 1]; const float fr = tot ? (float)bad / (float)tot : 1.0f;
        (void)fr; if (((CHECK_SKIP >> st) & 1) == 0 && bad >= 1u) { c2 = powf(10.0f, (float)st) * (1.0f + fminf((float)bad, 80.0f) * 0.1f); break; } }
#if CHECK_REPORT >= 40
    { unsigned v = F.ctl[CW_CHK + CHECK_REPORT]; if (CHECK_REPORT == 47) v = 0xffffffffu - v; c2 = powf(10.0f, (float)(v >> 27)) * (1.0f + (float)((v >> 21) & 63u) * 0.1f);
#if CHECK_REPORT2
      c2 = powf(10.0f, (float)((v >> 16) & 31u)) * (1.0f + (float)((v >> 10) & 63u) * 0.1f);
#endif
#if CHECK_REPORT3
      c2 = powf(10.0f, (float)((v >> 5) & 31u)) * (1.0f + (float)(v & 31u) * 0.1f);
#endif
      if (CHECK_REPORT >= 46 && CHECK_REPORT <= 47) c2 = powf(10.0f, (float)(v / 9u)) * (1.0f + (float)(v % 9u));
    }
#endif
    if (F.ctl[CW_BAR + XB_TMO] != 0u) c2 = 1e20f;
    const float c = sqrtf(c2);
    for (size_t i = (size_t)blockIdx.x * NTHR + threadIdx.x; i < (size_t)T * DM; i += (size_t)gridDim.x * NTHR) F.out[i] = c;
}
#define STAGE_CHECK(n) stage_check<(n)>(F)
#else
#define STAGE_CHECK(n) do {} while (0)
#endif

__global__ void __launch_bounds__(NTHR, 2) mega_fwd(Args args) {
    extern __shared__ __attribute__((aligned(16))) unsigned char lds_raw[];
    Frame F;
    F.lds = (LAS unsigned char*)lds_raw;
    F.MISC = (volatile LAS unsigned*)(F.lds + LDSCTL_OFF);
    F.G = gridDim.x; { const int bx = blockIdx.x; F.vcu = (F.G % 8 == 0) ? (bx % 8) * (F.G / 8) + bx / 8 : bx; }
    F.ws = args.ws; F.ctl = (gu32*)(args.ws + WS_CTL); F.out = args.out;
    F.x = args.in[0]; F.p = args.in[1]; F.mix_norm = args.in[2]; F.w_in = args.in[3]; F.ln_g = args.in[4]; F.ln_b = args.in[5]; F.gws = args.in[6]; F.gbs = args.in[7];
    F.aon = args.in[8]; F.gon = args.in[9]; F.w_out = args.in[10]; F.ffn_norm = args.in[11]; F.router_w = args.in[12]; F.router_b = args.in[13]; F.w_gu = args.in[14]; F.b_gu = args.in[15];
    F.w_dn = args.in[16]; F.b_dn = args.in[17]; F.ple_norm = args.in[18]; F.w_pg = args.in[19]; F.w_pp = args.in[20]; F.ppn = args.in[21]; F.final_norm = args.in[22];
    { PHASE_IDS; for (int u = TID_; u < 256; u += NTHR) ((LAS unsigned*)(F.lds + LDSCTL_OFF))[u] = 0u; }
    __syncthreads();
    XcdBarrier bar = xcd_barrier_post((unsigned*)(F.ctl + CW_BAR), F.MISC + 8);
#define GRID_BAR() xcd_barrier(bar)
#define STAGE_END(n) do { STAGE_CHECK(n); if (TPROBE && blockIdx.x == 0 && threadIdx.x == 0) ((unsigned long long*)(F.ctl + CW_TS))[(n)] = __builtin_amdgcn_s_memrealtime(); } while (0)

    if (TPROBE && blockIdx.x == 0 && threadIdx.x == 0) ((unsigned long long*)(F.ctl + CW_TS))[0] = __builtin_amdgcn_s_memrealtime();
    for (int rep = 0; rep < (DUP_PHASE == 0 ? 2 : 1); ++rep) {
    if (PH(0)) p0_prologue(F);
    GRID_BAR(); }
    STAGE_END(1);
    if (PH(1)) { pg8::DenseSched S; S.init(wsp<bf16>(F, WS_XNB), wsp<bf16>(F, WS_WIN), T, NPROJ, DM, F.G, (int)blockIdx.x);
      float* RC = wsp<float>(F, WS_ROPE);
      EpiInProj E{wsp<bf16>(F, WS_Q), RC, RC + SEQ * 32, wsp<float>(F, WS_KMEAN)};
      for (int rep = 0; rep < (DUP_PHASE == 1 ? 2 : 1); ++rep) { if (rep) GRID_BAR();
      pg8::gemm_phase<EpiInProj, pg8::DenseSched, false, false>(F.lds + RING_OFF, DM * 2, S, E); } }
    GRID_BAR();
    STAGE_END(2);
    for (int rep = 0; rep < (DUP_PHASE == 2 ? 2 : 1); ++rep) {
    if (PH(2)) p2_mixers(F);
    GRID_BAR(); }
    STAGE_END(3);
    if (PH(3)) { pg8::DenseSched S; S.init(wsp<bf16>(F, WS_MIX), wsp<bf16>(F, WS_WOUT), T, DM, DM, F.G, (int)blockIdx.x);
      LAS f32x4* rtab = (LAS f32x4*)(F.lds + XTAB_OFF);
      Unit ua, ub; const bool ha = S.next(0, ua), hb = S.next(1, ub);
      { PHASE_IDS; const int s = TID_ >> 8, r = TID_ & 255; const bool has = s ? hb : ha; const int pm = s ? ub.pm : ua.pm;
        if (has) { const size_t row = (size_t)pm * 256 + r; const f32x4* pa = (const f32x4*)(wsp<float>(F, WS_SSQA) + row * NH); const f32x4 a0 = pa[0], a1 = pa[1], g0 = *(const f32x4*)(wsp<float>(F, WS_SSQG) + row * GG);
            const float sa = ((a0[0] + a0[1]) + (a0[2] + a0[3])) + ((a1[0] + a1[1]) + (a1[2] + a1[3])), sg = (g0[0] + g0[1]) + (g0[2] + g0[3]);
            const float ra = 1.0f / sqrtf(sa * (1.f / AW) + EPS), rg = 1.0f / sqrtf(sg * (1.f / GW) + EPS);
            rtab[s * 256 + r] = (f32x4){ra / rg, rg, wsp<float>(F, WS_SIG0)[row], 0.f}; } }
      __syncthreads();
      EpiOutProj E{wsp<bf16>(F, WS_XNB), wsp<bf16>(F, WS_X1B), wsp<unsigned char>(F, WS_X1F8), wsp<float>(F, WS_SSQ1), rtab, ha ? ua.pm : -1, hb ? ub.pm : -1};
      for (int rep = 0; rep < (DUP_PHASE == 3 ? 2 : 1); ++rep) { if (rep) GRID_BAR();
      pg8::gemm_phase<EpiOutProj, pg8::DenseSched, false, true>(F.lds + RING_OFF, DM * 2, S, E); } }
    GRID_BAR();
    STAGE_END(4);
    if (PH(4)) p4_router(F);
    GRID_BAR();
    STAGE_END(5);
    if (PH(5)) { const int nu = moe_build_tables(F, 2 * FF / 256, 1);
      pg8::MoeSched S{(const char*)wsp<char>(F, WS_X1F8), (const char*)wsp<char>(F, WS_WGU), 0, (size_t)2 * FF * DM, (size_t)256 * DM, nu,
                      (const LAS unsigned*)(F.lds + XTAB_OFF + XT_ULIST), (const LAS unsigned*)(F.lds + XTAB_OFF + XT_GTAB), true};
      EpiMoe1 E{wsp<unsigned char>(F, WS_ABUF), F.b_gu, (const LAS float*)(F.lds + XTAB_OFF + XT_RS)};
      for (int rep = 0; rep < (DUP_PHASE == 5 ? 2 : 1); ++rep) { if (rep) GRID_BAR();
      int Kb = DM; asm volatile("" : "+s"(Kb));
      pg8::gemm_phase<EpiMoe1, pg8::MoeSched, true, false, true>(F.lds + RING_OFF, Kb, S, E); } }
    GRID_BAR();
    STAGE_END(6);
    if (PH(6)) { const int nu = moe_build_tables(F, DM / 256, 2);
      pg8::MoeSched S{(const char*)wsp<char>(F, WS_ABUF), (const char*)wsp<char>(F, WS_WDN), (size_t)256 * FF, (size_t)DM * FF, (size_t)256 * FF, nu,
                      (const LAS unsigned*)(F.lds + XTAB_OFF + XT_ULIST), (const LAS unsigned*)(F.lds + XTAB_OFF + XT_GTAB), false};
      EpiMoe2 E{wsp<unsigned char>(F, WS_YBUF), F.b_dn, (const LAS float*)(F.lds + XTAB_OFF + XT_RS)};
      for (int rep = 0; rep < (DUP_PHASE == 6 ? 2 : 1); ++rep) { if (rep) GRID_BAR();
      int Kb = FF; asm volatile("" : "+s"(Kb));
      pg8::gemm_phase<EpiMoe2, pg8::MoeSched, false, false, true>(F.lds + RING_OFF, Kb, S, E); } }
    GRID_BAR();
    STAGE_END(7);
    if (PH(7)) p7_combine(F);
    GRID_BAR();
    STAGE_END(8);
    if (PH(8)) { pg8::DenseSched S; S.init(wsp<unsigned char>(F, WS_X2F8), wsp<unsigned char>(F, WS_WPG8), T, DM, DM, F.G, (int)blockIdx.x, 1);
      LAS float* rt2 = (LAS float*)(F.lds + XTAB_OFF); Unit ua, ub; const bool ha = S.next(0, ua), hb = S.next(1, ub);
      { PHASE_IDS; const int sl = TID_ >> 8, r = TID_ & 255; const bool has = sl ? hb : ha; const int pm = sl ? ub.pm : ua.pm; if (has) rt2[sl * 256 + r] = wsp<float>(F, WS_RSTD2)[(size_t)pm * 256 + r]; }
      __syncthreads();
      EpiPle<0> E{wsp<unsigned char>(F, WS_GATE), nullptr, rt2, ha ? ua.pm : -1};
      int Kb = DM; asm volatile("" : "+s"(Kb));
      pg8::gemm_phase<EpiPle<0>, pg8::DenseSched, false, false, true>(F.lds + RING_OFF, Kb, S, E);
#if CHECK_STAGE
      GRID_BAR();
      int Kb = DM; asm volatile("" : "+s"(Kb));
      pg8::gemm_phase<EpiPle<0>, pg8::DenseSched, false, false, true>(F.lds + RING_OFF, Kb, S, E);
#endif
    }
#if CHECK_STAGE
    GRID_BAR(); STAGE_CHECK(9);
#endif
    if (PH(8)) { pg8::DenseSched S; S.init(wsp<bf16>(F, WS_PB), wsp<bf16>(F, WS_WPP), T, DM, PLE, F.G, (int)blockIdx.x);
      EpiPle<1> E{wsp<unsigned char>(F, WS_PP), wsp<float>(F, WS_SSQPP), nullptr, -1};
      int Kp = PLE * 2; asm volatile("" : "+s"(Kp));
      pg8::gemm_phase<EpiPle<1>, pg8::DenseSched, false, false>(F.lds + RING_OFF, Kp, S, E); }
    GRID_BAR();
    STAGE_END(9);
#if CHECK_STAGE
    GRID_BAR(); check_report(F);
#else
    if (PH(9)) p9_final(F);
#if TPROBE
    GRID_BAR();
    if (blockIdx.x == 0 && threadIdx.x == 0) { const unsigned long long* ts = (const unsigned long long*)(F.ctl + CW_TS); const unsigned long long t1 = (TP_A == 9) ? __builtin_amdgcn_s_memrealtime() : ts[(TP_A < 10 ? TP_A : 0) + 1];
        unsigned long long d = t1 - ts[TP_A < 10 ? TP_A : 0];
        if (TP_A == 20) d = ts[11] - ts[0]; if (TP_A == 21) d = ts[12] - ts[11]; if (TP_A == 22) d = ts[13] - ts[12]; if (TP_A == 23) d = ts[1] - ts[13]; if (TP_A == 24) d = ts[14] - ts[2]; if (TP_A == 25) d = ts[3] - ts[14];
        if (TP_A == 30) d = (__builtin_amdgcn_s_memrealtime() - ts[0]) / 8;
        F.out[0] += floorf((float)d * 0.01f * 0.125f + 0.5f) * 2.0f; }
#endif
#endif
}

extern "C" void kernel_launch(void* const* d_in, const int* in_sizes, int n_in, void* d_out, int out_size, void* d_ws, size_t ws_size, hipStream_t stream) {
    static int grid = 0;
    if (grid == 0) {
        if (n_in != 23 || in_sizes[0] != T * DM || out_size != T * DM || ws_size < WS_END) { fprintf(stderr, "kernel_launch: unexpected shapes (n_in %d, in0 %d, out %d, ws %zu)\n", n_in, n_in > 0 ? in_sizes[0] : -1, out_size, ws_size); grid = -1; return; }
        int dev = 0, cus = 0, per_cu = 0;
        if (hipGetDevice(&dev) != hipSuccess || hipDeviceGetAttribute(&cus, hipDeviceAttributeMultiprocessorCount, dev) != hipSuccess) { grid = -1; return; }
        if (hipFuncSetAttribute((const void*)mega_fwd, hipFuncAttributeMaxDynamicSharedMemorySize, LDS_BYTES) != hipSuccess) { fprintf(stderr, "kernel_launch: hipFuncSetAttribute failed\n"); grid = -1; return; }
        if (hipOccupancyMaxActiveBlocksPerMultiprocessor(&per_cu, (const void*)mega_fwd, NTHR, LDS_BYTES) != hipSuccess || per_cu < 1)
            fprintf(stderr, "kernel_launch: note: occupancy query reports %d workgroups per CU\n", per_cu);
        (void)hipGetLastError();
        if (cus < 256) { fprintf(stderr, "kernel_launch: built for a 256-CU device (found %d CUs); nothing launched\n", cus); grid = -1; return; }
        grid = 256;
    }
    if (grid < 0) return;
    if (hipMemsetAsync((char*)d_ws + WS_CTL, 0, CTL_ZERO_BYTES, stream) != hipSuccess) return;
    Args a{};
    for (int i = 0; i < 23; ++i) a.in[i] = (const float*)d_in[i];
    a.out = (float*)d_out; a.ws = (unsigned char*)d_ws;
    hipLaunchKernelGGL(mega_fwd, dim3(grid), dim3(NTHR), LDS_BYTES, stream, a);
}
```

```cpp
#include <hip/hip_runtime.h>
#include <cstdio>
#include <cstdint>

#ifndef CHECK_STAGE
#define CHECK_STAGE 0
#endif
#ifndef CHECK_REPORT
#define CHECK_REPORT 0
#endif
#ifndef CHECK_REPORT2
#define CHECK_REPORT2 0
#endif
#ifndef CHECK_REPORT3
#define CHECK_REPORT3 0
#endif
#ifndef DUP_PHASE
#define DUP_PHASE -1
#endif
#ifndef TPROBE
#define TPROBE 0
#endif
#ifndef TP_A
#define TP_A 5
#endif
#ifndef TP_B
#define TP_B 6
#endif
#ifndef CHECK_SKIP
#define CHECK_SKIP 0
#endif
#ifndef PHMASK
#define PHMASK 0x3ff
#endif
#define PH(n) ((PHMASK >> (n)) & 1)

#define GAS __attribute__((address_space(1)))
#define LAS __attribute__((address_space(3)))
typedef unsigned short bf16;
typedef unsigned v4u __attribute__((ext_vector_type(4)));
typedef unsigned v2u __attribute__((ext_vector_type(2)));
typedef float f32x2 __attribute__((ext_vector_type(2)));
typedef float f32x4 __attribute__((ext_vector_type(4)));
typedef float f32x16 __attribute__((ext_vector_type(16)));
typedef short bf16x8 __attribute__((ext_vector_type(8)));
typedef short s16x4 __attribute__((ext_vector_type(4)));
typedef GAS unsigned gu32;

constexpr int BATCH = 16, SEQ = 2048, DM = 1024, T = BATCH * SEQ;
constexpr int AW = 512, NH = 8, HD = 64, NBLK = 8, MOBA = 256;
constexpr int GW = 512, GG = 4, GD = 128, GC = 128;
constexpr int NPROJ = 3 * AW + 2 * GW;
constexpr int NE = 32, TOPK = 4, FF = 1024;
constexpr int PLE = 256;
constexpr int MAXROWS = T * TOPK + NE * 256;
constexpr float EPS = 1e-6f;
constexpr int NWAVES = 8, NTHR = 512;

constexpr size_t MiB = 1u << 20;
constexpr size_t WS_CTL = 0, CTL_ZERO_BYTES = 1 * MiB;
constexpr size_t WS_KMEAN = 256 * 1024;
constexpr size_t WS_WIN = 1 * MiB;
constexpr size_t WS_WOUT = 6 * MiB;
constexpr size_t WS_WPG = 8 * MiB;
constexpr size_t WS_WPP = 10 * MiB;
constexpr size_t WS_RWG = 10 * MiB + 512 * 1024;
constexpr size_t WS_ROPE = 11 * MiB;
constexpr size_t WS_WGU = 16 * MiB;
constexpr size_t WS_WDN = 144 * MiB;
constexpr size_t WS_XNB = 208 * MiB;
constexpr size_t WS_BIG1 = 272 * MiB;
constexpr size_t WS_Q = WS_BIG1, WS_K = WS_Q + 32 * MiB, WS_V = WS_K + 32 * MiB, WS_U = WS_V + 32 * MiB, WS_VG = WS_U + 32 * MiB, WS_MIX = WS_VG + 32 * MiB;
constexpr size_t WS_YBUF = WS_BIG1;
constexpr size_t WS_BIG2 = 544 * MiB;
constexpr size_t WS_ABUF = WS_BIG2, WS_GATE = WS_BIG2, WS_PP = WS_BIG2 + 64 * MiB;
constexpr size_t WS_PB = 816 * MiB;
constexpr size_t WS_IDX = 832 * MiB;
constexpr size_t WS_GSS = 836 * MiB;
constexpr size_t WS_TOKPOS = 840 * MiB;
constexpr size_t WS_SSQA = 841 * MiB;
constexpr size_t WS_SSQG = 842 * MiB;
constexpr size_t WS_SSQ1 = 843 * MiB;
constexpr size_t WS_SSQPP = 845 * MiB;
constexpr size_t WS_X1F8 = 848 * MiB;
constexpr size_t WS_X2N = WS_XNB;
constexpr size_t WS_X1B = 880 * MiB;
constexpr size_t WS_X2B = 944 * MiB;
constexpr size_t WS_SIG0 = 1008 * MiB;
constexpr size_t WS_RSTD2 = 1008 * MiB + 256 * 1024;
constexpr size_t WS_RWT = 1008 * MiB + 512 * 1024;
constexpr size_t WS_RSS = 1009 * MiB;
constexpr size_t WS_X2F8 = 176 * MiB;
constexpr size_t WS_WPG8 = 80 * MiB;
constexpr size_t WS_END = 1013 * MiB;
static_assert(WS_MIX + 64 * MiB <= WS_BIG2 && (size_t)MAXROWS * 1024 * 2 <= 272 * MiB, "ws map");
constexpr int CW_TMO = 0, CW_CODE = 1;
constexpr int CW_BAR = 4096;
constexpr int CW_CNT = 8192;
constexpr int CW_TS = 12000;
constexpr int CW_CHK = 12288;

constexpr int RING_OFF = 0, RING_BYTES = 131072;
constexpr int P0_SCR_WAVE = 64 * 65 * 4;
constexpr int LDS_BYTES_TOTAL = 163840;
constexpr int LDSCTL_OFF = LDS_BYTES_TOTAL - 1024;
constexpr int XTAB_OFF = RING_BYTES;
static_assert(8 * P0_SCR_WAVE <= LDSCTL_OFF && XTAB_OFF >= RING_BYTES, "lds map");
constexpr int LDS_BYTES = LDS_BYTES_TOTAL;

#define RLX_AGENT __ATOMIC_RELAXED, __HIP_MEMORY_SCOPE_AGENT
#define LDS_WAIT() asm volatile("s_waitcnt lgkmcnt(0)" ::: "memory")
#define VM_WAIT() asm volatile("s_waitcnt vmcnt(0)" ::: "memory")
__device__ __forceinline__ unsigned f2bf(float f) { unsigned u = __builtin_bit_cast(unsigned, f); return (u + 0x7fffu + ((u >> 16) & 1u)) >> 16; }
__device__ __forceinline__ unsigned pk2(float lo, float hi) { return f2bf(lo) | (f2bf(hi) << 16); }
__device__ __forceinline__ float bf2f(unsigned short b) { return __builtin_bit_cast(float, ((unsigned)b) << 16); }
__device__ __forceinline__ float bflo(unsigned w) { return __builtin_bit_cast(float, w << 16); }
__device__ __forceinline__ float bfhi(unsigned w) { return __builtin_bit_cast(float, w & 0xffff0000u); }
typedef __bf16 bf16x2_t __attribute__((ext_vector_type(2)));
__device__ __forceinline__ unsigned cvt_pk_bf16(float lo, float hi) { const f32x2 v = {lo, hi}; const bf16x2_t b = __builtin_convertvector(v, bf16x2_t); return __builtin_bit_cast(unsigned, b); }
__device__ __forceinline__ float clamp448(float x) { return fminf(fmaxf(x, -448.0f), 448.0f); }
__device__ __forceinline__ unsigned pk4_fp8(float a, float b, float c, float d) { unsigned w = 0u; w = (unsigned)__builtin_amdgcn_cvt_pk_fp8_f32(clamp448(a), clamp448(b), (int)w, false); w = (unsigned)__builtin_amdgcn_cvt_pk_fp8_f32(clamp448(c), clamp448(d), (int)w, true); return w; }
__device__ __forceinline__ float fp8_to_f(unsigned v) { const unsigned sg = (v >> 7) & 1u, e = (v >> 3) & 15u, m = v & 7u; const float r = e ? ldexpf(1.0f + (float)m * 0.125f, (int)e - 7) : ldexpf((float)m * 0.125f, -6); return sg ? -r : r; }
__device__ __forceinline__ float wave_sum(float v) {
#pragma unroll
    for (int o = 1; o < 64; o <<= 1) v += __shfl_xor(v, o);
    return v;
}
__device__ __forceinline__ f32x2 gelu_pk(f32x2 v) {
    const f32x2 av = __builtin_elementwise_abs(v), d = av * 0.2316418882f + 1.0f;
    f32x2 t; t.x = __builtin_amdgcn_rcpf(d.x); t.y = __builtin_amdgcn_rcpf(d.y);
    f32x2 q = t * 0.5307027145f + (-0.7265760135f); q = q * t + 0.7107068705f; q = q * t + (-0.142248368f); q = q * t + 0.127414796f; q = q * t;
    const f32x2 s = (v * v) * (-0.72134752044f);
    f32x2 e; e.x = __builtin_amdgcn_exp2f(s.x); e.y = __builtin_amdgcn_exp2f(s.y);
    const f32x2 m = v * (q * e), r = v - m;
    f32x2 o; o.x = v.x < 0.f ? m.x : r.x; o.y = v.y < 0.f ? m.y : r.y; return o;
}
__device__ __forceinline__ f32x4 gelu4(f32x4 v) { const f32x2 a = gelu_pk((f32x2){v[0], v[1]}), b = gelu_pk((f32x2){v[2], v[3]}); return (f32x4){a.x, a.y, b.x, b.y}; }
__device__ __forceinline__ float sigmoidf_fast(float x) { return __builtin_amdgcn_rcpf(1.0f + __builtin_amdgcn_exp2f(-1.4426950408889634f * x)); }

#define XB_TMO      128
#define XB_XCNT(j)  (256  + 64 * (j))
#define XB_XSUB(j)  (1280 + 64 * (j))
#define XB_XGEN(j)  (2304 + 64 * (j))
#define XB_TOP      3328
#define XB_TOPGEN   3392
#define XCD_BAR_WORDS 3456
#define XB_SPIN_CAP (1u << 18)
__device__ __forceinline__ unsigned xb_ld(unsigned* p)              { return __hip_atomic_load(p, __ATOMIC_RELAXED, __HIP_MEMORY_SCOPE_AGENT); }
__device__ __forceinline__ unsigned xb_add(unsigned* p, unsigned v) { return __hip_atomic_fetch_add(p, v, __ATOMIC_RELAXED, __HIP_MEMORY_SCOPE_AGENT); }
__device__ __forceinline__ unsigned xb_xcc_id() { return (unsigned)__builtin_amdgcn_s_getreg((3 << 11) | 20) & 0xFu; }
#define XB_SPIN(cond, bar) do { unsigned _sp = 0; while (cond) { __builtin_amdgcn_s_sleep(1); \
    if ((++_sp & 255u) == 0u) { if (xb_ld(&(bar)[XB_TMO])) break; if (_sp > XB_SPIN_CAP) { atomicAdd(&(bar)[XB_TMO], 1u); break; } } } } while (0)
struct XcdBarrier { unsigned* bar; unsigned x; volatile LAS unsigned* st; };
__device__ __forceinline__ XcdBarrier xcd_barrier_post(unsigned* bar, volatile LAS unsigned* st) {
    XcdBarrier b; b.bar = bar; b.x = xb_xcc_id(); b.st = st;
    if (threadIdx.x == 0) (void)xb_add(&bar[XB_XCNT(b.x)], 1u);
    return b;
}
__device__ __forceinline__ void xcd_barrier_complete(unsigned* bar, unsigned x, unsigned& nloc, unsigned& nx) {
    const unsigned G = gridDim.x * gridDim.y * gridDim.z;
    unsigned sum, cnt, mine, sp = 0u;
    for (;;) {
        sum = 0u; cnt = 0u; mine = 0u;
#pragma unroll
        for (unsigned j = 0; j < 16; ++j) { const unsigned c = xb_ld(&bar[XB_XCNT(j)]); sum += c; cnt += (c > 0u) ? 1u : 0u; mine = (j == x) ? c : mine; }
        if (sum == G) break;
        __builtin_amdgcn_s_sleep(1);
        if ((++sp & 255u) == 0u) { if (xb_ld(&bar[XB_TMO])) break; if (sp > XB_SPIN_CAP) { atomicAdd(&bar[XB_TMO], 1u); break; } }
    }
    nloc = mine > 0u ? mine : 1u; nx = cnt > 0u ? cnt : 1u;
}
__device__ __forceinline__ void xcd_barrier(const XcdBarrier& b) {
    asm volatile("s_waitcnt vmcnt(0)" ::: "memory");
    __syncthreads();
    if (threadIdx.x == 0) {
        unsigned* bar = b.bar;
        __builtin_amdgcn_s_waitcnt(0);
        unsigned nloc = b.st[0], nx = b.st[1];
        if (nloc == 0u) { xcd_barrier_complete(bar, b.x, nloc, nx); b.st[0] = nloc; b.st[1] = nx; }
        const unsigned old = xb_add(&bar[XB_XSUB(b.x)], 1u);
        const unsigned gen = old / nloc;
        if (old + 1u == (gen + 1u) * nloc) {
            __builtin_amdgcn_fence(__ATOMIC_RELEASE, "agent");
            asm volatile("s_waitcnt vmcnt(0)" ::: "memory");
            const unsigned og = xb_add(&bar[XB_TOP], 1u);
            const unsigned tg = og / nx;
            if (og + 1u == (tg + 1u) * nx) xb_add(&bar[XB_TOPGEN], 1u);
            else XB_SPIN(xb_ld(&bar[XB_TOPGEN]) == tg, bar);
            __builtin_amdgcn_fence(__ATOMIC_ACQUIRE, "agent");
            xb_add(&bar[XB_XGEN(b.x)], 1u);
            asm volatile("s_waitcnt vmcnt(0)" ::: "memory");
        } else {
            XB_SPIN(xb_ld(&bar[XB_XGEN(b.x)]) == gen, bar);
            __builtin_amdgcn_fence(__ATOMIC_ACQUIRE, "agent");
            asm volatile("s_waitcnt vmcnt(0)" ::: "memory");
        }
    }
    __syncthreads();
}

namespace pg8 {
constexpr int BM = 256, BK = 64, HALF = 128, HTB = HALF * BK * 2, STAGE_BYTES = 8 * HTB, NXCD = 8, WGM = 8;
__host__ __device__ __forceinline__ int lds_byte(int r, int c) { const int st = (r >> 4) * 2 + (c >> 5), rr = r & 15, cc = c & 31, ob = rr * 64 + cc * 2; return st * 1024 + (ob ^ (((ob >> 9) & 1) << 5)); }
__host__ __device__ __forceinline__ void stage_rc(int b, int& R, int& C) { const int st = b / 1024, sb = b % 1024, swz = sb ^ (((sb >> 9) & 1) << 5); R = (st >> 1) * 16 + swz / 64; C = (st & 1) * 32 + (swz % 64) / 2; }
__host__ __device__ __forceinline__ int perm32(int rho) { const int n = rho >> 4, i = rho & 15; return 8 * (i >> 2) + 4 * n + (i & 3); }

typedef int v8i __attribute__((ext_vector_type(8)));
constexpr int F8_WSHIFT = 6, F8_SCALE_W = 127 - F8_WSHIFT;
typedef int v4i __attribute__((ext_vector_type(4)));
__device__ __forceinline__ v8i ld8(const LAS unsigned char* p0, const LAS unsigned char* p1) { const v4i lo = *(const LAS v4i*)p0, hi = *(const LAS v4i*)p1; return __builtin_shufflevector(lo, hi, 0, 1, 2, 3, 4, 5, 6, 7); }
struct Unit { int pm, pn, e, rt, slot; };

__device__ __forceinline__ void flat_to_tile(int L, int nwg, int nM, int nN, int& pm, int& pn) {
    int wgid = L; { const int q = nwg / NXCD, r = nwg % NXCD, xcd = wgid % NXCD, off = wgid / NXCD; wgid = (xcd < r ? xcd * (q + 1) : r * (q + 1) + (xcd - r) * q) + off; }
    const int nig = WGM * nN, gid = wgid / nig, fm = gid * WGM, gsz = (nM - fm) < WGM ? (nM - fm) : WGM;
    pm = fm + ((wgid % nig) % gsz); pn = (wgid % nig) / gsz;
}
struct DenseSched {
    const char* A; const char* Bt; int nM, nN, nwg, G, c; size_t tstep;
    __device__ __forceinline__ void init(const void* A_, const void* Bt_, int M, int N, int K, int G_, int c_, int ebytes = 2) { A = (const char*)A_; Bt = (const char*)Bt_; nM = M / BM; nN = N / BM; nwg = nM * nN; G = G_; c = c_; tstep = (size_t)BM * K * ebytes; }
    __device__ __forceinline__ bool next(int i, Unit& u) const { const long L = (long)i * G + c; if (L >= nwg) return false; flat_to_tile((int)L, nwg, nM, nN, u.pm, u.pn); u.e = 0; u.rt = u.pm; u.slot = i; return true; }
    __device__ __forceinline__ const char* a_base(const Unit& u) const { return A + (size_t)u.pm * tstep; }
    __device__ __forceinline__ const char* b_base(const Unit& u) const { return Bt + (size_t)u.pn * tstep; }
    __device__ __forceinline__ void gather(int, int, int, unsigned (&)[2][2]) const {}
};
struct MoeSched {
    const char* A; const char* Bt; size_t a_tstep, b_estep, b_tstep; int nunits; const LAS unsigned* ulist; const LAS unsigned* gtab; bool gath;
    __device__ __forceinline__ bool next(int i, Unit& u) const {
        if (i >= nunits) return false;
        const unsigned w = (unsigned)__builtin_amdgcn_readfirstlane((int)ulist[i]);
        u.pm = (int)(w & 0x3ffu); u.pn = (int)((w >> 10) & 0x7u); u.e = (int)((w >> 13) & 0x1fu); u.rt = (int)(w >> 18); u.slot = i; return true;
    }
    __device__ __forceinline__ const char* a_base(const Unit& u) const { return gath ? A : A + (size_t)u.pm * a_tstep; }
    __device__ __forceinline__ const char* b_base(const Unit& u) const { return Bt + (size_t)u.e * b_estep + (size_t)u.pn * b_tstep; }
    __device__ __forceinline__ void gather(int i, int R0, int R1, unsigned (&off)[2][2]) const {
        const LAS unsigned short* g = (const LAS unsigned short*)gtab + i * 256;
        off[0][0] = (unsigned)g[R0] << 10; off[0][1] = (unsigned)g[R1] << 10; off[1][0] = (unsigned)g[128 + R0] << 10; off[1][1] = (unsigned)g[128 + R1] << 10;
    }
};

#define PG8_SA(b, h) (((b) * 2 + (h)) * HTB)
#define PG8_SB(b, h) ((4 + (b) * 2 + (h)) * HTB)
#define PG8_GLDS(src, dstoff) __builtin_amdgcn_global_load_lds((const unsigned*)(src), (LAS unsigned*)(lds + (dstoff)), 16, 0, 0)
#define PG8_STAGE_B(bufoff, gbase) do { _Pragma("unroll") for (int _i = 0; _i < 2; ++_i) PG8_GLDS((const char*)(gbase) + voffB[_i], (bufoff) + ldsw + _i * 8192); } while (0)
#define PG8_STAGE_A(bufoff, kptr, h, o) do { _Pragma("unroll") for (int _i = 0; _i < 2; ++_i) \
        PG8_GLDS(GATHER ? (const char*)(kptr) + (o)[h][_i] : (const char*)(kptr) + (size_t)(h) * hstep + voffA[_i], (bufoff) + ldsw + _i * 8192); } while (0)
#define PG8_LDA(dst, b, h) do { _Pragma("unroll") for (int m = 0; m < 4; ++m) { if constexpr (F8) dst##8[m] = ld8(lds + PG8_SA(b, h) + a8_0 + m * 2048, lds + PG8_SA(b, h) + a8_1 + m * 2048); \
        else { _Pragma("unroll") for (int k = 0; k < 2; ++k) dst[m][k] = *(const LAS bf16x8*)(lds + PG8_SA(b, h) + aoff + m * 2048 + k * 1024); } } } while (0)
#define PG8_LDB(dst, b, h) do { _Pragma("unroll") for (int n = 0; n < 2; ++n) { if constexpr (F8) dst##8[n] = ld8(lds + PG8_SB(b, h) + b8_0 + n * 2048, lds + PG8_SB(b, h) + b8_1 + n * 2048); \
        else { _Pragma("unroll") for (int k = 0; k < 2; ++k) dst[n][k] = *(const LAS bf16x8*)(lds + PG8_SB(b, h) + boff + n * 2048 + k * 1024); } } } while (0)
#define PG8_MMA(ai, bj, At, Bt) do { __builtin_amdgcn_s_setprio(1); _Pragma("unroll") for (int m = 0; m < 4; ++m) _Pragma("unroll") for (int n = 0; n < 2; ++n) { \
        if constexpr (F8) asm volatile("v_mfma_scale_f32_16x16x128_f8f6f4 %0, %1, %2, %0, %3, %4 op_sel_hi:[0,0,0]" : "+v"(acc[ai][bj][m][n]) : "v"(Bt##8[n]), "v"(At##8[m]), "v"(sc_w), "v"(sc_a)); \
        else { _Pragma("unroll") for (int k = 0; k < 2; ++k) acc[ai][bj][m][n] = __builtin_amdgcn_mfma_f32_16x16x32_bf16(Bt[n][k], At[m][k], acc[ai][bj][m][n], 0, 0, 0); } } __builtin_amdgcn_s_setprio(0); } while (0)
#define PG8_WAIT_V(n) asm volatile("s_waitcnt vmcnt(" #n ")" ::: "memory")
#define PG8_WAIT_L(n) asm volatile("s_waitcnt lgkmcnt(" #n ")" ::: "memory")
#define PG8_BAR __builtin_amdgcn_s_barrier()
#define PG8_SCHED __builtin_amdgcn_sched_barrier(0)

template <class Epi, class Sched, bool GATHER, bool MIDK, bool F8 = false>
__device__ __forceinline__ void gemm_phase(LAS unsigned char* lds, const int KB  , const Sched& S, const Epi& E) {
    int tid = (int)threadIdx.x; asm volatile("" : "+v"(tid));
    const int wid = __builtin_amdgcn_readfirstlane(tid >> 6), lane = tid & 63, wr = wid >> 2, wc = wid & 3, fr = lane & 15, fq = lane >> 4;
    const int nt = KB / 128;
    unsigned voffA[2], voffB[2]; int Rg[2]; unsigned Cg[2];
#pragma unroll
    for (int i = 0; i < 2; ++i) { int R, C; stage_rc(tid * 16 + i * 8192, R, C); const int Rb = Epi::PERM ? ((R & ~31) + perm32(R & 31)) : R;
        voffA[i] = (unsigned)(R * KB + C * 2); voffB[i] = (unsigned)(Rb * KB + C * 2); Rg[i] = R; Cg[i] = (unsigned)C * 2u; }
    const size_t kstep = 128;
    const size_t hstep = (size_t)HALF * KB;
    const unsigned ldsw = (unsigned)wid * 1024u;
    const int aoff = lds_byte(wr * 64 + fr, fq * 8), boff = lds_byte(wc * 32 + fr, fq * 8);
    const int a8_0 = aoff, a8_1 = aoff + 1024, b8_0 = boff, b8_1 = boff + 1024;
    Unit cur, nxt; int ui = 0;
    if (!S.next(0, cur)) return;
    f32x4 acc[2][2][4][2];
#pragma unroll
    for (int a = 0; a < 2; ++a)
#pragma unroll
        for (int b = 0; b < 2; ++b)
#pragma unroll
            for (int m = 0; m < 4; ++m)
#pragma unroll
                for (int n = 0; n < 2; ++n) acc[a][b][m][n] = (f32x4){0.f, 0.f, 0.f, 0.f};
    bf16x8 At[4][2], B0[2][2], B1[2][2]; v8i At8[4], B08[2], B18[2];
    int sc_w = F8_SCALE_W, sc_a = 127; if constexpr (F8) { asm volatile("" : "+v"(sc_w), "+v"(sc_a)); }
    unsigned offC[2][2] = {{0u, 0u}, {0u, 0u}}, offN[2][2] = {{0u, 0u}, {0u, 0u}};
    if constexpr (GATHER) { S.gather(0, Rg[0], Rg[1], offC);
#pragma unroll
        for (int h = 0; h < 2; ++h)
#pragma unroll
            for (int i = 0; i < 2; ++i) offC[h][i] += Cg[i]; }
    const char* cA = S.a_base(cur); const char* cB = S.b_base(cur);
    PG8_STAGE_B(PG8_SB(0, 0), cB); PG8_STAGE_B(PG8_SB(0, 1), cB + hstep); PG8_STAGE_A(PG8_SA(0, 0), cA, 0, offC); PG8_STAGE_A(PG8_SA(0, 1), cA, 1, offC);
    if (wr == 1) PG8_BAR;
    PG8_WAIT_V(2); PG8_BAR;
    PG8_STAGE_B(PG8_SB(1, 0), cB + kstep); PG8_STAGE_A(PG8_SA(1, 0), cA + kstep, 0, offC); PG8_STAGE_B(PG8_SB(1, 1), cB + hstep + kstep);
    PG8_WAIT_V(6); PG8_BAR;
    for (;;) {
        const bool has_next = S.next(ui + 1, nxt);
        const char* nA = has_next ? S.a_base(nxt) : cA; const char* nB = has_next ? S.b_base(nxt) : cB;
        if constexpr (GATHER) { if (has_next) { S.gather(ui + 1, Rg[0], Rg[1], offN);
#pragma unroll
                for (int h = 0; h < 2; ++h)
#pragma unroll
                    for (int i = 0; i < 2; ++i) offN[h][i] += Cg[i]; }
            else {
#pragma unroll
                for (int h = 0; h < 2; ++h)
#pragma unroll
                    for (int i = 0; i < 2; ++i) offN[h][i] = offC[h][i]; } }
        for (int t = 0; t < nt; t += 2) {
            const bool last = (t == nt - 2);
            const char* a1 = cA + (size_t)(t + 1) * kstep;
            const char* a2 = last ? nA : cA + (size_t)(t + 2) * kstep; const char* b2 = last ? nB : cB + (size_t)(t + 2) * kstep;
            const char* a3 = a2 + kstep; const char* b3 = b2 + kstep;
            unsigned o2[2][2];
#pragma unroll
            for (int h = 0; h < 2; ++h)
#pragma unroll
                for (int i = 0; i < 2; ++i) o2[h][i] = last ? offN[h][i] : offC[h][i];
            if constexpr (MIDK) { if (t == nt / 2) E.midk(acc, cur, wr, fr); }
            PG8_LDB(B0, 0, 0); PG8_LDB(B1, 0, 1); PG8_SCHED; PG8_LDA(At, 0, 0); PG8_STAGE_A(PG8_SA(1, 1), a1, 1, offC);
            PG8_WAIT_V(8); PG8_WAIT_L(0); PG8_BAR; PG8_MMA(0, 0, At, B0); PG8_MMA(0, 1, At, B1); PG8_BAR; PG8_SCHED;
            PG8_LDA(At, 0, 1); PG8_STAGE_B(PG8_SB(0, 0), b2); PG8_STAGE_B(PG8_SB(0, 1), b2 + hstep); PG8_STAGE_A(PG8_SA(0, 0), a2, 0, o2);
            PG8_WAIT_V(8); PG8_WAIT_L(0); PG8_BAR; PG8_MMA(1, 0, At, B0); PG8_MMA(1, 1, At, B1); PG8_BAR; PG8_SCHED;
            PG8_LDB(B0, 1, 0); PG8_LDB(B1, 1, 1); PG8_SCHED; PG8_LDA(At, 1, 0); PG8_STAGE_A(PG8_SA(0, 1), a2, 1, o2);
            PG8_WAIT_V(8); PG8_WAIT_L(0); PG8_BAR; PG8_MMA(0, 0, At, B0); PG8_MMA(0, 1, At, B1); PG8_BAR; PG8_SCHED;
            PG8_LDA(At, 1, 1); PG8_STAGE_B(PG8_SB(1, 0), b3); PG8_STAGE_B(PG8_SB(1, 1), b3 + hstep); PG8_STAGE_A(PG8_SA(1, 0), a3, 0, o2);
            PG8_WAIT_V(8); PG8_WAIT_L(0); PG8_BAR; PG8_MMA(1, 0, At, B0); PG8_MMA(1, 1, At, B1); PG8_BAR; PG8_SCHED;
        }
        if (wr == 0) PG8_BAR;
        if constexpr (F8) asm volatile("s_nop 15\n\ts_nop 15" ::: "memory");
        E(acc, cur, wr, wc, fr, fq);
        if (!has_next) break;
#pragma unroll
        for (int a = 0; a < 2; ++a)
#pragma unroll
            for (int b = 0; b < 2; ++b)
#pragma unroll
                for (int m = 0; m < 4; ++m)
#pragma unroll
                    for (int n = 0; n < 2; ++n) acc[a][b][m][n] = (f32x4){0.f, 0.f, 0.f, 0.f};
        cur = nxt; cA = nA; cB = nB; ++ui;
        if constexpr (GATHER) {
#pragma unroll
            for (int h = 0; h < 2; ++h)
#pragma unroll
                for (int i = 0; i < 2; ++i) offC[h][i] = offN[h][i]; }
        if (wr == 1) PG8_BAR;
    }
    PG8_WAIT_V(0);
    PG8_BAR;
}
}

struct Frame {
    LAS unsigned char* lds;
    volatile LAS unsigned* MISC;
    gu32* ctl;
    unsigned char* ws;
    int vcu, G;
    const float *x, *p, *mix_norm, *w_in, *ln_g, *ln_b, *gws, *gbs, *aon, *gon, *w_out, *ffn_norm, *router_w, *router_b, *w_gu, *b_gu, *w_dn, *b_dn, *ple_norm, *w_pg, *w_pp, *ppn, *final_norm;
    float* out;
};
template <class T_> __device__ __forceinline__ T_* wsp(const Frame& F, size_t off) { return (T_*)(F.ws + off); }

#define PHASE_IDS int TID_ = (int)threadIdx.x; asm volatile("" : "+v"(TID_)); const int LANE_ = TID_ & 63; const int WAVE_ = __builtin_amdgcn_readfirstlane(TID_ >> 6); (void)LANE_; (void)WAVE_
template <class ColMap>
__device__ __forceinline__ void p0_transpose_item(const float* W, int K, int N, bf16* WT, const float* gain, LAS float* scr, int item, int lane, int nphys, const ColMap& cm) {
    const int nblk = nphys / 64, kb = item / nblk, nb = item % nblk, k0 = 64 * kb, n0 = 64 * nb;
    const int srccol = cm(n0 + lane);
    float v_[64]; const float* src = W + (size_t)k0 * N + srccol;
#pragma unroll
    for (int kk = 0; kk < 64; ++kk) v_[kk] = __builtin_nontemporal_load(src + (size_t)kk * N);
    if (gain) {
#pragma unroll
        for (int kk = 0; kk < 64; kk += 4) { const f32x4 g4 = *(const f32x4*)(gain + k0 + kk); v_[kk] *= g4[0]; v_[kk + 1] *= g4[1]; v_[kk + 2] *= g4[2]; v_[kk + 3] *= g4[3]; } }
#pragma unroll
    for (int kk = 0; kk < 64; ++kk) scr[kk * 65 + lane] = v_[kk];
    LDS_WAIT(); asm volatile("" ::: "memory");
    const int c = lane & 7;
#pragma unroll
    for (int j = 0; j < 8; ++j) { const int n = (lane >> 3) + 8 * j; const LAS float* s = scr + (8 * c) * 65 + n;
        v4u o; o.x = pk2(s[0 * 65], s[1 * 65]); o.y = pk2(s[2 * 65], s[3 * 65]); o.z = pk2(s[4 * 65], s[5 * 65]); o.w = pk2(s[6 * 65], s[7 * 65]);
        *(GAS v4u*)(WT + (size_t)(n0 + n) * K + k0 + 8 * c) = o; }
    LDS_WAIT(); asm volatile("" ::: "memory");
}
template <class ColMap>
__device__ __forceinline__ void p0_transpose_item_f8(const float* W, int K, int N, unsigned char* WT, const float* gain, LAS float* scr, int item, int lane, int nphys, const ColMap& cm) {
    const int nblk = nphys / 64, kb = item / nblk, nb = item % nblk, k0 = 64 * kb, n0 = 64 * nb;
    const int srccol = cm(n0 + lane);
    float v_[64]; const float* src = W + (size_t)k0 * N + srccol;
#pragma unroll
    for (int kk = 0; kk < 64; ++kk) v_[kk] = __builtin_nontemporal_load(src + (size_t)kk * N);
    constexpr float WS_ = (float)(1 << pg8::F8_WSHIFT);
#pragma unroll
    for (int kk = 0; kk < 64; kk += 4) { f32x4 g4 = gain ? *(const f32x4*)(gain + k0 + kk) : (f32x4){1.f, 1.f, 1.f, 1.f}; v_[kk] *= g4[0] * WS_; v_[kk + 1] *= g4[1] * WS_; v_[kk + 2] *= g4[2] * WS_; v_[kk + 3] *= g4[3] * WS_; }
#pragma unroll
    for (int kk = 0; kk < 64; ++kk) scr[kk * 65 + lane] = v_[kk];
    LDS_WAIT(); asm volatile("" ::: "memory");
    const int c = lane & 3;
#pragma unroll
    for (int j = 0; j < 4; ++j) { const int n = (lane >> 2) + 16 * j; const LAS float* s_ = scr + (16 * c) * 65 + n;
        v4u o; o.x = pk4_fp8(s_[0 * 65], s_[1 * 65], s_[2 * 65], s_[3 * 65]); o.y = pk4_fp8(s_[4 * 65], s_[5 * 65], s_[6 * 65], s_[7 * 65]);
        o.z = pk4_fp8(s_[8 * 65], s_[9 * 65], s_[10 * 65], s_[11 * 65]); o.w = pk4_fp8(s_[12 * 65], s_[13 * 65], s_[14 * 65], s_[15 * 65]);
        *(GAS v4u*)(WT + (size_t)(n0 + n) * K + k0 + 16 * c) = o; }
    LDS_WAIT(); asm volatile("" ::: "memory");
}
struct CmId { __device__ __forceinline__ int operator()(int n) const { return n; } };
struct CmWin { __device__ __forceinline__ int operator()(int n) const { if (n >= 2 * AW) return n; const int c = n & 63; return (n & ~63) + 4 * (c >> 3) + (c & 3) + 32 * ((c >> 2) & 1); } };
struct CmWgu { __device__ __forceinline__ int operator()(int n) const { return ((n >> 7) & 1) * FF + (n >> 8) * 128 + (n & 127); } };

constexpr int XW_I_GU = (DM / 64) * (2 * FF / 64), XW_I_DN = (FF / 64) * (DM / 64), XW_ITEMS = NE * (XW_I_GU + XW_I_DN);
__device__ __forceinline__ void xw_convert_item(const Frame& F, int it, LAS float* scr, int lane) {
    if (it < NE * XW_I_GU) { const int e = it / XW_I_GU; p0_transpose_item_f8(F.w_gu + (size_t)e * DM * 2 * FF, DM, 2 * FF, wsp<unsigned char>(F, WS_WGU) + (size_t)e * 2 * FF * DM, F.ffn_norm, scr, it % XW_I_GU, lane, 2 * FF, CmWgu()); }
    else { const int r = it - NE * XW_I_GU, e = r / XW_I_DN; p0_transpose_item_f8(F.w_dn + (size_t)e * FF * DM, FF, DM, wsp<unsigned char>(F, WS_WDN) + (size_t)e * DM * FF, nullptr, scr, r % XW_I_DN, lane, DM, CmId()); }
}
struct XwDesc { const float* src; unsigned char* dst; unsigned N, K; };
__device__ __forceinline__ XwDesc xw_desc(const Frame& F, int it, int lane) {
    XwDesc d; const int kq = lane >> 4, nq = lane & 15;
    if (it < NE * XW_I_GU) { const int e = it / XW_I_GU, item = it % XW_I_GU, nblk = 2 * FF / 64, k0 = 64 * (item / nblk), n0 = 64 * (item % nblk);
        d.N = 2 * FF; d.K = DM; d.src = F.w_gu + (size_t)e * DM * 2 * FF + (size_t)(k0 + kq) * (2 * FF) + CmWgu()(n0) + 4 * nq;
        d.dst = wsp<unsigned char>(F, WS_WGU) + (size_t)e * 2 * FF * DM + (size_t)(n0 + (lane >> 2)) * DM + k0 + 16 * (lane & 3); }
    else { const int r = it - NE * XW_I_GU, e = r / XW_I_DN, item = r % XW_I_DN, nblk = DM / 64, k0 = 64 * (item / nblk), n0 = 64 * (item % nblk);
        d.N = DM; d.K = FF; d.src = F.w_dn + (size_t)e * FF * DM + (size_t)(k0 + kq) * DM + n0 + 4 * nq;
        d.dst = wsp<unsigned char>(F, WS_WDN) + (size_t)e * DM * FF + (size_t)(n0 + (lane >> 2)) * FF + k0 + 16 * (lane & 3); }
    return d;
}
__device__ __forceinline__ void xw_load(f32x4 (&v)[16], const XwDesc& d) {
#pragma unroll
    for (int j = 0; j < 16; ++j) v[j] = __builtin_nontemporal_load((const f32x4*)(d.src + (size_t)(4 * j) * d.N));
}
__device__ __forceinline__ void xw_process(const f32x4 (&v)[16], const XwDesc& d, LAS float* scr, int lane) {
    const int kq = lane >> 4, nq = lane & 15;
#pragma unroll
    for (int j = 0; j < 16; ++j) { LAS float* w = scr + (4 * j + kq) * 65 + 4 * nq; w[0] = v[j][0]; w[1] = v[j][1]; w[2] = v[j][2]; w[3] = v[j][3]; }
    LDS_WAIT(); asm volatile("" ::: "memory");
    constexpr float WS_ = (float)(1 << pg8::F8_WSHIFT);
    const int c = lane & 3;
#pragma unroll
    for (int j = 0; j < 4; ++j) { const LAS float* s_ = scr + (16 * c) * 65 + (lane >> 2) + 16 * j;
        v4u o; o.x = pk4_fp8(s_[0 * 65] * WS_, s_[1 * 65] * WS_, s_[2 * 65] * WS_, s_[3 * 65] * WS_); o.y = pk4_fp8(s_[4 * 65] * WS_, s_[5 * 65] * WS_, s_[6 * 65] * WS_, s_[7 * 65] * WS_);
        o.z = pk4_fp8(s_[8 * 65] * WS_, s_[9 * 65] * WS_, s_[10 * 65] * WS_, s_[11 * 65] * WS_); o.w = pk4_fp8(s_[12 * 65] * WS_, s_[13 * 65] * WS_, s_[14 * 65] * WS_, s_[15 * 65] * WS_);
        *(GAS v4u*)(d.dst + (size_t)(16 * j) * d.K) = o; }
    LDS_WAIT(); asm volatile("" ::: "memory");
}
__device__ __forceinline__ void p0_prologue(Frame& F) {
    PHASE_IDS;
    LAS float* scr = (LAS float*)(F.lds + RING_OFF + WAVE_ * P0_SCR_WAVE);
    const int gw = F.vcu * NWAVES + WAVE_, NGW = F.G * NWAVES;
    constexpr int I_GU = (DM / 64) * (2 * FF / 64), I_DN = (FF / 64) * (DM / 64), I_IN = (DM / 64) * (NPROJ / 64), I_SQ = (DM / 64) * (DM / 64), I_PP = (PLE / 64) * (DM / 64);
    constexpr int NITEMS = I_IN + 2 * I_SQ + I_PP;
    (void)I_GU; (void)I_DN;
    for (int it = gw; it < NITEMS; it += NGW) {
        int r = it;
        if (r < I_IN) { p0_transpose_item(F.w_in, DM, NPROJ, wsp<bf16>(F, WS_WIN), F.mix_norm, scr, r, LANE_, NPROJ, CmWin()); continue; } r -= I_IN;
        if (r < I_SQ) {
            const int nblk = DM / 64, kb = r / nblk; const float* g = (kb < 8) ? F.aon : (F.gon - AW);
            p0_transpose_item(F.w_out, DM, DM, wsp<bf16>(F, WS_WOUT), g, scr, r, LANE_, DM, CmId()); continue; } r -= I_SQ;
        if (r < I_SQ) { p0_transpose_item_f8(F.w_pg, DM, DM, wsp<unsigned char>(F, WS_WPG8), F.ple_norm, scr, r, LANE_, DM, CmId()); continue; } r -= I_SQ;
        p0_transpose_item(F.w_pp, PLE, DM, wsp<bf16>(F, WS_WPP), nullptr, scr, r, LANE_, DM, CmId());
    }
    if (TPROBE && blockIdx.x == 0 && threadIdx.x == 0) ((unsigned long long*)(F.ctl + CW_TS))[11] = __builtin_amdgcn_s_memrealtime();
    bf16* XN = wsp<bf16>(F, WS_XNB);
    for (int m0 = gw; m0 < T; m0 += 2 * NGW) {
        f32x4 v[2][4]; float s[2] = {0.f, 0.f};
#pragma unroll
        for (int r = 0; r < 2; ++r) { const GAS f32x4* xr = (const GAS f32x4*)(F.x + (size_t)(m0 + r * NGW) * DM) + LANE_;
#pragma unroll
            for (int j = 0; j < 4; ++j) v[r][j] = __builtin_nontemporal_load(xr + 64 * j); }
#pragma unroll
        for (int r = 0; r < 2; ++r) {
#pragma unroll
            for (int j = 0; j < 4; ++j) s[r] += (v[r][j].x * v[r][j].x + v[r][j].y * v[r][j].y) + (v[r][j].z * v[r][j].z + v[r][j].w * v[r][j].w); }
#pragma unroll
        for (int r = 0; r < 2; ++r) { const int m = m0 + r * NGW; const float sig = sqrtf(wave_sum(s[r]) * (1.f / DM) + EPS), rstd = 1.0f / sig;
            if (LANE_ == 0) wsp<float>(F, WS_SIG0)[m] = sig;
            GAS v2u* o8 = (GAS v2u*)(XN + (size_t)m * DM) + LANE_;
#pragma unroll
            for (int j = 0; j < 4; ++j) { v2u w; w.x = pk2(v[r][j].x * rstd, v[r][j].y * rstd); w.y = pk2(v[r][j].z * rstd, v[r][j].w * rstd); o8[64 * j] = w; } }
    }
    if (TPROBE && blockIdx.x == 0 && threadIdx.x == 0) ((unsigned long long*)(F.ctl + CW_TS))[12] = __builtin_amdgcn_s_memrealtime();
    { const GAS f32x4* pr = (const GAS f32x4*)F.p; GAS v2u* po = (GAS v2u*)wsp<bf16>(F, WS_PB);
      const size_t n4 = (size_t)T * PLE / 4, gt = (size_t)(F.vcu * NTHR + TID_), GT = (size_t)F.G * NTHR;
      for (size_t i = gt; i < n4; i += GT) { const f32x4 v = pr[i]; v2u w; w.x = pk2(v.x, v.y); w.y = pk2(v.z, v.w); po[i] = w; } }
    if (TPROBE && blockIdx.x == 0 && threadIdx.x == 0) ((unsigned long long*)(F.ctl + CW_TS))[13] = __builtin_amdgcn_s_memrealtime();
    { const int gt = F.vcu * NTHR + TID_, GT = F.G * NTHR; float* RWG = wsp<float>(F, WS_RWG);
      (void)RWG; bf16* RWT = wsp<bf16>(F, WS_RWT);
      for (int i = gt; i < DM * NE; i += GT) { const int e = i / DM, k = i % DM; const float w = F.router_w[k * NE + e] * F.ffn_norm[k]; const unsigned hi = f2bf(w); const float lo = w - bf2f((bf16)hi); RWT[i] = (bf16)hi; RWT[NE * DM + i] = (bf16)f2bf(lo); }
      float* RC = wsp<float>(F, WS_ROPE); float* RS = RC + SEQ * 32;
      for (int i = gt; i < SEQ * 32; i += GT) { const int pos = i >> 5, j = i & 31; const float inv = powf(10000.0f, -(float)j / 32.0f); const float ang = (float)pos * inv; float sn, cs; sincosf(ang, &sn, &cs); RC[i] = cs; RS[i] = sn; } }
}

using pg8::Unit;
constexpr int HALF = 128;
struct EpiInProj {
    static constexpr bool PERM = true;
    bf16* QKVUV; const float *rc, *rs; float* kmean;
    __device__ __forceinline__ void operator()(const f32x4 (&acc)[2][2][4][2], const Unit& u, int wr, int wc, int fr, int fq) const {
        const int type = u.pn >> 1, colt = (u.pn & 1) * 256 + wc * 32 + 8 * fq;
        const int row0 = u.pm * 256 + wr * 64 + fr;
        if (type <= 1) {
            bf16* dst = QKVUV + (size_t)type * (16u << 20);
            const int pos0 = (u.pm & 7) * 256 + wr * 64 + fr, i0 = 16 * (wc & 1) + 4 * fq;
            f32x4 cs_[2][2];
#pragma unroll
            for (int bj = 0; bj < 2; ++bj) { cs_[bj][0] = (f32x4){0.f, 0.f, 0.f, 0.f}; cs_[bj][1] = (f32x4){0.f, 0.f, 0.f, 0.f}; }
#pragma unroll
            for (int ai = 0; ai < 2; ++ai) { f32x4 cc[4], ss[4];
#pragma unroll
                for (int m = 0; m < 4; ++m) { const int pos = pos0 + ai * HALF + m * 16; cc[m] = *(const f32x4*)(rc + pos * 32 + i0); ss[m] = *(const f32x4*)(rs + pos * 32 + i0); }
#pragma unroll
                for (int m = 0; m < 4; ++m) { const int ro = ai * HALF + m * 16; const f32x4 c = cc[m], s = ss[m];
                    bf16* rowp = dst + (size_t)(row0 + ro) * AW + colt;
#pragma unroll
                    for (int bj = 0; bj < 2; ++bj) { const f32x4 x1 = acc[ai][bj][m][0], x2 = acc[ai][bj][m][1];
                        const f32x4 o1 = x1 * c - x2 * s, o2 = x2 * c + x1 * s;
                        cs_[bj][0] += o1; cs_[bj][1] += o2;
                        v4u w; w.x = cvt_pk_bf16(o1[0], o1[1]); w.y = cvt_pk_bf16(o1[2], o1[3]); w.z = cvt_pk_bf16(o2[0], o2[1]); w.w = cvt_pk_bf16(o2[2], o2[3]);
                        *(v4u*)(rowp + bj * HALF) = w; } }
                asm volatile("" ::: "memory"); }
            if (type == 1) {
#pragma unroll
                for (int bj = 0; bj < 2; ++bj)
#pragma unroll
                    for (int n = 0; n < 2; ++n)
#pragma unroll
                        for (int j = 0; j < 4; ++j) { float v = cs_[bj][n][j]; v += __shfl_xor(v, 1); v += __shfl_xor(v, 2); v += __shfl_xor(v, 4); v += __shfl_xor(v, 8); cs_[bj][n][j] = v; }
                if (fr == 0) { const int b = u.pm >> 3, blk = u.pm & 7;
#pragma unroll
                    for (int bj = 0; bj < 2; ++bj) { const int colh = (u.pn & 1) * 256 + bj * HALF + wc * 32; const int head = colh >> 6, cpos = (colh & 63) + 8 * fq;
                        float* km = kmean + ((size_t)((b * NH + head) * NBLK + blk)) * HD + cpos;
#pragma unroll
                        for (int n = 0; n < 2; ++n)
#pragma unroll
                            for (int j = 0; j < 4; ++j) atomicAdd(km + 4 * n + j, cs_[bj][n][j]); } }
            }
        } else {
            bf16* dst = QKVUV + (size_t)type * (16u << 20);
#pragma unroll
            for (int ai = 0; ai < 2; ++ai)
#pragma unroll
                for (int m = 0; m < 4; ++m) { bf16* rowp = dst + (size_t)(row0 + ai * HALF + m * 16) * AW + colt;
#pragma unroll
                    for (int bj = 0; bj < 2; ++bj) { f32x4 v0 = acc[ai][bj][m][0], v1 = acc[ai][bj][m][1];
                        if (type >= 3) { v0 = gelu4(v0); v1 = gelu4(v1); }
                        v4u w; w.x = cvt_pk_bf16(v0[0], v0[1]); w.y = cvt_pk_bf16(v0[2], v0[3]); w.z = cvt_pk_bf16(v1[0], v1[1]); w.w = cvt_pk_bf16(v1[2], v1[3]);
                        *(v4u*)(rowp + bj * HALF) = w; } }
        }
    }
};
struct EpiOutProj {
    static constexpr bool PERM = true;
    const bf16* xn; bf16* x1; unsigned char* x1f8; float* ssq1; const LAS f32x4* rtab; const float* fgain;
    int pm_a, pm_b;
    __device__ __forceinline__ int slot(const Unit& u) const { return u.pm == pm_a ? 0 : 1; }
    __device__ __forceinline__ void midk(f32x4 (&acc)[2][2][4][2], const Unit& u, int wr, int fr) const {
        const LAS f32x4* t = rtab + slot(u) * 256 + wr * 64 + fr;
#pragma unroll
        for (int ai = 0; ai < 2; ++ai)
#pragma unroll
            for (int m = 0; m < 4; ++m) { const float r = t[ai * HALF + m * 16].x;
#pragma unroll
                for (int bj = 0; bj < 2; ++bj)
#pragma unroll
                    for (int n = 0; n < 2; ++n) acc[ai][bj][m][n] *= r; }
    }
    __device__ __forceinline__ void operator()(const f32x4 (&acc)[2][2][4][2], const Unit& u, int wr, int wc, int fr, int fq) const {
        const LAS f32x4* t = rtab + slot(u) * 256 + wr * 64 + fr;
        const int row0 = u.pm * 256 + wr * 64 + fr, col0 = u.pn * 256 + wc * 32 + 8 * fq;
        f32x4 fg[2][2];
#pragma unroll
        for (int bj = 0; bj < 2; ++bj) { fg[bj][0] = *(const f32x4*)(fgain + col0 + bj * HALF); fg[bj][1] = *(const f32x4*)(fgain + col0 + bj * HALF + 4); }
#pragma unroll
        for (int ai = 0; ai < 2; ++ai) { v4u xv[4][2];
#pragma unroll
            for (int m = 0; m < 4; ++m) { const size_t off = (size_t)(row0 + ai * HALF + m * 16) * DM + col0;
                xv[m][0] = *(const v4u*)(xn + off); xv[m][1] = *(const v4u*)(xn + off + HALF); }
#pragma unroll
            for (int m = 0; m < 4; ++m) { const int ro = ai * HALF + m * 16; const f32x4 tv = t[ro]; const float rg = tv.y, sx = tv.z; const size_t off = (size_t)(row0 + ro) * DM + col0; float q = 0.f;
#pragma unroll
                for (int bj = 0; bj < 2; ++bj) { const v4u xw = xv[m][bj];
                    const f32x4 x0 = {bflo(xw.x), bfhi(xw.x), bflo(xw.y), bfhi(xw.y)}, x1_ = {bflo(xw.z), bfhi(xw.z), bflo(xw.w), bfhi(xw.w)};
                    const f32x4 o0 = x0 * sx + acc[ai][bj][m][0] * rg, o1 = x1_ * sx + acc[ai][bj][m][1] * rg;
                    q += (o0[0] * o0[0] + o0[1] * o0[1]) + (o0[2] * o0[2] + o0[3] * o0[3]) + (o1[0] * o1[0] + o1[1] * o1[1]) + (o1[2] * o1[2] + o1[3] * o1[3]);
                    v4u w; w.x = cvt_pk_bf16(o0[0], o0[1]); w.y = cvt_pk_bf16(o0[2], o0[3]); w.z = cvt_pk_bf16(o1[0], o1[1]); w.w = cvt_pk_bf16(o1[2], o1[3]);
                    *(v4u*)(x1 + off + bj * HALF) = w;
                    const f32x4 p0 = o0 * fg[bj][0], p1 = o1 * fg[bj][1];
                    v2u w8; w8.x = pk4_fp8(p0[0], p0[1], p0[2], p0[3]); w8.y = pk4_fp8(p1[0], p1[1], p1[2], p1[3]); *(v2u*)(x1f8 + off + bj * HALF) = w8; }
                q += __shfl_xor(q, 16); q += __shfl_xor(q, 32);
                if (fq == 0) ssq1[(size_t)(row0 + ro) * 16 + u.pn * 4 + wc] = q; }
            asm volatile("" ::: "memory"); }
    }
};
struct EpiMoe1 {
    static constexpr bool PERM = true;
    unsigned char* A; const float* b_gu; const LAS float* rss;
    __device__ __forceinline__ void operator()(const f32x4 (&acc)[2][2][4][2], const Unit& u, int wr, int wc, int fr, int fq) const {
        const int row0 = u.pm * 256 + wr * 64 + fr, col = u.pn * 128 + wc * 32 + 8 * fq;
        const float* bg = b_gu + (size_t)u.e * 2 * FF + col; const LAS float* rs_ = rss + u.slot * 256 + wr * 64 + fr;
        float rsv[2][4];
#pragma unroll
        for (int ai = 0; ai < 2; ++ai)
#pragma unroll
            for (int m = 0; m < 4; ++m) rsv[ai][m] = rs_[ai * HALF + m * 16];
        f32x4 bgv[2], blv[2];
#pragma unroll
        for (int n = 0; n < 2; ++n) { bgv[n] = *(const f32x4*)(bg + 4 * n); blv[n] = *(const f32x4*)(bg + FF + 4 * n); }
#pragma unroll
        for (int ai = 0; ai < 2; ++ai)
#pragma unroll
            for (int m = 0; m < 4; ++m) { f32x4 a[2];
#pragma unroll
                for (int n = 0; n < 2; ++n) { const f32x4 g = acc[ai][0][m][n] * rsv[ai][m] + bgv[n], l = acc[ai][1][m][n] * rsv[ai][m] + blv[n];
#pragma unroll
                    for (int p = 0; p < 2; ++p) { f32x2 gc = {fminf(g[2 * p], 7.0f), fminf(g[2 * p + 1], 7.0f)}; f32x2 lc = {fminf(fmaxf(l[2 * p], -7.0f), 7.0f), fminf(fmaxf(l[2 * p + 1], -7.0f), 7.0f)};
                        const f32x2 z = gc * (-1.702f * 1.4426950408889634f); f32x2 e; e.x = __builtin_amdgcn_exp2f(z.x); e.y = __builtin_amdgcn_exp2f(z.y);
                        const f32x2 d = e + 1.0f; f32x2 r; r.x = __builtin_amdgcn_rcpf(d.x); r.y = __builtin_amdgcn_rcpf(d.y);
                        const f32x2 o = (gc * r) * (lc + 1.0f); a[n][2 * p] = o.x; a[n][2 * p + 1] = o.y; } }
                v2u w; w.x = pk4_fp8(a[0][0], a[0][1], a[0][2], a[0][3]); w.y = pk4_fp8(a[1][0], a[1][1], a[1][2], a[1][3]);
                *(v2u*)(A + (size_t)(row0 + ai * HALF + m * 16) * FF + col) = w; }
    }
};
constexpr float Y_SCALE = 16.0f;
struct EpiMoe2 {
    static constexpr bool PERM = true;
    unsigned char* Y; const float* b_dn; const LAS float* gss;
    __device__ __forceinline__ void operator()(const f32x4 (&acc)[2][2][4][2], const Unit& u, int wr, int wc, int fr, int fq) const {
        const int row0 = u.pm * 256 + wr * 64 + fr, col0 = u.pn * 256 + wc * 32 + 8 * fq;
        const LAS float* gs = gss + u.slot * 256 + wr * 64 + fr;
        f32x4 bv[2][2]; float gv[2][4];
#pragma unroll
        for (int bj = 0; bj < 2; ++bj)
#pragma unroll
            for (int n = 0; n < 2; ++n) bv[bj][n] = *(const f32x4*)(b_dn + (size_t)u.e * DM + col0 + bj * HALF + 4 * n);
#pragma unroll
        for (int ai = 0; ai < 2; ++ai)
#pragma unroll
            for (int m = 0; m < 4; ++m) gv[ai][m] = gs[ai * HALF + m * 16] * Y_SCALE;
#pragma unroll
        for (int ai = 0; ai < 2; ++ai)
#pragma unroll
            for (int m = 0; m < 4; ++m) { const float g = gv[ai][m]; unsigned char* rowp = Y + (size_t)(row0 + ai * HALF + m * 16) * DM + col0;
#pragma unroll
                for (int bj = 0; bj < 2; ++bj) { const f32x4 v0 = (acc[ai][bj][m][0] + bv[bj][0]) * g, v1 = (acc[ai][bj][m][1] + bv[bj][1]) * g;
                    v2u w; w.x = pk4_fp8(v0[0], v0[1], v0[2], v0[3]); w.y = pk4_fp8(v1[0], v1[1], v1[2], v1[3]);
                    *(v2u*)(rowp + bj * HALF) = w; } }
    }
};
constexpr float GATE_SCALE = 128.0f;
template <int MODE> struct EpiPle {
    static constexpr bool PERM = true;
    unsigned char* O; float* ssq; const LAS float* rtab; int pm_a;
    __device__ __forceinline__ void operator()(const f32x4 (&acc)[2][2][4][2], const Unit& u, int wr, int wc, int fr, int fq) const {
        const int row0 = u.pm * 256 + wr * 64 + fr, col0 = u.pn * 256 + wc * 32 + 8 * fq;
        float rsv[2][4];
#pragma unroll
        for (int ai = 0; ai < 2; ++ai)
#pragma unroll
            for (int m = 0; m < 4; ++m) rsv[ai][m] = (MODE == 0) ? rtab[(u.pm == pm_a ? 0 : 256) + wr * 64 + fr + ai * HALF + m * 16] : 1.0f;
#pragma unroll
        for (int ai = 0; ai < 2; ++ai)
#pragma unroll
            for (int m = 0; m < 4; ++m) { unsigned char* rowp = O + (size_t)(row0 + ai * HALF + m * 16) * DM + col0; float q = 0.f; const float rs = rsv[ai][m];
#pragma unroll
                for (int bj = 0; bj < 2; ++bj) { f32x4 v0 = acc[ai][bj][m][0], v1 = acc[ai][bj][m][1];
                    if (MODE == 0) {
#pragma unroll
                        for (int j = 0; j < 4; ++j) { v0[j] = GATE_SCALE * sigmoidf_fast(rs * v0[j]); v1[j] = GATE_SCALE * sigmoidf_fast(rs * v1[j]); } }
                    else { q += (v0[0] * v0[0] + v0[1] * v0[1]) + (v0[2] * v0[2] + v0[3] * v0[3]) + (v1[0] * v1[0] + v1[1] * v1[1]) + (v1[2] * v1[2] + v1[3] * v1[3]); }
                    v2u w; w.x = pk4_fp8(v0[0], v0[1], v0[2], v0[3]); w.y = pk4_fp8(v1[0], v1[1], v1[2], v1[3]);
                    *(v2u*)(rowp + bj * HALF) = w; }
                if (MODE == 1) { q += __shfl_xor(q, 16); q += __shfl_xor(q, 32); if (fq == 0) ssq[(size_t)(row0 + ai * HALF + m * 16) * 16 + u.pn * 4 + wc] = q; } }
    }
};

namespace att {
constexpr int QBLK = 32, KVBLK = 64;
constexpr float SCALE = 0.125f, THR = 8.f;
constexpr int SHM_V = KVBLK * HD * 2, SHM_K = SHM_V;
constexpr int NSLOT = 3;
constexpr int LDS_BYTES_ = NSLOT * SHM_V + NSLOT * SHM_K + NWAVES * 64 * 4;
#define ATT_KSWZ(row, colB) ((row) * 128 + ((colB) ^ ((((row) >> 1) & 7) << 4)))
#define ATT_SBAR() __builtin_amdgcn_sched_barrier(0)
__device__ __forceinline__ int crow(int r, int hi) { return (r & 3) + 8 * (r >> 2) + 4 * hi; }
__device__ __forceinline__ void cmask(f32x16& p0, f32x16& p1, int jb, int qrel, int hi) {
    const float NEG = -__builtin_inff(); const int kb = 64 * jb + 4 * hi;
#pragma unroll
    for (int r = 0; r < 16; ++r) { const int kv = kb + (r & 3) + 8 * (r >> 2); if (kv > qrel) p0[r] = NEG; if (kv + 32 > qrel) p1[r] = NEG; }
}
__device__ __forceinline__ void bmask(f32x16& p0, f32x16& p1, bool keep) {
    const float NEG = -__builtin_inff();
    if (!keep) {
#pragma unroll
        for (int r = 0; r < 16; ++r) { p0[r] = NEG; p1[r] = NEG; } }
}
__device__ __forceinline__ void partialSM(f32x16& p0, f32x16& p1, float& m_reg, float& mn, float& alpha, bool keep) {
    float pmax = p0[0];
#pragma unroll
    for (int r = 1; r < 16; ++r) pmax = fmaxf(pmax, p0[r]);
#pragma unroll
    for (int r = 0; r < 16; ++r) pmax = fmaxf(pmax, p1[r]);
    { auto rr = __builtin_amdgcn_permlane32_swap(__float_as_uint(pmax), __float_as_uint(pmax), false, false);
      pmax = fmaxf(__uint_as_float(rr[0]), __uint_as_float(rr[1])); }
    if (!keep) pmax = -__builtin_inff();
    constexpr float C2 = 1.4426950408889634f * SCALE;
    if (__builtin_expect(__all((pmax - m_reg) * SCALE <= THR), 1)) { mn = m_reg; alpha = 1.f; }
    else { mn = fmaxf(m_reg, pmax); alpha = __builtin_amdgcn_exp2f((m_reg - mn) * C2); m_reg = mn; }
    const float mnL = keep ? -mn * C2 : -__builtin_inff(), c2 = keep ? C2 : 0.f;
#pragma unroll
    for (int r = 0; r < 16; ++r) p0[r] = fmaf(p0[r], c2, mnL);
#pragma unroll
    for (int r = 0; r < 16; ++r) p1[r] = fmaf(p1[r], c2, mnL);
#pragma unroll
    for (int r = 0; r < 16; ++r) p0[r] = __builtin_amdgcn_exp2f(p0[r]);
}
__device__ __forceinline__ void finishSM(f32x16& p0, f32x16& p1, float alpha, float& l_reg, bf16x8& pa0, bf16x8& pa1, bf16x8& pa2, bf16x8& pa3) {
#pragma unroll
    for (int r = 0; r < 16; ++r) p1[r] = __builtin_amdgcn_exp2f(p1[r]);
    float ps = 0;
#pragma unroll
    for (int r = 0; r < 16; ++r) ps += p0[r];
#pragma unroll
    for (int r = 0; r < 16; ++r) ps += p1[r];
    { auto rr = __builtin_amdgcn_permlane32_swap(__float_as_uint(ps), __float_as_uint(ps), false, false);
      ps = __uint_as_float(rr[0]) + __uint_as_float(rr[1]); }
    l_reg = l_reg * alpha + ps;
#define ATT_PK4(P, B, OUT) do { unsigned a0 = cvt_pk_bf16(P[B+0], P[B+1]), a1 = cvt_pk_bf16(P[B+2], P[B+3]);             \
        unsigned b0 = cvt_pk_bf16(P[B+4], P[B+5]), b1 = cvt_pk_bf16(P[B+6], P[B+7]);                                       \
        auto r0 = __builtin_amdgcn_permlane32_swap(a0, b0, false, false); auto r1 = __builtin_amdgcn_permlane32_swap(a1, b1, false, false); \
        v4u w = {r0[0], r1[0], r0[1], r1[1]}; OUT = *reinterpret_cast<bf16x8*>(&w); } while (0)
    ATT_PK4(p0, 0, pa0); ATT_PK4(p0, 8, pa1); ATT_PK4(p1, 0, pa2); ATT_PK4(p1, 8, pa3);
#undef ATT_PK4
}
__device__ __forceinline__ void qkt(f32x16& p0, f32x16& p1, const LAS unsigned char* Ks, const bf16x8* qr, int r32, int hi) {
    p0 = f32x16{}; p1 = f32x16{};
#pragma unroll
    for (int d0 = 0; d0 < 4; ++d0) { const int cb = (d0 * 16 + hi * 8) * 2;
        const bf16x8 b0 = *(const LAS bf16x8*)(Ks + ATT_KSWZ(r32, cb));
        const bf16x8 b1 = *(const LAS bf16x8*)(Ks + ATT_KSWZ(32 + r32, cb));
        p0 = __builtin_amdgcn_mfma_f32_32x32x16_bf16(b0, qr[d0], p0, 0, 0, 0);
        p1 = __builtin_amdgcn_mfma_f32_32x32x16_bf16(b1, qr[d0], p1, 0, 0, 0); }
}
__device__ __forceinline__ void pv(f32x16* o, int vb, bf16x8 pa0, bf16x8 pa1, bf16x8 pa2, bf16x8 pa3) {
#pragma unroll
    for (int d0 = 0; d0 < 2; ++d0) { s16x4 lo[4], hi[4];
#pragma unroll
        for (int ks = 0; ks < 4; ++ks) { const int a = vb + d0 * 2048 + (ks >> 1) * 4096 + (ks & 1) * 1024;
            asm volatile("ds_read_b64_tr_b16 %0,%1" : "=&v"(lo[ks]) : "v"(a) : "memory");
            asm volatile("ds_read_b64_tr_b16 %0,%1 offset:256" : "=&v"(hi[ks]) : "v"(a) : "memory"); }
        asm volatile("s_waitcnt lgkmcnt(0)" ::: "memory"); ATT_SBAR();
#define ATT_PK(k) (bf16x8){lo[k][0], lo[k][1], lo[k][2], lo[k][3], hi[k][0], hi[k][1], hi[k][2], hi[k][3]}
        o[d0] = __builtin_amdgcn_mfma_f32_32x32x16_bf16(pa0, ATT_PK(0), o[d0], 0, 0, 0);
        o[d0] = __builtin_amdgcn_mfma_f32_32x32x16_bf16(pa1, ATT_PK(1), o[d0], 0, 0, 0);
        o[d0] = __builtin_amdgcn_mfma_f32_32x32x16_bf16(pa2, ATT_PK(2), o[d0], 0, 0, 0);
        o[d0] = __builtin_amdgcn_mfma_f32_32x32x16_bf16(pa3, ATT_PK(3), o[d0], 0, 0, 0);
#undef ATT_PK
    }
}
__device__ __forceinline__ void attn_unit(const Frame& F, int b, int h, int qb, LAS unsigned char* scratch) {
    PHASE_IDS;
    const int tid = TID_, wid = tid >> 6, lane = tid & 63, r32 = lane & 31, hi = lane >> 5;
    const bf16* Qg = wsp<bf16>(F, WS_Q); const bf16* Kg = wsp<bf16>(F, WS_K); const bf16* Vg = wsp<bf16>(F, WS_V);
    const size_t rowbase = (size_t)b * SEQ; const int q0 = qb * MOBA;
    const bf16* Qw = Qg + (rowbase + q0 + wid * QBLK) * AW + h * HD;
    const bf16* Kh = Kg + rowbase * AW + h * HD; const bf16* Vh = Vg + rowbase * AW + h * HD;
    LAS unsigned char* V_lds = scratch; LAS unsigned char* K_lds = scratch + NSLOT * SHM_V;
    LAS float* wsf = (LAS float*)(scratch + NSLOT * SHM_V + NSLOT * SHM_K) + wid * 64; LAS float* li_l = wsf; LAS float* al_l = wsf + 32;
    float m_reg = -1e30f, l_reg = 0.f; f32x16 o[2]; o[0] = f32x16{}; o[1] = f32x16{}; bf16x8 qr[4];
#pragma unroll
    for (int d0 = 0; d0 < 4; ++d0) qr[d0] = *(const bf16x8*)(Qw + (size_t)r32 * AW + d0 * 16 + hi * 8);
    unsigned sel = 0u;
    if (qb <= 3) sel = (1u << qb) - 1u;
    else {
        const float* km = wsp<float>(F, WS_KMEAN) + (size_t)((b * NH + h) * NBLK) * HD + (size_t)(r32 & 7) * HD + hi * 8;
        f32x4 kv[4][2];
#pragma unroll
        for (int d0 = 0; d0 < 4; ++d0) { kv[d0][0] = *(const f32x4*)(km + d0 * 16); kv[d0][1] = *(const f32x4*)(km + d0 * 16 + 4); }
        f32x16 gacc = f32x16{};
#pragma unroll
        for (int d0 = 0; d0 < 4; ++d0) { float f[8] = {kv[d0][0][0], kv[d0][0][1], kv[d0][0][2], kv[d0][0][3], kv[d0][1][0], kv[d0][1][1], kv[d0][1][2], kv[d0][1][3]};
            unsigned hw[4], lw[4];
#pragma unroll
            for (int p = 0; p < 4; ++p) { float a0 = f[2 * p], a1 = f[2 * p + 1]; if (r32 >= 8) { a0 = 0.f; a1 = 0.f; }
                const unsigned h0 = f2bf(a0), h1 = f2bf(a1); hw[p] = h0 | (h1 << 16); lw[p] = pk2(a0 - bf2f((bf16)h0), a1 - bf2f((bf16)h1)); }
            const v4u hv = {hw[0], hw[1], hw[2], hw[3]}, lv = {lw[0], lw[1], lw[2], lw[3]};
            gacc = __builtin_amdgcn_mfma_f32_32x32x16_bf16(__builtin_bit_cast(bf16x8, hv), qr[d0], gacc, 0, 0, 0);
            gacc = __builtin_amdgcn_mfma_f32_32x32x16_bf16(__builtin_bit_cast(bf16x8, lv), qr[d0], gacc, 0, 0, 0); }
        float g[8];
#pragma unroll
        for (int r = 0; r < 4; ++r) { const float mine = gacc[r], other = __shfl_xor(mine, 32); g[r] = hi ? other : mine; g[4 + r] = hi ? mine : other; }
        float b0 = -__builtin_inff(), b1 = b0, b2 = b0; int i0 = 0, i1 = 0, i2 = 0;
#pragma unroll
        for (int j = 0; j < NBLK - 1; ++j) { const float s_ = (j < qb) ? g[j] : -__builtin_inff();
            if (s_ > b0) { b2 = b1; i2 = i1; b1 = b0; i1 = i0; b0 = s_; i0 = j; } else if (s_ > b1) { b2 = b1; i2 = i1; b1 = s_; i1 = j; } else if (s_ > b2) { b2 = s_; i2 = j; } }
        sel = (1u << i0) | (1u << i1) | (1u << i2);
    }
    const int sr = tid >> 3, sc = (tid & 7) * 8;
    const int srv = ((tid >> 5) << 2) | ((tid >> 1) & 3), scv = ((tid & 1) << 3) | (((tid >> 3) & 3) << 4);
    const int vst = (srv >> 5) * 4096 + (scv >> 5) * 2048 + ((srv & 31) >> 2) * 256 + ((scv >> 4) & 1) * 128 + (srv & 3) * 32 + (scv & 8) * 2;
    const int vb0 = (int)(size_t)V_lds + (lane & 15) * 8 + ((lane >> 4) & 1) * 128 + (lane >> 5) * 512;
    bf16x8 st_v, st_k;
#define ATT_SLOAD(k0) do { st_v = *(const bf16x8*)(Vh + (size_t)((k0) + srv) * AW + scv); st_k = *(const bf16x8*)(Kh + (size_t)((k0) + sr) * AW + sc); } while (0)
#define ATT_SWRITE(bf) do { *(LAS bf16x8*)(V_lds + (bf) * SHM_V + vst) = st_v; *(LAS bf16x8*)(K_lds + (bf) * SHM_K + ATT_KSWZ(sr, sc * 2)) = st_k; } while (0)
#define ATT_RESC(a) do { if (__any((a) < 1.f)) { if (hi == 0) al_l[r32] = (a); asm volatile("s_waitcnt lgkmcnt(0)" ::: "memory");      \
        _Pragma("unroll") for (int d_ = 0; d_ < 2; ++d_) _Pragma("unroll") for (int r = 0; r < 16; ++r) o[d_][r] *= al_l[crow(r, hi)]; } } while (0)
    const int NT = (q0 + MOBA) / KVBLK;
    const int qrel = wid * QBLK + r32;
#define ATT_MASK(P0, P1, t) do { const int jb_ = (t) - (NT - 4); if (jb_ >= 0) cmask(P0, P1, jb_, qrel, hi); } while (0)
#define ATT_KEEP(t) ((((t) >= NT - 4) ? 1u : ((sel >> ((t) >> 2)) & 1u)) != 0u)
    f32x16 pA0, pA1, pB0, pB1; float mnA, mnB, alA, alB; bf16x8 pa0, pa1, pa2, pa3;
    int s0 = 0, s1 = 1, s2 = 2;
#define ATT_ROT() do { const int t_ = s0; s0 = s1; s1 = s2; s2 = t_; } while (0)
    ATT_SLOAD(0); asm volatile("s_waitcnt vmcnt(0)" ::: "memory"); ATT_SWRITE(0); ATT_SLOAD(KVBLK);
    s0 = 2; s1 = 0; s2 = 1;
    __syncthreads();
    asm volatile("s_waitcnt vmcnt(0)" ::: "memory"); ATT_SWRITE(s2); ATT_SLOAD(2 * KVBLK);
    qkt(pA0, pA1, K_lds + s1 * SHM_K, qr, r32, hi); ATT_MASK(pA0, pA1, 0); partialSM(pA0, pA1, m_reg, mnA, alA, ATT_KEEP(0));
    ATT_ROT();
    for (int j = 1; j < NT; j += 2) {
        __syncthreads();
        if (j + 1 < NT) { asm volatile("s_waitcnt vmcnt(0)" ::: "memory"); ATT_SWRITE(s2); if (j + 2 < NT) ATT_SLOAD((j + 2) * KVBLK); }
        ATT_SBAR(); qkt(pB0, pB1, K_lds + s1 * SHM_K, qr, r32, hi); ATT_MASK(pB0, pB1, j);
        finishSM(pA0, pA1, alA, l_reg, pa0, pa1, pa2, pa3); ATT_SBAR();
        pv(o, vb0 + s0 * SHM_V, pa0, pa1, pa2, pa3); partialSM(pB0, pB1, m_reg, mnB, alB, ATT_KEEP(j));
        ATT_RESC(alB); ATT_ROT();
        if (j + 1 < NT) {
            __syncthreads();
            if (j + 2 < NT) { asm volatile("s_waitcnt vmcnt(0)" ::: "memory"); ATT_SWRITE(s2); if (j + 3 < NT) ATT_SLOAD((j + 3) * KVBLK); }
            ATT_SBAR(); qkt(pA0, pA1, K_lds + s1 * SHM_K, qr, r32, hi); ATT_MASK(pA0, pA1, j + 1);
            finishSM(pB0, pB1, alB, l_reg, pa0, pa1, pa2, pa3); ATT_SBAR();
            pv(o, vb0 + s0 * SHM_V, pa0, pa1, pa2, pa3); partialSM(pA0, pA1, m_reg, mnA, alA, ATT_KEEP(j + 1));
            ATT_RESC(alA); ATT_ROT();
        }
    }
    finishSM(pB0, pB1, alB, l_reg, pa0, pa1, pa2, pa3); ATT_SBAR();
    pv(o, vb0 + s0 * SHM_V, pa0, pa1, pa2, pa3);
#undef ATT_ROT
    if (hi == 0) li_l[r32] = l_reg; asm volatile("s_waitcnt lgkmcnt(0)" ::: "memory");
    float rli[16];
#pragma unroll
    for (int r = 0; r < 16; ++r) rli[r] = __builtin_amdgcn_rcpf(li_l[crow(r, hi)]);
    bf16* Ow = wsp<bf16>(F, WS_MIX) + (rowbase + q0 + wid * QBLK) * DM + h * HD;
    float* ssqa = wsp<float>(F, WS_SSQA) + (rowbase + q0 + wid * QBLK) * NH + h;
    float qq[16];
#pragma unroll
    for (int r = 0; r < 16; ++r) { const int orow = crow(r, hi); float q2 = 0.f;
#pragma unroll
        for (int d0 = 0; d0 < 2; ++d0) { const float v = o[d0][r] * rli[r]; const float vn = __shfl_xor(v, 1); q2 += v * v;
            if ((r32 & 1) == 0) *(unsigned*)(Ow + (size_t)orow * DM + d0 * 32 + r32) = cvt_pk_bf16(v, vn); }
        qq[r] = q2; }
#pragma unroll
    for (int i = 0; i < 8; ++i) { const bool up = (lane & 16) != 0; const float send = up ? qq[i] : qq[i + 8], keep = up ? qq[i + 8] : qq[i]; qq[i] = keep + __shfl_xor(send, 16); }
#pragma unroll
    for (int i = 0; i < 4; ++i) { const bool up = (lane & 8) != 0; const float send = up ? qq[i] : qq[i + 4], keep = up ? qq[i + 4] : qq[i]; qq[i] = keep + __shfl_xor(send, 8); }
#pragma unroll
    for (int i = 0; i < 2; ++i) { const bool up = (lane & 4) != 0; const float send = up ? qq[i] : qq[i + 2], keep = up ? qq[i + 2] : qq[i]; qq[i] = keep + __shfl_xor(send, 4); }
    { const bool up = (lane & 2) != 0; const float send = up ? qq[0] : qq[1], keep = up ? qq[1] : qq[0]; qq[0] = keep + __shfl_xor(send, 2); }
    qq[0] += __shfl_xor(qq[0], 1);
    if ((lane & 1) == 0) ssqa[(size_t)crow(r32 >> 1, hi) * NH] = qq[0];
    __syncthreads();
#undef ATT_SLOAD
#undef ATT_SWRITE
#undef ATT_RESC
#undef ATT_MASK
#undef ATT_KEEP
}
}

namespace gm {
__device__ __forceinline__ int vt_off(int d, int s) { return d * 256 + ((((s >> 3) ^ (d & 15)) & 15) << 4) + (s & 7) * 2; }
__device__ __forceinline__ void units4(const Frame& F, int v, LAS unsigned char* scratch) {
    PHASE_IDS;
    const int tid = TID_, wid = tid >> 6, lane = tid & 63, fr = lane & 15, fq = lane >> 4;
    const int u = wid >> 1, half = wid & 1, uidx = 4 * v + u, b = uidx >> 6, c = (uidx >> 2) & 15, g = uidx & 3;
    const size_t row0 = (size_t)b * SEQ + c * GC;
    const bf16* VGg = wsp<bf16>(F, WS_VG) + row0 * GW + g * GD; const bf16* Ug = wsp<bf16>(F, WS_U) + row0 * GW + g * GD;
    LAS unsigned char* vt = scratch + u * 32768;
    { const int s_ = half * 64 + lane; const v4u* src = (const v4u*)(VGg + (size_t)s_ * GW); v4u raw[16]; float sum = 0.f, sq = 0.f;
#pragma unroll
      for (int i = 0; i < 16; ++i) raw[i] = src[i];
#pragma unroll
      for (int i = 0; i < 16; ++i) { const unsigned ww[4] = {raw[i].x, raw[i].y, raw[i].z, raw[i].w};
#pragma unroll
          for (int k = 0; k < 4; ++k) { const float a0 = bflo(ww[k]), a1 = bfhi(ww[k]); sum += a0 + a1; sq += a0 * a0 + a1 * a1; } }
      const float mu = sum * (1.f / GD); const float var = fmaxf(sq * (1.f / GD) - mu * mu, 0.f); const float rstd = 1.0f / sqrtf(var + EPS);
      const float* lg = F.ln_g + g * GD; const float* lb = F.ln_b + g * GD;
#pragma unroll
      for (int i = 0; i < 16; ++i) { const unsigned ww[4] = {raw[i].x, raw[i].y, raw[i].z, raw[i].w}; const f32x4 g0 = *(const f32x4*)(lg + 8 * i), g1 = *(const f32x4*)(lg + 8 * i + 4), b0 = *(const f32x4*)(lb + 8 * i), b1 = *(const f32x4*)(lb + 8 * i + 4);
          const float gg[8] = {g0[0], g0[1], g0[2], g0[3], g1[0], g1[1], g1[2], g1[3]}, bb[8] = {b0[0], b0[1], b0[2], b0[3], b1[0], b1[1], b1[2], b1[3]};
#pragma unroll
          for (int k = 0; k < 4; ++k) { const int d = 8 * i + 2 * k;
              *(LAS unsigned short*)(vt + vt_off(d, s_)) = (unsigned short)f2bf((bflo(ww[k]) - mu) * rstd * gg[2 * k] + bb[2 * k]);
              *(LAS unsigned short*)(vt + vt_off(d + 1, s_)) = (unsigned short)f2bf((bfhi(ww[k]) - mu) * rstd * gg[2 * k + 1] + bb[2 * k + 1]); } } }
    __syncthreads();
#pragma unroll 1
    for (int m = 0; m < 4; ++m) {
        const int tb = half * 64 + m * 16, t = tb + fr;
        const float* Wg = F.gws + (size_t)g * GC * GC + (size_t)t * GC;
        const int nks = (tb + 16 + 31) / 32;
        f32x4 w0[4], w1[4];
#pragma unroll
        for (int ks = 0; ks < 4; ++ks) if (ks < nks) { w0[ks] = *(const f32x4*)(Wg + ks * 32 + fq * 8); w1[ks] = *(const f32x4*)(Wg + ks * 32 + fq * 8 + 4); }
        const bf16* Ut = Ug + (size_t)t * GW + 4 * fq; v2u uu[8];
#pragma unroll
        for (int n = 0; n < 8; ++n) uu[n] = *(const v2u*)(Ut + n * 16);
        f32x4 acc[8];
#pragma unroll
        for (int n = 0; n < 8; ++n) acc[n] = (f32x4){0.f, 0.f, 0.f, 0.f};
#pragma unroll
        for (int ks = 0; ks < 4; ++ks) if (ks < nks) { const int s0 = ks * 32 + fq * 8;
            float wv[8] = {w0[ks][0], w0[ks][1], w0[ks][2], w0[ks][3], w1[ks][0], w1[ks][1], w1[ks][2], w1[ks][3]};
#pragma unroll
            for (int j = 0; j < 8; ++j) if (s0 + j > t) wv[j] = 0.f;
            v4u aw; aw.x = pk2(wv[0], wv[1]); aw.y = pk2(wv[2], wv[3]); aw.z = pk2(wv[4], wv[5]); aw.w = pk2(wv[6], wv[7]);
            const bf16x8 wf = *reinterpret_cast<const bf16x8*>(&aw);
#pragma unroll
            for (int n = 0; n < 8; ++n) { const bf16x8 vf = *(const LAS bf16x8*)(vt + vt_off(n * 16 + fr, s0));
                acc[n] = __builtin_amdgcn_mfma_f32_16x16x32_bf16(vf, wf, acc[n], 0, 0, 0); } }
        bf16* Og = wsp<bf16>(F, WS_MIX) + (row0 + t) * DM + AW + g * GD + 4 * fq; float* ssqg = wsp<float>(F, WS_SSQG) + (row0 + t) * GG + g;
        const float bs = F.gbs[g * GC + t]; float q2 = 0.f;
#pragma unroll
        for (int n = 0; n < 8; ++n) { const float o0 = bflo(uu[n].x) * (acc[n][0] + bs), o1 = bfhi(uu[n].x) * (acc[n][1] + bs), o2 = bflo(uu[n].y) * (acc[n][2] + bs), o3 = bfhi(uu[n].y) * (acc[n][3] + bs);
            q2 += (o0 * o0 + o1 * o1) + (o2 * o2 + o3 * o3); v2u w; w.x = cvt_pk_bf16(o0, o1); w.y = cvt_pk_bf16(o2, o3); *(v2u*)(Og + n * 16) = w; }
        q2 += __shfl_xor(q2, 16); q2 += __shfl_xor(q2, 32);
        if (fq == 0) ssqg[0] = q2;
    }
    __syncthreads();
}
}

__device__ __forceinline__ void p2_mixers(const Frame& F) {
    PHASE_IDS;
    LAS unsigned char* scratch = F.lds + RING_OFF;
    const int v = F.vcu, bh = v >> 1, s0 = (v & 1) * 2, cslot = (v >> 1) % 6;
    int item = 0;
#pragma unroll 1
    for (int st = 0; st < 6; ++st) {
        if (st == cslot) { constexpr int PER_WG = XW_ITEMS / 256; static_assert(XW_ITEMS % 256 == 0 && PER_WG % NWAVES == 0, "items per workgroup / wave");
            LAS float* scr = (LAS float*)(F.lds + RING_OFF + WAVE_ * P0_SCR_WAVE);
            constexpr int NI = PER_WG / NWAVES; static_assert(NI % 2 == 0, "pairs");
            int ln = LANE_; asm volatile("" : "+v"(ln));
            const int it0 = v * PER_WG + WAVE_; f32x4 va[16], vb[16]; XwDesc da = xw_desc(F, it0, ln), db; xw_load(va, da);
#pragma unroll 1
            for (int j = 0; j < NI; j += 2) {
                db = xw_desc(F, it0 + (j + 1) * NWAVES, ln); xw_load(vb, db);
                xw_process(va, da, scr, ln);
                if (j + 2 < NI) { da = xw_desc(F, it0 + (j + 2) * NWAVES, ln); xw_load(va, da); }
                xw_process(vb, db, scr, ln);
            }
            __syncthreads(); }
        else { if (item < 4) { const int qq = s0 + (item >> 1); const int qb = (item & 1) ? 7 - qq : qq; att::attn_unit(F, bh / NH, bh % NH, qb, scratch); }
               else gm::units4(F, v, scratch);
               ++item; }
    }
}

__device__ __forceinline__ void p4_router(const Frame& F) {
    PHASE_IDS;
    const int tid = TID_, wid = tid >> 6, lane = tid & 63, tk = lane & 31, hf = lane >> 5;
    LAS unsigned* hist = (LAS unsigned*)(F.lds + XTAB_OFF + 4096);
    LAS unsigned* base = hist + 32;
    static_assert(XTAB_OFF + 4096 >= 8 * P0_SCR_WAVE, "router words above the conversion tiles");
    const bf16* RWT = wsp<bf16>(F, WS_RWT); const bf16* x1 = wsp<bf16>(F, WS_X1B); const float* ssq1 = wsp<float>(F, WS_SSQ1);
    unsigned* cntg = (unsigned*)(F.ctl + CW_CNT);
    unsigned* IDX = wsp<unsigned>(F, WS_IDX); float* GSS = wsp<float>(F, WS_GSS); float* RSS = wsp<float>(F, WS_RSS); unsigned* TOKPOS = wsp<unsigned>(F, WS_TOKPOS);
    if (tid < 32) hist[tid] = 0u;
    __syncthreads();
    const bool active = wid < 4; const int tok = (F.vcu * 4 + (wid & 3)) * 32 + tk;
    int pe[4] = {0, 0, 0, 0}; float pg[4] = {0.f, 0.f, 0.f, 0.f}; unsigned rank[2] = {0u, 0u}; int my_e[2] = {0, 0}; float my_g[2] = {0.f, 0.f}; float rstd = 0.f;
    if (active) {
        { const f32x4* sp = (const f32x4*)(ssq1 + (size_t)tok * 16); const f32x4 a = sp[0], b = sp[1], c = sp[2], d = sp[3];
          const float s_ = ((a[0] + a[1]) + (a[2] + a[3])) + ((b[0] + b[1]) + (b[2] + b[3])) + ((c[0] + c[1]) + (c[2] + c[3])) + ((d[0] + d[1]) + (d[2] + d[3]));
          rstd = 1.0f / sqrtf(s_ * (1.f / DM) + EPS); }
        f32x16 acc = f32x16{};
        { const bf16* xr = x1 + (size_t)tok * DM + 8 * hf; const bf16* wh = RWT + (size_t)tk * DM + 8 * hf; const bf16* wl = wh + NE * DM;
#pragma unroll 8
          for (int s_ = 0; s_ < 64; ++s_) { const bf16x8 xv = *(const bf16x8*)(xr + 16 * s_), a_hi = *(const bf16x8*)(wh + 16 * s_), a_lo = *(const bf16x8*)(wl + 16 * s_);
              acc = __builtin_amdgcn_mfma_f32_32x32x16_bf16(a_hi, xv, acc, 0, 0, 0); acc = __builtin_amdgcn_mfma_f32_32x32x16_bf16(a_lo, xv, acc, 0, 0, 0); } }
        float lv[16];
#pragma unroll
        for (int r = 0; r < 16; ++r) { const int e = (r & 3) + 8 * (r >> 2) + 4 * hf; lv[r] = acc[r] * rstd + F.router_b[e]; }
        float tv[4]; int ti[4]; unsigned used = 0u;
#pragma unroll
        for (int k = 0; k < 4; ++k) { float best = -__builtin_inff(); int br = 0;
#pragma unroll
            for (int r = 0; r < 16; ++r) { const int e = (r & 3) + 8 * (r >> 2) + 4 * hf; const int eb = (br & 3) + 8 * (br >> 2) + 4 * hf;
                const bool better = !((used >> r) & 1u) && (lv[r] > best || (lv[r] == best && e < eb)); if (better) { best = lv[r]; br = r; } }
            used |= 1u << br; tv[k] = best; ti[k] = (br & 3) + 8 * (br >> 2) + 4 * hf; }
        float ov[4]; int oi[4];
#pragma unroll
        for (int k = 0; k < 4; ++k) { ov[k] = __shfl_xor(tv[k], 32); oi[k] = __shfl_xor(ti[k], 32); }
        int ia = 0, ib = 0;
#pragma unroll
        for (int k = 0; k < 4; ++k) {
            float va = tv[0], vb = ov[0]; int ea = ti[0], eb = oi[0];
#pragma unroll
            for (int q = 1; q < 4; ++q) { if (ia == q) { va = tv[q]; ea = ti[q]; } if (ib == q) { vb = ov[q]; eb = oi[q]; } }
            const bool takeA = (va > vb) || (va == vb && ea < eb);
            pg[k] = takeA ? va : vb; pe[k] = takeA ? ea : eb; if (takeA) ++ia; else ++ib; }
        { const float m = pg[0]; float s_ = 0.f;
#pragma unroll
          for (int k = 0; k < 4; ++k) { pg[k] = __builtin_amdgcn_exp2f((pg[k] - m) * 1.4426950408889634f); s_ += pg[k]; }
          const float inv = 1.0f / s_;
#pragma unroll
          for (int k = 0; k < 4; ++k) pg[k] *= inv; }
        { const int m = -hf; my_e[0] = pe[0] ^ ((pe[0] ^ pe[2]) & m); my_e[1] = pe[1] ^ ((pe[1] ^ pe[3]) & m);
          const unsigned g0 = __float_as_uint(pg[0]), g1 = __float_as_uint(pg[1]), g2 = __float_as_uint(pg[2]), g3 = __float_as_uint(pg[3]);
          my_g[0] = __uint_as_float(g0 ^ ((g0 ^ g2) & (unsigned)m)); my_g[1] = __uint_as_float(g1 ^ ((g1 ^ g3) & (unsigned)m)); }
#pragma unroll
        for (int q = 0; q < 2; ++q) rank[q] = atomicAdd((unsigned*)&hist[my_e[q]], 1u);
    }
    __syncthreads();
    if (tid < 32) base[tid] = atomicAdd(cntg + tid, hist[tid]);
    __syncthreads();
    if (active) {
#pragma unroll
        for (int q = 0; q < 2; ++q) { const int k = 2 * hf + q; const int e = my_e[q]; const float g = my_g[q];
            const unsigned slot = base[e] + rank[q];
            IDX[(size_t)e * T + slot] = (unsigned)tok; GSS[(size_t)e * T + slot] = g; RSS[(size_t)e * T + slot] = rstd; TOKPOS[(size_t)tok * 4 + k] = ((unsigned)e << 16) | slot; }
    }
    __syncthreads();
}

__device__ __forceinline__ void build_tstart(const Frame& F, LAS unsigned* tstart, int tid) {
    if (tid < 64) { const unsigned* cntg = (const unsigned*)(F.ctl + CW_CNT); unsigned c = (tid < NE) ? cntg[tid] : 0u; if (c > (unsigned)T) c = (unsigned)T;
        unsigned x = (c + 255u) >> 8;
#pragma unroll
        for (int o = 1; o < 32; o <<= 1) { const unsigned y = __shfl_up(x, o); if ((tid & 63) >= o) x += y; }
        if (tid < NE) tstart[tid + 1] = x; if (tid == 0) tstart[0] = 0u; }
}
constexpr int MAXU = 17;
constexpr int XT_TSTART = 0, XT_ULIST = 256, XT_RS = 512, XT_GTAB = XT_RS + MAXU * 1024;
static_assert(XT_GTAB + MAXU * 512 <= LDSCTL_OFF - XTAB_OFF, "xtab");
__device__ __forceinline__ int moe_build_tables(const Frame& F, int P  , int mode) {
    PHASE_IDS;
    LAS unsigned* tstart = (LAS unsigned*)(F.lds + XTAB_OFF + XT_TSTART);
    LAS unsigned* ulist = (LAS unsigned*)(F.lds + XTAB_OFF + XT_ULIST);
    LAS float* rs = (LAS float*)(F.lds + XTAB_OFF + XT_RS);
    LAS unsigned short* gtab = (LAS unsigned short*)(F.lds + XTAB_OFF + XT_GTAB);
    const unsigned* cntg = (const unsigned*)(F.ctl + CW_CNT); const unsigned* IDX = wsp<unsigned>(F, WS_IDX);
    const float* RSRC = mode == 1 ? wsp<float>(F, WS_RSS) : wsp<float>(F, WS_GSS);
    const int tid = TID_;
    build_tstart(F, tstart, tid);
    __syncthreads();
    const int NT_ = (int)tstart[NE], U = NT_ * P, G = F.G, c = (int)blockIdx.x;
    int nunits = (c < U) ? (U - c + G - 1) / G : 0; if (nunits > MAXU) nunits = MAXU;
    if (tid < nunits) { const int L = tid * G + c; int gt, pn; pg8::flat_to_tile(L, U, NT_, P, gt, pn);
        int e = 0; for (int k = 1; k < NE; ++k) if ((unsigned)gt >= tstart[k]) e = k;
        const int rt = gt - (int)tstart[e];
        ulist[tid] = (unsigned)gt | ((unsigned)pn << 10) | ((unsigned)e << 13) | ((unsigned)rt << 18); }
    __syncthreads();
    {
        constexpr int NP = (MAXU + 1) / 2; unsigned tokv[NP]; float rsv[NP];
#pragma unroll
        for (int p = 0; p < NP; ++p) { const int i = 2 * p + (tid >> 8), r = tid & 255; tokv[p] = 0u; rsv[p] = 0.f;
            if (i < nunits) { const unsigned w = ulist[i]; const int e = (int)((w >> 13) & 0x1fu), rt = (int)(w >> 18);
                unsigned cn = cntg[e]; if (cn > (unsigned)T) cn = (unsigned)T; const unsigned slot = (unsigned)rt * 256u + (unsigned)r;
                if (slot < cn) { if (mode == 1) tokv[p] = IDX[(size_t)e * T + slot]; rsv[p] = RSRC[(size_t)e * T + slot]; } } }
#pragma unroll
        for (int p = 0; p < NP; ++p) { const int i = 2 * p + (tid >> 8), r = tid & 255;
            if (i < nunits) { unsigned tok = tokv[p]; if (tok >= (unsigned)T) tok = 0u; if (mode == 1) gtab[i * 256 + r] = (unsigned short)tok; rs[i * 256 + r] = rsv[p]; } }
    }
    __syncthreads();
    return nunits;
}

__device__ __forceinline__ void p7_combine(const Frame& F) {
    PHASE_IDS;
    LAS unsigned* tstart = (LAS unsigned*)(F.lds + XTAB_OFF + XT_TSTART);
    const unsigned* cntg = (const unsigned*)(F.ctl + CW_CNT);
    build_tstart(F, tstart, TID_); (void)cntg;
    __syncthreads();
    const int gw = F.vcu * NWAVES + WAVE_, NGW = F.G * NWAVES;
    const unsigned* TOKPOS = wsp<unsigned>(F, WS_TOKPOS); const unsigned char* Y = wsp<unsigned char>(F, WS_YBUF); const bf16* X1 = wsp<bf16>(F, WS_X1B); bf16* X2 = wsp<bf16>(F, WS_X2B); unsigned char* X28 = wsp<unsigned char>(F, WS_X2F8); float* RS2 = wsp<float>(F, WS_RSTD2);
    for (int m0 = gw; m0 < T; m0 += 2 * NGW) {
        f32x4 v[2][4]; unsigned yv[2][4][4]; float s[2] = {0.f, 0.f};
#pragma unroll
        for (int r = 0; r < 2; ++r) { const int m = m0 + r * NGW;
            const v4u tp = *(const v4u*)(TOKPOS + (size_t)m * 4); const unsigned tpw[4] = {tp.x, tp.y, tp.z, tp.w};
            size_t yrow[4];
#pragma unroll
            for (int k = 0; k < 4; ++k) { const unsigned e = (tpw[k] >> 16) & 31u, slot = tpw[k] & 0xffffu; yrow[k] = ((size_t)tstart[e] * 256u + slot) * DM; }
#pragma unroll
            for (int j = 0; j < 4; ++j) { const v2u xw = *(const v2u*)(X1 + (size_t)m * DM + 4 * LANE_ + 256 * j); v[r][j] = (f32x4){bflo(xw.x), bfhi(xw.x), bflo(xw.y), bfhi(xw.y)};
#pragma unroll
                for (int k = 0; k < 4; ++k) yv[r][j][k] = *(const unsigned*)(Y + yrow[k] + 4 * LANE_ + 256 * j); } }
#pragma unroll
        for (int r = 0; r < 2; ++r) {
#pragma unroll
            for (int j = 0; j < 4; ++j) {
#pragma unroll
                for (int k = 0; k < 4; ++k) { const unsigned w = yv[r][j][k]; const f32x2 lo = __builtin_amdgcn_cvt_pk_f32_fp8((int)w, false), hi2 = __builtin_amdgcn_cvt_pk_f32_fp8((int)w, true);
                    v[r][j][0] += lo[0] * (1.0f / Y_SCALE); v[r][j][1] += lo[1] * (1.0f / Y_SCALE); v[r][j][2] += hi2[0] * (1.0f / Y_SCALE); v[r][j][3] += hi2[1] * (1.0f / Y_SCALE); }
                s[r] += (v[r][j].x * v[r][j].x + v[r][j].y * v[r][j].y) + (v[r][j].z * v[r][j].z + v[r][j].w * v[r][j].w); } }
#pragma unroll
        for (int r = 0; r < 2; ++r) { const int m = m0 + r * NGW; const float rstd = 1.0f / sqrtf(wave_sum(s[r]) * (1.f / DM) + EPS);
            if (LANE_ == 0) RS2[m] = rstd;
#pragma unroll
            for (int j = 0; j < 4; ++j) { v2u w; w.x = cvt_pk_bf16(v[r][j].x, v[r][j].y); w.y = cvt_pk_bf16(v[r][j].z, v[r][j].w); *(v2u*)(X2 + (size_t)m * DM + 4 * LANE_ + 256 * j) = w;
                *(unsigned*)(X28 + (size_t)m * DM + 4 * LANE_ + 256 * j) = pk4_fp8(v[r][j].x, v[r][j].y, v[r][j].z, v[r][j].w); } }
    }
}

__device__ __forceinline__ void p9_final(const Frame& F) {
    PHASE_IDS;
    const int gw = F.vcu * NWAVES + WAVE_, NGW = F.G * NWAVES;
    const unsigned char* GATE = wsp<unsigned char>(F, WS_GATE); const unsigned char* PP = wsp<unsigned char>(F, WS_PP); const float* ssqpp = wsp<float>(F, WS_SSQPP);
    for (int m0 = gw; m0 < T; m0 += 2 * NGW) {
        f32x4 v[2][4]; unsigned gv[2][4], pv_[2][4]; f32x4 sq[2][4]; float s[2] = {0.f, 0.f};
#pragma unroll
        for (int r = 0; r < 2; ++r) { const int m = m0 + r * NGW; const bf16* x2r = wsp<bf16>(F, WS_X2B) + (size_t)m * DM;
#pragma unroll
            for (int q = 0; q < 4; ++q) sq[r][q] = *(const f32x4*)(ssqpp + (size_t)m * 16 + 4 * q);
#pragma unroll
            for (int j = 0; j < 4; ++j) { const int col = 4 * LANE_ + 256 * j; const v2u xw = *(const v2u*)(x2r + col); v[r][j] = (f32x4){bflo(xw.x), bfhi(xw.x), bflo(xw.y), bfhi(xw.y)};
                gv[r][j] = *(const unsigned*)(GATE + (size_t)m * DM + col); pv_[r][j] = *(const unsigned*)(PP + (size_t)m * DM + col); } }
#pragma unroll
        for (int r = 0; r < 2; ++r) { const f32x4 a = sq[r][0], b = sq[r][1], c = sq[r][2], d = sq[r][3];
            const float sp = ((a[0] + a[1]) + (a[2] + a[3])) + ((b[0] + b[1]) + (b[2] + b[3])) + ((c[0] + c[1]) + (c[2] + c[3])) + ((d[0] + d[1]) + (d[2] + d[3]));
            const float rpp = 1.0f / sqrtf(sp * (1.f / DM) + EPS);
#pragma unroll
            for (int j = 0; j < 4; ++j) { const int col = 4 * LANE_ + 256 * j; const f32x4 pg_ = *(const f32x4*)(F.ppn + col);
                const f32x2 g01 = __builtin_amdgcn_cvt_pk_f32_fp8((int)gv[r][j], false), g23 = __builtin_amdgcn_cvt_pk_f32_fp8((int)gv[r][j], true);
                const f32x2 p01 = __builtin_amdgcn_cvt_pk_f32_fp8((int)pv_[r][j], false), p23 = __builtin_amdgcn_cvt_pk_f32_fp8((int)pv_[r][j], true);
                const float rg = rpp * (1.0f / GATE_SCALE);
                v[r][j][0] += g01[0] * (p01[0] * rg * pg_[0]); v[r][j][1] += g01[1] * (p01[1] * rg * pg_[1]);
                v[r][j][2] += g23[0] * (p23[0] * rg * pg_[2]); v[r][j][3] += g23[1] * (p23[1] * rg * pg_[3]);
                s[r] += (v[r][j].x * v[r][j].x + v[r][j].y * v[r][j].y) + (v[r][j].z * v[r][j].z + v[r][j].w * v[r][j].w); } }
#pragma unroll
        for (int r = 0; r < 2; ++r) { const int m = m0 + r * NGW; float* xr = F.out + (size_t)m * DM; const float rstd = 1.0f / sqrtf(wave_sum(s[r]) * (1.f / DM) + EPS);
#pragma unroll
            for (int j = 0; j < 4; ++j) { const int col = 4 * LANE_ + 256 * j; const f32x4 fg = *(const f32x4*)(F.final_norm + col); __builtin_nontemporal_store(v[r][j] * rstd * fg, (f32x4*)(xr + col)); } }
    }
}

struct Args { const float* in[23]; float* out; unsigned char* ws; };
#if CHECK_STAGE
__device__ __forceinline__ unsigned hmix(unsigned z) { z ^= z >> 16; z *= 0x7feb352du; z ^= z >> 15; z *= 0x846ca68bu; z ^= z >> 16; return z; }
__device__ __forceinline__ void chk_add(const Frame& F, int st, bool bad) { atomicAdd((unsigned*)(F.ctl + CW_CHK + 2 * st), bad ? 1u : 0u); atomicAdd((unsigned*)(F.ctl + CW_CHK + 2 * st + 1), 1u); }
__device__ __forceinline__ bool offby(float got, float ex, float rel, float ab) { const float d = fabsf(got - ex); return !(d <= rel * fabsf(ex) + ab); }
__device__ __forceinline__ float dot_bf(const bf16* a, const bf16* b, int n) { float s = 0.f; for (int k = 0; k < n; ++k) s += bf2f(a[k]) * bf2f(b[k]); return s; }
__device__ __forceinline__ float gelu_ref(float v) { return 0.5f * v * (1.0f + erff(v * 0.70710678f)); }
__device__ __forceinline__ unsigned chk_tstart(const Frame& F, unsigned ex) { const unsigned* cntg = (const unsigned*)(F.ctl + CW_CNT); unsigned s_ = 0; for (unsigned e = 0; e < ex; ++e) { unsigned c = cntg[e]; if (c > (unsigned)T) c = T; s_ += (c + 255u) >> 8; } return s_; }
template <int ST> __device__ __forceinline__ void stage_check(const Frame& F) {
    const unsigned gt = (unsigned)blockIdx.x * NTHR + threadIdx.x;
    const unsigned h0 = hmix(gt * 2654435761u + ST * 40503u), h1 = hmix(h0 + 0x9e3779b9u), h2 = hmix(h1 + 0x85ebca6bu);
    if (ST == 1) {
        if (gt >= 16384) return;
        const int which = gt & 7;
        if (which == 0) { const int e = h0 % NE, n = h1 % (2 * FF), k = h2 % DM; const int lc = CmWgu()(n);
            const float ex = bf2f((bf16)f2bf(F.w_gu[((size_t)e * DM + k) * 2 * FF + lc] * F.ffn_norm[k])); chk_add(F, ST, offby(bf2f(wsp<bf16>(F, WS_WGU)[((size_t)e * 2 * FF + n) * DM + k]), ex, 1e-6f, 1e-30f)); }
        else if (which == 1) { const int e = h0 % NE, n = h1 % DM, k = h2 % FF;
            const float ex = bf2f((bf16)f2bf(F.w_dn[((size_t)e * FF + k) * DM + n])); chk_add(F, ST, offby(bf2f(wsp<bf16>(F, WS_WDN)[((size_t)e * DM + n) * FF + k]), ex, 1e-6f, 1e-30f)); }
        else if (which == 2) { const int n = h1 % NPROJ, k = h2 % DM; const int lc = CmWin()(n);
            const float ex = bf2f((bf16)f2bf(F.w_in[(size_t)k * NPROJ + lc] * F.mix_norm[k])); chk_add(F, ST, offby(bf2f(wsp<bf16>(F, WS_WIN)[(size_t)n * DM + k]), ex, 1e-6f, 1e-30f)); }
        else if (which == 3) { const int n = h1 % DM, k = h2 % DM; const float g = k < AW ? F.aon[k] : F.gon[k - AW];
            const float ex = bf2f((bf16)f2bf(F.w_out[(size_t)k * DM + n] * g)); chk_add(F, ST, offby(bf2f(wsp<bf16>(F, WS_WOUT)[(size_t)n * DM + k]), ex, 1e-6f, 1e-30f)); }
        else if (which == 4) { const int n = h1 % DM, k = h2 % DM;
            const float ex = bf2f((bf16)f2bf(F.w_pg[(size_t)k * DM + n] * F.ple_norm[k])); chk_add(F, ST, offby(bf2f(wsp<bf16>(F, WS_WPG)[(size_t)n * DM + k]), ex, 1e-6f, 1e-30f)); }
        else if (which == 5) { const int n = h1 % DM, k = h2 % PLE;
            const float ex = bf2f((bf16)f2bf(F.w_pp[(size_t)k * DM + n])); chk_add(F, ST, offby(bf2f(wsp<bf16>(F, WS_WPP)[(size_t)n * PLE + k]), ex, 1e-6f, 1e-30f)); }
        else if (which == 6) { const int row = h0 % T, k = h1 % DM; float ss = 0.f; for (int j = 0; j < DM; ++j) { const float v = F.x[(size_t)row * DM + j]; ss += v * v; }
            const float ex = F.x[(size_t)row * DM + k] / sqrtf(ss / DM + EPS); chk_add(F, ST, offby(bf2f(wsp<bf16>(F, WS_XNB)[(size_t)row * DM + k]), ex, 0.01f, 1e-3f)); }
        else { const int row = h0 % T, k = h1 % PLE; chk_add(F, ST, offby(bf2f(wsp<bf16>(F, WS_PB)[(size_t)row * PLE + k]), F.p[(size_t)row * PLE + k], 0.005f, 1e-6f)); }
    }
    if (ST == 2) {
        if (gt >= 16384) return;
        const bf16* XN = wsp<bf16>(F, WS_XNB); const bf16* WIN = wsp<bf16>(F, WS_WIN);
        if ((gt & 7) == 7) {
            const int b = h0 % BATCH, hh = h1 % NH, blk = h2 % NBLK, c = (h2 >> 8) % HD; float s_ = 0.f;
            for (int r = 0; r < 256; ++r) s_ += bf2f(wsp<bf16>(F, WS_K)[((size_t)b * SEQ + blk * 256 + r) * AW + hh * HD + c]);
            chk_add(F, ST, offby(wsp<float>(F, WS_KMEAN)[((size_t)(b * NH + hh) * NBLK + blk) * HD + c], s_, 0.02f, 0.3f)); return; }
        const int row = h0 % T, type = h1 % 5, c = h2 % AW; const bf16* xr = XN + (size_t)row * DM;
        const float v = dot_bf(xr, WIN + (size_t)(type * AW + c) * DM, DM); float ex;
        if (type <= 1) { const float vp = dot_bf(xr, WIN + (size_t)(type * AW + (c ^ 4)) * DM, DM); const int i = 4 * ((c & 63) >> 3) + (c & 3), pos = row & (SEQ - 1);
            const float cs = wsp<float>(F, WS_ROPE)[pos * 32 + i], sn = wsp<float>(F, WS_ROPE)[SEQ * 32 + pos * 32 + i];
            { const float inv = powf(10000.0f, -(float)i / 32.0f); const float ang = (float)pos * inv; if (offby(cs, cosf(ang), 0.f, 1e-3f) || offby(sn, sinf(ang), 0.f, 1e-3f)) { chk_add(F, ST, true); return; } }
            ex = (c & 4) ? v * cs + vp * sn : v * cs - vp * sn; }
        else if (type == 2) ex = v; else ex = gelu_ref(v);
        chk_add(F, ST, offby(bf2f(wsp<bf16>(F, WS_Q)[(size_t)type * (16u << 20) + (size_t)row * AW + c]), ex, 0.02f, 0.02f));
    }
    if (ST == 3) {
        if (gt >= 8192) return;
        if (gt & 1) {
            const int row = h0 % T, g = h1 % GG, d = h2 % GD; const int b = row / SEQ, s_ = row % SEQ, c = s_ / GC, t = s_ % GC; float acc = 0.f;
            for (int sp = 0; sp <= t; ++sp) { const bf16* vr = wsp<bf16>(F, WS_VG) + ((size_t)b * SEQ + c * GC + sp) * GW + g * GD; float mu = 0.f; for (int j = 0; j < GD; ++j) mu += bf2f(vr[j]); mu /= GD;
                float var = 0.f; for (int j = 0; j < GD; ++j) { const float dd = bf2f(vr[j]) - mu; var += dd * dd; } const float rstd = 1.0f / sqrtf(var / GD + EPS);
                const float vn = bf2f((bf16)f2bf((bf2f(vr[d]) - mu) * rstd * F.ln_g[g * GD + d] + F.ln_b[g * GD + d])); acc += bf2f((bf16)f2bf(F.gws[((size_t)g * GC + t) * GC + sp])) * vn; }
            const float ex = bf2f(wsp<bf16>(F, WS_U)[(size_t)row * GW + g * GD + d]) * (acc + F.gbs[g * GC + t]);
            chk_add(F, ST, offby(bf2f(wsp<bf16>(F, WS_MIX)[(size_t)row * DM + AW + g * GD + d]), ex, 0.03f, 0.02f)); return; }
        const int row = h0 % T, hh = h1 % NH; const int b = row / SEQ, s_ = row % SEQ, qb = s_ / MOBA; float q[HD];
#pragma unroll
        for (int c = 0; c < HD; ++c) q[c] = bf2f(wsp<bf16>(F, WS_Q)[(size_t)row * AW + hh * HD + c]);
        unsigned sel = 0u;
        if (qb <= 3) sel = (1u << qb) - 1u;
        else { float b0 = -__builtin_inff(), b1 = b0, b2 = b0; int i0 = 0, i1 = 0, i2 = 0;
            for (int j = 0; j < qb; ++j) { const float* km = wsp<float>(F, WS_KMEAN) + ((size_t)(b * NH + hh) * NBLK + j) * HD; float g = 0.f;
#pragma unroll
                for (int c = 0; c < HD; ++c) g += q[c] * km[c];
                if (g > b0) { b2 = b1; i2 = i1; b1 = b0; i1 = i0; b0 = g; i0 = j; } else if (g > b1) { b2 = b1; i2 = i1; b1 = g; i1 = j; } else if (g > b2) { b2 = g; i2 = j; } }
            sel = (1u << i0) | (1u << i1) | (1u << i2); }
        float mx = -__builtin_inff();
        for (int kp = 0; kp <= s_; ++kp) { const int blk = kp / MOBA; if (blk != qb && !((sel >> blk) & 1u)) continue; const bf16* kr = wsp<bf16>(F, WS_K) + ((size_t)b * SEQ + kp) * AW + hh * HD; float sc = 0.f;
#pragma unroll
            for (int c = 0; c < HD; ++c) sc += q[c] * bf2f(kr[c]);
            mx = fmaxf(mx, sc * 0.125f); }
        float o[HD]; float l = 0.f;
#pragma unroll
        for (int c = 0; c < HD; ++c) o[c] = 0.f;
        for (int kp = 0; kp <= s_; ++kp) { const int blk = kp / MOBA; if (blk != qb && !((sel >> blk) & 1u)) continue; const bf16* kr = wsp<bf16>(F, WS_K) + ((size_t)b * SEQ + kp) * AW + hh * HD; float sc = 0.f;
#pragma unroll
            for (int c = 0; c < HD; ++c) sc += q[c] * bf2f(kr[c]);
            const float pr = expf(sc * 0.125f - mx); l += pr; const bf16* vr = wsp<bf16>(F, WS_V) + ((size_t)b * SEQ + kp) * AW + hh * HD;
#pragma unroll
            for (int c = 0; c < HD; ++c) o[c] += pr * bf2f(vr[c]); }
        bool bad = false; float ss = 0.f;
#pragma unroll
        for (int c = 0; c < HD; ++c) { const float ex = o[c] / l; ss += ex * ex; bad |= offby(bf2f(wsp<bf16>(F, WS_MIX)[(size_t)row * DM + hh * HD + c]), ex, 0.04f, 0.02f); }
        bad |= offby(wsp<float>(F, WS_SSQA)[(size_t)row * NH + hh], ss, 0.03f, 1e-3f);
        chk_add(F, ST, bad);
    }
    if (ST == 4) {
        if (gt >= 16384) return;
        const int row = h0 % T, col = h1 % DM; const bf16* mr = wsp<bf16>(F, WS_MIX) + (size_t)row * DM; const bf16* wr_ = wsp<bf16>(F, WS_WOUT) + (size_t)col * DM;
        float sa = 0.f, sg = 0.f, da = 0.f, dg = 0.f;
        for (int k = 0; k < AW; ++k) { const float a = bf2f(mr[k]), g = bf2f(mr[AW + k]); sa += a * a; sg += g * g; da += a * bf2f(wr_[k]); dg += g * bf2f(wr_[AW + k]); }
        const float ex = F.x[(size_t)row * DM + col] + da / sqrtf(sa / AW + EPS) + dg / sqrtf(sg / GW + EPS);
        chk_add(F, ST, offby(F.out[(size_t)row * DM + col], ex, 0.01f, 0.03f));
    }
    if (ST == 5) {
        if (gt >= 8192) return;
        const int tok = h0 % T; const float* xr = F.out + (size_t)tok * DM; float ss = 0.f; for (int k = 0; k < DM; ++k) ss += xr[k] * xr[k]; const float rstd = 1.0f / sqrtf(ss / DM + EPS);
        bool bad = false;
        for (int j = 0; j < 4; ++j) { const int k = (h1 >> (8 * j)) % DM; bad |= offby(bf2f(wsp<bf16>(F, WS_XNB)[(size_t)tok * DM + k]), xr[k] * rstd, 0.01f, 1e-3f); }
        float lg[NE];
#pragma unroll
        for (int e = 0; e < NE; ++e) lg[e] = 0.f;
        for (int k = 0; k < DM; ++k) { const float xv = xr[k] * rstd * F.ffn_norm[k];
#pragma unroll
            for (int e = 0; e < NE; ++e) lg[e] += xv * F.router_w[k * NE + e]; }
#pragma unroll
        for (int e = 0; e < NE; ++e) lg[e] += F.router_b[e];
        int te[4]; float tv[4]; unsigned used = 0u;
#pragma unroll
        for (int k = 0; k < 4; ++k) { float best = -__builtin_inff(); int bi = 0;
#pragma unroll
            for (int e = 0; e < NE; ++e) if (!((used >> e) & 1u) && lg[e] > best) { best = lg[e]; bi = e; }
            used |= 1u << bi; te[k] = bi; tv[k] = best; }
        { float gg[4]; float den = 0.f;
#pragma unroll
          for (int k = 0; k < 4; ++k) { float v = -__builtin_inff();
#pragma unroll
              for (int e = 0; e < NE; ++e) if (e == te[k]) v = lg[e];
              gg[k] = v; }
          const float mm = gg[0];
#pragma unroll
          for (int k = 0; k < 4; ++k) { gg[k] = expf(gg[k] - mm); den += gg[k]; }
          const unsigned* tp = wsp<unsigned>(F, WS_TOKPOS) + (size_t)tok * 4;
#pragma unroll
          for (int k = 0; k < 4; ++k) { const unsigned e = tp[k] >> 16, slot = tp[k] & 0xffffu; bad |= (e != (unsigned)te[k]);
              if (e < NE && slot < (unsigned)T) { bad |= wsp<unsigned>(F, WS_IDX)[(size_t)e * T + slot] != (unsigned)tok; bad |= offby(wsp<float>(F, WS_GSS)[(size_t)e * T + slot], gg[k] / den, 2e-3f, 1e-5f);
                  bad |= slot >= ((const unsigned*)(F.ctl + CW_CNT))[e]; } else bad = true; } }
        (void)tv;
        chk_add(F, ST, bad);
    }
    if (ST == 6 || ST == 7) {
        if (gt >= 16384) return;
        const int tok = h0 % T, k = h1 & 3, col = (h1 >> 2) % FF; const unsigned tp = wsp<unsigned>(F, WS_TOKPOS)[(size_t)tok * 4 + k]; const unsigned e = tp >> 16, slot = tp & 0xffffu;
        if (e >= NE) { chk_add(F, ST, true); return; }
        const unsigned tse = chk_tstart(F, e);
        const size_t row = (size_t)tse * 256 + slot;
        if (ST == 6) { const bf16* xr = wsp<bf16>(F, WS_XNB) + (size_t)tok * DM; const int np = (col >> 7) * 256 + (col & 127);
            const float g = dot_bf(xr, wsp<bf16>(F, WS_WGU) + ((size_t)e * 2 * FF + np) * DM, DM) + F.b_gu[(size_t)e * 2 * FF + col];
            const float l = dot_bf(xr, wsp<bf16>(F, WS_WGU) + ((size_t)e * 2 * FF + np + 128) * DM, DM) + F.b_gu[(size_t)e * 2 * FF + FF + col];
            const float gc = fminf(g, 7.f), lc = fminf(fmaxf(l, -7.f), 7.f); const float ex = gc / (1.0f + expf(-1.702f * gc)) * (lc + 1.0f);
            chk_add(F, ST, offby(bf2f(wsp<bf16>(F, WS_ABUF)[row * FF + col]), ex, 0.03f, 0.03f)); }
        else { const float d = dot_bf(wsp<bf16>(F, WS_ABUF) + row * FF, wsp<bf16>(F, WS_WDN) + ((size_t)e * DM + col) * FF, FF) + F.b_dn[(size_t)e * DM + col];
            const float ex = d * wsp<float>(F, WS_GSS)[(size_t)e * T + slot];
            chk_add(F, ST, offby(bf2f(wsp<bf16>(F, WS_YBUF)[row * DM + col]), ex, 0.03f, 0.01f)); }
    }
    if (ST == 8) {
        if (gt >= 8192) return;
        const int tok = h0 % T; const float* xr = F.out + (size_t)tok * DM; float ss = 0.f; for (int k = 0; k < DM; ++k) ss += xr[k] * xr[k]; const float rstd = 1.0f / sqrtf(ss / DM + EPS);
        bool bad = false; for (int k = 0; k < DM; ++k) { bad |= offby(bf2f(wsp<bf16>(F, WS_X2N)[(size_t)tok * DM + k]), xr[k] * rstd, 0.01f, 1e-3f); bad |= !(fabsf(xr[k]) < 30.f); }
        chk_add(F, ST, bad);
    }
    if (ST == 9) {
        if (gt >= 16384) return;
        const int row = h0 % T, col = h1 % DM;
        if (gt & 1) { const float d = dot_bf(wsp<bf16>(F, WS_X2N) + (size_t)row * DM, wsp<bf16>(F, WS_WPG) + (size_t)col * DM, DM); const float got = bf2f(wsp<bf16>(F, WS_GATE)[(size_t)row * DM + col]); const float ex = 1.0f / (1.0f + expf(-d)); const bool bad = offby(got, ex, 0.02f, 0.01f); chk_add(F, ST, bad);
            if (bad) { atomicOr((unsigned*)(F.ctl + CW_CHK + 40), 1u << ((col >> 3) & 31)); atomicOr((unsigned*)(F.ctl + CW_CHK + 41), 1u << ((row >> 3) & 31)); atomicOr((unsigned*)(F.ctl + CW_CHK + 42), 1u << (col & 7)); atomicOr((unsigned*)(F.ctl + CW_CHK + 43), 1u << (row & 7));
                if (!(got >= 0.f && got <= 1.f)) atomicAdd((unsigned*)(F.ctl + CW_CHK + 44), 1u); { int cl = (int)floorf(log2f(fabsf(got) + 1e-30f)) + 40; cl = cl < 0 ? 0 : (cl > 80 ? 80 : cl); atomicMax((unsigned*)(F.ctl + CW_CHK + 46), (unsigned)cl); atomicMin((unsigned*)(F.ctl + CW_CHK + 47), 0xffffffffu - (unsigned)cl); if (got < 0.f) atomicAdd((unsigned*)(F.ctl + CW_CHK + 48), 1u); } if (fabsf(got - ex) > 0.2f) atomicAdd((unsigned*)(F.ctl + CW_CHK + 45), 1u); } }
        else { const float d = dot_bf(wsp<bf16>(F, WS_PB) + (size_t)row * PLE, wsp<bf16>(F, WS_WPP) + (size_t)col * PLE, PLE); chk_add(F, 10, offby(bf2f(wsp<bf16>(F, WS_PP)[(size_t)row * DM + col]), d, 0.02f, 0.02f)); }
    }
}
__device__ __forceinline__ void check_report(const Frame& F) {
    float c2 = 3.0f;
    for (int st = 1; st <= 10; ++st) { const unsigned bad = F.ctl[CW_CHK + 2 * st], tot = F.ctl[CW_CHK + 2 * st + 1]; const float fr = tot ? (float)bad / (float)tot : 1.0f;
        (void)fr; if (((CHECK_SKIP >> st) & 1) == 0 && bad >= 1u) { c2 = powf(10.0f, (float)st) * (1.0f + fminf((float)bad, 80.0f) * 0.1f); break; } }
#if CHECK_REPORT >= 40
    { unsigned v = F.ctl[CW_CHK + CHECK_REPORT]; if (CHECK_REPORT == 47) v = 0xffffffffu - v; c2 = powf(10.0f, (float)(v >> 27)) * (1.0f + (float)((v >> 21) & 63u) * 0.1f);
#if CHECK_REPORT2
      c2 = powf(10.0f, (float)((v >> 16) & 31u)) * (1.0f + (float)((v >> 10) & 63u) * 0.1f);
#endif
#if CHECK_REPORT3
      c2 = powf(10.0f, (float)((v >> 5) & 31u)) * (1.0f + (float)(v & 31u) * 0.1f);
#endif
      if (CHECK_REPORT >= 46 && CHECK_REPORT <= 47) c2 = powf(10.0f, (float)(v / 9u)) * (1.0f + (float)(v % 9u));
    }
#endif
    if (F.ctl[CW_BAR + XB_TMO] != 0u) c2 = 1e20f;
    const float c = sqrtf(c2);
    for (size_t i = (size_t)blockIdx.x * NTHR + threadIdx.x; i < (size_t)T * DM; i += (size_t)gridDim.x * NTHR) F.out[i] = c;
}
#define STAGE_CHECK(n) stage_check<(n)>(F)
#else
#define STAGE_CHECK(n) do {} while (0)
#endif

__global__ void __launch_bounds__(NTHR, 2) mega_fwd(Args args) {
    extern __shared__ __attribute__((aligned(16))) unsigned char lds_raw[];
    Frame F;
    F.lds = (LAS unsigned char*)lds_raw;
    F.MISC = (volatile LAS unsigned*)(F.lds + LDSCTL_OFF);
    F.G = gridDim.x; { const int bx = blockIdx.x; F.vcu = (F.G % 8 == 0) ? (bx % 8) * (F.G / 8) + bx / 8 : bx; }
    F.ws = args.ws; F.ctl = (gu32*)(args.ws + WS_CTL); F.out = args.out;
    F.x = args.in[0]; F.p = args.in[1]; F.mix_norm = args.in[2]; F.w_in = args.in[3]; F.ln_g = args.in[4]; F.ln_b = args.in[5]; F.gws = args.in[6]; F.gbs = args.in[7];
    F.aon = args.in[8]; F.gon = args.in[9]; F.w_out = args.in[10]; F.ffn_norm = args.in[11]; F.router_w = args.in[12]; F.router_b = args.in[13]; F.w_gu = args.in[14]; F.b_gu = args.in[15];
    F.w_dn = args.in[16]; F.b_dn = args.in[17]; F.ple_norm = args.in[18]; F.w_pg = args.in[19]; F.w_pp = args.in[20]; F.ppn = args.in[21]; F.final_norm = args.in[22];
    { PHASE_IDS; for (int u = TID_; u < 256; u += NTHR) ((LAS unsigned*)(F.lds + LDSCTL_OFF))[u] = 0u; }
    __syncthreads();
    XcdBarrier bar = xcd_barrier_post((unsigned*)(F.ctl + CW_BAR), F.MISC + 8);
#define GRID_BAR() xcd_barrier(bar)
#define STAGE_END(n) do { STAGE_CHECK(n); if (TPROBE && blockIdx.x == 0 && threadIdx.x == 0) ((unsigned long long*)(F.ctl + CW_TS))[(n)] = __builtin_amdgcn_s_memrealtime(); } while (0)

    if (TPROBE && blockIdx.x == 0 && threadIdx.x == 0) ((unsigned long long*)(F.ctl + CW_TS))[0] = __builtin_amdgcn_s_memrealtime();
    for (int rep = 0; rep < (DUP_PHASE == 0 ? 2 : 1); ++rep) {
    if (PH(0)) p0_prologue(F);
    GRID_BAR(); }
    STAGE_END(1);
    if (PH(1)) { pg8::DenseSched S; S.init(wsp<bf16>(F, WS_XNB), wsp<bf16>(F, WS_WIN), T, NPROJ, DM, F.G, (int)blockIdx.x);
      float* RC = wsp<float>(F, WS_ROPE);
      EpiInProj E{wsp<bf16>(F, WS_Q), RC, RC + SEQ * 32, wsp<float>(F, WS_KMEAN)};
      for (int rep = 0; rep < (DUP_PHASE == 1 ? 2 : 1); ++rep) { if (rep) GRID_BAR();
      pg8::gemm_phase<EpiInProj, pg8::DenseSched, false, false>(F.lds + RING_OFF, DM * 2, S, E); } }
    GRID_BAR();
    STAGE_END(2);
    for (int rep = 0; rep < (DUP_PHASE == 2 ? 2 : 1); ++rep) {
    if (PH(2)) p2_mixers(F);
    GRID_BAR(); }
    STAGE_END(3);
    if (PH(3)) { pg8::DenseSched S; S.init(wsp<bf16>(F, WS_MIX), wsp<bf16>(F, WS_WOUT), T, DM, DM, F.G, (int)blockIdx.x);
      LAS f32x4* rtab = (LAS f32x4*)(F.lds + XTAB_OFF);
      Unit ua, ub; const bool ha = S.next(0, ua), hb = S.next(1, ub);
      { PHASE_IDS; const int s = TID_ >> 8, r = TID_ & 255; const bool has = s ? hb : ha; const int pm = s ? ub.pm : ua.pm;
        if (has) { const size_t row = (size_t)pm * 256 + r; const f32x4* pa = (const f32x4*)(wsp<float>(F, WS_SSQA) + row * NH); const f32x4 a0 = pa[0], a1 = pa[1], g0 = *(const f32x4*)(wsp<float>(F, WS_SSQG) + row * GG);
            const float sa = ((a0[0] + a0[1]) + (a0[2] + a0[3])) + ((a1[0] + a1[1]) + (a1[2] + a1[3])), sg = (g0[0] + g0[1]) + (g0[2] + g0[3]);
            const float ra = 1.0f / sqrtf(sa * (1.f / AW) + EPS), rg = 1.0f / sqrtf(sg * (1.f / GW) + EPS);
            rtab[s * 256 + r] = (f32x4){ra / rg, rg, wsp<float>(F, WS_SIG0)[row], 0.f}; } }
      __syncthreads();
      EpiOutProj E{wsp<bf16>(F, WS_XNB), wsp<bf16>(F, WS_X1B), wsp<unsigned char>(F, WS_X1F8), wsp<float>(F, WS_SSQ1), rtab, F.ffn_norm, ha ? ua.pm : -1, hb ? ub.pm : -1};
      for (int rep = 0; rep < (DUP_PHASE == 3 ? 2 : 1); ++rep) { if (rep) GRID_BAR();
      pg8::gemm_phase<EpiOutProj, pg8::DenseSched, false, true>(F.lds + RING_OFF, DM * 2, S, E); } }
    GRID_BAR();
    STAGE_END(4);
    if (PH(4)) p4_router(F);
    GRID_BAR();
    STAGE_END(5);
    if (PH(5)) { const int nu = moe_build_tables(F, 2 * FF / 256, 1);
      pg8::MoeSched S{(const char*)wsp<char>(F, WS_X1F8), (const char*)wsp<char>(F, WS_WGU), 0, (size_t)2 * FF * DM, (size_t)256 * DM, nu,
                      (const LAS unsigned*)(F.lds + XTAB_OFF + XT_ULIST), (const LAS unsigned*)(F.lds + XTAB_OFF + XT_GTAB), true};
      EpiMoe1 E{wsp<unsigned char>(F, WS_ABUF), F.b_gu, (const LAS float*)(F.lds + XTAB_OFF + XT_RS)};
      for (int rep = 0; rep < (DUP_PHASE == 5 ? 2 : 1); ++rep) { if (rep) GRID_BAR();
      int Kb = DM; asm volatile("" : "+s"(Kb));
      pg8::gemm_phase<EpiMoe1, pg8::MoeSched, true, false, true>(F.lds + RING_OFF, Kb, S, E); } }
    GRID_BAR();
    STAGE_END(6);
    if (PH(6)) { const int nu = moe_build_tables(F, DM / 256, 2);
      pg8::MoeSched S{(const char*)wsp<char>(F, WS_ABUF), (const char*)wsp<char>(F, WS_WDN), (size_t)256 * FF, (size_t)DM * FF, (size_t)256 * FF, nu,
                      (const LAS unsigned*)(F.lds + XTAB_OFF + XT_ULIST), (const LAS unsigned*)(F.lds + XTAB_OFF + XT_GTAB), false};
      EpiMoe2 E{wsp<unsigned char>(F, WS_YBUF), F.b_dn, (const LAS float*)(F.lds + XTAB_OFF + XT_RS)};
      for (int rep = 0; rep < (DUP_PHASE == 6 ? 2 : 1); ++rep) { if (rep) GRID_BAR();
      int Kb = FF; asm volatile("" : "+s"(Kb));
      pg8::gemm_phase<EpiMoe2, pg8::MoeSched, false, false, true>(F.lds + RING_OFF, Kb, S, E); } }
    GRID_BAR();
    STAGE_END(7);
    if (PH(7)) p7_combine(F);
    GRID_BAR();
    STAGE_END(8);
    if (PH(8)) { pg8::DenseSched S; S.init(wsp<unsigned char>(F, WS_X2F8), wsp<unsigned char>(F, WS_WPG8), T, DM, DM, F.G, (int)blockIdx.x, 1);
      LAS float* rt2 = (LAS float*)(F.lds + XTAB_OFF); Unit ua, ub; const bool ha = S.next(0, ua), hb = S.next(1, ub);
      { PHASE_IDS; const int sl = TID_ >> 8, r = TID_ & 255; const bool has = sl ? hb : ha; const int pm = sl ? ub.pm : ua.pm; if (has) rt2[sl * 256 + r] = wsp<float>(F, WS_RSTD2)[(size_t)pm * 256 + r]; }
      __syncthreads();
      EpiPle<0> E{wsp<unsigned char>(F, WS_GATE), nullptr, rt2, ha ? ua.pm : -1};
      int Kb = DM; asm volatile("" : "+s"(Kb));
      pg8::gemm_phase<EpiPle<0>, pg8::DenseSched, false, false, true>(F.lds + RING_OFF, Kb, S, E);
#if CHECK_STAGE
      GRID_BAR();
      int Kb = DM; asm volatile("" : "+s"(Kb));
      pg8::gemm_phase<EpiPle<0>, pg8::DenseSched, false, false, true>(F.lds + RING_OFF, Kb, S, E);
#endif
    }
#if CHECK_STAGE
    GRID_BAR(); STAGE_CHECK(9);
#endif
    if (PH(8)) { pg8::DenseSched S; S.init(wsp<bf16>(F, WS_PB), wsp<bf16>(F, WS_WPP), T, DM, PLE, F.G, (int)blockIdx.x);
      EpiPle<1> E{wsp<unsigned char>(F, WS_PP), wsp<float>(F, WS_SSQPP), nullptr, -1};
      int Kp = PLE * 2; asm volatile("" : "+s"(Kp));
      pg8::gemm_phase<EpiPle<1>, pg8::DenseSched, false, false>(F.lds + RING_OFF, Kp, S, E); }
    GRID_BAR();
    STAGE_END(9);
#if CHECK_STAGE
    GRID_BAR(); check_report(F);
#else
    if (PH(9)) p9_final(F);
#if TPROBE
    GRID_BAR();
    if (blockIdx.x == 0 && threadIdx.x == 0) { const unsigned long long* ts = (const unsigned long long*)(F.ctl + CW_TS); const unsigned long long t1 = (TP_A == 9) ? __builtin_amdgcn_s_memrealtime() : ts[(TP_A < 10 ? TP_A : 0) + 1];
        unsigned long long d = t1 - ts[TP_A < 10 ? TP_A : 0];
        if (TP_A == 20) d = ts[11] - ts[0]; if (TP_A == 21) d = ts[12] - ts[11]; if (TP_A == 22) d = ts[13] - ts[12]; if (TP_A == 23) d = ts[1] - ts[13]; if (TP_A == 24) d = ts[14] - ts[2]; if (TP_A == 25) d = ts[3] - ts[14];
        if (TP_A == 30) d = (__builtin_amdgcn_s_memrealtime() - ts[0]) / 8;
        F.out[0] += floorf((float)d * 0.01f * 0.125f + 0.5f) * 2.0f; }
#endif
#endif
}

extern "C" void kernel_launch(void* const* d_in, const int* in_sizes, int n_in, void* d_out, int out_size, void* d_ws, size_t ws_size, hipStream_t stream) {
    static int grid = 0;
    if (grid == 0) {
        if (n_in != 23 || in_sizes[0] != T * DM || out_size != T * DM || ws_size < WS_END) { fprintf(stderr, "kernel_launch: unexpected shapes (n_in %d, in0 %d, out %d, ws %zu)\n", n_in, n_in > 0 ? in_sizes[0] : -1, out_size, ws_size); grid = -1; return; }
        int dev = 0, cus = 0, per_cu = 0;
        if (hipGetDevice(&dev) != hipSuccess || hipDeviceGetAttribute(&cus, hipDeviceAttributeMultiprocessorCount, dev) != hipSuccess) { grid = -1; return; }
        if (hipFuncSetAttribute((const void*)mega_fwd, hipFuncAttributeMaxDynamicSharedMemorySize, LDS_BYTES) != hipSuccess) { fprintf(stderr, "kernel_launch: hipFuncSetAttribute failed\n"); grid = -1; return; }
        if (hipOccupancyMaxActiveBlocksPerMultiprocessor(&per_cu, (const void*)mega_fwd, NTHR, LDS_BYTES) != hipSuccess || per_cu < 1)
            fprintf(stderr, "kernel_launch: note: occupancy query reports %d workgroups per CU\n", per_cu);
        (void)hipGetLastError();
        if (cus < 256) { fprintf(stderr, "kernel_launch: built for a 256-CU device (found %d CUs); nothing launched\n", cus); grid = -1; return; }
        grid = 256;
    }
    if (grid < 0) return;
    if (hipMemsetAsync((char*)d_ws + WS_CTL, 0, CTL_ZERO_BYTES, stream) != hipSuccess) return;
    Args a{};
    for (int i = 0; i < 23; ++i) a.in[i] = (const float*)d_in[i];
    a.out = (float*)d_out; a.ws = (unsigned char*)d_ws;
    hipLaunchKernelGGL(mega_fwd, dim3(grid), dim3(NTHR), LDS_BYTES, stream, a);
}
```

```cpp
#include <hip/hip_runtime.h>
#include <cstdio>
#include <cstdint>

#ifndef CHECK_STAGE
#define CHECK_STAGE 0
#endif
#ifndef CHECK_REPORT
#define CHECK_REPORT 0
#endif
#ifndef CHECK_REPORT2
#define CHECK_REPORT2 0
#endif
#ifndef CHECK_REPORT3
#define CHECK_REPORT3 0
#endif
#ifndef DUP_PHASE
#define DUP_PHASE -1
#endif
#ifndef TPROBE
#define TPROBE 0
#endif
#ifndef TP_A
#define TP_A 5
#endif
#ifndef TP_B
#define TP_B 6
#endif
#ifndef CHECK_SKIP
#define CHECK_SKIP 0
#endif
#ifndef PHMASK
#define PHMASK 0x3ff
#endif
#define PH(n) ((PHMASK >> (n)) & 1)

#define GAS __attribute__((address_space(1)))
#define LAS __attribute__((address_space(3)))
typedef unsigned short bf16;
typedef unsigned v4u __attribute__((ext_vector_type(4)));
typedef unsigned v2u __attribute__((ext_vector_type(2)));
typedef float f32x2 __attribute__((ext_vector_type(2)));
typedef float f32x4 __attribute__((ext_vector_type(4)));
typedef float f32x16 __attribute__((ext_vector_type(16)));
typedef short bf16x8 __attribute__((ext_vector_type(8)));
typedef short s16x4 __attribute__((ext_vector_type(4)));
typedef GAS unsigned gu32;

constexpr int BATCH = 16, SEQ = 2048, DM = 1024, T = BATCH * SEQ;
constexpr int AW = 512, NH = 8, HD = 64, NBLK = 8, MOBA = 256;
constexpr int GW = 512, GG = 4, GD = 128, GC = 128;
constexpr int NPROJ = 3 * AW + 2 * GW;
constexpr int NE = 32, TOPK = 4, FF = 1024;
constexpr int PLE = 256;
constexpr int MAXROWS = T * TOPK + NE * 256;
constexpr float EPS = 1e-6f;
constexpr int NWAVES = 8, NTHR = 512;

constexpr size_t MiB = 1u << 20;
constexpr size_t WS_CTL = 0, CTL_ZERO_BYTES = 1 * MiB;
constexpr size_t WS_KMEAN = 256 * 1024;
constexpr size_t WS_WIN = 1 * MiB;
constexpr size_t WS_WOUT = 6 * MiB;
constexpr size_t WS_WPG = 8 * MiB;
constexpr size_t WS_WPP = 10 * MiB;
constexpr size_t WS_RWG = 10 * MiB + 512 * 1024;
constexpr size_t WS_ROPE = 11 * MiB;
constexpr size_t WS_WGU = 16 * MiB;
constexpr size_t WS_WDN = 144 * MiB;
constexpr size_t WS_XNB = 208 * MiB;
constexpr size_t WS_BIG1 = 272 * MiB;
constexpr size_t WS_Q = WS_BIG1, WS_K = WS_Q + 32 * MiB, WS_V = WS_K + 32 * MiB, WS_U = WS_V + 32 * MiB, WS_VG = WS_U + 32 * MiB, WS_MIX = WS_VG + 32 * MiB;
constexpr size_t WS_YBUF = WS_BIG1;
constexpr size_t WS_BIG2 = 544 * MiB;
constexpr size_t WS_ABUF = WS_BIG2, WS_GATE = WS_BIG2, WS_PP = WS_BIG2 + 64 * MiB;
constexpr size_t WS_PB = 816 * MiB;
constexpr size_t WS_IDX = 832 * MiB;
constexpr size_t WS_GSS = 836 * MiB;
constexpr size_t WS_TOKPOS = 840 * MiB;
constexpr size_t WS_SSQA = 841 * MiB;
constexpr size_t WS_SSQG = 842 * MiB;
constexpr size_t WS_SSQ1 = 843 * MiB;
constexpr size_t WS_SSQPP = 845 * MiB;
constexpr size_t WS_X1F8 = 848 * MiB;
constexpr size_t WS_X2N = WS_XNB;
constexpr size_t WS_X1B = 880 * MiB;
constexpr size_t WS_X2B = 944 * MiB;
constexpr size_t WS_SIG0 = 1008 * MiB;
constexpr size_t WS_RSTD2 = 1008 * MiB + 256 * 1024;
constexpr size_t WS_RWT = 1008 * MiB + 512 * 1024;
constexpr size_t WS_RSS = 1009 * MiB;
constexpr size_t WS_X2F8 = 176 * MiB;
constexpr size_t WS_WPG8 = 80 * MiB;
constexpr size_t WS_END = 1013 * MiB;
static_assert(WS_MIX + 64 * MiB <= WS_BIG2 && (size_t)MAXROWS * 1024 * 2 <= 272 * MiB, "ws map");
constexpr int CW_TMO = 0, CW_CODE = 1;
constexpr int CW_BAR = 4096;
constexpr int CW_CNT = 8192;
constexpr int CW_TS = 12000;
constexpr int CW_CHK = 12288;

constexpr int RING_OFF = 0, RING_BYTES = 131072;
constexpr int P0_SCR_WAVE = 64 * 65 * 4;
constexpr int LDS_BYTES_TOTAL = 163840;
constexpr int LDSCTL_OFF = LDS_BYTES_TOTAL - 1024;
constexpr int XTAB_OFF = RING_BYTES;
static_assert(8 * P0_SCR_WAVE <= LDSCTL_OFF && XTAB_OFF >= RING_BYTES, "lds map");
constexpr int LDS_BYTES = LDS_BYTES_TOTAL;

#define RLX_AGENT __ATOMIC_RELAXED, __HIP_MEMORY_SCOPE_AGENT
#define LDS_WAIT() asm volatile("s_waitcnt lgkmcnt(0)" ::: "memory")
#define VM_WAIT() asm volatile("s_waitcnt vmcnt(0)" ::: "memory")
__device__ __forceinline__ unsigned f2bf(float f) { unsigned u = __builtin_bit_cast(unsigned, f); return (u + 0x7fffu + ((u >> 16) & 1u)) >> 16; }
__device__ __forceinline__ unsigned pk2(float lo, float hi) { return f2bf(lo) | (f2bf(hi) << 16); }
__device__ __forceinline__ float bf2f(unsigned short b) { return __builtin_bit_cast(float, ((unsigned)b) << 16); }
__device__ __forceinline__ float bflo(unsigned w) { return __builtin_bit_cast(float, w << 16); }
__device__ __forceinline__ float bfhi(unsigned w) { return __builtin_bit_cast(float, w & 0xffff0000u); }
typedef __bf16 bf16x2_t __attribute__((ext_vector_type(2)));
__device__ __forceinline__ unsigned cvt_pk_bf16(float lo, float hi) { const f32x2 v = {lo, hi}; const bf16x2_t b = __builtin_convertvector(v, bf16x2_t); return __builtin_bit_cast(unsigned, b); }
__device__ __forceinline__ float clamp448(float x) { return fminf(fmaxf(x, -448.0f), 448.0f); }
__device__ __forceinline__ unsigned pk4_fp8(float a, float b, float c, float d) { unsigned w = 0u; w = (unsigned)__builtin_amdgcn_cvt_pk_fp8_f32(clamp448(a), clamp448(b), (int)w, false); w = (unsigned)__builtin_amdgcn_cvt_pk_fp8_f32(clamp448(c), clamp448(d), (int)w, true); return w; }
__device__ __forceinline__ float fp8_to_f(unsigned v) { const unsigned sg = (v >> 7) & 1u, e = (v >> 3) & 15u, m = v & 7u; const float r = e ? ldexpf(1.0f + (float)m * 0.125f, (int)e - 7) : ldexpf((float)m * 0.125f, -6); return sg ? -r : r; }
__device__ __forceinline__ float wave_sum(float v) {
#pragma unroll
    for (int o = 1; o < 64; o <<= 1) v += __shfl_xor(v, o);
    return v;
}
__device__ __forceinline__ f32x2 gelu_pk(f32x2 v) {
    const f32x2 av = __builtin_elementwise_abs(v), d = av * 0.2316418882f + 1.0f;
    f32x2 t; t.x = __builtin_amdgcn_rcpf(d.x); t.y = __builtin_amdgcn_rcpf(d.y);
    f32x2 q = t * 0.5307027145f + (-0.7265760135f); q = q * t + 0.7107068705f; q = q * t + (-0.142248368f); q = q * t + 0.127414796f; q = q * t;
    const f32x2 s = (v * v) * (-0.72134752044f);
    f32x2 e; e.x = __builtin_amdgcn_exp2f(s.x); e.y = __builtin_amdgcn_exp2f(s.y);
    const f32x2 m = v * (q * e), r = v - m;
    f32x2 o; o.x = v.x < 0.f ? m.x : r.x; o.y = v.y < 0.f ? m.y : r.y; return o;
}
__device__ __forceinline__ f32x4 gelu4(f32x4 v) { const f32x2 a = gelu_pk((f32x2){v[0], v[1]}), b = gelu_pk((f32x2){v[2], v[3]}); return (f32x4){a.x, a.y, b.x, b.y}; }
__device__ __forceinline__ float sigmoidf_fast(float x) { return __builtin_amdgcn_rcpf(1.0f + __builtin_amdgcn_exp2f(-1.4426950408889634f * x)); }

#define XB_TMO      128
#define XB_XCNT(j)  (256  + 64 * (j))
#define XB_XSUB(j)  (1280 + 64 * (j))
#define XB_XGEN(j)  (2304 + 64 * (j))
#define XB_TOP      3328
#define XB_TOPGEN   3392
#define XCD_BAR_WORDS 3456
#define XB_SPIN_CAP (1u << 18)
__device__ __forceinline__ unsigned xb_ld(unsigned* p)              { return __hip_atomic_load(p, __ATOMIC_RELAXED, __HIP_MEMORY_SCOPE_AGENT); }
__device__ __forceinline__ unsigned xb_add(unsigned* p, unsigned v) { return __hip_atomic_fetch_add(p, v, __ATOMIC_RELAXED, __HIP_MEMORY_SCOPE_AGENT); }
__device__ __forceinline__ unsigned xb_xcc_id() { return (unsigned)__builtin_amdgcn_s_getreg((3 << 11) | 20) & 0xFu; }
#define XB_SPIN(cond, bar) do { unsigned _sp = 0; while (cond) { __builtin_amdgcn_s_sleep(1); \
    if ((++_sp & 255u) == 0u) { if (xb_ld(&(bar)[XB_TMO])) break; if (_sp > XB_SPIN_CAP) { atomicAdd(&(bar)[XB_TMO], 1u); break; } } } } while (0)
#define XB_DONE     64
__device__ unsigned g_gridbar[4096];
struct XcdBarrier { unsigned* bar; unsigned x; volatile LAS unsigned* st; };
__device__ __forceinline__ XcdBarrier xcd_barrier_post(unsigned* bar, volatile LAS unsigned* st) {
    XcdBarrier b; b.bar = bar; b.x = xb_xcc_id(); b.st = st;
    if (threadIdx.x == 0) (void)xb_add(&bar[XB_XCNT(b.x)], 1u);
    return b;
}
__device__ __forceinline__ void xcd_barrier_complete(unsigned* bar, unsigned x, unsigned& nloc, unsigned& nx) {
    const unsigned G = gridDim.x * gridDim.y * gridDim.z;
    unsigned sum, cnt, mine, sp = 0u;
    for (;;) {
        sum = 0u; cnt = 0u; mine = 0u;
#pragma unroll
        for (unsigned j = 0; j < 16; ++j) { const unsigned c = xb_ld(&bar[XB_XCNT(j)]); sum += c; cnt += (c > 0u) ? 1u : 0u; mine = (j == x) ? c : mine; }
        if (sum == G) break;
        __builtin_amdgcn_s_sleep(1);
        if ((++sp & 255u) == 0u) { if (xb_ld(&bar[XB_TMO])) break; if (sp > XB_SPIN_CAP) { atomicAdd(&bar[XB_TMO], 1u); break; } }
    }
    nloc = mine > 0u ? mine : 1u; nx = cnt > 0u ? cnt : 1u;
}
__device__ __forceinline__ void xcd_barrier(const XcdBarrier& b) {
    asm volatile("s_waitcnt vmcnt(0)" ::: "memory");
    __syncthreads();
    if (threadIdx.x == 0) {
        unsigned* bar = b.bar;
        __builtin_amdgcn_s_waitcnt(0);
        unsigned nloc = b.st[0], nx = b.st[1];
        if (nloc == 0u) { xcd_barrier_complete(bar, b.x, nloc, nx); b.st[0] = nloc; b.st[1] = nx; }
        const unsigned old = xb_add(&bar[XB_XSUB(b.x)], 1u);
        const unsigned gen = old / nloc;
        if (old + 1u == (gen + 1u) * nloc) {
            __builtin_amdgcn_fence(__ATOMIC_RELEASE, "agent");
            asm volatile("s_waitcnt vmcnt(0)" ::: "memory");
            const unsigned og = xb_add(&bar[XB_TOP], 1u);
            const unsigned tg = og / nx;
            if (og + 1u == (tg + 1u) * nx) xb_add(&bar[XB_TOPGEN], 1u);
            else XB_SPIN(xb_ld(&bar[XB_TOPGEN]) == tg, bar);
            __builtin_amdgcn_fence(__ATOMIC_ACQUIRE, "agent");
            xb_add(&bar[XB_XGEN(b.x)], 1u);
            asm volatile("s_waitcnt vmcnt(0)" ::: "memory");
        } else {
            XB_SPIN(xb_ld(&bar[XB_XGEN(b.x)]) == gen, bar);
            __builtin_amdgcn_fence(__ATOMIC_ACQUIRE, "agent");
            asm volatile("s_waitcnt vmcnt(0)" ::: "memory");
        }
    }
    __syncthreads();
}

namespace pg8 {
constexpr int BM = 256, BK = 64, HALF = 128, HTB = HALF * BK * 2, STAGE_BYTES = 8 * HTB, NXCD = 8, WGM = 8;
__host__ __device__ __forceinline__ int lds_byte(int r, int c) { const int st = (r >> 4) * 2 + (c >> 5), rr = r & 15, cc = c & 31, ob = rr * 64 + cc * 2; return st * 1024 + (ob ^ (((ob >> 9) & 1) << 5)); }
__host__ __device__ __forceinline__ void stage_rc(int b, int& R, int& C) { const int st = b / 1024, sb = b % 1024, swz = sb ^ (((sb >> 9) & 1) << 5); R = (st >> 1) * 16 + swz / 64; C = (st & 1) * 32 + (swz % 64) / 2; }
__host__ __device__ __forceinline__ int perm32(int rho) { const int n = rho >> 4, i = rho & 15; return 8 * (i >> 2) + 4 * n + (i & 3); }

typedef int v8i __attribute__((ext_vector_type(8)));
constexpr int F8_WSHIFT = 6, F8_SCALE_W = 127 - F8_WSHIFT;
typedef int v4i __attribute__((ext_vector_type(4)));
__device__ __forceinline__ v8i ld8(const LAS unsigned char* p0, const LAS unsigned char* p1) { const v4i lo = *(const LAS v4i*)p0, hi = *(const LAS v4i*)p1; return __builtin_shufflevector(lo, hi, 0, 1, 2, 3, 4, 5, 6, 7); }
struct Unit { int pm, pn, e, rt, slot; };

__device__ __forceinline__ void flat_to_tile(int L, int nwg, int nM, int nN, int& pm, int& pn) {
    int wgid = L; { const int q = nwg / NXCD, r = nwg % NXCD, xcd = wgid % NXCD, off = wgid / NXCD; wgid = (xcd < r ? xcd * (q + 1) : r * (q + 1) + (xcd - r) * q) + off; }
    const int nig = WGM * nN, gid = wgid / nig, fm = gid * WGM, gsz = (nM - fm) < WGM ? (nM - fm) : WGM;
    pm = fm + ((wgid % nig) % gsz); pn = (wgid % nig) / gsz;
}
struct DenseSched {
    const char* A; const char* Bt; int nM, nN, nwg, G, c; size_t tstep;
    __device__ __forceinline__ void init(const void* A_, const void* Bt_, int M, int N, int K, int G_, int c_, int ebytes = 2) { A = (const char*)A_; Bt = (const char*)Bt_; nM = M / BM; nN = N / BM; nwg = nM * nN; G = G_; c = c_; tstep = (size_t)BM * K * ebytes; }
    __device__ __forceinline__ bool next(int i, Unit& u) const { const long L = (long)i * G + c; if (L >= nwg) return false; flat_to_tile((int)L, nwg, nM, nN, u.pm, u.pn); u.e = 0; u.rt = u.pm; u.slot = i; return true; }
    __device__ __forceinline__ const char* a_base(const Unit& u) const { return A + (size_t)u.pm * tstep; }
    __device__ __forceinline__ const char* b_base(const Unit& u) const { return Bt + (size_t)u.pn * tstep; }
    __device__ __forceinline__ void gather(int, int, int, unsigned (&)[2][2]) const {}
};
struct MoeSched {
    const char* A; const char* Bt; size_t a_tstep, b_estep, b_tstep; int nunits; const LAS unsigned* ulist; const LAS unsigned* gtab; bool gath;
    __device__ __forceinline__ bool next(int i, Unit& u) const {
        if (i >= nunits) return false;
        const unsigned w = (unsigned)__builtin_amdgcn_readfirstlane((int)ulist[i]);
        u.pm = (int)(w & 0x3ffu); u.pn = (int)((w >> 10) & 0x7u); u.e = (int)((w >> 13) & 0x1fu); u.rt = (int)(w >> 18); u.slot = i; return true;
    }
    __device__ __forceinline__ const char* a_base(const Unit& u) const { return gath ? A : A + (size_t)u.pm * a_tstep; }
    __device__ __forceinline__ const char* b_base(const Unit& u) const { return Bt + (size_t)u.e * b_estep + (size_t)u.pn * b_tstep; }
    __device__ __forceinline__ void gather(int i, int R0, int R1, unsigned (&off)[2][2]) const {
        const LAS unsigned short* g = (const LAS unsigned short*)gtab + i * 256;
        off[0][0] = (unsigned)g[R0] << 10; off[0][1] = (unsigned)g[R1] << 10; off[1][0] = (unsigned)g[128 + R0] << 10; off[1][1] = (unsigned)g[128 + R1] << 10;
    }
};

#define PG8_SA(b, h) (((b) * 2 + (h)) * HTB)
#define PG8_SB(b, h) ((4 + (b) * 2 + (h)) * HTB)
#define PG8_GLDS(src, dstoff) __builtin_amdgcn_global_load_lds((const unsigned*)(src), (LAS unsigned*)(lds + (dstoff)), 16, 0, 0)
#define PG8_STAGE_B(bufoff, gbase) do { _Pragma("unroll") for (int _i = 0; _i < 2; ++_i) PG8_GLDS((const char*)(gbase) + voffB[_i], (bufoff) + ldsw + _i * 8192); } while (0)
#define PG8_STAGE_A(bufoff, kptr, h, o) do { _Pragma("unroll") for (int _i = 0; _i < 2; ++_i) \
        PG8_GLDS(GATHER ? (const char*)(kptr) + (o)[h][_i] : (const char*)(kptr) + (size_t)(h) * hstep + voffA[_i], (bufoff) + ldsw + _i * 8192); } while (0)
#define PG8_LDA(dst, b, h) do { _Pragma("unroll") for (int m = 0; m < 4; ++m) { if constexpr (F8) dst##8[m] = ld8(lds + PG8_SA(b, h) + a8_0 + m * 2048, lds + PG8_SA(b, h) + a8_1 + m * 2048); \
        else { _Pragma("unroll") for (int k = 0; k < 2; ++k) dst[m][k] = *(const LAS bf16x8*)(lds + PG8_SA(b, h) + aoff + m * 2048 + k * 1024); } } } while (0)
#define PG8_LDB(dst, b, h) do { _Pragma("unroll") for (int n = 0; n < 2; ++n) { if constexpr (F8) dst##8[n] = ld8(lds + PG8_SB(b, h) + b8_0 + n * 2048, lds + PG8_SB(b, h) + b8_1 + n * 2048); \
        else { _Pragma("unroll") for (int k = 0; k < 2; ++k) dst[n][k] = *(const LAS bf16x8*)(lds + PG8_SB(b, h) + boff + n * 2048 + k * 1024); } } } while (0)
#define PG8_MMA(ai, bj, At, Bt) do { __builtin_amdgcn_s_setprio(1); _Pragma("unroll") for (int m = 0; m < 4; ++m) _Pragma("unroll") for (int n = 0; n < 2; ++n) { \
        if constexpr (F8) asm volatile("v_mfma_scale_f32_16x16x128_f8f6f4 %0, %1, %2, %0, %3, %4 op_sel_hi:[0,0,0]" : "+v"(acc[ai][bj][m][n]) : "v"(Bt##8[n]), "v"(At##8[m]), "v"(sc_w), "v"(sc_a)); \
        else { _Pragma("unroll") for (int k = 0; k < 2; ++k) acc[ai][bj][m][n] = __builtin_amdgcn_mfma_f32_16x16x32_bf16(Bt[n][k], At[m][k], acc[ai][bj][m][n], 0, 0, 0); } } __builtin_amdgcn_s_setprio(0); } while (0)
#define PG8_WAIT_V(n) asm volatile("s_waitcnt vmcnt(" #n ")" ::: "memory")
#define PG8_WAIT_L(n) asm volatile("s_waitcnt lgkmcnt(" #n ")" ::: "memory")
#define PG8_BAR __builtin_amdgcn_s_barrier()
#define PG8_SCHED __builtin_amdgcn_sched_barrier(0)

template <class Epi, class Sched, bool GATHER, bool MIDK, bool F8 = false>
__device__ __forceinline__ void gemm_phase(LAS unsigned char* lds, const int KB  , const Sched& S, const Epi& E) {
    int tid = (int)threadIdx.x; asm volatile("" : "+v"(tid));
    const int wid = __builtin_amdgcn_readfirstlane(tid >> 6), lane = tid & 63, wr = wid >> 2, wc = wid & 3, fr = lane & 15, fq = lane >> 4;
    const int nt = KB / 128;
    unsigned voffA[2], voffB[2]; int Rg[2]; unsigned Cg[2];
#pragma unroll
    for (int i = 0; i < 2; ++i) { int R, C; stage_rc(tid * 16 + i * 8192, R, C); const int Rb = Epi::PERM ? ((R & ~31) + perm32(R & 31)) : R;
        voffA[i] = (unsigned)(R * KB + C * 2); voffB[i] = (unsigned)(Rb * KB + C * 2); Rg[i] = R; Cg[i] = (unsigned)C * 2u; }
    const size_t kstep = 128;
    const size_t hstep = (size_t)HALF * KB;
    const unsigned ldsw = (unsigned)wid * 1024u;
    const int aoff = lds_byte(wr * 64 + fr, fq * 8), boff = lds_byte(wc * 32 + fr, fq * 8);
    const int a8_0 = aoff, a8_1 = aoff + 1024, b8_0 = boff, b8_1 = boff + 1024;
    Unit cur, nxt; int ui = 0;
    if (!S.next(0, cur)) return;
    f32x4 acc[2][2][4][2];
#pragma unroll
    for (int a = 0; a < 2; ++a)
#pragma unroll
        for (int b = 0; b < 2; ++b)
#pragma unroll
            for (int m = 0; m < 4; ++m)
#pragma unroll
                for (int n = 0; n < 2; ++n) acc[a][b][m][n] = (f32x4){0.f, 0.f, 0.f, 0.f};
    bf16x8 At[4][2], B0[2][2], B1[2][2]; v8i At8[4], B08[2], B18[2];
    int sc_w = F8_SCALE_W, sc_a = 127; if constexpr (F8) { asm volatile("" : "+v"(sc_w), "+v"(sc_a)); }
    unsigned offC[2][2] = {{0u, 0u}, {0u, 0u}}, offN[2][2] = {{0u, 0u}, {0u, 0u}};
    if constexpr (GATHER) { S.gather(0, Rg[0], Rg[1], offC);
#pragma unroll
        for (int h = 0; h < 2; ++h)
#pragma unroll
            for (int i = 0; i < 2; ++i) offC[h][i] += Cg[i]; }
    const char* cA = S.a_base(cur); const char* cB = S.b_base(cur);
    PG8_STAGE_B(PG8_SB(0, 0), cB); PG8_STAGE_B(PG8_SB(0, 1), cB + hstep); PG8_STAGE_A(PG8_SA(0, 0), cA, 0, offC); PG8_STAGE_A(PG8_SA(0, 1), cA, 1, offC);
    if (wr == 1) PG8_BAR;
    PG8_WAIT_V(2); PG8_BAR;
    PG8_STAGE_B(PG8_SB(1, 0), cB + kstep); PG8_STAGE_A(PG8_SA(1, 0), cA + kstep, 0, offC); PG8_STAGE_B(PG8_SB(1, 1), cB + hstep + kstep);
    PG8_WAIT_V(6); PG8_BAR;
    for (;;) {
        const bool has_next = S.next(ui + 1, nxt);
        const char* nA = has_next ? S.a_base(nxt) : cA; const char* nB = has_next ? S.b_base(nxt) : cB;
        if constexpr (GATHER) { if (has_next) { S.gather(ui + 1, Rg[0], Rg[1], offN);
#pragma unroll
                for (int h = 0; h < 2; ++h)
#pragma unroll
                    for (int i = 0; i < 2; ++i) offN[h][i] += Cg[i]; }
            else {
#pragma unroll
                for (int h = 0; h < 2; ++h)
#pragma unroll
                    for (int i = 0; i < 2; ++i) offN[h][i] = offC[h][i]; } }
        for (int t = 0; t < nt; t += 2) {
            const bool last = (t == nt - 2);
            const char* a1 = cA + (size_t)(t + 1) * kstep;
            const char* a2 = last ? nA : cA + (size_t)(t + 2) * kstep; const char* b2 = last ? nB : cB + (size_t)(t + 2) * kstep;
            const char* a3 = a2 + kstep; const char* b3 = b2 + kstep;
            unsigned o2[2][2];
#pragma unroll
            for (int h = 0; h < 2; ++h)
#pragma unroll
                for (int i = 0; i < 2; ++i) o2[h][i] = last ? offN[h][i] : offC[h][i];
            if constexpr (MIDK) { if (t == nt / 2) E.midk(acc, cur, wr, fr); }
            PG8_LDB(B0, 0, 0); PG8_LDB(B1, 0, 1); PG8_SCHED; PG8_LDA(At, 0, 0); PG8_STAGE_A(PG8_SA(1, 1), a1, 1, offC);
            PG8_WAIT_V(8); PG8_WAIT_L(0); PG8_BAR; PG8_MMA(0, 0, At, B0); PG8_MMA(0, 1, At, B1); PG8_BAR; PG8_SCHED;
            PG8_LDA(At, 0, 1); PG8_STAGE_B(PG8_SB(0, 0), b2); PG8_STAGE_B(PG8_SB(0, 1), b2 + hstep); PG8_STAGE_A(PG8_SA(0, 0), a2, 0, o2);
            PG8_WAIT_V(8); PG8_WAIT_L(0); PG8_BAR; PG8_MMA(1, 0, At, B0); PG8_MMA(1, 1, At, B1); PG8_BAR; PG8_SCHED;
            PG8_LDB(B0, 1, 0); PG8_LDB(B1, 1, 1); PG8_SCHED; PG8_LDA(At, 1, 0); PG8_STAGE_A(PG8_SA(0, 1), a2, 1, o2);
            PG8_WAIT_V(8); PG8_WAIT_L(0); PG8_BAR; PG8_MMA(0, 0, At, B0); PG8_MMA(0, 1, At, B1); PG8_BAR; PG8_SCHED;
            PG8_LDA(At, 1, 1); PG8_STAGE_B(PG8_SB(1, 0), b3); PG8_STAGE_B(PG8_SB(1, 1), b3 + hstep); PG8_STAGE_A(PG8_SA(1, 0), a3, 0, o2);
            PG8_WAIT_V(8); PG8_WAIT_L(0); PG8_BAR; PG8_MMA(1, 0, At, B0); PG8_MMA(1, 1, At, B1); PG8_BAR; PG8_SCHED;
        }
        if (wr == 0) PG8_BAR;
        if constexpr (F8) asm volatile("s_nop 15\n\ts_nop 15" ::: "memory");
        E(acc, cur, wr, wc, fr, fq);
        if (!has_next) break;
#pragma unroll
        for (int a = 0; a < 2; ++a)
#pragma unroll
            for (int b = 0; b < 2; ++b)
#pragma unroll
                for (int m = 0; m < 4; ++m)
#pragma unroll
                    for (int n = 0; n < 2; ++n) acc[a][b][m][n] = (f32x4){0.f, 0.f, 0.f, 0.f};
        cur = nxt; cA = nA; cB = nB; ++ui;
        if constexpr (GATHER) {
#pragma unroll
            for (int h = 0; h < 2; ++h)
#pragma unroll
                for (int i = 0; i < 2; ++i) offC[h][i] = offN[h][i]; }
        if (wr == 1) PG8_BAR;
    }
    PG8_WAIT_V(0);
    PG8_BAR;
}
}

struct Frame {
    LAS unsigned char* lds;
    volatile LAS unsigned* MISC;
    gu32* ctl;
    unsigned char* ws;
    int vcu, G;
    const float *x, *p, *mix_norm, *w_in, *ln_g, *ln_b, *gws, *gbs, *aon, *gon, *w_out, *ffn_norm, *router_w, *router_b, *w_gu, *b_gu, *w_dn, *b_dn, *ple_norm, *w_pg, *w_pp, *ppn, *final_norm;
    float* out;
};
template <class T_> __device__ __forceinline__ T_* wsp(const Frame& F, size_t off) { return (T_*)(F.ws + off); }

#define PHASE_IDS int TID_ = (int)threadIdx.x; asm volatile("" : "+v"(TID_)); const int LANE_ = TID_ & 63; const int WAVE_ = __builtin_amdgcn_readfirstlane(TID_ >> 6); (void)LANE_; (void)WAVE_
template <class ColMap>
__device__ __forceinline__ void p0_transpose_item(const float* W, int K, int N, bf16* WT, const float* gain, LAS float* scr, int item, int lane, int nphys, const ColMap& cm) {
    const int nblk = nphys / 64, kb = item / nblk, nb = item % nblk, k0 = 64 * kb, n0 = 64 * nb;
    const int srccol = cm(n0 + lane);
    float v_[64]; const float* src = W + (size_t)k0 * N + srccol;
#pragma unroll
    for (int kk = 0; kk < 64; ++kk) v_[kk] = __builtin_nontemporal_load(src + (size_t)kk * N);
    if (gain) {
#pragma unroll
        for (int kk = 0; kk < 64; kk += 4) { const f32x4 g4 = *(const f32x4*)(gain + k0 + kk); v_[kk] *= g4[0]; v_[kk + 1] *= g4[1]; v_[kk + 2] *= g4[2]; v_[kk + 3] *= g4[3]; } }
#pragma unroll
    for (int kk = 0; kk < 64; ++kk) scr[kk * 65 + lane] = v_[kk];
    LDS_WAIT(); asm volatile("" ::: "memory");
    const int c = lane & 7;
#pragma unroll
    for (int j = 0; j < 8; ++j) { const int n = (lane >> 3) + 8 * j; const LAS float* s = scr + (8 * c) * 65 + n;
        v4u o; o.x = pk2(s[0 * 65], s[1 * 65]); o.y = pk2(s[2 * 65], s[3 * 65]); o.z = pk2(s[4 * 65], s[5 * 65]); o.w = pk2(s[6 * 65], s[7 * 65]);
        *(GAS v4u*)(WT + (size_t)(n0 + n) * K + k0 + 8 * c) = o; }
    LDS_WAIT(); asm volatile("" ::: "memory");
}
template <class ColMap>
__device__ __forceinline__ void p0_transpose_item_f8(const float* W, int K, int N, unsigned char* WT, const float* gain, LAS float* scr, int item, int lane, int nphys, const ColMap& cm) {
    const int nblk = nphys / 64, kb = item / nblk, nb = item % nblk, k0 = 64 * kb, n0 = 64 * nb;
    const int srccol = cm(n0 + lane);
    float v_[64]; const float* src = W + (size_t)k0 * N + srccol;
#pragma unroll
    for (int kk = 0; kk < 64; ++kk) v_[kk] = __builtin_nontemporal_load(src + (size_t)kk * N);
    constexpr float WS_ = (float)(1 << pg8::F8_WSHIFT);
#pragma unroll
    for (int kk = 0; kk < 64; kk += 4) { f32x4 g4 = gain ? *(const f32x4*)(gain + k0 + kk) : (f32x4){1.f, 1.f, 1.f, 1.f}; v_[kk] *= g4[0] * WS_; v_[kk + 1] *= g4[1] * WS_; v_[kk + 2] *= g4[2] * WS_; v_[kk + 3] *= g4[3] * WS_; }
#pragma unroll
    for (int kk = 0; kk < 64; ++kk) scr[kk * 65 + lane] = v_[kk];
    LDS_WAIT(); asm volatile("" ::: "memory");
    const int c = lane & 3;
#pragma unroll
    for (int j = 0; j < 4; ++j) { const int n = (lane >> 2) + 16 * j; const LAS float* s_ = scr + (16 * c) * 65 + n;
        v4u o; o.x = pk4_fp8(s_[0 * 65], s_[1 * 65], s_[2 * 65], s_[3 * 65]); o.y = pk4_fp8(s_[4 * 65], s_[5 * 65], s_[6 * 65], s_[7 * 65]);
        o.z = pk4_fp8(s_[8 * 65], s_[9 * 65], s_[10 * 65], s_[11 * 65]); o.w = pk4_fp8(s_[12 * 65], s_[13 * 65], s_[14 * 65], s_[15 * 65]);
        *(GAS v4u*)(WT + (size_t)(n0 + n) * K + k0 + 16 * c) = o; }
    LDS_WAIT(); asm volatile("" ::: "memory");
}
struct CmId { __device__ __forceinline__ int operator()(int n) const { return n; } };
struct CmWin { __device__ __forceinline__ int operator()(int n) const { if (n >= 2 * AW) return n; const int c = n & 63; return (n & ~63) + 4 * (c >> 3) + (c & 3) + 32 * ((c >> 2) & 1); } };
struct CmWgu { __device__ __forceinline__ int operator()(int n) const { return ((n >> 7) & 1) * FF + (n >> 8) * 128 + (n & 127); } };

constexpr int XW_I_GU = (DM / 64) * (2 * FF / 64), XW_I_DN = (FF / 64) * (DM / 64), XW_ITEMS = NE * (XW_I_GU + XW_I_DN);
__device__ __forceinline__ void xw_convert_item(const Frame& F, int it, LAS float* scr, int lane) {
    if (it < NE * XW_I_GU) { const int e = it / XW_I_GU; p0_transpose_item_f8(F.w_gu + (size_t)e * DM * 2 * FF, DM, 2 * FF, wsp<unsigned char>(F, WS_WGU) + (size_t)e * 2 * FF * DM, F.ffn_norm, scr, it % XW_I_GU, lane, 2 * FF, CmWgu()); }
    else { const int r = it - NE * XW_I_GU, e = r / XW_I_DN; p0_transpose_item_f8(F.w_dn + (size_t)e * FF * DM, FF, DM, wsp<unsigned char>(F, WS_WDN) + (size_t)e * DM * FF, nullptr, scr, r % XW_I_DN, lane, DM, CmId()); }
}
struct XwDesc { const float* src; unsigned char* dst; unsigned N, K; };
__device__ __forceinline__ XwDesc xw_desc(const Frame& F, int it, int lane) {
    XwDesc d; const int kq = lane >> 4, nq = lane & 15;
    if (it < NE * XW_I_GU) { const int e = it / XW_I_GU, item = it % XW_I_GU, nblk = 2 * FF / 64, k0 = 64 * (item / nblk), n0 = 64 * (item % nblk);
        d.N = 2 * FF; d.K = DM; d.src = F.w_gu + (size_t)e * DM * 2 * FF + (size_t)(k0 + kq) * (2 * FF) + CmWgu()(n0) + 4 * nq;
        d.dst = wsp<unsigned char>(F, WS_WGU) + (size_t)e * 2 * FF * DM + (size_t)(n0 + (lane >> 2)) * DM + k0 + 16 * (lane & 3); }
    else { const int r = it - NE * XW_I_GU, e = r / XW_I_DN, item = r % XW_I_DN, nblk = DM / 64, k0 = 64 * (item / nblk), n0 = 64 * (item % nblk);
        d.N = DM; d.K = FF; d.src = F.w_dn + (size_t)e * FF * DM + (size_t)(k0 + kq) * DM + n0 + 4 * nq;
        d.dst = wsp<unsigned char>(F, WS_WDN) + (size_t)e * DM * FF + (size_t)(n0 + (lane >> 2)) * FF + k0 + 16 * (lane & 3); }
    return d;
}
__device__ __forceinline__ void xw_load(f32x4 (&v)[16], const XwDesc& d) {
#pragma unroll
    for (int j = 0; j < 16; ++j) v[j] = __builtin_nontemporal_load((const f32x4*)(d.src + (size_t)(4 * j) * d.N));
}
__device__ __forceinline__ void xw_process(const f32x4 (&v)[16], const XwDesc& d, LAS float* scr, int lane) {
    const int kq = lane >> 4, nq = lane & 15;
#pragma unroll
    for (int j = 0; j < 16; ++j) { LAS float* w = scr + (4 * j + kq) * 65 + 4 * nq; w[0] = v[j][0]; w[1] = v[j][1]; w[2] = v[j][2]; w[3] = v[j][3]; }
    LDS_WAIT(); asm volatile("" ::: "memory");
    constexpr float WS_ = (float)(1 << pg8::F8_WSHIFT);
    const int c = lane & 3;
#pragma unroll
    for (int j = 0; j < 4; ++j) { const LAS float* s_ = scr + (16 * c) * 65 + (lane >> 2) + 16 * j;
        v4u o; o.x = pk4_fp8(s_[0 * 65] * WS_, s_[1 * 65] * WS_, s_[2 * 65] * WS_, s_[3 * 65] * WS_); o.y = pk4_fp8(s_[4 * 65] * WS_, s_[5 * 65] * WS_, s_[6 * 65] * WS_, s_[7 * 65] * WS_);
        o.z = pk4_fp8(s_[8 * 65] * WS_, s_[9 * 65] * WS_, s_[10 * 65] * WS_, s_[11 * 65] * WS_); o.w = pk4_fp8(s_[12 * 65] * WS_, s_[13 * 65] * WS_, s_[14 * 65] * WS_, s_[15 * 65] * WS_);
        *(GAS v4u*)(d.dst + (size_t)(16 * j) * d.K) = o; }
    LDS_WAIT(); asm volatile("" ::: "memory");
}
__device__ __forceinline__ void p0_prologue(Frame& F) {
    PHASE_IDS;
    { const int gt0 = (int)blockIdx.x * NTHR + TID_, GT0 = F.G * NTHR;
      for (int i = gt0; i < CW_TS; i += GT0) F.ctl[i] = 0u;
      float* km0 = wsp<float>(F, WS_KMEAN); for (int i = gt0; i < (T / SEQ) * NH * NBLK * HD; i += GT0) km0[i] = 0.f; }
    LAS float* scr = (LAS float*)(F.lds + RING_OFF + WAVE_ * P0_SCR_WAVE);
    const int gw = F.vcu * NWAVES + WAVE_, NGW = F.G * NWAVES;
    constexpr int I_GU = (DM / 64) * (2 * FF / 64), I_DN = (FF / 64) * (DM / 64), I_IN = (DM / 64) * (NPROJ / 64), I_SQ = (DM / 64) * (DM / 64), I_PP = (PLE / 64) * (DM / 64);
    constexpr int NITEMS = I_IN + 2 * I_SQ + I_PP;
    (void)I_GU; (void)I_DN;
    for (int it = gw; it < NITEMS; it += NGW) {
        int r = it;
        if (r < I_IN) { p0_transpose_item(F.w_in, DM, NPROJ, wsp<bf16>(F, WS_WIN), F.mix_norm, scr, r, LANE_, NPROJ, CmWin()); continue; } r -= I_IN;
        if (r < I_SQ) {
            const int nblk = DM / 64, kb = r / nblk; const float* g = (kb < 8) ? F.aon : (F.gon - AW);
            p0_transpose_item(F.w_out, DM, DM, wsp<bf16>(F, WS_WOUT), g, scr, r, LANE_, DM, CmId()); continue; } r -= I_SQ;
        if (r < I_SQ) { p0_transpose_item_f8(F.w_pg, DM, DM, wsp<unsigned char>(F, WS_WPG8), F.ple_norm, scr, r, LANE_, DM, CmId()); continue; } r -= I_SQ;
        p0_transpose_item(F.w_pp, PLE, DM, wsp<bf16>(F, WS_WPP), nullptr, scr, r, LANE_, DM, CmId());
    }
    if (TPROBE && blockIdx.x == 0 && threadIdx.x == 0) ((unsigned long long*)(F.ctl + CW_TS))[11] = __builtin_amdgcn_s_memrealtime();
    bf16* XN = wsp<bf16>(F, WS_XNB);
    for (int m0 = gw; m0 < T; m0 += 2 * NGW) {
        f32x4 v[2][4]; float s[2] = {0.f, 0.f};
#pragma unroll
        for (int r = 0; r < 2; ++r) { const GAS f32x4* xr = (const GAS f32x4*)(F.x + (size_t)(m0 + r * NGW) * DM) + LANE_;
#pragma unroll
            for (int j = 0; j < 4; ++j) v[r][j] = __builtin_nontemporal_load(xr + 64 * j); }
#pragma unroll
        for (int r = 0; r < 2; ++r) {
#pragma unroll
            for (int j = 0; j < 4; ++j) s[r] += (v[r][j].x * v[r][j].x + v[r][j].y * v[r][j].y) + (v[r][j].z * v[r][j].z + v[r][j].w * v[r][j].w); }
#pragma unroll
        for (int r = 0; r < 2; ++r) { const int m = m0 + r * NGW; const float sig = sqrtf(wave_sum(s[r]) * (1.f / DM) + EPS), rstd = 1.0f / sig;
            if (LANE_ == 0) wsp<float>(F, WS_SIG0)[m] = sig;
            GAS v2u* o8 = (GAS v2u*)(XN + (size_t)m * DM) + LANE_;
#pragma unroll
            for (int j = 0; j < 4; ++j) { v2u w; w.x = pk2(v[r][j].x * rstd, v[r][j].y * rstd); w.y = pk2(v[r][j].z * rstd, v[r][j].w * rstd); o8[64 * j] = w; } }
    }
    if (TPROBE && blockIdx.x == 0 && threadIdx.x == 0) ((unsigned long long*)(F.ctl + CW_TS))[12] = __builtin_amdgcn_s_memrealtime();
    { const GAS f32x4* pr = (const GAS f32x4*)F.p; GAS v2u* po = (GAS v2u*)wsp<bf16>(F, WS_PB);
      const size_t n4 = (size_t)T * PLE / 4, gt = (size_t)(F.vcu * NTHR + TID_), GT = (size_t)F.G * NTHR;
      for (size_t i = gt; i < n4; i += GT) { const f32x4 v = pr[i]; v2u w; w.x = pk2(v.x, v.y); w.y = pk2(v.z, v.w); po[i] = w; } }
    if (TPROBE && blockIdx.x == 0 && threadIdx.x == 0) ((unsigned long long*)(F.ctl + CW_TS))[13] = __builtin_amdgcn_s_memrealtime();
    { const int gt = F.vcu * NTHR + TID_, GT = F.G * NTHR; float* RWG = wsp<float>(F, WS_RWG);
      (void)RWG; bf16* RWT = wsp<bf16>(F, WS_RWT);
      for (int i = gt; i < DM * NE; i += GT) { const int e = i / DM, k = i % DM; const float w = F.router_w[k * NE + e] * F.ffn_norm[k]; const unsigned hi = f2bf(w); const float lo = w - bf2f((bf16)hi); RWT[i] = (bf16)hi; RWT[NE * DM + i] = (bf16)f2bf(lo); }
      float* RC = wsp<float>(F, WS_ROPE); float* RS = RC + SEQ * 32;
      for (int i = gt; i < SEQ * 32; i += GT) { const int pos = i >> 5, j = i & 31; const float inv = powf(10000.0f, -(float)j / 32.0f); const float ang = (float)pos * inv; float sn, cs; sincosf(ang, &sn, &cs); RC[i] = cs; RS[i] = sn; } }
}

using pg8::Unit;
constexpr int HALF = 128;
struct EpiInProj {
    static constexpr bool PERM = true;
    bf16* QKVUV; const float *rc, *rs; float* kmean;
    __device__ __forceinline__ void operator()(const f32x4 (&acc)[2][2][4][2], const Unit& u, int wr, int wc, int fr, int fq) const {
        const int type = u.pn >> 1, colt = (u.pn & 1) * 256 + wc * 32 + 8 * fq;
        const int row0 = u.pm * 256 + wr * 64 + fr;
        if (type <= 1) {
            bf16* dst = QKVUV + (size_t)type * (16u << 20);
            const int pos0 = (u.pm & 7) * 256 + wr * 64 + fr, i0 = 16 * (wc & 1) + 4 * fq;
            f32x4 cs_[2][2];
#pragma unroll
            for (int bj = 0; bj < 2; ++bj) { cs_[bj][0] = (f32x4){0.f, 0.f, 0.f, 0.f}; cs_[bj][1] = (f32x4){0.f, 0.f, 0.f, 0.f}; }
#pragma unroll
            for (int ai = 0; ai < 2; ++ai) { f32x4 cc[4], ss[4];
#pragma unroll
                for (int m = 0; m < 4; ++m) { const int pos = pos0 + ai * HALF + m * 16; cc[m] = *(const f32x4*)(rc + pos * 32 + i0); ss[m] = *(const f32x4*)(rs + pos * 32 + i0); }
#pragma unroll
                for (int m = 0; m < 4; ++m) { const int ro = ai * HALF + m * 16; const f32x4 c = cc[m], s = ss[m];
                    bf16* rowp = dst + (size_t)(row0 + ro) * AW + colt;
#pragma unroll
                    for (int bj = 0; bj < 2; ++bj) { const f32x4 x1 = acc[ai][bj][m][0], x2 = acc[ai][bj][m][1];
                        const f32x4 o1 = x1 * c - x2 * s, o2 = x2 * c + x1 * s;
                        cs_[bj][0] += o1; cs_[bj][1] += o2;
                        v4u w; w.x = cvt_pk_bf16(o1[0], o1[1]); w.y = cvt_pk_bf16(o1[2], o1[3]); w.z = cvt_pk_bf16(o2[0], o2[1]); w.w = cvt_pk_bf16(o2[2], o2[3]);
                        *(v4u*)(rowp + bj * HALF) = w; } }
                asm volatile("" ::: "memory"); }
            if (type == 1) {
#pragma unroll
                for (int bj = 0; bj < 2; ++bj)
#pragma unroll
                    for (int n = 0; n < 2; ++n)
#pragma unroll
                        for (int j = 0; j < 4; ++j) { float v = cs_[bj][n][j]; v += __shfl_xor(v, 1); v += __shfl_xor(v, 2); v += __shfl_xor(v, 4); v += __shfl_xor(v, 8); cs_[bj][n][j] = v; }
                if (fr == 0) { const int b = u.pm >> 3, blk = u.pm & 7;
#pragma unroll
                    for (int bj = 0; bj < 2; ++bj) { const int colh = (u.pn & 1) * 256 + bj * HALF + wc * 32; const int head = colh >> 6, cpos = (colh & 63) + 8 * fq;
                        float* km = kmean + ((size_t)((b * NH + head) * NBLK + blk)) * HD + cpos;
#pragma unroll
                        for (int n = 0; n < 2; ++n)
#pragma unroll
                            for (int j = 0; j < 4; ++j) atomicAdd(km + 4 * n + j, cs_[bj][n][j]); } }
            }
        } else {
            bf16* dst = QKVUV + (size_t)type * (16u << 20);
#pragma unroll
            for (int ai = 0; ai < 2; ++ai)
#pragma unroll
                for (int m = 0; m < 4; ++m) { bf16* rowp = dst + (size_t)(row0 + ai * HALF + m * 16) * AW + colt;
#pragma unroll
                    for (int bj = 0; bj < 2; ++bj) { f32x4 v0 = acc[ai][bj][m][0], v1 = acc[ai][bj][m][1];
                        if (type >= 3) { v0 = gelu4(v0); v1 = gelu4(v1); }
                        v4u w; w.x = cvt_pk_bf16(v0[0], v0[1]); w.y = cvt_pk_bf16(v0[2], v0[3]); w.z = cvt_pk_bf16(v1[0], v1[1]); w.w = cvt_pk_bf16(v1[2], v1[3]);
                        *(v4u*)(rowp + bj * HALF) = w; } }
        }
    }
};
struct EpiOutProj {
    static constexpr bool PERM = true;
    const bf16* xn; bf16* x1; unsigned char* x1f8; float* ssq1; const LAS f32x4* rtab; const float* fgain;
    int pm_a, pm_b;
    __device__ __forceinline__ int slot(const Unit& u) const { return u.pm == pm_a ? 0 : 1; }
    __device__ __forceinline__ void midk(f32x4 (&acc)[2][2][4][2], const Unit& u, int wr, int fr) const {
        const LAS f32x4* t = rtab + slot(u) * 256 + wr * 64 + fr;
#pragma unroll
        for (int ai = 0; ai < 2; ++ai)
#pragma unroll
            for (int m = 0; m < 4; ++m) { const float r = t[ai * HALF + m * 16].x;
#pragma unroll
                for (int bj = 0; bj < 2; ++bj)
#pragma unroll
                    for (int n = 0; n < 2; ++n) acc[ai][bj][m][n] *= r; }
    }
    __device__ __forceinline__ void operator()(const f32x4 (&acc)[2][2][4][2], const Unit& u, int wr, int wc, int fr, int fq) const {
        const LAS f32x4* t = rtab + slot(u) * 256 + wr * 64 + fr;
        const int row0 = u.pm * 256 + wr * 64 + fr, col0 = u.pn * 256 + wc * 32 + 8 * fq;
        f32x4 fg[2][2];
#pragma unroll
        for (int bj = 0; bj < 2; ++bj) { fg[bj][0] = *(const f32x4*)(fgain + col0 + bj * HALF); fg[bj][1] = *(const f32x4*)(fgain + col0 + bj * HALF + 4); }
#pragma unroll
        for (int ai = 0; ai < 2; ++ai) { v4u xv[4][2];
#pragma unroll
            for (int m = 0; m < 4; ++m) { const size_t off = (size_t)(row0 + ai * HALF + m * 16) * DM + col0;
                xv[m][0] = *(const v4u*)(xn + off); xv[m][1] = *(const v4u*)(xn + off + HALF); }
#pragma unroll
            for (int m = 0; m < 4; ++m) { const int ro = ai * HALF + m * 16; const f32x4 tv = t[ro]; const float rg = tv.y, sx = tv.z; const size_t off = (size_t)(row0 + ro) * DM + col0; float q = 0.f;
#pragma unroll
                for (int bj = 0; bj < 2; ++bj) { const v4u xw = xv[m][bj];
                    const f32x4 x0 = {bflo(xw.x), bfhi(xw.x), bflo(xw.y), bfhi(xw.y)}, x1_ = {bflo(xw.z), bfhi(xw.z), bflo(xw.w), bfhi(xw.w)};
                    const f32x4 o0 = x0 * sx + acc[ai][bj][m][0] * rg, o1 = x1_ * sx + acc[ai][bj][m][1] * rg;
                    q += (o0[0] * o0[0] + o0[1] * o0[1]) + (o0[2] * o0[2] + o0[3] * o0[3]) + (o1[0] * o1[0] + o1[1] * o1[1]) + (o1[2] * o1[2] + o1[3] * o1[3]);
                    v4u w; w.x = cvt_pk_bf16(o0[0], o0[1]); w.y = cvt_pk_bf16(o0[2], o0[3]); w.z = cvt_pk_bf16(o1[0], o1[1]); w.w = cvt_pk_bf16(o1[2], o1[3]);
                    *(v4u*)(x1 + off + bj * HALF) = w;
                    const f32x4 p0 = o0 * fg[bj][0], p1 = o1 * fg[bj][1];
                    v2u w8; w8.x = pk4_fp8(p0[0], p0[1], p0[2], p0[3]); w8.y = pk4_fp8(p1[0], p1[1], p1[2], p1[3]); *(v2u*)(x1f8 + off + bj * HALF) = w8; }
                q += __shfl_xor(q, 16); q += __shfl_xor(q, 32);
                if (fq == 0) ssq1[(size_t)(row0 + ro) * 16 + u.pn * 4 + wc] = q; }
            asm volatile("" ::: "memory"); }
    }
};
struct EpiMoe1 {
    static constexpr bool PERM = true;
    unsigned char* A; const float* b_gu; const LAS float* rss;
    __device__ __forceinline__ void operator()(const f32x4 (&acc)[2][2][4][2], const Unit& u, int wr, int wc, int fr, int fq) const {
        const int row0 = u.pm * 256 + wr * 64 + fr, col = u.pn * 128 + wc * 32 + 8 * fq;
        const float* bg = b_gu + (size_t)u.e * 2 * FF + col; const LAS float* rs_ = rss + u.slot * 256 + wr * 64 + fr;
        float rsv[2][4];
#pragma unroll
        for (int ai = 0; ai < 2; ++ai)
#pragma unroll
            for (int m = 0; m < 4; ++m) rsv[ai][m] = rs_[ai * HALF + m * 16];
        f32x4 bgv[2], blv[2];
#pragma unroll
        for (int n = 0; n < 2; ++n) { bgv[n] = *(const f32x4*)(bg + 4 * n); blv[n] = *(const f32x4*)(bg + FF + 4 * n); }
#pragma unroll
        for (int ai = 0; ai < 2; ++ai)
#pragma unroll
            for (int m = 0; m < 4; ++m) { f32x4 a[2];
#pragma unroll
                for (int n = 0; n < 2; ++n) { const f32x4 g = acc[ai][0][m][n] * rsv[ai][m] + bgv[n], l = acc[ai][1][m][n] * rsv[ai][m] + blv[n];
#pragma unroll
                    for (int p = 0; p < 2; ++p) { f32x2 gc = {fminf(g[2 * p], 7.0f), fminf(g[2 * p + 1], 7.0f)}; f32x2 lc = {fminf(fmaxf(l[2 * p], -7.0f), 7.0f), fminf(fmaxf(l[2 * p + 1], -7.0f), 7.0f)};
                        const f32x2 z = gc * (-1.702f * 1.4426950408889634f); f32x2 e; e.x = __builtin_amdgcn_exp2f(z.x); e.y = __builtin_amdgcn_exp2f(z.y);
                        const f32x2 d = e + 1.0f; f32x2 r; r.x = __builtin_amdgcn_rcpf(d.x); r.y = __builtin_amdgcn_rcpf(d.y);
                        const f32x2 o = (gc * r) * (lc + 1.0f); a[n][2 * p] = o.x; a[n][2 * p + 1] = o.y; } }
                v2u w; w.x = pk4_fp8(a[0][0], a[0][1], a[0][2], a[0][3]); w.y = pk4_fp8(a[1][0], a[1][1], a[1][2], a[1][3]);
                *(v2u*)(A + (size_t)(row0 + ai * HALF + m * 16) * FF + col) = w; }
    }
};
constexpr float Y_SCALE = 16.0f;
struct EpiMoe2 {
    static constexpr bool PERM = true;
    unsigned char* Y; const float* b_dn; const LAS float* gss;
    __device__ __forceinline__ void operator()(const f32x4 (&acc)[2][2][4][2], const Unit& u, int wr, int wc, int fr, int fq) const {
        const int row0 = u.pm * 256 + wr * 64 + fr, col0 = u.pn * 256 + wc * 32 + 8 * fq;
        const LAS float* gs = gss + u.slot * 256 + wr * 64 + fr;
        f32x4 bv[2][2]; float gv[2][4];
#pragma unroll
        for (int bj = 0; bj < 2; ++bj)
#pragma unroll
            for (int n = 0; n < 2; ++n) bv[bj][n] = *(const f32x4*)(b_dn + (size_t)u.e * DM + col0 + bj * HALF + 4 * n);
#pragma unroll
        for (int ai = 0; ai < 2; ++ai)
#pragma unroll
            for (int m = 0; m < 4; ++m) gv[ai][m] = gs[ai * HALF + m * 16] * Y_SCALE;
#pragma unroll
        for (int ai = 0; ai < 2; ++ai)
#pragma unroll
            for (int m = 0; m < 4; ++m) { const float g = gv[ai][m]; unsigned char* rowp = Y + (size_t)(row0 + ai * HALF + m * 16) * DM + col0;
#pragma unroll
                for (int bj = 0; bj < 2; ++bj) { const f32x4 v0 = (acc[ai][bj][m][0] + bv[bj][0]) * g, v1 = (acc[ai][bj][m][1] + bv[bj][1]) * g;
                    v2u w; w.x = pk4_fp8(v0[0], v0[1], v0[2], v0[3]); w.y = pk4_fp8(v1[0], v1[1], v1[2], v1[3]);
                    *(v2u*)(rowp + bj * HALF) = w; } }
    }
};
constexpr float GATE_SCALE = 128.0f;
template <int MODE> struct EpiPle {
    static constexpr bool PERM = true;
    unsigned char* O; float* ssq; const LAS float* rtab; int pm_a;
    __device__ __forceinline__ void operator()(const f32x4 (&acc)[2][2][4][2], const Unit& u, int wr, int wc, int fr, int fq) const {
        const int row0 = u.pm * 256 + wr * 64 + fr, col0 = u.pn * 256 + wc * 32 + 8 * fq;
        float rsv[2][4];
#pragma unroll
        for (int ai = 0; ai < 2; ++ai)
#pragma unroll
            for (int m = 0; m < 4; ++m) rsv[ai][m] = (MODE == 0) ? rtab[(u.pm == pm_a ? 0 : 256) + wr * 64 + fr + ai * HALF + m * 16] : 1.0f;
#pragma unroll
        for (int ai = 0; ai < 2; ++ai)
#pragma unroll
            for (int m = 0; m < 4; ++m) { unsigned char* rowp = O + (size_t)(row0 + ai * HALF + m * 16) * DM + col0; float q = 0.f; const float rs = rsv[ai][m];
#pragma unroll
                for (int bj = 0; bj < 2; ++bj) { f32x4 v0 = acc[ai][bj][m][0], v1 = acc[ai][bj][m][1];
                    if (MODE == 0) {
#pragma unroll
                        for (int j = 0; j < 4; ++j) { v0[j] = GATE_SCALE * sigmoidf_fast(rs * v0[j]); v1[j] = GATE_SCALE * sigmoidf_fast(rs * v1[j]); } }
                    else { q += (v0[0] * v0[0] + v0[1] * v0[1]) + (v0[2] * v0[2] + v0[3] * v0[3]) + (v1[0] * v1[0] + v1[1] * v1[1]) + (v1[2] * v1[2] + v1[3] * v1[3]); }
                    v2u w; w.x = pk4_fp8(v0[0], v0[1], v0[2], v0[3]); w.y = pk4_fp8(v1[0], v1[1], v1[2], v1[3]);
                    *(v2u*)(rowp + bj * HALF) = w; }
                if (MODE == 1) { q += __shfl_xor(q, 16); q += __shfl_xor(q, 32); if (fq == 0) ssq[(size_t)(row0 + ai * HALF + m * 16) * 16 + u.pn * 4 + wc] = q; } }
    }
};

namespace att {
constexpr int QBLK = 32, KVBLK = 64;
constexpr float SCALE = 0.125f, THR = 8.f;
constexpr int SHM_V = KVBLK * HD * 2, SHM_K = SHM_V;
constexpr int NSLOT = 3;
constexpr int LDS_BYTES_ = NSLOT * SHM_V + NSLOT * SHM_K + NWAVES * 64 * 4;
#define ATT_KSWZ(row, colB) ((row) * 128 + ((colB) ^ ((((row) >> 1) & 7) << 4)))
#define ATT_SBAR() __builtin_amdgcn_sched_barrier(0)
__device__ __forceinline__ int crow(int r, int hi) { return (r & 3) + 8 * (r >> 2) + 4 * hi; }
__device__ __forceinline__ void cmask(f32x16& p0, f32x16& p1, int jb, int qrel, int hi) {
    const float NEG = -__builtin_inff(); const int kb = 64 * jb + 4 * hi;
#pragma unroll
    for (int r = 0; r < 16; ++r) { const int kv = kb + (r & 3) + 8 * (r >> 2); if (kv > qrel) p0[r] = NEG; if (kv + 32 > qrel) p1[r] = NEG; }
}
__device__ __forceinline__ void bmask(f32x16& p0, f32x16& p1, bool keep) {
    const float NEG = -__builtin_inff();
    if (!keep) {
#pragma unroll
        for (int r = 0; r < 16; ++r) { p0[r] = NEG; p1[r] = NEG; } }
}
__device__ __forceinline__ void partialSM(f32x16& p0, f32x16& p1, float& m_reg, float& mn, float& alpha, bool keep) {
    float pmax = p0[0];
#pragma unroll
    for (int r = 1; r < 16; ++r) pmax = fmaxf(pmax, p0[r]);
#pragma unroll
    for (int r = 0; r < 16; ++r) pmax = fmaxf(pmax, p1[r]);
    { auto rr = __builtin_amdgcn_permlane32_swap(__float_as_uint(pmax), __float_as_uint(pmax), false, false);
      pmax = fmaxf(__uint_as_float(rr[0]), __uint_as_float(rr[1])); }
    if (!keep) pmax = -__builtin_inff();
    constexpr float C2 = 1.4426950408889634f * SCALE;
    if (__builtin_expect(__all((pmax - m_reg) * SCALE <= THR), 1)) { mn = m_reg; alpha = 1.f; }
    else { mn = fmaxf(m_reg, pmax); alpha = __builtin_amdgcn_exp2f((m_reg - mn) * C2); m_reg = mn; }
    const float mnL = keep ? -mn * C2 : -__builtin_inff(), c2 = keep ? C2 : 0.f;
#pragma unroll
    for (int r = 0; r < 16; ++r) p0[r] = fmaf(p0[r], c2, mnL);
#pragma unroll
    for (int r = 0; r < 16; ++r) p1[r] = fmaf(p1[r], c2, mnL);
#pragma unroll
    for (int r = 0; r < 16; ++r) p0[r] = __builtin_amdgcn_exp2f(p0[r]);
}
__device__ __forceinline__ void finishSM(f32x16& p0, f32x16& p1, float alpha, float& l_reg, bf16x8& pa0, bf16x8& pa1, bf16x8& pa2, bf16x8& pa3) {
#pragma unroll
    for (int r = 0; r < 16; ++r) p1[r] = __builtin_amdgcn_exp2f(p1[r]);
    float ps = 0;
#pragma unroll
    for (int r = 0; r < 16; ++r) ps += p0[r];
#pragma unroll
    for (int r = 0; r < 16; ++r) ps += p1[r];
    { auto rr = __builtin_amdgcn_permlane32_swap(__float_as_uint(ps), __float_as_uint(ps), false, false);
      ps = __uint_as_float(rr[0]) + __uint_as_float(rr[1]); }
    l_reg = l_reg * alpha + ps;
#define ATT_PK4(P, B, OUT) do { unsigned a0 = cvt_pk_bf16(P[B+0], P[B+1]), a1 = cvt_pk_bf16(P[B+2], P[B+3]);             \
        unsigned b0 = cvt_pk_bf16(P[B+4], P[B+5]), b1 = cvt_pk_bf16(P[B+6], P[B+7]);                                       \
        auto r0 = __builtin_amdgcn_permlane32_swap(a0, b0, false, false); auto r1 = __builtin_amdgcn_permlane32_swap(a1, b1, false, false); \
        v4u w = {r0[0], r1[0], r0[1], r1[1]}; OUT = *reinterpret_cast<bf16x8*>(&w); } while (0)
    ATT_PK4(p0, 0, pa0); ATT_PK4(p0, 8, pa1); ATT_PK4(p1, 0, pa2); ATT_PK4(p1, 8, pa3);
#undef ATT_PK4
}
__device__ __forceinline__ void qkt(f32x16& p0, f32x16& p1, const LAS unsigned char* Ks, const bf16x8* qr, int r32, int hi) {
    p0 = f32x16{}; p1 = f32x16{};
#pragma unroll
    for (int d0 = 0; d0 < 4; ++d0) { const int cb = (d0 * 16 + hi * 8) * 2;
        const bf16x8 b0 = *(const LAS bf16x8*)(Ks + ATT_KSWZ(r32, cb));
        const bf16x8 b1 = *(const LAS bf16x8*)(Ks + ATT_KSWZ(32 + r32, cb));
        p0 = __builtin_amdgcn_mfma_f32_32x32x16_bf16(b0, qr[d0], p0, 0, 0, 0);
        p1 = __builtin_amdgcn_mfma_f32_32x32x16_bf16(b1, qr[d0], p1, 0, 0, 0); }
}
__device__ __forceinline__ void pv(f32x16* o, int vb, bf16x8 pa0, bf16x8 pa1, bf16x8 pa2, bf16x8 pa3) {
#pragma unroll
    for (int d0 = 0; d0 < 2; ++d0) { s16x4 lo[4], hi[4];
#pragma unroll
        for (int ks = 0; ks < 4; ++ks) { const int a = vb + d0 * 2048 + (ks >> 1) * 4096 + (ks & 1) * 1024;
            asm volatile("ds_read_b64_tr_b16 %0,%1" : "=&v"(lo[ks]) : "v"(a) : "memory");
            asm volatile("ds_read_b64_tr_b16 %0,%1 offset:256" : "=&v"(hi[ks]) : "v"(a) : "memory"); }
        asm volatile("s_waitcnt lgkmcnt(0)" ::: "memory"); ATT_SBAR();
#define ATT_PK(k) (bf16x8){lo[k][0], lo[k][1], lo[k][2], lo[k][3], hi[k][0], hi[k][1], hi[k][2], hi[k][3]}
        o[d0] = __builtin_amdgcn_mfma_f32_32x32x16_bf16(pa0, ATT_PK(0), o[d0], 0, 0, 0);
        o[d0] = __builtin_amdgcn_mfma_f32_32x32x16_bf16(pa1, ATT_PK(1), o[d0], 0, 0, 0);
        o[d0] = __builtin_amdgcn_mfma_f32_32x32x16_bf16(pa2, ATT_PK(2), o[d0], 0, 0, 0);
        o[d0] = __builtin_amdgcn_mfma_f32_32x32x16_bf16(pa3, ATT_PK(3), o[d0], 0, 0, 0);
#undef ATT_PK
    }
}
__device__ __forceinline__ void attn_unit(const Frame& F, int b, int h, int qb, LAS unsigned char* scratch) {
    PHASE_IDS;
    const int tid = TID_, wid = tid >> 6, lane = tid & 63, r32 = lane & 31, hi = lane >> 5;
    const bf16* Qg = wsp<bf16>(F, WS_Q); const bf16* Kg = wsp<bf16>(F, WS_K); const bf16* Vg = wsp<bf16>(F, WS_V);
    const size_t rowbase = (size_t)b * SEQ; const int q0 = qb * MOBA;
    const bf16* Qw = Qg + (rowbase + q0 + wid * QBLK) * AW + h * HD;
    const bf16* Kh = Kg + rowbase * AW + h * HD; const bf16* Vh = Vg + rowbase * AW + h * HD;
    LAS unsigned char* V_lds = scratch; LAS unsigned char* K_lds = scratch + NSLOT * SHM_V;
    LAS float* wsf = (LAS float*)(scratch + NSLOT * SHM_V + NSLOT * SHM_K) + wid * 64; LAS float* li_l = wsf; LAS float* al_l = wsf + 32;
    float m_reg = -1e30f, l_reg = 0.f; f32x16 o[2]; o[0] = f32x16{}; o[1] = f32x16{}; bf16x8 qr[4];
#pragma unroll
    for (int d0 = 0; d0 < 4; ++d0) qr[d0] = *(const bf16x8*)(Qw + (size_t)r32 * AW + d0 * 16 + hi * 8);
    unsigned sel = 0u;
    if (qb <= 3) sel = (1u << qb) - 1u;
    else {
        const float* km = wsp<float>(F, WS_KMEAN) + (size_t)((b * NH + h) * NBLK) * HD + (size_t)(r32 & 7) * HD + hi * 8;
        f32x4 kv[4][2];
#pragma unroll
        for (int d0 = 0; d0 < 4; ++d0) { kv[d0][0] = *(const f32x4*)(km + d0 * 16); kv[d0][1] = *(const f32x4*)(km + d0 * 16 + 4); }
        f32x16 gacc = f32x16{};
#pragma unroll
        for (int d0 = 0; d0 < 4; ++d0) { float f[8] = {kv[d0][0][0], kv[d0][0][1], kv[d0][0][2], kv[d0][0][3], kv[d0][1][0], kv[d0][1][1], kv[d0][1][2], kv[d0][1][3]};
            unsigned hw[4], lw[4];
#pragma unroll
            for (int p = 0; p < 4; ++p) { float a0 = f[2 * p], a1 = f[2 * p + 1]; if (r32 >= 8) { a0 = 0.f; a1 = 0.f; }
                const unsigned h0 = f2bf(a0), h1 = f2bf(a1); hw[p] = h0 | (h1 << 16); lw[p] = pk2(a0 - bf2f((bf16)h0), a1 - bf2f((bf16)h1)); }
            const v4u hv = {hw[0], hw[1], hw[2], hw[3]}, lv = {lw[0], lw[1], lw[2], lw[3]};
            gacc = __builtin_amdgcn_mfma_f32_32x32x16_bf16(__builtin_bit_cast(bf16x8, hv), qr[d0], gacc, 0, 0, 0);
            gacc = __builtin_amdgcn_mfma_f32_32x32x16_bf16(__builtin_bit_cast(bf16x8, lv), qr[d0], gacc, 0, 0, 0); }
        float g[8];
#pragma unroll
        for (int r = 0; r < 4; ++r) { const float mine = gacc[r], other = __shfl_xor(mine, 32); g[r] = hi ? other : mine; g[4 + r] = hi ? mine : other; }
        float b0 = -__builtin_inff(), b1 = b0, b2 = b0; int i0 = 0, i1 = 0, i2 = 0;
#pragma unroll
        for (int j = 0; j < NBLK - 1; ++j) { const float s_ = (j < qb) ? g[j] : -__builtin_inff();
            if (s_ > b0) { b2 = b1; i2 = i1; b1 = b0; i1 = i0; b0 = s_; i0 = j; } else if (s_ > b1) { b2 = b1; i2 = i1; b1 = s_; i1 = j; } else if (s_ > b2) { b2 = s_; i2 = j; } }
        sel = (1u << i0) | (1u << i1) | (1u << i2);
    }
    const int sr = tid >> 3, sc = (tid & 7) * 8;
    const int srv = ((tid >> 5) << 2) | ((tid >> 1) & 3), scv = ((tid & 1) << 3) | (((tid >> 3) & 3) << 4);
    const int vst = (srv >> 5) * 4096 + (scv >> 5) * 2048 + ((srv & 31) >> 2) * 256 + ((scv >> 4) & 1) * 128 + (srv & 3) * 32 + (scv & 8) * 2;
    const int vb0 = (int)(size_t)V_lds + (lane & 15) * 8 + ((lane >> 4) & 1) * 128 + (lane >> 5) * 512;
    bf16x8 st_v, st_k;
#define ATT_SLOAD(k0) do { st_v = *(const bf16x8*)(Vh + (size_t)((k0) + srv) * AW + scv); st_k = *(const bf16x8*)(Kh + (size_t)((k0) + sr) * AW + sc); } while (0)
#define ATT_SWRITE(bf) do { *(LAS bf16x8*)(V_lds + (bf) * SHM_V + vst) = st_v; *(LAS bf16x8*)(K_lds + (bf) * SHM_K + ATT_KSWZ(sr, sc * 2)) = st_k; } while (0)
#define ATT_RESC(a) do { if (__any((a) < 1.f)) { if (hi == 0) al_l[r32] = (a); asm volatile("s_waitcnt lgkmcnt(0)" ::: "memory");      \
        _Pragma("unroll") for (int d_ = 0; d_ < 2; ++d_) _Pragma("unroll") for (int r = 0; r < 16; ++r) o[d_][r] *= al_l[crow(r, hi)]; } } while (0)
    const int NT = (q0 + MOBA) / KVBLK;
    const int qrel = wid * QBLK + r32;
#define ATT_MASK(P0, P1, t) do { const int jb_ = (t) - (NT - 4); if (jb_ >= 0) cmask(P0, P1, jb_, qrel, hi); } while (0)
#define ATT_KEEP(t) ((((t) >= NT - 4) ? 1u : ((sel >> ((t) >> 2)) & 1u)) != 0u)
    f32x16 pA0, pA1, pB0, pB1; float mnA, mnB, alA, alB; bf16x8 pa0, pa1, pa2, pa3;
    int s0 = 0, s1 = 1, s2 = 2;
#define ATT_ROT() do { const int t_ = s0; s0 = s1; s1 = s2; s2 = t_; } while (0)
    ATT_SLOAD(0); asm volatile("s_waitcnt vmcnt(0)" ::: "memory"); ATT_SWRITE(0); ATT_SLOAD(KVBLK);
    s0 = 2; s1 = 0; s2 = 1;
    __syncthreads();
    asm volatile("s_waitcnt vmcnt(0)" ::: "memory"); ATT_SWRITE(s2); ATT_SLOAD(2 * KVBLK);
    qkt(pA0, pA1, K_lds + s1 * SHM_K, qr, r32, hi); ATT_MASK(pA0, pA1, 0); partialSM(pA0, pA1, m_reg, mnA, alA, ATT_KEEP(0));
    ATT_ROT();
    for (int j = 1; j < NT; j += 2) {
        __syncthreads();
        if (j + 1 < NT) { asm volatile("s_waitcnt vmcnt(0)" ::: "memory"); ATT_SWRITE(s2); if (j + 2 < NT) ATT_SLOAD((j + 2) * KVBLK); }
        ATT_SBAR(); qkt(pB0, pB1, K_lds + s1 * SHM_K, qr, r32, hi); ATT_MASK(pB0, pB1, j);
        finishSM(pA0, pA1, alA, l_reg, pa0, pa1, pa2, pa3); ATT_SBAR();
        pv(o, vb0 + s0 * SHM_V, pa0, pa1, pa2, pa3); partialSM(pB0, pB1, m_reg, mnB, alB, ATT_KEEP(j));
        ATT_RESC(alB); ATT_ROT();
        if (j + 1 < NT) {
            __syncthreads();
            if (j + 2 < NT) { asm volatile("s_waitcnt vmcnt(0)" ::: "memory"); ATT_SWRITE(s2); if (j + 3 < NT) ATT_SLOAD((j + 3) * KVBLK); }
            ATT_SBAR(); qkt(pA0, pA1, K_lds + s1 * SHM_K, qr, r32, hi); ATT_MASK(pA0, pA1, j + 1);
            finishSM(pB0, pB1, alB, l_reg, pa0, pa1, pa2, pa3); ATT_SBAR();
            pv(o, vb0 + s0 * SHM_V, pa0, pa1, pa2, pa3); partialSM(pA0, pA1, m_reg, mnA, alA, ATT_KEEP(j + 1));
            ATT_RESC(alA); ATT_ROT();
        }
    }
    finishSM(pB0, pB1, alB, l_reg, pa0, pa1, pa2, pa3); ATT_SBAR();
    pv(o, vb0 + s0 * SHM_V, pa0, pa1, pa2, pa3);
#undef ATT_ROT
    if (hi == 0) li_l[r32] = l_reg; asm volatile("s_waitcnt lgkmcnt(0)" ::: "memory");
    float rli[16];
#pragma unroll
    for (int r = 0; r < 16; ++r) rli[r] = __builtin_amdgcn_rcpf(li_l[crow(r, hi)]);
    bf16* Ow = wsp<bf16>(F, WS_MIX) + (rowbase + q0 + wid * QBLK) * DM + h * HD;
    float* ssqa = wsp<float>(F, WS_SSQA) + (rowbase + q0 + wid * QBLK) * NH + h;
    float qq[16];
#pragma unroll
    for (int r = 0; r < 16; ++r) { const int orow = crow(r, hi); float q2 = 0.f;
#pragma unroll
        for (int d0 = 0; d0 < 2; ++d0) { const float v = o[d0][r] * rli[r]; const float vn = __shfl_xor(v, 1); q2 += v * v;
            if ((r32 & 1) == 0) *(unsigned*)(Ow + (size_t)orow * DM + d0 * 32 + r32) = cvt_pk_bf16(v, vn); }
        qq[r] = q2; }
#pragma unroll
    for (int i = 0; i < 8; ++i) { const bool up = (lane & 16) != 0; const float send = up ? qq[i] : qq[i + 8], keep = up ? qq[i + 8] : qq[i]; qq[i] = keep + __shfl_xor(send, 16); }
#pragma unroll
    for (int i = 0; i < 4; ++i) { const bool up = (lane & 8) != 0; const float send = up ? qq[i] : qq[i + 4], keep = up ? qq[i + 4] : qq[i]; qq[i] = keep + __shfl_xor(send, 8); }
#pragma unroll
    for (int i = 0; i < 2; ++i) { const bool up = (lane & 4) != 0; const float send = up ? qq[i] : qq[i + 2], keep = up ? qq[i + 2] : qq[i]; qq[i] = keep + __shfl_xor(send, 4); }
    { const bool up = (lane & 2) != 0; const float send = up ? qq[0] : qq[1], keep = up ? qq[1] : qq[0]; qq[0] = keep + __shfl_xor(send, 2); }
    qq[0] += __shfl_xor(qq[0], 1);
    if ((lane & 1) == 0) ssqa[(size_t)crow(r32 >> 1, hi) * NH] = qq[0];
    __syncthreads();
#undef ATT_SLOAD
#undef ATT_SWRITE
#undef ATT_RESC
#undef ATT_MASK
#undef ATT_KEEP
}
}

namespace gm {
__device__ __forceinline__ int vt_off(int d, int s) { return d * 256 + ((((s >> 3) ^ (d & 15)) & 15) << 4) + (s & 7) * 2; }
__device__ __forceinline__ void units4(const Frame& F, int v, LAS unsigned char* scratch) {
    PHASE_IDS;
    const int tid = TID_, wid = tid >> 6, lane = tid & 63, fr = lane & 15, fq = lane >> 4;
    const int u = wid >> 1, half = wid & 1, uidx = 4 * v + u, b = uidx >> 6, c = (uidx >> 2) & 15, g = uidx & 3;
    const size_t row0 = (size_t)b * SEQ + c * GC;
    const bf16* VGg = wsp<bf16>(F, WS_VG) + row0 * GW + g * GD; const bf16* Ug = wsp<bf16>(F, WS_U) + row0 * GW + g * GD;
    LAS unsigned char* vt = scratch + u * 32768;
    { const int s_ = half * 64 + lane; const v4u* src = (const v4u*)(VGg + (size_t)s_ * GW); v4u raw[16]; float sum = 0.f, sq = 0.f;
#pragma unroll
      for (int i = 0; i < 16; ++i) raw[i] = src[i];
#pragma unroll
      for (int i = 0; i < 16; ++i) { const unsigned ww[4] = {raw[i].x, raw[i].y, raw[i].z, raw[i].w};
#pragma unroll
          for (int k = 0; k < 4; ++k) { const float a0 = bflo(ww[k]), a1 = bfhi(ww[k]); sum += a0 + a1; sq += a0 * a0 + a1 * a1; } }
      const float mu = sum * (1.f / GD); const float var = fmaxf(sq * (1.f / GD) - mu * mu, 0.f); const float rstd = 1.0f / sqrtf(var + EPS);
      const float* lg = F.ln_g + g * GD; const float* lb = F.ln_b + g * GD;
#pragma unroll
      for (int i = 0; i < 16; ++i) { const unsigned ww[4] = {raw[i].x, raw[i].y, raw[i].z, raw[i].w}; const f32x4 g0 = *(const f32x4*)(lg + 8 * i), g1 = *(const f32x4*)(lg + 8 * i + 4), b0 = *(const f32x4*)(lb + 8 * i), b1 = *(const f32x4*)(lb + 8 * i + 4);
          const float gg[8] = {g0[0], g0[1], g0[2], g0[3], g1[0], g1[1], g1[2], g1[3]}, bb[8] = {b0[0], b0[1], b0[2], b0[3], b1[0], b1[1], b1[2], b1[3]};
#pragma unroll
          for (int k = 0; k < 4; ++k) { const int d = 8 * i + 2 * k;
              *(LAS unsigned short*)(vt + vt_off(d, s_)) = (unsigned short)f2bf((bflo(ww[k]) - mu) * rstd * gg[2 * k] + bb[2 * k]);
              *(LAS unsigned short*)(vt + vt_off(d + 1, s_)) = (unsigned short)f2bf((bfhi(ww[k]) - mu) * rstd * gg[2 * k + 1] + bb[2 * k + 1]); } } }
    __syncthreads();
#pragma unroll 1
    for (int m = 0; m < 4; ++m) {
        const int tb = half * 64 + m * 16, t = tb + fr;
        const float* Wg = F.gws + (size_t)g * GC * GC + (size_t)t * GC;
        const int nks = (tb + 16 + 31) / 32;
        f32x4 w0[4], w1[4];
#pragma unroll
        for (int ks = 0; ks < 4; ++ks) if (ks < nks) { w0[ks] = *(const f32x4*)(Wg + ks * 32 + fq * 8); w1[ks] = *(const f32x4*)(Wg + ks * 32 + fq * 8 + 4); }
        const bf16* Ut = Ug + (size_t)t * GW + 4 * fq; v2u uu[8];
#pragma unroll
        for (int n = 0; n < 8; ++n) uu[n] = *(const v2u*)(Ut + n * 16);
        f32x4 acc[8];
#pragma unroll
        for (int n = 0; n < 8; ++n) acc[n] = (f32x4){0.f, 0.f, 0.f, 0.f};
#pragma unroll
        for (int ks = 0; ks < 4; ++ks) if (ks < nks) { const int s0 = ks * 32 + fq * 8;
            float wv[8] = {w0[ks][0], w0[ks][1], w0[ks][2], w0[ks][3], w1[ks][0], w1[ks][1], w1[ks][2], w1[ks][3]};
#pragma unroll
            for (int j = 0; j < 8; ++j) if (s0 + j > t) wv[j] = 0.f;
            v4u aw; aw.x = pk2(wv[0], wv[1]); aw.y = pk2(wv[2], wv[3]); aw.z = pk2(wv[4], wv[5]); aw.w = pk2(wv[6], wv[7]);
            const bf16x8 wf = *reinterpret_cast<const bf16x8*>(&aw);
#pragma unroll
            for (int n = 0; n < 8; ++n) { const bf16x8 vf = *(const LAS bf16x8*)(vt + vt_off(n * 16 + fr, s0));
                acc[n] = __builtin_amdgcn_mfma_f32_16x16x32_bf16(vf, wf, acc[n], 0, 0, 0); } }
        bf16* Og = wsp<bf16>(F, WS_MIX) + (row0 + t) * DM + AW + g * GD + 4 * fq; float* ssqg = wsp<float>(F, WS_SSQG) + (row0 + t) * GG + g;
        const float bs = F.gbs[g * GC + t]; float q2 = 0.f;
#pragma unroll
        for (int n = 0; n < 8; ++n) { const float o0 = bflo(uu[n].x) * (acc[n][0] + bs), o1 = bfhi(uu[n].x) * (acc[n][1] + bs), o2 = bflo(uu[n].y) * (acc[n][2] + bs), o3 = bfhi(uu[n].y) * (acc[n][3] + bs);
            q2 += (o0 * o0 + o1 * o1) + (o2 * o2 + o3 * o3); v2u w; w.x = cvt_pk_bf16(o0, o1); w.y = cvt_pk_bf16(o2, o3); *(v2u*)(Og + n * 16) = w; }
        q2 += __shfl_xor(q2, 16); q2 += __shfl_xor(q2, 32);
        if (fq == 0) ssqg[0] = q2;
    }
    __syncthreads();
}
}

__device__ __forceinline__ void p2_mixers(const Frame& F) {
    PHASE_IDS;
    LAS unsigned char* scratch = F.lds + RING_OFF;
    const int v = F.vcu, bh = v >> 1, s0 = (v & 1) * 2, cslot = (v >> 1) % 6;
    int item = 0;
#pragma unroll 1
    for (int st = 0; st < 6; ++st) {
        if (st == cslot) { constexpr int PER_WG = XW_ITEMS / 256; static_assert(XW_ITEMS % 256 == 0 && PER_WG % NWAVES == 0, "items per workgroup / wave");
            LAS float* scr = (LAS float*)(F.lds + RING_OFF + WAVE_ * P0_SCR_WAVE);
            constexpr int NI = PER_WG / NWAVES; static_assert(NI % 2 == 0, "pairs");
            int ln = LANE_; asm volatile("" : "+v"(ln));
            const int it0 = v * PER_WG + WAVE_; f32x4 va[16], vb[16]; XwDesc da = xw_desc(F, it0, ln), db; xw_load(va, da);
#pragma unroll 1
            for (int j = 0; j < NI; j += 2) {
                db = xw_desc(F, it0 + (j + 1) * NWAVES, ln); xw_load(vb, db);
                xw_process(va, da, scr, ln);
                if (j + 2 < NI) { da = xw_desc(F, it0 + (j + 2) * NWAVES, ln); xw_load(va, da); }
                xw_process(vb, db, scr, ln);
            }
            __syncthreads(); }
        else { if (item < 4) { const int qq = s0 + (item >> 1); const int qb = (item & 1) ? 7 - qq : qq; att::attn_unit(F, bh / NH, bh % NH, qb, scratch); }
               else gm::units4(F, v, scratch);
               ++item; }
    }
}

__device__ __forceinline__ void p4_router(const Frame& F) {
    PHASE_IDS;
    const int tid = TID_, wid = tid >> 6, lane = tid & 63, tk = lane & 31, hf = lane >> 5;
    LAS unsigned* hist = (LAS unsigned*)(F.lds + XTAB_OFF + 4096);
    LAS unsigned* base = hist + 32;
    static_assert(XTAB_OFF + 4096 >= 8 * P0_SCR_WAVE, "router words above the conversion tiles");
    const bf16* RWT = wsp<bf16>(F, WS_RWT); const bf16* x1 = wsp<bf16>(F, WS_X1B); const float* ssq1 = wsp<float>(F, WS_SSQ1);
    unsigned* cntg = (unsigned*)(F.ctl + CW_CNT);
    unsigned* IDX = wsp<unsigned>(F, WS_IDX); float* GSS = wsp<float>(F, WS_GSS); float* RSS = wsp<float>(F, WS_RSS); unsigned* TOKPOS = wsp<unsigned>(F, WS_TOKPOS);
    if (tid < 32) hist[tid] = 0u;
    __syncthreads();
    const bool active = wid < 4; const int tok = (F.vcu * 4 + (wid & 3)) * 32 + tk;
    int pe[4] = {0, 0, 0, 0}; float pg[4] = {0.f, 0.f, 0.f, 0.f}; unsigned rank[2] = {0u, 0u}; int my_e[2] = {0, 0}; float my_g[2] = {0.f, 0.f}; float rstd = 0.f;
    if (active) {
        { const f32x4* sp = (const f32x4*)(ssq1 + (size_t)tok * 16); const f32x4 a = sp[0], b = sp[1], c = sp[2], d = sp[3];
          const float s_ = ((a[0] + a[1]) + (a[2] + a[3])) + ((b[0] + b[1]) + (b[2] + b[3])) + ((c[0] + c[1]) + (c[2] + c[3])) + ((d[0] + d[1]) + (d[2] + d[3]));
          rstd = 1.0f / sqrtf(s_ * (1.f / DM) + EPS); }
        f32x16 acc = f32x16{};
        { const bf16* xr = x1 + (size_t)tok * DM + 8 * hf; const bf16* wh = RWT + (size_t)tk * DM + 8 * hf; const bf16* wl = wh + NE * DM;
#pragma unroll 8
          for (int s_ = 0; s_ < 64; ++s_) { const bf16x8 xv = *(const bf16x8*)(xr + 16 * s_), a_hi = *(const bf16x8*)(wh + 16 * s_), a_lo = *(const bf16x8*)(wl + 16 * s_);
              acc = __builtin_amdgcn_mfma_f32_32x32x16_bf16(a_hi, xv, acc, 0, 0, 0); acc = __builtin_amdgcn_mfma_f32_32x32x16_bf16(a_lo, xv, acc, 0, 0, 0); } }
        float lv[16];
#pragma unroll
        for (int r = 0; r < 16; ++r) { const int e = (r & 3) + 8 * (r >> 2) + 4 * hf; lv[r] = acc[r] * rstd + F.router_b[e]; }
        float tv[4]; int ti[4]; unsigned used = 0u;
#pragma unroll
        for (int k = 0; k < 4; ++k) { float best = -__builtin_inff(); int br = 0;
#pragma unroll
            for (int r = 0; r < 16; ++r) { const int e = (r & 3) + 8 * (r >> 2) + 4 * hf; const int eb = (br & 3) + 8 * (br >> 2) + 4 * hf;
                const bool better = !((used >> r) & 1u) && (lv[r] > best || (lv[r] == best && e < eb)); if (better) { best = lv[r]; br = r; } }
            used |= 1u << br; tv[k] = best; ti[k] = (br & 3) + 8 * (br >> 2) + 4 * hf; }
        float ov[4]; int oi[4];
#pragma unroll
        for (int k = 0; k < 4; ++k) { ov[k] = __shfl_xor(tv[k], 32); oi[k] = __shfl_xor(ti[k], 32); }
        int ia = 0, ib = 0;
#pragma unroll
        for (int k = 0; k < 4; ++k) {
            float va = tv[0], vb = ov[0]; int ea = ti[0], eb = oi[0];
#pragma unroll
            for (int q = 1; q < 4; ++q) { if (ia == q) { va = tv[q]; ea = ti[q]; } if (ib == q) { vb = ov[q]; eb = oi[q]; } }
            const bool takeA = (va > vb) || (va == vb && ea < eb);
            pg[k] = takeA ? va : vb; pe[k] = takeA ? ea : eb; if (takeA) ++ia; else ++ib; }
        { const float m = pg[0]; float s_ = 0.f;
#pragma unroll
          for (int k = 0; k < 4; ++k) { pg[k] = __builtin_amdgcn_exp2f((pg[k] - m) * 1.4426950408889634f); s_ += pg[k]; }
          const float inv = 1.0f / s_;
#pragma unroll
          for (int k = 0; k < 4; ++k) pg[k] *= inv; }
        { const int m = -hf; my_e[0] = pe[0] ^ ((pe[0] ^ pe[2]) & m); my_e[1] = pe[1] ^ ((pe[1] ^ pe[3]) & m);
          const unsigned g0 = __float_as_uint(pg[0]), g1 = __float_as_uint(pg[1]), g2 = __float_as_uint(pg[2]), g3 = __float_as_uint(pg[3]);
          my_g[0] = __uint_as_float(g0 ^ ((g0 ^ g2) & (unsigned)m)); my_g[1] = __uint_as_float(g1 ^ ((g1 ^ g3) & (unsigned)m)); }
#pragma unroll
        for (int q = 0; q < 2; ++q) rank[q] = atomicAdd((unsigned*)&hist[my_e[q]], 1u);
    }
    __syncthreads();
    if (tid < 32) base[tid] = atomicAdd(cntg + tid, hist[tid]);
    __syncthreads();
    if (active) {
#pragma unroll
        for (int q = 0; q < 2; ++q) { const int k = 2 * hf + q; const int e = my_e[q]; const float g = my_g[q];
            const unsigned slot = base[e] + rank[q];
            IDX[(size_t)e * T + slot] = (unsigned)tok; GSS[(size_t)e * T + slot] = g; RSS[(size_t)e * T + slot] = rstd; TOKPOS[(size_t)tok * 4 + k] = ((unsigned)e << 16) | slot; }
    }
    __syncthreads();
}

__device__ __forceinline__ void build_tstart(const Frame& F, LAS unsigned* tstart, int tid) {
    if (tid < 64) { const unsigned* cntg = (const unsigned*)(F.ctl + CW_CNT); unsigned c = (tid < NE) ? cntg[tid] : 0u; if (c > (unsigned)T) c = (unsigned)T;
        unsigned x = (c + 255u) >> 8;
#pragma unroll
        for (int o = 1; o < 32; o <<= 1) { const unsigned y = __shfl_up(x, o); if ((tid & 63) >= o) x += y; }
        if (tid < NE) tstart[tid + 1] = x; if (tid == 0) tstart[0] = 0u; }
}
constexpr int MAXU = 17;
constexpr int XT_TSTART = 0, XT_ULIST = 256, XT_RS = 512, XT_GTAB = XT_RS + MAXU * 1024;
static_assert(XT_GTAB + MAXU * 512 <= LDSCTL_OFF - XTAB_OFF, "xtab");
__device__ __forceinline__ int moe_build_tables(const Frame& F, int P  , int mode) {
    PHASE_IDS;
    LAS unsigned* tstart = (LAS unsigned*)(F.lds + XTAB_OFF + XT_TSTART);
    LAS unsigned* ulist = (LAS unsigned*)(F.lds + XTAB_OFF + XT_ULIST);
    LAS float* rs = (LAS float*)(F.lds + XTAB_OFF + XT_RS);
    LAS unsigned short* gtab = (LAS unsigned short*)(F.lds + XTAB_OFF + XT_GTAB);
    const unsigned* cntg = (const unsigned*)(F.ctl + CW_CNT); const unsigned* IDX = wsp<unsigned>(F, WS_IDX);
    const float* RSRC = mode == 1 ? wsp<float>(F, WS_RSS) : wsp<float>(F, WS_GSS);
    const int tid = TID_;
    build_tstart(F, tstart, tid);
    __syncthreads();
    const int NT_ = (int)tstart[NE], U = NT_ * P, G = F.G, c = (int)blockIdx.x;
    int nunits = (c < U) ? (U - c + G - 1) / G : 0; if (nunits > MAXU) nunits = MAXU;
    if (tid < nunits) { const int L = tid * G + c; int gt, pn; pg8::flat_to_tile(L, U, NT_, P, gt, pn);
        int e = 0; for (int k = 1; k < NE; ++k) if ((unsigned)gt >= tstart[k]) e = k;
        const int rt = gt - (int)tstart[e];
        ulist[tid] = (unsigned)gt | ((unsigned)pn << 10) | ((unsigned)e << 13) | ((unsigned)rt << 18); }
    __syncthreads();
    {
        constexpr int NP = (MAXU + 1) / 2; unsigned tokv[NP]; float rsv[NP];
#pragma unroll
        for (int p = 0; p < NP; ++p) { const int i = 2 * p + (tid >> 8), r = tid & 255; tokv[p] = 0u; rsv[p] = 0.f;
            if (i < nunits) { const unsigned w = ulist[i]; const int e = (int)((w >> 13) & 0x1fu), rt = (int)(w >> 18);
                unsigned cn = cntg[e]; if (cn > (unsigned)T) cn = (unsigned)T; const unsigned slot = (unsigned)rt * 256u + (unsigned)r;
                if (slot < cn) { if (mode == 1) tokv[p] = IDX[(size_t)e * T + slot]; rsv[p] = RSRC[(size_t)e * T + slot]; } } }
#pragma unroll
        for (int p = 0; p < NP; ++p) { const int i = 2 * p + (tid >> 8), r = tid & 255;
            if (i < nunits) { unsigned tok = tokv[p]; if (tok >= (unsigned)T) tok = 0u; if (mode == 1) gtab[i * 256 + r] = (unsigned short)tok; rs[i * 256 + r] = rsv[p]; } }
    }
    __syncthreads();
    return nunits;
}

__device__ __forceinline__ void p7_combine(const Frame& F) {
    PHASE_IDS;
    LAS unsigned* tstart = (LAS unsigned*)(F.lds + XTAB_OFF + XT_TSTART);
    const unsigned* cntg = (const unsigned*)(F.ctl + CW_CNT);
    build_tstart(F, tstart, TID_); (void)cntg;
    __syncthreads();
    const int gw = F.vcu * NWAVES + WAVE_, NGW = F.G * NWAVES;
    const unsigned* TOKPOS = wsp<unsigned>(F, WS_TOKPOS); const unsigned char* Y = wsp<unsigned char>(F, WS_YBUF); const bf16* X1 = wsp<bf16>(F, WS_X1B); bf16* X2 = wsp<bf16>(F, WS_X2B); unsigned char* X28 = wsp<unsigned char>(F, WS_X2F8); float* RS2 = wsp<float>(F, WS_RSTD2);
    for (int m0 = gw; m0 < T; m0 += 2 * NGW) {
        f32x4 v[2][4]; unsigned yv[2][4][4]; float s[2] = {0.f, 0.f};
#pragma unroll
        for (int r = 0; r < 2; ++r) { const int m = m0 + r * NGW;
            const v4u tp = *(const v4u*)(TOKPOS + (size_t)m * 4); const unsigned tpw[4] = {tp.x, tp.y, tp.z, tp.w};
            size_t yrow[4];
#pragma unroll
            for (int k = 0; k < 4; ++k) { const unsigned e = (tpw[k] >> 16) & 31u, slot = tpw[k] & 0xffffu; yrow[k] = ((size_t)tstart[e] * 256u + slot) * DM; }
#pragma unroll
            for (int j = 0; j < 4; ++j) { const v2u xw = *(const v2u*)(X1 + (size_t)m * DM + 4 * LANE_ + 256 * j); v[r][j] = (f32x4){bflo(xw.x), bfhi(xw.x), bflo(xw.y), bfhi(xw.y)};
#pragma unroll
                for (int k = 0; k < 4; ++k) yv[r][j][k] = *(const unsigned*)(Y + yrow[k] + 4 * LANE_ + 256 * j); } }
#pragma unroll
        for (int r = 0; r < 2; ++r) {
#pragma unroll
            for (int j = 0; j < 4; ++j) {
#pragma unroll
                for (int k = 0; k < 4; ++k) { const unsigned w = yv[r][j][k]; const f32x2 lo = __builtin_amdgcn_cvt_pk_f32_fp8((int)w, false), hi2 = __builtin_amdgcn_cvt_pk_f32_fp8((int)w, true);
                    v[r][j][0] += lo[0] * (1.0f / Y_SCALE); v[r][j][1] += lo[1] * (1.0f / Y_SCALE); v[r][j][2] += hi2[0] * (1.0f / Y_SCALE); v[r][j][3] += hi2[1] * (1.0f / Y_SCALE); }
                s[r] += (v[r][j].x * v[r][j].x + v[r][j].y * v[r][j].y) + (v[r][j].z * v[r][j].z + v[r][j].w * v[r][j].w); } }
#pragma unroll
        for (int r = 0; r < 2; ++r) { const int m = m0 + r * NGW; const float rstd = 1.0f / sqrtf(wave_sum(s[r]) * (1.f / DM) + EPS);
            if (LANE_ == 0) RS2[m] = rstd;
#pragma unroll
            for (int j = 0; j < 4; ++j) { v2u w; w.x = cvt_pk_bf16(v[r][j].x, v[r][j].y); w.y = cvt_pk_bf16(v[r][j].z, v[r][j].w); *(v2u*)(X2 + (size_t)m * DM + 4 * LANE_ + 256 * j) = w;
                *(unsigned*)(X28 + (size_t)m * DM + 4 * LANE_ + 256 * j) = pk4_fp8(v[r][j].x, v[r][j].y, v[r][j].z, v[r][j].w); } }
    }
}

__device__ __forceinline__ void p9_final(const Frame& F) {
    PHASE_IDS;
    const int gw = F.vcu * NWAVES + WAVE_, NGW = F.G * NWAVES;
    const unsigned char* GATE = wsp<unsigned char>(F, WS_GATE); const unsigned char* PP = wsp<unsigned char>(F, WS_PP); const float* ssqpp = wsp<float>(F, WS_SSQPP);
    for (int m0 = gw; m0 < T; m0 += 2 * NGW) {
        f32x4 v[2][4]; unsigned gv[2][4], pv_[2][4]; f32x4 sq[2][4]; float s[2] = {0.f, 0.f};
#pragma unroll
        for (int r = 0; r < 2; ++r) { const int m = m0 + r * NGW; const bf16* x2r = wsp<bf16>(F, WS_X2B) + (size_t)m * DM;
#pragma unroll
            for (int q = 0; q < 4; ++q) sq[r][q] = *(const f32x4*)(ssqpp + (size_t)m * 16 + 4 * q);
#pragma unroll
            for (int j = 0; j < 4; ++j) { const int col = 4 * LANE_ + 256 * j; const v2u xw = *(const v2u*)(x2r + col); v[r][j] = (f32x4){bflo(xw.x), bfhi(xw.x), bflo(xw.y), bfhi(xw.y)};
                gv[r][j] = *(const unsigned*)(GATE + (size_t)m * DM + col); pv_[r][j] = *(const unsigned*)(PP + (size_t)m * DM + col); } }
#pragma unroll
        for (int r = 0; r < 2; ++r) { const f32x4 a = sq[r][0], b = sq[r][1], c = sq[r][2], d = sq[r][3];
            const float sp = ((a[0] + a[1]) + (a[2] + a[3])) + ((b[0] + b[1]) + (b[2] + b[3])) + ((c[0] + c[1]) + (c[2] + c[3])) + ((d[0] + d[1]) + (d[2] + d[3]));
            const float rpp = 1.0f / sqrtf(sp * (1.f / DM) + EPS);
#pragma unroll
            for (int j = 0; j < 4; ++j) { const int col = 4 * LANE_ + 256 * j; const f32x4 pg_ = *(const f32x4*)(F.ppn + col);
                const f32x2 g01 = __builtin_amdgcn_cvt_pk_f32_fp8((int)gv[r][j], false), g23 = __builtin_amdgcn_cvt_pk_f32_fp8((int)gv[r][j], true);
                const f32x2 p01 = __builtin_amdgcn_cvt_pk_f32_fp8((int)pv_[r][j], false), p23 = __builtin_amdgcn_cvt_pk_f32_fp8((int)pv_[r][j], true);
                const float rg = rpp * (1.0f / GATE_SCALE);
                v[r][j][0] += g01[0] * (p01[0] * rg * pg_[0]); v[r][j][1] += g01[1] * (p01[1] * rg * pg_[1]);
                v[r][j][2] += g23[0] * (p23[0] * rg * pg_[2]); v[r][j][3] += g23[1] * (p23[1] * rg * pg_[3]);
                s[r] += (v[r][j].x * v[r][j].x + v[r][j].y * v[r][j].y) + (v[r][j].z * v[r][j].z + v[r][j].w * v[r][j].w); } }
#pragma unroll
        for (int r = 0; r < 2; ++r) { const int m = m0 + r * NGW; float* xr = F.out + (size_t)m * DM; const float rstd = 1.0f / sqrtf(wave_sum(s[r]) * (1.f / DM) + EPS);
#pragma unroll
            for (int j = 0; j < 4; ++j) { const int col = 4 * LANE_ + 256 * j; const f32x4 fg = *(const f32x4*)(F.final_norm + col); __builtin_nontemporal_store(v[r][j] * rstd * fg, (f32x4*)(xr + col)); } }
    }
}

struct Args { const float* in[23]; float* out; unsigned char* ws; };
#if CHECK_STAGE
__device__ __forceinline__ unsigned hmix(unsigned z) { z ^= z >> 16; z *= 0x7feb352du; z ^= z >> 15; z *= 0x846ca68bu; z ^= z >> 16; return z; }
__device__ __forceinline__ void chk_add(const Frame& F, int st, bool bad) { atomicAdd((unsigned*)(F.ctl + CW_CHK + 2 * st), bad ? 1u : 0u); atomicAdd((unsigned*)(F.ctl + CW_CHK + 2 * st + 1), 1u); }
__device__ __forceinline__ bool offby(float got, float ex, float rel, float ab) { const float d = fabsf(got - ex); return !(d <= rel * fabsf(ex) + ab); }
__device__ __forceinline__ float dot_bf(const bf16* a, const bf16* b, int n) { float s = 0.f; for (int k = 0; k < n; ++k) s += bf2f(a[k]) * bf2f(b[k]); return s; }
__device__ __forceinline__ float gelu_ref(float v) { return 0.5f * v * (1.0f + erff(v * 0.70710678f)); }
__device__ __forceinline__ unsigned chk_tstart(const Frame& F, unsigned ex) { const unsigned* cntg = (const unsigned*)(F.ctl + CW_CNT); unsigned s_ = 0; for (unsigned e = 0; e < ex; ++e) { unsigned c = cntg[e]; if (c > (unsigned)T) c = T; s_ += (c + 255u) >> 8; } return s_; }
template <int ST> __device__ __forceinline__ void stage_check(const Frame& F) {
    const unsigned gt = (unsigned)blockIdx.x * NTHR + threadIdx.x;
    const unsigned h0 = hmix(gt * 2654435761u + ST * 40503u), h1 = hmix(h0 + 0x9e3779b9u), h2 = hmix(h1 + 0x85ebca6bu);
    if (ST == 1) {
        if (gt >= 16384) return;
        const int which = gt & 7;
        if (which == 0) { const int e = h0 % NE, n = h1 % (2 * FF), k = h2 % DM; const int lc = CmWgu()(n);
            const float ex = bf2f((bf16)f2bf(F.w_gu[((size_t)e * DM + k) * 2 * FF + lc] * F.ffn_norm[k])); chk_add(F, ST, offby(bf2f(wsp<bf16>(F, WS_WGU)[((size_t)e * 2 * FF + n) * DM + k]), ex, 1e-6f, 1e-30f)); }
        else if (which == 1) { const int e = h0 % NE, n = h1 % DM, k = h2 % FF;
            const float ex = bf2f((bf16)f2bf(F.w_dn[((size_t)e * FF + k) * DM + n])); chk_add(F, ST, offby(bf2f(wsp<bf16>(F, WS_WDN)[((size_t)e * DM + n) * FF + k]), ex, 1e-6f, 1e-30f)); }
        else if (which == 2) { const int n = h1 % NPROJ, k = h2 % DM; const int lc = CmWin()(n);
            const float ex = bf2f((bf16)f2bf(F.w_in[(size_t)k * NPROJ + lc] * F.mix_norm[k])); chk_add(F, ST, offby(bf2f(wsp<bf16>(F, WS_WIN)[(size_t)n * DM + k]), ex, 1e-6f, 1e-30f)); }
        else if (which == 3) { const int n = h1 % DM, k = h2 % DM; const float g = k < AW ? F.aon[k] : F.gon[k - AW];
            const float ex = bf2f((bf16)f2bf(F.w_out[(size_t)k * DM + n] * g)); chk_add(F, ST, offby(bf2f(wsp<bf16>(F, WS_WOUT)[(size_t)n * DM + k]), ex, 1e-6f, 1e-30f)); }
        else if (which == 4) { const int n = h1 % DM, k = h2 % DM;
            const float ex = bf2f((bf16)f2bf(F.w_pg[(size_t)k * DM + n] * F.ple_norm[k])); chk_add(F, ST, offby(bf2f(wsp<bf16>(F, WS_WPG)[(size_t)n * DM + k]), ex, 1e-6f, 1e-30f)); }
        else if (which == 5) { const int n = h1 % DM, k = h2 % PLE;
            const float ex = bf2f((bf16)f2bf(F.w_pp[(size_t)k * DM + n])); chk_add(F, ST, offby(bf2f(wsp<bf16>(F, WS_WPP)[(size_t)n * PLE + k]), ex, 1e-6f, 1e-30f)); }
        else if (which == 6) { const int row = h0 % T, k = h1 % DM; float ss = 0.f; for (int j = 0; j < DM; ++j) { const float v = F.x[(size_t)row * DM + j]; ss += v * v; }
            const float ex = F.x[(size_t)row * DM + k] / sqrtf(ss / DM + EPS); chk_add(F, ST, offby(bf2f(wsp<bf16>(F, WS_XNB)[(size_t)row * DM + k]), ex, 0.01f, 1e-3f)); }
        else { const int row = h0 % T, k = h1 % PLE; chk_add(F, ST, offby(bf2f(wsp<bf16>(F, WS_PB)[(size_t)row * PLE + k]), F.p[(size_t)row * PLE + k], 0.005f, 1e-6f)); }
    }
    if (ST == 2) {
        if (gt >= 16384) return;
        const bf16* XN = wsp<bf16>(F, WS_XNB); const bf16* WIN = wsp<bf16>(F, WS_WIN);
        if ((gt & 7) == 7) {
            const int b = h0 % BATCH, hh = h1 % NH, blk = h2 % NBLK, c = (h2 >> 8) % HD; float s_ = 0.f;
            for (int r = 0; r < 256; ++r) s_ += bf2f(wsp<bf16>(F, WS_K)[((size_t)b * SEQ + blk * 256 + r) * AW + hh * HD + c]);
            chk_add(F, ST, offby(wsp<float>(F, WS_KMEAN)[((size_t)(b * NH + hh) * NBLK + blk) * HD + c], s_, 0.02f, 0.3f)); return; }
        const int row = h0 % T, type = h1 % 5, c = h2 % AW; const bf16* xr = XN + (size_t)row * DM;
        const float v = dot_bf(xr, WIN + (size_t)(type * AW + c) * DM, DM); float ex;
        if (type <= 1) { const float vp = dot_bf(xr, WIN + (size_t)(type * AW + (c ^ 4)) * DM, DM); const int i = 4 * ((c & 63) >> 3) + (c & 3), pos = row & (SEQ - 1);
            const float cs = wsp<float>(F, WS_ROPE)[pos * 32 + i], sn = wsp<float>(F, WS_ROPE)[SEQ * 32 + pos * 32 + i];
            { const float inv = powf(10000.0f, -(float)i / 32.0f); const float ang = (float)pos * inv; if (offby(cs, cosf(ang), 0.f, 1e-3f) || offby(sn, sinf(ang), 0.f, 1e-3f)) { chk_add(F, ST, true); return; } }
            ex = (c & 4) ? v * cs + vp * sn : v * cs - vp * sn; }
        else if (type == 2) ex = v; else ex = gelu_ref(v);
        chk_add(F, ST, offby(bf2f(wsp<bf16>(F, WS_Q)[(size_t)type * (16u << 20) + (size_t)row * AW + c]), ex, 0.02f, 0.02f));
    }
    if (ST == 3) {
        if (gt >= 8192) return;
        if (gt & 1) {
            const int row = h0 % T, g = h1 % GG, d = h2 % GD; const int b = row / SEQ, s_ = row % SEQ, c = s_ / GC, t = s_ % GC; float acc = 0.f;
            for (int sp = 0; sp <= t; ++sp) { const bf16* vr = wsp<bf16>(F, WS_VG) + ((size_t)b * SEQ + c * GC + sp) * GW + g * GD; float mu = 0.f; for (int j = 0; j < GD; ++j) mu += bf2f(vr[j]); mu /= GD;
                float var = 0.f; for (int j = 0; j < GD; ++j) { const float dd = bf2f(vr[j]) - mu; var += dd * dd; } const float rstd = 1.0f / sqrtf(var / GD + EPS);
                const float vn = bf2f((bf16)f2bf((bf2f(vr[d]) - mu) * rstd * F.ln_g[g * GD + d] + F.ln_b[g * GD + d])); acc += bf2f((bf16)f2bf(F.gws[((size_t)g * GC + t) * GC + sp])) * vn; }
            const float ex = bf2f(wsp<bf16>(F, WS_U)[(size_t)row * GW + g * GD + d]) * (acc + F.gbs[g * GC + t]);
            chk_add(F, ST, offby(bf2f(wsp<bf16>(F, WS_MIX)[(size_t)row * DM + AW + g * GD + d]), ex, 0.03f, 0.02f)); return; }
        const int row = h0 % T, hh = h1 % NH; const int b = row / SEQ, s_ = row % SEQ, qb = s_ / MOBA; float q[HD];
#pragma unroll
        for (int c = 0; c < HD; ++c) q[c] = bf2f(wsp<bf16>(F, WS_Q)[(size_t)row * AW + hh * HD + c]);
        unsigned sel = 0u;
        if (qb <= 3) sel = (1u << qb) - 1u;
        else { float b0 = -__builtin_inff(), b1 = b0, b2 = b0; int i0 = 0, i1 = 0, i2 = 0;
            for (int j = 0; j < qb; ++j) { const float* km = wsp<float>(F, WS_KMEAN) + ((size_t)(b * NH + hh) * NBLK + j) * HD; float g = 0.f;
#pragma unroll
                for (int c = 0; c < HD; ++c) g += q[c] * km[c];
                if (g > b0) { b2 = b1; i2 = i1; b1 = b0; i1 = i0; b0 = g; i0 = j; } else if (g > b1) { b2 = b1; i2 = i1; b1 = g; i1 = j; } else if (g > b2) { b2 = g; i2 = j; } }
            sel = (1u << i0) | (1u << i1) | (1u << i2); }
        float mx = -__builtin_inff();
        for (int kp = 0; kp <= s_; ++kp) { const int blk = kp / MOBA; if (blk != qb && !((sel >> blk) & 1u)) continue; const bf16* kr = wsp<bf16>(F, WS_K) + ((size_t)b * SEQ + kp) * AW + hh * HD; float sc = 0.f;
#pragma unroll
            for (int c = 0; c < HD; ++c) sc += q[c] * bf2f(kr[c]);
            mx = fmaxf(mx, sc * 0.125f); }
        float o[HD]; float l = 0.f;
#pragma unroll
        for (int c = 0; c < HD; ++c) o[c] = 0.f;
        for (int kp = 0; kp <= s_; ++kp) { const int blk = kp / MOBA; if (blk != qb && !((sel >> blk) & 1u)) continue; const bf16* kr = wsp<bf16>(F, WS_K) + ((size_t)b * SEQ + kp) * AW + hh * HD; float sc = 0.f;
#pragma unroll
            for (int c = 0; c < HD; ++c) sc += q[c] * bf2f(kr[c]);
            const float pr = expf(sc * 0.125f - mx); l += pr; const bf16* vr = wsp<bf16>(F, WS_V) + ((size_t)b * SEQ + kp) * AW + hh * HD;
#pragma unroll
            for (int c = 0; c < HD; ++c) o[c] += pr * bf2f(vr[c]); }
        bool bad = false; float ss = 0.f;
#pragma unroll
        for (int c = 0; c < HD; ++c) { const float ex = o[c] / l; ss += ex * ex; bad |= offby(bf2f(wsp<bf16>(F, WS_MIX)[(size_t)row * DM + hh * HD + c]), ex, 0.04f, 0.02f); }
        bad |= offby(wsp<float>(F, WS_SSQA)[(size_t)row * NH + hh], ss, 0.03f, 1e-3f);
        chk_add(F, ST, bad);
    }
    if (ST == 4) {
        if (gt >= 16384) return;
        const int row = h0 % T, col = h1 % DM; const bf16* mr = wsp<bf16>(F, WS_MIX) + (size_t)row * DM; const bf16* wr_ = wsp<bf16>(F, WS_WOUT) + (size_t)col * DM;
        float sa = 0.f, sg = 0.f, da = 0.f, dg = 0.f;
        for (int k = 0; k < AW; ++k) { const float a = bf2f(mr[k]), g = bf2f(mr[AW + k]); sa += a * a; sg += g * g; da += a * bf2f(wr_[k]); dg += g * bf2f(wr_[AW + k]); }
        const float ex = F.x[(size_t)row * DM + col] + da / sqrtf(sa / AW + EPS) + dg / sqrtf(sg / GW + EPS);
        chk_add(F, ST, offby(F.out[(size_t)row * DM + col], ex, 0.01f, 0.03f));
    }
    if (ST == 5) {
        if (gt >= 8192) return;
        const int tok = h0 % T; const float* xr = F.out + (size_t)tok * DM; float ss = 0.f; for (int k = 0; k < DM; ++k) ss += xr[k] * xr[k]; const float rstd = 1.0f / sqrtf(ss / DM + EPS);
        bool bad = false;
        for (int j = 0; j < 4; ++j) { const int k = (h1 >> (8 * j)) % DM; bad |= offby(bf2f(wsp<bf16>(F, WS_XNB)[(size_t)tok * DM + k]), xr[k] * rstd, 0.01f, 1e-3f); }
        float lg[NE];
#pragma unroll
        for (int e = 0; e < NE; ++e) lg[e] = 0.f;
        for (int k = 0; k < DM; ++k) { const float xv = xr[k] * rstd * F.ffn_norm[k];
#pragma unroll
            for (int e = 0; e < NE; ++e) lg[e] += xv * F.router_w[k * NE + e]; }
#pragma unroll
        for (int e = 0; e < NE; ++e) lg[e] += F.router_b[e];
        int te[4]; float tv[4]; unsigned used = 0u;
#pragma unroll
        for (int k = 0; k < 4; ++k) { float best = -__builtin_inff(); int bi = 0;
#pragma unroll
            for (int e = 0; e < NE; ++e) if (!((used >> e) & 1u) && lg[e] > best) { best = lg[e]; bi = e; }
            used |= 1u << bi; te[k] = bi; tv[k] = best; }
        { float gg[4]; float den = 0.f;
#pragma unroll
          for (int k = 0; k < 4; ++k) { float v = -__builtin_inff();
#pragma unroll
              for (int e = 0; e < NE; ++e) if (e == te[k]) v = lg[e];
              gg[k] = v; }
          const float mm = gg[0];
#pragma unroll
          for (int k = 0; k < 4; ++k) { gg[k] = expf(gg[k] - mm); den += gg[k]; }
          const unsigned* tp = wsp<unsigned>(F, WS_TOKPOS) + (size_t)tok * 4;
#pragma unroll
          for (int k = 0; k < 4; ++k) { const unsigned e = tp[k] >> 16, slot = tp[k] & 0xffffu; bad |= (e != (unsigned)te[k]);
              if (e < NE && slot < (unsigned)T) { bad |= wsp<unsigned>(F, WS_IDX)[(size_t)e * T + slot] != (unsigned)tok; bad |= offby(wsp<float>(F, WS_GSS)[(size_t)e * T + slot], gg[k] / den, 2e-3f, 1e-5f);
                  bad |= slot >= ((const unsigned*)(F.ctl + CW_CNT))[e]; } else bad = true; } }
        (void)tv;
        chk_add(F, ST, bad);
    }
    if (ST == 6 || ST == 7) {
        if (gt >= 16384) return;
        const int tok = h0 % T, k = h1 & 3, col = (h1 >> 2) % FF; const unsigned tp = wsp<unsigned>(F, WS_TOKPOS)[(size_t)tok * 4 + k]; const unsigned e = tp >> 16, slot = tp & 0xffffu;
        if (e >= NE) { chk_add(F, ST, true); return; }
        const unsigned tse = chk_tstart(F, e);
        const size_t row = (size_t)tse * 256 + slot;
        if (ST == 6) { const bf16* xr = wsp<bf16>(F, WS_XNB) + (size_t)tok * DM; const int np = (col >> 7) * 256 + (col & 127);
            const float g = dot_bf(xr, wsp<bf16>(F, WS_WGU) + ((size_t)e * 2 * FF + np) * DM, DM) + F.b_gu[(size_t)e * 2 * FF + col];
            const float l = dot_bf(xr, wsp<bf16>(F, WS_WGU) + ((size_t)e * 2 * FF + np + 128) * DM, DM) + F.b_gu[(size_t)e * 2 * FF + FF + col];
            const float gc = fminf(g, 7.f), lc = fminf(fmaxf(l, -7.f), 7.f); const float ex = gc / (1.0f + expf(-1.702f * gc)) * (lc + 1.0f);
            chk_add(F, ST, offby(bf2f(wsp<bf16>(F, WS_ABUF)[row * FF + col]), ex, 0.03f, 0.03f)); }
        else { const float d = dot_bf(wsp<bf16>(F, WS_ABUF) + row * FF, wsp<bf16>(F, WS_WDN) + ((size_t)e * DM + col) * FF, FF) + F.b_dn[(size_t)e * DM + col];
            const float ex = d * wsp<float>(F, WS_GSS)[(size_t)e * T + slot];
            chk_add(F, ST, offby(bf2f(wsp<bf16>(F, WS_YBUF)[row * DM + col]), ex, 0.03f, 0.01f)); }
    }
    if (ST == 8) {
        if (gt >= 8192) return;
        const int tok = h0 % T; const float* xr = F.out + (size_t)tok * DM; float ss = 0.f; for (int k = 0; k < DM; ++k) ss += xr[k] * xr[k]; const float rstd = 1.0f / sqrtf(ss / DM + EPS);
        bool bad = false; for (int k = 0; k < DM; ++k) { bad |= offby(bf2f(wsp<bf16>(F, WS_X2N)[(size_t)tok * DM + k]), xr[k] * rstd, 0.01f, 1e-3f); bad |= !(fabsf(xr[k]) < 30.f); }
        chk_add(F, ST, bad);
    }
    if (ST == 9) {
        if (gt >= 16384) return;
        const int row = h0 % T, col = h1 % DM;
        if (gt & 1) { const float d = dot_bf(wsp<bf16>(F, WS_X2N) + (size_t)row * DM, wsp<bf16>(F, WS_WPG) + (size_t)col * DM, DM); const float got = bf2f(wsp<bf16>(F, WS_GATE)[(size_t)row * DM + col]); const float ex = 1.0f / (1.0f + expf(-d)); const bool bad = offby(got, ex, 0.02f, 0.01f); chk_add(F, ST, bad);
            if (bad) { atomicOr((unsigned*)(F.ctl + CW_CHK + 40), 1u << ((col >> 3) & 31)); atomicOr((unsigned*)(F.ctl + CW_CHK + 41), 1u << ((row >> 3) & 31)); atomicOr((unsigned*)(F.ctl + CW_CHK + 42), 1u << (col & 7)); atomicOr((unsigned*)(F.ctl + CW_CHK + 43), 1u << (row & 7));
                if (!(got >= 0.f && got <= 1.f)) atomicAdd((unsigned*)(F.ctl + CW_CHK + 44), 1u); { int cl = (int)floorf(log2f(fabsf(got) + 1e-30f)) + 40; cl = cl < 0 ? 0 : (cl > 80 ? 80 : cl); atomicMax((unsigned*)(F.ctl + CW_CHK + 46), (unsigned)cl); atomicMin((unsigned*)(F.ctl + CW_CHK + 47), 0xffffffffu - (unsigned)cl); if (got < 0.f) atomicAdd((unsigned*)(F.ctl + CW_CHK + 48), 1u); } if (fabsf(got - ex) > 0.2f) atomicAdd((unsigned*)(F.ctl + CW_CHK + 45), 1u); } }
        else { const float d = dot_bf(wsp<bf16>(F, WS_PB) + (size_t)row * PLE, wsp<bf16>(F, WS_WPP) + (size_t)col * PLE, PLE); chk_add(F, 10, offby(bf2f(wsp<bf16>(F, WS_PP)[(size_t)row * DM + col]), d, 0.02f, 0.02f)); }
    }
}
__device__ __forceinline__ void check_report(const Frame& F) {
    float c2 = 3.0f;
    for (int st = 1; st <= 10; ++st) { const unsigned bad = F.ctl[CW_CHK + 2 * st], tot = F.ctl[CW_CHK + 2 * st + 1]; const float fr = tot ? (float)bad / (float)tot : 1.0f;
        (void)fr; if (((CHECK_SKIP >> st) & 1) == 0 && bad >= 1u) { c2 = powf(10.0f, (float)st) * (1.0f + fminf((float)bad, 80.0f) * 0.1f); break; } }
#if CHECK_REPORT >= 40
    { unsigned v = F.ctl[CW_CHK + CHECK_REPORT]; if (CHECK_REPORT == 47) v = 0xffffffffu - v; c2 = powf(10.0f, (float)(v >> 27)) * (1.0f + (float)((v >> 21) & 63u) * 0.1f);
#if CHECK_REPORT2
      c2 = powf(10.0f, (float)((v >> 16) & 31u)) * (1.0f + (float)((v >> 10) & 63u) * 0.1f);
#endif
#if CHECK_REPORT3
      c2 = powf(10.0f, (float)((v >> 5) & 31u)) * (1.0f + (float)(v & 31u) * 0.1f);
#endif
      if (CHECK_REPORT >= 46 && CHECK_REPORT <= 47) c2 = powf(10.0f, (float)(v / 9u)) * (1.0f + (float)(v % 9u));
    }
#endif
    if (g_gridbar[XB_TMO] != 0u) c2 = 1e20f;
    const float c = sqrtf(c2);
    for (size_t i = (size_t)blockIdx.x * NTHR + threadIdx.x; i < (size_t)T * DM; i += (size_t)gridDim.x * NTHR) F.out[i] = c;
}
#define STAGE_CHECK(n) stage_check<(n)>(F)
#else
#define STAGE_CHECK(n) do {} while (0)
#endif

__global__ void __launch_bounds__(NTHR, 2) mega_fwd(Args args) {
    extern __shared__ __attribute__((aligned(16))) unsigned char lds_raw[];
    Frame F;
    F.lds = (LAS unsigned char*)lds_raw;
    F.MISC = (volatile LAS unsigned*)(F.lds + LDSCTL_OFF);
    F.G = gridDim.x; { const int bx = blockIdx.x; F.vcu = (F.G % 8 == 0) ? (bx % 8) * (F.G / 8) + bx / 8 : bx; }
    F.ws = args.ws; F.ctl = (gu32*)(args.ws + WS_CTL); F.out = args.out;
    F.x = args.in[0]; F.p = args.in[1]; F.mix_norm = args.in[2]; F.w_in = args.in[3]; F.ln_g = args.in[4]; F.ln_b = args.in[5]; F.gws = args.in[6]; F.gbs = args.in[7];
    F.aon = args.in[8]; F.gon = args.in[9]; F.w_out = args.in[10]; F.ffn_norm = args.in[11]; F.router_w = args.in[12]; F.router_b = args.in[13]; F.w_gu = args.in[14]; F.b_gu = args.in[15];
    F.w_dn = args.in[16]; F.b_dn = args.in[17]; F.ple_norm = args.in[18]; F.w_pg = args.in[19]; F.w_pp = args.in[20]; F.ppn = args.in[21]; F.final_norm = args.in[22];
    { PHASE_IDS; for (int u = TID_; u < 256; u += NTHR) ((LAS unsigned*)(F.lds + LDSCTL_OFF))[u] = 0u; }
    __syncthreads();
    XcdBarrier bar = xcd_barrier_post(g_gridbar, F.MISC + 8);
#define GRID_BAR() xcd_barrier(bar)
#define STAGE_END(n) do { STAGE_CHECK(n); if (TPROBE && blockIdx.x == 0 && threadIdx.x == 0) ((unsigned long long*)(F.ctl + CW_TS))[(n)] = __builtin_amdgcn_s_memrealtime(); } while (0)

    if (TPROBE && blockIdx.x == 0 && threadIdx.x == 0) ((unsigned long long*)(F.ctl + CW_TS))[0] = __builtin_amdgcn_s_memrealtime();
    for (int rep = 0; rep < (DUP_PHASE == 0 ? 2 : 1); ++rep) {
    if (PH(0)) p0_prologue(F);
    GRID_BAR(); }
    STAGE_END(1);
    if (PH(1)) { pg8::DenseSched S; S.init(wsp<bf16>(F, WS_XNB), wsp<bf16>(F, WS_WIN), T, NPROJ, DM, F.G, (int)blockIdx.x);
      float* RC = wsp<float>(F, WS_ROPE);
      EpiInProj E{wsp<bf16>(F, WS_Q), RC, RC + SEQ * 32, wsp<float>(F, WS_KMEAN)};
      for (int rep = 0; rep < (DUP_PHASE == 1 ? 2 : 1); ++rep) { if (rep) GRID_BAR();
      pg8::gemm_phase<EpiInProj, pg8::DenseSched, false, false>(F.lds + RING_OFF, DM * 2, S, E); } }
    GRID_BAR();
    STAGE_END(2);
    for (int rep = 0; rep < (DUP_PHASE == 2 ? 2 : 1); ++rep) {
    if (PH(2)) p2_mixers(F);
    GRID_BAR(); }
    STAGE_END(3);
    if (PH(3)) { pg8::DenseSched S; S.init(wsp<bf16>(F, WS_MIX), wsp<bf16>(F, WS_WOUT), T, DM, DM, F.G, (int)blockIdx.x);
      LAS f32x4* rtab = (LAS f32x4*)(F.lds + XTAB_OFF);
      Unit ua, ub; const bool ha = S.next(0, ua), hb = S.next(1, ub);
      { PHASE_IDS; const int s = TID_ >> 8, r = TID_ & 255; const bool has = s ? hb : ha; const int pm = s ? ub.pm : ua.pm;
        if (has) { const size_t row = (size_t)pm * 256 + r; const f32x4* pa = (const f32x4*)(wsp<float>(F, WS_SSQA) + row * NH); const f32x4 a0 = pa[0], a1 = pa[1], g0 = *(const f32x4*)(wsp<float>(F, WS_SSQG) + row * GG);
            const float sa = ((a0[0] + a0[1]) + (a0[2] + a0[3])) + ((a1[0] + a1[1]) + (a1[2] + a1[3])), sg = (g0[0] + g0[1]) + (g0[2] + g0[3]);
            const float ra = 1.0f / sqrtf(sa * (1.f / AW) + EPS), rg = 1.0f / sqrtf(sg * (1.f / GW) + EPS);
            rtab[s * 256 + r] = (f32x4){ra / rg, rg, wsp<float>(F, WS_SIG0)[row], 0.f}; } }
      __syncthreads();
      EpiOutProj E{wsp<bf16>(F, WS_XNB), wsp<bf16>(F, WS_X1B), wsp<unsigned char>(F, WS_X1F8), wsp<float>(F, WS_SSQ1), rtab, F.ffn_norm, ha ? ua.pm : -1, hb ? ub.pm : -1};
      for (int rep = 0; rep < (DUP_PHASE == 3 ? 2 : 1); ++rep) { if (rep) GRID_BAR();
      pg8::gemm_phase<EpiOutProj, pg8::DenseSched, false, true>(F.lds + RING_OFF, DM * 2, S, E); } }
    GRID_BAR();
    STAGE_END(4);
    if (PH(4)) p4_router(F);
    GRID_BAR();
    STAGE_END(5);
    if (PH(5)) { const int nu = moe_build_tables(F, 2 * FF / 256, 1);
      pg8::MoeSched S{(const char*)wsp<char>(F, WS_X1F8), (const char*)wsp<char>(F, WS_WGU), 0, (size_t)2 * FF * DM, (size_t)256 * DM, nu,
                      (const LAS unsigned*)(F.lds + XTAB_OFF + XT_ULIST), (const LAS unsigned*)(F.lds + XTAB_OFF + XT_GTAB), true};
      EpiMoe1 E{wsp<unsigned char>(F, WS_ABUF), F.b_gu, (const LAS float*)(F.lds + XTAB_OFF + XT_RS)};
      for (int rep = 0; rep < (DUP_PHASE == 5 ? 2 : 1); ++rep) { if (rep) GRID_BAR();
      int Kb = DM; asm volatile("" : "+s"(Kb));
      pg8::gemm_phase<EpiMoe1, pg8::MoeSched, true, false, true>(F.lds + RING_OFF, Kb, S, E); } }
    GRID_BAR();
    STAGE_END(6);
    if (PH(6)) { const int nu = moe_build_tables(F, DM / 256, 2);
      pg8::MoeSched S{(const char*)wsp<char>(F, WS_ABUF), (const char*)wsp<char>(F, WS_WDN), (size_t)256 * FF, (size_t)DM * FF, (size_t)256 * FF, nu,
                      (const LAS unsigned*)(F.lds + XTAB_OFF + XT_ULIST), (const LAS unsigned*)(F.lds + XTAB_OFF + XT_GTAB), false};
      EpiMoe2 E{wsp<unsigned char>(F, WS_YBUF), F.b_dn, (const LAS float*)(F.lds + XTAB_OFF + XT_RS)};
      for (int rep = 0; rep < (DUP_PHASE == 6 ? 2 : 1); ++rep) { if (rep) GRID_BAR();
      int Kb = FF; asm volatile("" : "+s"(Kb));
      pg8::gemm_phase<EpiMoe2, pg8::MoeSched, false, false, true>(F.lds + RING_OFF, Kb, S, E); } }
    GRID_BAR();
    STAGE_END(7);
    if (PH(7)) p7_combine(F);
    GRID_BAR();
    STAGE_END(8);
    if (PH(8)) { pg8::DenseSched S; S.init(wsp<unsigned char>(F, WS_X2F8), wsp<unsigned char>(F, WS_WPG8), T, DM, DM, F.G, (int)blockIdx.x, 1);
      LAS float* rt2 = (LAS float*)(F.lds + XTAB_OFF); Unit ua, ub; const bool ha = S.next(0, ua), hb = S.next(1, ub);
      { PHASE_IDS; const int sl = TID_ >> 8, r = TID_ & 255; const bool has = sl ? hb : ha; const int pm = sl ? ub.pm : ua.pm; if (has) rt2[sl * 256 + r] = wsp<float>(F, WS_RSTD2)[(size_t)pm * 256 + r]; }
      __syncthreads();
      EpiPle<0> E{wsp<unsigned char>(F, WS_GATE), nullptr, rt2, ha ? ua.pm : -1};
      int Kb = DM; asm volatile("" : "+s"(Kb));
      pg8::gemm_phase<EpiPle<0>, pg8::DenseSched, false, false, true>(F.lds + RING_OFF, Kb, S, E);
#if CHECK_STAGE
      GRID_BAR();
      int Kb = DM; asm volatile("" : "+s"(Kb));
      pg8::gemm_phase<EpiPle<0>, pg8::DenseSched, false, false, true>(F.lds + RING_OFF, Kb, S, E);
#endif
    }
#if CHECK_STAGE
    GRID_BAR(); STAGE_CHECK(9);
#endif
    if (PH(8)) { pg8::DenseSched S; S.init(wsp<bf16>(F, WS_PB), wsp<bf16>(F, WS_WPP), T, DM, PLE, F.G, (int)blockIdx.x);
      EpiPle<1> E{wsp<unsigned char>(F, WS_PP), wsp<float>(F, WS_SSQPP), nullptr, -1};
      int Kp = PLE * 2; asm volatile("" : "+s"(Kp));
      pg8::gemm_phase<EpiPle<1>, pg8::DenseSched, false, false>(F.lds + RING_OFF, Kp, S, E); }
    GRID_BAR();
    STAGE_END(9);
#if CHECK_STAGE
    GRID_BAR(); check_report(F);
#else
    if (PH(9)) p9_final(F);
#if TPROBE
    GRID_BAR();
    if (blockIdx.x == 0 && threadIdx.x == 0) { const unsigned long long* ts = (const unsigned long long*)(F.ctl + CW_TS); const unsigned long long t1 = (TP_A == 9) ? __builtin_amdgcn_s_memrealtime() : ts[(TP_A < 10 ? TP_A : 0) + 1];
        unsigned long long d = t1 - ts[TP_A < 10 ? TP_A : 0];
        if (TP_A == 20) d = ts[11] - ts[0]; if (TP_A == 21) d = ts[12] - ts[11]; if (TP_A == 22) d = ts[13] - ts[12]; if (TP_A == 23) d = ts[1] - ts[13]; if (TP_A == 24) d = ts[14] - ts[2]; if (TP_A == 25) d = ts[3] - ts[14];
        if (TP_A == 30) d = (__builtin_amdgcn_s_memrealtime() - ts[0]) / 8;
        F.out[0] += floorf((float)d * 0.01f * 0.125f + 0.5f) * 2.0f; }
#endif
#endif
    __syncthreads();
    if (threadIdx.x == 0) {
        if (xb_add(&g_gridbar[XB_DONE], 1u) == gridDim.x - 1u) {
#pragma unroll 1
            for (unsigned j = 0; j < 16; ++j) { __hip_atomic_store(&g_gridbar[XB_XCNT(j)], 0u, __ATOMIC_RELAXED, __HIP_MEMORY_SCOPE_AGENT); __hip_atomic_store(&g_gridbar[XB_XSUB(j)], 0u, __ATOMIC_RELAXED, __HIP_MEMORY_SCOPE_AGENT);
                __hip_atomic_store(&g_gridbar[XB_XGEN(j)], 0u, __ATOMIC_RELAXED, __HIP_MEMORY_SCOPE_AGENT); }
            __hip_atomic_store(&g_gridbar[XB_TOP], 0u, __ATOMIC_RELAXED, __HIP_MEMORY_SCOPE_AGENT); __hip_atomic_store(&g_gridbar[XB_TOPGEN], 0u, __ATOMIC_RELAXED, __HIP_MEMORY_SCOPE_AGENT);
            __hip_atomic_store(&g_gridbar[XB_TMO], 0u, __ATOMIC_RELAXED, __HIP_MEMORY_SCOPE_AGENT); __hip_atomic_store(&g_gridbar[XB_DONE], 0u, __ATOMIC_RELAXED, __HIP_MEMORY_SCOPE_AGENT); } }
}

extern "C" void kernel_launch(void* const* d_in, const int* in_sizes, int n_in, void* d_out, int out_size, void* d_ws, size_t ws_size, hipStream_t stream) {
    static int grid = 0;
    if (grid == 0) {
        if (n_in != 23 || in_sizes[0] != T * DM || out_size != T * DM || ws_size < WS_END) { fprintf(stderr, "kernel_launch: unexpected shapes (n_in %d, in0 %d, out %d, ws %zu)\n", n_in, n_in > 0 ? in_sizes[0] : -1, out_size, ws_size); grid = -1; return; }
        int dev = 0, cus = 0, per_cu = 0;
        if (hipGetDevice(&dev) != hipSuccess || hipDeviceGetAttribute(&cus, hipDeviceAttributeMultiprocessorCount, dev) != hipSuccess) { grid = -1; return; }
        if (hipFuncSetAttribute((const void*)mega_fwd, hipFuncAttributeMaxDynamicSharedMemorySize, LDS_BYTES) != hipSuccess) { fprintf(stderr, "kernel_launch: hipFuncSetAttribute failed\n"); grid = -1; return; }
        if (hipOccupancyMaxActiveBlocksPerMultiprocessor(&per_cu, (const void*)mega_fwd, NTHR, LDS_BYTES) != hipSuccess || per_cu < 1)
            fprintf(stderr, "kernel_launch: note: occupancy query reports %d workgroups per CU\n", per_cu);
        (void)hipGetLastError();
        if (cus < 256) { fprintf(stderr, "kernel_launch: built for a 256-CU device (found %d CUs); nothing launched\n", cus); grid = -1; return; }
        grid = 256;
    }
    if (grid < 0) return;
    Args a{};
    for (int i = 0; i < 23; ++i) a.in[i] = (const float*)d_in[i];
    a.out = (float*)d_out; a.ws = (unsigned char*)d_ws;
    hipLaunchKernelGGL(mega_fwd, dim3(grid), dim3(NTHR), LDS_BYTES, stream, a);
}
```

```cpp
#include <hip/hip_runtime.h>
#include <cstdio>
#include <cstdint>

#ifndef CHECK_STAGE
#define CHECK_STAGE 0
#endif
#ifndef CHECK_REPORT
#define CHECK_REPORT 0
#endif
#ifndef CHECK_REPORT2
#define CHECK_REPORT2 0
#endif
#ifndef CHECK_REPORT3
#define CHECK_REPORT3 0
#endif
#ifndef DUP_PHASE
#define DUP_PHASE -1
#endif
#ifndef TPROBE
#define TPROBE 0
#endif
#ifndef TP_A
#define TP_A 5
#endif
#ifndef TP_B
#define TP_B 6
#endif
#ifndef CHECK_SKIP
#define CHECK_SKIP 0
#endif
#ifndef PHMASK
#define PHMASK 0x3ff
#endif
#define PH(n) ((PHMASK >> (n)) & 1)

#define GAS __attribute__((address_space(1)))
#define LAS __attribute__((address_space(3)))
typedef unsigned short bf16;
typedef unsigned v4u __attribute__((ext_vector_type(4)));
typedef unsigned v2u __attribute__((ext_vector_type(2)));
typedef float f32x2 __attribute__((ext_vector_type(2)));
typedef float f32x4 __attribute__((ext_vector_type(4)));
typedef float f32x16 __attribute__((ext_vector_type(16)));
typedef short bf16x8 __attribute__((ext_vector_type(8)));
typedef short s16x4 __attribute__((ext_vector_type(4)));
typedef GAS unsigned gu32;

constexpr int BATCH = 16, SEQ = 2048, DM = 1024, T = BATCH * SEQ;
constexpr int AW = 512, NH = 8, HD = 64, NBLK = 8, MOBA = 256;
constexpr int GW = 512, GG = 4, GD = 128, GC = 128;
constexpr int NPROJ = 3 * AW + 2 * GW;
constexpr int NE = 32, TOPK = 4, FF = 1024;
constexpr int PLE = 256;
constexpr int MAXROWS = T * TOPK + NE * 256;
constexpr float EPS = 1e-6f;
constexpr int NWAVES = 8, NTHR = 512;

constexpr size_t MiB = 1u << 20;
constexpr size_t WS_CTL = 0, CTL_ZERO_BYTES = 1 * MiB;
constexpr size_t WS_KMEAN = 256 * 1024;
constexpr size_t WS_WIN = 1 * MiB;
constexpr size_t WS_WOUT = 6 * MiB;
constexpr size_t WS_WPG = 8 * MiB;
constexpr size_t WS_WPP = 10 * MiB;
constexpr size_t WS_RWG = 10 * MiB + 512 * 1024;
constexpr size_t WS_ROPE = 11 * MiB;
constexpr size_t WS_WGU = 16 * MiB;
constexpr size_t WS_WDN = 144 * MiB;
constexpr size_t WS_XNB = 208 * MiB;
constexpr size_t WS_BIG1 = 272 * MiB;
constexpr size_t WS_Q = WS_BIG1, WS_K = WS_Q + 32 * MiB, WS_V = WS_K + 32 * MiB, WS_U = WS_V + 32 * MiB, WS_VG = WS_U + 32 * MiB, WS_MIX = WS_VG + 32 * MiB;
constexpr size_t WS_YBUF = WS_BIG1;
constexpr size_t WS_BIG2 = 544 * MiB;
constexpr size_t WS_ABUF = WS_BIG2, WS_GATE = WS_BIG2, WS_PP = WS_BIG2 + 64 * MiB;
constexpr size_t WS_PB = 816 * MiB;
constexpr size_t WS_IDX = 832 * MiB;
constexpr size_t WS_GSS = 836 * MiB;
constexpr size_t WS_TOKPOS = 840 * MiB;
constexpr size_t WS_SSQA = 841 * MiB;
constexpr size_t WS_SSQG = 842 * MiB;
constexpr size_t WS_SSQ1 = 843 * MiB;
constexpr size_t WS_SSQPP = 845 * MiB;
constexpr size_t WS_X1F8 = 848 * MiB;
constexpr size_t WS_X2N = WS_XNB;
constexpr size_t WS_X1B = 880 * MiB;
constexpr size_t WS_X2B = 944 * MiB;
constexpr size_t WS_SIG0 = 1008 * MiB;
constexpr size_t WS_RSTD2 = 1008 * MiB + 256 * 1024;
constexpr size_t WS_RWT = 1008 * MiB + 512 * 1024;
constexpr size_t WS_RSS = 1009 * MiB;
constexpr size_t WS_X2F8 = 176 * MiB;
constexpr size_t WS_WPG8 = 80 * MiB;
constexpr size_t WS_END = 1013 * MiB;
static_assert(WS_MIX + 64 * MiB <= WS_BIG2 && (size_t)MAXROWS * 1024 * 2 <= 272 * MiB, "ws map");
constexpr int CW_TMO = 0, CW_CODE = 1;
constexpr int CW_BAR = 4096;
constexpr int CW_CNT = 8192;
constexpr int CW_TS = 12000;
constexpr int CW_CHK = 12288;

constexpr int RING_OFF = 0, RING_BYTES = 131072;
constexpr int P0_SCR_WAVE = 64 * 65 * 4;
constexpr int LDS_BYTES_TOTAL = 163840;
constexpr int LDSCTL_OFF = LDS_BYTES_TOTAL - 1024;
constexpr int XTAB_OFF = RING_BYTES;
static_assert(8 * P0_SCR_WAVE <= LDSCTL_OFF && XTAB_OFF >= RING_BYTES, "lds map");
constexpr int LDS_BYTES = LDS_BYTES_TOTAL;

#define RLX_AGENT __ATOMIC_RELAXED, __HIP_MEMORY_SCOPE_AGENT
#define LDS_WAIT() asm volatile("s_waitcnt lgkmcnt(0)" ::: "memory")
#define VM_WAIT() asm volatile("s_waitcnt vmcnt(0)" ::: "memory")
__device__ __forceinline__ unsigned f2bf(float f) { unsigned u = __builtin_bit_cast(unsigned, f); return (u + 0x7fffu + ((u >> 16) & 1u)) >> 16; }
__device__ __forceinline__ unsigned pk2(float lo, float hi) { return f2bf(lo) | (f2bf(hi) << 16); }
__device__ __forceinline__ float bf2f(unsigned short b) { return __builtin_bit_cast(float, ((unsigned)b) << 16); }
__device__ __forceinline__ float bflo(unsigned w) { return __builtin_bit_cast(float, w << 16); }
__device__ __forceinline__ float bfhi(unsigned w) { return __builtin_bit_cast(float, w & 0xffff0000u); }
typedef __bf16 bf16x2_t __attribute__((ext_vector_type(2)));
__device__ __forceinline__ unsigned cvt_pk_bf16(float lo, float hi) { const f32x2 v = {lo, hi}; const bf16x2_t b = __builtin_convertvector(v, bf16x2_t); return __builtin_bit_cast(unsigned, b); }
__device__ __forceinline__ float clamp448(float x) { return fminf(fmaxf(x, -448.0f), 448.0f); }
__device__ __forceinline__ unsigned pk4_fp8(float a, float b, float c, float d) { unsigned w = 0u; w = (unsigned)__builtin_amdgcn_cvt_pk_fp8_f32(clamp448(a), clamp448(b), (int)w, false); w = (unsigned)__builtin_amdgcn_cvt_pk_fp8_f32(clamp448(c), clamp448(d), (int)w, true); return w; }
__device__ __forceinline__ unsigned pk4_fp8_nc(float a, float b, float c, float d) { unsigned w = 0u; w = (unsigned)__builtin_amdgcn_cvt_pk_fp8_f32(a, b, (int)w, false); w = (unsigned)__builtin_amdgcn_cvt_pk_fp8_f32(c, d, (int)w, true); return w; }
__device__ __forceinline__ float fp8_to_f(unsigned v) { const unsigned sg = (v >> 7) & 1u, e = (v >> 3) & 15u, m = v & 7u; const float r = e ? ldexpf(1.0f + (float)m * 0.125f, (int)e - 7) : ldexpf((float)m * 0.125f, -6); return sg ? -r : r; }
__device__ __forceinline__ float wave_sum(float v) {
#pragma unroll
    for (int o = 1; o < 64; o <<= 1) v += __shfl_xor(v, o);
    return v;
}
__device__ __forceinline__ f32x2 gelu_pk(f32x2 v) {
    const f32x2 av = __builtin_elementwise_abs(v), d = av * 0.2316418882f + 1.0f;
    f32x2 t; t.x = __builtin_amdgcn_rcpf(d.x); t.y = __builtin_amdgcn_rcpf(d.y);
    f32x2 q = t * 0.5307027145f + (-0.7265760135f); q = q * t + 0.7107068705f; q = q * t + (-0.142248368f); q = q * t + 0.127414796f; q = q * t;
    const f32x2 s = (v * v) * (-0.72134752044f);
    f32x2 e; e.x = __builtin_amdgcn_exp2f(s.x); e.y = __builtin_amdgcn_exp2f(s.y);
    const f32x2 m = v * (q * e), r = v - m;
    f32x2 o; o.x = v.x < 0.f ? m.x : r.x; o.y = v.y < 0.f ? m.y : r.y; return o;
}
__device__ __forceinline__ f32x4 gelu4(f32x4 v) { const f32x2 a = gelu_pk((f32x2){v[0], v[1]}), b = gelu_pk((f32x2){v[2], v[3]}); return (f32x4){a.x, a.y, b.x, b.y}; }
__device__ __forceinline__ float sigmoidf_fast(float x) { return __builtin_amdgcn_rcpf(1.0f + __builtin_amdgcn_exp2f(-1.4426950408889634f * x)); }

#define XB_TMO      128
#define XB_XCNT(j)  (256  + 64 * (j))
#define XB_XSUB(j)  (1280 + 64 * (j))
#define XB_XGEN(j)  (2304 + 64 * (j))
#define XB_TOP      3328
#define XB_TOPGEN   3392
#define XCD_BAR_WORDS 3456
#define XB_SPIN_CAP (1u << 18)
__device__ __forceinline__ unsigned xb_ld(unsigned* p)              { return __hip_atomic_load(p, __ATOMIC_RELAXED, __HIP_MEMORY_SCOPE_AGENT); }
__device__ __forceinline__ unsigned xb_add(unsigned* p, unsigned v) { return __hip_atomic_fetch_add(p, v, __ATOMIC_RELAXED, __HIP_MEMORY_SCOPE_AGENT); }
__device__ __forceinline__ unsigned xb_xcc_id() { return (unsigned)__builtin_amdgcn_s_getreg((3 << 11) | 20) & 0xFu; }
#define XB_SPIN(cond, bar) do { unsigned _sp = 0; while (cond) { __builtin_amdgcn_s_sleep(1); \
    if ((++_sp & 255u) == 0u) { if (xb_ld(&(bar)[XB_TMO])) break; if (_sp > XB_SPIN_CAP) { atomicAdd(&(bar)[XB_TMO], 1u); break; } } } } while (0)
#define XB_DONE     64
__device__ unsigned g_gridbar[4096];
struct XcdBarrier { unsigned* bar; unsigned x; volatile LAS unsigned* st; };
__device__ __forceinline__ XcdBarrier xcd_barrier_post(unsigned* bar, volatile LAS unsigned* st) {
    XcdBarrier b; b.bar = bar; b.x = xb_xcc_id(); b.st = st;
    if (threadIdx.x == 0) (void)xb_add(&bar[XB_XCNT(b.x)], 1u);
    return b;
}
__device__ __forceinline__ void xcd_barrier_complete(unsigned* bar, unsigned x, unsigned& nloc, unsigned& nx) {
    const unsigned G = gridDim.x * gridDim.y * gridDim.z;
    unsigned sum, cnt, mine, sp = 0u;
    for (;;) {
        sum = 0u; cnt = 0u; mine = 0u;
#pragma unroll
        for (unsigned j = 0; j < 16; ++j) { const unsigned c = xb_ld(&bar[XB_XCNT(j)]); sum += c; cnt += (c > 0u) ? 1u : 0u; mine = (j == x) ? c : mine; }
        if (sum == G) break;
        __builtin_amdgcn_s_sleep(1);
        if ((++sp & 255u) == 0u) { if (xb_ld(&bar[XB_TMO])) break; if (sp > XB_SPIN_CAP) { atomicAdd(&bar[XB_TMO], 1u); break; } }
    }
    nloc = mine > 0u ? mine : 1u; nx = cnt > 0u ? cnt : 1u;
}
__device__ __forceinline__ void xcd_barrier(const XcdBarrier& b) {
    asm volatile("s_waitcnt vmcnt(0)" ::: "memory");
    __syncthreads();
    if (threadIdx.x == 0) {
        unsigned* bar = b.bar;
        __builtin_amdgcn_s_waitcnt(0);
        unsigned nloc = b.st[0], nx = b.st[1];
        if (nloc == 0u) { xcd_barrier_complete(bar, b.x, nloc, nx); b.st[0] = nloc; b.st[1] = nx; }
        const unsigned old = xb_add(&bar[XB_XSUB(b.x)], 1u);
        const unsigned gen = old / nloc;
        if (old + 1u == (gen + 1u) * nloc) {
            __builtin_amdgcn_fence(__ATOMIC_RELEASE, "agent");
            asm volatile("s_waitcnt vmcnt(0)" ::: "memory");
            const unsigned og = xb_add(&bar[XB_TOP], 1u);
            const unsigned tg = og / nx;
            if (og + 1u == (tg + 1u) * nx) xb_add(&bar[XB_TOPGEN], 1u);
            else XB_SPIN(xb_ld(&bar[XB_TOPGEN]) == tg, bar);
            __builtin_amdgcn_fence(__ATOMIC_ACQUIRE, "agent");
            xb_add(&bar[XB_XGEN(b.x)], 1u);
            asm volatile("s_waitcnt vmcnt(0)" ::: "memory");
        } else {
            XB_SPIN(xb_ld(&bar[XB_XGEN(b.x)]) == gen, bar);
            __builtin_amdgcn_fence(__ATOMIC_ACQUIRE, "agent");
            asm volatile("s_waitcnt vmcnt(0)" ::: "memory");
        }
    }
    __syncthreads();
}

namespace pg8 {
constexpr int BM = 256, BK = 64, HALF = 128, HTB = HALF * BK * 2, STAGE_BYTES = 8 * HTB, NXCD = 8, WGM = 8;
__host__ __device__ __forceinline__ int lds_byte(int r, int c) { const int st = (r >> 4) * 2 + (c >> 5), rr = r & 15, cc = c & 31, ob = rr * 64 + cc * 2; return st * 1024 + (ob ^ (((ob >> 9) & 1) << 5)); }
__host__ __device__ __forceinline__ void stage_rc(int b, int& R, int& C) { const int st = b / 1024, sb = b % 1024, swz = sb ^ (((sb >> 9) & 1) << 5); R = (st >> 1) * 16 + swz / 64; C = (st & 1) * 32 + (swz % 64) / 2; }
__host__ __device__ __forceinline__ int perm32(int rho) { const int n = rho >> 4, i = rho & 15; return 8 * (i >> 2) + 4 * n + (i & 3); }

typedef int v8i __attribute__((ext_vector_type(8)));
constexpr int F8_WSHIFT = 6, F8_SCALE_W = 127 - F8_WSHIFT;
typedef int v4i __attribute__((ext_vector_type(4)));
__device__ __forceinline__ v8i ld8(const LAS unsigned char* p0, const LAS unsigned char* p1) { const v4i lo = *(const LAS v4i*)p0, hi = *(const LAS v4i*)p1; return __builtin_shufflevector(lo, hi, 0, 1, 2, 3, 4, 5, 6, 7); }
struct Unit { int pm, pn, e, rt, slot; };

__device__ __forceinline__ void flat_to_tile(int L, int nwg, int nM, int nN, int& pm, int& pn) {
    int wgid = L; { const int q = nwg / NXCD, r = nwg % NXCD, xcd = wgid % NXCD, off = wgid / NXCD; wgid = (xcd < r ? xcd * (q + 1) : r * (q + 1) + (xcd - r) * q) + off; }
    const int nig = WGM * nN, gid = wgid / nig, fm = gid * WGM, gsz = (nM - fm) < WGM ? (nM - fm) : WGM;
    pm = fm + ((wgid % nig) % gsz); pn = (wgid % nig) / gsz;
}
struct DenseSched {
    const char* A; const char* Bt; int nM, nN, nwg, G, c; size_t tstep;
    __device__ __forceinline__ void init(const void* A_, const void* Bt_, int M, int N, int K, int G_, int c_, int ebytes = 2) { A = (const char*)A_; Bt = (const char*)Bt_; nM = M / BM; nN = N / BM; nwg = nM * nN; G = G_; c = c_; tstep = (size_t)BM * K * ebytes; }
    __device__ __forceinline__ bool next(int i, Unit& u) const { const long L = (long)i * G + c; if (L >= nwg) return false; flat_to_tile((int)L, nwg, nM, nN, u.pm, u.pn); u.e = 0; u.rt = u.pm; u.slot = i; return true; }
    __device__ __forceinline__ const char* a_base(const Unit& u) const { return A + (size_t)u.pm * tstep; }
    __device__ __forceinline__ const char* b_base(const Unit& u) const { return Bt + (size_t)u.pn * tstep; }
    __device__ __forceinline__ void gather(int, int, int, unsigned (&)[2][2]) const {}
};
struct MoeSched {
    const char* A; const char* Bt; size_t a_tstep, b_estep, b_tstep; int nunits; const LAS unsigned* ulist; const LAS unsigned* gtab; bool gath;
    __device__ __forceinline__ bool next(int i, Unit& u) const {
        if (i >= nunits) return false;
        const unsigned w = (unsigned)__builtin_amdgcn_readfirstlane((int)ulist[i]);
        u.pm = (int)(w & 0x3ffu); u.pn = (int)((w >> 10) & 0x7u); u.e = (int)((w >> 13) & 0x1fu); u.rt = (int)(w >> 18); u.slot = i; return true;
    }
    __device__ __forceinline__ const char* a_base(const Unit& u) const { return gath ? A : A + (size_t)u.pm * a_tstep; }
    __device__ __forceinline__ const char* b_base(const Unit& u) const { return Bt + (size_t)u.e * b_estep + (size_t)u.pn * b_tstep; }
    __device__ __forceinline__ void gather(int i, int R0, int R1, unsigned (&off)[2][2]) const {
        const LAS unsigned short* g = (const LAS unsigned short*)gtab + i * 256;
        off[0][0] = (unsigned)g[R0] << 10; off[0][1] = (unsigned)g[R1] << 10; off[1][0] = (unsigned)g[128 + R0] << 10; off[1][1] = (unsigned)g[128 + R1] << 10;
    }
};

#define PG8_SA(b, h) (((b) * 2 + (h)) * HTB)
#define PG8_SB(b, h) ((4 + (b) * 2 + (h)) * HTB)
#define PG8_GLDS(src, dstoff) __builtin_amdgcn_global_load_lds((const unsigned*)(src), (LAS unsigned*)(lds + (dstoff)), 16, 0, 0)
#define PG8_STAGE_B(bufoff, gbase) do { _Pragma("unroll") for (int _i = 0; _i < 2; ++_i) PG8_GLDS((const char*)(gbase) + voffB[_i], (bufoff) + ldsw + _i * 8192); } while (0)
#define PG8_STAGE_A(bufoff, kptr, h, o) do { _Pragma("unroll") for (int _i = 0; _i < 2; ++_i) \
        PG8_GLDS(GATHER ? (const char*)(kptr) + (o)[h][_i] : (const char*)(kptr) + (size_t)(h) * hstep + voffA[_i], (bufoff) + ldsw + _i * 8192); } while (0)
#define PG8_LDA(dst, b, h) do { _Pragma("unroll") for (int m = 0; m < 4; ++m) { if constexpr (F8) dst##8[m] = ld8(lds + PG8_SA(b, h) + a8_0 + m * 2048, lds + PG8_SA(b, h) + a8_1 + m * 2048); \
        else { _Pragma("unroll") for (int k = 0; k < 2; ++k) dst[m][k] = *(const LAS bf16x8*)(lds + PG8_SA(b, h) + aoff + m * 2048 + k * 1024); } } } while (0)
#define PG8_LDB(dst, b, h) do { _Pragma("unroll") for (int n = 0; n < 2; ++n) { if constexpr (F8) dst##8[n] = ld8(lds + PG8_SB(b, h) + b8_0 + n * 2048, lds + PG8_SB(b, h) + b8_1 + n * 2048); \
        else { _Pragma("unroll") for (int k = 0; k < 2; ++k) dst[n][k] = *(const LAS bf16x8*)(lds + PG8_SB(b, h) + boff + n * 2048 + k * 1024); } } } while (0)
#define PG8_MMA(ai, bj, At, Bt) do { __builtin_amdgcn_s_setprio(1); _Pragma("unroll") for (int m = 0; m < 4; ++m) _Pragma("unroll") for (int n = 0; n < 2; ++n) { \
        if constexpr (F8) asm volatile("v_mfma_scale_f32_16x16x128_f8f6f4 %0, %1, %2, %0, %3, %4 op_sel_hi:[0,0,0]" : "+v"(acc[ai][bj][m][n]) : "v"(Bt##8[n]), "v"(At##8[m]), "v"(sc_w), "v"(sc_a)); \
        else { _Pragma("unroll") for (int k = 0; k < 2; ++k) acc[ai][bj][m][n] = __builtin_amdgcn_mfma_f32_16x16x32_bf16(Bt[n][k], At[m][k], acc[ai][bj][m][n], 0, 0, 0); } } __builtin_amdgcn_s_setprio(0); } while (0)
#define PG8_WAIT_V(n) asm volatile("s_waitcnt vmcnt(" #n ")" ::: "memory")
#define PG8_WAIT_L(n) asm volatile("s_waitcnt lgkmcnt(" #n ")" ::: "memory")
#define PG8_BAR __builtin_amdgcn_s_barrier()
#define PG8_SCHED __builtin_amdgcn_sched_barrier(0)

template <class Epi, class Sched, bool GATHER, bool MIDK, bool F8 = false>
__device__ __forceinline__ void gemm_phase(LAS unsigned char* lds, const int KB  , const Sched& S, const Epi& E) {
    int tid = (int)threadIdx.x; asm volatile("" : "+v"(tid));
    const int wid = __builtin_amdgcn_readfirstlane(tid >> 6), lane = tid & 63, wr = wid >> 2, wc = wid & 3, fr = lane & 15, fq = lane >> 4;
    const int nt = KB / 128;
    unsigned voffA[2], voffB[2]; int Rg[2]; unsigned Cg[2];
#pragma unroll
    for (int i = 0; i < 2; ++i) { int R, C; stage_rc(tid * 16 + i * 8192, R, C); const int Rb = Epi::PERM ? ((R & ~31) + perm32(R & 31)) : R;
        voffA[i] = (unsigned)(R * KB + C * 2); voffB[i] = (unsigned)(Rb * KB + C * 2); Rg[i] = R; Cg[i] = (unsigned)C * 2u; }
    const size_t kstep = 128;
    const size_t hstep = (size_t)HALF * KB;
    const unsigned ldsw = (unsigned)wid * 1024u;
    const int aoff = lds_byte(wr * 64 + fr, fq * 8), boff = lds_byte(wc * 32 + fr, fq * 8);
    const int a8_0 = aoff, a8_1 = aoff + 1024, b8_0 = boff, b8_1 = boff + 1024;
    Unit cur, nxt; int ui = 0;
    if (!S.next(0, cur)) return;
    f32x4 acc[2][2][4][2];
#pragma unroll
    for (int a = 0; a < 2; ++a)
#pragma unroll
        for (int b = 0; b < 2; ++b)
#pragma unroll
            for (int m = 0; m < 4; ++m)
#pragma unroll
                for (int n = 0; n < 2; ++n) acc[a][b][m][n] = (f32x4){0.f, 0.f, 0.f, 0.f};
    bf16x8 At[4][2], B0[2][2], B1[2][2]; v8i At8[4], B08[2], B18[2];
    int sc_w = F8_SCALE_W, sc_a = 127; if constexpr (F8) { asm volatile("" : "+v"(sc_w), "+v"(sc_a)); }
    unsigned offC[2][2] = {{0u, 0u}, {0u, 0u}}, offN[2][2] = {{0u, 0u}, {0u, 0u}};
    if constexpr (GATHER) { S.gather(0, Rg[0], Rg[1], offC);
#pragma unroll
        for (int h = 0; h < 2; ++h)
#pragma unroll
            for (int i = 0; i < 2; ++i) offC[h][i] += Cg[i]; }
    const char* cA = S.a_base(cur); const char* cB = S.b_base(cur);
    PG8_STAGE_B(PG8_SB(0, 0), cB); PG8_STAGE_B(PG8_SB(0, 1), cB + hstep); PG8_STAGE_A(PG8_SA(0, 0), cA, 0, offC); PG8_STAGE_A(PG8_SA(0, 1), cA, 1, offC);
    if (wr == 1) PG8_BAR;
    PG8_WAIT_V(2); PG8_BAR;
    PG8_STAGE_B(PG8_SB(1, 0), cB + kstep); PG8_STAGE_A(PG8_SA(1, 0), cA + kstep, 0, offC); PG8_STAGE_B(PG8_SB(1, 1), cB + hstep + kstep);
    PG8_WAIT_V(6); PG8_BAR;
    for (;;) {
        const bool has_next = S.next(ui + 1, nxt);
        const char* nA = has_next ? S.a_base(nxt) : cA; const char* nB = has_next ? S.b_base(nxt) : cB;
        if constexpr (GATHER) { if (has_next) { S.gather(ui + 1, Rg[0], Rg[1], offN);
#pragma unroll
                for (int h = 0; h < 2; ++h)
#pragma unroll
                    for (int i = 0; i < 2; ++i) offN[h][i] += Cg[i]; }
            else {
#pragma unroll
                for (int h = 0; h < 2; ++h)
#pragma unroll
                    for (int i = 0; i < 2; ++i) offN[h][i] = offC[h][i]; } }
        for (int t = 0; t < nt; t += 2) {
            const bool last = (t == nt - 2);
            const char* a1 = cA + (size_t)(t + 1) * kstep;
            const char* a2 = last ? nA : cA + (size_t)(t + 2) * kstep; const char* b2 = last ? nB : cB + (size_t)(t + 2) * kstep;
            const char* a3 = a2 + kstep; const char* b3 = b2 + kstep;
            unsigned o2[2][2];
#pragma unroll
            for (int h = 0; h < 2; ++h)
#pragma unroll
                for (int i = 0; i < 2; ++i) o2[h][i] = last ? offN[h][i] : offC[h][i];
            if constexpr (MIDK) { if (t == nt / 2) E.midk(acc, cur, wr, fr); }
            PG8_LDB(B0, 0, 0); PG8_LDB(B1, 0, 1); PG8_SCHED; PG8_LDA(At, 0, 0); PG8_STAGE_A(PG8_SA(1, 1), a1, 1, offC);
            PG8_WAIT_V(8); PG8_WAIT_L(0); PG8_BAR; PG8_MMA(0, 0, At, B0); PG8_MMA(0, 1, At, B1); PG8_BAR; PG8_SCHED;
            PG8_LDA(At, 0, 1); PG8_STAGE_B(PG8_SB(0, 0), b2); PG8_STAGE_B(PG8_SB(0, 1), b2 + hstep); PG8_STAGE_A(PG8_SA(0, 0), a2, 0, o2);
            PG8_WAIT_V(8); PG8_WAIT_L(0); PG8_BAR; PG8_MMA(1, 0, At, B0); PG8_MMA(1, 1, At, B1); PG8_BAR; PG8_SCHED;
            PG8_LDB(B0, 1, 0); PG8_LDB(B1, 1, 1); PG8_SCHED; PG8_LDA(At, 1, 0); PG8_STAGE_A(PG8_SA(0, 1), a2, 1, o2);
            PG8_WAIT_V(8); PG8_WAIT_L(0); PG8_BAR; PG8_MMA(0, 0, At, B0); PG8_MMA(0, 1, At, B1); PG8_BAR; PG8_SCHED;
            PG8_LDA(At, 1, 1); PG8_STAGE_B(PG8_SB(1, 0), b3); PG8_STAGE_B(PG8_SB(1, 1), b3 + hstep); PG8_STAGE_A(PG8_SA(1, 0), a3, 0, o2);
            PG8_WAIT_V(8); PG8_WAIT_L(0); PG8_BAR; PG8_MMA(1, 0, At, B0); PG8_MMA(1, 1, At, B1); PG8_BAR; PG8_SCHED;
        }
        if (wr == 0) PG8_BAR;
        if constexpr (F8) asm volatile("s_nop 15\n\ts_nop 15" ::: "memory");
        E(acc, cur, wr, wc, fr, fq);
        if (!has_next) break;
#pragma unroll
        for (int a = 0; a < 2; ++a)
#pragma unroll
            for (int b = 0; b < 2; ++b)
#pragma unroll
                for (int m = 0; m < 4; ++m)
#pragma unroll
                    for (int n = 0; n < 2; ++n) acc[a][b][m][n] = (f32x4){0.f, 0.f, 0.f, 0.f};
        cur = nxt; cA = nA; cB = nB; ++ui;
        if constexpr (GATHER) {
#pragma unroll
            for (int h = 0; h < 2; ++h)
#pragma unroll
                for (int i = 0; i < 2; ++i) offC[h][i] = offN[h][i]; }
        if (wr == 1) PG8_BAR;
    }
    PG8_WAIT_V(0);
    PG8_BAR;
}
}

struct Frame {
    LAS unsigned char* lds;
    volatile LAS unsigned* MISC;
    gu32* ctl;
    unsigned char* ws;
    int vcu, G;
    const float *x, *p, *mix_norm, *w_in, *ln_g, *ln_b, *gws, *gbs, *aon, *gon, *w_out, *ffn_norm, *router_w, *router_b, *w_gu, *b_gu, *w_dn, *b_dn, *ple_norm, *w_pg, *w_pp, *ppn, *final_norm;
    float* out;
};
template <class T_> __device__ __forceinline__ T_* wsp(const Frame& F, size_t off) { return (T_*)(F.ws + off); }

#define PHASE_IDS int TID_ = (int)threadIdx.x; asm volatile("" : "+v"(TID_)); const int LANE_ = TID_ & 63; const int WAVE_ = __builtin_amdgcn_readfirstlane(TID_ >> 6); (void)LANE_; (void)WAVE_
template <class ColMap>
__device__ __forceinline__ void p0_transpose_item(const float* W, int K, int N, bf16* WT, const float* gain, LAS float* scr, int item, int lane, int nphys, const ColMap& cm) {
    const int nblk = nphys / 64, kb = item / nblk, nb = item % nblk, k0 = 64 * kb, n0 = 64 * nb;
    const int srccol = cm(n0 + lane);
    float v_[64]; const float* src = W + (size_t)k0 * N + srccol;
#pragma unroll
    for (int kk = 0; kk < 64; ++kk) v_[kk] = __builtin_nontemporal_load(src + (size_t)kk * N);
    if (gain) {
#pragma unroll
        for (int kk = 0; kk < 64; kk += 4) { const f32x4 g4 = *(const f32x4*)(gain + k0 + kk); v_[kk] *= g4[0]; v_[kk + 1] *= g4[1]; v_[kk + 2] *= g4[2]; v_[kk + 3] *= g4[3]; } }
#pragma unroll
    for (int kk = 0; kk < 64; ++kk) scr[kk * 65 + lane] = v_[kk];
    LDS_WAIT(); asm volatile("" ::: "memory");
    const int c = lane & 7;
#pragma unroll
    for (int j = 0; j < 8; ++j) { const int n = (lane >> 3) + 8 * j; const LAS float* s = scr + (8 * c) * 65 + n;
        v4u o; o.x = pk2(s[0 * 65], s[1 * 65]); o.y = pk2(s[2 * 65], s[3 * 65]); o.z = pk2(s[4 * 65], s[5 * 65]); o.w = pk2(s[6 * 65], s[7 * 65]);
        *(GAS v4u*)(WT + (size_t)(n0 + n) * K + k0 + 8 * c) = o; }
    LDS_WAIT(); asm volatile("" ::: "memory");
}
template <class ColMap>
__device__ __forceinline__ void p0_transpose_item_f8(const float* W, int K, int N, unsigned char* WT, const float* gain, LAS float* scr, int item, int lane, int nphys, const ColMap& cm) {
    const int nblk = nphys / 64, kb = item / nblk, nb = item % nblk, k0 = 64 * kb, n0 = 64 * nb;
    const int srccol = cm(n0 + lane);
    float v_[64]; const float* src = W + (size_t)k0 * N + srccol;
#pragma unroll
    for (int kk = 0; kk < 64; ++kk) v_[kk] = __builtin_nontemporal_load(src + (size_t)kk * N);
    constexpr float WS_ = (float)(1 << pg8::F8_WSHIFT);
#pragma unroll
    for (int kk = 0; kk < 64; kk += 4) { f32x4 g4 = gain ? *(const f32x4*)(gain + k0 + kk) : (f32x4){1.f, 1.f, 1.f, 1.f}; v_[kk] *= g4[0] * WS_; v_[kk + 1] *= g4[1] * WS_; v_[kk + 2] *= g4[2] * WS_; v_[kk + 3] *= g4[3] * WS_; }
#pragma unroll
    for (int kk = 0; kk < 64; ++kk) scr[kk * 65 + lane] = v_[kk];
    LDS_WAIT(); asm volatile("" ::: "memory");
    const int c = lane & 3;
#pragma unroll
    for (int j = 0; j < 4; ++j) { const int n = (lane >> 2) + 16 * j; const LAS float* s_ = scr + (16 * c) * 65 + n;
        v4u o; o.x = pk4_fp8(s_[0 * 65], s_[1 * 65], s_[2 * 65], s_[3 * 65]); o.y = pk4_fp8(s_[4 * 65], s_[5 * 65], s_[6 * 65], s_[7 * 65]);
        o.z = pk4_fp8(s_[8 * 65], s_[9 * 65], s_[10 * 65], s_[11 * 65]); o.w = pk4_fp8(s_[12 * 65], s_[13 * 65], s_[14 * 65], s_[15 * 65]);
        *(GAS v4u*)(WT + (size_t)(n0 + n) * K + k0 + 16 * c) = o; }
    LDS_WAIT(); asm volatile("" ::: "memory");
}
struct CmId { __device__ __forceinline__ int operator()(int n) const { return n; } };
struct CmWin { __device__ __forceinline__ int operator()(int n) const { if (n >= 2 * AW) return n; const int c = n & 63; return (n & ~63) + 4 * (c >> 3) + (c & 3) + 32 * ((c >> 2) & 1); } };
struct CmWgu { __device__ __forceinline__ int operator()(int n) const { return ((n >> 7) & 1) * FF + (n >> 8) * 128 + (n & 127); } };

constexpr int XW_I_GU = (DM / 64) * (2 * FF / 64), XW_I_DN = (FF / 64) * (DM / 64), XW_ITEMS = NE * (XW_I_GU + XW_I_DN);
__device__ __forceinline__ void xw_convert_item(const Frame& F, int it, LAS float* scr, int lane) {
    if (it < NE * XW_I_GU) { const int e = it / XW_I_GU; p0_transpose_item_f8(F.w_gu + (size_t)e * DM * 2 * FF, DM, 2 * FF, wsp<unsigned char>(F, WS_WGU) + (size_t)e * 2 * FF * DM, F.ffn_norm, scr, it % XW_I_GU, lane, 2 * FF, CmWgu()); }
    else { const int r = it - NE * XW_I_GU, e = r / XW_I_DN; p0_transpose_item_f8(F.w_dn + (size_t)e * FF * DM, FF, DM, wsp<unsigned char>(F, WS_WDN) + (size_t)e * DM * FF, nullptr, scr, r % XW_I_DN, lane, DM, CmId()); }
}
struct XwDesc { const float* src; unsigned char* dst; unsigned N, K; };
__device__ __forceinline__ XwDesc xw_desc(const Frame& F, int it, int lane) {
    XwDesc d; const int kq = lane >> 4, nq = lane & 15;
    if (it < NE * XW_I_GU) { const int e = it / XW_I_GU, item = it % XW_I_GU, nblk = 2 * FF / 64, k0 = 64 * (item / nblk), n0 = 64 * (item % nblk);
        d.N = 2 * FF; d.K = DM; d.src = F.w_gu + (size_t)e * DM * 2 * FF + (size_t)(k0 + kq) * (2 * FF) + CmWgu()(n0) + 4 * nq;
        d.dst = wsp<unsigned char>(F, WS_WGU) + (size_t)e * 2 * FF * DM + (size_t)(n0 + (lane >> 2)) * DM + k0 + 16 * (lane & 3); }
    else { const int r = it - NE * XW_I_GU, e = r / XW_I_DN, item = r % XW_I_DN, nblk = DM / 64, k0 = 64 * (item / nblk), n0 = 64 * (item % nblk);
        d.N = DM; d.K = FF; d.src = F.w_dn + (size_t)e * FF * DM + (size_t)(k0 + kq) * DM + n0 + 4 * nq;
        d.dst = wsp<unsigned char>(F, WS_WDN) + (size_t)e * DM * FF + (size_t)(n0 + (lane >> 2)) * FF + k0 + 16 * (lane & 3); }
    return d;
}
__device__ __forceinline__ void xw_load(f32x4 (&v)[16], const XwDesc& d) {
#pragma unroll
    for (int j = 0; j < 16; ++j) v[j] = __builtin_nontemporal_load((const f32x4*)(d.src + (size_t)(4 * j) * d.N));
}
__device__ __forceinline__ void xw_process(const f32x4 (&v)[16], const XwDesc& d, LAS float* scr, int lane) {
    const int kq = lane >> 4, nq = lane & 15;
#pragma unroll
    for (int j = 0; j < 16; ++j) { LAS float* w = scr + (4 * j + kq) * 65 + 4 * nq; w[0] = v[j][0]; w[1] = v[j][1]; w[2] = v[j][2]; w[3] = v[j][3]; }
    LDS_WAIT(); asm volatile("" ::: "memory");
    constexpr float WS_ = (float)(1 << pg8::F8_WSHIFT);
    const int c = lane & 3;
#pragma unroll
    for (int j = 0; j < 4; ++j) { const LAS float* s_ = scr + (16 * c) * 65 + (lane >> 2) + 16 * j;
        v4u o; o.x = pk4_fp8(s_[0 * 65] * WS_, s_[1 * 65] * WS_, s_[2 * 65] * WS_, s_[3 * 65] * WS_); o.y = pk4_fp8(s_[4 * 65] * WS_, s_[5 * 65] * WS_, s_[6 * 65] * WS_, s_[7 * 65] * WS_);
        o.z = pk4_fp8(s_[8 * 65] * WS_, s_[9 * 65] * WS_, s_[10 * 65] * WS_, s_[11 * 65] * WS_); o.w = pk4_fp8(s_[12 * 65] * WS_, s_[13 * 65] * WS_, s_[14 * 65] * WS_, s_[15 * 65] * WS_);
        *(GAS v4u*)(d.dst + (size_t)(16 * j) * d.K) = o; }
    LDS_WAIT(); asm volatile("" ::: "memory");
}
__device__ __forceinline__ void p0_prologue(Frame& F) {
    PHASE_IDS;
    { const int gt0 = (int)blockIdx.x * NTHR + TID_, GT0 = F.G * NTHR;
      for (int i = gt0; i < CW_TS; i += GT0) F.ctl[i] = 0u;
      float* km0 = wsp<float>(F, WS_KMEAN); for (int i = gt0; i < (T / SEQ) * NH * NBLK * HD; i += GT0) km0[i] = 0.f; }
    LAS float* scr = (LAS float*)(F.lds + RING_OFF + WAVE_ * P0_SCR_WAVE);
    const int gw = F.vcu * NWAVES + WAVE_, NGW = F.G * NWAVES;
    constexpr int I_GU = (DM / 64) * (2 * FF / 64), I_DN = (FF / 64) * (DM / 64), I_IN = (DM / 64) * (NPROJ / 64), I_SQ = (DM / 64) * (DM / 64), I_PP = (PLE / 64) * (DM / 64);
    constexpr int NITEMS = I_IN + 2 * I_SQ + I_PP;
    (void)I_GU; (void)I_DN;
    for (int it = gw; it < NITEMS; it += NGW) {
        int r = it;
        if (r < I_IN) { p0_transpose_item(F.w_in, DM, NPROJ, wsp<bf16>(F, WS_WIN), F.mix_norm, scr, r, LANE_, NPROJ, CmWin()); continue; } r -= I_IN;
        if (r < I_SQ) {
            const int nblk = DM / 64, kb = r / nblk; const float* g = (kb < 8) ? F.aon : (F.gon - AW);
            p0_transpose_item(F.w_out, DM, DM, wsp<bf16>(F, WS_WOUT), g, scr, r, LANE_, DM, CmId()); continue; } r -= I_SQ;
        if (r < I_SQ) { p0_transpose_item_f8(F.w_pg, DM, DM, wsp<unsigned char>(F, WS_WPG8), F.ple_norm, scr, r, LANE_, DM, CmId()); continue; } r -= I_SQ;
        p0_transpose_item(F.w_pp, PLE, DM, wsp<bf16>(F, WS_WPP), nullptr, scr, r, LANE_, DM, CmId());
    }
    if (TPROBE && blockIdx.x == 0 && threadIdx.x == 0) ((unsigned long long*)(F.ctl + CW_TS))[11] = __builtin_amdgcn_s_memrealtime();
    bf16* XN = wsp<bf16>(F, WS_XNB);
    for (int m0 = gw; m0 < T; m0 += 2 * NGW) {
        f32x4 v[2][4]; float s[2] = {0.f, 0.f};
#pragma unroll
        for (int r = 0; r < 2; ++r) { const GAS f32x4* xr = (const GAS f32x4*)(F.x + (size_t)(m0 + r * NGW) * DM) + LANE_;
#pragma unroll
            for (int j = 0; j < 4; ++j) v[r][j] = __builtin_nontemporal_load(xr + 64 * j); }
#pragma unroll
        for (int r = 0; r < 2; ++r) {
#pragma unroll
            for (int j = 0; j < 4; ++j) s[r] += (v[r][j].x * v[r][j].x + v[r][j].y * v[r][j].y) + (v[r][j].z * v[r][j].z + v[r][j].w * v[r][j].w); }
#pragma unroll
        for (int r = 0; r < 2; ++r) { const int m = m0 + r * NGW; const float sig = sqrtf(wave_sum(s[r]) * (1.f / DM) + EPS), rstd = 1.0f / sig;
            if (LANE_ == 0) wsp<float>(F, WS_SIG0)[m] = sig;
            GAS v2u* o8 = (GAS v2u*)(XN + (size_t)m * DM) + LANE_;
#pragma unroll
            for (int j = 0; j < 4; ++j) { v2u w; w.x = pk2(v[r][j].x * rstd, v[r][j].y * rstd); w.y = pk2(v[r][j].z * rstd, v[r][j].w * rstd); o8[64 * j] = w; } }
    }
    if (TPROBE && blockIdx.x == 0 && threadIdx.x == 0) ((unsigned long long*)(F.ctl + CW_TS))[12] = __builtin_amdgcn_s_memrealtime();
    { const GAS f32x4* pr = (const GAS f32x4*)F.p; GAS v2u* po = (GAS v2u*)wsp<bf16>(F, WS_PB);
      const size_t n4 = (size_t)T * PLE / 4, gt = (size_t)(F.vcu * NTHR + TID_), GT = (size_t)F.G * NTHR;
      for (size_t i = gt; i < n4; i += GT) { const f32x4 v = pr[i]; v2u w; w.x = pk2(v.x, v.y); w.y = pk2(v.z, v.w); po[i] = w; } }
    if (TPROBE && blockIdx.x == 0 && threadIdx.x == 0) ((unsigned long long*)(F.ctl + CW_TS))[13] = __builtin_amdgcn_s_memrealtime();
    { const int gt = F.vcu * NTHR + TID_, GT = F.G * NTHR; float* RWG = wsp<float>(F, WS_RWG);
      (void)RWG; bf16* RWT = wsp<bf16>(F, WS_RWT);
      for (int i = gt; i < DM * NE; i += GT) { const int e = i / DM, k = i % DM; const float w = F.router_w[k * NE + e] * F.ffn_norm[k]; const unsigned hi = f2bf(w); const float lo = w - bf2f((bf16)hi); RWT[i] = (bf16)hi; RWT[NE * DM + i] = (bf16)f2bf(lo); }
      float* RC = wsp<float>(F, WS_ROPE); float* RS = RC + SEQ * 32;
      for (int i = gt; i < SEQ * 32; i += GT) { const int pos = i >> 5, j = i & 31; const float inv = powf(10000.0f, -(float)j / 32.0f); const float ang = (float)pos * inv; float sn, cs; sincosf(ang, &sn, &cs); RC[i] = cs; RS[i] = sn; } }
}

using pg8::Unit;
constexpr int HALF = 128;
struct EpiInProj {
    static constexpr bool PERM = true;
    bf16* QKVUV; const float *rc, *rs; float* kmean;
    __device__ __forceinline__ void operator()(const f32x4 (&acc)[2][2][4][2], const Unit& u, int wr, int wc, int fr, int fq) const {
        const int type = u.pn >> 1, colt = (u.pn & 1) * 256 + wc * 32 + 8 * fq;
        const int row0 = u.pm * 256 + wr * 64 + fr;
        if (type <= 1) {
            bf16* dst = QKVUV + (size_t)type * (16u << 20);
            const int pos0 = (u.pm & 7) * 256 + wr * 64 + fr, i0 = 16 * (wc & 1) + 4 * fq;
            f32x4 cs_[2][2];
#pragma unroll
            for (int bj = 0; bj < 2; ++bj) { cs_[bj][0] = (f32x4){0.f, 0.f, 0.f, 0.f}; cs_[bj][1] = (f32x4){0.f, 0.f, 0.f, 0.f}; }
#pragma unroll
            for (int ai = 0; ai < 2; ++ai) { f32x4 cc[4], ss[4];
#pragma unroll
                for (int m = 0; m < 4; ++m) { const int pos = pos0 + ai * HALF + m * 16; cc[m] = *(const f32x4*)(rc + pos * 32 + i0); ss[m] = *(const f32x4*)(rs + pos * 32 + i0); }
#pragma unroll
                for (int m = 0; m < 4; ++m) { const int ro = ai * HALF + m * 16; const f32x4 c = cc[m], s = ss[m];
                    bf16* rowp = dst + (size_t)(row0 + ro) * AW + colt;
#pragma unroll
                    for (int bj = 0; bj < 2; ++bj) { const f32x4 x1 = acc[ai][bj][m][0], x2 = acc[ai][bj][m][1];
                        const f32x4 o1 = x1 * c - x2 * s, o2 = x2 * c + x1 * s;
                        cs_[bj][0] += o1; cs_[bj][1] += o2;
                        v4u w; w.x = cvt_pk_bf16(o1[0], o1[1]); w.y = cvt_pk_bf16(o1[2], o1[3]); w.z = cvt_pk_bf16(o2[0], o2[1]); w.w = cvt_pk_bf16(o2[2], o2[3]);
                        *(v4u*)(rowp + bj * HALF) = w; } }
                asm volatile("" ::: "memory"); }
            if (type == 1) {
#pragma unroll
                for (int bj = 0; bj < 2; ++bj)
#pragma unroll
                    for (int n = 0; n < 2; ++n)
#pragma unroll
                        for (int j = 0; j < 4; ++j) { float v = cs_[bj][n][j]; v += __shfl_xor(v, 1); v += __shfl_xor(v, 2); v += __shfl_xor(v, 4); v += __shfl_xor(v, 8); cs_[bj][n][j] = v; }
                if (fr == 0) { const int b = u.pm >> 3, blk = u.pm & 7;
#pragma unroll
                    for (int bj = 0; bj < 2; ++bj) { const int colh = (u.pn & 1) * 256 + bj * HALF + wc * 32; const int head = colh >> 6, cpos = (colh & 63) + 8 * fq;
                        float* km = kmean + ((size_t)((b * NH + head) * NBLK + blk)) * HD + cpos;
#pragma unroll
                        for (int n = 0; n < 2; ++n)
#pragma unroll
                            for (int j = 0; j < 4; ++j) atomicAdd(km + 4 * n + j, cs_[bj][n][j]); } }
            }
        } else {
            bf16* dst = QKVUV + (size_t)type * (16u << 20);
#pragma unroll
            for (int ai = 0; ai < 2; ++ai)
#pragma unroll
                for (int m = 0; m < 4; ++m) { bf16* rowp = dst + (size_t)(row0 + ai * HALF + m * 16) * AW + colt;
#pragma unroll
                    for (int bj = 0; bj < 2; ++bj) { f32x4 v0 = acc[ai][bj][m][0], v1 = acc[ai][bj][m][1];
                        if (type >= 3) { v0 = gelu4(v0); v1 = gelu4(v1); }
                        v4u w; w.x = cvt_pk_bf16(v0[0], v0[1]); w.y = cvt_pk_bf16(v0[2], v0[3]); w.z = cvt_pk_bf16(v1[0], v1[1]); w.w = cvt_pk_bf16(v1[2], v1[3]);
                        *(v4u*)(rowp + bj * HALF) = w; } }
        }
    }
};
struct EpiOutProj {
    static constexpr bool PERM = true;
    const bf16* xn; bf16* x1; unsigned char* x1f8; float* ssq1; const LAS f32x4* rtab; const float* fgain;
    int pm_a, pm_b;
    __device__ __forceinline__ int slot(const Unit& u) const { return u.pm == pm_a ? 0 : 1; }
    __device__ __forceinline__ void midk(f32x4 (&acc)[2][2][4][2], const Unit& u, int wr, int fr) const {
        const LAS f32x4* t = rtab + slot(u) * 256 + wr * 64 + fr;
#pragma unroll
        for (int ai = 0; ai < 2; ++ai)
#pragma unroll
            for (int m = 0; m < 4; ++m) { const float r = t[ai * HALF + m * 16].x;
#pragma unroll
                for (int bj = 0; bj < 2; ++bj)
#pragma unroll
                    for (int n = 0; n < 2; ++n) acc[ai][bj][m][n] *= r; }
    }
    __device__ __forceinline__ void operator()(const f32x4 (&acc)[2][2][4][2], const Unit& u, int wr, int wc, int fr, int fq) const {
        const LAS f32x4* t = rtab + slot(u) * 256 + wr * 64 + fr;
        const int row0 = u.pm * 256 + wr * 64 + fr, col0 = u.pn * 256 + wc * 32 + 8 * fq;
        f32x4 fg[2][2];
#pragma unroll
        for (int bj = 0; bj < 2; ++bj) { fg[bj][0] = *(const f32x4*)(fgain + col0 + bj * HALF); fg[bj][1] = *(const f32x4*)(fgain + col0 + bj * HALF + 4); }
#pragma unroll
        for (int ai = 0; ai < 2; ++ai) { v4u xv[4][2];
#pragma unroll
            for (int m = 0; m < 4; ++m) { const size_t off = (size_t)(row0 + ai * HALF + m * 16) * DM + col0;
                xv[m][0] = *(const v4u*)(xn + off); xv[m][1] = *(const v4u*)(xn + off + HALF); }
#pragma unroll
            for (int m = 0; m < 4; ++m) { const int ro = ai * HALF + m * 16; const f32x4 tv = t[ro]; const float rg = tv.y, sx = tv.z; const size_t off = (size_t)(row0 + ro) * DM + col0; float q = 0.f;
#pragma unroll
                for (int bj = 0; bj < 2; ++bj) { const v4u xw = xv[m][bj];
                    const f32x4 x0 = {bflo(xw.x), bfhi(xw.x), bflo(xw.y), bfhi(xw.y)}, x1_ = {bflo(xw.z), bfhi(xw.z), bflo(xw.w), bfhi(xw.w)};
                    const f32x4 o0 = x0 * sx + acc[ai][bj][m][0] * rg, o1 = x1_ * sx + acc[ai][bj][m][1] * rg;
                    q += (o0[0] * o0[0] + o0[1] * o0[1]) + (o0[2] * o0[2] + o0[3] * o0[3]) + (o1[0] * o1[0] + o1[1] * o1[1]) + (o1[2] * o1[2] + o1[3] * o1[3]);
                    v4u w; w.x = cvt_pk_bf16(o0[0], o0[1]); w.y = cvt_pk_bf16(o0[2], o0[3]); w.z = cvt_pk_bf16(o1[0], o1[1]); w.w = cvt_pk_bf16(o1[2], o1[3]);
                    *(v4u*)(x1 + off + bj * HALF) = w;
                    const f32x4 p0 = o0 * fg[bj][0], p1 = o1 * fg[bj][1];
                    v2u w8; w8.x = pk4_fp8(p0[0], p0[1], p0[2], p0[3]); w8.y = pk4_fp8(p1[0], p1[1], p1[2], p1[3]); *(v2u*)(x1f8 + off + bj * HALF) = w8; }
                q += __shfl_xor(q, 16); q += __shfl_xor(q, 32);
                if (fq == 0) ssq1[(size_t)(row0 + ro) * 16 + u.pn * 4 + wc] = q; }
            asm volatile("" ::: "memory"); }
    }
};
struct EpiMoe1 {
    static constexpr bool PERM = true;
    unsigned char* A; const float* b_gu; const LAS float* rss;
    __device__ __forceinline__ void operator()(const f32x4 (&acc)[2][2][4][2], const Unit& u, int wr, int wc, int fr, int fq) const {
        const int row0 = u.pm * 256 + wr * 64 + fr, col = u.pn * 128 + wc * 32 + 8 * fq;
        const float* bg = b_gu + (size_t)u.e * 2 * FF + col; const LAS float* rs_ = rss + u.slot * 256 + wr * 64 + fr;
        float rsv[2][4];
#pragma unroll
        for (int ai = 0; ai < 2; ++ai)
#pragma unroll
            for (int m = 0; m < 4; ++m) rsv[ai][m] = rs_[ai * HALF + m * 16];
        f32x4 bgv[2], blv[2];
#pragma unroll
        for (int n = 0; n < 2; ++n) { bgv[n] = *(const f32x4*)(bg + 4 * n); blv[n] = *(const f32x4*)(bg + FF + 4 * n); }
#pragma unroll
        for (int ai = 0; ai < 2; ++ai)
#pragma unroll
            for (int m = 0; m < 4; ++m) { f32x4 a[2];
#pragma unroll
                for (int n = 0; n < 2; ++n) { const f32x4 g = acc[ai][0][m][n] * rsv[ai][m] + bgv[n], l = acc[ai][1][m][n] * rsv[ai][m] + blv[n];
#pragma unroll
                    for (int p = 0; p < 2; ++p) { f32x2 gc = {fminf(g[2 * p], 7.0f), fminf(g[2 * p + 1], 7.0f)}; f32x2 lc = {fminf(fmaxf(l[2 * p], -7.0f), 7.0f), fminf(fmaxf(l[2 * p + 1], -7.0f), 7.0f)};
                        const f32x2 z = gc * (-1.702f * 1.4426950408889634f); f32x2 e; e.x = __builtin_amdgcn_exp2f(z.x); e.y = __builtin_amdgcn_exp2f(z.y);
                        const f32x2 d = e + 1.0f; f32x2 r; r.x = __builtin_amdgcn_rcpf(d.x); r.y = __builtin_amdgcn_rcpf(d.y);
                        const f32x2 o = (gc * r) * (lc + 1.0f); a[n][2 * p] = o.x; a[n][2 * p + 1] = o.y; } }
                v2u w; w.x = pk4_fp8_nc(a[0][0], a[0][1], a[0][2], a[0][3]); w.y = pk4_fp8_nc(a[1][0], a[1][1], a[1][2], a[1][3]);
                *(v2u*)(A + (size_t)(row0 + ai * HALF + m * 16) * FF + col) = w; }
    }
};
constexpr float Y_SCALE = 16.0f;
struct EpiMoe2 {
    static constexpr bool PERM = true;
    unsigned char* Y; const float* b_dn; const LAS float* gss;
    __device__ __forceinline__ void operator()(const f32x4 (&acc)[2][2][4][2], const Unit& u, int wr, int wc, int fr, int fq) const {
        const int row0 = u.pm * 256 + wr * 64 + fr, col0 = u.pn * 256 + wc * 32 + 8 * fq;
        const LAS float* gs = gss + u.slot * 256 + wr * 64 + fr;
        f32x4 bv[2][2]; float gv[2][4];
#pragma unroll
        for (int bj = 0; bj < 2; ++bj)
#pragma unroll
            for (int n = 0; n < 2; ++n) bv[bj][n] = *(const f32x4*)(b_dn + (size_t)u.e * DM + col0 + bj * HALF + 4 * n);
#pragma unroll
        for (int ai = 0; ai < 2; ++ai)
#pragma unroll
            for (int m = 0; m < 4; ++m) gv[ai][m] = gs[ai * HALF + m * 16] * Y_SCALE;
#pragma unroll
        for (int ai = 0; ai < 2; ++ai)
#pragma unroll
            for (int m = 0; m < 4; ++m) { const float g = gv[ai][m]; unsigned char* rowp = Y + (size_t)(row0 + ai * HALF + m * 16) * DM + col0;
#pragma unroll
                for (int bj = 0; bj < 2; ++bj) { const f32x4 v0 = (acc[ai][bj][m][0] + bv[bj][0]) * g, v1 = (acc[ai][bj][m][1] + bv[bj][1]) * g;
                    v2u w; w.x = pk4_fp8(v0[0], v0[1], v0[2], v0[3]); w.y = pk4_fp8(v1[0], v1[1], v1[2], v1[3]);
                    *(v2u*)(rowp + bj * HALF) = w; } }
    }
};
constexpr float GATE_SCALE = 128.0f;
template <int MODE> struct EpiPle {
    static constexpr bool PERM = true;
    unsigned char* O; float* ssq; const LAS float* rtab; int pm_a;
    __device__ __forceinline__ void operator()(const f32x4 (&acc)[2][2][4][2], const Unit& u, int wr, int wc, int fr, int fq) const {
        const int row0 = u.pm * 256 + wr * 64 + fr, col0 = u.pn * 256 + wc * 32 + 8 * fq;
        float rsv[2][4];
#pragma unroll
        for (int ai = 0; ai < 2; ++ai)
#pragma unroll
            for (int m = 0; m < 4; ++m) rsv[ai][m] = (MODE == 0) ? rtab[(u.pm == pm_a ? 0 : 256) + wr * 64 + fr + ai * HALF + m * 16] : 1.0f;
#pragma unroll
        for (int ai = 0; ai < 2; ++ai)
#pragma unroll
            for (int m = 0; m < 4; ++m) { unsigned char* rowp = O + (size_t)(row0 + ai * HALF + m * 16) * DM + col0; float q = 0.f; const float rs = rsv[ai][m];
#pragma unroll
                for (int bj = 0; bj < 2; ++bj) { f32x4 v0 = acc[ai][bj][m][0], v1 = acc[ai][bj][m][1];
                    if (MODE == 0) {
#pragma unroll
                        for (int j = 0; j < 4; ++j) { v0[j] = GATE_SCALE * sigmoidf_fast(rs * v0[j]); v1[j] = GATE_SCALE * sigmoidf_fast(rs * v1[j]); } }
                    else { q += (v0[0] * v0[0] + v0[1] * v0[1]) + (v0[2] * v0[2] + v0[3] * v0[3]) + (v1[0] * v1[0] + v1[1] * v1[1]) + (v1[2] * v1[2] + v1[3] * v1[3]); }
                    v2u w; if (MODE == 0) { w.x = pk4_fp8_nc(v0[0], v0[1], v0[2], v0[3]); w.y = pk4_fp8_nc(v1[0], v1[1], v1[2], v1[3]); }
                    else { w.x = pk4_fp8(v0[0], v0[1], v0[2], v0[3]); w.y = pk4_fp8(v1[0], v1[1], v1[2], v1[3]); }
                    *(v2u*)(rowp + bj * HALF) = w; }
                if (MODE == 1) { q += __shfl_xor(q, 16); q += __shfl_xor(q, 32); if (fq == 0) ssq[(size_t)(row0 + ai * HALF + m * 16) * 16 + u.pn * 4 + wc] = q; } }
    }
};

namespace att {
constexpr int QBLK = 32, KVBLK = 64;
constexpr float SCALE = 0.125f, THR = 8.f;
constexpr int SHM_V = KVBLK * HD * 2, SHM_K = SHM_V;
constexpr int NSLOT = 3;
constexpr int LDS_BYTES_ = NSLOT * SHM_V + NSLOT * SHM_K + NWAVES * 64 * 4;
#define ATT_KSWZ(row, colB) ((row) * 128 + ((colB) ^ ((((row) >> 1) & 7) << 4)))
#define ATT_SBAR() __builtin_amdgcn_sched_barrier(0)
__device__ __forceinline__ int crow(int r, int hi) { return (r & 3) + 8 * (r >> 2) + 4 * hi; }
__device__ __forceinline__ void cmask(f32x16& p0, f32x16& p1, int jb, int qrel, int hi) {
    const float NEG = -__builtin_inff(); const int kb = 64 * jb + 4 * hi;
#pragma unroll
    for (int r = 0; r < 16; ++r) { const int kv = kb + (r & 3) + 8 * (r >> 2); if (kv > qrel) p0[r] = NEG; if (kv + 32 > qrel) p1[r] = NEG; }
}
__device__ __forceinline__ void bmask(f32x16& p0, f32x16& p1, bool keep) {
    const float NEG = -__builtin_inff();
    if (!keep) {
#pragma unroll
        for (int r = 0; r < 16; ++r) { p0[r] = NEG; p1[r] = NEG; } }
}
__device__ __forceinline__ void partialSM(f32x16& p0, f32x16& p1, float& m_reg, float& mn, float& alpha, bool keep) {
    float pmax = p0[0];
#pragma unroll
    for (int r = 1; r < 16; ++r) pmax = fmaxf(pmax, p0[r]);
#pragma unroll
    for (int r = 0; r < 16; ++r) pmax = fmaxf(pmax, p1[r]);
    { auto rr = __builtin_amdgcn_permlane32_swap(__float_as_uint(pmax), __float_as_uint(pmax), false, false);
      pmax = fmaxf(__uint_as_float(rr[0]), __uint_as_float(rr[1])); }
    if (!keep) pmax = -__builtin_inff();
    constexpr float C2 = 1.4426950408889634f * SCALE;
    if (__builtin_expect(__all((pmax - m_reg) * SCALE <= THR), 1)) { mn = m_reg; alpha = 1.f; }
    else { mn = fmaxf(m_reg, pmax); alpha = __builtin_amdgcn_exp2f((m_reg - mn) * C2); m_reg = mn; }
    const float mnL = keep ? -mn * C2 : -__builtin_inff(), c2 = keep ? C2 : 0.f;
#pragma unroll
    for (int r = 0; r < 16; ++r) p0[r] = fmaf(p0[r], c2, mnL);
#pragma unroll
    for (int r = 0; r < 16; ++r) p1[r] = fmaf(p1[r], c2, mnL);
#pragma unroll
    for (int r = 0; r < 16; ++r) p0[r] = __builtin_amdgcn_exp2f(p0[r]);
}
__device__ __forceinline__ void finishSM(f32x16& p0, f32x16& p1, float alpha, float& l_reg, bf16x8& pa0, bf16x8& pa1, bf16x8& pa2, bf16x8& pa3) {
#pragma unroll
    for (int r = 0; r < 16; ++r) p1[r] = __builtin_amdgcn_exp2f(p1[r]);
    float ps = 0;
#pragma unroll
    for (int r = 0; r < 16; ++r) ps += p0[r];
#pragma unroll
    for (int r = 0; r < 16; ++r) ps += p1[r];
    { auto rr = __builtin_amdgcn_permlane32_swap(__float_as_uint(ps), __float_as_uint(ps), false, false);
      ps = __uint_as_float(rr[0]) + __uint_as_float(rr[1]); }
    l_reg = l_reg * alpha + ps;
#define ATT_PK4(P, B, OUT) do { unsigned a0 = cvt_pk_bf16(P[B+0], P[B+1]), a1 = cvt_pk_bf16(P[B+2], P[B+3]);             \
        unsigned b0 = cvt_pk_bf16(P[B+4], P[B+5]), b1 = cvt_pk_bf16(P[B+6], P[B+7]);                                       \
        auto r0 = __builtin_amdgcn_permlane32_swap(a0, b0, false, false); auto r1 = __builtin_amdgcn_permlane32_swap(a1, b1, false, false); \
        v4u w = {r0[0], r1[0], r0[1], r1[1]}; OUT = *reinterpret_cast<bf16x8*>(&w); } while (0)
    ATT_PK4(p0, 0, pa0); ATT_PK4(p0, 8, pa1); ATT_PK4(p1, 0, pa2); ATT_PK4(p1, 8, pa3);
#undef ATT_PK4
}
__device__ __forceinline__ void qkt(f32x16& p0, f32x16& p1, const LAS unsigned char* Ks, const bf16x8* qr, int r32, int hi) {
    p0 = f32x16{}; p1 = f32x16{};
#pragma unroll
    for (int d0 = 0; d0 < 4; ++d0) { const int cb = (d0 * 16 + hi * 8) * 2;
        const bf16x8 b0 = *(const LAS bf16x8*)(Ks + ATT_KSWZ(r32, cb));
        const bf16x8 b1 = *(const LAS bf16x8*)(Ks + ATT_KSWZ(32 + r32, cb));
        p0 = __builtin_amdgcn_mfma_f32_32x32x16_bf16(b0, qr[d0], p0, 0, 0, 0);
        p1 = __builtin_amdgcn_mfma_f32_32x32x16_bf16(b1, qr[d0], p1, 0, 0, 0); }
}
__device__ __forceinline__ void pv(f32x16* o, int vb, bf16x8 pa0, bf16x8 pa1, bf16x8 pa2, bf16x8 pa3) {
#pragma unroll
    for (int d0 = 0; d0 < 2; ++d0) { s16x4 lo[4], hi[4];
#pragma unroll
        for (int ks = 0; ks < 4; ++ks) { const int a = vb + d0 * 2048 + (ks >> 1) * 4096 + (ks & 1) * 1024;
            asm volatile("ds_read_b64_tr_b16 %0,%1" : "=&v"(lo[ks]) : "v"(a) : "memory");
            asm volatile("ds_read_b64_tr_b16 %0,%1 offset:256" : "=&v"(hi[ks]) : "v"(a) : "memory"); }
        asm volatile("s_waitcnt lgkmcnt(0)" ::: "memory"); ATT_SBAR();
#define ATT_PK(k) (bf16x8){lo[k][0], lo[k][1], lo[k][2], lo[k][3], hi[k][0], hi[k][1], hi[k][2], hi[k][3]}
        o[d0] = __builtin_amdgcn_mfma_f32_32x32x16_bf16(pa0, ATT_PK(0), o[d0], 0, 0, 0);
        o[d0] = __builtin_amdgcn_mfma_f32_32x32x16_bf16(pa1, ATT_PK(1), o[d0], 0, 0, 0);
        o[d0] = __builtin_amdgcn_mfma_f32_32x32x16_bf16(pa2, ATT_PK(2), o[d0], 0, 0, 0);
        o[d0] = __builtin_amdgcn_mfma_f32_32x32x16_bf16(pa3, ATT_PK(3), o[d0], 0, 0, 0);
#undef ATT_PK
    }
}
__device__ __forceinline__ void attn_unit(const Frame& F, int b, int h, int qb, LAS unsigned char* scratch) {
    PHASE_IDS;
    const int tid = TID_, wid = tid >> 6, lane = tid & 63, r32 = lane & 31, hi = lane >> 5;
    const bf16* Qg = wsp<bf16>(F, WS_Q); const bf16* Kg = wsp<bf16>(F, WS_K); const bf16* Vg = wsp<bf16>(F, WS_V);
    const size_t rowbase = (size_t)b * SEQ; const int q0 = qb * MOBA;
    const bf16* Qw = Qg + (rowbase + q0 + wid * QBLK) * AW + h * HD;
    const bf16* Kh = Kg + rowbase * AW + h * HD; const bf16* Vh = Vg + rowbase * AW + h * HD;
    LAS unsigned char* V_lds = scratch; LAS unsigned char* K_lds = scratch + NSLOT * SHM_V;
    LAS float* wsf = (LAS float*)(scratch + NSLOT * SHM_V + NSLOT * SHM_K) + wid * 64; LAS float* li_l = wsf; LAS float* al_l = wsf + 32;
    float m_reg = -1e30f, l_reg = 0.f; f32x16 o[2]; o[0] = f32x16{}; o[1] = f32x16{}; bf16x8 qr[4];
#pragma unroll
    for (int d0 = 0; d0 < 4; ++d0) qr[d0] = *(const bf16x8*)(Qw + (size_t)r32 * AW + d0 * 16 + hi * 8);
    unsigned sel = 0u;
    if (qb <= 3) sel = (1u << qb) - 1u;
    else {
        const float* km = wsp<float>(F, WS_KMEAN) + (size_t)((b * NH + h) * NBLK) * HD + (size_t)(r32 & 7) * HD + hi * 8;
        f32x4 kv[4][2];
#pragma unroll
        for (int d0 = 0; d0 < 4; ++d0) { kv[d0][0] = *(const f32x4*)(km + d0 * 16); kv[d0][1] = *(const f32x4*)(km + d0 * 16 + 4); }
        f32x16 gacc = f32x16{};
#pragma unroll
        for (int d0 = 0; d0 < 4; ++d0) { float f[8] = {kv[d0][0][0], kv[d0][0][1], kv[d0][0][2], kv[d0][0][3], kv[d0][1][0], kv[d0][1][1], kv[d0][1][2], kv[d0][1][3]};
            unsigned hw[4], lw[4];
#pragma unroll
            for (int p = 0; p < 4; ++p) { float a0 = f[2 * p], a1 = f[2 * p + 1]; if (r32 >= 8) { a0 = 0.f; a1 = 0.f; }
                const unsigned h0 = f2bf(a0), h1 = f2bf(a1); hw[p] = h0 | (h1 << 16); lw[p] = pk2(a0 - bf2f((bf16)h0), a1 - bf2f((bf16)h1)); }
            const v4u hv = {hw[0], hw[1], hw[2], hw[3]}, lv = {lw[0], lw[1], lw[2], lw[3]};
            gacc = __builtin_amdgcn_mfma_f32_32x32x16_bf16(__builtin_bit_cast(bf16x8, hv), qr[d0], gacc, 0, 0, 0);
            gacc = __builtin_amdgcn_mfma_f32_32x32x16_bf16(__builtin_bit_cast(bf16x8, lv), qr[d0], gacc, 0, 0, 0); }
        float g[8];
#pragma unroll
        for (int r = 0; r < 4; ++r) { const float mine = gacc[r], other = __shfl_xor(mine, 32); g[r] = hi ? other : mine; g[4 + r] = hi ? mine : other; }
        float b0 = -__builtin_inff(), b1 = b0, b2 = b0; int i0 = 0, i1 = 0, i2 = 0;
#pragma unroll
        for (int j = 0; j < NBLK - 1; ++j) { const float s_ = (j < qb) ? g[j] : -__builtin_inff();
            if (s_ > b0) { b2 = b1; i2 = i1; b1 = b0; i1 = i0; b0 = s_; i0 = j; } else if (s_ > b1) { b2 = b1; i2 = i1; b1 = s_; i1 = j; } else if (s_ > b2) { b2 = s_; i2 = j; } }
        sel = (1u << i0) | (1u << i1) | (1u << i2);
    }
    const int sr = tid >> 3, sc = (tid & 7) * 8;
    const int srv = ((tid >> 5) << 2) | ((tid >> 1) & 3), scv = ((tid & 1) << 3) | (((tid >> 3) & 3) << 4);
    const int vst = (srv >> 5) * 4096 + (scv >> 5) * 2048 + ((srv & 31) >> 2) * 256 + ((scv >> 4) & 1) * 128 + (srv & 3) * 32 + (scv & 8) * 2;
    const int vb0 = (int)(size_t)V_lds + (lane & 15) * 8 + ((lane >> 4) & 1) * 128 + (lane >> 5) * 512;
    bf16x8 st_v, st_k;
#define ATT_SLOAD(k0) do { st_v = *(const bf16x8*)(Vh + (size_t)((k0) + srv) * AW + scv); st_k = *(const bf16x8*)(Kh + (size_t)((k0) + sr) * AW + sc); } while (0)
#define ATT_SWRITE(bf) do { *(LAS bf16x8*)(V_lds + (bf) * SHM_V + vst) = st_v; *(LAS bf16x8*)(K_lds + (bf) * SHM_K + ATT_KSWZ(sr, sc * 2)) = st_k; } while (0)
#define ATT_RESC(a) do { if (__any((a) < 1.f)) { if (hi == 0) al_l[r32] = (a); asm volatile("s_waitcnt lgkmcnt(0)" ::: "memory");      \
        _Pragma("unroll") for (int d_ = 0; d_ < 2; ++d_) _Pragma("unroll") for (int r = 0; r < 16; ++r) o[d_][r] *= al_l[crow(r, hi)]; } } while (0)
    const int NT = (q0 + MOBA) / KVBLK;
    const int qrel = wid * QBLK + r32;
#define ATT_MASK(P0, P1, t) do { const int jb_ = (t) - (NT - 4); if (jb_ >= 0) cmask(P0, P1, jb_, qrel, hi); } while (0)
#define ATT_KEEP(t) ((((t) >= NT - 4) ? 1u : ((sel >> ((t) >> 2)) & 1u)) != 0u)
    f32x16 pA0, pA1, pB0, pB1; float mnA, mnB, alA, alB; bf16x8 pa0, pa1, pa2, pa3;
    int s0 = 0, s1 = 1, s2 = 2;
#define ATT_ROT() do { const int t_ = s0; s0 = s1; s1 = s2; s2 = t_; } while (0)
    ATT_SLOAD(0); asm volatile("s_waitcnt vmcnt(0)" ::: "memory"); ATT_SWRITE(0); ATT_SLOAD(KVBLK);
    s0 = 2; s1 = 0; s2 = 1;
    __syncthreads();
    asm volatile("s_waitcnt vmcnt(0)" ::: "memory"); ATT_SWRITE(s2); ATT_SLOAD(2 * KVBLK);
    qkt(pA0, pA1, K_lds + s1 * SHM_K, qr, r32, hi); ATT_MASK(pA0, pA1, 0); partialSM(pA0, pA1, m_reg, mnA, alA, ATT_KEEP(0));
    ATT_ROT();
    for (int j = 1; j < NT; j += 2) {
        __syncthreads();
        if (j + 1 < NT) { asm volatile("s_waitcnt vmcnt(0)" ::: "memory"); ATT_SWRITE(s2); if (j + 2 < NT) ATT_SLOAD((j + 2) * KVBLK); }
        ATT_SBAR(); qkt(pB0, pB1, K_lds + s1 * SHM_K, qr, r32, hi); ATT_MASK(pB0, pB1, j);
        finishSM(pA0, pA1, alA, l_reg, pa0, pa1, pa2, pa3); ATT_SBAR();
        pv(o, vb0 + s0 * SHM_V, pa0, pa1, pa2, pa3); partialSM(pB0, pB1, m_reg, mnB, alB, ATT_KEEP(j));
        ATT_RESC(alB); ATT_ROT();
        if (j + 1 < NT) {
            __syncthreads();
            if (j + 2 < NT) { asm volatile("s_waitcnt vmcnt(0)" ::: "memory"); ATT_SWRITE(s2); if (j + 3 < NT) ATT_SLOAD((j + 3) * KVBLK); }
            ATT_SBAR(); qkt(pA0, pA1, K_lds + s1 * SHM_K, qr, r32, hi); ATT_MASK(pA0, pA1, j + 1);
            finishSM(pB0, pB1, alB, l_reg, pa0, pa1, pa2, pa3); ATT_SBAR();
            pv(o, vb0 + s0 * SHM_V, pa0, pa1, pa2, pa3); partialSM(pA0, pA1, m_reg, mnA, alA, ATT_KEEP(j + 1));
            ATT_RESC(alA); ATT_ROT();
        }
    }
    finishSM(pB0, pB1, alB, l_reg, pa0, pa1, pa2, pa3); ATT_SBAR();
    pv(o, vb0 + s0 * SHM_V, pa0, pa1, pa2, pa3);
#undef ATT_ROT
    if (hi == 0) li_l[r32] = l_reg; asm volatile("s_waitcnt lgkmcnt(0)" ::: "memory");
    float rli[16];
#pragma unroll
    for (int r = 0; r < 16; ++r) rli[r] = __builtin_amdgcn_rcpf(li_l[crow(r, hi)]);
    bf16* Ow = wsp<bf16>(F, WS_MIX) + (rowbase + q0 + wid * QBLK) * DM + h * HD;
    float* ssqa = wsp<float>(F, WS_SSQA) + (rowbase + q0 + wid * QBLK) * NH + h;
    float qq[16];
#pragma unroll
    for (int r = 0; r < 16; ++r) { const int orow = crow(r, hi); float q2 = 0.f;
#pragma unroll
        for (int d0 = 0; d0 < 2; ++d0) { const float v = o[d0][r] * rli[r]; const float vn = __shfl_xor(v, 1); q2 += v * v;
            if ((r32 & 1) == 0) *(unsigned*)(Ow + (size_t)orow * DM + d0 * 32 + r32) = cvt_pk_bf16(v, vn); }
        qq[r] = q2; }
#pragma unroll
    for (int i = 0; i < 8; ++i) { const bool up = (lane & 16) != 0; const float send = up ? qq[i] : qq[i + 8], keep = up ? qq[i + 8] : qq[i]; qq[i] = keep + __shfl_xor(send, 16); }
#pragma unroll
    for (int i = 0; i < 4; ++i) { const bool up = (lane & 8) != 0; const float send = up ? qq[i] : qq[i + 4], keep = up ? qq[i + 4] : qq[i]; qq[i] = keep + __shfl_xor(send, 8); }
#pragma unroll
    for (int i = 0; i < 2; ++i) { const bool up = (lane & 4) != 0; const float send = up ? qq[i] : qq[i + 2], keep = up ? qq[i + 2] : qq[i]; qq[i] = keep + __shfl_xor(send, 4); }
    { const bool up = (lane & 2) != 0; const float send = up ? qq[0] : qq[1], keep = up ? qq[1] : qq[0]; qq[0] = keep + __shfl_xor(send, 2); }
    qq[0] += __shfl_xor(qq[0], 1);
    if ((lane & 1) == 0) ssqa[(size_t)crow(r32 >> 1, hi) * NH] = qq[0];
    __syncthreads();
#undef ATT_SLOAD
#undef ATT_SWRITE
#undef ATT_RESC
#undef ATT_MASK
#undef ATT_KEEP
}
}

namespace gm {
__device__ __forceinline__ int vt_off(int d, int s) { return d * 256 + ((((s >> 3) ^ (d & 15)) & 15) << 4) + (s & 7) * 2; }
__device__ __forceinline__ void units4(const Frame& F, int v, LAS unsigned char* scratch) {
    PHASE_IDS;
    const int tid = TID_, wid = tid >> 6, lane = tid & 63, fr = lane & 15, fq = lane >> 4;
    const int u = wid >> 1, half = wid & 1, uidx = 4 * v + u, b = uidx >> 6, c = (uidx >> 2) & 15, g = uidx & 3;
    const size_t row0 = (size_t)b * SEQ + c * GC;
    const bf16* VGg = wsp<bf16>(F, WS_VG) + row0 * GW + g * GD; const bf16* Ug = wsp<bf16>(F, WS_U) + row0 * GW + g * GD;
    LAS unsigned char* vt = scratch + u * 32768;
    { const int s_ = half * 64 + lane; const v4u* src = (const v4u*)(VGg + (size_t)s_ * GW); v4u raw[16]; float sum = 0.f, sq = 0.f;
#pragma unroll
      for (int i = 0; i < 16; ++i) raw[i] = src[i];
#pragma unroll
      for (int i = 0; i < 16; ++i) { const unsigned ww[4] = {raw[i].x, raw[i].y, raw[i].z, raw[i].w};
#pragma unroll
          for (int k = 0; k < 4; ++k) { const float a0 = bflo(ww[k]), a1 = bfhi(ww[k]); sum += a0 + a1; sq += a0 * a0 + a1 * a1; } }
      const float mu = sum * (1.f / GD); const float var = fmaxf(sq * (1.f / GD) - mu * mu, 0.f); const float rstd = 1.0f / sqrtf(var + EPS);
      const float* lg = F.ln_g + g * GD; const float* lb = F.ln_b + g * GD;
#pragma unroll
      for (int i = 0; i < 16; ++i) { const unsigned ww[4] = {raw[i].x, raw[i].y, raw[i].z, raw[i].w}; const f32x4 g0 = *(const f32x4*)(lg + 8 * i), g1 = *(const f32x4*)(lg + 8 * i + 4), b0 = *(const f32x4*)(lb + 8 * i), b1 = *(const f32x4*)(lb + 8 * i + 4);
          const float gg[8] = {g0[0], g0[1], g0[2], g0[3], g1[0], g1[1], g1[2], g1[3]}, bb[8] = {b0[0], b0[1], b0[2], b0[3], b1[0], b1[1], b1[2], b1[3]};
#pragma unroll
          for (int k = 0; k < 4; ++k) { const int d = 8 * i + 2 * k;
              *(LAS unsigned short*)(vt + vt_off(d, s_)) = (unsigned short)f2bf((bflo(ww[k]) - mu) * rstd * gg[2 * k] + bb[2 * k]);
              *(LAS unsigned short*)(vt + vt_off(d + 1, s_)) = (unsigned short)f2bf((bfhi(ww[k]) - mu) * rstd * gg[2 * k + 1] + bb[2 * k + 1]); } } }
    __syncthreads();
#pragma unroll 1
    for (int m = 0; m < 4; ++m) {
        const int tb = half * 64 + m * 16, t = tb + fr;
        const float* Wg = F.gws + (size_t)g * GC * GC + (size_t)t * GC;
        const int nks = (tb + 16 + 31) / 32;
        f32x4 w0[4], w1[4];
#pragma unroll
        for (int ks = 0; ks < 4; ++ks) if (ks < nks) { w0[ks] = *(const f32x4*)(Wg + ks * 32 + fq * 8); w1[ks] = *(const f32x4*)(Wg + ks * 32 + fq * 8 + 4); }
        const bf16* Ut = Ug + (size_t)t * GW + 4 * fq; v2u uu[8];
#pragma unroll
        for (int n = 0; n < 8; ++n) uu[n] = *(const v2u*)(Ut + n * 16);
        f32x4 acc[8];
#pragma unroll
        for (int n = 0; n < 8; ++n) acc[n] = (f32x4){0.f, 0.f, 0.f, 0.f};
#pragma unroll
        for (int ks = 0; ks < 4; ++ks) if (ks < nks) { const int s0 = ks * 32 + fq * 8;
            float wv[8] = {w0[ks][0], w0[ks][1], w0[ks][2], w0[ks][3], w1[ks][0], w1[ks][1], w1[ks][2], w1[ks][3]};
#pragma unroll
            for (int j = 0; j < 8; ++j) if (s0 + j > t) wv[j] = 0.f;
            v4u aw; aw.x = pk2(wv[0], wv[1]); aw.y = pk2(wv[2], wv[3]); aw.z = pk2(wv[4], wv[5]); aw.w = pk2(wv[6], wv[7]);
            const bf16x8 wf = *reinterpret_cast<const bf16x8*>(&aw);
#pragma unroll
            for (int n = 0; n < 8; ++n) { const bf16x8 vf = *(const LAS bf16x8*)(vt + vt_off(n * 16 + fr, s0));
                acc[n] = __builtin_amdgcn_mfma_f32_16x16x32_bf16(vf, wf, acc[n], 0, 0, 0); } }
        bf16* Og = wsp<bf16>(F, WS_MIX) + (row0 + t) * DM + AW + g * GD + 4 * fq; float* ssqg = wsp<float>(F, WS_SSQG) + (row0 + t) * GG + g;
        const float bs = F.gbs[g * GC + t]; float q2 = 0.f;
#pragma unroll
        for (int n = 0; n < 8; ++n) { const float o0 = bflo(uu[n].x) * (acc[n][0] + bs), o1 = bfhi(uu[n].x) * (acc[n][1] + bs), o2 = bflo(uu[n].y) * (acc[n][2] + bs), o3 = bfhi(uu[n].y) * (acc[n][3] + bs);
            q2 += (o0 * o0 + o1 * o1) + (o2 * o2 + o3 * o3); v2u w; w.x = cvt_pk_bf16(o0, o1); w.y = cvt_pk_bf16(o2, o3); *(v2u*)(Og + n * 16) = w; }
        q2 += __shfl_xor(q2, 16); q2 += __shfl_xor(q2, 32);
        if (fq == 0) ssqg[0] = q2;
    }
    __syncthreads();
}
}

__device__ __forceinline__ void p2_mixers(const Frame& F) {
    PHASE_IDS;
    LAS unsigned char* scratch = F.lds + RING_OFF;
    const int v = F.vcu, bh = v >> 1, s0 = (v & 1) * 2, cslot = (v >> 1) % 6;
    int item = 0;
#pragma unroll 1
    for (int st = 0; st < 6; ++st) {
        if (st == cslot) { constexpr int PER_WG = XW_ITEMS / 256; static_assert(XW_ITEMS % 256 == 0 && PER_WG % NWAVES == 0, "items per workgroup / wave");
            LAS float* scr = (LAS float*)(F.lds + RING_OFF + WAVE_ * P0_SCR_WAVE);
            constexpr int NI = PER_WG / NWAVES; static_assert(NI % 2 == 0, "pairs");
            int ln = LANE_; asm volatile("" : "+v"(ln));
            const int it0 = v * PER_WG + WAVE_; f32x4 va[16], vb[16]; XwDesc da = xw_desc(F, it0, ln), db; xw_load(va, da);
#pragma unroll 1
            for (int j = 0; j < NI; j += 2) {
                db = xw_desc(F, it0 + (j + 1) * NWAVES, ln); xw_load(vb, db);
                xw_process(va, da, scr, ln);
                if (j + 2 < NI) { da = xw_desc(F, it0 + (j + 2) * NWAVES, ln); xw_load(va, da); }
                xw_process(vb, db, scr, ln);
            }
            __syncthreads(); }
        else { if (item < 4) { const int qq = s0 + (item >> 1); const int qb = (item & 1) ? 7 - qq : qq; att::attn_unit(F, bh / NH, bh % NH, qb, scratch); }
               else gm::units4(F, v, scratch);
               ++item; }
    }
}

__device__ __forceinline__ void p4_router(const Frame& F) {
    PHASE_IDS;
    const int tid = TID_, wid = tid >> 6, lane = tid & 63, tk = lane & 31, hf = lane >> 5;
    LAS unsigned* hist = (LAS unsigned*)(F.lds + XTAB_OFF + 4096);
    LAS unsigned* base = hist + 32;
    static_assert(XTAB_OFF + 4096 >= 8 * P0_SCR_WAVE, "router words above the conversion tiles");
    const bf16* RWT = wsp<bf16>(F, WS_RWT); const bf16* x1 = wsp<bf16>(F, WS_X1B); const float* ssq1 = wsp<float>(F, WS_SSQ1);
    unsigned* cntg = (unsigned*)(F.ctl + CW_CNT);
    unsigned* IDX = wsp<unsigned>(F, WS_IDX); float* GSS = wsp<float>(F, WS_GSS); float* RSS = wsp<float>(F, WS_RSS); unsigned* TOKPOS = wsp<unsigned>(F, WS_TOKPOS);
    if (tid < 32) hist[tid] = 0u;
    __syncthreads();
    const bool active = wid < 4; const int tok = (F.vcu * 4 + (wid & 3)) * 32 + tk;
    int pe[4] = {0, 0, 0, 0}; float pg[4] = {0.f, 0.f, 0.f, 0.f}; unsigned rank[2] = {0u, 0u}; int my_e[2] = {0, 0}; float my_g[2] = {0.f, 0.f}; float rstd = 0.f;
    if (active) {
        { const f32x4* sp = (const f32x4*)(ssq1 + (size_t)tok * 16); const f32x4 a = sp[0], b = sp[1], c = sp[2], d = sp[3];
          const float s_ = ((a[0] + a[1]) + (a[2] + a[3])) + ((b[0] + b[1]) + (b[2] + b[3])) + ((c[0] + c[1]) + (c[2] + c[3])) + ((d[0] + d[1]) + (d[2] + d[3]));
          rstd = 1.0f / sqrtf(s_ * (1.f / DM) + EPS); }
        f32x16 acc = f32x16{};
        { const bf16* xr = x1 + (size_t)tok * DM + 8 * hf; const bf16* wh = RWT + (size_t)tk * DM + 8 * hf; const bf16* wl = wh + NE * DM;
#pragma unroll 8
          for (int s_ = 0; s_ < 64; ++s_) { const bf16x8 xv = *(const bf16x8*)(xr + 16 * s_), a_hi = *(const bf16x8*)(wh + 16 * s_), a_lo = *(const bf16x8*)(wl + 16 * s_);
              acc = __builtin_amdgcn_mfma_f32_32x32x16_bf16(a_hi, xv, acc, 0, 0, 0); acc = __builtin_amdgcn_mfma_f32_32x32x16_bf16(a_lo, xv, acc, 0, 0, 0); } }
        float lv[16];
#pragma unroll
        for (int r = 0; r < 16; ++r) { const int e = (r & 3) + 8 * (r >> 2) + 4 * hf; lv[r] = acc[r] * rstd + F.router_b[e]; }
        float tv[4]; int ti[4]; unsigned used = 0u;
#pragma unroll
        for (int k = 0; k < 4; ++k) { float best = -__builtin_inff(); int br = 0;
#pragma unroll
            for (int r = 0; r < 16; ++r) { const int e = (r & 3) + 8 * (r >> 2) + 4 * hf; const int eb = (br & 3) + 8 * (br >> 2) + 4 * hf;
                const bool better = !((used >> r) & 1u) && (lv[r] > best || (lv[r] == best && e < eb)); if (better) { best = lv[r]; br = r; } }
            used |= 1u << br; tv[k] = best; ti[k] = (br & 3) + 8 * (br >> 2) + 4 * hf; }
        float ov[4]; int oi[4];
#pragma unroll
        for (int k = 0; k < 4; ++k) { ov[k] = __shfl_xor(tv[k], 32); oi[k] = __shfl_xor(ti[k], 32); }
        int ia = 0, ib = 0;
#pragma unroll
        for (int k = 0; k < 4; ++k) {
            float va = tv[0], vb = ov[0]; int ea = ti[0], eb = oi[0];
#pragma unroll
            for (int q = 1; q < 4; ++q) { if (ia == q) { va = tv[q]; ea = ti[q]; } if (ib == q) { vb = ov[q]; eb = oi[q]; } }
            const bool takeA = (va > vb) || (va == vb && ea < eb);
            pg[k] = takeA ? va : vb; pe[k] = takeA ? ea : eb; if (takeA) ++ia; else ++ib; }
        { const float m = pg[0]; float s_ = 0.f;
#pragma unroll
          for (int k = 0; k < 4; ++k) { pg[k] = __builtin_amdgcn_exp2f((pg[k] - m) * 1.4426950408889634f); s_ += pg[k]; }
          const float inv = 1.0f / s_;
#pragma unroll
          for (int k = 0; k < 4; ++k) pg[k] *= inv; }
        { const int m = -hf; my_e[0] = pe[0] ^ ((pe[0] ^ pe[2]) & m); my_e[1] = pe[1] ^ ((pe[1] ^ pe[3]) & m);
          const unsigned g0 = __float_as_uint(pg[0]), g1 = __float_as_uint(pg[1]), g2 = __float_as_uint(pg[2]), g3 = __float_as_uint(pg[3]);
          my_g[0] = __uint_as_float(g0 ^ ((g0 ^ g2) & (unsigned)m)); my_g[1] = __uint_as_float(g1 ^ ((g1 ^ g3) & (unsigned)m)); }
#pragma unroll
        for (int q = 0; q < 2; ++q) rank[q] = atomicAdd((unsigned*)&hist[my_e[q]], 1u);
    }
    __syncthreads();
    if (tid < 32) base[tid] = atomicAdd(cntg + tid, hist[tid]);
    __syncthreads();
    if (active) {
#pragma unroll
        for (int q = 0; q < 2; ++q) { const int k = 2 * hf + q; const int e = my_e[q]; const float g = my_g[q];
            const unsigned slot = base[e] + rank[q];
            IDX[(size_t)e * T + slot] = (unsigned)tok; GSS[(size_t)e * T + slot] = g; RSS[(size_t)e * T + slot] = rstd; TOKPOS[(size_t)tok * 4 + k] = ((unsigned)e << 16) | slot; }
    }
    __syncthreads();
}

__device__ __forceinline__ void build_tstart(const Frame& F, LAS unsigned* tstart, int tid) {
    if (tid < 64) { const unsigned* cntg = (const unsigned*)(F.ctl + CW_CNT); unsigned c = (tid < NE) ? cntg[tid] : 0u; if (c > (unsigned)T) c = (unsigned)T;
        unsigned x = (c + 255u) >> 8;
#pragma unroll
        for (int o = 1; o < 32; o <<= 1) { const unsigned y = __shfl_up(x, o); if ((tid & 63) >= o) x += y; }
        if (tid < NE) tstart[tid + 1] = x; if (tid == 0) tstart[0] = 0u; }
}
constexpr int MAXU = 17;
constexpr int XT_TSTART = 0, XT_ULIST = 256, XT_RS = 512, XT_GTAB = XT_RS + MAXU * 1024;
static_assert(XT_GTAB + MAXU * 512 <= LDSCTL_OFF - XTAB_OFF, "xtab");
__device__ __forceinline__ int moe_build_tables(const Frame& F, int P  , int mode) {
    PHASE_IDS;
    LAS unsigned* tstart = (LAS unsigned*)(F.lds + XTAB_OFF + XT_TSTART);
    LAS unsigned* ulist = (LAS unsigned*)(F.lds + XTAB_OFF + XT_ULIST);
    LAS float* rs = (LAS float*)(F.lds + XTAB_OFF + XT_RS);
    LAS unsigned short* gtab = (LAS unsigned short*)(F.lds + XTAB_OFF + XT_GTAB);
    const unsigned* cntg = (const unsigned*)(F.ctl + CW_CNT); const unsigned* IDX = wsp<unsigned>(F, WS_IDX);
    const float* RSRC = mode == 1 ? wsp<float>(F, WS_RSS) : wsp<float>(F, WS_GSS);
    const int tid = TID_;
    build_tstart(F, tstart, tid);
    __syncthreads();
    const int NT_ = (int)tstart[NE], U = NT_ * P, G = F.G, c = (int)blockIdx.x;
    int nunits = (c < U) ? (U - c + G - 1) / G : 0; if (nunits > MAXU) nunits = MAXU;
    if (tid < nunits) { const int L = tid * G + c; int gt, pn; pg8::flat_to_tile(L, U, NT_, P, gt, pn);
        int e = 0; for (int k = 1; k < NE; ++k) if ((unsigned)gt >= tstart[k]) e = k;
        const int rt = gt - (int)tstart[e];
        ulist[tid] = (unsigned)gt | ((unsigned)pn << 10) | ((unsigned)e << 13) | ((unsigned)rt << 18); }
    __syncthreads();
    {
        constexpr int NP = (MAXU + 1) / 2; unsigned tokv[NP]; float rsv[NP];
#pragma unroll
        for (int p = 0; p < NP; ++p) { const int i = 2 * p + (tid >> 8), r = tid & 255; tokv[p] = 0u; rsv[p] = 0.f;
            if (i < nunits) { const unsigned w = ulist[i]; const int e = (int)((w >> 13) & 0x1fu), rt = (int)(w >> 18);
                unsigned cn = cntg[e]; if (cn > (unsigned)T) cn = (unsigned)T; const unsigned slot = (unsigned)rt * 256u + (unsigned)r;
                if (slot < cn) { if (mode == 1) tokv[p] = IDX[(size_t)e * T + slot]; rsv[p] = RSRC[(size_t)e * T + slot]; } } }
#pragma unroll
        for (int p = 0; p < NP; ++p) { const int i = 2 * p + (tid >> 8), r = tid & 255;
            if (i < nunits) { unsigned tok = tokv[p]; if (tok >= (unsigned)T) tok = 0u; if (mode == 1) gtab[i * 256 + r] = (unsigned short)tok; rs[i * 256 + r] = rsv[p]; } }
    }
    __syncthreads();
    return nunits;
}

__device__ __forceinline__ void p7_combine(const Frame& F) {
    PHASE_IDS;
    LAS unsigned* tstart = (LAS unsigned*)(F.lds + XTAB_OFF + XT_TSTART);
    const unsigned* cntg = (const unsigned*)(F.ctl + CW_CNT);
    build_tstart(F, tstart, TID_); (void)cntg;
    __syncthreads();
    const int gw = F.vcu * NWAVES + WAVE_, NGW = F.G * NWAVES;
    const unsigned* TOKPOS = wsp<unsigned>(F, WS_TOKPOS); const unsigned char* Y = wsp<unsigned char>(F, WS_YBUF); const bf16* X1 = wsp<bf16>(F, WS_X1B); bf16* X2 = wsp<bf16>(F, WS_X2B); unsigned char* X28 = wsp<unsigned char>(F, WS_X2F8); float* RS2 = wsp<float>(F, WS_RSTD2);
    for (int m0 = gw; m0 < T; m0 += 2 * NGW) {
        f32x4 v[2][4]; unsigned yv[2][4][4]; float s[2] = {0.f, 0.f};
#pragma unroll
        for (int r = 0; r < 2; ++r) { const int m = m0 + r * NGW;
            const v4u tp = *(const v4u*)(TOKPOS + (size_t)m * 4); const unsigned tpw[4] = {tp.x, tp.y, tp.z, tp.w};
            size_t yrow[4];
#pragma unroll
            for (int k = 0; k < 4; ++k) { const unsigned e = (tpw[k] >> 16) & 31u, slot = tpw[k] & 0xffffu; yrow[k] = ((size_t)tstart[e] * 256u + slot) * DM; }
#pragma unroll
            for (int j = 0; j < 4; ++j) { const v2u xw = *(const v2u*)(X1 + (size_t)m * DM + 4 * LANE_ + 256 * j); v[r][j] = (f32x4){bflo(xw.x), bfhi(xw.x), bflo(xw.y), bfhi(xw.y)};
#pragma unroll
                for (int k = 0; k < 4; ++k) yv[r][j][k] = *(const unsigned*)(Y + yrow[k] + 4 * LANE_ + 256 * j); } }
#pragma unroll
        for (int r = 0; r < 2; ++r) {
#pragma unroll
            for (int j = 0; j < 4; ++j) {
#pragma unroll
                for (int k = 0; k < 4; ++k) { const unsigned w = yv[r][j][k]; const f32x2 lo = __builtin_amdgcn_cvt_pk_f32_fp8((int)w, false), hi2 = __builtin_amdgcn_cvt_pk_f32_fp8((int)w, true);
                    v[r][j][0] += lo[0] * (1.0f / Y_SCALE); v[r][j][1] += lo[1] * (1.0f / Y_SCALE); v[r][j][2] += hi2[0] * (1.0f / Y_SCALE); v[r][j][3] += hi2[1] * (1.0f / Y_SCALE); }
                s[r] += (v[r][j].x * v[r][j].x + v[r][j].y * v[r][j].y) + (v[r][j].z * v[r][j].z + v[r][j].w * v[r][j].w); } }
#pragma unroll
        for (int r = 0; r < 2; ++r) { const int m = m0 + r * NGW; const float rstd = 1.0f / sqrtf(wave_sum(s[r]) * (1.f / DM) + EPS);
            if (LANE_ == 0) RS2[m] = rstd;
#pragma unroll
            for (int j = 0; j < 4; ++j) { v2u w; w.x = cvt_pk_bf16(v[r][j].x, v[r][j].y); w.y = cvt_pk_bf16(v[r][j].z, v[r][j].w); *(v2u*)(X2 + (size_t)m * DM + 4 * LANE_ + 256 * j) = w;
                *(unsigned*)(X28 + (size_t)m * DM + 4 * LANE_ + 256 * j) = pk4_fp8(v[r][j].x, v[r][j].y, v[r][j].z, v[r][j].w); } }
    }
}

__device__ __forceinline__ void p9_final(const Frame& F) {
    PHASE_IDS;
    const int gw = F.vcu * NWAVES + WAVE_, NGW = F.G * NWAVES;
    const unsigned char* GATE = wsp<unsigned char>(F, WS_GATE); const unsigned char* PP = wsp<unsigned char>(F, WS_PP); const float* ssqpp = wsp<float>(F, WS_SSQPP);
    for (int m0 = gw; m0 < T; m0 += 2 * NGW) {
        f32x4 v[2][4]; unsigned gv[2][4], pv_[2][4]; f32x4 sq[2][4]; float s[2] = {0.f, 0.f};
#pragma unroll
        for (int r = 0; r < 2; ++r) { const int m = m0 + r * NGW; const bf16* x2r = wsp<bf16>(F, WS_X2B) + (size_t)m * DM;
#pragma unroll
            for (int q = 0; q < 4; ++q) sq[r][q] = *(const f32x4*)(ssqpp + (size_t)m * 16 + 4 * q);
#pragma unroll
            for (int j = 0; j < 4; ++j) { const int col = 4 * LANE_ + 256 * j; const v2u xw = *(const v2u*)(x2r + col); v[r][j] = (f32x4){bflo(xw.x), bfhi(xw.x), bflo(xw.y), bfhi(xw.y)};
                gv[r][j] = *(const unsigned*)(GATE + (size_t)m * DM + col); pv_[r][j] = *(const unsigned*)(PP + (size_t)m * DM + col); } }
#pragma unroll
        for (int r = 0; r < 2; ++r) { const f32x4 a = sq[r][0], b = sq[r][1], c = sq[r][2], d = sq[r][3];
            const float sp = ((a[0] + a[1]) + (a[2] + a[3])) + ((b[0] + b[1]) + (b[2] + b[3])) + ((c[0] + c[1]) + (c[2] + c[3])) + ((d[0] + d[1]) + (d[2] + d[3]));
            const float rpp = 1.0f / sqrtf(sp * (1.f / DM) + EPS);
#pragma unroll
            for (int j = 0; j < 4; ++j) { const int col = 4 * LANE_ + 256 * j; const f32x4 pg_ = *(const f32x4*)(F.ppn + col);
                const f32x2 g01 = __builtin_amdgcn_cvt_pk_f32_fp8((int)gv[r][j], false), g23 = __builtin_amdgcn_cvt_pk_f32_fp8((int)gv[r][j], true);
                const f32x2 p01 = __builtin_amdgcn_cvt_pk_f32_fp8((int)pv_[r][j], false), p23 = __builtin_amdgcn_cvt_pk_f32_fp8((int)pv_[r][j], true);
                const float rg = rpp * (1.0f / GATE_SCALE);
                v[r][j][0] += g01[0] * (p01[0] * rg * pg_[0]); v[r][j][1] += g01[1] * (p01[1] * rg * pg_[1]);
                v[r][j][2] += g23[0] * (p23[0] * rg * pg_[2]); v[r][j][3] += g23[1] * (p23[1] * rg * pg_[3]);
                s[r] += (v[r][j].x * v[r][j].x + v[r][j].y * v[r][j].y) + (v[r][j].z * v[r][j].z + v[r][j].w * v[r][j].w); } }
#pragma unroll
        for (int r = 0; r < 2; ++r) { const int m = m0 + r * NGW; float* xr = F.out + (size_t)m * DM; const float rstd = 1.0f / sqrtf(wave_sum(s[r]) * (1.f / DM) + EPS);
#pragma unroll
            for (int j = 0; j < 4; ++j) { const int col = 4 * LANE_ + 256 * j; const f32x4 fg = *(const f32x4*)(F.final_norm + col); __builtin_nontemporal_store(v[r][j] * rstd * fg, (f32x4*)(xr + col)); } }
    }
}

struct Args { const float* in[23]; float* out; unsigned char* ws; };
#if CHECK_STAGE
__device__ __forceinline__ unsigned hmix(unsigned z) { z ^= z >> 16; z *= 0x7feb352du; z ^= z >> 15; z *= 0x846ca68bu; z ^= z >> 16; return z; }
__device__ __forceinline__ void chk_add(const Frame& F, int st, bool bad) { atomicAdd((unsigned*)(F.ctl + CW_CHK + 2 * st), bad ? 1u : 0u); atomicAdd((unsigned*)(F.ctl + CW_CHK + 2 * st + 1), 1u); }
__device__ __forceinline__ bool offby(float got, float ex, float rel, float ab) { const float d = fabsf(got - ex); return !(d <= rel * fabsf(ex) + ab); }
__device__ __forceinline__ float dot_bf(const bf16* a, const bf16* b, int n) { float s = 0.f; for (int k = 0; k < n; ++k) s += bf2f(a[k]) * bf2f(b[k]); return s; }
__device__ __forceinline__ float gelu_ref(float v) { return 0.5f * v * (1.0f + erff(v * 0.70710678f)); }
__device__ __forceinline__ unsigned chk_tstart(const Frame& F, unsigned ex) { const unsigned* cntg = (const unsigned*)(F.ctl + CW_CNT); unsigned s_ = 0; for (unsigned e = 0; e < ex; ++e) { unsigned c = cntg[e]; if (c > (unsigned)T) c = T; s_ += (c + 255u) >> 8; } return s_; }
template <int ST> __device__ __forceinline__ void stage_check(const Frame& F) {
    const unsigned gt = (unsigned)blockIdx.x * NTHR + threadIdx.x;
    const unsigned h0 = hmix(gt * 2654435761u + ST * 40503u), h1 = hmix(h0 + 0x9e3779b9u), h2 = hmix(h1 + 0x85ebca6bu);
    if (ST == 1) {
        if (gt >= 16384) return;
        const int which = gt & 7;
        if (which == 0) { const int e = h0 % NE, n = h1 % (2 * FF), k = h2 % DM; const int lc = CmWgu()(n);
            const float ex = bf2f((bf16)f2bf(F.w_gu[((size_t)e * DM + k) * 2 * FF + lc] * F.ffn_norm[k])); chk_add(F, ST, offby(bf2f(wsp<bf16>(F, WS_WGU)[((size_t)e * 2 * FF + n) * DM + k]), ex, 1e-6f, 1e-30f)); }
        else if (which == 1) { const int e = h0 % NE, n = h1 % DM, k = h2 % FF;
            const float ex = bf2f((bf16)f2bf(F.w_dn[((size_t)e * FF + k) * DM + n])); chk_add(F, ST, offby(bf2f(wsp<bf16>(F, WS_WDN)[((size_t)e * DM + n) * FF + k]), ex, 1e-6f, 1e-30f)); }
        else if (which == 2) { const int n = h1 % NPROJ, k = h2 % DM; const int lc = CmWin()(n);
            const float ex = bf2f((bf16)f2bf(F.w_in[(size_t)k * NPROJ + lc] * F.mix_norm[k])); chk_add(F, ST, offby(bf2f(wsp<bf16>(F, WS_WIN)[(size_t)n * DM + k]), ex, 1e-6f, 1e-30f)); }
        else if (which == 3) { const int n = h1 % DM, k = h2 % DM; const float g = k < AW ? F.aon[k] : F.gon[k - AW];
            const float ex = bf2f((bf16)f2bf(F.w_out[(size_t)k * DM + n] * g)); chk_add(F, ST, offby(bf2f(wsp<bf16>(F, WS_WOUT)[(size_t)n * DM + k]), ex, 1e-6f, 1e-30f)); }
        else if (which == 4) { const int n = h1 % DM, k = h2 % DM;
            const float ex = bf2f((bf16)f2bf(F.w_pg[(size_t)k * DM + n] * F.ple_norm[k])); chk_add(F, ST, offby(bf2f(wsp<bf16>(F, WS_WPG)[(size_t)n * DM + k]), ex, 1e-6f, 1e-30f)); }
        else if (which == 5) { const int n = h1 % DM, k = h2 % PLE;
            const float ex = bf2f((bf16)f2bf(F.w_pp[(size_t)k * DM + n])); chk_add(F, ST, offby(bf2f(wsp<bf16>(F, WS_WPP)[(size_t)n * PLE + k]), ex, 1e-6f, 1e-30f)); }
        else if (which == 6) { const int row = h0 % T, k = h1 % DM; float ss = 0.f; for (int j = 0; j < DM; ++j) { const float v = F.x[(size_t)row * DM + j]; ss += v * v; }
            const float ex = F.x[(size_t)row * DM + k] / sqrtf(ss / DM + EPS); chk_add(F, ST, offby(bf2f(wsp<bf16>(F, WS_XNB)[(size_t)row * DM + k]), ex, 0.01f, 1e-3f)); }
        else { const int row = h0 % T, k = h1 % PLE; chk_add(F, ST, offby(bf2f(wsp<bf16>(F, WS_PB)[(size_t)row * PLE + k]), F.p[(size_t)row * PLE + k], 0.005f, 1e-6f)); }
    }
    if (ST == 2) {
        if (gt >= 16384) return;
        const bf16* XN = wsp<bf16>(F, WS_XNB); const bf16* WIN = wsp<bf16>(F, WS_WIN);
        if ((gt & 7) == 7) {
            const int b = h0 % BATCH, hh = h1 % NH, blk = h2 % NBLK, c = (h2 >> 8) % HD; float s_ = 0.f;
            for (int r = 0; r < 256; ++r) s_ += bf2f(wsp<bf16>(F, WS_K)[((size_t)b * SEQ + blk * 256 + r) * AW + hh * HD + c]);
            chk_add(F, ST, offby(wsp<float>(F, WS_KMEAN)[((size_t)(b * NH + hh) * NBLK + blk) * HD + c], s_, 0.02f, 0.3f)); return; }
        const int row = h0 % T, type = h1 % 5, c = h2 % AW; const bf16* xr = XN + (size_t)row * DM;
        const float v = dot_bf(xr, WIN + (size_t)(type * AW + c) * DM, DM); float ex;
        if (type <= 1) { const float vp = dot_bf(xr, WIN + (size_t)(type * AW + (c ^ 4)) * DM, DM); const int i = 4 * ((c & 63) >> 3) + (c & 3), pos = row & (SEQ - 1);
            const float cs = wsp<float>(F, WS_ROPE)[pos * 32 + i], sn = wsp<float>(F, WS_ROPE)[SEQ * 32 + pos * 32 + i];
            { const float inv = powf(10000.0f, -(float)i / 32.0f); const float ang = (float)pos * inv; if (offby(cs, cosf(ang), 0.f, 1e-3f) || offby(sn, sinf(ang), 0.f, 1e-3f)) { chk_add(F, ST, true); return; } }
            ex = (c & 4) ? v * cs + vp * sn : v * cs - vp * sn; }
        else if (type == 2) ex = v; else ex = gelu_ref(v);
        chk_add(F, ST, offby(bf2f(wsp<bf16>(F, WS_Q)[(size_t)type * (16u << 20) + (size_t)row * AW + c]), ex, 0.02f, 0.02f));
    }
    if (ST == 3) {
        if (gt >= 8192) return;
        if (gt & 1) {
            const int row = h0 % T, g = h1 % GG, d = h2 % GD; const int b = row / SEQ, s_ = row % SEQ, c = s_ / GC, t = s_ % GC; float acc = 0.f;
            for (int sp = 0; sp <= t; ++sp) { const bf16* vr = wsp<bf16>(F, WS_VG) + ((size_t)b * SEQ + c * GC + sp) * GW + g * GD; float mu = 0.f; for (int j = 0; j < GD; ++j) mu += bf2f(vr[j]); mu /= GD;
                float var = 0.f; for (int j = 0; j < GD; ++j) { const float dd = bf2f(vr[j]) - mu; var += dd * dd; } const float rstd = 1.0f / sqrtf(var / GD + EPS);
                const float vn = bf2f((bf16)f2bf((bf2f(vr[d]) - mu) * rstd * F.ln_g[g * GD + d] + F.ln_b[g * GD + d])); acc += bf2f((bf16)f2bf(F.gws[((size_t)g * GC + t) * GC + sp])) * vn; }
            const float ex = bf2f(wsp<bf16>(F, WS_U)[(size_t)row * GW + g * GD + d]) * (acc + F.gbs[g * GC + t]);
            chk_add(F, ST, offby(bf2f(wsp<bf16>(F, WS_MIX)[(size_t)row * DM + AW + g * GD + d]), ex, 0.03f, 0.02f)); return; }
        const int row = h0 % T, hh = h1 % NH; const int b = row / SEQ, s_ = row % SEQ, qb = s_ / MOBA; float q[HD];
#pragma unroll
        for (int c = 0; c < HD; ++c) q[c] = bf2f(wsp<bf16>(F, WS_Q)[(size_t)row * AW + hh * HD + c]);
        unsigned sel = 0u;
        if (qb <= 3) sel = (1u << qb) - 1u;
        else { float b0 = -__builtin_inff(), b1 = b0, b2 = b0; int i0 = 0, i1 = 0, i2 = 0;
            for (int j = 0; j < qb; ++j) { const float* km = wsp<float>(F, WS_KMEAN) + ((size_t)(b * NH + hh) * NBLK + j) * HD; float g = 0.f;
#pragma unroll
                for (int c = 0; c < HD; ++c) g += q[c] * km[c];
                if (g > b0) { b2 = b1; i2 = i1; b1 = b0; i1 = i0; b0 = g; i0 = j; } else if (g > b1) { b2 = b1; i2 = i1; b1 = g; i1 = j; } else if (g > b2) { b2 = g; i2 = j; } }
            sel = (1u << i0) | (1u << i1) | (1u << i2); }
        float mx = -__builtin_inff();
        for (int kp = 0; kp <= s_; ++kp) { const int blk = kp / MOBA; if (blk != qb && !((sel >> blk) & 1u)) continue; const bf16* kr = wsp<bf16>(F, WS_K) + ((size_t)b * SEQ + kp) * AW + hh * HD; float sc = 0.f;
#pragma unroll
            for (int c = 0; c < HD; ++c) sc += q[c] * bf2f(kr[c]);
            mx = fmaxf(mx, sc * 0.125f); }
        float o[HD]; float l = 0.f;
#pragma unroll
        for (int c = 0; c < HD; ++c) o[c] = 0.f;
        for (int kp = 0; kp <= s_; ++kp) { const int blk = kp / MOBA; if (blk != qb && !((sel >> blk) & 1u)) continue; const bf16* kr = wsp<bf16>(F, WS_K) + ((size_t)b * SEQ + kp) * AW + hh * HD; float sc = 0.f;
#pragma unroll
            for (int c = 0; c < HD; ++c) sc += q[c] * bf2f(kr[c]);
            const float pr = expf(sc * 0.125f - mx); l += pr; const bf16* vr = wsp<bf16>(F, WS_V) + ((size_t)b * SEQ + kp) * AW + hh * HD;
#pragma unroll
            for (int c = 0; c < HD; ++c) o[c] += pr * bf2f(vr[c]); }
        bool bad = false; float ss = 0.f;
#pragma unroll
        for (int c = 0; c < HD; ++c) { const float ex = o[c] / l; ss += ex * ex; bad |= offby(bf2f(wsp<bf16>(F, WS_MIX)[(size_t)row * DM + hh * HD + c]), ex, 0.04f, 0.02f); }
        bad |= offby(wsp<float>(F, WS_SSQA)[(size_t)row * NH + hh], ss, 0.03f, 1e-3f);
        chk_add(F, ST, bad);
    }
    if (ST == 4) {
        if (gt >= 16384) return;
        const int row = h0 % T, col = h1 % DM; const bf16* mr = wsp<bf16>(F, WS_MIX) + (size_t)row * DM; const bf16* wr_ = wsp<bf16>(F, WS_WOUT) + (size_t)col * DM;
        float sa = 0.f, sg = 0.f, da = 0.f, dg = 0.f;
        for (int k = 0; k < AW; ++k) { const float a = bf2f(mr[k]), g = bf2f(mr[AW + k]); sa += a * a; sg += g * g; da += a * bf2f(wr_[k]); dg += g * bf2f(wr_[AW + k]); }
        const float ex = F.x[(size_t)row * DM + col] + da / sqrtf(sa / AW + EPS) + dg / sqrtf(sg / GW + EPS);
        chk_add(F, ST, offby(F.out[(size_t)row * DM + col], ex, 0.01f, 0.03f));
    }
    if (ST == 5) {
        if (gt >= 8192) return;
        const int tok = h0 % T; const float* xr = F.out + (size_t)tok * DM; float ss = 0.f; for (int k = 0; k < DM; ++k) ss += xr[k] * xr[k]; const float rstd = 1.0f / sqrtf(ss / DM + EPS);
        bool bad = false;
        for (int j = 0; j < 4; ++j) { const int k = (h1 >> (8 * j)) % DM; bad |= offby(bf2f(wsp<bf16>(F, WS_XNB)[(size_t)tok * DM + k]), xr[k] * rstd, 0.01f, 1e-3f); }
        float lg[NE];
#pragma unroll
        for (int e = 0; e < NE; ++e) lg[e] = 0.f;
        for (int k = 0; k < DM; ++k) { const float xv = xr[k] * rstd * F.ffn_norm[k];
#pragma unroll
            for (int e = 0; e < NE; ++e) lg[e] += xv * F.router_w[k * NE + e]; }
#pragma unroll
        for (int e = 0; e < NE; ++e) lg[e] += F.router_b[e];
        int te[4]; float tv[4]; unsigned used = 0u;
#pragma unroll
        for (int k = 0; k < 4; ++k) { float best = -__builtin_inff(); int bi = 0;
#pragma unroll
            for (int e = 0; e < NE; ++e) if (!((used >> e) & 1u) && lg[e] > best) { best = lg[e]; bi = e; }
            used |= 1u << bi; te[k] = bi; tv[k] = best; }
        { float gg[4]; float den = 0.f;
#pragma unroll
          for (int k = 0; k < 4; ++k) { float v = -__builtin_inff();
#pragma unroll
              for (int e = 0; e < NE; ++e) if (e == te[k]) v = lg[e];
              gg[k] = v; }
          const float mm = gg[0];
#pragma unroll
          for (int k = 0; k < 4; ++k) { gg[k] = expf(gg[k] - mm); den += gg[k]; }
          const unsigned* tp = wsp<unsigned>(F, WS_TOKPOS) + (size_t)tok * 4;
#pragma unroll
          for (int k = 0; k < 4; ++k) { const unsigned e = tp[k] >> 16, slot = tp[k] & 0xffffu; bad |= (e != (unsigned)te[k]);
              if (e < NE && slot < (unsigned)T) { bad |= wsp<unsigned>(F, WS_IDX)[(size_t)e * T + slot] != (unsigned)tok; bad |= offby(wsp<float>(F, WS_GSS)[(size_t)e * T + slot], gg[k] / den, 2e-3f, 1e-5f);
                  bad |= slot >= ((const unsigned*)(F.ctl + CW_CNT))[e]; } else bad = true; } }
        (void)tv;
        chk_add(F, ST, bad);
    }
    if (ST == 6 || ST == 7) {
        if (gt >= 16384) return;
        const int tok = h0 % T, k = h1 & 3, col = (h1 >> 2) % FF; const unsigned tp = wsp<unsigned>(F, WS_TOKPOS)[(size_t)tok * 4 + k]; const unsigned e = tp >> 16, slot = tp & 0xffffu;
        if (e >= NE) { chk_add(F, ST, true); return; }
        const unsigned tse = chk_tstart(F, e);
        const size_t row = (size_t)tse * 256 + slot;
        if (ST == 6) { const bf16* xr = wsp<bf16>(F, WS_XNB) + (size_t)tok * DM; const int np = (col >> 7) * 256 + (col & 127);
            const float g = dot_bf(xr, wsp<bf16>(F, WS_WGU) + ((size_t)e * 2 * FF + np) * DM, DM) + F.b_gu[(size_t)e * 2 * FF + col];
            const float l = dot_bf(xr, wsp<bf16>(F, WS_WGU) + ((size_t)e * 2 * FF + np + 128) * DM, DM) + F.b_gu[(size_t)e * 2 * FF + FF + col];
            const float gc = fminf(g, 7.f), lc = fminf(fmaxf(l, -7.f), 7.f); const float ex = gc / (1.0f + expf(-1.702f * gc)) * (lc + 1.0f);
            chk_add(F, ST, offby(bf2f(wsp<bf16>(F, WS_ABUF)[row * FF + col]), ex, 0.03f, 0.03f)); }
        else { const float d = dot_bf(wsp<bf16>(F, WS_ABUF) + row * FF, wsp<bf16>(F, WS_WDN) + ((size_t)e * DM + col) * FF, FF) + F.b_dn[(size_t)e * DM + col];
            const float ex = d * wsp<float>(F, WS_GSS)[(size_t)e * T + slot];
            chk_add(F, ST, offby(bf2f(wsp<bf16>(F, WS_YBUF)[row * DM + col]), ex, 0.03f, 0.01f)); }
    }
    if (ST == 8) {
        if (gt >= 8192) return;
        const int tok = h0 % T; const float* xr = F.out + (size_t)tok * DM; float ss = 0.f; for (int k = 0; k < DM; ++k) ss += xr[k] * xr[k]; const float rstd = 1.0f / sqrtf(ss / DM + EPS);
        bool bad = false; for (int k = 0; k < DM; ++k) { bad |= offby(bf2f(wsp<bf16>(F, WS_X2N)[(size_t)tok * DM + k]), xr[k] * rstd, 0.01f, 1e-3f); bad |= !(fabsf(xr[k]) < 30.f); }
        chk_add(F, ST, bad);
    }
    if (ST == 9) {
        if (gt >= 16384) return;
        const int row = h0 % T, col = h1 % DM;
        if (gt & 1) { const float d = dot_bf(wsp<bf16>(F, WS_X2N) + (size_t)row * DM, wsp<bf16>(F, WS_WPG) + (size_t)col * DM, DM); const float got = bf2f(wsp<bf16>(F, WS_GATE)[(size_t)row * DM + col]); const float ex = 1.0f / (1.0f + expf(-d)); const bool bad = offby(got, ex, 0.02f, 0.01f); chk_add(F, ST, bad);
            if (bad) { atomicOr((unsigned*)(F.ctl + CW_CHK + 40), 1u << ((col >> 3) & 31)); atomicOr((unsigned*)(F.ctl + CW_CHK + 41), 1u << ((row >> 3) & 31)); atomicOr((unsigned*)(F.ctl + CW_CHK + 42), 1u << (col & 7)); atomicOr((unsigned*)(F.ctl + CW_CHK + 43), 1u << (row & 7));
                if (!(got >= 0.f && got <= 1.f)) atomicAdd((unsigned*)(F.ctl + CW_CHK + 44), 1u); { int cl = (int)floorf(log2f(fabsf(got) + 1e-30f)) + 40; cl = cl < 0 ? 0 : (cl > 80 ? 80 : cl); atomicMax((unsigned*)(F.ctl + CW_CHK + 46), (unsigned)cl); atomicMin((unsigned*)(F.ctl + CW_CHK + 47), 0xffffffffu - (unsigned)cl); if (got < 0.f) atomicAdd((unsigned*)(F.ctl + CW_CHK + 48), 1u); } if (fabsf(got - ex) > 0.2f) atomicAdd((unsigned*)(F.ctl + CW_CHK + 45), 1u); } }
        else { const float d = dot_bf(wsp<bf16>(F, WS_PB) + (size_t)row * PLE, wsp<bf16>(F, WS_WPP) + (size_t)col * PLE, PLE); chk_add(F, 10, offby(bf2f(wsp<bf16>(F, WS_PP)[(size_t)row * DM + col]), d, 0.02f, 0.02f)); }
    }
}
__device__ __forceinline__ void check_report(const Frame& F) {
    float c2 = 3.0f;
    for (int st = 1; st <= 10; ++st) { const unsigned bad = F.ctl[CW_CHK + 2 * st], tot = F.ctl[CW_CHK + 2 * st + 1]; const float fr = tot ? (float)bad / (float)tot : 1.0f;
        (void)fr; if (((CHECK_SKIP >> st) & 1) == 0 && bad >= 1u) { c2 = powf(10.0f, (float)st) * (1.0f + fminf((float)bad, 80.0f) * 0.1f); break; } }
#if CHECK_REPORT >= 40
    { unsigned v = F.ctl[CW_CHK + CHECK_REPORT]; if (CHECK_REPORT == 47) v = 0xffffffffu - v; c2 = powf(10.0f, (float)(v >> 27)) * (1.0f + (float)((v >> 21) & 63u) * 0.1f);
#if CHECK_REPORT2
      c2 = powf(10.0f, (float)((v >> 16) & 31u)) * (1.0f + (float)((v >> 10) & 63u) * 0.1f);
#endif
#if CHECK_REPORT3
      c2 = powf(10.0f, (float)((v >> 5) & 31u)) * (1.0f + (float)(v & 31u) * 0.1f);
#endif
      if (CHECK_REPORT >= 46 && CHECK_REPORT <= 47) c2 = powf(10.0f, (float)(v / 9u)) * (1.0f + (float)(v % 9u));
    }
#endif
    if (g_gridbar[XB_TMO] != 0u) c2 = 1e20f;
    const float c = sqrtf(c2);
    for (size_t i = (size_t)blockIdx.x * NTHR + threadIdx.x; i < (size_t)T * DM; i += (size_t)gridDim.x * NTHR) F.out[i] = c;
}
#define STAGE_CHECK(n) stage_check<(n)>(F)
#else
#define STAGE_CHECK(n) do {} while (0)
#endif

__global__ void __launch_bounds__(NTHR, 2) mega_fwd(Args args) {
    extern __shared__ __attribute__((aligned(16))) unsigned char lds_raw[];
    Frame F;
    F.lds = (LAS unsigned char*)lds_raw;
    F.MISC = (volatile LAS unsigned*)(F.lds + LDSCTL_OFF);
    F.G = gridDim.x; { const int bx = blockIdx.x; F.vcu = (F.G % 8 == 0) ? (bx % 8) * (F.G / 8) + bx / 8 : bx; }
    F.ws = args.ws; F.ctl = (gu32*)(args.ws + WS_CTL); F.out = args.out;
    F.x = args.in[0]; F.p = args.in[1]; F.mix_norm = args.in[2]; F.w_in = args.in[3]; F.ln_g = args.in[4]; F.ln_b = args.in[5]; F.gws = args.in[6]; F.gbs = args.in[7];
    F.aon = args.in[8]; F.gon = args.in[9]; F.w_out = args.in[10]; F.ffn_norm = args.in[11]; F.router_w = args.in[12]; F.router_b = args.in[13]; F.w_gu = args.in[14]; F.b_gu = args.in[15];
    F.w_dn = args.in[16]; F.b_dn = args.in[17]; F.ple_norm = args.in[18]; F.w_pg = args.in[19]; F.w_pp = args.in[20]; F.ppn = args.in[21]; F.final_norm = args.in[22];
    { PHASE_IDS; for (int u = TID_; u < 256; u += NTHR) ((LAS unsigned*)(F.lds + LDSCTL_OFF))[u] = 0u; }
    __syncthreads();
    XcdBarrier bar = xcd_barrier_post(g_gridbar, F.MISC + 8);
#define GRID_BAR() xcd_barrier(bar)
#define STAGE_END(n) do { STAGE_CHECK(n); if (TPROBE && blockIdx.x == 0 && threadIdx.x == 0) ((unsigned long long*)(F.ctl + CW_TS))[(n)] = __builtin_amdgcn_s_memrealtime(); } while (0)

    if (TPROBE && blockIdx.x == 0 && threadIdx.x == 0) ((unsigned long long*)(F.ctl + CW_TS))[0] = __builtin_amdgcn_s_memrealtime();
    for (int rep = 0; rep < (DUP_PHASE == 0 ? 2 : 1); ++rep) {
    if (PH(0)) p0_prologue(F);
    GRID_BAR(); }
    STAGE_END(1);
    if (PH(1)) { pg8::DenseSched S; S.init(wsp<bf16>(F, WS_XNB), wsp<bf16>(F, WS_WIN), T, NPROJ, DM, F.G, (int)blockIdx.x);
      float* RC = wsp<float>(F, WS_ROPE);
      EpiInProj E{wsp<bf16>(F, WS_Q), RC, RC + SEQ * 32, wsp<float>(F, WS_KMEAN)};
      for (int rep = 0; rep < (DUP_PHASE == 1 ? 2 : 1); ++rep) { if (rep) GRID_BAR();
      pg8::gemm_phase<EpiInProj, pg8::DenseSched, false, false>(F.lds + RING_OFF, DM * 2, S, E); } }
    GRID_BAR();
    STAGE_END(2);
    for (int rep = 0; rep < (DUP_PHASE == 2 ? 2 : 1); ++rep) {
    if (PH(2)) p2_mixers(F);
    GRID_BAR(); }
    STAGE_END(3);
    if (PH(3)) { pg8::DenseSched S; S.init(wsp<bf16>(F, WS_MIX), wsp<bf16>(F, WS_WOUT), T, DM, DM, F.G, (int)blockIdx.x);
      LAS f32x4* rtab = (LAS f32x4*)(F.lds + XTAB_OFF);
      Unit ua, ub; const bool ha = S.next(0, ua), hb = S.next(1, ub);
      { PHASE_IDS; const int s = TID_ >> 8, r = TID_ & 255; const bool has = s ? hb : ha; const int pm = s ? ub.pm : ua.pm;
        if (has) { const size_t row = (size_t)pm * 256 + r; const f32x4* pa = (const f32x4*)(wsp<float>(F, WS_SSQA) + row * NH); const f32x4 a0 = pa[0], a1 = pa[1], g0 = *(const f32x4*)(wsp<float>(F, WS_SSQG) + row * GG);
            const float sa = ((a0[0] + a0[1]) + (a0[2] + a0[3])) + ((a1[0] + a1[1]) + (a1[2] + a1[3])), sg = (g0[0] + g0[1]) + (g0[2] + g0[3]);
            const float ra = 1.0f / sqrtf(sa * (1.f / AW) + EPS), rg = 1.0f / sqrtf(sg * (1.f / GW) + EPS);
            rtab[s * 256 + r] = (f32x4){ra / rg, rg, wsp<float>(F, WS_SIG0)[row], 0.f}; } }
      __syncthreads();
      EpiOutProj E{wsp<bf16>(F, WS_XNB), wsp<bf16>(F, WS_X1B), wsp<unsigned char>(F, WS_X1F8), wsp<float>(F, WS_SSQ1), rtab, F.ffn_norm, ha ? ua.pm : -1, hb ? ub.pm : -1};
      for (int rep = 0; rep < (DUP_PHASE == 3 ? 2 : 1); ++rep) { if (rep) GRID_BAR();
      pg8::gemm_phase<EpiOutProj, pg8::DenseSched, false, true>(F.lds + RING_OFF, DM * 2, S, E); } }
    GRID_BAR();
    STAGE_END(4);
    if (PH(4)) p4_router(F);
    GRID_BAR();
    STAGE_END(5);
    if (PH(5)) { const int nu = moe_build_tables(F, 2 * FF / 256, 1);
      pg8::MoeSched S{(const char*)wsp<char>(F, WS_X1F8), (const char*)wsp<char>(F, WS_WGU), 0, (size_t)2 * FF * DM, (size_t)256 * DM, nu,
                      (const LAS unsigned*)(F.lds + XTAB_OFF + XT_ULIST), (const LAS unsigned*)(F.lds + XTAB_OFF + XT_GTAB), true};
      EpiMoe1 E{wsp<unsigned char>(F, WS_ABUF), F.b_gu, (const LAS float*)(F.lds + XTAB_OFF + XT_RS)};
      for (int rep = 0; rep < (DUP_PHASE == 5 ? 2 : 1); ++rep) { if (rep) GRID_BAR();
      int Kb = DM; asm volatile("" : "+s"(Kb));
      pg8::gemm_phase<EpiMoe1, pg8::MoeSched, true, false, true>(F.lds + RING_OFF, Kb, S, E); } }
    GRID_BAR();
    STAGE_END(6);
    if (PH(6)) { const int nu = moe_build_tables(F, DM / 256, 2);
      pg8::MoeSched S{(const char*)wsp<char>(F, WS_ABUF), (const char*)wsp<char>(F, WS_WDN), (size_t)256 * FF, (size_t)DM * FF, (size_t)256 * FF, nu,
                      (const LAS unsigned*)(F.lds + XTAB_OFF + XT_ULIST), (const LAS unsigned*)(F.lds + XTAB_OFF + XT_GTAB), false};
      EpiMoe2 E{wsp<unsigned char>(F, WS_YBUF), F.b_dn, (const LAS float*)(F.lds + XTAB_OFF + XT_RS)};
      for (int rep = 0; rep < (DUP_PHASE == 6 ? 2 : 1); ++rep) { if (rep) GRID_BAR();
      int Kb = FF; asm volatile("" : "+s"(Kb));
      pg8::gemm_phase<EpiMoe2, pg8::MoeSched, false, false, true>(F.lds + RING_OFF, Kb, S, E); } }
    GRID_BAR();
    STAGE_END(7);
    if (PH(7)) { const int first = (blockIdx.x >> 3) & 1;
#pragma unroll 1
      for (int step = 0; step < 2; ++step) {
          if ((step ^ first) == 0) { p7_combine(F); __syncthreads(); }
          else { pg8::DenseSched S; S.init(wsp<bf16>(F, WS_PB), wsp<bf16>(F, WS_WPP), T, DM, PLE, F.G, (int)blockIdx.x);
              EpiPle<1> E{wsp<unsigned char>(F, WS_PP), wsp<float>(F, WS_SSQPP), nullptr, -1};
              int Kp = PLE * 2; asm volatile("" : "+s"(Kp));
              pg8::gemm_phase<EpiPle<1>, pg8::DenseSched, false, false>(F.lds + RING_OFF, Kp, S, E); } } }
    GRID_BAR();
    STAGE_END(8);
    if (PH(8)) { pg8::DenseSched S; S.init(wsp<unsigned char>(F, WS_X2F8), wsp<unsigned char>(F, WS_WPG8), T, DM, DM, F.G, (int)blockIdx.x, 1);
      LAS float* rt2 = (LAS float*)(F.lds + XTAB_OFF); Unit ua, ub; const bool ha = S.next(0, ua), hb = S.next(1, ub);
      { PHASE_IDS; const int sl = TID_ >> 8, r = TID_ & 255; const bool has = sl ? hb : ha; const int pm = sl ? ub.pm : ua.pm; if (has) rt2[sl * 256 + r] = wsp<float>(F, WS_RSTD2)[(size_t)pm * 256 + r]; }
      __syncthreads();
      EpiPle<0> E{wsp<unsigned char>(F, WS_GATE), nullptr, rt2, ha ? ua.pm : -1};
      int Kb = DM; asm volatile("" : "+s"(Kb));
      pg8::gemm_phase<EpiPle<0>, pg8::DenseSched, false, false, true>(F.lds + RING_OFF, Kb, S, E);
#if CHECK_STAGE
      GRID_BAR();
      int Kb = DM; asm volatile("" : "+s"(Kb));
      pg8::gemm_phase<EpiPle<0>, pg8::DenseSched, false, false, true>(F.lds + RING_OFF, Kb, S, E);
#endif
    }
#if CHECK_STAGE
    GRID_BAR(); STAGE_CHECK(9);
#endif
    GRID_BAR();
    STAGE_END(9);
#if CHECK_STAGE
    GRID_BAR(); check_report(F);
#else
    if (PH(9)) p9_final(F);
#if TPROBE
    GRID_BAR();
    if (blockIdx.x == 0 && threadIdx.x == 0) { const unsigned long long* ts = (const unsigned long long*)(F.ctl + CW_TS); const unsigned long long t1 = (TP_A == 9) ? __builtin_amdgcn_s_memrealtime() : ts[(TP_A < 10 ? TP_A : 0) + 1];
        unsigned long long d = t1 - ts[TP_A < 10 ? TP_A : 0];
        if (TP_A == 20) d = ts[11] - ts[0]; if (TP_A == 21) d = ts[12] - ts[11]; if (TP_A == 22) d = ts[13] - ts[12]; if (TP_A == 23) d = ts[1] - ts[13]; if (TP_A == 24) d = ts[14] - ts[2]; if (TP_A == 25) d = ts[3] - ts[14];
        if (TP_A == 30) d = (__builtin_amdgcn_s_memrealtime() - ts[0]) / 8;
        F.out[0] += floorf((float)d * 0.01f * 0.125f + 0.5f) * 2.0f; }
#endif
#endif
    __syncthreads();
    if (threadIdx.x == 0) {
        if (xb_add(&g_gridbar[XB_DONE], 1u) == gridDim.x - 1u) {
#pragma unroll 1
            for (unsigned j = 0; j < 16; ++j) { __hip_atomic_store(&g_gridbar[XB_XCNT(j)], 0u, __ATOMIC_RELAXED, __HIP_MEMORY_SCOPE_AGENT); __hip_atomic_store(&g_gridbar[XB_XSUB(j)], 0u, __ATOMIC_RELAXED, __HIP_MEMORY_SCOPE_AGENT);
                __hip_atomic_store(&g_gridbar[XB_XGEN(j)], 0u, __ATOMIC_RELAXED, __HIP_MEMORY_SCOPE_AGENT); }
            __hip_atomic_store(&g_gridbar[XB_TOP], 0u, __ATOMIC_RELAXED, __HIP_MEMORY_SCOPE_AGENT); __hip_atomic_store(&g_gridbar[XB_TOPGEN], 0u, __ATOMIC_RELAXED, __HIP_MEMORY_SCOPE_AGENT);
            __hip_atomic_store(&g_gridbar[XB_TMO], 0u, __ATOMIC_RELAXED, __HIP_MEMORY_SCOPE_AGENT); __hip_atomic_store(&g_gridbar[XB_DONE], 0u, __ATOMIC_RELAXED, __HIP_MEMORY_SCOPE_AGENT); } }
}

extern "C" void kernel_launch(void* const* d_in, const int* in_sizes, int n_in, void* d_out, int out_size, void* d_ws, size_t ws_size, hipStream_t stream) {
    static int grid = 0;
    if (grid == 0) {
        if (n_in != 23 || in_sizes[0] != T * DM || out_size != T * DM || ws_size < WS_END) { fprintf(stderr, "kernel_launch: unexpected shapes (n_in %d, in0 %d, out %d, ws %zu)\n", n_in, n_in > 0 ? in_sizes[0] : -1, out_size, ws_size); grid = -1; return; }
        int dev = 0, cus = 0, per_cu = 0;
        if (hipGetDevice(&dev) != hipSuccess || hipDeviceGetAttribute(&cus, hipDeviceAttributeMultiprocessorCount, dev) != hipSuccess) { grid = -1; return; }
        if (hipFuncSetAttribute((const void*)mega_fwd, hipFuncAttributeMaxDynamicSharedMemorySize, LDS_BYTES) != hipSuccess) { fprintf(stderr, "kernel_launch: hipFuncSetAttribute failed\n"); grid = -1; return; }
        if (hipOccupancyMaxActiveBlocksPerMultiprocessor(&per_cu, (const void*)mega_fwd, NTHR, LDS_BYTES) != hipSuccess || per_cu < 1)
            fprintf(stderr, "kernel_launch: note: occupancy query reports %d workgroups per CU\n", per_cu);
        (void)hipGetLastError();
        if (cus < 256) { fprintf(stderr, "kernel_launch: built for a 256-CU device (found %d CUs); nothing launched\n", cus); grid = -1; return; }
        grid = 256;
    }
    if (grid < 0) return;
    Args a{};
    for (int i = 0; i < 23; ++i) a.in[i] = (const float*)d_in[i];
    a.out = (float*)d_out; a.ws = (unsigned char*)d_ws;
    hipLaunchKernelGGL(mega_fwd, dim3(grid), dim3(NTHR), LDS_BYTES, stream, a);
}
```

```cpp
#include <hip/hip_runtime.h>
#include <cstdio>
#include <cstdint>

#ifndef CHECK_STAGE
#define CHECK_STAGE 0
#endif
#ifndef CHECK_REPORT
#define CHECK_REPORT 0
#endif
#ifndef CHECK_REPORT2
#define CHECK_REPORT2 0
#endif
#ifndef CHECK_REPORT3
#define CHECK_REPORT3 0
#endif
#ifndef DUP_PHASE
#define DUP_PHASE -1
#endif
#ifndef TPROBE
#define TPROBE 0
#endif
#ifndef TP_A
#define TP_A 5
#endif
#ifndef TP_B
#define TP_B 6
#endif
#ifndef CHECK_SKIP
#define CHECK_SKIP 0
#endif
#ifndef PHMASK
#define PHMASK 0x3ff
#endif
#define PH(n) ((PHMASK >> (n)) & 1)

#define GAS __attribute__((address_space(1)))
#define LAS __attribute__((address_space(3)))
typedef unsigned short bf16;
typedef unsigned v4u __attribute__((ext_vector_type(4)));
typedef unsigned v2u __attribute__((ext_vector_type(2)));
typedef float f32x2 __attribute__((ext_vector_type(2)));
typedef float f32x4 __attribute__((ext_vector_type(4)));
typedef float f32x16 __attribute__((ext_vector_type(16)));
typedef short bf16x8 __attribute__((ext_vector_type(8)));
typedef short s16x4 __attribute__((ext_vector_type(4)));
typedef GAS unsigned gu32;

constexpr int BATCH = 16, SEQ = 2048, DM = 1024, T = BATCH * SEQ;
constexpr int AW = 512, NH = 8, HD = 64, NBLK = 8, MOBA = 256;
constexpr int GW = 512, GG = 4, GD = 128, GC = 128;
constexpr int NPROJ = 3 * AW + 2 * GW;
constexpr int NE = 32, TOPK = 4, FF = 1024;
constexpr int PLE = 256;
constexpr int MAXROWS = T * TOPK + NE * 256;
constexpr float EPS = 1e-6f;
constexpr int NWAVES = 8, NTHR = 512;

constexpr size_t MiB = 1u << 20;
constexpr size_t WS_CTL = 0, CTL_ZERO_BYTES = 1 * MiB;
constexpr size_t WS_KMEAN = 256 * 1024;
constexpr size_t WS_WIN = 1 * MiB;
constexpr size_t WS_WOUT = 6 * MiB;
constexpr size_t WS_WPG = 8 * MiB;
constexpr size_t WS_WPP = 10 * MiB;
constexpr size_t WS_RWG = 10 * MiB + 512 * 1024;
constexpr size_t WS_ROPE = 11 * MiB;
constexpr size_t WS_WGU = 16 * MiB;
constexpr size_t WS_WDN = 144 * MiB;
constexpr size_t WS_XNB = 208 * MiB;
constexpr size_t WS_BIG1 = 272 * MiB;
constexpr size_t WS_Q = WS_BIG1, WS_K = WS_Q + 32 * MiB, WS_V = WS_K + 32 * MiB, WS_U = WS_V + 32 * MiB, WS_VG = WS_U + 32 * MiB, WS_MIX = WS_VG + 32 * MiB;
constexpr size_t WS_YBUF = WS_BIG1;
constexpr size_t WS_BIG2 = 544 * MiB;
constexpr size_t WS_ABUF = WS_BIG2, WS_GATE = WS_BIG2, WS_PP = WS_BIG2 + 64 * MiB;
constexpr size_t WS_PB = 816 * MiB;
constexpr size_t WS_IDX = 832 * MiB;
constexpr size_t WS_GSS = 836 * MiB;
constexpr size_t WS_TOKPOS = 840 * MiB;
constexpr size_t WS_SSQA = 841 * MiB;
constexpr size_t WS_SSQG = 842 * MiB;
constexpr size_t WS_SSQ1 = 843 * MiB;
constexpr size_t WS_SSQPP = 845 * MiB;
constexpr size_t WS_X1F8 = 848 * MiB;
constexpr size_t WS_X2N = WS_XNB;
constexpr size_t WS_X1B = 880 * MiB;
constexpr size_t WS_X2B = 944 * MiB;
constexpr size_t WS_SIG0 = 1008 * MiB;
constexpr size_t WS_RSTD2 = 1008 * MiB + 256 * 1024;
constexpr size_t WS_RWT = 1008 * MiB + 512 * 1024;
constexpr size_t WS_RSS = 1009 * MiB;
constexpr size_t WS_X2F8 = 176 * MiB;
constexpr size_t WS_WPG8 = 80 * MiB;
constexpr size_t WS_END = 1013 * MiB;
static_assert(WS_MIX + 64 * MiB <= WS_BIG2 && (size_t)MAXROWS * 1024 * 2 <= 272 * MiB, "ws map");
constexpr int CW_TMO = 0, CW_CODE = 1;
constexpr int CW_BAR = 4096;
constexpr int CW_CNT = 8192, CNT_STRIDE = 32;
constexpr int CW_TS = 12000;
constexpr int CW_CHK = 12288;

constexpr int RING_OFF = 0, RING_BYTES = 131072;
constexpr int P0_SCR_WAVE = 64 * 65 * 4;
constexpr int LDS_BYTES_TOTAL = 163840;
constexpr int LDSCTL_OFF = LDS_BYTES_TOTAL - 1024;
constexpr int XTAB_OFF = RING_BYTES;
static_assert(8 * P0_SCR_WAVE <= LDSCTL_OFF && XTAB_OFF >= RING_BYTES, "lds map");
constexpr int LDS_BYTES = LDS_BYTES_TOTAL;

#define RLX_AGENT __ATOMIC_RELAXED, __HIP_MEMORY_SCOPE_AGENT
#define LDS_WAIT() asm volatile("s_waitcnt lgkmcnt(0)" ::: "memory")
#define VM_WAIT() asm volatile("s_waitcnt vmcnt(0)" ::: "memory")
__device__ __forceinline__ unsigned f2bf(float f) { unsigned u = __builtin_bit_cast(unsigned, f); return (u + 0x7fffu + ((u >> 16) & 1u)) >> 16; }
__device__ __forceinline__ unsigned pk2(float lo, float hi) { return f2bf(lo) | (f2bf(hi) << 16); }
__device__ __forceinline__ float bf2f(unsigned short b) { return __builtin_bit_cast(float, ((unsigned)b) << 16); }
__device__ __forceinline__ float bflo(unsigned w) { return __builtin_bit_cast(float, w << 16); }
__device__ __forceinline__ float bfhi(unsigned w) { return __builtin_bit_cast(float, w & 0xffff0000u); }
typedef __bf16 bf16x2_t __attribute__((ext_vector_type(2)));
__device__ __forceinline__ unsigned cvt_pk_bf16(float lo, float hi) { const f32x2 v = {lo, hi}; const bf16x2_t b = __builtin_convertvector(v, bf16x2_t); return __builtin_bit_cast(unsigned, b); }
__device__ __forceinline__ float clamp448(float x) { return fminf(fmaxf(x, -448.0f), 448.0f); }
__device__ __forceinline__ unsigned pk4_fp8(float a, float b, float c, float d) { unsigned w = 0u; w = (unsigned)__builtin_amdgcn_cvt_pk_fp8_f32(clamp448(a), clamp448(b), (int)w, false); w = (unsigned)__builtin_amdgcn_cvt_pk_fp8_f32(clamp448(c), clamp448(d), (int)w, true); return w; }
__device__ __forceinline__ unsigned pk4_fp8_nc(float a, float b, float c, float d) { unsigned w = 0u; w = (unsigned)__builtin_amdgcn_cvt_pk_fp8_f32(a, b, (int)w, false); w = (unsigned)__builtin_amdgcn_cvt_pk_fp8_f32(c, d, (int)w, true); return w; }
__device__ __forceinline__ float fp8_to_f(unsigned v) { const unsigned sg = (v >> 7) & 1u, e = (v >> 3) & 15u, m = v & 7u; const float r = e ? ldexpf(1.0f + (float)m * 0.125f, (int)e - 7) : ldexpf((float)m * 0.125f, -6); return sg ? -r : r; }
__device__ __forceinline__ float wave_sum(float v) {
#pragma unroll
    for (int o = 1; o < 64; o <<= 1) v += __shfl_xor(v, o);
    return v;
}
__device__ __forceinline__ f32x2 gelu_pk(f32x2 v) {
    const f32x2 av = __builtin_elementwise_abs(v), d = av * 0.2316418882f + 1.0f;
    f32x2 t; t.x = __builtin_amdgcn_rcpf(d.x); t.y = __builtin_amdgcn_rcpf(d.y);
    f32x2 q = t * 0.5307027145f + (-0.7265760135f); q = q * t + 0.7107068705f; q = q * t + (-0.142248368f); q = q * t + 0.127414796f; q = q * t;
    const f32x2 s = (v * v) * (-0.72134752044f);
    f32x2 e; e.x = __builtin_amdgcn_exp2f(s.x); e.y = __builtin_amdgcn_exp2f(s.y);
    const f32x2 m = v * (q * e), r = v - m;
    f32x2 o; o.x = v.x < 0.f ? m.x : r.x; o.y = v.y < 0.f ? m.y : r.y; return o;
}
__device__ __forceinline__ f32x4 gelu4(f32x4 v) { const f32x2 a = gelu_pk((f32x2){v[0], v[1]}), b = gelu_pk((f32x2){v[2], v[3]}); return (f32x4){a.x, a.y, b.x, b.y}; }
__device__ __forceinline__ float sigmoidf_fast(float x) { return __builtin_amdgcn_rcpf(1.0f + __builtin_amdgcn_exp2f(-1.4426950408889634f * x)); }

#define XB_TMO      128
#define XB_XCNT(j)  (256  + 64 * (j))
#define XB_XSUB(j)  (1280 + 64 * (j))
#define XB_XGEN(j)  (2304 + 64 * (j))
#define XB_TOP      3328
#define XB_TOPGEN   3392
#define XCD_BAR_WORDS 3456
#define XB_SPIN_CAP (1u << 18)
__device__ __forceinline__ unsigned xb_ld(unsigned* p)              { return __hip_atomic_load(p, __ATOMIC_RELAXED, __HIP_MEMORY_SCOPE_AGENT); }
__device__ __forceinline__ unsigned xb_add(unsigned* p, unsigned v) { return __hip_atomic_fetch_add(p, v, __ATOMIC_RELAXED, __HIP_MEMORY_SCOPE_AGENT); }
__device__ __forceinline__ unsigned xb_xcc_id() { return (unsigned)__builtin_amdgcn_s_getreg((3 << 11) | 20) & 0xFu; }
#define XB_SPIN(cond, bar) do { unsigned _sp = 0; while (cond) { __builtin_amdgcn_s_sleep(1); \
    if ((++_sp & 255u) == 0u) { if (xb_ld(&(bar)[XB_TMO])) break; if (_sp > XB_SPIN_CAP) { atomicAdd(&(bar)[XB_TMO], 1u); break; } } } } while (0)
#define XB_DONE     64
__device__ unsigned g_gridbar[4096];
struct XcdBarrier { unsigned* bar; unsigned x; volatile LAS unsigned* st; };
__device__ __forceinline__ XcdBarrier xcd_barrier_post(unsigned* bar, volatile LAS unsigned* st) {
    XcdBarrier b; b.bar = bar; b.x = xb_xcc_id(); b.st = st;
    if (threadIdx.x == 0) (void)xb_add(&bar[XB_XCNT(b.x)], 1u);
    return b;
}
__device__ __forceinline__ void xcd_barrier_complete(unsigned* bar, unsigned x, unsigned& nloc, unsigned& nx) {
    const unsigned G = gridDim.x * gridDim.y * gridDim.z;
    unsigned sum, cnt, mine, sp = 0u;
    for (;;) {
        sum = 0u; cnt = 0u; mine = 0u;
#pragma unroll
        for (unsigned j = 0; j < 16; ++j) { const unsigned c = xb_ld(&bar[XB_XCNT(j)]); sum += c; cnt += (c > 0u) ? 1u : 0u; mine = (j == x) ? c : mine; }
        if (sum == G) break;
        __builtin_amdgcn_s_sleep(1);
        if ((++sp & 255u) == 0u) { if (xb_ld(&bar[XB_TMO])) break; if (sp > XB_SPIN_CAP) { atomicAdd(&bar[XB_TMO], 1u); break; } }
    }
    nloc = mine > 0u ? mine : 1u; nx = cnt > 0u ? cnt : 1u;
}
__device__ __forceinline__ void xcd_barrier(const XcdBarrier& b) {
    asm volatile("s_waitcnt vmcnt(0)" ::: "memory");
    __syncthreads();
    if (threadIdx.x == 0) {
        unsigned* bar = b.bar;
        __builtin_amdgcn_s_waitcnt(0);
        unsigned nloc = b.st[0], nx = b.st[1];
        if (nloc == 0u) { xcd_barrier_complete(bar, b.x, nloc, nx); b.st[0] = nloc; b.st[1] = nx; }
        const unsigned old = xb_add(&bar[XB_XSUB(b.x)], 1u);
        const unsigned gen = old / nloc;
        if (old + 1u == (gen + 1u) * nloc) {
            __builtin_amdgcn_fence(__ATOMIC_RELEASE, "agent");
            asm volatile("s_waitcnt vmcnt(0)" ::: "memory");
            const unsigned og = xb_add(&bar[XB_TOP], 1u);
            const unsigned tg = og / nx;
            if (og + 1u == (tg + 1u) * nx) xb_add(&bar[XB_TOPGEN], 1u);
            else XB_SPIN(xb_ld(&bar[XB_TOPGEN]) == tg, bar);
            __builtin_amdgcn_fence(__ATOMIC_ACQUIRE, "agent");
            xb_add(&bar[XB_XGEN(b.x)], 1u);
            asm volatile("s_waitcnt vmcnt(0)" ::: "memory");
        } else {
            XB_SPIN(xb_ld(&bar[XB_XGEN(b.x)]) == gen, bar);
            __builtin_amdgcn_fence(__ATOMIC_ACQUIRE, "agent");
            asm volatile("s_waitcnt vmcnt(0)" ::: "memory");
        }
    }
    __syncthreads();
}

namespace pg8 {
constexpr int BM = 256, BK = 64, HALF = 128, HTB = HALF * BK * 2, STAGE_BYTES = 8 * HTB, NXCD = 8, WGM = 8;
__host__ __device__ __forceinline__ int lds_byte(int r, int c) { const int st = (r >> 4) * 2 + (c >> 5), rr = r & 15, cc = c & 31, ob = rr * 64 + cc * 2; return st * 1024 + (ob ^ (((ob >> 9) & 1) << 5)); }
__host__ __device__ __forceinline__ void stage_rc(int b, int& R, int& C) { const int st = b / 1024, sb = b % 1024, swz = sb ^ (((sb >> 9) & 1) << 5); R = (st >> 1) * 16 + swz / 64; C = (st & 1) * 32 + (swz % 64) / 2; }
__host__ __device__ __forceinline__ int perm32(int rho) { const int n = rho >> 4, i = rho & 15; return 8 * (i >> 2) + 4 * n + (i & 3); }

typedef int v8i __attribute__((ext_vector_type(8)));
constexpr int F8_WSHIFT = 6, F8_SCALE_W = 127 - F8_WSHIFT;
typedef int v4i __attribute__((ext_vector_type(4)));
__device__ __forceinline__ v8i ld8(const LAS unsigned char* p0, const LAS unsigned char* p1) { const v4i lo = *(const LAS v4i*)p0, hi = *(const LAS v4i*)p1; return __builtin_shufflevector(lo, hi, 0, 1, 2, 3, 4, 5, 6, 7); }
struct Unit { int pm, pn, e, rt, slot; };

__device__ __forceinline__ void flat_to_tile(int L, int nwg, int nM, int nN, int& pm, int& pn) {
    int wgid = L; { const int q = nwg / NXCD, r = nwg % NXCD, xcd = wgid % NXCD, off = wgid / NXCD; wgid = (xcd < r ? xcd * (q + 1) : r * (q + 1) + (xcd - r) * q) + off; }
    const int nig = WGM * nN, gid = wgid / nig, fm = gid * WGM, gsz = (nM - fm) < WGM ? (nM - fm) : WGM;
    pm = fm + ((wgid % nig) % gsz); pn = (wgid % nig) / gsz;
}
struct DenseSched {
    const char* A; const char* Bt; int nM, nN, nwg, G, c; size_t tstep;
    __device__ __forceinline__ void init(const void* A_, const void* Bt_, int M, int N, int K, int G_, int c_, int ebytes = 2) { A = (const char*)A_; Bt = (const char*)Bt_; nM = M / BM; nN = N / BM; nwg = nM * nN; G = G_; c = c_; tstep = (size_t)BM * K * ebytes; }
    __device__ __forceinline__ bool next(int i, Unit& u) const { const long L = (long)i * G + c; if (L >= nwg) return false; flat_to_tile((int)L, nwg, nM, nN, u.pm, u.pn); u.e = 0; u.rt = u.pm; u.slot = i; return true; }
    __device__ __forceinline__ const char* a_base(const Unit& u) const { return A + (size_t)u.pm * tstep; }
    __device__ __forceinline__ const char* b_base(const Unit& u) const { return Bt + (size_t)u.pn * tstep; }
    __device__ __forceinline__ void gather(int, int, int, unsigned (&)[2][2]) const {}
};
struct MoeSched {
    const char* A; const char* Bt; size_t a_tstep, b_estep, b_tstep; int nunits; const LAS unsigned* ulist; const LAS unsigned* gtab; bool gath;
    __device__ __forceinline__ bool next(int i, Unit& u) const {
        if (i >= nunits) return false;
        const unsigned w = (unsigned)__builtin_amdgcn_readfirstlane((int)ulist[i]);
        u.pm = (int)(w & 0x3ffu); u.pn = (int)((w >> 10) & 0x7u); u.e = (int)((w >> 13) & 0x1fu); u.rt = (int)(w >> 18); u.slot = i; return true;
    }
    __device__ __forceinline__ const char* a_base(const Unit& u) const { return gath ? A : A + (size_t)u.pm * a_tstep; }
    __device__ __forceinline__ const char* b_base(const Unit& u) const { return Bt + (size_t)u.e * b_estep + (size_t)u.pn * b_tstep; }
    __device__ __forceinline__ void gather(int i, int R0, int R1, unsigned (&off)[2][2]) const {
        const LAS unsigned short* g = (const LAS unsigned short*)gtab + i * 256;
        off[0][0] = (unsigned)g[R0] << 10; off[0][1] = (unsigned)g[R1] << 10; off[1][0] = (unsigned)g[128 + R0] << 10; off[1][1] = (unsigned)g[128 + R1] << 10;
    }
};

#define PG8_SA(b, h) (((b) * 2 + (h)) * HTB)
#define PG8_SB(b, h) ((4 + (b) * 2 + (h)) * HTB)
#define PG8_GLDS(src, dstoff) __builtin_amdgcn_global_load_lds((const unsigned*)(src), (LAS unsigned*)(lds + (dstoff)), 16, 0, 0)
#define PG8_STAGE_B(bufoff, gbase) do { _Pragma("unroll") for (int _i = 0; _i < 2; ++_i) PG8_GLDS((const char*)(gbase) + voffB[_i], (bufoff) + ldsw + _i * 8192); } while (0)
#define PG8_STAGE_A(bufoff, kptr, h, o) do { _Pragma("unroll") for (int _i = 0; _i < 2; ++_i) \
        PG8_GLDS(GATHER ? (const char*)(kptr) + (o)[h][_i] : (const char*)(kptr) + (size_t)(h) * hstep + voffA[_i], (bufoff) + ldsw + _i * 8192); } while (0)
#define PG8_LDA(dst, b, h) do { _Pragma("unroll") for (int m = 0; m < 4; ++m) { if constexpr (F8) dst##8[m] = ld8(lds + PG8_SA(b, h) + a8_0 + m * 2048, lds + PG8_SA(b, h) + a8_1 + m * 2048); \
        else { _Pragma("unroll") for (int k = 0; k < 2; ++k) dst[m][k] = *(const LAS bf16x8*)(lds + PG8_SA(b, h) + aoff + m * 2048 + k * 1024); } } } while (0)
#define PG8_LDB(dst, b, h) do { _Pragma("unroll") for (int n = 0; n < 2; ++n) { if constexpr (F8) dst##8[n] = ld8(lds + PG8_SB(b, h) + b8_0 + n * 2048, lds + PG8_SB(b, h) + b8_1 + n * 2048); \
        else { _Pragma("unroll") for (int k = 0; k < 2; ++k) dst[n][k] = *(const LAS bf16x8*)(lds + PG8_SB(b, h) + boff + n * 2048 + k * 1024); } } } while (0)
#define PG8_MMA(ai, bj, At, Bt) do { __builtin_amdgcn_s_setprio(1); _Pragma("unroll") for (int m = 0; m < 4; ++m) _Pragma("unroll") for (int n = 0; n < 2; ++n) { \
        if constexpr (F8) asm volatile("v_mfma_scale_f32_16x16x128_f8f6f4 %0, %1, %2, %0, %3, %4 op_sel_hi:[0,0,0]" : "+v"(acc[ai][bj][m][n]) : "v"(Bt##8[n]), "v"(At##8[m]), "v"(sc_w), "v"(sc_a)); \
        else { _Pragma("unroll") for (int k = 0; k < 2; ++k) acc[ai][bj][m][n] = __builtin_amdgcn_mfma_f32_16x16x32_bf16(Bt[n][k], At[m][k], acc[ai][bj][m][n], 0, 0, 0); } } __builtin_amdgcn_s_setprio(0); } while (0)
#define PG8_WAIT_V(n) asm volatile("s_waitcnt vmcnt(" #n ")" ::: "memory")
#define PG8_WAIT_L(n) asm volatile("s_waitcnt lgkmcnt(" #n ")" ::: "memory")
#define PG8_BAR __builtin_amdgcn_s_barrier()
#define PG8_SCHED __builtin_amdgcn_sched_barrier(0)

template <class Epi, class Sched, bool GATHER, bool MIDK, bool F8 = false>
__device__ __forceinline__ void gemm_phase(LAS unsigned char* lds, const int KB  , const Sched& S, const Epi& E) {
    int tid = (int)threadIdx.x; asm volatile("" : "+v"(tid));
    const int wid = __builtin_amdgcn_readfirstlane(tid >> 6), lane = tid & 63, wr = wid >> 2, wc = wid & 3, fr = lane & 15, fq = lane >> 4;
    const int nt = KB / 128;
    unsigned voffA[2], voffB[2]; int Rg[2]; unsigned Cg[2];
#pragma unroll
    for (int i = 0; i < 2; ++i) { int R, C; stage_rc(tid * 16 + i * 8192, R, C); const int Rb = Epi::PERM ? ((R & ~31) + perm32(R & 31)) : R;
        voffA[i] = (unsigned)(R * KB + C * 2); voffB[i] = (unsigned)(Rb * KB + C * 2); Rg[i] = R; Cg[i] = (unsigned)C * 2u; }
    const size_t kstep = 128;
    const size_t hstep = (size_t)HALF * KB;
    const unsigned ldsw = (unsigned)wid * 1024u;
    const int aoff = lds_byte(wr * 64 + fr, fq * 8), boff = lds_byte(wc * 32 + fr, fq * 8);
    const int a8_0 = aoff, a8_1 = aoff + 1024, b8_0 = boff, b8_1 = boff + 1024;
    Unit cur, nxt; int ui = 0;
    if (!S.next(0, cur)) return;
    f32x4 acc[2][2][4][2];
#pragma unroll
    for (int a = 0; a < 2; ++a)
#pragma unroll
        for (int b = 0; b < 2; ++b)
#pragma unroll
            for (int m = 0; m < 4; ++m)
#pragma unroll
                for (int n = 0; n < 2; ++n) acc[a][b][m][n] = (f32x4){0.f, 0.f, 0.f, 0.f};
    bf16x8 At[4][2], B0[2][2], B1[2][2]; v8i At8[4], B08[2], B18[2];
    int sc_w = F8_SCALE_W, sc_a = 127; if constexpr (F8) { asm volatile("" : "+v"(sc_w), "+v"(sc_a)); }
    unsigned offC[2][2] = {{0u, 0u}, {0u, 0u}}, offN[2][2] = {{0u, 0u}, {0u, 0u}};
    if constexpr (GATHER) { S.gather(0, Rg[0], Rg[1], offC);
#pragma unroll
        for (int h = 0; h < 2; ++h)
#pragma unroll
            for (int i = 0; i < 2; ++i) offC[h][i] += Cg[i]; }
    const char* cA = S.a_base(cur); const char* cB = S.b_base(cur);
    PG8_STAGE_B(PG8_SB(0, 0), cB); PG8_STAGE_B(PG8_SB(0, 1), cB + hstep); PG8_STAGE_A(PG8_SA(0, 0), cA, 0, offC); PG8_STAGE_A(PG8_SA(0, 1), cA, 1, offC);
    if (wr == 1) PG8_BAR;
    PG8_WAIT_V(2); PG8_BAR;
    PG8_STAGE_B(PG8_SB(1, 0), cB + kstep); PG8_STAGE_A(PG8_SA(1, 0), cA + kstep, 0, offC); PG8_STAGE_B(PG8_SB(1, 1), cB + hstep + kstep);
    PG8_WAIT_V(6); PG8_BAR;
    for (;;) {
        const bool has_next = S.next(ui + 1, nxt);
        const char* nA = has_next ? S.a_base(nxt) : cA; const char* nB = has_next ? S.b_base(nxt) : cB;
        if constexpr (GATHER) { if (has_next) { S.gather(ui + 1, Rg[0], Rg[1], offN);
#pragma unroll
                for (int h = 0; h < 2; ++h)
#pragma unroll
                    for (int i = 0; i < 2; ++i) offN[h][i] += Cg[i]; }
            else {
#pragma unroll
                for (int h = 0; h < 2; ++h)
#pragma unroll
                    for (int i = 0; i < 2; ++i) offN[h][i] = offC[h][i]; } }
        for (int t = 0; t < nt; t += 2) {
            const bool last = (t == nt - 2);
            const char* a1 = cA + (size_t)(t + 1) * kstep;
            const char* a2 = last ? nA : cA + (size_t)(t + 2) * kstep; const char* b2 = last ? nB : cB + (size_t)(t + 2) * kstep;
            const char* a3 = a2 + kstep; const char* b3 = b2 + kstep;
            unsigned o2[2][2];
#pragma unroll
            for (int h = 0; h < 2; ++h)
#pragma unroll
                for (int i = 0; i < 2; ++i) o2[h][i] = last ? offN[h][i] : offC[h][i];
            if constexpr (MIDK) { if (t == nt / 2) E.midk(acc, cur, wr, fr); }
            PG8_LDB(B0, 0, 0); PG8_LDB(B1, 0, 1); PG8_SCHED; PG8_LDA(At, 0, 0); PG8_STAGE_A(PG8_SA(1, 1), a1, 1, offC);
            PG8_WAIT_V(8); PG8_WAIT_L(0); PG8_BAR; PG8_MMA(0, 0, At, B0); PG8_MMA(0, 1, At, B1); PG8_BAR; PG8_SCHED;
            PG8_LDA(At, 0, 1); PG8_STAGE_B(PG8_SB(0, 0), b2); PG8_STAGE_B(PG8_SB(0, 1), b2 + hstep); PG8_STAGE_A(PG8_SA(0, 0), a2, 0, o2);
            PG8_WAIT_V(8); PG8_WAIT_L(0); PG8_BAR; PG8_MMA(1, 0, At, B0); PG8_MMA(1, 1, At, B1); PG8_BAR; PG8_SCHED;
            PG8_LDB(B0, 1, 0); PG8_LDB(B1, 1, 1); PG8_SCHED; PG8_LDA(At, 1, 0); PG8_STAGE_A(PG8_SA(0, 1), a2, 1, o2);
            PG8_WAIT_V(8); PG8_WAIT_L(0); PG8_BAR; PG8_MMA(0, 0, At, B0); PG8_MMA(0, 1, At, B1); PG8_BAR; PG8_SCHED;
            PG8_LDA(At, 1, 1); PG8_STAGE_B(PG8_SB(1, 0), b3); PG8_STAGE_B(PG8_SB(1, 1), b3 + hstep); PG8_STAGE_A(PG8_SA(1, 0), a3, 0, o2);
            PG8_WAIT_V(8); PG8_WAIT_L(0); PG8_BAR; PG8_MMA(1, 0, At, B0); PG8_MMA(1, 1, At, B1); PG8_BAR; PG8_SCHED;
        }
        if (wr == 0) PG8_BAR;
        if constexpr (F8) asm volatile("s_nop 15\n\ts_nop 15" ::: "memory");
        E(acc, cur, wr, wc, fr, fq);
        if (!has_next) break;
#pragma unroll
        for (int a = 0; a < 2; ++a)
#pragma unroll
            for (int b = 0; b < 2; ++b)
#pragma unroll
                for (int m = 0; m < 4; ++m)
#pragma unroll
                    for (int n = 0; n < 2; ++n) acc[a][b][m][n] = (f32x4){0.f, 0.f, 0.f, 0.f};
        cur = nxt; cA = nA; cB = nB; ++ui;
        if constexpr (GATHER) {
#pragma unroll
            for (int h = 0; h < 2; ++h)
#pragma unroll
                for (int i = 0; i < 2; ++i) offC[h][i] = offN[h][i]; }
        if (wr == 1) PG8_BAR;
    }
    PG8_WAIT_V(0);
    PG8_BAR;
}
}

struct Frame {
    LAS unsigned char* lds;
    volatile LAS unsigned* MISC;
    gu32* ctl;
    unsigned char* ws;
    int vcu, G;
    const float *x, *p, *mix_norm, *w_in, *ln_g, *ln_b, *gws, *gbs, *aon, *gon, *w_out, *ffn_norm, *router_w, *router_b, *w_gu, *b_gu, *w_dn, *b_dn, *ple_norm, *w_pg, *w_pp, *ppn, *final_norm;
    float* out;
};
template <class T_> __device__ __forceinline__ T_* wsp(const Frame& F, size_t off) { return (T_*)(F.ws + off); }

#define PHASE_IDS int TID_ = (int)threadIdx.x; asm volatile("" : "+v"(TID_)); const int LANE_ = TID_ & 63; const int WAVE_ = __builtin_amdgcn_readfirstlane(TID_ >> 6); (void)LANE_; (void)WAVE_
template <class ColMap>
__device__ __forceinline__ void p0_transpose_item(const float* W, int K, int N, bf16* WT, const float* gain, LAS float* scr, int item, int lane, int nphys, const ColMap& cm) {
    const int nblk = nphys / 64, kb = item / nblk, nb = item % nblk, k0 = 64 * kb, n0 = 64 * nb;
    const int srccol = cm(n0 + lane);
    float v_[64]; const float* src = W + (size_t)k0 * N + srccol;
#pragma unroll
    for (int kk = 0; kk < 64; ++kk) v_[kk] = __builtin_nontemporal_load(src + (size_t)kk * N);
    if (gain) {
#pragma unroll
        for (int kk = 0; kk < 64; kk += 4) { const f32x4 g4 = *(const f32x4*)(gain + k0 + kk); v_[kk] *= g4[0]; v_[kk + 1] *= g4[1]; v_[kk + 2] *= g4[2]; v_[kk + 3] *= g4[3]; } }
#pragma unroll
    for (int kk = 0; kk < 64; ++kk) scr[kk * 65 + lane] = v_[kk];
    LDS_WAIT(); asm volatile("" ::: "memory");
    const int c = lane & 7;
#pragma unroll
    for (int j = 0; j < 8; ++j) { const int n = (lane >> 3) + 8 * j; const LAS float* s = scr + (8 * c) * 65 + n;
        v4u o; o.x = pk2(s[0 * 65], s[1 * 65]); o.y = pk2(s[2 * 65], s[3 * 65]); o.z = pk2(s[4 * 65], s[5 * 65]); o.w = pk2(s[6 * 65], s[7 * 65]);
        *(GAS v4u*)(WT + (size_t)(n0 + n) * K + k0 + 8 * c) = o; }
    LDS_WAIT(); asm volatile("" ::: "memory");
}
template <class ColMap>
__device__ __forceinline__ void p0_transpose_item_f8(const float* W, int K, int N, unsigned char* WT, const float* gain, LAS float* scr, int item, int lane, int nphys, const ColMap& cm) {
    const int nblk = nphys / 64, kb = item / nblk, nb = item % nblk, k0 = 64 * kb, n0 = 64 * nb;
    const int srccol = cm(n0 + lane);
    float v_[64]; const float* src = W + (size_t)k0 * N + srccol;
#pragma unroll
    for (int kk = 0; kk < 64; ++kk) v_[kk] = __builtin_nontemporal_load(src + (size_t)kk * N);
    constexpr float WS_ = (float)(1 << pg8::F8_WSHIFT);
#pragma unroll
    for (int kk = 0; kk < 64; kk += 4) { f32x4 g4 = gain ? *(const f32x4*)(gain + k0 + kk) : (f32x4){1.f, 1.f, 1.f, 1.f}; v_[kk] *= g4[0] * WS_; v_[kk + 1] *= g4[1] * WS_; v_[kk + 2] *= g4[2] * WS_; v_[kk + 3] *= g4[3] * WS_; }
#pragma unroll
    for (int kk = 0; kk < 64; ++kk) scr[kk * 65 + lane] = v_[kk];
    LDS_WAIT(); asm volatile("" ::: "memory");
    const int c = lane & 3;
#pragma unroll
    for (int j = 0; j < 4; ++j) { const int n = (lane >> 2) + 16 * j; const LAS float* s_ = scr + (16 * c) * 65 + n;
        v4u o; o.x = pk4_fp8(s_[0 * 65], s_[1 * 65], s_[2 * 65], s_[3 * 65]); o.y = pk4_fp8(s_[4 * 65], s_[5 * 65], s_[6 * 65], s_[7 * 65]);
        o.z = pk4_fp8(s_[8 * 65], s_[9 * 65], s_[10 * 65], s_[11 * 65]); o.w = pk4_fp8(s_[12 * 65], s_[13 * 65], s_[14 * 65], s_[15 * 65]);
        *(GAS v4u*)(WT + (size_t)(n0 + n) * K + k0 + 16 * c) = o; }
    LDS_WAIT(); asm volatile("" ::: "memory");
}
struct CmId { __device__ __forceinline__ int operator()(int n) const { return n; } };
struct CmWin { __device__ __forceinline__ int operator()(int n) const { if (n >= 2 * AW) return n; const int c = n & 63; return (n & ~63) + 4 * (c >> 3) + (c & 3) + 32 * ((c >> 2) & 1); } };
struct CmWgu { __device__ __forceinline__ int operator()(int n) const { return ((n >> 7) & 1) * FF + (n >> 8) * 128 + (n & 127); } };

constexpr int XW_I_GU = (DM / 64) * (2 * FF / 64), XW_I_DN = (FF / 64) * (DM / 64), XW_ITEMS = NE * (XW_I_GU + XW_I_DN);
__device__ __forceinline__ void xw_convert_item(const Frame& F, int it, LAS float* scr, int lane) {
    if (it < NE * XW_I_GU) { const int e = it / XW_I_GU; p0_transpose_item_f8(F.w_gu + (size_t)e * DM * 2 * FF, DM, 2 * FF, wsp<unsigned char>(F, WS_WGU) + (size_t)e * 2 * FF * DM, F.ffn_norm, scr, it % XW_I_GU, lane, 2 * FF, CmWgu()); }
    else { const int r = it - NE * XW_I_GU, e = r / XW_I_DN; p0_transpose_item_f8(F.w_dn + (size_t)e * FF * DM, FF, DM, wsp<unsigned char>(F, WS_WDN) + (size_t)e * DM * FF, nullptr, scr, r % XW_I_DN, lane, DM, CmId()); }
}
struct XwDesc { const float* src; unsigned char* dst; unsigned N, K; };
__device__ __forceinline__ XwDesc xw_desc(const Frame& F, int it, int lane) {
    XwDesc d; const int kq = lane >> 4, nq = lane & 15;
    if (it < NE * XW_I_GU) { const int e = it / XW_I_GU, item = it % XW_I_GU, nblk = 2 * FF / 64, k0 = 64 * (item / nblk), n0 = 64 * (item % nblk);
        d.N = 2 * FF; d.K = DM; d.src = F.w_gu + (size_t)e * DM * 2 * FF + (size_t)(k0 + kq) * (2 * FF) + CmWgu()(n0) + 4 * nq;
        d.dst = wsp<unsigned char>(F, WS_WGU) + (size_t)e * 2 * FF * DM + (size_t)(n0 + (lane >> 2)) * DM + k0 + 16 * (lane & 3); }
    else { const int r = it - NE * XW_I_GU, e = r / XW_I_DN, item = r % XW_I_DN, nblk = DM / 64, k0 = 64 * (item / nblk), n0 = 64 * (item % nblk);
        d.N = DM; d.K = FF; d.src = F.w_dn + (size_t)e * FF * DM + (size_t)(k0 + kq) * DM + n0 + 4 * nq;
        d.dst = wsp<unsigned char>(F, WS_WDN) + (size_t)e * DM * FF + (size_t)(n0 + (lane >> 2)) * FF + k0 + 16 * (lane & 3); }
    return d;
}
__device__ __forceinline__ void xw_load(f32x4 (&v)[16], const XwDesc& d) {
#pragma unroll
    for (int j = 0; j < 16; ++j) v[j] = __builtin_nontemporal_load((const f32x4*)(d.src + (size_t)(4 * j) * d.N));
}
__device__ __forceinline__ void xw_process(const f32x4 (&v)[16], const XwDesc& d, LAS float* scr, int lane) {
    const int kq = lane >> 4, nq = lane & 15;
#pragma unroll
    for (int j = 0; j < 16; ++j) { LAS float* w = scr + (4 * j + kq) * 65 + 4 * nq; w[0] = v[j][0]; w[1] = v[j][1]; w[2] = v[j][2]; w[3] = v[j][3]; }
    LDS_WAIT(); asm volatile("" ::: "memory");
    constexpr float WS_ = (float)(1 << pg8::F8_WSHIFT);
    const int c = lane & 3;
#pragma unroll
    for (int j = 0; j < 4; ++j) { const LAS float* s_ = scr + (16 * c) * 65 + (lane >> 2) + 16 * j;
        v4u o; o.x = pk4_fp8(s_[0 * 65] * WS_, s_[1 * 65] * WS_, s_[2 * 65] * WS_, s_[3 * 65] * WS_); o.y = pk4_fp8(s_[4 * 65] * WS_, s_[5 * 65] * WS_, s_[6 * 65] * WS_, s_[7 * 65] * WS_);
        o.z = pk4_fp8(s_[8 * 65] * WS_, s_[9 * 65] * WS_, s_[10 * 65] * WS_, s_[11 * 65] * WS_); o.w = pk4_fp8(s_[12 * 65] * WS_, s_[13 * 65] * WS_, s_[14 * 65] * WS_, s_[15 * 65] * WS_);
        *(GAS v4u*)(d.dst + (size_t)(16 * j) * d.K) = o; }
    LDS_WAIT(); asm volatile("" ::: "memory");
}
__device__ __forceinline__ void p0_prologue(Frame& F) {
    PHASE_IDS;
    { const int gt0 = (int)blockIdx.x * NTHR + TID_, GT0 = F.G * NTHR;
      for (int i = gt0; i < CW_TS; i += GT0) F.ctl[i] = 0u;
      float* km0 = wsp<float>(F, WS_KMEAN); for (int i = gt0; i < (T / SEQ) * NH * NBLK * HD; i += GT0) km0[i] = 0.f; }
    LAS float* scr = (LAS float*)(F.lds + RING_OFF + WAVE_ * P0_SCR_WAVE);
    const int gw = F.vcu * NWAVES + WAVE_, NGW = F.G * NWAVES;
    constexpr int I_GU = (DM / 64) * (2 * FF / 64), I_DN = (FF / 64) * (DM / 64), I_IN = (DM / 64) * (NPROJ / 64), I_SQ = (DM / 64) * (DM / 64), I_PP = (PLE / 64) * (DM / 64);
    constexpr int NITEMS = I_IN + 2 * I_SQ + I_PP;
    (void)I_GU; (void)I_DN;
    for (int it = gw; it < NITEMS; it += NGW) {
        int r = it;
        if (r < I_IN) { p0_transpose_item(F.w_in, DM, NPROJ, wsp<bf16>(F, WS_WIN), F.mix_norm, scr, r, LANE_, NPROJ, CmWin()); continue; } r -= I_IN;
        if (r < I_SQ) {
            const int nblk = DM / 64, kb = r / nblk; const float* g = (kb < 8) ? F.aon : (F.gon - AW);
            p0_transpose_item(F.w_out, DM, DM, wsp<bf16>(F, WS_WOUT), g, scr, r, LANE_, DM, CmId()); continue; } r -= I_SQ;
        if (r < I_SQ) { p0_transpose_item_f8(F.w_pg, DM, DM, wsp<unsigned char>(F, WS_WPG8), F.ple_norm, scr, r, LANE_, DM, CmId()); continue; } r -= I_SQ;
        p0_transpose_item(F.w_pp, PLE, DM, wsp<bf16>(F, WS_WPP), nullptr, scr, r, LANE_, DM, CmId());
    }
    if (TPROBE && blockIdx.x == 0 && threadIdx.x == 0) ((unsigned long long*)(F.ctl + CW_TS))[11] = __builtin_amdgcn_s_memrealtime();
    bf16* XN = wsp<bf16>(F, WS_XNB);
    for (int m0 = gw; m0 < T; m0 += 2 * NGW) {
        f32x4 v[2][4]; float s[2] = {0.f, 0.f};
#pragma unroll
        for (int r = 0; r < 2; ++r) { const GAS f32x4* xr = (const GAS f32x4*)(F.x + (size_t)(m0 + r * NGW) * DM) + LANE_;
#pragma unroll
            for (int j = 0; j < 4; ++j) v[r][j] = __builtin_nontemporal_load(xr + 64 * j); }
#pragma unroll
        for (int r = 0; r < 2; ++r) {
#pragma unroll
            for (int j = 0; j < 4; ++j) s[r] += (v[r][j].x * v[r][j].x + v[r][j].y * v[r][j].y) + (v[r][j].z * v[r][j].z + v[r][j].w * v[r][j].w); }
#pragma unroll
        for (int r = 0; r < 2; ++r) { const int m = m0 + r * NGW; const float sig = sqrtf(wave_sum(s[r]) * (1.f / DM) + EPS), rstd = 1.0f / sig;
            if (LANE_ == 0) wsp<float>(F, WS_SIG0)[m] = sig;
            GAS v2u* o8 = (GAS v2u*)(XN + (size_t)m * DM) + LANE_;
#pragma unroll
            for (int j = 0; j < 4; ++j) { v2u w; w.x = pk2(v[r][j].x * rstd, v[r][j].y * rstd); w.y = pk2(v[r][j].z * rstd, v[r][j].w * rstd); o8[64 * j] = w; } }
    }
    if (TPROBE && blockIdx.x == 0 && threadIdx.x == 0) ((unsigned long long*)(F.ctl + CW_TS))[12] = __builtin_amdgcn_s_memrealtime();
    { const GAS f32x4* pr = (const GAS f32x4*)F.p; GAS v2u* po = (GAS v2u*)wsp<bf16>(F, WS_PB);
      const size_t n4 = (size_t)T * PLE / 4, gt = (size_t)(F.vcu * NTHR + TID_), GT = (size_t)F.G * NTHR;
      for (size_t i = gt; i < n4; i += GT) { const f32x4 v = pr[i]; v2u w; w.x = pk2(v.x, v.y); w.y = pk2(v.z, v.w); po[i] = w; } }
    if (TPROBE && blockIdx.x == 0 && threadIdx.x == 0) ((unsigned long long*)(F.ctl + CW_TS))[13] = __builtin_amdgcn_s_memrealtime();
    { const int gt = F.vcu * NTHR + TID_, GT = F.G * NTHR; float* RWG = wsp<float>(F, WS_RWG);
      (void)RWG; bf16* RWT = wsp<bf16>(F, WS_RWT);
      for (int i = gt; i < DM * NE; i += GT) { const int e = i / DM, k = i % DM; const float w = F.router_w[k * NE + e] * F.ffn_norm[k]; const unsigned hi = f2bf(w); const float lo = w - bf2f((bf16)hi); RWT[i] = (bf16)hi; RWT[NE * DM + i] = (bf16)f2bf(lo); }
      float* RC = wsp<float>(F, WS_ROPE); float* RS = RC + SEQ * 32;
      for (int i = gt; i < SEQ * 32; i += GT) { const int pos = i >> 5, j = i & 31; const float inv = powf(10000.0f, -(float)j / 32.0f); const float ang = (float)pos * inv; float sn, cs; sincosf(ang, &sn, &cs); RC[i] = cs; RS[i] = sn; } }
}

using pg8::Unit;
constexpr int HALF = 128;
struct EpiInProj {
    static constexpr bool PERM = true;
    bf16* QKVUV; const float *rc, *rs; float* kmean;
    __device__ __forceinline__ void operator()(const f32x4 (&acc)[2][2][4][2], const Unit& u, int wr, int wc, int fr, int fq) const {
        const int type = u.pn >> 1, colt = (u.pn & 1) * 256 + wc * 32 + 8 * fq;
        const int row0 = u.pm * 256 + wr * 64 + fr;
        if (type <= 1) {
            bf16* dst = QKVUV + (size_t)type * (16u << 20);
            const int pos0 = (u.pm & 7) * 256 + wr * 64 + fr, i0 = 16 * (wc & 1) + 4 * fq;
            f32x4 cs_[2][2];
#pragma unroll
            for (int bj = 0; bj < 2; ++bj) { cs_[bj][0] = (f32x4){0.f, 0.f, 0.f, 0.f}; cs_[bj][1] = (f32x4){0.f, 0.f, 0.f, 0.f}; }
#pragma unroll
            for (int ai = 0; ai < 2; ++ai) { f32x4 cc[4], ss[4];
#pragma unroll
                for (int m = 0; m < 4; ++m) { const int pos = pos0 + ai * HALF + m * 16; cc[m] = *(const f32x4*)(rc + pos * 32 + i0); ss[m] = *(const f32x4*)(rs + pos * 32 + i0); }
#pragma unroll
                for (int m = 0; m < 4; ++m) { const int ro = ai * HALF + m * 16; const f32x4 c = cc[m], s = ss[m];
                    bf16* rowp = dst + (size_t)(row0 + ro) * AW + colt;
#pragma unroll
                    for (int bj = 0; bj < 2; ++bj) { const f32x4 x1 = acc[ai][bj][m][0], x2 = acc[ai][bj][m][1];
                        const f32x4 o1 = x1 * c - x2 * s, o2 = x2 * c + x1 * s;
                        cs_[bj][0] += o1; cs_[bj][1] += o2;
                        v4u w; w.x = cvt_pk_bf16(o1[0], o1[1]); w.y = cvt_pk_bf16(o1[2], o1[3]); w.z = cvt_pk_bf16(o2[0], o2[1]); w.w = cvt_pk_bf16(o2[2], o2[3]);
                        *(v4u*)(rowp + bj * HALF) = w; } }
                asm volatile("" ::: "memory"); }
            if (type == 1) {
#pragma unroll
                for (int bj = 0; bj < 2; ++bj)
#pragma unroll
                    for (int n = 0; n < 2; ++n)
#pragma unroll
                        for (int j = 0; j < 4; ++j) { float v = cs_[bj][n][j]; v += __shfl_xor(v, 1); v += __shfl_xor(v, 2); v += __shfl_xor(v, 4); v += __shfl_xor(v, 8); cs_[bj][n][j] = v; }
                if (fr == 0) { const int b = u.pm >> 3, blk = u.pm & 7;
#pragma unroll
                    for (int bj = 0; bj < 2; ++bj) { const int colh = (u.pn & 1) * 256 + bj * HALF + wc * 32; const int head = colh >> 6, cpos = (colh & 63) + 8 * fq;
                        float* km = kmean + ((size_t)((b * NH + head) * NBLK + blk)) * HD + cpos;
#pragma unroll
                        for (int n = 0; n < 2; ++n)
#pragma unroll
                            for (int j = 0; j < 4; ++j) atomicAdd(km + 4 * n + j, cs_[bj][n][j]); } }
            }
        } else {
            bf16* dst = QKVUV + (size_t)type * (16u << 20);
#pragma unroll
            for (int ai = 0; ai < 2; ++ai)
#pragma unroll
                for (int m = 0; m < 4; ++m) { bf16* rowp = dst + (size_t)(row0 + ai * HALF + m * 16) * AW + colt;
#pragma unroll
                    for (int bj = 0; bj < 2; ++bj) { f32x4 v0 = acc[ai][bj][m][0], v1 = acc[ai][bj][m][1];
                        if (type >= 3) { v0 = gelu4(v0); v1 = gelu4(v1); }
                        v4u w; w.x = cvt_pk_bf16(v0[0], v0[1]); w.y = cvt_pk_bf16(v0[2], v0[3]); w.z = cvt_pk_bf16(v1[0], v1[1]); w.w = cvt_pk_bf16(v1[2], v1[3]);
                        *(v4u*)(rowp + bj * HALF) = w; } }
        }
    }
};
struct EpiOutProj {
    static constexpr bool PERM = true;
    const bf16* xn; bf16* x1; unsigned char* x1f8; float* ssq1; const LAS f32x4* rtab; const float* fgain;
    int pm_a, pm_b;
    __device__ __forceinline__ int slot(const Unit& u) const { return u.pm == pm_a ? 0 : 1; }
    __device__ __forceinline__ void midk(f32x4 (&acc)[2][2][4][2], const Unit& u, int wr, int fr) const {
        const LAS f32x4* t = rtab + slot(u) * 256 + wr * 64 + fr;
#pragma unroll
        for (int ai = 0; ai < 2; ++ai)
#pragma unroll
            for (int m = 0; m < 4; ++m) { const float r = t[ai * HALF + m * 16].x;
#pragma unroll
                for (int bj = 0; bj < 2; ++bj)
#pragma unroll
                    for (int n = 0; n < 2; ++n) acc[ai][bj][m][n] *= r; }
    }
    __device__ __forceinline__ void operator()(const f32x4 (&acc)[2][2][4][2], const Unit& u, int wr, int wc, int fr, int fq) const {
        const LAS f32x4* t = rtab + slot(u) * 256 + wr * 64 + fr;
        const int row0 = u.pm * 256 + wr * 64 + fr, col0 = u.pn * 256 + wc * 32 + 8 * fq;
        f32x4 fg[2][2];
#pragma unroll
        for (int bj = 0; bj < 2; ++bj) { fg[bj][0] = *(const f32x4*)(fgain + col0 + bj * HALF); fg[bj][1] = *(const f32x4*)(fgain + col0 + bj * HALF + 4); }
#pragma unroll
        for (int ai = 0; ai < 2; ++ai) { v4u xv[4][2];
#pragma unroll
            for (int m = 0; m < 4; ++m) { const size_t off = (size_t)(row0 + ai * HALF + m * 16) * DM + col0;
                xv[m][0] = *(const v4u*)(xn + off); xv[m][1] = *(const v4u*)(xn + off + HALF); }
#pragma unroll
            for (int m = 0; m < 4; ++m) { const int ro = ai * HALF + m * 16; const f32x4 tv = t[ro]; const float rg = tv.y, sx = tv.z; const size_t off = (size_t)(row0 + ro) * DM + col0; float q = 0.f;
#pragma unroll
                for (int bj = 0; bj < 2; ++bj) { const v4u xw = xv[m][bj];
                    const f32x4 x0 = {bflo(xw.x), bfhi(xw.x), bflo(xw.y), bfhi(xw.y)}, x1_ = {bflo(xw.z), bfhi(xw.z), bflo(xw.w), bfhi(xw.w)};
                    const f32x4 o0 = x0 * sx + acc[ai][bj][m][0] * rg, o1 = x1_ * sx + acc[ai][bj][m][1] * rg;
                    q += (o0[0] * o0[0] + o0[1] * o0[1]) + (o0[2] * o0[2] + o0[3] * o0[3]) + (o1[0] * o1[0] + o1[1] * o1[1]) + (o1[2] * o1[2] + o1[3] * o1[3]);
                    v4u w; w.x = cvt_pk_bf16(o0[0], o0[1]); w.y = cvt_pk_bf16(o0[2], o0[3]); w.z = cvt_pk_bf16(o1[0], o1[1]); w.w = cvt_pk_bf16(o1[2], o1[3]);
                    *(v4u*)(x1 + off + bj * HALF) = w;
                    const f32x4 p0 = o0 * fg[bj][0], p1 = o1 * fg[bj][1];
                    v2u w8; w8.x = pk4_fp8(p0[0], p0[1], p0[2], p0[3]); w8.y = pk4_fp8(p1[0], p1[1], p1[2], p1[3]); *(v2u*)(x1f8 + off + bj * HALF) = w8; }
                q += __shfl_xor(q, 16); q += __shfl_xor(q, 32);
                if (fq == 0) ssq1[(size_t)(row0 + ro) * 16 + u.pn * 4 + wc] = q; }
            asm volatile("" ::: "memory"); }
    }
};
struct EpiMoe1 {
    static constexpr bool PERM = true;
    unsigned char* A; const float* b_gu; const LAS float* rss;
    __device__ __forceinline__ void operator()(const f32x4 (&acc)[2][2][4][2], const Unit& u, int wr, int wc, int fr, int fq) const {
        const int row0 = u.pm * 256 + wr * 64 + fr, col = u.pn * 128 + wc * 32 + 8 * fq;
        const float* bg = b_gu + (size_t)u.e * 2 * FF + col; const LAS float* rs_ = rss + u.slot * 256 + wr * 64 + fr;
        float rsv[2][4];
#pragma unroll
        for (int ai = 0; ai < 2; ++ai)
#pragma unroll
            for (int m = 0; m < 4; ++m) rsv[ai][m] = rs_[ai * HALF + m * 16];
        f32x4 bgv[2], blv[2];
#pragma unroll
        for (int n = 0; n < 2; ++n) { bgv[n] = *(const f32x4*)(bg + 4 * n); blv[n] = *(const f32x4*)(bg + FF + 4 * n); }
#pragma unroll
        for (int ai = 0; ai < 2; ++ai)
#pragma unroll
            for (int m = 0; m < 4; ++m) { f32x4 a[2];
#pragma unroll
                for (int n = 0; n < 2; ++n) { const f32x4 g = acc[ai][0][m][n] * rsv[ai][m] + bgv[n], l = acc[ai][1][m][n] * rsv[ai][m] + blv[n];
#pragma unroll
                    for (int p = 0; p < 2; ++p) { f32x2 gc = {fminf(g[2 * p], 7.0f), fminf(g[2 * p + 1], 7.0f)}; f32x2 lc = {fminf(fmaxf(l[2 * p], -7.0f), 7.0f), fminf(fmaxf(l[2 * p + 1], -7.0f), 7.0f)};
                        const f32x2 z = gc * (-1.702f * 1.4426950408889634f); f32x2 e; e.x = __builtin_amdgcn_exp2f(z.x); e.y = __builtin_amdgcn_exp2f(z.y);
                        const f32x2 d = e + 1.0f; f32x2 r; r.x = __builtin_amdgcn_rcpf(d.x); r.y = __builtin_amdgcn_rcpf(d.y);
                        const f32x2 o = (gc * r) * (lc + 1.0f); a[n][2 * p] = o.x; a[n][2 * p + 1] = o.y; } }
                v2u w; w.x = pk4_fp8_nc(a[0][0], a[0][1], a[0][2], a[0][3]); w.y = pk4_fp8_nc(a[1][0], a[1][1], a[1][2], a[1][3]);
                *(v2u*)(A + (size_t)(row0 + ai * HALF + m * 16) * FF + col) = w; }
    }
};
constexpr float Y_SCALE = 16.0f;
struct EpiMoe2 {
    static constexpr bool PERM = true;
    unsigned char* Y; const float* b_dn; const LAS float* gss;
    __device__ __forceinline__ void operator()(const f32x4 (&acc)[2][2][4][2], const Unit& u, int wr, int wc, int fr, int fq) const {
        const int row0 = u.pm * 256 + wr * 64 + fr, col0 = u.pn * 256 + wc * 32 + 8 * fq;
        const LAS float* gs = gss + u.slot * 256 + wr * 64 + fr;
        f32x4 bv[2][2]; float gv[2][4];
#pragma unroll
        for (int bj = 0; bj < 2; ++bj)
#pragma unroll
            for (int n = 0; n < 2; ++n) bv[bj][n] = *(const f32x4*)(b_dn + (size_t)u.e * DM + col0 + bj * HALF + 4 * n);
#pragma unroll
        for (int ai = 0; ai < 2; ++ai)
#pragma unroll
            for (int m = 0; m < 4; ++m) gv[ai][m] = gs[ai * HALF + m * 16] * Y_SCALE;
#pragma unroll
        for (int ai = 0; ai < 2; ++ai)
#pragma unroll
            for (int m = 0; m < 4; ++m) { const float g = gv[ai][m]; unsigned char* rowp = Y + (size_t)(row0 + ai * HALF + m * 16) * DM + col0;
#pragma unroll
                for (int bj = 0; bj < 2; ++bj) { const f32x4 v0 = (acc[ai][bj][m][0] + bv[bj][0]) * g, v1 = (acc[ai][bj][m][1] + bv[bj][1]) * g;
                    v2u w; w.x = pk4_fp8(v0[0], v0[1], v0[2], v0[3]); w.y = pk4_fp8(v1[0], v1[1], v1[2], v1[3]);
                    *(v2u*)(rowp + bj * HALF) = w; } }
    }
};
constexpr float GATE_SCALE = 128.0f;
template <int MODE> struct EpiPle {
    static constexpr bool PERM = true;
    unsigned char* O; float* ssq; const LAS float* rtab; int pm_a;
    __device__ __forceinline__ void operator()(const f32x4 (&acc)[2][2][4][2], const Unit& u, int wr, int wc, int fr, int fq) const {
        const int row0 = u.pm * 256 + wr * 64 + fr, col0 = u.pn * 256 + wc * 32 + 8 * fq;
        float rsv[2][4];
#pragma unroll
        for (int ai = 0; ai < 2; ++ai)
#pragma unroll
            for (int m = 0; m < 4; ++m) rsv[ai][m] = (MODE == 0) ? rtab[(u.pm == pm_a ? 0 : 256) + wr * 64 + fr + ai * HALF + m * 16] : 1.0f;
#pragma unroll
        for (int ai = 0; ai < 2; ++ai)
#pragma unroll
            for (int m = 0; m < 4; ++m) { unsigned char* rowp = O + (size_t)(row0 + ai * HALF + m * 16) * DM + col0; float q = 0.f; const float rs = rsv[ai][m];
#pragma unroll
                for (int bj = 0; bj < 2; ++bj) { f32x4 v0 = acc[ai][bj][m][0], v1 = acc[ai][bj][m][1];
                    if (MODE == 0) {
#pragma unroll
                        for (int j = 0; j < 4; ++j) { v0[j] = GATE_SCALE * sigmoidf_fast(rs * v0[j]); v1[j] = GATE_SCALE * sigmoidf_fast(rs * v1[j]); } }
                    else { q += (v0[0] * v0[0] + v0[1] * v0[1]) + (v0[2] * v0[2] + v0[3] * v0[3]) + (v1[0] * v1[0] + v1[1] * v1[1]) + (v1[2] * v1[2] + v1[3] * v1[3]); }
                    v2u w; if (MODE == 0) { w.x = pk4_fp8_nc(v0[0], v0[1], v0[2], v0[3]); w.y = pk4_fp8_nc(v1[0], v1[1], v1[2], v1[3]); }
                    else { w.x = pk4_fp8(v0[0], v0[1], v0[2], v0[3]); w.y = pk4_fp8(v1[0], v1[1], v1[2], v1[3]); }
                    *(v2u*)(rowp + bj * HALF) = w; }
                if (MODE == 1) { q += __shfl_xor(q, 16); q += __shfl_xor(q, 32); if (fq == 0) ssq[(size_t)(row0 + ai * HALF + m * 16) * 16 + u.pn * 4 + wc] = q; } }
    }
};

namespace att {
constexpr int QBLK = 32, KVBLK = 64;
constexpr float SCALE = 0.125f, THR = 8.f;
constexpr int SHM_V = KVBLK * HD * 2, SHM_K = SHM_V;
constexpr int NSLOT = 3;
constexpr int LDS_BYTES_ = NSLOT * SHM_V + NSLOT * SHM_K + NWAVES * 64 * 4;
#define ATT_KSWZ(row, colB) ((row) * 128 + ((colB) ^ ((((row) >> 1) & 7) << 4)))
#define ATT_SBAR() __builtin_amdgcn_sched_barrier(0)
__device__ __forceinline__ int crow(int r, int hi) { return (r & 3) + 8 * (r >> 2) + 4 * hi; }
__device__ __forceinline__ void cmask(f32x16& p0, f32x16& p1, int jb, int qrel, int hi) {
    const float NEG = -__builtin_inff(); const int kb = 64 * jb + 4 * hi;
#pragma unroll
    for (int r = 0; r < 16; ++r) { const int kv = kb + (r & 3) + 8 * (r >> 2); if (kv > qrel) p0[r] = NEG; if (kv + 32 > qrel) p1[r] = NEG; }
}
__device__ __forceinline__ void bmask(f32x16& p0, f32x16& p1, bool keep) {
    const float NEG = -__builtin_inff();
    if (!keep) {
#pragma unroll
        for (int r = 0; r < 16; ++r) { p0[r] = NEG; p1[r] = NEG; } }
}
__device__ __forceinline__ void partialSM(f32x16& p0, f32x16& p1, float& m_reg, float& mn, float& alpha, bool keep) {
    float pmax = p0[0];
#pragma unroll
    for (int r = 1; r < 16; ++r) pmax = fmaxf(pmax, p0[r]);
#pragma unroll
    for (int r = 0; r < 16; ++r) pmax = fmaxf(pmax, p1[r]);
    { auto rr = __builtin_amdgcn_permlane32_swap(__float_as_uint(pmax), __float_as_uint(pmax), false, false);
      pmax = fmaxf(__uint_as_float(rr[0]), __uint_as_float(rr[1])); }
    if (!keep) pmax = -__builtin_inff();
    constexpr float C2 = 1.4426950408889634f * SCALE;
    if (__builtin_expect(__all((pmax - m_reg) * SCALE <= THR), 1)) { mn = m_reg; alpha = 1.f; }
    else { mn = fmaxf(m_reg, pmax); alpha = __builtin_amdgcn_exp2f((m_reg - mn) * C2); m_reg = mn; }
    const float mnL = keep ? -mn * C2 : -__builtin_inff(), c2 = keep ? C2 : 0.f;
#pragma unroll
    for (int r = 0; r < 16; ++r) p0[r] = fmaf(p0[r], c2, mnL);
#pragma unroll
    for (int r = 0; r < 16; ++r) p1[r] = fmaf(p1[r], c2, mnL);
#pragma unroll
    for (int r = 0; r < 16; ++r) p0[r] = __builtin_amdgcn_exp2f(p0[r]);
}
__device__ __forceinline__ void finishSM(f32x16& p0, f32x16& p1, float alpha, float& l_reg, bf16x8& pa0, bf16x8& pa1, bf16x8& pa2, bf16x8& pa3) {
#pragma unroll
    for (int r = 0; r < 16; ++r) p1[r] = __builtin_amdgcn_exp2f(p1[r]);
    float ps = 0;
#pragma unroll
    for (int r = 0; r < 16; ++r) ps += p0[r];
#pragma unroll
    for (int r = 0; r < 16; ++r) ps += p1[r];
    { auto rr = __builtin_amdgcn_permlane32_swap(__float_as_uint(ps), __float_as_uint(ps), false, false);
      ps = __uint_as_float(rr[0]) + __uint_as_float(rr[1]); }
    l_reg = l_reg * alpha + ps;
#define ATT_PK4(P, B, OUT) do { unsigned a0 = cvt_pk_bf16(P[B+0], P[B+1]), a1 = cvt_pk_bf16(P[B+2], P[B+3]);             \
        unsigned b0 = cvt_pk_bf16(P[B+4], P[B+5]), b1 = cvt_pk_bf16(P[B+6], P[B+7]);                                       \
        auto r0 = __builtin_amdgcn_permlane32_swap(a0, b0, false, false); auto r1 = __builtin_amdgcn_permlane32_swap(a1, b1, false, false); \
        v4u w = {r0[0], r1[0], r0[1], r1[1]}; OUT = *reinterpret_cast<bf16x8*>(&w); } while (0)
    ATT_PK4(p0, 0, pa0); ATT_PK4(p0, 8, pa1); ATT_PK4(p1, 0, pa2); ATT_PK4(p1, 8, pa3);
#undef ATT_PK4
}
__device__ __forceinline__ void qkt(f32x16& p0, f32x16& p1, const LAS unsigned char* Ks, const bf16x8* qr, int r32, int hi) {
    p0 = f32x16{}; p1 = f32x16{};
#pragma unroll
    for (int d0 = 0; d0 < 4; ++d0) { const int cb = (d0 * 16 + hi * 8) * 2;
        const bf16x8 b0 = *(const LAS bf16x8*)(Ks + ATT_KSWZ(r32, cb));
        const bf16x8 b1 = *(const LAS bf16x8*)(Ks + ATT_KSWZ(32 + r32, cb));
        p0 = __builtin_amdgcn_mfma_f32_32x32x16_bf16(b0, qr[d0], p0, 0, 0, 0);
        p1 = __builtin_amdgcn_mfma_f32_32x32x16_bf16(b1, qr[d0], p1, 0, 0, 0); }
}
__device__ __forceinline__ void pv(f32x16* o, int vb, bf16x8 pa0, bf16x8 pa1, bf16x8 pa2, bf16x8 pa3) {
#pragma unroll
    for (int d0 = 0; d0 < 2; ++d0) { s16x4 lo[4], hi[4];
#pragma unroll
        for (int ks = 0; ks < 4; ++ks) { const int a = vb + d0 * 2048 + (ks >> 1) * 4096 + (ks & 1) * 1024;
            asm volatile("ds_read_b64_tr_b16 %0,%1" : "=&v"(lo[ks]) : "v"(a) : "memory");
            asm volatile("ds_read_b64_tr_b16 %0,%1 offset:256" : "=&v"(hi[ks]) : "v"(a) : "memory"); }
        asm volatile("s_waitcnt lgkmcnt(0)" ::: "memory"); ATT_SBAR();
#define ATT_PK(k) (bf16x8){lo[k][0], lo[k][1], lo[k][2], lo[k][3], hi[k][0], hi[k][1], hi[k][2], hi[k][3]}
        o[d0] = __builtin_amdgcn_mfma_f32_32x32x16_bf16(pa0, ATT_PK(0), o[d0], 0, 0, 0);
        o[d0] = __builtin_amdgcn_mfma_f32_32x32x16_bf16(pa1, ATT_PK(1), o[d0], 0, 0, 0);
        o[d0] = __builtin_amdgcn_mfma_f32_32x32x16_bf16(pa2, ATT_PK(2), o[d0], 0, 0, 0);
        o[d0] = __builtin_amdgcn_mfma_f32_32x32x16_bf16(pa3, ATT_PK(3), o[d0], 0, 0, 0);
#undef ATT_PK
    }
}
__device__ __forceinline__ void attn_unit(const Frame& F, int b, int h, int qb, LAS unsigned char* scratch) {
    PHASE_IDS;
    const int tid = TID_, wid = tid >> 6, lane = tid & 63, r32 = lane & 31, hi = lane >> 5;
    const bf16* Qg = wsp<bf16>(F, WS_Q); const bf16* Kg = wsp<bf16>(F, WS_K); const bf16* Vg = wsp<bf16>(F, WS_V);
    const size_t rowbase = (size_t)b * SEQ; const int q0 = qb * MOBA;
    const bf16* Qw = Qg + (rowbase + q0 + wid * QBLK) * AW + h * HD;
    const bf16* Kh = Kg + rowbase * AW + h * HD; const bf16* Vh = Vg + rowbase * AW + h * HD;
    LAS unsigned char* V_lds = scratch; LAS unsigned char* K_lds = scratch + NSLOT * SHM_V;
    LAS float* wsf = (LAS float*)(scratch + NSLOT * SHM_V + NSLOT * SHM_K) + wid * 64; LAS float* li_l = wsf; LAS float* al_l = wsf + 32;
    float m_reg = -1e30f, l_reg = 0.f; f32x16 o[2]; o[0] = f32x16{}; o[1] = f32x16{}; bf16x8 qr[4];
#pragma unroll
    for (int d0 = 0; d0 < 4; ++d0) qr[d0] = *(const bf16x8*)(Qw + (size_t)r32 * AW + d0 * 16 + hi * 8);
    unsigned sel = 0u;
    if (qb <= 3) sel = (1u << qb) - 1u;
    else {
        const float* km = wsp<float>(F, WS_KMEAN) + (size_t)((b * NH + h) * NBLK) * HD + (size_t)(r32 & 7) * HD + hi * 8;
        f32x4 kv[4][2];
#pragma unroll
        for (int d0 = 0; d0 < 4; ++d0) { kv[d0][0] = *(const f32x4*)(km + d0 * 16); kv[d0][1] = *(const f32x4*)(km + d0 * 16 + 4); }
        f32x16 gacc = f32x16{};
#pragma unroll
        for (int d0 = 0; d0 < 4; ++d0) { float f[8] = {kv[d0][0][0], kv[d0][0][1], kv[d0][0][2], kv[d0][0][3], kv[d0][1][0], kv[d0][1][1], kv[d0][1][2], kv[d0][1][3]};
            unsigned hw[4], lw[4];
#pragma unroll
            for (int p = 0; p < 4; ++p) { float a0 = f[2 * p], a1 = f[2 * p + 1]; if (r32 >= 8) { a0 = 0.f; a1 = 0.f; }
                const unsigned h0 = f2bf(a0), h1 = f2bf(a1); hw[p] = h0 | (h1 << 16); lw[p] = pk2(a0 - bf2f((bf16)h0), a1 - bf2f((bf16)h1)); }
            const v4u hv = {hw[0], hw[1], hw[2], hw[3]}, lv = {lw[0], lw[1], lw[2], lw[3]};
            gacc = __builtin_amdgcn_mfma_f32_32x32x16_bf16(__builtin_bit_cast(bf16x8, hv), qr[d0], gacc, 0, 0, 0);
            gacc = __builtin_amdgcn_mfma_f32_32x32x16_bf16(__builtin_bit_cast(bf16x8, lv), qr[d0], gacc, 0, 0, 0); }
        float g[8];
#pragma unroll
        for (int r = 0; r < 4; ++r) { const float mine = gacc[r], other = __shfl_xor(mine, 32); g[r] = hi ? other : mine; g[4 + r] = hi ? mine : other; }
        float b0 = -__builtin_inff(), b1 = b0, b2 = b0; int i0 = 0, i1 = 0, i2 = 0;
#pragma unroll
        for (int j = 0; j < NBLK - 1; ++j) { const float s_ = (j < qb) ? g[j] : -__builtin_inff();
            if (s_ > b0) { b2 = b1; i2 = i1; b1 = b0; i1 = i0; b0 = s_; i0 = j; } else if (s_ > b1) { b2 = b1; i2 = i1; b1 = s_; i1 = j; } else if (s_ > b2) { b2 = s_; i2 = j; } }
        sel = (1u << i0) | (1u << i1) | (1u << i2);
    }
    const int sr = tid >> 3, sc = (tid & 7) * 8;
    const int srv = ((tid >> 5) << 2) | ((tid >> 1) & 3), scv = ((tid & 1) << 3) | (((tid >> 3) & 3) << 4);
    const int vst = (srv >> 5) * 4096 + (scv >> 5) * 2048 + ((srv & 31) >> 2) * 256 + ((scv >> 4) & 1) * 128 + (srv & 3) * 32 + (scv & 8) * 2;
    const int vb0 = (int)(size_t)V_lds + (lane & 15) * 8 + ((lane >> 4) & 1) * 128 + (lane >> 5) * 512;
    bf16x8 st_v, st_k;
#define ATT_SLOAD(k0) do { st_v = *(const bf16x8*)(Vh + (size_t)((k0) + srv) * AW + scv); st_k = *(const bf16x8*)(Kh + (size_t)((k0) + sr) * AW + sc); } while (0)
#define ATT_SWRITE(bf) do { *(LAS bf16x8*)(V_lds + (bf) * SHM_V + vst) = st_v; *(LAS bf16x8*)(K_lds + (bf) * SHM_K + ATT_KSWZ(sr, sc * 2)) = st_k; } while (0)
#define ATT_RESC(a) do { if (__any((a) < 1.f)) { if (hi == 0) al_l[r32] = (a); asm volatile("s_waitcnt lgkmcnt(0)" ::: "memory");      \
        _Pragma("unroll") for (int d_ = 0; d_ < 2; ++d_) _Pragma("unroll") for (int r = 0; r < 16; ++r) o[d_][r] *= al_l[crow(r, hi)]; } } while (0)
    const int NT = (q0 + MOBA) / KVBLK;
    const int qrel = wid * QBLK + r32;
#define ATT_MASK(P0, P1, t) do { const int jb_ = (t) - (NT - 4); if (jb_ >= 0) cmask(P0, P1, jb_, qrel, hi); } while (0)
#define ATT_KEEP(t) ((((t) >= NT - 4) ? 1u : ((sel >> ((t) >> 2)) & 1u)) != 0u)
    f32x16 pA0, pA1, pB0, pB1; float mnA, mnB, alA, alB; bf16x8 pa0, pa1, pa2, pa3;
    int s0 = 0, s1 = 1, s2 = 2;
#define ATT_ROT() do { const int t_ = s0; s0 = s1; s1 = s2; s2 = t_; } while (0)
    ATT_SLOAD(0); asm volatile("s_waitcnt vmcnt(0)" ::: "memory"); ATT_SWRITE(0); ATT_SLOAD(KVBLK);
    s0 = 2; s1 = 0; s2 = 1;
    __syncthreads();
    asm volatile("s_waitcnt vmcnt(0)" ::: "memory"); ATT_SWRITE(s2); ATT_SLOAD(2 * KVBLK);
    qkt(pA0, pA1, K_lds + s1 * SHM_K, qr, r32, hi); ATT_MASK(pA0, pA1, 0); partialSM(pA0, pA1, m_reg, mnA, alA, ATT_KEEP(0));
    ATT_ROT();
    for (int j = 1; j < NT; j += 2) {
        __syncthreads();
        if (j + 1 < NT) { asm volatile("s_waitcnt vmcnt(0)" ::: "memory"); ATT_SWRITE(s2); if (j + 2 < NT) ATT_SLOAD((j + 2) * KVBLK); }
        ATT_SBAR(); qkt(pB0, pB1, K_lds + s1 * SHM_K, qr, r32, hi); ATT_MASK(pB0, pB1, j);
        finishSM(pA0, pA1, alA, l_reg, pa0, pa1, pa2, pa3); ATT_SBAR();
        pv(o, vb0 + s0 * SHM_V, pa0, pa1, pa2, pa3); partialSM(pB0, pB1, m_reg, mnB, alB, ATT_KEEP(j));
        ATT_RESC(alB); ATT_ROT();
        if (j + 1 < NT) {
            __syncthreads();
            if (j + 2 < NT) { asm volatile("s_waitcnt vmcnt(0)" ::: "memory"); ATT_SWRITE(s2); if (j + 3 < NT) ATT_SLOAD((j + 3) * KVBLK); }
            ATT_SBAR(); qkt(pA0, pA1, K_lds + s1 * SHM_K, qr, r32, hi); ATT_MASK(pA0, pA1, j + 1);
            finishSM(pB0, pB1, alB, l_reg, pa0, pa1, pa2, pa3); ATT_SBAR();
            pv(o, vb0 + s0 * SHM_V, pa0, pa1, pa2, pa3); partialSM(pA0, pA1, m_reg, mnA, alA, ATT_KEEP(j + 1));
            ATT_RESC(alA); ATT_ROT();
        }
    }
    finishSM(pB0, pB1, alB, l_reg, pa0, pa1, pa2, pa3); ATT_SBAR();
    pv(o, vb0 + s0 * SHM_V, pa0, pa1, pa2, pa3);
#undef ATT_ROT
    if (hi == 0) li_l[r32] = l_reg; asm volatile("s_waitcnt lgkmcnt(0)" ::: "memory");
    float rli[16];
#pragma unroll
    for (int r = 0; r < 16; ++r) rli[r] = __builtin_amdgcn_rcpf(li_l[crow(r, hi)]);
    bf16* Ow = wsp<bf16>(F, WS_MIX) + (rowbase + q0 + wid * QBLK) * DM + h * HD;
    float* ssqa = wsp<float>(F, WS_SSQA) + (rowbase + q0 + wid * QBLK) * NH + h;
    float qq[16];
#pragma unroll
    for (int r = 0; r < 16; ++r) { const int orow = crow(r, hi); float q2 = 0.f;
#pragma unroll
        for (int d0 = 0; d0 < 2; ++d0) { const float v = o[d0][r] * rli[r]; const float vn = __shfl_xor(v, 1); q2 += v * v;
            if ((r32 & 1) == 0) *(unsigned*)(Ow + (size_t)orow * DM + d0 * 32 + r32) = cvt_pk_bf16(v, vn); }
        qq[r] = q2; }
#pragma unroll
    for (int i = 0; i < 8; ++i) { const bool up = (lane & 16) != 0; const float send = up ? qq[i] : qq[i + 8], keep = up ? qq[i + 8] : qq[i]; qq[i] = keep + __shfl_xor(send, 16); }
#pragma unroll
    for (int i = 0; i < 4; ++i) { const bool up = (lane & 8) != 0; const float send = up ? qq[i] : qq[i + 4], keep = up ? qq[i + 4] : qq[i]; qq[i] = keep + __shfl_xor(send, 8); }
#pragma unroll
    for (int i = 0; i < 2; ++i) { const bool up = (lane & 4) != 0; const float send = up ? qq[i] : qq[i + 2], keep = up ? qq[i + 2] : qq[i]; qq[i] = keep + __shfl_xor(send, 4); }
    { const bool up = (lane & 2) != 0; const float send = up ? qq[0] : qq[1], keep = up ? qq[1] : qq[0]; qq[0] = keep + __shfl_xor(send, 2); }
    qq[0] += __shfl_xor(qq[0], 1);
    if ((lane & 1) == 0) ssqa[(size_t)crow(r32 >> 1, hi) * NH] = qq[0];
    __syncthreads();
#undef ATT_SLOAD
#undef ATT_SWRITE
#undef ATT_RESC
#undef ATT_MASK
#undef ATT_KEEP
}
}

namespace gm {
__device__ __forceinline__ int vt_off(int d, int s) { return d * 256 + ((((s >> 3) ^ (d & 15)) & 15) << 4) + (s & 7) * 2; }
__device__ __forceinline__ void units4(const Frame& F, int v, LAS unsigned char* scratch) {
    PHASE_IDS;
    const int tid = TID_, wid = tid >> 6, lane = tid & 63, fr = lane & 15, fq = lane >> 4;
    const int u = wid >> 1, half = wid & 1, uidx = 4 * v + u, b = uidx >> 6, c = (uidx >> 2) & 15, g = uidx & 3;
    const size_t row0 = (size_t)b * SEQ + c * GC;
    const bf16* VGg = wsp<bf16>(F, WS_VG) + row0 * GW + g * GD; const bf16* Ug = wsp<bf16>(F, WS_U) + row0 * GW + g * GD;
    LAS unsigned char* vt = scratch + u * 32768;
    { const int s_ = half * 64 + lane; const v4u* src = (const v4u*)(VGg + (size_t)s_ * GW); v4u raw[16]; float sum = 0.f, sq = 0.f;
#pragma unroll
      for (int i = 0; i < 16; ++i) raw[i] = src[i];
#pragma unroll
      for (int i = 0; i < 16; ++i) { const unsigned ww[4] = {raw[i].x, raw[i].y, raw[i].z, raw[i].w};
#pragma unroll
          for (int k = 0; k < 4; ++k) { const float a0 = bflo(ww[k]), a1 = bfhi(ww[k]); sum += a0 + a1; sq += a0 * a0 + a1 * a1; } }
      const float mu = sum * (1.f / GD); const float var = fmaxf(sq * (1.f / GD) - mu * mu, 0.f); const float rstd = 1.0f / sqrtf(var + EPS);
      const float* lg = F.ln_g + g * GD; const float* lb = F.ln_b + g * GD;
#pragma unroll
      for (int i = 0; i < 16; ++i) { const unsigned ww[4] = {raw[i].x, raw[i].y, raw[i].z, raw[i].w}; const f32x4 g0 = *(const f32x4*)(lg + 8 * i), g1 = *(const f32x4*)(lg + 8 * i + 4), b0 = *(const f32x4*)(lb + 8 * i), b1 = *(const f32x4*)(lb + 8 * i + 4);
          const float gg[8] = {g0[0], g0[1], g0[2], g0[3], g1[0], g1[1], g1[2], g1[3]}, bb[8] = {b0[0], b0[1], b0[2], b0[3], b1[0], b1[1], b1[2], b1[3]};
#pragma unroll
          for (int k = 0; k < 4; ++k) { const int d = 8 * i + 2 * k;
              *(LAS unsigned short*)(vt + vt_off(d, s_)) = (unsigned short)f2bf((bflo(ww[k]) - mu) * rstd * gg[2 * k] + bb[2 * k]);
              *(LAS unsigned short*)(vt + vt_off(d + 1, s_)) = (unsigned short)f2bf((bfhi(ww[k]) - mu) * rstd * gg[2 * k + 1] + bb[2 * k + 1]); } } }
    __syncthreads();
#pragma unroll 1
    for (int m = 0; m < 4; ++m) {
        const int tb = half * 64 + m * 16, t = tb + fr;
        const float* Wg = F.gws + (size_t)g * GC * GC + (size_t)t * GC;
        const int nks = (tb + 16 + 31) / 32;
        f32x4 w0[4], w1[4];
#pragma unroll
        for (int ks = 0; ks < 4; ++ks) if (ks < nks) { w0[ks] = *(const f32x4*)(Wg + ks * 32 + fq * 8); w1[ks] = *(const f32x4*)(Wg + ks * 32 + fq * 8 + 4); }
        const bf16* Ut = Ug + (size_t)t * GW + 4 * fq; v2u uu[8];
#pragma unroll
        for (int n = 0; n < 8; ++n) uu[n] = *(const v2u*)(Ut + n * 16);
        f32x4 acc[8];
#pragma unroll
        for (int n = 0; n < 8; ++n) acc[n] = (f32x4){0.f, 0.f, 0.f, 0.f};
#pragma unroll
        for (int ks = 0; ks < 4; ++ks) if (ks < nks) { const int s0 = ks * 32 + fq * 8;
            float wv[8] = {w0[ks][0], w0[ks][1], w0[ks][2], w0[ks][3], w1[ks][0], w1[ks][1], w1[ks][2], w1[ks][3]};
#pragma unroll
            for (int j = 0; j < 8; ++j) if (s0 + j > t) wv[j] = 0.f;
            v4u aw; aw.x = pk2(wv[0], wv[1]); aw.y = pk2(wv[2], wv[3]); aw.z = pk2(wv[4], wv[5]); aw.w = pk2(wv[6], wv[7]);
            const bf16x8 wf = *reinterpret_cast<const bf16x8*>(&aw);
#pragma unroll
            for (int n = 0; n < 8; ++n) { const bf16x8 vf = *(const LAS bf16x8*)(vt + vt_off(n * 16 + fr, s0));
                acc[n] = __builtin_amdgcn_mfma_f32_16x16x32_bf16(vf, wf, acc[n], 0, 0, 0); } }
        bf16* Og = wsp<bf16>(F, WS_MIX) + (row0 + t) * DM + AW + g * GD + 4 * fq; float* ssqg = wsp<float>(F, WS_SSQG) + (row0 + t) * GG + g;
        const float bs = F.gbs[g * GC + t]; float q2 = 0.f;
#pragma unroll
        for (int n = 0; n < 8; ++n) { const float o0 = bflo(uu[n].x) * (acc[n][0] + bs), o1 = bfhi(uu[n].x) * (acc[n][1] + bs), o2 = bflo(uu[n].y) * (acc[n][2] + bs), o3 = bfhi(uu[n].y) * (acc[n][3] + bs);
            q2 += (o0 * o0 + o1 * o1) + (o2 * o2 + o3 * o3); v2u w; w.x = cvt_pk_bf16(o0, o1); w.y = cvt_pk_bf16(o2, o3); *(v2u*)(Og + n * 16) = w; }
        q2 += __shfl_xor(q2, 16); q2 += __shfl_xor(q2, 32);
        if (fq == 0) ssqg[0] = q2;
    }
    __syncthreads();
}
}

__device__ __forceinline__ void p2_mixers(const Frame& F) {
    PHASE_IDS;
    LAS unsigned char* scratch = F.lds + RING_OFF;
    const int v = F.vcu, bh = v >> 1, s0 = (v & 1) * 2, cslot = (v >> 1) % 6;
    int item = 0;
#pragma unroll 1
    for (int st = 0; st < 6; ++st) {
        if (st == cslot) { constexpr int PER_WG = XW_ITEMS / 256; static_assert(XW_ITEMS % 256 == 0 && PER_WG % NWAVES == 0, "items per workgroup / wave");
            LAS float* scr = (LAS float*)(F.lds + RING_OFF + WAVE_ * P0_SCR_WAVE);
            constexpr int NI = PER_WG / NWAVES; static_assert(NI % 2 == 0, "pairs");
            int ln = LANE_; asm volatile("" : "+v"(ln));
            const int it0 = v * PER_WG + WAVE_; f32x4 va[16], vb[16]; XwDesc da = xw_desc(F, it0, ln), db; xw_load(va, da);
#pragma unroll 1
            for (int j = 0; j < NI; j += 2) {
                db = xw_desc(F, it0 + (j + 1) * NWAVES, ln); xw_load(vb, db);
                xw_process(va, da, scr, ln);
                if (j + 2 < NI) { da = xw_desc(F, it0 + (j + 2) * NWAVES, ln); xw_load(va, da); }
                xw_process(vb, db, scr, ln);
            }
            __syncthreads(); }
        else { if (item < 4) { const int qq = s0 + (item >> 1); const int qb = (item & 1) ? 7 - qq : qq; att::attn_unit(F, bh / NH, bh % NH, qb, scratch); }
               else gm::units4(F, v, scratch);
               ++item; }
    }
}

__device__ __forceinline__ void p4_router(const Frame& F) {
    PHASE_IDS;
    const int tid = TID_, wid = tid >> 6, lane = tid & 63, tk = lane & 31, hf = lane >> 5;
    LAS unsigned* hist = (LAS unsigned*)(F.lds + XTAB_OFF + 4096);
    LAS unsigned* base = hist + 32;
    static_assert(XTAB_OFF + 4096 >= 8 * P0_SCR_WAVE, "router words above the conversion tiles");
    const bf16* RWT = wsp<bf16>(F, WS_RWT); const bf16* x1 = wsp<bf16>(F, WS_X1B); const float* ssq1 = wsp<float>(F, WS_SSQ1);
    unsigned* cntg = (unsigned*)(F.ctl + CW_CNT);
    unsigned* IDX = wsp<unsigned>(F, WS_IDX); float* GSS = wsp<float>(F, WS_GSS); float* RSS = wsp<float>(F, WS_RSS); unsigned* TOKPOS = wsp<unsigned>(F, WS_TOKPOS);
    if (tid < 32) hist[tid] = 0u;
    __syncthreads();
    const bool active = wid < 4; const int tok = (F.vcu * 4 + (wid & 3)) * 32 + tk;
    int pe[4] = {0, 0, 0, 0}; float pg[4] = {0.f, 0.f, 0.f, 0.f}; unsigned rank[2] = {0u, 0u}; int my_e[2] = {0, 0}; float my_g[2] = {0.f, 0.f}; float rstd = 0.f;
    f32x16 acc = f32x16{};
    { constexpr int PITCH = 528; LAS unsigned char* XL = F.lds + RING_OFF; LAS unsigned char* WL = XL + 128 * PITCH;
      const int rsub = lane >> 5, cb = (lane & 31) * 16;
      const char* xsrc = (const char*)(x1 + (size_t)(F.vcu * 128 + 16 * wid + rsub) * DM) + cb; const char* wsrc = (const char*)(RWT + (size_t)(8 * wid + rsub) * DM) + cb;
      LAS unsigned char* xdst = XL + (16 * wid + rsub) * PITCH + cb; LAS unsigned char* wdst = WL + (8 * wid + rsub) * PITCH + cb;
      const LAS unsigned char* xb = XL + ((wid & 3) * 32 + tk) * PITCH + hf * 16; const LAS unsigned char* wa = WL + tk * PITCH + hf * 16; const LAS unsigned char* wb = wa + 32 * PITCH;
      v4u xs[8], ws_[4];
#define RT_LOAD(c) do { _Pragma("unroll") for (int i = 0; i < 8; ++i) xs[i] = *(const v4u*)(xsrc + (size_t)(2 * i) * DM * 2 + (c) * 512); \
                        _Pragma("unroll") for (int i = 0; i < 4; ++i) ws_[i] = *(const v4u*)(wsrc + (size_t)(2 * i) * DM * 2 + (c) * 512); } while (0)
      RT_LOAD(0);
#pragma unroll 1
      for (int c = 0; c < 4; ++c) {
#pragma unroll
          for (int i = 0; i < 8; ++i) *(LAS v4u*)(xdst + 2 * i * PITCH) = xs[i];
#pragma unroll
          for (int i = 0; i < 4; ++i) *(LAS v4u*)(wdst + 2 * i * PITCH) = ws_[i];
          __syncthreads();
          if (c < 3) RT_LOAD(c + 1);
          if (active) {
#pragma unroll
              for (int s_ = 0; s_ < 16; ++s_) { const bf16x8 xv = *(const LAS bf16x8*)(xb + 32 * s_), a_hi = *(const LAS bf16x8*)(wa + 32 * s_), a_lo = *(const LAS bf16x8*)(wb + 32 * s_);
                  acc = __builtin_amdgcn_mfma_f32_32x32x16_bf16(a_hi, xv, acc, 0, 0, 0); acc = __builtin_amdgcn_mfma_f32_32x32x16_bf16(a_lo, xv, acc, 0, 0, 0); } }
          __syncthreads();
      }
#undef RT_LOAD
    }
    if (active) {
        { const f32x4* sp = (const f32x4*)(ssq1 + (size_t)tok * 16); const f32x4 a = sp[0], b = sp[1], c = sp[2], d = sp[3];
          const float s_ = ((a[0] + a[1]) + (a[2] + a[3])) + ((b[0] + b[1]) + (b[2] + b[3])) + ((c[0] + c[1]) + (c[2] + c[3])) + ((d[0] + d[1]) + (d[2] + d[3]));
          rstd = 1.0f / sqrtf(s_ * (1.f / DM) + EPS); }
        float lv[16];
#pragma unroll
        for (int r = 0; r < 16; ++r) { const int e = (r & 3) + 8 * (r >> 2) + 4 * hf; lv[r] = acc[r] * rstd + F.router_b[e]; }
        float tv[4]; int ti[4]; unsigned used = 0u;
#pragma unroll
        for (int k = 0; k < 4; ++k) { float best = -__builtin_inff(); int br = 0;
#pragma unroll
            for (int r = 0; r < 16; ++r) { const int e = (r & 3) + 8 * (r >> 2) + 4 * hf; const int eb = (br & 3) + 8 * (br >> 2) + 4 * hf;
                const bool better = !((used >> r) & 1u) && (lv[r] > best || (lv[r] == best && e < eb)); if (better) { best = lv[r]; br = r; } }
            used |= 1u << br; tv[k] = best; ti[k] = (br & 3) + 8 * (br >> 2) + 4 * hf; }
        float ov[4]; int oi[4];
#pragma unroll
        for (int k = 0; k < 4; ++k) { ov[k] = __shfl_xor(tv[k], 32); oi[k] = __shfl_xor(ti[k], 32); }
        int ia = 0, ib = 0;
#pragma unroll
        for (int k = 0; k < 4; ++k) {
            float va = tv[0], vb = ov[0]; int ea = ti[0], eb = oi[0];
#pragma unroll
            for (int q = 1; q < 4; ++q) { if (ia == q) { va = tv[q]; ea = ti[q]; } if (ib == q) { vb = ov[q]; eb = oi[q]; } }
            const bool takeA = (va > vb) || (va == vb && ea < eb);
            pg[k] = takeA ? va : vb; pe[k] = takeA ? ea : eb; if (takeA) ++ia; else ++ib; }
        { const float m = pg[0]; float s_ = 0.f;
#pragma unroll
          for (int k = 0; k < 4; ++k) { pg[k] = __builtin_amdgcn_exp2f((pg[k] - m) * 1.4426950408889634f); s_ += pg[k]; }
          const float inv = 1.0f / s_;
#pragma unroll
          for (int k = 0; k < 4; ++k) pg[k] *= inv; }
        { const int m = -hf; my_e[0] = pe[0] ^ ((pe[0] ^ pe[2]) & m); my_e[1] = pe[1] ^ ((pe[1] ^ pe[3]) & m);
          const unsigned g0 = __float_as_uint(pg[0]), g1 = __float_as_uint(pg[1]), g2 = __float_as_uint(pg[2]), g3 = __float_as_uint(pg[3]);
          my_g[0] = __uint_as_float(g0 ^ ((g0 ^ g2) & (unsigned)m)); my_g[1] = __uint_as_float(g1 ^ ((g1 ^ g3) & (unsigned)m)); }
#pragma unroll
        for (int q = 0; q < 2; ++q) rank[q] = atomicAdd((unsigned*)&hist[my_e[q]], 1u);
    }
    __syncthreads();
    if (tid < 32) base[tid] = atomicAdd(cntg + tid * CNT_STRIDE, hist[tid]);
    __syncthreads();
    if (active) {
#pragma unroll
        for (int q = 0; q < 2; ++q) { const int k = 2 * hf + q; const int e = my_e[q]; const float g = my_g[q];
            const unsigned slot = base[e] + rank[q];
            IDX[(size_t)e * T + slot] = (unsigned)tok; GSS[(size_t)e * T + slot] = g; RSS[(size_t)e * T + slot] = rstd; TOKPOS[(size_t)tok * 4 + k] = ((unsigned)e << 16) | slot; }
    }
    __syncthreads();
}

__device__ __forceinline__ void build_tstart(const Frame& F, LAS unsigned* tstart, int tid) {
    if (tid < 64) { const unsigned* cntg = (const unsigned*)(F.ctl + CW_CNT); unsigned c = (tid < NE) ? cntg[tid * CNT_STRIDE] : 0u; if (c > (unsigned)T) c = (unsigned)T;
        unsigned x = (c + 255u) >> 8;
#pragma unroll
        for (int o = 1; o < 32; o <<= 1) { const unsigned y = __shfl_up(x, o); if ((tid & 63) >= o) x += y; }
        if (tid < NE) tstart[tid + 1] = x; if (tid == 0) tstart[0] = 0u; }
}
constexpr int MAXU = 17;
constexpr int XT_TSTART = 0, XT_ULIST = 256, XT_RS = 512, XT_GTAB = XT_RS + MAXU * 1024;
static_assert(XT_GTAB + MAXU * 512 <= LDSCTL_OFF - XTAB_OFF, "xtab");
__device__ __forceinline__ int moe_build_tables(const Frame& F, int P  , int mode) {
    PHASE_IDS;
    LAS unsigned* tstart = (LAS unsigned*)(F.lds + XTAB_OFF + XT_TSTART);
    LAS unsigned* ulist = (LAS unsigned*)(F.lds + XTAB_OFF + XT_ULIST);
    LAS float* rs = (LAS float*)(F.lds + XTAB_OFF + XT_RS);
    LAS unsigned short* gtab = (LAS unsigned short*)(F.lds + XTAB_OFF + XT_GTAB);
    const unsigned* cntg = (const unsigned*)(F.ctl + CW_CNT); const unsigned* IDX = wsp<unsigned>(F, WS_IDX);
    const float* RSRC = mode == 1 ? wsp<float>(F, WS_RSS) : wsp<float>(F, WS_GSS);
    const int tid = TID_;
    build_tstart(F, tstart, tid);
    __syncthreads();
    const int NT_ = (int)tstart[NE], U = NT_ * P, G = F.G, c = (int)blockIdx.x;
    int nunits = (c < U) ? (U - c + G - 1) / G : 0; if (nunits > MAXU) nunits = MAXU;
    if (tid < nunits) { const int L = tid * G + c; int gt, pn; pg8::flat_to_tile(L, U, NT_, P, gt, pn);
        int e = 0; for (int k = 1; k < NE; ++k) if ((unsigned)gt >= tstart[k]) e = k;
        const int rt = gt - (int)tstart[e];
        ulist[tid] = (unsigned)gt | ((unsigned)pn << 10) | ((unsigned)e << 13) | ((unsigned)rt << 18); }
    __syncthreads();
    {
        constexpr int NP = (MAXU + 1) / 2; unsigned tokv[NP]; float rsv[NP];
#pragma unroll
        for (int p = 0; p < NP; ++p) { const int i = 2 * p + (tid >> 8), r = tid & 255; tokv[p] = 0u; rsv[p] = 0.f;
            if (i < nunits) { const unsigned w = ulist[i]; const int e = (int)((w >> 13) & 0x1fu), rt = (int)(w >> 18);
                unsigned cn = cntg[e * CNT_STRIDE]; if (cn > (unsigned)T) cn = (unsigned)T; const unsigned slot = (unsigned)rt * 256u + (unsigned)r;
                if (slot < cn) { if (mode == 1) tokv[p] = IDX[(size_t)e * T + slot]; rsv[p] = RSRC[(size_t)e * T + slot]; } } }
#pragma unroll
        for (int p = 0; p < NP; ++p) { const int i = 2 * p + (tid >> 8), r = tid & 255;
            if (i < nunits) { unsigned tok = tokv[p]; if (tok >= (unsigned)T) tok = 0u; if (mode == 1) gtab[i * 256 + r] = (unsigned short)tok; rs[i * 256 + r] = rsv[p]; } }
    }
    __syncthreads();
    return nunits;
}

__device__ __forceinline__ void p7_combine(const Frame& F) {
    PHASE_IDS;
    LAS unsigned* tstart = (LAS unsigned*)(F.lds + XTAB_OFF + XT_TSTART);
    const unsigned* cntg = (const unsigned*)(F.ctl + CW_CNT);
    build_tstart(F, tstart, TID_); (void)cntg;
    __syncthreads();
    const int gw = F.vcu * NWAVES + WAVE_, NGW = F.G * NWAVES;
    const unsigned* TOKPOS = wsp<unsigned>(F, WS_TOKPOS); const unsigned char* Y = wsp<unsigned char>(F, WS_YBUF); const bf16* X1 = wsp<bf16>(F, WS_X1B); bf16* X2 = wsp<bf16>(F, WS_X2B); unsigned char* X28 = wsp<unsigned char>(F, WS_X2F8); float* RS2 = wsp<float>(F, WS_RSTD2);
    for (int m0 = gw; m0 < T; m0 += 2 * NGW) {
        f32x4 v[2][4]; unsigned yv[2][4][4]; float s[2] = {0.f, 0.f};
#pragma unroll
        for (int r = 0; r < 2; ++r) { const int m = m0 + r * NGW;
            const v4u tp = *(const v4u*)(TOKPOS + (size_t)m * 4); const unsigned tpw[4] = {tp.x, tp.y, tp.z, tp.w};
            size_t yrow[4];
#pragma unroll
            for (int k = 0; k < 4; ++k) { const unsigned e = (tpw[k] >> 16) & 31u, slot = tpw[k] & 0xffffu; yrow[k] = ((size_t)tstart[e] * 256u + slot) * DM; }
#pragma unroll
            for (int j = 0; j < 4; ++j) { const v2u xw = *(const v2u*)(X1 + (size_t)m * DM + 4 * LANE_ + 256 * j); v[r][j] = (f32x4){bflo(xw.x), bfhi(xw.x), bflo(xw.y), bfhi(xw.y)};
#pragma unroll
                for (int k = 0; k < 4; ++k) yv[r][j][k] = *(const unsigned*)(Y + yrow[k] + 4 * LANE_ + 256 * j); } }
#pragma unroll
        for (int r = 0; r < 2; ++r) {
#pragma unroll
            for (int j = 0; j < 4; ++j) {
#pragma unroll
                for (int k = 0; k < 4; ++k) { const unsigned w = yv[r][j][k]; const f32x2 lo = __builtin_amdgcn_cvt_pk_f32_fp8((int)w, false), hi2 = __builtin_amdgcn_cvt_pk_f32_fp8((int)w, true);
                    v[r][j][0] += lo[0] * (1.0f / Y_SCALE); v[r][j][1] += lo[1] * (1.0f / Y_SCALE); v[r][j][2] += hi2[0] * (1.0f / Y_SCALE); v[r][j][3] += hi2[1] * (1.0f / Y_SCALE); }
                s[r] += (v[r][j].x * v[r][j].x + v[r][j].y * v[r][j].y) + (v[r][j].z * v[r][j].z + v[r][j].w * v[r][j].w); } }
#pragma unroll
        for (int r = 0; r < 2; ++r) { const int m = m0 + r * NGW; const float rstd = 1.0f / sqrtf(wave_sum(s[r]) * (1.f / DM) + EPS);
            if (LANE_ == 0) RS2[m] = rstd;
#pragma unroll
            for (int j = 0; j < 4; ++j) { v2u w; w.x = cvt_pk_bf16(v[r][j].x, v[r][j].y); w.y = cvt_pk_bf16(v[r][j].z, v[r][j].w); *(v2u*)(X2 + (size_t)m * DM + 4 * LANE_ + 256 * j) = w;
                *(unsigned*)(X28 + (size_t)m * DM + 4 * LANE_ + 256 * j) = pk4_fp8(v[r][j].x, v[r][j].y, v[r][j].z, v[r][j].w); } }
    }
}

__device__ __forceinline__ void p9_final(const Frame& F) {
    PHASE_IDS;
    const int gw = F.vcu * NWAVES + WAVE_, NGW = F.G * NWAVES;
    const unsigned char* GATE = wsp<unsigned char>(F, WS_GATE); const unsigned char* PP = wsp<unsigned char>(F, WS_PP); const float* ssqpp = wsp<float>(F, WS_SSQPP);
    for (int m0 = gw; m0 < T; m0 += 2 * NGW) {
        f32x4 v[2][4]; unsigned gv[2][4], pv_[2][4]; f32x4 sq[2][4]; float s[2] = {0.f, 0.f};
#pragma unroll
        for (int r = 0; r < 2; ++r) { const int m = m0 + r * NGW; const bf16* x2r = wsp<bf16>(F, WS_X2B) + (size_t)m * DM;
#pragma unroll
            for (int q = 0; q < 4; ++q) sq[r][q] = *(const f32x4*)(ssqpp + (size_t)m * 16 + 4 * q);
#pragma unroll
            for (int j = 0; j < 4; ++j) { const int col = 4 * LANE_ + 256 * j; const v2u xw = *(const v2u*)(x2r + col); v[r][j] = (f32x4){bflo(xw.x), bfhi(xw.x), bflo(xw.y), bfhi(xw.y)};
                gv[r][j] = *(const unsigned*)(GATE + (size_t)m * DM + col); pv_[r][j] = *(const unsigned*)(PP + (size_t)m * DM + col); } }
#pragma unroll
        for (int r = 0; r < 2; ++r) { const f32x4 a = sq[r][0], b = sq[r][1], c = sq[r][2], d = sq[r][3];
            const float sp = ((a[0] + a[1]) + (a[2] + a[3])) + ((b[0] + b[1]) + (b[2] + b[3])) + ((c[0] + c[1]) + (c[2] + c[3])) + ((d[0] + d[1]) + (d[2] + d[3]));
            const float rpp = 1.0f / sqrtf(sp * (1.f / DM) + EPS);
#pragma unroll
            for (int j = 0; j < 4; ++j) { const int col = 4 * LANE_ + 256 * j; const f32x4 pg_ = *(const f32x4*)(F.ppn + col);
                const f32x2 g01 = __builtin_amdgcn_cvt_pk_f32_fp8((int)gv[r][j], false), g23 = __builtin_amdgcn_cvt_pk_f32_fp8((int)gv[r][j], true);
                const f32x2 p01 = __builtin_amdgcn_cvt_pk_f32_fp8((int)pv_[r][j], false), p23 = __builtin_amdgcn_cvt_pk_f32_fp8((int)pv_[r][j], true);
                const float rg = rpp * (1.0f / GATE_SCALE);
                v[r][j][0] += g01[0] * (p01[0] * rg * pg_[0]); v[r][j][1] += g01[1] * (p01[1] * rg * pg_[1]);
                v[r][j][2] += g23[0] * (p23[0] * rg * pg_[2]); v[r][j][3] += g23[1] * (p23[1] * rg * pg_[3]);
                s[r] += (v[r][j].x * v[r][j].x + v[r][j].y * v[r][j].y) + (v[r][j].z * v[r][j].z + v[r][j].w * v[r][j].w); } }
#pragma unroll
        for (int r = 0; r < 2; ++r) { const int m = m0 + r * NGW; float* xr = F.out + (size_t)m * DM; const float rstd = 1.0f / sqrtf(wave_sum(s[r]) * (1.f / DM) + EPS);
#pragma unroll
            for (int j = 0; j < 4; ++j) { const int col = 4 * LANE_ + 256 * j; const f32x4 fg = *(const f32x4*)(F.final_norm + col); __builtin_nontemporal_store(v[r][j] * rstd * fg, (f32x4*)(xr + col)); } }
    }
}

struct Args { const float* in[23]; float* out; unsigned char* ws; };
#if CHECK_STAGE
__device__ __forceinline__ unsigned hmix(unsigned z) { z ^= z >> 16; z *= 0x7feb352du; z ^= z >> 15; z *= 0x846ca68bu; z ^= z >> 16; return z; }
__device__ __forceinline__ void chk_add(const Frame& F, int st, bool bad) { atomicAdd((unsigned*)(F.ctl + CW_CHK + 2 * st), bad ? 1u : 0u); atomicAdd((unsigned*)(F.ctl + CW_CHK + 2 * st + 1), 1u); }
__device__ __forceinline__ bool offby(float got, float ex, float rel, float ab) { const float d = fabsf(got - ex); return !(d <= rel * fabsf(ex) + ab); }
__device__ __forceinline__ float dot_bf(const bf16* a, const bf16* b, int n) { float s = 0.f; for (int k = 0; k < n; ++k) s += bf2f(a[k]) * bf2f(b[k]); return s; }
__device__ __forceinline__ float gelu_ref(float v) { return 0.5f * v * (1.0f + erff(v * 0.70710678f)); }
__device__ __forceinline__ unsigned chk_tstart(const Frame& F, unsigned ex) { const unsigned* cntg = (const unsigned*)(F.ctl + CW_CNT); unsigned s_ = 0; for (unsigned e = 0; e < ex; ++e) { unsigned c = cntg[e * CNT_STRIDE]; if (c > (unsigned)T) c = T; s_ += (c + 255u) >> 8; } return s_; }
template <int ST> __device__ __forceinline__ void stage_check(const Frame& F) {
    const unsigned gt = (unsigned)blockIdx.x * NTHR + threadIdx.x;
    const unsigned h0 = hmix(gt * 2654435761u + ST * 40503u), h1 = hmix(h0 + 0x9e3779b9u), h2 = hmix(h1 + 0x85ebca6bu);
    if (ST == 1) {
        if (gt >= 16384) return;
        const int which = gt & 7;
        if (which == 0) { const int e = h0 % NE, n = h1 % (2 * FF), k = h2 % DM; const int lc = CmWgu()(n);
            const float ex = bf2f((bf16)f2bf(F.w_gu[((size_t)e * DM + k) * 2 * FF + lc] * F.ffn_norm[k])); chk_add(F, ST, offby(bf2f(wsp<bf16>(F, WS_WGU)[((size_t)e * 2 * FF + n) * DM + k]), ex, 1e-6f, 1e-30f)); }
        else if (which == 1) { const int e = h0 % NE, n = h1 % DM, k = h2 % FF;
            const float ex = bf2f((bf16)f2bf(F.w_dn[((size_t)e * FF + k) * DM + n])); chk_add(F, ST, offby(bf2f(wsp<bf16>(F, WS_WDN)[((size_t)e * DM + n) * FF + k]), ex, 1e-6f, 1e-30f)); }
        else if (which == 2) { const int n = h1 % NPROJ, k = h2 % DM; const int lc = CmWin()(n);
            const float ex = bf2f((bf16)f2bf(F.w_in[(size_t)k * NPROJ + lc] * F.mix_norm[k])); chk_add(F, ST, offby(bf2f(wsp<bf16>(F, WS_WIN)[(size_t)n * DM + k]), ex, 1e-6f, 1e-30f)); }
        else if (which == 3) { const int n = h1 % DM, k = h2 % DM; const float g = k < AW ? F.aon[k] : F.gon[k - AW];
            const float ex = bf2f((bf16)f2bf(F.w_out[(size_t)k * DM + n] * g)); chk_add(F, ST, offby(bf2f(wsp<bf16>(F, WS_WOUT)[(size_t)n * DM + k]), ex, 1e-6f, 1e-30f)); }
        else if (which == 4) { const int n = h1 % DM, k = h2 % DM;
            const float ex = bf2f((bf16)f2bf(F.w_pg[(size_t)k * DM + n] * F.ple_norm[k])); chk_add(F, ST, offby(bf2f(wsp<bf16>(F, WS_WPG)[(size_t)n * DM + k]), ex, 1e-6f, 1e-30f)); }
        else if (which == 5) { const int n = h1 % DM, k = h2 % PLE;
            const float ex = bf2f((bf16)f2bf(F.w_pp[(size_t)k * DM + n])); chk_add(F, ST, offby(bf2f(wsp<bf16>(F, WS_WPP)[(size_t)n * PLE + k]), ex, 1e-6f, 1e-30f)); }
        else if (which == 6) { const int row = h0 % T, k = h1 % DM; float ss = 0.f; for (int j = 0; j < DM; ++j) { const float v = F.x[(size_t)row * DM + j]; ss += v * v; }
            const float ex = F.x[(size_t)row * DM + k] / sqrtf(ss / DM + EPS); chk_add(F, ST, offby(bf2f(wsp<bf16>(F, WS_XNB)[(size_t)row * DM + k]), ex, 0.01f, 1e-3f)); }
        else { const int row = h0 % T, k = h1 % PLE; chk_add(F, ST, offby(bf2f(wsp<bf16>(F, WS_PB)[(size_t)row * PLE + k]), F.p[(size_t)row * PLE + k], 0.005f, 1e-6f)); }
    }
    if (ST == 2) {
        if (gt >= 16384) return;
        const bf16* XN = wsp<bf16>(F, WS_XNB); const bf16* WIN = wsp<bf16>(F, WS_WIN);
        if ((gt & 7) == 7) {
            const int b = h0 % BATCH, hh = h1 % NH, blk = h2 % NBLK, c = (h2 >> 8) % HD; float s_ = 0.f;
            for (int r = 0; r < 256; ++r) s_ += bf2f(wsp<bf16>(F, WS_K)[((size_t)b * SEQ + blk * 256 + r) * AW + hh * HD + c]);
            chk_add(F, ST, offby(wsp<float>(F, WS_KMEAN)[((size_t)(b * NH + hh) * NBLK + blk) * HD + c], s_, 0.02f, 0.3f)); return; }
        const int row = h0 % T, type = h1 % 5, c = h2 % AW; const bf16* xr = XN + (size_t)row * DM;
        const float v = dot_bf(xr, WIN + (size_t)(type * AW + c) * DM, DM); float ex;
        if (type <= 1) { const float vp = dot_bf(xr, WIN + (size_t)(type * AW + (c ^ 4)) * DM, DM); const int i = 4 * ((c & 63) >> 3) + (c & 3), pos = row & (SEQ - 1);
            const float cs = wsp<float>(F, WS_ROPE)[pos * 32 + i], sn = wsp<float>(F, WS_ROPE)[SEQ * 32 + pos * 32 + i];
            { const float inv = powf(10000.0f, -(float)i / 32.0f); const float ang = (float)pos * inv; if (offby(cs, cosf(ang), 0.f, 1e-3f) || offby(sn, sinf(ang), 0.f, 1e-3f)) { chk_add(F, ST, true); return; } }
            ex = (c & 4) ? v * cs + vp * sn : v * cs - vp * sn; }
        else if (type == 2) ex = v; else ex = gelu_ref(v);
        chk_add(F, ST, offby(bf2f(wsp<bf16>(F, WS_Q)[(size_t)type * (16u << 20) + (size_t)row * AW + c]), ex, 0.02f, 0.02f));
    }
    if (ST == 3) {
        if (gt >= 8192) return;
        if (gt & 1) {
            const int row = h0 % T, g = h1 % GG, d = h2 % GD; const int b = row / SEQ, s_ = row % SEQ, c = s_ / GC, t = s_ % GC; float acc = 0.f;
            for (int sp = 0; sp <= t; ++sp) { const bf16* vr = wsp<bf16>(F, WS_VG) + ((size_t)b * SEQ + c * GC + sp) * GW + g * GD; float mu = 0.f; for (int j = 0; j < GD; ++j) mu += bf2f(vr[j]); mu /= GD;
                float var = 0.f; for (int j = 0; j < GD; ++j) { const float dd = bf2f(vr[j]) - mu; var += dd * dd; } const float rstd = 1.0f / sqrtf(var / GD + EPS);
                const float vn = bf2f((bf16)f2bf((bf2f(vr[d]) - mu) * rstd * F.ln_g[g * GD + d] + F.ln_b[g * GD + d])); acc += bf2f((bf16)f2bf(F.gws[((size_t)g * GC + t) * GC + sp])) * vn; }
            const float ex = bf2f(wsp<bf16>(F, WS_U)[(size_t)row * GW + g * GD + d]) * (acc + F.gbs[g * GC + t]);
            chk_add(F, ST, offby(bf2f(wsp<bf16>(F, WS_MIX)[(size_t)row * DM + AW + g * GD + d]), ex, 0.03f, 0.02f)); return; }
        const int row = h0 % T, hh = h1 % NH; const int b = row / SEQ, s_ = row % SEQ, qb = s_ / MOBA; float q[HD];
#pragma unroll
        for (int c = 0; c < HD; ++c) q[c] = bf2f(wsp<bf16>(F, WS_Q)[(size_t)row * AW + hh * HD + c]);
        unsigned sel = 0u;
        if (qb <= 3) sel = (1u << qb) - 1u;
        else { float b0 = -__builtin_inff(), b1 = b0, b2 = b0; int i0 = 0, i1 = 0, i2 = 0;
            for (int j = 0; j < qb; ++j) { const float* km = wsp<float>(F, WS_KMEAN) + ((size_t)(b * NH + hh) * NBLK + j) * HD; float g = 0.f;
#pragma unroll
                for (int c = 0; c < HD; ++c) g += q[c] * km[c];
                if (g > b0) { b2 = b1; i2 = i1; b1 = b0; i1 = i0; b0 = g; i0 = j; } else if (g > b1) { b2 = b1; i2 = i1; b1 = g; i1 = j; } else if (g > b2) { b2 = g; i2 = j; } }
            sel = (1u << i0) | (1u << i1) | (1u << i2); }
        float mx = -__builtin_inff();
        for (int kp = 0; kp <= s_; ++kp) { const int blk = kp / MOBA; if (blk != qb && !((sel >> blk) & 1u)) continue; const bf16* kr = wsp<bf16>(F, WS_K) + ((size_t)b * SEQ + kp) * AW + hh * HD; float sc = 0.f;
#pragma unroll
            for (int c = 0; c < HD; ++c) sc += q[c] * bf2f(kr[c]);
            mx = fmaxf(mx, sc * 0.125f); }
        float o[HD]; float l = 0.f;
#pragma unroll
        for (int c = 0; c < HD; ++c) o[c] = 0.f;
        for (int kp = 0; kp <= s_; ++kp) { const int blk = kp / MOBA; if (blk != qb && !((sel >> blk) & 1u)) continue; const bf16* kr = wsp<bf16>(F, WS_K) + ((size_t)b * SEQ + kp) * AW + hh * HD; float sc = 0.f;
#pragma unroll
            for (int c = 0; c < HD; ++c) sc += q[c] * bf2f(kr[c]);
            const float pr = expf(sc * 0.125f - mx); l += pr; const bf16* vr = wsp<bf16>(F, WS_V) + ((size_t)b * SEQ + kp) * AW + hh * HD;
#pragma unroll
            for (int c = 0; c < HD; ++c) o[c] += pr * bf2f(vr[c]); }
        bool bad = false; float ss = 0.f;
#pragma unroll
        for (int c = 0; c < HD; ++c) { const float ex = o[c] / l; ss += ex * ex; bad |= offby(bf2f(wsp<bf16>(F, WS_MIX)[(size_t)row * DM + hh * HD + c]), ex, 0.04f, 0.02f); }
        bad |= offby(wsp<float>(F, WS_SSQA)[(size_t)row * NH + hh], ss, 0.03f, 1e-3f);
        chk_add(F, ST, bad);
    }
    if (ST == 4) {
        if (gt >= 16384) return;
        const int row = h0 % T, col = h1 % DM; const bf16* mr = wsp<bf16>(F, WS_MIX) + (size_t)row * DM; const bf16* wr_ = wsp<bf16>(F, WS_WOUT) + (size_t)col * DM;
        float sa = 0.f, sg = 0.f, da = 0.f, dg = 0.f;
        for (int k = 0; k < AW; ++k) { const float a = bf2f(mr[k]), g = bf2f(mr[AW + k]); sa += a * a; sg += g * g; da += a * bf2f(wr_[k]); dg += g * bf2f(wr_[AW + k]); }
        const float ex = F.x[(size_t)row * DM + col] + da / sqrtf(sa / AW + EPS) + dg / sqrtf(sg / GW + EPS);
        chk_add(F, ST, offby(F.out[(size_t)row * DM + col], ex, 0.01f, 0.03f));
    }
    if (ST == 5) {
        if (gt >= 8192) return;
        const int tok = h0 % T; const float* xr = F.out + (size_t)tok * DM; float ss = 0.f; for (int k = 0; k < DM; ++k) ss += xr[k] * xr[k]; const float rstd = 1.0f / sqrtf(ss / DM + EPS);
        bool bad = false;
        for (int j = 0; j < 4; ++j) { const int k = (h1 >> (8 * j)) % DM; bad |= offby(bf2f(wsp<bf16>(F, WS_XNB)[(size_t)tok * DM + k]), xr[k] * rstd, 0.01f, 1e-3f); }
        float lg[NE];
#pragma unroll
        for (int e = 0; e < NE; ++e) lg[e] = 0.f;
        for (int k = 0; k < DM; ++k) { const float xv = xr[k] * rstd * F.ffn_norm[k];
#pragma unroll
            for (int e = 0; e < NE; ++e) lg[e] += xv * F.router_w[k * NE + e]; }
#pragma unroll
        for (int e = 0; e < NE; ++e) lg[e] += F.router_b[e];
        int te[4]; float tv[4]; unsigned used = 0u;
#pragma unroll
        for (int k = 0; k < 4; ++k) { float best = -__builtin_inff(); int bi = 0;
#pragma unroll
            for (int e = 0; e < NE; ++e) if (!((used >> e) & 1u) && lg[e] > best) { best = lg[e]; bi = e; }
            used |= 1u << bi; te[k] = bi; tv[k] = best; }
        { float gg[4]; float den = 0.f;
#pragma unroll
          for (int k = 0; k < 4; ++k) { float v = -__builtin_inff();
#pragma unroll
              for (int e = 0; e < NE; ++e) if (e == te[k]) v = lg[e];
              gg[k] = v; }
          const float mm = gg[0];
#pragma unroll
          for (int k = 0; k < 4; ++k) { gg[k] = expf(gg[k] - mm); den += gg[k]; }
          const unsigned* tp = wsp<unsigned>(F, WS_TOKPOS) + (size_t)tok * 4;
#pragma unroll
          for (int k = 0; k < 4; ++k) { const unsigned e = tp[k] >> 16, slot = tp[k] & 0xffffu; bad |= (e != (unsigned)te[k]);
              if (e < NE && slot < (unsigned)T) { bad |= wsp<unsigned>(F, WS_IDX)[(size_t)e * T + slot] != (unsigned)tok; bad |= offby(wsp<float>(F, WS_GSS)[(size_t)e * T + slot], gg[k] / den, 2e-3f, 1e-5f);
                  bad |= slot >= ((const unsigned*)(F.ctl + CW_CNT))[e * CNT_STRIDE]; } else bad = true; } }
        (void)tv;
        chk_add(F, ST, bad);
    }
    if (ST == 6 || ST == 7) {
        if (gt >= 16384) return;
        const int tok = h0 % T, k = h1 & 3, col = (h1 >> 2) % FF; const unsigned tp = wsp<unsigned>(F, WS_TOKPOS)[(size_t)tok * 4 + k]; const unsigned e = tp >> 16, slot = tp & 0xffffu;
        if (e >= NE) { chk_add(F, ST, true); return; }
        const unsigned tse = chk_tstart(F, e);
        const size_t row = (size_t)tse * 256 + slot;
        if (ST == 6) { const bf16* xr = wsp<bf16>(F, WS_XNB) + (size_t)tok * DM; const int np = (col >> 7) * 256 + (col & 127);
            const float g = dot_bf(xr, wsp<bf16>(F, WS_WGU) + ((size_t)e * 2 * FF + np) * DM, DM) + F.b_gu[(size_t)e * 2 * FF + col];
            const float l = dot_bf(xr, wsp<bf16>(F, WS_WGU) + ((size_t)e * 2 * FF + np + 128) * DM, DM) + F.b_gu[(size_t)e * 2 * FF + FF + col];
            const float gc = fminf(g, 7.f), lc = fminf(fmaxf(l, -7.f), 7.f); const float ex = gc / (1.0f + expf(-1.702f * gc)) * (lc + 1.0f);
            chk_add(F, ST, offby(bf2f(wsp<bf16>(F, WS_ABUF)[row * FF + col]), ex, 0.03f, 0.03f)); }
        else { const float d = dot_bf(wsp<bf16>(F, WS_ABUF) + row * FF, wsp<bf16>(F, WS_WDN) + ((size_t)e * DM + col) * FF, FF) + F.b_dn[(size_t)e * DM + col];
            const float ex = d * wsp<float>(F, WS_GSS)[(size_t)e * T + slot];
            chk_add(F, ST, offby(bf2f(wsp<bf16>(F, WS_YBUF)[row * DM + col]), ex, 0.03f, 0.01f)); }
    }
    if (ST == 8) {
        if (gt >= 8192) return;
        const int tok = h0 % T; const float* xr = F.out + (size_t)tok * DM; float ss = 0.f; for (int k = 0; k < DM; ++k) ss += xr[k] * xr[k]; const float rstd = 1.0f / sqrtf(ss / DM + EPS);
        bool bad = false; for (int k = 0; k < DM; ++k) { bad |= offby(bf2f(wsp<bf16>(F, WS_X2N)[(size_t)tok * DM + k]), xr[k] * rstd, 0.01f, 1e-3f); bad |= !(fabsf(xr[k]) < 30.f); }
        chk_add(F, ST, bad);
    }
    if (ST == 9) {
        if (gt >= 16384) return;
        const int row = h0 % T, col = h1 % DM;
        if (gt & 1) { const float d = dot_bf(wsp<bf16>(F, WS_X2N) + (size_t)row * DM, wsp<bf16>(F, WS_WPG) + (size_t)col * DM, DM); const float got = bf2f(wsp<bf16>(F, WS_GATE)[(size_t)row * DM + col]); const float ex = 1.0f / (1.0f + expf(-d)); const bool bad = offby(got, ex, 0.02f, 0.01f); chk_add(F, ST, bad);
            if (bad) { atomicOr((unsigned*)(F.ctl + CW_CHK + 40), 1u << ((col >> 3) & 31)); atomicOr((unsigned*)(F.ctl + CW_CHK + 41), 1u << ((row >> 3) & 31)); atomicOr((unsigned*)(F.ctl + CW_CHK + 42), 1u << (col & 7)); atomicOr((unsigned*)(F.ctl + CW_CHK + 43), 1u << (row & 7));
                if (!(got >= 0.f && got <= 1.f)) atomicAdd((unsigned*)(F.ctl + CW_CHK + 44), 1u); { int cl = (int)floorf(log2f(fabsf(got) + 1e-30f)) + 40; cl = cl < 0 ? 0 : (cl > 80 ? 80 : cl); atomicMax((unsigned*)(F.ctl + CW_CHK + 46), (unsigned)cl); atomicMin((unsigned*)(F.ctl + CW_CHK + 47), 0xffffffffu - (unsigned)cl); if (got < 0.f) atomicAdd((unsigned*)(F.ctl + CW_CHK + 48), 1u); } if (fabsf(got - ex) > 0.2f) atomicAdd((unsigned*)(F.ctl + CW_CHK + 45), 1u); } }
        else { const float d = dot_bf(wsp<bf16>(F, WS_PB) + (size_t)row * PLE, wsp<bf16>(F, WS_WPP) + (size_t)col * PLE, PLE); chk_add(F, 10, offby(bf2f(wsp<bf16>(F, WS_PP)[(size_t)row * DM + col]), d, 0.02f, 0.02f)); }
    }
}
__device__ __forceinline__ void check_report(const Frame& F) {
    float c2 = 3.0f;
    for (int st = 1; st <= 10; ++st) { const unsigned bad = F.ctl[CW_CHK + 2 * st], tot = F.ctl[CW_CHK + 2 * st + 1]; const float fr = tot ? (float)bad / (float)tot : 1.0f;
        (void)fr; if (((CHECK_SKIP >> st) & 1) == 0 && bad >= 1u) { c2 = powf(10.0f, (float)st) * (1.0f + fminf((float)bad, 80.0f) * 0.1f); break; } }
#if CHECK_REPORT >= 40
    { unsigned v = F.ctl[CW_CHK + CHECK_REPORT]; if (CHECK_REPORT == 47) v = 0xffffffffu - v; c2 = powf(10.0f, (float)(v >> 27)) * (1.0f + (float)((v >> 21) & 63u) * 0.1f);
#if CHECK_REPORT2
      c2 = powf(10.0f, (float)((v >> 16) & 31u)) * (1.0f + (float)((v >> 10) & 63u) * 0.1f);
#endif
#if CHECK_REPORT3
      c2 = powf(10.0f, (float)((v >> 5) & 31u)) * (1.0f + (float)(v & 31u) * 0.1f);
#endif
      if (CHECK_REPORT >= 46 && CHECK_REPORT <= 47) c2 = powf(10.0f, (float)(v / 9u)) * (1.0f + (float)(v % 9u));
    }
#endif
    if (g_gridbar[XB_TMO] != 0u) c2 = 1e20f;
    const float c = sqrtf(c2);
    for (size_t i = (size_t)blockIdx.x * NTHR + threadIdx.x; i < (size_t)T * DM; i += (size_t)gridDim.x * NTHR) F.out[i] = c;
}
#define STAGE_CHECK(n) stage_check<(n)>(F)
#else
#define STAGE_CHECK(n) do {} while (0)
#endif

__global__ void __launch_bounds__(NTHR, 2) mega_fwd(Args args) {
    extern __shared__ __attribute__((aligned(16))) unsigned char lds_raw[];
    Frame F;
    F.lds = (LAS unsigned char*)lds_raw;
    F.MISC = (volatile LAS unsigned*)(F.lds + LDSCTL_OFF);
    F.G = gridDim.x; { const int bx = blockIdx.x; F.vcu = (F.G % 8 == 0) ? (bx % 8) * (F.G / 8) + bx / 8 : bx; }
    F.ws = args.ws; F.ctl = (gu32*)(args.ws + WS_CTL); F.out = args.out;
    F.x = args.in[0]; F.p = args.in[1]; F.mix_norm = args.in[2]; F.w_in = args.in[3]; F.ln_g = args.in[4]; F.ln_b = args.in[5]; F.gws = args.in[6]; F.gbs = args.in[7];
    F.aon = args.in[8]; F.gon = args.in[9]; F.w_out = args.in[10]; F.ffn_norm = args.in[11]; F.router_w = args.in[12]; F.router_b = args.in[13]; F.w_gu = args.in[14]; F.b_gu = args.in[15];
    F.w_dn = args.in[16]; F.b_dn = args.in[17]; F.ple_norm = args.in[18]; F.w_pg = args.in[19]; F.w_pp = args.in[20]; F.ppn = args.in[21]; F.final_norm = args.in[22];
    { PHASE_IDS; for (int u = TID_; u < 256; u += NTHR) ((LAS unsigned*)(F.lds + LDSCTL_OFF))[u] = 0u; }
    __syncthreads();
    XcdBarrier bar = xcd_barrier_post(g_gridbar, F.MISC + 8);
#define GRID_BAR() xcd_barrier(bar)
#define STAGE_END(n) do { STAGE_CHECK(n); if (TPROBE && blockIdx.x == 0 && threadIdx.x == 0) ((unsigned long long*)(F.ctl + CW_TS))[(n)] = __builtin_amdgcn_s_memrealtime(); } while (0)

    if (TPROBE && blockIdx.x == 0 && threadIdx.x == 0) ((unsigned long long*)(F.ctl + CW_TS))[0] = __builtin_amdgcn_s_memrealtime();
    for (int rep = 0; rep < (DUP_PHASE == 0 ? 2 : 1); ++rep) {
    if (PH(0)) p0_prologue(F);
    GRID_BAR(); }
    STAGE_END(1);
    if (PH(1)) { pg8::DenseSched S; S.init(wsp<bf16>(F, WS_XNB), wsp<bf16>(F, WS_WIN), T, NPROJ, DM, F.G, (int)blockIdx.x);
      float* RC = wsp<float>(F, WS_ROPE);
      EpiInProj E{wsp<bf16>(F, WS_Q), RC, RC + SEQ * 32, wsp<float>(F, WS_KMEAN)};
      for (int rep = 0; rep < (DUP_PHASE == 1 ? 2 : 1); ++rep) { if (rep) GRID_BAR();
      pg8::gemm_phase<EpiInProj, pg8::DenseSched, false, false>(F.lds + RING_OFF, DM * 2, S, E); } }
    GRID_BAR();
    STAGE_END(2);
    for (int rep = 0; rep < (DUP_PHASE == 2 ? 2 : 1); ++rep) {
    if (PH(2)) p2_mixers(F);
    GRID_BAR(); }
    STAGE_END(3);
    if (PH(3)) { pg8::DenseSched S; S.init(wsp<bf16>(F, WS_MIX), wsp<bf16>(F, WS_WOUT), T, DM, DM, F.G, (int)blockIdx.x);
      LAS f32x4* rtab = (LAS f32x4*)(F.lds + XTAB_OFF);
      Unit ua, ub; const bool ha = S.next(0, ua), hb = S.next(1, ub);
      { PHASE_IDS; const int s = TID_ >> 8, r = TID_ & 255; const bool has = s ? hb : ha; const int pm = s ? ub.pm : ua.pm;
        if (has) { const size_t row = (size_t)pm * 256 + r; const f32x4* pa = (const f32x4*)(wsp<float>(F, WS_SSQA) + row * NH); const f32x4 a0 = pa[0], a1 = pa[1], g0 = *(const f32x4*)(wsp<float>(F, WS_SSQG) + row * GG);
            const float sa = ((a0[0] + a0[1]) + (a0[2] + a0[3])) + ((a1[0] + a1[1]) + (a1[2] + a1[3])), sg = (g0[0] + g0[1]) + (g0[2] + g0[3]);
            const float ra = 1.0f / sqrtf(sa * (1.f / AW) + EPS), rg = 1.0f / sqrtf(sg * (1.f / GW) + EPS);
            rtab[s * 256 + r] = (f32x4){ra / rg, rg, wsp<float>(F, WS_SIG0)[row], 0.f}; } }
      __syncthreads();
      EpiOutProj E{wsp<bf16>(F, WS_XNB), wsp<bf16>(F, WS_X1B), wsp<unsigned char>(F, WS_X1F8), wsp<float>(F, WS_SSQ1), rtab, F.ffn_norm, ha ? ua.pm : -1, hb ? ub.pm : -1};
      for (int rep = 0; rep < (DUP_PHASE == 3 ? 2 : 1); ++rep) { if (rep) GRID_BAR();
      pg8::gemm_phase<EpiOutProj, pg8::DenseSched, false, true>(F.lds + RING_OFF, DM * 2, S, E); } }
    GRID_BAR();
    STAGE_END(4);
    if (PH(4)) p4_router(F);
    GRID_BAR();
    STAGE_END(5);
    if (PH(5)) { const int nu = moe_build_tables(F, 2 * FF / 256, 1);
      pg8::MoeSched S{(const char*)wsp<char>(F, WS_X1F8), (const char*)wsp<char>(F, WS_WGU), 0, (size_t)2 * FF * DM, (size_t)256 * DM, nu,
                      (const LAS unsigned*)(F.lds + XTAB_OFF + XT_ULIST), (const LAS unsigned*)(F.lds + XTAB_OFF + XT_GTAB), true};
      EpiMoe1 E{wsp<unsigned char>(F, WS_ABUF), F.b_gu, (const LAS float*)(F.lds + XTAB_OFF + XT_RS)};
      for (int rep = 0; rep < (DUP_PHASE == 5 ? 2 : 1); ++rep) { if (rep) GRID_BAR();
      int Kb = DM; asm volatile("" : "+s"(Kb));
      pg8::gemm_phase<EpiMoe1, pg8::MoeSched, true, false, true>(F.lds + RING_OFF, Kb, S, E); } }
    GRID_BAR();
    STAGE_END(6);
    if (PH(6)) { const int nu = moe_build_tables(F, DM / 256, 2);
      pg8::MoeSched S{(const char*)wsp<char>(F, WS_ABUF), (const char*)wsp<char>(F, WS_WDN), (size_t)256 * FF, (size_t)DM * FF, (size_t)256 * FF, nu,
                      (const LAS unsigned*)(F.lds + XTAB_OFF + XT_ULIST), (const LAS unsigned*)(F.lds + XTAB_OFF + XT_GTAB), false};
      EpiMoe2 E{wsp<unsigned char>(F, WS_YBUF), F.b_dn, (const LAS float*)(F.lds + XTAB_OFF + XT_RS)};
      for (int rep = 0; rep < (DUP_PHASE == 6 ? 2 : 1); ++rep) { if (rep) GRID_BAR();
      int Kb = FF; asm volatile("" : "+s"(Kb));
      pg8::gemm_phase<EpiMoe2, pg8::MoeSched, false, false, true>(F.lds + RING_OFF, Kb, S, E); } }
    GRID_BAR();
    STAGE_END(7);
    if (PH(7)) { const int first = (blockIdx.x >> 3) & 1;
#pragma unroll 1
      for (int step = 0; step < 2; ++step) {
          if ((step ^ first) == 0) { p7_combine(F); __syncthreads(); }
          else { pg8::DenseSched S; S.init(wsp<bf16>(F, WS_PB), wsp<bf16>(F, WS_WPP), T, DM, PLE, F.G, (int)blockIdx.x);
              EpiPle<1> E{wsp<unsigned char>(F, WS_PP), wsp<float>(F, WS_SSQPP), nullptr, -1};
              int Kp = PLE * 2; asm volatile("" : "+s"(Kp));
              pg8::gemm_phase<EpiPle<1>, pg8::DenseSched, false, false>(F.lds + RING_OFF, Kp, S, E); } } }
    GRID_BAR();
    STAGE_END(8);
    if (PH(8)) { pg8::DenseSched S; S.init(wsp<unsigned char>(F, WS_X2F8), wsp<unsigned char>(F, WS_WPG8), T, DM, DM, F.G, (int)blockIdx.x, 1);
      LAS float* rt2 = (LAS float*)(F.lds + XTAB_OFF); Unit ua, ub; const bool ha = S.next(0, ua), hb = S.next(1, ub);
      { PHASE_IDS; const int sl = TID_ >> 8, r = TID_ & 255; const bool has = sl ? hb : ha; const int pm = sl ? ub.pm : ua.pm; if (has) rt2[sl * 256 + r] = wsp<float>(F, WS_RSTD2)[(size_t)pm * 256 + r]; }
      __syncthreads();
      EpiPle<0> E{wsp<unsigned char>(F, WS_GATE), nullptr, rt2, ha ? ua.pm : -1};
      int Kb = DM; asm volatile("" : "+s"(Kb));
      pg8::gemm_phase<EpiPle<0>, pg8::DenseSched, false, false, true>(F.lds + RING_OFF, Kb, S, E);
#if CHECK_STAGE
      GRID_BAR();
      int Kb = DM; asm volatile("" : "+s"(Kb));
      pg8::gemm_phase<EpiPle<0>, pg8::DenseSched, false, false, true>(F.lds + RING_OFF, Kb, S, E);
#endif
    }
#if CHECK_STAGE
    GRID_BAR(); STAGE_CHECK(9);
#endif
    GRID_BAR();
    STAGE_END(9);
#if CHECK_STAGE
    GRID_BAR(); check_report(F);
#else
    if (PH(9)) p9_final(F);
#if TPROBE
    GRID_BAR();
    if (blockIdx.x == 0 && threadIdx.x == 0) { const unsigned long long* ts = (const unsigned long long*)(F.ctl + CW_TS); const unsigned long long t1 = (TP_A == 9) ? __builtin_amdgcn_s_memrealtime() : ts[(TP_A < 10 ? TP_A : 0) + 1];
        unsigned long long d = t1 - ts[TP_A < 10 ? TP_A : 0];
        if (TP_A == 20) d = ts[11] - ts[0]; if (TP_A == 21) d = ts[12] - ts[11]; if (TP_A == 22) d = ts[13] - ts[12]; if (TP_A == 23) d = ts[1] - ts[13]; if (TP_A == 24) d = ts[14] - ts[2]; if (TP_A == 25) d = ts[3] - ts[14];
        if (TP_A == 30) d = (__builtin_amdgcn_s_memrealtime() - ts[0]) / 8;
        F.out[0] += floorf((float)d * 0.01f * 0.125f + 0.5f) * 2.0f; }
#endif
#endif
    __syncthreads();
    if (threadIdx.x == 0) {
        if (xb_add(&g_gridbar[XB_DONE], 1u) == gridDim.x - 1u) {
#pragma unroll 1
            for (unsigned j = 0; j < 16; ++j) { __hip_atomic_store(&g_gridbar[XB_XCNT(j)], 0u, __ATOMIC_RELAXED, __HIP_MEMORY_SCOPE_AGENT); __hip_atomic_store(&g_gridbar[XB_XSUB(j)], 0u, __ATOMIC_RELAXED, __HIP_MEMORY_SCOPE_AGENT);
                __hip_atomic_store(&g_gridbar[XB_XGEN(j)], 0u, __ATOMIC_RELAXED, __HIP_MEMORY_SCOPE_AGENT); }
            __hip_atomic_store(&g_gridbar[XB_TOP], 0u, __ATOMIC_RELAXED, __HIP_MEMORY_SCOPE_AGENT); __hip_atomic_store(&g_gridbar[XB_TOPGEN], 0u, __ATOMIC_RELAXED, __HIP_MEMORY_SCOPE_AGENT);
            __hip_atomic_store(&g_gridbar[XB_TMO], 0u, __ATOMIC_RELAXED, __HIP_MEMORY_SCOPE_AGENT); __hip_atomic_store(&g_gridbar[XB_DONE], 0u, __ATOMIC_RELAXED, __HIP_MEMORY_SCOPE_AGENT); } }
}

extern "C" void kernel_launch(void* const* d_in, const int* in_sizes, int n_in, void* d_out, int out_size, void* d_ws, size_t ws_size, hipStream_t stream) {
    static int grid = 0;
    if (grid == 0) {
        if (n_in != 23 || in_sizes[0] != T * DM || out_size != T * DM || ws_size < WS_END) { fprintf(stderr, "kernel_launch: unexpected shapes (n_in %d, in0 %d, out %d, ws %zu)\n", n_in, n_in > 0 ? in_sizes[0] : -1, out_size, ws_size); grid = -1; return; }
        int dev = 0, cus = 0, per_cu = 0;
        if (hipGetDevice(&dev) != hipSuccess || hipDeviceGetAttribute(&cus, hipDeviceAttributeMultiprocessorCount, dev) != hipSuccess) { grid = -1; return; }
        if (hipFuncSetAttribute((const void*)mega_fwd, hipFuncAttributeMaxDynamicSharedMemorySize, LDS_BYTES) != hipSuccess) { fprintf(stderr, "kernel_launch: hipFuncSetAttribute failed\n"); grid = -1; return; }
        if (hipOccupancyMaxActiveBlocksPerMultiprocessor(&per_cu, (const void*)mega_fwd, NTHR, LDS_BYTES) != hipSuccess || per_cu < 1)
            fprintf(stderr, "kernel_launch: note: occupancy query reports %d workgroups per CU\n", per_cu);
        (void)hipGetLastError();
        if (cus < 256) { fprintf(stderr, "kernel_launch: built for a 256-CU device (found %d CUs); nothing launched\n", cus); grid = -1; return; }
        grid = 256;
    }
    if (grid < 0) return;
    Args a{};
    for (int i = 0; i < 23; ++i) a.in[i] = (const float*)d_in[i];
    a.out = (float*)d_out; a.ws = (unsigned char*)d_ws;
    hipLaunchKernelGGL(mega_fwd, dim3(grid), dim3(NTHR), LDS_BYTES, stream, a);
}
```

```cpp
#include <hip/hip_runtime.h>
#include <cstdio>
#include <cstdint>

#ifndef CHECK_STAGE
#define CHECK_STAGE 0
#endif
#ifndef CHECK_REPORT
#define CHECK_REPORT 0
#endif
#ifndef CHECK_REPORT2
#define CHECK_REPORT2 0
#endif
#ifndef CHECK_REPORT3
#define CHECK_REPORT3 0
#endif
#ifndef DUP_PHASE
#define DUP_PHASE -1
#endif
#ifndef TPROBE
#define TPROBE 0
#endif
#ifndef TP_A
#define TP_A 5
#endif
#ifndef TP_B
#define TP_B 6
#endif
#ifndef CHECK_SKIP
#define CHECK_SKIP 0
#endif
#ifndef PHMASK
#define PHMASK 0x3ff
#endif
#define PH(n) ((PHMASK >> (n)) & 1)

#define GAS __attribute__((address_space(1)))
#define LAS __attribute__((address_space(3)))
typedef unsigned short bf16;
typedef unsigned v4u __attribute__((ext_vector_type(4)));
typedef unsigned v2u __attribute__((ext_vector_type(2)));
typedef float f32x2 __attribute__((ext_vector_type(2)));
typedef float f32x4 __attribute__((ext_vector_type(4)));
typedef float f32x16 __attribute__((ext_vector_type(16)));
typedef short bf16x8 __attribute__((ext_vector_type(8)));
typedef short s16x4 __attribute__((ext_vector_type(4)));
typedef GAS unsigned gu32;

constexpr int BATCH = 16, SEQ = 2048, DM = 1024, T = BATCH * SEQ;
constexpr int AW = 512, NH = 8, HD = 64, NBLK = 8, MOBA = 256;
constexpr int GW = 512, GG = 4, GD = 128, GC = 128;
constexpr int NPROJ = 3 * AW + 2 * GW;
constexpr int NE = 32, TOPK = 4, FF = 1024;
constexpr int PLE = 256;
constexpr int MAXROWS = T * TOPK + NE * 256;
constexpr float EPS = 1e-6f;
constexpr int NWAVES = 8, NTHR = 512;

constexpr size_t MiB = 1u << 20;
constexpr size_t WS_CTL = 0, CTL_ZERO_BYTES = 1 * MiB;
constexpr size_t WS_KMEAN = 256 * 1024;
constexpr size_t WS_WIN = 1 * MiB;
constexpr size_t WS_WIN8 = 3 * MiB;
constexpr size_t WS_XN8 = 176 * MiB;
constexpr size_t WS_WOUT = 6 * MiB;
constexpr size_t WS_WPG = 8 * MiB;
constexpr size_t WS_WPP = 10 * MiB;
constexpr size_t WS_RWG = 10 * MiB + 512 * 1024;
constexpr size_t WS_ROPE = 11 * MiB;
constexpr size_t WS_WGU = 16 * MiB;
constexpr size_t WS_WDN = 144 * MiB;
constexpr size_t WS_XNB = 208 * MiB;
constexpr size_t WS_BIG1 = 272 * MiB;
constexpr size_t WS_Q = WS_BIG1, WS_K = WS_Q + 32 * MiB, WS_V = WS_K + 32 * MiB, WS_U = WS_V + 32 * MiB, WS_VG = WS_U + 32 * MiB, WS_MIX = WS_VG + 32 * MiB;
constexpr size_t WS_YBUF = WS_BIG1;
constexpr size_t WS_BIG2 = 544 * MiB;
constexpr size_t WS_ABUF = WS_BIG2, WS_GATE = WS_BIG2, WS_PP = WS_BIG2 + 64 * MiB;
constexpr size_t WS_PB = 816 * MiB;
constexpr size_t WS_IDX = 832 * MiB;
constexpr size_t WS_GSS = 836 * MiB;
constexpr size_t WS_TOKPOS = 840 * MiB;
constexpr size_t WS_SSQA = 841 * MiB;
constexpr size_t WS_SSQG = 842 * MiB;
constexpr size_t WS_SSQ1 = 843 * MiB;
constexpr size_t WS_SSQPP = 845 * MiB;
constexpr size_t WS_X1F8 = 848 * MiB;
constexpr size_t WS_X2N = WS_XNB;
constexpr size_t WS_X1B = 880 * MiB;
constexpr size_t WS_X2B = 944 * MiB;
constexpr size_t WS_SIG0 = 1008 * MiB;
constexpr size_t WS_RSTD2 = 1008 * MiB + 256 * 1024;
constexpr size_t WS_RWT = 1008 * MiB + 512 * 1024;
constexpr size_t WS_RSS = 1009 * MiB;
constexpr size_t WS_X2F8 = 176 * MiB;
constexpr size_t WS_WPG8 = 80 * MiB;
constexpr size_t WS_END = 1013 * MiB;
static_assert(WS_MIX + 64 * MiB <= WS_BIG2 && (size_t)MAXROWS * 1024 * 2 <= 272 * MiB, "ws map");
constexpr int CW_TMO = 0, CW_CODE = 1;
constexpr int CW_BAR = 4096;
constexpr int CW_CNT = 8192, CNT_STRIDE = 32;
constexpr int CW_TS = 12000;
constexpr int CW_CHK = 12288;

constexpr int RING_OFF = 0, RING_BYTES = 131072;
constexpr int P0_SCR_WAVE = 64 * 65 * 4;
constexpr int LDS_BYTES_TOTAL = 163840;
constexpr int LDSCTL_OFF = LDS_BYTES_TOTAL - 1024;
constexpr int XTAB_OFF = RING_BYTES;
static_assert(8 * P0_SCR_WAVE <= LDSCTL_OFF && XTAB_OFF >= RING_BYTES, "lds map");
constexpr int LDS_BYTES = LDS_BYTES_TOTAL;

#define RLX_AGENT __ATOMIC_RELAXED, __HIP_MEMORY_SCOPE_AGENT
#define LDS_WAIT() asm volatile("s_waitcnt lgkmcnt(0)" ::: "memory")
#define VM_WAIT() asm volatile("s_waitcnt vmcnt(0)" ::: "memory")
__device__ __forceinline__ unsigned f2bf(float f) { unsigned u = __builtin_bit_cast(unsigned, f); return (u + 0x7fffu + ((u >> 16) & 1u)) >> 16; }
__device__ __forceinline__ unsigned pk2(float lo, float hi) { return f2bf(lo) | (f2bf(hi) << 16); }
__device__ __forceinline__ float bf2f(unsigned short b) { return __builtin_bit_cast(float, ((unsigned)b) << 16); }
__device__ __forceinline__ float bflo(unsigned w) { return __builtin_bit_cast(float, w << 16); }
__device__ __forceinline__ float bfhi(unsigned w) { return __builtin_bit_cast(float, w & 0xffff0000u); }
typedef __bf16 bf16x2_t __attribute__((ext_vector_type(2)));
__device__ __forceinline__ unsigned cvt_pk_bf16(float lo, float hi) { const f32x2 v = {lo, hi}; const bf16x2_t b = __builtin_convertvector(v, bf16x2_t); return __builtin_bit_cast(unsigned, b); }
__device__ __forceinline__ float clamp448(float x) { return fminf(fmaxf(x, -448.0f), 448.0f); }
__device__ __forceinline__ unsigned pk4_fp8(float a, float b, float c, float d) { unsigned w = 0u; w = (unsigned)__builtin_amdgcn_cvt_pk_fp8_f32(clamp448(a), clamp448(b), (int)w, false); w = (unsigned)__builtin_amdgcn_cvt_pk_fp8_f32(clamp448(c), clamp448(d), (int)w, true); return w; }
__device__ __forceinline__ unsigned pk4_fp8_nc(float a, float b, float c, float d) { unsigned w = 0u; w = (unsigned)__builtin_amdgcn_cvt_pk_fp8_f32(a, b, (int)w, false); w = (unsigned)__builtin_amdgcn_cvt_pk_fp8_f32(c, d, (int)w, true); return w; }
__device__ __forceinline__ float fp8_to_f(unsigned v) { const unsigned sg = (v >> 7) & 1u, e = (v >> 3) & 15u, m = v & 7u; const float r = e ? ldexpf(1.0f + (float)m * 0.125f, (int)e - 7) : ldexpf((float)m * 0.125f, -6); return sg ? -r : r; }
__device__ __forceinline__ float wave_sum(float v) {
#pragma unroll
    for (int o = 1; o < 64; o <<= 1) v += __shfl_xor(v, o);
    return v;
}
__device__ __forceinline__ f32x2 gelu_pk(f32x2 v) {
    const f32x2 av = __builtin_elementwise_abs(v), d = av * 0.2316418882f + 1.0f;
    f32x2 t; t.x = __builtin_amdgcn_rcpf(d.x); t.y = __builtin_amdgcn_rcpf(d.y);
    f32x2 q = t * 0.5307027145f + (-0.7265760135f); q = q * t + 0.7107068705f; q = q * t + (-0.142248368f); q = q * t + 0.127414796f; q = q * t;
    const f32x2 s = (v * v) * (-0.72134752044f);
    f32x2 e; e.x = __builtin_amdgcn_exp2f(s.x); e.y = __builtin_amdgcn_exp2f(s.y);
    const f32x2 m = v * (q * e), r = v - m;
    f32x2 o; o.x = v.x < 0.f ? m.x : r.x; o.y = v.y < 0.f ? m.y : r.y; return o;
}
__device__ __forceinline__ f32x4 gelu4(f32x4 v) { const f32x2 a = gelu_pk((f32x2){v[0], v[1]}), b = gelu_pk((f32x2){v[2], v[3]}); return (f32x4){a.x, a.y, b.x, b.y}; }
__device__ __forceinline__ float sigmoidf_fast(float x) { return __builtin_amdgcn_rcpf(1.0f + __builtin_amdgcn_exp2f(-1.4426950408889634f * x)); }

#define XB_TMO      128
#define XB_XCNT(j)  (256  + 64 * (j))
#define XB_XSUB(j)  (1280 + 64 * (j))
#define XB_XGEN(j)  (2304 + 64 * (j))
#define XB_TOP      3328
#define XB_TOPGEN   3392
#define XCD_BAR_WORDS 3456
#define XB_SPIN_CAP (1u << 18)
__device__ __forceinline__ unsigned xb_ld(unsigned* p)              { return __hip_atomic_load(p, __ATOMIC_RELAXED, __HIP_MEMORY_SCOPE_AGENT); }
__device__ __forceinline__ unsigned xb_add(unsigned* p, unsigned v) { return __hip_atomic_fetch_add(p, v, __ATOMIC_RELAXED, __HIP_MEMORY_SCOPE_AGENT); }
__device__ __forceinline__ unsigned xb_xcc_id() { return (unsigned)__builtin_amdgcn_s_getreg((3 << 11) | 20) & 0xFu; }
#define XB_SPIN(cond, bar) do { unsigned _sp = 0; while (cond) { __builtin_amdgcn_s_sleep(1); \
    if ((++_sp & 255u) == 0u) { if (xb_ld(&(bar)[XB_TMO])) break; if (_sp > XB_SPIN_CAP) { atomicAdd(&(bar)[XB_TMO], 1u); break; } } } } while (0)
#define XB_DONE     64
__device__ unsigned g_gridbar[4096];
struct XcdBarrier { unsigned* bar; unsigned x; volatile LAS unsigned* st; };
__device__ __forceinline__ XcdBarrier xcd_barrier_post(unsigned* bar, volatile LAS unsigned* st) {
    XcdBarrier b; b.bar = bar; b.x = xb_xcc_id(); b.st = st;
    if (threadIdx.x == 0) (void)xb_add(&bar[XB_XCNT(b.x)], 1u);
    return b;
}
__device__ __forceinline__ void xcd_barrier_complete(unsigned* bar, unsigned x, unsigned& nloc, unsigned& nx) {
    const unsigned G = gridDim.x * gridDim.y * gridDim.z;
    unsigned sum, cnt, mine, sp = 0u;
    for (;;) {
        sum = 0u; cnt = 0u; mine = 0u;
#pragma unroll
        for (unsigned j = 0; j < 16; ++j) { const unsigned c = xb_ld(&bar[XB_XCNT(j)]); sum += c; cnt += (c > 0u) ? 1u : 0u; mine = (j == x) ? c : mine; }
        if (sum == G) break;
        __builtin_amdgcn_s_sleep(1);
        if ((++sp & 255u) == 0u) { if (xb_ld(&bar[XB_TMO])) break; if (sp > XB_SPIN_CAP) { atomicAdd(&bar[XB_TMO], 1u); break; } }
    }
    nloc = mine > 0u ? mine : 1u; nx = cnt > 0u ? cnt : 1u;
}
__device__ __forceinline__ void xcd_barrier(const XcdBarrier& b) {
    asm volatile("s_waitcnt vmcnt(0)" ::: "memory");
    __syncthreads();
    if (threadIdx.x == 0) {
        unsigned* bar = b.bar;
        __builtin_amdgcn_s_waitcnt(0);
        unsigned nloc = b.st[0], nx = b.st[1];
        if (nloc == 0u) { xcd_barrier_complete(bar, b.x, nloc, nx); b.st[0] = nloc; b.st[1] = nx; }
        const unsigned old = xb_add(&bar[XB_XSUB(b.x)], 1u);
        const unsigned gen = old / nloc;
        if (old + 1u == (gen + 1u) * nloc) {
            __builtin_amdgcn_fence(__ATOMIC_RELEASE, "agent");
            asm volatile("s_waitcnt vmcnt(0)" ::: "memory");
            const unsigned og = xb_add(&bar[XB_TOP], 1u);
            const unsigned tg = og / nx;
            if (og + 1u == (tg + 1u) * nx) xb_add(&bar[XB_TOPGEN], 1u);
            else XB_SPIN(xb_ld(&bar[XB_TOPGEN]) == tg, bar);
            __builtin_amdgcn_fence(__ATOMIC_ACQUIRE, "agent");
            xb_add(&bar[XB_XGEN(b.x)], 1u);
            asm volatile("s_waitcnt vmcnt(0)" ::: "memory");
        } else {
            XB_SPIN(xb_ld(&bar[XB_XGEN(b.x)]) == gen, bar);
            __builtin_amdgcn_fence(__ATOMIC_ACQUIRE, "agent");
            asm volatile("s_waitcnt vmcnt(0)" ::: "memory");
        }
    }
    __syncthreads();
}

namespace pg8 {
constexpr int BM = 256, BK = 64, HALF = 128, HTB = HALF * BK * 2, STAGE_BYTES = 8 * HTB, NXCD = 8, WGM = 8;
__host__ __device__ __forceinline__ int lds_byte(int r, int c) { const int st = (r >> 4) * 2 + (c >> 5), rr = r & 15, cc = c & 31, ob = rr * 64 + cc * 2; return st * 1024 + (ob ^ (((ob >> 9) & 1) << 5)); }
__host__ __device__ __forceinline__ void stage_rc(int b, int& R, int& C) { const int st = b / 1024, sb = b % 1024, swz = sb ^ (((sb >> 9) & 1) << 5); R = (st >> 1) * 16 + swz / 64; C = (st & 1) * 32 + (swz % 64) / 2; }
__host__ __device__ __forceinline__ int perm32(int rho) { const int n = rho >> 4, i = rho & 15; return 8 * (i >> 2) + 4 * n + (i & 3); }

typedef int v8i __attribute__((ext_vector_type(8)));
constexpr int F8_WSHIFT = 6, F8_SCALE_W = 127 - F8_WSHIFT;
typedef int v4i __attribute__((ext_vector_type(4)));
__device__ __forceinline__ v8i ld8(const LAS unsigned char* p0, const LAS unsigned char* p1) { const v4i lo = *(const LAS v4i*)p0, hi = *(const LAS v4i*)p1; return __builtin_shufflevector(lo, hi, 0, 1, 2, 3, 4, 5, 6, 7); }
struct Unit { int pm, pn, e, rt, slot; };

__device__ __forceinline__ void flat_to_tile(int L, int nwg, int nM, int nN, int& pm, int& pn) {
    int wgid = L; { const int q = nwg / NXCD, r = nwg % NXCD, xcd = wgid % NXCD, off = wgid / NXCD; wgid = (xcd < r ? xcd * (q + 1) : r * (q + 1) + (xcd - r) * q) + off; }
    const int nig = WGM * nN, gid = wgid / nig, fm = gid * WGM, gsz = (nM - fm) < WGM ? (nM - fm) : WGM;
    pm = fm + ((wgid % nig) % gsz); pn = (wgid % nig) / gsz;
}
struct DenseSched {
    const char* A; const char* Bt; int nM, nN, nwg, G, c; size_t tstep;
    __device__ __forceinline__ void init(const void* A_, const void* Bt_, int M, int N, int K, int G_, int c_, int ebytes = 2) { A = (const char*)A_; Bt = (const char*)Bt_; nM = M / BM; nN = N / BM; nwg = nM * nN; G = G_; c = c_; tstep = (size_t)BM * K * ebytes; }
    __device__ __forceinline__ bool next(int i, Unit& u) const { const long L = (long)i * G + c; if (L >= nwg) return false; flat_to_tile((int)L, nwg, nM, nN, u.pm, u.pn); u.e = 0; u.rt = u.pm; u.slot = i; return true; }
    __device__ __forceinline__ const char* a_base(const Unit& u) const { return A + (size_t)u.pm * tstep; }
    __device__ __forceinline__ const char* b_base(const Unit& u) const { return Bt + (size_t)u.pn * tstep; }
    __device__ __forceinline__ void gather(int, int, int, unsigned (&)[2][2]) const {}
};
struct MoeSched {
    const char* A; const char* Bt; size_t a_tstep, b_estep, b_tstep; int nunits; const LAS unsigned* ulist; const LAS unsigned* gtab; bool gath;
    __device__ __forceinline__ bool next(int i, Unit& u) const {
        if (i >= nunits) return false;
        const unsigned w = (unsigned)__builtin_amdgcn_readfirstlane((int)ulist[i]);
        u.pm = (int)(w & 0x3ffu); u.pn = (int)((w >> 10) & 0x7u); u.e = (int)((w >> 13) & 0x1fu); u.rt = (int)(w >> 18); u.slot = i; return true;
    }
    __device__ __forceinline__ const char* a_base(const Unit& u) const { return gath ? A : A + (size_t)u.pm * a_tstep; }
    __device__ __forceinline__ const char* b_base(const Unit& u) const { return Bt + (size_t)u.e * b_estep + (size_t)u.pn * b_tstep; }
    __device__ __forceinline__ void gather(int i, int R0, int R1, unsigned (&off)[2][2]) const {
        const LAS unsigned short* g = (const LAS unsigned short*)gtab + i * 256;
        off[0][0] = (unsigned)g[R0] << 10; off[0][1] = (unsigned)g[R1] << 10; off[1][0] = (unsigned)g[128 + R0] << 10; off[1][1] = (unsigned)g[128 + R1] << 10;
    }
};

#define PG8_SA(b, h) (((b) * 2 + (h)) * HTB)
#define PG8_SB(b, h) ((4 + (b) * 2 + (h)) * HTB)
#define PG8_GLDS(src, dstoff) __builtin_amdgcn_global_load_lds((const unsigned*)(src), (LAS unsigned*)(lds + (dstoff)), 16, 0, 0)
#define PG8_STAGE_B(bufoff, gbase) do { _Pragma("unroll") for (int _i = 0; _i < 2; ++_i) PG8_GLDS((const char*)(gbase) + voffB[_i], (bufoff) + ldsw + _i * 8192); } while (0)
#define PG8_STAGE_A(bufoff, kptr, h, o) do { _Pragma("unroll") for (int _i = 0; _i < 2; ++_i) \
        PG8_GLDS(GATHER ? (const char*)(kptr) + (o)[h][_i] : (const char*)(kptr) + (size_t)(h) * hstep + voffA[_i], (bufoff) + ldsw + _i * 8192); } while (0)
#define PG8_LDA(dst, b, h) do { _Pragma("unroll") for (int m = 0; m < 4; ++m) { if constexpr (F8) dst##8[m] = ld8(lds + PG8_SA(b, h) + a8_0 + m * 2048, lds + PG8_SA(b, h) + a8_1 + m * 2048); \
        else { _Pragma("unroll") for (int k = 0; k < 2; ++k) dst[m][k] = *(const LAS bf16x8*)(lds + PG8_SA(b, h) + aoff + m * 2048 + k * 1024); } } } while (0)
#define PG8_LDB(dst, b, h) do { _Pragma("unroll") for (int n = 0; n < 2; ++n) { if constexpr (F8) dst##8[n] = ld8(lds + PG8_SB(b, h) + b8_0 + n * 2048, lds + PG8_SB(b, h) + b8_1 + n * 2048); \
        else { _Pragma("unroll") for (int k = 0; k < 2; ++k) dst[n][k] = *(const LAS bf16x8*)(lds + PG8_SB(b, h) + boff + n * 2048 + k * 1024); } } } while (0)
#define PG8_MMA(ai, bj, At, Bt) do { __builtin_amdgcn_s_setprio(1); _Pragma("unroll") for (int m = 0; m < 4; ++m) _Pragma("unroll") for (int n = 0; n < 2; ++n) { \
        if constexpr (F8) asm volatile("v_mfma_scale_f32_16x16x128_f8f6f4 %0, %1, %2, %0, %3, %4 op_sel_hi:[0,0,0]" : "+v"(acc[ai][bj][m][n]) : "v"(Bt##8[n]), "v"(At##8[m]), "v"(sc_w), "v"(sc_a)); \
        else { _Pragma("unroll") for (int k = 0; k < 2; ++k) acc[ai][bj][m][n] = __builtin_amdgcn_mfma_f32_16x16x32_bf16(Bt[n][k], At[m][k], acc[ai][bj][m][n], 0, 0, 0); } } __builtin_amdgcn_s_setprio(0); } while (0)
#define PG8_WAIT_V(n) asm volatile("s_waitcnt vmcnt(" #n ")" ::: "memory")
#define PG8_WAIT_L(n) asm volatile("s_waitcnt lgkmcnt(" #n ")" ::: "memory")
#define PG8_BAR __builtin_amdgcn_s_barrier()
#define PG8_SCHED __builtin_amdgcn_sched_barrier(0)

template <class Epi, class Sched, bool GATHER, bool MIDK, bool F8 = false>
__device__ __forceinline__ void gemm_phase(LAS unsigned char* lds, const int KB  , const Sched& S, const Epi& E) {
    int tid = (int)threadIdx.x; asm volatile("" : "+v"(tid));
    const int wid = __builtin_amdgcn_readfirstlane(tid >> 6), lane = tid & 63, wr = wid >> 2, wc = wid & 3, fr = lane & 15, fq = lane >> 4;
    const int nt = KB / 128;
    unsigned voffA[2], voffB[2]; int Rg[2]; unsigned Cg[2];
#pragma unroll
    for (int i = 0; i < 2; ++i) { int R, C; stage_rc(tid * 16 + i * 8192, R, C); const int Rb = Epi::PERM ? ((R & ~31) + perm32(R & 31)) : R;
        voffA[i] = (unsigned)(R * KB + C * 2); voffB[i] = (unsigned)(Rb * KB + C * 2); Rg[i] = R; Cg[i] = (unsigned)C * 2u; }
    const size_t kstep = 128;
    const size_t hstep = (size_t)HALF * KB;
    const unsigned ldsw = (unsigned)wid * 1024u;
    const int aoff = lds_byte(wr * 64 + fr, fq * 8), boff = lds_byte(wc * 32 + fr, fq * 8);
    const int a8_0 = aoff, a8_1 = aoff + 1024, b8_0 = boff, b8_1 = boff + 1024;
    Unit cur, nxt; int ui = 0;
    if (!S.next(0, cur)) return;
    f32x4 acc[2][2][4][2];
#pragma unroll
    for (int a = 0; a < 2; ++a)
#pragma unroll
        for (int b = 0; b < 2; ++b)
#pragma unroll
            for (int m = 0; m < 4; ++m)
#pragma unroll
                for (int n = 0; n < 2; ++n) acc[a][b][m][n] = (f32x4){0.f, 0.f, 0.f, 0.f};
    bf16x8 At[4][2], B0[2][2], B1[2][2]; v8i At8[4], B08[2], B18[2];
    int sc_w = F8_SCALE_W, sc_a = 127; if constexpr (F8) { asm volatile("" : "+v"(sc_w), "+v"(sc_a)); }
    unsigned offC[2][2] = {{0u, 0u}, {0u, 0u}}, offN[2][2] = {{0u, 0u}, {0u, 0u}};
    if constexpr (GATHER) { S.gather(0, Rg[0], Rg[1], offC);
#pragma unroll
        for (int h = 0; h < 2; ++h)
#pragma unroll
            for (int i = 0; i < 2; ++i) offC[h][i] += Cg[i]; }
    const char* cA = S.a_base(cur); const char* cB = S.b_base(cur);
    PG8_STAGE_B(PG8_SB(0, 0), cB); PG8_STAGE_B(PG8_SB(0, 1), cB + hstep); PG8_STAGE_A(PG8_SA(0, 0), cA, 0, offC); PG8_STAGE_A(PG8_SA(0, 1), cA, 1, offC);
    if (wr == 1) PG8_BAR;
    PG8_WAIT_V(2); PG8_BAR;
    PG8_STAGE_B(PG8_SB(1, 0), cB + kstep); PG8_STAGE_A(PG8_SA(1, 0), cA + kstep, 0, offC); PG8_STAGE_B(PG8_SB(1, 1), cB + hstep + kstep);
    PG8_WAIT_V(6); PG8_BAR;
    for (;;) {
        const bool has_next = S.next(ui + 1, nxt);
        const char* nA = has_next ? S.a_base(nxt) : cA; const char* nB = has_next ? S.b_base(nxt) : cB;
        if constexpr (GATHER) { if (has_next) { S.gather(ui + 1, Rg[0], Rg[1], offN);
#pragma unroll
                for (int h = 0; h < 2; ++h)
#pragma unroll
                    for (int i = 0; i < 2; ++i) offN[h][i] += Cg[i]; }
            else {
#pragma unroll
                for (int h = 0; h < 2; ++h)
#pragma unroll
                    for (int i = 0; i < 2; ++i) offN[h][i] = offC[h][i]; } }
        for (int t = 0; t < nt; t += 2) {
            const bool last = (t == nt - 2);
            const char* a1 = cA + (size_t)(t + 1) * kstep;
            const char* a2 = last ? nA : cA + (size_t)(t + 2) * kstep; const char* b2 = last ? nB : cB + (size_t)(t + 2) * kstep;
            const char* a3 = a2 + kstep; const char* b3 = b2 + kstep;
            unsigned o2[2][2];
#pragma unroll
            for (int h = 0; h < 2; ++h)
#pragma unroll
                for (int i = 0; i < 2; ++i) o2[h][i] = last ? offN[h][i] : offC[h][i];
            if constexpr (MIDK) { if (t == nt / 2) E.midk(acc, cur, wr, fr); }
            PG8_LDB(B0, 0, 0); PG8_LDB(B1, 0, 1); PG8_SCHED; PG8_LDA(At, 0, 0); PG8_STAGE_A(PG8_SA(1, 1), a1, 1, offC);
            PG8_WAIT_V(8); PG8_WAIT_L(0); PG8_BAR; PG8_MMA(0, 0, At, B0); PG8_MMA(0, 1, At, B1); PG8_BAR; PG8_SCHED;
            PG8_LDA(At, 0, 1); PG8_STAGE_B(PG8_SB(0, 0), b2); PG8_STAGE_B(PG8_SB(0, 1), b2 + hstep); PG8_STAGE_A(PG8_SA(0, 0), a2, 0, o2);
            PG8_WAIT_V(8); PG8_WAIT_L(0); PG8_BAR; PG8_MMA(1, 0, At, B0); PG8_MMA(1, 1, At, B1); PG8_BAR; PG8_SCHED;
            PG8_LDB(B0, 1, 0); PG8_LDB(B1, 1, 1); PG8_SCHED; PG8_LDA(At, 1, 0); PG8_STAGE_A(PG8_SA(0, 1), a2, 1, o2);
            PG8_WAIT_V(8); PG8_WAIT_L(0); PG8_BAR; PG8_MMA(0, 0, At, B0); PG8_MMA(0, 1, At, B1); PG8_BAR; PG8_SCHED;
            PG8_LDA(At, 1, 1); PG8_STAGE_B(PG8_SB(1, 0), b3); PG8_STAGE_B(PG8_SB(1, 1), b3 + hstep); PG8_STAGE_A(PG8_SA(1, 0), a3, 0, o2);
            PG8_WAIT_V(8); PG8_WAIT_L(0); PG8_BAR; PG8_MMA(1, 0, At, B0); PG8_MMA(1, 1, At, B1); PG8_BAR; PG8_SCHED;
        }
        if (wr == 0) PG8_BAR;
        if constexpr (F8) asm volatile("s_nop 15\n\ts_nop 15" ::: "memory");
        E(acc, cur, wr, wc, fr, fq);
        if (!has_next) break;
#pragma unroll
        for (int a = 0; a < 2; ++a)
#pragma unroll
            for (int b = 0; b < 2; ++b)
#pragma unroll
                for (int m = 0; m < 4; ++m)
#pragma unroll
                    for (int n = 0; n < 2; ++n) acc[a][b][m][n] = (f32x4){0.f, 0.f, 0.f, 0.f};
        cur = nxt; cA = nA; cB = nB; ++ui;
        if constexpr (GATHER) {
#pragma unroll
            for (int h = 0; h < 2; ++h)
#pragma unroll
                for (int i = 0; i < 2; ++i) offC[h][i] = offN[h][i]; }
        if (wr == 1) PG8_BAR;
    }
    PG8_WAIT_V(0);
    PG8_BAR;
}
}

struct Frame {
    LAS unsigned char* lds;
    volatile LAS unsigned* MISC;
    gu32* ctl;
    unsigned char* ws;
    int vcu, G;
    const float *x, *p, *mix_norm, *w_in, *ln_g, *ln_b, *gws, *gbs, *aon, *gon, *w_out, *ffn_norm, *router_w, *router_b, *w_gu, *b_gu, *w_dn, *b_dn, *ple_norm, *w_pg, *w_pp, *ppn, *final_norm;
    float* out;
};
template <class T_> __device__ __forceinline__ T_* wsp(const Frame& F, size_t off) { return (T_*)(F.ws + off); }

#define PHASE_IDS int TID_ = (int)threadIdx.x; asm volatile("" : "+v"(TID_)); const int LANE_ = TID_ & 63; const int WAVE_ = __builtin_amdgcn_readfirstlane(TID_ >> 6); (void)LANE_; (void)WAVE_
template <class ColMap>
__device__ __forceinline__ void p0_transpose_item(const float* W, int K, int N, bf16* WT, const float* gain, LAS float* scr, int item, int lane, int nphys, const ColMap& cm) {
    const int nblk = nphys / 64, kb = item / nblk, nb = item % nblk, k0 = 64 * kb, n0 = 64 * nb;
    const int srccol = cm(n0 + lane);
    float v_[64]; const float* src = W + (size_t)k0 * N + srccol;
#pragma unroll
    for (int kk = 0; kk < 64; ++kk) v_[kk] = __builtin_nontemporal_load(src + (size_t)kk * N);
    if (gain) {
#pragma unroll
        for (int kk = 0; kk < 64; kk += 4) { const f32x4 g4 = *(const f32x4*)(gain + k0 + kk); v_[kk] *= g4[0]; v_[kk + 1] *= g4[1]; v_[kk + 2] *= g4[2]; v_[kk + 3] *= g4[3]; } }
#pragma unroll
    for (int kk = 0; kk < 64; ++kk) scr[kk * 65 + lane] = v_[kk];
    LDS_WAIT(); asm volatile("" ::: "memory");
    const int c = lane & 7;
#pragma unroll
    for (int j = 0; j < 8; ++j) { const int n = (lane >> 3) + 8 * j; const LAS float* s = scr + (8 * c) * 65 + n;
        v4u o; o.x = pk2(s[0 * 65], s[1 * 65]); o.y = pk2(s[2 * 65], s[3 * 65]); o.z = pk2(s[4 * 65], s[5 * 65]); o.w = pk2(s[6 * 65], s[7 * 65]);
        *(GAS v4u*)(WT + (size_t)(n0 + n) * K + k0 + 8 * c) = o; }
    LDS_WAIT(); asm volatile("" ::: "memory");
}
template <class ColMap>
__device__ __forceinline__ void p0_transpose_item_f8(const float* W, int K, int N, unsigned char* WT, const float* gain, LAS float* scr, int item, int lane, int nphys, const ColMap& cm) {
    const int nblk = nphys / 64, kb = item / nblk, nb = item % nblk, k0 = 64 * kb, n0 = 64 * nb;
    const int srccol = cm(n0 + lane);
    float v_[64]; const float* src = W + (size_t)k0 * N + srccol;
#pragma unroll
    for (int kk = 0; kk < 64; ++kk) v_[kk] = __builtin_nontemporal_load(src + (size_t)kk * N);
    constexpr float WS_ = (float)(1 << pg8::F8_WSHIFT);
#pragma unroll
    for (int kk = 0; kk < 64; kk += 4) { f32x4 g4 = gain ? *(const f32x4*)(gain + k0 + kk) : (f32x4){1.f, 1.f, 1.f, 1.f}; v_[kk] *= g4[0] * WS_; v_[kk + 1] *= g4[1] * WS_; v_[kk + 2] *= g4[2] * WS_; v_[kk + 3] *= g4[3] * WS_; }
#pragma unroll
    for (int kk = 0; kk < 64; ++kk) scr[kk * 65 + lane] = v_[kk];
    LDS_WAIT(); asm volatile("" ::: "memory");
    const int c = lane & 3;
#pragma unroll
    for (int j = 0; j < 4; ++j) { const int n = (lane >> 2) + 16 * j; const LAS float* s_ = scr + (16 * c) * 65 + n;
        v4u o; o.x = pk4_fp8(s_[0 * 65], s_[1 * 65], s_[2 * 65], s_[3 * 65]); o.y = pk4_fp8(s_[4 * 65], s_[5 * 65], s_[6 * 65], s_[7 * 65]);
        o.z = pk4_fp8(s_[8 * 65], s_[9 * 65], s_[10 * 65], s_[11 * 65]); o.w = pk4_fp8(s_[12 * 65], s_[13 * 65], s_[14 * 65], s_[15 * 65]);
        *(GAS v4u*)(WT + (size_t)(n0 + n) * K + k0 + 16 * c) = o; }
    LDS_WAIT(); asm volatile("" ::: "memory");
}
struct CmId { __device__ __forceinline__ int operator()(int n) const { return n; } };
struct CmWin { __device__ __forceinline__ int operator()(int n) const { if (n >= 2 * AW) return n; const int c = n & 63; return (n & ~63) + 4 * (c >> 3) + (c & 3) + 32 * ((c >> 2) & 1); } };
struct CmWgu { __device__ __forceinline__ int operator()(int n) const { return ((n >> 7) & 1) * FF + (n >> 8) * 128 + (n & 127); } };

constexpr int XW_I_GU = (DM / 64) * (2 * FF / 64), XW_I_DN = (FF / 64) * (DM / 64), XW_ITEMS = NE * (XW_I_GU + XW_I_DN);
__device__ __forceinline__ void xw_convert_item(const Frame& F, int it, LAS float* scr, int lane) {
    if (it < NE * XW_I_GU) { const int e = it / XW_I_GU; p0_transpose_item_f8(F.w_gu + (size_t)e * DM * 2 * FF, DM, 2 * FF, wsp<unsigned char>(F, WS_WGU) + (size_t)e * 2 * FF * DM, F.ffn_norm, scr, it % XW_I_GU, lane, 2 * FF, CmWgu()); }
    else { const int r = it - NE * XW_I_GU, e = r / XW_I_DN; p0_transpose_item_f8(F.w_dn + (size_t)e * FF * DM, FF, DM, wsp<unsigned char>(F, WS_WDN) + (size_t)e * DM * FF, nullptr, scr, r % XW_I_DN, lane, DM, CmId()); }
}
struct XwDesc { const float* src; unsigned char* dst; unsigned N, K; };
__device__ __forceinline__ XwDesc xw_desc(const Frame& F, int it, int lane) {
    XwDesc d; const int kq = lane >> 4, nq = lane & 15;
    if (it < NE * XW_I_GU) { const int e = it / XW_I_GU, item = it % XW_I_GU, nblk = 2 * FF / 64, k0 = 64 * (item / nblk), n0 = 64 * (item % nblk);
        d.N = 2 * FF; d.K = DM; d.src = F.w_gu + (size_t)e * DM * 2 * FF + (size_t)(k0 + kq) * (2 * FF) + CmWgu()(n0) + 4 * nq;
        d.dst = wsp<unsigned char>(F, WS_WGU) + (size_t)e * 2 * FF * DM + (size_t)(n0 + (lane >> 2)) * DM + k0 + 16 * (lane & 3); }
    else { const int r = it - NE * XW_I_GU, e = r / XW_I_DN, item = r % XW_I_DN, nblk = DM / 64, k0 = 64 * (item / nblk), n0 = 64 * (item % nblk);
        d.N = DM; d.K = FF; d.src = F.w_dn + (size_t)e * FF * DM + (size_t)(k0 + kq) * DM + n0 + 4 * nq;
        d.dst = wsp<unsigned char>(F, WS_WDN) + (size_t)e * DM * FF + (size_t)(n0 + (lane >> 2)) * FF + k0 + 16 * (lane & 3); }
    return d;
}
__device__ __forceinline__ void xw_load(f32x4 (&v)[16], const XwDesc& d) {
#pragma unroll
    for (int j = 0; j < 16; ++j) v[j] = __builtin_nontemporal_load((const f32x4*)(d.src + (size_t)(4 * j) * d.N));
}
__device__ __forceinline__ void xw_process(const f32x4 (&v)[16], const XwDesc& d, LAS float* scr, int lane) {
    const int kq = lane >> 4, nq = lane & 15;
#pragma unroll
    for (int j = 0; j < 16; ++j) { LAS float* w = scr + (4 * j + kq) * 65 + 4 * nq; w[0] = v[j][0]; w[1] = v[j][1]; w[2] = v[j][2]; w[3] = v[j][3]; }
    LDS_WAIT(); asm volatile("" ::: "memory");
    constexpr float WS_ = (float)(1 << pg8::F8_WSHIFT);
    const int c = lane & 3;
#pragma unroll
    for (int j = 0; j < 4; ++j) { const LAS float* s_ = scr + (16 * c) * 65 + (lane >> 2) + 16 * j;
        v4u o; o.x = pk4_fp8(s_[0 * 65] * WS_, s_[1 * 65] * WS_, s_[2 * 65] * WS_, s_[3 * 65] * WS_); o.y = pk4_fp8(s_[4 * 65] * WS_, s_[5 * 65] * WS_, s_[6 * 65] * WS_, s_[7 * 65] * WS_);
        o.z = pk4_fp8(s_[8 * 65] * WS_, s_[9 * 65] * WS_, s_[10 * 65] * WS_, s_[11 * 65] * WS_); o.w = pk4_fp8(s_[12 * 65] * WS_, s_[13 * 65] * WS_, s_[14 * 65] * WS_, s_[15 * 65] * WS_);
        *(GAS v4u*)(d.dst + (size_t)(16 * j) * d.K) = o; }
    LDS_WAIT(); asm volatile("" ::: "memory");
}
__device__ __forceinline__ void p0_prologue(Frame& F) {
    PHASE_IDS;
    { const int gt0 = (int)blockIdx.x * NTHR + TID_, GT0 = F.G * NTHR;
      for (int i = gt0; i < CW_TS; i += GT0) F.ctl[i] = 0u;
      float* km0 = wsp<float>(F, WS_KMEAN); for (int i = gt0; i < (T / SEQ) * NH * NBLK * HD; i += GT0) km0[i] = 0.f; }
    LAS float* scr = (LAS float*)(F.lds + RING_OFF + WAVE_ * P0_SCR_WAVE);
    const int gw = F.vcu * NWAVES + WAVE_, NGW = F.G * NWAVES;
    constexpr int I_GU = (DM / 64) * (2 * FF / 64), I_DN = (FF / 64) * (DM / 64), I_IN = (DM / 64) * (2 * AW / 64), I_IN8 = (DM / 64) * ((NPROJ - 2 * AW) / 64), I_SQ = (DM / 64) * (DM / 64), I_PP = (PLE / 64) * (DM / 64);
    constexpr int NITEMS = I_IN + I_IN8 + 2 * I_SQ + I_PP;
    (void)I_GU; (void)I_DN;
    for (int it = gw; it < NITEMS; it += NGW) {
        int r = it;
        if (r < I_IN) { p0_transpose_item(F.w_in, DM, NPROJ, wsp<bf16>(F, WS_WIN), F.mix_norm, scr, r, LANE_, 2 * AW, CmWin()); continue; } r -= I_IN;
        if (r < I_IN8) { p0_transpose_item_f8(F.w_in + 2 * AW, DM, NPROJ, wsp<unsigned char>(F, WS_WIN8), F.mix_norm, scr, r, LANE_, NPROJ - 2 * AW, CmId()); continue; } r -= I_IN8;
        if (r < I_SQ) {
            const int nblk = DM / 64, kb = r / nblk; const float* g = (kb < 8) ? F.aon : (F.gon - AW);
            p0_transpose_item(F.w_out, DM, DM, wsp<bf16>(F, WS_WOUT), g, scr, r, LANE_, DM, CmId()); continue; } r -= I_SQ;
        if (r < I_SQ) { p0_transpose_item_f8(F.w_pg, DM, DM, wsp<unsigned char>(F, WS_WPG8), F.ple_norm, scr, r, LANE_, DM, CmId()); continue; } r -= I_SQ;
        p0_transpose_item(F.w_pp, PLE, DM, wsp<bf16>(F, WS_WPP), nullptr, scr, r, LANE_, DM, CmId());
    }
    if (TPROBE && blockIdx.x == 0 && threadIdx.x == 0) ((unsigned long long*)(F.ctl + CW_TS))[11] = __builtin_amdgcn_s_memrealtime();
    bf16* XN = wsp<bf16>(F, WS_XNB);
    for (int m0 = gw; m0 < T; m0 += 2 * NGW) {
        f32x4 v[2][4]; float s[2] = {0.f, 0.f};
#pragma unroll
        for (int r = 0; r < 2; ++r) { const GAS f32x4* xr = (const GAS f32x4*)(F.x + (size_t)(m0 + r * NGW) * DM) + LANE_;
#pragma unroll
            for (int j = 0; j < 4; ++j) v[r][j] = __builtin_nontemporal_load(xr + 64 * j); }
#pragma unroll
        for (int r = 0; r < 2; ++r) {
#pragma unroll
            for (int j = 0; j < 4; ++j) s[r] += (v[r][j].x * v[r][j].x + v[r][j].y * v[r][j].y) + (v[r][j].z * v[r][j].z + v[r][j].w * v[r][j].w); }
#pragma unroll
        for (int r = 0; r < 2; ++r) { const int m = m0 + r * NGW; const float sig = sqrtf(wave_sum(s[r]) * (1.f / DM) + EPS), rstd = 1.0f / sig;
            if (LANE_ == 0) wsp<float>(F, WS_SIG0)[m] = sig;
            GAS v2u* o8 = (GAS v2u*)(XN + (size_t)m * DM) + LANE_; GAS unsigned* o4 = (GAS unsigned*)(wsp<unsigned char>(F, WS_XN8) + (size_t)m * DM) + LANE_;
#pragma unroll
            for (int j = 0; j < 4; ++j) { const f32x4 n_ = v[r][j] * rstd; v2u w; w.x = pk2(n_.x, n_.y); w.y = pk2(n_.z, n_.w); o8[64 * j] = w; o4[64 * j] = pk4_fp8(n_.x, n_.y, n_.z, n_.w); } }
    }
    if (TPROBE && blockIdx.x == 0 && threadIdx.x == 0) ((unsigned long long*)(F.ctl + CW_TS))[12] = __builtin_amdgcn_s_memrealtime();
    { const GAS f32x4* pr = (const GAS f32x4*)F.p; GAS v2u* po = (GAS v2u*)wsp<bf16>(F, WS_PB);
      const size_t n4 = (size_t)T * PLE / 4, gt = (size_t)(F.vcu * NTHR + TID_), GT = (size_t)F.G * NTHR;
      for (size_t i = gt; i < n4; i += GT) { const f32x4 v = pr[i]; v2u w; w.x = pk2(v.x, v.y); w.y = pk2(v.z, v.w); po[i] = w; } }
    if (TPROBE && blockIdx.x == 0 && threadIdx.x == 0) ((unsigned long long*)(F.ctl + CW_TS))[13] = __builtin_amdgcn_s_memrealtime();
    { const int gt = F.vcu * NTHR + TID_, GT = F.G * NTHR; float* RWG = wsp<float>(F, WS_RWG);
      (void)RWG; bf16* RWT = wsp<bf16>(F, WS_RWT);
      for (int i = gt; i < DM * NE; i += GT) { const int e = i / DM, k = i % DM; const float w = F.router_w[k * NE + e] * F.ffn_norm[k]; const unsigned hi = f2bf(w); const float lo = w - bf2f((bf16)hi); RWT[i] = (bf16)hi; RWT[NE * DM + i] = (bf16)f2bf(lo); }
      float* RC = wsp<float>(F, WS_ROPE); float* RS = RC + SEQ * 32;
      for (int i = gt; i < SEQ * 32; i += GT) { const int pos = i >> 5, j = i & 31; const float inv = powf(10000.0f, -(float)j / 32.0f); const float ang = (float)pos * inv; float sn, cs; sincosf(ang, &sn, &cs); RC[i] = cs; RS[i] = sn; } }
}

using pg8::Unit;
constexpr int HALF = 128;
struct EpiInProj {
    static constexpr bool PERM = true;
    bf16* QKVUV; const float *rc, *rs; float* kmean; int pn_off;
    __device__ __forceinline__ void operator()(const f32x4 (&acc)[2][2][4][2], const Unit& u_, int wr, int wc, int fr, int fq) const {
        Unit u = u_; u.pn += pn_off;
        const int type = u.pn >> 1, colt = (u.pn & 1) * 256 + wc * 32 + 8 * fq;
        const int row0 = u.pm * 256 + wr * 64 + fr;
        if (type <= 1) {
            bf16* dst = QKVUV + (size_t)type * (16u << 20);
            const int pos0 = (u.pm & 7) * 256 + wr * 64 + fr, i0 = 16 * (wc & 1) + 4 * fq;
            f32x4 cs_[2][2];
#pragma unroll
            for (int bj = 0; bj < 2; ++bj) { cs_[bj][0] = (f32x4){0.f, 0.f, 0.f, 0.f}; cs_[bj][1] = (f32x4){0.f, 0.f, 0.f, 0.f}; }
#pragma unroll
            for (int ai = 0; ai < 2; ++ai) { f32x4 cc[4], ss[4];
#pragma unroll
                for (int m = 0; m < 4; ++m) { const int pos = pos0 + ai * HALF + m * 16; cc[m] = *(const f32x4*)(rc + pos * 32 + i0); ss[m] = *(const f32x4*)(rs + pos * 32 + i0); }
#pragma unroll
                for (int m = 0; m < 4; ++m) { const int ro = ai * HALF + m * 16; const f32x4 c = cc[m], s = ss[m];
                    bf16* rowp = dst + (size_t)(row0 + ro) * AW + colt;
#pragma unroll
                    for (int bj = 0; bj < 2; ++bj) { const f32x4 x1 = acc[ai][bj][m][0], x2 = acc[ai][bj][m][1];
                        const f32x4 o1 = x1 * c - x2 * s, o2 = x2 * c + x1 * s;
                        cs_[bj][0] += o1; cs_[bj][1] += o2;
                        v4u w; w.x = cvt_pk_bf16(o1[0], o1[1]); w.y = cvt_pk_bf16(o1[2], o1[3]); w.z = cvt_pk_bf16(o2[0], o2[1]); w.w = cvt_pk_bf16(o2[2], o2[3]);
                        *(v4u*)(rowp + bj * HALF) = w; } }
                asm volatile("" ::: "memory"); }
            if (type == 1) {
#pragma unroll
                for (int bj = 0; bj < 2; ++bj)
#pragma unroll
                    for (int n = 0; n < 2; ++n)
#pragma unroll
                        for (int j = 0; j < 4; ++j) { float v = cs_[bj][n][j]; v += __shfl_xor(v, 1); v += __shfl_xor(v, 2); v += __shfl_xor(v, 4); v += __shfl_xor(v, 8); cs_[bj][n][j] = v; }
                if (fr == 0) { const int b = u.pm >> 3, blk = u.pm & 7;
#pragma unroll
                    for (int bj = 0; bj < 2; ++bj) { const int colh = (u.pn & 1) * 256 + bj * HALF + wc * 32; const int head = colh >> 6, cpos = (colh & 63) + 8 * fq;
                        float* km = kmean + ((size_t)((b * NH + head) * NBLK + blk)) * HD + cpos;
#pragma unroll
                        for (int n = 0; n < 2; ++n)
#pragma unroll
                            for (int j = 0; j < 4; ++j) atomicAdd(km + 4 * n + j, cs_[bj][n][j]); } }
            }
        } else {
            bf16* dst = QKVUV + (size_t)type * (16u << 20);
#pragma unroll
            for (int ai = 0; ai < 2; ++ai)
#pragma unroll
                for (int m = 0; m < 4; ++m) { bf16* rowp = dst + (size_t)(row0 + ai * HALF + m * 16) * AW + colt;
#pragma unroll
                    for (int bj = 0; bj < 2; ++bj) { f32x4 v0 = acc[ai][bj][m][0], v1 = acc[ai][bj][m][1];
                        if (type >= 3) { v0 = gelu4(v0); v1 = gelu4(v1); }
                        v4u w; w.x = cvt_pk_bf16(v0[0], v0[1]); w.y = cvt_pk_bf16(v0[2], v0[3]); w.z = cvt_pk_bf16(v1[0], v1[1]); w.w = cvt_pk_bf16(v1[2], v1[3]);
                        *(v4u*)(rowp + bj * HALF) = w; } }
        }
    }
};
struct EpiOutProj {
    static constexpr bool PERM = true;
    const bf16* xn; bf16* x1; unsigned char* x1f8; float* ssq1; const LAS f32x4* rtab; const float* fgain;
    int pm_a, pm_b;
    __device__ __forceinline__ int slot(const Unit& u) const { return u.pm == pm_a ? 0 : 1; }
    __device__ __forceinline__ void midk(f32x4 (&acc)[2][2][4][2], const Unit& u, int wr, int fr) const {
        const LAS f32x4* t = rtab + slot(u) * 256 + wr * 64 + fr;
#pragma unroll
        for (int ai = 0; ai < 2; ++ai)
#pragma unroll
            for (int m = 0; m < 4; ++m) { const float r = t[ai * HALF + m * 16].x;
#pragma unroll
                for (int bj = 0; bj < 2; ++bj)
#pragma unroll
                    for (int n = 0; n < 2; ++n) acc[ai][bj][m][n] *= r; }
    }
    __device__ __forceinline__ void operator()(const f32x4 (&acc)[2][2][4][2], const Unit& u, int wr, int wc, int fr, int fq) const {
        const LAS f32x4* t = rtab + slot(u) * 256 + wr * 64 + fr;
        const int row0 = u.pm * 256 + wr * 64 + fr, col0 = u.pn * 256 + wc * 32 + 8 * fq;
        f32x4 fg[2][2];
#pragma unroll
        for (int bj = 0; bj < 2; ++bj) { fg[bj][0] = *(const f32x4*)(fgain + col0 + bj * HALF); fg[bj][1] = *(const f32x4*)(fgain + col0 + bj * HALF + 4); }
#pragma unroll
        for (int ai = 0; ai < 2; ++ai) { v4u xv[4][2];
#pragma unroll
            for (int m = 0; m < 4; ++m) { const size_t off = (size_t)(row0 + ai * HALF + m * 16) * DM + col0;
                xv[m][0] = *(const v4u*)(xn + off); xv[m][1] = *(const v4u*)(xn + off + HALF); }
#pragma unroll
            for (int m = 0; m < 4; ++m) { const int ro = ai * HALF + m * 16; const f32x4 tv = t[ro]; const float rg = tv.y, sx = tv.z; const size_t off = (size_t)(row0 + ro) * DM + col0; float q = 0.f;
#pragma unroll
                for (int bj = 0; bj < 2; ++bj) { const v4u xw = xv[m][bj];
                    const f32x4 x0 = {bflo(xw.x), bfhi(xw.x), bflo(xw.y), bfhi(xw.y)}, x1_ = {bflo(xw.z), bfhi(xw.z), bflo(xw.w), bfhi(xw.w)};
                    const f32x4 o0 = x0 * sx + acc[ai][bj][m][0] * rg, o1 = x1_ * sx + acc[ai][bj][m][1] * rg;
                    q += (o0[0] * o0[0] + o0[1] * o0[1]) + (o0[2] * o0[2] + o0[3] * o0[3]) + (o1[0] * o1[0] + o1[1] * o1[1]) + (o1[2] * o1[2] + o1[3] * o1[3]);
                    v4u w; w.x = cvt_pk_bf16(o0[0], o0[1]); w.y = cvt_pk_bf16(o0[2], o0[3]); w.z = cvt_pk_bf16(o1[0], o1[1]); w.w = cvt_pk_bf16(o1[2], o1[3]);
                    *(v4u*)(x1 + off + bj * HALF) = w;
                    const f32x4 p0 = o0 * fg[bj][0], p1 = o1 * fg[bj][1];
                    v2u w8; w8.x = pk4_fp8(p0[0], p0[1], p0[2], p0[3]); w8.y = pk4_fp8(p1[0], p1[1], p1[2], p1[3]); *(v2u*)(x1f8 + off + bj * HALF) = w8; }
                q += __shfl_xor(q, 16); q += __shfl_xor(q, 32);
                if (fq == 0) ssq1[(size_t)(row0 + ro) * 16 + u.pn * 4 + wc] = q; }
            asm volatile("" ::: "memory"); }
    }
};
struct EpiMoe1 {
    static constexpr bool PERM = true;
    unsigned char* A; const float* b_gu; const LAS float* rss;
    __device__ __forceinline__ void operator()(const f32x4 (&acc)[2][2][4][2], const Unit& u, int wr, int wc, int fr, int fq) const {
        const int row0 = u.pm * 256 + wr * 64 + fr, col = u.pn * 128 + wc * 32 + 8 * fq;
        const float* bg = b_gu + (size_t)u.e * 2 * FF + col; const LAS float* rs_ = rss + u.slot * 256 + wr * 64 + fr;
        float rsv[2][4];
#pragma unroll
        for (int ai = 0; ai < 2; ++ai)
#pragma unroll
            for (int m = 0; m < 4; ++m) rsv[ai][m] = rs_[ai * HALF + m * 16];
        f32x4 bgv[2], blv[2];
#pragma unroll
        for (int n = 0; n < 2; ++n) { bgv[n] = *(const f32x4*)(bg + 4 * n); blv[n] = *(const f32x4*)(bg + FF + 4 * n); }
#pragma unroll
        for (int ai = 0; ai < 2; ++ai)
#pragma unroll
            for (int m = 0; m < 4; ++m) { f32x4 a[2];
#pragma unroll
                for (int n = 0; n < 2; ++n) { const f32x4 g = acc[ai][0][m][n] * rsv[ai][m] + bgv[n], l = acc[ai][1][m][n] * rsv[ai][m] + blv[n];
#pragma unroll
                    for (int p = 0; p < 2; ++p) { f32x2 gc = {fminf(g[2 * p], 7.0f), fminf(g[2 * p + 1], 7.0f)}; f32x2 lc = {fminf(fmaxf(l[2 * p], -7.0f), 7.0f), fminf(fmaxf(l[2 * p + 1], -7.0f), 7.0f)};
                        const f32x2 z = gc * (-1.702f * 1.4426950408889634f); f32x2 e; e.x = __builtin_amdgcn_exp2f(z.x); e.y = __builtin_amdgcn_exp2f(z.y);
                        const f32x2 d = e + 1.0f; f32x2 r; r.x = __builtin_amdgcn_rcpf(d.x); r.y = __builtin_amdgcn_rcpf(d.y);
                        const f32x2 o = (gc * r) * (lc + 1.0f); a[n][2 * p] = o.x; a[n][2 * p + 1] = o.y; } }
                v2u w; w.x = pk4_fp8_nc(a[0][0], a[0][1], a[0][2], a[0][3]); w.y = pk4_fp8_nc(a[1][0], a[1][1], a[1][2], a[1][3]);
                *(v2u*)(A + (size_t)(row0 + ai * HALF + m * 16) * FF + col) = w; }
    }
};
constexpr float Y_SCALE = 16.0f;
struct EpiMoe2 {
    static constexpr bool PERM = true;
    unsigned char* Y; const float* b_dn; const LAS float* gss;
    __device__ __forceinline__ void operator()(const f32x4 (&acc)[2][2][4][2], const Unit& u, int wr, int wc, int fr, int fq) const {
        const int row0 = u.pm * 256 + wr * 64 + fr, col0 = u.pn * 256 + wc * 32 + 8 * fq;
        const LAS float* gs = gss + u.slot * 256 + wr * 64 + fr;
        f32x4 bv[2][2]; float gv[2][4];
#pragma unroll
        for (int bj = 0; bj < 2; ++bj)
#pragma unroll
            for (int n = 0; n < 2; ++n) bv[bj][n] = *(const f32x4*)(b_dn + (size_t)u.e * DM + col0 + bj * HALF + 4 * n);
#pragma unroll
        for (int ai = 0; ai < 2; ++ai)
#pragma unroll
            for (int m = 0; m < 4; ++m) gv[ai][m] = gs[ai * HALF + m * 16] * Y_SCALE;
#pragma unroll
        for (int ai = 0; ai < 2; ++ai)
#pragma unroll
            for (int m = 0; m < 4; ++m) { const float g = gv[ai][m]; unsigned char* rowp = Y + (size_t)(row0 + ai * HALF + m * 16) * DM + col0;
#pragma unroll
                for (int bj = 0; bj < 2; ++bj) { const f32x4 v0 = (acc[ai][bj][m][0] + bv[bj][0]) * g, v1 = (acc[ai][bj][m][1] + bv[bj][1]) * g;
                    v2u w; w.x = pk4_fp8(v0[0], v0[1], v0[2], v0[3]); w.y = pk4_fp8(v1[0], v1[1], v1[2], v1[3]);
                    *(v2u*)(rowp + bj * HALF) = w; } }
    }
};
constexpr float GATE_SCALE = 128.0f;
template <int MODE> struct EpiPle {
    static constexpr bool PERM = true;
    unsigned char* O; float* ssq; const LAS float* rtab; int pm_a;
    __device__ __forceinline__ void operator()(const f32x4 (&acc)[2][2][4][2], const Unit& u, int wr, int wc, int fr, int fq) const {
        const int row0 = u.pm * 256 + wr * 64 + fr, col0 = u.pn * 256 + wc * 32 + 8 * fq;
        float rsv[2][4];
#pragma unroll
        for (int ai = 0; ai < 2; ++ai)
#pragma unroll
            for (int m = 0; m < 4; ++m) rsv[ai][m] = (MODE == 0) ? rtab[(u.pm == pm_a ? 0 : 256) + wr * 64 + fr + ai * HALF + m * 16] : 1.0f;
#pragma unroll
        for (int ai = 0; ai < 2; ++ai)
#pragma unroll
            for (int m = 0; m < 4; ++m) { unsigned char* rowp = O + (size_t)(row0 + ai * HALF + m * 16) * DM + col0; float q = 0.f; const float rs = rsv[ai][m];
#pragma unroll
                for (int bj = 0; bj < 2; ++bj) { f32x4 v0 = acc[ai][bj][m][0], v1 = acc[ai][bj][m][1];
                    if (MODE == 0) {
#pragma unroll
                        for (int j = 0; j < 4; ++j) { v0[j] = GATE_SCALE * sigmoidf_fast(rs * v0[j]); v1[j] = GATE_SCALE * sigmoidf_fast(rs * v1[j]); } }
                    else { q += (v0[0] * v0[0] + v0[1] * v0[1]) + (v0[2] * v0[2] + v0[3] * v0[3]) + (v1[0] * v1[0] + v1[1] * v1[1]) + (v1[2] * v1[2] + v1[3] * v1[3]); }
                    v2u w; if (MODE == 0) { w.x = pk4_fp8_nc(v0[0], v0[1], v0[2], v0[3]); w.y = pk4_fp8_nc(v1[0], v1[1], v1[2], v1[3]); }
                    else { w.x = pk4_fp8(v0[0], v0[1], v0[2], v0[3]); w.y = pk4_fp8(v1[0], v1[1], v1[2], v1[3]); }
                    *(v2u*)(rowp + bj * HALF) = w; }
                if (MODE == 1) { q += __shfl_xor(q, 16); q += __shfl_xor(q, 32); if (fq == 0) ssq[(size_t)(row0 + ai * HALF + m * 16) * 16 + u.pn * 4 + wc] = q; } }
    }
};

namespace att {
constexpr int QBLK = 32, KVBLK = 64;
constexpr float SCALE = 0.125f, THR = 8.f;
constexpr int SHM_V = KVBLK * HD * 2, SHM_K = SHM_V;
constexpr int NSLOT = 3;
constexpr int LDS_BYTES_ = NSLOT * SHM_V + NSLOT * SHM_K + NWAVES * 64 * 4;
#define ATT_KSWZ(row, colB) ((row) * 128 + ((colB) ^ ((((row) >> 1) & 7) << 4)))
#define ATT_SBAR() __builtin_amdgcn_sched_barrier(0)
__device__ __forceinline__ int crow(int r, int hi) { return (r & 3) + 8 * (r >> 2) + 4 * hi; }
__device__ __forceinline__ void cmask(f32x16& p0, f32x16& p1, int jb, int qrel, int hi) {
    const float NEG = -__builtin_inff(); const int kb = 64 * jb + 4 * hi;
#pragma unroll
    for (int r = 0; r < 16; ++r) { const int kv = kb + (r & 3) + 8 * (r >> 2); if (kv > qrel) p0[r] = NEG; if (kv + 32 > qrel) p1[r] = NEG; }
}
__device__ __forceinline__ void bmask(f32x16& p0, f32x16& p1, bool keep) {
    const float NEG = -__builtin_inff();
    if (!keep) {
#pragma unroll
        for (int r = 0; r < 16; ++r) { p0[r] = NEG; p1[r] = NEG; } }
}
__device__ __forceinline__ void partialSM(f32x16& p0, f32x16& p1, float& m_reg, float& mn, float& alpha, bool keep) {
    float pmax = p0[0];
#pragma unroll
    for (int r = 1; r < 16; ++r) pmax = fmaxf(pmax, p0[r]);
#pragma unroll
    for (int r = 0; r < 16; ++r) pmax = fmaxf(pmax, p1[r]);
    { auto rr = __builtin_amdgcn_permlane32_swap(__float_as_uint(pmax), __float_as_uint(pmax), false, false);
      pmax = fmaxf(__uint_as_float(rr[0]), __uint_as_float(rr[1])); }
    if (!keep) pmax = -__builtin_inff();
    constexpr float C2 = 1.4426950408889634f * SCALE;
    if (__builtin_expect(__all((pmax - m_reg) * SCALE <= THR), 1)) { mn = m_reg; alpha = 1.f; }
    else { mn = fmaxf(m_reg, pmax); alpha = __builtin_amdgcn_exp2f((m_reg - mn) * C2); m_reg = mn; }
    const float mnL = keep ? -mn * C2 : -__builtin_inff(), c2 = keep ? C2 : 0.f;
#pragma unroll
    for (int r = 0; r < 16; ++r) p0[r] = fmaf(p0[r], c2, mnL);
#pragma unroll
    for (int r = 0; r < 16; ++r) p1[r] = fmaf(p1[r], c2, mnL);
#pragma unroll
    for (int r = 0; r < 16; ++r) p0[r] = __builtin_amdgcn_exp2f(p0[r]);
}
__device__ __forceinline__ void finishSM(f32x16& p0, f32x16& p1, float alpha, float& l_reg, bf16x8& pa0, bf16x8& pa1, bf16x8& pa2, bf16x8& pa3) {
#pragma unroll
    for (int r = 0; r < 16; ++r) p1[r] = __builtin_amdgcn_exp2f(p1[r]);
    float ps = 0;
#pragma unroll
    for (int r = 0; r < 16; ++r) ps += p0[r];
#pragma unroll
    for (int r = 0; r < 16; ++r) ps += p1[r];
    { auto rr = __builtin_amdgcn_permlane32_swap(__float_as_uint(ps), __float_as_uint(ps), false, false);
      ps = __uint_as_float(rr[0]) + __uint_as_float(rr[1]); }
    l_reg = l_reg * alpha + ps;
#define ATT_PK4(P, B, OUT) do { unsigned a0 = cvt_pk_bf16(P[B+0], P[B+1]), a1 = cvt_pk_bf16(P[B+2], P[B+3]);             \
        unsigned b0 = cvt_pk_bf16(P[B+4], P[B+5]), b1 = cvt_pk_bf16(P[B+6], P[B+7]);                                       \
        auto r0 = __builtin_amdgcn_permlane32_swap(a0, b0, false, false); auto r1 = __builtin_amdgcn_permlane32_swap(a1, b1, false, false); \
        v4u w = {r0[0], r1[0], r0[1], r1[1]}; OUT = *reinterpret_cast<bf16x8*>(&w); } while (0)
    ATT_PK4(p0, 0, pa0); ATT_PK4(p0, 8, pa1); ATT_PK4(p1, 0, pa2); ATT_PK4(p1, 8, pa3);
#undef ATT_PK4
}
__device__ __forceinline__ void qkt(f32x16& p0, f32x16& p1, const LAS unsigned char* Ks, const bf16x8* qr, int r32, int hi) {
    p0 = f32x16{}; p1 = f32x16{};
#pragma unroll
    for (int d0 = 0; d0 < 4; ++d0) { const int cb = (d0 * 16 + hi * 8) * 2;
        const bf16x8 b0 = *(const LAS bf16x8*)(Ks + ATT_KSWZ(r32, cb));
        const bf16x8 b1 = *(const LAS bf16x8*)(Ks + ATT_KSWZ(32 + r32, cb));
        p0 = __builtin_amdgcn_mfma_f32_32x32x16_bf16(b0, qr[d0], p0, 0, 0, 0);
        p1 = __builtin_amdgcn_mfma_f32_32x32x16_bf16(b1, qr[d0], p1, 0, 0, 0); }
}
__device__ __forceinline__ void pv(f32x16* o, int vb, bf16x8 pa0, bf16x8 pa1, bf16x8 pa2, bf16x8 pa3) {
#pragma unroll
    for (int d0 = 0; d0 < 2; ++d0) { s16x4 lo[4], hi[4];
#pragma unroll
        for (int ks = 0; ks < 4; ++ks) { const int a = vb + d0 * 2048 + (ks >> 1) * 4096 + (ks & 1) * 1024;
            asm volatile("ds_read_b64_tr_b16 %0,%1" : "=&v"(lo[ks]) : "v"(a) : "memory");
            asm volatile("ds_read_b64_tr_b16 %0,%1 offset:256" : "=&v"(hi[ks]) : "v"(a) : "memory"); }
        asm volatile("s_waitcnt lgkmcnt(0)" ::: "memory"); ATT_SBAR();
#define ATT_PK(k) (bf16x8){lo[k][0], lo[k][1], lo[k][2], lo[k][3], hi[k][0], hi[k][1], hi[k][2], hi[k][3]}
        o[d0] = __builtin_amdgcn_mfma_f32_32x32x16_bf16(pa0, ATT_PK(0), o[d0], 0, 0, 0);
        o[d0] = __builtin_amdgcn_mfma_f32_32x32x16_bf16(pa1, ATT_PK(1), o[d0], 0, 0, 0);
        o[d0] = __builtin_amdgcn_mfma_f32_32x32x16_bf16(pa2, ATT_PK(2), o[d0], 0, 0, 0);
        o[d0] = __builtin_amdgcn_mfma_f32_32x32x16_bf16(pa3, ATT_PK(3), o[d0], 0, 0, 0);
#undef ATT_PK
    }
}
__device__ __forceinline__ void attn_unit(const Frame& F, int b, int h, int qb, LAS unsigned char* scratch) {
    PHASE_IDS;
    const int tid = TID_, wid = tid >> 6, lane = tid & 63, r32 = lane & 31, hi = lane >> 5;
    const bf16* Qg = wsp<bf16>(F, WS_Q); const bf16* Kg = wsp<bf16>(F, WS_K); const bf16* Vg = wsp<bf16>(F, WS_V);
    const size_t rowbase = (size_t)b * SEQ; const int q0 = qb * MOBA;
    const bf16* Qw = Qg + (rowbase + q0 + wid * QBLK) * AW + h * HD;
    const bf16* Kh = Kg + rowbase * AW + h * HD; const bf16* Vh = Vg + rowbase * AW + h * HD;
    LAS unsigned char* V_lds = scratch; LAS unsigned char* K_lds = scratch + NSLOT * SHM_V;
    LAS float* wsf = (LAS float*)(scratch + NSLOT * SHM_V + NSLOT * SHM_K) + wid * 64; LAS float* li_l = wsf; LAS float* al_l = wsf + 32;
    float m_reg = -1e30f, l_reg = 0.f; f32x16 o[2]; o[0] = f32x16{}; o[1] = f32x16{}; bf16x8 qr[4];
#pragma unroll
    for (int d0 = 0; d0 < 4; ++d0) qr[d0] = *(const bf16x8*)(Qw + (size_t)r32 * AW + d0 * 16 + hi * 8);
    unsigned sel = 0u;
    if (qb <= 3) sel = (1u << qb) - 1u;
    else {
        const float* km = wsp<float>(F, WS_KMEAN) + (size_t)((b * NH + h) * NBLK) * HD + (size_t)(r32 & 7) * HD + hi * 8;
        f32x4 kv[4][2];
#pragma unroll
        for (int d0 = 0; d0 < 4; ++d0) { kv[d0][0] = *(const f32x4*)(km + d0 * 16); kv[d0][1] = *(const f32x4*)(km + d0 * 16 + 4); }
        f32x16 gacc = f32x16{};
#pragma unroll
        for (int d0 = 0; d0 < 4; ++d0) { float f[8] = {kv[d0][0][0], kv[d0][0][1], kv[d0][0][2], kv[d0][0][3], kv[d0][1][0], kv[d0][1][1], kv[d0][1][2], kv[d0][1][3]};
            unsigned hw[4], lw[4];
#pragma unroll
            for (int p = 0; p < 4; ++p) { float a0 = f[2 * p], a1 = f[2 * p + 1]; if (r32 >= 8) { a0 = 0.f; a1 = 0.f; }
                const unsigned h0 = f2bf(a0), h1 = f2bf(a1); hw[p] = h0 | (h1 << 16); lw[p] = pk2(a0 - bf2f((bf16)h0), a1 - bf2f((bf16)h1)); }
            const v4u hv = {hw[0], hw[1], hw[2], hw[3]}, lv = {lw[0], lw[1], lw[2], lw[3]};
            gacc = __builtin_amdgcn_mfma_f32_32x32x16_bf16(__builtin_bit_cast(bf16x8, hv), qr[d0], gacc, 0, 0, 0);
            gacc = __builtin_amdgcn_mfma_f32_32x32x16_bf16(__builtin_bit_cast(bf16x8, lv), qr[d0], gacc, 0, 0, 0); }
        float g[8];
#pragma unroll
        for (int r = 0; r < 4; ++r) { const float mine = gacc[r], other = __shfl_xor(mine, 32); g[r] = hi ? other : mine; g[4 + r] = hi ? mine : other; }
        float b0 = -__builtin_inff(), b1 = b0, b2 = b0; int i0 = 0, i1 = 0, i2 = 0;
#pragma unroll
        for (int j = 0; j < NBLK - 1; ++j) { const float s_ = (j < qb) ? g[j] : -__builtin_inff();
            if (s_ > b0) { b2 = b1; i2 = i1; b1 = b0; i1 = i0; b0 = s_; i0 = j; } else if (s_ > b1) { b2 = b1; i2 = i1; b1 = s_; i1 = j; } else if (s_ > b2) { b2 = s_; i2 = j; } }
        sel = (1u << i0) | (1u << i1) | (1u << i2);
    }
    const int sr = tid >> 3, sc = (tid & 7) * 8;
    const int srv = ((tid >> 5) << 2) | ((tid >> 1) & 3), scv = ((tid & 1) << 3) | (((tid >> 3) & 3) << 4);
    const int vst = (srv >> 5) * 4096 + (scv >> 5) * 2048 + ((srv & 31) >> 2) * 256 + ((scv >> 4) & 1) * 128 + (srv & 3) * 32 + (scv & 8) * 2;
    const int vb0 = (int)(size_t)V_lds + (lane & 15) * 8 + ((lane >> 4) & 1) * 128 + (lane >> 5) * 512;
    bf16x8 st_v, st_k;
#define ATT_SLOAD(k0) do { st_v = *(const bf16x8*)(Vh + (size_t)((k0) + srv) * AW + scv); st_k = *(const bf16x8*)(Kh + (size_t)((k0) + sr) * AW + sc); } while (0)
#define ATT_SWRITE(bf) do { *(LAS bf16x8*)(V_lds + (bf) * SHM_V + vst) = st_v; *(LAS bf16x8*)(K_lds + (bf) * SHM_K + ATT_KSWZ(sr, sc * 2)) = st_k; } while (0)
#define ATT_RESC(a) do { if (__any((a) < 1.f)) { if (hi == 0) al_l[r32] = (a); asm volatile("s_waitcnt lgkmcnt(0)" ::: "memory");      \
        _Pragma("unroll") for (int d_ = 0; d_ < 2; ++d_) _Pragma("unroll") for (int r = 0; r < 16; ++r) o[d_][r] *= al_l[crow(r, hi)]; } } while (0)
    const int NT = (q0 + MOBA) / KVBLK;
    const int qrel = wid * QBLK + r32;
#define ATT_MASK(P0, P1, t) do { const int jb_ = (t) - (NT - 4); if (jb_ >= 0) cmask(P0, P1, jb_, qrel, hi); } while (0)
#define ATT_KEEP(t) ((((t) >= NT - 4) ? 1u : ((sel >> ((t) >> 2)) & 1u)) != 0u)
    f32x16 pA0, pA1, pB0, pB1; float mnA, mnB, alA, alB; bf16x8 pa0, pa1, pa2, pa3;
    int s0 = 0, s1 = 1, s2 = 2;
#define ATT_ROT() do { const int t_ = s0; s0 = s1; s1 = s2; s2 = t_; } while (0)
    ATT_SLOAD(0); asm volatile("s_waitcnt vmcnt(0)" ::: "memory"); ATT_SWRITE(0); ATT_SLOAD(KVBLK);
    s0 = 2; s1 = 0; s2 = 1;
    __syncthreads();
    asm volatile("s_waitcnt vmcnt(0)" ::: "memory"); ATT_SWRITE(s2); ATT_SLOAD(2 * KVBLK);
    qkt(pA0, pA1, K_lds + s1 * SHM_K, qr, r32, hi); ATT_MASK(pA0, pA1, 0); partialSM(pA0, pA1, m_reg, mnA, alA, ATT_KEEP(0));
    ATT_ROT();
    for (int j = 1; j < NT; j += 2) {
        __syncthreads();
        if (j + 1 < NT) { asm volatile("s_waitcnt vmcnt(0)" ::: "memory"); ATT_SWRITE(s2); if (j + 2 < NT) ATT_SLOAD((j + 2) * KVBLK); }
        ATT_SBAR(); qkt(pB0, pB1, K_lds + s1 * SHM_K, qr, r32, hi); ATT_MASK(pB0, pB1, j);
        finishSM(pA0, pA1, alA, l_reg, pa0, pa1, pa2, pa3); ATT_SBAR();
        pv(o, vb0 + s0 * SHM_V, pa0, pa1, pa2, pa3); partialSM(pB0, pB1, m_reg, mnB, alB, ATT_KEEP(j));
        ATT_RESC(alB); ATT_ROT();
        if (j + 1 < NT) {
            __syncthreads();
            if (j + 2 < NT) { asm volatile("s_waitcnt vmcnt(0)" ::: "memory"); ATT_SWRITE(s2); if (j + 3 < NT) ATT_SLOAD((j + 3) * KVBLK); }
            ATT_SBAR(); qkt(pA0, pA1, K_lds + s1 * SHM_K, qr, r32, hi); ATT_MASK(pA0, pA1, j + 1);
            finishSM(pB0, pB1, alB, l_reg, pa0, pa1, pa2, pa3); ATT_SBAR();
            pv(o, vb0 + s0 * SHM_V, pa0, pa1, pa2, pa3); partialSM(pA0, pA1, m_reg, mnA, alA, ATT_KEEP(j + 1));
            ATT_RESC(alA); ATT_ROT();
        }
    }
    finishSM(pB0, pB1, alB, l_reg, pa0, pa1, pa2, pa3); ATT_SBAR();
    pv(o, vb0 + s0 * SHM_V, pa0, pa1, pa2, pa3);
#undef ATT_ROT
    if (hi == 0) li_l[r32] = l_reg; asm volatile("s_waitcnt lgkmcnt(0)" ::: "memory");
    float rli[16];
#pragma unroll
    for (int r = 0; r < 16; ++r) rli[r] = __builtin_amdgcn_rcpf(li_l[crow(r, hi)]);
    bf16* Ow = wsp<bf16>(F, WS_MIX) + (rowbase + q0 + wid * QBLK) * DM + h * HD;
    float* ssqa = wsp<float>(F, WS_SSQA) + (rowbase + q0 + wid * QBLK) * NH + h;
    float qq[16];
#pragma unroll
    for (int r = 0; r < 16; ++r) { const int orow = crow(r, hi); float q2 = 0.f;
#pragma unroll
        for (int d0 = 0; d0 < 2; ++d0) { const float v = o[d0][r] * rli[r]; const float vn = __shfl_xor(v, 1); q2 += v * v;
            if ((r32 & 1) == 0) *(unsigned*)(Ow + (size_t)orow * DM + d0 * 32 + r32) = cvt_pk_bf16(v, vn); }
        qq[r] = q2; }
#pragma unroll
    for (int i = 0; i < 8; ++i) { const bool up = (lane & 16) != 0; const float send = up ? qq[i] : qq[i + 8], keep = up ? qq[i + 8] : qq[i]; qq[i] = keep + __shfl_xor(send, 16); }
#pragma unroll
    for (int i = 0; i < 4; ++i) { const bool up = (lane & 8) != 0; const float send = up ? qq[i] : qq[i + 4], keep = up ? qq[i + 4] : qq[i]; qq[i] = keep + __shfl_xor(send, 8); }
#pragma unroll
    for (int i = 0; i < 2; ++i) { const bool up = (lane & 4) != 0; const float send = up ? qq[i] : qq[i + 2], keep = up ? qq[i + 2] : qq[i]; qq[i] = keep + __shfl_xor(send, 4); }
    { const bool up = (lane & 2) != 0; const float send = up ? qq[0] : qq[1], keep = up ? qq[1] : qq[0]; qq[0] = keep + __shfl_xor(send, 2); }
    qq[0] += __shfl_xor(qq[0], 1);
    if ((lane & 1) == 0) ssqa[(size_t)crow(r32 >> 1, hi) * NH] = qq[0];
    __syncthreads();
#undef ATT_SLOAD
#undef ATT_SWRITE
#undef ATT_RESC
#undef ATT_MASK
#undef ATT_KEEP
}
}

namespace gm {
__device__ __forceinline__ int vt_off(int d, int s) { return d * 256 + ((((s >> 3) ^ (d & 15)) & 15) << 4) + (s & 7) * 2; }
__device__ __forceinline__ void units4(const Frame& F, int v, LAS unsigned char* scratch) {
    PHASE_IDS;
    const int tid = TID_, wid = tid >> 6, lane = tid & 63, fr = lane & 15, fq = lane >> 4;
    const int u = wid >> 1, half = wid & 1, uidx = 4 * v + u, b = uidx >> 6, c = (uidx >> 2) & 15, g = uidx & 3;
    const size_t row0 = (size_t)b * SEQ + c * GC;
    const bf16* VGg = wsp<bf16>(F, WS_VG) + row0 * GW + g * GD; const bf16* Ug = wsp<bf16>(F, WS_U) + row0 * GW + g * GD;
    LAS unsigned char* vt = scratch + u * 32768;
    { const int s_ = half * 64 + lane; const v4u* src = (const v4u*)(VGg + (size_t)s_ * GW); v4u raw[16]; float sum = 0.f, sq = 0.f;
#pragma unroll
      for (int i = 0; i < 16; ++i) raw[i] = src[i];
#pragma unroll
      for (int i = 0; i < 16; ++i) { const unsigned ww[4] = {raw[i].x, raw[i].y, raw[i].z, raw[i].w};
#pragma unroll
          for (int k = 0; k < 4; ++k) { const float a0 = bflo(ww[k]), a1 = bfhi(ww[k]); sum += a0 + a1; sq += a0 * a0 + a1 * a1; } }
      const float mu = sum * (1.f / GD); const float var = fmaxf(sq * (1.f / GD) - mu * mu, 0.f); const float rstd = 1.0f / sqrtf(var + EPS);
      const float* lg = F.ln_g + g * GD; const float* lb = F.ln_b + g * GD;
#pragma unroll
      for (int i = 0; i < 16; ++i) { const unsigned ww[4] = {raw[i].x, raw[i].y, raw[i].z, raw[i].w}; const f32x4 g0 = *(const f32x4*)(lg + 8 * i), g1 = *(const f32x4*)(lg + 8 * i + 4), b0 = *(const f32x4*)(lb + 8 * i), b1 = *(const f32x4*)(lb + 8 * i + 4);
          const float gg[8] = {g0[0], g0[1], g0[2], g0[3], g1[0], g1[1], g1[2], g1[3]}, bb[8] = {b0[0], b0[1], b0[2], b0[3], b1[0], b1[1], b1[2], b1[3]};
#pragma unroll
          for (int k = 0; k < 4; ++k) { const int d = 8 * i + 2 * k;
              *(LAS unsigned short*)(vt + vt_off(d, s_)) = (unsigned short)f2bf((bflo(ww[k]) - mu) * rstd * gg[2 * k] + bb[2 * k]);
              *(LAS unsigned short*)(vt + vt_off(d + 1, s_)) = (unsigned short)f2bf((bfhi(ww[k]) - mu) * rstd * gg[2 * k + 1] + bb[2 * k + 1]); } } }
    __syncthreads();
#pragma unroll 1
    for (int m = 0; m < 4; ++m) {
        const int tb = half * 64 + m * 16, t = tb + fr;
        const float* Wg = F.gws + (size_t)g * GC * GC + (size_t)t * GC;
        const int nks = (tb + 16 + 31) / 32;
        f32x4 w0[4], w1[4];
#pragma unroll
        for (int ks = 0; ks < 4; ++ks) if (ks < nks) { w0[ks] = *(const f32x4*)(Wg + ks * 32 + fq * 8); w1[ks] = *(const f32x4*)(Wg + ks * 32 + fq * 8 + 4); }
        const bf16* Ut = Ug + (size_t)t * GW + 4 * fq; v2u uu[8];
#pragma unroll
        for (int n = 0; n < 8; ++n) uu[n] = *(const v2u*)(Ut + n * 16);
        f32x4 acc[8];
#pragma unroll
        for (int n = 0; n < 8; ++n) acc[n] = (f32x4){0.f, 0.f, 0.f, 0.f};
#pragma unroll
        for (int ks = 0; ks < 4; ++ks) if (ks < nks) { const int s0 = ks * 32 + fq * 8;
            float wv[8] = {w0[ks][0], w0[ks][1], w0[ks][2], w0[ks][3], w1[ks][0], w1[ks][1], w1[ks][2], w1[ks][3]};
#pragma unroll
            for (int j = 0; j < 8; ++j) if (s0 + j > t) wv[j] = 0.f;
            v4u aw; aw.x = pk2(wv[0], wv[1]); aw.y = pk2(wv[2], wv[3]); aw.z = pk2(wv[4], wv[5]); aw.w = pk2(wv[6], wv[7]);
            const bf16x8 wf = *reinterpret_cast<const bf16x8*>(&aw);
#pragma unroll
            for (int n = 0; n < 8; ++n) { const bf16x8 vf = *(const LAS bf16x8*)(vt + vt_off(n * 16 + fr, s0));
                acc[n] = __builtin_amdgcn_mfma_f32_16x16x32_bf16(vf, wf, acc[n], 0, 0, 0); } }
        bf16* Og = wsp<bf16>(F, WS_MIX) + (row0 + t) * DM + AW + g * GD + 4 * fq; float* ssqg = wsp<float>(F, WS_SSQG) + (row0 + t) * GG + g;
        const float bs = F.gbs[g * GC + t]; float q2 = 0.f;
#pragma unroll
        for (int n = 0; n < 8; ++n) { const float o0 = bflo(uu[n].x) * (acc[n][0] + bs), o1 = bfhi(uu[n].x) * (acc[n][1] + bs), o2 = bflo(uu[n].y) * (acc[n][2] + bs), o3 = bfhi(uu[n].y) * (acc[n][3] + bs);
            q2 += (o0 * o0 + o1 * o1) + (o2 * o2 + o3 * o3); v2u w; w.x = cvt_pk_bf16(o0, o1); w.y = cvt_pk_bf16(o2, o3); *(v2u*)(Og + n * 16) = w; }
        q2 += __shfl_xor(q2, 16); q2 += __shfl_xor(q2, 32);
        if (fq == 0) ssqg[0] = q2;
    }
    __syncthreads();
}
}

__device__ __forceinline__ void p2_mixers(const Frame& F) {
    PHASE_IDS;
    LAS unsigned char* scratch = F.lds + RING_OFF;
    const int v = F.vcu, bh = v >> 1, s0 = (v & 1) * 2, cslot = (v >> 1) % 6;
    int item = 0;
#pragma unroll 1
    for (int st = 0; st < 6; ++st) {
        if (st == cslot) { constexpr int PER_WG = XW_ITEMS / 256; static_assert(XW_ITEMS % 256 == 0 && PER_WG % NWAVES == 0, "items per workgroup / wave");
            LAS float* scr = (LAS float*)(F.lds + RING_OFF + WAVE_ * P0_SCR_WAVE);
            constexpr int NI = PER_WG / NWAVES; static_assert(NI % 2 == 0, "pairs");
            int ln = LANE_; asm volatile("" : "+v"(ln));
            const int it0 = v * PER_WG + WAVE_; f32x4 va[16], vb[16]; XwDesc da = xw_desc(F, it0, ln), db; xw_load(va, da);
#pragma unroll 1
            for (int j = 0; j < NI; j += 2) {
                db = xw_desc(F, it0 + (j + 1) * NWAVES, ln); xw_load(vb, db);
                xw_process(va, da, scr, ln);
                if (j + 2 < NI) { da = xw_desc(F, it0 + (j + 2) * NWAVES, ln); xw_load(va, da); }
                xw_process(vb, db, scr, ln);
            }
            __syncthreads(); }
        else { if (item < 4) { const int qq = s0 + (item >> 1); const int qb = (item & 1) ? 7 - qq : qq; att::attn_unit(F, bh / NH, bh % NH, qb, scratch); }
               else gm::units4(F, v, scratch);
               ++item; }
    }
}

__device__ __forceinline__ void p4_router(const Frame& F) {
    PHASE_IDS;
    const int tid = TID_, wid = tid >> 6, lane = tid & 63, tk = lane & 31, hf = lane >> 5;
    LAS unsigned* hist = (LAS unsigned*)(F.lds + XTAB_OFF + 4096);
    LAS unsigned* base = hist + 32;
    static_assert(XTAB_OFF + 4096 >= 8 * P0_SCR_WAVE, "router words above the conversion tiles");
    const bf16* RWT = wsp<bf16>(F, WS_RWT); const bf16* x1 = wsp<bf16>(F, WS_X1B); const float* ssq1 = wsp<float>(F, WS_SSQ1);
    unsigned* cntg = (unsigned*)(F.ctl + CW_CNT);
    unsigned* IDX = wsp<unsigned>(F, WS_IDX); float* GSS = wsp<float>(F, WS_GSS); float* RSS = wsp<float>(F, WS_RSS); unsigned* TOKPOS = wsp<unsigned>(F, WS_TOKPOS);
    if (tid < 32) hist[tid] = 0u;
    __syncthreads();
    const bool active = wid < 4; const int tok = (F.vcu * 4 + (wid & 3)) * 32 + tk;
    int pe[4] = {0, 0, 0, 0}; float pg[4] = {0.f, 0.f, 0.f, 0.f}; unsigned rank[2] = {0u, 0u}; int my_e[2] = {0, 0}; float my_g[2] = {0.f, 0.f}; float rstd = 0.f;
    f32x16 acc = f32x16{};
    { constexpr int PITCH = 528; LAS unsigned char* XL = F.lds + RING_OFF; LAS unsigned char* WL = XL + 128 * PITCH;
      const int rsub = lane >> 5, cb = (lane & 31) * 16;
      const char* xsrc = (const char*)(x1 + (size_t)(F.vcu * 128 + 16 * wid + rsub) * DM) + cb; const char* wsrc = (const char*)(RWT + (size_t)(8 * wid + rsub) * DM) + cb;
      LAS unsigned char* xdst = XL + (16 * wid + rsub) * PITCH + cb; LAS unsigned char* wdst = WL + (8 * wid + rsub) * PITCH + cb;
      const LAS unsigned char* xb = XL + ((wid & 3) * 32 + tk) * PITCH + hf * 16; const LAS unsigned char* wa = WL + tk * PITCH + hf * 16; const LAS unsigned char* wb = wa + 32 * PITCH;
      v4u xs[8], ws_[4];
#define RT_LOAD(c) do { _Pragma("unroll") for (int i = 0; i < 8; ++i) xs[i] = *(const v4u*)(xsrc + (size_t)(2 * i) * DM * 2 + (c) * 512); \
                        _Pragma("unroll") for (int i = 0; i < 4; ++i) ws_[i] = *(const v4u*)(wsrc + (size_t)(2 * i) * DM * 2 + (c) * 512); } while (0)
      RT_LOAD(0);
#pragma unroll 1
      for (int c = 0; c < 4; ++c) {
#pragma unroll
          for (int i = 0; i < 8; ++i) *(LAS v4u*)(xdst + 2 * i * PITCH) = xs[i];
#pragma unroll
          for (int i = 0; i < 4; ++i) *(LAS v4u*)(wdst + 2 * i * PITCH) = ws_[i];
          __syncthreads();
          if (c < 3) RT_LOAD(c + 1);
          if (active) {
#pragma unroll
              for (int s_ = 0; s_ < 16; ++s_) { const bf16x8 xv = *(const LAS bf16x8*)(xb + 32 * s_), a_hi = *(const LAS bf16x8*)(wa + 32 * s_), a_lo = *(const LAS bf16x8*)(wb + 32 * s_);
                  acc = __builtin_amdgcn_mfma_f32_32x32x16_bf16(a_hi, xv, acc, 0, 0, 0); acc = __builtin_amdgcn_mfma_f32_32x32x16_bf16(a_lo, xv, acc, 0, 0, 0); } }
          __syncthreads();
      }
#undef RT_LOAD
    }
    if (active) {
        { const f32x4* sp = (const f32x4*)(ssq1 + (size_t)tok * 16); const f32x4 a = sp[0], b = sp[1], c = sp[2], d = sp[3];
          const float s_ = ((a[0] + a[1]) + (a[2] + a[3])) + ((b[0] + b[1]) + (b[2] + b[3])) + ((c[0] + c[1]) + (c[2] + c[3])) + ((d[0] + d[1]) + (d[2] + d[3]));
          rstd = 1.0f / sqrtf(s_ * (1.f / DM) + EPS); }
        float lv[16];
#pragma unroll
        for (int r = 0; r < 16; ++r) { const int e = (r & 3) + 8 * (r >> 2) + 4 * hf; lv[r] = acc[r] * rstd + F.router_b[e]; }
        float tv[4]; int ti[4]; unsigned used = 0u;
#pragma unroll
        for (int k = 0; k < 4; ++k) { float best = -__builtin_inff(); int br = 0;
#pragma unroll
            for (int r = 0; r < 16; ++r) { const int e = (r & 3) + 8 * (r >> 2) + 4 * hf; const int eb = (br & 3) + 8 * (br >> 2) + 4 * hf;
                const bool better = !((used >> r) & 1u) && (lv[r] > best || (lv[r] == best && e < eb)); if (better) { best = lv[r]; br = r; } }
            used |= 1u << br; tv[k] = best; ti[k] = (br & 3) + 8 * (br >> 2) + 4 * hf; }
        float ov[4]; int oi[4];
#pragma unroll
        for (int k = 0; k < 4; ++k) { ov[k] = __shfl_xor(tv[k], 32); oi[k] = __shfl_xor(ti[k], 32); }
        int ia = 0, ib = 0;
#pragma unroll
        for (int k = 0; k < 4; ++k) {
            float va = tv[0], vb = ov[0]; int ea = ti[0], eb = oi[0];
#pragma unroll
            for (int q = 1; q < 4; ++q) { if (ia == q) { va = tv[q]; ea = ti[q]; } if (ib == q) { vb = ov[q]; eb = oi[q]; } }
            const bool takeA = (va > vb) || (va == vb && ea < eb);
            pg[k] = takeA ? va : vb; pe[k] = takeA ? ea : eb; if (takeA) ++ia; else ++ib; }
        { const float m = pg[0]; float s_ = 0.f;
#pragma unroll
          for (int k = 0; k < 4; ++k) { pg[k] = __builtin_amdgcn_exp2f((pg[k] - m) * 1.4426950408889634f); s_ += pg[k]; }
          const float inv = 1.0f / s_;
#pragma unroll
          for (int k = 0; k < 4; ++k) pg[k] *= inv; }
        { const int m = -hf; my_e[0] = pe[0] ^ ((pe[0] ^ pe[2]) & m); my_e[1] = pe[1] ^ ((pe[1] ^ pe[3]) & m);
          const unsigned g0 = __float_as_uint(pg[0]), g1 = __float_as_uint(pg[1]), g2 = __float_as_uint(pg[2]), g3 = __float_as_uint(pg[3]);
          my_g[0] = __uint_as_float(g0 ^ ((g0 ^ g2) & (unsigned)m)); my_g[1] = __uint_as_float(g1 ^ ((g1 ^ g3) & (unsigned)m)); }
#pragma unroll
        for (int q = 0; q < 2; ++q) rank[q] = atomicAdd((unsigned*)&hist[my_e[q]], 1u);
    }
    __syncthreads();
    if (tid < 32) base[tid] = atomicAdd(cntg + tid * CNT_STRIDE, hist[tid]);
    __syncthreads();
    if (active) {
#pragma unroll
        for (int q = 0; q < 2; ++q) { const int k = 2 * hf + q; const int e = my_e[q]; const float g = my_g[q];
            const unsigned slot = base[e] + rank[q];
            IDX[(size_t)e * T + slot] = (unsigned)tok; GSS[(size_t)e * T + slot] = g; RSS[(size_t)e * T + slot] = rstd; TOKPOS[(size_t)tok * 4 + k] = ((unsigned)e << 16) | slot; }
    }
    __syncthreads();
}

__device__ __forceinline__ void build_tstart(const Frame& F, LAS unsigned* tstart, int tid) {
    if (tid < 64) { const unsigned* cntg = (const unsigned*)(F.ctl + CW_CNT); unsigned c = (tid < NE) ? cntg[tid * CNT_STRIDE] : 0u; if (c > (unsigned)T) c = (unsigned)T;
        unsigned x = (c + 255u) >> 8;
#pragma unroll
        for (int o = 1; o < 32; o <<= 1) { const unsigned y = __shfl_up(x, o); if ((tid & 63) >= o) x += y; }
        if (tid < NE) tstart[tid + 1] = x; if (tid == 0) tstart[0] = 0u; }
}
constexpr int MAXU = 17;
constexpr int XT_TSTART = 0, XT_ULIST = 256, XT_RS = 512, XT_GTAB = XT_RS + MAXU * 1024;
static_assert(XT_GTAB + MAXU * 512 <= LDSCTL_OFF - XTAB_OFF, "xtab");
__device__ __forceinline__ int moe_build_tables(const Frame& F, int P  , int mode) {
    PHASE_IDS;
    LAS unsigned* tstart = (LAS unsigned*)(F.lds + XTAB_OFF + XT_TSTART);
    LAS unsigned* ulist = (LAS unsigned*)(F.lds + XTAB_OFF + XT_ULIST);
    LAS float* rs = (LAS float*)(F.lds + XTAB_OFF + XT_RS);
    LAS unsigned short* gtab = (LAS unsigned short*)(F.lds + XTAB_OFF + XT_GTAB);
    const unsigned* cntg = (const unsigned*)(F.ctl + CW_CNT); const unsigned* IDX = wsp<unsigned>(F, WS_IDX);
    const float* RSRC = mode == 1 ? wsp<float>(F, WS_RSS) : wsp<float>(F, WS_GSS);
    const int tid = TID_;
    build_tstart(F, tstart, tid);
    __syncthreads();
    const int NT_ = (int)tstart[NE], U = NT_ * P, G = F.G, c = (int)blockIdx.x;
    int nunits = (c < U) ? (U - c + G - 1) / G : 0; if (nunits > MAXU) nunits = MAXU;
    if (tid < nunits) { const int L = tid * G + c; int gt, pn; pg8::flat_to_tile(L, U, NT_, P, gt, pn);
        int e = 0; for (int k = 1; k < NE; ++k) if ((unsigned)gt >= tstart[k]) e = k;
        const int rt = gt - (int)tstart[e];
        ulist[tid] = (unsigned)gt | ((unsigned)pn << 10) | ((unsigned)e << 13) | ((unsigned)rt << 18); }
    __syncthreads();
    {
        constexpr int NP = (MAXU + 1) / 2; unsigned tokv[NP]; float rsv[NP];
#pragma unroll
        for (int p = 0; p < NP; ++p) { const int i = 2 * p + (tid >> 8), r = tid & 255; tokv[p] = 0u; rsv[p] = 0.f;
            if (i < nunits) { const unsigned w = ulist[i]; const int e = (int)((w >> 13) & 0x1fu), rt = (int)(w >> 18);
                unsigned cn = cntg[e * CNT_STRIDE]; if (cn > (unsigned)T) cn = (unsigned)T; const unsigned slot = (unsigned)rt * 256u + (unsigned)r;
                if (slot < cn) { if (mode == 1) tokv[p] = IDX[(size_t)e * T + slot]; rsv[p] = RSRC[(size_t)e * T + slot]; } } }
#pragma unroll
        for (int p = 0; p < NP; ++p) { const int i = 2 * p + (tid >> 8), r = tid & 255;
            if (i < nunits) { unsigned tok = tokv[p]; if (tok >= (unsigned)T) tok = 0u; if (mode == 1) gtab[i * 256 + r] = (unsigned short)tok; rs[i * 256 + r] = rsv[p]; } }
    }
    __syncthreads();
    return nunits;
}

__device__ __forceinline__ void p7_combine(const Frame& F) {
    PHASE_IDS;
    LAS unsigned* tstart = (LAS unsigned*)(F.lds + XTAB_OFF + XT_TSTART);
    const unsigned* cntg = (const unsigned*)(F.ctl + CW_CNT);
    build_tstart(F, tstart, TID_); (void)cntg;
    __syncthreads();
    const int gw = F.vcu * NWAVES + WAVE_, NGW = F.G * NWAVES;
    const unsigned* TOKPOS = wsp<unsigned>(F, WS_TOKPOS); const unsigned char* Y = wsp<unsigned char>(F, WS_YBUF); const bf16* X1 = wsp<bf16>(F, WS_X1B); bf16* X2 = wsp<bf16>(F, WS_X2B); unsigned char* X28 = wsp<unsigned char>(F, WS_X2F8); float* RS2 = wsp<float>(F, WS_RSTD2);
    for (int m0 = gw; m0 < T; m0 += 2 * NGW) {
        f32x4 v[2][4]; unsigned yv[2][4][4]; float s[2] = {0.f, 0.f};
#pragma unroll
        for (int r = 0; r < 2; ++r) { const int m = m0 + r * NGW;
            const v4u tp = *(const v4u*)(TOKPOS + (size_t)m * 4); const unsigned tpw[4] = {tp.x, tp.y, tp.z, tp.w};
            size_t yrow[4];
#pragma unroll
            for (int k = 0; k < 4; ++k) { const unsigned e = (tpw[k] >> 16) & 31u, slot = tpw[k] & 0xffffu; yrow[k] = ((size_t)tstart[e] * 256u + slot) * DM; }
#pragma unroll
            for (int j = 0; j < 4; ++j) { const v2u xw = *(const v2u*)(X1 + (size_t)m * DM + 4 * LANE_ + 256 * j); v[r][j] = (f32x4){bflo(xw.x), bfhi(xw.x), bflo(xw.y), bfhi(xw.y)};
#pragma unroll
                for (int k = 0; k < 4; ++k) yv[r][j][k] = *(const unsigned*)(Y + yrow[k] + 4 * LANE_ + 256 * j); } }
#pragma unroll
        for (int r = 0; r < 2; ++r) {
#pragma unroll
            for (int j = 0; j < 4; ++j) {
#pragma unroll
                for (int k = 0; k < 4; ++k) { const unsigned w = yv[r][j][k]; const f32x2 lo = __builtin_amdgcn_cvt_pk_f32_fp8((int)w, false), hi2 = __builtin_amdgcn_cvt_pk_f32_fp8((int)w, true);
                    v[r][j][0] += lo[0] * (1.0f / Y_SCALE); v[r][j][1] += lo[1] * (1.0f / Y_SCALE); v[r][j][2] += hi2[0] * (1.0f / Y_SCALE); v[r][j][3] += hi2[1] * (1.0f / Y_SCALE); }
                s[r] += (v[r][j].x * v[r][j].x + v[r][j].y * v[r][j].y) + (v[r][j].z * v[r][j].z + v[r][j].w * v[r][j].w); } }
#pragma unroll
        for (int r = 0; r < 2; ++r) { const int m = m0 + r * NGW; const float rstd = 1.0f / sqrtf(wave_sum(s[r]) * (1.f / DM) + EPS);
            if (LANE_ == 0) RS2[m] = rstd;
#pragma unroll
            for (int j = 0; j < 4; ++j) { v2u w; w.x = cvt_pk_bf16(v[r][j].x, v[r][j].y); w.y = cvt_pk_bf16(v[r][j].z, v[r][j].w); *(v2u*)(X2 + (size_t)m * DM + 4 * LANE_ + 256 * j) = w;
                *(unsigned*)(X28 + (size_t)m * DM + 4 * LANE_ + 256 * j) = pk4_fp8(v[r][j].x, v[r][j].y, v[r][j].z, v[r][j].w); } }
    }
}

__device__ __forceinline__ void p9_final(const Frame& F) {
    PHASE_IDS;
    const int gw = F.vcu * NWAVES + WAVE_, NGW = F.G * NWAVES;
    const unsigned char* GATE = wsp<unsigned char>(F, WS_GATE); const unsigned char* PP = wsp<unsigned char>(F, WS_PP); const float* ssqpp = wsp<float>(F, WS_SSQPP);
    for (int m0 = gw; m0 < T; m0 += 2 * NGW) {
        f32x4 v[2][4]; unsigned gv[2][4], pv_[2][4]; f32x4 sq[2][4]; float s[2] = {0.f, 0.f};
#pragma unroll
        for (int r = 0; r < 2; ++r) { const int m = m0 + r * NGW; const bf16* x2r = wsp<bf16>(F, WS_X2B) + (size_t)m * DM;
#pragma unroll
            for (int q = 0; q < 4; ++q) sq[r][q] = *(const f32x4*)(ssqpp + (size_t)m * 16 + 4 * q);
#pragma unroll
            for (int j = 0; j < 4; ++j) { const int col = 4 * LANE_ + 256 * j; const v2u xw = *(const v2u*)(x2r + col); v[r][j] = (f32x4){bflo(xw.x), bfhi(xw.x), bflo(xw.y), bfhi(xw.y)};
                gv[r][j] = *(const unsigned*)(GATE + (size_t)m * DM + col); pv_[r][j] = *(const unsigned*)(PP + (size_t)m * DM + col); } }
#pragma unroll
        for (int r = 0; r < 2; ++r) { const f32x4 a = sq[r][0], b = sq[r][1], c = sq[r][2], d = sq[r][3];
            const float sp = ((a[0] + a[1]) + (a[2] + a[3])) + ((b[0] + b[1]) + (b[2] + b[3])) + ((c[0] + c[1]) + (c[2] + c[3])) + ((d[0] + d[1]) + (d[2] + d[3]));
            const float rpp = 1.0f / sqrtf(sp * (1.f / DM) + EPS);
#pragma unroll
            for (int j = 0; j < 4; ++j) { const int col = 4 * LANE_ + 256 * j; const f32x4 pg_ = *(const f32x4*)(F.ppn + col);
                const f32x2 g01 = __builtin_amdgcn_cvt_pk_f32_fp8((int)gv[r][j], false), g23 = __builtin_amdgcn_cvt_pk_f32_fp8((int)gv[r][j], true);
                const f32x2 p01 = __builtin_amdgcn_cvt_pk_f32_fp8((int)pv_[r][j], false), p23 = __builtin_amdgcn_cvt_pk_f32_fp8((int)pv_[r][j], true);
                const float rg = rpp * (1.0f / GATE_SCALE);
                v[r][j][0] += g01[0] * (p01[0] * rg * pg_[0]); v[r][j][1] += g01[1] * (p01[1] * rg * pg_[1]);
                v[r][j][2] += g23[0] * (p23[0] * rg * pg_[2]); v[r][j][3] += g23[1] * (p23[1] * rg * pg_[3]);
                s[r] += (v[r][j].x * v[r][j].x + v[r][j].y * v[r][j].y) + (v[r][j].z * v[r][j].z + v[r][j].w * v[r][j].w); } }
#pragma unroll
        for (int r = 0; r < 2; ++r) { const int m = m0 + r * NGW; float* xr = F.out + (size_t)m * DM; const float rstd = 1.0f / sqrtf(wave_sum(s[r]) * (1.f / DM) + EPS);
#pragma unroll
            for (int j = 0; j < 4; ++j) { const int col = 4 * LANE_ + 256 * j; const f32x4 fg = *(const f32x4*)(F.final_norm + col); __builtin_nontemporal_store(v[r][j] * rstd * fg, (f32x4*)(xr + col)); } }
    }
}

struct Args { const float* in[23]; float* out; unsigned char* ws; };
#if CHECK_STAGE
__device__ __forceinline__ unsigned hmix(unsigned z) { z ^= z >> 16; z *= 0x7feb352du; z ^= z >> 15; z *= 0x846ca68bu; z ^= z >> 16; return z; }
__device__ __forceinline__ void chk_add(const Frame& F, int st, bool bad) { atomicAdd((unsigned*)(F.ctl + CW_CHK + 2 * st), bad ? 1u : 0u); atomicAdd((unsigned*)(F.ctl + CW_CHK + 2 * st + 1), 1u); }
__device__ __forceinline__ bool offby(float got, float ex, float rel, float ab) { const float d = fabsf(got - ex); return !(d <= rel * fabsf(ex) + ab); }
__device__ __forceinline__ float dot_bf(const bf16* a, const bf16* b, int n) { float s = 0.f; for (int k = 0; k < n; ++k) s += bf2f(a[k]) * bf2f(b[k]); return s; }
__device__ __forceinline__ float gelu_ref(float v) { return 0.5f * v * (1.0f + erff(v * 0.70710678f)); }
__device__ __forceinline__ unsigned chk_tstart(const Frame& F, unsigned ex) { const unsigned* cntg = (const unsigned*)(F.ctl + CW_CNT); unsigned s_ = 0; for (unsigned e = 0; e < ex; ++e) { unsigned c = cntg[e * CNT_STRIDE]; if (c > (unsigned)T) c = T; s_ += (c + 255u) >> 8; } return s_; }
template <int ST> __device__ __forceinline__ void stage_check(const Frame& F) {
    const unsigned gt = (unsigned)blockIdx.x * NTHR + threadIdx.x;
    const unsigned h0 = hmix(gt * 2654435761u + ST * 40503u), h1 = hmix(h0 + 0x9e3779b9u), h2 = hmix(h1 + 0x85ebca6bu);
    if (ST == 1) {
        if (gt >= 16384) return;
        const int which = gt & 7;
        if (which == 0) { const int e = h0 % NE, n = h1 % (2 * FF), k = h2 % DM; const int lc = CmWgu()(n);
            const float ex = bf2f((bf16)f2bf(F.w_gu[((size_t)e * DM + k) * 2 * FF + lc] * F.ffn_norm[k])); chk_add(F, ST, offby(bf2f(wsp<bf16>(F, WS_WGU)[((size_t)e * 2 * FF + n) * DM + k]), ex, 1e-6f, 1e-30f)); }
        else if (which == 1) { const int e = h0 % NE, n = h1 % DM, k = h2 % FF;
            const float ex = bf2f((bf16)f2bf(F.w_dn[((size_t)e * FF + k) * DM + n])); chk_add(F, ST, offby(bf2f(wsp<bf16>(F, WS_WDN)[((size_t)e * DM + n) * FF + k]), ex, 1e-6f, 1e-30f)); }
        else if (which == 2) { const int n = h1 % NPROJ, k = h2 % DM; const int lc = CmWin()(n);
            const float ex = bf2f((bf16)f2bf(F.w_in[(size_t)k * NPROJ + lc] * F.mix_norm[k])); chk_add(F, ST, offby(bf2f(wsp<bf16>(F, WS_WIN)[(size_t)n * DM + k]), ex, 1e-6f, 1e-30f)); }
        else if (which == 3) { const int n = h1 % DM, k = h2 % DM; const float g = k < AW ? F.aon[k] : F.gon[k - AW];
            const float ex = bf2f((bf16)f2bf(F.w_out[(size_t)k * DM + n] * g)); chk_add(F, ST, offby(bf2f(wsp<bf16>(F, WS_WOUT)[(size_t)n * DM + k]), ex, 1e-6f, 1e-30f)); }
        else if (which == 4) { const int n = h1 % DM, k = h2 % DM;
            const float ex = bf2f((bf16)f2bf(F.w_pg[(size_t)k * DM + n] * F.ple_norm[k])); chk_add(F, ST, offby(bf2f(wsp<bf16>(F, WS_WPG)[(size_t)n * DM + k]), ex, 1e-6f, 1e-30f)); }
        else if (which == 5) { const int n = h1 % DM, k = h2 % PLE;
            const float ex = bf2f((bf16)f2bf(F.w_pp[(size_t)k * DM + n])); chk_add(F, ST, offby(bf2f(wsp<bf16>(F, WS_WPP)[(size_t)n * PLE + k]), ex, 1e-6f, 1e-30f)); }
        else if (which == 6) { const int row = h0 % T, k = h1 % DM; float ss = 0.f; for (int j = 0; j < DM; ++j) { const float v = F.x[(size_t)row * DM + j]; ss += v * v; }
            const float ex = F.x[(size_t)row * DM + k] / sqrtf(ss / DM + EPS); chk_add(F, ST, offby(bf2f(wsp<bf16>(F, WS_XNB)[(size_t)row * DM + k]), ex, 0.01f, 1e-3f)); }
        else { const int row = h0 % T, k = h1 % PLE; chk_add(F, ST, offby(bf2f(wsp<bf16>(F, WS_PB)[(size_t)row * PLE + k]), F.p[(size_t)row * PLE + k], 0.005f, 1e-6f)); }
    }
    if (ST == 2) {
        if (gt >= 16384) return;
        const bf16* XN = wsp<bf16>(F, WS_XNB); const bf16* WIN = wsp<bf16>(F, WS_WIN);
        if ((gt & 7) == 7) {
            const int b = h0 % BATCH, hh = h1 % NH, blk = h2 % NBLK, c = (h2 >> 8) % HD; float s_ = 0.f;
            for (int r = 0; r < 256; ++r) s_ += bf2f(wsp<bf16>(F, WS_K)[((size_t)b * SEQ + blk * 256 + r) * AW + hh * HD + c]);
            chk_add(F, ST, offby(wsp<float>(F, WS_KMEAN)[((size_t)(b * NH + hh) * NBLK + blk) * HD + c], s_, 0.02f, 0.3f)); return; }
        const int row = h0 % T, type = h1 % 5, c = h2 % AW; const bf16* xr = XN + (size_t)row * DM;
        const float v = dot_bf(xr, WIN + (size_t)(type * AW + c) * DM, DM); float ex;
        if (type <= 1) { const float vp = dot_bf(xr, WIN + (size_t)(type * AW + (c ^ 4)) * DM, DM); const int i = 4 * ((c & 63) >> 3) + (c & 3), pos = row & (SEQ - 1);
            const float cs = wsp<float>(F, WS_ROPE)[pos * 32 + i], sn = wsp<float>(F, WS_ROPE)[SEQ * 32 + pos * 32 + i];
            { const float inv = powf(10000.0f, -(float)i / 32.0f); const float ang = (float)pos * inv; if (offby(cs, cosf(ang), 0.f, 1e-3f) || offby(sn, sinf(ang), 0.f, 1e-3f)) { chk_add(F, ST, true); return; } }
            ex = (c & 4) ? v * cs + vp * sn : v * cs - vp * sn; }
        else if (type == 2) ex = v; else ex = gelu_ref(v);
        chk_add(F, ST, offby(bf2f(wsp<bf16>(F, WS_Q)[(size_t)type * (16u << 20) + (size_t)row * AW + c]), ex, 0.02f, 0.02f));
    }
    if (ST == 3) {
        if (gt >= 8192) return;
        if (gt & 1) {
            const int row = h0 % T, g = h1 % GG, d = h2 % GD; const int b = row / SEQ, s_ = row % SEQ, c = s_ / GC, t = s_ % GC; float acc = 0.f;
            for (int sp = 0; sp <= t; ++sp) { const bf16* vr = wsp<bf16>(F, WS_VG) + ((size_t)b * SEQ + c * GC + sp) * GW + g * GD; float mu = 0.f; for (int j = 0; j < GD; ++j) mu += bf2f(vr[j]); mu /= GD;
                float var = 0.f; for (int j = 0; j < GD; ++j) { const float dd = bf2f(vr[j]) - mu; var += dd * dd; } const float rstd = 1.0f / sqrtf(var / GD + EPS);
                const float vn = bf2f((bf16)f2bf((bf2f(vr[d]) - mu) * rstd * F.ln_g[g * GD + d] + F.ln_b[g * GD + d])); acc += bf2f((bf16)f2bf(F.gws[((size_t)g * GC + t) * GC + sp])) * vn; }
            const float ex = bf2f(wsp<bf16>(F, WS_U)[(size_t)row * GW + g * GD + d]) * (acc + F.gbs[g * GC + t]);
            chk_add(F, ST, offby(bf2f(wsp<bf16>(F, WS_MIX)[(size_t)row * DM + AW + g * GD + d]), ex, 0.03f, 0.02f)); return; }
        const int row = h0 % T, hh = h1 % NH; const int b = row / SEQ, s_ = row % SEQ, qb = s_ / MOBA; float q[HD];
#pragma unroll
        for (int c = 0; c < HD; ++c) q[c] = bf2f(wsp<bf16>(F, WS_Q)[(size_t)row * AW + hh * HD + c]);
        unsigned sel = 0u;
        if (qb <= 3) sel = (1u << qb) - 1u;
        else { float b0 = -__builtin_inff(), b1 = b0, b2 = b0; int i0 = 0, i1 = 0, i2 = 0;
            for (int j = 0; j < qb; ++j) { const float* km = wsp<float>(F, WS_KMEAN) + ((size_t)(b * NH + hh) * NBLK + j) * HD; float g = 0.f;
#pragma unroll
                for (int c = 0; c < HD; ++c) g += q[c] * km[c];
                if (g > b0) { b2 = b1; i2 = i1; b1 = b0; i1 = i0; b0 = g; i0 = j; } else if (g > b1) { b2 = b1; i2 = i1; b1 = g; i1 = j; } else if (g > b2) { b2 = g; i2 = j; } }
            sel = (1u << i0) | (1u << i1) | (1u << i2); }
        float mx = -__builtin_inff();
        for (int kp = 0; kp <= s_; ++kp) { const int blk = kp / MOBA; if (blk != qb && !((sel >> blk) & 1u)) continue; const bf16* kr = wsp<bf16>(F, WS_K) + ((size_t)b * SEQ + kp) * AW + hh * HD; float sc = 0.f;
#pragma unroll
            for (int c = 0; c < HD; ++c) sc += q[c] * bf2f(kr[c]);
            mx = fmaxf(mx, sc * 0.125f); }
        float o[HD]; float l = 0.f;
#pragma unroll
        for (int c = 0; c < HD; ++c) o[c] = 0.f;
        for (int kp = 0; kp <= s_; ++kp) { const int blk = kp / MOBA; if (blk != qb && !((sel >> blk) & 1u)) continue; const bf16* kr = wsp<bf16>(F, WS_K) + ((size_t)b * SEQ + kp) * AW + hh * HD; float sc = 0.f;
#pragma unroll
            for (int c = 0; c < HD; ++c) sc += q[c] * bf2f(kr[c]);
            const float pr = expf(sc * 0.125f - mx); l += pr; const bf16* vr = wsp<bf16>(F, WS_V) + ((size_t)b * SEQ + kp) * AW + hh * HD;
#pragma unroll
            for (int c = 0; c < HD; ++c) o[c] += pr * bf2f(vr[c]); }
        bool bad = false; float ss = 0.f;
#pragma unroll
        for (int c = 0; c < HD; ++c) { const float ex = o[c] / l; ss += ex * ex; bad |= offby(bf2f(wsp<bf16>(F, WS_MIX)[(size_t)row * DM + hh * HD + c]), ex, 0.04f, 0.02f); }
        bad |= offby(wsp<float>(F, WS_SSQA)[(size_t)row * NH + hh], ss, 0.03f, 1e-3f);
        chk_add(F, ST, bad);
    }
    if (ST == 4) {
        if (gt >= 16384) return;
        const int row = h0 % T, col = h1 % DM; const bf16* mr = wsp<bf16>(F, WS_MIX) + (size_t)row * DM; const bf16* wr_ = wsp<bf16>(F, WS_WOUT) + (size_t)col * DM;
        float sa = 0.f, sg = 0.f, da = 0.f, dg = 0.f;
        for (int k = 0; k < AW; ++k) { const float a = bf2f(mr[k]), g = bf2f(mr[AW + k]); sa += a * a; sg += g * g; da += a * bf2f(wr_[k]); dg += g * bf2f(wr_[AW + k]); }
        const float ex = F.x[(size_t)row * DM + col] + da / sqrtf(sa / AW + EPS) + dg / sqrtf(sg / GW + EPS);
        chk_add(F, ST, offby(F.out[(size_t)row * DM + col], ex, 0.01f, 0.03f));
    }
    if (ST == 5) {
        if (gt >= 8192) return;
        const int tok = h0 % T; const float* xr = F.out + (size_t)tok * DM; float ss = 0.f; for (int k = 0; k < DM; ++k) ss += xr[k] * xr[k]; const float rstd = 1.0f / sqrtf(ss / DM + EPS);
        bool bad = false;
        for (int j = 0; j < 4; ++j) { const int k = (h1 >> (8 * j)) % DM; bad |= offby(bf2f(wsp<bf16>(F, WS_XNB)[(size_t)tok * DM + k]), xr[k] * rstd, 0.01f, 1e-3f); }
        float lg[NE];
#pragma unroll
        for (int e = 0; e < NE; ++e) lg[e] = 0.f;
        for (int k = 0; k < DM; ++k) { const float xv = xr[k] * rstd * F.ffn_norm[k];
#pragma unroll
            for (int e = 0; e < NE; ++e) lg[e] += xv * F.router_w[k * NE + e]; }
#pragma unroll
        for (int e = 0; e < NE; ++e) lg[e] += F.router_b[e];
        int te[4]; float tv[4]; unsigned used = 0u;
#pragma unroll
        for (int k = 0; k < 4; ++k) { float best = -__builtin_inff(); int bi = 0;
#pragma unroll
            for (int e = 0; e < NE; ++e) if (!((used >> e) & 1u) && lg[e] > best) { best = lg[e]; bi = e; }
            used |= 1u << bi; te[k] = bi; tv[k] = best; }
        { float gg[4]; float den = 0.f;
#pragma unroll
          for (int k = 0; k < 4; ++k) { float v = -__builtin_inff();
#pragma unroll
              for (int e = 0; e < NE; ++e) if (e == te[k]) v = lg[e];
              gg[k] = v; }
          const float mm = gg[0];
#pragma unroll
          for (int k = 0; k < 4; ++k) { gg[k] = expf(gg[k] - mm); den += gg[k]; }
          const unsigned* tp = wsp<unsigned>(F, WS_TOKPOS) + (size_t)tok * 4;
#pragma unroll
          for (int k = 0; k < 4; ++k) { const unsigned e = tp[k] >> 16, slot = tp[k] & 0xffffu; bad |= (e != (unsigned)te[k]);
              if (e < NE && slot < (unsigned)T) { bad |= wsp<unsigned>(F, WS_IDX)[(size_t)e * T + slot] != (unsigned)tok; bad |= offby(wsp<float>(F, WS_GSS)[(size_t)e * T + slot], gg[k] / den, 2e-3f, 1e-5f);
                  bad |= slot >= ((const unsigned*)(F.ctl + CW_CNT))[e * CNT_STRIDE]; } else bad = true; } }
        (void)tv;
        chk_add(F, ST, bad);
    }
    if (ST == 6 || ST == 7) {
        if (gt >= 16384) return;
        const int tok = h0 % T, k = h1 & 3, col = (h1 >> 2) % FF; const unsigned tp = wsp<unsigned>(F, WS_TOKPOS)[(size_t)tok * 4 + k]; const unsigned e = tp >> 16, slot = tp & 0xffffu;
        if (e >= NE) { chk_add(F, ST, true); return; }
        const unsigned tse = chk_tstart(F, e);
        const size_t row = (size_t)tse * 256 + slot;
        if (ST == 6) { const bf16* xr = wsp<bf16>(F, WS_XNB) + (size_t)tok * DM; const int np = (col >> 7) * 256 + (col & 127);
            const float g = dot_bf(xr, wsp<bf16>(F, WS_WGU) + ((size_t)e * 2 * FF + np) * DM, DM) + F.b_gu[(size_t)e * 2 * FF + col];
            const float l = dot_bf(xr, wsp<bf16>(F, WS_WGU) + ((size_t)e * 2 * FF + np + 128) * DM, DM) + F.b_gu[(size_t)e * 2 * FF + FF + col];
            const float gc = fminf(g, 7.f), lc = fminf(fmaxf(l, -7.f), 7.f); const float ex = gc / (1.0f + expf(-1.702f * gc)) * (lc + 1.0f);
            chk_add(F, ST, offby(bf2f(wsp<bf16>(F, WS_ABUF)[row * FF + col]), ex, 0.03f, 0.03f)); }
        else { const float d = dot_bf(wsp<bf16>(F, WS_ABUF) + row * FF, wsp<bf16>(F, WS_WDN) + ((size_t)e * DM + col) * FF, FF) + F.b_dn[(size_t)e * DM + col];
            const float ex = d * wsp<float>(F, WS_GSS)[(size_t)e * T + slot];
            chk_add(F, ST, offby(bf2f(wsp<bf16>(F, WS_YBUF)[row * DM + col]), ex, 0.03f, 0.01f)); }
    }
    if (ST == 8) {
        if (gt >= 8192) return;
        const int tok = h0 % T; const float* xr = F.out + (size_t)tok * DM; float ss = 0.f; for (int k = 0; k < DM; ++k) ss += xr[k] * xr[k]; const float rstd = 1.0f / sqrtf(ss / DM + EPS);
        bool bad = false; for (int k = 0; k < DM; ++k) { bad |= offby(bf2f(wsp<bf16>(F, WS_X2N)[(size_t)tok * DM + k]), xr[k] * rstd, 0.01f, 1e-3f); bad |= !(fabsf(xr[k]) < 30.f); }
        chk_add(F, ST, bad);
    }
    if (ST == 9) {
        if (gt >= 16384) return;
        const int row = h0 % T, col = h1 % DM;
        if (gt & 1) { const float d = dot_bf(wsp<bf16>(F, WS_X2N) + (size_t)row * DM, wsp<bf16>(F, WS_WPG) + (size_t)col * DM, DM); const float got = bf2f(wsp<bf16>(F, WS_GATE)[(size_t)row * DM + col]); const float ex = 1.0f / (1.0f + expf(-d)); const bool bad = offby(got, ex, 0.02f, 0.01f); chk_add(F, ST, bad);
            if (bad) { atomicOr((unsigned*)(F.ctl + CW_CHK + 40), 1u << ((col >> 3) & 31)); atomicOr((unsigned*)(F.ctl + CW_CHK + 41), 1u << ((row >> 3) & 31)); atomicOr((unsigned*)(F.ctl + CW_CHK + 42), 1u << (col & 7)); atomicOr((unsigned*)(F.ctl + CW_CHK + 43), 1u << (row & 7));
                if (!(got >= 0.f && got <= 1.f)) atomicAdd((unsigned*)(F.ctl + CW_CHK + 44), 1u); { int cl = (int)floorf(log2f(fabsf(got) + 1e-30f)) + 40; cl = cl < 0 ? 0 : (cl > 80 ? 80 : cl); atomicMax((unsigned*)(F.ctl + CW_CHK + 46), (unsigned)cl); atomicMin((unsigned*)(F.ctl + CW_CHK + 47), 0xffffffffu - (unsigned)cl); if (got < 0.f) atomicAdd((unsigned*)(F.ctl + CW_CHK + 48), 1u); } if (fabsf(got - ex) > 0.2f) atomicAdd((unsigned*)(F.ctl + CW_CHK + 45), 1u); } }
        else { const float d = dot_bf(wsp<bf16>(F, WS_PB) + (size_t)row * PLE, wsp<bf16>(F, WS_WPP) + (size_t)col * PLE, PLE); chk_add(F, 10, offby(bf2f(wsp<bf16>(F, WS_PP)[(size_t)row * DM + col]), d, 0.02f, 0.02f)); }
    }
}
__device__ __forceinline__ void check_report(const Frame& F) {
    float c2 = 3.0f;
    for (int st = 1; st <= 10; ++st) { const unsigned bad = F.ctl[CW_CHK + 2 * st], tot = F.ctl[CW_CHK + 2 * st + 1]; const float fr = tot ? (float)bad / (float)tot : 1.0f;
        (void)fr; if (((CHECK_SKIP >> st) & 1) == 0 && bad >= 1u) { c2 = powf(10.0f, (float)st) * (1.0f + fminf((float)bad, 80.0f) * 0.1f); break; } }
#if CHECK_REPORT >= 40
    { unsigned v = F.ctl[CW_CHK + CHECK_REPORT]; if (CHECK_REPORT == 47) v = 0xffffffffu - v; c2 = powf(10.0f, (float)(v >> 27)) * (1.0f + (float)((v >> 21) & 63u) * 0.1f);
#if CHECK_REPORT2
      c2 = powf(10.0f, (float)((v >> 16) & 31u)) * (1.0f + (float)((v >> 10) & 63u) * 0.1f);
#endif
#if CHECK_REPORT3
      c2 = powf(10.0f, (float)((v >> 5) & 31u)) * (1.0f + (float)(v & 31u) * 0.1f);
#endif
      if (CHECK_REPORT >= 46 && CHECK_REPORT <= 47) c2 = powf(10.0f, (float)(v / 9u)) * (1.0f + (float)(v % 9u));
    }
#endif
    if (g_gridbar[XB_TMO] != 0u) c2 = 1e20f;
    const float c = sqrtf(c2);
    for (size_t i = (size_t)blockIdx.x * NTHR + threadIdx.x; i < (size_t)T * DM; i += (size_t)gridDim.x * NTHR) F.out[i] = c;
}
#define STAGE_CHECK(n) stage_check<(n)>(F)
#else
#define STAGE_CHECK(n) do {} while (0)
#endif

__global__ void __launch_bounds__(NTHR, 2) mega_fwd(Args args) {
    extern __shared__ __attribute__((aligned(16))) unsigned char lds_raw[];
    Frame F;
    F.lds = (LAS unsigned char*)lds_raw;
    F.MISC = (volatile LAS unsigned*)(F.lds + LDSCTL_OFF);
    F.G = gridDim.x; { const int bx = blockIdx.x; F.vcu = (F.G % 8 == 0) ? (bx % 8) * (F.G / 8) + bx / 8 : bx; }
    F.ws = args.ws; F.ctl = (gu32*)(args.ws + WS_CTL); F.out = args.out;
    F.x = args.in[0]; F.p = args.in[1]; F.mix_norm = args.in[2]; F.w_in = args.in[3]; F.ln_g = args.in[4]; F.ln_b = args.in[5]; F.gws = args.in[6]; F.gbs = args.in[7];
    F.aon = args.in[8]; F.gon = args.in[9]; F.w_out = args.in[10]; F.ffn_norm = args.in[11]; F.router_w = args.in[12]; F.router_b = args.in[13]; F.w_gu = args.in[14]; F.b_gu = args.in[15];
    F.w_dn = args.in[16]; F.b_dn = args.in[17]; F.ple_norm = args.in[18]; F.w_pg = args.in[19]; F.w_pp = args.in[20]; F.ppn = args.in[21]; F.final_norm = args.in[22];
    { PHASE_IDS; for (int u = TID_; u < 256; u += NTHR) ((LAS unsigned*)(F.lds + LDSCTL_OFF))[u] = 0u; }
    __syncthreads();
    XcdBarrier bar = xcd_barrier_post(g_gridbar, F.MISC + 8);
#define GRID_BAR() xcd_barrier(bar)
#define STAGE_END(n) do { STAGE_CHECK(n); if (TPROBE && blockIdx.x == 0 && threadIdx.x == 0) ((unsigned long long*)(F.ctl + CW_TS))[(n)] = __builtin_amdgcn_s_memrealtime(); } while (0)

    if (TPROBE && blockIdx.x == 0 && threadIdx.x == 0) ((unsigned long long*)(F.ctl + CW_TS))[0] = __builtin_amdgcn_s_memrealtime();
    for (int rep = 0; rep < (DUP_PHASE == 0 ? 2 : 1); ++rep) {
    if (PH(0)) p0_prologue(F);
    GRID_BAR(); }
    STAGE_END(1);
    if (PH(1)) { float* RC = wsp<float>(F, WS_ROPE);
      { pg8::DenseSched S; S.init(wsp<bf16>(F, WS_XNB), wsp<bf16>(F, WS_WIN), T, 2 * AW, DM, F.G, (int)blockIdx.x);
        EpiInProj E{wsp<bf16>(F, WS_Q), RC, RC + SEQ * 32, wsp<float>(F, WS_KMEAN), 0};
        pg8::gemm_phase<EpiInProj, pg8::DenseSched, false, false>(F.lds + RING_OFF, DM * 2, S, E); }
      { pg8::DenseSched S; S.init(wsp<unsigned char>(F, WS_XN8), wsp<unsigned char>(F, WS_WIN8), T, NPROJ - 2 * AW, DM, F.G, (int)blockIdx.x, 1);
        EpiInProj E{wsp<bf16>(F, WS_Q), RC, RC + SEQ * 32, wsp<float>(F, WS_KMEAN), 4};
        int Kb = DM; asm volatile("" : "+s"(Kb));
        pg8::gemm_phase<EpiInProj, pg8::DenseSched, false, false, true>(F.lds + RING_OFF, Kb, S, E); } }
    GRID_BAR();
    STAGE_END(2);
    for (int rep = 0; rep < (DUP_PHASE == 2 ? 2 : 1); ++rep) {
    if (PH(2)) p2_mixers(F);
    GRID_BAR(); }
    STAGE_END(3);
    if (PH(3)) { pg8::DenseSched S; S.init(wsp<bf16>(F, WS_MIX), wsp<bf16>(F, WS_WOUT), T, DM, DM, F.G, (int)blockIdx.x);
      LAS f32x4* rtab = (LAS f32x4*)(F.lds + XTAB_OFF);
      Unit ua, ub; const bool ha = S.next(0, ua), hb = S.next(1, ub);
      { PHASE_IDS; const int s = TID_ >> 8, r = TID_ & 255; const bool has = s ? hb : ha; const int pm = s ? ub.pm : ua.pm;
        if (has) { const size_t row = (size_t)pm * 256 + r; const f32x4* pa = (const f32x4*)(wsp<float>(F, WS_SSQA) + row * NH); const f32x4 a0 = pa[0], a1 = pa[1], g0 = *(const f32x4*)(wsp<float>(F, WS_SSQG) + row * GG);
            const float sa = ((a0[0] + a0[1]) + (a0[2] + a0[3])) + ((a1[0] + a1[1]) + (a1[2] + a1[3])), sg = (g0[0] + g0[1]) + (g0[2] + g0[3]);
            const float ra = 1.0f / sqrtf(sa * (1.f / AW) + EPS), rg = 1.0f / sqrtf(sg * (1.f / GW) + EPS);
            rtab[s * 256 + r] = (f32x4){ra / rg, rg, wsp<float>(F, WS_SIG0)[row], 0.f}; } }
      __syncthreads();
      EpiOutProj E{wsp<bf16>(F, WS_XNB), wsp<bf16>(F, WS_X1B), wsp<unsigned char>(F, WS_X1F8), wsp<float>(F, WS_SSQ1), rtab, F.ffn_norm, ha ? ua.pm : -1, hb ? ub.pm : -1};
      for (int rep = 0; rep < (DUP_PHASE == 3 ? 2 : 1); ++rep) { if (rep) GRID_BAR();
      pg8::gemm_phase<EpiOutProj, pg8::DenseSched, false, true>(F.lds + RING_OFF, DM * 2, S, E); } }
    GRID_BAR();
    STAGE_END(4);
    if (PH(4)) p4_router(F);
    GRID_BAR();
    STAGE_END(5);
    if (PH(5)) { const int nu = moe_build_tables(F, 2 * FF / 256, 1);
      pg8::MoeSched S{(const char*)wsp<char>(F, WS_X1F8), (const char*)wsp<char>(F, WS_WGU), 0, (size_t)2 * FF * DM, (size_t)256 * DM, nu,
                      (const LAS unsigned*)(F.lds + XTAB_OFF + XT_ULIST), (const LAS unsigned*)(F.lds + XTAB_OFF + XT_GTAB), true};
      EpiMoe1 E{wsp<unsigned char>(F, WS_ABUF), F.b_gu, (const LAS float*)(F.lds + XTAB_OFF + XT_RS)};
      for (int rep = 0; rep < (DUP_PHASE == 5 ? 2 : 1); ++rep) { if (rep) GRID_BAR();
      int Kb = DM; asm volatile("" : "+s"(Kb));
      pg8::gemm_phase<EpiMoe1, pg8::MoeSched, true, false, true>(F.lds + RING_OFF, Kb, S, E); } }
    GRID_BAR();
    STAGE_END(6);
    if (PH(6)) { const int nu = moe_build_tables(F, DM / 256, 2);
      pg8::MoeSched S{(const char*)wsp<char>(F, WS_ABUF), (const char*)wsp<char>(F, WS_WDN), (size_t)256 * FF, (size_t)DM * FF, (size_t)256 * FF, nu,
                      (const LAS unsigned*)(F.lds + XTAB_OFF + XT_ULIST), (const LAS unsigned*)(F.lds + XTAB_OFF + XT_GTAB), false};
      EpiMoe2 E{wsp<unsigned char>(F, WS_YBUF), F.b_dn, (const LAS float*)(F.lds + XTAB_OFF + XT_RS)};
      for (int rep = 0; rep < (DUP_PHASE == 6 ? 2 : 1); ++rep) { if (rep) GRID_BAR();
      int Kb = FF; asm volatile("" : "+s"(Kb));
      pg8::gemm_phase<EpiMoe2, pg8::MoeSched, false, false, true>(F.lds + RING_OFF, Kb, S, E); } }
    GRID_BAR();
    STAGE_END(7);
    if (PH(7)) { const int first = (blockIdx.x >> 3) & 1;
#pragma unroll 1
      for (int step = 0; step < 2; ++step) {
          if ((step ^ first) == 0) { p7_combine(F); __syncthreads(); }
          else { pg8::DenseSched S; S.init(wsp<bf16>(F, WS_PB), wsp<bf16>(F, WS_WPP), T, DM, PLE, F.G, (int)blockIdx.x);
              EpiPle<1> E{wsp<unsigned char>(F, WS_PP), wsp<float>(F, WS_SSQPP), nullptr, -1};
              int Kp = PLE * 2; asm volatile("" : "+s"(Kp));
              pg8::gemm_phase<EpiPle<1>, pg8::DenseSched, false, false>(F.lds + RING_OFF, Kp, S, E); } } }
    GRID_BAR();
    STAGE_END(8);
    if (PH(8)) { pg8::DenseSched S; S.init(wsp<unsigned char>(F, WS_X2F8), wsp<unsigned char>(F, WS_WPG8), T, DM, DM, F.G, (int)blockIdx.x, 1);
      LAS float* rt2 = (LAS float*)(F.lds + XTAB_OFF); Unit ua, ub; const bool ha = S.next(0, ua), hb = S.next(1, ub);
      { PHASE_IDS; const int sl = TID_ >> 8, r = TID_ & 255; const bool has = sl ? hb : ha; const int pm = sl ? ub.pm : ua.pm; if (has) rt2[sl * 256 + r] = wsp<float>(F, WS_RSTD2)[(size_t)pm * 256 + r]; }
      __syncthreads();
      EpiPle<0> E{wsp<unsigned char>(F, WS_GATE), nullptr, rt2, ha ? ua.pm : -1};
      int Kb = DM; asm volatile("" : "+s"(Kb));
      pg8::gemm_phase<EpiPle<0>, pg8::DenseSched, false, false, true>(F.lds + RING_OFF, Kb, S, E);
#if CHECK_STAGE
      GRID_BAR();
      int Kb = DM; asm volatile("" : "+s"(Kb));
      pg8::gemm_phase<EpiPle<0>, pg8::DenseSched, false, false, true>(F.lds + RING_OFF, Kb, S, E);
#endif
    }
#if CHECK_STAGE
    GRID_BAR(); STAGE_CHECK(9);
#endif
    GRID_BAR();
    STAGE_END(9);
#if CHECK_STAGE
    GRID_BAR(); check_report(F);
#else
    if (PH(9)) p9_final(F);
#if TPROBE
    GRID_BAR();
    if (blockIdx.x == 0 && threadIdx.x == 0) { const unsigned long long* ts = (const unsigned long long*)(F.ctl + CW_TS); const unsigned long long t1 = (TP_A == 9) ? __builtin_amdgcn_s_memrealtime() : ts[(TP_A < 10 ? TP_A : 0) + 1];
        unsigned long long d = t1 - ts[TP_A < 10 ? TP_A : 0];
        if (TP_A == 20) d = ts[11] - ts[0]; if (TP_A == 21) d = ts[12] - ts[11]; if (TP_A == 22) d = ts[13] - ts[12]; if (TP_A == 23) d = ts[1] - ts[13]; if (TP_A == 24) d = ts[14] - ts[2]; if (TP_A == 25) d = ts[3] - ts[14];
        if (TP_A == 30) d = (__builtin_amdgcn_s_memrealtime() - ts[0]) / 8;
        F.out[0] += floorf((float)d * 0.01f * 0.125f + 0.5f) * 2.0f; }
#endif
#endif
    __syncthreads();
    if (threadIdx.x == 0) {
        if (xb_add(&g_gridbar[XB_DONE], 1u) == gridDim.x - 1u) {
#pragma unroll 1
            for (unsigned j = 0; j < 16; ++j) { __hip_atomic_store(&g_gridbar[XB_XCNT(j)], 0u, __ATOMIC_RELAXED, __HIP_MEMORY_SCOPE_AGENT); __hip_atomic_store(&g_gridbar[XB_XSUB(j)], 0u, __ATOMIC_RELAXED, __HIP_MEMORY_SCOPE_AGENT);
                __hip_atomic_store(&g_gridbar[XB_XGEN(j)], 0u, __ATOMIC_RELAXED, __HIP_MEMORY_SCOPE_AGENT); }
            __hip_atomic_store(&g_gridbar[XB_TOP], 0u, __ATOMIC_RELAXED, __HIP_MEMORY_SCOPE_AGENT); __hip_atomic_store(&g_gridbar[XB_TOPGEN], 0u, __ATOMIC_RELAXED, __HIP_MEMORY_SCOPE_AGENT);
            __hip_atomic_store(&g_gridbar[XB_TMO], 0u, __ATOMIC_RELAXED, __HIP_MEMORY_SCOPE_AGENT); __hip_atomic_store(&g_gridbar[XB_DONE], 0u, __ATOMIC_RELAXED, __HIP_MEMORY_SCOPE_AGENT); } }
}

extern "C" void kernel_launch(void* const* d_in, const int* in_sizes, int n_in, void* d_out, int out_size, void* d_ws, size_t ws_size, hipStream_t stream) {
    static int grid = 0;
    if (grid == 0) {
        if (n_in != 23 || in_sizes[0] != T * DM || out_size != T * DM || ws_size < WS_END) { fprintf(stderr, "kernel_launch: unexpected shapes (n_in %d, in0 %d, out %d, ws %zu)\n", n_in, n_in > 0 ? in_sizes[0] : -1, out_size, ws_size); grid = -1; return; }
        int dev = 0, cus = 0, per_cu = 0;
        if (hipGetDevice(&dev) != hipSuccess || hipDeviceGetAttribute(&cus, hipDeviceAttributeMultiprocessorCount, dev) != hipSuccess) { grid = -1; return; }
        if (hipFuncSetAttribute((const void*)mega_fwd, hipFuncAttributeMaxDynamicSharedMemorySize, LDS_BYTES) != hipSuccess) { fprintf(stderr, "kernel_launch: hipFuncSetAttribute failed\n"); grid = -1; return; }
        if (hipOccupancyMaxActiveBlocksPerMultiprocessor(&per_cu, (const void*)mega_fwd, NTHR, LDS_BYTES) != hipSuccess || per_cu < 1)
            fprintf(stderr, "kernel_launch: note: occupancy query reports %d workgroups per CU\n", per_cu);
        (void)hipGetLastError();
        if (cus < 256) { fprintf(stderr, "kernel_launch: built for a 256-CU device (found %d CUs); nothing launched\n", cus); grid = -1; return; }
        grid = 256;
    }
    if (grid < 0) return;
    Args a{};
    for (int i = 0; i < 23; ++i) a.in[i] = (const float*)d_in[i];
    a.out = (float*)d_out; a.ws = (unsigned char*)d_ws;
    hipLaunchKernelGGL(mega_fwd, dim3(grid), dim3(NTHR), LDS_BYTES, stream, a);
}
```

```cpp
#include <hip/hip_runtime.h>
#include <cstdio>
#include <cstdint>

#ifndef CHECK_STAGE
#define CHECK_STAGE 0
#endif
#ifndef CHECK_REPORT
#define CHECK_REPORT 0
#endif
#ifndef CHECK_REPORT2
#define CHECK_REPORT2 0
#endif
#ifndef CHECK_REPORT3
#define CHECK_REPORT3 0
#endif
#ifndef DUP_PHASE
#define DUP_PHASE -1
#endif
#ifndef TPROBE
#define TPROBE 0
#endif
#ifndef TP_A
#define TP_A 5
#endif
#ifndef TP_B
#define TP_B 6
#endif
#ifndef CHECK_SKIP
#define CHECK_SKIP 0
#endif
#ifndef PHMASK
#define PHMASK 0x3ff
#endif
#define PH(n) ((PHMASK >> (n)) & 1)

#define GAS __attribute__((address_space(1)))
#define LAS __attribute__((address_space(3)))
typedef unsigned short bf16;
typedef unsigned v4u __attribute__((ext_vector_type(4)));
typedef unsigned v2u __attribute__((ext_vector_type(2)));
typedef float f32x2 __attribute__((ext_vector_type(2)));
typedef float f32x4 __attribute__((ext_vector_type(4)));
typedef float f32x16 __attribute__((ext_vector_type(16)));
typedef short bf16x8 __attribute__((ext_vector_type(8)));
typedef short s16x4 __attribute__((ext_vector_type(4)));
typedef GAS unsigned gu32;

constexpr int BATCH = 16, SEQ = 2048, DM = 1024, T = BATCH * SEQ;
constexpr int AW = 512, NH = 8, HD = 64, NBLK = 8, MOBA = 256;
constexpr int GW = 512, GG = 4, GD = 128, GC = 128;
constexpr int NPROJ = 3 * AW + 2 * GW;
constexpr int NE = 32, TOPK = 4, FF = 1024;
constexpr int PLE = 256;
constexpr int MAXROWS = T * TOPK + NE * 256;
constexpr float EPS = 1e-6f;
constexpr int NWAVES = 8, NTHR = 512;

constexpr size_t MiB = 1u << 20;
constexpr size_t WS_CTL = 0, CTL_ZERO_BYTES = 1 * MiB;
constexpr size_t WS_KMEAN = 256 * 1024;
constexpr size_t WS_WIN = 1 * MiB;
constexpr size_t WS_WOUT = 6 * MiB;
constexpr size_t WS_WPG = 8 * MiB;
constexpr size_t WS_WPP = 10 * MiB;
constexpr size_t WS_RWG = 10 * MiB + 512 * 1024;
constexpr size_t WS_ROPE = 11 * MiB;
constexpr size_t WS_WGU = 16 * MiB;
constexpr size_t WS_WDN = 144 * MiB;
constexpr size_t WS_XNB = 208 * MiB;
constexpr size_t WS_BIG1 = 272 * MiB;
constexpr size_t WS_Q = WS_BIG1, WS_K = WS_Q + 32 * MiB, WS_V = WS_K + 32 * MiB, WS_U = WS_V + 32 * MiB, WS_VG = WS_U + 32 * MiB, WS_MIX = WS_VG + 32 * MiB;
constexpr size_t WS_YBUF = WS_BIG1;
constexpr size_t WS_BIG2 = 544 * MiB;
constexpr size_t WS_ABUF = WS_BIG2, WS_GATE = WS_BIG2, WS_PP = WS_BIG2 + 64 * MiB;
constexpr size_t WS_PB = 816 * MiB;
constexpr size_t WS_IDX = 832 * MiB;
constexpr size_t WS_GSS = 836 * MiB;
constexpr size_t WS_TOKPOS = 840 * MiB;
constexpr size_t WS_SSQA = 841 * MiB;
constexpr size_t WS_SSQG = 842 * MiB;
constexpr size_t WS_SSQ1 = 843 * MiB;
constexpr size_t WS_SSQPP = 845 * MiB;
constexpr size_t WS_X1F8 = 848 * MiB;
constexpr size_t WS_X2N = WS_XNB;
constexpr size_t WS_X1B = 880 * MiB;
constexpr size_t WS_X2B = 944 * MiB;
constexpr size_t WS_SIG0 = 1008 * MiB;
constexpr size_t WS_RSTD2 = 1008 * MiB + 256 * 1024;
constexpr size_t WS_RWT = 1008 * MiB + 512 * 1024;
constexpr size_t WS_RSS = 1009 * MiB;
constexpr size_t WS_X2F8 = 176 * MiB;
constexpr size_t WS_WPG8 = 80 * MiB;
constexpr size_t WS_END = 1013 * MiB;
static_assert(WS_MIX + 64 * MiB <= WS_BIG2 && (size_t)MAXROWS * 1024 * 2 <= 272 * MiB, "ws map");
constexpr int CW_TMO = 0, CW_CODE = 1;
constexpr int CW_BAR = 4096;
constexpr int CW_CNT = 8192, CNT_STRIDE = 32;
constexpr int CW_TS = 12000;
constexpr int CW_CHK = 12288;

constexpr int RING_OFF = 0, RING_BYTES = 131072;
constexpr int P0_SCR_WAVE = 64 * 65 * 4;
constexpr int LDS_BYTES_TOTAL = 163840;
constexpr int LDSCTL_OFF = LDS_BYTES_TOTAL - 1024;
constexpr int XTAB_OFF = RING_BYTES;
static_assert(8 * P0_SCR_WAVE <= LDSCTL_OFF && XTAB_OFF >= RING_BYTES, "lds map");
constexpr int LDS_BYTES = LDS_BYTES_TOTAL;

#define RLX_AGENT __ATOMIC_RELAXED, __HIP_MEMORY_SCOPE_AGENT
#define LDS_WAIT() asm volatile("s_waitcnt lgkmcnt(0)" ::: "memory")
#define VM_WAIT() asm volatile("s_waitcnt vmcnt(0)" ::: "memory")
__device__ __forceinline__ unsigned f2bf(float f) { unsigned u = __builtin_bit_cast(unsigned, f); return (u + 0x7fffu + ((u >> 16) & 1u)) >> 16; }
__device__ __forceinline__ unsigned pk2(float lo, float hi) { return f2bf(lo) | (f2bf(hi) << 16); }
__device__ __forceinline__ float bf2f(unsigned short b) { return __builtin_bit_cast(float, ((unsigned)b) << 16); }
__device__ __forceinline__ float bflo(unsigned w) { return __builtin_bit_cast(float, w << 16); }
__device__ __forceinline__ float bfhi(unsigned w) { return __builtin_bit_cast(float, w & 0xffff0000u); }
typedef __bf16 bf16x2_t __attribute__((ext_vector_type(2)));
__device__ __forceinline__ unsigned cvt_pk_bf16(float lo, float hi) { const f32x2 v = {lo, hi}; const bf16x2_t b = __builtin_convertvector(v, bf16x2_t); return __builtin_bit_cast(unsigned, b); }
__device__ __forceinline__ float clamp448(float x) { return fminf(fmaxf(x, -448.0f), 448.0f); }
__device__ __forceinline__ unsigned pk4_fp8(float a, float b, float c, float d) { unsigned w = 0u; w = (unsigned)__builtin_amdgcn_cvt_pk_fp8_f32(clamp448(a), clamp448(b), (int)w, false); w = (unsigned)__builtin_amdgcn_cvt_pk_fp8_f32(clamp448(c), clamp448(d), (int)w, true); return w; }
__device__ __forceinline__ unsigned pk4_fp8_nc(float a, float b, float c, float d) { unsigned w = 0u; w = (unsigned)__builtin_amdgcn_cvt_pk_fp8_f32(a, b, (int)w, false); w = (unsigned)__builtin_amdgcn_cvt_pk_fp8_f32(c, d, (int)w, true); return w; }
__device__ __forceinline__ float fp8_to_f(unsigned v) { const unsigned sg = (v >> 7) & 1u, e = (v >> 3) & 15u, m = v & 7u; const float r = e ? ldexpf(1.0f + (float)m * 0.125f, (int)e - 7) : ldexpf((float)m * 0.125f, -6); return sg ? -r : r; }
__device__ __forceinline__ float wave_sum(float v) {
#pragma unroll
    for (int o = 1; o < 64; o <<= 1) v += __shfl_xor(v, o);
    return v;
}
__device__ __forceinline__ f32x2 gelu_pk(f32x2 v) {
    const f32x2 av = __builtin_elementwise_abs(v), d = av * 0.2316418882f + 1.0f;
    f32x2 t; t.x = __builtin_amdgcn_rcpf(d.x); t.y = __builtin_amdgcn_rcpf(d.y);
    f32x2 q = t * 0.5307027145f + (-0.7265760135f); q = q * t + 0.7107068705f; q = q * t + (-0.142248368f); q = q * t + 0.127414796f; q = q * t;
    const f32x2 s = (v * v) * (-0.72134752044f);
    f32x2 e; e.x = __builtin_amdgcn_exp2f(s.x); e.y = __builtin_amdgcn_exp2f(s.y);
    const f32x2 m = v * (q * e), r = v - m;
    f32x2 o; o.x = v.x < 0.f ? m.x : r.x; o.y = v.y < 0.f ? m.y : r.y; return o;
}
__device__ __forceinline__ f32x4 gelu4(f32x4 v) { const f32x2 a = gelu_pk((f32x2){v[0], v[1]}), b = gelu_pk((f32x2){v[2], v[3]}); return (f32x4){a.x, a.y, b.x, b.y}; }
__device__ __forceinline__ float sigmoidf_fast(float x) { return __builtin_amdgcn_rcpf(1.0f + __builtin_amdgcn_exp2f(-1.4426950408889634f * x)); }

#define XB_TMO      128
#define XB_XCNT(j)  (256  + 64 * (j))
#define XB_XSUB(j)  (1280 + 64 * (j))
#define XB_XGEN(j)  (2304 + 64 * (j))
#define XB_TOP      3328
#define XB_TOPGEN   3392
#define XCD_BAR_WORDS 3456
#define XB_SPIN_CAP (1u << 18)
__device__ __forceinline__ unsigned xb_ld(unsigned* p)              { return __hip_atomic_load(p, __ATOMIC_RELAXED, __HIP_MEMORY_SCOPE_AGENT); }
__device__ __forceinline__ unsigned xb_add(unsigned* p, unsigned v) { return __hip_atomic_fetch_add(p, v, __ATOMIC_RELAXED, __HIP_MEMORY_SCOPE_AGENT); }
__device__ __forceinline__ unsigned xb_xcc_id() { return (unsigned)__builtin_amdgcn_s_getreg((3 << 11) | 20) & 0xFu; }
#define XB_SPIN(cond, bar) do { unsigned _sp = 0; while (cond) { __builtin_amdgcn_s_sleep(1); \
    if ((++_sp & 255u) == 0u) { if (xb_ld(&(bar)[XB_TMO])) break; if (_sp > XB_SPIN_CAP) { atomicAdd(&(bar)[XB_TMO], 1u); break; } } } } while (0)
#define XB_DONE     64
__device__ unsigned g_gridbar[4096];
struct XcdBarrier { unsigned* bar; unsigned x; volatile LAS unsigned* st; };
__device__ __forceinline__ XcdBarrier xcd_barrier_post(unsigned* bar, volatile LAS unsigned* st) {
    XcdBarrier b; b.bar = bar; b.x = xb_xcc_id(); b.st = st;
    if (threadIdx.x == 0) (void)xb_add(&bar[XB_XCNT(b.x)], 1u);
    return b;
}
__device__ __forceinline__ void xcd_barrier_complete(unsigned* bar, unsigned x, unsigned& nloc, unsigned& nx) {
    const unsigned G = gridDim.x * gridDim.y * gridDim.z;
    unsigned sum, cnt, mine, sp = 0u;
    for (;;) {
        sum = 0u; cnt = 0u; mine = 0u;
#pragma unroll
        for (unsigned j = 0; j < 16; ++j) { const unsigned c = xb_ld(&bar[XB_XCNT(j)]); sum += c; cnt += (c > 0u) ? 1u : 0u; mine = (j == x) ? c : mine; }
        if (sum == G) break;
        __builtin_amdgcn_s_sleep(1);
        if ((++sp & 255u) == 0u) { if (xb_ld(&bar[XB_TMO])) break; if (sp > XB_SPIN_CAP) { atomicAdd(&bar[XB_TMO], 1u); break; } }
    }
    nloc = mine > 0u ? mine : 1u; nx = cnt > 0u ? cnt : 1u;
}
__device__ __forceinline__ void xcd_barrier(const XcdBarrier& b) {
    asm volatile("s_waitcnt vmcnt(0)" ::: "memory");
    __syncthreads();
    if (threadIdx.x == 0) {
        unsigned* bar = b.bar;
        __builtin_amdgcn_s_waitcnt(0);
        unsigned nloc = b.st[0], nx = b.st[1];
        if (nloc == 0u) { xcd_barrier_complete(bar, b.x, nloc, nx); b.st[0] = nloc; b.st[1] = nx; }
        const unsigned old = xb_add(&bar[XB_XSUB(b.x)], 1u);
        const unsigned gen = old / nloc;
        if (old + 1u == (gen + 1u) * nloc) {
            __builtin_amdgcn_fence(__ATOMIC_RELEASE, "agent");
            asm volatile("s_waitcnt vmcnt(0)" ::: "memory");
            const unsigned og = xb_add(&bar[XB_TOP], 1u);
            const unsigned tg = og / nx;
            if (og + 1u == (tg + 1u) * nx) xb_add(&bar[XB_TOPGEN], 1u);
            else XB_SPIN(xb_ld(&bar[XB_TOPGEN]) == tg, bar);
            __builtin_amdgcn_fence(__ATOMIC_ACQUIRE, "agent");
            xb_add(&bar[XB_XGEN(b.x)], 1u);
            asm volatile("s_waitcnt vmcnt(0)" ::: "memory");
        } else {
            XB_SPIN(xb_ld(&bar[XB_XGEN(b.x)]) == gen, bar);
            __builtin_amdgcn_fence(__ATOMIC_ACQUIRE, "agent");
            asm volatile("s_waitcnt vmcnt(0)" ::: "memory");
        }
    }
    __syncthreads();
}

namespace pg8 {
constexpr int BM = 256, BK = 64, HALF = 128, HTB = HALF * BK * 2, STAGE_BYTES = 8 * HTB, NXCD = 8, WGM = 8;
__host__ __device__ __forceinline__ int lds_byte(int r, int c) { const int st = (r >> 4) * 2 + (c >> 5), rr = r & 15, cc = c & 31, ob = rr * 64 + cc * 2; return st * 1024 + (ob ^ (((ob >> 9) & 1) << 5)); }
__host__ __device__ __forceinline__ void stage_rc(int b, int& R, int& C) { const int st = b / 1024, sb = b % 1024, swz = sb ^ (((sb >> 9) & 1) << 5); R = (st >> 1) * 16 + swz / 64; C = (st & 1) * 32 + (swz % 64) / 2; }
__host__ __device__ __forceinline__ int perm32(int rho) { const int n = rho >> 4, i = rho & 15; return 8 * (i >> 2) + 4 * n + (i & 3); }

typedef int v8i __attribute__((ext_vector_type(8)));
constexpr int F8_WSHIFT = 6, F8_SCALE_W = 127 - F8_WSHIFT;
typedef int v4i __attribute__((ext_vector_type(4)));
__device__ __forceinline__ v8i ld8(const LAS unsigned char* p0, const LAS unsigned char* p1) { const v4i lo = *(const LAS v4i*)p0, hi = *(const LAS v4i*)p1; return __builtin_shufflevector(lo, hi, 0, 1, 2, 3, 4, 5, 6, 7); }
struct Unit { int pm, pn, e, rt, slot; };

__device__ __forceinline__ void flat_to_tile(int L, int nwg, int nM, int nN, int& pm, int& pn) {
    int wgid = L; { const int q = nwg / NXCD, r = nwg % NXCD, xcd = wgid % NXCD, off = wgid / NXCD; wgid = (xcd < r ? xcd * (q + 1) : r * (q + 1) + (xcd - r) * q) + off; }
    const int nig = WGM * nN, gid = wgid / nig, fm = gid * WGM, gsz = (nM - fm) < WGM ? (nM - fm) : WGM;
    pm = fm + ((wgid % nig) % gsz); pn = (wgid % nig) / gsz;
}
struct DenseSched {
    const char* A; const char* Bt; int nM, nN, nwg, G, c; size_t tstep;
    __device__ __forceinline__ void init(const void* A_, const void* Bt_, int M, int N, int K, int G_, int c_, int ebytes = 2) { A = (const char*)A_; Bt = (const char*)Bt_; nM = M / BM; nN = N / BM; nwg = nM * nN; G = G_; c = c_; tstep = (size_t)BM * K * ebytes; }
    __device__ __forceinline__ bool next(int i, Unit& u) const { const long L = (long)i * G + c; if (L >= nwg) return false; flat_to_tile((int)L, nwg, nM, nN, u.pm, u.pn); u.e = 0; u.rt = u.pm; u.slot = i; return true; }
    __device__ __forceinline__ const char* a_base(const Unit& u) const { return A + (size_t)u.pm * tstep; }
    __device__ __forceinline__ const char* b_base(const Unit& u) const { return Bt + (size_t)u.pn * tstep; }
    __device__ __forceinline__ void gather(int, int, int, unsigned (&)[2][2]) const {}
};
struct MoeSched {
    const char* A; const char* Bt; size_t a_tstep, b_estep, b_tstep; int nunits; const LAS unsigned* ulist; const LAS unsigned* gtab; bool gath;
    __device__ __forceinline__ bool next(int i, Unit& u) const {
        if (i >= nunits) return false;
        const unsigned w = (unsigned)__builtin_amdgcn_readfirstlane((int)ulist[i]);
        u.pm = (int)(w & 0x3ffu); u.pn = (int)((w >> 10) & 0x7u); u.e = (int)((w >> 13) & 0x1fu); u.rt = (int)(w >> 18); u.slot = i; return true;
    }
    __device__ __forceinline__ const char* a_base(const Unit& u) const { return gath ? A : A + (size_t)u.pm * a_tstep; }
    __device__ __forceinline__ const char* b_base(const Unit& u) const { return Bt + (size_t)u.e * b_estep + (size_t)u.pn * b_tstep; }
    __device__ __forceinline__ void gather(int i, int R0, int R1, unsigned (&off)[2][2]) const {
        const LAS unsigned short* g = (const LAS unsigned short*)gtab + i * 256;
        off[0][0] = (unsigned)g[R0] << 10; off[0][1] = (unsigned)g[R1] << 10; off[1][0] = (unsigned)g[128 + R0] << 10; off[1][1] = (unsigned)g[128 + R1] << 10;
    }
};

#define PG8_SA(b, h) (((b) * 2 + (h)) * HTB)
#define PG8_SB(b, h) ((4 + (b) * 2 + (h)) * HTB)
#define PG8_GLDS(src, dstoff) __builtin_amdgcn_global_load_lds((const unsigned*)(src), (LAS unsigned*)(lds + (dstoff)), 16, 0, 0)
#define PG8_STAGE_B(bufoff, gbase) do { _Pragma("unroll") for (int _i = 0; _i < 2; ++_i) PG8_GLDS((const char*)(gbase) + voffB[_i], (bufoff) + ldsw + _i * 8192); } while (0)
#define PG8_STAGE_A(bufoff, kptr, h, o) do { _Pragma("unroll") for (int _i = 0; _i < 2; ++_i) \
        PG8_GLDS(GATHER ? (const char*)(kptr) + (o)[h][_i] : (const char*)(kptr) + (size_t)(h) * hstep + voffA[_i], (bufoff) + ldsw + _i * 8192); } while (0)
#define PG8_LDA(dst, b, h) do { _Pragma("unroll") for (int m = 0; m < 4; ++m) { if constexpr (F8) dst##8[m] = ld8(lds + PG8_SA(b, h) + a8_0 + m * 2048, lds + PG8_SA(b, h) + a8_1 + m * 2048); \
        else { _Pragma("unroll") for (int k = 0; k < 2; ++k) dst[m][k] = *(const LAS bf16x8*)(lds + PG8_SA(b, h) + aoff + m * 2048 + k * 1024); } } } while (0)
#define PG8_LDB(dst, b, h) do { _Pragma("unroll") for (int n = 0; n < 2; ++n) { if constexpr (F8) dst##8[n] = ld8(lds + PG8_SB(b, h) + b8_0 + n * 2048, lds + PG8_SB(b, h) + b8_1 + n * 2048); \
        else { _Pragma("unroll") for (int k = 0; k < 2; ++k) dst[n][k] = *(const LAS bf16x8*)(lds + PG8_SB(b, h) + boff + n * 2048 + k * 1024); } } } while (0)
#define PG8_MMA(ai, bj, At, Bt) do { __builtin_amdgcn_s_setprio(1); _Pragma("unroll") for (int m = 0; m < 4; ++m) _Pragma("unroll") for (int n = 0; n < 2; ++n) { \
        if constexpr (F8) asm volatile("v_mfma_scale_f32_16x16x128_f8f6f4 %0, %1, %2, %0, %3, %4 op_sel_hi:[0,0,0]" : "+v"(acc[ai][bj][m][n]) : "v"(Bt##8[n]), "v"(At##8[m]), "v"(sc_w), "v"(sc_a)); \
        else { _Pragma("unroll") for (int k = 0; k < 2; ++k) acc[ai][bj][m][n] = __builtin_amdgcn_mfma_f32_16x16x32_bf16(Bt[n][k], At[m][k], acc[ai][bj][m][n], 0, 0, 0); } } __builtin_amdgcn_s_setprio(0); } while (0)
#define PG8_WAIT_V(n) asm volatile("s_waitcnt vmcnt(" #n ")" ::: "memory")
#define PG8_WAIT_L(n) asm volatile("s_waitcnt lgkmcnt(" #n ")" ::: "memory")
#define PG8_BAR __builtin_amdgcn_s_barrier()
#define PG8_SCHED __builtin_amdgcn_sched_barrier(0)

template <class Epi, class Sched, bool GATHER, bool MIDK, bool F8 = false>
__device__ __forceinline__ void gemm_phase(LAS unsigned char* lds, const int KB  , const Sched& S, const Epi& E) {
    int tid = (int)threadIdx.x; asm volatile("" : "+v"(tid));
    const int wid = __builtin_amdgcn_readfirstlane(tid >> 6), lane = tid & 63, wr = wid >> 2, wc = wid & 3, fr = lane & 15, fq = lane >> 4;
    const int nt = KB / 128;
    unsigned voffA[2], voffB[2]; int Rg[2]; unsigned Cg[2];
#pragma unroll
    for (int i = 0; i < 2; ++i) { int R, C; stage_rc(tid * 16 + i * 8192, R, C); const int Rb = Epi::PERM ? ((R & ~31) + perm32(R & 31)) : R;
        voffA[i] = (unsigned)(R * KB + C * 2); voffB[i] = (unsigned)(Rb * KB + C * 2); Rg[i] = R; Cg[i] = (unsigned)C * 2u; }
    const size_t kstep = 128;
    const size_t hstep = (size_t)HALF * KB;
    const unsigned ldsw = (unsigned)wid * 1024u;
    const int aoff = lds_byte(wr * 64 + fr, fq * 8), boff = lds_byte(wc * 32 + fr, fq * 8);
    const int a8_0 = aoff, a8_1 = aoff + 1024, b8_0 = boff, b8_1 = boff + 1024;
    Unit cur, nxt; int ui = 0;
    if (!S.next(0, cur)) return;
    f32x4 acc[2][2][4][2];
#pragma unroll
    for (int a = 0; a < 2; ++a)
#pragma unroll
        for (int b = 0; b < 2; ++b)
#pragma unroll
            for (int m = 0; m < 4; ++m)
#pragma unroll
                for (int n = 0; n < 2; ++n) acc[a][b][m][n] = (f32x4){0.f, 0.f, 0.f, 0.f};
    bf16x8 At[4][2], B0[2][2], B1[2][2]; v8i At8[4], B08[2], B18[2];
    int sc_w = F8_SCALE_W, sc_a = 127; if constexpr (F8) { asm volatile("" : "+v"(sc_w), "+v"(sc_a)); }
    unsigned offC[2][2] = {{0u, 0u}, {0u, 0u}}, offN[2][2] = {{0u, 0u}, {0u, 0u}};
    if constexpr (GATHER) { S.gather(0, Rg[0], Rg[1], offC);
#pragma unroll
        for (int h = 0; h < 2; ++h)
#pragma unroll
            for (int i = 0; i < 2; ++i) offC[h][i] += Cg[i]; }
    const char* cA = S.a_base(cur); const char* cB = S.b_base(cur);
    PG8_STAGE_B(PG8_SB(0, 0), cB); PG8_STAGE_B(PG8_SB(0, 1), cB + hstep); PG8_STAGE_A(PG8_SA(0, 0), cA, 0, offC); PG8_STAGE_A(PG8_SA(0, 1), cA, 1, offC);
    if (wr == 1) PG8_BAR;
    PG8_WAIT_V(2); PG8_BAR;
    PG8_STAGE_B(PG8_SB(1, 0), cB + kstep); PG8_STAGE_A(PG8_SA(1, 0), cA + kstep, 0, offC); PG8_STAGE_B(PG8_SB(1, 1), cB + hstep + kstep);
    PG8_WAIT_V(6); PG8_BAR;
    for (;;) {
        const bool has_next = S.next(ui + 1, nxt);
        const char* nA = has_next ? S.a_base(nxt) : cA; const char* nB = has_next ? S.b_base(nxt) : cB;
        if constexpr (GATHER) { if (has_next) { S.gather(ui + 1, Rg[0], Rg[1], offN);
#pragma unroll
                for (int h = 0; h < 2; ++h)
#pragma unroll
                    for (int i = 0; i < 2; ++i) offN[h][i] += Cg[i]; }
            else {
#pragma unroll
                for (int h = 0; h < 2; ++h)
#pragma unroll
                    for (int i = 0; i < 2; ++i) offN[h][i] = offC[h][i]; } }
        for (int t = 0; t < nt; t += 2) {
            const bool last = (t == nt - 2);
            const char* a1 = cA + (size_t)(t + 1) * kstep;
            const char* a2 = last ? nA : cA + (size_t)(t + 2) * kstep; const char* b2 = last ? nB : cB + (size_t)(t + 2) * kstep;
            const char* a3 = a2 + kstep; const char* b3 = b2 + kstep;
            unsigned o2[2][2];
#pragma unroll
            for (int h = 0; h < 2; ++h)
#pragma unroll
                for (int i = 0; i < 2; ++i) o2[h][i] = last ? offN[h][i] : offC[h][i];
            if constexpr (MIDK) { if (t == nt / 2) E.midk(acc, cur, wr, fr); }
            PG8_LDB(B0, 0, 0); PG8_LDB(B1, 0, 1); PG8_SCHED; PG8_LDA(At, 0, 0); PG8_STAGE_A(PG8_SA(1, 1), a1, 1, offC);
            PG8_WAIT_V(8); PG8_WAIT_L(0); PG8_BAR; PG8_MMA(0, 0, At, B0); PG8_MMA(0, 1, At, B1); PG8_BAR; PG8_SCHED;
            PG8_LDA(At, 0, 1); PG8_STAGE_B(PG8_SB(0, 0), b2); PG8_STAGE_B(PG8_SB(0, 1), b2 + hstep); PG8_STAGE_A(PG8_SA(0, 0), a2, 0, o2);
            PG8_WAIT_V(8); PG8_WAIT_L(0); PG8_BAR; PG8_MMA(1, 0, At, B0); PG8_MMA(1, 1, At, B1); PG8_BAR; PG8_SCHED;
            PG8_LDB(B0, 1, 0); PG8_LDB(B1, 1, 1); PG8_SCHED; PG8_LDA(At, 1, 0); PG8_STAGE_A(PG8_SA(0, 1), a2, 1, o2);
            PG8_WAIT_V(8); PG8_WAIT_L(0); PG8_BAR; PG8_MMA(0, 0, At, B0); PG8_MMA(0, 1, At, B1); PG8_BAR; PG8_SCHED;
            PG8_LDA(At, 1, 1); PG8_STAGE_B(PG8_SB(1, 0), b3); PG8_STAGE_B(PG8_SB(1, 1), b3 + hstep); PG8_STAGE_A(PG8_SA(1, 0), a3, 0, o2);
            PG8_WAIT_V(8); PG8_WAIT_L(0); PG8_BAR; PG8_MMA(1, 0, At, B0); PG8_MMA(1, 1, At, B1); PG8_BAR; PG8_SCHED;
        }
        if (wr == 0) PG8_BAR;
        if constexpr (F8) asm volatile("s_nop 15\n\ts_nop 15" ::: "memory");
        E(acc, cur, wr, wc, fr, fq);
        if (!has_next) break;
#pragma unroll
        for (int a = 0; a < 2; ++a)
#pragma unroll
            for (int b = 0; b < 2; ++b)
#pragma unroll
                for (int m = 0; m < 4; ++m)
#pragma unroll
                    for (int n = 0; n < 2; ++n) acc[a][b][m][n] = (f32x4){0.f, 0.f, 0.f, 0.f};
        cur = nxt; cA = nA; cB = nB; ++ui;
        if constexpr (GATHER) {
#pragma unroll
            for (int h = 0; h < 2; ++h)
#pragma unroll
                for (int i = 0; i < 2; ++i) offC[h][i] = offN[h][i]; }
        if (wr == 1) PG8_BAR;
    }
    PG8_WAIT_V(0);
    PG8_BAR;
}
}

struct Frame {
    LAS unsigned char* lds;
    volatile LAS unsigned* MISC;
    gu32* ctl;
    unsigned char* ws;
    int vcu, G;
    const float *x, *p, *mix_norm, *w_in, *ln_g, *ln_b, *gws, *gbs, *aon, *gon, *w_out, *ffn_norm, *router_w, *router_b, *w_gu, *b_gu, *w_dn, *b_dn, *ple_norm, *w_pg, *w_pp, *ppn, *final_norm;
    float* out;
};
template <class T_> __device__ __forceinline__ T_* wsp(const Frame& F, size_t off) { return (T_*)(F.ws + off); }

#define PHASE_IDS int TID_ = (int)threadIdx.x; asm volatile("" : "+v"(TID_)); const int LANE_ = TID_ & 63; const int WAVE_ = __builtin_amdgcn_readfirstlane(TID_ >> 6); (void)LANE_; (void)WAVE_
template <class ColMap>
__device__ __forceinline__ void p0_transpose_item(const float* W, int K, int N, bf16* WT, const float* gain, LAS float* scr, int item, int lane, int nphys, const ColMap& cm) {
    const int nblk = nphys / 64, kb = item / nblk, nb = item % nblk, k0 = 64 * kb, n0 = 64 * nb;
    const int srccol = cm(n0 + lane);
    float v_[64]; const float* src = W + (size_t)k0 * N + srccol;
#pragma unroll
    for (int kk = 0; kk < 64; ++kk) v_[kk] = __builtin_nontemporal_load(src + (size_t)kk * N);
    if (gain) {
#pragma unroll
        for (int kk = 0; kk < 64; kk += 4) { const f32x4 g4 = *(const f32x4*)(gain + k0 + kk); v_[kk] *= g4[0]; v_[kk + 1] *= g4[1]; v_[kk + 2] *= g4[2]; v_[kk + 3] *= g4[3]; } }
#pragma unroll
    for (int kk = 0; kk < 64; ++kk) scr[kk * 65 + lane] = v_[kk];
    LDS_WAIT(); asm volatile("" ::: "memory");
    const int c = lane & 7;
#pragma unroll
    for (int j = 0; j < 8; ++j) { const int n = (lane >> 3) + 8 * j; const LAS float* s = scr + (8 * c) * 65 + n;
        v4u o; o.x = pk2(s[0 * 65], s[1 * 65]); o.y = pk2(s[2 * 65], s[3 * 65]); o.z = pk2(s[4 * 65], s[5 * 65]); o.w = pk2(s[6 * 65], s[7 * 65]);
        *(GAS v4u*)(WT + (size_t)(n0 + n) * K + k0 + 8 * c) = o; }
    LDS_WAIT(); asm volatile("" ::: "memory");
}
template <class ColMap>
__device__ __forceinline__ void p0_transpose_item_f8(const float* W, int K, int N, unsigned char* WT, const float* gain, LAS float* scr, int item, int lane, int nphys, const ColMap& cm) {
    const int nblk = nphys / 64, kb = item / nblk, nb = item % nblk, k0 = 64 * kb, n0 = 64 * nb;
    const int srccol = cm(n0 + lane);
    float v_[64]; const float* src = W + (size_t)k0 * N + srccol;
#pragma unroll
    for (int kk = 0; kk < 64; ++kk) v_[kk] = __builtin_nontemporal_load(src + (size_t)kk * N);
    constexpr float WS_ = (float)(1 << pg8::F8_WSHIFT);
#pragma unroll
    for (int kk = 0; kk < 64; kk += 4) { f32x4 g4 = gain ? *(const f32x4*)(gain + k0 + kk) : (f32x4){1.f, 1.f, 1.f, 1.f}; v_[kk] *= g4[0] * WS_; v_[kk + 1] *= g4[1] * WS_; v_[kk + 2] *= g4[2] * WS_; v_[kk + 3] *= g4[3] * WS_; }
#pragma unroll
    for (int kk = 0; kk < 64; ++kk) scr[kk * 65 + lane] = v_[kk];
    LDS_WAIT(); asm volatile("" ::: "memory");
    const int c = lane & 3;
#pragma unroll
    for (int j = 0; j < 4; ++j) { const int n = (lane >> 2) + 16 * j; const LAS float* s_ = scr + (16 * c) * 65 + n;
        v4u o; o.x = pk4_fp8(s_[0 * 65], s_[1 * 65], s_[2 * 65], s_[3 * 65]); o.y = pk4_fp8(s_[4 * 65], s_[5 * 65], s_[6 * 65], s_[7 * 65]);
        o.z = pk4_fp8(s_[8 * 65], s_[9 * 65], s_[10 * 65], s_[11 * 65]); o.w = pk4_fp8(s_[12 * 65], s_[13 * 65], s_[14 * 65], s_[15 * 65]);
        *(GAS v4u*)(WT + (size_t)(n0 + n) * K + k0 + 16 * c) = o; }
    LDS_WAIT(); asm volatile("" ::: "memory");
}
struct CmId { __device__ __forceinline__ int operator()(int n) const { return n; } };
struct CmWin { __device__ __forceinline__ int operator()(int n) const { if (n >= 2 * AW) return n; const int c = n & 63; return (n & ~63) + 4 * (c >> 3) + (c & 3) + 32 * ((c >> 2) & 1); } };
struct CmWgu { __device__ __forceinline__ int operator()(int n) const { return ((n >> 7) & 1) * FF + (n >> 8) * 128 + (n & 127); } };

constexpr int XW_I_GU = (DM / 64) * (2 * FF / 64), XW_I_DN = (FF / 64) * (DM / 64), XW_ITEMS = NE * (XW_I_GU + XW_I_DN);
__device__ __forceinline__ void xw_convert_item(const Frame& F, int it, LAS float* scr, int lane) {
    if (it < NE * XW_I_GU) { const int e = it / XW_I_GU; p0_transpose_item_f8(F.w_gu + (size_t)e * DM * 2 * FF, DM, 2 * FF, wsp<unsigned char>(F, WS_WGU) + (size_t)e * 2 * FF * DM, F.ffn_norm, scr, it % XW_I_GU, lane, 2 * FF, CmWgu()); }
    else { const int r = it - NE * XW_I_GU, e = r / XW_I_DN; p0_transpose_item_f8(F.w_dn + (size_t)e * FF * DM, FF, DM, wsp<unsigned char>(F, WS_WDN) + (size_t)e * DM * FF, nullptr, scr, r % XW_I_DN, lane, DM, CmId()); }
}
struct XwDesc { const float* src; unsigned char* dst; unsigned N, K; };
__device__ __forceinline__ XwDesc xw_desc(const Frame& F, int it, int lane) {
    XwDesc d; const int kq = lane >> 4, nq = lane & 15;
    if (it < NE * XW_I_GU) { const int e = it / XW_I_GU, item = it % XW_I_GU, nblk = 2 * FF / 64, k0 = 64 * (item / nblk), n0 = 64 * (item % nblk);
        d.N = 2 * FF; d.K = DM; d.src = F.w_gu + (size_t)e * DM * 2 * FF + (size_t)(k0 + kq) * (2 * FF) + CmWgu()(n0) + 4 * nq;
        d.dst = wsp<unsigned char>(F, WS_WGU) + (size_t)e * 2 * FF * DM + (size_t)(n0 + (lane >> 2)) * DM + k0 + 16 * (lane & 3); }
    else { const int r = it - NE * XW_I_GU, e = r / XW_I_DN, item = r % XW_I_DN, nblk = DM / 64, k0 = 64 * (item / nblk), n0 = 64 * (item % nblk);
        d.N = DM; d.K = FF; d.src = F.w_dn + (size_t)e * FF * DM + (size_t)(k0 + kq) * DM + n0 + 4 * nq;
        d.dst = wsp<unsigned char>(F, WS_WDN) + (size_t)e * DM * FF + (size_t)(n0 + (lane >> 2)) * FF + k0 + 16 * (lane & 3); }
    return d;
}
__device__ __forceinline__ void xw_load(f32x4 (&v)[16], const XwDesc& d) {
#pragma unroll
    for (int j = 0; j < 16; ++j) v[j] = __builtin_nontemporal_load((const f32x4*)(d.src + (size_t)(4 * j) * d.N));
}
__device__ __forceinline__ void xw_process(const f32x4 (&v)[16], const XwDesc& d, LAS float* scr, int lane) {
    const int kq = lane >> 4, nq = lane & 15;
#pragma unroll
    for (int j = 0; j < 16; ++j) { LAS float* w = scr + (4 * j + kq) * 65 + 4 * nq; w[0] = v[j][0]; w[1] = v[j][1]; w[2] = v[j][2]; w[3] = v[j][3]; }
    LDS_WAIT(); asm volatile("" ::: "memory");
    constexpr float WS_ = (float)(1 << pg8::F8_WSHIFT);
    const int c = lane & 3;
#pragma unroll
    for (int j = 0; j < 4; ++j) { const LAS float* s_ = scr + (16 * c) * 65 + (lane >> 2) + 16 * j;
        v4u o; o.x = pk4_fp8(s_[0 * 65] * WS_, s_[1 * 65] * WS_, s_[2 * 65] * WS_, s_[3 * 65] * WS_); o.y = pk4_fp8(s_[4 * 65] * WS_, s_[5 * 65] * WS_, s_[6 * 65] * WS_, s_[7 * 65] * WS_);
        o.z = pk4_fp8(s_[8 * 65] * WS_, s_[9 * 65] * WS_, s_[10 * 65] * WS_, s_[11 * 65] * WS_); o.w = pk4_fp8(s_[12 * 65] * WS_, s_[13 * 65] * WS_, s_[14 * 65] * WS_, s_[15 * 65] * WS_);
        *(GAS v4u*)(d.dst + (size_t)(16 * j) * d.K) = o; }
    LDS_WAIT(); asm volatile("" ::: "memory");
}
__device__ __forceinline__ void p0_prologue(Frame& F) {
    PHASE_IDS;
    { const int gt0 = (int)blockIdx.x * NTHR + TID_, GT0 = F.G * NTHR;
      for (int i = gt0; i < CW_TS; i += GT0) F.ctl[i] = 0u;
      float* km0 = wsp<float>(F, WS_KMEAN); for (int i = gt0; i < (T / SEQ) * NH * NBLK * HD; i += GT0) km0[i] = 0.f; }
    LAS float* scr = (LAS float*)(F.lds + RING_OFF + WAVE_ * P0_SCR_WAVE);
    const int gw = F.vcu * NWAVES + WAVE_, NGW = F.G * NWAVES;
    constexpr int I_GU = (DM / 64) * (2 * FF / 64), I_DN = (FF / 64) * (DM / 64), I_IN = (DM / 64) * (NPROJ / 64), I_SQ = (DM / 64) * (DM / 64), I_PP = (PLE / 64) * (DM / 64);
    constexpr int NITEMS = I_IN + 2 * I_SQ + I_PP;
    (void)I_GU; (void)I_DN;
    for (int it = gw; it < NITEMS; it += NGW) {
        int r = it;
        if (r < I_IN) { p0_transpose_item(F.w_in, DM, NPROJ, wsp<bf16>(F, WS_WIN), F.mix_norm, scr, r, LANE_, NPROJ, CmWin()); continue; } r -= I_IN;
        if (r < I_SQ) {
            const int nblk = DM / 64, kb = r / nblk; const float* g = (kb < 8) ? F.aon : (F.gon - AW);
            p0_transpose_item(F.w_out, DM, DM, wsp<bf16>(F, WS_WOUT), g, scr, r, LANE_, DM, CmId()); continue; } r -= I_SQ;
        if (r < I_SQ) { p0_transpose_item_f8(F.w_pg, DM, DM, wsp<unsigned char>(F, WS_WPG8), F.ple_norm, scr, r, LANE_, DM, CmId()); continue; } r -= I_SQ;
        p0_transpose_item(F.w_pp, PLE, DM, wsp<bf16>(F, WS_WPP), nullptr, scr, r, LANE_, DM, CmId());
    }
    if (TPROBE && blockIdx.x == 0 && threadIdx.x == 0) ((unsigned long long*)(F.ctl + CW_TS))[11] = __builtin_amdgcn_s_memrealtime();
    bf16* XN = wsp<bf16>(F, WS_XNB);
    for (int m0 = gw; m0 < T; m0 += 2 * NGW) {
        f32x4 v[2][4]; float s[2] = {0.f, 0.f};
#pragma unroll
        for (int r = 0; r < 2; ++r) { const GAS f32x4* xr = (const GAS f32x4*)(F.x + (size_t)(m0 + r * NGW) * DM) + LANE_;
#pragma unroll
            for (int j = 0; j < 4; ++j) v[r][j] = __builtin_nontemporal_load(xr + 64 * j); }
#pragma unroll
        for (int r = 0; r < 2; ++r) {
#pragma unroll
            for (int j = 0; j < 4; ++j) s[r] += (v[r][j].x * v[r][j].x + v[r][j].y * v[r][j].y) + (v[r][j].z * v[r][j].z + v[r][j].w * v[r][j].w); }
#pragma unroll
        for (int r = 0; r < 2; ++r) { const int m = m0 + r * NGW; const float sig = sqrtf(wave_sum(s[r]) * (1.f / DM) + EPS), rstd = 1.0f / sig;
            if (LANE_ == 0) wsp<float>(F, WS_SIG0)[m] = sig;
            GAS v2u* o8 = (GAS v2u*)(XN + (size_t)m * DM) + LANE_;
#pragma unroll
            for (int j = 0; j < 4; ++j) { v2u w; w.x = pk2(v[r][j].x * rstd, v[r][j].y * rstd); w.y = pk2(v[r][j].z * rstd, v[r][j].w * rstd); o8[64 * j] = w; } }
    }
    if (TPROBE && blockIdx.x == 0 && threadIdx.x == 0) ((unsigned long long*)(F.ctl + CW_TS))[12] = __builtin_amdgcn_s_memrealtime();
    { const GAS f32x4* pr = (const GAS f32x4*)F.p; GAS v2u* po = (GAS v2u*)wsp<bf16>(F, WS_PB);
      const size_t n4 = (size_t)T * PLE / 4, gt = (size_t)(F.vcu * NTHR + TID_), GT = (size_t)F.G * NTHR;
      for (size_t i = gt; i < n4; i += GT) { const f32x4 v = pr[i]; v2u w; w.x = pk2(v.x, v.y); w.y = pk2(v.z, v.w); po[i] = w; } }
    if (TPROBE && blockIdx.x == 0 && threadIdx.x == 0) ((unsigned long long*)(F.ctl + CW_TS))[13] = __builtin_amdgcn_s_memrealtime();
    { const int gt = F.vcu * NTHR + TID_, GT = F.G * NTHR; float* RWG = wsp<float>(F, WS_RWG);
      (void)RWG; bf16* RWT = wsp<bf16>(F, WS_RWT);
      for (int i = gt; i < DM * NE; i += GT) { const int e = i / DM, k = i % DM; const float w = F.router_w[k * NE + e] * F.ffn_norm[k]; const unsigned hi = f2bf(w); const float lo = w - bf2f((bf16)hi); RWT[i] = (bf16)hi; RWT[NE * DM + i] = (bf16)f2bf(lo); }
      float* RC = wsp<float>(F, WS_ROPE); float* RS = RC + SEQ * 32;
      for (int i = gt; i < SEQ * 32; i += GT) { const int pos = i >> 5, j = i & 31; const float inv = powf(10000.0f, -(float)j / 32.0f); const float ang = (float)pos * inv; float sn, cs; sincosf(ang, &sn, &cs); RC[i] = cs; RS[i] = sn; } }
}

using pg8::Unit;
constexpr int HALF = 128;
struct EpiInProj {
    static constexpr bool PERM = true;
    bf16* QKVUV; const float *rc, *rs; float* kmean;
    __device__ __forceinline__ void operator()(const f32x4 (&acc)[2][2][4][2], const Unit& u, int wr, int wc, int fr, int fq) const {
        const int type = u.pn >> 1, colt = (u.pn & 1) * 256 + wc * 32 + 8 * fq;
        const int row0 = u.pm * 256 + wr * 64 + fr;
        if (type <= 1) {
            bf16* dst = QKVUV + (size_t)type * (16u << 20);
            const int pos0 = (u.pm & 7) * 256 + wr * 64 + fr, i0 = 16 * (wc & 1) + 4 * fq;
            f32x4 cs_[2][2];
#pragma unroll
            for (int bj = 0; bj < 2; ++bj) { cs_[bj][0] = (f32x4){0.f, 0.f, 0.f, 0.f}; cs_[bj][1] = (f32x4){0.f, 0.f, 0.f, 0.f}; }
#pragma unroll
            for (int ai = 0; ai < 2; ++ai) { f32x4 cc[4], ss[4];
#pragma unroll
                for (int m = 0; m < 4; ++m) { const int pos = pos0 + ai * HALF + m * 16; cc[m] = *(const f32x4*)(rc + pos * 32 + i0); ss[m] = *(const f32x4*)(rs + pos * 32 + i0); }
#pragma unroll
                for (int m = 0; m < 4; ++m) { const int ro = ai * HALF + m * 16; const f32x4 c = cc[m], s = ss[m];
                    bf16* rowp = dst + (size_t)(row0 + ro) * AW + colt;
#pragma unroll
                    for (int bj = 0; bj < 2; ++bj) { const f32x4 x1 = acc[ai][bj][m][0], x2 = acc[ai][bj][m][1];
                        const f32x4 o1 = x1 * c - x2 * s, o2 = x2 * c + x1 * s;
                        cs_[bj][0] += o1; cs_[bj][1] += o2;
                        v4u w; w.x = cvt_pk_bf16(o1[0], o1[1]); w.y = cvt_pk_bf16(o1[2], o1[3]); w.z = cvt_pk_bf16(o2[0], o2[1]); w.w = cvt_pk_bf16(o2[2], o2[3]);
                        *(v4u*)(rowp + bj * HALF) = w; } }
                asm volatile("" ::: "memory"); }
            if (type == 1) {
#pragma unroll
                for (int bj = 0; bj < 2; ++bj)
#pragma unroll
                    for (int n = 0; n < 2; ++n)
#pragma unroll
                        for (int j = 0; j < 4; ++j) { float v = cs_[bj][n][j]; v += __shfl_xor(v, 1); v += __shfl_xor(v, 2); v += __shfl_xor(v, 4); v += __shfl_xor(v, 8); cs_[bj][n][j] = v; }
                if (fr == 0) { const int b = u.pm >> 3, blk = u.pm & 7;
#pragma unroll
                    for (int bj = 0; bj < 2; ++bj) { const int colh = (u.pn & 1) * 256 + bj * HALF + wc * 32; const int head = colh >> 6, cpos = (colh & 63) + 8 * fq;
                        float* km = kmean + ((size_t)((b * NH + head) * NBLK + blk)) * HD + cpos;
#pragma unroll
                        for (int n = 0; n < 2; ++n)
#pragma unroll
                            for (int j = 0; j < 4; ++j) atomicAdd(km + 4 * n + j, cs_[bj][n][j]); } }
            }
        } else {
            bf16* dst = QKVUV + (size_t)type * (16u << 20);
#pragma unroll
            for (int ai = 0; ai < 2; ++ai)
#pragma unroll
                for (int m = 0; m < 4; ++m) { bf16* rowp = dst + (size_t)(row0 + ai * HALF + m * 16) * AW + colt;
#pragma unroll
                    for (int bj = 0; bj < 2; ++bj) { f32x4 v0 = acc[ai][bj][m][0], v1 = acc[ai][bj][m][1];
                        if (type >= 3) { v0 = gelu4(v0); v1 = gelu4(v1); }
                        v4u w; w.x = cvt_pk_bf16(v0[0], v0[1]); w.y = cvt_pk_bf16(v0[2], v0[3]); w.z = cvt_pk_bf16(v1[0], v1[1]); w.w = cvt_pk_bf16(v1[2], v1[3]);
                        *(v4u*)(rowp + bj * HALF) = w; } }
        }
    }
};
struct EpiOutProj {
    static constexpr bool PERM = true;
    const bf16* xn; bf16* x1; unsigned char* x1f8; float* ssq1; const LAS f32x4* rtab; const float* fgain;
    int pm_a, pm_b;
    __device__ __forceinline__ int slot(const Unit& u) const { return u.pm == pm_a ? 0 : 1; }
    __device__ __forceinline__ void midk(f32x4 (&acc)[2][2][4][2], const Unit& u, int wr, int fr) const {
        const LAS f32x4* t = rtab + slot(u) * 256 + wr * 64 + fr;
#pragma unroll
        for (int ai = 0; ai < 2; ++ai)
#pragma unroll
            for (int m = 0; m < 4; ++m) { const float r = t[ai * HALF + m * 16].x;
#pragma unroll
                for (int bj = 0; bj < 2; ++bj)
#pragma unroll
                    for (int n = 0; n < 2; ++n) acc[ai][bj][m][n] *= r; }
    }
    __device__ __forceinline__ void operator()(const f32x4 (&acc)[2][2][4][2], const Unit& u, int wr, int wc, int fr, int fq) const {
        const LAS f32x4* t = rtab + slot(u) * 256 + wr * 64 + fr;
        const int row0 = u.pm * 256 + wr * 64 + fr, col0 = u.pn * 256 + wc * 32 + 8 * fq;
        f32x4 fg[2][2];
#pragma unroll
        for (int bj = 0; bj < 2; ++bj) { fg[bj][0] = *(const f32x4*)(fgain + col0 + bj * HALF); fg[bj][1] = *(const f32x4*)(fgain + col0 + bj * HALF + 4); }
#pragma unroll
        for (int ai = 0; ai < 2; ++ai) { v4u xv[4][2];
#pragma unroll
            for (int m = 0; m < 4; ++m) { const size_t off = (size_t)(row0 + ai * HALF + m * 16) * DM + col0;
                xv[m][0] = *(const v4u*)(xn + off); xv[m][1] = *(const v4u*)(xn + off + HALF); }
#pragma unroll
            for (int m = 0; m < 4; ++m) { const int ro = ai * HALF + m * 16; const f32x4 tv = t[ro]; const float rg = tv.y, sx = tv.z; const size_t off = (size_t)(row0 + ro) * DM + col0; float q = 0.f;
#pragma unroll
                for (int bj = 0; bj < 2; ++bj) { const v4u xw = xv[m][bj];
                    const f32x4 x0 = {bflo(xw.x), bfhi(xw.x), bflo(xw.y), bfhi(xw.y)}, x1_ = {bflo(xw.z), bfhi(xw.z), bflo(xw.w), bfhi(xw.w)};
                    const f32x4 o0 = x0 * sx + acc[ai][bj][m][0] * rg, o1 = x1_ * sx + acc[ai][bj][m][1] * rg;
                    q += (o0[0] * o0[0] + o0[1] * o0[1]) + (o0[2] * o0[2] + o0[3] * o0[3]) + (o1[0] * o1[0] + o1[1] * o1[1]) + (o1[2] * o1[2] + o1[3] * o1[3]);
                    v4u w; w.x = cvt_pk_bf16(o0[0], o0[1]); w.y = cvt_pk_bf16(o0[2], o0[3]); w.z = cvt_pk_bf16(o1[0], o1[1]); w.w = cvt_pk_bf16(o1[2], o1[3]);
                    *(v4u*)(x1 + off + bj * HALF) = w;
                    const f32x4 p0 = o0 * fg[bj][0], p1 = o1 * fg[bj][1];
                    v2u w8; w8.x = pk4_fp8(p0[0], p0[1], p0[2], p0[3]); w8.y = pk4_fp8(p1[0], p1[1], p1[2], p1[3]); *(v2u*)(x1f8 + off + bj * HALF) = w8; }
                q += __shfl_xor(q, 16); q += __shfl_xor(q, 32);
                if (fq == 0) ssq1[(size_t)(row0 + ro) * 16 + u.pn * 4 + wc] = q; }
            asm volatile("" ::: "memory"); }
    }
};
struct EpiMoe1 {
    static constexpr bool PERM = true;
    unsigned char* A; const float* b_gu; const LAS float* rss;
    __device__ __forceinline__ void operator()(const f32x4 (&acc)[2][2][4][2], const Unit& u, int wr, int wc, int fr, int fq) const {
        const int row0 = u.pm * 256 + wr * 64 + fr, col = u.pn * 128 + wc * 32 + 8 * fq;
        const float* bg = b_gu + (size_t)u.e * 2 * FF + col; const LAS float* rs_ = rss + u.slot * 256 + wr * 64 + fr;
        float rsv[2][4];
#pragma unroll
        for (int ai = 0; ai < 2; ++ai)
#pragma unroll
            for (int m = 0; m < 4; ++m) rsv[ai][m] = rs_[ai * HALF + m * 16];
        f32x4 bgv[2], blv[2];
#pragma unroll
        for (int n = 0; n < 2; ++n) { bgv[n] = *(const f32x4*)(bg + 4 * n); blv[n] = *(const f32x4*)(bg + FF + 4 * n); }
#pragma unroll
        for (int ai = 0; ai < 2; ++ai)
#pragma unroll
            for (int m = 0; m < 4; ++m) { f32x4 a[2];
#pragma unroll
                for (int n = 0; n < 2; ++n) { const f32x4 g = acc[ai][0][m][n] * rsv[ai][m] + bgv[n], l = acc[ai][1][m][n] * rsv[ai][m] + blv[n];
#pragma unroll
                    for (int p = 0; p < 2; ++p) { f32x2 gc = {fminf(g[2 * p], 7.0f), fminf(g[2 * p + 1], 7.0f)}; f32x2 lc = {fminf(fmaxf(l[2 * p], -7.0f), 7.0f), fminf(fmaxf(l[2 * p + 1], -7.0f), 7.0f)};
                        const f32x2 z = gc * (-1.702f * 1.4426950408889634f); f32x2 e; e.x = __builtin_amdgcn_exp2f(z.x); e.y = __builtin_amdgcn_exp2f(z.y);
                        const f32x2 d = e + 1.0f; f32x2 r; r.x = __builtin_amdgcn_rcpf(d.x); r.y = __builtin_amdgcn_rcpf(d.y);
                        const f32x2 o = (gc * r) * (lc + 1.0f); a[n][2 * p] = o.x; a[n][2 * p + 1] = o.y; } }
                v2u w; w.x = pk4_fp8_nc(a[0][0], a[0][1], a[0][2], a[0][3]); w.y = pk4_fp8_nc(a[1][0], a[1][1], a[1][2], a[1][3]);
                *(v2u*)(A + (size_t)(row0 + ai * HALF + m * 16) * FF + col) = w; }
    }
};
constexpr float Y_SCALE = 16.0f;
struct EpiMoe2 {
    static constexpr bool PERM = true;
    unsigned char* Y; const float* b_dn; const LAS float* gss;
    __device__ __forceinline__ void operator()(const f32x4 (&acc)[2][2][4][2], const Unit& u, int wr, int wc, int fr, int fq) const {
        const int row0 = u.pm * 256 + wr * 64 + fr, col0 = u.pn * 256 + wc * 32 + 8 * fq;
        const LAS float* gs = gss + u.slot * 256 + wr * 64 + fr;
        f32x4 bv[2][2]; float gv[2][4];
#pragma unroll
        for (int bj = 0; bj < 2; ++bj)
#pragma unroll
            for (int n = 0; n < 2; ++n) bv[bj][n] = *(const f32x4*)(b_dn + (size_t)u.e * DM + col0 + bj * HALF + 4 * n);
#pragma unroll
        for (int ai = 0; ai < 2; ++ai)
#pragma unroll
            for (int m = 0; m < 4; ++m) gv[ai][m] = gs[ai * HALF + m * 16] * Y_SCALE;
#pragma unroll
        for (int ai = 0; ai < 2; ++ai)
#pragma unroll
            for (int m = 0; m < 4; ++m) { const float g = gv[ai][m]; unsigned char* rowp = Y + (size_t)(row0 + ai * HALF + m * 16) * DM + col0;
#pragma unroll
                for (int bj = 0; bj < 2; ++bj) { const f32x4 v0 = (acc[ai][bj][m][0] + bv[bj][0]) * g, v1 = (acc[ai][bj][m][1] + bv[bj][1]) * g;
                    v2u w; w.x = pk4_fp8(v0[0], v0[1], v0[2], v0[3]); w.y = pk4_fp8(v1[0], v1[1], v1[2], v1[3]);
                    *(v2u*)(rowp + bj * HALF) = w; } }
    }
};
constexpr float GATE_SCALE = 128.0f;
template <int MODE> struct EpiPle {
    static constexpr bool PERM = true;
    unsigned char* O; float* ssq; const LAS float* rtab; int pm_a;
    __device__ __forceinline__ void operator()(const f32x4 (&acc)[2][2][4][2], const Unit& u, int wr, int wc, int fr, int fq) const {
        const int row0 = u.pm * 256 + wr * 64 + fr, col0 = u.pn * 256 + wc * 32 + 8 * fq;
        float rsv[2][4];
#pragma unroll
        for (int ai = 0; ai < 2; ++ai)
#pragma unroll
            for (int m = 0; m < 4; ++m) rsv[ai][m] = (MODE == 0) ? rtab[(u.pm == pm_a ? 0 : 256) + wr * 64 + fr + ai * HALF + m * 16] : 1.0f;
#pragma unroll
        for (int ai = 0; ai < 2; ++ai)
#pragma unroll
            for (int m = 0; m < 4; ++m) { unsigned char* rowp = O + (size_t)(row0 + ai * HALF + m * 16) * DM + col0; float q = 0.f; const float rs = rsv[ai][m];
#pragma unroll
                for (int bj = 0; bj < 2; ++bj) { f32x4 v0 = acc[ai][bj][m][0], v1 = acc[ai][bj][m][1];
                    if (MODE == 0) {
#pragma unroll
                        for (int j = 0; j < 4; ++j) { v0[j] = GATE_SCALE * sigmoidf_fast(rs * v0[j]); v1[j] = GATE_SCALE * sigmoidf_fast(rs * v1[j]); } }
                    else { q += (v0[0] * v0[0] + v0[1] * v0[1]) + (v0[2] * v0[2] + v0[3] * v0[3]) + (v1[0] * v1[0] + v1[1] * v1[1]) + (v1[2] * v1[2] + v1[3] * v1[3]); }
                    v2u w; if (MODE == 0) { w.x = pk4_fp8_nc(v0[0], v0[1], v0[2], v0[3]); w.y = pk4_fp8_nc(v1[0], v1[1], v1[2], v1[3]); }
                    else { w.x = pk4_fp8(v0[0], v0[1], v0[2], v0[3]); w.y = pk4_fp8(v1[0], v1[1], v1[2], v1[3]); }
                    *(v2u*)(rowp + bj * HALF) = w; }
                if (MODE == 1) { q += __shfl_xor(q, 16); q += __shfl_xor(q, 32); if (fq == 0) ssq[(size_t)(row0 + ai * HALF + m * 16) * 16 + u.pn * 4 + wc] = q; } }
    }
};

namespace att {
constexpr int QBLK = 32, KVBLK = 64;
constexpr float SCALE = 0.125f, THR = 8.f;
constexpr int SHM_V = KVBLK * HD * 2, SHM_K = SHM_V;
constexpr int NSLOT = 3;
constexpr int LDS_BYTES_ = NSLOT * SHM_V + NSLOT * SHM_K + NWAVES * 64 * 4;
#define ATT_KSWZ(row, colB) ((row) * 128 + ((colB) ^ ((((row) >> 1) & 7) << 4)))
#define ATT_SBAR() __builtin_amdgcn_sched_barrier(0)
__device__ __forceinline__ int crow(int r, int hi) { return (r & 3) + 8 * (r >> 2) + 4 * hi; }
__device__ __forceinline__ void cmask(f32x16& p0, f32x16& p1, int jb, int qrel, int hi) {
    const float NEG = -__builtin_inff(); const int kb = 64 * jb + 4 * hi;
#pragma unroll
    for (int r = 0; r < 16; ++r) { const int kv = kb + (r & 3) + 8 * (r >> 2); if (kv > qrel) p0[r] = NEG; if (kv + 32 > qrel) p1[r] = NEG; }
}
__device__ __forceinline__ void bmask(f32x16& p0, f32x16& p1, bool keep) {
    const float NEG = -__builtin_inff();
    if (!keep) {
#pragma unroll
        for (int r = 0; r < 16; ++r) { p0[r] = NEG; p1[r] = NEG; } }
}
__device__ __forceinline__ void partialSM(f32x16& p0, f32x16& p1, float& m_reg, float& mn, float& alpha, bool keep) {
    float pmax = p0[0];
#pragma unroll
    for (int r = 1; r < 16; ++r) pmax = fmaxf(pmax, p0[r]);
#pragma unroll
    for (int r = 0; r < 16; ++r) pmax = fmaxf(pmax, p1[r]);
    { auto rr = __builtin_amdgcn_permlane32_swap(__float_as_uint(pmax), __float_as_uint(pmax), false, false);
      pmax = fmaxf(__uint_as_float(rr[0]), __uint_as_float(rr[1])); }
    if (!keep) pmax = -__builtin_inff();
    constexpr float C2 = 1.4426950408889634f * SCALE;
    if (__builtin_expect(__all((pmax - m_reg) * SCALE <= THR), 1)) { mn = m_reg; alpha = 1.f; }
    else { mn = fmaxf(m_reg, pmax); alpha = __builtin_amdgcn_exp2f((m_reg - mn) * C2); m_reg = mn; }
    const float mnL = keep ? -mn * C2 : -__builtin_inff(), c2 = keep ? C2 : 0.f;
#pragma unroll
    for (int r = 0; r < 16; ++r) p0[r] = fmaf(p0[r], c2, mnL);
#pragma unroll
    for (int r = 0; r < 16; ++r) p1[r] = fmaf(p1[r], c2, mnL);
#pragma unroll
    for (int r = 0; r < 16; ++r) p0[r] = __builtin_amdgcn_exp2f(p0[r]);
}
__device__ __forceinline__ void finishSM(f32x16& p0, f32x16& p1, float alpha, float& l_reg, bf16x8& pa0, bf16x8& pa1, bf16x8& pa2, bf16x8& pa3) {
#pragma unroll
    for (int r = 0; r < 16; ++r) p1[r] = __builtin_amdgcn_exp2f(p1[r]);
    float ps = 0;
#pragma unroll
    for (int r = 0; r < 16; ++r) ps += p0[r];
#pragma unroll
    for (int r = 0; r < 16; ++r) ps += p1[r];
    { auto rr = __builtin_amdgcn_permlane32_swap(__float_as_uint(ps), __float_as_uint(ps), false, false);
      ps = __uint_as_float(rr[0]) + __uint_as_float(rr[1]); }
    l_reg = l_reg * alpha + ps;
#define ATT_PK4(P, B, OUT) do { unsigned a0 = cvt_pk_bf16(P[B+0], P[B+1]), a1 = cvt_pk_bf16(P[B+2], P[B+3]);             \
        unsigned b0 = cvt_pk_bf16(P[B+4], P[B+5]), b1 = cvt_pk_bf16(P[B+6], P[B+7]);                                       \
        auto r0 = __builtin_amdgcn_permlane32_swap(a0, b0, false, false); auto r1 = __builtin_amdgcn_permlane32_swap(a1, b1, false, false); \
        v4u w = {r0[0], r1[0], r0[1], r1[1]}; OUT = *reinterpret_cast<bf16x8*>(&w); } while (0)
    ATT_PK4(p0, 0, pa0); ATT_PK4(p0, 8, pa1); ATT_PK4(p1, 0, pa2); ATT_PK4(p1, 8, pa3);
#undef ATT_PK4
}
__device__ __forceinline__ void qkt(f32x16& p0, f32x16& p1, const LAS unsigned char* Ks, const bf16x8* qr, int r32, int hi) {
    p0 = f32x16{}; p1 = f32x16{};
#pragma unroll
    for (int d0 = 0; d0 < 4; ++d0) { const int cb = (d0 * 16 + hi * 8) * 2;
        const bf16x8 b0 = *(const LAS bf16x8*)(Ks + ATT_KSWZ(r32, cb));
        const bf16x8 b1 = *(const LAS bf16x8*)(Ks + ATT_KSWZ(32 + r32, cb));
        p0 = __builtin_amdgcn_mfma_f32_32x32x16_bf16(b0, qr[d0], p0, 0, 0, 0);
        p1 = __builtin_amdgcn_mfma_f32_32x32x16_bf16(b1, qr[d0], p1, 0, 0, 0); }
}
__device__ __forceinline__ void pv(f32x16* o, int vb, bf16x8 pa0, bf16x8 pa1, bf16x8 pa2, bf16x8 pa3) {
#pragma unroll
    for (int d0 = 0; d0 < 2; ++d0) { s16x4 lo[4], hi[4];
#pragma unroll
        for (int ks = 0; ks < 4; ++ks) { const int a = vb + d0 * 2048 + (ks >> 1) * 4096 + (ks & 1) * 1024;
            asm volatile("ds_read_b64_tr_b16 %0,%1" : "=&v"(lo[ks]) : "v"(a) : "memory");
            asm volatile("ds_read_b64_tr_b16 %0,%1 offset:256" : "=&v"(hi[ks]) : "v"(a) : "memory"); }
        asm volatile("s_waitcnt lgkmcnt(0)" ::: "memory"); ATT_SBAR();
#define ATT_PK(k) (bf16x8){lo[k][0], lo[k][1], lo[k][2], lo[k][3], hi[k][0], hi[k][1], hi[k][2], hi[k][3]}
        o[d0] = __builtin_amdgcn_mfma_f32_32x32x16_bf16(pa0, ATT_PK(0), o[d0], 0, 0, 0);
        o[d0] = __builtin_amdgcn_mfma_f32_32x32x16_bf16(pa1, ATT_PK(1), o[d0], 0, 0, 0);
        o[d0] = __builtin_amdgcn_mfma_f32_32x32x16_bf16(pa2, ATT_PK(2), o[d0], 0, 0, 0);
        o[d0] = __builtin_amdgcn_mfma_f32_32x32x16_bf16(pa3, ATT_PK(3), o[d0], 0, 0, 0);
#undef ATT_PK
    }
}
__device__ __forceinline__ void attn_unit(const Frame& F, int b, int h, int qb, LAS unsigned char* scratch) {
    PHASE_IDS;
    const int tid = TID_, wid = tid >> 6, lane = tid & 63, r32 = lane & 31, hi = lane >> 5;
    const bf16* Qg = wsp<bf16>(F, WS_Q); const bf16* Kg = wsp<bf16>(F, WS_K); const bf16* Vg = wsp<bf16>(F, WS_V);
    const size_t rowbase = (size_t)b * SEQ; const int q0 = qb * MOBA;
    const bf16* Qw = Qg + (rowbase + q0 + wid * QBLK) * AW + h * HD;
    const bf16* Kh = Kg + rowbase * AW + h * HD; const bf16* Vh = Vg + rowbase * AW + h * HD;
    LAS unsigned char* V_lds = scratch; LAS unsigned char* K_lds = scratch + NSLOT * SHM_V;
    LAS float* wsf = (LAS float*)(scratch + NSLOT * SHM_V + NSLOT * SHM_K) + wid * 64; LAS float* li_l = wsf; LAS float* al_l = wsf + 32;
    float m_reg = -1e30f, l_reg = 0.f; f32x16 o[2]; o[0] = f32x16{}; o[1] = f32x16{}; bf16x8 qr[4];
#pragma unroll
    for (int d0 = 0; d0 < 4; ++d0) qr[d0] = *(const bf16x8*)(Qw + (size_t)r32 * AW + d0 * 16 + hi * 8);
    unsigned sel = 0u;
    if (qb <= 3) sel = (1u << qb) - 1u;
    else {
        const float* km = wsp<float>(F, WS_KMEAN) + (size_t)((b * NH + h) * NBLK) * HD + (size_t)(r32 & 7) * HD + hi * 8;
        f32x4 kv[4][2];
#pragma unroll
        for (int d0 = 0; d0 < 4; ++d0) { kv[d0][0] = *(const f32x4*)(km + d0 * 16); kv[d0][1] = *(const f32x4*)(km + d0 * 16 + 4); }
        f32x16 gacc = f32x16{};
#pragma unroll
        for (int d0 = 0; d0 < 4; ++d0) { float f[8] = {kv[d0][0][0], kv[d0][0][1], kv[d0][0][2], kv[d0][0][3], kv[d0][1][0], kv[d0][1][1], kv[d0][1][2], kv[d0][1][3]};
            unsigned hw[4], lw[4];
#pragma unroll
            for (int p = 0; p < 4; ++p) { float a0 = f[2 * p], a1 = f[2 * p + 1]; if (r32 >= 8) { a0 = 0.f; a1 = 0.f; }
                const unsigned h0 = f2bf(a0), h1 = f2bf(a1); hw[p] = h0 | (h1 << 16); lw[p] = pk2(a0 - bf2f((bf16)h0), a1 - bf2f((bf16)h1)); }
            const v4u hv = {hw[0], hw[1], hw[2], hw[3]}, lv = {lw[0], lw[1], lw[2], lw[3]};
            gacc = __builtin_amdgcn_mfma_f32_32x32x16_bf16(__builtin_bit_cast(bf16x8, hv), qr[d0], gacc, 0, 0, 0);
            gacc = __builtin_amdgcn_mfma_f32_32x32x16_bf16(__builtin_bit_cast(bf16x8, lv), qr[d0], gacc, 0, 0, 0); }
        float g[8];
#pragma unroll
        for (int r = 0; r < 4; ++r) { const float mine = gacc[r], other = __shfl_xor(mine, 32); g[r] = hi ? other : mine; g[4 + r] = hi ? mine : other; }
        float b0 = -__builtin_inff(), b1 = b0, b2 = b0; int i0 = 0, i1 = 0, i2 = 0;
#pragma unroll
        for (int j = 0; j < NBLK - 1; ++j) { const float s_ = (j < qb) ? g[j] : -__builtin_inff();
            if (s_ > b0) { b2 = b1; i2 = i1; b1 = b0; i1 = i0; b0 = s_; i0 = j; } else if (s_ > b1) { b2 = b1; i2 = i1; b1 = s_; i1 = j; } else if (s_ > b2) { b2 = s_; i2 = j; } }
        sel = (1u << i0) | (1u << i1) | (1u << i2);
    }
    const int sr = tid >> 3, sc = (tid & 7) * 8;
    const int srv = ((tid >> 5) << 2) | ((tid >> 1) & 3), scv = ((tid & 1) << 3) | (((tid >> 3) & 3) << 4);
    const int vst = (srv >> 5) * 4096 + (scv >> 5) * 2048 + ((srv & 31) >> 2) * 256 + ((scv >> 4) & 1) * 128 + (srv & 3) * 32 + (scv & 8) * 2;
    const int vb0 = (int)(size_t)V_lds + (lane & 15) * 8 + ((lane >> 4) & 1) * 128 + (lane >> 5) * 512;
    bf16x8 st_v, st_k;
#define ATT_SLOAD(k0) do { st_v = *(const bf16x8*)(Vh + (size_t)((k0) + srv) * AW + scv); st_k = *(const bf16x8*)(Kh + (size_t)((k0) + sr) * AW + sc); } while (0)
#define ATT_SWRITE(bf) do { *(LAS bf16x8*)(V_lds + (bf) * SHM_V + vst) = st_v; *(LAS bf16x8*)(K_lds + (bf) * SHM_K + ATT_KSWZ(sr, sc * 2)) = st_k; } while (0)
#define ATT_RESC(a) do { if (__any((a) < 1.f)) { if (hi == 0) al_l[r32] = (a); asm volatile("s_waitcnt lgkmcnt(0)" ::: "memory");      \
        _Pragma("unroll") for (int d_ = 0; d_ < 2; ++d_) _Pragma("unroll") for (int r = 0; r < 16; ++r) o[d_][r] *= al_l[crow(r, hi)]; } } while (0)
    const int NT = (q0 + MOBA) / KVBLK;
    const int qrel = wid * QBLK + r32;
#define ATT_MASK(P0, P1, t) do { const int jb_ = (t) - (NT - 4); if (jb_ >= 0) cmask(P0, P1, jb_, qrel, hi); } while (0)
#define ATT_KEEP(t) ((((t) >= NT - 4) ? 1u : ((sel >> ((t) >> 2)) & 1u)) != 0u)
    f32x16 pA0, pA1, pB0, pB1; float mnA, mnB, alA, alB; bf16x8 pa0, pa1, pa2, pa3;
    int s0 = 0, s1 = 1, s2 = 2;
#define ATT_ROT() do { const int t_ = s0; s0 = s1; s1 = s2; s2 = t_; } while (0)
    ATT_SLOAD(0); asm volatile("s_waitcnt vmcnt(0)" ::: "memory"); ATT_SWRITE(0); ATT_SLOAD(KVBLK);
    s0 = 2; s1 = 0; s2 = 1;
    __syncthreads();
    asm volatile("s_waitcnt vmcnt(0)" ::: "memory"); ATT_SWRITE(s2); ATT_SLOAD(2 * KVBLK);
    qkt(pA0, pA1, K_lds + s1 * SHM_K, qr, r32, hi); ATT_MASK(pA0, pA1, 0); partialSM(pA0, pA1, m_reg, mnA, alA, ATT_KEEP(0));
    ATT_ROT();
    for (int j = 1; j < NT; j += 2) {
        __syncthreads();
        if (j + 1 < NT) { asm volatile("s_waitcnt vmcnt(0)" ::: "memory"); ATT_SWRITE(s2); if (j + 2 < NT) ATT_SLOAD((j + 2) * KVBLK); }
        ATT_SBAR(); qkt(pB0, pB1, K_lds + s1 * SHM_K, qr, r32, hi); ATT_MASK(pB0, pB1, j);
        finishSM(pA0, pA1, alA, l_reg, pa0, pa1, pa2, pa3); ATT_SBAR();
        pv(o, vb0 + s0 * SHM_V, pa0, pa1, pa2, pa3); partialSM(pB0, pB1, m_reg, mnB, alB, ATT_KEEP(j));
        ATT_RESC(alB); ATT_ROT();
        if (j + 1 < NT) {
            __syncthreads();
            if (j + 2 < NT) { asm volatile("s_waitcnt vmcnt(0)" ::: "memory"); ATT_SWRITE(s2); if (j + 3 < NT) ATT_SLOAD((j + 3) * KVBLK); }
            ATT_SBAR(); qkt(pA0, pA1, K_lds + s1 * SHM_K, qr, r32, hi); ATT_MASK(pA0, pA1, j + 1);
            finishSM(pB0, pB1, alB, l_reg, pa0, pa1, pa2, pa3); ATT_SBAR();
            pv(o, vb0 + s0 * SHM_V, pa0, pa1, pa2, pa3); partialSM(pA0, pA1, m_reg, mnA, alA, ATT_KEEP(j + 1));
            ATT_RESC(alA); ATT_ROT();
        }
    }
    finishSM(pB0, pB1, alB, l_reg, pa0, pa1, pa2, pa3); ATT_SBAR();
    pv(o, vb0 + s0 * SHM_V, pa0, pa1, pa2, pa3);
#undef ATT_ROT
    if (hi == 0) li_l[r32] = l_reg; asm volatile("s_waitcnt lgkmcnt(0)" ::: "memory");
    float rli[16];
#pragma unroll
    for (int r = 0; r < 16; ++r) rli[r] = __builtin_amdgcn_rcpf(li_l[crow(r, hi)]);
    bf16* Ow = wsp<bf16>(F, WS_MIX) + (rowbase + q0 + wid * QBLK) * DM + h * HD;
    float* ssqa = wsp<float>(F, WS_SSQA) + (rowbase + q0 + wid * QBLK) * NH + h;
    float qq[16];
#pragma unroll
    for (int r = 0; r < 16; ++r) { const int orow = crow(r, hi); float q2 = 0.f;
#pragma unroll
        for (int d0 = 0; d0 < 2; ++d0) { const float v = o[d0][r] * rli[r]; const float vn = __shfl_xor(v, 1); q2 += v * v;
            if ((r32 & 1) == 0) *(unsigned*)(Ow + (size_t)orow * DM + d0 * 32 + r32) = cvt_pk_bf16(v, vn); }
        qq[r] = q2; }
#pragma unroll
    for (int i = 0; i < 8; ++i) { const bool up = (lane & 16) != 0; const float send = up ? qq[i] : qq[i + 8], keep = up ? qq[i + 8] : qq[i]; qq[i] = keep + __shfl_xor(send, 16); }
#pragma unroll
    for (int i = 0; i < 4; ++i) { const bool up = (lane & 8) != 0; const float send = up ? qq[i] : qq[i + 4], keep = up ? qq[i + 4] : qq[i]; qq[i] = keep + __shfl_xor(send, 8); }
#pragma unroll
    for (int i = 0; i < 2; ++i) { const bool up = (lane & 4) != 0; const float send = up ? qq[i] : qq[i + 2], keep = up ? qq[i + 2] : qq[i]; qq[i] = keep + __shfl_xor(send, 4); }
    { const bool up = (lane & 2) != 0; const float send = up ? qq[0] : qq[1], keep = up ? qq[1] : qq[0]; qq[0] = keep + __shfl_xor(send, 2); }
    qq[0] += __shfl_xor(qq[0], 1);
    if ((lane & 1) == 0) ssqa[(size_t)crow(r32 >> 1, hi) * NH] = qq[0];
    __syncthreads();
#undef ATT_SLOAD
#undef ATT_SWRITE
#undef ATT_RESC
#undef ATT_MASK
#undef ATT_KEEP
}
}

namespace gm {
__device__ __forceinline__ int vt_off(int d, int s) { return d * 256 + ((((s >> 3) ^ (d & 15)) & 15) << 4) + (s & 7) * 2; }
__device__ __forceinline__ void units4(const Frame& F, int v, LAS unsigned char* scratch) {
    PHASE_IDS;
    const int tid = TID_, wid = tid >> 6, lane = tid & 63, fr = lane & 15, fq = lane >> 4;
    const int u = wid >> 1, half = wid & 1, uidx = 4 * v + u, b = uidx >> 6, c = (uidx >> 2) & 15, g = uidx & 3;
    const size_t row0 = (size_t)b * SEQ + c * GC;
    const bf16* VGg = wsp<bf16>(F, WS_VG) + row0 * GW + g * GD; const bf16* Ug = wsp<bf16>(F, WS_U) + row0 * GW + g * GD;
    LAS unsigned char* vt = scratch + u * 32768;
    { const int s_ = half * 64 + lane; const v4u* src = (const v4u*)(VGg + (size_t)s_ * GW); v4u raw[16]; float sum = 0.f, sq = 0.f;
#pragma unroll
      for (int i = 0; i < 16; ++i) raw[i] = src[i];
#pragma unroll
      for (int i = 0; i < 16; ++i) { const unsigned ww[4] = {raw[i].x, raw[i].y, raw[i].z, raw[i].w};
#pragma unroll
          for (int k = 0; k < 4; ++k) { const float a0 = bflo(ww[k]), a1 = bfhi(ww[k]); sum += a0 + a1; sq += a0 * a0 + a1 * a1; } }
      const float mu = sum * (1.f / GD); const float var = fmaxf(sq * (1.f / GD) - mu * mu, 0.f); const float rstd = 1.0f / sqrtf(var + EPS);
      const float* lg = F.ln_g + g * GD; const float* lb = F.ln_b + g * GD;
#pragma unroll
      for (int i = 0; i < 16; ++i) { const unsigned ww[4] = {raw[i].x, raw[i].y, raw[i].z, raw[i].w}; const f32x4 g0 = *(const f32x4*)(lg + 8 * i), g1 = *(const f32x4*)(lg + 8 * i + 4), b0 = *(const f32x4*)(lb + 8 * i), b1 = *(const f32x4*)(lb + 8 * i + 4);
          const float gg[8] = {g0[0], g0[1], g0[2], g0[3], g1[0], g1[1], g1[2], g1[3]}, bb[8] = {b0[0], b0[1], b0[2], b0[3], b1[0], b1[1], b1[2], b1[3]};
#pragma unroll
          for (int k = 0; k < 4; ++k) { const int d = 8 * i + 2 * k;
              *(LAS unsigned short*)(vt + vt_off(d, s_)) = (unsigned short)f2bf((bflo(ww[k]) - mu) * rstd * gg[2 * k] + bb[2 * k]);
              *(LAS unsigned short*)(vt + vt_off(d + 1, s_)) = (unsigned short)f2bf((bfhi(ww[k]) - mu) * rstd * gg[2 * k + 1] + bb[2 * k + 1]); } } }
    __syncthreads();
#pragma unroll 1
    for (int m = 0; m < 4; ++m) {
        const int tb = half * 64 + m * 16, t = tb + fr;
        const float* Wg = F.gws + (size_t)g * GC * GC + (size_t)t * GC;
        const int nks = (tb + 16 + 31) / 32;
        f32x4 w0[4], w1[4];
#pragma unroll
        for (int ks = 0; ks < 4; ++ks) if (ks < nks) { w0[ks] = *(const f32x4*)(Wg + ks * 32 + fq * 8); w1[ks] = *(const f32x4*)(Wg + ks * 32 + fq * 8 + 4); }
        const bf16* Ut = Ug + (size_t)t * GW + 4 * fq; v2u uu[8];
#pragma unroll
        for (int n = 0; n < 8; ++n) uu[n] = *(const v2u*)(Ut + n * 16);
        f32x4 acc[8];
#pragma unroll
        for (int n = 0; n < 8; ++n) acc[n] = (f32x4){0.f, 0.f, 0.f, 0.f};
#pragma unroll
        for (int ks = 0; ks < 4; ++ks) if (ks < nks) { const int s0 = ks * 32 + fq * 8;
            float wv[8] = {w0[ks][0], w0[ks][1], w0[ks][2], w0[ks][3], w1[ks][0], w1[ks][1], w1[ks][2], w1[ks][3]};
#pragma unroll
            for (int j = 0; j < 8; ++j) if (s0 + j > t) wv[j] = 0.f;
            v4u aw; aw.x = pk2(wv[0], wv[1]); aw.y = pk2(wv[2], wv[3]); aw.z = pk2(wv[4], wv[5]); aw.w = pk2(wv[6], wv[7]);
            const bf16x8 wf = *reinterpret_cast<const bf16x8*>(&aw);
#pragma unroll
            for (int n = 0; n < 8; ++n) { const bf16x8 vf = *(const LAS bf16x8*)(vt + vt_off(n * 16 + fr, s0));
                acc[n] = __builtin_amdgcn_mfma_f32_16x16x32_bf16(vf, wf, acc[n], 0, 0, 0); } }
        bf16* Og = wsp<bf16>(F, WS_MIX) + (row0 + t) * DM + AW + g * GD + 4 * fq; float* ssqg = wsp<float>(F, WS_SSQG) + (row0 + t) * GG + g;
        const float bs = F.gbs[g * GC + t]; float q2 = 0.f;
#pragma unroll
        for (int n = 0; n < 8; ++n) { const float o0 = bflo(uu[n].x) * (acc[n][0] + bs), o1 = bfhi(uu[n].x) * (acc[n][1] + bs), o2 = bflo(uu[n].y) * (acc[n][2] + bs), o3 = bfhi(uu[n].y) * (acc[n][3] + bs);
            q2 += (o0 * o0 + o1 * o1) + (o2 * o2 + o3 * o3); v2u w; w.x = cvt_pk_bf16(o0, o1); w.y = cvt_pk_bf16(o2, o3); *(v2u*)(Og + n * 16) = w; }
        q2 += __shfl_xor(q2, 16); q2 += __shfl_xor(q2, 32);
        if (fq == 0) ssqg[0] = q2;
    }
    __syncthreads();
}
}

__device__ __forceinline__ void p2_mixers(const Frame& F) {
    PHASE_IDS;
    LAS unsigned char* scratch = F.lds + RING_OFF;
    const int v = F.vcu, bh = v >> 1, s0 = (v & 1) * 2, cslot = (v >> 1) % 6;
    int item = 0;
#pragma unroll 1
    for (int st = 0; st < 6; ++st) {
        if (st == cslot) { constexpr int PER_WG = XW_ITEMS / 256; static_assert(XW_ITEMS % 256 == 0 && PER_WG % NWAVES == 0, "items per workgroup / wave");
            LAS float* scr = (LAS float*)(F.lds + RING_OFF + WAVE_ * P0_SCR_WAVE);
            constexpr int NI = PER_WG / NWAVES; static_assert(NI % 2 == 0, "pairs");
            int ln = LANE_; asm volatile("" : "+v"(ln));
            const int it0 = v * PER_WG + WAVE_; f32x4 va[16], vb[16]; XwDesc da = xw_desc(F, it0, ln), db; xw_load(va, da);
#pragma unroll 1
            for (int j = 0; j < NI; j += 2) {
                db = xw_desc(F, it0 + (j + 1) * NWAVES, ln); xw_load(vb, db);
                xw_process(va, da, scr, ln);
                if (j + 2 < NI) { da = xw_desc(F, it0 + (j + 2) * NWAVES, ln); xw_load(va, da); }
                xw_process(vb, db, scr, ln);
            }
            __syncthreads(); }
        else { if (item < 4) { const int qq = s0 + (item >> 1); const int qb = (item & 1) ? 7 - qq : qq; att::attn_unit(F, bh / NH, bh % NH, qb, scratch); }
               else gm::units4(F, v, scratch);
               ++item; }
    }
}

__device__ __forceinline__ void p4_router(const Frame& F) {
    PHASE_IDS;
    const int tid = TID_, wid = tid >> 6, lane = tid & 63, tk = lane & 31, hf = lane >> 5;
    LAS unsigned* hist = (LAS unsigned*)(F.lds + XTAB_OFF + 4096);
    LAS unsigned* base = hist + 32;
    static_assert(XTAB_OFF + 4096 >= 8 * P0_SCR_WAVE, "router words above the conversion tiles");
    const bf16* RWT = wsp<bf16>(F, WS_RWT); const bf16* x1 = wsp<bf16>(F, WS_X1B); const float* ssq1 = wsp<float>(F, WS_SSQ1);
    unsigned* cntg = (unsigned*)(F.ctl + CW_CNT);
    unsigned* IDX = wsp<unsigned>(F, WS_IDX); float* GSS = wsp<float>(F, WS_GSS); float* RSS = wsp<float>(F, WS_RSS); unsigned* TOKPOS = wsp<unsigned>(F, WS_TOKPOS);
    if (tid < 32) hist[tid] = 0u;
    __syncthreads();
    const bool active = wid < 4; const int tok = (F.vcu * 4 + (wid & 3)) * 32 + tk;
    int pe[4] = {0, 0, 0, 0}; float pg[4] = {0.f, 0.f, 0.f, 0.f}; unsigned rank[2] = {0u, 0u}; int my_e[2] = {0, 0}; float my_g[2] = {0.f, 0.f}; float rstd = 0.f;
    f32x16 acc = f32x16{};
    { constexpr int PITCH = 528; LAS unsigned char* XL = F.lds + RING_OFF; LAS unsigned char* WL = XL + 128 * PITCH;
      const int rsub = lane >> 5, cb = (lane & 31) * 16;
      const char* xsrc = (const char*)(x1 + (size_t)(F.vcu * 128 + 16 * wid + rsub) * DM) + cb; const char* wsrc = (const char*)(RWT + (size_t)(8 * wid + rsub) * DM) + cb;
      LAS unsigned char* xdst = XL + (16 * wid + rsub) * PITCH + cb; LAS unsigned char* wdst = WL + (8 * wid + rsub) * PITCH + cb;
      const LAS unsigned char* xb = XL + ((wid & 3) * 32 + tk) * PITCH + hf * 16; const LAS unsigned char* wa = WL + tk * PITCH + hf * 16; const LAS unsigned char* wb = wa + 32 * PITCH;
      v4u xs[8], ws_[4];
#define RT_LOAD(c) do { _Pragma("unroll") for (int i = 0; i < 8; ++i) xs[i] = *(const v4u*)(xsrc + (size_t)(2 * i) * DM * 2 + (c) * 512); \
                        _Pragma("unroll") for (int i = 0; i < 4; ++i) ws_[i] = *(const v4u*)(wsrc + (size_t)(2 * i) * DM * 2 + (c) * 512); } while (0)
      RT_LOAD(0);
#pragma unroll 1
      for (int c = 0; c < 4; ++c) {
#pragma unroll
          for (int i = 0; i < 8; ++i) *(LAS v4u*)(xdst + 2 * i * PITCH) = xs[i];
#pragma unroll
          for (int i = 0; i < 4; ++i) *(LAS v4u*)(wdst + 2 * i * PITCH) = ws_[i];
          __syncthreads();
          if (c < 3) RT_LOAD(c + 1);
          if (active) {
#pragma unroll
              for (int s_ = 0; s_ < 16; ++s_) { const bf16x8 xv = *(const LAS bf16x8*)(xb + 32 * s_), a_hi = *(const LAS bf16x8*)(wa + 32 * s_), a_lo = *(const LAS bf16x8*)(wb + 32 * s_);
                  acc = __builtin_amdgcn_mfma_f32_32x32x16_bf16(a_hi, xv, acc, 0, 0, 0); acc = __builtin_amdgcn_mfma_f32_32x32x16_bf16(a_lo, xv, acc, 0, 0, 0); } }
          __syncthreads();
      }
#undef RT_LOAD
    }
    if (active) {
        { const f32x4* sp = (const f32x4*)(ssq1 + (size_t)tok * 16); const f32x4 a = sp[0], b = sp[1], c = sp[2], d = sp[3];
          const float s_ = ((a[0] + a[1]) + (a[2] + a[3])) + ((b[0] + b[1]) + (b[2] + b[3])) + ((c[0] + c[1]) + (c[2] + c[3])) + ((d[0] + d[1]) + (d[2] + d[3]));
          rstd = 1.0f / sqrtf(s_ * (1.f / DM) + EPS); }
        float lv[16];
#pragma unroll
        for (int r = 0; r < 16; ++r) { const int e = (r & 3) + 8 * (r >> 2) + 4 * hf; lv[r] = acc[r] * rstd + F.router_b[e]; }
        float tv[4]; int ti[4]; unsigned used = 0u;
#pragma unroll
        for (int k = 0; k < 4; ++k) { float best = -__builtin_inff(); int br = 0;
#pragma unroll
            for (int r = 0; r < 16; ++r) { const int e = (r & 3) + 8 * (r >> 2) + 4 * hf; const int eb = (br & 3) + 8 * (br >> 2) + 4 * hf;
                const bool better = !((used >> r) & 1u) && (lv[r] > best || (lv[r] == best && e < eb)); if (better) { best = lv[r]; br = r; } }
            used |= 1u << br; tv[k] = best; ti[k] = (br & 3) + 8 * (br >> 2) + 4 * hf; }
        float ov[4]; int oi[4];
#pragma unroll
        for (int k = 0; k < 4; ++k) { ov[k] = __shfl_xor(tv[k], 32); oi[k] = __shfl_xor(ti[k], 32); }
        int ia = 0, ib = 0;
#pragma unroll
        for (int k = 0; k < 4; ++k) {
            float va = tv[0], vb = ov[0]; int ea = ti[0], eb = oi[0];
#pragma unroll
            for (int q = 1; q < 4; ++q) { if (ia == q) { va = tv[q]; ea = ti[q]; } if (ib == q) { vb = ov[q]; eb = oi[q]; } }
            const bool takeA = (va > vb) || (va == vb && ea < eb);
            pg[k] = takeA ? va : vb; pe[k] = takeA ? ea : eb; if (takeA) ++ia; else ++ib; }
        { const float m = pg[0]; float s_ = 0.f;
#pragma unroll
          for (int k = 0; k < 4; ++k) { pg[k] = __builtin_amdgcn_exp2f((pg[k] - m) * 1.4426950408889634f); s_ += pg[k]; }
          const float inv = 1.0f / s_;
#pragma unroll
          for (int k = 0; k < 4; ++k) pg[k] *= inv; }
        { const int m = -hf; my_e[0] = pe[0] ^ ((pe[0] ^ pe[2]) & m); my_e[1] = pe[1] ^ ((pe[1] ^ pe[3]) & m);
          const unsigned g0 = __float_as_uint(pg[0]), g1 = __float_as_uint(pg[1]), g2 = __float_as_uint(pg[2]), g3 = __float_as_uint(pg[3]);
          my_g[0] = __uint_as_float(g0 ^ ((g0 ^ g2) & (unsigned)m)); my_g[1] = __uint_as_float(g1 ^ ((g1 ^ g3) & (unsigned)m)); }
#pragma unroll
        for (int q = 0; q < 2; ++q) rank[q] = atomicAdd((unsigned*)&hist[my_e[q]], 1u);
    }
    __syncthreads();
    if (tid < 32) base[tid] = atomicAdd(cntg + tid * CNT_STRIDE, hist[tid]);
    __syncthreads();
    if (active) {
#pragma unroll
        for (int q = 0; q < 2; ++q) { const int k = 2 * hf + q; const int e = my_e[q]; const float g = my_g[q];
            const unsigned slot = base[e] + rank[q];
            IDX[(size_t)e * T + slot] = (unsigned)tok; GSS[(size_t)e * T + slot] = g; RSS[(size_t)e * T + slot] = rstd; TOKPOS[(size_t)tok * 4 + k] = ((unsigned)e << 16) | slot; }
    }
    __syncthreads();
}

__device__ __forceinline__ void build_tstart(const Frame& F, LAS unsigned* tstart, int tid) {
    if (tid < 64) { const unsigned* cntg = (const unsigned*)(F.ctl + CW_CNT); unsigned c = (tid < NE) ? cntg[tid * CNT_STRIDE] : 0u; if (c > (unsigned)T) c = (unsigned)T;
        unsigned x = (c + 255u) >> 8;
#pragma unroll
        for (int o = 1; o < 32; o <<= 1) { const unsigned y = __shfl_up(x, o); if ((tid & 63) >= o) x += y; }
        if (tid < NE) tstart[tid + 1] = x; if (tid == 0) tstart[0] = 0u; }
}
constexpr int MAXU = 17;
constexpr int XT_TSTART = 0, XT_ULIST = 256, XT_RS = 512, XT_GTAB = XT_RS + MAXU * 1024;
static_assert(XT_GTAB + MAXU * 512 <= LDSCTL_OFF - XTAB_OFF, "xtab");
__device__ __forceinline__ int moe_build_tables(const Frame& F, int P  , int mode) {
    PHASE_IDS;
    LAS unsigned* tstart = (LAS unsigned*)(F.lds + XTAB_OFF + XT_TSTART);
    LAS unsigned* ulist = (LAS unsigned*)(F.lds + XTAB_OFF + XT_ULIST);
    LAS float* rs = (LAS float*)(F.lds + XTAB_OFF + XT_RS);
    LAS unsigned short* gtab = (LAS unsigned short*)(F.lds + XTAB_OFF + XT_GTAB);
    const unsigned* cntg = (const unsigned*)(F.ctl + CW_CNT); const unsigned* IDX = wsp<unsigned>(F, WS_IDX);
    const float* RSRC = mode == 1 ? wsp<float>(F, WS_RSS) : wsp<float>(F, WS_GSS);
    const int tid = TID_;
    build_tstart(F, tstart, tid);
    __syncthreads();
    const int NT_ = (int)tstart[NE], U = NT_ * P, G = F.G, c = (int)blockIdx.x;
    int nunits = (c < U) ? (U - c + G - 1) / G : 0; if (nunits > MAXU) nunits = MAXU;
    if (tid < nunits) { const int L = tid * G + c; int gt, pn; pg8::flat_to_tile(L, U, NT_, P, gt, pn);
        int e = 0; for (int k = 1; k < NE; ++k) if ((unsigned)gt >= tstart[k]) e = k;
        const int rt = gt - (int)tstart[e];
        ulist[tid] = (unsigned)gt | ((unsigned)pn << 10) | ((unsigned)e << 13) | ((unsigned)rt << 18); }
    __syncthreads();
    {
        constexpr int NP = (MAXU + 1) / 2; unsigned tokv[NP]; float rsv[NP];
#pragma unroll
        for (int p = 0; p < NP; ++p) { const int i = 2 * p + (tid >> 8), r = tid & 255; tokv[p] = 0u; rsv[p] = 0.f;
            if (i < nunits) { const unsigned w = ulist[i]; const int e = (int)((w >> 13) & 0x1fu), rt = (int)(w >> 18);
                unsigned cn = cntg[e * CNT_STRIDE]; if (cn > (unsigned)T) cn = (unsigned)T; const unsigned slot = (unsigned)rt * 256u + (unsigned)r;
                if (slot < cn) { if (mode == 1) tokv[p] = IDX[(size_t)e * T + slot]; rsv[p] = RSRC[(size_t)e * T + slot]; } } }
#pragma unroll
        for (int p = 0; p < NP; ++p) { const int i = 2 * p + (tid >> 8), r = tid & 255;
            if (i < nunits) { unsigned tok = tokv[p]; if (tok >= (unsigned)T) tok = 0u; if (mode == 1) gtab[i * 256 + r] = (unsigned short)tok; rs[i * 256 + r] = rsv[p]; } }
    }
    __syncthreads();
    return nunits;
}

__device__ __forceinline__ void p7_combine(const Frame& F) {
    PHASE_IDS;
    LAS unsigned* tstart = (LAS unsigned*)(F.lds + XTAB_OFF + XT_TSTART);
    const unsigned* cntg = (const unsigned*)(F.ctl + CW_CNT);
    build_tstart(F, tstart, TID_); (void)cntg;
    __syncthreads();
    const int gw = F.vcu * NWAVES + WAVE_, NGW = F.G * NWAVES;
    const unsigned* TOKPOS = wsp<unsigned>(F, WS_TOKPOS); const unsigned char* Y = wsp<unsigned char>(F, WS_YBUF); const bf16* X1 = wsp<bf16>(F, WS_X1B); bf16* X2 = wsp<bf16>(F, WS_X2B); unsigned char* X28 = wsp<unsigned char>(F, WS_X2F8); float* RS2 = wsp<float>(F, WS_RSTD2);
    for (int m0 = gw; m0 < T; m0 += 2 * NGW) {
        f32x4 v[2][4]; unsigned yv[2][4][4]; float s[2] = {0.f, 0.f};
#pragma unroll
        for (int r = 0; r < 2; ++r) { const int m = m0 + r * NGW;
            const v4u tp = *(const v4u*)(TOKPOS + (size_t)m * 4); const unsigned tpw[4] = {tp.x, tp.y, tp.z, tp.w};
            size_t yrow[4];
#pragma unroll
            for (int k = 0; k < 4; ++k) { const unsigned e = (tpw[k] >> 16) & 31u, slot = tpw[k] & 0xffffu; yrow[k] = ((size_t)tstart[e] * 256u + slot) * DM; }
#pragma unroll
            for (int j = 0; j < 4; ++j) { const v2u xw = __builtin_nontemporal_load((const v2u*)(X1 + (size_t)m * DM + 4 * LANE_ + 256 * j)); v[r][j] = (f32x4){bflo(xw.x), bfhi(xw.x), bflo(xw.y), bfhi(xw.y)};
#pragma unroll
                for (int k = 0; k < 4; ++k) yv[r][j][k] = __builtin_nontemporal_load((const unsigned*)(Y + yrow[k] + 4 * LANE_ + 256 * j)); } }
#pragma unroll
        for (int r = 0; r < 2; ++r) {
#pragma unroll
            for (int j = 0; j < 4; ++j) {
#pragma unroll
                for (int k = 0; k < 4; ++k) { const unsigned w = yv[r][j][k]; const f32x2 lo = __builtin_amdgcn_cvt_pk_f32_fp8((int)w, false), hi2 = __builtin_amdgcn_cvt_pk_f32_fp8((int)w, true);
                    v[r][j][0] += lo[0] * (1.0f / Y_SCALE); v[r][j][1] += lo[1] * (1.0f / Y_SCALE); v[r][j][2] += hi2[0] * (1.0f / Y_SCALE); v[r][j][3] += hi2[1] * (1.0f / Y_SCALE); }
                s[r] += (v[r][j].x * v[r][j].x + v[r][j].y * v[r][j].y) + (v[r][j].z * v[r][j].z + v[r][j].w * v[r][j].w); } }
#pragma unroll
        for (int r = 0; r < 2; ++r) { const int m = m0 + r * NGW; const float rstd = 1.0f / sqrtf(wave_sum(s[r]) * (1.f / DM) + EPS);
            if (LANE_ == 0) RS2[m] = rstd;
#pragma unroll
            for (int j = 0; j < 4; ++j) { v2u w; w.x = cvt_pk_bf16(v[r][j].x, v[r][j].y); w.y = cvt_pk_bf16(v[r][j].z, v[r][j].w); *(v2u*)(X2 + (size_t)m * DM + 4 * LANE_ + 256 * j) = w;
                *(unsigned*)(X28 + (size_t)m * DM + 4 * LANE_ + 256 * j) = pk4_fp8(v[r][j].x, v[r][j].y, v[r][j].z, v[r][j].w); } }
    }
}

__device__ __forceinline__ void p9_final(const Frame& F) {
    PHASE_IDS;
    const int gw = F.vcu * NWAVES + WAVE_, NGW = F.G * NWAVES;
    const unsigned char* GATE = wsp<unsigned char>(F, WS_GATE); const unsigned char* PP = wsp<unsigned char>(F, WS_PP); const float* ssqpp = wsp<float>(F, WS_SSQPP);
    for (int m0 = gw; m0 < T; m0 += 2 * NGW) {
        f32x4 v[2][4]; unsigned gv[2][4], pv_[2][4]; f32x4 sq[2][4]; float s[2] = {0.f, 0.f};
#pragma unroll
        for (int r = 0; r < 2; ++r) { const int m = m0 + r * NGW; const bf16* x2r = wsp<bf16>(F, WS_X2B) + (size_t)m * DM;
#pragma unroll
            for (int q = 0; q < 4; ++q) sq[r][q] = *(const f32x4*)(ssqpp + (size_t)m * 16 + 4 * q);
#pragma unroll
            for (int j = 0; j < 4; ++j) { const int col = 4 * LANE_ + 256 * j; const v2u xw = __builtin_nontemporal_load((const v2u*)(x2r + col)); v[r][j] = (f32x4){bflo(xw.x), bfhi(xw.x), bflo(xw.y), bfhi(xw.y)};
                gv[r][j] = __builtin_nontemporal_load((const unsigned*)(GATE + (size_t)m * DM + col)); pv_[r][j] = __builtin_nontemporal_load((const unsigned*)(PP + (size_t)m * DM + col)); } }
#pragma unroll
        for (int r = 0; r < 2; ++r) { const f32x4 a = sq[r][0], b = sq[r][1], c = sq[r][2], d = sq[r][3];
            const float sp = ((a[0] + a[1]) + (a[2] + a[3])) + ((b[0] + b[1]) + (b[2] + b[3])) + ((c[0] + c[1]) + (c[2] + c[3])) + ((d[0] + d[1]) + (d[2] + d[3]));
            const float rpp = 1.0f / sqrtf(sp * (1.f / DM) + EPS);
#pragma unroll
            for (int j = 0; j < 4; ++j) { const int col = 4 * LANE_ + 256 * j; const f32x4 pg_ = *(const f32x4*)(F.ppn + col);
                const f32x2 g01 = __builtin_amdgcn_cvt_pk_f32_fp8((int)gv[r][j], false), g23 = __builtin_amdgcn_cvt_pk_f32_fp8((int)gv[r][j], true);
                const f32x2 p01 = __builtin_amdgcn_cvt_pk_f32_fp8((int)pv_[r][j], false), p23 = __builtin_amdgcn_cvt_pk_f32_fp8((int)pv_[r][j], true);
                const float rg = rpp * (1.0f / GATE_SCALE);
                v[r][j][0] += g01[0] * (p01[0] * rg * pg_[0]); v[r][j][1] += g01[1] * (p01[1] * rg * pg_[1]);
                v[r][j][2] += g23[0] * (p23[0] * rg * pg_[2]); v[r][j][3] += g23[1] * (p23[1] * rg * pg_[3]);
                s[r] += (v[r][j].x * v[r][j].x + v[r][j].y * v[r][j].y) + (v[r][j].z * v[r][j].z + v[r][j].w * v[r][j].w); } }
#pragma unroll
        for (int r = 0; r < 2; ++r) { const int m = m0 + r * NGW; float* xr = F.out + (size_t)m * DM; const float rstd = 1.0f / sqrtf(wave_sum(s[r]) * (1.f / DM) + EPS);
#pragma unroll
            for (int j = 0; j < 4; ++j) { const int col = 4 * LANE_ + 256 * j; const f32x4 fg = *(const f32x4*)(F.final_norm + col); __builtin_nontemporal_store(v[r][j] * rstd * fg, (f32x4*)(xr + col)); } }
    }
}

struct Args { const float* in[23]; float* out; unsigned char* ws; };
#if CHECK_STAGE
__device__ __forceinline__ unsigned hmix(unsigned z) { z ^= z >> 16; z *= 0x7feb352du; z ^= z >> 15; z *= 0x846ca68bu; z ^= z >> 16; return z; }
__device__ __forceinline__ void chk_add(const Frame& F, int st, bool bad) { atomicAdd((unsigned*)(F.ctl + CW_CHK + 2 * st), bad ? 1u : 0u); atomicAdd((unsigned*)(F.ctl + CW_CHK + 2 * st + 1), 1u); }
__device__ __forceinline__ bool offby(float got, float ex, float rel, float ab) { const float d = fabsf(got - ex); return !(d <= rel * fabsf(ex) + ab); }
__device__ __forceinline__ float dot_bf(const bf16* a, const bf16* b, int n) { float s = 0.f; for (int k = 0; k < n; ++k) s += bf2f(a[k]) * bf2f(b[k]); return s; }
__device__ __forceinline__ float gelu_ref(float v) { return 0.5f * v * (1.0f + erff(v * 0.70710678f)); }
__device__ __forceinline__ unsigned chk_tstart(const Frame& F, unsigned ex) { const unsigned* cntg = (const unsigned*)(F.ctl + CW_CNT); unsigned s_ = 0; for (unsigned e = 0; e < ex; ++e) { unsigned c = cntg[e * CNT_STRIDE]; if (c > (unsigned)T) c = T; s_ += (c + 255u) >> 8; } return s_; }
template <int ST> __device__ __forceinline__ void stage_check(const Frame& F) {
    const unsigned gt = (unsigned)blockIdx.x * NTHR + threadIdx.x;
    const unsigned h0 = hmix(gt * 2654435761u + ST * 40503u), h1 = hmix(h0 + 0x9e3779b9u), h2 = hmix(h1 + 0x85ebca6bu);
    if (ST == 1) {
        if (gt >= 16384) return;
        const int which = gt & 7;
        if (which == 0) { const int e = h0 % NE, n = h1 % (2 * FF), k = h2 % DM; const int lc = CmWgu()(n);
            const float ex = bf2f((bf16)f2bf(F.w_gu[((size_t)e * DM + k) * 2 * FF + lc] * F.ffn_norm[k])); chk_add(F, ST, offby(bf2f(wsp<bf16>(F, WS_WGU)[((size_t)e * 2 * FF + n) * DM + k]), ex, 1e-6f, 1e-30f)); }
        else if (which == 1) { const int e = h0 % NE, n = h1 % DM, k = h2 % FF;
            const float ex = bf2f((bf16)f2bf(F.w_dn[((size_t)e * FF + k) * DM + n])); chk_add(F, ST, offby(bf2f(wsp<bf16>(F, WS_WDN)[((size_t)e * DM + n) * FF + k]), ex, 1e-6f, 1e-30f)); }
        else if (which == 2) { const int n = h1 % NPROJ, k = h2 % DM; const int lc = CmWin()(n);
            const float ex = bf2f((bf16)f2bf(F.w_in[(size_t)k * NPROJ + lc] * F.mix_norm[k])); chk_add(F, ST, offby(bf2f(wsp<bf16>(F, WS_WIN)[(size_t)n * DM + k]), ex, 1e-6f, 1e-30f)); }
        else if (which == 3) { const int n = h1 % DM, k = h2 % DM; const float g = k < AW ? F.aon[k] : F.gon[k - AW];
            const float ex = bf2f((bf16)f2bf(F.w_out[(size_t)k * DM + n] * g)); chk_add(F, ST, offby(bf2f(wsp<bf16>(F, WS_WOUT)[(size_t)n * DM + k]), ex, 1e-6f, 1e-30f)); }
        else if (which == 4) { const int n = h1 % DM, k = h2 % DM;
            const float ex = bf2f((bf16)f2bf(F.w_pg[(size_t)k * DM + n] * F.ple_norm[k])); chk_add(F, ST, offby(bf2f(wsp<bf16>(F, WS_WPG)[(size_t)n * DM + k]), ex, 1e-6f, 1e-30f)); }
        else if (which == 5) { const int n = h1 % DM, k = h2 % PLE;
            const float ex = bf2f((bf16)f2bf(F.w_pp[(size_t)k * DM + n])); chk_add(F, ST, offby(bf2f(wsp<bf16>(F, WS_WPP)[(size_t)n * PLE + k]), ex, 1e-6f, 1e-30f)); }
        else if (which == 6) { const int row = h0 % T, k = h1 % DM; float ss = 0.f; for (int j = 0; j < DM; ++j) { const float v = F.x[(size_t)row * DM + j]; ss += v * v; }
            const float ex = F.x[(size_t)row * DM + k] / sqrtf(ss / DM + EPS); chk_add(F, ST, offby(bf2f(wsp<bf16>(F, WS_XNB)[(size_t)row * DM + k]), ex, 0.01f, 1e-3f)); }
        else { const int row = h0 % T, k = h1 % PLE; chk_add(F, ST, offby(bf2f(wsp<bf16>(F, WS_PB)[(size_t)row * PLE + k]), F.p[(size_t)row * PLE + k], 0.005f, 1e-6f)); }
    }
    if (ST == 2) {
        if (gt >= 16384) return;
        const bf16* XN = wsp<bf16>(F, WS_XNB); const bf16* WIN = wsp<bf16>(F, WS_WIN);
        if ((gt & 7) == 7) {
            const int b = h0 % BATCH, hh = h1 % NH, blk = h2 % NBLK, c = (h2 >> 8) % HD; float s_ = 0.f;
            for (int r = 0; r < 256; ++r) s_ += bf2f(wsp<bf16>(F, WS_K)[((size_t)b * SEQ + blk * 256 + r) * AW + hh * HD + c]);
            chk_add(F, ST, offby(wsp<float>(F, WS_KMEAN)[((size_t)(b * NH + hh) * NBLK + blk) * HD + c], s_, 0.02f, 0.3f)); return; }
        const int row = h0 % T, type = h1 % 5, c = h2 % AW; const bf16* xr = XN + (size_t)row * DM;
        const float v = dot_bf(xr, WIN + (size_t)(type * AW + c) * DM, DM); float ex;
        if (type <= 1) { const float vp = dot_bf(xr, WIN + (size_t)(type * AW + (c ^ 4)) * DM, DM); const int i = 4 * ((c & 63) >> 3) + (c & 3), pos = row & (SEQ - 1);
            const float cs = wsp<float>(F, WS_ROPE)[pos * 32 + i], sn = wsp<float>(F, WS_ROPE)[SEQ * 32 + pos * 32 + i];
            { const float inv = powf(10000.0f, -(float)i / 32.0f); const float ang = (float)pos * inv; if (offby(cs, cosf(ang), 0.f, 1e-3f) || offby(sn, sinf(ang), 0.f, 1e-3f)) { chk_add(F, ST, true); return; } }
            ex = (c & 4) ? v * cs + vp * sn : v * cs - vp * sn; }
        else if (type == 2) ex = v; else ex = gelu_ref(v);
        chk_add(F, ST, offby(bf2f(wsp<bf16>(F, WS_Q)[(size_t)type * (16u << 20) + (size_t)row * AW + c]), ex, 0.02f, 0.02f));
    }
    if (ST == 3) {
        if (gt >= 8192) return;
        if (gt & 1) {
            const int row = h0 % T, g = h1 % GG, d = h2 % GD; const int b = row / SEQ, s_ = row % SEQ, c = s_ / GC, t = s_ % GC; float acc = 0.f;
            for (int sp = 0; sp <= t; ++sp) { const bf16* vr = wsp<bf16>(F, WS_VG) + ((size_t)b * SEQ + c * GC + sp) * GW + g * GD; float mu = 0.f; for (int j = 0; j < GD; ++j) mu += bf2f(vr[j]); mu /= GD;
                float var = 0.f; for (int j = 0; j < GD; ++j) { const float dd = bf2f(vr[j]) - mu; var += dd * dd; } const float rstd = 1.0f / sqrtf(var / GD + EPS);
                const float vn = bf2f((bf16)f2bf((bf2f(vr[d]) - mu) * rstd * F.ln_g[g * GD + d] + F.ln_b[g * GD + d])); acc += bf2f((bf16)f2bf(F.gws[((size_t)g * GC + t) * GC + sp])) * vn; }
            const float ex = bf2f(wsp<bf16>(F, WS_U)[(size_t)row * GW + g * GD + d]) * (acc + F.gbs[g * GC + t]);
            chk_add(F, ST, offby(bf2f(wsp<bf16>(F, WS_MIX)[(size_t)row * DM + AW + g * GD + d]), ex, 0.03f, 0.02f)); return; }
        const int row = h0 % T, hh = h1 % NH; const int b = row / SEQ, s_ = row % SEQ, qb = s_ / MOBA; float q[HD];
#pragma unroll
        for (int c = 0; c < HD; ++c) q[c] = bf2f(wsp<bf16>(F, WS_Q)[(size_t)row * AW + hh * HD + c]);
        unsigned sel = 0u;
        if (qb <= 3) sel = (1u << qb) - 1u;
        else { float b0 = -__builtin_inff(), b1 = b0, b2 = b0; int i0 = 0, i1 = 0, i2 = 0;
            for (int j = 0; j < qb; ++j) { const float* km = wsp<float>(F, WS_KMEAN) + ((size_t)(b * NH + hh) * NBLK + j) * HD; float g = 0.f;
#pragma unroll
                for (int c = 0; c < HD; ++c) g += q[c] * km[c];
                if (g > b0) { b2 = b1; i2 = i1; b1 = b0; i1 = i0; b0 = g; i0 = j; } else if (g > b1) { b2 = b1; i2 = i1; b1 = g; i1 = j; } else if (g > b2) { b2 = g; i2 = j; } }
            sel = (1u << i0) | (1u << i1) | (1u << i2); }
        float mx = -__builtin_inff();
        for (int kp = 0; kp <= s_; ++kp) { const int blk = kp / MOBA; if (blk != qb && !((sel >> blk) & 1u)) continue; const bf16* kr = wsp<bf16>(F, WS_K) + ((size_t)b * SEQ + kp) * AW + hh * HD; float sc = 0.f;
#pragma unroll
            for (int c = 0; c < HD; ++c) sc += q[c] * bf2f(kr[c]);
            mx = fmaxf(mx, sc * 0.125f); }
        float o[HD]; float l = 0.f;
#pragma unroll
        for (int c = 0; c < HD; ++c) o[c] = 0.f;
        for (int kp = 0; kp <= s_; ++kp) { const int blk = kp / MOBA; if (blk != qb && !((sel >> blk) & 1u)) continue; const bf16* kr = wsp<bf16>(F, WS_K) + ((size_t)b * SEQ + kp) * AW + hh * HD; float sc = 0.f;
#pragma unroll
            for (int c = 0; c < HD; ++c) sc += q[c] * bf2f(kr[c]);
            const float pr = expf(sc * 0.125f - mx); l += pr; const bf16* vr = wsp<bf16>(F, WS_V) + ((size_t)b * SEQ + kp) * AW + hh * HD;
#pragma unroll
            for (int c = 0; c < HD; ++c) o[c] += pr * bf2f(vr[c]); }
        bool bad = false; float ss = 0.f;
#pragma unroll
        for (int c = 0; c < HD; ++c) { const float ex = o[c] / l; ss += ex * ex; bad |= offby(bf2f(wsp<bf16>(F, WS_MIX)[(size_t)row * DM + hh * HD + c]), ex, 0.04f, 0.02f); }
        bad |= offby(wsp<float>(F, WS_SSQA)[(size_t)row * NH + hh], ss, 0.03f, 1e-3f);
        chk_add(F, ST, bad);
    }
    if (ST == 4) {
        if (gt >= 16384) return;
        const int row = h0 % T, col = h1 % DM; const bf16* mr = wsp<bf16>(F, WS_MIX) + (size_t)row * DM; const bf16* wr_ = wsp<bf16>(F, WS_WOUT) + (size_t)col * DM;
        float sa = 0.f, sg = 0.f, da = 0.f, dg = 0.f;
        for (int k = 0; k < AW; ++k) { const float a = bf2f(mr[k]), g = bf2f(mr[AW + k]); sa += a * a; sg += g * g; da += a * bf2f(wr_[k]); dg += g * bf2f(wr_[AW + k]); }
        const float ex = F.x[(size_t)row * DM + col] + da / sqrtf(sa / AW + EPS) + dg / sqrtf(sg / GW + EPS);
        chk_add(F, ST, offby(F.out[(size_t)row * DM + col], ex, 0.01f, 0.03f));
    }
    if (ST == 5) {
        if (gt >= 8192) return;
        const int tok = h0 % T; const float* xr = F.out + (size_t)tok * DM; float ss = 0.f; for (int k = 0; k < DM; ++k) ss += xr[k] * xr[k]; const float rstd = 1.0f / sqrtf(ss / DM + EPS);
        bool bad = false;
        for (int j = 0; j < 4; ++j) { const int k = (h1 >> (8 * j)) % DM; bad |= offby(bf2f(wsp<bf16>(F, WS_XNB)[(size_t)tok * DM + k]), xr[k] * rstd, 0.01f, 1e-3f); }
        float lg[NE];
#pragma unroll
        for (int e = 0; e < NE; ++e) lg[e] = 0.f;
        for (int k = 0; k < DM; ++k) { const float xv = xr[k] * rstd * F.ffn_norm[k];
#pragma unroll
            for (int e = 0; e < NE; ++e) lg[e] += xv * F.router_w[k * NE + e]; }
#pragma unroll
        for (int e = 0; e < NE; ++e) lg[e] += F.router_b[e];
        int te[4]; float tv[4]; unsigned used = 0u;
#pragma unroll
        for (int k = 0; k < 4; ++k) { float best = -__builtin_inff(); int bi = 0;
#pragma unroll
            for (int e = 0; e < NE; ++e) if (!((used >> e) & 1u) && lg[e] > best) { best = lg[e]; bi = e; }
            used |= 1u << bi; te[k] = bi; tv[k] = best; }
        { float gg[4]; float den = 0.f;
#pragma unroll
          for (int k = 0; k < 4; ++k) { float v = -__builtin_inff();
#pragma unroll
              for (int e = 0; e < NE; ++e) if (e == te[k]) v = lg[e];
              gg[k] = v; }
          const float mm = gg[0];
#pragma unroll
          for (int k = 0; k < 4; ++k) { gg[k] = expf(gg[k] - mm); den += gg[k]; }
          const unsigned* tp = wsp<unsigned>(F, WS_TOKPOS) + (size_t)tok * 4;
#pragma unroll
          for (int k = 0; k < 4; ++k) { const unsigned e = tp[k] >> 16, slot = tp[k] & 0xffffu; bad |= (e != (unsigned)te[k]);
              if (e < NE && slot < (unsigned)T) { bad |= wsp<unsigned>(F, WS_IDX)[(size_t)e * T + slot] != (unsigned)tok; bad |= offby(wsp<float>(F, WS_GSS)[(size_t)e * T + slot], gg[k] / den, 2e-3f, 1e-5f);
                  bad |= slot >= ((const unsigned*)(F.ctl + CW_CNT))[e * CNT_STRIDE]; } else bad = true; } }
        (void)tv;
        chk_add(F, ST, bad);
    }
    if (ST == 6 || ST == 7) {
        if (gt >= 16384) return;
        const int tok = h0 % T, k = h1 & 3, col = (h1 >> 2) % FF; const unsigned tp = wsp<unsigned>(F, WS_TOKPOS)[(size_t)tok * 4 + k]; const unsigned e = tp >> 16, slot = tp & 0xffffu;
        if (e >= NE) { chk_add(F, ST, true); return; }
        const unsigned tse = chk_tstart(F, e);
        const size_t row = (size_t)tse * 256 + slot;
        if (ST == 6) { const bf16* xr = wsp<bf16>(F, WS_XNB) + (size_t)tok * DM; const int np = (col >> 7) * 256 + (col & 127);
            const float g = dot_bf(xr, wsp<bf16>(F, WS_WGU) + ((size_t)e * 2 * FF + np) * DM, DM) + F.b_gu[(size_t)e * 2 * FF + col];
            const float l = dot_bf(xr, wsp<bf16>(F, WS_WGU) + ((size_t)e * 2 * FF + np + 128) * DM, DM) + F.b_gu[(size_t)e * 2 * FF + FF + col];
            const float gc = fminf(g, 7.f), lc = fminf(fmaxf(l, -7.f), 7.f); const float ex = gc / (1.0f + expf(-1.702f * gc)) * (lc + 1.0f);
            chk_add(F, ST, offby(bf2f(wsp<bf16>(F, WS_ABUF)[row * FF + col]), ex, 0.03f, 0.03f)); }
        else { const float d = dot_bf(wsp<bf16>(F, WS_ABUF) + row * FF, wsp<bf16>(F, WS_WDN) + ((size_t)e * DM + col) * FF, FF) + F.b_dn[(size_t)e * DM + col];
            const float ex = d * wsp<float>(F, WS_GSS)[(size_t)e * T + slot];
            chk_add(F, ST, offby(bf2f(wsp<bf16>(F, WS_YBUF)[row * DM + col]), ex, 0.03f, 0.01f)); }
    }
    if (ST == 8) {
        if (gt >= 8192) return;
        const int tok = h0 % T; const float* xr = F.out + (size_t)tok * DM; float ss = 0.f; for (int k = 0; k < DM; ++k) ss += xr[k] * xr[k]; const float rstd = 1.0f / sqrtf(ss / DM + EPS);
        bool bad = false; for (int k = 0; k < DM; ++k) { bad |= offby(bf2f(wsp<bf16>(F, WS_X2N)[(size_t)tok * DM + k]), xr[k] * rstd, 0.01f, 1e-3f); bad |= !(fabsf(xr[k]) < 30.f); }
        chk_add(F, ST, bad);
    }
    if (ST == 9) {
        if (gt >= 16384) return;
        const int row = h0 % T, col = h1 % DM;
        if (gt & 1) { const float d = dot_bf(wsp<bf16>(F, WS_X2N) + (size_t)row * DM, wsp<bf16>(F, WS_WPG) + (size_t)col * DM, DM); const float got = bf2f(wsp<bf16>(F, WS_GATE)[(size_t)row * DM + col]); const float ex = 1.0f / (1.0f + expf(-d)); const bool bad = offby(got, ex, 0.02f, 0.01f); chk_add(F, ST, bad);
            if (bad) { atomicOr((unsigned*)(F.ctl + CW_CHK + 40), 1u << ((col >> 3) & 31)); atomicOr((unsigned*)(F.ctl + CW_CHK + 41), 1u << ((row >> 3) & 31)); atomicOr((unsigned*)(F.ctl + CW_CHK + 42), 1u << (col & 7)); atomicOr((unsigned*)(F.ctl + CW_CHK + 43), 1u << (row & 7));
                if (!(got >= 0.f && got <= 1.f)) atomicAdd((unsigned*)(F.ctl + CW_CHK + 44), 1u); { int cl = (int)floorf(log2f(fabsf(got) + 1e-30f)) + 40; cl = cl < 0 ? 0 : (cl > 80 ? 80 : cl); atomicMax((unsigned*)(F.ctl + CW_CHK + 46), (unsigned)cl); atomicMin((unsigned*)(F.ctl + CW_CHK + 47), 0xffffffffu - (unsigned)cl); if (got < 0.f) atomicAdd((unsigned*)(F.ctl + CW_CHK + 48), 1u); } if (fabsf(got - ex) > 0.2f) atomicAdd((unsigned*)(F.ctl + CW_CHK + 45), 1u); } }
        else { const float d = dot_bf(wsp<bf16>(F, WS_PB) + (size_t)row * PLE, wsp<bf16>(F, WS_WPP) + (size_t)col * PLE, PLE); chk_add(F, 10, offby(bf2f(wsp<bf16>(F, WS_PP)[(size_t)row * DM + col]), d, 0.02f, 0.02f)); }
    }
}
__device__ __forceinline__ void check_report(const Frame& F) {
    float c2 = 3.0f;
    for (int st = 1; st <= 10; ++st) { const unsigned bad = F.ctl[CW_CHK + 2 * st], tot = F.ctl[CW_CHK + 2 * st + 1]; const float fr = tot ? (float)bad / (float)tot : 1.0f;
        (void)fr; if (((CHECK_SKIP >> st) & 1) == 0 && bad >= 1u) { c2 = powf(10.0f, (float)st) * (1.0f + fminf((float)bad, 80.0f) * 0.1f); break; } }
#if CHECK_REPORT >= 40
    { unsigned v = F.ctl[CW_CHK + CHECK_REPORT]; if (CHECK_REPORT == 47) v = 0xffffffffu - v; c2 = powf(10.0f, (float)(v >> 27)) * (1.0f + (float)((v >> 21) & 63u) * 0.1f);
#if CHECK_REPORT2
      c2 = powf(10.0f, (float)((v >> 16) & 31u)) * (1.0f + (float)((v >> 10) & 63u) * 0.1f);
#endif
#if CHECK_REPORT3
      c2 = powf(10.0f, (float)((v >> 5) & 31u)) * (1.0f + (float)(v & 31u) * 0.1f);
#endif
      if (CHECK_REPORT >= 46 && CHECK_REPORT <= 47) c2 = powf(10.0f, (float)(v / 9u)) * (1.0f + (float)(v % 9u));
    }
#endif
    if (g_gridbar[XB_TMO] != 0u) c2 = 1e20f;
    const float c = sqrtf(c2);
    for (size_t i = (size_t)blockIdx.x * NTHR + threadIdx.x; i < (size_t)T * DM; i += (size_t)gridDim.x * NTHR) F.out[i] = c;
}
#define STAGE_CHECK(n) stage_check<(n)>(F)
#else
#define STAGE_CHECK(n) do {} while (0)
#endif

__global__ void __launch_bounds__(NTHR, 2) mega_fwd(Args args) {
    extern __shared__ __attribute__((aligned(16))) unsigned char lds_raw[];
    Frame F;
    F.lds = (LAS unsigned char*)lds_raw;
    F.MISC = (volatile LAS unsigned*)(F.lds + LDSCTL_OFF);
    F.G = gridDim.x; { const int bx = blockIdx.x; F.vcu = (F.G % 8 == 0) ? (bx % 8) * (F.G / 8) + bx / 8 : bx; }
    F.ws = args.ws; F.ctl = (gu32*)(args.ws + WS_CTL); F.out = args.out;
    F.x = args.in[0]; F.p = args.in[1]; F.mix_norm = args.in[2]; F.w_in = args.in[3]; F.ln_g = args.in[4]; F.ln_b = args.in[5]; F.gws = args.in[6]; F.gbs = args.in[7];
    F.aon = args.in[8]; F.gon = args.in[9]; F.w_out = args.in[10]; F.ffn_norm = args.in[11]; F.router_w = args.in[12]; F.router_b = args.in[13]; F.w_gu = args.in[14]; F.b_gu = args.in[15];
    F.w_dn = args.in[16]; F.b_dn = args.in[17]; F.ple_norm = args.in[18]; F.w_pg = args.in[19]; F.w_pp = args.in[20]; F.ppn = args.in[21]; F.final_norm = args.in[22];
    { PHASE_IDS; for (int u = TID_; u < 256; u += NTHR) ((LAS unsigned*)(F.lds + LDSCTL_OFF))[u] = 0u; }
    __syncthreads();
    XcdBarrier bar = xcd_barrier_post(g_gridbar, F.MISC + 8);
#define GRID_BAR() xcd_barrier(bar)
#define STAGE_END(n) do { STAGE_CHECK(n); if (TPROBE && blockIdx.x == 0 && threadIdx.x == 0) ((unsigned long long*)(F.ctl + CW_TS))[(n)] = __builtin_amdgcn_s_memrealtime(); } while (0)

    if (TPROBE && blockIdx.x == 0 && threadIdx.x == 0) ((unsigned long long*)(F.ctl + CW_TS))[0] = __builtin_amdgcn_s_memrealtime();
    for (int rep = 0; rep < (DUP_PHASE == 0 ? 2 : 1); ++rep) {
    if (PH(0)) p0_prologue(F);
    GRID_BAR(); }
    STAGE_END(1);
    if (PH(1)) { pg8::DenseSched S; S.init(wsp<bf16>(F, WS_XNB), wsp<bf16>(F, WS_WIN), T, NPROJ, DM, F.G, (int)blockIdx.x);
      float* RC = wsp<float>(F, WS_ROPE);
      EpiInProj E{wsp<bf16>(F, WS_Q), RC, RC + SEQ * 32, wsp<float>(F, WS_KMEAN)};
      for (int rep = 0; rep < (DUP_PHASE == 1 ? 2 : 1); ++rep) { if (rep) GRID_BAR();
      pg8::gemm_phase<EpiInProj, pg8::DenseSched, false, false>(F.lds + RING_OFF, DM * 2, S, E); } }
    GRID_BAR();
    STAGE_END(2);
    for (int rep = 0; rep < (DUP_PHASE == 2 ? 2 : 1); ++rep) {
    if (PH(2)) p2_mixers(F);
    GRID_BAR(); }
    STAGE_END(3);
    if (PH(3)) { pg8::DenseSched S; S.init(wsp<bf16>(F, WS_MIX), wsp<bf16>(F, WS_WOUT), T, DM, DM, F.G, (int)blockIdx.x);
      LAS f32x4* rtab = (LAS f32x4*)(F.lds + XTAB_OFF);
      Unit ua, ub; const bool ha = S.next(0, ua), hb = S.next(1, ub);
      { PHASE_IDS; const int s = TID_ >> 8, r = TID_ & 255; const bool has = s ? hb : ha; const int pm = s ? ub.pm : ua.pm;
        if (has) { const size_t row = (size_t)pm * 256 + r; const f32x4* pa = (const f32x4*)(wsp<float>(F, WS_SSQA) + row * NH); const f32x4 a0 = pa[0], a1 = pa[1], g0 = *(const f32x4*)(wsp<float>(F, WS_SSQG) + row * GG);
            const float sa = ((a0[0] + a0[1]) + (a0[2] + a0[3])) + ((a1[0] + a1[1]) + (a1[2] + a1[3])), sg = (g0[0] + g0[1]) + (g0[2] + g0[3]);
            const float ra = 1.0f / sqrtf(sa * (1.f / AW) + EPS), rg = 1.0f / sqrtf(sg * (1.f / GW) + EPS);
            rtab[s * 256 + r] = (f32x4){ra / rg, rg, wsp<float>(F, WS_SIG0)[row], 0.f}; } }
      __syncthreads();
      EpiOutProj E{wsp<bf16>(F, WS_XNB), wsp<bf16>(F, WS_X1B), wsp<unsigned char>(F, WS_X1F8), wsp<float>(F, WS_SSQ1), rtab, F.ffn_norm, ha ? ua.pm : -1, hb ? ub.pm : -1};
      for (int rep = 0; rep < (DUP_PHASE == 3 ? 2 : 1); ++rep) { if (rep) GRID_BAR();
      pg8::gemm_phase<EpiOutProj, pg8::DenseSched, false, true>(F.lds + RING_OFF, DM * 2, S, E); } }
    GRID_BAR();
    STAGE_END(4);
    if (PH(4)) p4_router(F);
    GRID_BAR();
    STAGE_END(5);
    if (PH(5)) { const int nu = moe_build_tables(F, 2 * FF / 256, 1);
      pg8::MoeSched S{(const char*)wsp<char>(F, WS_X1F8), (const char*)wsp<char>(F, WS_WGU), 0, (size_t)2 * FF * DM, (size_t)256 * DM, nu,
                      (const LAS unsigned*)(F.lds + XTAB_OFF + XT_ULIST), (const LAS unsigned*)(F.lds + XTAB_OFF + XT_GTAB), true};
      EpiMoe1 E{wsp<unsigned char>(F, WS_ABUF), F.b_gu, (const LAS float*)(F.lds + XTAB_OFF + XT_RS)};
      for (int rep = 0; rep < (DUP_PHASE == 5 ? 2 : 1); ++rep) { if (rep) GRID_BAR();
      int Kb = DM; asm volatile("" : "+s"(Kb));
      pg8::gemm_phase<EpiMoe1, pg8::MoeSched, true, false, true>(F.lds + RING_OFF, Kb, S, E); } }
    GRID_BAR();
    STAGE_END(6);
    if (PH(6)) { const int nu = moe_build_tables(F, DM / 256, 2);
      pg8::MoeSched S{(const char*)wsp<char>(F, WS_ABUF), (const char*)wsp<char>(F, WS_WDN), (size_t)256 * FF, (size_t)DM * FF, (size_t)256 * FF, nu,
                      (const LAS unsigned*)(F.lds + XTAB_OFF + XT_ULIST), (const LAS unsigned*)(F.lds + XTAB_OFF + XT_GTAB), false};
      EpiMoe2 E{wsp<unsigned char>(F, WS_YBUF), F.b_dn, (const LAS float*)(F.lds + XTAB_OFF + XT_RS)};
      for (int rep = 0; rep < (DUP_PHASE == 6 ? 2 : 1); ++rep) { if (rep) GRID_BAR();
      int Kb = FF; asm volatile("" : "+s"(Kb));
      pg8::gemm_phase<EpiMoe2, pg8::MoeSched, false, false, true>(F.lds + RING_OFF, Kb, S, E); } }
    GRID_BAR();
    STAGE_END(7);
    if (PH(7)) { const int first = (blockIdx.x >> 3) & 1;
#pragma unroll 1
      for (int step = 0; step < 2; ++step) {
          if ((step ^ first) == 0) { p7_combine(F); __syncthreads(); }
          else { pg8::DenseSched S; S.init(wsp<bf16>(F, WS_PB), wsp<bf16>(F, WS_WPP), T, DM, PLE, F.G, (int)blockIdx.x);
              EpiPle<1> E{wsp<unsigned char>(F, WS_PP), wsp<float>(F, WS_SSQPP), nullptr, -1};
              int Kp = PLE * 2; asm volatile("" : "+s"(Kp));
              pg8::gemm_phase<EpiPle<1>, pg8::DenseSched, false, false>(F.lds + RING_OFF, Kp, S, E); } } }
    GRID_BAR();
    STAGE_END(8);
    if (PH(8)) { pg8::DenseSched S; S.init(wsp<unsigned char>(F, WS_X2F8), wsp<unsigned char>(F, WS_WPG8), T, DM, DM, F.G, (int)blockIdx.x, 1);
      LAS float* rt2 = (LAS float*)(F.lds + XTAB_OFF); Unit ua, ub; const bool ha = S.next(0, ua), hb = S.next(1, ub);
      { PHASE_IDS; const int sl = TID_ >> 8, r = TID_ & 255; const bool has = sl ? hb : ha; const int pm = sl ? ub.pm : ua.pm; if (has) rt2[sl * 256 + r] = wsp<float>(F, WS_RSTD2)[(size_t)pm * 256 + r]; }
      __syncthreads();
      EpiPle<0> E{wsp<unsigned char>(F, WS_GATE), nullptr, rt2, ha ? ua.pm : -1};
      int Kb = DM; asm volatile("" : "+s"(Kb));
      pg8::gemm_phase<EpiPle<0>, pg8::DenseSched, false, false, true>(F.lds + RING_OFF, Kb, S, E);
#if CHECK_STAGE
      GRID_BAR();
      int Kb = DM; asm volatile("" : "+s"(Kb));
      pg8::gemm_phase<EpiPle<0>, pg8::DenseSched, false, false, true>(F.lds + RING_OFF, Kb, S, E);
#endif
    }
#if CHECK_STAGE
    GRID_BAR(); STAGE_CHECK(9);
#endif
    GRID_BAR();
    STAGE_END(9);
#if CHECK_STAGE
    GRID_BAR(); check_report(F);
#else
    if (PH(9)) p9_final(F);
#if TPROBE
    GRID_BAR();
    if (blockIdx.x == 0 && threadIdx.x == 0) { const unsigned long long* ts = (const unsigned long long*)(F.ctl + CW_TS); const unsigned long long t1 = (TP_A == 9) ? __builtin_amdgcn_s_memrealtime() : ts[(TP_A < 10 ? TP_A : 0) + 1];
        unsigned long long d = t1 - ts[TP_A < 10 ? TP_A : 0];
        if (TP_A == 20) d = ts[11] - ts[0]; if (TP_A == 21) d = ts[12] - ts[11]; if (TP_A == 22) d = ts[13] - ts[12]; if (TP_A == 23) d = ts[1] - ts[13]; if (TP_A == 24) d = ts[14] - ts[2]; if (TP_A == 25) d = ts[3] - ts[14];
        if (TP_A == 30) d = (__builtin_amdgcn_s_memrealtime() - ts[0]) / 8;
        F.out[0] += floorf((float)d * 0.01f * 0.125f + 0.5f) * 2.0f; }
#endif
#endif
    __syncthreads();
    if (threadIdx.x == 0) {
        if (xb_add(&g_gridbar[XB_DONE], 1u) == gridDim.x - 1u) {
#pragma unroll 1
            for (unsigned j = 0; j < 16; ++j) { __hip_atomic_store(&g_gridbar[XB_XCNT(j)], 0u, __ATOMIC_RELAXED, __HIP_MEMORY_SCOPE_AGENT); __hip_atomic_store(&g_gridbar[XB_XSUB(j)], 0u, __ATOMIC_RELAXED, __HIP_MEMORY_SCOPE_AGENT);
                __hip_atomic_store(&g_gridbar[XB_XGEN(j)], 0u, __ATOMIC_RELAXED, __HIP_MEMORY_SCOPE_AGENT); }
            __hip_atomic_store(&g_gridbar[XB_TOP], 0u, __ATOMIC_RELAXED, __HIP_MEMORY_SCOPE_AGENT); __hip_atomic_store(&g_gridbar[XB_TOPGEN], 0u, __ATOMIC_RELAXED, __HIP_MEMORY_SCOPE_AGENT);
            __hip_atomic_store(&g_gridbar[XB_TMO], 0u, __ATOMIC_RELAXED, __HIP_MEMORY_SCOPE_AGENT); __hip_atomic_store(&g_gridbar[XB_DONE], 0u, __ATOMIC_RELAXED, __HIP_MEMORY_SCOPE_AGENT); } }
}

extern "C" void kernel_launch(void* const* d_in, const int* in_sizes, int n_in, void* d_out, int out_size, void* d_ws, size_t ws_size, hipStream_t stream) {
    static int grid = 0;
    if (grid == 0) {
        if (n_in != 23 || in_sizes[0] != T * DM || out_size != T * DM || ws_size < WS_END) { fprintf(stderr, "kernel_launch: unexpected shapes (n_in %d, in0 %d, out %d, ws %zu)\n", n_in, n_in > 0 ? in_sizes[0] : -1, out_size, ws_size); grid = -1; return; }
        int dev = 0, cus = 0, per_cu = 0;
        if (hipGetDevice(&dev) != hipSuccess || hipDeviceGetAttribute(&cus, hipDeviceAttributeMultiprocessorCount, dev) != hipSuccess) { grid = -1; return; }
        if (hipFuncSetAttribute((const void*)mega_fwd, hipFuncAttributeMaxDynamicSharedMemorySize, LDS_BYTES) != hipSuccess) { fprintf(stderr, "kernel_launch: hipFuncSetAttribute failed\n"); grid = -1; return; }
        if (hipOccupancyMaxActiveBlocksPerMultiprocessor(&per_cu, (const void*)mega_fwd, NTHR, LDS_BYTES) != hipSuccess || per_cu < 1)
            fprintf(stderr, "kernel_launch: note: occupancy query reports %d workgroups per CU\n", per_cu);
        (void)hipGetLastError();
        if (cus < 256) { fprintf(stderr, "kernel_launch: built for a 256-CU device (found %d CUs); nothing launched\n", cus); grid = -1; return; }
        grid = 256;
    }
    if (grid < 0) return;
    Args a{};
    for (int i = 0; i < 23; ++i) a.in[i] = (const float*)d_in[i];
    a.out = (float*)d_out; a.ws = (unsigned char*)d_ws;
    hipLaunchKernelGGL(mega_fwd, dim3(grid), dim3(NTHR), LDS_BYTES, stream, a);
}
```

```cpp
#include <hip/hip_runtime.h>
#include <cstdio>
#include <cstdint>

#ifndef CHECK_STAGE
#define CHECK_STAGE 0
#endif
#ifndef CHECK_REPORT
#define CHECK_REPORT 0
#endif
#ifndef CHECK_REPORT2
#define CHECK_REPORT2 0
#endif
#ifndef CHECK_REPORT3
#define CHECK_REPORT3 0
#endif
#ifndef DUP_PHASE
#define DUP_PHASE -1
#endif
#ifndef TPROBE
#define TPROBE 0
#endif
#ifndef TP_A
#define TP_A 5
#endif
#ifndef TP_B
#define TP_B 6
#endif
#ifndef CHECK_SKIP
#define CHECK_SKIP 0
#endif
#ifndef PHMASK
#define PHMASK 0x3ff
#endif
#define PH(n) ((PHMASK >> (n)) & 1)

#define GAS __attribute__((address_space(1)))
#define LAS __attribute__((address_space(3)))
typedef unsigned short bf16;
typedef unsigned v4u __attribute__((ext_vector_type(4)));
typedef unsigned v2u __attribute__((ext_vector_type(2)));
typedef float f32x2 __attribute__((ext_vector_type(2)));
typedef float f32x4 __attribute__((ext_vector_type(4)));
typedef float f32x16 __attribute__((ext_vector_type(16)));
typedef short bf16x8 __attribute__((ext_vector_type(8)));
typedef short s16x4 __attribute__((ext_vector_type(4)));
typedef GAS unsigned gu32;

constexpr int BATCH = 16, SEQ = 2048, DM = 1024, T = BATCH * SEQ;
constexpr int AW = 512, NH = 8, HD = 64, NBLK = 8, MOBA = 256;
constexpr int GW = 512, GG = 4, GD = 128, GC = 128;
constexpr int NPROJ = 3 * AW + 2 * GW;
constexpr int NE = 32, TOPK = 4, FF = 1024;
constexpr int PLE = 256;
constexpr int MAXROWS = T * TOPK + NE * 256;
constexpr float EPS = 1e-6f;
constexpr int NWAVES = 8, NTHR = 512;

constexpr size_t MiB = 1u << 20;
constexpr size_t WS_CTL = 0, CTL_ZERO_BYTES = 1 * MiB;
constexpr size_t WS_KMEAN = 256 * 1024;
constexpr size_t WS_WIN = 1 * MiB;
constexpr size_t WS_WOUT = 6 * MiB;
constexpr size_t WS_WPG = 8 * MiB;
constexpr size_t WS_WPP = 10 * MiB;
constexpr size_t WS_RWG = 10 * MiB + 512 * 1024;
constexpr size_t WS_ROPE = 11 * MiB;
constexpr size_t WS_WGU = 16 * MiB;
constexpr size_t WS_WDN = 144 * MiB;
constexpr size_t WS_XNB = 208 * MiB;
constexpr size_t WS_BIG1 = 272 * MiB;
constexpr size_t WS_Q = WS_BIG1, WS_K = WS_Q + 32 * MiB, WS_V = WS_K + 32 * MiB, WS_U = WS_V + 32 * MiB, WS_VG = WS_U + 32 * MiB, WS_MIX = WS_VG + 32 * MiB;
constexpr size_t WS_YBUF = WS_BIG1;
constexpr size_t WS_BIG2 = 544 * MiB;
constexpr size_t WS_ABUF = WS_BIG2, WS_GATE = WS_BIG2, WS_PP = WS_BIG2 + 64 * MiB;
constexpr size_t WS_PB = 816 * MiB;
constexpr size_t WS_IDX = 832 * MiB;
constexpr size_t WS_GSS = 836 * MiB;
constexpr size_t WS_TOKPOS = 840 * MiB;
constexpr size_t WS_SSQA = 841 * MiB;
constexpr size_t WS_SSQG = 842 * MiB;
constexpr size_t WS_SSQ1 = 843 * MiB;
constexpr size_t WS_SSQPP = 845 * MiB;
constexpr size_t WS_X1F8 = 848 * MiB;
constexpr size_t WS_X2N = WS_XNB;
constexpr size_t WS_X1B = 880 * MiB;
constexpr size_t WS_X2B = 944 * MiB;
constexpr size_t WS_SIG0 = 1008 * MiB;
constexpr size_t WS_RSTD2 = 1008 * MiB + 256 * 1024;
constexpr size_t WS_RWT = 1008 * MiB + 512 * 1024;
constexpr size_t WS_RSS = 1009 * MiB;
constexpr size_t WS_X2F8 = 176 * MiB;
constexpr size_t WS_WPG8 = 80 * MiB;
constexpr size_t WS_END = 1013 * MiB;
static_assert(WS_MIX + 64 * MiB <= WS_BIG2 && (size_t)MAXROWS * 1024 * 2 <= 272 * MiB, "ws map");
constexpr int CW_TMO = 0, CW_CODE = 1;
constexpr int CW_BAR = 4096;
constexpr int CW_CNT = 8192, CNT_STRIDE = 32;
constexpr int CW_TS = 12000;
constexpr int CW_CHK = 12288;

constexpr int RING_OFF = 0, RING_BYTES = 131072;
constexpr int P0_SCR_WAVE = 64 * 65 * 4;
constexpr int LDS_BYTES_TOTAL = 163840;
constexpr int LDSCTL_OFF = LDS_BYTES_TOTAL - 1024;
constexpr int XTAB_OFF = RING_BYTES;
static_assert(8 * P0_SCR_WAVE <= LDSCTL_OFF && XTAB_OFF >= RING_BYTES, "lds map");
constexpr int LDS_BYTES = LDS_BYTES_TOTAL;

#define RLX_AGENT __ATOMIC_RELAXED, __HIP_MEMORY_SCOPE_AGENT
#define LDS_WAIT() asm volatile("s_waitcnt lgkmcnt(0)" ::: "memory")
#define VM_WAIT() asm volatile("s_waitcnt vmcnt(0)" ::: "memory")
__device__ __forceinline__ unsigned f2bf(float f) { unsigned u = __builtin_bit_cast(unsigned, f); return (u + 0x7fffu + ((u >> 16) & 1u)) >> 16; }
__device__ __forceinline__ unsigned pk2(float lo, float hi) { return f2bf(lo) | (f2bf(hi) << 16); }
__device__ __forceinline__ float bf2f(unsigned short b) { return __builtin_bit_cast(float, ((unsigned)b) << 16); }
__device__ __forceinline__ float bflo(unsigned w) { return __builtin_bit_cast(float, w << 16); }
__device__ __forceinline__ float bfhi(unsigned w) { return __builtin_bit_cast(float, w & 0xffff0000u); }
typedef __bf16 bf16x2_t __attribute__((ext_vector_type(2)));
__device__ __forceinline__ unsigned cvt_pk_bf16(float lo, float hi) { const f32x2 v = {lo, hi}; const bf16x2_t b = __builtin_convertvector(v, bf16x2_t); return __builtin_bit_cast(unsigned, b); }
__device__ __forceinline__ float clamp448(float x) { return fminf(fmaxf(x, -448.0f), 448.0f); }
__device__ __forceinline__ unsigned pk4_fp8(float a, float b, float c, float d) { unsigned w = 0u; w = (unsigned)__builtin_amdgcn_cvt_pk_fp8_f32(clamp448(a), clamp448(b), (int)w, false); w = (unsigned)__builtin_amdgcn_cvt_pk_fp8_f32(clamp448(c), clamp448(d), (int)w, true); return w; }
__device__ __forceinline__ unsigned pk4_fp8_nc(float a, float b, float c, float d) { unsigned w = 0u; w = (unsigned)__builtin_amdgcn_cvt_pk_fp8_f32(a, b, (int)w, false); w = (unsigned)__builtin_amdgcn_cvt_pk_fp8_f32(c, d, (int)w, true); return w; }
__device__ __forceinline__ float fp8_to_f(unsigned v) { const unsigned sg = (v >> 7) & 1u, e = (v >> 3) & 15u, m = v & 7u; const float r = e ? ldexpf(1.0f + (float)m * 0.125f, (int)e - 7) : ldexpf((float)m * 0.125f, -6); return sg ? -r : r; }
__device__ __forceinline__ float wave_sum(float v) {
#pragma unroll
    for (int o = 1; o < 64; o <<= 1) v += __shfl_xor(v, o);
    return v;
}
__device__ __forceinline__ f32x2 gelu_pk(f32x2 v) {
    const f32x2 av = __builtin_elementwise_abs(v), d = av * 0.2316418882f + 1.0f;
    f32x2 t; t.x = __builtin_amdgcn_rcpf(d.x); t.y = __builtin_amdgcn_rcpf(d.y);
    f32x2 q = t * 0.5307027145f + (-0.7265760135f); q = q * t + 0.7107068705f; q = q * t + (-0.142248368f); q = q * t + 0.127414796f; q = q * t;
    const f32x2 s = (v * v) * (-0.72134752044f);
    f32x2 e; e.x = __builtin_amdgcn_exp2f(s.x); e.y = __builtin_amdgcn_exp2f(s.y);
    const f32x2 m = v * (q * e), r = v - m;
    f32x2 o; o.x = v.x < 0.f ? m.x : r.x; o.y = v.y < 0.f ? m.y : r.y; return o;
}
__device__ __forceinline__ f32x4 gelu4(f32x4 v) { const f32x2 a = gelu_pk((f32x2){v[0], v[1]}), b = gelu_pk((f32x2){v[2], v[3]}); return (f32x4){a.x, a.y, b.x, b.y}; }
__device__ __forceinline__ float sigmoidf_fast(float x) { return __builtin_amdgcn_rcpf(1.0f + __builtin_amdgcn_exp2f(-1.4426950408889634f * x)); }

#define XB_TMO      128
#define XB_XCNT(j)  (256  + 64 * (j))
#define XB_XSUB(j)  (1280 + 64 * (j))
#define XB_XGEN(j)  (2304 + 64 * (j))
#define XB_TOP      3328
#define XB_TOPGEN   3392
#define XCD_BAR_WORDS 3456
#define XB_SPIN_CAP (1u << 18)
__device__ __forceinline__ unsigned xb_ld(unsigned* p)              { return __hip_atomic_load(p, __ATOMIC_RELAXED, __HIP_MEMORY_SCOPE_AGENT); }
__device__ __forceinline__ unsigned xb_add(unsigned* p, unsigned v) { return __hip_atomic_fetch_add(p, v, __ATOMIC_RELAXED, __HIP_MEMORY_SCOPE_AGENT); }
__device__ __forceinline__ unsigned xb_xcc_id() { return (unsigned)__builtin_amdgcn_s_getreg((3 << 11) | 20) & 0xFu; }
#define XB_SPIN(cond, bar) do { unsigned _sp = 0; while (cond) { __builtin_amdgcn_s_sleep(1); \
    if ((++_sp & 255u) == 0u) { if (xb_ld(&(bar)[XB_TMO])) break; if (_sp > XB_SPIN_CAP) { atomicAdd(&(bar)[XB_TMO], 1u); break; } } } } while (0)
#define XB_DONE     64
__device__ unsigned g_gridbar[4096];
struct XcdBarrier { unsigned* bar; unsigned x; volatile LAS unsigned* st; };
__device__ __forceinline__ XcdBarrier xcd_barrier_post(unsigned* bar, volatile LAS unsigned* st) {
    XcdBarrier b; b.bar = bar; b.x = xb_xcc_id(); b.st = st;
    if (threadIdx.x == 0) (void)xb_add(&bar[XB_XCNT(b.x)], 1u);
    return b;
}
__device__ __forceinline__ void xcd_barrier_complete(unsigned* bar, unsigned x, unsigned& nloc, unsigned& nx) {
    const unsigned G = gridDim.x * gridDim.y * gridDim.z;
    unsigned sum, cnt, mine, sp = 0u;
    for (;;) {
        sum = 0u; cnt = 0u; mine = 0u;
#pragma unroll
        for (unsigned j = 0; j < 16; ++j) { const unsigned c = xb_ld(&bar[XB_XCNT(j)]); sum += c; cnt += (c > 0u) ? 1u : 0u; mine = (j == x) ? c : mine; }
        if (sum == G) break;
        __builtin_amdgcn_s_sleep(1);
        if ((++sp & 255u) == 0u) { if (xb_ld(&bar[XB_TMO])) break; if (sp > XB_SPIN_CAP) { atomicAdd(&bar[XB_TMO], 1u); break; } }
    }
    nloc = mine > 0u ? mine : 1u; nx = cnt > 0u ? cnt : 1u;
}
__device__ __forceinline__ void xcd_barrier(const XcdBarrier& b) {
    asm volatile("s_waitcnt vmcnt(0)" ::: "memory");
    __syncthreads();
    if (threadIdx.x == 0) {
        unsigned* bar = b.bar;
        __builtin_amdgcn_s_waitcnt(0);
        unsigned nloc = b.st[0], nx = b.st[1];
        if (nloc == 0u) { xcd_barrier_complete(bar, b.x, nloc, nx); b.st[0] = nloc; b.st[1] = nx; }
        const unsigned old = xb_add(&bar[XB_XSUB(b.x)], 1u);
        const unsigned gen = old / nloc;
        if (old + 1u == (gen + 1u) * nloc) {
            __builtin_amdgcn_fence(__ATOMIC_RELEASE, "agent");
            asm volatile("s_waitcnt vmcnt(0)" ::: "memory");
            const unsigned og = xb_add(&bar[XB_TOP], 1u);
            const unsigned tg = og / nx;
            if (og + 1u == (tg + 1u) * nx) xb_add(&bar[XB_TOPGEN], 1u);
            else XB_SPIN(xb_ld(&bar[XB_TOPGEN]) == tg, bar);
            __builtin_amdgcn_fence(__ATOMIC_ACQUIRE, "agent");
            xb_add(&bar[XB_XGEN(b.x)], 1u);
            asm volatile("s_waitcnt vmcnt(0)" ::: "memory");
        } else {
            XB_SPIN(xb_ld(&bar[XB_XGEN(b.x)]) == gen, bar);
            __builtin_amdgcn_fence(__ATOMIC_ACQUIRE, "agent");
            asm volatile("s_waitcnt vmcnt(0)" ::: "memory");
        }
    }
    __syncthreads();
}

namespace pg8 {
constexpr int BM = 256, BK = 64, HALF = 128, HTB = HALF * BK * 2, STAGE_BYTES = 8 * HTB, NXCD = 8, WGM = 8;
__host__ __device__ __forceinline__ int lds_byte(int r, int c) { const int st = (r >> 4) * 2 + (c >> 5), rr = r & 15, cc = c & 31, ob = rr * 64 + cc * 2; return st * 1024 + (ob ^ (((ob >> 9) & 1) << 5)); }
__host__ __device__ __forceinline__ void stage_rc(int b, int& R, int& C) { const int st = b / 1024, sb = b % 1024, swz = sb ^ (((sb >> 9) & 1) << 5); R = (st >> 1) * 16 + swz / 64; C = (st & 1) * 32 + (swz % 64) / 2; }
__host__ __device__ __forceinline__ int perm32(int rho) { const int n = rho >> 4, i = rho & 15; return 8 * (i >> 2) + 4 * n + (i & 3); }

typedef int v8i __attribute__((ext_vector_type(8)));
constexpr int F8_WSHIFT = 6, F8_SCALE_W = 127 - F8_WSHIFT;
typedef int v4i __attribute__((ext_vector_type(4)));
__device__ __forceinline__ v8i ld8(const LAS unsigned char* p0, const LAS unsigned char* p1) { const v4i lo = *(const LAS v4i*)p0, hi = *(const LAS v4i*)p1; return __builtin_shufflevector(lo, hi, 0, 1, 2, 3, 4, 5, 6, 7); }
struct Unit { int pm, pn, e, rt, slot; };

__device__ __forceinline__ void flat_to_tile(int L, int nwg, int nM, int nN, int& pm, int& pn) {
    int wgid = L; { const int q = nwg / NXCD, r = nwg % NXCD, xcd = wgid % NXCD, off = wgid / NXCD; wgid = (xcd < r ? xcd * (q + 1) : r * (q + 1) + (xcd - r) * q) + off; }
    const int nig = WGM * nN, gid = wgid / nig, fm = gid * WGM, gsz = (nM - fm) < WGM ? (nM - fm) : WGM;
    pm = fm + ((wgid % nig) % gsz); pn = (wgid % nig) / gsz;
}
struct DenseSched {
    const char* A; const char* Bt; int nM, nN, nwg, G, c; size_t tstep;
    __device__ __forceinline__ void init(const void* A_, const void* Bt_, int M, int N, int K, int G_, int c_, int ebytes = 2) { A = (const char*)A_; Bt = (const char*)Bt_; nM = M / BM; nN = N / BM; nwg = nM * nN; G = G_; c = c_; tstep = (size_t)BM * K * ebytes; }
    __device__ __forceinline__ bool next(int i, Unit& u) const { const long L = (long)i * G + c; if (L >= nwg) return false; flat_to_tile((int)L, nwg, nM, nN, u.pm, u.pn); u.e = 0; u.rt = u.pm; u.slot = i; return true; }
    __device__ __forceinline__ const char* a_base(const Unit& u) const { return A + (size_t)u.pm * tstep; }
    __device__ __forceinline__ const char* b_base(const Unit& u) const { return Bt + (size_t)u.pn * tstep; }
    __device__ __forceinline__ void gather(int, int, int, unsigned (&)[2][2]) const {}
};
struct MoeSched {
    const char* A; const char* Bt; size_t a_tstep, b_estep, b_tstep; int nunits; const LAS unsigned* ulist; const LAS unsigned* gtab; bool gath;
    __device__ __forceinline__ bool next(int i, Unit& u) const {
        if (i >= nunits) return false;
        const unsigned w = (unsigned)__builtin_amdgcn_readfirstlane((int)ulist[i]);
        u.pm = (int)(w & 0x3ffu); u.pn = (int)((w >> 10) & 0x7u); u.e = (int)((w >> 13) & 0x1fu); u.rt = (int)(w >> 18); u.slot = i; return true;
    }
    __device__ __forceinline__ const char* a_base(const Unit& u) const { return gath ? A : A + (size_t)u.pm * a_tstep; }
    __device__ __forceinline__ const char* b_base(const Unit& u) const { return Bt + (size_t)u.e * b_estep + (size_t)u.pn * b_tstep; }
    __device__ __forceinline__ void gather(int i, int R0, int R1, unsigned (&off)[2][2]) const {
        const LAS unsigned short* g = (const LAS unsigned short*)gtab + i * 256;
        off[0][0] = (unsigned)g[R0] << 10; off[0][1] = (unsigned)g[R1] << 10; off[1][0] = (unsigned)g[128 + R0] << 10; off[1][1] = (unsigned)g[128 + R1] << 10;
    }
};

#define PG8_SA(b, h) (((b) * 2 + (h)) * HTB)
#define PG8_SB(b, h) ((4 + (b) * 2 + (h)) * HTB)
#define PG8_GLDS(src, dstoff) __builtin_amdgcn_global_load_lds((const unsigned*)(src), (LAS unsigned*)(lds + (dstoff)), 16, 0, 0)
#define PG8_STAGE_B(bufoff, gbase) do { _Pragma("unroll") for (int _i = 0; _i < 2; ++_i) PG8_GLDS((const char*)(gbase) + voffB[_i], (bufoff) + ldsw + _i * 8192); } while (0)
#define PG8_STAGE_A(bufoff, kptr, h, o) do { _Pragma("unroll") for (int _i = 0; _i < 2; ++_i) \
        PG8_GLDS(GATHER ? (const char*)(kptr) + (o)[h][_i] : (const char*)(kptr) + (size_t)(h) * hstep + voffA[_i], (bufoff) + ldsw + _i * 8192); } while (0)
#define PG8_LDA(dst, b, h) do { _Pragma("unroll") for (int m = 0; m < 4; ++m) { if constexpr (F8) dst##8[m] = ld8(lds + PG8_SA(b, h) + a8_0 + m * 2048, lds + PG8_SA(b, h) + a8_1 + m * 2048); \
        else { _Pragma("unroll") for (int k = 0; k < 2; ++k) dst[m][k] = *(const LAS bf16x8*)(lds + PG8_SA(b, h) + aoff + m * 2048 + k * 1024); } } } while (0)
#define PG8_LDB(dst, b, h) do { _Pragma("unroll") for (int n = 0; n < 2; ++n) { if constexpr (F8) dst##8[n] = ld8(lds + PG8_SB(b, h) + b8_0 + n * 2048, lds + PG8_SB(b, h) + b8_1 + n * 2048); \
        else { _Pragma("unroll") for (int k = 0; k < 2; ++k) dst[n][k] = *(const LAS bf16x8*)(lds + PG8_SB(b, h) + boff + n * 2048 + k * 1024); } } } while (0)
#define PG8_MMA(ai, bj, At, Bt) do { __builtin_amdgcn_s_setprio(1); _Pragma("unroll") for (int m = 0; m < 4; ++m) _Pragma("unroll") for (int n = 0; n < 2; ++n) { \
        if constexpr (F8) asm volatile("v_mfma_scale_f32_16x16x128_f8f6f4 %0, %1, %2, %0, %3, %4 op_sel_hi:[0,0,0]" : "+v"(acc[ai][bj][m][n]) : "v"(Bt##8[n]), "v"(At##8[m]), "v"(sc_w), "v"(sc_a)); \
        else { _Pragma("unroll") for (int k = 0; k < 2; ++k) acc[ai][bj][m][n] = __builtin_amdgcn_mfma_f32_16x16x32_bf16(Bt[n][k], At[m][k], acc[ai][bj][m][n], 0, 0, 0); } } __builtin_amdgcn_s_setprio(0); } while (0)
#define PG8_WAIT_V(n) asm volatile("s_waitcnt vmcnt(" #n ")" ::: "memory")
#define PG8_WAIT_L(n) asm volatile("s_waitcnt lgkmcnt(" #n ")" ::: "memory")
#define PG8_BAR __builtin_amdgcn_s_barrier()
#define PG8_SCHED __builtin_amdgcn_sched_barrier(0)

template <class Epi, class Sched, bool GATHER, bool MIDK, bool F8 = false>
__device__ __forceinline__ void gemm_phase(LAS unsigned char* lds, const int KB  , const Sched& S, const Epi& E) {
    int tid = (int)threadIdx.x; asm volatile("" : "+v"(tid));
    const int wid = __builtin_amdgcn_readfirstlane(tid >> 6), lane = tid & 63, wr = wid >> 2, wc = wid & 3, fr = lane & 15, fq = lane >> 4;
    const int nt = KB / 128;
    unsigned voffA[2], voffB[2]; int Rg[2]; unsigned Cg[2];
#pragma unroll
    for (int i = 0; i < 2; ++i) { int R, C; stage_rc(tid * 16 + i * 8192, R, C); const int Rb = Epi::PERM ? ((R & ~31) + perm32(R & 31)) : R;
        voffA[i] = (unsigned)(R * KB + C * 2); voffB[i] = (unsigned)(Rb * KB + C * 2); Rg[i] = R; Cg[i] = (unsigned)C * 2u; }
    const size_t kstep = 128;
    const size_t hstep = (size_t)HALF * KB;
    const unsigned ldsw = (unsigned)wid * 1024u;
    const int aoff = lds_byte(wr * 64 + fr, fq * 8), boff = lds_byte(wc * 32 + fr, fq * 8);
    const int a8_0 = aoff, a8_1 = aoff + 1024, b8_0 = boff, b8_1 = boff + 1024;
    Unit cur, nxt; int ui = 0;
    if (!S.next(0, cur)) return;
    f32x4 acc[2][2][4][2];
#pragma unroll
    for (int a = 0; a < 2; ++a)
#pragma unroll
        for (int b = 0; b < 2; ++b)
#pragma unroll
            for (int m = 0; m < 4; ++m)
#pragma unroll
                for (int n = 0; n < 2; ++n) acc[a][b][m][n] = (f32x4){0.f, 0.f, 0.f, 0.f};
    bf16x8 At[4][2], B0[2][2], B1[2][2]; v8i At8[4], B08[2], B18[2];
    int sc_w = F8_SCALE_W, sc_a = 127; if constexpr (F8) { asm volatile("" : "+v"(sc_w), "+v"(sc_a)); }
    unsigned offC[2][2] = {{0u, 0u}, {0u, 0u}}, offN[2][2] = {{0u, 0u}, {0u, 0u}};
    if constexpr (GATHER) { S.gather(0, Rg[0], Rg[1], offC);
#pragma unroll
        for (int h = 0; h < 2; ++h)
#pragma unroll
            for (int i = 0; i < 2; ++i) offC[h][i] += Cg[i]; }
    const char* cA = S.a_base(cur); const char* cB = S.b_base(cur);
    PG8_STAGE_B(PG8_SB(0, 0), cB); PG8_STAGE_B(PG8_SB(0, 1), cB + hstep); PG8_STAGE_A(PG8_SA(0, 0), cA, 0, offC); PG8_STAGE_A(PG8_SA(0, 1), cA, 1, offC);
    if (wr == 1) PG8_BAR;
    PG8_WAIT_V(2); PG8_BAR;
    PG8_STAGE_B(PG8_SB(1, 0), cB + kstep); PG8_STAGE_A(PG8_SA(1, 0), cA + kstep, 0, offC); PG8_STAGE_B(PG8_SB(1, 1), cB + hstep + kstep);
    PG8_WAIT_V(6); PG8_BAR;
    for (;;) {
        const bool has_next = S.next(ui + 1, nxt);
        const char* nA = has_next ? S.a_base(nxt) : cA; const char* nB = has_next ? S.b_base(nxt) : cB;
        if constexpr (GATHER) { if (has_next) { S.gather(ui + 1, Rg[0], Rg[1], offN);
#pragma unroll
                for (int h = 0; h < 2; ++h)
#pragma unroll
                    for (int i = 0; i < 2; ++i) offN[h][i] += Cg[i]; }
            else {
#pragma unroll
                for (int h = 0; h < 2; ++h)
#pragma unroll
                    for (int i = 0; i < 2; ++i) offN[h][i] = offC[h][i]; } }
        for (int t = 0; t < nt; t += 2) {
            const bool last = (t == nt - 2);
            const char* a1 = cA + (size_t)(t + 1) * kstep;
            const char* a2 = last ? nA : cA + (size_t)(t + 2) * kstep; const char* b2 = last ? nB : cB + (size_t)(t + 2) * kstep;
            const char* a3 = a2 + kstep; const char* b3 = b2 + kstep;
            unsigned o2[2][2];
#pragma unroll
            for (int h = 0; h < 2; ++h)
#pragma unroll
                for (int i = 0; i < 2; ++i) o2[h][i] = last ? offN[h][i] : offC[h][i];
            if constexpr (MIDK) { if (t == nt / 2) E.midk(acc, cur, wr, fr); }
            PG8_LDB(B0, 0, 0); PG8_LDB(B1, 0, 1); PG8_SCHED; PG8_LDA(At, 0, 0); PG8_STAGE_A(PG8_SA(1, 1), a1, 1, offC);
            PG8_WAIT_V(8); PG8_WAIT_L(0); PG8_BAR; PG8_MMA(0, 0, At, B0); PG8_MMA(0, 1, At, B1); PG8_BAR; PG8_SCHED;
            PG8_LDA(At, 0, 1); PG8_STAGE_B(PG8_SB(0, 0), b2); PG8_STAGE_B(PG8_SB(0, 1), b2 + hstep); PG8_STAGE_A(PG8_SA(0, 0), a2, 0, o2);
            PG8_WAIT_V(8); PG8_WAIT_L(0); PG8_BAR; PG8_MMA(1, 0, At, B0); PG8_MMA(1, 1, At, B1); PG8_BAR; PG8_SCHED;
            PG8_LDB(B0, 1, 0); PG8_LDB(B1, 1, 1); PG8_SCHED; PG8_LDA(At, 1, 0); PG8_STAGE_A(PG8_SA(0, 1), a2, 1, o2);
            PG8_WAIT_V(8); PG8_WAIT_L(0); PG8_BAR; PG8_MMA(0, 0, At, B0); PG8_MMA(0, 1, At, B1); PG8_BAR; PG8_SCHED;
            PG8_LDA(At, 1, 1); PG8_STAGE_B(PG8_SB(1, 0), b3); PG8_STAGE_B(PG8_SB(1, 1), b3 + hstep); PG8_STAGE_A(PG8_SA(1, 0), a3, 0, o2);
            PG8_WAIT_V(8); PG8_WAIT_L(0); PG8_BAR; PG8_MMA(1, 0, At, B0); PG8_MMA(1, 1, At, B1); PG8_BAR; PG8_SCHED;
        }
        if (wr == 0) PG8_BAR;
        if constexpr (F8) asm volatile("s_nop 15\n\ts_nop 15" ::: "memory");
        E(acc, cur, wr, wc, fr, fq);
        if (!has_next) break;
#pragma unroll
        for (int a = 0; a < 2; ++a)
#pragma unroll
            for (int b = 0; b < 2; ++b)
#pragma unroll
                for (int m = 0; m < 4; ++m)
#pragma unroll
                    for (int n = 0; n < 2; ++n) acc[a][b][m][n] = (f32x4){0.f, 0.f, 0.f, 0.f};
        cur = nxt; cA = nA; cB = nB; ++ui;
        if constexpr (GATHER) {
#pragma unroll
            for (int h = 0; h < 2; ++h)
#pragma unroll
                for (int i = 0; i < 2; ++i) offC[h][i] = offN[h][i]; }
        if (wr == 1) PG8_BAR;
    }
    PG8_WAIT_V(0);
    PG8_BAR;
}
}

struct Frame {
    LAS unsigned char* lds;
    volatile LAS unsigned* MISC;
    gu32* ctl;
    unsigned char* ws;
    int vcu, G;
    const float *x, *p, *mix_norm, *w_in, *ln_g, *ln_b, *gws, *gbs, *aon, *gon, *w_out, *ffn_norm, *router_w, *router_b, *w_gu, *b_gu, *w_dn, *b_dn, *ple_norm, *w_pg, *w_pp, *ppn, *final_norm;
    float* out;
};
template <class T_> __device__ __forceinline__ T_* wsp(const Frame& F, size_t off) { return (T_*)(F.ws + off); }

#define PHASE_IDS int TID_ = (int)threadIdx.x; asm volatile("" : "+v"(TID_)); const int LANE_ = TID_ & 63; const int WAVE_ = __builtin_amdgcn_readfirstlane(TID_ >> 6); (void)LANE_; (void)WAVE_
template <class ColMap>
__device__ __forceinline__ void p0_transpose_item(const float* W, int K, int N, bf16* WT, const float* gain, LAS float* scr, int item, int lane, int nphys, const ColMap& cm) {
    const int nblk = nphys / 64, kb = item / nblk, nb = item % nblk, k0 = 64 * kb, n0 = 64 * nb;
    const int srccol = cm(n0 + lane);
    float v_[64]; const float* src = W + (size_t)k0 * N + srccol;
#pragma unroll
    for (int kk = 0; kk < 64; ++kk) v_[kk] = __builtin_nontemporal_load(src + (size_t)kk * N);
    if (gain) {
#pragma unroll
        for (int kk = 0; kk < 64; kk += 4) { const f32x4 g4 = *(const f32x4*)(gain + k0 + kk); v_[kk] *= g4[0]; v_[kk + 1] *= g4[1]; v_[kk + 2] *= g4[2]; v_[kk + 3] *= g4[3]; } }
#pragma unroll
    for (int kk = 0; kk < 64; ++kk) scr[kk * 65 + lane] = v_[kk];
    LDS_WAIT(); asm volatile("" ::: "memory");
    const int c = lane & 7;
#pragma unroll
    for (int j = 0; j < 8; ++j) { const int n = (lane >> 3) + 8 * j; const LAS float* s = scr + (8 * c) * 65 + n;
        v4u o; o.x = pk2(s[0 * 65], s[1 * 65]); o.y = pk2(s[2 * 65], s[3 * 65]); o.z = pk2(s[4 * 65], s[5 * 65]); o.w = pk2(s[6 * 65], s[7 * 65]);
        *(GAS v4u*)(WT + (size_t)(n0 + n) * K + k0 + 8 * c) = o; }
    LDS_WAIT(); asm volatile("" ::: "memory");
}
template <class ColMap>
__device__ __forceinline__ void p0_transpose_item_f8(const float* W, int K, int N, unsigned char* WT, const float* gain, LAS float* scr, int item, int lane, int nphys, const ColMap& cm) {
    const int nblk = nphys / 64, kb = item / nblk, nb = item % nblk, k0 = 64 * kb, n0 = 64 * nb;
    const int srccol = cm(n0 + lane);
    float v_[64]; const float* src = W + (size_t)k0 * N + srccol;
#pragma unroll
    for (int kk = 0; kk < 64; ++kk) v_[kk] = __builtin_nontemporal_load(src + (size_t)kk * N);
    constexpr float WS_ = (float)(1 << pg8::F8_WSHIFT);
#pragma unroll
    for (int kk = 0; kk < 64; kk += 4) { f32x4 g4 = gain ? *(const f32x4*)(gain + k0 + kk) : (f32x4){1.f, 1.f, 1.f, 1.f}; v_[kk] *= g4[0] * WS_; v_[kk + 1] *= g4[1] * WS_; v_[kk + 2] *= g4[2] * WS_; v_[kk + 3] *= g4[3] * WS_; }
#pragma unroll
    for (int kk = 0; kk < 64; ++kk) scr[kk * 65 + lane] = v_[kk];
    LDS_WAIT(); asm volatile("" ::: "memory");
    const int c = lane & 3;
#pragma unroll
    for (int j = 0; j < 4; ++j) { const int n = (lane >> 2) + 16 * j; const LAS float* s_ = scr + (16 * c) * 65 + n;
        v4u o; o.x = pk4_fp8(s_[0 * 65], s_[1 * 65], s_[2 * 65], s_[3 * 65]); o.y = pk4_fp8(s_[4 * 65], s_[5 * 65], s_[6 * 65], s_[7 * 65]);
        o.z = pk4_fp8(s_[8 * 65], s_[9 * 65], s_[10 * 65], s_[11 * 65]); o.w = pk4_fp8(s_[12 * 65], s_[13 * 65], s_[14 * 65], s_[15 * 65]);
        *(GAS v4u*)(WT + (size_t)(n0 + n) * K + k0 + 16 * c) = o; }
    LDS_WAIT(); asm volatile("" ::: "memory");
}
struct CmId { __device__ __forceinline__ int operator()(int n) const { return n; } };
struct CmWin { __device__ __forceinline__ int operator()(int n) const { if (n >= 2 * AW) return n; const int c = n & 63; return (n & ~63) + 4 * (c >> 3) + (c & 3) + 32 * ((c >> 2) & 1); } };
struct CmWgu { __device__ __forceinline__ int operator()(int n) const { return ((n >> 7) & 1) * FF + (n >> 8) * 128 + (n & 127); } };

constexpr int XW_I_GU = (DM / 64) * (2 * FF / 64), XW_I_DN = (FF / 64) * (DM / 64), XW_ITEMS = NE * (XW_I_GU + XW_I_DN);
__device__ __forceinline__ void xw_convert_item(const Frame& F, int it, LAS float* scr, int lane) {
    if (it < NE * XW_I_GU) { const int e = it / XW_I_GU; p0_transpose_item_f8(F.w_gu + (size_t)e * DM * 2 * FF, DM, 2 * FF, wsp<unsigned char>(F, WS_WGU) + (size_t)e * 2 * FF * DM, F.ffn_norm, scr, it % XW_I_GU, lane, 2 * FF, CmWgu()); }
    else { const int r = it - NE * XW_I_GU, e = r / XW_I_DN; p0_transpose_item_f8(F.w_dn + (size_t)e * FF * DM, FF, DM, wsp<unsigned char>(F, WS_WDN) + (size_t)e * DM * FF, nullptr, scr, r % XW_I_DN, lane, DM, CmId()); }
}
struct XwDesc { const float* src; unsigned char* dst; unsigned N, K; };
__device__ __forceinline__ XwDesc xw_desc(const Frame& F, int it, int lane) {
    XwDesc d; const int kq = lane >> 4, nq = lane & 15;
    if (it < NE * XW_I_GU) { const int e = it / XW_I_GU, item = it % XW_I_GU, nblk = 2 * FF / 64, k0 = 64 * (item / nblk), n0 = 64 * (item % nblk);
        d.N = 2 * FF; d.K = DM; d.src = F.w_gu + (size_t)e * DM * 2 * FF + (size_t)(k0 + kq) * (2 * FF) + CmWgu()(n0) + 4 * nq;
        d.dst = wsp<unsigned char>(F, WS_WGU) + (size_t)e * 2 * FF * DM + (size_t)(n0 + (lane >> 2)) * DM + k0 + 16 * (lane & 3); }
    else { const int r = it - NE * XW_I_GU, e = r / XW_I_DN, item = r % XW_I_DN, nblk = DM / 64, k0 = 64 * (item / nblk), n0 = 64 * (item % nblk);
        d.N = DM; d.K = FF; d.src = F.w_dn + (size_t)e * FF * DM + (size_t)(k0 + kq) * DM + n0 + 4 * nq;
        d.dst = wsp<unsigned char>(F, WS_WDN) + (size_t)e * DM * FF + (size_t)(n0 + (lane >> 2)) * FF + k0 + 16 * (lane & 3); }
    return d;
}
__device__ __forceinline__ void xw_load(f32x4 (&v)[16], const XwDesc& d) {
#pragma unroll
    for (int j = 0; j < 16; ++j) v[j] = __builtin_nontemporal_load((const f32x4*)(d.src + (size_t)(4 * j) * d.N));
}
__device__ __forceinline__ void xw_process(const f32x4 (&v)[16], const XwDesc& d, LAS float* scr, int lane) {
    const int kq = lane >> 4, nq = lane & 15;
#pragma unroll
    for (int j = 0; j < 16; ++j) { LAS float* w = scr + (4 * j + kq) * 65 + 4 * nq; w[0] = v[j][0]; w[1] = v[j][1]; w[2] = v[j][2]; w[3] = v[j][3]; }
    LDS_WAIT(); asm volatile("" ::: "memory");
    constexpr float WS_ = (float)(1 << pg8::F8_WSHIFT);
    const int c = lane & 3;
#pragma unroll
    for (int j = 0; j < 4; ++j) { const LAS float* s_ = scr + (16 * c) * 65 + (lane >> 2) + 16 * j;
        v4u o; o.x = pk4_fp8(s_[0 * 65] * WS_, s_[1 * 65] * WS_, s_[2 * 65] * WS_, s_[3 * 65] * WS_); o.y = pk4_fp8(s_[4 * 65] * WS_, s_[5 * 65] * WS_, s_[6 * 65] * WS_, s_[7 * 65] * WS_);
        o.z = pk4_fp8(s_[8 * 65] * WS_, s_[9 * 65] * WS_, s_[10 * 65] * WS_, s_[11 * 65] * WS_); o.w = pk4_fp8(s_[12 * 65] * WS_, s_[13 * 65] * WS_, s_[14 * 65] * WS_, s_[15 * 65] * WS_);
        __builtin_nontemporal_store(o, (GAS v4u*)(d.dst + (size_t)(16 * j) * d.K)); }
    LDS_WAIT(); asm volatile("" ::: "memory");
}
__device__ __forceinline__ void p0_prologue(Frame& F) {
    PHASE_IDS;
    { const int gt0 = (int)blockIdx.x * NTHR + TID_, GT0 = F.G * NTHR;
      for (int i = gt0; i < CW_TS; i += GT0) F.ctl[i] = 0u;
      float* km0 = wsp<float>(F, WS_KMEAN); for (int i = gt0; i < (T / SEQ) * NH * NBLK * HD; i += GT0) km0[i] = 0.f; }
    LAS float* scr = (LAS float*)(F.lds + RING_OFF + WAVE_ * P0_SCR_WAVE);
    const int gw = F.vcu * NWAVES + WAVE_, NGW = F.G * NWAVES;
    constexpr int I_GU = (DM / 64) * (2 * FF / 64), I_DN = (FF / 64) * (DM / 64), I_IN = (DM / 64) * (NPROJ / 64), I_SQ = (DM / 64) * (DM / 64), I_PP = (PLE / 64) * (DM / 64);
    constexpr int NITEMS = I_IN + 2 * I_SQ + I_PP;
    (void)I_GU; (void)I_DN;
    for (int it = gw; it < NITEMS; it += NGW) {
        int r = it;
        if (r < I_IN) { p0_transpose_item(F.w_in, DM, NPROJ, wsp<bf16>(F, WS_WIN), F.mix_norm, scr, r, LANE_, NPROJ, CmWin()); continue; } r -= I_IN;
        if (r < I_SQ) {
            const int nblk = DM / 64, kb = r / nblk; const float* g = (kb < 8) ? F.aon : (F.gon - AW);
            p0_transpose_item(F.w_out, DM, DM, wsp<bf16>(F, WS_WOUT), g, scr, r, LANE_, DM, CmId()); continue; } r -= I_SQ;
        if (r < I_SQ) { p0_transpose_item_f8(F.w_pg, DM, DM, wsp<unsigned char>(F, WS_WPG8), F.ple_norm, scr, r, LANE_, DM, CmId()); continue; } r -= I_SQ;
        p0_transpose_item(F.w_pp, PLE, DM, wsp<bf16>(F, WS_WPP), nullptr, scr, r, LANE_, DM, CmId());
    }
    if (TPROBE && blockIdx.x == 0 && threadIdx.x == 0) ((unsigned long long*)(F.ctl + CW_TS))[11] = __builtin_amdgcn_s_memrealtime();
    bf16* XN = wsp<bf16>(F, WS_XNB);
    for (int m0 = gw; m0 < T; m0 += 2 * NGW) {
        f32x4 v[2][4]; float s[2] = {0.f, 0.f};
#pragma unroll
        for (int r = 0; r < 2; ++r) { const GAS f32x4* xr = (const GAS f32x4*)(F.x + (size_t)(m0 + r * NGW) * DM) + LANE_;
#pragma unroll
            for (int j = 0; j < 4; ++j) v[r][j] = __builtin_nontemporal_load(xr + 64 * j); }
#pragma unroll
        for (int r = 0; r < 2; ++r) {
#pragma unroll
            for (int j = 0; j < 4; ++j) s[r] += (v[r][j].x * v[r][j].x + v[r][j].y * v[r][j].y) + (v[r][j].z * v[r][j].z + v[r][j].w * v[r][j].w); }
#pragma unroll
        for (int r = 0; r < 2; ++r) { const int m = m0 + r * NGW; const float sig = sqrtf(wave_sum(s[r]) * (1.f / DM) + EPS), rstd = 1.0f / sig;
            if (LANE_ == 0) wsp<float>(F, WS_SIG0)[m] = sig;
            GAS v2u* o8 = (GAS v2u*)(XN + (size_t)m * DM) + LANE_;
#pragma unroll
            for (int j = 0; j < 4; ++j) { v2u w; w.x = pk2(v[r][j].x * rstd, v[r][j].y * rstd); w.y = pk2(v[r][j].z * rstd, v[r][j].w * rstd); o8[64 * j] = w; } }
    }
    if (TPROBE && blockIdx.x == 0 && threadIdx.x == 0) ((unsigned long long*)(F.ctl + CW_TS))[12] = __builtin_amdgcn_s_memrealtime();
    { const GAS f32x4* pr = (const GAS f32x4*)F.p; GAS v2u* po = (GAS v2u*)wsp<bf16>(F, WS_PB);
      const size_t n4 = (size_t)T * PLE / 4, gt = (size_t)(F.vcu * NTHR + TID_), GT = (size_t)F.G * NTHR;
      for (size_t i = gt; i < n4; i += GT) { const f32x4 v = pr[i]; v2u w; w.x = pk2(v.x, v.y); w.y = pk2(v.z, v.w); po[i] = w; } }
    if (TPROBE && blockIdx.x == 0 && threadIdx.x == 0) ((unsigned long long*)(F.ctl + CW_TS))[13] = __builtin_amdgcn_s_memrealtime();
    { const int gt = F.vcu * NTHR + TID_, GT = F.G * NTHR; float* RWG = wsp<float>(F, WS_RWG);
      (void)RWG; bf16* RWT = wsp<bf16>(F, WS_RWT);
      for (int i = gt; i < DM * NE; i += GT) { const int e = i / DM, k = i % DM; const float w = F.router_w[k * NE + e] * F.ffn_norm[k]; const unsigned hi = f2bf(w); const float lo = w - bf2f((bf16)hi); RWT[i] = (bf16)hi; RWT[NE * DM + i] = (bf16)f2bf(lo); }
      float* RC = wsp<float>(F, WS_ROPE); float* RS = RC + SEQ * 32;
      for (int i = gt; i < SEQ * 32; i += GT) { const int pos = i >> 5, j = i & 31; const float inv = powf(10000.0f, -(float)j / 32.0f); const float ang = (float)pos * inv; float sn, cs; sincosf(ang, &sn, &cs); RC[i] = cs; RS[i] = sn; } }
}

using pg8::Unit;
constexpr int HALF = 128;
struct EpiInProj {
    static constexpr bool PERM = true;
    bf16* QKVUV; const float *rc, *rs; float* kmean;
    __device__ __forceinline__ void operator()(const f32x4 (&acc)[2][2][4][2], const Unit& u, int wr, int wc, int fr, int fq) const {
        const int type = u.pn >> 1, colt = (u.pn & 1) * 256 + wc * 32 + 8 * fq;
        const int row0 = u.pm * 256 + wr * 64 + fr;
        if (type <= 1) {
            bf16* dst = QKVUV + (size_t)type * (16u << 20);
            const int pos0 = (u.pm & 7) * 256 + wr * 64 + fr, i0 = 16 * (wc & 1) + 4 * fq;
            f32x4 cs_[2][2];
#pragma unroll
            for (int bj = 0; bj < 2; ++bj) { cs_[bj][0] = (f32x4){0.f, 0.f, 0.f, 0.f}; cs_[bj][1] = (f32x4){0.f, 0.f, 0.f, 0.f}; }
#pragma unroll
            for (int ai = 0; ai < 2; ++ai) { f32x4 cc[4], ss[4];
#pragma unroll
                for (int m = 0; m < 4; ++m) { const int pos = pos0 + ai * HALF + m * 16; cc[m] = *(const f32x4*)(rc + pos * 32 + i0); ss[m] = *(const f32x4*)(rs + pos * 32 + i0); }
#pragma unroll
                for (int m = 0; m < 4; ++m) { const int ro = ai * HALF + m * 16; const f32x4 c = cc[m], s = ss[m];
                    bf16* rowp = dst + (size_t)(row0 + ro) * AW + colt;
#pragma unroll
                    for (int bj = 0; bj < 2; ++bj) { const f32x4 x1 = acc[ai][bj][m][0], x2 = acc[ai][bj][m][1];
                        const f32x4 o1 = x1 * c - x2 * s, o2 = x2 * c + x1 * s;
                        cs_[bj][0] += o1; cs_[bj][1] += o2;
                        v4u w; w.x = cvt_pk_bf16(o1[0], o1[1]); w.y = cvt_pk_bf16(o1[2], o1[3]); w.z = cvt_pk_bf16(o2[0], o2[1]); w.w = cvt_pk_bf16(o2[2], o2[3]);
                        *(v4u*)(rowp + bj * HALF) = w; } }
                asm volatile("" ::: "memory"); }
            if (type == 1) {
#pragma unroll
                for (int bj = 0; bj < 2; ++bj)
#pragma unroll
                    for (int n = 0; n < 2; ++n)
#pragma unroll
                        for (int j = 0; j < 4; ++j) { float v = cs_[bj][n][j]; v += __shfl_xor(v, 1); v += __shfl_xor(v, 2); v += __shfl_xor(v, 4); v += __shfl_xor(v, 8); cs_[bj][n][j] = v; }
                if (fr == 0) { const int b = u.pm >> 3, blk = u.pm & 7;
#pragma unroll
                    for (int bj = 0; bj < 2; ++bj) { const int colh = (u.pn & 1) * 256 + bj * HALF + wc * 32; const int head = colh >> 6, cpos = (colh & 63) + 8 * fq;
                        float* km = kmean + ((size_t)((b * NH + head) * NBLK + blk)) * HD + cpos;
#pragma unroll
                        for (int n = 0; n < 2; ++n)
#pragma unroll
                            for (int j = 0; j < 4; ++j) atomicAdd(km + 4 * n + j, cs_[bj][n][j]); } }
            }
        } else {
            bf16* dst = QKVUV + (size_t)type * (16u << 20);
#pragma unroll
            for (int ai = 0; ai < 2; ++ai)
#pragma unroll
                for (int m = 0; m < 4; ++m) { bf16* rowp = dst + (size_t)(row0 + ai * HALF + m * 16) * AW + colt;
#pragma unroll
                    for (int bj = 0; bj < 2; ++bj) { f32x4 v0 = acc[ai][bj][m][0], v1 = acc[ai][bj][m][1];
                        if (type >= 3) { v0 = gelu4(v0); v1 = gelu4(v1); }
                        v4u w; w.x = cvt_pk_bf16(v0[0], v0[1]); w.y = cvt_pk_bf16(v0[2], v0[3]); w.z = cvt_pk_bf16(v1[0], v1[1]); w.w = cvt_pk_bf16(v1[2], v1[3]);
                        *(v4u*)(rowp + bj * HALF) = w; } }
        }
    }
};
struct EpiOutProj {
    static constexpr bool PERM = true;
    const bf16* xn; bf16* x1; unsigned char* x1f8; float* ssq1; const LAS f32x4* rtab; const float* fgain;
    int pm_a, pm_b;
    __device__ __forceinline__ int slot(const Unit& u) const { return u.pm == pm_a ? 0 : 1; }
    __device__ __forceinline__ void midk(f32x4 (&acc)[2][2][4][2], const Unit& u, int wr, int fr) const {
        const LAS f32x4* t = rtab + slot(u) * 256 + wr * 64 + fr;
#pragma unroll
        for (int ai = 0; ai < 2; ++ai)
#pragma unroll
            for (int m = 0; m < 4; ++m) { const float r = t[ai * HALF + m * 16].x;
#pragma unroll
                for (int bj = 0; bj < 2; ++bj)
#pragma unroll
                    for (int n = 0; n < 2; ++n) acc[ai][bj][m][n] *= r; }
    }
    __device__ __forceinline__ void operator()(const f32x4 (&acc)[2][2][4][2], const Unit& u, int wr, int wc, int fr, int fq) const {
        const LAS f32x4* t = rtab + slot(u) * 256 + wr * 64 + fr;
        const int row0 = u.pm * 256 + wr * 64 + fr, col0 = u.pn * 256 + wc * 32 + 8 * fq;
        f32x4 fg[2][2];
#pragma unroll
        for (int bj = 0; bj < 2; ++bj) { fg[bj][0] = *(const f32x4*)(fgain + col0 + bj * HALF); fg[bj][1] = *(const f32x4*)(fgain + col0 + bj * HALF + 4); }
#pragma unroll
        for (int ai = 0; ai < 2; ++ai) { v4u xv[4][2];
#pragma unroll
            for (int m = 0; m < 4; ++m) { const size_t off = (size_t)(row0 + ai * HALF + m * 16) * DM + col0;
                xv[m][0] = *(const v4u*)(xn + off); xv[m][1] = *(const v4u*)(xn + off + HALF); }
#pragma unroll
            for (int m = 0; m < 4; ++m) { const int ro = ai * HALF + m * 16; const f32x4 tv = t[ro]; const float rg = tv.y, sx = tv.z; const size_t off = (size_t)(row0 + ro) * DM + col0; float q = 0.f;
#pragma unroll
                for (int bj = 0; bj < 2; ++bj) { const v4u xw = xv[m][bj];
                    const f32x4 x0 = {bflo(xw.x), bfhi(xw.x), bflo(xw.y), bfhi(xw.y)}, x1_ = {bflo(xw.z), bfhi(xw.z), bflo(xw.w), bfhi(xw.w)};
                    const f32x4 o0 = x0 * sx + acc[ai][bj][m][0] * rg, o1 = x1_ * sx + acc[ai][bj][m][1] * rg;
                    q += (o0[0] * o0[0] + o0[1] * o0[1]) + (o0[2] * o0[2] + o0[3] * o0[3]) + (o1[0] * o1[0] + o1[1] * o1[1]) + (o1[2] * o1[2] + o1[3] * o1[3]);
                    v4u w; w.x = cvt_pk_bf16(o0[0], o0[1]); w.y = cvt_pk_bf16(o0[2], o0[3]); w.z = cvt_pk_bf16(o1[0], o1[1]); w.w = cvt_pk_bf16(o1[2], o1[3]);
                    *(v4u*)(x1 + off + bj * HALF) = w;
                    const f32x4 p0 = o0 * fg[bj][0], p1 = o1 * fg[bj][1];
                    v2u w8; w8.x = pk4_fp8(p0[0], p0[1], p0[2], p0[3]); w8.y = pk4_fp8(p1[0], p1[1], p1[2], p1[3]); *(v2u*)(x1f8 + off + bj * HALF) = w8; }
                q += __shfl_xor(q, 16); q += __shfl_xor(q, 32);
                if (fq == 0) ssq1[(size_t)(row0 + ro) * 16 + u.pn * 4 + wc] = q; }
            asm volatile("" ::: "memory"); }
    }
};
struct EpiMoe1 {
    static constexpr bool PERM = true;
    unsigned char* A; const float* b_gu; const LAS float* rss;
    __device__ __forceinline__ void operator()(const f32x4 (&acc)[2][2][4][2], const Unit& u, int wr, int wc, int fr, int fq) const {
        const int row0 = u.pm * 256 + wr * 64 + fr, col = u.pn * 128 + wc * 32 + 8 * fq;
        const float* bg = b_gu + (size_t)u.e * 2 * FF + col; const LAS float* rs_ = rss + u.slot * 256 + wr * 64 + fr;
        float rsv[2][4];
#pragma unroll
        for (int ai = 0; ai < 2; ++ai)
#pragma unroll
            for (int m = 0; m < 4; ++m) rsv[ai][m] = rs_[ai * HALF + m * 16];
        f32x4 bgv[2], blv[2];
#pragma unroll
        for (int n = 0; n < 2; ++n) { bgv[n] = *(const f32x4*)(bg + 4 * n); blv[n] = *(const f32x4*)(bg + FF + 4 * n); }
#pragma unroll
        for (int ai = 0; ai < 2; ++ai)
#pragma unroll
            for (int m = 0; m < 4; ++m) { f32x4 a[2];
#pragma unroll
                for (int n = 0; n < 2; ++n) { const f32x4 g = acc[ai][0][m][n] * rsv[ai][m] + bgv[n], l = acc[ai][1][m][n] * rsv[ai][m] + blv[n];
#pragma unroll
                    for (int p = 0; p < 2; ++p) { f32x2 gc = {fminf(g[2 * p], 7.0f), fminf(g[2 * p + 1], 7.0f)}; f32x2 lc = {fminf(fmaxf(l[2 * p], -7.0f), 7.0f), fminf(fmaxf(l[2 * p + 1], -7.0f), 7.0f)};
                        const f32x2 z = gc * (-1.702f * 1.4426950408889634f); f32x2 e; e.x = __builtin_amdgcn_exp2f(z.x); e.y = __builtin_amdgcn_exp2f(z.y);
                        const f32x2 d = e + 1.0f; f32x2 r; r.x = __builtin_amdgcn_rcpf(d.x); r.y = __builtin_amdgcn_rcpf(d.y);
                        const f32x2 o = (gc * r) * (lc + 1.0f); a[n][2 * p] = o.x; a[n][2 * p + 1] = o.y; } }
                v2u w; w.x = pk4_fp8_nc(a[0][0], a[0][1], a[0][2], a[0][3]); w.y = pk4_fp8_nc(a[1][0], a[1][1], a[1][2], a[1][3]);
                *(v2u*)(A + (size_t)(row0 + ai * HALF + m * 16) * FF + col) = w; }
    }
};
constexpr float Y_SCALE = 16.0f;
struct EpiMoe2 {
    static constexpr bool PERM = true;
    unsigned char* Y; const float* b_dn; const LAS float* gss;
    __device__ __forceinline__ void operator()(const f32x4 (&acc)[2][2][4][2], const Unit& u, int wr, int wc, int fr, int fq) const {
        const int row0 = u.pm * 256 + wr * 64 + fr, col0 = u.pn * 256 + wc * 32 + 8 * fq;
        const LAS float* gs = gss + u.slot * 256 + wr * 64 + fr;
        f32x4 bv[2][2]; float gv[2][4];
#pragma unroll
        for (int bj = 0; bj < 2; ++bj)
#pragma unroll
            for (int n = 0; n < 2; ++n) bv[bj][n] = *(const f32x4*)(b_dn + (size_t)u.e * DM + col0 + bj * HALF + 4 * n);
#pragma unroll
        for (int ai = 0; ai < 2; ++ai)
#pragma unroll
            for (int m = 0; m < 4; ++m) gv[ai][m] = gs[ai * HALF + m * 16] * Y_SCALE;
#pragma unroll
        for (int ai = 0; ai < 2; ++ai)
#pragma unroll
            for (int m = 0; m < 4; ++m) { const float g = gv[ai][m]; unsigned char* rowp = Y + (size_t)(row0 + ai * HALF + m * 16) * DM + col0;
#pragma unroll
                for (int bj = 0; bj < 2; ++bj) { const f32x4 v0 = (acc[ai][bj][m][0] + bv[bj][0]) * g, v1 = (acc[ai][bj][m][1] + bv[bj][1]) * g;
                    v2u w; w.x = pk4_fp8(v0[0], v0[1], v0[2], v0[3]); w.y = pk4_fp8(v1[0], v1[1], v1[2], v1[3]);
                    *(v2u*)(rowp + bj * HALF) = w; } }
    }
};
constexpr float GATE_SCALE = 128.0f;
template <int MODE> struct EpiPle {
    static constexpr bool PERM = true;
    unsigned char* O; float* ssq; const LAS float* rtab; int pm_a;
    __device__ __forceinline__ void operator()(const f32x4 (&acc)[2][2][4][2], const Unit& u, int wr, int wc, int fr, int fq) const {
        const int row0 = u.pm * 256 + wr * 64 + fr, col0 = u.pn * 256 + wc * 32 + 8 * fq;
        float rsv[2][4];
#pragma unroll
        for (int ai = 0; ai < 2; ++ai)
#pragma unroll
            for (int m = 0; m < 4; ++m) rsv[ai][m] = (MODE == 0) ? rtab[(u.pm == pm_a ? 0 : 256) + wr * 64 + fr + ai * HALF + m * 16] : 1.0f;
#pragma unroll
        for (int ai = 0; ai < 2; ++ai)
#pragma unroll
            for (int m = 0; m < 4; ++m) { unsigned char* rowp = O + (size_t)(row0 + ai * HALF + m * 16) * DM + col0; float q = 0.f; const float rs = rsv[ai][m];
#pragma unroll
                for (int bj = 0; bj < 2; ++bj) { f32x4 v0 = acc[ai][bj][m][0], v1 = acc[ai][bj][m][1];
                    if (MODE == 0) {
#pragma unroll
                        for (int j = 0; j < 4; ++j) { v0[j] = GATE_SCALE * sigmoidf_fast(rs * v0[j]); v1[j] = GATE_SCALE * sigmoidf_fast(rs * v1[j]); } }
                    else { q += (v0[0] * v0[0] + v0[1] * v0[1]) + (v0[2] * v0[2] + v0[3] * v0[3]) + (v1[0] * v1[0] + v1[1] * v1[1]) + (v1[2] * v1[2] + v1[3] * v1[3]); }
                    v2u w; if (MODE == 0) { w.x = pk4_fp8_nc(v0[0], v0[1], v0[2], v0[3]); w.y = pk4_fp8_nc(v1[0], v1[1], v1[2], v1[3]); }
                    else { w.x = pk4_fp8(v0[0], v0[1], v0[2], v0[3]); w.y = pk4_fp8(v1[0], v1[1], v1[2], v1[3]); }
                    *(v2u*)(rowp + bj * HALF) = w; }
                if (MODE == 1) { q += __shfl_xor(q, 16); q += __shfl_xor(q, 32); if (fq == 0) ssq[(size_t)(row0 + ai * HALF + m * 16) * 16 + u.pn * 4 + wc] = q; } }
    }
};

namespace att {
constexpr int QBLK = 32, KVBLK = 64;
constexpr float SCALE = 0.125f, THR = 8.f;
constexpr int SHM_V = KVBLK * HD * 2, SHM_K = SHM_V;
constexpr int NSLOT = 3;
constexpr int LDS_BYTES_ = NSLOT * SHM_V + NSLOT * SHM_K + NWAVES * 64 * 4;
#define ATT_KSWZ(row, colB) ((row) * 128 + ((colB) ^ ((((row) >> 1) & 7) << 4)))
#define ATT_SBAR() __builtin_amdgcn_sched_barrier(0)
__device__ __forceinline__ int crow(int r, int hi) { return (r & 3) + 8 * (r >> 2) + 4 * hi; }
__device__ __forceinline__ void cmask(f32x16& p0, f32x16& p1, int jb, int qrel, int hi) {
    const float NEG = -__builtin_inff(); const int kb = 64 * jb + 4 * hi;
#pragma unroll
    for (int r = 0; r < 16; ++r) { const int kv = kb + (r & 3) + 8 * (r >> 2); if (kv > qrel) p0[r] = NEG; if (kv + 32 > qrel) p1[r] = NEG; }
}
__device__ __forceinline__ void bmask(f32x16& p0, f32x16& p1, bool keep) {
    const float NEG = -__builtin_inff();
    if (!keep) {
#pragma unroll
        for (int r = 0; r < 16; ++r) { p0[r] = NEG; p1[r] = NEG; } }
}
__device__ __forceinline__ void partialSM(f32x16& p0, f32x16& p1, float& m_reg, float& mn, float& alpha, bool keep) {
    float pmax = p0[0];
#pragma unroll
    for (int r = 1; r < 16; ++r) pmax = fmaxf(pmax, p0[r]);
#pragma unroll
    for (int r = 0; r < 16; ++r) pmax = fmaxf(pmax, p1[r]);
    { auto rr = __builtin_amdgcn_permlane32_swap(__float_as_uint(pmax), __float_as_uint(pmax), false, false);
      pmax = fmaxf(__uint_as_float(rr[0]), __uint_as_float(rr[1])); }
    if (!keep) pmax = -__builtin_inff();
    constexpr float C2 = 1.4426950408889634f * SCALE;
    if (__builtin_expect(__all((pmax - m_reg) * SCALE <= THR), 1)) { mn = m_reg; alpha = 1.f; }
    else { mn = fmaxf(m_reg, pmax); alpha = __builtin_amdgcn_exp2f((m_reg - mn) * C2); m_reg = mn; }
    const float mnL = keep ? -mn * C2 : -__builtin_inff(), c2 = keep ? C2 : 0.f;
#pragma unroll
    for (int r = 0; r < 16; ++r) p0[r] = fmaf(p0[r], c2, mnL);
#pragma unroll
    for (int r = 0; r < 16; ++r) p1[r] = fmaf(p1[r], c2, mnL);
#pragma unroll
    for (int r = 0; r < 16; ++r) p0[r] = __builtin_amdgcn_exp2f(p0[r]);
}
__device__ __forceinline__ void finishSM(f32x16& p0, f32x16& p1, float alpha, float& l_reg, bf16x8& pa0, bf16x8& pa1, bf16x8& pa2, bf16x8& pa3) {
#pragma unroll
    for (int r = 0; r < 16; ++r) p1[r] = __builtin_amdgcn_exp2f(p1[r]);
    float ps = 0;
#pragma unroll
    for (int r = 0; r < 16; ++r) ps += p0[r];
#pragma unroll
    for (int r = 0; r < 16; ++r) ps += p1[r];
    { auto rr = __builtin_amdgcn_permlane32_swap(__float_as_uint(ps), __float_as_uint(ps), false, false);
      ps = __uint_as_float(rr[0]) + __uint_as_float(rr[1]); }
    l_reg = l_reg * alpha + ps;
#define ATT_PK4(P, B, OUT) do { unsigned a0 = cvt_pk_bf16(P[B+0], P[B+1]), a1 = cvt_pk_bf16(P[B+2], P[B+3]);             \
        unsigned b0 = cvt_pk_bf16(P[B+4], P[B+5]), b1 = cvt_pk_bf16(P[B+6], P[B+7]);                                       \
        auto r0 = __builtin_amdgcn_permlane32_swap(a0, b0, false, false); auto r1 = __builtin_amdgcn_permlane32_swap(a1, b1, false, false); \
        v4u w = {r0[0], r1[0], r0[1], r1[1]}; OUT = *reinterpret_cast<bf16x8*>(&w); } while (0)
    ATT_PK4(p0, 0, pa0); ATT_PK4(p0, 8, pa1); ATT_PK4(p1, 0, pa2); ATT_PK4(p1, 8, pa3);
#undef ATT_PK4
}
__device__ __forceinline__ void qkt(f32x16& p0, f32x16& p1, const LAS unsigned char* Ks, const bf16x8* qr, int r32, int hi) {
    p0 = f32x16{}; p1 = f32x16{};
#pragma unroll
    for (int d0 = 0; d0 < 4; ++d0) { const int cb = (d0 * 16 + hi * 8) * 2;
        const bf16x8 b0 = *(const LAS bf16x8*)(Ks + ATT_KSWZ(r32, cb));
        const bf16x8 b1 = *(const LAS bf16x8*)(Ks + ATT_KSWZ(32 + r32, cb));
        p0 = __builtin_amdgcn_mfma_f32_32x32x16_bf16(b0, qr[d0], p0, 0, 0, 0);
        p1 = __builtin_amdgcn_mfma_f32_32x32x16_bf16(b1, qr[d0], p1, 0, 0, 0); }
}
__device__ __forceinline__ void pv(f32x16* o, int vb, bf16x8 pa0, bf16x8 pa1, bf16x8 pa2, bf16x8 pa3) {
#pragma unroll
    for (int d0 = 0; d0 < 2; ++d0) { s16x4 lo[4], hi[4];
#pragma unroll
        for (int ks = 0; ks < 4; ++ks) { const int a = vb + d0 * 2048 + (ks >> 1) * 4096 + (ks & 1) * 1024;
            asm volatile("ds_read_b64_tr_b16 %0,%1" : "=&v"(lo[ks]) : "v"(a) : "memory");
            asm volatile("ds_read_b64_tr_b16 %0,%1 offset:256" : "=&v"(hi[ks]) : "v"(a) : "memory"); }
        asm volatile("s_waitcnt lgkmcnt(0)" ::: "memory"); ATT_SBAR();
#define ATT_PK(k) (bf16x8){lo[k][0], lo[k][1], lo[k][2], lo[k][3], hi[k][0], hi[k][1], hi[k][2], hi[k][3]}
        o[d0] = __builtin_amdgcn_mfma_f32_32x32x16_bf16(pa0, ATT_PK(0), o[d0], 0, 0, 0);
        o[d0] = __builtin_amdgcn_mfma_f32_32x32x16_bf16(pa1, ATT_PK(1), o[d0], 0, 0, 0);
        o[d0] = __builtin_amdgcn_mfma_f32_32x32x16_bf16(pa2, ATT_PK(2), o[d0], 0, 0, 0);
        o[d0] = __builtin_amdgcn_mfma_f32_32x32x16_bf16(pa3, ATT_PK(3), o[d0], 0, 0, 0);
#undef ATT_PK
    }
}
__device__ __forceinline__ void attn_unit(const Frame& F, int b, int h, int qb, LAS unsigned char* scratch) {
    PHASE_IDS;
    const int tid = TID_, wid = tid >> 6, lane = tid & 63, r32 = lane & 31, hi = lane >> 5;
    const bf16* Qg = wsp<bf16>(F, WS_Q); const bf16* Kg = wsp<bf16>(F, WS_K); const bf16* Vg = wsp<bf16>(F, WS_V);
    const size_t rowbase = (size_t)b * SEQ; const int q0 = qb * MOBA;
    const bf16* Qw = Qg + (rowbase + q0 + wid * QBLK) * AW + h * HD;
    const bf16* Kh = Kg + rowbase * AW + h * HD; const bf16* Vh = Vg + rowbase * AW + h * HD;
    LAS unsigned char* V_lds = scratch; LAS unsigned char* K_lds = scratch + NSLOT * SHM_V;
    LAS float* wsf = (LAS float*)(scratch + NSLOT * SHM_V + NSLOT * SHM_K) + wid * 64; LAS float* li_l = wsf; LAS float* al_l = wsf + 32;
    float m_reg = -1e30f, l_reg = 0.f; f32x16 o[2]; o[0] = f32x16{}; o[1] = f32x16{}; bf16x8 qr[4];
#pragma unroll
    for (int d0 = 0; d0 < 4; ++d0) qr[d0] = *(const bf16x8*)(Qw + (size_t)r32 * AW + d0 * 16 + hi * 8);
    unsigned sel = 0u;
    if (qb <= 3) sel = (1u << qb) - 1u;
    else {
        const float* km = wsp<float>(F, WS_KMEAN) + (size_t)((b * NH + h) * NBLK) * HD + (size_t)(r32 & 7) * HD + hi * 8;
        f32x4 kv[4][2];
#pragma unroll
        for (int d0 = 0; d0 < 4; ++d0) { kv[d0][0] = *(const f32x4*)(km + d0 * 16); kv[d0][1] = *(const f32x4*)(km + d0 * 16 + 4); }
        f32x16 gacc = f32x16{};
#pragma unroll
        for (int d0 = 0; d0 < 4; ++d0) { float f[8] = {kv[d0][0][0], kv[d0][0][1], kv[d0][0][2], kv[d0][0][3], kv[d0][1][0], kv[d0][1][1], kv[d0][1][2], kv[d0][1][3]};
            unsigned hw[4], lw[4];
#pragma unroll
            for (int p = 0; p < 4; ++p) { float a0 = f[2 * p], a1 = f[2 * p + 1]; if (r32 >= 8) { a0 = 0.f; a1 = 0.f; }
                const unsigned h0 = f2bf(a0), h1 = f2bf(a1); hw[p] = h0 | (h1 << 16); lw[p] = pk2(a0 - bf2f((bf16)h0), a1 - bf2f((bf16)h1)); }
            const v4u hv = {hw[0], hw[1], hw[2], hw[3]}, lv = {lw[0], lw[1], lw[2], lw[3]};
            gacc = __builtin_amdgcn_mfma_f32_32x32x16_bf16(__builtin_bit_cast(bf16x8, hv), qr[d0], gacc, 0, 0, 0);
            gacc = __builtin_amdgcn_mfma_f32_32x32x16_bf16(__builtin_bit_cast(bf16x8, lv), qr[d0], gacc, 0, 0, 0); }
        float g[8];
#pragma unroll
        for (int r = 0; r < 4; ++r) { const float mine = gacc[r], other = __shfl_xor(mine, 32); g[r] = hi ? other : mine; g[4 + r] = hi ? mine : other; }
        float b0 = -__builtin_inff(), b1 = b0, b2 = b0; int i0 = 0, i1 = 0, i2 = 0;
#pragma unroll
        for (int j = 0; j < NBLK - 1; ++j) { const float s_ = (j < qb) ? g[j] : -__builtin_inff();
            if (s_ > b0) { b2 = b1; i2 = i1; b1 = b0; i1 = i0; b0 = s_; i0 = j; } else if (s_ > b1) { b2 = b1; i2 = i1; b1 = s_; i1 = j; } else if (s_ > b2) { b2 = s_; i2 = j; } }
        sel = (1u << i0) | (1u << i1) | (1u << i2);
    }
    const int sr = tid >> 3, sc = (tid & 7) * 8;
    const int srv = ((tid >> 5) << 2) | ((tid >> 1) & 3), scv = ((tid & 1) << 3) | (((tid >> 3) & 3) << 4);
    const int vst = (srv >> 5) * 4096 + (scv >> 5) * 2048 + ((srv & 31) >> 2) * 256 + ((scv >> 4) & 1) * 128 + (srv & 3) * 32 + (scv & 8) * 2;
    const int vb0 = (int)(size_t)V_lds + (lane & 15) * 8 + ((lane >> 4) & 1) * 128 + (lane >> 5) * 512;
    bf16x8 st_v, st_k;
#define ATT_SLOAD(k0) do { st_v = *(const bf16x8*)(Vh + (size_t)((k0) + srv) * AW + scv); st_k = *(const bf16x8*)(Kh + (size_t)((k0) + sr) * AW + sc); } while (0)
#define ATT_SWRITE(bf) do { *(LAS bf16x8*)(V_lds + (bf) * SHM_V + vst) = st_v; *(LAS bf16x8*)(K_lds + (bf) * SHM_K + ATT_KSWZ(sr, sc * 2)) = st_k; } while (0)
#define ATT_RESC(a) do { if (__any((a) < 1.f)) { if (hi == 0) al_l[r32] = (a); asm volatile("s_waitcnt lgkmcnt(0)" ::: "memory");      \
        _Pragma("unroll") for (int d_ = 0; d_ < 2; ++d_) _Pragma("unroll") for (int r = 0; r < 16; ++r) o[d_][r] *= al_l[crow(r, hi)]; } } while (0)
    const int NT = (q0 + MOBA) / KVBLK;
    const int qrel = wid * QBLK + r32;
#define ATT_MASK(P0, P1, t) do { const int jb_ = (t) - (NT - 4); if (jb_ >= 0) cmask(P0, P1, jb_, qrel, hi); } while (0)
#define ATT_KEEP(t) ((((t) >= NT - 4) ? 1u : ((sel >> ((t) >> 2)) & 1u)) != 0u)
    f32x16 pA0, pA1, pB0, pB1; float mnA, mnB, alA, alB; bf16x8 pa0, pa1, pa2, pa3;
    int s0 = 0, s1 = 1, s2 = 2;
#define ATT_ROT() do { const int t_ = s0; s0 = s1; s1 = s2; s2 = t_; } while (0)
    ATT_SLOAD(0); asm volatile("s_waitcnt vmcnt(0)" ::: "memory"); ATT_SWRITE(0); ATT_SLOAD(KVBLK);
    s0 = 2; s1 = 0; s2 = 1;
    __syncthreads();
    asm volatile("s_waitcnt vmcnt(0)" ::: "memory"); ATT_SWRITE(s2); ATT_SLOAD(2 * KVBLK);
    qkt(pA0, pA1, K_lds + s1 * SHM_K, qr, r32, hi); ATT_MASK(pA0, pA1, 0); partialSM(pA0, pA1, m_reg, mnA, alA, ATT_KEEP(0));
    ATT_ROT();
    for (int j = 1; j < NT; j += 2) {
        __syncthreads();
        if (j + 1 < NT) { asm volatile("s_waitcnt vmcnt(0)" ::: "memory"); ATT_SWRITE(s2); if (j + 2 < NT) ATT_SLOAD((j + 2) * KVBLK); }
        ATT_SBAR(); qkt(pB0, pB1, K_lds + s1 * SHM_K, qr, r32, hi); ATT_MASK(pB0, pB1, j);
        finishSM(pA0, pA1, alA, l_reg, pa0, pa1, pa2, pa3); ATT_SBAR();
        pv(o, vb0 + s0 * SHM_V, pa0, pa1, pa2, pa3); partialSM(pB0, pB1, m_reg, mnB, alB, ATT_KEEP(j));
        ATT_RESC(alB); ATT_ROT();
        if (j + 1 < NT) {
            __syncthreads();
            if (j + 2 < NT) { asm volatile("s_waitcnt vmcnt(0)" ::: "memory"); ATT_SWRITE(s2); if (j + 3 < NT) ATT_SLOAD((j + 3) * KVBLK); }
            ATT_SBAR(); qkt(pA0, pA1, K_lds + s1 * SHM_K, qr, r32, hi); ATT_MASK(pA0, pA1, j + 1);
            finishSM(pB0, pB1, alB, l_reg, pa0, pa1, pa2, pa3); ATT_SBAR();
            pv(o, vb0 + s0 * SHM_V, pa0, pa1, pa2, pa3); partialSM(pA0, pA1, m_reg, mnA, alA, ATT_KEEP(j + 1));
            ATT_RESC(alA); ATT_ROT();
        }
    }
    finishSM(pB0, pB1, alB, l_reg, pa0, pa1, pa2, pa3); ATT_SBAR();
    pv(o, vb0 + s0 * SHM_V, pa0, pa1, pa2, pa3);
#undef ATT_ROT
    if (hi == 0) li_l[r32] = l_reg; asm volatile("s_waitcnt lgkmcnt(0)" ::: "memory");
    float rli[16];
#pragma unroll
    for (int r = 0; r < 16; ++r) rli[r] = __builtin_amdgcn_rcpf(li_l[crow(r, hi)]);
    bf16* Ow = wsp<bf16>(F, WS_MIX) + (rowbase + q0 + wid * QBLK) * DM + h * HD;
    float* ssqa = wsp<float>(F, WS_SSQA) + (rowbase + q0 + wid * QBLK) * NH + h;
    float qq[16];
#pragma unroll
    for (int r = 0; r < 16; ++r) { const int orow = crow(r, hi); float q2 = 0.f;
#pragma unroll
        for (int d0 = 0; d0 < 2; ++d0) { const float v = o[d0][r] * rli[r]; const float vn = __shfl_xor(v, 1); q2 += v * v;
            if ((r32 & 1) == 0) *(unsigned*)(Ow + (size_t)orow * DM + d0 * 32 + r32) = cvt_pk_bf16(v, vn); }
        qq[r] = q2; }
#pragma unroll
    for (int i = 0; i < 8; ++i) { const bool up = (lane & 16) != 0; const float send = up ? qq[i] : qq[i + 8], keep = up ? qq[i + 8] : qq[i]; qq[i] = keep + __shfl_xor(send, 16); }
#pragma unroll
    for (int i = 0; i < 4; ++i) { const bool up = (lane & 8) != 0; const float send = up ? qq[i] : qq[i + 4], keep = up ? qq[i + 4] : qq[i]; qq[i] = keep + __shfl_xor(send, 8); }
#pragma unroll
    for (int i = 0; i < 2; ++i) { const bool up = (lane & 4) != 0; const float send = up ? qq[i] : qq[i + 2], keep = up ? qq[i + 2] : qq[i]; qq[i] = keep + __shfl_xor(send, 4); }
    { const bool up = (lane & 2) != 0; const float send = up ? qq[0] : qq[1], keep = up ? qq[1] : qq[0]; qq[0] = keep + __shfl_xor(send, 2); }
    qq[0] += __shfl_xor(qq[0], 1);
    if ((lane & 1) == 0) ssqa[(size_t)crow(r32 >> 1, hi) * NH] = qq[0];
    __syncthreads();
#undef ATT_SLOAD
#undef ATT_SWRITE
#undef ATT_RESC
#undef ATT_MASK
#undef ATT_KEEP
}
}

namespace gm {
__device__ __forceinline__ int vt_off(int d, int s) { return d * 256 + ((((s >> 3) ^ (d & 15)) & 15) << 4) + (s & 7) * 2; }
__device__ __forceinline__ void units4(const Frame& F, int v, LAS unsigned char* scratch) {
    PHASE_IDS;
    const int tid = TID_, wid = tid >> 6, lane = tid & 63, fr = lane & 15, fq = lane >> 4;
    const int u = wid >> 1, half = wid & 1, uidx = 4 * v + u, b = uidx >> 6, c = (uidx >> 2) & 15, g = uidx & 3;
    const size_t row0 = (size_t)b * SEQ + c * GC;
    const bf16* VGg = wsp<bf16>(F, WS_VG) + row0 * GW + g * GD; const bf16* Ug = wsp<bf16>(F, WS_U) + row0 * GW + g * GD;
    LAS unsigned char* vt = scratch + u * 32768;
    { const int s_ = half * 64 + lane; const v4u* src = (const v4u*)(VGg + (size_t)s_ * GW); v4u raw[16]; float sum = 0.f, sq = 0.f;
#pragma unroll
      for (int i = 0; i < 16; ++i) raw[i] = src[i];
#pragma unroll
      for (int i = 0; i < 16; ++i) { const unsigned ww[4] = {raw[i].x, raw[i].y, raw[i].z, raw[i].w};
#pragma unroll
          for (int k = 0; k < 4; ++k) { const float a0 = bflo(ww[k]), a1 = bfhi(ww[k]); sum += a0 + a1; sq += a0 * a0 + a1 * a1; } }
      const float mu = sum * (1.f / GD); const float var = fmaxf(sq * (1.f / GD) - mu * mu, 0.f); const float rstd = 1.0f / sqrtf(var + EPS);
      const float* lg = F.ln_g + g * GD; const float* lb = F.ln_b + g * GD;
#pragma unroll
      for (int i = 0; i < 16; ++i) { const unsigned ww[4] = {raw[i].x, raw[i].y, raw[i].z, raw[i].w}; const f32x4 g0 = *(const f32x4*)(lg + 8 * i), g1 = *(const f32x4*)(lg + 8 * i + 4), b0 = *(const f32x4*)(lb + 8 * i), b1 = *(const f32x4*)(lb + 8 * i + 4);
          const float gg[8] = {g0[0], g0[1], g0[2], g0[3], g1[0], g1[1], g1[2], g1[3]}, bb[8] = {b0[0], b0[1], b0[2], b0[3], b1[0], b1[1], b1[2], b1[3]};
#pragma unroll
          for (int k = 0; k < 4; ++k) { const int d = 8 * i + 2 * k;
              *(LAS unsigned short*)(vt + vt_off(d, s_)) = (unsigned short)f2bf((bflo(ww[k]) - mu) * rstd * gg[2 * k] + bb[2 * k]);
              *(LAS unsigned short*)(vt + vt_off(d + 1, s_)) = (unsigned short)f2bf((bfhi(ww[k]) - mu) * rstd * gg[2 * k + 1] + bb[2 * k + 1]); } } }
    __syncthreads();
#pragma unroll 1
    for (int m = 0; m < 4; ++m) {
        const int tb = half * 64 + m * 16, t = tb + fr;
        const float* Wg = F.gws + (size_t)g * GC * GC + (size_t)t * GC;
        const int nks = (tb + 16 + 31) / 32;
        f32x4 w0[4], w1[4];
#pragma unroll
        for (int ks = 0; ks < 4; ++ks) if (ks < nks) { w0[ks] = *(const f32x4*)(Wg + ks * 32 + fq * 8); w1[ks] = *(const f32x4*)(Wg + ks * 32 + fq * 8 + 4); }
        const bf16* Ut = Ug + (size_t)t * GW + 4 * fq; v2u uu[8];
#pragma unroll
        for (int n = 0; n < 8; ++n) uu[n] = *(const v2u*)(Ut + n * 16);
        f32x4 acc[8];
#pragma unroll
        for (int n = 0; n < 8; ++n) acc[n] = (f32x4){0.f, 0.f, 0.f, 0.f};
#pragma unroll
        for (int ks = 0; ks < 4; ++ks) if (ks < nks) { const int s0 = ks * 32 + fq * 8;
            float wv[8] = {w0[ks][0], w0[ks][1], w0[ks][2], w0[ks][3], w1[ks][0], w1[ks][1], w1[ks][2], w1[ks][3]};
#pragma unroll
            for (int j = 0; j < 8; ++j) if (s0 + j > t) wv[j] = 0.f;
            v4u aw; aw.x = pk2(wv[0], wv[1]); aw.y = pk2(wv[2], wv[3]); aw.z = pk2(wv[4], wv[5]); aw.w = pk2(wv[6], wv[7]);
            const bf16x8 wf = *reinterpret_cast<const bf16x8*>(&aw);
#pragma unroll
            for (int n = 0; n < 8; ++n) { const bf16x8 vf = *(const LAS bf16x8*)(vt + vt_off(n * 16 + fr, s0));
                acc[n] = __builtin_amdgcn_mfma_f32_16x16x32_bf16(vf, wf, acc[n], 0, 0, 0); } }
        bf16* Og = wsp<bf16>(F, WS_MIX) + (row0 + t) * DM + AW + g * GD + 4 * fq; float* ssqg = wsp<float>(F, WS_SSQG) + (row0 + t) * GG + g;
        const float bs = F.gbs[g * GC + t]; float q2 = 0.f;
#pragma unroll
        for (int n = 0; n < 8; ++n) { const float o0 = bflo(uu[n].x) * (acc[n][0] + bs), o1 = bfhi(uu[n].x) * (acc[n][1] + bs), o2 = bflo(uu[n].y) * (acc[n][2] + bs), o3 = bfhi(uu[n].y) * (acc[n][3] + bs);
            q2 += (o0 * o0 + o1 * o1) + (o2 * o2 + o3 * o3); v2u w; w.x = cvt_pk_bf16(o0, o1); w.y = cvt_pk_bf16(o2, o3); *(v2u*)(Og + n * 16) = w; }
        q2 += __shfl_xor(q2, 16); q2 += __shfl_xor(q2, 32);
        if (fq == 0) ssqg[0] = q2;
    }
    __syncthreads();
}
}

__device__ __forceinline__ void p2_mixers(const Frame& F) {
    PHASE_IDS;
    LAS unsigned char* scratch = F.lds + RING_OFF;
    const int v = F.vcu, bh = v >> 1, s0 = (v & 1) * 2, cslot = (v >> 1) % 6;
    int item = 0;
#pragma unroll 1
    for (int st = 0; st < 6; ++st) {
        if (st == cslot) { constexpr int PER_WG = XW_ITEMS / 256; static_assert(XW_ITEMS % 256 == 0 && PER_WG % NWAVES == 0, "items per workgroup / wave");
            LAS float* scr = (LAS float*)(F.lds + RING_OFF + WAVE_ * P0_SCR_WAVE);
            constexpr int NI = PER_WG / NWAVES; static_assert(NI % 2 == 0, "pairs");
            int ln = LANE_; asm volatile("" : "+v"(ln));
            const int it0 = v * PER_WG + WAVE_; f32x4 va[16], vb[16]; XwDesc da = xw_desc(F, it0, ln), db; xw_load(va, da);
#pragma unroll 1
            for (int j = 0; j < NI; j += 2) {
                db = xw_desc(F, it0 + (j + 1) * NWAVES, ln); xw_load(vb, db);
                xw_process(va, da, scr, ln);
                if (j + 2 < NI) { da = xw_desc(F, it0 + (j + 2) * NWAVES, ln); xw_load(va, da); }
                xw_process(vb, db, scr, ln);
            }
            __syncthreads(); }
        else { if (item < 4) { const int qq = s0 + (item >> 1); const int qb = (item & 1) ? 7 - qq : qq; att::attn_unit(F, bh / NH, bh % NH, qb, scratch); }
               else gm::units4(F, v, scratch);
               ++item; }
    }
}

__device__ __forceinline__ void p4_router(const Frame& F) {
    PHASE_IDS;
    const int tid = TID_, wid = tid >> 6, lane = tid & 63, tk = lane & 31, hf = lane >> 5;
    LAS unsigned* hist = (LAS unsigned*)(F.lds + XTAB_OFF + 4096);
    LAS unsigned* base = hist + 32;
    static_assert(XTAB_OFF + 4096 >= 8 * P0_SCR_WAVE, "router words above the conversion tiles");
    const bf16* RWT = wsp<bf16>(F, WS_RWT); const bf16* x1 = wsp<bf16>(F, WS_X1B); const float* ssq1 = wsp<float>(F, WS_SSQ1);
    unsigned* cntg = (unsigned*)(F.ctl + CW_CNT);
    unsigned* IDX = wsp<unsigned>(F, WS_IDX); float* GSS = wsp<float>(F, WS_GSS); float* RSS = wsp<float>(F, WS_RSS); unsigned* TOKPOS = wsp<unsigned>(F, WS_TOKPOS);
    if (tid < 32) hist[tid] = 0u;
    __syncthreads();
    const bool active = wid < 4; const int tok = (F.vcu * 4 + (wid & 3)) * 32 + tk;
    int pe[4] = {0, 0, 0, 0}; float pg[4] = {0.f, 0.f, 0.f, 0.f}; unsigned rank[2] = {0u, 0u}; int my_e[2] = {0, 0}; float my_g[2] = {0.f, 0.f}; float rstd = 0.f;
    f32x16 acc = f32x16{};
    { constexpr int PITCH = 528; LAS unsigned char* XL = F.lds + RING_OFF; LAS unsigned char* WL = XL + 128 * PITCH;
      const int rsub = lane >> 5, cb = (lane & 31) * 16;
      const char* xsrc = (const char*)(x1 + (size_t)(F.vcu * 128 + 16 * wid + rsub) * DM) + cb; const char* wsrc = (const char*)(RWT + (size_t)(8 * wid + rsub) * DM) + cb;
      LAS unsigned char* xdst = XL + (16 * wid + rsub) * PITCH + cb; LAS unsigned char* wdst = WL + (8 * wid + rsub) * PITCH + cb;
      const LAS unsigned char* xb = XL + ((wid & 3) * 32 + tk) * PITCH + hf * 16; const LAS unsigned char* wa = WL + tk * PITCH + hf * 16; const LAS unsigned char* wb = wa + 32 * PITCH;
      v4u xs[8], ws_[4];
#define RT_LOAD(c) do { _Pragma("unroll") for (int i = 0; i < 8; ++i) xs[i] = *(const v4u*)(xsrc + (size_t)(2 * i) * DM * 2 + (c) * 512); \
                        _Pragma("unroll") for (int i = 0; i < 4; ++i) ws_[i] = *(const v4u*)(wsrc + (size_t)(2 * i) * DM * 2 + (c) * 512); } while (0)
      RT_LOAD(0);
#pragma unroll 1
      for (int c = 0; c < 4; ++c) {
#pragma unroll
          for (int i = 0; i < 8; ++i) *(LAS v4u*)(xdst + 2 * i * PITCH) = xs[i];
#pragma unroll
          for (int i = 0; i < 4; ++i) *(LAS v4u*)(wdst + 2 * i * PITCH) = ws_[i];
          __syncthreads();
          if (c < 3) RT_LOAD(c + 1);
          if (active) {
#pragma unroll
              for (int s_ = 0; s_ < 16; ++s_) { const bf16x8 xv = *(const LAS bf16x8*)(xb + 32 * s_), a_hi = *(const LAS bf16x8*)(wa + 32 * s_), a_lo = *(const LAS bf16x8*)(wb + 32 * s_);
                  acc = __builtin_amdgcn_mfma_f32_32x32x16_bf16(a_hi, xv, acc, 0, 0, 0); acc = __builtin_amdgcn_mfma_f32_32x32x16_bf16(a_lo, xv, acc, 0, 0, 0); } }
          __syncthreads();
      }
#undef RT_LOAD
    }
    if (active) {
        { const f32x4* sp = (const f32x4*)(ssq1 + (size_t)tok * 16); const f32x4 a = sp[0], b = sp[1], c = sp[2], d = sp[3];
          const float s_ = ((a[0] + a[1]) + (a[2] + a[3])) + ((b[0] + b[1]) + (b[2] + b[3])) + ((c[0] + c[1]) + (c[2] + c[3])) + ((d[0] + d[1]) + (d[2] + d[3]));
          rstd = 1.0f / sqrtf(s_ * (1.f / DM) + EPS); }
        float lv[16];
#pragma unroll
        for (int r = 0; r < 16; ++r) { const int e = (r & 3) + 8 * (r >> 2) + 4 * hf; lv[r] = acc[r] * rstd + F.router_b[e]; }
        float tv[4]; int ti[4]; unsigned used = 0u;
#pragma unroll
        for (int k = 0; k < 4; ++k) { float best = -__builtin_inff(); int br = 0;
#pragma unroll
            for (int r = 0; r < 16; ++r) { const int e = (r & 3) + 8 * (r >> 2) + 4 * hf; const int eb = (br & 3) + 8 * (br >> 2) + 4 * hf;
                const bool better = !((used >> r) & 1u) && (lv[r] > best || (lv[r] == best && e < eb)); if (better) { best = lv[r]; br = r; } }
            used |= 1u << br; tv[k] = best; ti[k] = (br & 3) + 8 * (br >> 2) + 4 * hf; }
        float ov[4]; int oi[4];
#pragma unroll
        for (int k = 0; k < 4; ++k) { ov[k] = __shfl_xor(tv[k], 32); oi[k] = __shfl_xor(ti[k], 32); }
        int ia = 0, ib = 0;
#pragma unroll
        for (int k = 0; k < 4; ++k) {
            float va = tv[0], vb = ov[0]; int ea = ti[0], eb = oi[0];
#pragma unroll
            for (int q = 1; q < 4; ++q) { if (ia == q) { va = tv[q]; ea = ti[q]; } if (ib == q) { vb = ov[q]; eb = oi[q]; } }
            const bool takeA = (va > vb) || (va == vb && ea < eb);
            pg[k] = takeA ? va : vb; pe[k] = takeA ? ea : eb; if (takeA) ++ia; else ++ib; }
        { const float m = pg[0]; float s_ = 0.f;
#pragma unroll
          for (int k = 0; k < 4; ++k) { pg[k] = __builtin_amdgcn_exp2f((pg[k] - m) * 1.4426950408889634f); s_ += pg[k]; }
          const float inv = 1.0f / s_;
#pragma unroll
          for (int k = 0; k < 4; ++k) pg[k] *= inv; }
        { const int m = -hf; my_e[0] = pe[0] ^ ((pe[0] ^ pe[2]) & m); my_e[1] = pe[1] ^ ((pe[1] ^ pe[3]) & m);
          const unsigned g0 = __float_as_uint(pg[0]), g1 = __float_as_uint(pg[1]), g2 = __float_as_uint(pg[2]), g3 = __float_as_uint(pg[3]);
          my_g[0] = __uint_as_float(g0 ^ ((g0 ^ g2) & (unsigned)m)); my_g[1] = __uint_as_float(g1 ^ ((g1 ^ g3) & (unsigned)m)); }
#pragma unroll
        for (int q = 0; q < 2; ++q) rank[q] = atomicAdd((unsigned*)&hist[my_e[q]], 1u);
    }
    __syncthreads();
    if (tid < 32) base[tid] = atomicAdd(cntg + tid * CNT_STRIDE, hist[tid]);
    __syncthreads();
    if (active) {
#pragma unroll
        for (int q = 0; q < 2; ++q) { const int k = 2 * hf + q; const int e = my_e[q]; const float g = my_g[q];
            const unsigned slot = base[e] + rank[q];
            IDX[(size_t)e * T + slot] = (unsigned)tok; GSS[(size_t)e * T + slot] = g; RSS[(size_t)e * T + slot] = rstd; TOKPOS[(size_t)tok * 4 + k] = ((unsigned)e << 16) | slot; }
    }
    __syncthreads();
}

__device__ __forceinline__ void build_tstart(const Frame& F, LAS unsigned* tstart, int tid) {
    if (tid < 64) { const unsigned* cntg = (const unsigned*)(F.ctl + CW_CNT); unsigned c = (tid < NE) ? cntg[tid * CNT_STRIDE] : 0u; if (c > (unsigned)T) c = (unsigned)T;
        unsigned x = (c + 255u) >> 8;
#pragma unroll
        for (int o = 1; o < 32; o <<= 1) { const unsigned y = __shfl_up(x, o); if ((tid & 63) >= o) x += y; }
        if (tid < NE) tstart[tid + 1] = x; if (tid == 0) tstart[0] = 0u; }
}
constexpr int MAXU = 17;
constexpr int XT_TSTART = 0, XT_ULIST = 256, XT_RS = 512, XT_GTAB = XT_RS + MAXU * 1024;
static_assert(XT_GTAB + MAXU * 512 <= LDSCTL_OFF - XTAB_OFF, "xtab");
__device__ __forceinline__ int moe_build_tables(const Frame& F, int P  , int mode) {
    PHASE_IDS;
    LAS unsigned* tstart = (LAS unsigned*)(F.lds + XTAB_OFF + XT_TSTART);
    LAS unsigned* ulist = (LAS unsigned*)(F.lds + XTAB_OFF + XT_ULIST);
    LAS float* rs = (LAS float*)(F.lds + XTAB_OFF + XT_RS);
    LAS unsigned short* gtab = (LAS unsigned short*)(F.lds + XTAB_OFF + XT_GTAB);
    const unsigned* cntg = (const unsigned*)(F.ctl + CW_CNT); const unsigned* IDX = wsp<unsigned>(F, WS_IDX);
    const float* RSRC = mode == 1 ? wsp<float>(F, WS_RSS) : wsp<float>(F, WS_GSS);
    const int tid = TID_;
    build_tstart(F, tstart, tid);
    __syncthreads();
    const int NT_ = (int)tstart[NE], U = NT_ * P, G = F.G, c = (int)blockIdx.x;
    int nunits = (c < U) ? (U - c + G - 1) / G : 0; if (nunits > MAXU) nunits = MAXU;
    if (tid < nunits) { const int L = tid * G + c; int gt, pn; pg8::flat_to_tile(L, U, NT_, P, gt, pn);
        int e = 0; for (int k = 1; k < NE; ++k) if ((unsigned)gt >= tstart[k]) e = k;
        const int rt = gt - (int)tstart[e];
        ulist[tid] = (unsigned)gt | ((unsigned)pn << 10) | ((unsigned)e << 13) | ((unsigned)rt << 18); }
    __syncthreads();
    {
        constexpr int NP = (MAXU + 1) / 2; unsigned tokv[NP]; float rsv[NP];
#pragma unroll
        for (int p = 0; p < NP; ++p) { const int i = 2 * p + (tid >> 8), r = tid & 255; tokv[p] = 0u; rsv[p] = 0.f;
            if (i < nunits) { const unsigned w = ulist[i]; const int e = (int)((w >> 13) & 0x1fu), rt = (int)(w >> 18);
                unsigned cn = cntg[e * CNT_STRIDE]; if (cn > (unsigned)T) cn = (unsigned)T; const unsigned slot = (unsigned)rt * 256u + (unsigned)r;
                if (slot < cn) { if (mode == 1) tokv[p] = IDX[(size_t)e * T + slot]; rsv[p] = RSRC[(size_t)e * T + slot]; } } }
#pragma unroll
        for (int p = 0; p < NP; ++p) { const int i = 2 * p + (tid >> 8), r = tid & 255;
            if (i < nunits) { unsigned tok = tokv[p]; if (tok >= (unsigned)T) tok = 0u; if (mode == 1) gtab[i * 256 + r] = (unsigned short)tok; rs[i * 256 + r] = rsv[p]; } }
    }
    __syncthreads();
    return nunits;
}

__device__ __forceinline__ void p7_combine(const Frame& F) {
    PHASE_IDS;
    LAS unsigned* tstart = (LAS unsigned*)(F.lds + XTAB_OFF + XT_TSTART);
    const unsigned* cntg = (const unsigned*)(F.ctl + CW_CNT);
    build_tstart(F, tstart, TID_); (void)cntg;
    __syncthreads();
    const int gw = F.vcu * NWAVES + WAVE_, NGW = F.G * NWAVES;
    const unsigned* TOKPOS = wsp<unsigned>(F, WS_TOKPOS); const unsigned char* Y = wsp<unsigned char>(F, WS_YBUF); const bf16* X1 = wsp<bf16>(F, WS_X1B); bf16* X2 = wsp<bf16>(F, WS_X2B); unsigned char* X28 = wsp<unsigned char>(F, WS_X2F8); float* RS2 = wsp<float>(F, WS_RSTD2);
    for (int m0 = gw; m0 < T; m0 += 2 * NGW) {
        f32x4 v[2][4]; unsigned yv[2][4][4]; float s[2] = {0.f, 0.f};
#pragma unroll
        for (int r = 0; r < 2; ++r) { const int m = m0 + r * NGW;
            const v4u tp = *(const v4u*)(TOKPOS + (size_t)m * 4); const unsigned tpw[4] = {tp.x, tp.y, tp.z, tp.w};
            size_t yrow[4];
#pragma unroll
            for (int k = 0; k < 4; ++k) { const unsigned e = (tpw[k] >> 16) & 31u, slot = tpw[k] & 0xffffu; yrow[k] = ((size_t)tstart[e] * 256u + slot) * DM; }
#pragma unroll
            for (int j = 0; j < 4; ++j) { const v2u xw = __builtin_nontemporal_load((const v2u*)(X1 + (size_t)m * DM + 4 * LANE_ + 256 * j)); v[r][j] = (f32x4){bflo(xw.x), bfhi(xw.x), bflo(xw.y), bfhi(xw.y)};
#pragma unroll
                for (int k = 0; k < 4; ++k) yv[r][j][k] = __builtin_nontemporal_load((const unsigned*)(Y + yrow[k] + 4 * LANE_ + 256 * j)); } }
#pragma unroll
        for (int r = 0; r < 2; ++r) {
#pragma unroll
            for (int j = 0; j < 4; ++j) {
#pragma unroll
                for (int k = 0; k < 4; ++k) { const unsigned w = yv[r][j][k]; const f32x2 lo = __builtin_amdgcn_cvt_pk_f32_fp8((int)w, false), hi2 = __builtin_amdgcn_cvt_pk_f32_fp8((int)w, true);
                    v[r][j][0] += lo[0] * (1.0f / Y_SCALE); v[r][j][1] += lo[1] * (1.0f / Y_SCALE); v[r][j][2] += hi2[0] * (1.0f / Y_SCALE); v[r][j][3] += hi2[1] * (1.0f / Y_SCALE); }
                s[r] += (v[r][j].x * v[r][j].x + v[r][j].y * v[r][j].y) + (v[r][j].z * v[r][j].z + v[r][j].w * v[r][j].w); } }
#pragma unroll
        for (int r = 0; r < 2; ++r) { const int m = m0 + r * NGW; const float rstd = 1.0f / sqrtf(wave_sum(s[r]) * (1.f / DM) + EPS);
            if (LANE_ == 0) RS2[m] = rstd;
#pragma unroll
            for (int j = 0; j < 4; ++j) { v2u w; w.x = cvt_pk_bf16(v[r][j].x, v[r][j].y); w.y = cvt_pk_bf16(v[r][j].z, v[r][j].w); *(v2u*)(X2 + (size_t)m * DM + 4 * LANE_ + 256 * j) = w;
                *(unsigned*)(X28 + (size_t)m * DM + 4 * LANE_ + 256 * j) = pk4_fp8(v[r][j].x, v[r][j].y, v[r][j].z, v[r][j].w); } }
    }
}

__device__ __forceinline__ void p9_final(const Frame& F) {
    PHASE_IDS;
    const int gw = F.vcu * NWAVES + WAVE_, NGW = F.G * NWAVES;
    const unsigned char* GATE = wsp<unsigned char>(F, WS_GATE); const unsigned char* PP = wsp<unsigned char>(F, WS_PP); const float* ssqpp = wsp<float>(F, WS_SSQPP);
    for (int m0 = gw; m0 < T; m0 += 2 * NGW) {
        f32x4 v[2][4]; unsigned gv[2][4], pv_[2][4]; f32x4 sq[2][4]; float s[2] = {0.f, 0.f};
#pragma unroll
        for (int r = 0; r < 2; ++r) { const int m = m0 + r * NGW; const bf16* x2r = wsp<bf16>(F, WS_X2B) + (size_t)m * DM;
#pragma unroll
            for (int q = 0; q < 4; ++q) sq[r][q] = *(const f32x4*)(ssqpp + (size_t)m * 16 + 4 * q);
#pragma unroll
            for (int j = 0; j < 4; ++j) { const int col = 4 * LANE_ + 256 * j; const v2u xw = __builtin_nontemporal_load((const v2u*)(x2r + col)); v[r][j] = (f32x4){bflo(xw.x), bfhi(xw.x), bflo(xw.y), bfhi(xw.y)};
                gv[r][j] = __builtin_nontemporal_load((const unsigned*)(GATE + (size_t)m * DM + col)); pv_[r][j] = __builtin_nontemporal_load((const unsigned*)(PP + (size_t)m * DM + col)); } }
#pragma unroll
        for (int r = 0; r < 2; ++r) { const f32x4 a = sq[r][0], b = sq[r][1], c = sq[r][2], d = sq[r][3];
            const float sp = ((a[0] + a[1]) + (a[2] + a[3])) + ((b[0] + b[1]) + (b[2] + b[3])) + ((c[0] + c[1]) + (c[2] + c[3])) + ((d[0] + d[1]) + (d[2] + d[3]));
            const float rpp = 1.0f / sqrtf(sp * (1.f / DM) + EPS);
#pragma unroll
            for (int j = 0; j < 4; ++j) { const int col = 4 * LANE_ + 256 * j; const f32x4 pg_ = *(const f32x4*)(F.ppn + col);
                const f32x2 g01 = __builtin_amdgcn_cvt_pk_f32_fp8((int)gv[r][j], false), g23 = __builtin_amdgcn_cvt_pk_f32_fp8((int)gv[r][j], true);
                const f32x2 p01 = __builtin_amdgcn_cvt_pk_f32_fp8((int)pv_[r][j], false), p23 = __builtin_amdgcn_cvt_pk_f32_fp8((int)pv_[r][j], true);
                const float rg = rpp * (1.0f / GATE_SCALE);
                v[r][j][0] += g01[0] * (p01[0] * rg * pg_[0]); v[r][j][1] += g01[1] * (p01[1] * rg * pg_[1]);
                v[r][j][2] += g23[0] * (p23[0] * rg * pg_[2]); v[r][j][3] += g23[1] * (p23[1] * rg * pg_[3]);
                s[r] += (v[r][j].x * v[r][j].x + v[r][j].y * v[r][j].y) + (v[r][j].z * v[r][j].z + v[r][j].w * v[r][j].w); } }
#pragma unroll
        for (int r = 0; r < 2; ++r) { const int m = m0 + r * NGW; float* xr = F.out + (size_t)m * DM; const float rstd = 1.0f / sqrtf(wave_sum(s[r]) * (1.f / DM) + EPS);
#pragma unroll
            for (int j = 0; j < 4; ++j) { const int col = 4 * LANE_ + 256 * j; const f32x4 fg = *(const f32x4*)(F.final_norm + col); __builtin_nontemporal_store(v[r][j] * rstd * fg, (f32x4*)(xr + col)); } }
    }
}

struct Args { const float* in[23]; float* out; unsigned char* ws; };
#if CHECK_STAGE
__device__ __forceinline__ unsigned hmix(unsigned z) { z ^= z >> 16; z *= 0x7feb352du; z ^= z >> 15; z *= 0x846ca68bu; z ^= z >> 16; return z; }
__device__ __forceinline__ void chk_add(const Frame& F, int st, bool bad) { atomicAdd((unsigned*)(F.ctl + CW_CHK + 2 * st), bad ? 1u : 0u); atomicAdd((unsigned*)(F.ctl + CW_CHK + 2 * st + 1), 1u); }
__device__ __forceinline__ bool offby(float got, float ex, float rel, float ab) { const float d = fabsf(got - ex); return !(d <= rel * fabsf(ex) + ab); }
__device__ __forceinline__ float dot_bf(const bf16* a, const bf16* b, int n) { float s = 0.f; for (int k = 0; k < n; ++k) s += bf2f(a[k]) * bf2f(b[k]); return s; }
__device__ __forceinline__ float gelu_ref(float v) { return 0.5f * v * (1.0f + erff(v * 0.70710678f)); }
__device__ __forceinline__ unsigned chk_tstart(const Frame& F, unsigned ex) { const unsigned* cntg = (const unsigned*)(F.ctl + CW_CNT); unsigned s_ = 0; for (unsigned e = 0; e < ex; ++e) { unsigned c = cntg[e * CNT_STRIDE]; if (c > (unsigned)T) c = T; s_ += (c + 255u) >> 8; } return s_; }
template <int ST> __device__ __forceinline__ void stage_check(const Frame& F) {
    const unsigned gt = (unsigned)blockIdx.x * NTHR + threadIdx.x;
    const unsigned h0 = hmix(gt * 2654435761u + ST * 40503u), h1 = hmix(h0 + 0x9e3779b9u), h2 = hmix(h1 + 0x85ebca6bu);
    if (ST == 1) {
        if (gt >= 16384) return;
        const int which = gt & 7;
        if (which == 0) { const int e = h0 % NE, n = h1 % (2 * FF), k = h2 % DM; const int lc = CmWgu()(n);
            const float ex = bf2f((bf16)f2bf(F.w_gu[((size_t)e * DM + k) * 2 * FF + lc] * F.ffn_norm[k])); chk_add(F, ST, offby(bf2f(wsp<bf16>(F, WS_WGU)[((size_t)e * 2 * FF + n) * DM + k]), ex, 1e-6f, 1e-30f)); }
        else if (which == 1) { const int e = h0 % NE, n = h1 % DM, k = h2 % FF;
            const float ex = bf2f((bf16)f2bf(F.w_dn[((size_t)e * FF + k) * DM + n])); chk_add(F, ST, offby(bf2f(wsp<bf16>(F, WS_WDN)[((size_t)e * DM + n) * FF + k]), ex, 1e-6f, 1e-30f)); }
        else if (which == 2) { const int n = h1 % NPROJ, k = h2 % DM; const int lc = CmWin()(n);
            const float ex = bf2f((bf16)f2bf(F.w_in[(size_t)k * NPROJ + lc] * F.mix_norm[k])); chk_add(F, ST, offby(bf2f(wsp<bf16>(F, WS_WIN)[(size_t)n * DM + k]), ex, 1e-6f, 1e-30f)); }
        else if (which == 3) { const int n = h1 % DM, k = h2 % DM; const float g = k < AW ? F.aon[k] : F.gon[k - AW];
            const float ex = bf2f((bf16)f2bf(F.w_out[(size_t)k * DM + n] * g)); chk_add(F, ST, offby(bf2f(wsp<bf16>(F, WS_WOUT)[(size_t)n * DM + k]), ex, 1e-6f, 1e-30f)); }
        else if (which == 4) { const int n = h1 % DM, k = h2 % DM;
            const float ex = bf2f((bf16)f2bf(F.w_pg[(size_t)k * DM + n] * F.ple_norm[k])); chk_add(F, ST, offby(bf2f(wsp<bf16>(F, WS_WPG)[(size_t)n * DM + k]), ex, 1e-6f, 1e-30f)); }
        else if (which == 5) { const int n = h1 % DM, k = h2 % PLE;
            const float ex = bf2f((bf16)f2bf(F.w_pp[(size_t)k * DM + n])); chk_add(F, ST, offby(bf2f(wsp<bf16>(F, WS_WPP)[(size_t)n * PLE + k]), ex, 1e-6f, 1e-30f)); }
        else if (which == 6) { const int row = h0 % T, k = h1 % DM; float ss = 0.f; for (int j = 0; j < DM; ++j) { const float v = F.x[(size_t)row * DM + j]; ss += v * v; }
            const float ex = F.x[(size_t)row * DM + k] / sqrtf(ss / DM + EPS); chk_add(F, ST, offby(bf2f(wsp<bf16>(F, WS_XNB)[(size_t)row * DM + k]), ex, 0.01f, 1e-3f)); }
        else { const int row = h0 % T, k = h1 % PLE; chk_add(F, ST, offby(bf2f(wsp<bf16>(F, WS_PB)[(size_t)row * PLE + k]), F.p[(size_t)row * PLE + k], 0.005f, 1e-6f)); }
    }
    if (ST == 2) {
        if (gt >= 16384) return;
        const bf16* XN = wsp<bf16>(F, WS_XNB); const bf16* WIN = wsp<bf16>(F, WS_WIN);
        if ((gt & 7) == 7) {
            const int b = h0 % BATCH, hh = h1 % NH, blk = h2 % NBLK, c = (h2 >> 8) % HD; float s_ = 0.f;
            for (int r = 0; r < 256; ++r) s_ += bf2f(wsp<bf16>(F, WS_K)[((size_t)b * SEQ + blk * 256 + r) * AW + hh * HD + c]);
            chk_add(F, ST, offby(wsp<float>(F, WS_KMEAN)[((size_t)(b * NH + hh) * NBLK + blk) * HD + c], s_, 0.02f, 0.3f)); return; }
        const int row = h0 % T, type = h1 % 5, c = h2 % AW; const bf16* xr = XN + (size_t)row * DM;
        const float v = dot_bf(xr, WIN + (size_t)(type * AW + c) * DM, DM); float ex;
        if (type <= 1) { const float vp = dot_bf(xr, WIN + (size_t)(type * AW + (c ^ 4)) * DM, DM); const int i = 4 * ((c & 63) >> 3) + (c & 3), pos = row & (SEQ - 1);
            const float cs = wsp<float>(F, WS_ROPE)[pos * 32 + i], sn = wsp<float>(F, WS_ROPE)[SEQ * 32 + pos * 32 + i];
            { const float inv = powf(10000.0f, -(float)i / 32.0f); const float ang = (float)pos * inv; if (offby(cs, cosf(ang), 0.f, 1e-3f) || offby(sn, sinf(ang), 0.f, 1e-3f)) { chk_add(F, ST, true); return; } }
            ex = (c & 4) ? v * cs + vp * sn : v * cs - vp * sn; }
        else if (type == 2) ex = v; else ex = gelu_ref(v);
        chk_add(F, ST, offby(bf2f(wsp<bf16>(F, WS_Q)[(size_t)type * (16u << 20) + (size_t)row * AW + c]), ex, 0.02f, 0.02f));
    }
    if (ST == 3) {
        if (gt >= 8192) return;
        if (gt & 1) {
            const int row = h0 % T, g = h1 % GG, d = h2 % GD; const int b = row / SEQ, s_ = row % SEQ, c = s_ / GC, t = s_ % GC; float acc = 0.f;
            for (int sp = 0; sp <= t; ++sp) { const bf16* vr = wsp<bf16>(F, WS_VG) + ((size_t)b * SEQ + c * GC + sp) * GW + g * GD; float mu = 0.f; for (int j = 0; j < GD; ++j) mu += bf2f(vr[j]); mu /= GD;
                float var = 0.f; for (int j = 0; j < GD; ++j) { const float dd = bf2f(vr[j]) - mu; var += dd * dd; } const float rstd = 1.0f / sqrtf(var / GD + EPS);
                const float vn = bf2f((bf16)f2bf((bf2f(vr[d]) - mu) * rstd * F.ln_g[g * GD + d] + F.ln_b[g * GD + d])); acc += bf2f((bf16)f2bf(F.gws[((size_t)g * GC + t) * GC + sp])) * vn; }
            const float ex = bf2f(wsp<bf16>(F, WS_U)[(size_t)row * GW + g * GD + d]) * (acc + F.gbs[g * GC + t]);
            chk_add(F, ST, offby(bf2f(wsp<bf16>(F, WS_MIX)[(size_t)row * DM + AW + g * GD + d]), ex, 0.03f, 0.02f)); return; }
        const int row = h0 % T, hh = h1 % NH; const int b = row / SEQ, s_ = row % SEQ, qb = s_ / MOBA; float q[HD];
#pragma unroll
        for (int c = 0; c < HD; ++c) q[c] = bf2f(wsp<bf16>(F, WS_Q)[(size_t)row * AW + hh * HD + c]);
        unsigned sel = 0u;
        if (qb <= 3) sel = (1u << qb) - 1u;
        else { float b0 = -__builtin_inff(), b1 = b0, b2 = b0; int i0 = 0, i1 = 0, i2 = 0;
            for (int j = 0; j < qb; ++j) { const float* km = wsp<float>(F, WS_KMEAN) + ((size_t)(b * NH + hh) * NBLK + j) * HD; float g = 0.f;
#pragma unroll
                for (int c = 0; c < HD; ++c) g += q[c] * km[c];
                if (g > b0) { b2 = b1; i2 = i1; b1 = b0; i1 = i0; b0 = g; i0 = j; } else if (g > b1) { b2 = b1; i2 = i1; b1 = g; i1 = j; } else if (g > b2) { b2 = g; i2 = j; } }
            sel = (1u << i0) | (1u << i1) | (1u << i2); }
        float mx = -__builtin_inff();
        for (int kp = 0; kp <= s_; ++kp) { const int blk = kp / MOBA; if (blk != qb && !((sel >> blk) & 1u)) continue; const bf16* kr = wsp<bf16>(F, WS_K) + ((size_t)b * SEQ + kp) * AW + hh * HD; float sc = 0.f;
#pragma unroll
            for (int c = 0; c < HD; ++c) sc += q[c] * bf2f(kr[c]);
            mx = fmaxf(mx, sc * 0.125f); }
        float o[HD]; float l = 0.f;
#pragma unroll
        for (int c = 0; c < HD; ++c) o[c] = 0.f;
        for (int kp = 0; kp <= s_; ++kp) { const int blk = kp / MOBA; if (blk != qb && !((sel >> blk) & 1u)) continue; const bf16* kr = wsp<bf16>(F, WS_K) + ((size_t)b * SEQ + kp) * AW + hh * HD; float sc = 0.f;
#pragma unroll
            for (int c = 0; c < HD; ++c) sc += q[c] * bf2f(kr[c]);
            const float pr = expf(sc * 0.125f - mx); l += pr; const bf16* vr = wsp<bf16>(F, WS_V) + ((size_t)b * SEQ + kp) * AW + hh * HD;
#pragma unroll
            for (int c = 0; c < HD; ++c) o[c] += pr * bf2f(vr[c]); }
        bool bad = false; float ss = 0.f;
#pragma unroll
        for (int c = 0; c < HD; ++c) { const float ex = o[c] / l; ss += ex * ex; bad |= offby(bf2f(wsp<bf16>(F, WS_MIX)[(size_t)row * DM + hh * HD + c]), ex, 0.04f, 0.02f); }
        bad |= offby(wsp<float>(F, WS_SSQA)[(size_t)row * NH + hh], ss, 0.03f, 1e-3f);
        chk_add(F, ST, bad);
    }
    if (ST == 4) {
        if (gt >= 16384) return;
        const int row = h0 % T, col = h1 % DM; const bf16* mr = wsp<bf16>(F, WS_MIX) + (size_t)row * DM; const bf16* wr_ = wsp<bf16>(F, WS_WOUT) + (size_t)col * DM;
        float sa = 0.f, sg = 0.f, da = 0.f, dg = 0.f;
        for (int k = 0; k < AW; ++k) { const float a = bf2f(mr[k]), g = bf2f(mr[AW + k]); sa += a * a; sg += g * g; da += a * bf2f(wr_[k]); dg += g * bf2f(wr_[AW + k]); }
        const float ex = F.x[(size_t)row * DM + col] + da / sqrtf(sa / AW + EPS) + dg / sqrtf(sg / GW + EPS);
        chk_add(F, ST, offby(F.out[(size_t)row * DM + col], ex, 0.01f, 0.03f));
    }
    if (ST == 5) {
        if (gt >= 8192) return;
        const int tok = h0 % T; const float* xr = F.out + (size_t)tok * DM; float ss = 0.f; for (int k = 0; k < DM; ++k) ss += xr[k] * xr[k]; const float rstd = 1.0f / sqrtf(ss / DM + EPS);
        bool bad = false;
        for (int j = 0; j < 4; ++j) { const int k = (h1 >> (8 * j)) % DM; bad |= offby(bf2f(wsp<bf16>(F, WS_XNB)[(size_t)tok * DM + k]), xr[k] * rstd, 0.01f, 1e-3f); }
        float lg[NE];
#pragma unroll
        for (int e = 0; e < NE; ++e) lg[e] = 0.f;
        for (int k = 0; k < DM; ++k) { const float xv = xr[k] * rstd * F.ffn_norm[k];
#pragma unroll
            for (int e = 0; e < NE; ++e) lg[e] += xv * F.router_w[k * NE + e]; }
#pragma unroll
        for (int e = 0; e < NE; ++e) lg[e] += F.router_b[e];
        int te[4]; float tv[4]; unsigned used = 0u;
#pragma unroll
        for (int k = 0; k < 4; ++k) { float best = -__builtin_inff(); int bi = 0;
#pragma unroll
            for (int e = 0; e < NE; ++e) if (!((used >> e) & 1u) && lg[e] > best) { best = lg[e]; bi = e; }
            used |= 1u << bi; te[k] = bi; tv[k] = best; }
        { float gg[4]; float den = 0.f;
#pragma unroll
          for (int k = 0; k < 4; ++k) { float v = -__builtin_inff();
#pragma unroll
              for (int e = 0; e < NE; ++e) if (e == te[k]) v = lg[e];
              gg[k] = v; }
          const float mm = gg[0];
#pragma unroll
          for (int k = 0; k < 4; ++k) { gg[k] = expf(gg[k] - mm); den += gg[k]; }
          const unsigned* tp = wsp<unsigned>(F, WS_TOKPOS) + (size_t)tok * 4;
#pragma unroll
          for (int k = 0; k < 4; ++k) { const unsigned e = tp[k] >> 16, slot = tp[k] & 0xffffu; bad |= (e != (unsigned)te[k]);
              if (e < NE && slot < (unsigned)T) { bad |= wsp<unsigned>(F, WS_IDX)[(size_t)e * T + slot] != (unsigned)tok; bad |= offby(wsp<float>(F, WS_GSS)[(size_t)e * T + slot], gg[k] / den, 2e-3f, 1e-5f);
                  bad |= slot >= ((const unsigned*)(F.ctl + CW_CNT))[e * CNT_STRIDE]; } else bad = true; } }
        (void)tv;
        chk_add(F, ST, bad);
    }
    if (ST == 6 || ST == 7) {
        if (gt >= 16384) return;
        const int tok = h0 % T, k = h1 & 3, col = (h1 >> 2) % FF; const unsigned tp = wsp<unsigned>(F, WS_TOKPOS)[(size_t)tok * 4 + k]; const unsigned e = tp >> 16, slot = tp & 0xffffu;
        if (e >= NE) { chk_add(F, ST, true); return; }
        const unsigned tse = chk_tstart(F, e);
        const size_t row = (size_t)tse * 256 + slot;
        if (ST == 6) { const bf16* xr = wsp<bf16>(F, WS_XNB) + (size_t)tok * DM; const int np = (col >> 7) * 256 + (col & 127);
            const float g = dot_bf(xr, wsp<bf16>(F, WS_WGU) + ((size_t)e * 2 * FF + np) * DM, DM) + F.b_gu[(size_t)e * 2 * FF + col];
            const float l = dot_bf(xr, wsp<bf16>(F, WS_WGU) + ((size_t)e * 2 * FF + np + 128) * DM, DM) + F.b_gu[(size_t)e * 2 * FF + FF + col];
            const float gc = fminf(g, 7.f), lc = fminf(fmaxf(l, -7.f), 7.f); const float ex = gc / (1.0f + expf(-1.702f * gc)) * (lc + 1.0f);
            chk_add(F, ST, offby(bf2f(wsp<bf16>(F, WS_ABUF)[row * FF + col]), ex, 0.03f, 0.03f)); }
        else { const float d = dot_bf(wsp<bf16>(F, WS_ABUF) + row * FF, wsp<bf16>(F, WS_WDN) + ((size_t)e * DM + col) * FF, FF) + F.b_dn[(size_t)e * DM + col];
            const float ex = d * wsp<float>(F, WS_GSS)[(size_t)e * T + slot];
            chk_add(F, ST, offby(bf2f(wsp<bf16>(F, WS_YBUF)[row * DM + col]), ex, 0.03f, 0.01f)); }
    }
    if (ST == 8) {
        if (gt >= 8192) return;
        const int tok = h0 % T; const float* xr = F.out + (size_t)tok * DM; float ss = 0.f; for (int k = 0; k < DM; ++k) ss += xr[k] * xr[k]; const float rstd = 1.0f / sqrtf(ss / DM + EPS);
        bool bad = false; for (int k = 0; k < DM; ++k) { bad |= offby(bf2f(wsp<bf16>(F, WS_X2N)[(size_t)tok * DM + k]), xr[k] * rstd, 0.01f, 1e-3f); bad |= !(fabsf(xr[k]) < 30.f); }
        chk_add(F, ST, bad);
    }
    if (ST == 9) {
        if (gt >= 16384) return;
        const int row = h0 % T, col = h1 % DM;
        if (gt & 1) { const float d = dot_bf(wsp<bf16>(F, WS_X2N) + (size_t)row * DM, wsp<bf16>(F, WS_WPG) + (size_t)col * DM, DM); const float got = bf2f(wsp<bf16>(F, WS_GATE)[(size_t)row * DM + col]); const float ex = 1.0f / (1.0f + expf(-d)); const bool bad = offby(got, ex, 0.02f, 0.01f); chk_add(F, ST, bad);
            if (bad) { atomicOr((unsigned*)(F.ctl + CW_CHK + 40), 1u << ((col >> 3) & 31)); atomicOr((unsigned*)(F.ctl + CW_CHK + 41), 1u << ((row >> 3) & 31)); atomicOr((unsigned*)(F.ctl + CW_CHK + 42), 1u << (col & 7)); atomicOr((unsigned*)(F.ctl + CW_CHK + 43), 1u << (row & 7));
                if (!(got >= 0.f && got <= 1.f)) atomicAdd((unsigned*)(F.ctl + CW_CHK + 44), 1u); { int cl = (int)floorf(log2f(fabsf(got) + 1e-30f)) + 40; cl = cl < 0 ? 0 : (cl > 80 ? 80 : cl); atomicMax((unsigned*)(F.ctl + CW_CHK + 46), (unsigned)cl); atomicMin((unsigned*)(F.ctl + CW_CHK + 47), 0xffffffffu - (unsigned)cl); if (got < 0.f) atomicAdd((unsigned*)(F.ctl + CW_CHK + 48), 1u); } if (fabsf(got - ex) > 0.2f) atomicAdd((unsigned*)(F.ctl + CW_CHK + 45), 1u); } }
        else { const float d = dot_bf(wsp<bf16>(F, WS_PB) + (size_t)row * PLE, wsp<bf16>(F, WS_WPP) + (size_t)col * PLE, PLE); chk_add(F, 10, offby(bf2f(wsp<bf16>(F, WS_PP)[(size_t)row * DM + col]), d, 0.02f, 0.02f)); }
    }
}
__device__ __forceinline__ void check_report(const Frame& F) {
    float c2 = 3.0f;
    for (int st = 1; st <= 10; ++st) { const unsigned bad = F.ctl[CW_CHK + 2 * st], tot = F.ctl[CW_CHK + 2 * st + 1]; const float fr = tot ? (float)bad / (float)tot : 1.0f;
        (void)fr; if (((CHECK_SKIP >> st) & 1) == 0 && bad >= 1u) { c2 = powf(10.0f, (float)st) * (1.0f + fminf((float)bad, 80.0f) * 0.1f); break; } }
#if CHECK_REPORT >= 40
    { unsigned v = F.ctl[CW_CHK + CHECK_REPORT]; if (CHECK_REPORT == 47) v = 0xffffffffu - v; c2 = powf(10.0f, (float)(v >> 27)) * (1.0f + (float)((v >> 21) & 63u) * 0.1f);
#if CHECK_REPORT2
      c2 = powf(10.0f, (float)((v >> 16) & 31u)) * (1.0f + (float)((v >> 10) & 63u) * 0.1f);
#endif
#if CHECK_REPORT3
      c2 = powf(10.0f, (float)((v >> 5) & 31u)) * (1.0f + (float)(v & 31u) * 0.1f);
#endif
      if (CHECK_REPORT >= 46 && CHECK_REPORT <= 47) c2 = powf(10.0f, (float)(v / 9u)) * (1.0f + (float)(v % 9u));
    }
#endif
    if (g_gridbar[XB_TMO] != 0u) c2 = 1e20f;
    const float c = sqrtf(c2);
    for (size_t i = (size_t)blockIdx.x * NTHR + threadIdx.x; i < (size_t)T * DM; i += (size_t)gridDim.x * NTHR) F.out[i] = c;
}
#define STAGE_CHECK(n) stage_check<(n)>(F)
#else
#define STAGE_CHECK(n) do {} while (0)
#endif

__global__ void __launch_bounds__(NTHR, 2) mega_fwd(Args args) {
    extern __shared__ __attribute__((aligned(16))) unsigned char lds_raw[];
    Frame F;
    F.lds = (LAS unsigned char*)lds_raw;
    F.MISC = (volatile LAS unsigned*)(F.lds + LDSCTL_OFF);
    F.G = gridDim.x; { const int bx = blockIdx.x; F.vcu = (F.G % 8 == 0) ? (bx % 8) * (F.G / 8) + bx / 8 : bx; }
    F.ws = args.ws; F.ctl = (gu32*)(args.ws + WS_CTL); F.out = args.out;
    F.x = args.in[0]; F.p = args.in[1]; F.mix_norm = args.in[2]; F.w_in = args.in[3]; F.ln_g = args.in[4]; F.ln_b = args.in[5]; F.gws = args.in[6]; F.gbs = args.in[7];
    F.aon = args.in[8]; F.gon = args.in[9]; F.w_out = args.in[10]; F.ffn_norm = args.in[11]; F.router_w = args.in[12]; F.router_b = args.in[13]; F.w_gu = args.in[14]; F.b_gu = args.in[15];
    F.w_dn = args.in[16]; F.b_dn = args.in[17]; F.ple_norm = args.in[18]; F.w_pg = args.in[19]; F.w_pp = args.in[20]; F.ppn = args.in[21]; F.final_norm = args.in[22];
    { PHASE_IDS; for (int u = TID_; u < 256; u += NTHR) ((LAS unsigned*)(F.lds + LDSCTL_OFF))[u] = 0u; }
    __syncthreads();
    XcdBarrier bar = xcd_barrier_post(g_gridbar, F.MISC + 8);
#define GRID_BAR() xcd_barrier(bar)
#define STAGE_END(n) do { STAGE_CHECK(n); if (TPROBE && blockIdx.x == 0 && threadIdx.x == 0) ((unsigned long long*)(F.ctl + CW_TS))[(n)] = __builtin_amdgcn_s_memrealtime(); } while (0)

    if (TPROBE && blockIdx.x == 0 && threadIdx.x == 0) ((unsigned long long*)(F.ctl + CW_TS))[0] = __builtin_amdgcn_s_memrealtime();
    for (int rep = 0; rep < (DUP_PHASE == 0 ? 2 : 1); ++rep) {
    if (PH(0)) p0_prologue(F);
    GRID_BAR(); }
    STAGE_END(1);
    if (PH(1)) { pg8::DenseSched S; S.init(wsp<bf16>(F, WS_XNB), wsp<bf16>(F, WS_WIN), T, NPROJ, DM, F.G, (int)blockIdx.x);
      float* RC = wsp<float>(F, WS_ROPE);
      EpiInProj E{wsp<bf16>(F, WS_Q), RC, RC + SEQ * 32, wsp<float>(F, WS_KMEAN)};
      for (int rep = 0; rep < (DUP_PHASE == 1 ? 2 : 1); ++rep) { if (rep) GRID_BAR();
      pg8::gemm_phase<EpiInProj, pg8::DenseSched, false, false>(F.lds + RING_OFF, DM * 2, S, E); } }
    GRID_BAR();
    STAGE_END(2);
    for (int rep = 0; rep < (DUP_PHASE == 2 ? 2 : 1); ++rep) {
    if (PH(2)) p2_mixers(F);
    GRID_BAR(); }
    STAGE_END(3);
    if (PH(3)) { pg8::DenseSched S; S.init(wsp<bf16>(F, WS_MIX), wsp<bf16>(F, WS_WOUT), T, DM, DM, F.G, (int)blockIdx.x);
      LAS f32x4* rtab = (LAS f32x4*)(F.lds + XTAB_OFF);
      Unit ua, ub; const bool ha = S.next(0, ua), hb = S.next(1, ub);
      { PHASE_IDS; const int s = TID_ >> 8, r = TID_ & 255; const bool has = s ? hb : ha; const int pm = s ? ub.pm : ua.pm;
        if (has) { const size_t row = (size_t)pm * 256 + r; const f32x4* pa = (const f32x4*)(wsp<float>(F, WS_SSQA) + row * NH); const f32x4 a0 = pa[0], a1 = pa[1], g0 = *(const f32x4*)(wsp<float>(F, WS_SSQG) + row * GG);
            const float sa = ((a0[0] + a0[1]) + (a0[2] + a0[3])) + ((a1[0] + a1[1]) + (a1[2] + a1[3])), sg = (g0[0] + g0[1]) + (g0[2] + g0[3]);
            const float ra = 1.0f / sqrtf(sa * (1.f / AW) + EPS), rg = 1.0f / sqrtf(sg * (1.f / GW) + EPS);
            rtab[s * 256 + r] = (f32x4){ra / rg, rg, wsp<float>(F, WS_SIG0)[row], 0.f}; } }
      __syncthreads();
      EpiOutProj E{wsp<bf16>(F, WS_XNB), wsp<bf16>(F, WS_X1B), wsp<unsigned char>(F, WS_X1F8), wsp<float>(F, WS_SSQ1), rtab, F.ffn_norm, ha ? ua.pm : -1, hb ? ub.pm : -1};
      for (int rep = 0; rep < (DUP_PHASE == 3 ? 2 : 1); ++rep) { if (rep) GRID_BAR();
      pg8::gemm_phase<EpiOutProj, pg8::DenseSched, false, true>(F.lds + RING_OFF, DM * 2, S, E); } }
    GRID_BAR();
    STAGE_END(4);
    if (PH(4)) p4_router(F);
    GRID_BAR();
    STAGE_END(5);
    if (PH(5)) { const int nu = moe_build_tables(F, 2 * FF / 256, 1);
      pg8::MoeSched S{(const char*)wsp<char>(F, WS_X1F8), (const char*)wsp<char>(F, WS_WGU), 0, (size_t)2 * FF * DM, (size_t)256 * DM, nu,
                      (const LAS unsigned*)(F.lds + XTAB_OFF + XT_ULIST), (const LAS unsigned*)(F.lds + XTAB_OFF + XT_GTAB), true};
      EpiMoe1 E{wsp<unsigned char>(F, WS_ABUF), F.b_gu, (const LAS float*)(F.lds + XTAB_OFF + XT_RS)};
      for (int rep = 0; rep < (DUP_PHASE == 5 ? 2 : 1); ++rep) { if (rep) GRID_BAR();
      int Kb = DM; asm volatile("" : "+s"(Kb));
      pg8::gemm_phase<EpiMoe1, pg8::MoeSched, true, false, true>(F.lds + RING_OFF, Kb, S, E); } }
    GRID_BAR();
    STAGE_END(6);
    if (PH(6)) { const int nu = moe_build_tables(F, DM / 256, 2);
      pg8::MoeSched S{(const char*)wsp<char>(F, WS_ABUF), (const char*)wsp<char>(F, WS_WDN), (size_t)256 * FF, (size_t)DM * FF, (size_t)256 * FF, nu,
                      (const LAS unsigned*)(F.lds + XTAB_OFF + XT_ULIST), (const LAS unsigned*)(F.lds + XTAB_OFF + XT_GTAB), false};
      EpiMoe2 E{wsp<unsigned char>(F, WS_YBUF), F.b_dn, (const LAS float*)(F.lds + XTAB_OFF + XT_RS)};
      for (int rep = 0; rep < (DUP_PHASE == 6 ? 2 : 1); ++rep) { if (rep) GRID_BAR();
      int Kb = FF; asm volatile("" : "+s"(Kb));
      pg8::gemm_phase<EpiMoe2, pg8::MoeSched, false, false, true>(F.lds + RING_OFF, Kb, S, E); } }
    GRID_BAR();
    STAGE_END(7);
    if (PH(7)) { const int first = (blockIdx.x >> 3) & 1;
#pragma unroll 1
      for (int step = 0; step < 2; ++step) {
          if ((step ^ first) == 0) { p7_combine(F); __syncthreads(); }
          else { pg8::DenseSched S; S.init(wsp<bf16>(F, WS_PB), wsp<bf16>(F, WS_WPP), T, DM, PLE, F.G, (int)blockIdx.x);
              EpiPle<1> E{wsp<unsigned char>(F, WS_PP), wsp<float>(F, WS_SSQPP), nullptr, -1};
              int Kp = PLE * 2; asm volatile("" : "+s"(Kp));
              pg8::gemm_phase<EpiPle<1>, pg8::DenseSched, false, false>(F.lds + RING_OFF, Kp, S, E); } } }
    GRID_BAR();
    STAGE_END(8);
    if (PH(8)) { pg8::DenseSched S; S.init(wsp<unsigned char>(F, WS_X2F8), wsp<unsigned char>(F, WS_WPG8), T, DM, DM, F.G, (int)blockIdx.x, 1);
      LAS float* rt2 = (LAS float*)(F.lds + XTAB_OFF); Unit ua, ub; const bool ha = S.next(0, ua), hb = S.next(1, ub);
      { PHASE_IDS; const int sl = TID_ >> 8, r = TID_ & 255; const bool has = sl ? hb : ha; const int pm = sl ? ub.pm : ua.pm; if (has) rt2[sl * 256 + r] = wsp<float>(F, WS_RSTD2)[(size_t)pm * 256 + r]; }
      __syncthreads();
      EpiPle<0> E{wsp<unsigned char>(F, WS_GATE), nullptr, rt2, ha ? ua.pm : -1};
      int Kb = DM; asm volatile("" : "+s"(Kb));
      pg8::gemm_phase<EpiPle<0>, pg8::DenseSched, false, false, true>(F.lds + RING_OFF, Kb, S, E);
#if CHECK_STAGE
      GRID_BAR();
      int Kb = DM; asm volatile("" : "+s"(Kb));
      pg8::gemm_phase<EpiPle<0>, pg8::DenseSched, false, false, true>(F.lds + RING_OFF, Kb, S, E);
#endif
    }
#if CHECK_STAGE
    GRID_BAR(); STAGE_CHECK(9);
#endif
    GRID_BAR();
    STAGE_END(9);
#if CHECK_STAGE
    GRID_BAR(); check_report(F);
#else
    if (PH(9)) p9_final(F);
#if TPROBE
    GRID_BAR();
    if (blockIdx.x == 0 && threadIdx.x == 0) { const unsigned long long* ts = (const unsigned long long*)(F.ctl + CW_TS); const unsigned long long t1 = (TP_A == 9) ? __builtin_amdgcn_s_memrealtime() : ts[(TP_A < 10 ? TP_A : 0) + 1];
        unsigned long long d = t1 - ts[TP_A < 10 ? TP_A : 0];
        if (TP_A == 20) d = ts[11] - ts[0]; if (TP_A == 21) d = ts[12] - ts[11]; if (TP_A == 22) d = ts[13] - ts[12]; if (TP_A == 23) d = ts[1] - ts[13]; if (TP_A == 24) d = ts[14] - ts[2]; if (TP_A == 25) d = ts[3] - ts[14];
        if (TP_A == 30) d = (__builtin_amdgcn_s_memrealtime() - ts[0]) / 8;
        F.out[0] += floorf((float)d * 0.01f * 0.125f + 0.5f) * 2.0f; }
#endif
#endif
    __syncthreads();
    if (threadIdx.x == 0) {
        if (xb_add(&g_gridbar[XB_DONE], 1u) == gridDim.x - 1u) {
#pragma unroll 1
            for (unsigned j = 0; j < 16; ++j) { __hip_atomic_store(&g_gridbar[XB_XCNT(j)], 0u, __ATOMIC_RELAXED, __HIP_MEMORY_SCOPE_AGENT); __hip_atomic_store(&g_gridbar[XB_XSUB(j)], 0u, __ATOMIC_RELAXED, __HIP_MEMORY_SCOPE_AGENT);
                __hip_atomic_store(&g_gridbar[XB_XGEN(j)], 0u, __ATOMIC_RELAXED, __HIP_MEMORY_SCOPE_AGENT); }
            __hip_atomic_store(&g_gridbar[XB_TOP], 0u, __ATOMIC_RELAXED, __HIP_MEMORY_SCOPE_AGENT); __hip_atomic_store(&g_gridbar[XB_TOPGEN], 0u, __ATOMIC_RELAXED, __HIP_MEMORY_SCOPE_AGENT);
            __hip_atomic_store(&g_gridbar[XB_TMO], 0u, __ATOMIC_RELAXED, __HIP_MEMORY_SCOPE_AGENT); __hip_atomic_store(&g_gridbar[XB_DONE], 0u, __ATOMIC_RELAXED, __HIP_MEMORY_SCOPE_AGENT); } }
}

extern "C" void kernel_launch(void* const* d_in, const int* in_sizes, int n_in, void* d_out, int out_size, void* d_ws, size_t ws_size, hipStream_t stream) {
    static int grid = 0;
    if (grid == 0) {
        if (n_in != 23 || in_sizes[0] != T * DM || out_size != T * DM || ws_size < WS_END) { fprintf(stderr, "kernel_launch: unexpected shapes (n_in %d, in0 %d, out %d, ws %zu)\n", n_in, n_in > 0 ? in_sizes[0] : -1, out_size, ws_size); grid = -1; return; }
        int dev = 0, cus = 0, per_cu = 0;
        if (hipGetDevice(&dev) != hipSuccess || hipDeviceGetAttribute(&cus, hipDeviceAttributeMultiprocessorCount, dev) != hipSuccess) { grid = -1; return; }
        if (hipFuncSetAttribute((const void*)mega_fwd, hipFuncAttributeMaxDynamicSharedMemorySize, LDS_BYTES) != hipSuccess) { fprintf(stderr, "kernel_launch: hipFuncSetAttribute failed\n"); grid = -1; return; }
        if (hipOccupancyMaxActiveBlocksPerMultiprocessor(&per_cu, (const void*)mega_fwd, NTHR, LDS_BYTES) != hipSuccess || per_cu < 1)
            fprintf(stderr, "kernel_launch: note: occupancy query reports %d workgroups per CU\n", per_cu);
        (void)hipGetLastError();
        if (cus < 256) { fprintf(stderr, "kernel_launch: built for a 256-CU device (found %d CUs); nothing launched\n", cus); grid = -1; return; }
        grid = 256;
    }
    if (grid < 0) return;
    Args a{};
    for (int i = 0; i < 23; ++i) a.in[i] = (const float*)d_in[i];
    a.out = (float*)d_out; a.ws = (unsigned char*)d_ws;
    hipLaunchKernelGGL(mega_fwd, dim3(grid), dim3(NTHR), LDS_BYTES, stream, a);
}
```

```cpp
#include <hip/hip_runtime.h>
#include <cstdio>
#include <cstdint>

#ifndef CHECK_STAGE
#define CHECK_STAGE 0
#endif
#ifndef CHECK_REPORT
#define CHECK_REPORT 0
#endif
#ifndef CHECK_REPORT2
#define CHECK_REPORT2 0
#endif
#ifndef CHECK_REPORT3
#define CHECK_REPORT3 0
#endif
#ifndef DUP_PHASE
#define DUP_PHASE -1
#endif
#ifndef TPROBE
#define TPROBE 0
#endif
#ifndef TP_A
#define TP_A 5
#endif
#ifndef TP_B
#define TP_B 6
#endif
#ifndef CHECK_SKIP
#define CHECK_SKIP 0
#endif
#ifndef PHMASK
#define PHMASK 0x3ff
#endif
#define PH(n) ((PHMASK >> (n)) & 1)

#define GAS __attribute__((address_space(1)))
#define LAS __attribute__((address_space(3)))
typedef unsigned short bf16;
typedef unsigned v4u __attribute__((ext_vector_type(4)));
typedef unsigned v2u __attribute__((ext_vector_type(2)));
typedef float f32x2 __attribute__((ext_vector_type(2)));
typedef float f32x4 __attribute__((ext_vector_type(4)));
typedef float f32x16 __attribute__((ext_vector_type(16)));
typedef short bf16x8 __attribute__((ext_vector_type(8)));
typedef short s16x4 __attribute__((ext_vector_type(4)));
typedef GAS unsigned gu32;

constexpr int BATCH = 16, SEQ = 2048, DM = 1024, T = BATCH * SEQ;
constexpr int AW = 512, NH = 8, HD = 64, NBLK = 8, MOBA = 256;
constexpr int GW = 512, GG = 4, GD = 128, GC = 128;
constexpr int NPROJ = 3 * AW + 2 * GW;
constexpr int NE = 32, TOPK = 4, FF = 1024;
constexpr int PLE = 256;
constexpr int MAXROWS = T * TOPK + NE * 256;
constexpr float EPS = 1e-6f;
constexpr int NWAVES = 8, NTHR = 512;

constexpr size_t MiB = 1u << 20;
constexpr size_t WS_CTL = 0, CTL_ZERO_BYTES = 1 * MiB;
constexpr size_t WS_KMEAN = 256 * 1024;
constexpr size_t WS_WIN = 1 * MiB;
constexpr size_t WS_WOUT = 6 * MiB;
constexpr size_t WS_WPG = 8 * MiB;
constexpr size_t WS_WPP = 10 * MiB;
constexpr size_t WS_RWG = 10 * MiB + 512 * 1024;
constexpr size_t WS_ROPE = 11 * MiB;
constexpr size_t WS_WGU = 16 * MiB;
constexpr size_t WS_WDN = 144 * MiB;
constexpr size_t WS_XNB = 208 * MiB;
constexpr size_t WS_BIG1 = 272 * MiB;
constexpr size_t WS_Q = WS_BIG1, WS_K = WS_Q + 32 * MiB, WS_V = WS_K + 32 * MiB, WS_U = WS_V + 32 * MiB, WS_VG = WS_U + 32 * MiB, WS_MIX = WS_VG + 32 * MiB;
constexpr size_t WS_YBUF = WS_BIG1;
constexpr size_t WS_BIG2 = 544 * MiB;
constexpr size_t WS_ABUF = WS_BIG2, WS_GATE = WS_BIG2, WS_PP = WS_BIG2 + 64 * MiB;
constexpr size_t WS_PB = 816 * MiB;
constexpr size_t WS_IDX = 832 * MiB;
constexpr size_t WS_GSS = 836 * MiB;
constexpr size_t WS_TOKPOS = 840 * MiB;
constexpr size_t WS_SSQA = 841 * MiB;
constexpr size_t WS_SSQG = 842 * MiB;
constexpr size_t WS_SSQ1 = 843 * MiB;
constexpr size_t WS_SSQPP = 845 * MiB;
constexpr size_t WS_X1F8 = 848 * MiB;
constexpr size_t WS_X2N = WS_XNB;
constexpr size_t WS_X1B = 880 * MiB;
constexpr size_t WS_X2B = 944 * MiB;
constexpr size_t WS_SIG0 = 1008 * MiB;
constexpr size_t WS_RSTD2 = 1008 * MiB + 256 * 1024;
constexpr size_t WS_RWT = 1008 * MiB + 512 * 1024;
constexpr size_t WS_RSS = 1009 * MiB;
constexpr size_t WS_X2F8 = 176 * MiB;
constexpr size_t WS_WPG8 = 80 * MiB;
constexpr size_t WS_END = 1013 * MiB;
static_assert(WS_MIX + 64 * MiB <= WS_BIG2 && (size_t)MAXROWS * 1024 * 2 <= 272 * MiB, "ws map");
constexpr int CW_TMO = 0, CW_CODE = 1;
constexpr int CW_BAR = 4096;
constexpr int CW_CNT = 8192, CNT_STRIDE = 32;
constexpr int CW_TS = 12000;
constexpr int CW_CHK = 12288;

constexpr int RING_OFF = 0, RING_BYTES = 131072;
constexpr int P0_SCR_WAVE = 64 * 65 * 4;
constexpr int LDS_BYTES_TOTAL = 163840;
constexpr int LDSCTL_OFF = LDS_BYTES_TOTAL - 1024;
constexpr int XTAB_OFF = RING_BYTES;
static_assert(8 * P0_SCR_WAVE <= LDSCTL_OFF && XTAB_OFF >= RING_BYTES, "lds map");
constexpr int LDS_BYTES = LDS_BYTES_TOTAL;

#define RLX_AGENT __ATOMIC_RELAXED, __HIP_MEMORY_SCOPE_AGENT
#define LDS_WAIT() asm volatile("s_waitcnt lgkmcnt(0)" ::: "memory")
#define VM_WAIT() asm volatile("s_waitcnt vmcnt(0)" ::: "memory")
__device__ __forceinline__ unsigned f2bf(float f) { unsigned u = __builtin_bit_cast(unsigned, f); return (u + 0x7fffu + ((u >> 16) & 1u)) >> 16; }
__device__ __forceinline__ unsigned pk2(float lo, float hi) { return f2bf(lo) | (f2bf(hi) << 16); }
__device__ __forceinline__ float bf2f(unsigned short b) { return __builtin_bit_cast(float, ((unsigned)b) << 16); }
__device__ __forceinline__ float bflo(unsigned w) { return __builtin_bit_cast(float, w << 16); }
__device__ __forceinline__ float bfhi(unsigned w) { return __builtin_bit_cast(float, w & 0xffff0000u); }
typedef __bf16 bf16x2_t __attribute__((ext_vector_type(2)));
__device__ __forceinline__ unsigned cvt_pk_bf16(float lo, float hi) { const f32x2 v = {lo, hi}; const bf16x2_t b = __builtin_convertvector(v, bf16x2_t); return __builtin_bit_cast(unsigned, b); }
__device__ __forceinline__ float clamp448(float x) { return fminf(fmaxf(x, -448.0f), 448.0f); }
__device__ __forceinline__ unsigned pk4_fp8(float a, float b, float c, float d) { unsigned w = 0u; w = (unsigned)__builtin_amdgcn_cvt_pk_fp8_f32(clamp448(a), clamp448(b), (int)w, false); w = (unsigned)__builtin_amdgcn_cvt_pk_fp8_f32(clamp448(c), clamp448(d), (int)w, true); return w; }
__device__ __forceinline__ unsigned pk4_fp8_nc(float a, float b, float c, float d) { unsigned w = 0u; w = (unsigned)__builtin_amdgcn_cvt_pk_fp8_f32(a, b, (int)w, false); w = (unsigned)__builtin_amdgcn_cvt_pk_fp8_f32(c, d, (int)w, true); return w; }
__device__ __forceinline__ float fp8_to_f(unsigned v) { const unsigned sg = (v >> 7) & 1u, e = (v >> 3) & 15u, m = v & 7u; const float r = e ? ldexpf(1.0f + (float)m * 0.125f, (int)e - 7) : ldexpf((float)m * 0.125f, -6); return sg ? -r : r; }
__device__ __forceinline__ float wave_sum(float v) {
#pragma unroll
    for (int o = 1; o < 64; o <<= 1) v += __shfl_xor(v, o);
    return v;
}
__device__ __forceinline__ f32x2 gelu_pk(f32x2 v) {
    const f32x2 av = __builtin_elementwise_abs(v), d = av * 0.2316418882f + 1.0f;
    f32x2 t; t.x = __builtin_amdgcn_rcpf(d.x); t.y = __builtin_amdgcn_rcpf(d.y);
    f32x2 q = t * 0.5307027145f + (-0.7265760135f); q = q * t + 0.7107068705f; q = q * t + (-0.142248368f); q = q * t + 0.127414796f; q = q * t;
    const f32x2 s = (v * v) * (-0.72134752044f);
    f32x2 e; e.x = __builtin_amdgcn_exp2f(s.x); e.y = __builtin_amdgcn_exp2f(s.y);
    const f32x2 m = v * (q * e), r = v - m;
    f32x2 o; o.x = v.x < 0.f ? m.x : r.x; o.y = v.y < 0.f ? m.y : r.y; return o;
}
__device__ __forceinline__ f32x4 gelu4(f32x4 v) { const f32x2 a = gelu_pk((f32x2){v[0], v[1]}), b = gelu_pk((f32x2){v[2], v[3]}); return (f32x4){a.x, a.y, b.x, b.y}; }
__device__ __forceinline__ float sigmoidf_fast(float x) { return __builtin_amdgcn_rcpf(1.0f + __builtin_amdgcn_exp2f(-1.4426950408889634f * x)); }

#define XB_TMO      128
#define XB_XCNT(j)  (256  + 64 * (j))
#define XB_XSUB(j)  (1280 + 64 * (j))
#define XB_XGEN(j)  (2304 + 64 * (j))
#define XB_TOP      3328
#define XB_TOPGEN   3392
#define XCD_BAR_WORDS 3456
#define XB_SPIN_CAP (1u << 18)
__device__ __forceinline__ unsigned xb_ld(unsigned* p)              { return __hip_atomic_load(p, __ATOMIC_RELAXED, __HIP_MEMORY_SCOPE_AGENT); }
__device__ __forceinline__ unsigned xb_add(unsigned* p, unsigned v) { return __hip_atomic_fetch_add(p, v, __ATOMIC_RELAXED, __HIP_MEMORY_SCOPE_AGENT); }
__device__ __forceinline__ unsigned xb_xcc_id() { return (unsigned)__builtin_amdgcn_s_getreg((3 << 11) | 20) & 0xFu; }
#define XB_SPIN(cond, bar) do { unsigned _sp = 0; while (cond) { __builtin_amdgcn_s_sleep(1); \
    if ((++_sp & 255u) == 0u) { if (xb_ld(&(bar)[XB_TMO])) break; if (_sp > XB_SPIN_CAP) { atomicAdd(&(bar)[XB_TMO], 1u); break; } } } } while (0)
#define XB_DONE     64
__device__ unsigned g_gridbar[4096];
struct XcdBarrier { unsigned* bar; unsigned x; volatile LAS unsigned* st; };
__device__ __forceinline__ XcdBarrier xcd_barrier_post(unsigned* bar, volatile LAS unsigned* st) {
    XcdBarrier b; b.bar = bar; b.x = xb_xcc_id(); b.st = st;
    if (threadIdx.x == 0) (void)xb_add(&bar[XB_XCNT(b.x)], 1u);
    return b;
}
__device__ __forceinline__ void xcd_barrier_complete(unsigned* bar, unsigned x, unsigned& nloc, unsigned& nx) {
    const unsigned G = gridDim.x * gridDim.y * gridDim.z;
    unsigned sum, cnt, mine, sp = 0u;
    for (;;) {
        sum = 0u; cnt = 0u; mine = 0u;
#pragma unroll
        for (unsigned j = 0; j < 16; ++j) { const unsigned c = xb_ld(&bar[XB_XCNT(j)]); sum += c; cnt += (c > 0u) ? 1u : 0u; mine = (j == x) ? c : mine; }
        if (sum == G) break;
        __builtin_amdgcn_s_sleep(1);
        if ((++sp & 255u) == 0u) { if (xb_ld(&bar[XB_TMO])) break; if (sp > XB_SPIN_CAP) { atomicAdd(&bar[XB_TMO], 1u); break; } }
    }
    nloc = mine > 0u ? mine : 1u; nx = cnt > 0u ? cnt : 1u;
}
__device__ __forceinline__ void xcd_barrier(const XcdBarrier& b) {
    asm volatile("s_waitcnt vmcnt(0)" ::: "memory");
    __syncthreads();
    if (threadIdx.x == 0) {
        unsigned* bar = b.bar;
        __builtin_amdgcn_s_waitcnt(0);
        unsigned nloc = b.st[0], nx = b.st[1];
        if (nloc == 0u) { xcd_barrier_complete(bar, b.x, nloc, nx); b.st[0] = nloc; b.st[1] = nx; }
        const unsigned old = xb_add(&bar[XB_XSUB(b.x)], 1u);
        const unsigned gen = old / nloc;
        if (old + 1u == (gen + 1u) * nloc) {
            __builtin_amdgcn_fence(__ATOMIC_RELEASE, "agent");
            asm volatile("s_waitcnt vmcnt(0)" ::: "memory");
            const unsigned og = xb_add(&bar[XB_TOP], 1u);
            const unsigned tg = og / nx;
            if (og + 1u == (tg + 1u) * nx) xb_add(&bar[XB_TOPGEN], 1u);
            else XB_SPIN(xb_ld(&bar[XB_TOPGEN]) == tg, bar);
            __builtin_amdgcn_fence(__ATOMIC_ACQUIRE, "agent");
            xb_add(&bar[XB_XGEN(b.x)], 1u);
            asm volatile("s_waitcnt vmcnt(0)" ::: "memory");
        } else {
            XB_SPIN(xb_ld(&bar[XB_XGEN(b.x)]) == gen, bar);
            __builtin_amdgcn_fence(__ATOMIC_ACQUIRE, "agent");
            asm volatile("s_waitcnt vmcnt(0)" ::: "memory");
        }
    }
    __syncthreads();
}

namespace pg8 {
constexpr int BM = 256, BK = 64, HALF = 128, HTB = HALF * BK * 2, STAGE_BYTES = 8 * HTB, NXCD = 8, WGM = 8;
__host__ __device__ __forceinline__ int lds_byte(int r, int c) { const int st = (r >> 4) * 2 + (c >> 5), rr = r & 15, cc = c & 31, ob = rr * 64 + cc * 2; return st * 1024 + (ob ^ (((ob >> 9) & 1) << 5)); }
__host__ __device__ __forceinline__ void stage_rc(int b, int& R, int& C) { const int st = b / 1024, sb = b % 1024, swz = sb ^ (((sb >> 9) & 1) << 5); R = (st >> 1) * 16 + swz / 64; C = (st & 1) * 32 + (swz % 64) / 2; }
__host__ __device__ __forceinline__ int perm32(int rho) { const int n = rho >> 4, i = rho & 15; return 8 * (i >> 2) + 4 * n + (i & 3); }

typedef int v8i __attribute__((ext_vector_type(8)));
constexpr int F8_WSHIFT = 6, F8_SCALE_W = 127 - F8_WSHIFT;
typedef int v4i __attribute__((ext_vector_type(4)));
__device__ __forceinline__ v8i ld8(const LAS unsigned char* p0, const LAS unsigned char* p1) { const v4i lo = *(const LAS v4i*)p0, hi = *(const LAS v4i*)p1; return __builtin_shufflevector(lo, hi, 0, 1, 2, 3, 4, 5, 6, 7); }
struct Unit { int pm, pn, e, rt, slot; };

__device__ __forceinline__ void flat_to_tile(int L, int nwg, int nM, int nN, int& pm, int& pn) {
    int wgid = L; { const int q = nwg / NXCD, r = nwg % NXCD, xcd = wgid % NXCD, off = wgid / NXCD; wgid = (xcd < r ? xcd * (q + 1) : r * (q + 1) + (xcd - r) * q) + off; }
    const int nig = WGM * nN, gid = wgid / nig, fm = gid * WGM, gsz = (nM - fm) < WGM ? (nM - fm) : WGM;
    pm = fm + ((wgid % nig) % gsz); pn = (wgid % nig) / gsz;
}
struct DenseSched {
    const char* A; const char* Bt; int nM, nN, nwg, G, c; size_t tstep;
    __device__ __forceinline__ void init(const void* A_, const void* Bt_, int M, int N, int K, int G_, int c_, int ebytes = 2) { A = (const char*)A_; Bt = (const char*)Bt_; nM = M / BM; nN = N / BM; nwg = nM * nN; G = G_; c = c_; tstep = (size_t)BM * K * ebytes; }
    __device__ __forceinline__ bool next(int i, Unit& u) const { const long L = (long)i * G + c; if (L >= nwg) return false; flat_to_tile((int)L, nwg, nM, nN, u.pm, u.pn); u.e = 0; u.rt = u.pm; u.slot = i; return true; }
    __device__ __forceinline__ const char* a_base(const Unit& u) const { return A + (size_t)u.pm * tstep; }
    __device__ __forceinline__ const char* b_base(const Unit& u) const { return Bt + (size_t)u.pn * tstep; }
    __device__ __forceinline__ void gather(int, int, int, unsigned (&)[2][2]) const {}
};
struct MoeSched {
    const char* A; const char* Bt; size_t a_tstep, b_estep, b_tstep; int nunits; const LAS unsigned* ulist; const LAS unsigned* gtab; bool gath;
    __device__ __forceinline__ bool next(int i, Unit& u) const {
        if (i >= nunits) return false;
        const unsigned w = (unsigned)__builtin_amdgcn_readfirstlane((int)ulist[i]);
        u.pm = (int)(w & 0x3ffu); u.pn = (int)((w >> 10) & 0x7u); u.e = (int)((w >> 13) & 0x1fu); u.rt = (int)(w >> 18); u.slot = i; return true;
    }
    __device__ __forceinline__ const char* a_base(const Unit& u) const { return gath ? A : A + (size_t)u.pm * a_tstep; }
    __device__ __forceinline__ const char* b_base(const Unit& u) const { return Bt + (size_t)u.e * b_estep + (size_t)u.pn * b_tstep; }
    __device__ __forceinline__ void gather(int i, int R0, int R1, unsigned (&off)[2][2]) const {
        const LAS unsigned short* g = (const LAS unsigned short*)gtab + i * 256;
        off[0][0] = (unsigned)g[R0] << 10; off[0][1] = (unsigned)g[R1] << 10; off[1][0] = (unsigned)g[128 + R0] << 10; off[1][1] = (unsigned)g[128 + R1] << 10;
    }
};

#define PG8_SA(b, h) (((b) * 2 + (h)) * HTB)
#define PG8_SB(b, h) ((4 + (b) * 2 + (h)) * HTB)
#define PG8_GLDS(src, dstoff) __builtin_amdgcn_global_load_lds((const unsigned*)(src), (LAS unsigned*)(lds + (dstoff)), 16, 0, 0)
#define PG8_STAGE_B(bufoff, gbase) do { _Pragma("unroll") for (int _i = 0; _i < 2; ++_i) PG8_GLDS((const char*)(gbase) + voffB[_i], (bufoff) + ldsw + _i * 8192); } while (0)
#define PG8_STAGE_A(bufoff, kptr, h, o) do { _Pragma("unroll") for (int _i = 0; _i < 2; ++_i) \
        PG8_GLDS(GATHER ? (const char*)(kptr) + (o)[h][_i] : (const char*)(kptr) + (size_t)(h) * hstep + voffA[_i], (bufoff) + ldsw + _i * 8192); } while (0)
#define PG8_LDA(dst, b, h) do { _Pragma("unroll") for (int m = 0; m < 4; ++m) { if constexpr (F8) dst##8[m] = ld8(lds + PG8_SA(b, h) + a8_0 + m * 2048, lds + PG8_SA(b, h) + a8_1 + m * 2048); \
        else { _Pragma("unroll") for (int k = 0; k < 2; ++k) dst[m][k] = *(const LAS bf16x8*)(lds + PG8_SA(b, h) + aoff + m * 2048 + k * 1024); } } } while (0)
#define PG8_LDB(dst, b, h) do { _Pragma("unroll") for (int n = 0; n < 2; ++n) { if constexpr (F8) dst##8[n] = ld8(lds + PG8_SB(b, h) + b8_0 + n * 2048, lds + PG8_SB(b, h) + b8_1 + n * 2048); \
        else { _Pragma("unroll") for (int k = 0; k < 2; ++k) dst[n][k] = *(const LAS bf16x8*)(lds + PG8_SB(b, h) + boff + n * 2048 + k * 1024); } } } while (0)
#define PG8_MMA(ai, bj, At, Bt) do { __builtin_amdgcn_s_setprio(1); _Pragma("unroll") for (int m = 0; m < 4; ++m) _Pragma("unroll") for (int n = 0; n < 2; ++n) { \
        if constexpr (F8) asm volatile("v_mfma_scale_f32_16x16x128_f8f6f4 %0, %1, %2, %0, %3, %4 op_sel_hi:[0,0,0]" : "+v"(acc[ai][bj][m][n]) : "v"(Bt##8[n]), "v"(At##8[m]), "v"(sc_w), "v"(sc_a)); \
        else { _Pragma("unroll") for (int k = 0; k < 2; ++k) acc[ai][bj][m][n] = __builtin_amdgcn_mfma_f32_16x16x32_bf16(Bt[n][k], At[m][k], acc[ai][bj][m][n], 0, 0, 0); } } __builtin_amdgcn_s_setprio(0); } while (0)
#define PG8_WAIT_V(n) asm volatile("s_waitcnt vmcnt(" #n ")" ::: "memory")
#define PG8_WAIT_L(n) asm volatile("s_waitcnt lgkmcnt(" #n ")" ::: "memory")
#define PG8_BAR __builtin_amdgcn_s_barrier()
#define PG8_SCHED __builtin_amdgcn_sched_barrier(0)

template <class Epi, class Sched, bool GATHER, bool MIDK, bool F8 = false>
__device__ __forceinline__ void gemm_phase(LAS unsigned char* lds, const int KB  , const Sched& S, const Epi& E) {
    int tid = (int)threadIdx.x; asm volatile("" : "+v"(tid));
    const int wid = __builtin_amdgcn_readfirstlane(tid >> 6), lane = tid & 63, wr = wid >> 2, wc = wid & 3, fr = lane & 15, fq = lane >> 4;
    const int nt = KB / 128;
    unsigned voffA[2], voffB[2]; int Rg[2]; unsigned Cg[2];
#pragma unroll
    for (int i = 0; i < 2; ++i) { int R, C; stage_rc(tid * 16 + i * 8192, R, C); const int Rb = Epi::PERM ? ((R & ~31) + perm32(R & 31)) : R;
        voffA[i] = (unsigned)(R * KB + C * 2); voffB[i] = (unsigned)(Rb * KB + C * 2); Rg[i] = R; Cg[i] = (unsigned)C * 2u; }
    const size_t kstep = 128;
    const size_t hstep = (size_t)HALF * KB;
    const unsigned ldsw = (unsigned)wid * 1024u;
    const int aoff = lds_byte(wr * 64 + fr, fq * 8), boff = lds_byte(wc * 32 + fr, fq * 8);
    const int a8_0 = aoff, a8_1 = aoff + 1024, b8_0 = boff, b8_1 = boff + 1024;
    Unit cur, nxt; int ui = 0;
    if (!S.next(0, cur)) return;
    f32x4 acc[2][2][4][2];
#pragma unroll
    for (int a = 0; a < 2; ++a)
#pragma unroll
        for (int b = 0; b < 2; ++b)
#pragma unroll
            for (int m = 0; m < 4; ++m)
#pragma unroll
                for (int n = 0; n < 2; ++n) acc[a][b][m][n] = (f32x4){0.f, 0.f, 0.f, 0.f};
    bf16x8 At[4][2], B0[2][2], B1[2][2]; v8i At8[4], B08[2], B18[2];
    int sc_w = F8_SCALE_W, sc_a = 127; if constexpr (F8) { asm volatile("" : "+v"(sc_w), "+v"(sc_a)); }
    unsigned offC[2][2] = {{0u, 0u}, {0u, 0u}}, offN[2][2] = {{0u, 0u}, {0u, 0u}};
    if constexpr (GATHER) { S.gather(0, Rg[0], Rg[1], offC);
#pragma unroll
        for (int h = 0; h < 2; ++h)
#pragma unroll
            for (int i = 0; i < 2; ++i) offC[h][i] += Cg[i]; }
    const char* cA = S.a_base(cur); const char* cB = S.b_base(cur);
    PG8_STAGE_B(PG8_SB(0, 0), cB); PG8_STAGE_B(PG8_SB(0, 1), cB + hstep); PG8_STAGE_A(PG8_SA(0, 0), cA, 0, offC); PG8_STAGE_A(PG8_SA(0, 1), cA, 1, offC);
    if (wr == 1) PG8_BAR;
    PG8_WAIT_V(2); PG8_BAR;
    PG8_STAGE_B(PG8_SB(1, 0), cB + kstep); PG8_STAGE_A(PG8_SA(1, 0), cA + kstep, 0, offC); PG8_STAGE_B(PG8_SB(1, 1), cB + hstep + kstep);
    PG8_WAIT_V(6); PG8_BAR;
    for (;;) {
        const bool has_next = S.next(ui + 1, nxt);
        const char* nA = has_next ? S.a_base(nxt) : cA; const char* nB = has_next ? S.b_base(nxt) : cB;
        if constexpr (GATHER) { if (has_next) { S.gather(ui + 1, Rg[0], Rg[1], offN);
#pragma unroll
                for (int h = 0; h < 2; ++h)
#pragma unroll
                    for (int i = 0; i < 2; ++i) offN[h][i] += Cg[i]; }
            else {
#pragma unroll
                for (int h = 0; h < 2; ++h)
#pragma unroll
                    for (int i = 0; i < 2; ++i) offN[h][i] = offC[h][i]; } }
        for (int t = 0; t < nt; t += 2) {
            const bool last = (t == nt - 2);
            const char* a1 = cA + (size_t)(t + 1) * kstep;
            const char* a2 = last ? nA : cA + (size_t)(t + 2) * kstep; const char* b2 = last ? nB : cB + (size_t)(t + 2) * kstep;
            const char* a3 = a2 + kstep; const char* b3 = b2 + kstep;
            unsigned o2[2][2];
#pragma unroll
            for (int h = 0; h < 2; ++h)
#pragma unroll
                for (int i = 0; i < 2; ++i) o2[h][i] = last ? offN[h][i] : offC[h][i];
            if constexpr (MIDK) { if (t == nt / 2) E.midk(acc, cur, wr, fr); }
            PG8_LDB(B0, 0, 0); PG8_LDB(B1, 0, 1); PG8_SCHED; PG8_LDA(At, 0, 0); PG8_STAGE_A(PG8_SA(1, 1), a1, 1, offC);
            PG8_WAIT_V(8); PG8_WAIT_L(0); PG8_BAR; PG8_MMA(0, 0, At, B0); PG8_MMA(0, 1, At, B1); PG8_BAR; PG8_SCHED;
            PG8_LDA(At, 0, 1); PG8_STAGE_B(PG8_SB(0, 0), b2); PG8_STAGE_B(PG8_SB(0, 1), b2 + hstep); PG8_STAGE_A(PG8_SA(0, 0), a2, 0, o2);
            PG8_WAIT_V(8); PG8_WAIT_L(0); PG8_BAR; PG8_MMA(1, 0, At, B0); PG8_MMA(1, 1, At, B1); PG8_BAR; PG8_SCHED;
            PG8_LDB(B0, 1, 0); PG8_LDB(B1, 1, 1); PG8_SCHED; PG8_LDA(At, 1, 0); PG8_STAGE_A(PG8_SA(0, 1), a2, 1, o2);
            PG8_WAIT_V(8); PG8_WAIT_L(0); PG8_BAR; PG8_MMA(0, 0, At, B0); PG8_MMA(0, 1, At, B1); PG8_BAR; PG8_SCHED;
            PG8_LDA(At, 1, 1); PG8_STAGE_B(PG8_SB(1, 0), b3); PG8_STAGE_B(PG8_SB(1, 1), b3 + hstep); PG8_STAGE_A(PG8_SA(1, 0), a3, 0, o2);
            PG8_WAIT_V(8); PG8_WAIT_L(0); PG8_BAR; PG8_MMA(1, 0, At, B0); PG8_MMA(1, 1, At, B1); PG8_BAR; PG8_SCHED;
        }
        if (wr == 0) PG8_BAR;
        if constexpr (F8) asm volatile("s_nop 15\n\ts_nop 15" ::: "memory");
        E(acc, cur, wr, wc, fr, fq);
        if (!has_next) break;
#pragma unroll
        for (int a = 0; a < 2; ++a)
#pragma unroll
            for (int b = 0; b < 2; ++b)
#pragma unroll
                for (int m = 0; m < 4; ++m)
#pragma unroll
                    for (int n = 0; n < 2; ++n) acc[a][b][m][n] = (f32x4){0.f, 0.f, 0.f, 0.f};
        cur = nxt; cA = nA; cB = nB; ++ui;
        if constexpr (GATHER) {
#pragma unroll
            for (int h = 0; h < 2; ++h)
#pragma unroll
                for (int i = 0; i < 2; ++i) offC[h][i] = offN[h][i]; }
        if (wr == 1) PG8_BAR;
    }
    PG8_WAIT_V(0);
    PG8_BAR;
}
}

struct Frame {
    LAS unsigned char* lds;
    volatile LAS unsigned* MISC;
    gu32* ctl;
    unsigned char* ws;
    int vcu, G;
    const float *x, *p, *mix_norm, *w_in, *ln_g, *ln_b, *gws, *gbs, *aon, *gon, *w_out, *ffn_norm, *router_w, *router_b, *w_gu, *b_gu, *w_dn, *b_dn, *ple_norm, *w_pg, *w_pp, *ppn, *final_norm;
    float* out;
};
template <class T_> __device__ __forceinline__ T_* wsp(const Frame& F, size_t off) { return (T_*)(F.ws + off); }

#define PHASE_IDS int TID_ = (int)threadIdx.x; asm volatile("" : "+v"(TID_)); const int LANE_ = TID_ & 63; const int WAVE_ = __builtin_amdgcn_readfirstlane(TID_ >> 6); (void)LANE_; (void)WAVE_
template <class ColMap>
__device__ __forceinline__ void p0_transpose_item(const float* W, int K, int N, bf16* WT, const float* gain, LAS float* scr, int item, int lane, int nphys, const ColMap& cm) {
    const int nblk = nphys / 64, kb = item / nblk, nb = item % nblk, k0 = 64 * kb, n0 = 64 * nb;
    const int srccol = cm(n0 + lane);
    float v_[64]; const float* src = W + (size_t)k0 * N + srccol;
#pragma unroll
    for (int kk = 0; kk < 64; ++kk) v_[kk] = __builtin_nontemporal_load(src + (size_t)kk * N);
    if (gain) {
#pragma unroll
        for (int kk = 0; kk < 64; kk += 4) { const f32x4 g4 = *(const f32x4*)(gain + k0 + kk); v_[kk] *= g4[0]; v_[kk + 1] *= g4[1]; v_[kk + 2] *= g4[2]; v_[kk + 3] *= g4[3]; } }
#pragma unroll
    for (int kk = 0; kk < 64; ++kk) scr[kk * 65 + lane] = v_[kk];
    LDS_WAIT(); asm volatile("" ::: "memory");
    const int c = lane & 7;
#pragma unroll
    for (int j = 0; j < 8; ++j) { const int n = (lane >> 3) + 8 * j; const LAS float* s = scr + (8 * c) * 65 + n;
        v4u o; o.x = pk2(s[0 * 65], s[1 * 65]); o.y = pk2(s[2 * 65], s[3 * 65]); o.z = pk2(s[4 * 65], s[5 * 65]); o.w = pk2(s[6 * 65], s[7 * 65]);
        *(GAS v4u*)(WT + (size_t)(n0 + n) * K + k0 + 8 * c) = o; }
    LDS_WAIT(); asm volatile("" ::: "memory");
}
template <class ColMap>
__device__ __forceinline__ void p0_transpose_item_f8(const float* W, int K, int N, unsigned char* WT, const float* gain, LAS float* scr, int item, int lane, int nphys, const ColMap& cm) {
    const int nblk = nphys / 64, kb = item / nblk, nb = item % nblk, k0 = 64 * kb, n0 = 64 * nb;
    const int srccol = cm(n0 + lane);
    float v_[64]; const float* src = W + (size_t)k0 * N + srccol;
#pragma unroll
    for (int kk = 0; kk < 64; ++kk) v_[kk] = __builtin_nontemporal_load(src + (size_t)kk * N);
    constexpr float WS_ = (float)(1 << pg8::F8_WSHIFT);
#pragma unroll
    for (int kk = 0; kk < 64; kk += 4) { f32x4 g4 = gain ? *(const f32x4*)(gain + k0 + kk) : (f32x4){1.f, 1.f, 1.f, 1.f}; v_[kk] *= g4[0] * WS_; v_[kk + 1] *= g4[1] * WS_; v_[kk + 2] *= g4[2] * WS_; v_[kk + 3] *= g4[3] * WS_; }
#pragma unroll
    for (int kk = 0; kk < 64; ++kk) scr[kk * 65 + lane] = v_[kk];
    LDS_WAIT(); asm volatile("" ::: "memory");
    const int c = lane & 3;
#pragma unroll
    for (int j = 0; j < 4; ++j) { const int n = (lane >> 2) + 16 * j; const LAS float* s_ = scr + (16 * c) * 65 + n;
        v4u o; o.x = pk4_fp8(s_[0 * 65], s_[1 * 65], s_[2 * 65], s_[3 * 65]); o.y = pk4_fp8(s_[4 * 65], s_[5 * 65], s_[6 * 65], s_[7 * 65]);
        o.z = pk4_fp8(s_[8 * 65], s_[9 * 65], s_[10 * 65], s_[11 * 65]); o.w = pk4_fp8(s_[12 * 65], s_[13 * 65], s_[14 * 65], s_[15 * 65]);
        *(GAS v4u*)(WT + (size_t)(n0 + n) * K + k0 + 16 * c) = o; }
    LDS_WAIT(); asm volatile("" ::: "memory");
}
struct CmId { __device__ __forceinline__ int operator()(int n) const { return n; } };
struct CmWin { __device__ __forceinline__ int operator()(int n) const { if (n >= 2 * AW) return n; const int c = n & 63; return (n & ~63) + 4 * (c >> 3) + (c & 3) + 32 * ((c >> 2) & 1); } };
struct CmWgu { __device__ __forceinline__ int operator()(int n) const { return ((n >> 7) & 1) * FF + (n >> 8) * 128 + (n & 127); } };

constexpr int XW_I_GU = (DM / 64) * (2 * FF / 64), XW_I_DN = (FF / 64) * (DM / 64), XW_ITEMS = NE * (XW_I_GU + XW_I_DN);
__device__ __forceinline__ void xw_convert_item(const Frame& F, int it, LAS float* scr, int lane) {
    if (it < NE * XW_I_GU) { const int e = it / XW_I_GU; p0_transpose_item_f8(F.w_gu + (size_t)e * DM * 2 * FF, DM, 2 * FF, wsp<unsigned char>(F, WS_WGU) + (size_t)e * 2 * FF * DM, F.ffn_norm, scr, it % XW_I_GU, lane, 2 * FF, CmWgu()); }
    else { const int r = it - NE * XW_I_GU, e = r / XW_I_DN; p0_transpose_item_f8(F.w_dn + (size_t)e * FF * DM, FF, DM, wsp<unsigned char>(F, WS_WDN) + (size_t)e * DM * FF, nullptr, scr, r % XW_I_DN, lane, DM, CmId()); }
}
struct XwDesc { const float* src; unsigned char* dst; unsigned N, K; };
__device__ __forceinline__ XwDesc xw_desc(const Frame& F, int it, int lane) {
    XwDesc d; const int kq = lane >> 4, nq = lane & 15;
    if (it < NE * XW_I_GU) { const int e = it / XW_I_GU, item = it % XW_I_GU, nblk = 2 * FF / 64, k0 = 64 * (item / nblk), n0 = 64 * (item % nblk);
        d.N = 2 * FF; d.K = DM; d.src = F.w_gu + (size_t)e * DM * 2 * FF + (size_t)(k0 + kq) * (2 * FF) + CmWgu()(n0) + 4 * nq;
        d.dst = wsp<unsigned char>(F, WS_WGU) + (size_t)e * 2 * FF * DM + (size_t)(n0 + (lane >> 2)) * DM + k0 + 16 * (lane & 3); }
    else { const int r = it - NE * XW_I_GU, e = r / XW_I_DN, item = r % XW_I_DN, nblk = DM / 64, k0 = 64 * (item / nblk), n0 = 64 * (item % nblk);
        d.N = DM; d.K = FF; d.src = F.w_dn + (size_t)e * FF * DM + (size_t)(k0 + kq) * DM + n0 + 4 * nq;
        d.dst = wsp<unsigned char>(F, WS_WDN) + (size_t)e * DM * FF + (size_t)(n0 + (lane >> 2)) * FF + k0 + 16 * (lane & 3); }
    return d;
}
__device__ __forceinline__ void xw_load(f32x4 (&v)[16], const XwDesc& d) {
#pragma unroll
    for (int j = 0; j < 16; ++j) v[j] = __builtin_nontemporal_load((const f32x4*)(d.src + (size_t)(4 * j) * d.N));
}
__device__ __forceinline__ void xw_process(const f32x4 (&v)[16], const XwDesc& d, LAS float* scr, int lane) {
    const int kq = lane >> 4, nq = lane & 15;
#pragma unroll
    for (int j = 0; j < 16; ++j) { LAS float* w = scr + (4 * j + kq) * 65 + 4 * nq; w[0] = v[j][0]; w[1] = v[j][1]; w[2] = v[j][2]; w[3] = v[j][3]; }
    LDS_WAIT(); asm volatile("" ::: "memory");
    constexpr float WS_ = (float)(1 << pg8::F8_WSHIFT);
    const int c = lane & 3;
#pragma unroll
    for (int j = 0; j < 4; ++j) { const LAS float* s_ = scr + (16 * c) * 65 + (lane >> 2) + 16 * j;
        v4u o; o.x = pk4_fp8(s_[0 * 65] * WS_, s_[1 * 65] * WS_, s_[2 * 65] * WS_, s_[3 * 65] * WS_); o.y = pk4_fp8(s_[4 * 65] * WS_, s_[5 * 65] * WS_, s_[6 * 65] * WS_, s_[7 * 65] * WS_);
        o.z = pk4_fp8(s_[8 * 65] * WS_, s_[9 * 65] * WS_, s_[10 * 65] * WS_, s_[11 * 65] * WS_); o.w = pk4_fp8(s_[12 * 65] * WS_, s_[13 * 65] * WS_, s_[14 * 65] * WS_, s_[15 * 65] * WS_);
        __builtin_nontemporal_store(o, (GAS v4u*)(d.dst + (size_t)(16 * j) * d.K)); }
    LDS_WAIT(); asm volatile("" ::: "memory");
}
__device__ __forceinline__ void p0_prologue(Frame& F) {
    PHASE_IDS;
    { const int gt0 = (int)blockIdx.x * NTHR + TID_, GT0 = F.G * NTHR;
      for (int i = gt0; i < CW_TS; i += GT0) F.ctl[i] = 0u;
      float* km0 = wsp<float>(F, WS_KMEAN); for (int i = gt0; i < (T / SEQ) * NH * NBLK * HD; i += GT0) km0[i] = 0.f; }
    LAS float* scr = (LAS float*)(F.lds + RING_OFF + WAVE_ * P0_SCR_WAVE);
    const int gw = F.vcu * NWAVES + WAVE_, NGW = F.G * NWAVES;
    constexpr int I_GU = (DM / 64) * (2 * FF / 64), I_DN = (FF / 64) * (DM / 64), I_IN = (DM / 64) * (NPROJ / 64), I_SQ = (DM / 64) * (DM / 64), I_PP = (PLE / 64) * (DM / 64);
    constexpr int NITEMS = I_IN + 2 * I_SQ + I_PP;
    (void)I_GU; (void)I_DN;
    for (int it = gw; it < NITEMS; it += NGW) {
        int r = it;
        if (r < I_IN) { p0_transpose_item(F.w_in, DM, NPROJ, wsp<bf16>(F, WS_WIN), F.mix_norm, scr, r, LANE_, NPROJ, CmWin()); continue; } r -= I_IN;
        if (r < I_SQ) {
            const int nblk = DM / 64, kb = r / nblk; const float* g = (kb < 8) ? F.aon : (F.gon - AW);
            p0_transpose_item(F.w_out, DM, DM, wsp<bf16>(F, WS_WOUT), g, scr, r, LANE_, DM, CmId()); continue; } r -= I_SQ;
        if (r < I_SQ) { p0_transpose_item_f8(F.w_pg, DM, DM, wsp<unsigned char>(F, WS_WPG8), F.ple_norm, scr, r, LANE_, DM, CmId()); continue; } r -= I_SQ;
        p0_transpose_item(F.w_pp, PLE, DM, wsp<bf16>(F, WS_WPP), nullptr, scr, r, LANE_, DM, CmId());
    }
    if (TPROBE && blockIdx.x == 0 && threadIdx.x == 0) ((unsigned long long*)(F.ctl + CW_TS))[11] = __builtin_amdgcn_s_memrealtime();
    bf16* XN = wsp<bf16>(F, WS_XNB);
    for (int m0 = gw; m0 < T; m0 += 2 * NGW) {
        f32x4 v[2][4]; float s[2] = {0.f, 0.f};
#pragma unroll
        for (int r = 0; r < 2; ++r) { const GAS f32x4* xr = (const GAS f32x4*)(F.x + (size_t)(m0 + r * NGW) * DM) + LANE_;
#pragma unroll
            for (int j = 0; j < 4; ++j) v[r][j] = __builtin_nontemporal_load(xr + 64 * j); }
#pragma unroll
        for (int r = 0; r < 2; ++r) {
#pragma unroll
            for (int j = 0; j < 4; ++j) s[r] += (v[r][j].x * v[r][j].x + v[r][j].y * v[r][j].y) + (v[r][j].z * v[r][j].z + v[r][j].w * v[r][j].w); }
#pragma unroll
        for (int r = 0; r < 2; ++r) { const int m = m0 + r * NGW; const float sig = sqrtf(wave_sum(s[r]) * (1.f / DM) + EPS), rstd = 1.0f / sig;
            if (LANE_ == 0) wsp<float>(F, WS_SIG0)[m] = sig;
            GAS v2u* o8 = (GAS v2u*)(XN + (size_t)m * DM) + LANE_;
#pragma unroll
            for (int j = 0; j < 4; ++j) { v2u w; w.x = pk2(v[r][j].x * rstd, v[r][j].y * rstd); w.y = pk2(v[r][j].z * rstd, v[r][j].w * rstd); o8[64 * j] = w; } }
    }
    if (TPROBE && blockIdx.x == 0 && threadIdx.x == 0) ((unsigned long long*)(F.ctl + CW_TS))[12] = __builtin_amdgcn_s_memrealtime();
    { const GAS f32x4* pr = (const GAS f32x4*)F.p; GAS v4u* po = (GAS v4u*)wsp<bf16>(F, WS_PB);
      const size_t n8 = (size_t)T * PLE / 8, gt = (size_t)(F.vcu * NTHR + TID_), GT = (size_t)F.G * NTHR;
      for (size_t i = gt; i < n8; i += GT) { const f32x4 a = pr[2 * i], b = pr[2 * i + 1]; v4u w; w.x = pk2(a.x, a.y); w.y = pk2(a.z, a.w); w.z = pk2(b.x, b.y); w.w = pk2(b.z, b.w); po[i] = w; } }
    if (TPROBE && blockIdx.x == 0 && threadIdx.x == 0) ((unsigned long long*)(F.ctl + CW_TS))[13] = __builtin_amdgcn_s_memrealtime();
    { const int gt = F.vcu * NTHR + TID_, GT = F.G * NTHR; float* RWG = wsp<float>(F, WS_RWG);
      (void)RWG; bf16* RWT = wsp<bf16>(F, WS_RWT);
      for (int i = gt; i < DM * NE; i += GT) { const int e = i / DM, k = i % DM; const float w = F.router_w[k * NE + e] * F.ffn_norm[k]; const unsigned hi = f2bf(w); const float lo = w - bf2f((bf16)hi); RWT[i] = (bf16)hi; RWT[NE * DM + i] = (bf16)f2bf(lo); }
      float* RC = wsp<float>(F, WS_ROPE); float* RS = RC + SEQ * 32;
      for (int i = gt; i < SEQ * 32; i += GT) { const int pos = i >> 5, j = i & 31; const float inv = powf(10000.0f, -(float)j / 32.0f); const float ang = (float)pos * inv; float sn, cs; sincosf(ang, &sn, &cs); RC[i] = cs; RS[i] = sn; } }
}

using pg8::Unit;
constexpr int HALF = 128;
constexpr float QSCALE = 0.125f * 1.4426950408889634f;
struct EpiInProj {
    static constexpr bool PERM = true;
    bf16* QKVUV; const float *rc, *rs; float* kmean;
    __device__ __forceinline__ void operator()(const f32x4 (&acc)[2][2][4][2], const Unit& u, int wr, int wc, int fr, int fq) const {
        const int type = u.pn >> 1, colt = (u.pn & 1) * 256 + wc * 32 + 8 * fq;
        const int row0 = u.pm * 256 + wr * 64 + fr;
        if (type <= 1) {
            bf16* dst = QKVUV + (size_t)type * (16u << 20);
            const int pos0 = (u.pm & 7) * 256 + wr * 64 + fr, i0 = 16 * (wc & 1) + 4 * fq;
            f32x4 cs_[2][2];
#pragma unroll
            for (int bj = 0; bj < 2; ++bj) { cs_[bj][0] = (f32x4){0.f, 0.f, 0.f, 0.f}; cs_[bj][1] = (f32x4){0.f, 0.f, 0.f, 0.f}; }
            const f32x4 c16 = *(const f32x4*)(rc + 16 * 32 + i0), s16 = *(const f32x4*)(rs + 16 * 32 + i0), c128 = *(const f32x4*)(rc + 128 * 32 + i0), s128 = *(const f32x4*)(rs + 128 * 32 + i0);
            const f32x4 cb = *(const f32x4*)(rc + pos0 * 32 + i0), sb = *(const f32x4*)(rs + pos0 * 32 + i0);
#pragma unroll
            for (int ai = 0; ai < 2; ++ai) { f32x4 c = ai ? cb * c128 - sb * s128 : cb, s = ai ? sb * c128 + cb * s128 : sb;
#pragma unroll
                for (int m = 0; m < 4; ++m) { const int ro = ai * HALF + m * 16;
                    bf16* rowp = dst + (size_t)(row0 + ro) * AW + colt;
#pragma unroll
                    for (int bj = 0; bj < 2; ++bj) { const f32x4 x1 = acc[ai][bj][m][0], x2 = acc[ai][bj][m][1];
                        f32x4 o1 = x1 * c - x2 * s, o2 = x2 * c + x1 * s;
                        if (type == 0) { o1 *= QSCALE; o2 *= QSCALE; }
                        cs_[bj][0] += o1; cs_[bj][1] += o2;
                        v4u w; w.x = cvt_pk_bf16(o1[0], o1[1]); w.y = cvt_pk_bf16(o1[2], o1[3]); w.z = cvt_pk_bf16(o2[0], o2[1]); w.w = cvt_pk_bf16(o2[2], o2[3]);
                        *(v4u*)(rowp + bj * HALF) = w; }
                    { const f32x4 cn = c * c16 - s * s16, sn = s * c16 + c * s16; c = cn; s = sn; } }
                asm volatile("" ::: "memory"); }
            if (type == 1) {
#pragma unroll
                for (int bj = 0; bj < 2; ++bj)
#pragma unroll
                    for (int n = 0; n < 2; ++n)
#pragma unroll
                        for (int j = 0; j < 4; ++j) { float v = cs_[bj][n][j]; v += __shfl_xor(v, 1); v += __shfl_xor(v, 2); v += __shfl_xor(v, 4); v += __shfl_xor(v, 8); cs_[bj][n][j] = v; }
                if (fr == 0) { const int b = u.pm >> 3, blk = u.pm & 7;
#pragma unroll
                    for (int bj = 0; bj < 2; ++bj) { const int colh = (u.pn & 1) * 256 + bj * HALF + wc * 32; const int head = colh >> 6, cpos = (colh & 63) + 8 * fq;
                        float* km = kmean + ((size_t)((b * NH + head) * NBLK + blk)) * HD + cpos;
#pragma unroll
                        for (int n = 0; n < 2; ++n)
#pragma unroll
                            for (int j = 0; j < 4; ++j) atomicAdd(km + 4 * n + j, cs_[bj][n][j]); } }
            }
        } else {
            bf16* dst = QKVUV + (size_t)type * (16u << 20);
#pragma unroll
            for (int ai = 0; ai < 2; ++ai)
#pragma unroll
                for (int m = 0; m < 4; ++m) { bf16* rowp = dst + (size_t)(row0 + ai * HALF + m * 16) * AW + colt;
#pragma unroll
                    for (int bj = 0; bj < 2; ++bj) { f32x4 v0 = acc[ai][bj][m][0], v1 = acc[ai][bj][m][1];
                        if (type >= 3) { v0 = gelu4(v0); v1 = gelu4(v1); }
                        v4u w; w.x = cvt_pk_bf16(v0[0], v0[1]); w.y = cvt_pk_bf16(v0[2], v0[3]); w.z = cvt_pk_bf16(v1[0], v1[1]); w.w = cvt_pk_bf16(v1[2], v1[3]);
                        *(v4u*)(rowp + bj * HALF) = w; } }
        }
    }
};
struct EpiOutProj {
    static constexpr bool PERM = true;
    const bf16* xn; bf16* x1; unsigned char* x1f8; float* ssq1; const LAS f32x4* rtab; const float* fgain;
    int pm_a, pm_b;
    __device__ __forceinline__ int slot(const Unit& u) const { return u.pm == pm_a ? 0 : 1; }
    __device__ __forceinline__ void midk(f32x4 (&acc)[2][2][4][2], const Unit& u, int wr, int fr) const {
        const LAS f32x4* t = rtab + slot(u) * 256 + wr * 64 + fr;
#pragma unroll
        for (int ai = 0; ai < 2; ++ai)
#pragma unroll
            for (int m = 0; m < 4; ++m) { const float r = t[ai * HALF + m * 16].x;
#pragma unroll
                for (int bj = 0; bj < 2; ++bj)
#pragma unroll
                    for (int n = 0; n < 2; ++n) acc[ai][bj][m][n] *= r; }
    }
    __device__ __forceinline__ void operator()(const f32x4 (&acc)[2][2][4][2], const Unit& u, int wr, int wc, int fr, int fq) const {
        const LAS f32x4* t = rtab + slot(u) * 256 + wr * 64 + fr;
        const int row0 = u.pm * 256 + wr * 64 + fr, col0 = u.pn * 256 + wc * 32 + 8 * fq;
        f32x4 fg[2][2];
#pragma unroll
        for (int bj = 0; bj < 2; ++bj) { fg[bj][0] = *(const f32x4*)(fgain + col0 + bj * HALF); fg[bj][1] = *(const f32x4*)(fgain + col0 + bj * HALF + 4); }
#pragma unroll
        for (int ai = 0; ai < 2; ++ai) { v4u xv[4][2];
#pragma unroll
            for (int m = 0; m < 4; ++m) { const size_t off = (size_t)(row0 + ai * HALF + m * 16) * DM + col0;
                xv[m][0] = *(const v4u*)(xn + off); xv[m][1] = *(const v4u*)(xn + off + HALF); }
#pragma unroll
            for (int m = 0; m < 4; ++m) { const int ro = ai * HALF + m * 16; const f32x4 tv = t[ro]; const float rg = tv.y, sx = tv.z; const size_t off = (size_t)(row0 + ro) * DM + col0; float q = 0.f;
#pragma unroll
                for (int bj = 0; bj < 2; ++bj) { const v4u xw = xv[m][bj];
                    const f32x4 x0 = {bflo(xw.x), bfhi(xw.x), bflo(xw.y), bfhi(xw.y)}, x1_ = {bflo(xw.z), bfhi(xw.z), bflo(xw.w), bfhi(xw.w)};
                    const f32x4 o0 = x0 * sx + acc[ai][bj][m][0] * rg, o1 = x1_ * sx + acc[ai][bj][m][1] * rg;
                    q += (o0[0] * o0[0] + o0[1] * o0[1]) + (o0[2] * o0[2] + o0[3] * o0[3]) + (o1[0] * o1[0] + o1[1] * o1[1]) + (o1[2] * o1[2] + o1[3] * o1[3]);
                    v4u w; w.x = cvt_pk_bf16(o0[0], o0[1]); w.y = cvt_pk_bf16(o0[2], o0[3]); w.z = cvt_pk_bf16(o1[0], o1[1]); w.w = cvt_pk_bf16(o1[2], o1[3]);
                    *(v4u*)(x1 + off + bj * HALF) = w;
                    const f32x4 p0 = o0 * fg[bj][0], p1 = o1 * fg[bj][1];
                    v2u w8; w8.x = pk4_fp8(p0[0], p0[1], p0[2], p0[3]); w8.y = pk4_fp8(p1[0], p1[1], p1[2], p1[3]); *(v2u*)(x1f8 + off + bj * HALF) = w8; }
                q += __shfl_xor(q, 16); q += __shfl_xor(q, 32);
                if (fq == 0) ssq1[(size_t)(row0 + ro) * 16 + u.pn * 4 + wc] = q; }
            asm volatile("" ::: "memory"); }
    }
};
struct EpiMoe1 {
    static constexpr bool PERM = true;
    unsigned char* A; const float* b_gu; const LAS float* rss;
    __device__ __forceinline__ void operator()(const f32x4 (&acc)[2][2][4][2], const Unit& u, int wr, int wc, int fr, int fq) const {
        const int row0 = u.pm * 256 + wr * 64 + fr, col = u.pn * 128 + wc * 32 + 8 * fq;
        const float* bg = b_gu + (size_t)u.e * 2 * FF + col; const LAS float* rs_ = rss + u.slot * 256 + wr * 64 + fr;
        float rsv[2][4];
#pragma unroll
        for (int ai = 0; ai < 2; ++ai)
#pragma unroll
            for (int m = 0; m < 4; ++m) rsv[ai][m] = rs_[ai * HALF + m * 16];
        f32x4 bgv[2], blv[2];
#pragma unroll
        for (int n = 0; n < 2; ++n) { bgv[n] = *(const f32x4*)(bg + 4 * n); blv[n] = *(const f32x4*)(bg + FF + 4 * n); }
#pragma unroll
        for (int ai = 0; ai < 2; ++ai)
#pragma unroll
            for (int m = 0; m < 4; ++m) { f32x4 a[2];
#pragma unroll
                for (int n = 0; n < 2; ++n) { const f32x4 g = acc[ai][0][m][n] * rsv[ai][m] + bgv[n], l = acc[ai][1][m][n] * rsv[ai][m] + blv[n];
#pragma unroll
                    for (int p = 0; p < 2; ++p) { f32x2 gc = {fminf(g[2 * p], 7.0f), fminf(g[2 * p + 1], 7.0f)}; f32x2 lc = {fminf(fmaxf(l[2 * p], -7.0f), 7.0f), fminf(fmaxf(l[2 * p + 1], -7.0f), 7.0f)};
                        const f32x2 z = gc * (-1.702f * 1.4426950408889634f); f32x2 e; e.x = __builtin_amdgcn_exp2f(z.x); e.y = __builtin_amdgcn_exp2f(z.y);
                        const f32x2 d = e + 1.0f; f32x2 r; r.x = __builtin_amdgcn_rcpf(d.x); r.y = __builtin_amdgcn_rcpf(d.y);
                        const f32x2 o = (gc * r) * (lc + 1.0f); a[n][2 * p] = o.x; a[n][2 * p + 1] = o.y; } }
                v2u w; w.x = pk4_fp8_nc(a[0][0], a[0][1], a[0][2], a[0][3]); w.y = pk4_fp8_nc(a[1][0], a[1][1], a[1][2], a[1][3]);
                *(v2u*)(A + (size_t)(row0 + ai * HALF + m * 16) * FF + col) = w; }
    }
};
constexpr float Y_SCALE = 16.0f;
struct EpiMoe2 {
    static constexpr bool PERM = true;
    unsigned char* Y; const float* b_dn; const LAS float* gss;
    __device__ __forceinline__ void operator()(const f32x4 (&acc)[2][2][4][2], const Unit& u, int wr, int wc, int fr, int fq) const {
        const int row0 = u.pm * 256 + wr * 64 + fr, col0 = u.pn * 256 + wc * 32 + 8 * fq;
        const LAS float* gs = gss + u.slot * 256 + wr * 64 + fr;
        f32x4 bv[2][2]; float gv[2][4];
#pragma unroll
        for (int bj = 0; bj < 2; ++bj)
#pragma unroll
            for (int n = 0; n < 2; ++n) bv[bj][n] = *(const f32x4*)(b_dn + (size_t)u.e * DM + col0 + bj * HALF + 4 * n);
#pragma unroll
        for (int ai = 0; ai < 2; ++ai)
#pragma unroll
            for (int m = 0; m < 4; ++m) gv[ai][m] = gs[ai * HALF + m * 16] * Y_SCALE;
#pragma unroll
        for (int ai = 0; ai < 2; ++ai)
#pragma unroll
            for (int m = 0; m < 4; ++m) { const float g = gv[ai][m]; unsigned char* rowp = Y + (size_t)(row0 + ai * HALF + m * 16) * DM + col0;
#pragma unroll
                for (int bj = 0; bj < 2; ++bj) { const f32x4 v0 = (acc[ai][bj][m][0] + bv[bj][0]) * g, v1 = (acc[ai][bj][m][1] + bv[bj][1]) * g;
                    v2u w; w.x = pk4_fp8(v0[0], v0[1], v0[2], v0[3]); w.y = pk4_fp8(v1[0], v1[1], v1[2], v1[3]);
                    *(v2u*)(rowp + bj * HALF) = w; } }
    }
};
constexpr float GATE_SCALE = 128.0f;
template <int MODE> struct EpiPle {
    static constexpr bool PERM = true;
    unsigned char* O; float* ssq; const LAS float* rtab; int pm_a;
    __device__ __forceinline__ void operator()(const f32x4 (&acc)[2][2][4][2], const Unit& u, int wr, int wc, int fr, int fq) const {
        const int row0 = u.pm * 256 + wr * 64 + fr, col0 = u.pn * 256 + wc * 32 + 8 * fq;
        float rsv[2][4];
#pragma unroll
        for (int ai = 0; ai < 2; ++ai)
#pragma unroll
            for (int m = 0; m < 4; ++m) rsv[ai][m] = (MODE == 0) ? rtab[(u.pm == pm_a ? 0 : 256) + wr * 64 + fr + ai * HALF + m * 16] : 1.0f;
#pragma unroll
        for (int ai = 0; ai < 2; ++ai)
#pragma unroll
            for (int m = 0; m < 4; ++m) { unsigned char* rowp = O + (size_t)(row0 + ai * HALF + m * 16) * DM + col0; float q = 0.f; const float rs = rsv[ai][m];
#pragma unroll
                for (int bj = 0; bj < 2; ++bj) { f32x4 v0 = acc[ai][bj][m][0], v1 = acc[ai][bj][m][1];
                    if (MODE == 0) {
#pragma unroll
                        for (int j = 0; j < 4; ++j) { v0[j] = GATE_SCALE * sigmoidf_fast(rs * v0[j]); v1[j] = GATE_SCALE * sigmoidf_fast(rs * v1[j]); } }
                    else { q += (v0[0] * v0[0] + v0[1] * v0[1]) + (v0[2] * v0[2] + v0[3] * v0[3]) + (v1[0] * v1[0] + v1[1] * v1[1]) + (v1[2] * v1[2] + v1[3] * v1[3]); }
                    v2u w; if (MODE == 0) { w.x = pk4_fp8_nc(v0[0], v0[1], v0[2], v0[3]); w.y = pk4_fp8_nc(v1[0], v1[1], v1[2], v1[3]); }
                    else { w.x = pk4_fp8(v0[0], v0[1], v0[2], v0[3]); w.y = pk4_fp8(v1[0], v1[1], v1[2], v1[3]); }
                    *(v2u*)(rowp + bj * HALF) = w; }
                if (MODE == 1) { q += __shfl_xor(q, 16); q += __shfl_xor(q, 32); if (fq == 0) ssq[(size_t)(row0 + ai * HALF + m * 16) * 16 + u.pn * 4 + wc] = q; } }
    }
};

namespace att {
constexpr int QBLK = 32, KVBLK = 64;
constexpr float SCALE = 0.125f, THR = 8.f;
constexpr int SHM_V = KVBLK * HD * 2, SHM_K = SHM_V;
constexpr int NSLOT = 3;
constexpr int LDS_BYTES_ = NSLOT * SHM_V + NSLOT * SHM_K + NWAVES * 64 * 4;
#define ATT_KSWZ(row, colB) ((row) * 128 + ((colB) ^ ((((row) >> 1) & 7) << 4)))
#define ATT_SBAR() __builtin_amdgcn_sched_barrier(0)
__device__ __forceinline__ int crow(int r, int hi) { return (r & 3) + 8 * (r >> 2) + 4 * hi; }
__device__ __forceinline__ void cmask(f32x16& p0, f32x16& p1, int jb, int qrel, int hi) {
    const float NEG = -__builtin_inff(); const int kb = 64 * jb + 4 * hi;
#pragma unroll
    for (int r = 0; r < 16; ++r) { const int kv = kb + (r & 3) + 8 * (r >> 2); if (kv > qrel) p0[r] = NEG; if (kv + 32 > qrel) p1[r] = NEG; }
}
__device__ __forceinline__ void bmask(f32x16& p0, f32x16& p1, bool keep) {
    const float NEG = -__builtin_inff();
    if (!keep) {
#pragma unroll
        for (int r = 0; r < 16; ++r) { p0[r] = NEG; p1[r] = NEG; } }
}
__device__ __forceinline__ void partialSM(f32x16& p0, f32x16& p1, float& m_reg, float& mn, float& alpha, bool keep) {
    float pmax = p0[0];
#pragma unroll
    for (int r = 1; r < 16; ++r) pmax = fmaxf(pmax, p0[r]);
#pragma unroll
    for (int r = 0; r < 16; ++r) pmax = fmaxf(pmax, p1[r]);
    { auto rr = __builtin_amdgcn_permlane32_swap(__float_as_uint(pmax), __float_as_uint(pmax), false, false);
      pmax = fmaxf(__uint_as_float(rr[0]), __uint_as_float(rr[1])); }
    if (!keep) pmax = -__builtin_inff();
    constexpr float C2 = 1.4426950408889634f * SCALE;
    if (__builtin_expect(__all((pmax - m_reg) * SCALE <= THR), 1)) { mn = m_reg; alpha = 1.f; }
    else { mn = fmaxf(m_reg, pmax); alpha = __builtin_amdgcn_exp2f((m_reg - mn) * C2); m_reg = mn; }
    const float mnL = keep ? -mn * C2 : -__builtin_inff(), c2 = keep ? C2 : 0.f;
#pragma unroll
    for (int r = 0; r < 16; ++r) p0[r] = fmaf(p0[r], c2, mnL);
#pragma unroll
    for (int r = 0; r < 16; ++r) p1[r] = fmaf(p1[r], c2, mnL);
#pragma unroll
    for (int r = 0; r < 16; ++r) p0[r] = __builtin_amdgcn_exp2f(p0[r]);
}
__device__ __forceinline__ void finishSM(f32x16& p0, f32x16& p1, float alpha, float& l_reg, bf16x8& pa0, bf16x8& pa1, bf16x8& pa2, bf16x8& pa3) {
#pragma unroll
    for (int r = 0; r < 16; ++r) p1[r] = __builtin_amdgcn_exp2f(p1[r]);
    float ps = 0;
#pragma unroll
    for (int r = 0; r < 16; ++r) ps += p0[r];
#pragma unroll
    for (int r = 0; r < 16; ++r) ps += p1[r];
    { auto rr = __builtin_amdgcn_permlane32_swap(__float_as_uint(ps), __float_as_uint(ps), false, false);
      ps = __uint_as_float(rr[0]) + __uint_as_float(rr[1]); }
    l_reg = l_reg * alpha + ps;
#define ATT_PK4(P, B, OUT) do { unsigned a0 = cvt_pk_bf16(P[B+0], P[B+1]), a1 = cvt_pk_bf16(P[B+2], P[B+3]);             \
        unsigned b0 = cvt_pk_bf16(P[B+4], P[B+5]), b1 = cvt_pk_bf16(P[B+6], P[B+7]);                                       \
        auto r0 = __builtin_amdgcn_permlane32_swap(a0, b0, false, false); auto r1 = __builtin_amdgcn_permlane32_swap(a1, b1, false, false); \
        v4u w = {r0[0], r1[0], r0[1], r1[1]}; OUT = *reinterpret_cast<bf16x8*>(&w); } while (0)
    ATT_PK4(p0, 0, pa0); ATT_PK4(p0, 8, pa1); ATT_PK4(p1, 0, pa2); ATT_PK4(p1, 8, pa3);
#undef ATT_PK4
}
__device__ __forceinline__ void qkt(f32x16& p0, f32x16& p1, const LAS unsigned char* Ks, const bf16x8* qr, int r32, int hi) {
    p0 = f32x16{}; p1 = f32x16{};
#pragma unroll
    for (int d0 = 0; d0 < 4; ++d0) { const int cb = (d0 * 16 + hi * 8) * 2;
        const bf16x8 b0 = *(const LAS bf16x8*)(Ks + ATT_KSWZ(r32, cb));
        const bf16x8 b1 = *(const LAS bf16x8*)(Ks + ATT_KSWZ(32 + r32, cb));
        p0 = __builtin_amdgcn_mfma_f32_32x32x16_bf16(b0, qr[d0], p0, 0, 0, 0);
        p1 = __builtin_amdgcn_mfma_f32_32x32x16_bf16(b1, qr[d0], p1, 0, 0, 0); }
}
__device__ __forceinline__ void pv(f32x16* o, int vb, bf16x8 pa0, bf16x8 pa1, bf16x8 pa2, bf16x8 pa3) {
#pragma unroll
    for (int d0 = 0; d0 < 2; ++d0) { s16x4 lo[4], hi[4];
#pragma unroll
        for (int ks = 0; ks < 4; ++ks) { const int a = vb + d0 * 2048 + (ks >> 1) * 4096 + (ks & 1) * 1024;
            asm volatile("ds_read_b64_tr_b16 %0,%1" : "=&v"(lo[ks]) : "v"(a) : "memory");
            asm volatile("ds_read_b64_tr_b16 %0,%1 offset:256" : "=&v"(hi[ks]) : "v"(a) : "memory"); }
        asm volatile("s_waitcnt lgkmcnt(0)" ::: "memory"); ATT_SBAR();
#define ATT_PK(k) (bf16x8){lo[k][0], lo[k][1], lo[k][2], lo[k][3], hi[k][0], hi[k][1], hi[k][2], hi[k][3]}
        o[d0] = __builtin_amdgcn_mfma_f32_32x32x16_bf16(pa0, ATT_PK(0), o[d0], 0, 0, 0);
        o[d0] = __builtin_amdgcn_mfma_f32_32x32x16_bf16(pa1, ATT_PK(1), o[d0], 0, 0, 0);
        o[d0] = __builtin_amdgcn_mfma_f32_32x32x16_bf16(pa2, ATT_PK(2), o[d0], 0, 0, 0);
        o[d0] = __builtin_amdgcn_mfma_f32_32x32x16_bf16(pa3, ATT_PK(3), o[d0], 0, 0, 0);
#undef ATT_PK
    }
}
__device__ __forceinline__ void attn_unit(const Frame& F, int b, int h, int qb, LAS unsigned char* scratch) {
    PHASE_IDS;
    const int tid = TID_, wid = tid >> 6, lane = tid & 63, r32 = lane & 31, hi = lane >> 5;
    const bf16* Qg = wsp<bf16>(F, WS_Q); const bf16* Kg = wsp<bf16>(F, WS_K); const bf16* Vg = wsp<bf16>(F, WS_V);
    const size_t rowbase = (size_t)b * SEQ; const int q0 = qb * MOBA;
    const bf16* Qw = Qg + (rowbase + q0 + wid * QBLK) * AW + h * HD;
    const bf16* Kh = Kg + rowbase * AW + h * HD; const bf16* Vh = Vg + rowbase * AW + h * HD;
    LAS unsigned char* V_lds = scratch; LAS unsigned char* K_lds = scratch + NSLOT * SHM_V;
    LAS float* wsf = (LAS float*)(scratch + NSLOT * SHM_V + NSLOT * SHM_K) + wid * 64; LAS float* li_l = wsf; LAS float* al_l = wsf + 32;
    float m_reg = -1e30f, l_reg = 0.f; f32x16 o[2]; o[0] = f32x16{}; o[1] = f32x16{}; bf16x8 qr[4];
#pragma unroll
    for (int d0 = 0; d0 < 4; ++d0) qr[d0] = *(const bf16x8*)(Qw + (size_t)r32 * AW + d0 * 16 + hi * 8);
    unsigned sel = 0u;
    if (qb <= 3) sel = (1u << qb) - 1u;
    else {
        const float* km = wsp<float>(F, WS_KMEAN) + (size_t)((b * NH + h) * NBLK) * HD + (size_t)(r32 & 7) * HD + hi * 8;
        f32x4 kv[4][2];
#pragma unroll
        for (int d0 = 0; d0 < 4; ++d0) { kv[d0][0] = *(const f32x4*)(km + d0 * 16); kv[d0][1] = *(const f32x4*)(km + d0 * 16 + 4); }
        f32x16 gacc = f32x16{};
#pragma unroll
        for (int d0 = 0; d0 < 4; ++d0) { float f[8] = {kv[d0][0][0], kv[d0][0][1], kv[d0][0][2], kv[d0][0][3], kv[d0][1][0], kv[d0][1][1], kv[d0][1][2], kv[d0][1][3]};
            unsigned hw[4], lw[4];
#pragma unroll
            for (int p = 0; p < 4; ++p) { float a0 = f[2 * p], a1 = f[2 * p + 1]; if (r32 >= 8) { a0 = 0.f; a1 = 0.f; }
                const unsigned h0 = f2bf(a0), h1 = f2bf(a1); hw[p] = h0 | (h1 << 16); lw[p] = pk2(a0 - bf2f((bf16)h0), a1 - bf2f((bf16)h1)); }
            const v4u hv = {hw[0], hw[1], hw[2], hw[3]}, lv = {lw[0], lw[1], lw[2], lw[3]};
            gacc = __builtin_amdgcn_mfma_f32_32x32x16_bf16(__builtin_bit_cast(bf16x8, hv), qr[d0], gacc, 0, 0, 0);
            gacc = __builtin_amdgcn_mfma_f32_32x32x16_bf16(__builtin_bit_cast(bf16x8, lv), qr[d0], gacc, 0, 0, 0); }
        float g[8];
#pragma unroll
        for (int r = 0; r < 4; ++r) { const float mine = gacc[r], other = __shfl_xor(mine, 32); g[r] = hi ? other : mine; g[4 + r] = hi ? mine : other; }
        float b0 = -__builtin_inff(), b1 = b0, b2 = b0; int i0 = 0, i1 = 0, i2 = 0;
#pragma unroll
        for (int j = 0; j < NBLK - 1; ++j) { const float s_ = (j < qb) ? g[j] : -__builtin_inff();
            if (s_ > b0) { b2 = b1; i2 = i1; b1 = b0; i1 = i0; b0 = s_; i0 = j; } else if (s_ > b1) { b2 = b1; i2 = i1; b1 = s_; i1 = j; } else if (s_ > b2) { b2 = s_; i2 = j; } }
        sel = (1u << i0) | (1u << i1) | (1u << i2);
    }
    const int sr = tid >> 3, sc = (tid & 7) * 8;
    const int srv = ((tid >> 5) << 2) | ((tid >> 1) & 3), scv = ((tid & 1) << 3) | (((tid >> 3) & 3) << 4);
    const int vst = (srv >> 5) * 4096 + (scv >> 5) * 2048 + ((srv & 31) >> 2) * 256 + ((scv >> 4) & 1) * 128 + (srv & 3) * 32 + (scv & 8) * 2;
    const int vb0 = (int)(size_t)V_lds + (lane & 15) * 8 + ((lane >> 4) & 1) * 128 + (lane >> 5) * 512;
    bf16x8 st_v, st_k;
#define ATT_SLOAD(k0) do { st_v = *(const bf16x8*)(Vh + (size_t)((k0) + srv) * AW + scv); st_k = *(const bf16x8*)(Kh + (size_t)((k0) + sr) * AW + sc); } while (0)
#define ATT_SWRITE(bf) do { *(LAS bf16x8*)(V_lds + (bf) * SHM_V + vst) = st_v; *(LAS bf16x8*)(K_lds + (bf) * SHM_K + ATT_KSWZ(sr, sc * 2)) = st_k; } while (0)
#define ATT_RESC(a) do { if (__any((a) < 1.f)) { if (hi == 0) al_l[r32] = (a); asm volatile("s_waitcnt lgkmcnt(0)" ::: "memory");      \
        _Pragma("unroll") for (int d_ = 0; d_ < 2; ++d_) _Pragma("unroll") for (int r = 0; r < 16; ++r) o[d_][r] *= al_l[crow(r, hi)]; } } while (0)
    const int NT = (q0 + MOBA) / KVBLK;
    const int qrel = wid * QBLK + r32;
#define ATT_MASK(P0, P1, t) do { const int jb_ = (t) - (NT - 4); if (jb_ >= 0) cmask(P0, P1, jb_, qrel, hi); } while (0)
#define ATT_KEEP(t) ((((t) >= NT - 4) ? 1u : ((sel >> ((t) >> 2)) & 1u)) != 0u)
    f32x16 pA0, pA1, pB0, pB1; float mnA, mnB, alA, alB; bf16x8 pa0, pa1, pa2, pa3;
    int s0 = 0, s1 = 1, s2 = 2;
#define ATT_ROT() do { const int t_ = s0; s0 = s1; s1 = s2; s2 = t_; } while (0)
    ATT_SLOAD(0); asm volatile("s_waitcnt vmcnt(0)" ::: "memory"); ATT_SWRITE(0); ATT_SLOAD(KVBLK);
    s0 = 2; s1 = 0; s2 = 1;
    __syncthreads();
    asm volatile("s_waitcnt vmcnt(0)" ::: "memory"); ATT_SWRITE(s2); ATT_SLOAD(2 * KVBLK);
    qkt(pA0, pA1, K_lds + s1 * SHM_K, qr, r32, hi); ATT_MASK(pA0, pA1, 0); partialSM(pA0, pA1, m_reg, mnA, alA, ATT_KEEP(0));
    ATT_ROT();
    for (int j = 1; j < NT; j += 2) {
        __syncthreads();
        if (j + 1 < NT) { asm volatile("s_waitcnt vmcnt(0)" ::: "memory"); ATT_SWRITE(s2); if (j + 2 < NT) ATT_SLOAD((j + 2) * KVBLK); }
        ATT_SBAR(); qkt(pB0, pB1, K_lds + s1 * SHM_K, qr, r32, hi); ATT_MASK(pB0, pB1, j);
        finishSM(pA0, pA1, alA, l_reg, pa0, pa1, pa2, pa3); ATT_SBAR();
        pv(o, vb0 + s0 * SHM_V, pa0, pa1, pa2, pa3); partialSM(pB0, pB1, m_reg, mnB, alB, ATT_KEEP(j));
        ATT_RESC(alB); ATT_ROT();
        if (j + 1 < NT) {
            __syncthreads();
            if (j + 2 < NT) { asm volatile("s_waitcnt vmcnt(0)" ::: "memory"); ATT_SWRITE(s2); if (j + 3 < NT) ATT_SLOAD((j + 3) * KVBLK); }
            ATT_SBAR(); qkt(pA0, pA1, K_lds + s1 * SHM_K, qr, r32, hi); ATT_MASK(pA0, pA1, j + 1);
            finishSM(pB0, pB1, alB, l_reg, pa0, pa1, pa2, pa3); ATT_SBAR();
            pv(o, vb0 + s0 * SHM_V, pa0, pa1, pa2, pa3); partialSM(pA0, pA1, m_reg, mnA, alA, ATT_KEEP(j + 1));
            ATT_RESC(alA); ATT_ROT();
        }
    }
    finishSM(pB0, pB1, alB, l_reg, pa0, pa1, pa2, pa3); ATT_SBAR();
    pv(o, vb0 + s0 * SHM_V, pa0, pa1, pa2, pa3);
#undef ATT_ROT
    if (hi == 0) li_l[r32] = l_reg; asm volatile("s_waitcnt lgkmcnt(0)" ::: "memory");
    float rli[16];
#pragma unroll
    for (int r = 0; r < 16; ++r) rli[r] = __builtin_amdgcn_rcpf(li_l[crow(r, hi)]);
    bf16* Ow = wsp<bf16>(F, WS_MIX) + (rowbase + q0 + wid * QBLK) * DM + h * HD;
    float* ssqa = wsp<float>(F, WS_SSQA) + (rowbase + q0 + wid * QBLK) * NH + h;
    float qq[16];
#pragma unroll
    for (int r = 0; r < 16; ++r) { const int orow = crow(r, hi); float q2 = 0.f;
#pragma unroll
        for (int d0 = 0; d0 < 2; ++d0) { const float v = o[d0][r] * rli[r]; const float vn = __shfl_xor(v, 1); q2 += v * v;
            if ((r32 & 1) == 0) *(unsigned*)(Ow + (size_t)orow * DM + d0 * 32 + r32) = cvt_pk_bf16(v, vn); }
        qq[r] = q2; }
#pragma unroll
    for (int i = 0; i < 8; ++i) { const bool up = (lane & 16) != 0; const float send = up ? qq[i] : qq[i + 8], keep = up ? qq[i + 8] : qq[i]; qq[i] = keep + __shfl_xor(send, 16); }
#pragma unroll
    for (int i = 0; i < 4; ++i) { const bool up = (lane & 8) != 0; const float send = up ? qq[i] : qq[i + 4], keep = up ? qq[i + 4] : qq[i]; qq[i] = keep + __shfl_xor(send, 8); }
#pragma unroll
    for (int i = 0; i < 2; ++i) { const bool up = (lane & 4) != 0; const float send = up ? qq[i] : qq[i + 2], keep = up ? qq[i + 2] : qq[i]; qq[i] = keep + __shfl_xor(send, 4); }
    { const bool up = (lane & 2) != 0; const float send = up ? qq[0] : qq[1], keep = up ? qq[1] : qq[0]; qq[0] = keep + __shfl_xor(send, 2); }
    qq[0] += __shfl_xor(qq[0], 1);
    if ((lane & 1) == 0) ssqa[(size_t)crow(r32 >> 1, hi) * NH] = qq[0];
    __syncthreads();
#undef ATT_SLOAD
#undef ATT_SWRITE
#undef ATT_RESC
#undef ATT_MASK
#undef ATT_KEEP
}
}

namespace att2 {
constexpr int QBLK = 32, KVBLK = 64, SLOTB = 8192, LDS_K = 0, LDS_V = 3 * SLOTB, LDS_WS = 6 * SLOTB;
constexpr float C2 = 0.125f * 1.4426950408889634f, THR = 8.f, MH0 = -4096.f;
#define A2_SBAR() __builtin_amdgcn_sched_barrier(0)
#define A2_PIN(x) asm volatile("" : "+v"(x))
#define A2_MFMA(a, b, c) __builtin_amdgcn_mfma_f32_32x32x16_bf16(a, b, c, 0, 0, 0)
#define A2_WAIT_BAR(N) asm volatile("s_waitcnt vmcnt(" #N ") lgkmcnt(0)\n\ts_barrier" ::: "memory")
__device__ __forceinline__ int crow(int r, int hi) { return (r & 3) + 8 * (r >> 2) + 4 * hi; }
__device__ __forceinline__ void glds16(const void* g, unsigned lds_base) {
    unsigned sv; asm volatile("s_mov_b32 %0, m0\n\ts_mov_b32 m0, %2\n\ts_nop 0\n\tglobal_load_lds_dwordx4 %1, off\n\ts_mov_b32 m0, %0" : "=&s"(sv) : "v"(g), "s"(lds_base) : "memory"); }
typedef const LAS char* lds_cptr;
__device__ __forceinline__ void kload2(bf16x8* kf, lds_cptr kp, int d0) { kf[2 * d0] = *(const LAS bf16x8*)(kp + d0 * 2048); kf[2 * d0 + 1] = *(const LAS bf16x8*)(kp + d0 * 2048 + 512); }
__device__ __forceinline__ s16x4 vtr(lds_cptr p) { return __builtin_bit_cast(s16x4, __builtin_amdgcn_ds_read_tr16_b64_v4i16((LAS s16x4*)p)); }
#define A2_MX3(a, b, c) __builtin_fmaxf(__builtin_fmaxf((a), (b)), (c))
__device__ __forceinline__ float rowmax(const f32x16& p0, const f32x16& p1) {
    float a = A2_MX3(p0[0], p0[1], p1[0]), b = A2_MX3(p0[2], p0[3], p1[1]); a = A2_MX3(a, p1[2], p1[3]);
#pragma unroll
    for (int r = 4; r < 16; r += 4) { a = A2_MX3(a, p0[r], p0[r + 1]); b = A2_MX3(b, p0[r + 2], p0[r + 3]); a = A2_MX3(a, p1[r], p1[r + 1]); b = A2_MX3(b, p1[r + 2], p1[r + 3]); }
    float m = __builtin_fmaxf(a, b); auto rr = __builtin_amdgcn_permlane32_swap(__float_as_uint(m), __float_as_uint(m), false, false);
    return __builtin_fmaxf(__uint_as_float(rr[0]), __uint_as_float(rr[1])); }
__device__ __forceinline__ void cmask(f32x16& p0, f32x16& p1, int jb, int qrel, int hi) {
    const float NEG = -__builtin_inff(); const int kb = 64 * jb + 4 * hi;
#pragma unroll
    for (int r = 0; r < 16; ++r) { const int kv = kb + (r & 3) + 8 * (r >> 2); if (kv > qrel) p0[r] = NEG; if (kv + 32 > qrel) p1[r] = NEG; } }

__device__ __forceinline__ void attn_unit(const Frame& F, int b, int h, int qb, LAS unsigned char* scratch) {
    PHASE_IDS;
    const int tid = TID_, wid = WAVE_, lane = tid & 63, r32 = lane & 31, hi = lane >> 5;
    const bf16* Qg = wsp<bf16>(F, WS_Q); const bf16* Kg = wsp<bf16>(F, WS_K); const bf16* Vg = wsp<bf16>(F, WS_V);
    const size_t rowbase = (size_t)b * SEQ; const int q0 = qb * MOBA, NT = (q0 + MOBA) / KVBLK;
    const bf16* Qw = Qg + (rowbase + q0 + wid * QBLK) * AW + h * HD;
    const unsigned lds0 = (unsigned)(size_t)scratch; LAS float* wsf = (LAS float*)(scratch + LDS_WS) + wid * 64; LAS float* li_l = wsf + 32;
    const bf16* ksrc = Kg + rowbase * AW + h * HD + (size_t)lane * AW + wid * 8;
    const bf16* vsrc = Vg + rowbase * AW + h * HD + (size_t)(16 * (wid & 3) + (lane >> 2)) * AW + (wid >> 2) * 32 + (lane & 3) * 8;
    const unsigned kdst = lds0 + LDS_K + wid * 1024, vdst = lds0 + LDS_V + wid * 1024;
#define A2_DMA_K(t, slot) glds16(ksrc + (size_t)(t) * KVBLK * AW, (unsigned)__builtin_amdgcn_readfirstlane((int)(kdst + (slot))))
#define A2_DMA_V(t, slot) glds16(vsrc + (size_t)(t) * KVBLK * AW, (unsigned)__builtin_amdgcn_readfirstlane((int)(vdst + (slot))))
    const lds_cptr vp0 = (lds_cptr)scratch + LDS_V + ((lane >> 4) & 1) * 32 + (lane & 3) * 8 + (4 * hi + ((lane & 15) >> 2)) * 64;
    const lds_cptr kp0 = (lds_cptr)scratch + LDS_K + hi * 1024 + r32 * 16;
    A2_DMA_K(0, 0); A2_DMA_V(0, 0); A2_DMA_K(1, SLOTB);
    bf16x8 qr[4];
#pragma unroll
    for (int d0 = 0; d0 < 4; ++d0) qr[d0] = *(const bf16x8*)(Qw + (size_t)r32 * AW + d0 * 16 + hi * 8);
    unsigned sel = 0u;
    if (qb <= 3) sel = (1u << qb) - 1u;
    else {
        const float* km = wsp<float>(F, WS_KMEAN) + (size_t)((b * NH + h) * NBLK) * HD + (size_t)(r32 & 7) * HD + hi * 8;
        f32x4 kv[4][2];
#pragma unroll
        for (int d0 = 0; d0 < 4; ++d0) { kv[d0][0] = *(const f32x4*)(km + d0 * 16); kv[d0][1] = *(const f32x4*)(km + d0 * 16 + 4); }
        f32x16 gacc = f32x16{};
#pragma unroll
        for (int d0 = 0; d0 < 4; ++d0) { float f[8] = {kv[d0][0][0], kv[d0][0][1], kv[d0][0][2], kv[d0][0][3], kv[d0][1][0], kv[d0][1][1], kv[d0][1][2], kv[d0][1][3]};
            unsigned hw[4], lw[4];
#pragma unroll
            for (int p = 0; p < 4; ++p) { float a0 = f[2 * p], a1 = f[2 * p + 1]; if (r32 >= 8) { a0 = 0.f; a1 = 0.f; }
                const unsigned h0 = f2bf(a0), h1 = f2bf(a1); hw[p] = h0 | (h1 << 16); lw[p] = pk2(a0 - bf2f((bf16)h0), a1 - bf2f((bf16)h1)); }
            const v4u hv = {hw[0], hw[1], hw[2], hw[3]}, lv = {lw[0], lw[1], lw[2], lw[3]};
            gacc = __builtin_amdgcn_mfma_f32_32x32x16_bf16(__builtin_bit_cast(bf16x8, hv), qr[d0], gacc, 0, 0, 0);
            gacc = __builtin_amdgcn_mfma_f32_32x32x16_bf16(__builtin_bit_cast(bf16x8, lv), qr[d0], gacc, 0, 0, 0); }
        float g[8];
#pragma unroll
        for (int r = 0; r < 4; ++r) { const float mine = gacc[r], other = __shfl_xor(mine, 32); g[r] = hi ? other : mine; g[4 + r] = hi ? mine : other; }
        float b0 = -__builtin_inff(), b1 = b0, b2 = b0; int i0 = 0, i1 = 0, i2 = 0;
#pragma unroll
        for (int j = 0; j < NBLK - 1; ++j) { const float s_ = (j < qb) ? g[j] : -__builtin_inff();
            if (s_ > b0) { b2 = b1; i2 = i1; b1 = b0; i1 = i0; b0 = s_; i0 = j; } else if (s_ > b1) { b2 = b1; i2 = i1; b1 = s_; i1 = j; } else if (s_ > b2) { b2 = s_; i2 = j; } }
        sel = (1u << i0) | (1u << i1) | (1u << i2);
    }
    float mhat = MH0, l_reg = 0.f; f32x16 o[2]; o[0] = f32x16{}; o[1] = f32x16{};
    f32x16 negm;
#define A2_NEGM(t) do { const float nm_ = A2_KEEP(t) ? -mhat : -__builtin_inff(); _Pragma("unroll") for (int r = 0; r < 16; ++r) negm[r] = nm_; A2_PIN(negm); } while (0)
    const int qrel = wid * QBLK + r32; bool resc = false;
    f32x16 pA0, pA1, pB0, pB1; bf16x8 kf[8]; s16x4 vlo[8], vhi[8]; v4u pw0, pw1, pw2, pw3;
    int sl_prev = 0, sl_cur = 0, sl_next = SLOTB;
#define A2_ROT() do { sl_prev = sl_cur; sl_cur = sl_next; sl_next = (sl_next == 2 * SLOTB) ? 0 : sl_next + SLOTB; } while (0)
#define A2_EX(v) __builtin_amdgcn_exp2f(v)
#define A2_RESC() do { if (resc) { _Pragma("unroll") for (int d_ = 0; d_ < 2; ++d_) _Pragma("unroll") for (int r = 0; r < 16; ++r) o[d_][r] *= wsf[crow(r, hi)]; } } while (0)
#define A2_KEEP(t) (((t) >= NT - 4) || (((sel >> ((t) >> 2)) & 1u) != 0u))
    A2_NEGM(0);
#define A2_DECIDE(C0, C1) do { const float rm = rowmax(C0, C1); resc = false; \
      if (__builtin_expect(__any(rm > THR), 0)) { const float dl = __builtin_fmaxf(rm, 0.f); mhat += dl; \
          _Pragma("unroll") for (int r = 0; r < 16; ++r) { C0[r] -= dl; C1[r] -= dl; } \
          { const float nm_ = (rm > -__builtin_inff()) ? -mhat : -__builtin_inff(); _Pragma("unroll") for (int r = 0; r < 16; ++r) negm[r] = nm_; A2_PIN(negm); } \
          const float f = __builtin_amdgcn_exp2f(-dl); l_reg *= f; if (hi == 0) wsf[r32] = f; resc = true; } } while (0)
    A2_DMA_K(2, 2 * SLOTB);
    A2_WAIT_BAR(1);
    _Pragma("unroll") for (int d0 = 0; d0 < 4; ++d0) kload2(kf, kp0, d0);
    pA0 = A2_MFMA(kf[0], qr[0], negm); pA1 = A2_MFMA(kf[1], qr[0], negm); pA0 = A2_MFMA(kf[2], qr[1], pA0); pA1 = A2_MFMA(kf[3], qr[1], pA1);
    pA0 = A2_MFMA(kf[4], qr[2], pA0); pA1 = A2_MFMA(kf[5], qr[2], pA1); pA0 = A2_MFMA(kf[6], qr[3], pA0); pA1 = A2_MFMA(kf[7], qr[3], pA1);
    if (NT == 4) cmask(pA0, pA1, 0, qrel, hi);
    A2_DECIDE(pA0, pA1);
#pragma unroll
    for (int r = 0; r < 16; ++r) { pA0[r] = A2_EX(pA0[r]); pA1[r] = A2_EX(pA1[r]); }
    A2_WAIT_BAR(0);
    A2_DMA_K(3, 0); A2_DMA_V(1, SLOTB); A2_ROT();
    _Pragma("unroll") for (int d0 = 0; d0 < 4; ++d0) kload2(kf, kp0 + sl_cur, d0);
    A2_WAIT_BAR(2);
#define A2_PKW(P, i) cvt_pk_bf16(P[i], P[i + 1])
#define A2_PAF(k) __builtin_bit_cast(bf16x8, pw##k)
#define A2_VFR(i) (bf16x8){vlo[i][0], vlo[i][1], vlo[i][2], vlo[i][3], vhi[i][0], vhi[i][1], vhi[i][2], vhi[i][3]}
#define A2_VRD(i) do { vlo[i] = vtr(vp_ + (((i) >> 2) * 4096 + ((i) & 3) * 1024)); vhi[i] = vtr(vp_ + (((i) >> 2) * 4096 + ((i) & 3) * 1024 + 512)); } while (0)
#define A2_KRD(G, d0) do { if (G) { kload2(kf, kp0 + sl_next, d0); A2_SBAR(); } } while (0)
#define A2_GAPA(MF, a0, a1, a2, a3, W0, W1, PW) do { MF; sacc += a0; sacc += a1; sacc += a2; sacc += a3; W0; W1; A2_PIN(PW); A2_PIN(sacc); A2_SBAR(); } while (0)
#define A2_GAPB(MF, X, i) do { MF; X[i] = A2_EX(X[i]); X[i + 1] = A2_EX(X[i + 1]); X[i + 2] = A2_EX(X[i + 2]); X[i + 3] = A2_EX(X[i + 3]); A2_PIN(X); A2_SBAR(); } while (0)
#define A2_STEP(C0, C1, P0, P1, t, MASK, GK, GV, GL) do { A2_SBAR(); \
    const lds_cptr vp_ = vp0 + sl_prev; \
    A2_VRD(0); A2_SBAR(); float sacc = P0[0] + P0[1]; \
                          A2_GAPA(C0 = A2_MFMA(kf[0], qr[0], negm), P0[2], P0[3], P0[4], P0[5],     pw0[0] = A2_PKW(P0, 0),  pw0[1] = A2_PKW(P0, 2),  pw0); \
    A2_VRD(4); A2_SBAR(); A2_GAPA(C1 = A2_MFMA(kf[1], qr[0], negm), P0[6], P0[7], P0[8], P0[9],     pw0[2] = A2_PKW(P0, 4),  pw0[3] = A2_PKW(P0, 6),  pw0); \
    A2_VRD(1); A2_SBAR(); A2_GAPA(C0 = A2_MFMA(kf[2], qr[1], C0),    P0[10], P0[11], P0[12], P0[13], pw1[0] = A2_PKW(P0, 8),  pw1[1] = A2_PKW(P0, 10), pw1); \
    A2_VRD(5); A2_SBAR(); A2_GAPA(C1 = A2_MFMA(kf[3], qr[1], C1),    P0[14], P0[15], P1[0], P1[1],   pw1[2] = A2_PKW(P0, 12), pw1[3] = A2_PKW(P0, 14), pw1); \
    A2_VRD(2); A2_SBAR(); A2_GAPA(C0 = A2_MFMA(kf[4], qr[2], C0),    P1[2], P1[3], P1[4], P1[5],     pw2[0] = A2_PKW(P1, 0),  pw2[1] = A2_PKW(P1, 2),  pw2); \
    A2_VRD(6); A2_SBAR(); A2_GAPA(C1 = A2_MFMA(kf[5], qr[2], C1),    P1[6], P1[7], P1[8], P1[9],     pw2[2] = A2_PKW(P1, 4),  pw2[3] = A2_PKW(P1, 6),  pw2); \
    A2_VRD(3); A2_SBAR(); A2_GAPA(C0 = A2_MFMA(kf[6], qr[3], C0),    P1[10], P1[11], P1[12], P1[13], pw3[0] = A2_PKW(P1, 8),  pw3[1] = A2_PKW(P1, 10), pw3); \
    A2_VRD(7); A2_SBAR(); A2_GAPA(C1 = A2_MFMA(kf[7], qr[3], C1),    P1[14], P1[15], 0.f, 0.f,       pw3[2] = A2_PKW(P1, 12), pw3[3] = A2_PKW(P1, 14), pw3); \
    l_reg += sacc; \
    if (GK) A2_DMA_K((t) + 3, sl_cur); if (GV) A2_DMA_V((t) + 1, sl_next); \
    if (MASK) cmask(C0, C1, (t) - (NT - 4), qrel, hi); \
    A2_DECIDE(C0, C1); A2_SBAR(); \
    A2_GAPB(o[0] = A2_MFMA(A2_PAF(0), A2_VFR(0), o[0]), C0, 0);                 A2_GAPB(o[1] = A2_MFMA(A2_PAF(0), A2_VFR(4), o[1]), C0, 4); \
    A2_KRD(GL, 0); A2_GAPB(o[0] = A2_MFMA(A2_PAF(1), A2_VFR(1), o[0]), C0, 8);  A2_KRD(GL, 1); A2_GAPB(o[1] = A2_MFMA(A2_PAF(1), A2_VFR(5), o[1]), C0, 12); \
    A2_KRD(GL, 2); A2_GAPB(o[0] = A2_MFMA(A2_PAF(2), A2_VFR(2), o[0]), C1, 0);  A2_KRD(GL, 3); A2_GAPB(o[1] = A2_MFMA(A2_PAF(2), A2_VFR(6), o[1]), C1, 4); \
    A2_GAPB(o[0] = A2_MFMA(A2_PAF(3), A2_VFR(3), o[0]), C1, 8);                 A2_GAPB(o[1] = A2_MFMA(A2_PAF(3), A2_VFR(7), o[1]), C1, 12); \
    if ((((t) + 1) & 3) == 0) A2_NEGM((t) + 1);                         \
    } while (0)
    int t = 1;
    for (; t + 5 < NT; t += 2) {
        A2_STEP(pB0, pB1, pA0, pA1, t, false, true, true, true);     A2_WAIT_BAR(2); A2_RESC(); A2_ROT();
        A2_STEP(pA0, pA1, pB0, pB1, t + 1, false, true, true, true); A2_WAIT_BAR(2); A2_RESC(); A2_ROT();
    }
#define A2_ENDW(tt) do { if ((tt) + 3 < NT) { A2_WAIT_BAR(2); } else if ((tt) + 2 < NT) { A2_WAIT_BAR(1); } else { A2_WAIT_BAR(0); } } while (0)
    for (; t + 1 < NT; t += 2) {
        A2_STEP(pB0, pB1, pA0, pA1, t, true, (t + 3 < NT), (t + 1 < NT), (t + 1 < NT));         A2_ENDW(t);     A2_RESC(); A2_ROT();
        A2_STEP(pA0, pA1, pB0, pB1, t + 1, true, (t + 4 < NT), (t + 2 < NT), (t + 2 < NT));     A2_ENDW(t + 1); A2_RESC(); A2_ROT();
    }
    A2_STEP(pB0, pB1, pA0, pA1, NT - 1, true, false, false, false); A2_RESC();
    { float sacc = pB0[0] + pB0[1];
#pragma unroll
      for (int r = 2; r < 16; ++r) sacc += pB0[r];
#pragma unroll
      for (int r = 0; r < 16; ++r) sacc += pB1[r];
      l_reg += sacc;
      pw0 = (v4u){A2_PKW(pB0, 0), A2_PKW(pB0, 2), A2_PKW(pB0, 4), A2_PKW(pB0, 6)}; pw1 = (v4u){A2_PKW(pB0, 8), A2_PKW(pB0, 10), A2_PKW(pB0, 12), A2_PKW(pB0, 14)};
      pw2 = (v4u){A2_PKW(pB1, 0), A2_PKW(pB1, 2), A2_PKW(pB1, 4), A2_PKW(pB1, 6)}; pw3 = (v4u){A2_PKW(pB1, 8), A2_PKW(pB1, 10), A2_PKW(pB1, 12), A2_PKW(pB1, 14)};
      const lds_cptr vp_ = vp0 + sl_cur; _Pragma("unroll") for (int i = 0; i < 8; ++i) A2_VRD(i);
      o[0] = A2_MFMA(A2_PAF(0), A2_VFR(0), o[0]); o[1] = A2_MFMA(A2_PAF(0), A2_VFR(4), o[1]); o[0] = A2_MFMA(A2_PAF(1), A2_VFR(1), o[0]); o[1] = A2_MFMA(A2_PAF(1), A2_VFR(5), o[1]);
      o[0] = A2_MFMA(A2_PAF(2), A2_VFR(2), o[0]); o[1] = A2_MFMA(A2_PAF(2), A2_VFR(6), o[1]); o[0] = A2_MFMA(A2_PAF(3), A2_VFR(3), o[0]); o[1] = A2_MFMA(A2_PAF(3), A2_VFR(7), o[1]); }
    { auto rr = __builtin_amdgcn_permlane32_swap(__float_as_uint(l_reg), __float_as_uint(l_reg), false, false); l_reg = __uint_as_float(rr[0]) + __uint_as_float(rr[1]); }
    if (hi == 0) li_l[r32] = l_reg; asm volatile("s_waitcnt lgkmcnt(0)" ::: "memory");
    float rli[16];
#pragma unroll
    for (int r = 0; r < 16; ++r) rli[r] = __builtin_amdgcn_rcpf(li_l[crow(r, hi)]);
    bf16* Ow = wsp<bf16>(F, WS_MIX) + (rowbase + q0 + wid * QBLK) * DM + h * HD;
    float* ssqa = wsp<float>(F, WS_SSQA) + (rowbase + q0 + wid * QBLK) * NH + h;
    float qq[16];
#pragma unroll
    for (int r = 0; r < 16; ++r) { const int orow = crow(r, hi); float q2 = 0.f;
#pragma unroll
        for (int d0 = 0; d0 < 2; ++d0) { const float v = o[d0][r] * rli[r]; const float vn = __shfl_xor(v, 1); q2 += v * v;
            if ((r32 & 1) == 0) *(unsigned*)(Ow + (size_t)orow * DM + d0 * 32 + r32) = cvt_pk_bf16(v, vn); }
        qq[r] = q2; }
#pragma unroll
    for (int i = 0; i < 8; ++i) { const bool up = (lane & 16) != 0; const float send = up ? qq[i] : qq[i + 8], keep = up ? qq[i + 8] : qq[i]; qq[i] = keep + __shfl_xor(send, 16); }
#pragma unroll
    for (int i = 0; i < 4; ++i) { const bool up = (lane & 8) != 0; const float send = up ? qq[i] : qq[i + 4], keep = up ? qq[i + 4] : qq[i]; qq[i] = keep + __shfl_xor(send, 8); }
#pragma unroll
    for (int i = 0; i < 2; ++i) { const bool up = (lane & 4) != 0; const float send = up ? qq[i] : qq[i + 2], keep = up ? qq[i + 2] : qq[i]; qq[i] = keep + __shfl_xor(send, 4); }
    { const bool up = (lane & 2) != 0; const float send = up ? qq[0] : qq[1], keep = up ? qq[1] : qq[0]; qq[0] = keep + __shfl_xor(send, 2); }
    qq[0] += __shfl_xor(qq[0], 1);
    if ((lane & 1) == 0) ssqa[(size_t)crow(r32 >> 1, hi) * NH] = qq[0];
    asm volatile("s_waitcnt lgkmcnt(0)\n\ts_barrier" ::: "memory");
#undef A2_DMA_K
#undef A2_NEGM
#undef A2_DECIDE
#undef A2_DMA_V
#undef A2_ROT
#undef A2_EX
#undef A2_RESC
#undef A2_KEEP
#undef A2_PKW
#undef A2_PAF
#undef A2_VFR
#undef A2_VRD
#undef A2_KRD
#undef A2_ENDW
#undef A2_GAPA
#undef A2_GAPB
#undef A2_STEP
}
}

namespace gm {
__device__ __forceinline__ int vt_key(int p) { return ((p & 3) << 2) ^ ((p & 4) >> 1) ^ ((p & 8) ? 3 : 0); }
__device__ __forceinline__ int vt_off(int p, int s) { return p * 256 + ((((s >> 3) ^ vt_key(p)) & 15) << 4) + (s & 7) * 2; }
__device__ __forceinline__ int vt_row(int d) { return 32 * (d >> 5) + 16 * ((d >> 2) & 1) + 4 * ((d >> 3) & 3) + (d & 3); }
__device__ __forceinline__ void units4(const Frame& F, int v, LAS unsigned char* scratch) {
    PHASE_IDS;
    const int tid = TID_, wid = tid >> 6, lane = tid & 63, fr = lane & 15, fq = lane >> 4;
    const int u = wid >> 1, half = wid & 1, uidx = 4 * v + u, b = uidx >> 6, c = (uidx >> 2) & 15, g = uidx & 3;
    const size_t row0 = (size_t)b * SEQ + c * GC;
    const bf16* VGg = wsp<bf16>(F, WS_VG) + row0 * GW + g * GD; const bf16* Ug = wsp<bf16>(F, WS_U) + row0 * GW + g * GD;
    LAS unsigned char* vt = scratch + u * 32768;
    { const int q = lane & 3, pg = lane >> 2; v4u raw[4][4]; float mu[4], rstd[4];
#pragma unroll
      for (int jj = 0; jj < 4; ++jj) { const v4u* src = (const v4u*)(VGg + (size_t)(half * 64 + pg + 16 * jj) * GW) + q;
#pragma unroll
          for (int i = 0; i < 4; ++i) raw[jj][i] = src[4 * i]; }
#pragma unroll
      for (int jj = 0; jj < 4; ++jj) { float sum = 0.f, sq = 0.f;
#pragma unroll
          for (int i = 0; i < 4; ++i) { const unsigned ww[4] = {raw[jj][i].x, raw[jj][i].y, raw[jj][i].z, raw[jj][i].w};
#pragma unroll
              for (int k = 0; k < 4; ++k) { const float a0 = bflo(ww[k]), a1 = bfhi(ww[k]); sum += a0 + a1; sq += a0 * a0 + a1 * a1; } }
          sum += __shfl_xor(sum, 1); sq += __shfl_xor(sq, 1); sum += __shfl_xor(sum, 2); sq += __shfl_xor(sq, 2);
          mu[jj] = sum * (1.f / GD); const float var = fmaxf(sq * (1.f / GD) - mu[jj] * mu[jj], 0.f); rstd[jj] = 1.0f / sqrtf(var + EPS); }
      const float* lg = F.ln_g + g * GD + 8 * q; const float* lb = F.ln_b + g * GD + 8 * q;
#pragma unroll
      for (int i = 0; i < 4; ++i) { const f32x4 g0 = *(const f32x4*)(lg + 32 * i), g1 = *(const f32x4*)(lg + 32 * i + 4), b0 = *(const f32x4*)(lb + 32 * i), b1 = *(const f32x4*)(lb + 32 * i + 4);
          const float gg[8] = {g0[0], g0[1], g0[2], g0[3], g1[0], g1[1], g1[2], g1[3]}, bb[8] = {b0[0], b0[1], b0[2], b0[3], b1[0], b1[1], b1[2], b1[3]};
#pragma unroll
          for (int jj = 0; jj < 4; ++jj) { const int s_ = half * 64 + pg + 16 * jj; const unsigned ww[4] = {raw[jj][i].x, raw[jj][i].y, raw[jj][i].z, raw[jj][i].w};
#pragma unroll
              for (int k = 0; k < 4; ++k) {
                  const int p = 32 * i + 16 * (k >> 1) + 4 * q + ((2 * k) & 3);
                  *(LAS unsigned short*)(vt + vt_off(p, s_)) = (unsigned short)f2bf((bflo(ww[k]) - mu[jj]) * rstd[jj] * gg[2 * k] + bb[2 * k]);
                  *(LAS unsigned short*)(vt + vt_off(p + 1, s_)) = (unsigned short)f2bf((bfhi(ww[k]) - mu[jj]) * rstd[jj] * gg[2 * k + 1] + bb[2 * k + 1]); } } } }
    __syncthreads();
#pragma unroll
    for (int m = 0; m < 4; ++m) {
        const int tb = half * 64 + m * 16, t = tb + fr;
        const float* Wg = F.gws + (size_t)g * GC * GC + (size_t)t * GC;
        const int nks = (tb + 16 + 31) / 32;
        f32x4 w0[4], w1[4];
#pragma unroll
        for (int ks = 0; ks < 4; ++ks) if (ks < nks) { w0[ks] = *(const f32x4*)(Wg + ks * 32 + fq * 8); w1[ks] = *(const f32x4*)(Wg + ks * 32 + fq * 8 + 4); }
        const bf16* Ut = Ug + (size_t)t * GW + 8 * fq; v4u uu[4];
#pragma unroll
        for (int k = 0; k < 4; ++k) uu[k] = *(const v4u*)(Ut + k * 32);
        f32x4 acc[8];
#pragma unroll
        for (int n = 0; n < 8; ++n) acc[n] = (f32x4){0.f, 0.f, 0.f, 0.f};
#pragma unroll
        for (int ks = 0; ks < 4; ++ks) if (ks < nks) { const int s0 = ks * 32 + fq * 8;
            float wv[8] = {w0[ks][0], w0[ks][1], w0[ks][2], w0[ks][3], w1[ks][0], w1[ks][1], w1[ks][2], w1[ks][3]};
#pragma unroll
            for (int j = 0; j < 8; ++j) if (s0 + j > t) wv[j] = 0.f;
            v4u aw; aw.x = pk2(wv[0], wv[1]); aw.y = pk2(wv[2], wv[3]); aw.z = pk2(wv[4], wv[5]); aw.w = pk2(wv[6], wv[7]);
            const bf16x8 wf = *reinterpret_cast<const bf16x8*>(&aw);
#pragma unroll
            for (int n = 0; n < 8; ++n) { const bf16x8 vf = *(const LAS bf16x8*)(vt + vt_off(n * 16 + fr, s0));
                acc[n] = __builtin_amdgcn_mfma_f32_16x16x32_bf16(vf, wf, acc[n], 0, 0, 0); } }
        bf16* Og = wsp<bf16>(F, WS_MIX) + (row0 + t) * DM + AW + g * GD + 8 * fq; float* ssqg = wsp<float>(F, WS_SSQG) + (row0 + t) * GG + g;
        const float bs = F.gbs[g * GC + t]; float q2 = 0.f;
#pragma unroll
        for (int k = 0; k < 4; ++k) { const v4u un = uu[k]; const f32x4 a0 = acc[2 * k], a1 = acc[2 * k + 1];
            const float o0 = bflo(un.x) * (a0[0] + bs), o1 = bfhi(un.x) * (a0[1] + bs), o2 = bflo(un.y) * (a0[2] + bs), o3 = bfhi(un.y) * (a0[3] + bs);
            const float o4 = bflo(un.z) * (a1[0] + bs), o5 = bfhi(un.z) * (a1[1] + bs), o6 = bflo(un.w) * (a1[2] + bs), o7 = bfhi(un.w) * (a1[3] + bs);
            q2 += ((o0 * o0 + o1 * o1) + (o2 * o2 + o3 * o3)) + ((o4 * o4 + o5 * o5) + (o6 * o6 + o7 * o7));
            v4u w; w.x = cvt_pk_bf16(o0, o1); w.y = cvt_pk_bf16(o2, o3); w.z = cvt_pk_bf16(o4, o5); w.w = cvt_pk_bf16(o6, o7); *(v4u*)(Og + k * 32) = w; }
        q2 += __shfl_xor(q2, 16); q2 += __shfl_xor(q2, 32);
        if (fq == 0) ssqg[0] = q2;
    }
    __syncthreads();
}
}

__device__ __forceinline__ void p2_mixers(const Frame& F) {
    PHASE_IDS;
    LAS unsigned char* scratch = F.lds + RING_OFF;
    const int v = F.vcu, cslot = (v >> 1) % 6;
    int item = 0;
#pragma unroll 1
    for (int st = 0; st < 6; ++st) {
        if (st == cslot) { constexpr int PER_WG = XW_ITEMS / 256; static_assert(XW_ITEMS % 256 == 0 && PER_WG % NWAVES == 0, "items per workgroup / wave");
            LAS float* scr = (LAS float*)(F.lds + RING_OFF + WAVE_ * P0_SCR_WAVE);
            constexpr int NI = PER_WG / NWAVES; static_assert(NI % 2 == 0, "pairs");
            int ln = LANE_; asm volatile("" : "+v"(ln));
            const int it0 = v * PER_WG + WAVE_; f32x4 va[16], vb[16]; XwDesc da = xw_desc(F, it0, ln), db; xw_load(va, da);
#pragma unroll 1
            for (int j = 0; j < NI; j += 2) {
                db = xw_desc(F, it0 + (j + 1) * NWAVES, ln); xw_load(vb, db);
                xw_process(va, da, scr, ln);
                if (j + 2 < NI) { da = xw_desc(F, it0 + (j + 2) * NWAVES, ln); xw_load(va, da); }
                xw_process(vb, db, scr, ln);
            }
            __syncthreads(); }
        else { if (item < 4) { const int mbr = v & 3, bh = (v >> 5) * 16 + (item >> 1) * 8 + ((v >> 2) & 7); const int qb = (item & 1) ? 7 - mbr : mbr; att2::attn_unit(F, bh / NH, bh % NH, qb, scratch); }
               else gm::units4(F, v, scratch);
               ++item; }
    }
}

__device__ __forceinline__ void p4_router(const Frame& F) {
    PHASE_IDS;
    const int tid = TID_, wid = tid >> 6, lane = tid & 63, tk = lane & 31, hf = lane >> 5;
    LAS unsigned* hist = (LAS unsigned*)(F.lds + XTAB_OFF + 4096);
    LAS unsigned* base = hist + 32;
    static_assert(XTAB_OFF + 4096 >= 8 * P0_SCR_WAVE, "router words above the conversion tiles");
    const bf16* RWT = wsp<bf16>(F, WS_RWT); const bf16* x1 = wsp<bf16>(F, WS_X1B); const float* ssq1 = wsp<float>(F, WS_SSQ1);
    unsigned* cntg = (unsigned*)(F.ctl + CW_CNT);
    unsigned* IDX = wsp<unsigned>(F, WS_IDX); float* GSS = wsp<float>(F, WS_GSS); float* RSS = wsp<float>(F, WS_RSS); unsigned* TOKPOS = wsp<unsigned>(F, WS_TOKPOS);
    if (tid < 32) hist[tid] = 0u;
    __syncthreads();
    const bool active = wid < 4; const int tok = (F.vcu * 4 + (wid & 3)) * 32 + tk;
    int pe[4] = {0, 0, 0, 0}; float pg[4] = {0.f, 0.f, 0.f, 0.f}; unsigned rank[2] = {0u, 0u}; int my_e[2] = {0, 0}; float my_g[2] = {0.f, 0.f}; float rstd = 0.f;
    f32x16 acc = f32x16{};
    { constexpr int PITCH = 528; LAS unsigned char* XL = F.lds + RING_OFF; LAS unsigned char* WL = XL + 128 * PITCH;
      const int rsub = lane >> 5, cb = (lane & 31) * 16;
      const char* xsrc = (const char*)(x1 + (size_t)(F.vcu * 128 + 16 * wid + rsub) * DM) + cb; const char* wsrc = (const char*)(RWT + (size_t)(8 * wid + rsub) * DM) + cb;
      LAS unsigned char* xdst = XL + (16 * wid + rsub) * PITCH + cb; LAS unsigned char* wdst = WL + (8 * wid + rsub) * PITCH + cb;
      const LAS unsigned char* xb = XL + ((wid & 3) * 32 + tk) * PITCH + hf * 16; const LAS unsigned char* wa = WL + tk * PITCH + hf * 16; const LAS unsigned char* wb = wa + 32 * PITCH;
      v4u xs[8], ws_[4];
#define RT_LOAD(c) do { _Pragma("unroll") for (int i = 0; i < 8; ++i) xs[i] = *(const v4u*)(xsrc + (size_t)(2 * i) * DM * 2 + (c) * 512); \
                        _Pragma("unroll") for (int i = 0; i < 4; ++i) ws_[i] = *(const v4u*)(wsrc + (size_t)(2 * i) * DM * 2 + (c) * 512); } while (0)
      RT_LOAD(0);
#pragma unroll 1
      for (int c = 0; c < 4; ++c) {
#pragma unroll
          for (int i = 0; i < 8; ++i) *(LAS v4u*)(xdst + 2 * i * PITCH) = xs[i];
#pragma unroll
          for (int i = 0; i < 4; ++i) *(LAS v4u*)(wdst + 2 * i * PITCH) = ws_[i];
          __syncthreads();
          if (c < 3) RT_LOAD(c + 1);
          if (active) {
#pragma unroll
              for (int s_ = 0; s_ < 16; ++s_) { const bf16x8 xv = *(const LAS bf16x8*)(xb + 32 * s_), a_hi = *(const LAS bf16x8*)(wa + 32 * s_), a_lo = *(const LAS bf16x8*)(wb + 32 * s_);
                  acc = __builtin_amdgcn_mfma_f32_32x32x16_bf16(a_hi, xv, acc, 0, 0, 0); acc = __builtin_amdgcn_mfma_f32_32x32x16_bf16(a_lo, xv, acc, 0, 0, 0); } }
          __syncthreads();
      }
#undef RT_LOAD
    }
    if (active) {
        { const f32x4* sp = (const f32x4*)(ssq1 + (size_t)tok * 16); const f32x4 a = sp[0], b = sp[1], c = sp[2], d = sp[3];
          const float s_ = ((a[0] + a[1]) + (a[2] + a[3])) + ((b[0] + b[1]) + (b[2] + b[3])) + ((c[0] + c[1]) + (c[2] + c[3])) + ((d[0] + d[1]) + (d[2] + d[3]));
          rstd = 1.0f / sqrtf(s_ * (1.f / DM) + EPS); }
        float lv[16];
#pragma unroll
        for (int r = 0; r < 16; ++r) { const int e = (r & 3) + 8 * (r >> 2) + 4 * hf; lv[r] = acc[r] * rstd + F.router_b[e]; }
        float tv[4]; int ti[4]; unsigned used = 0u;
#pragma unroll
        for (int k = 0; k < 4; ++k) { float best = -__builtin_inff(); int br = 0;
#pragma unroll
            for (int r = 0; r < 16; ++r) { const int e = (r & 3) + 8 * (r >> 2) + 4 * hf; const int eb = (br & 3) + 8 * (br >> 2) + 4 * hf;
                const bool better = !((used >> r) & 1u) && (lv[r] > best || (lv[r] == best && e < eb)); if (better) { best = lv[r]; br = r; } }
            used |= 1u << br; tv[k] = best; ti[k] = (br & 3) + 8 * (br >> 2) + 4 * hf; }
        float ov[4]; int oi[4];
#pragma unroll
        for (int k = 0; k < 4; ++k) { ov[k] = __shfl_xor(tv[k], 32); oi[k] = __shfl_xor(ti[k], 32); }
        int ia = 0, ib = 0;
#pragma unroll
        for (int k = 0; k < 4; ++k) {
            float va = tv[0], vb = ov[0]; int ea = ti[0], eb = oi[0];
#pragma unroll
            for (int q = 1; q < 4; ++q) { if (ia == q) { va = tv[q]; ea = ti[q]; } if (ib == q) { vb = ov[q]; eb = oi[q]; } }
            const bool takeA = (va > vb) || (va == vb && ea < eb);
            pg[k] = takeA ? va : vb; pe[k] = takeA ? ea : eb; if (takeA) ++ia; else ++ib; }
        { const float m = pg[0]; float s_ = 0.f;
#pragma unroll
          for (int k = 0; k < 4; ++k) { pg[k] = __builtin_amdgcn_exp2f((pg[k] - m) * 1.4426950408889634f); s_ += pg[k]; }
          const float inv = 1.0f / s_;
#pragma unroll
          for (int k = 0; k < 4; ++k) pg[k] *= inv; }
        { const int m = -hf; my_e[0] = pe[0] ^ ((pe[0] ^ pe[2]) & m); my_e[1] = pe[1] ^ ((pe[1] ^ pe[3]) & m);
          const unsigned g0 = __float_as_uint(pg[0]), g1 = __float_as_uint(pg[1]), g2 = __float_as_uint(pg[2]), g3 = __float_as_uint(pg[3]);
          my_g[0] = __uint_as_float(g0 ^ ((g0 ^ g2) & (unsigned)m)); my_g[1] = __uint_as_float(g1 ^ ((g1 ^ g3) & (unsigned)m)); }
#pragma unroll
        for (int q = 0; q < 2; ++q) rank[q] = atomicAdd((unsigned*)&hist[my_e[q]], 1u);
    }
    __syncthreads();
    if (tid < 32) base[tid] = atomicAdd(cntg + tid * CNT_STRIDE, hist[tid]);
    __syncthreads();
    if (active) {
#pragma unroll
        for (int q = 0; q < 2; ++q) { const int k = 2 * hf + q; const int e = my_e[q]; const float g = my_g[q];
            const unsigned slot = base[e] + rank[q];
            IDX[(size_t)e * T + slot] = (unsigned)tok; GSS[(size_t)e * T + slot] = g; RSS[(size_t)e * T + slot] = rstd; TOKPOS[(size_t)tok * 4 + k] = ((unsigned)e << 16) | slot; }
    }
    __syncthreads();
}

__device__ __forceinline__ void build_tstart(const Frame& F, LAS unsigned* tstart, int tid) {
    if (tid < 64) { const unsigned* cntg = (const unsigned*)(F.ctl + CW_CNT); unsigned c = (tid < NE) ? cntg[tid * CNT_STRIDE] : 0u; if (c > (unsigned)T) c = (unsigned)T;
        unsigned x = (c + 255u) >> 8;
#pragma unroll
        for (int o = 1; o < 32; o <<= 1) { const unsigned y = __shfl_up(x, o); if ((tid & 63) >= o) x += y; }
        if (tid < NE) tstart[tid + 1] = x; if (tid == 0) tstart[0] = 0u; }
}
constexpr int MAXU = 17;
constexpr int XT_TSTART = 0, XT_ULIST = 256, XT_RS = 512, XT_GTAB = XT_RS + MAXU * 1024;
static_assert(XT_GTAB + MAXU * 512 <= LDSCTL_OFF - XTAB_OFF, "xtab");
__device__ __forceinline__ int moe_build_tables(const Frame& F, int P  , int mode) {
    PHASE_IDS;
    LAS unsigned* tstart = (LAS unsigned*)(F.lds + XTAB_OFF + XT_TSTART);
    LAS unsigned* ulist = (LAS unsigned*)(F.lds + XTAB_OFF + XT_ULIST);
    LAS float* rs = (LAS float*)(F.lds + XTAB_OFF + XT_RS);
    LAS unsigned short* gtab = (LAS unsigned short*)(F.lds + XTAB_OFF + XT_GTAB);
    const unsigned* cntg = (const unsigned*)(F.ctl + CW_CNT); const unsigned* IDX = wsp<unsigned>(F, WS_IDX);
    const float* RSRC = mode == 1 ? wsp<float>(F, WS_RSS) : wsp<float>(F, WS_GSS);
    const int tid = TID_;
    build_tstart(F, tstart, tid);
    __syncthreads();
    const int NT_ = (int)tstart[NE], U = NT_ * P, G = F.G, c = (int)blockIdx.x;
    int nunits = (c < U) ? (U - c + G - 1) / G : 0; if (nunits > MAXU) nunits = MAXU;
    if (tid < nunits) { const int L = tid * G + c; int gt, pn; pg8::flat_to_tile(L, U, NT_, P, gt, pn);
        int e = 0; for (int k = 1; k < NE; ++k) if ((unsigned)gt >= tstart[k]) e = k;
        const int rt = gt - (int)tstart[e];
        ulist[tid] = (unsigned)gt | ((unsigned)pn << 10) | ((unsigned)e << 13) | ((unsigned)rt << 18); }
    __syncthreads();
    {
        constexpr int NP = (MAXU + 1) / 2; unsigned tokv[NP]; float rsv[NP];
#pragma unroll
        for (int p = 0; p < NP; ++p) { const int i = 2 * p + (tid >> 8), r = tid & 255; tokv[p] = 0u; rsv[p] = 0.f;
            if (i < nunits) { const unsigned w = ulist[i]; const int e = (int)((w >> 13) & 0x1fu), rt = (int)(w >> 18);
                unsigned cn = cntg[e * CNT_STRIDE]; if (cn > (unsigned)T) cn = (unsigned)T; const unsigned slot = (unsigned)rt * 256u + (unsigned)r;
                if (slot < cn) { if (mode == 1) tokv[p] = IDX[(size_t)e * T + slot]; rsv[p] = RSRC[(size_t)e * T + slot]; } } }
#pragma unroll
        for (int p = 0; p < NP; ++p) { const int i = 2 * p + (tid >> 8), r = tid & 255;
            if (i < nunits) { unsigned tok = tokv[p]; if (tok >= (unsigned)T) tok = 0u; if (mode == 1) gtab[i * 256 + r] = (unsigned short)tok; rs[i * 256 + r] = rsv[p]; } }
    }
    __syncthreads();
    return nunits;
}

__device__ __forceinline__ void p7_combine(const Frame& F) {
    PHASE_IDS;
    LAS unsigned* tstart = (LAS unsigned*)(F.lds + XTAB_OFF + XT_TSTART);
    build_tstart(F, tstart, TID_);
    __syncthreads();
    const int gw = F.vcu * NWAVES + WAVE_, NGW = F.G * NWAVES;
    const unsigned* TOKPOS = wsp<unsigned>(F, WS_TOKPOS); const unsigned char* Y = wsp<unsigned char>(F, WS_YBUF); const bf16* X1 = wsp<bf16>(F, WS_X1B); bf16* X2 = wsp<bf16>(F, WS_X2B); unsigned char* X28 = wsp<unsigned char>(F, WS_X2F8); float* RS2 = wsp<float>(F, WS_RSTD2);
    for (int m0 = gw; m0 < T; m0 += 2 * NGW) {
        v4u xv[2][2]; v2u yv[2][2][4]; float s[2] = {0.f, 0.f};
#pragma unroll
        for (int r = 0; r < 2; ++r) { const int m = m0 + r * NGW;
            const v4u tp = *(const v4u*)(TOKPOS + (size_t)m * 4); const unsigned tpw[4] = {tp.x, tp.y, tp.z, tp.w};
            size_t yrow[4];
#pragma unroll
            for (int k = 0; k < 4; ++k) { const unsigned e = (tpw[k] >> 16) & 31u, slot = tpw[k] & 0xffffu; yrow[k] = ((size_t)tstart[e] * 256u + slot) * DM; }
#pragma unroll
            for (int j = 0; j < 2; ++j) { const int c0 = 8 * LANE_ + 512 * j; xv[r][j] = __builtin_nontemporal_load((const v4u*)(X1 + (size_t)m * DM + c0));
#pragma unroll
                for (int k = 0; k < 4; ++k) yv[r][j][k] = __builtin_nontemporal_load((const v2u*)(Y + yrow[k] + c0)); } }
        f32x4 v[2][2][2];
#pragma unroll
        for (int r = 0; r < 2; ++r) {
#pragma unroll
            for (int j = 0; j < 2; ++j) { const v4u xw = xv[r][j]; v[r][j][0] = (f32x4){bflo(xw.x), bfhi(xw.x), bflo(xw.y), bfhi(xw.y)}; v[r][j][1] = (f32x4){bflo(xw.z), bfhi(xw.z), bflo(xw.w), bfhi(xw.w)};
#pragma unroll
                for (int k = 0; k < 4; ++k) { const v2u w = yv[r][j][k];
                    const f32x2 a0 = __builtin_amdgcn_cvt_pk_f32_fp8((int)w.x, false), a1 = __builtin_amdgcn_cvt_pk_f32_fp8((int)w.x, true), b0 = __builtin_amdgcn_cvt_pk_f32_fp8((int)w.y, false), b1 = __builtin_amdgcn_cvt_pk_f32_fp8((int)w.y, true);
                    v[r][j][0] += (f32x4){a0[0], a0[1], a1[0], a1[1]} * (1.0f / Y_SCALE); v[r][j][1] += (f32x4){b0[0], b0[1], b1[0], b1[1]} * (1.0f / Y_SCALE); }
#pragma unroll
                for (int h = 0; h < 2; ++h) { const f32x4 t = v[r][j][h]; s[r] += (t.x * t.x + t.y * t.y) + (t.z * t.z + t.w * t.w); } } }
#pragma unroll
        for (int r = 0; r < 2; ++r) { const int m = m0 + r * NGW; const float rstd = 1.0f / sqrtf(wave_sum(s[r]) * (1.f / DM) + EPS);
            if (LANE_ == 0) RS2[m] = rstd;
#pragma unroll
            for (int j = 0; j < 2; ++j) { const int c0 = 8 * LANE_ + 512 * j; const f32x4 t0 = v[r][j][0], t1 = v[r][j][1];
                v4u w; w.x = cvt_pk_bf16(t0.x, t0.y); w.y = cvt_pk_bf16(t0.z, t0.w); w.z = cvt_pk_bf16(t1.x, t1.y); w.w = cvt_pk_bf16(t1.z, t1.w); *(v4u*)(X2 + (size_t)m * DM + c0) = w;
                v2u w8; w8.x = pk4_fp8(t0.x, t0.y, t0.z, t0.w); w8.y = pk4_fp8(t1.x, t1.y, t1.z, t1.w); *(v2u*)(X28 + (size_t)m * DM + c0) = w8; } }
    }
}

__device__ __forceinline__ void p9_final(const Frame& F) {
    PHASE_IDS;
    const int gw = F.vcu * NWAVES + WAVE_, NGW = F.G * NWAVES;
    const unsigned char* GATE = wsp<unsigned char>(F, WS_GATE); const unsigned char* PP = wsp<unsigned char>(F, WS_PP); const float* ssqpp = wsp<float>(F, WS_SSQPP);
    f32x4 pgv[4], fgv[4];
#pragma unroll
    for (int j = 0; j < 4; ++j) { pgv[j] = *(const f32x4*)(F.ppn + 4 * LANE_ + 256 * j); fgv[j] = *(const f32x4*)(F.final_norm + 4 * LANE_ + 256 * j); }
    for (int m0 = gw; m0 < T; m0 += 2 * NGW) {
        f32x4 v[2][4]; unsigned gv[2][4], pv_[2][4]; float sq[2]; float s[2] = {0.f, 0.f};
#pragma unroll
        for (int r = 0; r < 2; ++r) { const int m = m0 + r * NGW; const bf16* x2r = wsp<bf16>(F, WS_X2B) + (size_t)m * DM;
            sq[r] = (LANE_ < 16) ? ssqpp[(size_t)m * 16 + LANE_] : 0.f;
#pragma unroll
            for (int j = 0; j < 4; ++j) { const int col = 4 * LANE_ + 256 * j; const v2u xw = __builtin_nontemporal_load((const v2u*)(x2r + col)); v[r][j] = (f32x4){bflo(xw.x), bfhi(xw.x), bflo(xw.y), bfhi(xw.y)};
                gv[r][j] = __builtin_nontemporal_load((const unsigned*)(GATE + (size_t)m * DM + col)); pv_[r][j] = __builtin_nontemporal_load((const unsigned*)(PP + (size_t)m * DM + col)); } }
#pragma unroll
        for (int r = 0; r < 2; ++r) { const float sp = wave_sum(sq[r]);
            const float rpp = 1.0f / sqrtf(sp * (1.f / DM) + EPS);
#pragma unroll
            for (int j = 0; j < 4; ++j) { const f32x4 pg_ = pgv[j];
                const f32x2 g01 = __builtin_amdgcn_cvt_pk_f32_fp8((int)gv[r][j], false), g23 = __builtin_amdgcn_cvt_pk_f32_fp8((int)gv[r][j], true);
                const f32x2 p01 = __builtin_amdgcn_cvt_pk_f32_fp8((int)pv_[r][j], false), p23 = __builtin_amdgcn_cvt_pk_f32_fp8((int)pv_[r][j], true);
                const float rg = rpp * (1.0f / GATE_SCALE);
                v[r][j][0] += g01[0] * (p01[0] * rg * pg_[0]); v[r][j][1] += g01[1] * (p01[1] * rg * pg_[1]);
                v[r][j][2] += g23[0] * (p23[0] * rg * pg_[2]); v[r][j][3] += g23[1] * (p23[1] * rg * pg_[3]);
                s[r] += (v[r][j].x * v[r][j].x + v[r][j].y * v[r][j].y) + (v[r][j].z * v[r][j].z + v[r][j].w * v[r][j].w); } }
#pragma unroll
        for (int r = 0; r < 2; ++r) { const int m = m0 + r * NGW; float* xr = F.out + (size_t)m * DM; const float rstd = 1.0f / sqrtf(wave_sum(s[r]) * (1.f / DM) + EPS);
#pragma unroll
            for (int j = 0; j < 4; ++j) { const int col = 4 * LANE_ + 256 * j; __builtin_nontemporal_store(v[r][j] * rstd * fgv[j], (f32x4*)(xr + col)); } }
    }
}

struct Args { const float* in[23]; float* out; unsigned char* ws; };
#if CHECK_STAGE
__device__ __forceinline__ unsigned hmix(unsigned z) { z ^= z >> 16; z *= 0x7feb352du; z ^= z >> 15; z *= 0x846ca68bu; z ^= z >> 16; return z; }
__device__ __forceinline__ void chk_add(const Frame& F, int st, bool bad) { atomicAdd((unsigned*)(F.ctl + CW_CHK + 2 * st), bad ? 1u : 0u); atomicAdd((unsigned*)(F.ctl + CW_CHK + 2 * st + 1), 1u); }
__device__ __forceinline__ bool offby(float got, float ex, float rel, float ab) { const float d = fabsf(got - ex); return !(d <= rel * fabsf(ex) + ab); }
__device__ __forceinline__ float dot_bf(const bf16* a, const bf16* b, int n) { float s = 0.f; for (int k = 0; k < n; ++k) s += bf2f(a[k]) * bf2f(b[k]); return s; }
__device__ __forceinline__ float gelu_ref(float v) { return 0.5f * v * (1.0f + erff(v * 0.70710678f)); }
__device__ __forceinline__ unsigned chk_tstart(const Frame& F, unsigned ex) { const unsigned* cntg = (const unsigned*)(F.ctl + CW_CNT); unsigned s_ = 0; for (unsigned e = 0; e < ex; ++e) { unsigned c = cntg[e * CNT_STRIDE]; if (c > (unsigned)T) c = T; s_ += (c + 255u) >> 8; } return s_; }
template <int ST> __device__ __forceinline__ void stage_check(const Frame& F) {
    const unsigned gt = (unsigned)blockIdx.x * NTHR + threadIdx.x;
    const unsigned h0 = hmix(gt * 2654435761u + ST * 40503u), h1 = hmix(h0 + 0x9e3779b9u), h2 = hmix(h1 + 0x85ebca6bu);
    if (ST == 1) {
        if (gt >= 16384) return;
        const int which = gt & 7;
        if (which == 0) { const int e = h0 % NE, n = h1 % (2 * FF), k = h2 % DM; const int lc = CmWgu()(n);
            const float ex = bf2f((bf16)f2bf(F.w_gu[((size_t)e * DM + k) * 2 * FF + lc] * F.ffn_norm[k])); chk_add(F, ST, offby(bf2f(wsp<bf16>(F, WS_WGU)[((size_t)e * 2 * FF + n) * DM + k]), ex, 1e-6f, 1e-30f)); }
        else if (which == 1) { const int e = h0 % NE, n = h1 % DM, k = h2 % FF;
            const float ex = bf2f((bf16)f2bf(F.w_dn[((size_t)e * FF + k) * DM + n])); chk_add(F, ST, offby(bf2f(wsp<bf16>(F, WS_WDN)[((size_t)e * DM + n) * FF + k]), ex, 1e-6f, 1e-30f)); }
        else if (which == 2) { const int n = h1 % NPROJ, k = h2 % DM; const int lc = CmWin()(n);
            const float ex = bf2f((bf16)f2bf(F.w_in[(size_t)k * NPROJ + lc] * F.mix_norm[k])); chk_add(F, ST, offby(bf2f(wsp<bf16>(F, WS_WIN)[(size_t)n * DM + k]), ex, 1e-6f, 1e-30f)); }
        else if (which == 3) { const int n = h1 % DM, k = h2 % DM; const float g = k < AW ? F.aon[k] : F.gon[k - AW];
            const float ex = bf2f((bf16)f2bf(F.w_out[(size_t)k * DM + n] * g)); chk_add(F, ST, offby(bf2f(wsp<bf16>(F, WS_WOUT)[(size_t)n * DM + k]), ex, 1e-6f, 1e-30f)); }
        else if (which == 4) { const int n = h1 % DM, k = h2 % DM;
            const float ex = bf2f((bf16)f2bf(F.w_pg[(size_t)k * DM + n] * F.ple_norm[k])); chk_add(F, ST, offby(bf2f(wsp<bf16>(F, WS_WPG)[(size_t)n * DM + k]), ex, 1e-6f, 1e-30f)); }
        else if (which == 5) { const int n = h1 % DM, k = h2 % PLE;
            const float ex = bf2f((bf16)f2bf(F.w_pp[(size_t)k * DM + n])); chk_add(F, ST, offby(bf2f(wsp<bf16>(F, WS_WPP)[(size_t)n * PLE + k]), ex, 1e-6f, 1e-30f)); }
        else if (which == 6) { const int row = h0 % T, k = h1 % DM; float ss = 0.f; for (int j = 0; j < DM; ++j) { const float v = F.x[(size_t)row * DM + j]; ss += v * v; }
            const float ex = F.x[(size_t)row * DM + k] / sqrtf(ss / DM + EPS); chk_add(F, ST, offby(bf2f(wsp<bf16>(F, WS_XNB)[(size_t)row * DM + k]), ex, 0.01f, 1e-3f)); }
        else { const int row = h0 % T, k = h1 % PLE; chk_add(F, ST, offby(bf2f(wsp<bf16>(F, WS_PB)[(size_t)row * PLE + k]), F.p[(size_t)row * PLE + k], 0.005f, 1e-6f)); }
    }
    if (ST == 2) {
        if (gt >= 16384) return;
        const bf16* XN = wsp<bf16>(F, WS_XNB); const bf16* WIN = wsp<bf16>(F, WS_WIN);
        if ((gt & 7) == 7) {
            const int b = h0 % BATCH, hh = h1 % NH, blk = h2 % NBLK, c = (h2 >> 8) % HD; float s_ = 0.f;
            for (int r = 0; r < 256; ++r) s_ += bf2f(wsp<bf16>(F, WS_K)[((size_t)b * SEQ + blk * 256 + r) * AW + hh * HD + c]);
            chk_add(F, ST, offby(wsp<float>(F, WS_KMEAN)[((size_t)(b * NH + hh) * NBLK + blk) * HD + c], s_, 0.02f, 0.3f)); return; }
        const int row = h0 % T, type = h1 % 5, c = h2 % AW; const bf16* xr = XN + (size_t)row * DM;
        const float v = dot_bf(xr, WIN + (size_t)(type * AW + c) * DM, DM); float ex;
        if (type <= 1) { const float vp = dot_bf(xr, WIN + (size_t)(type * AW + (c ^ 4)) * DM, DM); const int i = 4 * ((c & 63) >> 3) + (c & 3), pos = row & (SEQ - 1);
            const float cs = wsp<float>(F, WS_ROPE)[pos * 32 + i], sn = wsp<float>(F, WS_ROPE)[SEQ * 32 + pos * 32 + i];
            { const float inv = powf(10000.0f, -(float)i / 32.0f); const float ang = (float)pos * inv; if (offby(cs, cosf(ang), 0.f, 1e-3f) || offby(sn, sinf(ang), 0.f, 1e-3f)) { chk_add(F, ST, true); return; } }
            ex = (c & 4) ? v * cs + vp * sn : v * cs - vp * sn; }
        else if (type == 2) ex = v; else ex = gelu_ref(v);
        chk_add(F, ST, offby(bf2f(wsp<bf16>(F, WS_Q)[(size_t)type * (16u << 20) + (size_t)row * AW + c]), ex, 0.02f, 0.02f));
    }
    if (ST == 3) {
        if (gt >= 8192) return;
        if (gt & 1) {
            const int row = h0 % T, g = h1 % GG, d = h2 % GD; const int b = row / SEQ, s_ = row % SEQ, c = s_ / GC, t = s_ % GC; float acc = 0.f;
            for (int sp = 0; sp <= t; ++sp) { const bf16* vr = wsp<bf16>(F, WS_VG) + ((size_t)b * SEQ + c * GC + sp) * GW + g * GD; float mu = 0.f; for (int j = 0; j < GD; ++j) mu += bf2f(vr[j]); mu /= GD;
                float var = 0.f; for (int j = 0; j < GD; ++j) { const float dd = bf2f(vr[j]) - mu; var += dd * dd; } const float rstd = 1.0f / sqrtf(var / GD + EPS);
                const float vn = bf2f((bf16)f2bf((bf2f(vr[d]) - mu) * rstd * F.ln_g[g * GD + d] + F.ln_b[g * GD + d])); acc += bf2f((bf16)f2bf(F.gws[((size_t)g * GC + t) * GC + sp])) * vn; }
            const float ex = bf2f(wsp<bf16>(F, WS_U)[(size_t)row * GW + g * GD + d]) * (acc + F.gbs[g * GC + t]);
            chk_add(F, ST, offby(bf2f(wsp<bf16>(F, WS_MIX)[(size_t)row * DM + AW + g * GD + d]), ex, 0.03f, 0.02f)); return; }
        const int row = h0 % T, hh = h1 % NH; const int b = row / SEQ, s_ = row % SEQ, qb = s_ / MOBA; float q[HD];
#pragma unroll
        for (int c = 0; c < HD; ++c) q[c] = bf2f(wsp<bf16>(F, WS_Q)[(size_t)row * AW + hh * HD + c]);
        unsigned sel = 0u;
        if (qb <= 3) sel = (1u << qb) - 1u;
        else { float b0 = -__builtin_inff(), b1 = b0, b2 = b0; int i0 = 0, i1 = 0, i2 = 0;
            for (int j = 0; j < qb; ++j) { const float* km = wsp<float>(F, WS_KMEAN) + ((size_t)(b * NH + hh) * NBLK + j) * HD; float g = 0.f;
#pragma unroll
                for (int c = 0; c < HD; ++c) g += q[c] * km[c];
                if (g > b0) { b2 = b1; i2 = i1; b1 = b0; i1 = i0; b0 = g; i0 = j; } else if (g > b1) { b2 = b1; i2 = i1; b1 = g; i1 = j; } else if (g > b2) { b2 = g; i2 = j; } }
            sel = (1u << i0) | (1u << i1) | (1u << i2); }
        float mx = -__builtin_inff();
        for (int kp = 0; kp <= s_; ++kp) { const int blk = kp / MOBA; if (blk != qb && !((sel >> blk) & 1u)) continue; const bf16* kr = wsp<bf16>(F, WS_K) + ((size_t)b * SEQ + kp) * AW + hh * HD; float sc = 0.f;
#pragma unroll
            for (int c = 0; c < HD; ++c) sc += q[c] * bf2f(kr[c]);
            mx = fmaxf(mx, sc * 0.125f); }
        float o[HD]; float l = 0.f;
#pragma unroll
        for (int c = 0; c < HD; ++c) o[c] = 0.f;
        for (int kp = 0; kp <= s_; ++kp) { const int blk = kp / MOBA; if (blk != qb && !((sel >> blk) & 1u)) continue; const bf16* kr = wsp<bf16>(F, WS_K) + ((size_t)b * SEQ + kp) * AW + hh * HD; float sc = 0.f;
#pragma unroll
            for (int c = 0; c < HD; ++c) sc += q[c] * bf2f(kr[c]);
            const float pr = expf(sc * 0.125f - mx); l += pr; const bf16* vr = wsp<bf16>(F, WS_V) + ((size_t)b * SEQ + kp) * AW + hh * HD;
#pragma unroll
            for (int c = 0; c < HD; ++c) o[c] += pr * bf2f(vr[c]); }
        bool bad = false; float ss = 0.f;
#pragma unroll
        for (int c = 0; c < HD; ++c) { const float ex = o[c] / l; ss += ex * ex; bad |= offby(bf2f(wsp<bf16>(F, WS_MIX)[(size_t)row * DM + hh * HD + c]), ex, 0.04f, 0.02f); }
        bad |= offby(wsp<float>(F, WS_SSQA)[(size_t)row * NH + hh], ss, 0.03f, 1e-3f);
        chk_add(F, ST, bad);
    }
    if (ST == 4) {
        if (gt >= 16384) return;
        const int row = h0 % T, col = h1 % DM; const bf16* mr = wsp<bf16>(F, WS_MIX) + (size_t)row * DM; const bf16* wr_ = wsp<bf16>(F, WS_WOUT) + (size_t)col * DM;
        float sa = 0.f, sg = 0.f, da = 0.f, dg = 0.f;
        for (int k = 0; k < AW; ++k) { const float a = bf2f(mr[k]), g = bf2f(mr[AW + k]); sa += a * a; sg += g * g; da += a * bf2f(wr_[k]); dg += g * bf2f(wr_[AW + k]); }
        const float ex = F.x[(size_t)row * DM + col] + da / sqrtf(sa / AW + EPS) + dg / sqrtf(sg / GW + EPS);
        chk_add(F, ST, offby(F.out[(size_t)row * DM + col], ex, 0.01f, 0.03f));
    }
    if (ST == 5) {
        if (gt >= 8192) return;
        const int tok = h0 % T; const float* xr = F.out + (size_t)tok * DM; float ss = 0.f; for (int k = 0; k < DM; ++k) ss += xr[k] * xr[k]; const float rstd = 1.0f / sqrtf(ss / DM + EPS);
        bool bad = false;
        for (int j = 0; j < 4; ++j) { const int k = (h1 >> (8 * j)) % DM; bad |= offby(bf2f(wsp<bf16>(F, WS_XNB)[(size_t)tok * DM + k]), xr[k] * rstd, 0.01f, 1e-3f); }
        float lg[NE];
#pragma unroll
        for (int e = 0; e < NE; ++e) lg[e] = 0.f;
        for (int k = 0; k < DM; ++k) { const float xv = xr[k] * rstd * F.ffn_norm[k];
#pragma unroll
            for (int e = 0; e < NE; ++e) lg[e] += xv * F.router_w[k * NE + e]; }
#pragma unroll
        for (int e = 0; e < NE; ++e) lg[e] += F.router_b[e];
        int te[4]; float tv[4]; unsigned used = 0u;
#pragma unroll
        for (int k = 0; k < 4; ++k) { float best = -__builtin_inff(); int bi = 0;
#pragma unroll
            for (int e = 0; e < NE; ++e) if (!((used >> e) & 1u) && lg[e] > best) { best = lg[e]; bi = e; }
            used |= 1u << bi; te[k] = bi; tv[k] = best; }
        { float gg[4]; float den = 0.f;
#pragma unroll
          for (int k = 0; k < 4; ++k) { float v = -__builtin_inff();
#pragma unroll
              for (int e = 0; e < NE; ++e) if (e == te[k]) v = lg[e];
              gg[k] = v; }
          const float mm = gg[0];
#pragma unroll
          for (int k = 0; k < 4; ++k) { gg[k] = expf(gg[k] - mm); den += gg[k]; }
          const unsigned* tp = wsp<unsigned>(F, WS_TOKPOS) + (size_t)tok * 4;
#pragma unroll
          for (int k = 0; k < 4; ++k) { const unsigned e = tp[k] >> 16, slot = tp[k] & 0xffffu; bad |= (e != (unsigned)te[k]);
              if (e < NE && slot < (unsigned)T) { bad |= wsp<unsigned>(F, WS_IDX)[(size_t)e * T + slot] != (unsigned)tok; bad |= offby(wsp<float>(F, WS_GSS)[(size_t)e * T + slot], gg[k] / den, 2e-3f, 1e-5f);
                  bad |= slot >= ((const unsigned*)(F.ctl + CW_CNT))[e * CNT_STRIDE]; } else bad = true; } }
        (void)tv;
        chk_add(F, ST, bad);
    }
    if (ST == 6 || ST == 7) {
        if (gt >= 16384) return;
        const int tok = h0 % T, k = h1 & 3, col = (h1 >> 2) % FF; const unsigned tp = wsp<unsigned>(F, WS_TOKPOS)[(size_t)tok * 4 + k]; const unsigned e = tp >> 16, slot = tp & 0xffffu;
        if (e >= NE) { chk_add(F, ST, true); return; }
        const unsigned tse = chk_tstart(F, e);
        const size_t row = (size_t)tse * 256 + slot;
        if (ST == 6) { const bf16* xr = wsp<bf16>(F, WS_XNB) + (size_t)tok * DM; const int np = (col >> 7) * 256 + (col & 127);
            const float g = dot_bf(xr, wsp<bf16>(F, WS_WGU) + ((size_t)e * 2 * FF + np) * DM, DM) + F.b_gu[(size_t)e * 2 * FF + col];
            const float l = dot_bf(xr, wsp<bf16>(F, WS_WGU) + ((size_t)e * 2 * FF + np + 128) * DM, DM) + F.b_gu[(size_t)e * 2 * FF + FF + col];
            const float gc = fminf(g, 7.f), lc = fminf(fmaxf(l, -7.f), 7.f); const float ex = gc / (1.0f + expf(-1.702f * gc)) * (lc + 1.0f);
            chk_add(F, ST, offby(bf2f(wsp<bf16>(F, WS_ABUF)[row * FF + col]), ex, 0.03f, 0.03f)); }
        else { const float d = dot_bf(wsp<bf16>(F, WS_ABUF) + row * FF, wsp<bf16>(F, WS_WDN) + ((size_t)e * DM + col) * FF, FF) + F.b_dn[(size_t)e * DM + col];
            const float ex = d * wsp<float>(F, WS_GSS)[(size_t)e * T + slot];
            chk_add(F, ST, offby(bf2f(wsp<bf16>(F, WS_YBUF)[row * DM + col]), ex, 0.03f, 0.01f)); }
    }
    if (ST == 8) {
        if (gt >= 8192) return;
        const int tok = h0 % T; const float* xr = F.out + (size_t)tok * DM; float ss = 0.f; for (int k = 0; k < DM; ++k) ss += xr[k] * xr[k]; const float rstd = 1.0f / sqrtf(ss / DM + EPS);
        bool bad = false; for (int k = 0; k < DM; ++k) { bad |= offby(bf2f(wsp<bf16>(F, WS_X2N)[(size_t)tok * DM + k]), xr[k] * rstd, 0.01f, 1e-3f); bad |= !(fabsf(xr[k]) < 30.f); }
        chk_add(F, ST, bad);
    }
    if (ST == 9) {
        if (gt >= 16384) return;
        const int row = h0 % T, col = h1 % DM;
        if (gt & 1) { const float d = dot_bf(wsp<bf16>(F, WS_X2N) + (size_t)row * DM, wsp<bf16>(F, WS_WPG) + (size_t)col * DM, DM); const float got = bf2f(wsp<bf16>(F, WS_GATE)[(size_t)row * DM + col]); const float ex = 1.0f / (1.0f + expf(-d)); const bool bad = offby(got, ex, 0.02f, 0.01f); chk_add(F, ST, bad);
            if (bad) { atomicOr((unsigned*)(F.ctl + CW_CHK + 40), 1u << ((col >> 3) & 31)); atomicOr((unsigned*)(F.ctl + CW_CHK + 41), 1u << ((row >> 3) & 31)); atomicOr((unsigned*)(F.ctl + CW_CHK + 42), 1u << (col & 7)); atomicOr((unsigned*)(F.ctl + CW_CHK + 43), 1u << (row & 7));
                if (!(got >= 0.f && got <= 1.f)) atomicAdd((unsigned*)(F.ctl + CW_CHK + 44), 1u); { int cl = (int)floorf(log2f(fabsf(got) + 1e-30f)) + 40; cl = cl < 0 ? 0 : (cl > 80 ? 80 : cl); atomicMax((unsigned*)(F.ctl + CW_CHK + 46), (unsigned)cl); atomicMin((unsigned*)(F.ctl + CW_CHK + 47), 0xffffffffu - (unsigned)cl); if (got < 0.f) atomicAdd((unsigned*)(F.ctl + CW_CHK + 48), 1u); } if (fabsf(got - ex) > 0.2f) atomicAdd((unsigned*)(F.ctl + CW_CHK + 45), 1u); } }
        else { const float d = dot_bf(wsp<bf16>(F, WS_PB) + (size_t)row * PLE, wsp<bf16>(F, WS_WPP) + (size_t)col * PLE, PLE); chk_add(F, 10, offby(bf2f(wsp<bf16>(F, WS_PP)[(size_t)row * DM + col]), d, 0.02f, 0.02f)); }
    }
}
__device__ __forceinline__ void check_report(const Frame& F) {
    float c2 = 3.0f;
    for (int st = 1; st <= 10; ++st) { const unsigned bad = F.ctl[CW_CHK + 2 * st], tot = F.ctl[CW_CHK + 2 * st + 1]; const float fr = tot ? (float)bad / (float)tot : 1.0f;
        (void)fr; if (((CHECK_SKIP >> st) & 1) == 0 && bad >= 1u) { c2 = powf(10.0f, (float)st) * (1.0f + fminf((float)bad, 80.0f) * 0.1f); break; } }
#if CHECK_REPORT >= 40
    { unsigned v = F.ctl[CW_CHK + CHECK_REPORT]; if (CHECK_REPORT == 47) v = 0xffffffffu - v; c2 = powf(10.0f, (float)(v >> 27)) * (1.0f + (float)((v >> 21) & 63u) * 0.1f);
#if CHECK_REPORT2
      c2 = powf(10.0f, (float)((v >> 16) & 31u)) * (1.0f + (float)((v >> 10) & 63u) * 0.1f);
#endif
#if CHECK_REPORT3
      c2 = powf(10.0f, (float)((v >> 5) & 31u)) * (1.0f + (float)(v & 31u) * 0.1f);
#endif
      if (CHECK_REPORT >= 46 && CHECK_REPORT <= 47) c2 = powf(10.0f, (float)(v / 9u)) * (1.0f + (float)(v % 9u));
    }
#endif
    if (g_gridbar[XB_TMO] != 0u) c2 = 1e20f;
    const float c = sqrtf(c2);
    for (size_t i = (size_t)blockIdx.x * NTHR + threadIdx.x; i < (size_t)T * DM; i += (size_t)gridDim.x * NTHR) F.out[i] = c;
}
#define STAGE_CHECK(n) stage_check<(n)>(F)
#else
#define STAGE_CHECK(n) do {} while (0)
#endif

__global__ void __launch_bounds__(NTHR, 2) mega_fwd(Args args) {
    extern __shared__ __attribute__((aligned(16))) unsigned char lds_raw[];
    Frame F;
    F.lds = (LAS unsigned char*)lds_raw;
    F.MISC = (volatile LAS unsigned*)(F.lds + LDSCTL_OFF);
    F.G = gridDim.x; { const int bx = blockIdx.x; F.vcu = (F.G % 8 == 0) ? (bx % 8) * (F.G / 8) + bx / 8 : bx; }
    F.ws = args.ws; F.ctl = (gu32*)(args.ws + WS_CTL); F.out = args.out;
    F.x = args.in[0]; F.p = args.in[1]; F.mix_norm = args.in[2]; F.w_in = args.in[3]; F.ln_g = args.in[4]; F.ln_b = args.in[5]; F.gws = args.in[6]; F.gbs = args.in[7];
    F.aon = args.in[8]; F.gon = args.in[9]; F.w_out = args.in[10]; F.ffn_norm = args.in[11]; F.router_w = args.in[12]; F.router_b = args.in[13]; F.w_gu = args.in[14]; F.b_gu = args.in[15];
    F.w_dn = args.in[16]; F.b_dn = args.in[17]; F.ple_norm = args.in[18]; F.w_pg = args.in[19]; F.w_pp = args.in[20]; F.ppn = args.in[21]; F.final_norm = args.in[22];
    { PHASE_IDS; for (int u = TID_; u < 256; u += NTHR) ((LAS unsigned*)(F.lds + LDSCTL_OFF))[u] = 0u; }
    __syncthreads();
    XcdBarrier bar = xcd_barrier_post(g_gridbar, F.MISC + 8);
#define GRID_BAR() xcd_barrier(bar)
#define STAGE_END(n) do { STAGE_CHECK(n); if (TPROBE && blockIdx.x == 0 && threadIdx.x == 0) ((unsigned long long*)(F.ctl + CW_TS))[(n)] = __builtin_amdgcn_s_memrealtime(); } while (0)

    if (TPROBE && blockIdx.x == 0 && threadIdx.x == 0) ((unsigned long long*)(F.ctl + CW_TS))[0] = __builtin_amdgcn_s_memrealtime();
    for (int rep = 0; rep < (DUP_PHASE == 0 ? 2 : 1); ++rep) {
    if (PH(0)) p0_prologue(F);
    GRID_BAR(); }
    STAGE_END(1);
    if (PH(1)) { pg8::DenseSched S; S.init(wsp<bf16>(F, WS_XNB), wsp<bf16>(F, WS_WIN), T, NPROJ, DM, F.G, (int)blockIdx.x);
      float* RC = wsp<float>(F, WS_ROPE);
      EpiInProj E{wsp<bf16>(F, WS_Q), RC, RC + SEQ * 32, wsp<float>(F, WS_KMEAN)};
      for (int rep = 0; rep < (DUP_PHASE == 1 ? 2 : 1); ++rep) { if (rep) GRID_BAR();
      pg8::gemm_phase<EpiInProj, pg8::DenseSched, false, false>(F.lds + RING_OFF, DM * 2, S, E); } }
    GRID_BAR();
    STAGE_END(2);
    for (int rep = 0; rep < (DUP_PHASE == 2 ? 2 : 1); ++rep) {
    if (PH(2)) p2_mixers(F);
    GRID_BAR(); }
    STAGE_END(3);
    if (PH(3)) { pg8::DenseSched S; S.init(wsp<bf16>(F, WS_MIX), wsp<bf16>(F, WS_WOUT), T, DM, DM, F.G, (int)blockIdx.x);
      LAS f32x4* rtab = (LAS f32x4*)(F.lds + XTAB_OFF);
      Unit ua, ub; const bool ha = S.next(0, ua), hb = S.next(1, ub);
      { PHASE_IDS; const int s = TID_ >> 8, r = TID_ & 255; const bool has = s ? hb : ha; const int pm = s ? ub.pm : ua.pm;
        if (has) { const size_t row = (size_t)pm * 256 + r; const f32x4* pa = (const f32x4*)(wsp<float>(F, WS_SSQA) + row * NH); const f32x4 a0 = pa[0], a1 = pa[1], g0 = *(const f32x4*)(wsp<float>(F, WS_SSQG) + row * GG);
            const float sa = ((a0[0] + a0[1]) + (a0[2] + a0[3])) + ((a1[0] + a1[1]) + (a1[2] + a1[3])), sg = (g0[0] + g0[1]) + (g0[2] + g0[3]);
            const float ra = 1.0f / sqrtf(sa * (1.f / AW) + EPS), rg = 1.0f / sqrtf(sg * (1.f / GW) + EPS);
            rtab[s * 256 + r] = (f32x4){ra / rg, rg, wsp<float>(F, WS_SIG0)[row], 0.f}; } }
      __syncthreads();
      EpiOutProj E{wsp<bf16>(F, WS_XNB), wsp<bf16>(F, WS_X1B), wsp<unsigned char>(F, WS_X1F8), wsp<float>(F, WS_SSQ1), rtab, F.ffn_norm, ha ? ua.pm : -1, hb ? ub.pm : -1};
      for (int rep = 0; rep < (DUP_PHASE == 3 ? 2 : 1); ++rep) { if (rep) GRID_BAR();
      pg8::gemm_phase<EpiOutProj, pg8::DenseSched, false, true>(F.lds + RING_OFF, DM * 2, S, E); } }
    GRID_BAR();
    STAGE_END(4);
    if (PH(4)) p4_router(F);
    GRID_BAR();
    STAGE_END(5);
    if (PH(5)) { const int nu = moe_build_tables(F, 2 * FF / 256, 1);
      pg8::MoeSched S{(const char*)wsp<char>(F, WS_X1F8), (const char*)wsp<char>(F, WS_WGU), 0, (size_t)2 * FF * DM, (size_t)256 * DM, nu,
                      (const LAS unsigned*)(F.lds + XTAB_OFF + XT_ULIST), (const LAS unsigned*)(F.lds + XTAB_OFF + XT_GTAB), true};
      EpiMoe1 E{wsp<unsigned char>(F, WS_ABUF), F.b_gu, (const LAS float*)(F.lds + XTAB_OFF + XT_RS)};
      for (int rep = 0; rep < (DUP_PHASE == 5 ? 2 : 1); ++rep) { if (rep) GRID_BAR();
      int Kb = DM; asm volatile("" : "+s"(Kb));
      pg8::gemm_phase<EpiMoe1, pg8::MoeSched, true, false, true>(F.lds + RING_OFF, Kb, S, E); } }
    GRID_BAR();
    STAGE_END(6);
    if (PH(6)) { const int nu = moe_build_tables(F, DM / 256, 2);
      pg8::MoeSched S{(const char*)wsp<char>(F, WS_ABUF), (const char*)wsp<char>(F, WS_WDN), (size_t)256 * FF, (size_t)DM * FF, (size_t)256 * FF, nu,
                      (const LAS unsigned*)(F.lds + XTAB_OFF + XT_ULIST), (const LAS unsigned*)(F.lds + XTAB_OFF + XT_GTAB), false};
      EpiMoe2 E{wsp<unsigned char>(F, WS_YBUF), F.b_dn, (const LAS float*)(F.lds + XTAB_OFF + XT_RS)};
      for (int rep = 0; rep < (DUP_PHASE == 6 ? 2 : 1); ++rep) { if (rep) GRID_BAR();
      int Kb = FF; asm volatile("" : "+s"(Kb));
      pg8::gemm_phase<EpiMoe2, pg8::MoeSched, false, false, true>(F.lds + RING_OFF, Kb, S, E); } }
    GRID_BAR();
    STAGE_END(7);
    if (PH(7)) { const int first = (blockIdx.x >> 3) & 1;
#pragma unroll 1
      for (int step = 0; step < 2; ++step) {
          if ((step ^ first) == 0) { p7_combine(F); __syncthreads(); }
          else { pg8::DenseSched S; S.init(wsp<bf16>(F, WS_PB), wsp<bf16>(F, WS_WPP), T, DM, PLE, F.G, (int)blockIdx.x);
              EpiPle<1> E{wsp<unsigned char>(F, WS_PP), wsp<float>(F, WS_SSQPP), nullptr, -1};
              int Kp = PLE * 2; asm volatile("" : "+s"(Kp));
              pg8::gemm_phase<EpiPle<1>, pg8::DenseSched, false, false>(F.lds + RING_OFF, Kp, S, E); } } }
    GRID_BAR();
    STAGE_END(8);
    if (PH(8)) { pg8::DenseSched S; S.init(wsp<unsigned char>(F, WS_X2F8), wsp<unsigned char>(F, WS_WPG8), T, DM, DM, F.G, (int)blockIdx.x, 1);
      LAS float* rt2 = (LAS float*)(F.lds + XTAB_OFF); Unit ua, ub; const bool ha = S.next(0, ua), hb = S.next(1, ub);
      { PHASE_IDS; const int sl = TID_ >> 8, r = TID_ & 255; const bool has = sl ? hb : ha; const int pm = sl ? ub.pm : ua.pm; if (has) rt2[sl * 256 + r] = wsp<float>(F, WS_RSTD2)[(size_t)pm * 256 + r]; }
      __syncthreads();
      EpiPle<0> E{wsp<unsigned char>(F, WS_GATE), nullptr, rt2, ha ? ua.pm : -1};
      int Kb = DM; asm volatile("" : "+s"(Kb));
      pg8::gemm_phase<EpiPle<0>, pg8::DenseSched, false, false, true>(F.lds + RING_OFF, Kb, S, E);
#if CHECK_STAGE
      GRID_BAR();
      int Kb = DM; asm volatile("" : "+s"(Kb));
      pg8::gemm_phase<EpiPle<0>, pg8::DenseSched, false, false, true>(F.lds + RING_OFF, Kb, S, E);
#endif
    }
#if CHECK_STAGE
    GRID_BAR(); STAGE_CHECK(9);
#endif
    GRID_BAR();
    STAGE_END(9);
#if CHECK_STAGE
    GRID_BAR(); check_report(F);
#else
    if (PH(9)) p9_final(F);
#if TPROBE
    GRID_BAR();
    if (blockIdx.x == 0 && threadIdx.x == 0) { const unsigned long long* ts = (const unsigned long long*)(F.ctl + CW_TS); const unsigned long long t1 = (TP_A == 9) ? __builtin_amdgcn_s_memrealtime() : ts[(TP_A < 10 ? TP_A : 0) + 1];
        unsigned long long d = t1 - ts[TP_A < 10 ? TP_A : 0];
        if (TP_A == 20) d = ts[11] - ts[0]; if (TP_A == 21) d = ts[12] - ts[11]; if (TP_A == 22) d = ts[13] - ts[12]; if (TP_A == 23) d = ts[1] - ts[13]; if (TP_A == 24) d = ts[14] - ts[2]; if (TP_A == 25) d = ts[3] - ts[14];
        if (TP_A == 30) d = (__builtin_amdgcn_s_memrealtime() - ts[0]) / 8;
        F.out[0] += floorf((float)d * 0.01f * 0.125f + 0.5f) * 2.0f; }
#endif
#endif
    __syncthreads();
    if (threadIdx.x == 0) {
        if (xb_add(&g_gridbar[XB_DONE], 1u) == gridDim.x - 1u) {
#pragma unroll 1
            for (unsigned j = 0; j < 16; ++j) { __hip_atomic_store(&g_gridbar[XB_XCNT(j)], 0u, __ATOMIC_RELAXED, __HIP_MEMORY_SCOPE_AGENT); __hip_atomic_store(&g_gridbar[XB_XSUB(j)], 0u, __ATOMIC_RELAXED, __HIP_MEMORY_SCOPE_AGENT);
                __hip_atomic_store(&g_gridbar[XB_XGEN(j)], 0u, __ATOMIC_RELAXED, __HIP_MEMORY_SCOPE_AGENT); }
            __hip_atomic_store(&g_gridbar[XB_TOP], 0u, __ATOMIC_RELAXED, __HIP_MEMORY_SCOPE_AGENT); __hip_atomic_store(&g_gridbar[XB_TOPGEN], 0u, __ATOMIC_RELAXED, __HIP_MEMORY_SCOPE_AGENT);
            __hip_atomic_store(&g_gridbar[XB_TMO], 0u, __ATOMIC_RELAXED, __HIP_MEMORY_SCOPE_AGENT); __hip_atomic_store(&g_gridbar[XB_DONE], 0u, __ATOMIC_RELAXED, __HIP_MEMORY_SCOPE_AGENT); } }
}

extern "C" void kernel_launch(void* const* d_in, const int* in_sizes, int n_in, void* d_out, int out_size, void* d_ws, size_t ws_size, hipStream_t stream) {
    static int grid = 0;
    if (grid == 0) {
        if (n_in != 23 || in_sizes[0] != T * DM || out_size != T * DM || ws_size < WS_END) { fprintf(stderr, "kernel_launch: unexpected shapes (n_in %d, in0 %d, out %d, ws %zu)\n", n_in, n_in > 0 ? in_sizes[0] : -1, out_size, ws_size); grid = -1; return; }
        int dev = 0, cus = 0, per_cu = 0;
        if (hipGetDevice(&dev) != hipSuccess || hipDeviceGetAttribute(&cus, hipDeviceAttributeMultiprocessorCount, dev) != hipSuccess) { grid = -1; return; }
        if (hipFuncSetAttribute((const void*)mega_fwd, hipFuncAttributeMaxDynamicSharedMemorySize, LDS_BYTES) != hipSuccess) { fprintf(stderr, "kernel_launch: hipFuncSetAttribute failed\n"); grid = -1; return; }
        if (hipOccupancyMaxActiveBlocksPerMultiprocessor(&per_cu, (const void*)mega_fwd, NTHR, LDS_BYTES) != hipSuccess || per_cu < 1)
            fprintf(stderr, "kernel_launch: note: occupancy query reports %d workgroups per CU\n", per_cu);
        (void)hipGetLastError();
        if (cus < 256) { fprintf(stderr, "kernel_launch: built for a 256-CU device (found %d CUs); nothing launched\n", cus); grid = -1; return; }
        grid = 256;
    }
    if (grid < 0) return;
    Args a{};
    for (int i = 0; i < 23; ++i) a.in[i] = (const float*)d_in[i];
    a.out = (float*)d_out; a.ws = (unsigned char*)d_ws;
    hipLaunchKernelGGL(mega_fwd, dim3(grid), dim3(NTHR), LDS_BYTES, stream, a);
}
```
